# Optimizing an MI355X kernel written in HIP

```python
import math
import jax
import jax.numpy as jnp
from jax import lax
import numpy as np

D_MODEL = 1024
BATCH = 16
SEQ = 2048
DEPTH = 4

GRID_W = 64
CTX_LEN = 256

D_MIX = D_MODEL
GROUP_W = D_MIX // 4
HY_W = GROUP_W
SC_W = GROUP_W
GLA_HEADS = 4
GLA_DV = GROUP_W // GLA_HEADS
GLA_DK = GLA_DV // 2
GLA_QK = GLA_HEADS * GLA_DK
GLA_V = GLA_HEADS * GLA_DV
GLA_RANK = 16
GLA_TAU = 16.0
GDN_HEADS = 4
GDN_DK = GROUP_W // GDN_HEADS
GDN_DV = GDN_DK
GDN_KW = GDN_HEADS * GDN_DK
GDN_VW = GDN_HEADS * GDN_DV
HY_EMB = 33
HY_HID = 64
HY_DECAY_TARGET = 1e-2
HY_FAST_PCT = 0.3
HY_SLOW_PCT = 1.5
CHUNK = 64
N_EXPERTS = 32
TOP_K = 4
D_EXPERT = D_MODEL
SWIGLU_LIMIT = 7.0
SWIGLU_ALPHA = 1.702
LN_EPS = 1e-5
RMS_EPS = 1e-6
L2_EPS = 1e-6
DN_ALPHA = (2 * DEPTH) ** 0.25
DN_BETA = (8 * DEPTH) ** -0.25

HY_COLS = 3 * HY_W
SC_COLS = 3 * SC_W
GLA_COLS = 2 * GLA_QK + 2 * GLA_V + 2 * GLA_RANK
GDN_COLS = 2 * GDN_KW + 2 * GDN_VW + 4 * GDN_HEADS
D_IN = HY_COLS + SC_COLS + GLA_COLS + GDN_COLS

kernel_name = 'hybrid_hyena_conv_gla_gdn_moe_diffusion_trunk'

F32 = jnp.float32


def _split(x, sizes):
    return jnp.split(x, [int(s) for s in np.cumsum(sizes)[:-1]], axis=-1)


def layer_norm(x, g, b):
    xf = x.astype(F32)
    xc = xf - jnp.mean(xf, axis=-1, keepdims=True)
    var = jnp.mean(xc * xc, axis=-1, keepdims=True)
    return (xc * lax.rsqrt(var + LN_EPS) * g.astype(F32) + b.astype(F32)).astype(x.dtype)


def rms_norm(x, w):
    xf = x.astype(F32)
    return xf * lax.rsqrt(jnp.mean(xf * xf, axis=-1, keepdims=True) + RMS_EPS) * w.astype(F32)


def l2_normalize(x):
    return x * lax.rsqrt(jnp.sum(x * x, axis=-1, keepdims=True) + L2_EPS)


def short_conv3(x, w, n_rows):
    bsz, L, ch = x.shape
    xr = x.reshape(bsz, n_rows, L // n_rows, ch)
    xp = jnp.pad(xr, ((0, 0), (0, 0), (1, 1), (0, 0)))
    y = xp[:, :, :-2] * w[0] + xp[:, :, 1:-1] * w[1] + xp[:, :, 2:] * w[2]
    return y.reshape(bsz, L, ch)


def hyena_filters(L, w1, b1, w2, b2, w3, b3, w4, freq):
    t = jnp.linspace(0.0, 1.0, L, dtype=F32)[:, None]
    bands = (HY_EMB - 1) // 2
    ang = 2.0 * math.pi * jnp.arange(L, dtype=F32)[:, None] / L
    f = jnp.linspace(1e-4, bands - 1, bands, dtype=F32)[None, :]
    z = jnp.concatenate([t, jnp.cos(f * ang), -jnp.sin(f * ang)], axis=-1).astype(w1.dtype)
    h = jnp.sin(freq[0] * (z @ w1 + b1))
    h = jnp.sin(freq[1] * (h @ w2 + b2))
    h = jnp.sin(freq[2] * (h @ w3 + b3))
    k = (h @ w4).astype(F32)
    max_decay = math.log(HY_DECAY_TARGET) / HY_FAST_PCT
    min_decay = math.log(HY_DECAY_TARGET) / HY_SLOW_PCT
    deltas = jnp.abs(jnp.linspace(min_decay, max_decay, HY_W, dtype=F32))
    window = jnp.exp(-t * deltas[None, :])
    k_fwd = k[:, :HY_W] * window
    k_bwd = k[:, HY_W:] * window
    l1 = jnp.sum(jnp.abs(k_fwd), axis=0) + jnp.sum(jnp.abs(k_bwd[1:]), axis=0)
    return k_fwd / l1, k_bwd / l1


def hyena_mix(p, n_rows, conv_w, conv_b, k_fwd, k_bwd, d_bias):
    u = short_conv3(p, conv_w, n_rows) + conv_b
    x0, x1, v = jnp.split(u, 3, axis=-1)
    z = x1 * v
    L = z.shape[1]
    k_full = jnp.concatenate([k_fwd, jnp.zeros((1, HY_W), F32), k_bwd[:0:-1]], axis=0)
    zf = jnp.fft.rfft(z.astype(F32), n=2 * L, axis=1)
    kf = jnp.fft.rfft(k_full, axis=0)
    y = jnp.fft.irfft(zf * kf[None], n=2 * L, axis=1)[:, :L].astype(z.dtype)
    return (y + z * d_bias) * x0


def shortconv_mix(p, n_rows, conv_w):
    bg, cg, hs = jnp.split(p, 3, axis=-1)
    return bg * short_conv3(cg * hs, conv_w, n_rows)


def _to_chunks(t, n):
    bsz, L, H = t.shape[:3]
    t = t.reshape((bsz, n, CHUNK, H) + t.shape[3:])
    return jnp.moveaxis(t, (1, 3), (0, 2))


def _from_chunks(o):
    o = jnp.moveaxis(o, (0, 2), (1, 3))
    return o.reshape((o.shape[0], o.shape[1] * o.shape[2]) + o.shape[3:])


def gla_chunked(q, k, v, g, s0):
    n = q.shape[1] // CHUNK
    causal = jnp.tril(jnp.ones((CHUNK, CHUNK), dtype=bool))

    def step(S, inp):
        qc, kc, vc, gc = inp
        b = jnp.cumsum(gc, axis=2)
        b_mid = b[:, :, CHUNK // 2:CHUNK // 2 + 1]
        b_last = b[:, :, -1:]
        a = jnp.einsum('bhik,bhjk->bhij', qc * jnp.exp(b - b_mid), kc * jnp.exp(b_mid - b))
        a = jnp.where(causal, a, 0.0)
        o = jnp.einsum('bhij,bhjv->bhiv', a, vc) + jnp.einsum('bhik,bhkv->bhiv', qc * jnp.exp(b), S)
        S = jnp.exp(b_last[:, :, 0])[..., None] * S + jnp.einsum('bhjk,bhjv->bhkv', kc * jnp.exp(b_last - b), vc)
        return S, o

    S, o = lax.scan(step, s0, (_to_chunks(q, n), _to_chunks(k, n), _to_chunks(v, n), _to_chunks(g, n)))
    return _from_chunks(o), S


def gdn_chunked(q, k, v, beta, g, s0):
    n = q.shape[1] // CHUNK
    V = v.shape[-1]
    tril_incl = jnp.tril(jnp.ones((CHUNK, CHUNK), dtype=bool))
    tril_strict = jnp.tril(jnp.ones((CHUNK, CHUNK), dtype=bool), k=-1)
    eye = jnp.eye(CHUNK, dtype=q.dtype)

    def step(S, inp):
        qc, kc, vc, bc, gc = inp
        cum = jnp.cumsum(gc, axis=-1)
        decay = jnp.exp(jnp.where(tril_incl, cum[..., :, None] - cum[..., None, :], -jnp.inf))
        kb = kc * bc[..., None]
        a_strict = jnp.where(tril_strict, jnp.einsum('bhik,bhjk->bhij', kb, kc) * decay, 0.0)
        rhs = jnp.concatenate([vc * bc[..., None], kb * jnp.exp(cum)[..., None]], axis=-1)
        sol = lax.linalg.triangular_solve(a_strict + eye, rhs, left_side=True, lower=True, unit_diagonal=True)
        u, w = sol[..., :V], sol[..., V:]
        v_new = u - jnp.einsum('bhck,bhkv->bhcv', w, S)
        attn = jnp.einsum('bhik,bhjk->bhij', qc, kc) * decay
        o = jnp.einsum('bhik,bhkv->bhiv', qc * jnp.exp(cum)[..., None], S) + jnp.einsum('bhij,bhjv->bhiv', attn, v_new)
        S = jnp.exp(cum[..., -1])[..., None, None] * S + jnp.einsum(
            'bhjk,bhjv->bhkv', kc * jnp.exp(cum[..., -1:] - cum)[..., None], v_new)
        return S, o

    xs = (_to_chunks(q, n), _to_chunks(k, n), _to_chunks(v, n), _to_chunks(beta, n), _to_chunks(g, n))
    S, o = lax.scan(step, s0, xs)
    return _from_chunks(o), S


def bidirectional_prefix_scan(scan_fn, ctx_f, ctx_b, lat_f, lat_b, s0):
    flip = lambda args: tuple(a[:, ::-1] for a in args)
    oc_f, sc_f = scan_fn(*ctx_f, s0)
    ol_f, _ = scan_fn(*lat_f, sc_f)
    oc_b, sc_b = scan_fn(*flip(ctx_b), s0)
    ol_b, _ = scan_fn(*flip(lat_b), sc_b)
    return oc_f + oc_b[:, ::-1], ol_f + ol_b[:, ::-1]


def gla_mix(pc, pl, w_a, b_a, norm_w):
    def prep(p):
        bsz, L, _ = p.shape
        q, k, v, r, a_f, a_b = _split(p, [GLA_QK, GLA_QK, GLA_V, GLA_V, GLA_RANK, GLA_RANK])
        heads = lambda t, d: t.astype(F32).reshape(bsz, L, GLA_HEADS, d)
        log_decay = lambda a, i: jax.nn.log_sigmoid((a @ w_a[i] + b_a[i]).astype(F32)) / GLA_TAU
        q = heads(q, GLA_DK) * GLA_DK ** -0.5
        k = heads(k, GLA_DK)
        v = heads(v, GLA_DV)
        return (q, k, v, heads(log_decay(a_f, 0), GLA_DK)), (q, k, v, heads(log_decay(a_b, 1), GLA_DK)), r

    fwd_c, bwd_c, r_c = prep(pc)
    fwd_l, bwd_l, r_l = prep(pl)
    s0 = jnp.zeros((pc.shape[0], GLA_HEADS, GLA_DK, GLA_DV), F32)
    o_c, o_l = bidirectional_prefix_scan(gla_chunked, fwd_c, bwd_c, fwd_l, bwd_l, s0)

    def finish(o, r):
        bsz, L = r.shape[:2]
        o = rms_norm(o, norm_w).reshape(bsz, L, GLA_V)
        return (o * jax.nn.silu(r.astype(F32))).astype(r.dtype)

    return finish(o_c, r_c), finish(o_l, r_l)


def gdn_mix(pc, pl, lat_rows, conv_w, a_log, dt_bias, norm_w):
    def prep(p, n_rows):
        bsz, L, _ = p.shape
        qkv, z, a_f, a_b, b_f, b_b = _split(p, [2 * GDN_KW + GDN_VW, GDN_VW, GDN_HEADS, GDN_HEADS, GDN_HEADS, GDN_HEADS])
        qkv = jax.nn.silu(short_conv3(qkv, conv_w, n_rows)).astype(F32)
        q, k, v = _split(qkv, [GDN_KW, GDN_KW, GDN_VW])
        q = l2_normalize(q.reshape(bsz, L, GDN_HEADS, GDN_DK)) * GDN_DK ** -0.5
        k = l2_normalize(k.reshape(bsz, L, GDN_HEADS, GDN_DK))
        v = v.reshape(bsz, L, GDN_HEADS, GDN_DV)

        def gates(a, b, i):
            g = -jnp.exp(a_log[i].astype(F32)) * jax.nn.softplus(a.astype(F32) + dt_bias[i].astype(F32))
            return jax.nn.sigmoid(b.astype(F32)), g

        beta_f, g_f = gates(a_f, b_f, 0)
        beta_b, g_b = gates(a_b, b_b, 1)
        return (q, k, v, beta_f, g_f), (q, k, v, beta_b, g_b), z

    fwd_c, bwd_c, z_c = prep(pc, 1)
    fwd_l, bwd_l, z_l = prep(pl, lat_rows)
    s0 = jnp.zeros((pc.shape[0], GDN_HEADS, GDN_DK, GDN_DV), F32)
    o_c, o_l = bidirectional_prefix_scan(gdn_chunked, fwd_c, bwd_c, fwd_l, bwd_l, s0)

    def finish(o, z):
        bsz, L = z.shape[:2]
        o = rms_norm(o, norm_w) * jax.nn.silu(z.astype(F32).reshape(bsz, L, GDN_HEADS, GDN_DV))
        return o.reshape(bsz, L, GDN_VW).astype(z.dtype)

    return finish(o_c, z_c), finish(o_l, z_l)


def token_mixers(pc, pl, lat_rows, hy_conv_w, hy_conv_b, hy_w1, hy_b1, hy_w2, hy_b2, hy_w3, hy_b3, hy_w4,
                 hy_freq, hy_d, sc_conv_w, gla_w_a, gla_b_a, gla_norm_w, gdn_conv_w, gdn_a_log, gdn_dt_bias,
                 gdn_norm_w):
    hy_c, sc_c, gla_c, gdn_c = _split(pc, [HY_COLS, SC_COLS, GLA_COLS, GDN_COLS])
    hy_l, sc_l, gla_l, gdn_l = _split(pl, [HY_COLS, SC_COLS, GLA_COLS, GDN_COLS])
    kf_c, kb_c = hyena_filters(pc.shape[1], hy_w1, hy_b1, hy_w2, hy_b2, hy_w3, hy_b3, hy_w4, hy_freq)
    kf_l, kb_l = hyena_filters(pl.shape[1], hy_w1, hy_b1, hy_w2, hy_b2, hy_w3, hy_b3, hy_w4, hy_freq)
    ya_c = hyena_mix(hy_c, 1, hy_conv_w, hy_conv_b, kf_c, kb_c, hy_d)
    ya_l = hyena_mix(hy_l, lat_rows, hy_conv_w, hy_conv_b, kf_l, kb_l, hy_d)
    yb_c = shortconv_mix(sc_c, 1, sc_conv_w)
    yb_l = shortconv_mix(sc_l, lat_rows, sc_conv_w)
    yc_c, yc_l = gla_mix(gla_c, gla_l, gla_w_a, gla_b_a, gla_norm_w)
    yd_c, yd_l = gdn_mix(gdn_c, gdn_l, lat_rows, gdn_conv_w, gdn_a_log, gdn_dt_bias, gdn_norm_w)
    return (jnp.concatenate([ya_c, yb_c, yc_c, yd_c], axis=-1),
            jnp.concatenate([ya_l, yb_l, yc_l, yd_l], axis=-1))


def moe_ffn(h, w_router, b_router, w_gate, b_gate, w_up, b_up, w_down, b_down):
    shape = h.shape
    t = h.reshape(-1, shape[-1])
    logits = (t @ w_router + b_router).astype(F32)
    top_logit, top_idx = lax.top_k(logits, TOP_K)
    top_w = jax.nn.softmax(top_logit, axis=-1)
    combine = jnp.einsum('tk,tke->et', top_w, jax.nn.one_hot(top_idx, N_EXPERTS, dtype=F32)).astype(t.dtype)

    def expert(acc, prm):
        wg, bg, wu, bu, wd, bd, cw = prm
        gate = jnp.minimum(t @ wg + bg, SWIGLU_LIMIT)
        up = jnp.clip(t @ wu + bu, -SWIGLU_LIMIT, SWIGLU_LIMIT)
        y = ((up + 1.0) * gate * jax.nn.sigmoid(SWIGLU_ALPHA * gate)) @ wd + bd
        return acc + cw[:, None] * y, None

    out, _ = lax.scan(expert, jnp.zeros_like(t), (w_gate, b_gate, w_up, b_up, w_down, b_down, combine))
    return out.reshape(shape)


def setup_inputs(seed: int = 0) -> dict:
    key = jax.random.key(seed)
    ks = iter(jax.random.split(key, 48))

    def nrm(shape, scale=1.0):
        return jax.random.normal(next(ks), shape, F32) * scale

    L, E, F = DEPTH, N_EXPERTS, D_EXPERT
    dt = jnp.exp(jax.random.uniform(next(ks), (L, 2, GDN_HEADS), F32, math.log(1e-3), math.log(1e-1)))
    a_log = jnp.log(jax.random.uniform(next(ks), (L, 2, GDN_HEADS), F32, 1.0, 16.0))
    return {
        'x': nrm((BATCH, SEQ, D_MODEL)),
        'c': nrm((BATCH, D_MODEL)),
        'ctx': nrm((BATCH, CTX_LEN, D_MODEL)),
        'c_ctx': nrm((D_MODEL,)),
        'w_ada': nrm((L, D_MODEL, 6 * D_MODEL), D_MODEL ** -0.5),
        'b_ada': nrm((L, 6 * D_MODEL), 0.02),
        'w_in': nrm((L, D_MODEL, D_IN), D_MODEL ** -0.5),
        'hy_conv_w': nrm((L, 3, HY_COLS), 3 ** -0.5),
        'hy_conv_b': nrm((L, HY_COLS), 0.02),
        'hy_w1': nrm((L, HY_EMB, HY_HID), HY_EMB ** -0.5),
        'hy_b1': nrm((L, HY_HID), 0.02),
        'hy_w2': nrm((L, HY_HID, HY_HID), HY_HID ** -0.5),
        'hy_b2': nrm((L, HY_HID), 0.02),
        'hy_w3': nrm((L, HY_HID, HY_HID), HY_HID ** -0.5),
        'hy_b3': nrm((L, HY_HID), 0.02),
        'hy_w4': nrm((L, HY_HID, 2 * HY_W), HY_HID ** -0.5),
        'hy_freq': 1.0 + nrm((L, 3, HY_HID), 0.1),
        'hy_d': nrm((L, HY_W)),
        'sc_conv_w': nrm((L, 3, SC_W), 3 ** -0.5),
        'gla_w_a': nrm((L, 2, GLA_RANK, GLA_QK), GLA_RANK ** -0.5),
        'gla_b_a': nrm((L, 2, GLA_QK), 0.02),
        'gla_norm_w': 1.0 + nrm((L, GLA_DV), 0.02),
        'gdn_conv_w': nrm((L, 3, 2 * GDN_KW + GDN_VW), 3 ** -0.5),
        'gdn_a_log': a_log,
        'gdn_dt_bias': dt + jnp.log(-jnp.expm1(-dt)),
        'gdn_norm_w': 1.0 + nrm((L, GDN_DV), 0.02),
        'w_out': nrm((L, D_MIX, D_MODEL), D_MIX ** -0.5 * DN_BETA),
        'ln1_g': 1.0 + nrm((L, D_MODEL), 0.02),
        'ln1_b': nrm((L, D_MODEL), 0.02),
        'w_router': nrm((L, D_MODEL, E), D_MODEL ** -0.5),
        'b_router': nrm((L, E), 0.01),
        'w_gate': nrm((L, E, D_MODEL, F), D_MODEL ** -0.5),
        'b_gate': nrm((L, E, F), 0.02),
        'w_up': nrm((L, E, D_MODEL, F), D_MODEL ** -0.5),
        'b_up': nrm((L, E, F), 0.02),
        'w_down': nrm((L, E, F, D_MODEL), F ** -0.5 * DN_BETA),
        'b_down': nrm((L, E, D_MODEL), 0.02),
        'ln2_g': 1.0 + nrm((L, D_MODEL), 0.02),
        'ln2_b': nrm((L, D_MODEL), 0.02),
    }


def reference(x, c, ctx, c_ctx, w_ada, b_ada, w_in, hy_conv_w, hy_conv_b, hy_w1, hy_b1, hy_w2, hy_b2, hy_w3,
              hy_b3, hy_w4, hy_freq, hy_d, sc_conv_w, gla_w_a, gla_b_a, gla_norm_w, gdn_conv_w, gdn_a_log,
              gdn_dt_bias, gdn_norm_w, w_out, ln1_g, ln1_b, w_router, b_router, w_gate, b_gate, w_up, b_up,
              w_down, b_down, ln2_g, ln2_b):
    ROWS = x.shape[1] // GRID_W
    n_ctx = ctx.shape[1]
    silu_c = jax.nn.silu(c)
    silu_cc = jax.nn.silu(c_ctx)
    xl, xc = x, ctx
    for l in range(DEPTH):
        last = l == DEPTH - 1
        sh1_l, sc1_l, g1_l, sh2_l, sc2_l, g2_l = jnp.split((silu_c @ w_ada[l] + b_ada[l])[:, None, :], 6, axis=-1)
        sh1_c, sc1_c, g1_c, sh2_c, sc2_c, g2_c = jnp.split((silu_cc @ w_ada[l] + b_ada[l])[None, None, :], 6, axis=-1)
        pl = (xl * (1.0 + sc1_l) + sh1_l) @ w_in[l]
        pc = (xc * (1.0 + sc1_c) + sh1_c) @ w_in[l]
        yc, yl = token_mixers(pc, pl, ROWS, hy_conv_w[l], hy_conv_b[l], hy_w1[l], hy_b1[l], hy_w2[l], hy_b2[l],
                              hy_w3[l], hy_b3[l], hy_w4[l], hy_freq[l], hy_d[l], sc_conv_w[l], gla_w_a[l],
                              gla_b_a[l], gla_norm_w[l], gdn_conv_w[l], gdn_a_log[l], gdn_dt_bias[l], gdn_norm_w[l])
        xl = layer_norm(DN_ALPHA * xl + g1_l * (yl @ w_out[l]), ln1_g[l], ln1_b[l])
        hl = xl * (1.0 + sc2_l) + sh2_l
        if last:
            fl = moe_ffn(hl, w_router[l], b_router[l], w_gate[l], b_gate[l], w_up[l], b_up[l], w_down[l], b_down[l])
        else:
            xc = layer_norm(DN_ALPHA * xc + g1_c * (yc @ w_out[l]), ln1_g[l], ln1_b[l])
            hc = xc * (1.0 + sc2_c) + sh2_c
            f = moe_ffn(jnp.concatenate([hc, hl], axis=1), w_router[l], b_router[l], w_gate[l], b_gate[l],
                        w_up[l], b_up[l], w_down[l], b_down[l])
            fc, fl = f[:, :n_ctx], f[:, n_ctx:]
            xc = layer_norm(DN_ALPHA * xc + g2_c * fc, ln2_g[l], ln2_b[l])
        xl = layer_norm(DN_ALPHA * xl + g2_l * fl, ln2_g[l], ln2_b[l])
    return xl
```

```cpp
#include <hip/hip_runtime.h>
#include <cstdio>
#include <cstdint>

#ifndef MK_FUSED
#define MK_FUSED 1
#endif

#define LAS __attribute__((address_space(3)))
#define GAS __attribute__((address_space(1)))
typedef unsigned short bf16;
typedef short bf16x8 __attribute__((ext_vector_type(8)));
typedef float f32x4 __attribute__((ext_vector_type(4)));
typedef float f32x2 __attribute__((ext_vector_type(2)));
typedef unsigned u32x4 __attribute__((ext_vector_type(4)));
typedef unsigned u32x2 __attribute__((ext_vector_type(2)));

constexpr int D = 1024, NB = 16, SEQ = 2048, CTXL = 256, DEPTH = 4;
constexpr int NTOK_C = NB * CTXL, NTOK_L = NB * SEQ, NTOK = NTOK_C + NTOK_L;
constexpr int D_IN = 3376, D_INP = 3584;
constexpr int HY0 = 0, SC0 = 768, GLA0 = 1536, GDN0 = 2336;
constexpr int NEXP = 32, TOPK = 4;
constexpr int MAXROWS = NTOK * TOPK + NEXP * 256;
constexpr float DN_ALPHA = 1.681792830507429f;
constexpr float LN_EPS = 1e-5f;

constexpr size_t MiB = 1u << 20;
constexpr size_t WS_CTL = 0, CTL_ZERO_BYTES = 1 * MiB;
constexpr size_t WS_MOD = 1 * MiB;
constexpr size_t WS_KUN = 4 * MiB;
constexpr size_t WS_WIN = 36 * MiB;
constexpr size_t WS_WOUT = 64 * MiB;
constexpr size_t WS_WGU = 72 * MiB;
constexpr size_t WS_WD = 200 * MiB;
constexpr size_t WS_X = 264 * MiB;
constexpr size_t WS_HB = 408 * MiB;
constexpr size_t WS_P = 480 * MiB;
constexpr size_t WS_YMIX = 732 * MiB;
constexpr size_t WS_YD = WS_P;
constexpr size_t WS_TMP = 804 * MiB;
constexpr size_t WS_LIST = 948 * MiB;
constexpr size_t WS_TOPE = 953 * MiB;
constexpr size_t WS_TOPW = 954 * MiB;
constexpr size_t WS_H = 956 * MiB;
constexpr size_t WS_MIX = 1264 * MiB;
constexpr size_t MX_ZT = 0;
constexpr size_t MX_YT = 20 * MiB;
constexpr size_t MX_GDF = 56 * MiB, MX_GDB = 76 * MiB;
constexpr size_t MX_GOF = 96 * MiB, MX_GOB = 132 * MiB;
constexpr size_t MX_DQ = 168 * MiB, MX_DK = 204 * MiB, MX_DV = 240 * MiB;
constexpr size_t MX_DG = 276 * MiB;
constexpr size_t MX_DOF = 280 * MiB, MX_DOB = 316 * MiB;
constexpr size_t WS_END = WS_MIX + 352 * MiB;
static_assert((size_t)MAXROWS * 1024 * 2 <= 324 * MiB, "YD overlay");
static_assert(WS_H + (size_t)MAXROWS * 1024 * 2 <= WS_MIX, "H");
constexpr int CW_BAR = 4096;
constexpr int CW_CNT = 16384;

constexpr int LDS_BYTES = 147456;
constexpr int MISC_OFF = 131072;
constexpr int TAB_OFF = 131072 + 256;

__device__ __forceinline__ float bf2f(unsigned v) { return __uint_as_float(v << 16); }
__device__ __forceinline__ unsigned f2bf(float f) { unsigned u = __float_as_uint(f); return (u + 0x7fffu + ((u >> 16) & 1u)) >> 16; }
__device__ __forceinline__ unsigned pk2(float lo, float hi) { return f2bf(lo) | (f2bf(hi) << 16); }
__device__ __forceinline__ float lo_bf(unsigned w) { return __uint_as_float(w << 16); }
__device__ __forceinline__ float hi_bf(unsigned w) { return __uint_as_float(w & 0xffff0000u); }
__device__ __forceinline__ float sigmoidf_(float x) { return 1.f / (1.f + __expf(-x)); }
__device__ __forceinline__ float siluf_(float x) { return x / (1.f + __expf(-x)); }
__device__ __forceinline__ float softplusf_(float x) { return x > 20.f ? x : log1pf(__expf(x)); }
__device__ __forceinline__ float logsigmoidf_(float x) { return x >= 0.f ? -log1pf(__expf(-x)) : x - log1pf(__expf(x)); }
__device__ __forceinline__ float sin_rev(float r) { return __builtin_amdgcn_sinf(__builtin_amdgcn_fractf(r)); }
__device__ __forceinline__ float sin_rad(float x) { return sin_rev(x * 0.15915494309189535f); }
__device__ __forceinline__ float wave_sum(float v) {
#pragma unroll
    for (int o = 1; o < 64; o <<= 1) v += __shfl_xor(v, o);
    return v;
}

__device__ __forceinline__ int tidx() { int t = threadIdx.x; asm volatile("" : "+v"(t)); return t; }

#define XB_TMO      128
#define XB_XCNT(j)  (256  + 64 * (j))
#define XB_XSUB(j)  (1280 + 64 * (j))
#define XB_XGEN(j)  (2304 + 64 * (j))
#define XB_TOP      3328
#define XB_TOPGEN   3392
#define XCD_BAR_WORDS 3456
#define XB_SPIN_CAP (1u << 25)
__device__ __forceinline__ unsigned xb_ld(unsigned* p)              { return __hip_atomic_load(p, __ATOMIC_RELAXED, __HIP_MEMORY_SCOPE_AGENT); }
__device__ __forceinline__ unsigned xb_add(unsigned* p, unsigned v) { return __hip_atomic_fetch_add(p, v, __ATOMIC_RELAXED, __HIP_MEMORY_SCOPE_AGENT); }
__device__ __forceinline__ unsigned xb_xcc_id() { return (unsigned)__builtin_amdgcn_s_getreg((3 << 11) | 20) & 0xFu; }
#define XB_SPIN(cond, bar) do { unsigned _sp = 0; while (cond) { __builtin_amdgcn_s_sleep(1); \
    if ((++_sp & 255u) == 0u) { if (xb_ld(&(bar)[XB_TMO])) break; if (_sp > XB_SPIN_CAP) { atomicAdd(&(bar)[XB_TMO], 1u); break; } } } } while (0)
struct XcdBarrier { unsigned* bar; unsigned x; volatile LAS unsigned* st; };
__device__ __forceinline__ XcdBarrier xcd_barrier_post(unsigned* bar, volatile LAS unsigned* st) {
    XcdBarrier b; b.bar = bar; b.x = xb_xcc_id(); b.st = st;
    if (threadIdx.x == 0) (void)xb_add(&bar[XB_XCNT(b.x)], 1u);
    return b;
}
__device__ __forceinline__ void xcd_barrier_complete(unsigned* bar, unsigned x, unsigned& nloc, unsigned& nx) {
    const unsigned G = gridDim.x * gridDim.y * gridDim.z;
    unsigned sum, cnt, mine, sp = 0u;
    for (;;) {
        sum = 0u; cnt = 0u; mine = 0u;
#pragma unroll
        for (unsigned j = 0; j < 16; ++j) { const unsigned c = xb_ld(&bar[XB_XCNT(j)]); sum += c; cnt += (c > 0u) ? 1u : 0u; mine = (j == x) ? c : mine; }
        if (sum == G) break;
        __builtin_amdgcn_s_sleep(1);
        if ((++sp & 255u) == 0u) { if (xb_ld(&bar[XB_TMO])) break; if (sp > XB_SPIN_CAP) { atomicAdd(&bar[XB_TMO], 1u); break; } }
    }
    nloc = mine > 0u ? mine : 1u; nx = cnt > 0u ? cnt : 1u;
}
__device__ __forceinline__ void xcd_barrier(const XcdBarrier& b) {
    asm volatile("s_waitcnt vmcnt(0)" ::: "memory");
    __syncthreads();
    if (threadIdx.x == 0) {
        unsigned* bar = b.bar;
        __builtin_amdgcn_s_waitcnt(0);
        unsigned nloc = b.st[0], nx = b.st[1];
        if (nloc == 0u) { xcd_barrier_complete(bar, b.x, nloc, nx); b.st[0] = nloc; b.st[1] = nx; }
        const unsigned old = xb_add(&bar[XB_XSUB(b.x)], 1u);
        const unsigned gen = old / nloc;
        if (old + 1u == (gen + 1u) * nloc) {
            __builtin_amdgcn_fence(__ATOMIC_RELEASE, "agent");
            asm volatile("s_waitcnt vmcnt(0)" ::: "memory");
            const unsigned og = xb_add(&bar[XB_TOP], 1u);
            const unsigned tg = og / nx;
            if (og + 1u == (tg + 1u) * nx) xb_add(&bar[XB_TOPGEN], 1u);
            else XB_SPIN(xb_ld(&bar[XB_TOPGEN]) == tg, bar);
            __builtin_amdgcn_fence(__ATOMIC_ACQUIRE, "agent");
            xb_add(&bar[XB_XGEN(b.x)], 1u);
            asm volatile("s_waitcnt vmcnt(0)" ::: "memory");
        } else {
            XB_SPIN(xb_ld(&bar[XB_XGEN(b.x)]) == gen, bar);
            __builtin_amdgcn_fence(__ATOMIC_ACQUIRE, "agent");
            asm volatile("s_waitcnt vmcnt(0)" ::: "memory");
        }
    }
    __syncthreads();
}

namespace pg8 {
constexpr int BM = 256, BK = 64, HALF = 128, HTB = HALF * BK * 2, STAGE_BYTES = 8 * HTB, NXCD = 8, WGM = 8;
__host__ __device__ __forceinline__ int lds_byte(int r, int c) { const int st = (r >> 4) * 2 + (c >> 5), rr = r & 15, cc = c & 31, ob = rr * 64 + cc * 2; return st * 1024 + (ob ^ (((ob >> 9) & 1) << 5)); }
__host__ __device__ __forceinline__ void stage_rc(int b, int& R, int& C) { const int st = b / 1024, sb = b % 1024, swz = sb ^ (((sb >> 9) & 1) << 5); R = (st >> 1) * 16 + swz / 64; C = (st & 1) * 32 + (swz % 64) / 2; }
__host__ __device__ __forceinline__ int perm32(int rho) { const int n = rho >> 4, i = rho & 15; return 8 * (i >> 2) + 4 * n + (i & 3); }
__device__ __forceinline__ unsigned cvt_pk_bf16(float lo, float hi) { unsigned r; asm volatile("v_cvt_pk_bf16_f32 %0, %1, %2" : "=v"(r) : "v"(lo), "v"(hi)); return r; }

struct Unit { int pm, pn, e, mt; };

struct DenseSched {
    const char* Bt; int K, nM, nN, nwg, G, c, row0;
    __device__ __forceinline__ void init(const bf16* Bt_, int K_, int M, int N, int G_, int c_, int row0_) { Bt = (const char*)Bt_; K = K_; nM = M / BM; nN = N / BM; nwg = nM * nN; G = G_; c = c_; row0 = row0_; }
    __device__ __forceinline__ bool next(int i, Unit& u) const {
        const long L = (long)i * G + c; if (L >= nwg) return false;
        int wgid = (int)L; { const int q = nwg / NXCD, r = nwg % NXCD, xcd = wgid % NXCD, off = wgid / NXCD; wgid = (xcd < r ? xcd * (q + 1) : r * (q + 1) + (xcd - r) * q) + off; }
        const int nig = WGM * nN, gid = wgid / nig, fm = gid * WGM, gsz = (nM - fm) < WGM ? (nM - fm) : WGM;
        u.pm = fm + ((wgid % nig) % gsz); u.pn = (wgid % nig) / gsz; u.e = 0; u.mt = 0; return true;
    }
    __device__ __forceinline__ const char* b_ptr(const Unit& u) const { return Bt + (size_t)u.pn * (size_t)(BM * 2) * K; }
    __device__ __forceinline__ void a_offsets(const Unit& u, const int (&R)[2], const int (&C)[2], unsigned (&v)[2][2]) const {
#pragma unroll
        for (int h = 0; h < 2; ++h)
#pragma unroll
            for (int i = 0; i < 2; ++i) v[h][i] = (unsigned)((row0 + u.pm * BM + h * HALF + R[i]) * K + C[i]) * 2u;
    }
};
template <bool GATHER, int NT>
struct MoeSched {
    const char* Bt; size_t bstride;
    const int* list;
    const LAS int* pre; const LAS int* mtl; const LAS int* rowoff; const LAS int* cnt;
    int K, G, c, total;
    __device__ __forceinline__ bool next(int i, Unit& u) const {
        const int L = i * G + c; if (L >= total) return false;
        int e = 0;
#pragma unroll 1
        for (int j = 1; j < NEXP; ++j) e = (L >= pre[j]) ? j : e;
        const int rem = L - pre[e], m = mtl[e];
        u.e = e; u.pn = rem / m; u.mt = rem % m; u.pm = 0; return true;
    }
    __device__ __forceinline__ const char* b_ptr(const Unit& u) const { return Bt + (size_t)u.e * bstride + (size_t)u.pn * (size_t)(BM * 2) * K; }
    __device__ __forceinline__ void a_offsets(const Unit& u, const int (&R)[2], const int (&C)[2], unsigned (&v)[2][2]) const {
        if (GATHER) {
            const int n = cnt[u.e]; const int* lp = list + (size_t)u.e * NTOK;
#pragma unroll
            for (int h = 0; h < 2; ++h)
#pragma unroll
                for (int i = 0; i < 2; ++i) { const int idx = u.mt * BM + h * HALF + R[i]; const int tok = idx < n ? lp[idx] : 0; v[h][i] = (unsigned)(tok * K + C[i]) * 2u; }
        } else {
            const int r0 = rowoff[u.e] + u.mt * BM;
#pragma unroll
            for (int h = 0; h < 2; ++h)
#pragma unroll
                for (int i = 0; i < 2; ++i) v[h][i] = (unsigned)((r0 + h * HALF + R[i]) * K + C[i]) * 2u;
        }
    }
};

struct EpiBf16 {
    static constexpr bool PERM = true;
    bf16* O; int ldc; int row0;
    __device__ __forceinline__ void operator()(const f32x4 (&acc)[2][2][4][2], const Unit& u, int wr, int wc, int fr, int fq) const {
        const int r0 = row0 + u.pm * BM + wr * 64 + fr, col0 = u.pn * BM + wc * 32 + 8 * fq;
#pragma unroll
        for (int ai = 0; ai < 2; ++ai)
#pragma unroll
            for (int m = 0; m < 4; ++m) { bf16* rowp = O + (size_t)(r0 + ai * HALF + m * 16) * ldc + col0;
#pragma unroll
                for (int bj = 0; bj < 2; ++bj) { const f32x4 v0 = acc[ai][bj][m][0], v1 = acc[ai][bj][m][1];
                    u32x4 w; w.x = cvt_pk_bf16(v0[0], v0[1]); w.y = cvt_pk_bf16(v0[2], v0[3]); w.z = cvt_pk_bf16(v1[0], v1[1]); w.w = cvt_pk_bf16(v1[2], v1[3]);
                    *(u32x4*)(rowp + bj * HALF) = w; } }
    }
};
struct EpiF32 {
    static constexpr bool PERM = false;
    float* Cc; int ldc; int row0;
    __device__ __forceinline__ void operator()(const f32x4 (&acc)[2][2][4][2], const Unit& u, int wr, int wc, int fr, int fq) const {
        const int r0 = row0 + u.pm * BM + wr * 64 + fr, col0 = u.pn * BM + wc * 32 + 4 * fq;
#pragma unroll
        for (int ai = 0; ai < 2; ++ai)
#pragma unroll
            for (int m = 0; m < 4; ++m) { float* rowp = Cc + (size_t)(r0 + ai * HALF + m * 16) * ldc + col0;
#pragma unroll
                for (int bj = 0; bj < 2; ++bj)
#pragma unroll
                    for (int n = 0; n < 2; ++n) *(f32x4*)(rowp + bj * HALF + n * 16) = acc[ai][bj][m][n]; }
    }
};
struct EpiSwiglu {
    static constexpr bool PERM = true;
    bf16* H; const float* bg; const float* bu; const LAS int* rowoff;
    __device__ __forceinline__ void operator()(const f32x4 (&acc)[2][2][4][2], const Unit& u, int wr, int wc, int fr, int fq) const {
        const int r0 = rowoff[u.e] + u.mt * BM + wr * 64 + fr, j0 = u.pn * HALF + wc * 32 + 8 * fq;
        f32x4 gb[2], ub[2];
#pragma unroll
        for (int n = 0; n < 2; ++n) { gb[n] = *(const f32x4*)(bg + u.e * 1024 + j0 + 4 * n); ub[n] = *(const f32x4*)(bu + u.e * 1024 + j0 + 4 * n); }
#pragma unroll
        for (int ai = 0; ai < 2; ++ai)
#pragma unroll
            for (int m = 0; m < 4; ++m) { bf16* rowp = H + (size_t)(r0 + ai * HALF + m * 16) * 1024 + j0; float hv[8];
#pragma unroll
                for (int n = 0; n < 2; ++n)
#pragma unroll
                    for (int j = 0; j < 4; ++j) { float g = acc[ai][0][m][n][j] + gb[n][j], up = acc[ai][1][m][n][j] + ub[n][j];
                        g = fminf(g, 7.f); up = fminf(fmaxf(up, -7.f), 7.f);
                        hv[n * 4 + j] = (up + 1.f) * g * __builtin_amdgcn_rcpf(1.f + __expf(-1.702f * g)); }
                u32x4 w; w.x = cvt_pk_bf16(hv[0], hv[1]); w.y = cvt_pk_bf16(hv[2], hv[3]); w.z = cvt_pk_bf16(hv[4], hv[5]); w.w = cvt_pk_bf16(hv[6], hv[7]);
                *(u32x4*)rowp = w; }
    }
};
struct EpiDown {
    static constexpr bool PERM = true;
    bf16* Y; const float* bd; const LAS int* rowoff;
    __device__ __forceinline__ void operator()(const f32x4 (&acc)[2][2][4][2], const Unit& u, int wr, int wc, int fr, int fq) const {
        const int r0 = rowoff[u.e] + u.mt * BM + wr * 64 + fr, col0 = u.pn * BM + wc * 32 + 8 * fq;
        f32x4 bv[2][2];
#pragma unroll
        for (int bj = 0; bj < 2; ++bj)
#pragma unroll
            for (int n = 0; n < 2; ++n) bv[bj][n] = *(const f32x4*)(bd + u.e * 1024 + col0 + bj * HALF + 4 * n);
#pragma unroll
        for (int ai = 0; ai < 2; ++ai)
#pragma unroll
            for (int m = 0; m < 4; ++m) { bf16* rowp = Y + (size_t)(r0 + ai * HALF + m * 16) * 1024 + col0;
#pragma unroll
                for (int bj = 0; bj < 2; ++bj) { const f32x4 v0 = acc[ai][bj][m][0] + bv[bj][0], v1 = acc[ai][bj][m][1] + bv[bj][1];
                    u32x4 w; w.x = cvt_pk_bf16(v0[0], v0[1]); w.y = cvt_pk_bf16(v0[2], v0[3]); w.z = cvt_pk_bf16(v1[0], v1[1]); w.w = cvt_pk_bf16(v1[2], v1[3]);
                    *(u32x4*)(rowp + bj * HALF) = w; } }
    }
};

template <class Epi, class Sched, bool ALIGN_EPI>
__device__ __forceinline__ void gemm_phase(LAS unsigned char* lds, const char* Abase, const int K, const Sched& S, const Epi& E) {
    const int tid = tidx(), wid = __builtin_amdgcn_readfirstlane(tid >> 6), lane = tid & 63, wr = wid >> 2, wc = wid & 3, fr = lane & 15, fq = lane >> 4;
    const int nt = K / BK;
    int Rp[2], Cp[2]; unsigned voffB[2];
#pragma unroll
    for (int i = 0; i < 2; ++i) { stage_rc(tid * 16 + i * 8192, Rp[i], Cp[i]); const int Rb = Epi::PERM ? ((Rp[i] & ~31) + perm32(Rp[i] & 31)) : Rp[i]; voffB[i] = (unsigned)(Rb * K + Cp[i]) * 2u; }
    const size_t kstep = (size_t)(BK * 2);
    const size_t hstep = (size_t)HALF * K * 2;
    const unsigned ldsw = (unsigned)wid * 1024u;
    const int aoff = lds_byte(wr * 64 + fr, fq * 8), boff = lds_byte(wc * 32 + fr, fq * 8);
#define PG8_SA(b, h) (((b) * 2 + (h)) * HTB)
#define PG8_SB(b, h) ((4 + (b) * 2 + (h)) * HTB)
#define PG8_STAGE(bufoff, gbase, voff) do { _Pragma("unroll") for (int _i = 0; _i < 2; ++_i) \
        __builtin_amdgcn_global_load_lds((const unsigned*)((const char*)(gbase) + (voff)[_i]), (LAS unsigned*)(lds + (bufoff) + ldsw + _i * 8192), 16, 0, 0); } while (0)
#define PG8_LDA(dst, b, h) do { _Pragma("unroll") for (int m = 0; m < 4; ++m) _Pragma("unroll") for (int k = 0; k < 2; ++k) dst[m][k] = *(const LAS bf16x8*)(lds + PG8_SA(b, h) + aoff + m * 2048 + k * 1024); } while (0)
#define PG8_LDB(dst, b, h) do { _Pragma("unroll") for (int n = 0; n < 2; ++n) _Pragma("unroll") for (int k = 0; k < 2; ++k) dst[n][k] = *(const LAS bf16x8*)(lds + PG8_SB(b, h) + boff + n * 2048 + k * 1024); } while (0)
#define PG8_MMA(ai, bj, At, Bt) do { __builtin_amdgcn_s_setprio(1); _Pragma("unroll") for (int m = 0; m < 4; ++m) _Pragma("unroll") for (int n = 0; n < 2; ++n) _Pragma("unroll") for (int k = 0; k < 2; ++k) \
        acc[ai][bj][m][n] = __builtin_amdgcn_mfma_f32_16x16x32_bf16(Bt[n][k], At[m][k], acc[ai][bj][m][n], 0, 0, 0); __builtin_amdgcn_s_setprio(0); } while (0)
#define PG8_WAIT_V(n) asm volatile("s_waitcnt vmcnt(" #n ")" ::: "memory")
#define PG8_WAIT_L(n) asm volatile("s_waitcnt lgkmcnt(" #n ")" ::: "memory")
#define PG8_BAR __builtin_amdgcn_s_barrier()
#define PG8_SCHED __builtin_amdgcn_sched_barrier(0)
    Unit cur, nxt; int ui = 0;
    if (!S.next(0, cur)) return;
    f32x4 acc[2][2][4][2];
#pragma unroll
    for (int a = 0; a < 2; ++a)
#pragma unroll
        for (int b = 0; b < 2; ++b)
#pragma unroll
            for (int m = 0; m < 4; ++m)
#pragma unroll
                for (int n = 0; n < 2; ++n) acc[a][b][m][n] = (f32x4){0.f, 0.f, 0.f, 0.f};
    bf16x8 At[4][2], B0[2][2], B1[2][2];
    unsigned vAc[2][2], vAn[2][2];
    S.a_offsets(cur, Rp, Cp, vAc);
    const char* cB = S.b_ptr(cur);
    PG8_STAGE(PG8_SB(0, 0), cB, voffB); PG8_STAGE(PG8_SB(0, 1), cB + hstep, voffB); PG8_STAGE(PG8_SA(0, 0), Abase, vAc[0]); PG8_STAGE(PG8_SA(0, 1), Abase, vAc[1]);
    if (wr == 1) PG8_BAR;
    PG8_WAIT_V(2); PG8_BAR;
    PG8_STAGE(PG8_SB(1, 0), cB + kstep, voffB); PG8_STAGE(PG8_SA(1, 0), Abase + kstep, vAc[0]); PG8_STAGE(PG8_SB(1, 1), cB + hstep + kstep, voffB);
    PG8_WAIT_V(6); PG8_BAR;
    for (;;) {
        const bool has_next = S.next(ui + 1, nxt);
        const char* nB = has_next ? S.b_ptr(nxt) : cB;
        if (has_next) S.a_offsets(nxt, Rp, Cp, vAn);
        else {
#pragma unroll
            for (int h = 0; h < 2; ++h)
#pragma unroll
                for (int i = 0; i < 2; ++i) vAn[h][i] = vAc[h][i]; }
        for (int t = 0; t < nt; t += 2) {
            const bool last = (t == nt - 2);
            const char* a1 = Abase + (size_t)(t + 1) * kstep;
            const char* a2 = last ? Abase : Abase + (size_t)(t + 2) * kstep; const char* b2 = last ? nB : cB + (size_t)(t + 2) * kstep;
            const char* a3 = a2 + kstep; const char* b3 = b2 + kstep;
            unsigned v2[2][2];
#pragma unroll
            for (int h = 0; h < 2; ++h)
#pragma unroll
                for (int i = 0; i < 2; ++i) v2[h][i] = last ? vAn[h][i] : vAc[h][i];
            PG8_LDB(B0, 0, 0); PG8_LDB(B1, 0, 1); PG8_SCHED; PG8_LDA(At, 0, 0); PG8_STAGE(PG8_SA(1, 1), a1, vAc[1]);
            PG8_WAIT_V(8); PG8_WAIT_L(0); PG8_BAR; PG8_MMA(0, 0, At, B0); PG8_MMA(0, 1, At, B1); PG8_BAR; PG8_SCHED;
            PG8_LDA(At, 0, 1); PG8_STAGE(PG8_SB(0, 0), b2, voffB); PG8_STAGE(PG8_SB(0, 1), b2 + hstep, voffB); PG8_STAGE(PG8_SA(0, 0), a2, v2[0]);
            PG8_WAIT_V(8); PG8_WAIT_L(0); PG8_BAR; PG8_MMA(1, 0, At, B0); PG8_MMA(1, 1, At, B1); PG8_BAR; PG8_SCHED;
            PG8_LDB(B0, 1, 0); PG8_LDB(B1, 1, 1); PG8_SCHED; PG8_LDA(At, 1, 0); PG8_STAGE(PG8_SA(0, 1), a2, v2[1]);
            PG8_WAIT_V(8); PG8_WAIT_L(0); PG8_BAR; PG8_MMA(0, 0, At, B0); PG8_MMA(0, 1, At, B1); PG8_BAR; PG8_SCHED;
            PG8_LDA(At, 1, 1); PG8_STAGE(PG8_SB(1, 0), b3, voffB); PG8_STAGE(PG8_SB(1, 1), b3 + hstep, voffB); PG8_STAGE(PG8_SA(1, 0), a3, v2[0]);
            PG8_WAIT_V(8); PG8_WAIT_L(0); PG8_BAR; PG8_MMA(1, 0, At, B0); PG8_MMA(1, 1, At, B1); PG8_BAR; PG8_SCHED;
        }
        if constexpr (ALIGN_EPI) { if (wr == 0) PG8_BAR; }
        E(acc, cur, wr, wc, fr, fq);
        if (!has_next) break;
#pragma unroll
        for (int a = 0; a < 2; ++a)
#pragma unroll
            for (int b = 0; b < 2; ++b)
#pragma unroll
                for (int m = 0; m < 4; ++m)
#pragma unroll
                    for (int n = 0; n < 2; ++n) acc[a][b][m][n] = (f32x4){0.f, 0.f, 0.f, 0.f};
        cur = nxt; cB = nB; ++ui;
#pragma unroll
        for (int h = 0; h < 2; ++h)
#pragma unroll
            for (int i = 0; i < 2; ++i) vAc[h][i] = vAn[h][i];
        if constexpr (ALIGN_EPI) { if (wr == 1) PG8_BAR; }
    }
    PG8_WAIT_V(0);
    if constexpr (!ALIGN_EPI) { if (wr == 0) PG8_BAR; }
    PG8_BAR;
#undef PG8_SA
#undef PG8_SB
#undef PG8_STAGE
#undef PG8_LDA
#undef PG8_LDB
#undef PG8_MMA
#undef PG8_WAIT_V
#undef PG8_WAIT_L
#undef PG8_BAR
#undef PG8_SCHED
}
}

struct Args { const float* in[39]; float* out; unsigned char* ws; int ph_lo, ph_hi; };
typedef const __attribute__((address_space(4))) Args CArgs;
enum { I_X = 0, I_C, I_CTX, I_CCTX, I_WADA, I_BADA, I_WIN, I_HYCW, I_HYCB, I_HYW1, I_HYB1, I_HYW2, I_HYB2, I_HYW3, I_HYB3, I_HYW4, I_HYFREQ, I_HYD, I_SCCW,
       I_GLAWA, I_GLABA, I_GLANW, I_GDNCW, I_GDNALOG, I_GDNDT, I_GDNNW, I_WOUT, I_LN1G, I_LN1B, I_WR, I_BR, I_WG, I_BG, I_WU, I_BU, I_WD, I_BD, I_LN2G, I_LN2B };

__device__ __forceinline__ int row_batch(int row) { return row < NTOK_C ? (row >> 8) : ((row - NTOK_C) >> 11); }
__device__ __forceinline__ int mod_vec(int row) { return row < NTOK_C ? 16 : ((row - NTOK_C) >> 11); }

__device__ __forceinline__ void ph_mod(CArgs& a, LAS unsigned char* lds, int bid, int nblk) {
    LAS float* sc = (LAS float*)lds; LAS float* red = (LAS float*)(lds + 17 * 1024 * 4);
    const int tid = tidx(), lane = tid & 63, w = tid >> 6;
    const float* c = a.in[I_C]; const float* cc = a.in[I_CCTX];
    for (int i = tid; i < 17 * 1024; i += 512) { const float v = i < 16 * 1024 ? c[i] : cc[i - 16 * 1024]; sc[i] = siluf_(v); }
    __syncthreads();
    float* MOD = (float*)(a.ws + WS_MOD);
    for (int it = bid; it < DEPTH * 96; it += nblk) {
        const int l = it / 96, j0 = (it % 96) * 64;
        const float* W = a.in[I_WADA] + (size_t)l * 1024 * 6144 + j0 + lane;
        float acc[17];
#pragma unroll
        for (int v = 0; v < 17; ++v) acc[v] = 0.f;
#pragma unroll 4
        for (int kk = 0; kk < 128; ++kk) { const int k = w * 128 + kk; const float wv = W[(size_t)k * 6144];
#pragma unroll
            for (int v = 0; v < 17; ++v) acc[v] += sc[v * 1024 + k] * wv; }
#pragma unroll
        for (int v = 0; v < 17; ++v) red[(w * 17 + v) * 64 + lane] = acc[v];
        __syncthreads();
        for (int o = tid; o < 17 * 64; o += 512) { const int v = o >> 6, jj = o & 63; float s = 0.f;
#pragma unroll
            for (int ww = 0; ww < 8; ++ww) s += red[(ww * 17 + v) * 64 + jj];
            MOD[(size_t)(l * 17 + v) * 6144 + j0 + jj] = s + a.in[I_BADA][l * 6144 + j0 + jj]; }
        __syncthreads();
    }
}

__device__ __forceinline__ void ph_filters(CArgs& a, int gw, int ngw) {
    const int lane = tidx() & 63;
    float* KUN = (float*)(a.ws + WS_KUN);
    for (int it = gw; it < DEPTH * (CTXL + SEQ); it += ngw) {
        const int l = it / (CTXL + SEQ), r = it % (CTXL + SEQ), Lt = r < CTXL ? 0 : 1, pos = Lt ? r - CTXL : r, L = Lt ? SEQ : CTXL;
        const float tn = (float)pos / (float)(L - 1);
        float z = 0.f;
        if (lane == 0) z = tn;
        else if (lane <= 32) { const int j = (lane - 1) & 15; const float fj = 1e-4f + (float)j * ((15.f - 1e-4f) / 15.f);
            double rev = (double)fj * (double)pos / (double)L; rev -= floor(rev); const float rf = (float)rev;
            z = lane <= 16 ? sin_rev(rf + 0.25f) : -sin_rev(rf); }
        const float* w1 = a.in[I_HYW1] + l * 33 * 64; const float* w2 = a.in[I_HYW2] + l * 64 * 64; const float* w3 = a.in[I_HYW3] + l * 64 * 64; const float* w4 = a.in[I_HYW4] + l * 64 * 512;
        const float* fq = a.in[I_HYFREQ] + l * 3 * 64;
        float s = a.in[I_HYB1][l * 64 + lane];
#pragma unroll
        for (int i = 0; i < 33; ++i) s += __shfl(z, i) * w1[i * 64 + lane];
        float h = sin_rad(fq[lane] * s);
        s = a.in[I_HYB2][l * 64 + lane];
#pragma unroll 16
        for (int i = 0; i < 64; ++i) s += __shfl(h, i) * w2[i * 64 + lane];
        h = sin_rad(fq[64 + lane] * s);
        s = a.in[I_HYB3][l * 64 + lane];
#pragma unroll 16
        for (int i = 0; i < 64; ++i) s += __shfl(h, i) * w3[i * 64 + lane];
        h = sin_rad(fq[128 + lane] * s);
        float k[8];
#pragma unroll
        for (int m = 0; m < 8; ++m) k[m] = 0.f;
#pragma unroll 8
        for (int i = 0; i < 64; ++i) { const float hi = __shfl(h, i);
#pragma unroll
            for (int m = 0; m < 8; ++m) k[m] += hi * w4[i * 512 + m * 64 + lane]; }
#pragma unroll
        for (int m = 0; m < 8; ++m) { const int o = m * 64 + lane, ch = o & 255;
            const float delta = 3.0701134573253944f + (float)ch * ((15.350567286626972f - 3.0701134573253944f) / 255.f);
            KUN[((size_t)((l * 2 + Lt) * 512 + o)) * 2048 + pos] = k[m] * __expf(-tn * delta); }
    }
}

__device__ __forceinline__ void tr_item(const float* W, int Nsrc, int K, bf16* WTrow0, int n0, int k0, LAS float* scr, int lane) {
    const int nn = n0 + (lane & 31);
#pragma unroll 8
    for (int i = 0; i < 32; ++i) { const int kk = 2 * i + (lane >> 5); scr[kk * 33 + (lane & 31)] = nn < Nsrc ? W[(size_t)(k0 + kk) * Nsrc + nn] : 0.f; }
    asm volatile("s_waitcnt lgkmcnt(0)" ::: "memory");
    const int c = lane & 7;
#pragma unroll
    for (int j = 0; j < 4; ++j) { const int n = (lane >> 3) + 8 * j; const LAS float* s = scr + (8 * c) * 33 + n;
        u32x4 o; o.x = pk2(s[0 * 33], s[1 * 33]); o.y = pk2(s[2 * 33], s[3 * 33]); o.z = pk2(s[4 * 33], s[5 * 33]); o.w = pk2(s[6 * 33], s[7 * 33]);
        *(u32x4*)(WTrow0 + (size_t)n * K + k0 + 8 * c) = o; }
    asm volatile("s_waitcnt lgkmcnt(0)" ::: "memory");
}
__device__ __forceinline__ void ph_tr_small(CArgs& a, LAS unsigned char* lds, int gw, int ngw) {
    const int lane = tidx() & 63, w = tidx() >> 6;
    LAS float* scr = (LAS float*)(lds + w * 8448);
    constexpr int I_IN = 16 * (D_INP / 32), I_OUT = 16 * 32;
    for (int it = gw; it < DEPTH * (I_IN + I_OUT); it += ngw) {
        const int l = it / (I_IN + I_OUT); int r = it % (I_IN + I_OUT);
        if (r < I_IN) { const int kb = r / (D_INP / 32), nb = r % (D_INP / 32);
            tr_item(a.in[I_WIN] + (size_t)l * 1024 * D_IN, D_IN, 1024, (bf16*)(a.ws + WS_WIN) + ((size_t)l * D_INP + nb * 32) * 1024, nb * 32, kb * 64, scr, lane); }
        else { r -= I_IN; const int kb = r / 32, nb = r % 32;
            tr_item(a.in[I_WOUT] + (size_t)l * 1024 * 1024, 1024, 1024, (bf16*)(a.ws + WS_WOUT) + ((size_t)l * 1024 + nb * 32) * 1024, nb * 32, kb * 64, scr, lane); }
    }
}
__device__ __forceinline__ void ph_tr_experts(CArgs& a, int l, LAS unsigned char* lds, int gw, int ngw) {
    const int lane = tidx() & 63, w = tidx() >> 6;
    LAS float* scr = (LAS float*)(lds + w * 8448);
    for (int it = gw; it < NEXP * 3 * 512; it += ngw) {
        const int e = it / 1536, r = it % 1536, which = r / 512, q = r % 512, kb = q / 32, nb = q % 32, n0 = nb * 32;
        const float* W = a.in[which == 0 ? I_WG : (which == 1 ? I_WU : I_WD)] + ((size_t)(l * NEXP + e)) * 1024 * 1024;
        bf16* dst;
        if (which == 2) dst = (bf16*)(a.ws + WS_WD) + ((size_t)e * 1024 + n0) * 1024;
        else dst = (bf16*)(a.ws + WS_WGU) + ((size_t)e * 2048 + (n0 >> 7) * 256 + which * 128 + (n0 & 127)) * 1024;
        tr_item(W, 1024, 1024, dst, n0, kb * 64, scr, lane);
    }
}
__device__ __forceinline__ void ph_mod_input(CArgs& a, int gw, int ngw) {
    const int lane = tidx() & 63;
    const float* MOD = (const float*)(a.ws + WS_MOD);
    bf16* HB = (bf16*)(a.ws + WS_HB);
    for (int row = gw; row < NTOK; row += ngw) {
        const float* src = row < NTOK_C ? a.in[I_CTX] + (size_t)row * D : a.in[I_X] + (size_t)(row - NTOK_C) * D;
        const float* mv = MOD + (size_t)mod_vec(row) * 6144;
#pragma unroll
        for (int j = 0; j < 4; ++j) { const int c0 = j * 256 + lane * 4; const f32x4 x = *(const f32x4*)(src + c0), sh = *(const f32x4*)(mv + c0), sc = *(const f32x4*)(mv + 1024 + c0);
            u32x2 o; o.x = pk2(x[0] * (1.f + sc[0]) + sh[0], x[1] * (1.f + sc[1]) + sh[1]); o.y = pk2(x[2] * (1.f + sc[2]) + sh[2], x[3] * (1.f + sc[3]) + sh[3]);
            *(u32x2*)(HB + (size_t)row * D + c0) = o; }
    }
}

struct Chunk { int b, t0, L, row0, lo, hi; };
__device__ __forceinline__ Chunk chunk_of(int it) {
    Chunk c;
    if (it < 64) { c.b = it >> 2; c.t0 = (it & 3) * 64; c.L = CTXL; c.row0 = c.b * CTXL + c.t0; c.lo = 0; c.hi = CTXL; }
    else { const int r = it - 64; c.b = r >> 5; c.t0 = (r & 31) * 64; c.L = SEQ; c.row0 = NTOK_C + c.b * SEQ + c.t0; c.lo = c.t0; c.hi = c.t0 + 64; }
    return c;
}
__device__ __forceinline__ f32x2 conv3_2(const bf16* P, const Chunk& c, int t, int col, const float* w, int wstride, int wcol) {
    const bf16* p = P + (size_t)(c.row0 + t - c.t0) * D_INP + col;
    const unsigned cur = *(const unsigned*)p;
    const unsigned prv = t - 1 >= c.lo ? *(const unsigned*)(p - D_INP) : 0u;
    const unsigned nxt = t + 1 < c.hi ? *(const unsigned*)(p + D_INP) : 0u;
    f32x2 r;
    r.x = w[wcol] * lo_bf(prv) + w[wstride + wcol] * lo_bf(cur) + w[2 * wstride + wcol] * lo_bf(nxt);
    r.y = w[wcol + 1] * hi_bf(prv) + w[wstride + wcol + 1] * hi_bf(cur) + w[2 * wstride + wcol + 1] * hi_bf(nxt);
    return r;
}
__device__ __forceinline__ void ph_prep_conv(CArgs& a, int l, LAS unsigned char* lds, int bid, int nblk) {
    const bf16* P = (const bf16*)(a.ws + WS_P);
    bf16* ZT = (bf16*)(a.ws + WS_MIX + MX_ZT); bf16* YMIX = (bf16*)(a.ws + WS_YMIX);
    LAS bf16* zt = (LAS bf16*)lds;
    const int tid = tidx(), c2 = (tid & 127) * 2, tg = tid >> 7;
    const float* hw = a.in[I_HYCW] + l * 3 * 768; const float* hb = a.in[I_HYCB] + l * 768; const float* sw = a.in[I_SCCW] + l * 3 * 256;
    for (int it = bid; it < 576; it += nblk) {
        const Chunk c = chunk_of(it);
#pragma unroll 1
        for (int tt = tg * 16; tt < tg * 16 + 16; ++tt) {
            const int t = c.t0 + tt;
            f32x2 x1 = conv3_2(P, c, t, HY0 + 256 + c2, hw, 768, 256 + c2), v = conv3_2(P, c, t, HY0 + 512 + c2, hw, 768, 512 + c2);
            x1.x += hb[256 + c2]; x1.y += hb[256 + c2 + 1]; v.x += hb[512 + c2]; v.y += hb[512 + c2 + 1];
            *(LAS unsigned*)(zt + tt * 258 + c2) = pk2(x1.x * v.x, x1.y * v.y);
            const bf16* p = P + (size_t)(c.row0 + tt) * D_INP + SC0 + c2;
            const unsigned bg = *(const unsigned*)p, cg = *(const unsigned*)(p + 256), hs = *(const unsigned*)(p + 512);
            float m0x = 0.f, m0y = 0.f, m2x = 0.f, m2y = 0.f;
            if (t - 1 >= c.lo) { const unsigned cg0 = *(const unsigned*)(p - D_INP + 256), hs0 = *(const unsigned*)(p - D_INP + 512); m0x = lo_bf(cg0) * lo_bf(hs0); m0y = hi_bf(cg0) * hi_bf(hs0); }
            if (t + 1 < c.hi) { const unsigned cg2 = *(const unsigned*)(p + D_INP + 256), hs2 = *(const unsigned*)(p + D_INP + 512); m2x = lo_bf(cg2) * lo_bf(hs2); m2y = hi_bf(cg2) * hi_bf(hs2); }
            const float m1x = lo_bf(cg) * lo_bf(hs), m1y = hi_bf(cg) * hi_bf(hs);
            const float yx = lo_bf(bg) * (sw[c2] * m0x + sw[256 + c2] * m1x + sw[512 + c2] * m2x), yy = hi_bf(bg) * (sw[c2 + 1] * m0y + sw[256 + c2 + 1] * m1y + sw[512 + c2 + 1] * m2y);
            *(unsigned*)(YMIX + (size_t)(c.row0 + tt) * D + 256 + c2) = pk2(yx, yy);
        }
        __syncthreads();
        { const int ch = tid & 255, g0 = (tid >> 8) * 4;
          const int soff = c.L == CTXL ? 0 : CTXL;
#pragma unroll
          for (int g = 0; g < 4; ++g) { const int t8 = (g0 + g) * 8; unsigned short e[8];
#pragma unroll
              for (int j = 0; j < 8; ++j) e[j] = zt[(t8 + j) * 258 + ch];
              u32x4 o; o.x = e[0] | ((unsigned)e[1] << 16); o.y = e[2] | ((unsigned)e[3] << 16); o.z = e[4] | ((unsigned)e[5] << 16); o.w = e[6] | ((unsigned)e[7] << 16);
              *(u32x4*)(ZT + ((size_t)(ch * 16 + c.b)) * 2304 + soff + c.t0 + t8) = o; } }
        __syncthreads();
    }
}
__device__ __forceinline__ void ph_prep_tok(CArgs& a, int l, int gw, int ngw) {
    const int lane = tidx() & 63;
    const bf16* P = (const bf16*)(a.ws + WS_P);
    float* GDF = (float*)(a.ws + WS_MIX + MX_GDF); float* GDB = (float*)(a.ws + WS_MIX + MX_GDB);
    float* DQ = (float*)(a.ws + WS_MIX + MX_DQ); float* DK = (float*)(a.ws + WS_MIX + MX_DK); float* DV = (float*)(a.ws + WS_MIX + MX_DV); float* DG = (float*)(a.ws + WS_MIX + MX_DG);
    const float* wa = a.in[I_GLAWA] + l * 2 * 16 * 128; const float* ba = a.in[I_GLABA] + l * 2 * 128;
    const float* cw = a.in[I_GDNCW] + l * 3 * 768;
#pragma unroll 1
    for (int row = gw; row < NTOK; row += ngw) {
        const bf16* pr = P + (size_t)row * D_INP;
        { int z = 0; asm volatile("" : "+v"(z)); wa += z; cw += z; }
        const float av = lane < 32 ? bf2f(pr[GLA0 + 768 + lane]) : 0.f;
        float s0 = ba[lane], s1 = ba[64 + lane], s2 = ba[128 + lane], s3 = ba[192 + lane];
#pragma unroll
        for (int i = 0; i < 16; ++i) { const float af = __shfl(av, i), ab = __shfl(av, 16 + i);
            s0 += af * wa[i * 128 + lane]; s1 += af * wa[i * 128 + 64 + lane]; s2 += ab * wa[2048 + i * 128 + lane]; s3 += ab * wa[2048 + i * 128 + 64 + lane]; }
        GDF[(size_t)row * 128 + lane] = __expf(logsigmoidf_(s0) * 0.0625f); GDF[(size_t)row * 128 + 64 + lane] = __expf(logsigmoidf_(s1) * 0.0625f);
        GDB[(size_t)row * 128 + lane] = __expf(logsigmoidf_(s2) * 0.0625f); GDB[(size_t)row * 128 + 64 + lane] = __expf(logsigmoidf_(s3) * 0.0625f);
        int tpos, lo, hi;
        if (row < NTOK_C) { tpos = row & 255; lo = 0; hi = CTXL; } else { tpos = (row - NTOK_C) & 2047; lo = tpos & ~63; hi = lo + 64; }
        const bool hp = tpos - 1 >= lo, hn = tpos + 1 < hi;
        float qkv[3][4];
#pragma unroll
        for (int g = 0; g < 3; ++g) { const int col = g * 256 + 4 * lane; const bf16* p = pr + GDN0 + col;
            const u32x2 cu = *(const u32x2*)p; u32x2 pv = {0u, 0u}, nv = {0u, 0u};
            if (hp) pv = *(const u32x2*)(p - D_INP); if (hn) nv = *(const u32x2*)(p + D_INP);
            const f32x4 w0 = *(const f32x4*)(cw + col), w1 = *(const f32x4*)(cw + 768 + col), w2 = *(const f32x4*)(cw + 1536 + col);
            qkv[g][0] = siluf_(w0[0] * lo_bf(pv.x) + w1[0] * lo_bf(cu.x) + w2[0] * lo_bf(nv.x));
            qkv[g][1] = siluf_(w0[1] * hi_bf(pv.x) + w1[1] * hi_bf(cu.x) + w2[1] * hi_bf(nv.x));
            qkv[g][2] = siluf_(w0[2] * lo_bf(pv.y) + w1[2] * lo_bf(cu.y) + w2[2] * lo_bf(nv.y));
            qkv[g][3] = siluf_(w0[3] * hi_bf(pv.y) + w1[3] * hi_bf(cu.y) + w2[3] * hi_bf(nv.y)); }
        float sq = qkv[0][0] * qkv[0][0] + qkv[0][1] * qkv[0][1] + qkv[0][2] * qkv[0][2] + qkv[0][3] * qkv[0][3];
        float sk = qkv[1][0] * qkv[1][0] + qkv[1][1] * qkv[1][1] + qkv[1][2] * qkv[1][2] + qkv[1][3] * qkv[1][3];
#pragma unroll
        for (int o = 1; o < 16; o <<= 1) { sq += __shfl_xor(sq, o); sk += __shfl_xor(sk, o); }
        const float rq = rsqrtf(sq + 1e-6f) * 0.125f, rk = rsqrtf(sk + 1e-6f);
        *(f32x4*)(DQ + (size_t)row * 256 + 4 * lane) = (f32x4){qkv[0][0] * rq, qkv[0][1] * rq, qkv[0][2] * rq, qkv[0][3] * rq};
        *(f32x4*)(DK + (size_t)row * 256 + 4 * lane) = (f32x4){qkv[1][0] * rk, qkv[1][1] * rk, qkv[1][2] * rk, qkv[1][3] * rk};
        *(f32x4*)(DV + (size_t)row * 256 + 4 * lane) = (f32x4){qkv[2][0], qkv[2][1], qkv[2][2], qkv[2][3]};
        if (lane < 4) { const int h = lane;
            const float af = bf2f(pr[GDN0 + 1024 + h]), ab = bf2f(pr[GDN0 + 1028 + h]), bfv = bf2f(pr[GDN0 + 1032 + h]), bbv = bf2f(pr[GDN0 + 1036 + h]);
            const float* al = a.in[I_GDNALOG] + l * 8; const float* dt = a.in[I_GDNDT] + l * 8;
            const float gf = -__expf(al[h]) * softplusf_(af + dt[h]), gb = -__expf(al[4 + h]) * softplusf_(ab + dt[4 + h]);
            *(f32x4*)(DG + (size_t)row * 16 + 4 * h) = (f32x4){sigmoidf_(bfv), __expf(gf), sigmoidf_(bbv), __expf(gb)}; }
    }
}

__device__ __forceinline__ int scan_row(int b, int dir, int n) {
    if (n < CTXL) return b * CTXL + (dir ? CTXL - 1 - n : n);
    const int m = n - CTXL; return NTOK_C + b * SEQ + (dir ? SEQ - 1 - m : m);
}
__device__ __forceinline__ void gla_chain(CArgs& a, int chain, LAS unsigned char* lds) {
    const int b = chain >> 3, h = (chain >> 1) & 3, dir = chain & 1;
    const int tid = tidx(), lane = tid & 63, w = tid >> 6, vv = lane & 7, kq = lane >> 3;
    const bf16* P = (const bf16*)(a.ws + WS_P);
    const float* GD = (const float*)(a.ws + WS_MIX + (dir ? MX_GDB : MX_GDF));
    float* GO = (float*)(a.ws + WS_MIX + (dir ? MX_GOB : MX_GOF));
    LAS float* sq = (LAS float*)lds;
    LAS float* sk = sq + 64 * 32;
    LAS float* sd = sk + 64 * 32;
    LAS float* sv = sd + 64 * 32;
    float S[4] = {0.f, 0.f, 0.f, 0.f};
    for (int ch = 0; ch < 36; ++ch) {
        { const int tt = tid >> 3, sub = tid & 7, row = scan_row(b, dir, ch * 64 + tt);
          const bf16* pr = P + (size_t)row * D_INP + GLA0;
          const u32x2 qv = *(const u32x2*)(pr + h * 32 + sub * 4), kv = *(const u32x2*)(pr + 128 + h * 32 + sub * 4);
          const f32x4 dv = *(const f32x4*)(GD + (size_t)row * 128 + h * 32 + sub * 4);
          const u32x4 vv8 = *(const u32x4*)(pr + 256 + h * 64 + sub * 8);
          const float qs = 0.17677669529663687f;
          *(LAS f32x4*)(sq + tt * 32 + sub * 4) = (f32x4){lo_bf(qv.x) * qs, hi_bf(qv.x) * qs, lo_bf(qv.y) * qs, hi_bf(qv.y) * qs};
          *(LAS f32x4*)(sk + tt * 32 + sub * 4) = (f32x4){lo_bf(kv.x), hi_bf(kv.x), lo_bf(kv.y), hi_bf(kv.y)};
          *(LAS f32x4*)(sd + tt * 32 + sub * 4) = dv;
          *(LAS f32x4*)(sv + tt * 64 + sub * 8) = (f32x4){lo_bf(vv8.x), hi_bf(vv8.x), lo_bf(vv8.y), hi_bf(vv8.y)};
          *(LAS f32x4*)(sv + tt * 64 + sub * 8 + 4) = (f32x4){lo_bf(vv8.z), hi_bf(vv8.z), lo_bf(vv8.w), hi_bf(vv8.w)}; }
        __syncthreads();
#pragma unroll 4
        for (int tt = 0; tt < 64; ++tt) {
            const f32x4 q4 = *(const LAS f32x4*)(sq + tt * 32 + kq * 4), k4 = *(const LAS f32x4*)(sk + tt * 32 + kq * 4), d4 = *(const LAS f32x4*)(sd + tt * 32 + kq * 4);
            const float v = sv[tt * 64 + w * 8 + vv];
            float o = 0.f;
#pragma unroll
            for (int j = 0; j < 4; ++j) { S[j] = d4[j] * S[j] + k4[j] * v; o += q4[j] * S[j]; }
            o += __shfl_xor(o, 8); o += __shfl_xor(o, 16); o += __shfl_xor(o, 32);
            if (kq == 0) GO[(size_t)scan_row(b, dir, ch * 64 + tt) * 256 + h * 64 + w * 8 + vv] = o;
        }
        __syncthreads();
    }
}
__device__ __forceinline__ void gdn_chain(CArgs& a, int chain, LAS unsigned char* lds) {
    const int b = chain >> 3, h = (chain >> 1) & 3, dir = chain & 1;
    const int tid = tidx(), lane = tid & 63, w = tid >> 6, vv = lane & 7, kq = lane >> 3;
    const float* DQ = (const float*)(a.ws + WS_MIX + MX_DQ); const float* DK = (const float*)(a.ws + WS_MIX + MX_DK); const float* DV = (const float*)(a.ws + WS_MIX + MX_DV);
    const float* DG = (const float*)(a.ws + WS_MIX + MX_DG);
    float* DO = (float*)(a.ws + WS_MIX + (dir ? MX_DOB : MX_DOF));
    LAS float* sq = (LAS float*)lds;
    LAS float* sk = sq + 64 * 64;
    LAS float* sv = sk + 64 * 64;
    LAS float* sg = sv + 64 * 64;
    float S[8];
#pragma unroll
    for (int j = 0; j < 8; ++j) S[j] = 0.f;
    for (int ch = 0; ch < 36; ++ch) {
        { const int tt = tid >> 3, sub = tid & 7, row = scan_row(b, dir, ch * 64 + tt);
          const size_t o = (size_t)row * 256 + h * 64 + sub * 8;
          *(LAS f32x4*)(sq + tt * 64 + sub * 8) = *(const f32x4*)(DQ + o); *(LAS f32x4*)(sq + tt * 64 + sub * 8 + 4) = *(const f32x4*)(DQ + o + 4);
          *(LAS f32x4*)(sk + tt * 64 + sub * 8) = *(const f32x4*)(DK + o); *(LAS f32x4*)(sk + tt * 64 + sub * 8 + 4) = *(const f32x4*)(DK + o + 4);
          *(LAS f32x4*)(sv + tt * 64 + sub * 8) = *(const f32x4*)(DV + o); *(LAS f32x4*)(sv + tt * 64 + sub * 8 + 4) = *(const f32x4*)(DV + o + 4);
          if (sub == 0) { const f32x4 g4 = *(const f32x4*)(DG + (size_t)row * 16 + h * 4); *(LAS f32x2*)(sg + tt * 2) = dir ? (f32x2){g4[2], g4[3]} : (f32x2){g4[0], g4[1]}; } }
        __syncthreads();
#pragma unroll 2
        for (int tt = 0; tt < 64; ++tt) {
            const f32x4 ka = *(const LAS f32x4*)(sk + tt * 64 + kq * 8), kb = *(const LAS f32x4*)(sk + tt * 64 + kq * 8 + 4);
            const f32x4 qa = *(const LAS f32x4*)(sq + tt * 64 + kq * 8), qb = *(const LAS f32x4*)(sq + tt * 64 + kq * 8 + 4);
            const float v = sv[tt * 64 + w * 8 + vv]; const f32x2 g2 = *(const LAS f32x2*)(sg + tt * 2);
            const float beta = g2.x, eg = g2.y;
            float ks = (ka[0] * S[0] + ka[1] * S[1]) + (ka[2] * S[2] + ka[3] * S[3]) + ((kb[0] * S[4] + kb[1] * S[5]) + (kb[2] * S[6] + kb[3] * S[7]));
            ks += __shfl_xor(ks, 8); ks += __shfl_xor(ks, 16); ks += __shfl_xor(ks, 32);
            const float wv = beta * (v - eg * ks);
            float o = 0.f;
#pragma unroll
            for (int j = 0; j < 4; ++j) { S[j] = eg * S[j] + ka[j] * wv; o += qa[j] * S[j]; }
#pragma unroll
            for (int j = 0; j < 4; ++j) { S[4 + j] = eg * S[4 + j] + kb[j] * wv; o += qb[j] * S[4 + j]; }
            o += __shfl_xor(o, 8); o += __shfl_xor(o, 16); o += __shfl_xor(o, 32);
            if (kq == 0) DO[(size_t)scan_row(b, dir, ch * 64 + tt) * 256 + h * 64 + w * 8 + vv] = o;
        }
        __syncthreads();
    }
}
template <int L>
__device__ __forceinline__ void hyena_unit(CArgs& a, int l, int c, LAS unsigned char* lds) {
    constexpr int Lt = L == SEQ ? 1 : 0, SOFF = L == SEQ ? CTXL : 0, CST = (2 * L + 16) * 2 + 32;
    constexpr int NTW = L / 16 / 8;
    const int tid = tidx(), lane = tid & 63, w = tid >> 6, fr = lane & 15, kg = lane >> 4;
    const float* kf = (const float*)(a.ws + WS_KUN) + ((size_t)((l * 2 + Lt) * 512 + c)) * 2048;
    const float* kb = kf + (size_t)256 * 2048;
    LAS float* red = (LAS float*)(lds + 8 * CST);
    float s = 0.f;
    for (int t = tid; t < L; t += 512) s += fabsf(kf[t]) + (t >= 1 ? fabsf(kb[t]) : 0.f);
    s = wave_sum(s);
    if (lane == 0) red[w] = s;
    __syncthreads();
    float l1 = 0.f;
#pragma unroll
    for (int i = 0; i < 8; ++i) l1 += red[i];
    const float inv = 1.f / l1;
    for (int idx = tid; idx < 2 * L + 16; idx += 512) {
        float gv = 0.f;
        if (idx >= 1 && idx <= L) gv = kf[L - idx] * inv; else if (idx > L && idx < 2 * L) gv = kb[idx - L] * inv;
        const bf16 gb = (bf16)f2bf(gv);
#pragma unroll
        for (int r = 0; r < 8; ++r) if (idx - r >= 0) *(LAS bf16*)(lds + r * CST + (idx - r) * 2) = gb;
    }
    __syncthreads();
    const bf16* Z = (const bf16*)(a.ws + WS_MIX + MX_ZT) + ((size_t)(c * 16 + fr)) * 2304 + SOFF;
    float* YT = (float*)(a.ws + WS_MIX + MX_YT) + ((size_t)(c * 16 + fr)) * 2304 + SOFF;
    f32x4 acc[NTW];
#pragma unroll
    for (int j = 0; j < NTW; ++j) acc[j] = (f32x4){0.f, 0.f, 0.f, 0.f};
    const int rr = (8 - (fr & 7)) & 7;
    for (int i = 0; i < L / 32; ++i) {
        const bf16x8 Bf = *(const bf16x8*)(Z + 32 * i + 8 * kg);
#pragma unroll
        for (int j = 0; j < NTW; ++j) {
            const int t0 = 16 * (w * NTW + j);
            const int o = 32 * i + 8 * kg - t0 - fr + L;
            const bf16x8 Af = *(const LAS bf16x8*)(lds + rr * CST + (o >> 3) * 16);
            acc[j] = __builtin_amdgcn_mfma_f32_16x16x32_bf16(Af, Bf, acc[j], 0, 0, 0);
        }
    }
#pragma unroll
    for (int j = 0; j < NTW; ++j) *(f32x4*)(YT + 16 * (w * NTW + j) + 4 * kg) = acc[j];
    __syncthreads();
}
__device__ __forceinline__ void ph_scan(CArgs& a, int l, LAS unsigned char* lds, int bid, int nblk) {
    for (int it = bid; it < 768; it += nblk) {
        if (it < 128) gdn_chain(a, it, lds);
        else if (it < 256) gla_chain(a, it - 128, lds);
        else if (it < 512) hyena_unit<SEQ>(a, l, it - 256, lds);
        else hyena_unit<CTXL>(a, l, it - 512, lds);
    }
}

__device__ __forceinline__ void ph_post_hyena(CArgs& a, int l, LAS unsigned char* lds, int bid, int nblk) {
    const bf16* P = (const bf16*)(a.ws + WS_P);
    const float* YT = (const float*)(a.ws + WS_MIX + MX_YT); bf16* YMIX = (bf16*)(a.ws + WS_YMIX);
    LAS float* yt = (LAS float*)lds;
    const int tid = tidx(), c2 = (tid & 127) * 2, tg = tid >> 7;
    const float* hw = a.in[I_HYCW] + l * 3 * 768; const float* hb = a.in[I_HYCB] + l * 768; const float* hd = a.in[I_HYD] + l * 256;
    for (int it = bid; it < 576; it += nblk) {
        const Chunk c = chunk_of(it);
        const int soff = c.L == CTXL ? 0 : CTXL;
        { const int ch = tid & 255, half = tid >> 8;
          const float* src = YT + ((size_t)(ch * 16 + c.b)) * 2304 + soff + c.t0 + half * 32;
#pragma unroll
          for (int j = 0; j < 8; ++j) { const f32x4 v = *(const f32x4*)(src + 4 * j);
              yt[ch * 65 + half * 32 + 4 * j] = v[0]; yt[ch * 65 + half * 32 + 4 * j + 1] = v[1]; yt[ch * 65 + half * 32 + 4 * j + 2] = v[2]; yt[ch * 65 + half * 32 + 4 * j + 3] = v[3]; } }
        __syncthreads();
#pragma unroll 1
        for (int tt = tg * 16; tt < tg * 16 + 16; ++tt) {
            const int t = c.t0 + tt;
            f32x2 x0 = conv3_2(P, c, t, HY0 + c2, hw, 768, c2), x1 = conv3_2(P, c, t, HY0 + 256 + c2, hw, 768, 256 + c2), v = conv3_2(P, c, t, HY0 + 512 + c2, hw, 768, 512 + c2);
            x0.x += hb[c2]; x0.y += hb[c2 + 1]; x1.x += hb[256 + c2]; x1.y += hb[256 + c2 + 1]; v.x += hb[512 + c2]; v.y += hb[512 + c2 + 1];
            const float zx = x1.x * v.x, zy = x1.y * v.y;
            const float ox = (yt[c2 * 65 + tt] + zx * hd[c2]) * x0.x, oy = (yt[(c2 + 1) * 65 + tt] + zy * hd[c2 + 1]) * x0.y;
            *(unsigned*)(YMIX + (size_t)(c.row0 + tt) * D + c2) = pk2(ox, oy);
        }
        __syncthreads();
    }
}
__device__ __forceinline__ void ph_post_tok(CArgs& a, int l, int gw, int ngw) {
    const int lane = tidx() & 63;
    const bf16* P = (const bf16*)(a.ws + WS_P); bf16* YMIX = (bf16*)(a.ws + WS_YMIX);
    const float* GOF = (const float*)(a.ws + WS_MIX + MX_GOF); const float* GOB = (const float*)(a.ws + WS_MIX + MX_GOB);
    const float* DOF = (const float*)(a.ws + WS_MIX + MX_DOF); const float* DOB = (const float*)(a.ws + WS_MIX + MX_DOB);
    const f32x4 nwa = *(const f32x4*)(a.in[I_GLANW] + l * 64 + (4 * lane & 63)), nwd = *(const f32x4*)(a.in[I_GDNNW] + l * 64 + (4 * lane & 63));
    for (int row = gw; row < NTOK; row += ngw) {
        const size_t o4 = (size_t)row * 256 + 4 * lane;
        f32x4 og = *(const f32x4*)(GOF + o4) + *(const f32x4*)(GOB + o4), od = *(const f32x4*)(DOF + o4) + *(const f32x4*)(DOB + o4);
        float sg = og[0] * og[0] + og[1] * og[1] + og[2] * og[2] + og[3] * og[3], sd = od[0] * od[0] + od[1] * od[1] + od[2] * od[2] + od[3] * od[3];
#pragma unroll
        for (int o = 1; o < 16; o <<= 1) { sg += __shfl_xor(sg, o); sd += __shfl_xor(sd, o); }
        const float rg = rsqrtf(sg * (1.f / 64.f) + 1e-6f), rd = rsqrtf(sd * (1.f / 64.f) + 1e-6f);
        const u32x2 r2 = *(const u32x2*)(P + (size_t)row * D_INP + GLA0 + 512 + 4 * lane), z2 = *(const u32x2*)(P + (size_t)row * D_INP + GDN0 + 768 + 4 * lane);
        u32x2 w;
        w.x = pk2(og[0] * rg * nwa[0] * siluf_(lo_bf(r2.x)), og[1] * rg * nwa[1] * siluf_(hi_bf(r2.x))); w.y = pk2(og[2] * rg * nwa[2] * siluf_(lo_bf(r2.y)), og[3] * rg * nwa[3] * siluf_(hi_bf(r2.y)));
        *(u32x2*)(YMIX + (size_t)row * D + 512 + 4 * lane) = w;
        w.x = pk2(od[0] * rd * nwd[0] * siluf_(lo_bf(z2.x)), od[1] * rd * nwd[1] * siluf_(hi_bf(z2.x))); w.y = pk2(od[2] * rd * nwd[2] * siluf_(lo_bf(z2.y)), od[3] * rd * nwd[3] * siluf_(hi_bf(z2.y)));
        *(u32x2*)(YMIX + (size_t)row * D + 768 + 4 * lane) = w;
    }
}

__device__ __forceinline__ void ph_ln1_route(CArgs& a, int l, LAS unsigned char* lds, int gw, int ngw) {
    const int lane = tidx() & 63, w = tidx() >> 6;
    const float* MOD = (const float*)(a.ws + WS_MOD) + (size_t)l * 17 * 6144;
    float* X = (float*)(a.ws + WS_X); const float* TMP = (const float*)(a.ws + WS_TMP); bf16* HB = (bf16*)(a.ws + WS_HB);
    const float* lg = a.in[I_LN1G] + l * D; const float* lb = a.in[I_LN1B] + l * D;
    const float* wr = a.in[I_WR] + (size_t)l * D * NEXP; const float* br = a.in[I_BR] + l * NEXP;
    unsigned* cnt = (unsigned*)(a.ws + WS_CTL) + CW_CNT + l * NEXP;
    int* LIST = (int*)(a.ws + WS_LIST); int* TOPE = (int*)(a.ws + WS_TOPE); float* TOPW = (float*)(a.ws + WS_TOPW);
    LAS float* hrow = (LAS float*)(lds + w * 4096);
    const int row_lo = (l == DEPTH - 1) ? NTOK_C : 0;
    for (int row = row_lo + gw; row < NTOK; row += ngw) {
        const float* xs = (l == 0) ? (row < NTOK_C ? a.in[I_CTX] + (size_t)row * D : a.in[I_X] + (size_t)(row - NTOK_C) * D) : X + (size_t)row * D;
        const float* mv = MOD + (size_t)mod_vec(row) * 6144;
        f32x4 v[4]; float s = 0.f;
#pragma unroll
        for (int j = 0; j < 4; ++j) { const int c0 = j * 256 + 4 * lane; const f32x4 x = *(const f32x4*)(xs + c0), t = *(const f32x4*)(TMP + (size_t)row * D + c0), g1 = *(const f32x4*)(mv + 2048 + c0);
            v[j] = DN_ALPHA * x + g1 * t; s += (v[j][0] + v[j][1]) + (v[j][2] + v[j][3]); }
        const float mean = wave_sum(s) * (1.f / D); float s2 = 0.f;
#pragma unroll
        for (int j = 0; j < 4; ++j) { v[j] = v[j] - mean; s2 += (v[j][0] * v[j][0] + v[j][1] * v[j][1]) + (v[j][2] * v[j][2] + v[j][3] * v[j][3]); }
        const float rstd = rsqrtf(wave_sum(s2) * (1.f / D) + LN_EPS);
#pragma unroll
        for (int j = 0; j < 4; ++j) { const int c0 = j * 256 + 4 * lane; const f32x4 g = *(const f32x4*)(lg + c0), bb = *(const f32x4*)(lb + c0), sh = *(const f32x4*)(mv + 3072 + c0), sc = *(const f32x4*)(mv + 4096 + c0);
            const f32x4 xn = v[j] * rstd * g + bb; *(f32x4*)(X + (size_t)row * D + c0) = xn;
            const f32x4 hh = xn * (1.f + sc) + sh;
            u32x2 o; o.x = pk2(hh[0], hh[1]); o.y = pk2(hh[2], hh[3]); *(u32x2*)(HB + (size_t)row * D + c0) = o;
            *(LAS f32x4*)(hrow + c0) = hh; }
        asm volatile("s_waitcnt lgkmcnt(0)" ::: "memory");
        const int e = lane & 31, par = lane >> 5; float lg_ = 0.f;
#pragma unroll 8
        for (int k = 0; k < 512; ++k) { const int kk = 2 * k + par; lg_ += hrow[kk] * wr[kk * NEXP + e]; }
        lg_ += __shfl_xor(lg_, 32); lg_ += br[e];
        float tv[4]; int ti[4]; float cur = lg_;
#pragma unroll
        for (int k = 0; k < 4; ++k) { float bv = cur; int bi = e;
#pragma unroll
            for (int o = 1; o < 32; o <<= 1) { const float ov = __shfl_xor(bv, o); const int oi = __shfl_xor(bi, o); if (ov > bv || (ov == bv && oi < bi)) { bv = ov; bi = oi; } }
            tv[k] = bv; ti[k] = bi; if (e == bi) cur = -3.0e38f; }
        const float e1 = __expf(tv[1] - tv[0]), e2 = __expf(tv[2] - tv[0]), e3 = __expf(tv[3] - tv[0]); const float inv = 1.f / (1.f + e1 + e2 + e3);
        if (lane < 4) { const int ee = lane == 0 ? ti[0] : lane == 1 ? ti[1] : lane == 2 ? ti[2] : ti[3]; const float ww = (lane == 0 ? 1.f : lane == 1 ? e1 : lane == 2 ? e2 : e3) * inv;
            const unsigned pos = atomicAdd(cnt + ee, 1u);
            LIST[(size_t)ee * NTOK + pos] = row; TOPE[(size_t)row * 4 + lane] = (ee << 20) | (int)pos; TOPW[(size_t)row * 4 + lane] = ww; }
    }
}
__device__ __forceinline__ void moe_tables(CArgs& a, int l, LAS unsigned char* lds, int NT) {
    LAS int* pre = (LAS int*)(lds + TAB_OFF); LAS int* mtl = pre + 40; LAS int* rowoff = pre + 80; LAS int* cn = pre + 120;
    if (tidx() == 0) { const unsigned* cnt = (const unsigned*)(a.ws + WS_CTL) + CW_CNT + l * NEXP; int p = 0, r = 0;
        for (int e = 0; e < NEXP; ++e) { const int n = (int)__hip_atomic_load(cnt + e, __ATOMIC_RELAXED, __HIP_MEMORY_SCOPE_AGENT), m = (n + 255) >> 8; pre[e] = p; mtl[e] = m > 0 ? m : 1; rowoff[e] = r; cn[e] = n; p += m * NT; r += m * 256; }
        pre[32] = p; }
    __syncthreads();
}
__device__ __forceinline__ void ph_ln2(CArgs& a, int l, LAS unsigned char* lds, int gw, int ngw) {
    const int lane = tidx() & 63;
    const float* MOD = (const float*)(a.ws + WS_MOD) + (size_t)l * 17 * 6144;
    float* X = (float*)(a.ws + WS_X); const bf16* YD = (const bf16*)(a.ws + WS_YD); bf16* HB = (bf16*)(a.ws + WS_HB);
    const float* lg = a.in[I_LN2G] + l * D; const float* lb = a.in[I_LN2B] + l * D;
    const int* TOPE = (const int*)(a.ws + WS_TOPE); const float* TOPW = (const float*)(a.ws + WS_TOPW);
    const LAS int* rowoff = (const LAS int*)(lds + TAB_OFF) + 80;
    const bool lastl = (l == DEPTH - 1);
    const int row_lo = lastl ? NTOK_C : 0;
    for (int row = row_lo + gw; row < NTOK; row += ngw) {
        const float* mv = MOD + (size_t)mod_vec(row) * 6144;
        f32x4 f[4];
#pragma unroll
        for (int j = 0; j < 4; ++j) f[j] = (f32x4){0.f, 0.f, 0.f, 0.f};
#pragma unroll
        for (int k = 0; k < 4; ++k) { const int te = TOPE[(size_t)row * 4 + k]; const float ww = TOPW[(size_t)row * 4 + k];
            const bf16* yr = YD + ((size_t)(rowoff[te >> 20] + (te & 0xfffff))) * D;
#pragma unroll
            for (int j = 0; j < 4; ++j) { const u32x2 y2 = *(const u32x2*)(yr + j * 256 + 4 * lane); f[j] += ww * (f32x4){lo_bf(y2.x), hi_bf(y2.x), lo_bf(y2.y), hi_bf(y2.y)}; } }
        f32x4 v[4]; float s = 0.f;
#pragma unroll
        for (int j = 0; j < 4; ++j) { const int c0 = j * 256 + 4 * lane; const f32x4 x = *(const f32x4*)(X + (size_t)row * D + c0), g2 = *(const f32x4*)(mv + 5120 + c0);
            v[j] = DN_ALPHA * x + g2 * f[j]; s += (v[j][0] + v[j][1]) + (v[j][2] + v[j][3]); }
        const float mean = wave_sum(s) * (1.f / D); float s2 = 0.f;
#pragma unroll
        for (int j = 0; j < 4; ++j) { v[j] = v[j] - mean; s2 += (v[j][0] * v[j][0] + v[j][1] * v[j][1]) + (v[j][2] * v[j][2] + v[j][3] * v[j][3]); }
        const float rstd = rsqrtf(wave_sum(s2) * (1.f / D) + LN_EPS);
        const float* mvn = mv + 17 * 6144;
#pragma unroll
        for (int j = 0; j < 4; ++j) { const int c0 = j * 256 + 4 * lane; const f32x4 g = *(const f32x4*)(lg + c0), bb = *(const f32x4*)(lb + c0);
            const f32x4 xn = v[j] * rstd * g + bb;
            if (lastl) *(f32x4*)(a.out + (size_t)(row - NTOK_C) * D + c0) = xn;
            else { *(f32x4*)(X + (size_t)row * D + c0) = xn; const f32x4 sh = *(const f32x4*)(mvn + c0), sc = *(const f32x4*)(mvn + 1024 + c0); const f32x4 hh = xn * (1.f + sc) + sh;
                u32x2 o; o.x = pk2(hh[0], hh[1]); o.y = pk2(hh[2], hh[3]); *(u32x2*)(HB + (size_t)row * D + c0) = o; } }
    }
}

constexpr int NPH = 2 + DEPTH * 9;
__device__ __forceinline__ CArgs* kargs() { CArgs* p = (CArgs*)__builtin_amdgcn_kernarg_segment_ptr(); asm volatile("" : "+s"(p)); return p; }
__global__ void __launch_bounds__(512, 2) trunk_fwd(Args a_unused) {
    extern __shared__ __attribute__((aligned(16))) unsigned char lds_raw[];
    LAS unsigned char* lds = (LAS unsigned char*)lds_raw;
    const int tid = threadIdx.x, wave = __builtin_amdgcn_readfirstlane(tid >> 6);
    const int bid = blockIdx.x, nblk = gridDim.x, gw = bid * 8 + wave, ngw = nblk * 8;
    volatile LAS unsigned* MISC = (volatile LAS unsigned*)(lds + MISC_OFF);
    if (tid < 64) MISC[tid] = 0u;
    __syncthreads();
    XcdBarrier bar; bar.x = 0; bar.st = nullptr;
    int lo, hi;
    { CArgs& a = *kargs(); lo = a.ph_lo; hi = a.ph_hi; bar.bar = (unsigned*)(a.ws + WS_CTL) + CW_BAR;
      if (hi - lo > 1) bar = xcd_barrier_post((unsigned*)(a.ws + WS_CTL) + CW_BAR, MISC); }
#define IN(k) (lo <= (k) && (k) < hi)
#define SEAM(k) do { if (IN(k) && IN((k) + 1)) xcd_barrier(bar); } while (0)
    if (IN(0)) { CArgs& a = *kargs(); ph_mod(a, lds, bid, nblk); __syncthreads(); ph_filters(a, gw, ngw); ph_tr_small(a, lds, gw, ngw); ph_tr_experts(a, 0, lds, gw, ngw); }
    SEAM(0);
    if (IN(1)) { CArgs& a = *kargs(); ph_mod_input(a, gw, ngw); }
    SEAM(1);
#pragma unroll 1
    for (int l = 0; l < DEPTH; ++l) {
        const int p0 = 2 + 9 * l;
        const bool lastl = (l == DEPTH - 1);
        if (IN(p0 + 0)) {
            CArgs& a = *kargs();
            pg8::DenseSched S; S.init((const bf16*)(a.ws + WS_WIN) + (size_t)l * D_INP * 1024, 1024, NTOK, D_INP, nblk, bid, 0);
            pg8::EpiBf16 E{(bf16*)(a.ws + WS_P), D_INP, 0};
            pg8::gemm_phase<pg8::EpiBf16, pg8::DenseSched, true>(lds, (const char*)(a.ws + WS_HB), 1024, S, E);
        }
        SEAM(p0 + 0);
        if (IN(p0 + 1)) { CArgs& a = *kargs(); ph_prep_conv(a, l, lds, bid, nblk); ph_prep_tok(a, l, gw, ngw); }
        SEAM(p0 + 1);
        if (IN(p0 + 2)) { CArgs& a = *kargs(); ph_scan(a, l, lds, bid, nblk); if (l > 0) { __syncthreads(); ph_tr_experts(a, l, lds, gw, ngw); } }
        SEAM(p0 + 2);
        if (IN(p0 + 3)) { CArgs& a = *kargs(); ph_post_hyena(a, l, lds, bid, nblk); ph_post_tok(a, l, gw, ngw); }
        SEAM(p0 + 3);
        if (IN(p0 + 4)) {
            CArgs& a = *kargs();
            const int r0 = lastl ? NTOK_C : 0;
            pg8::DenseSched S; S.init((const bf16*)(a.ws + WS_WOUT) + (size_t)l * 1024 * 1024, 1024, NTOK - r0, 1024, nblk, bid, r0);
            pg8::EpiF32 E{(float*)(a.ws + WS_TMP), 1024, r0};
            pg8::gemm_phase<pg8::EpiF32, pg8::DenseSched, true>(lds, (const char*)(a.ws + WS_YMIX), 1024, S, E);
        }
        SEAM(p0 + 4);
        if (IN(p0 + 5)) { CArgs& a = *kargs(); ph_ln1_route(a, l, lds, gw, ngw); }
        SEAM(p0 + 5);
        if (IN(p0 + 6)) {
            CArgs& a = *kargs();
            moe_tables(a, l, lds, 8);
            const LAS int* tb = (const LAS int*)(lds + TAB_OFF);
            pg8::MoeSched<true, 8> S; S.Bt = (const char*)(a.ws + WS_WGU); S.bstride = (size_t)2048 * 1024 * 2; S.list = (const int*)(a.ws + WS_LIST);
            S.pre = tb; S.mtl = tb + 40; S.rowoff = tb + 80; S.cnt = tb + 120; S.K = 1024; S.G = nblk; S.c = bid; S.total = tb[32];
            pg8::EpiSwiglu E{(bf16*)(a.ws + WS_H), a.in[I_BG] + (size_t)l * NEXP * 1024, a.in[I_BU] + (size_t)l * NEXP * 1024, tb + 80};
            pg8::gemm_phase<pg8::EpiSwiglu, pg8::MoeSched<true, 8>, true>(lds, (const char*)(a.ws + WS_HB), 1024, S, E);
        }
        SEAM(p0 + 6);
        if (IN(p0 + 7)) {
            CArgs& a = *kargs();
            moe_tables(a, l, lds, 4);
            const LAS int* tb = (const LAS int*)(lds + TAB_OFF);
            pg8::MoeSched<false, 4> S; S.Bt = (const char*)(a.ws + WS_WD); S.bstride = (size_t)1024 * 1024 * 2; S.list = nullptr;
            S.pre = tb; S.mtl = tb + 40; S.rowoff = tb + 80; S.cnt = tb + 120; S.K = 1024; S.G = nblk; S.c = bid; S.total = tb[32];
            pg8::EpiDown E{(bf16*)(a.ws + WS_YD), a.in[I_BD] + (size_t)l * NEXP * 1024, tb + 80};
            pg8::gemm_phase<pg8::EpiDown, pg8::MoeSched<false, 4>, true>(lds, (const char*)(a.ws + WS_H), 1024, S, E);
        }
        SEAM(p0 + 7);
        if (IN(p0 + 8)) { CArgs& a = *kargs(); moe_tables(a, l, lds, 4); ph_ln2(a, l, lds, gw, ngw); }
        if (!lastl) SEAM(p0 + 8);
    }
#undef IN
#undef SEAM
}

extern "C" void kernel_launch(void* const* d_in, const int* in_sizes, int n_in, void* d_out, int out_size, void* d_ws, size_t ws_size, hipStream_t stream) {
    static int grid = 0;
    if (grid == 0) {
        if (n_in != 39 || out_size != NTOK_L * D || ws_size < WS_END) { fprintf(stderr, "kernel_launch: unexpected problem (n_in %d, out %d, ws %zu < %zu)\n", n_in, out_size, ws_size, (size_t)WS_END); grid = -1; return; }
        int dev = 0, cus = 0, per_cu = 0;
        if (hipGetDevice(&dev) != hipSuccess || hipDeviceGetAttribute(&cus, hipDeviceAttributeMultiprocessorCount, dev) != hipSuccess) { grid = -1; return; }
        if (hipFuncSetAttribute((const void*)trunk_fwd, hipFuncAttributeMaxDynamicSharedMemorySize, LDS_BYTES) != hipSuccess) { fprintf(stderr, "kernel_launch: hipFuncSetAttribute failed\n"); grid = -1; return; }
        if (hipOccupancyMaxActiveBlocksPerMultiprocessor(&per_cu, (const void*)trunk_fwd, 512, LDS_BYTES) != hipSuccess || per_cu < 1) fprintf(stderr, "kernel_launch: occupancy query says %d\n", per_cu);
        (void)hipGetLastError();
        grid = cus;
    }
    if (grid < 0) return;
    (void)hipMemsetAsync((char*)d_ws + WS_CTL, 0, CTL_ZERO_BYTES, stream);
    Args a{};
    for (int i = 0; i < 39; ++i) a.in[i] = (const float*)d_in[i];
    a.out = (float*)d_out; a.ws = (unsigned char*)d_ws;
#if MK_FUSED
    a.ph_lo = 0; a.ph_hi = NPH;
    hipLaunchKernelGGL(trunk_fwd, dim3(grid), dim3(512), LDS_BYTES, stream, a);
#else
    for (int p = 0; p < NPH; ++p) { a.ph_lo = p; a.ph_hi = p + 1; hipLaunchKernelGGL(trunk_fwd, dim3(grid), dim3(512), LDS_BYTES, stream, a); }
#endif
}
```

```cpp
#include <hip/hip_runtime.h>
#include <cstdio>
#include <cstdint>

#ifndef MK_FUSED
#define MK_FUSED 1
#endif

#ifndef USE_NEW_GDN
#define USE_NEW_GDN 1
#endif
#ifndef USE_NEW_GLA
#define USE_NEW_GLA 1
#endif
#ifndef PROBE_PH
#define PROBE_PH -1
#endif

#define LAS __attribute__((address_space(3)))
#define GAS __attribute__((address_space(1)))
typedef unsigned short bf16;
typedef short bf16x8 __attribute__((ext_vector_type(8)));
typedef float f32x4 __attribute__((ext_vector_type(4)));
typedef float f32x2 __attribute__((ext_vector_type(2)));
typedef unsigned u32x4 __attribute__((ext_vector_type(4)));
typedef unsigned u32x2 __attribute__((ext_vector_type(2)));

constexpr int D = 1024, NB = 16, SEQ = 2048, CTXL = 256, DEPTH = 4;
constexpr int NTOK_C = NB * CTXL, NTOK_L = NB * SEQ, NTOK = NTOK_C + NTOK_L;
constexpr int D_IN = 3376, D_INP = 3584;
constexpr int HY0 = 0, SC0 = 768, GLA0 = 1536, GDN0 = 2336;
constexpr int NEXP = 32, TOPK = 4;
constexpr int MAXROWS = NTOK * TOPK + NEXP * 256;
constexpr float DN_ALPHA = 1.681792830507429f;
constexpr float LN_EPS = 1e-5f;

constexpr size_t MiB = 1u << 20;
constexpr size_t WS_CTL = 0, CTL_ZERO_BYTES = 1 * MiB;
constexpr size_t WS_MOD = 1 * MiB;
constexpr size_t WS_WRT = 3 * MiB;
constexpr size_t WS_KUN = 4 * MiB;
constexpr size_t WS_WIN = 36 * MiB;
constexpr size_t WS_WOUT = 64 * MiB;
constexpr size_t WS_WGU = 72 * MiB;
constexpr size_t WS_WD = 200 * MiB;
constexpr size_t WS_X = 264 * MiB;
constexpr size_t WS_HB = 408 * MiB;
constexpr size_t WS_P = 480 * MiB;
constexpr size_t WS_YMIX = 732 * MiB;
constexpr size_t WS_YD = WS_P;
constexpr size_t WS_TMP = 804 * MiB;
constexpr size_t WS_LIST = 948 * MiB;
constexpr size_t WS_TOPE = 953 * MiB;
constexpr size_t WS_TOPW = 954 * MiB;
constexpr size_t WS_H = 956 * MiB;
constexpr size_t WS_MIX = 1264 * MiB;
constexpr size_t MX_ZT = 0;
constexpr size_t MX_YT = 20 * MiB;
constexpr size_t MX_GDF = 56 * MiB, MX_GDB = 76 * MiB;
constexpr size_t MX_GOF = 96 * MiB, MX_GOB = 132 * MiB;
constexpr size_t MX_DQ = 168 * MiB, MX_DK = 204 * MiB, MX_DV = 240 * MiB;
constexpr size_t MX_DG = 276 * MiB;
constexpr size_t MX_DOF = 280 * MiB, MX_DOB = 316 * MiB;
constexpr size_t WS_END = WS_MIX + 352 * MiB;
static_assert((size_t)MAXROWS * 1024 * 2 <= 324 * MiB, "YD overlay");
static_assert(WS_H + (size_t)MAXROWS * 1024 * 2 <= WS_MIX, "H");
constexpr int CW_BAR = 4096;
constexpr int CW_CNT = 16384;

constexpr int LDS_BYTES = 147456;
constexpr int MISC_OFF = 131072;
constexpr int TAB_OFF = 131072 + 256;

__device__ __forceinline__ float bf2f(unsigned v) { return __uint_as_float(v << 16); }
__device__ __forceinline__ unsigned f2bf(float f) { unsigned u = __float_as_uint(f); return (u + 0x7fffu + ((u >> 16) & 1u)) >> 16; }
__device__ __forceinline__ unsigned pk2(float lo, float hi) { return f2bf(lo) | (f2bf(hi) << 16); }
__device__ __forceinline__ float lo_bf(unsigned w) { return __uint_as_float(w << 16); }
__device__ __forceinline__ float hi_bf(unsigned w) { return __uint_as_float(w & 0xffff0000u); }
__device__ __forceinline__ float sigmoidf_(float x) { return 1.f / (1.f + __expf(-x)); }
__device__ __forceinline__ float siluf_(float x) { return x / (1.f + __expf(-x)); }
__device__ __forceinline__ float softplusf_(float x) { return x > 20.f ? x : log1pf(__expf(x)); }
__device__ __forceinline__ float logsigmoidf_(float x) { return x >= 0.f ? -log1pf(__expf(-x)) : x - log1pf(__expf(x)); }
__device__ __forceinline__ float sin_rev(float r) { return __builtin_amdgcn_sinf(__builtin_amdgcn_fractf(r)); }
__device__ __forceinline__ float sin_rad(float x) { return sin_rev(x * 0.15915494309189535f); }
template <int CTRL> __device__ __forceinline__ float dpp_f(float v) { return __builtin_bit_cast(float, __builtin_amdgcn_update_dpp(0, __builtin_bit_cast(int, v), CTRL, 0xf, 0xf, true)); }
template <int CTRL> __device__ __forceinline__ int dpp_i(int v) { return __builtin_amdgcn_update_dpp(0, v, CTRL, 0xf, 0xf, true); }
__device__ __forceinline__ float quad_sum(float v) { v += dpp_f<0xB1>(v); v += dpp_f<0x4E>(v); return v; }
__device__ __forceinline__ float row16_sum(float v) { v += dpp_f<0xB1>(v); v += dpp_f<0x4E>(v); v += dpp_f<0x141>(v); v += dpp_f<0x140>(v); return v; }
__device__ __forceinline__ float rdlane_f(float v, int l) { return __builtin_bit_cast(float, __builtin_amdgcn_readlane(__builtin_bit_cast(int, v), l)); }
__device__ __forceinline__ float wave_sum(float v) {
    v = row16_sum(v);
    return (rdlane_f(v, 0) + rdlane_f(v, 16)) + (rdlane_f(v, 32) + rdlane_f(v, 48));
}
__device__ __forceinline__ int tidx() { int t = threadIdx.x; asm volatile("" : "+v"(t)); return t; }

#define XB_TMO      128
#define XB_XCNT(j)  (256  + 64 * (j))
#define XB_XSUB(j)  (1280 + 64 * (j))
#define XB_XGEN(j)  (2304 + 64 * (j))
#define XB_TOP      3328
#define XB_TOPGEN   3392
#define XCD_BAR_WORDS 3456
#define XB_SPIN_CAP (1u << 25)
__device__ __forceinline__ unsigned xb_ld(unsigned* p)              { return __hip_atomic_load(p, __ATOMIC_RELAXED, __HIP_MEMORY_SCOPE_AGENT); }
__device__ __forceinline__ unsigned xb_add(unsigned* p, unsigned v) { return __hip_atomic_fetch_add(p, v, __ATOMIC_RELAXED, __HIP_MEMORY_SCOPE_AGENT); }
__device__ __forceinline__ unsigned xb_xcc_id() { return (unsigned)__builtin_amdgcn_s_getreg((3 << 11) | 20) & 0xFu; }
#define XB_SPIN(cond, bar) do { unsigned _sp = 0; while (cond) { __builtin_amdgcn_s_sleep(1); \
    if ((++_sp & 255u) == 0u) { if (xb_ld(&(bar)[XB_TMO])) break; if (_sp > XB_SPIN_CAP) { atomicAdd(&(bar)[XB_TMO], 1u); break; } } } } while (0)
struct XcdBarrier { unsigned* bar; unsigned x; volatile LAS unsigned* st; };
__device__ __forceinline__ XcdBarrier xcd_barrier_post(unsigned* bar, volatile LAS unsigned* st) {
    XcdBarrier b; b.bar = bar; b.x = xb_xcc_id(); b.st = st;
    if (threadIdx.x == 0) (void)xb_add(&bar[XB_XCNT(b.x)], 1u);
    return b;
}
__device__ __forceinline__ void xcd_barrier_complete(unsigned* bar, unsigned x, unsigned& nloc, unsigned& nx) {
    const unsigned G = gridDim.x * gridDim.y * gridDim.z;
    unsigned sum, cnt, mine, sp = 0u;
    for (;;) {
        sum = 0u; cnt = 0u; mine = 0u;
#pragma unroll
        for (unsigned j = 0; j < 16; ++j) { const unsigned c = xb_ld(&bar[XB_XCNT(j)]); sum += c; cnt += (c > 0u) ? 1u : 0u; mine = (j == x) ? c : mine; }
        if (sum == G) break;
        __builtin_amdgcn_s_sleep(1);
        if ((++sp & 255u) == 0u) { if (xb_ld(&bar[XB_TMO])) break; if (sp > XB_SPIN_CAP) { atomicAdd(&bar[XB_TMO], 1u); break; } }
    }
    nloc = mine > 0u ? mine : 1u; nx = cnt > 0u ? cnt : 1u;
}
__device__ __forceinline__ void xcd_barrier(const XcdBarrier& b) {
    asm volatile("s_waitcnt vmcnt(0)" ::: "memory");
    __syncthreads();
    if (threadIdx.x == 0) {
        unsigned* bar = b.bar;
        __builtin_amdgcn_s_waitcnt(0);
        unsigned nloc = b.st[0], nx = b.st[1];
        if (nloc == 0u) { xcd_barrier_complete(bar, b.x, nloc, nx); b.st[0] = nloc; b.st[1] = nx; }
        const unsigned old = xb_add(&bar[XB_XSUB(b.x)], 1u);
        const unsigned gen = old / nloc;
        if (old + 1u == (gen + 1u) * nloc) {
            __builtin_amdgcn_fence(__ATOMIC_RELEASE, "agent");
            asm volatile("s_waitcnt vmcnt(0)" ::: "memory");
            const unsigned og = xb_add(&bar[XB_TOP], 1u);
            const unsigned tg = og / nx;
            if (og + 1u == (tg + 1u) * nx) xb_add(&bar[XB_TOPGEN], 1u);
            else XB_SPIN(xb_ld(&bar[XB_TOPGEN]) == tg, bar);
            __builtin_amdgcn_fence(__ATOMIC_ACQUIRE, "agent");
            xb_add(&bar[XB_XGEN(b.x)], 1u);
            asm volatile("s_waitcnt vmcnt(0)" ::: "memory");
        } else {
            XB_SPIN(xb_ld(&bar[XB_XGEN(b.x)]) == gen, bar);
            __builtin_amdgcn_fence(__ATOMIC_ACQUIRE, "agent");
            asm volatile("s_waitcnt vmcnt(0)" ::: "memory");
        }
    }
    __syncthreads();
}

namespace pg8 {
constexpr int BM = 256, BK = 64, HALF = 128, HTB = HALF * BK * 2, STAGE_BYTES = 8 * HTB, NXCD = 8, WGM = 8;
__host__ __device__ __forceinline__ int lds_byte(int r, int c) { const int st = (r >> 4) * 2 + (c >> 5), rr = r & 15, cc = c & 31, ob = rr * 64 + cc * 2; return st * 1024 + (ob ^ (((ob >> 9) & 1) << 5)); }
__host__ __device__ __forceinline__ void stage_rc(int b, int& R, int& C) { const int st = b / 1024, sb = b % 1024, swz = sb ^ (((sb >> 9) & 1) << 5); R = (st >> 1) * 16 + swz / 64; C = (st & 1) * 32 + (swz % 64) / 2; }
__host__ __device__ __forceinline__ int perm32(int rho) { const int n = rho >> 4, i = rho & 15; return 8 * (i >> 2) + 4 * n + (i & 3); }
__device__ __forceinline__ unsigned cvt_pk_bf16(float lo, float hi) { unsigned r; asm volatile("v_cvt_pk_bf16_f32 %0, %1, %2" : "=v"(r) : "v"(lo), "v"(hi)); return r; }

struct Unit { int pm, pn, e, mt; };

struct DenseSched {
    const char* Bt; int K, nM, nN, nwg, G, c, row0;
    __device__ __forceinline__ void init(const bf16* Bt_, int K_, int M, int N, int G_, int c_, int row0_) { Bt = (const char*)Bt_; K = K_; nM = M / BM; nN = N / BM; nwg = nM * nN; G = G_; c = c_; row0 = row0_; }
    __device__ __forceinline__ bool next(int i, Unit& u) const {
        const long L = (long)i * G + c; if (L >= nwg) return false;
        int wgid = (int)L; { const int q = nwg / NXCD, r = nwg % NXCD, xcd = wgid % NXCD, off = wgid / NXCD; wgid = (xcd < r ? xcd * (q + 1) : r * (q + 1) + (xcd - r) * q) + off; }
        const int nig = WGM * nN, gid = wgid / nig, fm = gid * WGM, gsz = (nM - fm) < WGM ? (nM - fm) : WGM;
        u.pm = fm + ((wgid % nig) % gsz); u.pn = (wgid % nig) / gsz; u.e = 0; u.mt = 0; return true;
    }
    __device__ __forceinline__ const char* b_ptr(const Unit& u) const { return Bt + (size_t)u.pn * (size_t)(BM * 2) * K; }
    __device__ __forceinline__ void a_offsets(const Unit& u, const int (&R)[2], const int (&C)[2], unsigned (&v)[2][2]) const {
#pragma unroll
        for (int h = 0; h < 2; ++h)
#pragma unroll
            for (int i = 0; i < 2; ++i) v[h][i] = (unsigned)((row0 + u.pm * BM + h * HALF + R[i]) * K + C[i]) * 2u;
    }
};
template <bool GATHER, int NT>
struct MoeSched {
    const char* Bt; size_t bstride;
    const int* list;
    const LAS int* pre; const LAS int* mtl; const LAS int* rowoff; const LAS int* cnt;
    int K, G, c, total;
    __device__ __forceinline__ bool next(int i, Unit& u) const {
        const int L = i * G + c; if (L >= total) return false;
        int e = 0;
#pragma unroll 1
        for (int j = 1; j < NEXP; ++j) e = (L >= pre[j]) ? j : e;
        const int rem = L - pre[e], m = mtl[e];
        u.e = e; u.pn = rem / m; u.mt = rem % m; u.pm = 0; return true;
    }
    __device__ __forceinline__ const char* b_ptr(const Unit& u) const { return Bt + (size_t)u.e * bstride + (size_t)u.pn * (size_t)(BM * 2) * K; }
    __device__ __forceinline__ void a_offsets(const Unit& u, const int (&R)[2], const int (&C)[2], unsigned (&v)[2][2]) const {
        if (GATHER) {
            const int n = cnt[u.e]; const int* lp = list + (size_t)u.e * NTOK;
#pragma unroll
            for (int h = 0; h < 2; ++h)
#pragma unroll
                for (int i = 0; i < 2; ++i) { const int idx = u.mt * BM + h * HALF + R[i]; const int tok = idx < n ? lp[idx] : 0; v[h][i] = (unsigned)(tok * K + C[i]) * 2u; }
        } else {
            const int r0 = rowoff[u.e] + u.mt * BM;
#pragma unroll
            for (int h = 0; h < 2; ++h)
#pragma unroll
                for (int i = 0; i < 2; ++i) v[h][i] = (unsigned)((r0 + h * HALF + R[i]) * K + C[i]) * 2u;
        }
    }
};

struct EpiBf16 {
    static constexpr bool PERM = true;
    bf16* O; int ldc; int row0;
    __device__ __forceinline__ void operator()(const f32x4 (&acc)[2][2][4][2], const Unit& u, int wr, int wc, int fr, int fq) const {
        const int r0 = row0 + u.pm * BM + wr * 64 + fr, col0 = u.pn * BM + wc * 32 + 8 * fq;
#pragma unroll
        for (int ai = 0; ai < 2; ++ai)
#pragma unroll
            for (int m = 0; m < 4; ++m) { bf16* rowp = O + (size_t)(r0 + ai * HALF + m * 16) * ldc + col0;
#pragma unroll
                for (int bj = 0; bj < 2; ++bj) { const f32x4 v0 = acc[ai][bj][m][0], v1 = acc[ai][bj][m][1];
                    u32x4 w; w.x = cvt_pk_bf16(v0[0], v0[1]); w.y = cvt_pk_bf16(v0[2], v0[3]); w.z = cvt_pk_bf16(v1[0], v1[1]); w.w = cvt_pk_bf16(v1[2], v1[3]);
                    *(u32x4*)(rowp + bj * HALF) = w; } }
    }
};
struct EpiF32 {
    static constexpr bool PERM = false;
    float* Cc; int ldc; int row0;
    __device__ __forceinline__ void operator()(const f32x4 (&acc)[2][2][4][2], const Unit& u, int wr, int wc, int fr, int fq) const {
        const int r0 = row0 + u.pm * BM + wr * 64 + fr, col0 = u.pn * BM + wc * 32 + 4 * fq;
#pragma unroll
        for (int ai = 0; ai < 2; ++ai)
#pragma unroll
            for (int m = 0; m < 4; ++m) { float* rowp = Cc + (size_t)(r0 + ai * HALF + m * 16) * ldc + col0;
#pragma unroll
                for (int bj = 0; bj < 2; ++bj)
#pragma unroll
                    for (int n = 0; n < 2; ++n) *(f32x4*)(rowp + bj * HALF + n * 16) = acc[ai][bj][m][n]; }
    }
};
struct EpiSwiglu {
    static constexpr bool PERM = true;
    bf16* H; const float* bg; const float* bu; const LAS int* rowoff;
    __device__ __forceinline__ void operator()(const f32x4 (&acc)[2][2][4][2], const Unit& u, int wr, int wc, int fr, int fq) const {
        const int r0 = rowoff[u.e] + u.mt * BM + wr * 64 + fr, j0 = u.pn * HALF + wc * 32 + 8 * fq;
        f32x4 gb[2], ub[2];
#pragma unroll
        for (int n = 0; n < 2; ++n) { gb[n] = *(const f32x4*)(bg + u.e * 1024 + j0 + 4 * n); ub[n] = *(const f32x4*)(bu + u.e * 1024 + j0 + 4 * n); }
#pragma unroll
        for (int ai = 0; ai < 2; ++ai)
#pragma unroll
            for (int m = 0; m < 4; ++m) { bf16* rowp = H + (size_t)(r0 + ai * HALF + m * 16) * 1024 + j0; float hv[8];
#pragma unroll
                for (int n = 0; n < 2; ++n)
#pragma unroll
                    for (int j = 0; j < 4; ++j) { float g = acc[ai][0][m][n][j] + gb[n][j], up = acc[ai][1][m][n][j] + ub[n][j];
                        g = fminf(g, 7.f); up = fminf(fmaxf(up, -7.f), 7.f);
                        hv[n * 4 + j] = (up + 1.f) * g * __builtin_amdgcn_rcpf(1.f + __expf(-1.702f * g)); }
                u32x4 w; w.x = cvt_pk_bf16(hv[0], hv[1]); w.y = cvt_pk_bf16(hv[2], hv[3]); w.z = cvt_pk_bf16(hv[4], hv[5]); w.w = cvt_pk_bf16(hv[6], hv[7]);
                *(u32x4*)rowp = w; }
    }
};
struct EpiDown {
    static constexpr bool PERM = true;
    bf16* Y; const float* bd; const LAS int* rowoff;
    __device__ __forceinline__ void operator()(const f32x4 (&acc)[2][2][4][2], const Unit& u, int wr, int wc, int fr, int fq) const {
        const int r0 = rowoff[u.e] + u.mt * BM + wr * 64 + fr, col0 = u.pn * BM + wc * 32 + 8 * fq;
        f32x4 bv[2][2];
#pragma unroll
        for (int bj = 0; bj < 2; ++bj)
#pragma unroll
            for (int n = 0; n < 2; ++n) bv[bj][n] = *(const f32x4*)(bd + u.e * 1024 + col0 + bj * HALF + 4 * n);
#pragma unroll
        for (int ai = 0; ai < 2; ++ai)
#pragma unroll
            for (int m = 0; m < 4; ++m) { bf16* rowp = Y + (size_t)(r0 + ai * HALF + m * 16) * 1024 + col0;
#pragma unroll
                for (int bj = 0; bj < 2; ++bj) { const f32x4 v0 = acc[ai][bj][m][0] + bv[bj][0], v1 = acc[ai][bj][m][1] + bv[bj][1];
                    u32x4 w; w.x = cvt_pk_bf16(v0[0], v0[1]); w.y = cvt_pk_bf16(v0[2], v0[3]); w.z = cvt_pk_bf16(v1[0], v1[1]); w.w = cvt_pk_bf16(v1[2], v1[3]);
                    *(u32x4*)(rowp + bj * HALF) = w; } }
    }
};

template <class Epi, class Sched, bool ALIGN_EPI>
__device__ __forceinline__ void gemm_phase(LAS unsigned char* lds, const char* Abase, const int K, const Sched& S, const Epi& E) {
    const int tid = tidx(), wid = __builtin_amdgcn_readfirstlane(tid >> 6), lane = tid & 63, wr = wid >> 2, wc = wid & 3, fr = lane & 15, fq = lane >> 4;
    const int nt = K / BK;
    int Rp[2], Cp[2]; unsigned voffB[2];
#pragma unroll
    for (int i = 0; i < 2; ++i) { stage_rc(tid * 16 + i * 8192, Rp[i], Cp[i]); const int Rb = Epi::PERM ? ((Rp[i] & ~31) + perm32(Rp[i] & 31)) : Rp[i]; voffB[i] = (unsigned)(Rb * K + Cp[i]) * 2u; }
    const size_t kstep = (size_t)(BK * 2);
    const size_t hstep = (size_t)HALF * K * 2;
    const unsigned ldsw = (unsigned)wid * 1024u;
    const int aoff = lds_byte(wr * 64 + fr, fq * 8), boff = lds_byte(wc * 32 + fr, fq * 8);
#define PG8_SA(b, h) (((b) * 2 + (h)) * HTB)
#define PG8_SB(b, h) ((4 + (b) * 2 + (h)) * HTB)
#define PG8_STAGE(bufoff, gbase, voff) do { _Pragma("unroll") for (int _i = 0; _i < 2; ++_i) \
        __builtin_amdgcn_global_load_lds((const unsigned*)((const char*)(gbase) + (voff)[_i]), (LAS unsigned*)(lds + (bufoff) + ldsw + _i * 8192), 16, 0, 0); } while (0)
#define PG8_LDA(dst, b, h) do { _Pragma("unroll") for (int m = 0; m < 4; ++m) _Pragma("unroll") for (int k = 0; k < 2; ++k) dst[m][k] = *(const LAS bf16x8*)(lds + PG8_SA(b, h) + aoff + m * 2048 + k * 1024); } while (0)
#define PG8_LDB(dst, b, h) do { _Pragma("unroll") for (int n = 0; n < 2; ++n) _Pragma("unroll") for (int k = 0; k < 2; ++k) dst[n][k] = *(const LAS bf16x8*)(lds + PG8_SB(b, h) + boff + n * 2048 + k * 1024); } while (0)
#define PG8_MMA(ai, bj, At, Bt) do { __builtin_amdgcn_s_setprio(1); _Pragma("unroll") for (int m = 0; m < 4; ++m) _Pragma("unroll") for (int n = 0; n < 2; ++n) _Pragma("unroll") for (int k = 0; k < 2; ++k) \
        acc[ai][bj][m][n] = __builtin_amdgcn_mfma_f32_16x16x32_bf16(Bt[n][k], At[m][k], acc[ai][bj][m][n], 0, 0, 0); __builtin_amdgcn_s_setprio(0); } while (0)
#define PG8_WAIT_V(n) asm volatile("s_waitcnt vmcnt(" #n ")" ::: "memory")
#define PG8_WAIT_L(n) asm volatile("s_waitcnt lgkmcnt(" #n ")" ::: "memory")
#define PG8_BAR __builtin_amdgcn_s_barrier()
#define PG8_SCHED __builtin_amdgcn_sched_barrier(0)
    Unit cur, nxt; int ui = 0;
    if (!S.next(0, cur)) return;
    f32x4 acc[2][2][4][2];
#pragma unroll
    for (int a = 0; a < 2; ++a)
#pragma unroll
        for (int b = 0; b < 2; ++b)
#pragma unroll
            for (int m = 0; m < 4; ++m)
#pragma unroll
                for (int n = 0; n < 2; ++n) acc[a][b][m][n] = (f32x4){0.f, 0.f, 0.f, 0.f};
    bf16x8 At[4][2], B0[2][2], B1[2][2];
    unsigned vAc[2][2], vAn[2][2];
    S.a_offsets(cur, Rp, Cp, vAc);
    const char* cB = S.b_ptr(cur);
    PG8_STAGE(PG8_SB(0, 0), cB, voffB); PG8_STAGE(PG8_SB(0, 1), cB + hstep, voffB); PG8_STAGE(PG8_SA(0, 0), Abase, vAc[0]); PG8_STAGE(PG8_SA(0, 1), Abase, vAc[1]);
    if (wr == 1) PG8_BAR;
    PG8_WAIT_V(2); PG8_BAR;
    PG8_STAGE(PG8_SB(1, 0), cB + kstep, voffB); PG8_STAGE(PG8_SA(1, 0), Abase + kstep, vAc[0]); PG8_STAGE(PG8_SB(1, 1), cB + hstep + kstep, voffB);
    PG8_WAIT_V(6); PG8_BAR;
    for (;;) {
        const bool has_next = S.next(ui + 1, nxt);
        const char* nB = has_next ? S.b_ptr(nxt) : cB;
        if (has_next) S.a_offsets(nxt, Rp, Cp, vAn);
        else {
#pragma unroll
            for (int h = 0; h < 2; ++h)
#pragma unroll
                for (int i = 0; i < 2; ++i) vAn[h][i] = vAc[h][i]; }
        for (int t = 0; t < nt; t += 2) {
            const bool last = (t == nt - 2);
            const char* a1 = Abase + (size_t)(t + 1) * kstep;
            const char* a2 = last ? Abase : Abase + (size_t)(t + 2) * kstep; const char* b2 = last ? nB : cB + (size_t)(t + 2) * kstep;
            const char* a3 = a2 + kstep; const char* b3 = b2 + kstep;
            unsigned v2[2][2];
#pragma unroll
            for (int h = 0; h < 2; ++h)
#pragma unroll
                for (int i = 0; i < 2; ++i) v2[h][i] = last ? vAn[h][i] : vAc[h][i];
            PG8_LDB(B0, 0, 0); PG8_LDB(B1, 0, 1); PG8_SCHED; PG8_LDA(At, 0, 0); PG8_STAGE(PG8_SA(1, 1), a1, vAc[1]);
            PG8_WAIT_V(8); PG8_WAIT_L(0); PG8_BAR; PG8_MMA(0, 0, At, B0); PG8_MMA(0, 1, At, B1); PG8_BAR; PG8_SCHED;
            PG8_LDA(At, 0, 1); PG8_STAGE(PG8_SB(0, 0), b2, voffB); PG8_STAGE(PG8_SB(0, 1), b2 + hstep, voffB); PG8_STAGE(PG8_SA(0, 0), a2, v2[0]);
            PG8_WAIT_V(8); PG8_WAIT_L(0); PG8_BAR; PG8_MMA(1, 0, At, B0); PG8_MMA(1, 1, At, B1); PG8_BAR; PG8_SCHED;
            PG8_LDB(B0, 1, 0); PG8_LDB(B1, 1, 1); PG8_SCHED; PG8_LDA(At, 1, 0); PG8_STAGE(PG8_SA(0, 1), a2, v2[1]);
            PG8_WAIT_V(8); PG8_WAIT_L(0); PG8_BAR; PG8_MMA(0, 0, At, B0); PG8_MMA(0, 1, At, B1); PG8_BAR; PG8_SCHED;
            PG8_LDA(At, 1, 1); PG8_STAGE(PG8_SB(1, 0), b3, voffB); PG8_STAGE(PG8_SB(1, 1), b3 + hstep, voffB); PG8_STAGE(PG8_SA(1, 0), a3, v2[0]);
            PG8_WAIT_V(8); PG8_WAIT_L(0); PG8_BAR; PG8_MMA(1, 0, At, B0); PG8_MMA(1, 1, At, B1); PG8_BAR; PG8_SCHED;
        }
        if constexpr (ALIGN_EPI) { if (wr == 0) PG8_BAR; }
        E(acc, cur, wr, wc, fr, fq);
        if (!has_next) break;
#pragma unroll
        for (int a = 0; a < 2; ++a)
#pragma unroll
            for (int b = 0; b < 2; ++b)
#pragma unroll
                for (int m = 0; m < 4; ++m)
#pragma unroll
                    for (int n = 0; n < 2; ++n) acc[a][b][m][n] = (f32x4){0.f, 0.f, 0.f, 0.f};
        cur = nxt; cB = nB; ++ui;
#pragma unroll
        for (int h = 0; h < 2; ++h)
#pragma unroll
            for (int i = 0; i < 2; ++i) vAc[h][i] = vAn[h][i];
        if constexpr (ALIGN_EPI) { if (wr == 1) PG8_BAR; }
    }
    PG8_WAIT_V(0);
    if constexpr (!ALIGN_EPI) { if (wr == 0) PG8_BAR; }
    PG8_BAR;
#undef PG8_SA
#undef PG8_SB
#undef PG8_STAGE
#undef PG8_LDA
#undef PG8_LDB
#undef PG8_MMA
#undef PG8_WAIT_V
#undef PG8_WAIT_L
#undef PG8_BAR
#undef PG8_SCHED
}
}

struct Args { const float* in[39]; float* out; unsigned char* ws; int ph_lo, ph_hi; };
typedef const __attribute__((address_space(4))) Args CArgs;
enum { I_X = 0, I_C, I_CTX, I_CCTX, I_WADA, I_BADA, I_WIN, I_HYCW, I_HYCB, I_HYW1, I_HYB1, I_HYW2, I_HYB2, I_HYW3, I_HYB3, I_HYW4, I_HYFREQ, I_HYD, I_SCCW,
       I_GLAWA, I_GLABA, I_GLANW, I_GDNCW, I_GDNALOG, I_GDNDT, I_GDNNW, I_WOUT, I_LN1G, I_LN1B, I_WR, I_BR, I_WG, I_BG, I_WU, I_BU, I_WD, I_BD, I_LN2G, I_LN2B };

__device__ __forceinline__ int row_batch(int row) { return row < NTOK_C ? (row >> 8) : ((row - NTOK_C) >> 11); }
__device__ __forceinline__ int mod_vec(int row) { return row < NTOK_C ? 16 : ((row - NTOK_C) >> 11); }

__device__ __forceinline__ void ph_mod(CArgs& a, LAS unsigned char* lds, int bid, int nblk) {
    LAS float* sc = (LAS float*)lds; LAS float* red = (LAS float*)(lds + 17 * 1024 * 4);
    const int tid = tidx(), lane = tid & 63, w = tid >> 6;
    const float* c = a.in[I_C]; const float* cc = a.in[I_CCTX];
    for (int i = tid; i < 17 * 1024; i += 512) { const float v = i < 16 * 1024 ? c[i] : cc[i - 16 * 1024]; sc[i] = siluf_(v); }
    __syncthreads();
    float* MOD = (float*)(a.ws + WS_MOD);
    for (int it = bid; it < DEPTH * 96; it += nblk) {
        const int l = it / 96, j0 = (it % 96) * 64;
        const float* W = a.in[I_WADA] + (size_t)l * 1024 * 6144 + j0 + lane;
        float acc[17];
#pragma unroll
        for (int v = 0; v < 17; ++v) acc[v] = 0.f;
#pragma unroll 16
        for (int kk = 0; kk < 128; ++kk) { const int k = w * 128 + kk; const float wv = W[(size_t)k * 6144];
#pragma unroll
            for (int v = 0; v < 17; ++v) acc[v] += sc[v * 1024 + k] * wv; }
#pragma unroll
        for (int v = 0; v < 17; ++v) red[(w * 17 + v) * 64 + lane] = acc[v];
        __syncthreads();
        for (int o = tid; o < 17 * 64; o += 512) { const int v = o >> 6, jj = o & 63; float s = 0.f;
#pragma unroll
            for (int ww = 0; ww < 8; ++ww) s += red[(ww * 17 + v) * 64 + jj];
            MOD[(size_t)(l * 17 + v) * 6144 + j0 + jj] = s + a.in[I_BADA][l * 6144 + j0 + jj]; }
        __syncthreads();
    }
}

__device__ __forceinline__ void ph_filters(CArgs& a, int gw, int ngw) {
    const int lane = tidx() & 63;
    float* KUN = (float*)(a.ws + WS_KUN);
#pragma unroll 1
    for (int it = gw; it < DEPTH * (CTXL + SEQ) / 4; it += ngw) {
        const int l = it / ((CTXL + SEQ) / 4), r = (it % ((CTXL + SEQ) / 4)) * 4, Lt = r < CTXL ? 0 : 1, pos0 = Lt ? r - CTXL : r, L = Lt ? SEQ : CTXL;
        float z[4], tn[4];
#pragma unroll
        for (int p = 0; p < 4; ++p) { const int pos = pos0 + p; tn[p] = (float)pos / (float)(L - 1); z[p] = 0.f;
            if (lane == 0) z[p] = tn[p];
            else if (lane <= 32) { const int j = (lane - 1) & 15; const float fj = 1e-4f + (float)j * ((15.f - 1e-4f) / 15.f);
                double rev = (double)fj * (double)pos / (double)L; rev -= floor(rev); const float rf = (float)rev;
                z[p] = lane <= 16 ? sin_rev(rf + 0.25f) : -sin_rev(rf); } }
        const float* w1 = a.in[I_HYW1] + l * 33 * 64; const float* w2 = a.in[I_HYW2] + l * 64 * 64; const float* w3 = a.in[I_HYW3] + l * 64 * 64; const float* w4 = a.in[I_HYW4] + l * 64 * 512;
        const float* fq = a.in[I_HYFREQ] + l * 3 * 64;
        float s[4], h[4];
        { const float bb = a.in[I_HYB1][l * 64 + lane];
#pragma unroll
          for (int p = 0; p < 4; ++p) s[p] = bb; }
#pragma unroll
        for (int i = 0; i < 33; ++i) { const float ww = w1[i * 64 + lane];
#pragma unroll
            for (int p = 0; p < 4; ++p) s[p] += rdlane_f(z[p], i) * ww; }
#pragma unroll
        for (int p = 0; p < 4; ++p) h[p] = sin_rad(fq[lane] * s[p]);
        { const float bb = a.in[I_HYB2][l * 64 + lane];
#pragma unroll
          for (int p = 0; p < 4; ++p) s[p] = bb; }
#pragma unroll 16
        for (int i = 0; i < 64; ++i) { const float ww = w2[i * 64 + lane];
#pragma unroll
            for (int p = 0; p < 4; ++p) s[p] += rdlane_f(h[p], i) * ww; }
#pragma unroll
        for (int p = 0; p < 4; ++p) h[p] = sin_rad(fq[64 + lane] * s[p]);
        { const float bb = a.in[I_HYB3][l * 64 + lane];
#pragma unroll
          for (int p = 0; p < 4; ++p) s[p] = bb; }
#pragma unroll 16
        for (int i = 0; i < 64; ++i) { const float ww = w3[i * 64 + lane];
#pragma unroll
            for (int p = 0; p < 4; ++p) s[p] += rdlane_f(h[p], i) * ww; }
#pragma unroll
        for (int p = 0; p < 4; ++p) h[p] = sin_rad(fq[128 + lane] * s[p]);
        float k[8][4];
#pragma unroll
        for (int m = 0; m < 8; ++m)
#pragma unroll
            for (int p = 0; p < 4; ++p) k[m][p] = 0.f;
#pragma unroll 4
        for (int i = 0; i < 64; ++i) { float hi[4];
#pragma unroll
            for (int p = 0; p < 4; ++p) hi[p] = rdlane_f(h[p], i);
#pragma unroll
            for (int m = 0; m < 8; ++m) { const float ww = w4[i * 512 + m * 64 + lane];
#pragma unroll
                for (int p = 0; p < 4; ++p) k[m][p] += hi[p] * ww; } }
#pragma unroll
        for (int m = 0; m < 8; ++m) { const int o = m * 64 + lane, ch = o & 255;
            const float delta = 3.0701134573253944f + (float)ch * ((15.350567286626972f - 3.0701134573253944f) / 255.f);
            *(f32x4*)(KUN + ((size_t)((l * 2 + Lt) * 512 + o)) * 2048 + pos0) = (f32x4){k[m][0] * __expf(-tn[0] * delta), k[m][1] * __expf(-tn[1] * delta), k[m][2] * __expf(-tn[2] * delta), k[m][3] * __expf(-tn[3] * delta)}; }
    }
}

__device__ __forceinline__ void ph_router_w(CArgs& a, int gt, int ngt) {
    bf16* hi = (bf16*)(a.ws + WS_WRT); bf16* lo = hi + DEPTH * NEXP * D;
    for (int i = gt; i < DEPTH * NEXP * D; i += ngt) { const int l = i / (NEXP * D), r = i % (NEXP * D), e = r / D, k = r % D;
        const float w = a.in[I_WR][((size_t)l * D + k) * NEXP + e]; const unsigned h = f2bf(w); hi[i] = (bf16)h; lo[i] = (bf16)f2bf(w - bf2f(h)); }
}
__device__ __forceinline__ void tr_item(const float* W, int Nsrc, int K, bf16* WTrow0, int n0, int k0, LAS float* scr, int lane) {
    const int c4 = (lane & 7) * 4; const bool ok = n0 + c4 < Nsrc;
    f32x4 t[8];
#pragma unroll
    for (int j = 0; j < 8; ++j) { const int kk = 8 * j + (lane >> 3); t[j] = ok ? *(const f32x4*)(W + (size_t)(k0 + kk) * Nsrc + n0 + c4) : (f32x4){0.f, 0.f, 0.f, 0.f}; }
#pragma unroll
    for (int j = 0; j < 8; ++j) { const int kk = 8 * j + (lane >> 3); LAS float* d = scr + kk * 33 + c4; d[0] = t[j][0]; d[1] = t[j][1]; d[2] = t[j][2]; d[3] = t[j][3]; }
    asm volatile("s_waitcnt lgkmcnt(0)" ::: "memory");
    const int c = lane & 7;
#pragma unroll
    for (int j = 0; j < 4; ++j) { const int n = (lane >> 3) + 8 * j; const LAS float* s = scr + (8 * c) * 33 + n;
        u32x4 o; o.x = pk2(s[0 * 33], s[1 * 33]); o.y = pk2(s[2 * 33], s[3 * 33]); o.z = pk2(s[4 * 33], s[5 * 33]); o.w = pk2(s[6 * 33], s[7 * 33]);
        *(u32x4*)(WTrow0 + (size_t)n * K + k0 + 8 * c) = o; }
    asm volatile("s_waitcnt lgkmcnt(0)" ::: "memory");
}
__device__ __forceinline__ void ph_tr_small(CArgs& a, LAS unsigned char* lds, int gw, int ngw) {
    const int lane = tidx() & 63, w = tidx() >> 6;
    LAS float* scr = (LAS float*)(lds + w * 8448);
    constexpr int I_IN = 16 * (D_INP / 32), I_OUT = 16 * 32;
    for (int it = gw; it < DEPTH * (I_IN + I_OUT); it += ngw) {
        const int l = it / (I_IN + I_OUT); int r = it % (I_IN + I_OUT);
        if (r < I_IN) { const int kb = r / (D_INP / 32), nb = r % (D_INP / 32);
            tr_item(a.in[I_WIN] + (size_t)l * 1024 * D_IN, D_IN, 1024, (bf16*)(a.ws + WS_WIN) + ((size_t)l * D_INP + nb * 32) * 1024, nb * 32, kb * 64, scr, lane); }
        else { r -= I_IN; const int kb = r / 32, nb = r % 32;
            tr_item(a.in[I_WOUT] + (size_t)l * 1024 * 1024, 1024, 1024, (bf16*)(a.ws + WS_WOUT) + ((size_t)l * 1024 + nb * 32) * 1024, nb * 32, kb * 64, scr, lane); }
    }
}
__device__ __forceinline__ void tr_experts_waves(CArgs& a, int l, LAS unsigned char* scrb, int gw, int ngw, int lane) {
    LAS float* scr = (LAS float*)scrb;
#pragma unroll 1
    for (int it = gw; it < NEXP * 3 * 512; it += ngw) {
        const int e = it / 1536, r = it % 1536, which = r / 512, q = r % 512, kb = q / 32, nb = q % 32, n0 = nb * 32;
        const float* W = a.in[which == 0 ? I_WG : (which == 1 ? I_WU : I_WD)] + ((size_t)(l * NEXP + e)) * 1024 * 1024;
        bf16* dst;
        if (which == 2) dst = (bf16*)(a.ws + WS_WD) + ((size_t)e * 1024 + n0) * 1024;
        else dst = (bf16*)(a.ws + WS_WGU) + ((size_t)e * 2048 + (n0 >> 7) * 256 + which * 128 + (n0 & 127)) * 1024;
        tr_item(W, 1024, 1024, dst, n0, kb * 64, scr, lane);
    }
}
__device__ __forceinline__ void ph_mod_input(CArgs& a, int gw, int ngw) {
    const int lane = tidx() & 63;
    const float* MOD = (const float*)(a.ws + WS_MOD);
    bf16* HB = (bf16*)(a.ws + WS_HB);
    for (int row = gw; row < NTOK; row += ngw) {
        const float* src = row < NTOK_C ? a.in[I_CTX] + (size_t)row * D : a.in[I_X] + (size_t)(row - NTOK_C) * D;
        const float* mv = MOD + (size_t)mod_vec(row) * 6144;
#pragma unroll
        for (int j = 0; j < 4; ++j) { const int c0 = j * 256 + lane * 4; const f32x4 x = *(const f32x4*)(src + c0), sh = *(const f32x4*)(mv + c0), sc = *(const f32x4*)(mv + 1024 + c0);
            u32x2 o; o.x = pk2(x[0] * (1.f + sc[0]) + sh[0], x[1] * (1.f + sc[1]) + sh[1]); o.y = pk2(x[2] * (1.f + sc[2]) + sh[2], x[3] * (1.f + sc[3]) + sh[3]);
            *(u32x2*)(HB + (size_t)row * D + c0) = o; }
    }
}

struct Chunk { int b, t0, L, row0, lo, hi; };
__device__ __forceinline__ Chunk chunk_of(int it) {
    Chunk c;
    if (it < 64) { c.b = it >> 2; c.t0 = (it & 3) * 64; c.L = CTXL; c.row0 = c.b * CTXL + c.t0; c.lo = 0; c.hi = CTXL; }
    else { const int r = it - 64; c.b = r >> 5; c.t0 = (r & 31) * 64; c.L = SEQ; c.row0 = NTOK_C + c.b * SEQ + c.t0; c.lo = c.t0; c.hi = c.t0 + 64; }
    return c;
}
__device__ __forceinline__ f32x4 bf4(u32x2 v) { return (f32x4){lo_bf(v.x), hi_bf(v.x), lo_bf(v.y), hi_bf(v.y)}; }
__device__ __forceinline__ void ph_prep_conv(CArgs& a, int l, LAS unsigned char* lds, int bid, int nblk) {
    const bf16* P = (const bf16*)(a.ws + WS_P);
    bf16* ZT = (bf16*)(a.ws + WS_MIX + MX_ZT); bf16* YMIX = (bf16*)(a.ws + WS_YMIX);
    LAS bf16* zt = (LAS bf16*)lds;
    const int tid = tidx(), c4 = (tid & 63) * 4, tg = tid >> 6;
    const float* hw = a.in[I_HYCW] + l * 3 * 768; const float* hb = a.in[I_HYCB] + l * 768; const float* sw = a.in[I_SCCW] + l * 3 * 256;
    f32x4 wx[3], wv[3], ws3[3];
#pragma unroll
    for (int k = 0; k < 3; ++k) { wx[k] = *(const f32x4*)(hw + k * 768 + 256 + c4); wv[k] = *(const f32x4*)(hw + k * 768 + 512 + c4); ws3[k] = *(const f32x4*)(sw + k * 256 + c4); }
    const f32x4 bx = *(const f32x4*)(hb + 256 + c4), bv = *(const f32x4*)(hb + 512 + c4);
#pragma unroll 1
    for (int it = bid; it < 576; it += nblk) {
        const Chunk c = chunk_of(it);
        const int tb = c.t0 + tg * 8;
        const bf16* pb = P + (size_t)(c.row0 + tg * 8) * D_INP;
        f32x4 x1[10], vv[10], mm[10];
#pragma unroll
        for (int r = 0; r < 10; ++r) { const int t = tb + r - 1; const bool ok = t >= c.lo && t < c.hi; const bf16* p = pb + (ptrdiff_t)(r - 1) * D_INP;
            x1[r] = ok ? bf4(*(const u32x2*)(p + HY0 + 256 + c4)) : (f32x4){0.f, 0.f, 0.f, 0.f}; vv[r] = ok ? bf4(*(const u32x2*)(p + HY0 + 512 + c4)) : (f32x4){0.f, 0.f, 0.f, 0.f};
            mm[r] = ok ? bf4(*(const u32x2*)(p + SC0 + 256 + c4)) * bf4(*(const u32x2*)(p + SC0 + 512 + c4)) : (f32x4){0.f, 0.f, 0.f, 0.f}; }
#pragma unroll
        for (int tt = 0; tt < 8; ++tt) {
            const f32x4 xx = wx[0] * x1[tt] + wx[1] * x1[tt + 1] + wx[2] * x1[tt + 2] + bx, v2 = wv[0] * vv[tt] + wv[1] * vv[tt + 1] + wv[2] * vv[tt + 2] + bv, z = xx * v2;
            u32x2 zo; zo.x = pk2(z[0], z[1]); zo.y = pk2(z[2], z[3]); *(LAS u32x2*)(zt + (tg * 8 + tt) * 264 + c4) = zo;
            const f32x4 bg = bf4(*(const u32x2*)(pb + (size_t)tt * D_INP + SC0 + c4));
            const f32x4 y = bg * (ws3[0] * mm[tt] + ws3[1] * mm[tt + 1] + ws3[2] * mm[tt + 2]);
            u32x2 yo; yo.x = pk2(y[0], y[1]); yo.y = pk2(y[2], y[3]); *(u32x2*)(YMIX + (size_t)(c.row0 + tg * 8 + tt) * D + 256 + c4) = yo;
        }
        __syncthreads();
        { const int ch = tid & 255, g0 = (tid >> 8) * 4;
          const int soff = c.L == CTXL ? 0 : CTXL;
#pragma unroll
          for (int g = 0; g < 4; ++g) { const int t8 = (g0 + g) * 8; unsigned short e[8];
#pragma unroll
              for (int j = 0; j < 8; ++j) e[j] = zt[(t8 + j) * 264 + ch];
              u32x4 o; o.x = e[0] | ((unsigned)e[1] << 16); o.y = e[2] | ((unsigned)e[3] << 16); o.z = e[4] | ((unsigned)e[5] << 16); o.w = e[6] | ((unsigned)e[7] << 16);
              *(u32x4*)(ZT + ((size_t)(ch * 16 + c.b)) * 2304 + soff + c.t0 + t8) = o; } }
        __syncthreads();
    }
}
__device__ __forceinline__ void ph_prep_tok(CArgs& a, int l, int gw, int ngw) {
    const int lane = tidx() & 63;
    const bf16* P = (const bf16*)(a.ws + WS_P);
    float* GDF = (float*)(a.ws + WS_MIX + MX_GDF); float* GDB = (float*)(a.ws + WS_MIX + MX_GDB);
    float* DQ = (float*)(a.ws + WS_MIX + MX_DQ); float* DK = (float*)(a.ws + WS_MIX + MX_DK); float* DV = (float*)(a.ws + WS_MIX + MX_DV); float* DG = (float*)(a.ws + WS_MIX + MX_DG);
    const float* wa = a.in[I_GLAWA] + l * 2 * 16 * 128; const float* ba = a.in[I_GLABA] + l * 2 * 128;
    const float* cw = a.in[I_GDNCW] + l * 3 * 768;
#pragma unroll 1
    for (int row = gw; row < NTOK; row += ngw) {
        const bf16* pr = P + (size_t)row * D_INP;
        { int z = 0; asm volatile("" : "+v"(z)); wa += z; cw += z; }
        const float av = lane < 32 ? bf2f(pr[GLA0 + 768 + lane]) : 0.f;
        float s0 = ba[lane], s1 = ba[64 + lane], s2 = ba[128 + lane], s3 = ba[192 + lane];
#pragma unroll
        for (int i = 0; i < 16; ++i) { const float af = rdlane_f(av, i), ab = rdlane_f(av, 16 + i);
            s0 += af * wa[i * 128 + lane]; s1 += af * wa[i * 128 + 64 + lane]; s2 += ab * wa[2048 + i * 128 + lane]; s3 += ab * wa[2048 + i * 128 + 64 + lane]; }
        GDF[(size_t)row * 128 + lane] = __expf(logsigmoidf_(s0) * 0.0625f); GDF[(size_t)row * 128 + 64 + lane] = __expf(logsigmoidf_(s1) * 0.0625f);
        GDB[(size_t)row * 128 + lane] = __expf(logsigmoidf_(s2) * 0.0625f); GDB[(size_t)row * 128 + 64 + lane] = __expf(logsigmoidf_(s3) * 0.0625f);
        int tpos, lo, hi;
        if (row < NTOK_C) { tpos = row & 255; lo = 0; hi = CTXL; } else { tpos = (row - NTOK_C) & 2047; lo = tpos & ~63; hi = lo + 64; }
        const bool hp = tpos - 1 >= lo, hn = tpos + 1 < hi;
        float qkv[3][4];
#pragma unroll
        for (int g = 0; g < 3; ++g) { const int col = g * 256 + 4 * lane; const bf16* p = pr + GDN0 + col;
            const u32x2 cu = *(const u32x2*)p; u32x2 pv = {0u, 0u}, nv = {0u, 0u};
            if (hp) pv = *(const u32x2*)(p - D_INP); if (hn) nv = *(const u32x2*)(p + D_INP);
            const f32x4 w0 = *(const f32x4*)(cw + col), w1 = *(const f32x4*)(cw + 768 + col), w2 = *(const f32x4*)(cw + 1536 + col);
            qkv[g][0] = siluf_(w0[0] * lo_bf(pv.x) + w1[0] * lo_bf(cu.x) + w2[0] * lo_bf(nv.x));
            qkv[g][1] = siluf_(w0[1] * hi_bf(pv.x) + w1[1] * hi_bf(cu.x) + w2[1] * hi_bf(nv.x));
            qkv[g][2] = siluf_(w0[2] * lo_bf(pv.y) + w1[2] * lo_bf(cu.y) + w2[2] * lo_bf(nv.y));
            qkv[g][3] = siluf_(w0[3] * hi_bf(pv.y) + w1[3] * hi_bf(cu.y) + w2[3] * hi_bf(nv.y)); }
        float sq = qkv[0][0] * qkv[0][0] + qkv[0][1] * qkv[0][1] + qkv[0][2] * qkv[0][2] + qkv[0][3] * qkv[0][3];
        float sk = qkv[1][0] * qkv[1][0] + qkv[1][1] * qkv[1][1] + qkv[1][2] * qkv[1][2] + qkv[1][3] * qkv[1][3];
        sq = row16_sum(sq); sk = row16_sum(sk);
        const float rq = rsqrtf(sq + 1e-6f) * 0.125f, rk = rsqrtf(sk + 1e-6f);
        *(f32x4*)(DQ + (size_t)row * 256 + 4 * lane) = (f32x4){qkv[0][0] * rq, qkv[0][1] * rq, qkv[0][2] * rq, qkv[0][3] * rq};
        *(f32x4*)(DK + (size_t)row * 256 + 4 * lane) = (f32x4){qkv[1][0] * rk, qkv[1][1] * rk, qkv[1][2] * rk, qkv[1][3] * rk};
        *(f32x4*)(DV + (size_t)row * 256 + 4 * lane) = (f32x4){qkv[2][0], qkv[2][1], qkv[2][2], qkv[2][3]};
        if (lane < 4) { const int h = lane;
            const float af = bf2f(pr[GDN0 + 1024 + h]), ab = bf2f(pr[GDN0 + 1028 + h]), bfv = bf2f(pr[GDN0 + 1032 + h]), bbv = bf2f(pr[GDN0 + 1036 + h]);
            const float* al = a.in[I_GDNALOG] + l * 8; const float* dt = a.in[I_GDNDT] + l * 8;
            const float gf = -__expf(al[h]) * softplusf_(af + dt[h]), gb = -__expf(al[4 + h]) * softplusf_(ab + dt[4 + h]);
            *(f32x4*)(DG + (size_t)row * 16 + 4 * h) = (f32x4){sigmoidf_(bfv), __expf(gf), sigmoidf_(bbv), __expf(gb)}; }
    }
}

__device__ __forceinline__ int scan_row(int b, int dir, int n) {
    if (n < CTXL) return b * CTXL + (dir ? CTXL - 1 - n : n);
    const int m = n - CTXL; return NTOK_C + b * SEQ + (dir ? SEQ - 1 - m : m);
}
__device__ __forceinline__ void gla_chain(CArgs& a, int chain, LAS unsigned char* lds) {
    const int b = chain >> 3, h = (chain >> 1) & 3, dir = chain & 1;
    const int tid = tidx(), lane = tid & 63, w = tid >> 6, vv = lane & 7, kq = lane >> 3;
    const bf16* P = (const bf16*)(a.ws + WS_P);
    const float* GD = (const float*)(a.ws + WS_MIX + (dir ? MX_GDB : MX_GDF));
    float* GO = (float*)(a.ws + WS_MIX + (dir ? MX_GOB : MX_GOF));
    LAS float* sq = (LAS float*)lds;
    LAS float* sk = sq + 64 * 32;
    LAS float* sd = sk + 64 * 32;
    LAS float* sv = sd + 64 * 32;
    float S[4] = {0.f, 0.f, 0.f, 0.f};
    for (int ch = 0; ch < 36; ++ch) {
        { const int tt = tid >> 3, sub = tid & 7, row = scan_row(b, dir, ch * 64 + tt);
          const bf16* pr = P + (size_t)row * D_INP + GLA0;
          const u32x2 qv = *(const u32x2*)(pr + h * 32 + sub * 4), kv = *(const u32x2*)(pr + 128 + h * 32 + sub * 4);
          const f32x4 dv = *(const f32x4*)(GD + (size_t)row * 128 + h * 32 + sub * 4);
          const u32x4 vv8 = *(const u32x4*)(pr + 256 + h * 64 + sub * 8);
          const float qs = 0.17677669529663687f;
          *(LAS f32x4*)(sq + tt * 32 + sub * 4) = (f32x4){lo_bf(qv.x) * qs, hi_bf(qv.x) * qs, lo_bf(qv.y) * qs, hi_bf(qv.y) * qs};
          *(LAS f32x4*)(sk + tt * 32 + sub * 4) = (f32x4){lo_bf(kv.x), hi_bf(kv.x), lo_bf(kv.y), hi_bf(kv.y)};
          *(LAS f32x4*)(sd + tt * 32 + sub * 4) = dv;
          *(LAS f32x4*)(sv + tt * 64 + sub * 8) = (f32x4){lo_bf(vv8.x), hi_bf(vv8.x), lo_bf(vv8.y), hi_bf(vv8.y)};
          *(LAS f32x4*)(sv + tt * 64 + sub * 8 + 4) = (f32x4){lo_bf(vv8.z), hi_bf(vv8.z), lo_bf(vv8.w), hi_bf(vv8.w)}; }
        __syncthreads();
#pragma unroll 4
        for (int tt = 0; tt < 64; ++tt) {
            const f32x4 q4 = *(const LAS f32x4*)(sq + tt * 32 + kq * 4), k4 = *(const LAS f32x4*)(sk + tt * 32 + kq * 4), d4 = *(const LAS f32x4*)(sd + tt * 32 + kq * 4);
            const float v = sv[tt * 64 + w * 8 + vv];
            float o = 0.f;
#pragma unroll
            for (int j = 0; j < 4; ++j) { S[j] = d4[j] * S[j] + k4[j] * v; o += q4[j] * S[j]; }
            o += __shfl_xor(o, 8); o += __shfl_xor(o, 16); o += __shfl_xor(o, 32);
            if (kq == 0) GO[(size_t)scan_row(b, dir, ch * 64 + tt) * 256 + h * 64 + w * 8 + vv] = o;
        }
        __syncthreads();
    }
}
__device__ __forceinline__ void gdn_chain(CArgs& a, int chain, LAS unsigned char* lds) {
    const int b = chain >> 3, h = (chain >> 1) & 3, dir = chain & 1;
    const int tid = tidx(), lane = tid & 63, w = tid >> 6, vv = lane & 7, kq = lane >> 3;
    const float* DQ = (const float*)(a.ws + WS_MIX + MX_DQ); const float* DK = (const float*)(a.ws + WS_MIX + MX_DK); const float* DV = (const float*)(a.ws + WS_MIX + MX_DV);
    const float* DG = (const float*)(a.ws + WS_MIX + MX_DG);
    float* DO = (float*)(a.ws + WS_MIX + (dir ? MX_DOB : MX_DOF));
    LAS float* sq = (LAS float*)lds;
    LAS float* sk = sq + 64 * 64;
    LAS float* sv = sk + 64 * 64;
    LAS float* sg = sv + 64 * 64;
    float S[8];
#pragma unroll
    for (int j = 0; j < 8; ++j) S[j] = 0.f;
    for (int ch = 0; ch < 36; ++ch) {
        { const int tt = tid >> 3, sub = tid & 7, row = scan_row(b, dir, ch * 64 + tt);
          const size_t o = (size_t)row * 256 + h * 64 + sub * 8;
          *(LAS f32x4*)(sq + tt * 64 + sub * 8) = *(const f32x4*)(DQ + o); *(LAS f32x4*)(sq + tt * 64 + sub * 8 + 4) = *(const f32x4*)(DQ + o + 4);
          *(LAS f32x4*)(sk + tt * 64 + sub * 8) = *(const f32x4*)(DK + o); *(LAS f32x4*)(sk + tt * 64 + sub * 8 + 4) = *(const f32x4*)(DK + o + 4);
          *(LAS f32x4*)(sv + tt * 64 + sub * 8) = *(const f32x4*)(DV + o); *(LAS f32x4*)(sv + tt * 64 + sub * 8 + 4) = *(const f32x4*)(DV + o + 4);
          if (sub == 0) { const f32x4 g4 = *(const f32x4*)(DG + (size_t)row * 16 + h * 4); *(LAS f32x2*)(sg + tt * 2) = dir ? (f32x2){g4[2], g4[3]} : (f32x2){g4[0], g4[1]}; } }
        __syncthreads();
#pragma unroll 2
        for (int tt = 0; tt < 64; ++tt) {
            const f32x4 ka = *(const LAS f32x4*)(sk + tt * 64 + kq * 8), kb = *(const LAS f32x4*)(sk + tt * 64 + kq * 8 + 4);
            const f32x4 qa = *(const LAS f32x4*)(sq + tt * 64 + kq * 8), qb = *(const LAS f32x4*)(sq + tt * 64 + kq * 8 + 4);
            const float v = sv[tt * 64 + w * 8 + vv]; const f32x2 g2 = *(const LAS f32x2*)(sg + tt * 2);
            const float beta = g2.x, eg = g2.y;
            float ks = (ka[0] * S[0] + ka[1] * S[1]) + (ka[2] * S[2] + ka[3] * S[3]) + ((kb[0] * S[4] + kb[1] * S[5]) + (kb[2] * S[6] + kb[3] * S[7]));
            ks += __shfl_xor(ks, 8); ks += __shfl_xor(ks, 16); ks += __shfl_xor(ks, 32);
            const float wv = beta * (v - eg * ks);
            float o = 0.f;
#pragma unroll
            for (int j = 0; j < 4; ++j) { S[j] = eg * S[j] + ka[j] * wv; o += qa[j] * S[j]; }
#pragma unroll
            for (int j = 0; j < 4; ++j) { S[4 + j] = eg * S[4 + j] + kb[j] * wv; o += qb[j] * S[4 + j]; }
            o += __shfl_xor(o, 8); o += __shfl_xor(o, 16); o += __shfl_xor(o, 32);
            if (kq == 0) DO[(size_t)scan_row(b, dir, ch * 64 + tt) * 256 + h * 64 + w * 8 + vv] = o;
        }
        __syncthreads();
    }
}
__device__ __forceinline__ float gdn_cprod(float eg, int lane) {
    float c = fmaxf(eg, 2.0611536e-9f);
    float t = dpp_f<0x90>(c); c *= (lane & 3) >= 1 ? t : 1.f;
    t = dpp_f<0x44>(c); c *= (lane & 3) >= 2 ? t : 1.f;
    return c;
}
__device__ __forceinline__ void gdn_wave(CArgs& a, int chain, int vbase, LAS unsigned char* wl, int lane) {
    const int b = chain >> 3, h = (chain >> 1) & 3, dir = chain & 1, vl = lane >> 2, kq = lane & 3;
    const float* DQ = (const float*)(a.ws + WS_MIX + MX_DQ); const float* DK = (const float*)(a.ws + WS_MIX + MX_DK); const float* DV = (const float*)(a.ws + WS_MIX + MX_DV);
    const float* DG = (const float*)(a.ws + WS_MIX + MX_DG);
    float* DO = (float*)(a.ws + WS_MIX + (dir ? MX_DOB : MX_DOF));
    f32x2 S2[8];
#pragma unroll
    for (int i = 0; i < 8; ++i) S2[i] = (f32x2){0.f, 0.f};
    f32x4 pk[4], pq[4], pv; f32x2 pg;
    const int step = dir ? -1 : 1;
#define GDN_FETCH(ci) do { const int r0_ = scan_row(b, dir, (ci) * 16); \
        _Pragma("unroll") for (int j = 0; j < 4; ++j) { const size_t o_ = (size_t)(r0_ + step * (4 * j + (lane >> 4))) * 256 + h * 64 + (lane & 15) * 4; pk[j] = *(const f32x4*)(DK + o_); pq[j] = *(const f32x4*)(DQ + o_); } \
        pv = *(const f32x4*)(DV + (size_t)(r0_ + step * (lane >> 2)) * 256 + h * 64 + vbase + (lane & 3) * 4); \
        pg = *(const f32x2*)(DG + (size_t)(r0_ + step * (lane & 15)) * 16 + h * 4 + dir * 2); } while (0)
#define GDN_PUT(bufp) do { _Pragma("unroll") for (int j = 0; j < 4; ++j) { *(LAS f32x4*)((bufp) + j * 1024 + lane * 16) = pk[j]; *(LAS f32x4*)((bufp) + 4096 + j * 1024 + lane * 16) = pq[j]; } \
        *(LAS f32x4*)((bufp) + 8192 + lane * 16) = pv; } while (0)
#define GDN_LD(K, Q, V, p, pvv) do { _Pragma("unroll") for (int m = 0; m < 4; ++m) { K[m] = *(const LAS f32x4*)((p) + 16 * m); Q[m] = *(const LAS f32x4*)((p) + 4096 + 16 * m); } V = *(const LAS float*)(pvv); } while (0)
#define GDN_TOK(K, Q, V, tt, tu) do { \
        const float tA = rdlane_f(cA, (tt)), tB = rdlane_f(cB, (tt)), tC = rdlane_f(cC, (tt)); \
        f32x2 ka = (f32x2){K[0][0], K[0][1]} * S2[0], kb = (f32x2){K[0][2], K[0][3]} * S2[1]; \
        _Pragma("unroll") for (int i = 1; i < 4; ++i) { ka = __builtin_elementwise_fma((f32x2){K[i][0], K[i][1]}, S2[2 * i], ka); kb = __builtin_elementwise_fma((f32x2){K[i][2], K[i][3]}, S2[2 * i + 1], kb); } \
        ka = ka + kb; \
        const float ks = quad_sum(ka.x + ka.y); \
        const float wh = tA * V - tB * ks; const f32x2 wh2 = (f32x2){wh, wh}; \
        _Pragma("unroll") for (int i = 0; i < 4; ++i) { S2[2 * i] = __builtin_elementwise_fma((f32x2){K[i][0], K[i][1]}, wh2, S2[2 * i]); S2[2 * i + 1] = __builtin_elementwise_fma((f32x2){K[i][2], K[i][3]}, wh2, S2[2 * i + 1]); } \
        f32x2 oa = (f32x2){Q[0][0], Q[0][1]} * S2[0], ob = (f32x2){Q[0][2], Q[0][3]} * S2[1]; \
        _Pragma("unroll") for (int i = 1; i < 4; ++i) { oa = __builtin_elementwise_fma((f32x2){Q[i][0], Q[i][1]}, S2[2 * i], oa); ob = __builtin_elementwise_fma((f32x2){Q[i][2], Q[i][3]}, S2[2 * i + 1], ob); } \
        oa = oa + ob; \
        const float o = tC * quad_sum(oa.x + oa.y); \
        okeep = ((tu) == kq) ? o : okeep; } while (0)
    GDN_FETCH(0);
    float gA, gB, gC;
    { const float c = gdn_cprod(pg.y, lane); gA = pg.x / c; gB = pg.x; gC = c; }
    GDN_PUT(wl);
    f32x4 KA[4], QA[4], KB[4], QB[4]; float VA, VB;
    GDN_LD(KA, QA, VA, wl + kq * 64, wl + 8192 + vl * 4);
    float cA = gA, cB = gB, cC = gC;
#pragma unroll 1
    for (int ci = 0; ci < 144; ++ci) {
        LAS unsigned char* buf = wl + (ci & 1) * 9216; LAS unsigned char* obuf = wl + ((ci + 1) & 1) * 9216;
        if (ci + 1 < 144) GDN_FETCH(ci + 1);
        const int r0 = scan_row(b, dir, ci * 16);
        float okeep = 0.f;
#pragma unroll 1
        for (int tg = 0; tg < 4; ++tg) {
            if (tg == 3 && ci + 1 < 144) {
                const float c = gdn_cprod(pg.y, lane); gA = pg.x / c; gB = pg.x; gC = c;
                GDN_PUT(obuf);
            }
            LAS unsigned char* pt = buf + tg * 1024 + kq * 64; LAS unsigned char* pvt = buf + 8192 + tg * 256 + vl * 4;
            LAS unsigned char* pn = (tg == 3) ? obuf + kq * 64 : pt + 1024; LAS unsigned char* pvn = (tg == 3) ? obuf + 8192 + vl * 4 : pvt + 256;
            const int tt0 = tg * 4;
            GDN_LD(KB, QB, VB, pt + 256, pvt + 64);  __builtin_amdgcn_sched_barrier(0); GDN_TOK(KA, QA, VA, tt0 + 0, 0); __builtin_amdgcn_sched_barrier(0);
            GDN_LD(KA, QA, VA, pt + 512, pvt + 128); __builtin_amdgcn_sched_barrier(0); GDN_TOK(KB, QB, VB, tt0 + 1, 1); __builtin_amdgcn_sched_barrier(0);
            GDN_LD(KB, QB, VB, pt + 768, pvt + 192); __builtin_amdgcn_sched_barrier(0); GDN_TOK(KA, QA, VA, tt0 + 2, 2); __builtin_amdgcn_sched_barrier(0);
            GDN_LD(KA, QA, VA, pn, pvn);             __builtin_amdgcn_sched_barrier(0); GDN_TOK(KB, QB, VB, tt0 + 3, 3); __builtin_amdgcn_sched_barrier(0);
            DO[(size_t)(r0 + step * (tt0 + kq)) * 256 + h * 64 + vbase + vl] = okeep;
            { const float cl = rdlane_f(cC, tt0 + 3);
#pragma unroll
              for (int i = 0; i < 8; ++i) S2[i] = S2[i] * cl; }
        }
        cA = gA; cB = gB; cC = gC;
    }
#undef GDN_FETCH
#undef GDN_PUT
#undef GDN_LD
#undef GDN_TOK
}
__device__ __forceinline__ void gla_wave(CArgs& a, int chain, int vbase, LAS unsigned char* wl, int lane) {
    const int b = chain >> 3, h = (chain >> 1) & 3, dir = chain & 1, vl = lane >> 2, kq = lane & 3;
    const bf16* P = (const bf16*)(a.ws + WS_P);
    const float* GD = (const float*)(a.ws + WS_MIX + (dir ? MX_GDB : MX_GDF));
    float* GO = (float*)(a.ws + WS_MIX + (dir ? MX_GOB : MX_GOF));
    f32x2 S2[4];
#pragma unroll
    for (int i = 0; i < 4; ++i) S2[i] = (f32x2){0.f, 0.f};
    u32x4 pq, pk; f32x4 pd[2]; u32x2 pv;
    const int step = dir ? -1 : 1;
#define GLA_FETCH(ci) do { const int r0_ = scan_row(b, dir, (ci) * 16); \
        const bf16* pr_ = P + (size_t)(r0_ + step * (lane >> 2)) * D_INP + GLA0; \
        pq = *(const u32x4*)(pr_ + h * 32 + (lane & 3) * 8); pk = *(const u32x4*)(pr_ + 128 + h * 32 + (lane & 3) * 8); pv = *(const u32x2*)(pr_ + 256 + h * 64 + vbase + (lane & 3) * 4); \
        _Pragma("unroll") for (int j = 0; j < 2; ++j) pd[j] = *(const f32x4*)(GD + (size_t)(r0_ + step * (8 * j + (lane >> 3))) * 128 + h * 32 + (lane & 7) * 4); } while (0)
#define GLA_PUT(bufp) do { const float qs_ = 0.17677669529663687f; \
        *(LAS f32x4*)((bufp) + lane * 32) = (f32x4){lo_bf(pq.x) * qs_, hi_bf(pq.x) * qs_, lo_bf(pq.y) * qs_, hi_bf(pq.y) * qs_}; *(LAS f32x4*)((bufp) + lane * 32 + 16) = (f32x4){lo_bf(pq.z) * qs_, hi_bf(pq.z) * qs_, lo_bf(pq.w) * qs_, hi_bf(pq.w) * qs_}; \
        *(LAS f32x4*)((bufp) + 2048 + lane * 32) = (f32x4){lo_bf(pk.x), hi_bf(pk.x), lo_bf(pk.y), hi_bf(pk.y)}; *(LAS f32x4*)((bufp) + 2048 + lane * 32 + 16) = (f32x4){lo_bf(pk.z), hi_bf(pk.z), lo_bf(pk.w), hi_bf(pk.w)}; \
        *(LAS f32x4*)((bufp) + 4096 + lane * 16) = pd[0]; *(LAS f32x4*)((bufp) + 4096 + 1024 + lane * 16) = pd[1]; \
        *(LAS f32x4*)((bufp) + 6144 + lane * 16) = (f32x4){lo_bf(pv.x), hi_bf(pv.x), lo_bf(pv.y), hi_bf(pv.y)}; } while (0)
#define GLA_LD(Q, K, Dd, V, p, pvv) do { _Pragma("unroll") for (int m = 0; m < 2; ++m) { Q[m] = *(const LAS f32x4*)((p) + 16 * m); K[m] = *(const LAS f32x4*)((p) + 2048 + 16 * m); Dd[m] = *(const LAS f32x4*)((p) + 4096 + 16 * m); } V = *(const LAS float*)(pvv); } while (0)
#define GLA_TOK(Q, K, Dd, V, tu) do { const f32x2 vv2 = (f32x2){V, V}; \
        S2[0] = __builtin_elementwise_fma((f32x2){K[0][0], K[0][1]}, vv2, (f32x2){Dd[0][0], Dd[0][1]} * S2[0]); S2[1] = __builtin_elementwise_fma((f32x2){K[0][2], K[0][3]}, vv2, (f32x2){Dd[0][2], Dd[0][3]} * S2[1]); \
        S2[2] = __builtin_elementwise_fma((f32x2){K[1][0], K[1][1]}, vv2, (f32x2){Dd[1][0], Dd[1][1]} * S2[2]); S2[3] = __builtin_elementwise_fma((f32x2){K[1][2], K[1][3]}, vv2, (f32x2){Dd[1][2], Dd[1][3]} * S2[3]); \
        f32x2 oa = (f32x2){Q[0][0], Q[0][1]} * S2[0], ob = (f32x2){Q[0][2], Q[0][3]} * S2[1]; \
        oa = __builtin_elementwise_fma((f32x2){Q[1][0], Q[1][1]}, S2[2], oa); ob = __builtin_elementwise_fma((f32x2){Q[1][2], Q[1][3]}, S2[3], ob); oa = oa + ob; \
        const float o = quad_sum(oa.x + oa.y); okeep = ((tu) == kq) ? o : okeep; } while (0)
    GLA_FETCH(0);
    GLA_PUT(wl);
    f32x4 QA[2], KA[2], DA[2], QB[2], KB[2], DB[2]; float VA, VB;
    GLA_LD(QA, KA, DA, VA, wl + kq * 32, wl + 6144 + vl * 4);
#pragma unroll 1
    for (int ci = 0; ci < 144; ++ci) {
        LAS unsigned char* buf = wl + (ci & 1) * 7168; LAS unsigned char* obuf = wl + ((ci + 1) & 1) * 7168;
        if (ci + 1 < 144) GLA_FETCH(ci + 1);
        const int r0 = scan_row(b, dir, ci * 16);
        float okeep = 0.f;
#pragma unroll 1
        for (int tg = 0; tg < 4; ++tg) {
            if (tg == 3 && ci + 1 < 144) GLA_PUT(obuf);
            LAS unsigned char* pt = buf + tg * 512 + kq * 32; LAS unsigned char* pvt = buf + 6144 + tg * 256 + vl * 4;
            LAS unsigned char* pn = (tg == 3) ? obuf + kq * 32 : pt + 512; LAS unsigned char* pvn = (tg == 3) ? obuf + 6144 + vl * 4 : pvt + 256;
            GLA_LD(QB, KB, DB, VB, pt + 128, pvt + 64);  __builtin_amdgcn_sched_barrier(0); GLA_TOK(QA, KA, DA, VA, 0); __builtin_amdgcn_sched_barrier(0);
            GLA_LD(QA, KA, DA, VA, pt + 256, pvt + 128); __builtin_amdgcn_sched_barrier(0); GLA_TOK(QB, KB, DB, VB, 1); __builtin_amdgcn_sched_barrier(0);
            GLA_LD(QB, KB, DB, VB, pt + 384, pvt + 192); __builtin_amdgcn_sched_barrier(0); GLA_TOK(QA, KA, DA, VA, 2); __builtin_amdgcn_sched_barrier(0);
            GLA_LD(QA, KA, DA, VA, pn, pvn);             __builtin_amdgcn_sched_barrier(0); GLA_TOK(QB, KB, DB, VB, 3); __builtin_amdgcn_sched_barrier(0);
            GO[(size_t)(r0 + step * (tg * 4 + kq)) * 256 + h * 64 + vbase + vl] = okeep;
        }
    }
#undef GLA_FETCH
#undef GLA_PUT
#undef GLA_LD
#undef GLA_TOK
}
template <int L>
__device__ __forceinline__ void hyena_unit(CArgs& a, int l, int c, LAS unsigned char* lds) {
    constexpr int Lt = L == SEQ ? 1 : 0, SOFF = L == SEQ ? CTXL : 0, CST = (2 * L + 16) * 2 + 32;
    constexpr int NTW = L / 16 / 8;
    const int tid = tidx(), lane = tid & 63, w = tid >> 6, fr = lane & 15, kg = lane >> 4;
    const float* kf = (const float*)(a.ws + WS_KUN) + ((size_t)((l * 2 + Lt) * 512 + c)) * 2048;
    const float* kb = kf + (size_t)256 * 2048;
    LAS float* red = (LAS float*)(lds + 8 * CST);
    float s = 0.f;
    for (int t = tid; t < L; t += 512) s += fabsf(kf[t]) + (t >= 1 ? fabsf(kb[t]) : 0.f);
    s = wave_sum(s);
    if (lane == 0) red[w] = s;
    __syncthreads();
    float l1 = 0.f;
#pragma unroll
    for (int i = 0; i < 8; ++i) l1 += red[i];
    const float inv = 1.f / l1;
    for (int idx = tid; idx < 2 * L + 16; idx += 512) {
        float gv = 0.f;
        if (idx >= 1 && idx <= L) gv = kf[L - idx] * inv; else if (idx > L && idx < 2 * L) gv = kb[idx - L] * inv;
        const bf16 gb = (bf16)f2bf(gv);
#pragma unroll
        for (int r = 0; r < 8; ++r) if (idx - r >= 0) *(LAS bf16*)(lds + r * CST + (idx - r) * 2) = gb;
    }
    __syncthreads();
    const bf16* Z = (const bf16*)(a.ws + WS_MIX + MX_ZT) + ((size_t)(c * 16 + fr)) * 2304 + SOFF;
    float* YT = (float*)(a.ws + WS_MIX + MX_YT) + ((size_t)(c * 16 + fr)) * 2304 + SOFF;
    f32x4 acc[NTW];
#pragma unroll
    for (int j = 0; j < NTW; ++j) acc[j] = (f32x4){0.f, 0.f, 0.f, 0.f};
    const int rr = (8 - (fr & 7)) & 7;
    for (int i = 0; i < L / 32; ++i) {
        const bf16x8 Bf = *(const bf16x8*)(Z + 32 * i + 8 * kg);
#pragma unroll
        for (int j = 0; j < NTW; ++j) {
            const int t0 = 16 * (w * NTW + j);
            const int o = 32 * i + 8 * kg - t0 - fr + L;
            const bf16x8 Af = *(const LAS bf16x8*)(lds + rr * CST + (o >> 3) * 16);
            acc[j] = __builtin_amdgcn_mfma_f32_16x16x32_bf16(Af, Bf, acc[j], 0, 0, 0);
        }
    }
#pragma unroll
    for (int j = 0; j < NTW; ++j) *(f32x4*)(YT + 16 * (w * NTW + j) + 4 * kg) = acc[j];
    __syncthreads();
}
__device__ __forceinline__ void ph_scan(CArgs& a, int l, LAS unsigned char* lds, int bid, int nblk, unsigned long long& tacc) {
    const int tid = tidx(), lane = tid & 63, w = __builtin_amdgcn_readfirstlane(tid >> 6);
    unsigned long long t0 = 0ull;
    if (PROBE_PH >= 20) t0 = __builtin_amdgcn_s_memrealtime();
    if (w < 4) {
        for (int it = bid; it < 256; it += nblk) {
            const int p = it >> 1, half = it & 1;
            if (w < 2) gdn_wave(a, p, 32 * half + 16 * (w & 1), lds + w * 18432, lane);
            else gla_wave(a, p, 32 * half + 16 * (w & 1), lds + 36864 + (w - 2) * 14336, lane);
        }
        if (PROBE_PH == 20 && w < 2) tacc += __builtin_amdgcn_s_memrealtime() - t0;
        if (PROBE_PH == 21 && w >= 2) tacc += __builtin_amdgcn_s_memrealtime() - t0;
    } else {
        tr_experts_waves(a, l, lds + 65536 + (w - 4) * 8448, bid * 4 + (w - 4), nblk * 4, lane);
        if (PROBE_PH == 22) tacc += __builtin_amdgcn_s_memrealtime() - t0;
    }
    __syncthreads();
    if (PROBE_PH == 23) t0 = __builtin_amdgcn_s_memrealtime();
    for (int it = bid; it < 512; it += nblk) {
        if (it < 256) hyena_unit<SEQ>(a, l, it, lds);
        else hyena_unit<CTXL>(a, l, it - 256, lds);
    }
    if (PROBE_PH == 23) tacc += __builtin_amdgcn_s_memrealtime() - t0;
}

__device__ __forceinline__ void ph_post_hyena(CArgs& a, int l, LAS unsigned char* lds, int bid, int nblk) {
    const bf16* P = (const bf16*)(a.ws + WS_P);
    const float* YT = (const float*)(a.ws + WS_MIX + MX_YT); bf16* YMIX = (bf16*)(a.ws + WS_YMIX);
    LAS float* yt = (LAS float*)lds;
    const int tid = tidx(), c4 = (tid & 63) * 4, tg = tid >> 6;
    const float* hw = a.in[I_HYCW] + l * 3 * 768; const float* hb = a.in[I_HYCB] + l * 768;
    f32x4 w0[3], wx[3], wv[3];
#pragma unroll
    for (int k = 0; k < 3; ++k) { w0[k] = *(const f32x4*)(hw + k * 768 + c4); wx[k] = *(const f32x4*)(hw + k * 768 + 256 + c4); wv[k] = *(const f32x4*)(hw + k * 768 + 512 + c4); }
    const f32x4 b0 = *(const f32x4*)(hb + c4), bx = *(const f32x4*)(hb + 256 + c4), bv = *(const f32x4*)(hb + 512 + c4), hd = *(const f32x4*)(a.in[I_HYD] + l * 256 + c4);
#pragma unroll 1
    for (int it = bid; it < 576; it += nblk) {
        const Chunk c = chunk_of(it);
        const int soff = c.L == CTXL ? 0 : CTXL;
        { const int ch = tid & 255, half = tid >> 8;
          const float* srcp = YT + ((size_t)(ch * 16 + c.b)) * 2304 + soff + c.t0 + half * 32;
#pragma unroll
          for (int j = 0; j < 8; ++j) { const f32x4 v = *(const f32x4*)(srcp + 4 * j);
              yt[(half * 32 + 4 * j) * 260 + ch] = v[0]; yt[(half * 32 + 4 * j + 1) * 260 + ch] = v[1]; yt[(half * 32 + 4 * j + 2) * 260 + ch] = v[2]; yt[(half * 32 + 4 * j + 3) * 260 + ch] = v[3]; } }
        __syncthreads();
        const int tb = c.t0 + tg * 8;
        const bf16* pb = P + (size_t)(c.row0 + tg * 8) * D_INP;
        f32x4 x0[10], x1[10], vv[10];
#pragma unroll
        for (int r = 0; r < 10; ++r) { const int t = tb + r - 1; const bool ok = t >= c.lo && t < c.hi; const bf16* p = pb + (ptrdiff_t)(r - 1) * D_INP;
            x0[r] = ok ? bf4(*(const u32x2*)(p + HY0 + c4)) : (f32x4){0.f, 0.f, 0.f, 0.f};
            x1[r] = ok ? bf4(*(const u32x2*)(p + HY0 + 256 + c4)) : (f32x4){0.f, 0.f, 0.f, 0.f}; vv[r] = ok ? bf4(*(const u32x2*)(p + HY0 + 512 + c4)) : (f32x4){0.f, 0.f, 0.f, 0.f}; }
#pragma unroll
        for (int tt = 0; tt < 8; ++tt) {
            const f32x4 u0 = w0[0] * x0[tt] + w0[1] * x0[tt + 1] + w0[2] * x0[tt + 2] + b0;
            const f32x4 xx = wx[0] * x1[tt] + wx[1] * x1[tt + 1] + wx[2] * x1[tt + 2] + bx, v2 = wv[0] * vv[tt] + wv[1] * vv[tt + 1] + wv[2] * vv[tt + 2] + bv, z = xx * v2;
            const f32x4 y = *(const LAS f32x4*)(yt + (tg * 8 + tt) * 260 + c4);
            const f32x4 o = (y + z * hd) * u0;
            u32x2 oo; oo.x = pk2(o[0], o[1]); oo.y = pk2(o[2], o[3]); *(u32x2*)(YMIX + (size_t)(c.row0 + tg * 8 + tt) * D + c4) = oo;
        }
        __syncthreads();
    }
}
__device__ __forceinline__ void ph_post_tok(CArgs& a, int l, int gw, int ngw) {
    const int lane = tidx() & 63;
    const bf16* P = (const bf16*)(a.ws + WS_P); bf16* YMIX = (bf16*)(a.ws + WS_YMIX);
    const float* GOF = (const float*)(a.ws + WS_MIX + MX_GOF); const float* GOB = (const float*)(a.ws + WS_MIX + MX_GOB);
    const float* DOF = (const float*)(a.ws + WS_MIX + MX_DOF); const float* DOB = (const float*)(a.ws + WS_MIX + MX_DOB);
    const f32x4 nwa = *(const f32x4*)(a.in[I_GLANW] + l * 64 + (4 * lane & 63)), nwd = *(const f32x4*)(a.in[I_GDNNW] + l * 64 + (4 * lane & 63));
    for (int row = gw; row < NTOK; row += ngw) {
        const size_t o4 = (size_t)row * 256 + 4 * lane;
        f32x4 og = *(const f32x4*)(GOF + o4) + *(const f32x4*)(GOB + o4), od = *(const f32x4*)(DOF + o4) + *(const f32x4*)(DOB + o4);
        float sg = og[0] * og[0] + og[1] * og[1] + og[2] * og[2] + og[3] * og[3], sd = od[0] * od[0] + od[1] * od[1] + od[2] * od[2] + od[3] * od[3];
        sg = row16_sum(sg); sd = row16_sum(sd);
        const float rg = rsqrtf(sg * (1.f / 64.f) + 1e-6f), rd = rsqrtf(sd * (1.f / 64.f) + 1e-6f);
        const u32x2 r2 = *(const u32x2*)(P + (size_t)row * D_INP + GLA0 + 512 + 4 * lane), z2 = *(const u32x2*)(P + (size_t)row * D_INP + GDN0 + 768 + 4 * lane);
        u32x2 w;
        w.x = pk2(og[0] * rg * nwa[0] * siluf_(lo_bf(r2.x)), og[1] * rg * nwa[1] * siluf_(hi_bf(r2.x))); w.y = pk2(og[2] * rg * nwa[2] * siluf_(lo_bf(r2.y)), og[3] * rg * nwa[3] * siluf_(hi_bf(r2.y)));
        *(u32x2*)(YMIX + (size_t)row * D + 512 + 4 * lane) = w;
        w.x = pk2(od[0] * rd * nwd[0] * siluf_(lo_bf(z2.x)), od[1] * rd * nwd[1] * siluf_(hi_bf(z2.x))); w.y = pk2(od[2] * rd * nwd[2] * siluf_(lo_bf(z2.y)), od[3] * rd * nwd[3] * siluf_(hi_bf(z2.y)));
        *(u32x2*)(YMIX + (size_t)row * D + 768 + 4 * lane) = w;
    }
}

__device__ __forceinline__ void ph_ln1_route(CArgs& a, int l, LAS unsigned char* lds, int bid, int nblk) {
    const int tid = tidx(), lane = tid & 63, w = __builtin_amdgcn_readfirstlane(tid >> 6);
    const float* MOD = (const float*)(a.ws + WS_MOD) + (size_t)l * 17 * 6144;
    float* X = (float*)(a.ws + WS_X); const float* TMP = (const float*)(a.ws + WS_TMP); bf16* HB = (bf16*)(a.ws + WS_HB);
    const float* lg = a.in[I_LN1G] + l * D; const float* lb = a.in[I_LN1B] + l * D;
    const float* br = a.in[I_BR] + l * NEXP;
    const bf16* wh = (const bf16*)(a.ws + WS_WRT) + (size_t)l * NEXP * D; const bf16* wl = wh + DEPTH * NEXP * D;
    unsigned* cnt = (unsigned*)(a.ws + WS_CTL) + CW_CNT + l * NEXP * 64;
    int* LIST = (int*)(a.ws + WS_LIST); int* TOPE = (int*)(a.ws + WS_TOPE); float* TOPW = (float*)(a.ws + WS_TOPW);
    LAS float* hrow = (LAS float*)lds;
    LAS float* part = (LAS float*)(lds + 65792);
    const int row_lo = (l == DEPTH - 1) ? NTOK_C : 0;
    const int e = lane & 31, par = lane >> 5, fr = lane & 15, kg = lane >> 4;
#pragma unroll 1
    for (int base = row_lo + bid * 16; base < NTOK; base += nblk * 16) {
#pragma unroll
        for (int t = 0; t < 2; ++t) {
            const int row = base + 2 * w + t;
            const float* xs = (l == 0) ? (row < NTOK_C ? a.in[I_CTX] + (size_t)row * D : a.in[I_X] + (size_t)(row - NTOK_C) * D) : X + (size_t)row * D;
            const float* mv = MOD + (size_t)mod_vec(row) * 6144;
            f32x4 v[4]; float s = 0.f;
#pragma unroll
            for (int j = 0; j < 4; ++j) { const int c0 = j * 256 + 4 * lane; const f32x4 x = *(const f32x4*)(xs + c0), tm = *(const f32x4*)(TMP + (size_t)row * D + c0), g1 = *(const f32x4*)(mv + 2048 + c0);
                v[j] = DN_ALPHA * x + g1 * tm; s += (v[j][0] + v[j][1]) + (v[j][2] + v[j][3]); }
            const float mean = wave_sum(s) * (1.f / D); float s2 = 0.f;
#pragma unroll
            for (int j = 0; j < 4; ++j) { v[j] = v[j] - mean; s2 += (v[j][0] * v[j][0] + v[j][1] * v[j][1]) + (v[j][2] * v[j][2] + v[j][3] * v[j][3]); }
            const float rstd = rsqrtf(wave_sum(s2) * (1.f / D) + LN_EPS);
#pragma unroll
            for (int j = 0; j < 4; ++j) { const int c0 = j * 256 + 4 * lane; const f32x4 g = *(const f32x4*)(lg + c0), bb = *(const f32x4*)(lb + c0), sh = *(const f32x4*)(mv + 3072 + c0), sc = *(const f32x4*)(mv + 4096 + c0);
                const f32x4 xn = v[j] * rstd * g + bb; *(f32x4*)(X + (size_t)row * D + c0) = xn;
                const f32x4 hh = xn * (1.f + sc) + sh;
                u32x2 o; o.x = pk2(hh[0], hh[1]); o.y = pk2(hh[2], hh[3]); *(u32x2*)(HB + (size_t)row * D + c0) = o;
                *(LAS f32x4*)(hrow + (2 * w + t) * 1028 + c0) = hh; }
        }
        __syncthreads();
        {
            f32x4 acc[2] = {(f32x4){0.f, 0.f, 0.f, 0.f}, (f32x4){0.f, 0.f, 0.f, 0.f}};
#pragma unroll
            for (int ss = 0; ss < 4; ++ss) { const int k0 = 128 * w + 32 * ss + 8 * kg;
                const f32x4 h0 = *(const LAS f32x4*)(hrow + fr * 1028 + k0), h1 = *(const LAS f32x4*)(hrow + fr * 1028 + k0 + 4);
                u32x4 ah, al;
                ah.x = pk2(h0[0], h0[1]); ah.y = pk2(h0[2], h0[3]); ah.z = pk2(h1[0], h1[1]); ah.w = pk2(h1[2], h1[3]);
                al.x = pk2(h0[0] - lo_bf(ah.x), h0[1] - hi_bf(ah.x)); al.y = pk2(h0[2] - lo_bf(ah.y), h0[3] - hi_bf(ah.y)); al.z = pk2(h1[0] - lo_bf(ah.z), h1[1] - hi_bf(ah.z)); al.w = pk2(h1[2] - lo_bf(ah.w), h1[3] - hi_bf(ah.w));
                const bf16x8 Ah = __builtin_bit_cast(bf16x8, ah), Al = __builtin_bit_cast(bf16x8, al);
#pragma unroll
                for (int t = 0; t < 2; ++t) { const size_t wo = (size_t)(16 * t + fr) * D + k0;
                    const bf16x8 Bh = *(const bf16x8*)(wh + wo), Bl = *(const bf16x8*)(wl + wo);
                    acc[t] = __builtin_amdgcn_mfma_f32_16x16x32_bf16(Ah, Bh, acc[t], 0, 0, 0);
                    acc[t] = __builtin_amdgcn_mfma_f32_16x16x32_bf16(Ah, Bl, acc[t], 0, 0, 0);
                    acc[t] = __builtin_amdgcn_mfma_f32_16x16x32_bf16(Al, Bh, acc[t], 0, 0, 0); } }
#pragma unroll
            for (int t = 0; t < 2; ++t)
#pragma unroll
                for (int j = 0; j < 4; ++j) part[((w * 2 + t) * 16 + 4 * kg + j) * 16 + fr] = acc[t][j];
        }
        __syncthreads();
        {
            const int row = base + 2 * w + par;
            float cur = br[e];
#pragma unroll
            for (int ww = 0; ww < 8; ++ww) cur += part[((ww * 2 + (e >> 4)) * 16 + 2 * w + par) * 16 + (e & 15)];
            float tv[4]; int ti[4];
#pragma unroll
            for (int k = 0; k < 4; ++k) { float bv = cur; int bi = e;
#define TOPSTEP(OV, OI) do { const float ov = (OV); const int oi = (OI); if (ov > bv || (ov == bv && oi < bi)) { bv = ov; bi = oi; } } while (0)
                TOPSTEP(dpp_f<0xB1>(bv), dpp_i<0xB1>(bi)); TOPSTEP(dpp_f<0x4E>(bv), dpp_i<0x4E>(bi)); TOPSTEP(dpp_f<0x141>(bv), dpp_i<0x141>(bi)); TOPSTEP(dpp_f<0x140>(bv), dpp_i<0x140>(bi));
                TOPSTEP(__shfl_xor(bv, 16), __shfl_xor(bi, 16));
#undef TOPSTEP
                tv[k] = bv; ti[k] = bi; if (e == bi) cur = -3.0e38f; }
            const float e1 = __expf(tv[1] - tv[0]), e2 = __expf(tv[2] - tv[0]), e3 = __expf(tv[3] - tv[0]); const float inv = 1.f / (1.f + e1 + e2 + e3);
            if (e < 4) { const int ee = e == 0 ? ti[0] : e == 1 ? ti[1] : e == 2 ? ti[2] : ti[3]; const float ww = (e == 0 ? 1.f : e == 1 ? e1 : e == 2 ? e2 : e3) * inv;
                const unsigned pos = atomicAdd(cnt + ee * 64, 1u);
                LIST[(size_t)ee * NTOK + pos] = row; TOPE[(size_t)row * 4 + e] = (ee << 20) | (int)pos; TOPW[(size_t)row * 4 + e] = ww; }
        }
    }
}
__device__ __forceinline__ void moe_tables(CArgs& a, int l, LAS unsigned char* lds, int NT) {
    LAS int* pre = (LAS int*)(lds + TAB_OFF); LAS int* mtl = pre + 40; LAS int* rowoff = pre + 80; LAS int* cn = pre + 120;
    if (tidx() == 0) { const unsigned* cnt = (const unsigned*)(a.ws + WS_CTL) + CW_CNT + l * NEXP * 64; int p = 0, r = 0;
        for (int e = 0; e < NEXP; ++e) { const int n = (int)__hip_atomic_load(cnt + e * 64, __ATOMIC_RELAXED, __HIP_MEMORY_SCOPE_AGENT), m = (n + 255) >> 8; pre[e] = p; mtl[e] = m > 0 ? m : 1; rowoff[e] = r; cn[e] = n; p += m * NT; r += m * 256; }
        pre[32] = p; }
    __syncthreads();
}
__device__ __forceinline__ void ph_ln2(CArgs& a, int l, LAS unsigned char* lds, int gw, int ngw) {
    const int lane = tidx() & 63;
    const float* MOD = (const float*)(a.ws + WS_MOD) + (size_t)l * 17 * 6144;
    float* X = (float*)(a.ws + WS_X); const bf16* YD = (const bf16*)(a.ws + WS_YD); bf16* HB = (bf16*)(a.ws + WS_HB);
    const float* lg = a.in[I_LN2G] + l * D; const float* lb = a.in[I_LN2B] + l * D;
    const int* TOPE = (const int*)(a.ws + WS_TOPE); const float* TOPW = (const float*)(a.ws + WS_TOPW);
    const LAS int* rowoff = (const LAS int*)(lds + TAB_OFF) + 80;
    const bool lastl = (l == DEPTH - 1);
    const int row_lo = lastl ? NTOK_C : 0;
#pragma unroll 1
    for (int row0 = row_lo + gw * 2; row0 < NTOK; row0 += ngw * 2) {
        u32x2 y2[2][4][4]; float tw[2][4]; f32x4 xv[2][4], g2v[2][4];
#pragma unroll
        for (int r = 0; r < 2; ++r) {
            const int row = row0 + r;
#pragma unroll
            for (int k = 0; k < 4; ++k) { const int te = TOPE[(size_t)row * 4 + k]; tw[r][k] = TOPW[(size_t)row * 4 + k];
                const bf16* yr = YD + ((size_t)(rowoff[te >> 20] + (te & 0xfffff))) * D;
#pragma unroll
                for (int j = 0; j < 4; ++j) y2[r][k][j] = *(const u32x2*)(yr + j * 256 + 4 * lane); }
            const float* mv = MOD + (size_t)mod_vec(row) * 6144;
#pragma unroll
            for (int j = 0; j < 4; ++j) { const int c0 = j * 256 + 4 * lane; xv[r][j] = *(const f32x4*)(X + (size_t)row * D + c0); g2v[r][j] = *(const f32x4*)(mv + 5120 + c0); }
        }
#pragma unroll
        for (int r = 0; r < 2; ++r) {
            const int row = row0 + r;
            const float* mv = MOD + (size_t)mod_vec(row) * 6144;
            f32x4 v[4]; float s = 0.f;
#pragma unroll
            for (int j = 0; j < 4; ++j) { f32x4 f = (f32x4){0.f, 0.f, 0.f, 0.f};
#pragma unroll
                for (int k = 0; k < 4; ++k) { const u32x2 yy = y2[r][k][j]; f += tw[r][k] * (f32x4){lo_bf(yy.x), hi_bf(yy.x), lo_bf(yy.y), hi_bf(yy.y)}; }
                v[j] = DN_ALPHA * xv[r][j] + g2v[r][j] * f; s += (v[j][0] + v[j][1]) + (v[j][2] + v[j][3]); }
            const float mean = wave_sum(s) * (1.f / D); float s2 = 0.f;
#pragma unroll
            for (int j = 0; j < 4; ++j) { v[j] = v[j] - mean; s2 += (v[j][0] * v[j][0] + v[j][1] * v[j][1]) + (v[j][2] * v[j][2] + v[j][3] * v[j][3]); }
            const float rstd = rsqrtf(wave_sum(s2) * (1.f / D) + LN_EPS);
            const float* mvn = mv + 17 * 6144;
#pragma unroll
            for (int j = 0; j < 4; ++j) { const int c0 = j * 256 + 4 * lane; const f32x4 g = *(const f32x4*)(lg + c0), bb = *(const f32x4*)(lb + c0);
                const f32x4 xn = v[j] * rstd * g + bb;
                if (lastl) *(f32x4*)(a.out + (size_t)(row - NTOK_C) * D + c0) = xn;
                else { *(f32x4*)(X + (size_t)row * D + c0) = xn; const f32x4 sh = *(const f32x4*)(mvn + c0), sc = *(const f32x4*)(mvn + 1024 + c0); const f32x4 hh = xn * (1.f + sc) + sh;
                    u32x2 o; o.x = pk2(hh[0], hh[1]); o.y = pk2(hh[2], hh[3]); *(u32x2*)(HB + (size_t)row * D + c0) = o; } }
        }
    }
}

constexpr int NPH = 2 + DEPTH * 9;
__device__ __forceinline__ CArgs* kargs() { CArgs* p = (CArgs*)__builtin_amdgcn_kernarg_segment_ptr(); asm volatile("" : "+s"(p)); return p; }
__global__ void __launch_bounds__(512, 2) trunk_fwd(Args a_unused) {
    extern __shared__ __attribute__((aligned(16))) unsigned char lds_raw[];
    LAS unsigned char* lds = (LAS unsigned char*)lds_raw;
    const int tid = threadIdx.x, wave = __builtin_amdgcn_readfirstlane(tid >> 6);
    const int bid = blockIdx.x, nblk = gridDim.x, gw = bid * 8 + wave, ngw = nblk * 8;
    volatile LAS unsigned* MISC = (volatile LAS unsigned*)(lds + MISC_OFF);
    if (tid < 64) MISC[tid] = 0u;
    __syncthreads();
    XcdBarrier bar; bar.x = 0; bar.st = nullptr;
    int lo, hi;
    { CArgs& a = *kargs(); lo = a.ph_lo; hi = a.ph_hi; bar.bar = (unsigned*)(a.ws + WS_CTL) + CW_BAR;
      if (hi - lo > 1) bar = xcd_barrier_post((unsigned*)(a.ws + WS_CTL) + CW_BAR, MISC); }
#define IN(k) (lo <= (k) && (k) < hi)
    unsigned long long tacc = 0ull, tbeg = 0ull;
#define PB_BEG(ty) do { if (PROBE_PH == (ty)) tbeg = __builtin_amdgcn_s_memrealtime(); } while (0)
#define PB_END(ty) do { if (PROBE_PH == (ty)) tacc += __builtin_amdgcn_s_memrealtime() - tbeg; } while (0)
#define SEAM(k) do { if (IN(k) && IN((k) + 1)) xcd_barrier(bar); } while (0)
    PB_BEG(0);
    if (IN(0)) { CArgs& a = *kargs(); unsigned long long t0 = 0ull;
#define PB_SUB(ty, stmt) do { if (PROBE_PH == (ty)) t0 = __builtin_amdgcn_s_memrealtime(); stmt; if (PROBE_PH == (ty)) tacc += __builtin_amdgcn_s_memrealtime() - t0; } while (0)
        PB_SUB(30, ph_mod(a, lds, bid, nblk)); __syncthreads(); PB_SUB(31, ph_filters(a, gw, ngw)); PB_SUB(32, ph_tr_small(a, lds, gw, ngw)); PB_SUB(33, ph_router_w(a, bid * 512 + tid, nblk * 512));
#undef PB_SUB
    }
    SEAM(0); PB_END(0); PB_BEG(1);
    if (IN(1)) { CArgs& a = *kargs(); ph_mod_input(a, gw, ngw); }
    SEAM(1); PB_END(1);
#pragma unroll 1
    for (int l = 0; l < DEPTH; ++l) {
        const int p0 = 2 + 9 * l;
        const bool lastl = (l == DEPTH - 1);
        PB_BEG(2);
        if (IN(p0 + 0)) {
            CArgs& a = *kargs();
            pg8::DenseSched S; S.init((const bf16*)(a.ws + WS_WIN) + (size_t)l * D_INP * 1024, 1024, NTOK, D_INP, nblk, bid, 0);
            pg8::EpiBf16 E{(bf16*)(a.ws + WS_P), D_INP, 0};
            pg8::gemm_phase<pg8::EpiBf16, pg8::DenseSched, true>(lds, (const char*)(a.ws + WS_HB), 1024, S, E);
        }
        SEAM(p0 + 0); PB_END(2); PB_BEG(3);
        if (IN(p0 + 1)) { CArgs& a = *kargs(); ph_prep_conv(a, l, lds, bid, nblk); ph_prep_tok(a, l, gw, ngw); }
        SEAM(p0 + 1); PB_END(3); PB_BEG(4);
        if (IN(p0 + 2)) { CArgs& a = *kargs(); ph_scan(a, l, lds, bid, nblk, tacc); }
        SEAM(p0 + 2); PB_END(4); PB_BEG(5);
        if (IN(p0 + 3)) { CArgs& a = *kargs(); ph_post_hyena(a, l, lds, bid, nblk); ph_post_tok(a, l, gw, ngw); }
        SEAM(p0 + 3); PB_END(5); PB_BEG(6);
        if (IN(p0 + 4)) {
            CArgs& a = *kargs();
            const int r0 = lastl ? NTOK_C : 0;
            pg8::DenseSched S; S.init((const bf16*)(a.ws + WS_WOUT) + (size_t)l * 1024 * 1024, 1024, NTOK - r0, 1024, nblk, bid, r0);
            pg8::EpiF32 E{(float*)(a.ws + WS_TMP), 1024, r0};
            pg8::gemm_phase<pg8::EpiF32, pg8::DenseSched, true>(lds, (const char*)(a.ws + WS_YMIX), 1024, S, E);
        }
        SEAM(p0 + 4); PB_END(6); PB_BEG(7);
        if (IN(p0 + 5)) { CArgs& a = *kargs(); ph_ln1_route(a, l, lds, bid, nblk); }
        SEAM(p0 + 5); PB_END(7); PB_BEG(8);
        if (IN(p0 + 6)) {
            CArgs& a = *kargs();
            moe_tables(a, l, lds, 8);
            const LAS int* tb = (const LAS int*)(lds + TAB_OFF);
            pg8::MoeSched<true, 8> S; S.Bt = (const char*)(a.ws + WS_WGU); S.bstride = (size_t)2048 * 1024 * 2; S.list = (const int*)(a.ws + WS_LIST);
            S.pre = tb; S.mtl = tb + 40; S.rowoff = tb + 80; S.cnt = tb + 120; S.K = 1024; S.G = nblk; S.c = bid; S.total = tb[32];
            pg8::EpiSwiglu E{(bf16*)(a.ws + WS_H), a.in[I_BG] + (size_t)l * NEXP * 1024, a.in[I_BU] + (size_t)l * NEXP * 1024, tb + 80};
            pg8::gemm_phase<pg8::EpiSwiglu, pg8::MoeSched<true, 8>, true>(lds, (const char*)(a.ws + WS_HB), 1024, S, E);
        }
        SEAM(p0 + 6); PB_END(8); PB_BEG(9);
        if (IN(p0 + 7)) {
            CArgs& a = *kargs();
            moe_tables(a, l, lds, 4);
            const LAS int* tb = (const LAS int*)(lds + TAB_OFF);
            pg8::MoeSched<false, 4> S; S.Bt = (const char*)(a.ws + WS_WD); S.bstride = (size_t)1024 * 1024 * 2; S.list = nullptr;
            S.pre = tb; S.mtl = tb + 40; S.rowoff = tb + 80; S.cnt = tb + 120; S.K = 1024; S.G = nblk; S.c = bid; S.total = tb[32];
            pg8::EpiDown E{(bf16*)(a.ws + WS_YD), a.in[I_BD] + (size_t)l * NEXP * 1024, tb + 80};
            pg8::gemm_phase<pg8::EpiDown, pg8::MoeSched<false, 4>, true>(lds, (const char*)(a.ws + WS_H), 1024, S, E);
        }
        SEAM(p0 + 7); PB_END(9); PB_BEG(10);
        if (IN(p0 + 8)) { CArgs& a = *kargs(); moe_tables(a, l, lds, 4); ph_ln2(a, l, lds, gw, ngw); }
        if (!lastl) SEAM(p0 + 8);
        PB_END(10);
    }
    if (PROBE_PH >= 0) { const unsigned long long t0 = __builtin_amdgcn_s_memrealtime(); while (__builtin_amdgcn_s_memrealtime() - t0 < tacc) __builtin_amdgcn_s_sleep(8); }
#undef IN
#undef SEAM
}

extern "C" void kernel_launch(void* const* d_in, const int* in_sizes, int n_in, void* d_out, int out_size, void* d_ws, size_t ws_size, hipStream_t stream) {
    static int grid = 0;
    if (grid == 0) {
        if (n_in != 39 || out_size != NTOK_L * D || ws_size < WS_END) { fprintf(stderr, "kernel_launch: unexpected problem (n_in %d, out %d, ws %zu < %zu)\n", n_in, out_size, ws_size, (size_t)WS_END); grid = -1; return; }
        int dev = 0, cus = 0, per_cu = 0;
        if (hipGetDevice(&dev) != hipSuccess || hipDeviceGetAttribute(&cus, hipDeviceAttributeMultiprocessorCount, dev) != hipSuccess) { grid = -1; return; }
        if (hipFuncSetAttribute((const void*)trunk_fwd, hipFuncAttributeMaxDynamicSharedMemorySize, LDS_BYTES) != hipSuccess) { fprintf(stderr, "kernel_launch: hipFuncSetAttribute failed\n"); grid = -1; return; }
        if (hipOccupancyMaxActiveBlocksPerMultiprocessor(&per_cu, (const void*)trunk_fwd, 512, LDS_BYTES) != hipSuccess || per_cu < 1) fprintf(stderr, "kernel_launch: occupancy query says %d\n", per_cu);
        (void)hipGetLastError();
        grid = cus;
    }
    if (grid < 0) return;
    (void)hipMemsetAsync((char*)d_ws + WS_CTL, 0, CTL_ZERO_BYTES, stream);
    Args a{};
    for (int i = 0; i < 39; ++i) a.in[i] = (const float*)d_in[i];
    a.out = (float*)d_out; a.ws = (unsigned char*)d_ws;
#if MK_FUSED
    a.ph_lo = 0; a.ph_hi = NPH;
    hipLaunchKernelGGL(trunk_fwd, dim3(grid), dim3(512), LDS_BYTES, stream, a);
#else
    for (int p = 0; p < NPH; ++p) { a.ph_lo = p; a.ph_hi = p + 1; hipLaunchKernelGGL(trunk_fwd, dim3(grid), dim3(512), LDS_BYTES, stream, a); }
#endif
}
```

```cpp
#include <hip/hip_runtime.h>
#include <cstdio>
#include <cstdint>

#ifndef MK_FUSED
#define MK_FUSED 1
#endif

#ifndef USE_NEW_GDN
#define USE_NEW_GDN 1
#endif
#ifndef USE_NEW_GLA
#define USE_NEW_GLA 1
#endif
#ifndef PROBE_PH
#define PROBE_PH -1
#endif

#define LAS __attribute__((address_space(3)))
#define GAS __attribute__((address_space(1)))
typedef unsigned short bf16;
typedef short bf16x8 __attribute__((ext_vector_type(8)));
typedef float f32x4 __attribute__((ext_vector_type(4)));
typedef float f32x2 __attribute__((ext_vector_type(2)));
typedef unsigned u32x4 __attribute__((ext_vector_type(4)));
typedef unsigned u32x2 __attribute__((ext_vector_type(2)));

constexpr int D = 1024, NB = 16, SEQ = 2048, CTXL = 256, DEPTH = 4;
constexpr int NTOK_C = NB * CTXL, NTOK_L = NB * SEQ, NTOK = NTOK_C + NTOK_L;
constexpr int D_IN = 3376, D_INP = 3584;
constexpr int HY0 = 0, SC0 = 768, GLA0 = 1536, GDN0 = 2336;
constexpr int NEXP = 32, TOPK = 4;
constexpr int MAXROWS = NTOK * TOPK + NEXP * 256;
constexpr float DN_ALPHA = 1.681792830507429f;
constexpr float LN_EPS = 1e-5f;

constexpr size_t MiB = 1u << 20;
constexpr size_t WS_CTL = 0, CTL_ZERO_BYTES = 1 * MiB;
constexpr size_t WS_MOD = 1 * MiB;
constexpr size_t WS_WRT = 3 * MiB;
constexpr size_t WS_KUN = 4 * MiB;
constexpr size_t WS_WIN = 36 * MiB;
constexpr size_t WS_WOUT = 64 * MiB;
constexpr size_t WS_WGU = 72 * MiB;
constexpr size_t WS_WD = 200 * MiB;
constexpr size_t WS_X = 264 * MiB;
constexpr size_t WS_HB = 408 * MiB;
constexpr size_t WS_P = 480 * MiB;
constexpr size_t WS_YMIX = 732 * MiB;
constexpr size_t WS_YD = WS_P;
constexpr size_t WS_TMP = 804 * MiB;
constexpr size_t WS_LIST = 948 * MiB;
constexpr size_t WS_TOPE = 953 * MiB;
constexpr size_t WS_TOPW = 954 * MiB;
constexpr size_t WS_H = 956 * MiB;
constexpr size_t WS_MIX = 1264 * MiB;
constexpr size_t MX_ZT = 0;
constexpr size_t MX_YT = 20 * MiB;
constexpr size_t MX_GDF = 56 * MiB, MX_GDB = 76 * MiB;
constexpr size_t MX_GOF = 96 * MiB, MX_GOB = 132 * MiB;
constexpr size_t MX_DQ = 168 * MiB, MX_DK = 204 * MiB, MX_DV = 240 * MiB;
constexpr size_t MX_DG = 276 * MiB;
constexpr size_t MX_DOF = 280 * MiB, MX_DOB = 316 * MiB;
constexpr size_t WS_END = WS_MIX + 352 * MiB;
static_assert((size_t)MAXROWS * 1024 * 2 <= 324 * MiB, "YD overlay");
static_assert(WS_H + (size_t)MAXROWS * 1024 * 2 <= WS_MIX, "H");
constexpr int CW_BAR = 4096;
constexpr int CW_CNT = 16384;

constexpr int LDS_BYTES = 147456;
constexpr int MISC_OFF = 131072;
constexpr int TAB_OFF = 131072 + 256;

__device__ __forceinline__ float bf2f(unsigned v) { return __uint_as_float(v << 16); }
__device__ __forceinline__ unsigned f2bf(float f) { unsigned u = __float_as_uint(f); return (u + 0x7fffu + ((u >> 16) & 1u)) >> 16; }
__device__ __forceinline__ unsigned pk2(float lo, float hi) { return f2bf(lo) | (f2bf(hi) << 16); }
__device__ __forceinline__ unsigned pk4_fp8(float a, float b, float c, float d) { int r = __builtin_amdgcn_cvt_pk_fp8_f32(a, b, 0, false); return (unsigned)__builtin_amdgcn_cvt_pk_fp8_f32(c, d, r, true); }
__device__ __forceinline__ float lo_bf(unsigned w) { return __uint_as_float(w << 16); }
__device__ __forceinline__ float hi_bf(unsigned w) { return __uint_as_float(w & 0xffff0000u); }
__device__ __forceinline__ float sigmoidf_(float x) { return 1.f / (1.f + __expf(-x)); }
__device__ __forceinline__ float siluf_(float x) { return x / (1.f + __expf(-x)); }
__device__ __forceinline__ float softplusf_(float x) { return x > 20.f ? x : log1pf(__expf(x)); }
__device__ __forceinline__ float logsigmoidf_(float x) { return x >= 0.f ? -log1pf(__expf(-x)) : x - log1pf(__expf(x)); }
__device__ __forceinline__ float sin_rev(float r) { return __builtin_amdgcn_sinf(__builtin_amdgcn_fractf(r)); }
__device__ __forceinline__ float sin_rad(float x) { return sin_rev(x * 0.15915494309189535f); }
template <int CTRL> __device__ __forceinline__ float dpp_f(float v) { return __builtin_bit_cast(float, __builtin_amdgcn_update_dpp(0, __builtin_bit_cast(int, v), CTRL, 0xf, 0xf, true)); }
template <int CTRL> __device__ __forceinline__ int dpp_i(int v) { return __builtin_amdgcn_update_dpp(0, v, CTRL, 0xf, 0xf, true); }
__device__ __forceinline__ float quad_sum(float v) { v += dpp_f<0xB1>(v); v += dpp_f<0x4E>(v); return v; }
__device__ __forceinline__ float row16_sum(float v) { v += dpp_f<0xB1>(v); v += dpp_f<0x4E>(v); v += dpp_f<0x141>(v); v += dpp_f<0x140>(v); return v; }
__device__ __forceinline__ float rdlane_f(float v, int l) { return __builtin_bit_cast(float, __builtin_amdgcn_readlane(__builtin_bit_cast(int, v), l)); }
__device__ __forceinline__ float wave_sum(float v) {
    v = row16_sum(v);
    return (rdlane_f(v, 0) + rdlane_f(v, 16)) + (rdlane_f(v, 32) + rdlane_f(v, 48));
}
__device__ __forceinline__ int tidx() { int t = threadIdx.x; asm volatile("" : "+v"(t)); return t; }

#define XB_TMO      128
#define XB_XCNT(j)  (256  + 64 * (j))
#define XB_XSUB(j)  (1280 + 64 * (j))
#define XB_XGEN(j)  (2304 + 64 * (j))
#define XB_TOP      3328
#define XB_TOPGEN   3392
#define XCD_BAR_WORDS 3456
#define XB_SPIN_CAP (1u << 25)
__device__ __forceinline__ unsigned xb_ld(unsigned* p)              { return __hip_atomic_load(p, __ATOMIC_RELAXED, __HIP_MEMORY_SCOPE_AGENT); }
__device__ __forceinline__ unsigned xb_add(unsigned* p, unsigned v) { return __hip_atomic_fetch_add(p, v, __ATOMIC_RELAXED, __HIP_MEMORY_SCOPE_AGENT); }
__device__ __forceinline__ unsigned xb_xcc_id() { return (unsigned)__builtin_amdgcn_s_getreg((3 << 11) | 20) & 0xFu; }
#define XB_SPIN(cond, bar) do { unsigned _sp = 0; while (cond) { __builtin_amdgcn_s_sleep(1); \
    if ((++_sp & 255u) == 0u) { if (xb_ld(&(bar)[XB_TMO])) break; if (_sp > XB_SPIN_CAP) { atomicAdd(&(bar)[XB_TMO], 1u); break; } } } } while (0)
struct XcdBarrier { unsigned* bar; unsigned x; volatile LAS unsigned* st; };
__device__ __forceinline__ XcdBarrier xcd_barrier_post(unsigned* bar, volatile LAS unsigned* st) {
    XcdBarrier b; b.bar = bar; b.x = xb_xcc_id(); b.st = st;
    if (threadIdx.x == 0) (void)xb_add(&bar[XB_XCNT(b.x)], 1u);
    return b;
}
__device__ __forceinline__ void xcd_barrier_complete(unsigned* bar, unsigned x, unsigned& nloc, unsigned& nx) {
    const unsigned G = gridDim.x * gridDim.y * gridDim.z;
    unsigned sum, cnt, mine, sp = 0u;
    for (;;) {
        sum = 0u; cnt = 0u; mine = 0u;
#pragma unroll
        for (unsigned j = 0; j < 16; ++j) { const unsigned c = xb_ld(&bar[XB_XCNT(j)]); sum += c; cnt += (c > 0u) ? 1u : 0u; mine = (j == x) ? c : mine; }
        if (sum == G) break;
        __builtin_amdgcn_s_sleep(1);
        if ((++sp & 255u) == 0u) { if (xb_ld(&bar[XB_TMO])) break; if (sp > XB_SPIN_CAP) { atomicAdd(&bar[XB_TMO], 1u); break; } }
    }
    nloc = mine > 0u ? mine : 1u; nx = cnt > 0u ? cnt : 1u;
}
__device__ __forceinline__ void xcd_barrier(const XcdBarrier& b) {
    asm volatile("s_waitcnt vmcnt(0)" ::: "memory");
    __syncthreads();
    if (threadIdx.x == 0) {
        unsigned* bar = b.bar;
        __builtin_amdgcn_s_waitcnt(0);
        unsigned nloc = b.st[0], nx = b.st[1];
        if (nloc == 0u) { xcd_barrier_complete(bar, b.x, nloc, nx); b.st[0] = nloc; b.st[1] = nx; }
        const unsigned old = xb_add(&bar[XB_XSUB(b.x)], 1u);
        const unsigned gen = old / nloc;
        if (old + 1u == (gen + 1u) * nloc) {
            __builtin_amdgcn_fence(__ATOMIC_RELEASE, "agent");
            asm volatile("s_waitcnt vmcnt(0)" ::: "memory");
            const unsigned og = xb_add(&bar[XB_TOP], 1u);
            const unsigned tg = og / nx;
            if (og + 1u == (tg + 1u) * nx) xb_add(&bar[XB_TOPGEN], 1u);
            else XB_SPIN(xb_ld(&bar[XB_TOPGEN]) == tg, bar);
            __builtin_amdgcn_fence(__ATOMIC_ACQUIRE, "agent");
            xb_add(&bar[XB_XGEN(b.x)], 1u);
            asm volatile("s_waitcnt vmcnt(0)" ::: "memory");
        } else {
            XB_SPIN(xb_ld(&bar[XB_XGEN(b.x)]) == gen, bar);
            __builtin_amdgcn_fence(__ATOMIC_ACQUIRE, "agent");
            asm volatile("s_waitcnt vmcnt(0)" ::: "memory");
        }
    }
    __syncthreads();
}

namespace pg8 {
constexpr int BM = 256, BK = 64, HALF = 128, HTB = HALF * BK * 2, STAGE_BYTES = 8 * HTB, NXCD = 8, WGM = 8;
__host__ __device__ __forceinline__ int lds_byte(int r, int c) { const int st = (r >> 4) * 2 + (c >> 5), rr = r & 15, cc = c & 31, ob = rr * 64 + cc * 2; return st * 1024 + (ob ^ (((ob >> 9) & 1) << 5)); }
__host__ __device__ __forceinline__ void stage_rc(int b, int& R, int& C) { const int st = b / 1024, sb = b % 1024, swz = sb ^ (((sb >> 9) & 1) << 5); R = (st >> 1) * 16 + swz / 64; C = (st & 1) * 32 + (swz % 64) / 2; }
__host__ __device__ __forceinline__ int perm32(int rho) { const int n = rho >> 4, i = rho & 15; return 8 * (i >> 2) + 4 * n + (i & 3); }
__device__ __forceinline__ unsigned cvt_pk_bf16(float lo, float hi) { unsigned r; asm volatile("v_cvt_pk_bf16_f32 %0, %1, %2" : "=v"(r) : "v"(lo), "v"(hi)); return r; }

struct Unit { int pm, pn, e, mt; };

struct DenseSched {
    const char* Bt; int K, nM, nN, nwg, G, c, row0;
    __device__ __forceinline__ void init(const bf16* Bt_, int K_, int M, int N, int G_, int c_, int row0_) { Bt = (const char*)Bt_; K = K_; nM = M / BM; nN = N / BM; nwg = nM * nN; G = G_; c = c_; row0 = row0_; }
    __device__ __forceinline__ bool next(int i, Unit& u) const {
        const long L = (long)i * G + c; if (L >= nwg) return false;
        int wgid = (int)L; { const int q = nwg / NXCD, r = nwg % NXCD, xcd = wgid % NXCD, off = wgid / NXCD; wgid = (xcd < r ? xcd * (q + 1) : r * (q + 1) + (xcd - r) * q) + off; }
        const int nig = WGM * nN, gid = wgid / nig, fm = gid * WGM, gsz = (nM - fm) < WGM ? (nM - fm) : WGM;
        u.pm = fm + ((wgid % nig) % gsz); u.pn = (wgid % nig) / gsz; u.e = 0; u.mt = 0; return true;
    }
    __device__ __forceinline__ const char* b_ptr(const Unit& u) const { return Bt + (size_t)u.pn * (size_t)(BM * 2) * K; }
    __device__ __forceinline__ void a_offsets(const Unit& u, const int (&R)[2], const int (&C)[2], unsigned (&v)[2][2]) const {
#pragma unroll
        for (int h = 0; h < 2; ++h)
#pragma unroll
            for (int i = 0; i < 2; ++i) v[h][i] = (unsigned)((row0 + u.pm * BM + h * HALF + R[i]) * K + C[i]) * 2u;
    }
};
template <bool GATHER, int NT>
struct MoeSched {
    const char* Bt; size_t bstride;
    int rb;
    const int* list;
    const LAS int* pre; const LAS int* mtl; const LAS int* rowoff; const LAS int* cnt;
    int K, G, c, total;
    __device__ __forceinline__ bool next(int i, Unit& u) const {
        const int L = i * G + c; if (L >= total) return false;
        int e = 0;
#pragma unroll 1
        for (int j = 1; j < NEXP; ++j) e = (L >= pre[j]) ? j : e;
        const int rem = L - pre[e];
        u.e = e; u.pn = rem % NT; u.mt = rem / NT; u.pm = 0; return true;
    }
    __device__ __forceinline__ const char* b_ptr(const Unit& u) const { return Bt + (size_t)u.e * bstride + (size_t)u.pn * (size_t)BM * rb; }
    __device__ __forceinline__ const char* a_ptr(const Unit& u, const char* Abase) const { return Abase + (size_t)(rowoff[u.e] + u.mt * BM) * rb; }
    __device__ __forceinline__ void a_offsets(const Unit& u, const int (&R)[2], const int (&C)[2], unsigned (&v)[2][2]) const {
        if (GATHER) {
            const int n = cnt[u.e]; const int* lp = list + (size_t)u.e * NTOK;
#pragma unroll
            for (int h = 0; h < 2; ++h)
#pragma unroll
                for (int i = 0; i < 2; ++i) { const int idx = u.mt * BM + h * HALF + R[i]; const int tok = idx < n ? lp[idx] : 0; v[h][i] = (unsigned)(tok * K + C[i]) * 2u; }
        } else {
            const int r0 = rowoff[u.e] + u.mt * BM;
#pragma unroll
            for (int h = 0; h < 2; ++h)
#pragma unroll
                for (int i = 0; i < 2; ++i) v[h][i] = (unsigned)((r0 + h * HALF + R[i]) * K + C[i]) * 2u;
        }
    }
};

struct EpiBf16 {
    static constexpr bool PERM = true;
    bf16* O; int ldc; int row0;
    __device__ __forceinline__ void operator()(const f32x4 (&acc)[2][2][4][2], const Unit& u, int wr, int wc, int fr, int fq) const {
        const int r0 = row0 + u.pm * BM + wr * 64 + fr, col0 = u.pn * BM + wc * 32 + 8 * fq;
#pragma unroll
        for (int ai = 0; ai < 2; ++ai)
#pragma unroll
            for (int m = 0; m < 4; ++m) { bf16* rowp = O + (size_t)(r0 + ai * HALF + m * 16) * ldc + col0;
#pragma unroll
                for (int bj = 0; bj < 2; ++bj) { const f32x4 v0 = acc[ai][bj][m][0], v1 = acc[ai][bj][m][1];
                    u32x4 w; w.x = cvt_pk_bf16(v0[0], v0[1]); w.y = cvt_pk_bf16(v0[2], v0[3]); w.z = cvt_pk_bf16(v1[0], v1[1]); w.w = cvt_pk_bf16(v1[2], v1[3]);
                    *(u32x4*)(rowp + bj * HALF) = w; } }
    }
};
struct EpiF32 {
    static constexpr bool PERM = false;
    float* Cc; int ldc; int row0;
    __device__ __forceinline__ void operator()(const f32x4 (&acc)[2][2][4][2], const Unit& u, int wr, int wc, int fr, int fq) const {
        const int r0 = row0 + u.pm * BM + wr * 64 + fr, col0 = u.pn * BM + wc * 32 + 4 * fq;
#pragma unroll
        for (int ai = 0; ai < 2; ++ai)
#pragma unroll
            for (int m = 0; m < 4; ++m) { float* rowp = Cc + (size_t)(r0 + ai * HALF + m * 16) * ldc + col0;
#pragma unroll
                for (int bj = 0; bj < 2; ++bj)
#pragma unroll
                    for (int n = 0; n < 2; ++n) *(f32x4*)(rowp + bj * HALF + n * 16) = acc[ai][bj][m][n]; }
    }
};
struct EpiSwiglu {
    static constexpr bool PERM = true;
    bf16* H; const float* bg; const float* bu; const LAS int* rowoff;
    __device__ __forceinline__ void operator()(const f32x4 (&acc)[2][2][4][2], const Unit& u, int wr, int wc, int fr, int fq) const {
        const int r0 = rowoff[u.e] + u.mt * BM + wr * 64 + fr, j0 = u.pn * HALF + wc * 32 + 8 * fq;
        f32x4 gb[2], ub[2];
#pragma unroll
        for (int n = 0; n < 2; ++n) { gb[n] = *(const f32x4*)(bg + u.e * 1024 + j0 + 4 * n); ub[n] = *(const f32x4*)(bu + u.e * 1024 + j0 + 4 * n); }
#pragma unroll
        for (int ai = 0; ai < 2; ++ai)
#pragma unroll
            for (int m = 0; m < 4; ++m) { unsigned char* rowp = (unsigned char*)H + (size_t)(r0 + ai * HALF + m * 16) * 1024 + j0; float hv[8];
#pragma unroll
                for (int n = 0; n < 2; ++n)
#pragma unroll
                    for (int j = 0; j < 4; ++j) { float g = acc[ai][0][m][n][j] + gb[n][j], up = acc[ai][1][m][n][j] + ub[n][j];
                        g = fminf(g, 7.f); up = fminf(fmaxf(up, -7.f), 7.f);
                        hv[n * 4 + j] = (up + 1.f) * g * __builtin_amdgcn_rcpf(1.f + __expf(-1.702f * g)); }
                *(u32x2*)rowp = (u32x2){pk4_fp8(hv[0], hv[1], hv[2], hv[3]), pk4_fp8(hv[4], hv[5], hv[6], hv[7])}; }
    }
};
struct EpiDown {
    static constexpr bool PERM = true;
    bf16* Y; const float* bd; const LAS int* rowoff; float ws;
    __device__ __forceinline__ void operator()(const f32x4 (&acc)[2][2][4][2], const Unit& u, int wr, int wc, int fr, int fq) const {
        const int r0 = rowoff[u.e] + u.mt * BM + wr * 64 + fr, col0 = u.pn * BM + wc * 32 + 8 * fq;
        f32x4 bv[2][2];
#pragma unroll
        for (int bj = 0; bj < 2; ++bj)
#pragma unroll
            for (int n = 0; n < 2; ++n) bv[bj][n] = *(const f32x4*)(bd + u.e * 1024 + col0 + bj * HALF + 4 * n);
#pragma unroll
        for (int ai = 0; ai < 2; ++ai)
#pragma unroll
            for (int m = 0; m < 4; ++m) { bf16* rowp = Y + (size_t)(r0 + ai * HALF + m * 16) * 1024 + col0;
#pragma unroll
                for (int bj = 0; bj < 2; ++bj) { const f32x4 v0 = acc[ai][bj][m][0] * ws + bv[bj][0], v1 = acc[ai][bj][m][1] * ws + bv[bj][1];
                    u32x4 w; w.x = cvt_pk_bf16(v0[0], v0[1]); w.y = cvt_pk_bf16(v0[2], v0[3]); w.z = cvt_pk_bf16(v1[0], v1[1]); w.w = cvt_pk_bf16(v1[2], v1[3]);
                    *(u32x4*)(rowp + bj * HALF) = w; } }
    }
};

template <class Epi, class Sched, bool ALIGN_EPI>
__device__ __forceinline__ void gemm_phase(LAS unsigned char* lds, const char* Abase, const int K, const Sched& S, const Epi& E) {
    const int tid = tidx(), wid = __builtin_amdgcn_readfirstlane(tid >> 6), lane = tid & 63, wr = wid >> 2, wc = wid & 3, fr = lane & 15, fq = lane >> 4;
    const int nt = K / BK;
    int Rp[2], Cp[2]; unsigned voffB0;
#pragma unroll
    for (int i = 0; i < 2; ++i) stage_rc(tid * 16 + i * 8192, Rp[i], Cp[i]);
    { const int Rb = Epi::PERM ? ((Rp[0] & ~31) + perm32(Rp[0] & 31)) : Rp[0]; voffB0 = (unsigned)(Rb * K + Cp[0]) * 2u; }
    const size_t kstep = (size_t)(BK * 2);
    const size_t hstep = (size_t)HALF * K * 2;
    const unsigned ldsw = (unsigned)wid * 1024u;
    const int aoff = lds_byte(wr * 64 + fr, fq * 8), boff = lds_byte(wc * 32 + fr, fq * 8);
#define PG8_SA(b, h) (((b) * 2 + (h)) * HTB)
#define PG8_SB(b, h) ((4 + (b) * 2 + (h)) * HTB)
#define PG8_STAGE(bufoff, gbase, voff) do { _Pragma("unroll") for (int _i = 0; _i < 2; ++_i) \
        __builtin_amdgcn_global_load_lds((const unsigned*)((const char*)(gbase) + (voff)[_i]), (LAS unsigned*)(lds + (bufoff) + ldsw + _i * 8192), 16, 0, 0); } while (0)
#define PG8_STAGEB(bufoff, gbase) do { _Pragma("unroll") for (int _i = 0; _i < 2; ++_i) \
        __builtin_amdgcn_global_load_lds((const unsigned*)((const char*)(gbase) + (size_t)_i * 128 * K + voffB0), (LAS unsigned*)(lds + (bufoff) + ldsw + _i * 8192), 16, 0, 0); } while (0)
#define PG8_LDA(dst, b, h) do { _Pragma("unroll") for (int m = 0; m < 4; ++m) _Pragma("unroll") for (int k = 0; k < 2; ++k) dst[m][k] = *(const LAS bf16x8*)(lds + PG8_SA(b, h) + aoff + m * 2048 + k * 1024); } while (0)
#define PG8_LDB(dst, b, h) do { _Pragma("unroll") for (int n = 0; n < 2; ++n) _Pragma("unroll") for (int k = 0; k < 2; ++k) dst[n][k] = *(const LAS bf16x8*)(lds + PG8_SB(b, h) + boff + n * 2048 + k * 1024); } while (0)
#define PG8_MMA(ai, bj, At, Bt) do { __builtin_amdgcn_s_setprio(1); _Pragma("unroll") for (int m = 0; m < 4; ++m) _Pragma("unroll") for (int n = 0; n < 2; ++n) _Pragma("unroll") for (int k = 0; k < 2; ++k) \
        acc[ai][bj][m][n] = __builtin_amdgcn_mfma_f32_16x16x32_bf16(Bt[n][k], At[m][k], acc[ai][bj][m][n], 0, 0, 0); __builtin_amdgcn_s_setprio(0); } while (0)
#define PG8_WAIT_V(n) asm volatile("s_waitcnt vmcnt(" #n ")" ::: "memory")
#define PG8_WAIT_L(n) asm volatile("s_waitcnt lgkmcnt(" #n ")" ::: "memory")
#define PG8_BAR __builtin_amdgcn_s_barrier()
#define PG8_SCHED __builtin_amdgcn_sched_barrier(0)
    Unit cur, nxt; int ui = 0;
    if (!S.next(0, cur)) return;
    f32x4 acc[2][2][4][2];
#pragma unroll
    for (int a = 0; a < 2; ++a)
#pragma unroll
        for (int b = 0; b < 2; ++b)
#pragma unroll
            for (int m = 0; m < 4; ++m)
#pragma unroll
                for (int n = 0; n < 2; ++n) acc[a][b][m][n] = (f32x4){0.f, 0.f, 0.f, 0.f};
    bf16x8 At[4][2], B0[2][2], B1[2][2];
    unsigned vAc[2][2], vAn[2][2];
    S.a_offsets(cur, Rp, Cp, vAc);
    const char* cB = S.b_ptr(cur);
    PG8_STAGEB(PG8_SB(0, 0), cB); PG8_STAGEB(PG8_SB(0, 1), cB + hstep); PG8_STAGE(PG8_SA(0, 0), Abase, vAc[0]); PG8_STAGE(PG8_SA(0, 1), Abase, vAc[1]);
    if (wr == 1) PG8_BAR;
    PG8_WAIT_V(2); PG8_BAR;
    PG8_STAGEB(PG8_SB(1, 0), cB + kstep); PG8_STAGE(PG8_SA(1, 0), Abase + kstep, vAc[0]); PG8_STAGEB(PG8_SB(1, 1), cB + hstep + kstep);
    PG8_WAIT_V(6); PG8_BAR;
    for (;;) {
        const bool has_next = S.next(ui + 1, nxt);
        const char* nB = has_next ? S.b_ptr(nxt) : cB;
        if (has_next) S.a_offsets(nxt, Rp, Cp, vAn);
        else {
#pragma unroll
            for (int h = 0; h < 2; ++h)
#pragma unroll
                for (int i = 0; i < 2; ++i) vAn[h][i] = vAc[h][i]; }
        for (int t = 0; t < nt; t += 2) {
            const bool last = (t == nt - 2);
            const char* a1 = Abase + (size_t)(t + 1) * kstep;
            const char* a2 = last ? Abase : Abase + (size_t)(t + 2) * kstep; const char* b2 = last ? nB : cB + (size_t)(t + 2) * kstep;
            const char* a3 = a2 + kstep; const char* b3 = b2 + kstep;
            unsigned v2[2][2];
#pragma unroll
            for (int h = 0; h < 2; ++h)
#pragma unroll
                for (int i = 0; i < 2; ++i) v2[h][i] = last ? vAn[h][i] : vAc[h][i];
            PG8_LDB(B0, 0, 0); PG8_LDB(B1, 0, 1); PG8_SCHED; PG8_LDA(At, 0, 0); PG8_STAGE(PG8_SA(1, 1), a1, vAc[1]);
            PG8_WAIT_V(8); PG8_WAIT_L(0); PG8_BAR; PG8_MMA(0, 0, At, B0); PG8_MMA(0, 1, At, B1); PG8_BAR; PG8_SCHED;
            PG8_LDA(At, 0, 1); PG8_STAGEB(PG8_SB(0, 0), b2); PG8_STAGEB(PG8_SB(0, 1), b2 + hstep); PG8_STAGE(PG8_SA(0, 0), a2, v2[0]);
            PG8_WAIT_V(8); PG8_WAIT_L(0); PG8_BAR; PG8_MMA(1, 0, At, B0); PG8_MMA(1, 1, At, B1); PG8_BAR; PG8_SCHED;
            PG8_LDB(B0, 1, 0); PG8_LDB(B1, 1, 1); PG8_SCHED; PG8_LDA(At, 1, 0); PG8_STAGE(PG8_SA(0, 1), a2, v2[1]);
            PG8_WAIT_V(8); PG8_WAIT_L(0); PG8_BAR; PG8_MMA(0, 0, At, B0); PG8_MMA(0, 1, At, B1); PG8_BAR; PG8_SCHED;
            PG8_LDA(At, 1, 1); PG8_STAGEB(PG8_SB(1, 0), b3); PG8_STAGEB(PG8_SB(1, 1), b3 + hstep); PG8_STAGE(PG8_SA(1, 0), a3, v2[0]);
            PG8_WAIT_V(8); PG8_WAIT_L(0); PG8_BAR; PG8_MMA(1, 0, At, B0); PG8_MMA(1, 1, At, B1); PG8_BAR; PG8_SCHED;
        }
        if constexpr (ALIGN_EPI) { if (wr == 0) PG8_BAR; }
        E(acc, cur, wr, wc, fr, fq);
        if (!has_next) break;
#pragma unroll
        for (int a = 0; a < 2; ++a)
#pragma unroll
            for (int b = 0; b < 2; ++b)
#pragma unroll
                for (int m = 0; m < 4; ++m)
#pragma unroll
                    for (int n = 0; n < 2; ++n) acc[a][b][m][n] = (f32x4){0.f, 0.f, 0.f, 0.f};
        cur = nxt; cB = nB; ++ui;
#pragma unroll
        for (int h = 0; h < 2; ++h)
#pragma unroll
            for (int i = 0; i < 2; ++i) vAc[h][i] = vAn[h][i];
        if constexpr (ALIGN_EPI) { if (wr == 1) PG8_BAR; }
    }
    PG8_WAIT_V(0);
    if constexpr (!ALIGN_EPI) { if (wr == 0) PG8_BAR; }
    PG8_BAR;
#undef PG8_SA
#undef PG8_SB
#undef PG8_STAGE
#undef PG8_STAGEB
#undef PG8_LDA
#undef PG8_LDB
#undef PG8_MMA
#undef PG8_WAIT_V
#undef PG8_WAIT_L
#undef PG8_BAR
#undef PG8_SCHED
}
template <class Epi, class Sched, bool ALIGN_EPI>
__device__ __forceinline__ void gemm_phase_f8(LAS unsigned char* lds, const char* Abase, const int K, const Sched& S, const Epi& E) {
    const int tid = tidx(), wid = __builtin_amdgcn_readfirstlane(tid >> 6), lane = tid & 63, wr = wid >> 2, wc = wid & 3, fr = lane & 15, fq = lane >> 4;
    const int nt = K / 128;
    int Rp[1], Cp[1]; unsigned voffB[1], voffA[1];
#pragma unroll
    for (int i = 0; i < 1; ++i) { stage_rc(tid * 16 + i * 8192, Rp[i], Cp[i]); const int Rb = Epi::PERM ? ((Rp[i] & ~31) + perm32(Rp[i] & 31)) : Rp[i]; voffB[i] = (unsigned)(Rb * K + 2 * Cp[i]); voffA[i] = (unsigned)(Rp[i] * K + 2 * Cp[i]); }
    const size_t kstep = (size_t)(BK * 2);
    const size_t hstep = (size_t)HALF * K;
    const unsigned ldsw = (unsigned)wid * 1024u;
    const int aoff0 = lds_byte(wr * 64 + fr, 16 * (fq & 1)) + (fq >> 1) * 1024, boff0 = lds_byte(wc * 32 + fr, 16 * (fq & 1)) + (fq >> 1) * 1024;
#define PG8_SA(b, h) (((b) * 2 + (h)) * HTB)
#define PG8_SB(b, h) ((4 + (b) * 2 + (h)) * HTB)
#define PG8_STAGE(bufoff, gbase, voff) do { _Pragma("unroll") for (int _i = 0; _i < 2; ++_i) \
        __builtin_amdgcn_global_load_lds((const unsigned*)((const char*)(gbase) + (size_t)_i * 64 * K + (voff)[0]), (LAS unsigned*)(lds + (bufoff) + ldsw + _i * 8192), 16, 0, 0); } while (0)
#define PG8_LDA(dst, b, h) do { _Pragma("unroll") for (int m = 0; m < 4; ++m) { const u32x4 lo_ = *(const LAS u32x4*)(lds + PG8_SA(b, h) + aoff0 + m * 2048), hi_ = *(const LAS u32x4*)(lds + PG8_SA(b, h) + aoff0 + 16 + m * 2048); \
        dst[m] = (v8i){(int)lo_.x, (int)lo_.y, (int)lo_.z, (int)lo_.w, (int)hi_.x, (int)hi_.y, (int)hi_.z, (int)hi_.w}; } } while (0)
#define PG8_LDB(dst, b, h) do { _Pragma("unroll") for (int n = 0; n < 2; ++n) { const u32x4 lo_ = *(const LAS u32x4*)(lds + PG8_SB(b, h) + boff0 + n * 2048), hi_ = *(const LAS u32x4*)(lds + PG8_SB(b, h) + boff0 + 16 + n * 2048); \
        dst[n] = (v8i){(int)lo_.x, (int)lo_.y, (int)lo_.z, (int)lo_.w, (int)hi_.x, (int)hi_.y, (int)hi_.z, (int)hi_.w}; } } while (0)
#define PG8_MMA(ai, bj, At, Bt) do { __builtin_amdgcn_s_setprio(1); _Pragma("unroll") for (int m = 0; m < 4; ++m) _Pragma("unroll") for (int n = 0; n < 2; ++n) \
        asm volatile("v_mfma_scale_f32_16x16x128_f8f6f4 %0, %1, %2, %0, %3, %3 op_sel_hi:[0,0,0]" : "+v"(acc[ai][bj][m][n]) : "v"(Bt[n]), "v"(At[m]), "v"(f8scale)); __builtin_amdgcn_s_setprio(0); } while (0)
#define PG8_WAIT_V(n) asm volatile("s_waitcnt vmcnt(" #n ")" ::: "memory")
#define PG8_WAIT_L(n) asm volatile("s_waitcnt lgkmcnt(" #n ")" ::: "memory")
#define PG8_BAR __builtin_amdgcn_s_barrier()
#define PG8_SCHED __builtin_amdgcn_sched_barrier(0)
    Unit cur, nxt; int ui = 0;
    if (!S.next(0, cur)) return;
    f32x4 acc[2][2][4][2];
#pragma unroll
    for (int a = 0; a < 2; ++a)
#pragma unroll
        for (int b = 0; b < 2; ++b)
#pragma unroll
            for (int m = 0; m < 4; ++m)
#pragma unroll
                for (int n = 0; n < 2; ++n) acc[a][b][m][n] = (f32x4){0.f, 0.f, 0.f, 0.f};
    typedef int v8i __attribute__((ext_vector_type(8)));
    v8i At[4], B0[2], B1[2];
    const int f8scale = 0x7f7f7f7f;
    const char* cA = S.a_ptr(cur, Abase);
    const char* cB = S.b_ptr(cur);
    PG8_STAGE(PG8_SB(0, 0), cB, voffB); PG8_STAGE(PG8_SB(0, 1), cB + hstep, voffB); PG8_STAGE(PG8_SA(0, 0), cA, voffA); PG8_STAGE(PG8_SA(0, 1), cA + hstep, voffA);
    if (wr == 1) PG8_BAR;
    PG8_WAIT_V(2); PG8_BAR;
    PG8_STAGE(PG8_SB(1, 0), cB + kstep, voffB); PG8_STAGE(PG8_SA(1, 0), cA + kstep, voffA); PG8_STAGE(PG8_SB(1, 1), cB + hstep + kstep, voffB);
    PG8_WAIT_V(6); PG8_BAR;
    for (;;) {
        const bool has_next = S.next(ui + 1, nxt);
        const char* nB = has_next ? S.b_ptr(nxt) : cB; const char* nA = has_next ? S.a_ptr(nxt, Abase) : cA;
#pragma unroll 1
        for (int t = 0; t < nt; t += 2) {
            const bool last = (t == nt - 2);
            const char* a1 = cA + (size_t)(t + 1) * kstep;
            const char* a2 = last ? nA : cA + (size_t)(t + 2) * kstep; const char* b2 = last ? nB : cB + (size_t)(t + 2) * kstep;
            const char* a3 = a2 + kstep; const char* b3 = b2 + kstep;
            PG8_LDB(B0, 0, 0); PG8_LDB(B1, 0, 1); PG8_SCHED; PG8_LDA(At, 0, 0); PG8_STAGE(PG8_SA(1, 1), a1 + hstep, voffA);
            PG8_WAIT_V(8); PG8_WAIT_L(0); PG8_BAR; PG8_MMA(0, 0, At, B0); PG8_MMA(0, 1, At, B1); PG8_BAR; PG8_SCHED;
            PG8_LDA(At, 0, 1); PG8_STAGE(PG8_SB(0, 0), b2, voffB); PG8_STAGE(PG8_SB(0, 1), b2 + hstep, voffB); PG8_STAGE(PG8_SA(0, 0), a2, voffA);
            PG8_WAIT_V(8); PG8_WAIT_L(0); PG8_BAR; PG8_MMA(1, 0, At, B0); PG8_MMA(1, 1, At, B1); PG8_BAR; PG8_SCHED;
            PG8_LDB(B0, 1, 0); PG8_LDB(B1, 1, 1); PG8_SCHED; PG8_LDA(At, 1, 0); PG8_STAGE(PG8_SA(0, 1), a2 + hstep, voffA);
            PG8_WAIT_V(8); PG8_WAIT_L(0); PG8_BAR; PG8_MMA(0, 0, At, B0); PG8_MMA(0, 1, At, B1); PG8_BAR; PG8_SCHED;
            PG8_LDA(At, 1, 1); PG8_STAGE(PG8_SB(1, 0), b3, voffB); PG8_STAGE(PG8_SB(1, 1), b3 + hstep, voffB); PG8_STAGE(PG8_SA(1, 0), a3, voffA);
            PG8_WAIT_V(8); PG8_WAIT_L(0); PG8_BAR; PG8_MMA(1, 0, At, B0); PG8_MMA(1, 1, At, B1); PG8_BAR; PG8_SCHED;
        }
        if constexpr (ALIGN_EPI) { if (wr == 0) PG8_BAR; }
        E(acc, cur, wr, wc, fr, fq);
        if (!has_next) break;
#pragma unroll
        for (int a = 0; a < 2; ++a)
#pragma unroll
            for (int b = 0; b < 2; ++b)
#pragma unroll
                for (int m = 0; m < 4; ++m)
#pragma unroll
                    for (int n = 0; n < 2; ++n) acc[a][b][m][n] = (f32x4){0.f, 0.f, 0.f, 0.f};
        cur = nxt; cB = nB; cA = nA; ++ui;
        if constexpr (ALIGN_EPI) { if (wr == 1) PG8_BAR; }
    }
    PG8_WAIT_V(0);
    if constexpr (!ALIGN_EPI) { if (wr == 0) PG8_BAR; }
    PG8_BAR;
#undef PG8_SA
#undef PG8_SB
#undef PG8_STAGE
#undef PG8_LDA
#undef PG8_LDB
#undef PG8_MMA
#undef PG8_WAIT_V
#undef PG8_WAIT_L
#undef PG8_BAR
#undef PG8_SCHED
}
}

struct Args { const float* in[39]; float* out; unsigned char* ws; int ph_lo, ph_hi; };
typedef const __attribute__((address_space(4))) Args CArgs;
enum { I_X = 0, I_C, I_CTX, I_CCTX, I_WADA, I_BADA, I_WIN, I_HYCW, I_HYCB, I_HYW1, I_HYB1, I_HYW2, I_HYB2, I_HYW3, I_HYB3, I_HYW4, I_HYFREQ, I_HYD, I_SCCW,
       I_GLAWA, I_GLABA, I_GLANW, I_GDNCW, I_GDNALOG, I_GDNDT, I_GDNNW, I_WOUT, I_LN1G, I_LN1B, I_WR, I_BR, I_WG, I_BG, I_WU, I_BU, I_WD, I_BD, I_LN2G, I_LN2B };

__device__ __forceinline__ int row_batch(int row) { return row < NTOK_C ? (row >> 8) : ((row - NTOK_C) >> 11); }
__device__ __forceinline__ int mod_vec(int row) { return row < NTOK_C ? 16 : ((row - NTOK_C) >> 11); }

__device__ __forceinline__ void ph_mod(CArgs& a, LAS unsigned char* lds, int bid, int nblk) {
    LAS float* sc = (LAS float*)lds; LAS float* red = (LAS float*)(lds + 17 * 1024 * 4);
    const int tid = tidx(), lane = tid & 63, w = tid >> 6;
    const float* c = a.in[I_C]; const float* cc = a.in[I_CCTX];
    for (int i = tid; i < 17 * 1024; i += 512) { const float v = i < 16 * 1024 ? c[i] : cc[i - 16 * 1024]; sc[i] = siluf_(v); }
    __syncthreads();
    float* MOD = (float*)(a.ws + WS_MOD);
    for (int it = bid; it < DEPTH * 96; it += nblk) {
        const int l = it / 96, j0 = (it % 96) * 64;
        const float* W = a.in[I_WADA] + (size_t)l * 1024 * 6144 + j0 + lane;
        float acc[17];
#pragma unroll
        for (int v = 0; v < 17; ++v) acc[v] = 0.f;
#pragma unroll 16
        for (int kk = 0; kk < 128; ++kk) { const int k = w * 128 + kk; const float wv = W[(size_t)k * 6144];
#pragma unroll
            for (int v = 0; v < 17; ++v) acc[v] += sc[v * 1024 + k] * wv; }
#pragma unroll
        for (int v = 0; v < 17; ++v) red[(w * 17 + v) * 64 + lane] = acc[v];
        __syncthreads();
        for (int o = tid; o < 17 * 64; o += 512) { const int v = o >> 6, jj = o & 63; float s = 0.f;
#pragma unroll
            for (int ww = 0; ww < 8; ++ww) s += red[(ww * 17 + v) * 64 + jj];
            MOD[(size_t)(l * 17 + v) * 6144 + j0 + jj] = s + a.in[I_BADA][l * 6144 + j0 + jj]; }
        __syncthreads();
    }
}

__device__ __forceinline__ void ph_filters(CArgs& a, int gw, int ngw) {
    const int lane = tidx() & 63;
    float* KUN = (float*)(a.ws + WS_KUN);
#pragma unroll 1
    for (int it = gw; it < DEPTH * (CTXL + SEQ) / 4; it += ngw) {
        const int l = it / ((CTXL + SEQ) / 4), r = (it % ((CTXL + SEQ) / 4)) * 4, Lt = r < CTXL ? 0 : 1, pos0 = Lt ? r - CTXL : r, L = Lt ? SEQ : CTXL;
        float z[4], tn[4];
#pragma unroll
        for (int p = 0; p < 4; ++p) { const int pos = pos0 + p; tn[p] = (float)pos / (float)(L - 1); z[p] = 0.f;
            if (lane == 0) z[p] = tn[p];
            else if (lane <= 32) { const int j = (lane - 1) & 15; const float fj = 1e-4f + (float)j * ((15.f - 1e-4f) / 15.f);
                double rev = (double)fj * (double)pos / (double)L; rev -= floor(rev); const float rf = (float)rev;
                z[p] = lane <= 16 ? sin_rev(rf + 0.25f) : -sin_rev(rf); } }
        const float* w1 = a.in[I_HYW1] + l * 33 * 64; const float* w2 = a.in[I_HYW2] + l * 64 * 64; const float* w3 = a.in[I_HYW3] + l * 64 * 64; const float* w4 = a.in[I_HYW4] + l * 64 * 512;
        const float* fq = a.in[I_HYFREQ] + l * 3 * 64;
        float s[4], h[4];
        { const float bb = a.in[I_HYB1][l * 64 + lane];
#pragma unroll
          for (int p = 0; p < 4; ++p) s[p] = bb; }
#pragma unroll
        for (int i = 0; i < 33; ++i) { const float ww = w1[i * 64 + lane];
#pragma unroll
            for (int p = 0; p < 4; ++p) s[p] += rdlane_f(z[p], i) * ww; }
#pragma unroll
        for (int p = 0; p < 4; ++p) h[p] = sin_rad(fq[lane] * s[p]);
        { const float bb = a.in[I_HYB2][l * 64 + lane];
#pragma unroll
          for (int p = 0; p < 4; ++p) s[p] = bb; }
#pragma unroll 16
        for (int i = 0; i < 64; ++i) { const float ww = w2[i * 64 + lane];
#pragma unroll
            for (int p = 0; p < 4; ++p) s[p] += rdlane_f(h[p], i) * ww; }
#pragma unroll
        for (int p = 0; p < 4; ++p) h[p] = sin_rad(fq[64 + lane] * s[p]);
        { const float bb = a.in[I_HYB3][l * 64 + lane];
#pragma unroll
          for (int p = 0; p < 4; ++p) s[p] = bb; }
#pragma unroll 16
        for (int i = 0; i < 64; ++i) { const float ww = w3[i * 64 + lane];
#pragma unroll
            for (int p = 0; p < 4; ++p) s[p] += rdlane_f(h[p], i) * ww; }
#pragma unroll
        for (int p = 0; p < 4; ++p) h[p] = sin_rad(fq[128 + lane] * s[p]);
        float k[8][4];
#pragma unroll
        for (int m = 0; m < 8; ++m)
#pragma unroll
            for (int p = 0; p < 4; ++p) k[m][p] = 0.f;
#pragma unroll 4
        for (int i = 0; i < 64; ++i) { float hi[4];
#pragma unroll
            for (int p = 0; p < 4; ++p) hi[p] = rdlane_f(h[p], i);
#pragma unroll
            for (int m = 0; m < 8; ++m) { const float ww = w4[i * 512 + m * 64 + lane];
#pragma unroll
                for (int p = 0; p < 4; ++p) k[m][p] += hi[p] * ww; } }
#pragma unroll
        for (int m = 0; m < 8; ++m) { const int o = m * 64 + lane, ch = o & 255;
            const float delta = 3.0701134573253944f + (float)ch * ((15.350567286626972f - 3.0701134573253944f) / 255.f);
            *(f32x4*)(KUN + ((size_t)((l * 2 + Lt) * 512 + o)) * 2048 + pos0) = (f32x4){k[m][0] * __expf(-tn[0] * delta), k[m][1] * __expf(-tn[1] * delta), k[m][2] * __expf(-tn[2] * delta), k[m][3] * __expf(-tn[3] * delta)}; }
    }
}

__device__ __forceinline__ void ph_router_w(CArgs& a, int gt, int ngt) {
    bf16* hi = (bf16*)(a.ws + WS_WRT); bf16* lo = hi + DEPTH * NEXP * D;
    for (int i = gt; i < DEPTH * NEXP * D; i += ngt) { const int l = i / (NEXP * D), r = i % (NEXP * D), e = r / D, k = r % D;
        const float w = a.in[I_WR][((size_t)l * D + k) * NEXP + e]; const unsigned h = f2bf(w); hi[i] = (bf16)h; lo[i] = (bf16)f2bf(w - bf2f(h)); }
}
__device__ __forceinline__ void tr_item(const float* W, int Nsrc, int K, bf16* WTrow0, int n0, int k0, LAS float* scr, int lane) {
    const int c4 = (lane & 7) * 4; const bool ok = n0 + c4 < Nsrc;
    f32x4 t[8];
#pragma unroll
    for (int j = 0; j < 8; ++j) { const int kk = 8 * j + (lane >> 3); t[j] = ok ? *(const f32x4*)(W + (size_t)(k0 + kk) * Nsrc + n0 + c4) : (f32x4){0.f, 0.f, 0.f, 0.f}; }
#pragma unroll
    for (int j = 0; j < 8; ++j) { const int kk = 8 * j + (lane >> 3); LAS float* d = scr + kk * 33 + c4; d[0] = t[j][0]; d[1] = t[j][1]; d[2] = t[j][2]; d[3] = t[j][3]; }
    asm volatile("s_waitcnt lgkmcnt(0)" ::: "memory");
    const int c = lane & 7;
#pragma unroll
    for (int j = 0; j < 4; ++j) { const int n = (lane >> 3) + 8 * j; const LAS float* s = scr + (8 * c) * 33 + n;
        u32x4 o; o.x = pk2(s[0 * 33], s[1 * 33]); o.y = pk2(s[2 * 33], s[3 * 33]); o.z = pk2(s[4 * 33], s[5 * 33]); o.w = pk2(s[6 * 33], s[7 * 33]);
        *(u32x4*)(WTrow0 + (size_t)n * K + k0 + 8 * c) = o; }
    asm volatile("s_waitcnt lgkmcnt(0)" ::: "memory");
}
__device__ __forceinline__ void tr_item_f8(const float* W, int Nsrc, int K, unsigned char* WTrow0, int n0, int k0, float scale, LAS float* scr, int lane) {
    const int c4 = (lane & 7) * 4;
    f32x4 t[8];
#pragma unroll
    for (int j = 0; j < 8; ++j) { const int kk = 8 * j + (lane >> 3); t[j] = *(const f32x4*)(W + (size_t)(k0 + kk) * Nsrc + n0 + c4); }
#pragma unroll
    for (int j = 0; j < 8; ++j) { const int kk = 8 * j + (lane >> 3); LAS float* d = scr + kk * 33 + c4; d[0] = t[j][0]; d[1] = t[j][1]; d[2] = t[j][2]; d[3] = t[j][3]; }
    asm volatile("s_waitcnt lgkmcnt(0)" ::: "memory");
    const int n = lane >> 1, half = lane & 1; const LAS float* s = scr + (32 * half) * 33 + n;
    unsigned o[8];
#pragma unroll
    for (int i = 0; i < 8; ++i) o[i] = pk4_fp8(s[(4 * i) * 33] * scale, s[(4 * i + 1) * 33] * scale, s[(4 * i + 2) * 33] * scale, s[(4 * i + 3) * 33] * scale);
    unsigned char* dst = WTrow0 + (size_t)n * K + k0 + 32 * half;
    *(u32x4*)dst = (u32x4){o[0], o[1], o[2], o[3]}; *(u32x4*)(dst + 16) = (u32x4){o[4], o[5], o[6], o[7]};
    asm volatile("s_waitcnt lgkmcnt(0)" ::: "memory");
}
__device__ __forceinline__ void ph_tr_small(CArgs& a, LAS unsigned char* lds, int gw, int ngw) {
    const int lane = tidx() & 63, w = tidx() >> 6;
    LAS float* scr = (LAS float*)(lds + w * 8448);
    constexpr int I_IN = 16 * (D_INP / 32), I_OUT = 16 * 32;
    for (int it = gw; it < DEPTH * (I_IN + I_OUT); it += ngw) {
        const int l = it / (I_IN + I_OUT); int r = it % (I_IN + I_OUT);
        if (r < I_IN) { const int kb = r / (D_INP / 32), nb = r % (D_INP / 32);
            tr_item(a.in[I_WIN] + (size_t)l * 1024 * D_IN, D_IN, 1024, (bf16*)(a.ws + WS_WIN) + ((size_t)l * D_INP + nb * 32) * 1024, nb * 32, kb * 64, scr, lane); }
        else { r -= I_IN; const int kb = r / 32, nb = r % 32;
            tr_item(a.in[I_WOUT] + (size_t)l * 1024 * 1024, 1024, 1024, (bf16*)(a.ws + WS_WOUT) + ((size_t)l * 1024 + nb * 32) * 1024, nb * 32, kb * 64, scr, lane); }
    }
}
__device__ __forceinline__ void tr_experts_waves(CArgs& a, int l, LAS unsigned char* scrb, int gw, int ngw, int lane) {
    LAS float* scr = (LAS float*)scrb;
#pragma unroll 1
    for (int it = gw; it < NEXP * 3 * 512; it += ngw) {
        const int e = it / 1536, r = it % 1536, which = r / 512, q = r % 512, kb = q / 32, nb = q % 32, n0 = nb * 32;
        const float* W = a.in[which == 0 ? I_WG : (which == 1 ? I_WU : I_WD)] + ((size_t)(l * NEXP + e)) * 1024 * 1024;
        if (which == 2) tr_item_f8(W, 1024, 1024, a.ws + WS_WD + ((size_t)e * 1024 + n0) * 1024, n0, kb * 64, 32.f, scr, lane);
        else tr_item(W, 1024, 1024, (bf16*)(a.ws + WS_WGU) + ((size_t)e * 2048 + (n0 >> 7) * 256 + which * 128 + (n0 & 127)) * 1024, n0, kb * 64, scr, lane);
    }
}
__device__ __forceinline__ void ph_mod_input(CArgs& a, int gw, int ngw) {
    const int lane = tidx() & 63;
    const float* MOD = (const float*)(a.ws + WS_MOD);
    bf16* HB = (bf16*)(a.ws + WS_HB);
    for (int row = gw; row < NTOK; row += ngw) {
        const float* src = row < NTOK_C ? a.in[I_CTX] + (size_t)row * D : a.in[I_X] + (size_t)(row - NTOK_C) * D;
        const float* mv = MOD + (size_t)mod_vec(row) * 6144;
#pragma unroll
        for (int j = 0; j < 4; ++j) { const int c0 = j * 256 + lane * 4; const f32x4 x = *(const f32x4*)(src + c0), sh = *(const f32x4*)(mv + c0), sc = *(const f32x4*)(mv + 1024 + c0);
            u32x2 o; o.x = pk2(x[0] * (1.f + sc[0]) + sh[0], x[1] * (1.f + sc[1]) + sh[1]); o.y = pk2(x[2] * (1.f + sc[2]) + sh[2], x[3] * (1.f + sc[3]) + sh[3]);
            *(u32x2*)(HB + (size_t)row * D + c0) = o; }
    }
}

struct Chunk { int b, t0, L, row0, lo, hi; };
__device__ __forceinline__ Chunk chunk_of(int it) {
    Chunk c;
    if (it < 64) { c.b = it >> 2; c.t0 = (it & 3) * 64; c.L = CTXL; c.row0 = c.b * CTXL + c.t0; c.lo = 0; c.hi = CTXL; }
    else { const int r = it - 64; c.b = r >> 5; c.t0 = (r & 31) * 64; c.L = SEQ; c.row0 = NTOK_C + c.b * SEQ + c.t0; c.lo = c.t0; c.hi = c.t0 + 64; }
    return c;
}
__device__ __forceinline__ f32x4 bf4(u32x2 v) { return (f32x4){lo_bf(v.x), hi_bf(v.x), lo_bf(v.y), hi_bf(v.y)}; }
__device__ __forceinline__ void ph_prep_conv(CArgs& a, int l, LAS unsigned char* lds, int bid, int nblk) {
    const bf16* P = (const bf16*)(a.ws + WS_P);
    bf16* ZT = (bf16*)(a.ws + WS_MIX + MX_ZT); bf16* YMIX = (bf16*)(a.ws + WS_YMIX);
    LAS bf16* zt = (LAS bf16*)lds;
    const int tid = tidx(), c4 = (tid & 63) * 4, tg = tid >> 6;
    const float* hw = a.in[I_HYCW] + l * 3 * 768; const float* hb = a.in[I_HYCB] + l * 768; const float* sw = a.in[I_SCCW] + l * 3 * 256;
    f32x4 wx[3], wv[3], ws3[3];
#pragma unroll
    for (int k = 0; k < 3; ++k) { wx[k] = *(const f32x4*)(hw + k * 768 + 256 + c4); wv[k] = *(const f32x4*)(hw + k * 768 + 512 + c4); ws3[k] = *(const f32x4*)(sw + k * 256 + c4); }
    const f32x4 bx = *(const f32x4*)(hb + 256 + c4), bv = *(const f32x4*)(hb + 512 + c4);
#pragma unroll 1
    for (int it = bid; it < 576; it += nblk) {
        const Chunk c = chunk_of(it);
        const int tb = c.t0 + tg * 8;
        const bf16* pb = P + (size_t)(c.row0 + tg * 8) * D_INP;
        f32x4 x1[10], vv[10], mm[10];
#pragma unroll
        for (int r = 0; r < 10; ++r) { const int t = tb + r - 1; const bool ok = t >= c.lo && t < c.hi; const bf16* p = pb + (ptrdiff_t)(r - 1) * D_INP;
            x1[r] = ok ? bf4(*(const u32x2*)(p + HY0 + 256 + c4)) : (f32x4){0.f, 0.f, 0.f, 0.f}; vv[r] = ok ? bf4(*(const u32x2*)(p + HY0 + 512 + c4)) : (f32x4){0.f, 0.f, 0.f, 0.f};
            mm[r] = ok ? bf4(*(const u32x2*)(p + SC0 + 256 + c4)) * bf4(*(const u32x2*)(p + SC0 + 512 + c4)) : (f32x4){0.f, 0.f, 0.f, 0.f}; }
#pragma unroll
        for (int tt = 0; tt < 8; ++tt) {
            const f32x4 xx = wx[0] * x1[tt] + wx[1] * x1[tt + 1] + wx[2] * x1[tt + 2] + bx, v2 = wv[0] * vv[tt] + wv[1] * vv[tt + 1] + wv[2] * vv[tt + 2] + bv, z = xx * v2;
            u32x2 zo; zo.x = pk2(z[0], z[1]); zo.y = pk2(z[2], z[3]); *(LAS u32x2*)(zt + (tg * 8 + tt) * 264 + c4) = zo;
            const f32x4 bg = bf4(*(const u32x2*)(pb + (size_t)tt * D_INP + SC0 + c4));
            const f32x4 y = bg * (ws3[0] * mm[tt] + ws3[1] * mm[tt + 1] + ws3[2] * mm[tt + 2]);
            u32x2 yo; yo.x = pk2(y[0], y[1]); yo.y = pk2(y[2], y[3]); *(u32x2*)(YMIX + (size_t)(c.row0 + tg * 8 + tt) * D + 256 + c4) = yo;
        }
        __syncthreads();
        { const int ch = tid & 255, g0 = (tid >> 8) * 4;
          const int soff = c.L == CTXL ? 0 : CTXL;
#pragma unroll
          for (int g = 0; g < 4; ++g) { const int t8 = (g0 + g) * 8; unsigned short e[8];
#pragma unroll
              for (int j = 0; j < 8; ++j) e[j] = zt[(t8 + j) * 264 + ch];
              u32x4 o; o.x = e[0] | ((unsigned)e[1] << 16); o.y = e[2] | ((unsigned)e[3] << 16); o.z = e[4] | ((unsigned)e[5] << 16); o.w = e[6] | ((unsigned)e[7] << 16);
              *(u32x4*)(ZT + ((size_t)(ch * 16 + c.b)) * 2304 + soff + c.t0 + t8) = o; } }
        __syncthreads();
    }
}
__device__ __forceinline__ void ph_prep_tok(CArgs& a, int l, int gw, int ngw) {
    const int lane = tidx() & 63;
    const bf16* P = (const bf16*)(a.ws + WS_P);
    float* GDF = (float*)(a.ws + WS_MIX + MX_GDF); float* GDB = (float*)(a.ws + WS_MIX + MX_GDB);
    float* DQ = (float*)(a.ws + WS_MIX + MX_DQ); float* DK = (float*)(a.ws + WS_MIX + MX_DK); float* DV = (float*)(a.ws + WS_MIX + MX_DV); float* DG = (float*)(a.ws + WS_MIX + MX_DG);
    const float* wa = a.in[I_GLAWA] + l * 2 * 16 * 128; const float* ba = a.in[I_GLABA] + l * 2 * 128;
    const float* cw = a.in[I_GDNCW] + l * 3 * 768;
#pragma unroll 1
    for (int row0 = gw * 4; row0 < NTOK; row0 += ngw * 4) {
        { int z = 0; asm volatile("" : "+v"(z)); wa += z; cw += z; }
        const bf16* pr0 = P + (size_t)row0 * D_INP;
        float av[4], s[4][4];
#pragma unroll
        for (int r = 0; r < 4; ++r) { av[r] = lane < 32 ? bf2f(pr0[(size_t)r * D_INP + GLA0 + 768 + lane]) : 0.f; s[r][0] = ba[lane]; s[r][1] = ba[64 + lane]; s[r][2] = ba[128 + lane]; s[r][3] = ba[192 + lane]; }
#pragma unroll
        for (int i = 0; i < 16; ++i) { const float w0 = wa[i * 128 + lane], w1 = wa[i * 128 + 64 + lane], w2 = wa[2048 + i * 128 + lane], w3 = wa[2048 + i * 128 + 64 + lane];
#pragma unroll
            for (int r = 0; r < 4; ++r) { const float af = rdlane_f(av[r], i), ab = rdlane_f(av[r], 16 + i); s[r][0] += af * w0; s[r][1] += af * w1; s[r][2] += ab * w2; s[r][3] += ab * w3; } }
#pragma unroll
        for (int r = 0; r < 4; ++r) { const size_t o = (size_t)(row0 + r) * 128;
            GDF[o + lane] = __expf(logsigmoidf_(s[r][0]) * 0.0625f); GDF[o + 64 + lane] = __expf(logsigmoidf_(s[r][1]) * 0.0625f);
            GDB[o + lane] = __expf(logsigmoidf_(s[r][2]) * 0.0625f); GDB[o + 64 + lane] = __expf(logsigmoidf_(s[r][3]) * 0.0625f); }
        int tpos, lo, hi;
        if (row0 < NTOK_C) { tpos = row0 & 255; lo = 0; hi = CTXL; } else { tpos = (row0 - NTOK_C) & 2047; lo = tpos & ~63; hi = lo + 64; }
        float sq[4] = {0.f, 0.f, 0.f, 0.f}, sk[4] = {0.f, 0.f, 0.f, 0.f}; f32x4 qv[4], kv[4];
#pragma unroll
        for (int g = 0; g < 3; ++g) { const int col = g * 256 + 4 * lane; const bf16* p = pr0 + GDN0 + col;
            f32x4 x[6];
#pragma unroll
            for (int r = 0; r < 6; ++r) { const int t = tpos + r - 1; x[r] = (t >= lo && t < hi) ? bf4(*(const u32x2*)(p + (ptrdiff_t)(r - 1) * D_INP)) : (f32x4){0.f, 0.f, 0.f, 0.f}; }
            const f32x4 w0 = *(const f32x4*)(cw + col), w1 = *(const f32x4*)(cw + 768 + col), w2 = *(const f32x4*)(cw + 1536 + col);
#pragma unroll
            for (int r = 0; r < 4; ++r) { f32x4 y = w0 * x[r] + w1 * x[r + 1] + w2 * x[r + 2];
                y[0] = siluf_(y[0]); y[1] = siluf_(y[1]); y[2] = siluf_(y[2]); y[3] = siluf_(y[3]);
                if (g == 0) { qv[r] = y; sq[r] = (y[0] * y[0] + y[1] * y[1]) + (y[2] * y[2] + y[3] * y[3]); }
                else if (g == 1) { kv[r] = y; sk[r] = (y[0] * y[0] + y[1] * y[1]) + (y[2] * y[2] + y[3] * y[3]); }
                else *(f32x4*)(DV + (size_t)(row0 + r) * 256 + 4 * lane) = y; } }
#pragma unroll
        for (int r = 0; r < 4; ++r) { const float rq = rsqrtf(row16_sum(sq[r]) + 1e-6f) * 0.125f, rk = rsqrtf(row16_sum(sk[r]) + 1e-6f);
            *(f32x4*)(DQ + (size_t)(row0 + r) * 256 + 4 * lane) = qv[r] * rq; *(f32x4*)(DK + (size_t)(row0 + r) * 256 + 4 * lane) = kv[r] * rk; }
        if (lane < 16) { const int h = lane & 3, r = lane >> 2; const bf16* pr = pr0 + (size_t)r * D_INP;
            const float af = bf2f(pr[GDN0 + 1024 + h]), ab = bf2f(pr[GDN0 + 1028 + h]), bfv = bf2f(pr[GDN0 + 1032 + h]), bbv = bf2f(pr[GDN0 + 1036 + h]);
            const float* al = a.in[I_GDNALOG] + l * 8; const float* dt = a.in[I_GDNDT] + l * 8;
            const float gf = -__expf(al[h]) * softplusf_(af + dt[h]), gb = -__expf(al[4 + h]) * softplusf_(ab + dt[4 + h]);
            *(f32x4*)(DG + (size_t)(row0 + r) * 16 + 4 * h) = (f32x4){sigmoidf_(bfv), __expf(gf), sigmoidf_(bbv), __expf(gb)}; }
    }
}

__device__ __forceinline__ int scan_row(int b, int dir, int n) {
    if (n < CTXL) return b * CTXL + (dir ? CTXL - 1 - n : n);
    const int m = n - CTXL; return NTOK_C + b * SEQ + (dir ? SEQ - 1 - m : m);
}
__device__ __forceinline__ void gla_chain(CArgs& a, int chain, LAS unsigned char* lds) {
    const int b = chain >> 3, h = (chain >> 1) & 3, dir = chain & 1;
    const int tid = tidx(), lane = tid & 63, w = tid >> 6, vv = lane & 7, kq = lane >> 3;
    const bf16* P = (const bf16*)(a.ws + WS_P);
    const float* GD = (const float*)(a.ws + WS_MIX + (dir ? MX_GDB : MX_GDF));
    float* GO = (float*)(a.ws + WS_MIX + (dir ? MX_GOB : MX_GOF));
    LAS float* sq = (LAS float*)lds;
    LAS float* sk = sq + 64 * 32;
    LAS float* sd = sk + 64 * 32;
    LAS float* sv = sd + 64 * 32;
    float S[4] = {0.f, 0.f, 0.f, 0.f};
    for (int ch = 0; ch < 36; ++ch) {
        { const int tt = tid >> 3, sub = tid & 7, row = scan_row(b, dir, ch * 64 + tt);
          const bf16* pr = P + (size_t)row * D_INP + GLA0;
          const u32x2 qv = *(const u32x2*)(pr + h * 32 + sub * 4), kv = *(const u32x2*)(pr + 128 + h * 32 + sub * 4);
          const f32x4 dv = *(const f32x4*)(GD + (size_t)row * 128 + h * 32 + sub * 4);
          const u32x4 vv8 = *(const u32x4*)(pr + 256 + h * 64 + sub * 8);
          const float qs = 0.17677669529663687f;
          *(LAS f32x4*)(sq + tt * 32 + sub * 4) = (f32x4){lo_bf(qv.x) * qs, hi_bf(qv.x) * qs, lo_bf(qv.y) * qs, hi_bf(qv.y) * qs};
          *(LAS f32x4*)(sk + tt * 32 + sub * 4) = (f32x4){lo_bf(kv.x), hi_bf(kv.x), lo_bf(kv.y), hi_bf(kv.y)};
          *(LAS f32x4*)(sd + tt * 32 + sub * 4) = dv;
          *(LAS f32x4*)(sv + tt * 64 + sub * 8) = (f32x4){lo_bf(vv8.x), hi_bf(vv8.x), lo_bf(vv8.y), hi_bf(vv8.y)};
          *(LAS f32x4*)(sv + tt * 64 + sub * 8 + 4) = (f32x4){lo_bf(vv8.z), hi_bf(vv8.z), lo_bf(vv8.w), hi_bf(vv8.w)}; }
        __syncthreads();
#pragma unroll 4
        for (int tt = 0; tt < 64; ++tt) {
            const f32x4 q4 = *(const LAS f32x4*)(sq + tt * 32 + kq * 4), k4 = *(const LAS f32x4*)(sk + tt * 32 + kq * 4), d4 = *(const LAS f32x4*)(sd + tt * 32 + kq * 4);
            const float v = sv[tt * 64 + w * 8 + vv];
            float o = 0.f;
#pragma unroll
            for (int j = 0; j < 4; ++j) { S[j] = d4[j] * S[j] + k4[j] * v; o += q4[j] * S[j]; }
            o += __shfl_xor(o, 8); o += __shfl_xor(o, 16); o += __shfl_xor(o, 32);
            if (kq == 0) GO[(size_t)scan_row(b, dir, ch * 64 + tt) * 256 + h * 64 + w * 8 + vv] = o;
        }
        __syncthreads();
    }
}
__device__ __forceinline__ void gdn_chain(CArgs& a, int chain, LAS unsigned char* lds) {
    const int b = chain >> 3, h = (chain >> 1) & 3, dir = chain & 1;
    const int tid = tidx(), lane = tid & 63, w = tid >> 6, vv = lane & 7, kq = lane >> 3;
    const float* DQ = (const float*)(a.ws + WS_MIX + MX_DQ); const float* DK = (const float*)(a.ws + WS_MIX + MX_DK); const float* DV = (const float*)(a.ws + WS_MIX + MX_DV);
    const float* DG = (const float*)(a.ws + WS_MIX + MX_DG);
    float* DO = (float*)(a.ws + WS_MIX + (dir ? MX_DOB : MX_DOF));
    LAS float* sq = (LAS float*)lds;
    LAS float* sk = sq + 64 * 64;
    LAS float* sv = sk + 64 * 64;
    LAS float* sg = sv + 64 * 64;
    float S[8];
#pragma unroll
    for (int j = 0; j < 8; ++j) S[j] = 0.f;
    for (int ch = 0; ch < 36; ++ch) {
        { const int tt = tid >> 3, sub = tid & 7, row = scan_row(b, dir, ch * 64 + tt);
          const size_t o = (size_t)row * 256 + h * 64 + sub * 8;
          *(LAS f32x4*)(sq + tt * 64 + sub * 8) = *(const f32x4*)(DQ + o); *(LAS f32x4*)(sq + tt * 64 + sub * 8 + 4) = *(const f32x4*)(DQ + o + 4);
          *(LAS f32x4*)(sk + tt * 64 + sub * 8) = *(const f32x4*)(DK + o); *(LAS f32x4*)(sk + tt * 64 + sub * 8 + 4) = *(const f32x4*)(DK + o + 4);
          *(LAS f32x4*)(sv + tt * 64 + sub * 8) = *(const f32x4*)(DV + o); *(LAS f32x4*)(sv + tt * 64 + sub * 8 + 4) = *(const f32x4*)(DV + o + 4);
          if (sub == 0) { const f32x4 g4 = *(const f32x4*)(DG + (size_t)row * 16 + h * 4); *(LAS f32x2*)(sg + tt * 2) = dir ? (f32x2){g4[2], g4[3]} : (f32x2){g4[0], g4[1]}; } }
        __syncthreads();
#pragma unroll 2
        for (int tt = 0; tt < 64; ++tt) {
            const f32x4 ka = *(const LAS f32x4*)(sk + tt * 64 + kq * 8), kb = *(const LAS f32x4*)(sk + tt * 64 + kq * 8 + 4);
            const f32x4 qa = *(const LAS f32x4*)(sq + tt * 64 + kq * 8), qb = *(const LAS f32x4*)(sq + tt * 64 + kq * 8 + 4);
            const float v = sv[tt * 64 + w * 8 + vv]; const f32x2 g2 = *(const LAS f32x2*)(sg + tt * 2);
            const float beta = g2.x, eg = g2.y;
            float ks = (ka[0] * S[0] + ka[1] * S[1]) + (ka[2] * S[2] + ka[3] * S[3]) + ((kb[0] * S[4] + kb[1] * S[5]) + (kb[2] * S[6] + kb[3] * S[7]));
            ks += __shfl_xor(ks, 8); ks += __shfl_xor(ks, 16); ks += __shfl_xor(ks, 32);
            const float wv = beta * (v - eg * ks);
            float o = 0.f;
#pragma unroll
            for (int j = 0; j < 4; ++j) { S[j] = eg * S[j] + ka[j] * wv; o += qa[j] * S[j]; }
#pragma unroll
            for (int j = 0; j < 4; ++j) { S[4 + j] = eg * S[4 + j] + kb[j] * wv; o += qb[j] * S[4 + j]; }
            o += __shfl_xor(o, 8); o += __shfl_xor(o, 16); o += __shfl_xor(o, 32);
            if (kq == 0) DO[(size_t)scan_row(b, dir, ch * 64 + tt) * 256 + h * 64 + w * 8 + vv] = o;
        }
        __syncthreads();
    }
}
__device__ __forceinline__ float gdn_cprod(float eg, int lane) {
    float c = fmaxf(eg, 2.0611536e-9f);
    float t = dpp_f<0x90>(c); c *= (lane & 3) >= 1 ? t : 1.f;
    t = dpp_f<0x44>(c); c *= (lane & 3) >= 2 ? t : 1.f;
    return c;
}
__device__ __forceinline__ float oct_sum(float v) { v += dpp_f<0xB1>(v); v += dpp_f<0x4E>(v); v += dpp_f<0x141>(v); return v; }
__device__ __forceinline__ void gdn_wave(CArgs& a, int chain, int vbase, LAS unsigned char* wl, int lane) {
    const int b = chain >> 3, h = (chain >> 1) & 3, dir = chain & 1, vl = lane >> 3, kq = lane & 7;
    const float* DQ = (const float*)(a.ws + WS_MIX + MX_DQ); const float* DK = (const float*)(a.ws + WS_MIX + MX_DK); const float* DV = (const float*)(a.ws + WS_MIX + MX_DV);
    const float* DG = (const float*)(a.ws + WS_MIX + MX_DG);
    float* DO = (float*)(a.ws + WS_MIX + (dir ? MX_DOB : MX_DOF));
    f32x2 S2[4];
#pragma unroll
    for (int i = 0; i < 4; ++i) S2[i] = (f32x2){0.f, 0.f};
    f32x4 pk[4], pq[4], pv; f32x2 pg;
    const int step = dir ? -1 : 1;
#define GDN_FETCH(ci) do { const int r0_ = scan_row(b, dir, (ci) * 16); \
        _Pragma("unroll") for (int j = 0; j < 4; ++j) { const size_t o_ = (size_t)(r0_ + step * (4 * j + (lane >> 4))) * 256 + h * 64 + (lane & 15) * 4; pk[j] = *(const f32x4*)(DK + o_); pq[j] = *(const f32x4*)(DQ + o_); } \
        pv = *(const f32x4*)(DV + (size_t)(r0_ + step * ((lane & 31) >> 1)) * 256 + h * 64 + vbase + (lane & 1) * 4); \
        pg = *(const f32x2*)(DG + (size_t)(r0_ + step * (lane & 15)) * 16 + h * 4 + dir * 2); } while (0)
#define GDN_PUT(bufp) do { _Pragma("unroll") for (int j = 0; j < 4; ++j) { *(LAS f32x4*)((bufp) + j * 1024 + lane * 16) = pk[j]; *(LAS f32x4*)((bufp) + 4096 + j * 1024 + lane * 16) = pq[j]; } \
        if (lane < 32) *(LAS f32x4*)((bufp) + 8192 + lane * 16) = pv; } while (0)
    GDN_FETCH(0);
    float gA, gB, gC;
    { const float c = gdn_cprod(pg.y, lane); gA = pg.x / c; gB = pg.x; gC = c; }
    GDN_PUT(wl);
#pragma unroll 1
    for (int ci = 0; ci < 144; ++ci) {
        const LAS unsigned char* buf = wl + (ci & 1) * 8704;
        const float cA = gA, cB = gB, cC = gC;
        if (ci + 1 < 144) GDN_FETCH(ci + 1);
        const int r0 = scan_row(b, dir, ci * 16);
        float okeep = 0.f;
#pragma unroll 1
        for (int tg = 0; tg < 4; ++tg) {
#pragma unroll
            for (int tu = 0; tu < 4; ++tu) {
                const int tt = tg * 4 + tu;
                const f32x4 k0 = *(const LAS f32x4*)(buf + (tt * 64 + kq * 8) * 4), k1 = *(const LAS f32x4*)(buf + (tt * 64 + kq * 8 + 4) * 4);
                const f32x4 q0 = *(const LAS f32x4*)(buf + 4096 + (tt * 64 + kq * 8) * 4), q1 = *(const LAS f32x4*)(buf + 4096 + (tt * 64 + kq * 8 + 4) * 4);
                const float vv = *(const LAS float*)(buf + 8192 + (tt * 8 + vl) * 4);
                const float tA = rdlane_f(cA, tt), tB = rdlane_f(cB, tt), tC = rdlane_f(cC, tt);
                f32x2 ka = (f32x2){k0[0], k0[1]} * S2[0], kb = (f32x2){k0[2], k0[3]} * S2[1];
                ka = __builtin_elementwise_fma((f32x2){k1[0], k1[1]}, S2[2], ka); kb = __builtin_elementwise_fma((f32x2){k1[2], k1[3]}, S2[3], kb);
                ka = ka + kb;
                const float ks = oct_sum(ka.x + ka.y);
                const float wh = tA * vv - tB * ks; const f32x2 wh2 = (f32x2){wh, wh};
                S2[0] = __builtin_elementwise_fma((f32x2){k0[0], k0[1]}, wh2, S2[0]); S2[1] = __builtin_elementwise_fma((f32x2){k0[2], k0[3]}, wh2, S2[1]);
                S2[2] = __builtin_elementwise_fma((f32x2){k1[0], k1[1]}, wh2, S2[2]); S2[3] = __builtin_elementwise_fma((f32x2){k1[2], k1[3]}, wh2, S2[3]);
                f32x2 oa = (f32x2){q0[0], q0[1]} * S2[0], ob = (f32x2){q0[2], q0[3]} * S2[1];
                oa = __builtin_elementwise_fma((f32x2){q1[0], q1[1]}, S2[2], oa); ob = __builtin_elementwise_fma((f32x2){q1[2], q1[3]}, S2[3], ob);
                oa = oa + ob;
                const float o = tC * oct_sum(oa.x + oa.y);
                okeep = ((tt & 7) == kq) ? o : okeep;
            }
            { const float cl = rdlane_f(cC, tg * 4 + 3);
#pragma unroll
              for (int i = 0; i < 4; ++i) S2[i] = S2[i] * cl; }
            if (tg & 1) DO[(size_t)(r0 + step * ((tg >> 1) * 8 + kq)) * 256 + h * 64 + vbase + vl] = okeep;
        }
        if (ci + 1 < 144) {
            const float c = gdn_cprod(pg.y, lane); gA = pg.x / c; gB = pg.x; gC = c;
            GDN_PUT(wl + ((ci + 1) & 1) * 8704);
        }
    }
#undef GDN_FETCH
#undef GDN_PUT
}
__device__ __forceinline__ void gla_wave(CArgs& a, int chain, int vbase, LAS unsigned char* wl, int lane) {
    const int b = chain >> 3, h = (chain >> 1) & 3, dir = chain & 1, vl = lane >> 2, kq = lane & 3;
    const bf16* P = (const bf16*)(a.ws + WS_P);
    const float* GD = (const float*)(a.ws + WS_MIX + (dir ? MX_GDB : MX_GDF));
    float* GO = (float*)(a.ws + WS_MIX + (dir ? MX_GOB : MX_GOF));
    f32x2 S2[4];
#pragma unroll
    for (int i = 0; i < 4; ++i) S2[i] = (f32x2){0.f, 0.f};
    u32x4 pq, pk; f32x4 pd[2]; u32x2 pv;
    const int step = dir ? -1 : 1;
#define GLA_FETCH(ci) do { const int r0_ = scan_row(b, dir, (ci) * 16); \
        const bf16* pr_ = P + (size_t)(r0_ + step * (lane >> 2)) * D_INP + GLA0; \
        pq = *(const u32x4*)(pr_ + h * 32 + (lane & 3) * 8); pk = *(const u32x4*)(pr_ + 128 + h * 32 + (lane & 3) * 8); pv = *(const u32x2*)(pr_ + 256 + h * 64 + vbase + (lane & 3) * 4); \
        _Pragma("unroll") for (int j = 0; j < 2; ++j) pd[j] = *(const f32x4*)(GD + (size_t)(r0_ + step * (8 * j + (lane >> 3))) * 128 + h * 32 + (lane & 7) * 4); } while (0)
#define GLA_PUT(bufp) do { const float qs_ = 0.17677669529663687f; \
        *(LAS f32x4*)((bufp) + lane * 32) = (f32x4){lo_bf(pq.x) * qs_, hi_bf(pq.x) * qs_, lo_bf(pq.y) * qs_, hi_bf(pq.y) * qs_}; *(LAS f32x4*)((bufp) + lane * 32 + 16) = (f32x4){lo_bf(pq.z) * qs_, hi_bf(pq.z) * qs_, lo_bf(pq.w) * qs_, hi_bf(pq.w) * qs_}; \
        *(LAS f32x4*)((bufp) + 2048 + lane * 32) = (f32x4){lo_bf(pk.x), hi_bf(pk.x), lo_bf(pk.y), hi_bf(pk.y)}; *(LAS f32x4*)((bufp) + 2048 + lane * 32 + 16) = (f32x4){lo_bf(pk.z), hi_bf(pk.z), lo_bf(pk.w), hi_bf(pk.w)}; \
        *(LAS f32x4*)((bufp) + 4096 + lane * 16) = pd[0]; *(LAS f32x4*)((bufp) + 4096 + 1024 + lane * 16) = pd[1]; \
        *(LAS f32x4*)((bufp) + 6144 + lane * 16) = (f32x4){lo_bf(pv.x), hi_bf(pv.x), lo_bf(pv.y), hi_bf(pv.y)}; } while (0)
#define GLA_LD(Q, K, Dd, V, p, pvv) do { _Pragma("unroll") for (int m = 0; m < 2; ++m) { Q[m] = *(const LAS f32x4*)((p) + 16 * m); K[m] = *(const LAS f32x4*)((p) + 2048 + 16 * m); Dd[m] = *(const LAS f32x4*)((p) + 4096 + 16 * m); } V = *(const LAS float*)(pvv); } while (0)
#define GLA_TOK(Q, K, Dd, V, tu) do { const f32x2 vv2 = (f32x2){V, V}; \
        S2[0] = __builtin_elementwise_fma((f32x2){K[0][0], K[0][1]}, vv2, (f32x2){Dd[0][0], Dd[0][1]} * S2[0]); S2[1] = __builtin_elementwise_fma((f32x2){K[0][2], K[0][3]}, vv2, (f32x2){Dd[0][2], Dd[0][3]} * S2[1]); \
        S2[2] = __builtin_elementwise_fma((f32x2){K[1][0], K[1][1]}, vv2, (f32x2){Dd[1][0], Dd[1][1]} * S2[2]); S2[3] = __builtin_elementwise_fma((f32x2){K[1][2], K[1][3]}, vv2, (f32x2){Dd[1][2], Dd[1][3]} * S2[3]); \
        f32x2 oa = (f32x2){Q[0][0], Q[0][1]} * S2[0], ob = (f32x2){Q[0][2], Q[0][3]} * S2[1]; \
        oa = __builtin_elementwise_fma((f32x2){Q[1][0], Q[1][1]}, S2[2], oa); ob = __builtin_elementwise_fma((f32x2){Q[1][2], Q[1][3]}, S2[3], ob); oa = oa + ob; \
        const float o = quad_sum(oa.x + oa.y); okeep = ((tu) == kq) ? o : okeep; } while (0)
    GLA_FETCH(0);
    GLA_PUT(wl);
    f32x4 QA[2], KA[2], DA[2], QB[2], KB[2], DB[2]; float VA, VB;
    GLA_LD(QA, KA, DA, VA, wl + kq * 32, wl + 6144 + vl * 4);
#pragma unroll 1
    for (int ci = 0; ci < 144; ++ci) {
        LAS unsigned char* buf = wl + (ci & 1) * 7168; LAS unsigned char* obuf = wl + ((ci + 1) & 1) * 7168;
        if (ci + 1 < 144) GLA_FETCH(ci + 1);
        const int r0 = scan_row(b, dir, ci * 16);
        float okeep = 0.f;
#pragma unroll 1
        for (int tg = 0; tg < 4; ++tg) {
            if (tg == 3 && ci + 1 < 144) GLA_PUT(obuf);
            LAS unsigned char* pt = buf + tg * 512 + kq * 32; LAS unsigned char* pvt = buf + 6144 + tg * 256 + vl * 4;
            LAS unsigned char* pn = (tg == 3) ? obuf + kq * 32 : pt + 512; LAS unsigned char* pvn = (tg == 3) ? obuf + 6144 + vl * 4 : pvt + 256;
            GLA_LD(QB, KB, DB, VB, pt + 128, pvt + 64);  __builtin_amdgcn_sched_barrier(0); GLA_TOK(QA, KA, DA, VA, 0); __builtin_amdgcn_sched_barrier(0);
            GLA_LD(QA, KA, DA, VA, pt + 256, pvt + 128); __builtin_amdgcn_sched_barrier(0); GLA_TOK(QB, KB, DB, VB, 1); __builtin_amdgcn_sched_barrier(0);
            GLA_LD(QB, KB, DB, VB, pt + 384, pvt + 192); __builtin_amdgcn_sched_barrier(0); GLA_TOK(QA, KA, DA, VA, 2); __builtin_amdgcn_sched_barrier(0);
            GLA_LD(QA, KA, DA, VA, pn, pvn);             __builtin_amdgcn_sched_barrier(0); GLA_TOK(QB, KB, DB, VB, 3); __builtin_amdgcn_sched_barrier(0);
            GO[(size_t)(r0 + step * (tg * 4 + kq)) * 256 + h * 64 + vbase + vl] = okeep;
        }
    }
#undef GLA_FETCH
#undef GLA_PUT
#undef GLA_LD
#undef GLA_TOK
}
template <int L>
__device__ __forceinline__ void hyena_unit(CArgs& a, int l, int c, LAS unsigned char* lds) {
    constexpr int Lt = L == SEQ ? 1 : 0, SOFF = L == SEQ ? CTXL : 0, CST = (2 * L + 16) * 2 + 32;
    constexpr int NTW = L / 16 / 8;
    const int tid = tidx(), lane = tid & 63, w = tid >> 6, fr = lane & 15, kg = lane >> 4;
    const float* kf = (const float*)(a.ws + WS_KUN) + ((size_t)((l * 2 + Lt) * 512 + c)) * 2048;
    const float* kb = kf + (size_t)256 * 2048;
    LAS float* red = (LAS float*)(lds + 8 * CST);
    float s = 0.f;
    for (int t = tid; t < L; t += 512) s += fabsf(kf[t]) + (t >= 1 ? fabsf(kb[t]) : 0.f);
    s = wave_sum(s);
    if (lane == 0) red[w] = s;
    __syncthreads();
    float l1 = 0.f;
#pragma unroll
    for (int i = 0; i < 8; ++i) l1 += red[i];
    const float inv = 1.f / l1;
    for (int idx = tid; idx < 2 * L + 16; idx += 512) {
        float gv = 0.f;
        if (idx >= 1 && idx <= L) gv = kf[L - idx] * inv; else if (idx > L && idx < 2 * L) gv = kb[idx - L] * inv;
        const bf16 gb = (bf16)f2bf(gv);
#pragma unroll
        for (int r = 0; r < 8; ++r) if (idx - r >= 0) *(LAS bf16*)(lds + r * CST + (idx - r) * 2) = gb;
    }
    __syncthreads();
    const bf16* Z = (const bf16*)(a.ws + WS_MIX + MX_ZT) + ((size_t)(c * 16 + fr)) * 2304 + SOFF;
    float* YT = (float*)(a.ws + WS_MIX + MX_YT) + ((size_t)(c * 16 + fr)) * 2304 + SOFF;
    f32x4 acc[NTW];
#pragma unroll
    for (int j = 0; j < NTW; ++j) acc[j] = (f32x4){0.f, 0.f, 0.f, 0.f};
    const int rr = (8 - (fr & 7)) & 7;
    for (int i = 0; i < L / 32; ++i) {
        const bf16x8 Bf = *(const bf16x8*)(Z + 32 * i + 8 * kg);
#pragma unroll
        for (int j = 0; j < NTW; ++j) {
            const int t0 = 16 * (w * NTW + j);
            const int o = 32 * i + 8 * kg - t0 - fr + L;
            const bf16x8 Af = *(const LAS bf16x8*)(lds + rr * CST + (o >> 3) * 16);
            acc[j] = __builtin_amdgcn_mfma_f32_16x16x32_bf16(Af, Bf, acc[j], 0, 0, 0);
        }
    }
#pragma unroll
    for (int j = 0; j < NTW; ++j) *(f32x4*)(YT + 16 * (w * NTW + j) + 4 * kg) = acc[j];
    __syncthreads();
}
__device__ __forceinline__ void ph_scan(CArgs& a, int l, LAS unsigned char* lds, int bid, int nblk, unsigned long long& tacc) {
    const int tid = tidx(), lane = tid & 63, w = __builtin_amdgcn_readfirstlane(tid >> 6);
    unsigned long long t0 = 0ull;
    if (PROBE_PH >= 20) t0 = __builtin_amdgcn_s_memrealtime();
    if (w < 6) {
        for (int it = bid; it < 256; it += nblk) {
            const int p = it >> 1, half = it & 1;
            if (w < 4) gdn_wave(a, p, 32 * half + 8 * w, lds + w * 17408, lane);
            else gla_wave(a, p, 32 * half + 16 * (w & 1), lds + 69632 + (w - 4) * 14336, lane);
        }
        if (PROBE_PH == 20 && w < 4) tacc += __builtin_amdgcn_s_memrealtime() - t0;
        if (PROBE_PH == 21 && w >= 4) tacc += __builtin_amdgcn_s_memrealtime() - t0;
    } else {
        tr_experts_waves(a, l, lds + 98304 + (w - 6) * 8448, bid * 2 + (w - 6), nblk * 2, lane);
        if (PROBE_PH == 22) tacc += __builtin_amdgcn_s_memrealtime() - t0;
    }
    __syncthreads();
    if (PROBE_PH == 23) t0 = __builtin_amdgcn_s_memrealtime();
    for (int it = bid; it < 512; it += nblk) {
        if (it < 256) hyena_unit<SEQ>(a, l, it, lds);
        else hyena_unit<CTXL>(a, l, it - 256, lds);
    }
    if (PROBE_PH == 23) tacc += __builtin_amdgcn_s_memrealtime() - t0;
}

__device__ __forceinline__ void ph_post_hyena(CArgs& a, int l, LAS unsigned char* lds, int bid, int nblk) {
    const bf16* P = (const bf16*)(a.ws + WS_P);
    const float* YT = (const float*)(a.ws + WS_MIX + MX_YT); bf16* YMIX = (bf16*)(a.ws + WS_YMIX);
    LAS float* yt = (LAS float*)lds;
    const int tid = tidx(), c4 = (tid & 63) * 4, tg = tid >> 6;
    const float* hw = a.in[I_HYCW] + l * 3 * 768; const float* hb = a.in[I_HYCB] + l * 768;
    f32x4 w0[3], wx[3], wv[3];
#pragma unroll
    for (int k = 0; k < 3; ++k) { w0[k] = *(const f32x4*)(hw + k * 768 + c4); wx[k] = *(const f32x4*)(hw + k * 768 + 256 + c4); wv[k] = *(const f32x4*)(hw + k * 768 + 512 + c4); }
    const f32x4 b0 = *(const f32x4*)(hb + c4), bx = *(const f32x4*)(hb + 256 + c4), bv = *(const f32x4*)(hb + 512 + c4), hd = *(const f32x4*)(a.in[I_HYD] + l * 256 + c4);
#pragma unroll 1
    for (int it = bid; it < 576; it += nblk) {
        const Chunk c = chunk_of(it);
        const int soff = c.L == CTXL ? 0 : CTXL;
        { const int ch = tid & 255, half = tid >> 8;
          const float* srcp = YT + ((size_t)(ch * 16 + c.b)) * 2304 + soff + c.t0 + half * 32;
#pragma unroll
          for (int j = 0; j < 8; ++j) { const f32x4 v = *(const f32x4*)(srcp + 4 * j);
              yt[(half * 32 + 4 * j) * 260 + ch] = v[0]; yt[(half * 32 + 4 * j + 1) * 260 + ch] = v[1]; yt[(half * 32 + 4 * j + 2) * 260 + ch] = v[2]; yt[(half * 32 + 4 * j + 3) * 260 + ch] = v[3]; } }
        __syncthreads();
        const int tb = c.t0 + tg * 8;
        const bf16* pb = P + (size_t)(c.row0 + tg * 8) * D_INP;
        f32x4 x0[10], x1[10], vv[10];
#pragma unroll
        for (int r = 0; r < 10; ++r) { const int t = tb + r - 1; const bool ok = t >= c.lo && t < c.hi; const bf16* p = pb + (ptrdiff_t)(r - 1) * D_INP;
            x0[r] = ok ? bf4(*(const u32x2*)(p + HY0 + c4)) : (f32x4){0.f, 0.f, 0.f, 0.f};
            x1[r] = ok ? bf4(*(const u32x2*)(p + HY0 + 256 + c4)) : (f32x4){0.f, 0.f, 0.f, 0.f}; vv[r] = ok ? bf4(*(const u32x2*)(p + HY0 + 512 + c4)) : (f32x4){0.f, 0.f, 0.f, 0.f}; }
#pragma unroll
        for (int tt = 0; tt < 8; ++tt) {
            const f32x4 u0 = w0[0] * x0[tt] + w0[1] * x0[tt + 1] + w0[2] * x0[tt + 2] + b0;
            const f32x4 xx = wx[0] * x1[tt] + wx[1] * x1[tt + 1] + wx[2] * x1[tt + 2] + bx, v2 = wv[0] * vv[tt] + wv[1] * vv[tt + 1] + wv[2] * vv[tt + 2] + bv, z = xx * v2;
            const f32x4 y = *(const LAS f32x4*)(yt + (tg * 8 + tt) * 260 + c4);
            const f32x4 o = (y + z * hd) * u0;
            u32x2 oo; oo.x = pk2(o[0], o[1]); oo.y = pk2(o[2], o[3]); *(u32x2*)(YMIX + (size_t)(c.row0 + tg * 8 + tt) * D + c4) = oo;
        }
        __syncthreads();
    }
}
__device__ __forceinline__ void ph_post_tok(CArgs& a, int l, int gw, int ngw) {
    const int lane = tidx() & 63;
    const bf16* P = (const bf16*)(a.ws + WS_P); bf16* YMIX = (bf16*)(a.ws + WS_YMIX);
    const float* GOF = (const float*)(a.ws + WS_MIX + MX_GOF); const float* GOB = (const float*)(a.ws + WS_MIX + MX_GOB);
    const float* DOF = (const float*)(a.ws + WS_MIX + MX_DOF); const float* DOB = (const float*)(a.ws + WS_MIX + MX_DOB);
    const f32x4 nwa = *(const f32x4*)(a.in[I_GLANW] + l * 64 + (4 * lane & 63)), nwd = *(const f32x4*)(a.in[I_GDNNW] + l * 64 + (4 * lane & 63));
    for (int row = gw; row < NTOK; row += ngw) {
        const size_t o4 = (size_t)row * 256 + 4 * lane;
        f32x4 og = *(const f32x4*)(GOF + o4) + *(const f32x4*)(GOB + o4), od = *(const f32x4*)(DOF + o4) + *(const f32x4*)(DOB + o4);
        float sg = og[0] * og[0] + og[1] * og[1] + og[2] * og[2] + og[3] * og[3], sd = od[0] * od[0] + od[1] * od[1] + od[2] * od[2] + od[3] * od[3];
        sg = row16_sum(sg); sd = row16_sum(sd);
        const float rg = rsqrtf(sg * (1.f / 64.f) + 1e-6f), rd = rsqrtf(sd * (1.f / 64.f) + 1e-6f);
        const u32x2 r2 = *(const u32x2*)(P + (size_t)row * D_INP + GLA0 + 512 + 4 * lane), z2 = *(const u32x2*)(P + (size_t)row * D_INP + GDN0 + 768 + 4 * lane);
        u32x2 w;
        w.x = pk2(og[0] * rg * nwa[0] * siluf_(lo_bf(r2.x)), og[1] * rg * nwa[1] * siluf_(hi_bf(r2.x))); w.y = pk2(og[2] * rg * nwa[2] * siluf_(lo_bf(r2.y)), og[3] * rg * nwa[3] * siluf_(hi_bf(r2.y)));
        *(u32x2*)(YMIX + (size_t)row * D + 512 + 4 * lane) = w;
        w.x = pk2(od[0] * rd * nwd[0] * siluf_(lo_bf(z2.x)), od[1] * rd * nwd[1] * siluf_(hi_bf(z2.x))); w.y = pk2(od[2] * rd * nwd[2] * siluf_(lo_bf(z2.y)), od[3] * rd * nwd[3] * siluf_(hi_bf(z2.y)));
        *(u32x2*)(YMIX + (size_t)row * D + 768 + 4 * lane) = w;
    }
}

__device__ __forceinline__ void ph_ln1_route(CArgs& a, int l, LAS unsigned char* lds, int bid, int nblk) {
    const int tid = tidx(), lane = tid & 63, w = __builtin_amdgcn_readfirstlane(tid >> 6);
    const float* MOD = (const float*)(a.ws + WS_MOD) + (size_t)l * 17 * 6144;
    float* X = (float*)(a.ws + WS_X); const float* TMP = (const float*)(a.ws + WS_TMP); bf16* HB = (bf16*)(a.ws + WS_HB);
    const float* lg = a.in[I_LN1G] + l * D; const float* lb = a.in[I_LN1B] + l * D;
    const float* br = a.in[I_BR] + l * NEXP;
    const bf16* wh = (const bf16*)(a.ws + WS_WRT) + (size_t)l * NEXP * D; const bf16* wl = wh + DEPTH * NEXP * D;
    unsigned* cnt = (unsigned*)(a.ws + WS_CTL) + CW_CNT + l * NEXP * 64;
    int* LIST = (int*)(a.ws + WS_LIST); int* TOPE = (int*)(a.ws + WS_TOPE); float* TOPW = (float*)(a.ws + WS_TOPW);
    LAS float* hrow = (LAS float*)lds;
    LAS float* part = (LAS float*)(lds + 65792);
    const int row_lo = (l == DEPTH - 1) ? NTOK_C : 0;
    const int e = lane & 31, par = lane >> 5, fr = lane & 15, kg = lane >> 4;
    f32x4 xv[2][4], tv[2][4];
#define LN1_FETCH(base_) do { _Pragma("unroll") for (int t = 0; t < 2; ++t) { const int row_ = (base_) + 2 * w + t; \
        const float* xs_ = (l == 0) ? (row_ < NTOK_C ? a.in[I_CTX] + (size_t)row_ * D : a.in[I_X] + (size_t)(row_ - NTOK_C) * D) : X + (size_t)row_ * D; \
        _Pragma("unroll") for (int j = 0; j < 4; ++j) { xv[t][j] = *(const f32x4*)(xs_ + j * 256 + 4 * lane); tv[t][j] = *(const f32x4*)(TMP + (size_t)row_ * D + j * 256 + 4 * lane); } } } while (0)
    int base = row_lo + bid * 16;
    if (base < NTOK) LN1_FETCH(base);
    int p_row = -1, p_ee = 0; unsigned p_pos = 0u; float p_ww = 0.f;
#pragma unroll 1
    for (; base < NTOK; base += nblk * 16) {
#pragma unroll
        for (int t = 0; t < 2; ++t) {
            const int row = base + 2 * w + t;
            const float* mv = MOD + (size_t)mod_vec(row) * 6144;
            f32x4 v[4]; float s = 0.f;
#pragma unroll
            for (int j = 0; j < 4; ++j) { const int c0 = j * 256 + 4 * lane; const f32x4 g1 = *(const f32x4*)(mv + 2048 + c0);
                v[j] = DN_ALPHA * xv[t][j] + g1 * tv[t][j]; s += (v[j][0] + v[j][1]) + (v[j][2] + v[j][3]); }
            const float mean = wave_sum(s) * (1.f / D); float s2 = 0.f;
#pragma unroll
            for (int j = 0; j < 4; ++j) { v[j] = v[j] - mean; s2 += (v[j][0] * v[j][0] + v[j][1] * v[j][1]) + (v[j][2] * v[j][2] + v[j][3] * v[j][3]); }
            const float rstd = rsqrtf(wave_sum(s2) * (1.f / D) + LN_EPS);
#pragma unroll
            for (int j = 0; j < 4; ++j) { const int c0 = j * 256 + 4 * lane; const f32x4 g = *(const f32x4*)(lg + c0), bb = *(const f32x4*)(lb + c0), sh = *(const f32x4*)(mv + 3072 + c0), sc = *(const f32x4*)(mv + 4096 + c0);
                const f32x4 xn = v[j] * rstd * g + bb; *(f32x4*)(X + (size_t)row * D + c0) = xn;
                const f32x4 hh = xn * (1.f + sc) + sh;
                u32x2 o; o.x = pk2(hh[0], hh[1]); o.y = pk2(hh[2], hh[3]); *(u32x2*)(HB + (size_t)row * D + c0) = o;
                *(LAS f32x4*)(hrow + (2 * w + t) * 1028 + c0) = hh; }
        }
        __syncthreads();
        if (base + nblk * 16 < NTOK) LN1_FETCH(base + nblk * 16);
        {
            f32x4 acc[2] = {(f32x4){0.f, 0.f, 0.f, 0.f}, (f32x4){0.f, 0.f, 0.f, 0.f}};
#pragma unroll
            for (int ss = 0; ss < 4; ++ss) { const int k0 = 128 * w + 32 * ss + 8 * kg;
                const f32x4 h0 = *(const LAS f32x4*)(hrow + fr * 1028 + k0), h1 = *(const LAS f32x4*)(hrow + fr * 1028 + k0 + 4);
                u32x4 ah, al;
                ah.x = pk2(h0[0], h0[1]); ah.y = pk2(h0[2], h0[3]); ah.z = pk2(h1[0], h1[1]); ah.w = pk2(h1[2], h1[3]);
                al.x = pk2(h0[0] - lo_bf(ah.x), h0[1] - hi_bf(ah.x)); al.y = pk2(h0[2] - lo_bf(ah.y), h0[3] - hi_bf(ah.y)); al.z = pk2(h1[0] - lo_bf(ah.z), h1[1] - hi_bf(ah.z)); al.w = pk2(h1[2] - lo_bf(ah.w), h1[3] - hi_bf(ah.w));
                const bf16x8 Ah = __builtin_bit_cast(bf16x8, ah), Al = __builtin_bit_cast(bf16x8, al);
#pragma unroll
                for (int t = 0; t < 2; ++t) { const size_t wo = (size_t)(16 * t + fr) * D + k0;
                    const bf16x8 Bh = *(const bf16x8*)(wh + wo), Bl = *(const bf16x8*)(wl + wo);
                    acc[t] = __builtin_amdgcn_mfma_f32_16x16x32_bf16(Ah, Bh, acc[t], 0, 0, 0);
                    acc[t] = __builtin_amdgcn_mfma_f32_16x16x32_bf16(Ah, Bl, acc[t], 0, 0, 0);
                    acc[t] = __builtin_amdgcn_mfma_f32_16x16x32_bf16(Al, Bh, acc[t], 0, 0, 0); } }
#pragma unroll
            for (int t = 0; t < 2; ++t)
#pragma unroll
                for (int j = 0; j < 4; ++j) part[((w * 2 + t) * 16 + 4 * kg + j) * 16 + fr] = acc[t][j];
        }
        __syncthreads();
        {
            const int row = base + 2 * w + par;
            float cur = br[e];
#pragma unroll
            for (int ww = 0; ww < 8; ++ww) cur += part[((ww * 2 + (e >> 4)) * 16 + 2 * w + par) * 16 + (e & 15)];
            float tvv[4]; int ti[4];
#pragma unroll
            for (int k = 0; k < 4; ++k) { float bv = cur; int bi = e;
#define TOPSTEP(OV, OI) do { const float ov = (OV); const int oi = (OI); if (ov > bv || (ov == bv && oi < bi)) { bv = ov; bi = oi; } } while (0)
                TOPSTEP(dpp_f<0xB1>(bv), dpp_i<0xB1>(bi)); TOPSTEP(dpp_f<0x4E>(bv), dpp_i<0x4E>(bi)); TOPSTEP(dpp_f<0x141>(bv), dpp_i<0x141>(bi)); TOPSTEP(dpp_f<0x140>(bv), dpp_i<0x140>(bi));
                TOPSTEP(__shfl_xor(bv, 16), __shfl_xor(bi, 16));
#undef TOPSTEP
                tvv[k] = bv; ti[k] = bi; if (e == bi) cur = -3.0e38f; }
            const float e1 = __expf(tvv[1] - tvv[0]), e2 = __expf(tvv[2] - tvv[0]), e3 = __expf(tvv[3] - tvv[0]); const float inv = 1.f / (1.f + e1 + e2 + e3);
            if (e < 4) {
                if (p_row >= 0) { LIST[(size_t)p_ee * NTOK + p_pos] = p_row; TOPE[(size_t)p_row * 4 + e] = (p_ee << 20) | (int)p_pos; TOPW[(size_t)p_row * 4 + e] = p_ww; }
                p_ee = e == 0 ? ti[0] : e == 1 ? ti[1] : e == 2 ? ti[2] : ti[3]; p_ww = (e == 0 ? 1.f : e == 1 ? e1 : e == 2 ? e2 : e3) * inv; p_row = row;
                p_pos = atomicAdd(cnt + p_ee * 64, 1u); }
        }
    }
    if (e < 4 && p_row >= 0) { LIST[(size_t)p_ee * NTOK + p_pos] = p_row; TOPE[(size_t)p_row * 4 + e] = (p_ee << 20) | (int)p_pos; TOPW[(size_t)p_row * 4 + e] = p_ww; }
#undef LN1_FETCH
}
__device__ __forceinline__ void moe_tables(CArgs& a, int l, LAS unsigned char* lds, int NT) {
    LAS int* pre = (LAS int*)(lds + TAB_OFF); LAS int* mtl = pre + 40; LAS int* rowoff = pre + 80; LAS int* cn = pre + 120;
    if (tidx() == 0) { const unsigned* cnt = (const unsigned*)(a.ws + WS_CTL) + CW_CNT + l * NEXP * 64; int p = 0, r = 0;
        for (int e = 0; e < NEXP; ++e) { const int n = (int)__hip_atomic_load(cnt + e * 64, __ATOMIC_RELAXED, __HIP_MEMORY_SCOPE_AGENT), m = (n + 255) >> 8; pre[e] = p; mtl[e] = m > 0 ? m : 1; rowoff[e] = r; cn[e] = n; p += m * NT; r += m * 256; }
        pre[32] = p; }
    __syncthreads();
}
__device__ __forceinline__ void ph_ln2(CArgs& a, int l, LAS unsigned char* lds, int gw, int ngw) {
    const int lane = tidx() & 63;
    const float* MOD = (const float*)(a.ws + WS_MOD) + (size_t)l * 17 * 6144;
    float* X = (float*)(a.ws + WS_X); const bf16* YD = (const bf16*)(a.ws + WS_YD); bf16* HB = (bf16*)(a.ws + WS_HB);
    const float* lg = a.in[I_LN2G] + l * D; const float* lb = a.in[I_LN2B] + l * D;
    const int* TOPE = (const int*)(a.ws + WS_TOPE); const float* TOPW = (const float*)(a.ws + WS_TOPW);
    const LAS int* rowoff = (const LAS int*)(lds + TAB_OFF) + 80;
    const bool lastl = (l == DEPTH - 1);
    const int row_lo = lastl ? NTOK_C : 0;
#pragma unroll 1
    for (int row0 = row_lo + gw * 2; row0 < NTOK; row0 += ngw * 2) {
        u32x2 y2[2][4][4]; float tw[2][4]; f32x4 xv[2][4], g2v[2][4];
#pragma unroll
        for (int r = 0; r < 2; ++r) {
            const int row = row0 + r;
#pragma unroll
            for (int k = 0; k < 4; ++k) { const int te = TOPE[(size_t)row * 4 + k]; tw[r][k] = TOPW[(size_t)row * 4 + k];
                const bf16* yr = YD + ((size_t)(rowoff[te >> 20] + (te & 0xfffff))) * D;
#pragma unroll
                for (int j = 0; j < 4; ++j) y2[r][k][j] = *(const u32x2*)(yr + j * 256 + 4 * lane); }
            const float* mv = MOD + (size_t)mod_vec(row) * 6144;
#pragma unroll
            for (int j = 0; j < 4; ++j) { const int c0 = j * 256 + 4 * lane; xv[r][j] = *(const f32x4*)(X + (size_t)row * D + c0); g2v[r][j] = *(const f32x4*)(mv + 5120 + c0); }
        }
#pragma unroll
        for (int r = 0; r < 2; ++r) {
            const int row = row0 + r;
            const float* mv = MOD + (size_t)mod_vec(row) * 6144;
            f32x4 v[4]; float s = 0.f;
#pragma unroll
            for (int j = 0; j < 4; ++j) { f32x4 f = (f32x4){0.f, 0.f, 0.f, 0.f};
#pragma unroll
                for (int k = 0; k < 4; ++k) { const u32x2 yy = y2[r][k][j]; f += tw[r][k] * (f32x4){lo_bf(yy.x), hi_bf(yy.x), lo_bf(yy.y), hi_bf(yy.y)}; }
                v[j] = DN_ALPHA * xv[r][j] + g2v[r][j] * f; s += (v[j][0] + v[j][1]) + (v[j][2] + v[j][3]); }
            const float mean = wave_sum(s) * (1.f / D); float s2 = 0.f;
#pragma unroll
            for (int j = 0; j < 4; ++j) { v[j] = v[j] - mean; s2 += (v[j][0] * v[j][0] + v[j][1] * v[j][1]) + (v[j][2] * v[j][2] + v[j][3] * v[j][3]); }
            const float rstd = rsqrtf(wave_sum(s2) * (1.f / D) + LN_EPS);
            const float* mvn = mv + 17 * 6144;
#pragma unroll
            for (int j = 0; j < 4; ++j) { const int c0 = j * 256 + 4 * lane; const f32x4 g = *(const f32x4*)(lg + c0), bb = *(const f32x4*)(lb + c0);
                const f32x4 xn = v[j] * rstd * g + bb;
                if (lastl) *(f32x4*)(a.out + (size_t)(row - NTOK_C) * D + c0) = xn;
                else { *(f32x4*)(X + (size_t)row * D + c0) = xn; const f32x4 sh = *(const f32x4*)(mvn + c0), sc = *(const f32x4*)(mvn + 1024 + c0); const f32x4 hh = xn * (1.f + sc) + sh;
                    u32x2 o; o.x = pk2(hh[0], hh[1]); o.y = pk2(hh[2], hh[3]); *(u32x2*)(HB + (size_t)row * D + c0) = o; } }
        }
    }
}

constexpr int NPH = 2 + DEPTH * 9;
__device__ __forceinline__ CArgs* kargs() { CArgs* p = (CArgs*)__builtin_amdgcn_kernarg_segment_ptr(); asm volatile("" : "+s"(p)); return p; }
__global__ void __launch_bounds__(512, 2) trunk_fwd(Args a_unused) {
    extern __shared__ __attribute__((aligned(16))) unsigned char lds_raw[];
    LAS unsigned char* lds = (LAS unsigned char*)lds_raw;
    const int tid = threadIdx.x, wave = __builtin_amdgcn_readfirstlane(tid >> 6);
    const int bid = blockIdx.x, nblk = gridDim.x, gw = bid * 8 + wave, ngw = nblk * 8;
    volatile LAS unsigned* MISC = (volatile LAS unsigned*)(lds + MISC_OFF);
    if (tid < 64) MISC[tid] = 0u;
    __syncthreads();
    XcdBarrier bar; bar.x = 0; bar.st = nullptr;
    int lo, hi;
    { CArgs& a = *kargs(); lo = a.ph_lo; hi = a.ph_hi; bar.bar = (unsigned*)(a.ws + WS_CTL) + CW_BAR;
      if (hi - lo > 1) bar = xcd_barrier_post((unsigned*)(a.ws + WS_CTL) + CW_BAR, MISC); }
#define IN(k) (lo <= (k) && (k) < hi)
    unsigned long long tacc = 0ull, tbeg = 0ull;
#define PB_BEG(ty) do { if (PROBE_PH == (ty)) tbeg = __builtin_amdgcn_s_memrealtime(); } while (0)
#define PB_END(ty) do { if (PROBE_PH == (ty)) tacc += __builtin_amdgcn_s_memrealtime() - tbeg; } while (0)
#define SEAM(k) do { if (IN(k) && IN((k) + 1)) xcd_barrier(bar); } while (0)
    PB_BEG(0);
    if (IN(0)) { CArgs& a = *kargs(); unsigned long long t0 = 0ull;
#define PB_SUB(ty, stmt) do { if (PROBE_PH == (ty)) t0 = __builtin_amdgcn_s_memrealtime(); stmt; if (PROBE_PH == (ty)) tacc += __builtin_amdgcn_s_memrealtime() - t0; } while (0)
        PB_SUB(30, ph_mod(a, lds, bid, nblk)); __syncthreads(); PB_SUB(31, ph_filters(a, gw, ngw)); PB_SUB(32, ph_tr_small(a, lds, gw, ngw)); PB_SUB(33, ph_router_w(a, bid * 512 + tid, nblk * 512));
#undef PB_SUB
    }
    SEAM(0); PB_END(0); PB_BEG(1);
    if (IN(1)) { CArgs& a = *kargs(); ph_mod_input(a, gw, ngw); }
    SEAM(1); PB_END(1);
#pragma unroll 1
    for (int l = 0; l < DEPTH; ++l) {
        const int p0 = 2 + 9 * l;
        const bool lastl = (l == DEPTH - 1);
        PB_BEG(2);
        if (IN(p0 + 0)) {
            CArgs& a = *kargs();
            pg8::DenseSched S; S.init((const bf16*)(a.ws + WS_WIN) + (size_t)l * D_INP * 1024, 1024, NTOK, D_INP, nblk, bid, 0);
            pg8::EpiBf16 E{(bf16*)(a.ws + WS_P), D_INP, 0};
            pg8::gemm_phase<pg8::EpiBf16, pg8::DenseSched, true>(lds, (const char*)(a.ws + WS_HB), 1024, S, E);
        }
        SEAM(p0 + 0); PB_END(2); PB_BEG(3);
        if (IN(p0 + 1)) { CArgs& a = *kargs(); ph_prep_conv(a, l, lds, bid, nblk); ph_prep_tok(a, l, gw, ngw); }
        SEAM(p0 + 1); PB_END(3); PB_BEG(4);
        if (IN(p0 + 2)) { CArgs& a = *kargs(); ph_scan(a, l, lds, bid, nblk, tacc); }
        SEAM(p0 + 2); PB_END(4); PB_BEG(5);
        if (IN(p0 + 3)) { CArgs& a = *kargs(); ph_post_hyena(a, l, lds, bid, nblk); ph_post_tok(a, l, gw, ngw); }
        SEAM(p0 + 3); PB_END(5); PB_BEG(6);
        if (IN(p0 + 4)) {
            CArgs& a = *kargs();
            const int r0 = lastl ? NTOK_C : 0;
            pg8::DenseSched S; S.init((const bf16*)(a.ws + WS_WOUT) + (size_t)l * 1024 * 1024, 1024, NTOK - r0, 1024, nblk, bid, r0);
            pg8::EpiF32 E{(float*)(a.ws + WS_TMP), 1024, r0};
            pg8::gemm_phase<pg8::EpiF32, pg8::DenseSched, true>(lds, (const char*)(a.ws + WS_YMIX), 1024, S, E);
        }
        SEAM(p0 + 4); PB_END(6); PB_BEG(7);
        if (IN(p0 + 5)) { CArgs& a = *kargs(); ph_ln1_route(a, l, lds, bid, nblk); }
        SEAM(p0 + 5); PB_END(7); PB_BEG(8);
        if (IN(p0 + 6)) {
            CArgs& a = *kargs();
            moe_tables(a, l, lds, 8);
            const LAS int* tb = (const LAS int*)(lds + TAB_OFF);
            pg8::MoeSched<true, 8> S; S.Bt = (const char*)(a.ws + WS_WGU); S.bstride = (size_t)2048 * 1024 * 2; S.rb = 2048; S.list = (const int*)(a.ws + WS_LIST);
            S.pre = tb; S.mtl = tb + 40; S.rowoff = tb + 80; S.cnt = tb + 120; S.K = 1024; S.G = nblk; S.c = (nblk % 8 == 0) ? (bid % 8) * (nblk / 8) + bid / 8 : bid; S.total = tb[32];
            pg8::EpiSwiglu E{(bf16*)(a.ws + WS_H), a.in[I_BG] + (size_t)l * NEXP * 1024, a.in[I_BU] + (size_t)l * NEXP * 1024, tb + 80};
            pg8::gemm_phase<pg8::EpiSwiglu, pg8::MoeSched<true, 8>, true>(lds, (const char*)(a.ws + WS_HB), 1024, S, E);
        }
        SEAM(p0 + 6); PB_END(8); PB_BEG(9);
        if (IN(p0 + 7)) {
            CArgs& a = *kargs();
            moe_tables(a, l, lds, 4);
            const LAS int* tb = (const LAS int*)(lds + TAB_OFF);
            pg8::MoeSched<false, 4> S; S.Bt = (const char*)(a.ws + WS_WD); S.bstride = (size_t)1024 * 1024; S.rb = 1024; S.list = nullptr;
            S.pre = tb; S.mtl = tb + 40; S.rowoff = tb + 80; S.cnt = tb + 120; S.K = 1024; S.G = nblk; S.c = (nblk % 8 == 0) ? (bid % 8) * (nblk / 8) + bid / 8 : bid; S.total = tb[32];
            pg8::EpiDown E{(bf16*)(a.ws + WS_YD), a.in[I_BD] + (size_t)l * NEXP * 1024, tb + 80, 1.f / 32.f};
            pg8::gemm_phase_f8<pg8::EpiDown, pg8::MoeSched<false, 4>, true>(lds, (const char*)(a.ws + WS_H), 1024, S, E);
        }
        SEAM(p0 + 7); PB_END(9); PB_BEG(10);
        if (IN(p0 + 8)) { CArgs& a = *kargs(); moe_tables(a, l, lds, 4); ph_ln2(a, l, lds, gw, ngw); }
        if (!lastl) SEAM(p0 + 8);
        PB_END(10);
    }
    if (PROBE_PH >= 0) { const unsigned long long t0 = __builtin_amdgcn_s_memrealtime(); while (__builtin_amdgcn_s_memrealtime() - t0 < tacc) __builtin_amdgcn_s_sleep(8); }
#undef IN
#undef SEAM
}

extern "C" void kernel_launch(void* const* d_in, const int* in_sizes, int n_in, void* d_out, int out_size, void* d_ws, size_t ws_size, hipStream_t stream) {
    static int grid = 0;
    if (grid == 0) {
        if (n_in != 39 || out_size != NTOK_L * D || ws_size < WS_END) { fprintf(stderr, "kernel_launch: unexpected problem (n_in %d, out %d, ws %zu < %zu)\n", n_in, out_size, ws_size, (size_t)WS_END); grid = -1; return; }
        int dev = 0, cus = 0, per_cu = 0;
        if (hipGetDevice(&dev) != hipSuccess || hipDeviceGetAttribute(&cus, hipDeviceAttributeMultiprocessorCount, dev) != hipSuccess) { grid = -1; return; }
        if (hipFuncSetAttribute((const void*)trunk_fwd, hipFuncAttributeMaxDynamicSharedMemorySize, LDS_BYTES) != hipSuccess) { fprintf(stderr, "kernel_launch: hipFuncSetAttribute failed\n"); grid = -1; return; }
        if (hipOccupancyMaxActiveBlocksPerMultiprocessor(&per_cu, (const void*)trunk_fwd, 512, LDS_BYTES) != hipSuccess || per_cu < 1) fprintf(stderr, "kernel_launch: occupancy query says %d\n", per_cu);
        (void)hipGetLastError();
        grid = cus;
    }
    if (grid < 0) return;
    (void)hipMemsetAsync((char*)d_ws + WS_CTL, 0, CTL_ZERO_BYTES, stream);
    Args a{};
    for (int i = 0; i < 39; ++i) a.in[i] = (const float*)d_in[i];
    a.out = (float*)d_out; a.ws = (unsigned char*)d_ws;
#if MK_FUSED
    a.ph_lo = 0; a.ph_hi = NPH;
    hipLaunchKernelGGL(trunk_fwd, dim3(grid), dim3(512), LDS_BYTES, stream, a);
#else
    for (int p = 0; p < NPH; ++p) { a.ph_lo = p; a.ph_hi = p + 1; hipLaunchKernelGGL(trunk_fwd, dim3(grid), dim3(512), LDS_BYTES, stream, a); }
#endif
}
```

```cpp
#include <hip/hip_runtime.h>
#include <cstdio>
#include <cstdint>

#ifndef MK_FUSED
#define MK_FUSED 1
#endif

#ifndef USE_NEW_GDN
#define USE_NEW_GDN 1
#endif
#ifndef USE_NEW_GLA
#define USE_NEW_GLA 1
#endif
#ifndef PROBE_PH
#define PROBE_PH -1
#endif

#define LAS __attribute__((address_space(3)))
#define GAS __attribute__((address_space(1)))
typedef unsigned short bf16;
typedef short bf16x8 __attribute__((ext_vector_type(8)));
typedef float f32x4 __attribute__((ext_vector_type(4)));
typedef float f32x2 __attribute__((ext_vector_type(2)));
typedef unsigned u32x4 __attribute__((ext_vector_type(4)));
typedef unsigned u32x2 __attribute__((ext_vector_type(2)));

constexpr int D = 1024, NB = 16, SEQ = 2048, CTXL = 256, DEPTH = 4;
constexpr int NTOK_C = NB * CTXL, NTOK_L = NB * SEQ, NTOK = NTOK_C + NTOK_L;
constexpr int D_IN = 3376, D_INP = 3584;
constexpr int HY0 = 0, SC0 = 768, GLA0 = 1536, GDN0 = 2336;
constexpr int NEXP = 32, TOPK = 4;
constexpr int MAXROWS = NTOK * TOPK + NEXP * 256;
constexpr float DN_ALPHA = 1.681792830507429f;
constexpr float LN_EPS = 1e-5f;

constexpr size_t MiB = 1u << 20;
constexpr size_t WS_CTL = 0, CTL_ZERO_BYTES = 1 * MiB;
constexpr size_t WS_MOD = 1 * MiB;
constexpr size_t WS_WRT = 3 * MiB;
constexpr size_t WS_KUN = 4 * MiB;
constexpr size_t WS_WIN = 36 * MiB;
constexpr size_t WS_WOUT = 64 * MiB;
constexpr size_t WS_WGU = 72 * MiB;
constexpr size_t WS_WD = 200 * MiB;
constexpr size_t WS_X = 264 * MiB;
constexpr size_t WS_HB = 408 * MiB;
constexpr size_t WS_P = 480 * MiB;
constexpr size_t WS_YMIX = 732 * MiB;
constexpr size_t WS_YD = WS_P;
constexpr size_t WS_TMP = 804 * MiB;
constexpr size_t WS_LIST = 948 * MiB;
constexpr size_t WS_TOPE = 953 * MiB;
constexpr size_t WS_TOPW = 954 * MiB;
constexpr size_t WS_H = 956 * MiB;
constexpr size_t WS_MIX = 1264 * MiB;
constexpr size_t MX_ZT = 0;
constexpr size_t MX_YT = 20 * MiB;
constexpr size_t MX_GDF = 56 * MiB, MX_GDB = 76 * MiB;
constexpr size_t MX_GOF = 96 * MiB, MX_GOB = 132 * MiB;
constexpr size_t MX_DQ = 168 * MiB, MX_DK = 204 * MiB, MX_DV = 240 * MiB;
constexpr size_t MX_DG = 276 * MiB;
constexpr size_t MX_DOF = 280 * MiB, MX_DOB = 316 * MiB;
constexpr size_t WS_HB8 = 1616 * MiB;
constexpr size_t WS_END = 1656 * MiB;
static_assert((size_t)MAXROWS * 1024 * 2 <= 324 * MiB, "YD overlay");
static_assert(WS_H + (size_t)MAXROWS * 1024 * 2 <= WS_MIX, "H");
constexpr int CW_BAR = 4096;
constexpr int CW_CNT = 16384;

constexpr int LDS_BYTES = 147456;
constexpr int MISC_OFF = 131072;
constexpr int TAB_OFF = 131072 + 256;

__device__ __forceinline__ float bf2f(unsigned v) { return __uint_as_float(v << 16); }
__device__ __forceinline__ unsigned f2bf(float f) { unsigned u = __float_as_uint(f); return (u + 0x7fffu + ((u >> 16) & 1u)) >> 16; }
__device__ __forceinline__ unsigned pk2(float lo, float hi) { return f2bf(lo) | (f2bf(hi) << 16); }
__device__ __forceinline__ unsigned pk4_fp8(float a, float b, float c, float d) { int r = __builtin_amdgcn_cvt_pk_fp8_f32(a, b, 0, false); return (unsigned)__builtin_amdgcn_cvt_pk_fp8_f32(c, d, r, true); }
__device__ __forceinline__ float lo_bf(unsigned w) { return __uint_as_float(w << 16); }
__device__ __forceinline__ float hi_bf(unsigned w) { return __uint_as_float(w & 0xffff0000u); }
__device__ __forceinline__ float sigmoidf_(float x) { return 1.f / (1.f + __expf(-x)); }
__device__ __forceinline__ float siluf_(float x) { return x / (1.f + __expf(-x)); }
__device__ __forceinline__ float softplusf_(float x) { return x > 20.f ? x : log1pf(__expf(x)); }
__device__ __forceinline__ float logsigmoidf_(float x) { return x >= 0.f ? -log1pf(__expf(-x)) : x - log1pf(__expf(x)); }
__device__ __forceinline__ float sin_rev(float r) { return __builtin_amdgcn_sinf(__builtin_amdgcn_fractf(r)); }
__device__ __forceinline__ float sin_rad(float x) { return sin_rev(x * 0.15915494309189535f); }
template <int CTRL> __device__ __forceinline__ float dpp_f(float v) { return __builtin_bit_cast(float, __builtin_amdgcn_update_dpp(0, __builtin_bit_cast(int, v), CTRL, 0xf, 0xf, true)); }
template <int CTRL> __device__ __forceinline__ int dpp_i(int v) { return __builtin_amdgcn_update_dpp(0, v, CTRL, 0xf, 0xf, true); }
__device__ __forceinline__ float quad_sum(float v) { v += dpp_f<0xB1>(v); v += dpp_f<0x4E>(v); return v; }
__device__ __forceinline__ float row16_sum(float v) { v += dpp_f<0xB1>(v); v += dpp_f<0x4E>(v); v += dpp_f<0x141>(v); v += dpp_f<0x140>(v); return v; }
__device__ __forceinline__ float rdlane_f(float v, int l) { return __builtin_bit_cast(float, __builtin_amdgcn_readlane(__builtin_bit_cast(int, v), l)); }
__device__ __forceinline__ float wave_sum(float v) {
    v = row16_sum(v);
    return (rdlane_f(v, 0) + rdlane_f(v, 16)) + (rdlane_f(v, 32) + rdlane_f(v, 48));
}
__device__ __forceinline__ int tidx() { int t = threadIdx.x; asm volatile("" : "+v"(t)); return t; }

#define XB_TMO      128
#define XB_XCNT(j)  (256  + 64 * (j))
#define XB_XSUB(j)  (1280 + 64 * (j))
#define XB_XGEN(j)  (2304 + 64 * (j))
#define XB_TOP      3328
#define XB_TOPGEN   3392
#define XCD_BAR_WORDS 3456
#define XB_SPIN_CAP (1u << 25)
__device__ __forceinline__ unsigned xb_ld(unsigned* p)              { return __hip_atomic_load(p, __ATOMIC_RELAXED, __HIP_MEMORY_SCOPE_AGENT); }
__device__ __forceinline__ unsigned xb_add(unsigned* p, unsigned v) { return __hip_atomic_fetch_add(p, v, __ATOMIC_RELAXED, __HIP_MEMORY_SCOPE_AGENT); }
__device__ __forceinline__ unsigned xb_xcc_id() { return (unsigned)__builtin_amdgcn_s_getreg((3 << 11) | 20) & 0xFu; }
#define XB_SPIN(cond, bar) do { unsigned _sp = 0; while (cond) { __builtin_amdgcn_s_sleep(1); \
    if ((++_sp & 255u) == 0u) { if (xb_ld(&(bar)[XB_TMO])) break; if (_sp > XB_SPIN_CAP) { atomicAdd(&(bar)[XB_TMO], 1u); break; } } } } while (0)
struct XcdBarrier { unsigned* bar; unsigned x; volatile LAS unsigned* st; };
__device__ __forceinline__ XcdBarrier xcd_barrier_post(unsigned* bar, volatile LAS unsigned* st) {
    XcdBarrier b; b.bar = bar; b.x = xb_xcc_id(); b.st = st;
    if (threadIdx.x == 0) (void)xb_add(&bar[XB_XCNT(b.x)], 1u);
    return b;
}
__device__ __forceinline__ void xcd_barrier_complete(unsigned* bar, unsigned x, unsigned& nloc, unsigned& nx) {
    const unsigned G = gridDim.x * gridDim.y * gridDim.z;
    unsigned sum, cnt, mine, sp = 0u;
    for (;;) {
        sum = 0u; cnt = 0u; mine = 0u;
#pragma unroll
        for (unsigned j = 0; j < 16; ++j) { const unsigned c = xb_ld(&bar[XB_XCNT(j)]); sum += c; cnt += (c > 0u) ? 1u : 0u; mine = (j == x) ? c : mine; }
        if (sum == G) break;
        __builtin_amdgcn_s_sleep(1);
        if ((++sp & 255u) == 0u) { if (xb_ld(&bar[XB_TMO])) break; if (sp > XB_SPIN_CAP) { atomicAdd(&bar[XB_TMO], 1u); break; } }
    }
    nloc = mine > 0u ? mine : 1u; nx = cnt > 0u ? cnt : 1u;
}
__device__ __forceinline__ void xcd_barrier(const XcdBarrier& b) {
    asm volatile("s_waitcnt vmcnt(0)" ::: "memory");
    __syncthreads();
    if (threadIdx.x == 0) {
        unsigned* bar = b.bar;
        __builtin_amdgcn_s_waitcnt(0);
        unsigned nloc = b.st[0], nx = b.st[1];
        if (nloc == 0u) { xcd_barrier_complete(bar, b.x, nloc, nx); b.st[0] = nloc; b.st[1] = nx; }
        const unsigned old = xb_add(&bar[XB_XSUB(b.x)], 1u);
        const unsigned gen = old / nloc;
        if (old + 1u == (gen + 1u) * nloc) {
            __builtin_amdgcn_fence(__ATOMIC_RELEASE, "agent");
            asm volatile("s_waitcnt vmcnt(0)" ::: "memory");
            const unsigned og = xb_add(&bar[XB_TOP], 1u);
            const unsigned tg = og / nx;
            if (og + 1u == (tg + 1u) * nx) xb_add(&bar[XB_TOPGEN], 1u);
            else XB_SPIN(xb_ld(&bar[XB_TOPGEN]) == tg, bar);
            __builtin_amdgcn_fence(__ATOMIC_ACQUIRE, "agent");
            xb_add(&bar[XB_XGEN(b.x)], 1u);
            asm volatile("s_waitcnt vmcnt(0)" ::: "memory");
        } else {
            XB_SPIN(xb_ld(&bar[XB_XGEN(b.x)]) == gen, bar);
            __builtin_amdgcn_fence(__ATOMIC_ACQUIRE, "agent");
            asm volatile("s_waitcnt vmcnt(0)" ::: "memory");
        }
    }
    __syncthreads();
}

namespace pg8 {
constexpr int BM = 256, BK = 64, HALF = 128, HTB = HALF * BK * 2, STAGE_BYTES = 8 * HTB, NXCD = 8, WGM = 8;
__host__ __device__ __forceinline__ int lds_byte(int r, int c) { const int st = (r >> 4) * 2 + (c >> 5), rr = r & 15, cc = c & 31, ob = rr * 64 + cc * 2; return st * 1024 + (ob ^ (((ob >> 9) & 1) << 5)); }
__host__ __device__ __forceinline__ void stage_rc(int b, int& R, int& C) { const int st = b / 1024, sb = b % 1024, swz = sb ^ (((sb >> 9) & 1) << 5); R = (st >> 1) * 16 + swz / 64; C = (st & 1) * 32 + (swz % 64) / 2; }
__host__ __device__ __forceinline__ int perm32(int rho) { const int n = rho >> 4, i = rho & 15; return 8 * (i >> 2) + 4 * n + (i & 3); }
__device__ __forceinline__ unsigned cvt_pk_bf16(float lo, float hi) { unsigned r; asm volatile("v_cvt_pk_bf16_f32 %0, %1, %2" : "=v"(r) : "v"(lo), "v"(hi)); return r; }

struct Unit { int pm, pn, e, mt; };

struct DenseSched {
    const char* Bt; int K, nM, nN, nwg, G, c, row0;
    __device__ __forceinline__ void init(const bf16* Bt_, int K_, int M, int N, int G_, int c_, int row0_) { Bt = (const char*)Bt_; K = K_; nM = M / BM; nN = N / BM; nwg = nM * nN; G = G_; c = c_; row0 = row0_; }
    __device__ __forceinline__ bool next(int i, Unit& u) const {
        const long L = (long)i * G + c; if (L >= nwg) return false;
        int wgid = (int)L; { const int q = nwg / NXCD, r = nwg % NXCD, xcd = wgid % NXCD, off = wgid / NXCD; wgid = (xcd < r ? xcd * (q + 1) : r * (q + 1) + (xcd - r) * q) + off; }
        const int nig = WGM * nN, gid = wgid / nig, fm = gid * WGM, gsz = (nM - fm) < WGM ? (nM - fm) : WGM;
        u.pm = fm + ((wgid % nig) % gsz); u.pn = (wgid % nig) / gsz; u.e = 0; u.mt = 0; return true;
    }
    __device__ __forceinline__ const char* b_ptr(const Unit& u) const { return Bt + (size_t)u.pn * (size_t)(BM * 2) * K; }
    __device__ __forceinline__ void a_offsets(const Unit& u, const int (&R)[2], const int (&C)[2], unsigned (&v)[2][2]) const {
#pragma unroll
        for (int h = 0; h < 2; ++h)
#pragma unroll
            for (int i = 0; i < 2; ++i) v[h][i] = (unsigned)((row0 + u.pm * BM + h * HALF + R[i]) * K + C[i]) * 2u;
    }
};
template <bool GATHER, int NT>
struct MoeSched {
    const char* Bt; size_t bstride;
    int rb;
    const int* list;
    const LAS int* pre; const LAS int* mtl; const LAS int* rowoff; const LAS int* cnt;
    int K, G, c, total;
    __device__ __forceinline__ bool next(int i, Unit& u) const {
        const int L = i * G + c; if (L >= total) return false;
        int e = 0;
#pragma unroll 1
        for (int j = 1; j < NEXP; ++j) e = (L >= pre[j]) ? j : e;
        const int rem = L - pre[e];
        u.e = e; u.pn = rem % NT; u.mt = rem / NT; u.pm = 0; return true;
    }
    __device__ __forceinline__ const char* b_ptr(const Unit& u) const { return Bt + (size_t)u.e * bstride + (size_t)u.pn * (size_t)BM * rb; }
    __device__ __forceinline__ const char* a_ptr(const Unit& u, const char* Abase) const { return Abase + (size_t)(rowoff[u.e] + u.mt * BM) * rb; }
    __device__ __forceinline__ void a_offsets(const Unit& u, const int (&R)[2], const int (&C)[2], unsigned (&v)[2][2]) const {
        if (GATHER) {
            const int n = cnt[u.e]; const int* lp = list + (size_t)u.e * NTOK;
#pragma unroll
            for (int h = 0; h < 2; ++h)
#pragma unroll
                for (int i = 0; i < 2; ++i) { const int idx = u.mt * BM + h * HALF + R[i]; const int tok = idx < n ? lp[idx] : 0; v[h][i] = (unsigned)(tok * rb + 2 * C[i]); }
        } else {
            const int r0 = rowoff[u.e] + u.mt * BM;
#pragma unroll
            for (int h = 0; h < 2; ++h)
#pragma unroll
                for (int i = 0; i < 2; ++i) v[h][i] = (unsigned)((r0 + h * HALF + R[i]) * K + C[i]) * 2u;
        }
    }
};

struct EpiBf16 {
    static constexpr bool PERM = true;
    bf16* O; int ldc; int row0;
    __device__ __forceinline__ void operator()(const f32x4 (&acc)[2][2][4][2], const Unit& u, int wr, int wc, int fr, int fq) const {
        const int r0 = row0 + u.pm * BM + wr * 64 + fr, col0 = u.pn * BM + wc * 32 + 8 * fq;
#pragma unroll
        for (int ai = 0; ai < 2; ++ai)
#pragma unroll
            for (int m = 0; m < 4; ++m) { bf16* rowp = O + (size_t)(r0 + ai * HALF + m * 16) * ldc + col0;
#pragma unroll
                for (int bj = 0; bj < 2; ++bj) { const f32x4 v0 = acc[ai][bj][m][0], v1 = acc[ai][bj][m][1];
                    u32x4 w; w.x = cvt_pk_bf16(v0[0], v0[1]); w.y = cvt_pk_bf16(v0[2], v0[3]); w.z = cvt_pk_bf16(v1[0], v1[1]); w.w = cvt_pk_bf16(v1[2], v1[3]);
                    *(u32x4*)(rowp + bj * HALF) = w; } }
    }
};
struct EpiF32 {
    static constexpr bool PERM = false;
    float* Cc; int ldc; int row0;
    __device__ __forceinline__ void operator()(const f32x4 (&acc)[2][2][4][2], const Unit& u, int wr, int wc, int fr, int fq) const {
        const int r0 = row0 + u.pm * BM + wr * 64 + fr, col0 = u.pn * BM + wc * 32 + 4 * fq;
#pragma unroll
        for (int ai = 0; ai < 2; ++ai)
#pragma unroll
            for (int m = 0; m < 4; ++m) { float* rowp = Cc + (size_t)(r0 + ai * HALF + m * 16) * ldc + col0;
#pragma unroll
                for (int bj = 0; bj < 2; ++bj)
#pragma unroll
                    for (int n = 0; n < 2; ++n) *(f32x4*)(rowp + bj * HALF + n * 16) = acc[ai][bj][m][n]; }
    }
};
struct EpiSwiglu {
    static constexpr bool PERM = true;
    bf16* H; const float* bg; const float* bu; const LAS int* rowoff; float ws;
    __device__ __forceinline__ void operator()(const f32x4 (&acc)[2][2][4][2], const Unit& u, int wr, int wc, int fr, int fq) const {
        const int r0 = rowoff[u.e] + u.mt * BM + wr * 64 + fr, j0 = u.pn * HALF + wc * 32 + 8 * fq;
        f32x4 gb[2], ub[2];
#pragma unroll
        for (int n = 0; n < 2; ++n) { gb[n] = *(const f32x4*)(bg + u.e * 1024 + j0 + 4 * n); ub[n] = *(const f32x4*)(bu + u.e * 1024 + j0 + 4 * n); }
#pragma unroll
        for (int ai = 0; ai < 2; ++ai)
#pragma unroll
            for (int m = 0; m < 4; ++m) { unsigned char* rowp = (unsigned char*)H + (size_t)(r0 + ai * HALF + m * 16) * 1024 + j0; float hv[8];
#pragma unroll
                for (int n = 0; n < 2; ++n)
#pragma unroll
                    for (int j = 0; j < 4; ++j) { float g = acc[ai][0][m][n][j] * ws + gb[n][j], up = acc[ai][1][m][n][j] * ws + ub[n][j];
                        g = fminf(g, 7.f); up = fminf(fmaxf(up, -7.f), 7.f);
                        hv[n * 4 + j] = (up + 1.f) * g * __builtin_amdgcn_rcpf(1.f + __expf(-1.702f * g)); }
                *(u32x2*)rowp = (u32x2){pk4_fp8(hv[0], hv[1], hv[2], hv[3]), pk4_fp8(hv[4], hv[5], hv[6], hv[7])}; }
    }
};
struct EpiDown {
    static constexpr bool PERM = true;
    bf16* Y; const float* bd; const LAS int* rowoff; float ws;
    __device__ __forceinline__ void operator()(const f32x4 (&acc)[2][2][4][2], const Unit& u, int wr, int wc, int fr, int fq) const {
        const int r0 = rowoff[u.e] + u.mt * BM + wr * 64 + fr, col0 = u.pn * BM + wc * 32 + 8 * fq;
        f32x4 bv[2][2];
#pragma unroll
        for (int bj = 0; bj < 2; ++bj)
#pragma unroll
            for (int n = 0; n < 2; ++n) bv[bj][n] = *(const f32x4*)(bd + u.e * 1024 + col0 + bj * HALF + 4 * n);
#pragma unroll
        for (int ai = 0; ai < 2; ++ai)
#pragma unroll
            for (int m = 0; m < 4; ++m) { bf16* rowp = Y + (size_t)(r0 + ai * HALF + m * 16) * 1024 + col0;
#pragma unroll
                for (int bj = 0; bj < 2; ++bj) { const f32x4 v0 = acc[ai][bj][m][0] * ws + bv[bj][0], v1 = acc[ai][bj][m][1] * ws + bv[bj][1];
                    u32x4 w; w.x = cvt_pk_bf16(v0[0], v0[1]); w.y = cvt_pk_bf16(v0[2], v0[3]); w.z = cvt_pk_bf16(v1[0], v1[1]); w.w = cvt_pk_bf16(v1[2], v1[3]);
                    *(u32x4*)(rowp + bj * HALF) = w; } }
    }
};

template <class Epi, class Sched, bool ALIGN_EPI>
__device__ __forceinline__ void gemm_phase(LAS unsigned char* lds, const char* Abase, const int K, const Sched& S, const Epi& E) {
    const int tid = tidx(), wid = __builtin_amdgcn_readfirstlane(tid >> 6), lane = tid & 63, wr = wid >> 2, wc = wid & 3, fr = lane & 15, fq = lane >> 4;
    const int nt = K / BK;
    int Rp[2], Cp[2]; unsigned voffB0;
#pragma unroll
    for (int i = 0; i < 2; ++i) stage_rc(tid * 16 + i * 8192, Rp[i], Cp[i]);
    { const int Rb = Epi::PERM ? ((Rp[0] & ~31) + perm32(Rp[0] & 31)) : Rp[0]; voffB0 = (unsigned)(Rb * K + Cp[0]) * 2u; }
    const size_t kstep = (size_t)(BK * 2);
    const size_t hstep = (size_t)HALF * K * 2;
    const unsigned ldsw = (unsigned)wid * 1024u;
    const int aoff = lds_byte(wr * 64 + fr, fq * 8), boff = lds_byte(wc * 32 + fr, fq * 8);
#define PG8_SA(b, h) (((b) * 2 + (h)) * HTB)
#define PG8_SB(b, h) ((4 + (b) * 2 + (h)) * HTB)
#define PG8_STAGE(bufoff, gbase, voff) do { _Pragma("unroll") for (int _i = 0; _i < 2; ++_i) \
        __builtin_amdgcn_global_load_lds((const unsigned*)((const char*)(gbase) + (voff)[_i]), (LAS unsigned*)(lds + (bufoff) + ldsw + _i * 8192), 16, 0, 0); } while (0)
#define PG8_STAGEB(bufoff, gbase) do { _Pragma("unroll") for (int _i = 0; _i < 2; ++_i) \
        __builtin_amdgcn_global_load_lds((const unsigned*)((const char*)(gbase) + (size_t)_i * 128 * K + voffB0), (LAS unsigned*)(lds + (bufoff) + ldsw + _i * 8192), 16, 0, 0); } while (0)
#define PG8_LDA(dst, b, h) do { _Pragma("unroll") for (int m = 0; m < 4; ++m) _Pragma("unroll") for (int k = 0; k < 2; ++k) dst[m][k] = *(const LAS bf16x8*)(lds + PG8_SA(b, h) + aoff + m * 2048 + k * 1024); } while (0)
#define PG8_LDB(dst, b, h) do { _Pragma("unroll") for (int n = 0; n < 2; ++n) _Pragma("unroll") for (int k = 0; k < 2; ++k) dst[n][k] = *(const LAS bf16x8*)(lds + PG8_SB(b, h) + boff + n * 2048 + k * 1024); } while (0)
#define PG8_MMA(ai, bj, At, Bt) do { __builtin_amdgcn_s_setprio(1); _Pragma("unroll") for (int m = 0; m < 4; ++m) _Pragma("unroll") for (int n = 0; n < 2; ++n) _Pragma("unroll") for (int k = 0; k < 2; ++k) \
        acc[ai][bj][m][n] = __builtin_amdgcn_mfma_f32_16x16x32_bf16(Bt[n][k], At[m][k], acc[ai][bj][m][n], 0, 0, 0); __builtin_amdgcn_s_setprio(0); } while (0)
#define PG8_WAIT_V(n) asm volatile("s_waitcnt vmcnt(" #n ")" ::: "memory")
#define PG8_WAIT_L(n) asm volatile("s_waitcnt lgkmcnt(" #n ")" ::: "memory")
#define PG8_BAR __builtin_amdgcn_s_barrier()
#define PG8_SCHED __builtin_amdgcn_sched_barrier(0)
    Unit cur, nxt; int ui = 0;
    if (!S.next(0, cur)) return;
    f32x4 acc[2][2][4][2];
#pragma unroll
    for (int a = 0; a < 2; ++a)
#pragma unroll
        for (int b = 0; b < 2; ++b)
#pragma unroll
            for (int m = 0; m < 4; ++m)
#pragma unroll
                for (int n = 0; n < 2; ++n) acc[a][b][m][n] = (f32x4){0.f, 0.f, 0.f, 0.f};
    bf16x8 At[4][2], B0[2][2], B1[2][2];
    unsigned vAc[2][2], vAn[2][2];
    S.a_offsets(cur, Rp, Cp, vAc);
    const char* cB = S.b_ptr(cur);
    PG8_STAGEB(PG8_SB(0, 0), cB); PG8_STAGEB(PG8_SB(0, 1), cB + hstep); PG8_STAGE(PG8_SA(0, 0), Abase, vAc[0]); PG8_STAGE(PG8_SA(0, 1), Abase, vAc[1]);
    if (wr == 1) PG8_BAR;
    PG8_WAIT_V(2); PG8_BAR;
    PG8_STAGEB(PG8_SB(1, 0), cB + kstep); PG8_STAGE(PG8_SA(1, 0), Abase + kstep, vAc[0]); PG8_STAGEB(PG8_SB(1, 1), cB + hstep + kstep);
    PG8_WAIT_V(6); PG8_BAR;
    for (;;) {
        const bool has_next = S.next(ui + 1, nxt);
        const char* nB = has_next ? S.b_ptr(nxt) : cB;
        if (has_next) S.a_offsets(nxt, Rp, Cp, vAn);
        else {
#pragma unroll
            for (int h = 0; h < 2; ++h)
#pragma unroll
                for (int i = 0; i < 2; ++i) vAn[h][i] = vAc[h][i]; }
        for (int t = 0; t < nt; t += 2) {
            const bool last = (t == nt - 2);
            const char* a1 = Abase + (size_t)(t + 1) * kstep;
            const char* a2 = last ? Abase : Abase + (size_t)(t + 2) * kstep; const char* b2 = last ? nB : cB + (size_t)(t + 2) * kstep;
            const char* a3 = a2 + kstep; const char* b3 = b2 + kstep;
            unsigned v2[2][2];
#pragma unroll
            for (int h = 0; h < 2; ++h)
#pragma unroll
                for (int i = 0; i < 2; ++i) v2[h][i] = last ? vAn[h][i] : vAc[h][i];
            PG8_LDB(B0, 0, 0); PG8_LDB(B1, 0, 1); PG8_SCHED; PG8_LDA(At, 0, 0); PG8_STAGE(PG8_SA(1, 1), a1, vAc[1]);
            PG8_WAIT_V(8); PG8_WAIT_L(0); PG8_BAR; PG8_MMA(0, 0, At, B0); PG8_MMA(0, 1, At, B1); PG8_BAR; PG8_SCHED;
            PG8_LDA(At, 0, 1); PG8_STAGEB(PG8_SB(0, 0), b2); PG8_STAGEB(PG8_SB(0, 1), b2 + hstep); PG8_STAGE(PG8_SA(0, 0), a2, v2[0]);
            PG8_WAIT_V(8); PG8_WAIT_L(0); PG8_BAR; PG8_MMA(1, 0, At, B0); PG8_MMA(1, 1, At, B1); PG8_BAR; PG8_SCHED;
            PG8_LDB(B0, 1, 0); PG8_LDB(B1, 1, 1); PG8_SCHED; PG8_LDA(At, 1, 0); PG8_STAGE(PG8_SA(0, 1), a2, v2[1]);
            PG8_WAIT_V(8); PG8_WAIT_L(0); PG8_BAR; PG8_MMA(0, 0, At, B0); PG8_MMA(0, 1, At, B1); PG8_BAR; PG8_SCHED;
            PG8_LDA(At, 1, 1); PG8_STAGEB(PG8_SB(1, 0), b3); PG8_STAGEB(PG8_SB(1, 1), b3 + hstep); PG8_STAGE(PG8_SA(1, 0), a3, v2[0]);
            PG8_WAIT_V(8); PG8_WAIT_L(0); PG8_BAR; PG8_MMA(1, 0, At, B0); PG8_MMA(1, 1, At, B1); PG8_BAR; PG8_SCHED;
        }
        if constexpr (ALIGN_EPI) { if (wr == 0) PG8_BAR; }
        E(acc, cur, wr, wc, fr, fq);
        if (!has_next) break;
#pragma unroll
        for (int a = 0; a < 2; ++a)
#pragma unroll
            for (int b = 0; b < 2; ++b)
#pragma unroll
                for (int m = 0; m < 4; ++m)
#pragma unroll
                    for (int n = 0; n < 2; ++n) acc[a][b][m][n] = (f32x4){0.f, 0.f, 0.f, 0.f};
        cur = nxt; cB = nB; ++ui;
#pragma unroll
        for (int h = 0; h < 2; ++h)
#pragma unroll
            for (int i = 0; i < 2; ++i) vAc[h][i] = vAn[h][i];
        if constexpr (ALIGN_EPI) { if (wr == 1) PG8_BAR; }
    }
    PG8_WAIT_V(0);
    if constexpr (!ALIGN_EPI) { if (wr == 0) PG8_BAR; }
    PG8_BAR;
#undef PG8_SA
#undef PG8_SB
#undef PG8_STAGE
#undef PG8_STAGEB
#undef PG8_LDA
#undef PG8_LDB
#undef PG8_MMA
#undef PG8_WAIT_V
#undef PG8_WAIT_L
#undef PG8_BAR
#undef PG8_SCHED
}
template <class Epi, class Sched, bool ALIGN_EPI>
__device__ __forceinline__ void gemm_phase_f8g(LAS unsigned char* lds, const char* Abase, const int K, const Sched& S, const Epi& E) {
    const int tid = tidx(), wid = __builtin_amdgcn_readfirstlane(tid >> 6), lane = tid & 63, wr = wid >> 2, wc = wid & 3, fr = lane & 15, fq = lane >> 4;
    const int nt = K / 128;
    int Rp[2], Cp[2]; unsigned voffB0;
#pragma unroll
    for (int i = 0; i < 2; ++i) stage_rc(tid * 16 + i * 8192, Rp[i], Cp[i]);
    { const int Rb = Epi::PERM ? ((Rp[0] & ~31) + perm32(Rp[0] & 31)) : Rp[0]; voffB0 = (unsigned)(Rb * K + 2 * Cp[0]); }
    const size_t kstep = (size_t)(BK * 2);
    const size_t hstep = (size_t)HALF * K;
    const unsigned ldsw = (unsigned)wid * 1024u;
    const int aoff0 = lds_byte(wr * 64 + fr, 16 * (fq & 1)) + (fq >> 1) * 1024, boff0 = lds_byte(wc * 32 + fr, 16 * (fq & 1)) + (fq >> 1) * 1024;
#define PG8_SA(b, h) (((b) * 2 + (h)) * HTB)
#define PG8_SB(b, h) ((4 + (b) * 2 + (h)) * HTB)
#define PG8_STAGE(bufoff, gbase, voff) do { _Pragma("unroll") for (int _i = 0; _i < 2; ++_i) \
        __builtin_amdgcn_global_load_lds((const unsigned*)((const char*)(gbase) + (voff)[_i]), (LAS unsigned*)(lds + (bufoff) + ldsw + _i * 8192), 16, 0, 0); } while (0)
#define PG8_STAGEB(bufoff, gbase) do { _Pragma("unroll") for (int _i = 0; _i < 2; ++_i) \
        __builtin_amdgcn_global_load_lds((const unsigned*)((const char*)(gbase) + (size_t)_i * 64 * K + voffB0), (LAS unsigned*)(lds + (bufoff) + ldsw + _i * 8192), 16, 0, 0); } while (0)
#define PG8_LDA(dst, b, h) do { _Pragma("unroll") for (int m = 0; m < 4; ++m) { const u32x4 lo_ = *(const LAS u32x4*)(lds + PG8_SA(b, h) + aoff0 + m * 2048), hi_ = *(const LAS u32x4*)(lds + PG8_SA(b, h) + aoff0 + 16 + m * 2048); \
        dst[m] = (v8i){(int)lo_.x, (int)lo_.y, (int)lo_.z, (int)lo_.w, (int)hi_.x, (int)hi_.y, (int)hi_.z, (int)hi_.w}; } } while (0)
#define PG8_LDB(dst, b, h) do { _Pragma("unroll") for (int n = 0; n < 2; ++n) { const u32x4 lo_ = *(const LAS u32x4*)(lds + PG8_SB(b, h) + boff0 + n * 2048), hi_ = *(const LAS u32x4*)(lds + PG8_SB(b, h) + boff0 + 16 + n * 2048); \
        dst[n] = (v8i){(int)lo_.x, (int)lo_.y, (int)lo_.z, (int)lo_.w, (int)hi_.x, (int)hi_.y, (int)hi_.z, (int)hi_.w}; } } while (0)
#define PG8_MMA(ai, bj, At, Bt) do { __builtin_amdgcn_s_setprio(1); _Pragma("unroll") for (int m = 0; m < 4; ++m) _Pragma("unroll") for (int n = 0; n < 2; ++n) \
        asm volatile("v_mfma_scale_f32_16x16x128_f8f6f4 %0, %1, %2, %0, %3, %3 op_sel_hi:[0,0,0]" : "+v"(acc[ai][bj][m][n]) : "v"(Bt[n]), "v"(At[m]), "v"(f8scale)); __builtin_amdgcn_s_setprio(0); } while (0)
#define PG8_WAIT_V(n) asm volatile("s_waitcnt vmcnt(" #n ")" ::: "memory")
#define PG8_WAIT_L(n) asm volatile("s_waitcnt lgkmcnt(" #n ")" ::: "memory")
#define PG8_BAR __builtin_amdgcn_s_barrier()
#define PG8_SCHED __builtin_amdgcn_sched_barrier(0)
    Unit cur, nxt; int ui = 0;
    if (!S.next(0, cur)) return;
    f32x4 acc[2][2][4][2];
#pragma unroll
    for (int a = 0; a < 2; ++a)
#pragma unroll
        for (int b = 0; b < 2; ++b)
#pragma unroll
            for (int m = 0; m < 4; ++m)
#pragma unroll
                for (int n = 0; n < 2; ++n) acc[a][b][m][n] = (f32x4){0.f, 0.f, 0.f, 0.f};
    typedef int v8i __attribute__((ext_vector_type(8)));
    v8i At[4], B0[2], B1[2];
    const int f8scale = 0x7f7f7f7f;
    unsigned vAc[2][2], vAn[2][2];
    S.a_offsets(cur, Rp, Cp, vAc);
    const char* cB = S.b_ptr(cur);
    PG8_STAGEB(PG8_SB(0, 0), cB); PG8_STAGEB(PG8_SB(0, 1), cB + hstep); PG8_STAGE(PG8_SA(0, 0), Abase, vAc[0]); PG8_STAGE(PG8_SA(0, 1), Abase, vAc[1]);
    if (wr == 1) PG8_BAR;
    PG8_WAIT_V(2); PG8_BAR;
    PG8_STAGEB(PG8_SB(1, 0), cB + kstep); PG8_STAGE(PG8_SA(1, 0), Abase + kstep, vAc[0]); PG8_STAGEB(PG8_SB(1, 1), cB + hstep + kstep);
    PG8_WAIT_V(6); PG8_BAR;
    for (;;) {
        const bool has_next = S.next(ui + 1, nxt);
        const char* nB = has_next ? S.b_ptr(nxt) : cB;
        if (has_next) S.a_offsets(nxt, Rp, Cp, vAn);
        else {
#pragma unroll
            for (int h = 0; h < 2; ++h)
#pragma unroll
                for (int i = 0; i < 2; ++i) vAn[h][i] = vAc[h][i]; }
#pragma unroll 1
        for (int t = 0; t < nt; t += 2) {
            const bool last = (t == nt - 2);
            const char* a1 = Abase + (size_t)(t + 1) * kstep;
            const char* a2 = last ? Abase : Abase + (size_t)(t + 2) * kstep; const char* b2 = last ? nB : cB + (size_t)(t + 2) * kstep;
            const char* a3 = a2 + kstep; const char* b3 = b2 + kstep;
            unsigned v2[2][2];
#pragma unroll
            for (int h = 0; h < 2; ++h)
#pragma unroll
                for (int i = 0; i < 2; ++i) v2[h][i] = last ? vAn[h][i] : vAc[h][i];
            PG8_LDB(B0, 0, 0); PG8_LDB(B1, 0, 1); PG8_SCHED; PG8_LDA(At, 0, 0); PG8_STAGE(PG8_SA(1, 1), a1, vAc[1]);
            PG8_WAIT_V(8); PG8_WAIT_L(0); PG8_BAR; PG8_MMA(0, 0, At, B0); PG8_MMA(0, 1, At, B1); PG8_BAR; PG8_SCHED;
            PG8_LDA(At, 0, 1); PG8_STAGEB(PG8_SB(0, 0), b2); PG8_STAGEB(PG8_SB(0, 1), b2 + hstep); PG8_STAGE(PG8_SA(0, 0), a2, v2[0]);
            PG8_WAIT_V(8); PG8_WAIT_L(0); PG8_BAR; PG8_MMA(1, 0, At, B0); PG8_MMA(1, 1, At, B1); PG8_BAR; PG8_SCHED;
            PG8_LDB(B0, 1, 0); PG8_LDB(B1, 1, 1); PG8_SCHED; PG8_LDA(At, 1, 0); PG8_STAGE(PG8_SA(0, 1), a2, v2[1]);
            PG8_WAIT_V(8); PG8_WAIT_L(0); PG8_BAR; PG8_MMA(0, 0, At, B0); PG8_MMA(0, 1, At, B1); PG8_BAR; PG8_SCHED;
            PG8_LDA(At, 1, 1); PG8_STAGEB(PG8_SB(1, 0), b3); PG8_STAGEB(PG8_SB(1, 1), b3 + hstep); PG8_STAGE(PG8_SA(1, 0), a3, v2[0]);
            PG8_WAIT_V(8); PG8_WAIT_L(0); PG8_BAR; PG8_MMA(1, 0, At, B0); PG8_MMA(1, 1, At, B1); PG8_BAR; PG8_SCHED;
        }
        if constexpr (ALIGN_EPI) { if (wr == 0) PG8_BAR; }
        E(acc, cur, wr, wc, fr, fq);
        if (!has_next) break;
#pragma unroll
        for (int a = 0; a < 2; ++a)
#pragma unroll
            for (int b = 0; b < 2; ++b)
#pragma unroll
                for (int m = 0; m < 4; ++m)
#pragma unroll
                    for (int n = 0; n < 2; ++n) acc[a][b][m][n] = (f32x4){0.f, 0.f, 0.f, 0.f};
        cur = nxt; cB = nB; ++ui;
#pragma unroll
        for (int h = 0; h < 2; ++h)
#pragma unroll
            for (int i = 0; i < 2; ++i) vAc[h][i] = vAn[h][i];
        if constexpr (ALIGN_EPI) { if (wr == 1) PG8_BAR; }
    }
    PG8_WAIT_V(0);
    if constexpr (!ALIGN_EPI) { if (wr == 0) PG8_BAR; }
    PG8_BAR;
#undef PG8_SA
#undef PG8_SB
#undef PG8_STAGE
#undef PG8_STAGEB
#undef PG8_LDA
#undef PG8_LDB
#undef PG8_MMA
#undef PG8_WAIT_V
#undef PG8_WAIT_L
#undef PG8_BAR
#undef PG8_SCHED
}
template <class Epi, class Sched, bool ALIGN_EPI>
__device__ __forceinline__ void gemm_phase_f8(LAS unsigned char* lds, const char* Abase, const int K, const Sched& S, const Epi& E) {
    const int tid = tidx(), wid = __builtin_amdgcn_readfirstlane(tid >> 6), lane = tid & 63, wr = wid >> 2, wc = wid & 3, fr = lane & 15, fq = lane >> 4;
    const int nt = K / 128;
    int Rp[1], Cp[1]; unsigned voffB[1], voffA[1];
#pragma unroll
    for (int i = 0; i < 1; ++i) { stage_rc(tid * 16 + i * 8192, Rp[i], Cp[i]); const int Rb = Epi::PERM ? ((Rp[i] & ~31) + perm32(Rp[i] & 31)) : Rp[i]; voffB[i] = (unsigned)(Rb * K + 2 * Cp[i]); voffA[i] = (unsigned)(Rp[i] * K + 2 * Cp[i]); }
    const size_t kstep = (size_t)(BK * 2);
    const size_t hstep = (size_t)HALF * K;
    const unsigned ldsw = (unsigned)wid * 1024u;
    const int aoff0 = lds_byte(wr * 64 + fr, 16 * (fq & 1)) + (fq >> 1) * 1024, boff0 = lds_byte(wc * 32 + fr, 16 * (fq & 1)) + (fq >> 1) * 1024;
#define PG8_SA(b, h) (((b) * 2 + (h)) * HTB)
#define PG8_SB(b, h) ((4 + (b) * 2 + (h)) * HTB)
#define PG8_STAGE(bufoff, gbase, voff) do { _Pragma("unroll") for (int _i = 0; _i < 2; ++_i) \
        __builtin_amdgcn_global_load_lds((const unsigned*)((const char*)(gbase) + (size_t)_i * 64 * K + (voff)[0]), (LAS unsigned*)(lds + (bufoff) + ldsw + _i * 8192), 16, 0, 0); } while (0)
#define PG8_LDA(dst, b, h) do { _Pragma("unroll") for (int m = 0; m < 4; ++m) { const u32x4 lo_ = *(const LAS u32x4*)(lds + PG8_SA(b, h) + aoff0 + m * 2048), hi_ = *(const LAS u32x4*)(lds + PG8_SA(b, h) + aoff0 + 16 + m * 2048); \
        dst[m] = (v8i){(int)lo_.x, (int)lo_.y, (int)lo_.z, (int)lo_.w, (int)hi_.x, (int)hi_.y, (int)hi_.z, (int)hi_.w}; } } while (0)
#define PG8_LDB(dst, b, h) do { _Pragma("unroll") for (int n = 0; n < 2; ++n) { const u32x4 lo_ = *(const LAS u32x4*)(lds + PG8_SB(b, h) + boff0 + n * 2048), hi_ = *(const LAS u32x4*)(lds + PG8_SB(b, h) + boff0 + 16 + n * 2048); \
        dst[n] = (v8i){(int)lo_.x, (int)lo_.y, (int)lo_.z, (int)lo_.w, (int)hi_.x, (int)hi_.y, (int)hi_.z, (int)hi_.w}; } } while (0)
#define PG8_MMA(ai, bj, At, Bt) do { __builtin_amdgcn_s_setprio(1); _Pragma("unroll") for (int m = 0; m < 4; ++m) _Pragma("unroll") for (int n = 0; n < 2; ++n) \
        asm volatile("v_mfma_scale_f32_16x16x128_f8f6f4 %0, %1, %2, %0, %3, %3 op_sel_hi:[0,0,0]" : "+v"(acc[ai][bj][m][n]) : "v"(Bt[n]), "v"(At[m]), "v"(f8scale)); __builtin_amdgcn_s_setprio(0); } while (0)
#define PG8_WAIT_V(n) asm volatile("s_waitcnt vmcnt(" #n ")" ::: "memory")
#define PG8_WAIT_L(n) asm volatile("s_waitcnt lgkmcnt(" #n ")" ::: "memory")
#define PG8_BAR __builtin_amdgcn_s_barrier()
#define PG8_SCHED __builtin_amdgcn_sched_barrier(0)
    Unit cur, nxt; int ui = 0;
    if (!S.next(0, cur)) return;
    f32x4 acc[2][2][4][2];
#pragma unroll
    for (int a = 0; a < 2; ++a)
#pragma unroll
        for (int b = 0; b < 2; ++b)
#pragma unroll
            for (int m = 0; m < 4; ++m)
#pragma unroll
                for (int n = 0; n < 2; ++n) acc[a][b][m][n] = (f32x4){0.f, 0.f, 0.f, 0.f};
    typedef int v8i __attribute__((ext_vector_type(8)));
    v8i At[4], B0[2], B1[2];
    const int f8scale = 0x7f7f7f7f;
    const char* cA = S.a_ptr(cur, Abase);
    const char* cB = S.b_ptr(cur);
    PG8_STAGE(PG8_SB(0, 0), cB, voffB); PG8_STAGE(PG8_SB(0, 1), cB + hstep, voffB); PG8_STAGE(PG8_SA(0, 0), cA, voffA); PG8_STAGE(PG8_SA(0, 1), cA + hstep, voffA);
    if (wr == 1) PG8_BAR;
    PG8_WAIT_V(2); PG8_BAR;
    PG8_STAGE(PG8_SB(1, 0), cB + kstep, voffB); PG8_STAGE(PG8_SA(1, 0), cA + kstep, voffA); PG8_STAGE(PG8_SB(1, 1), cB + hstep + kstep, voffB);
    PG8_WAIT_V(6); PG8_BAR;
    for (;;) {
        const bool has_next = S.next(ui + 1, nxt);
        const char* nB = has_next ? S.b_ptr(nxt) : cB; const char* nA = has_next ? S.a_ptr(nxt, Abase) : cA;
#pragma unroll 1
        for (int t = 0; t < nt; t += 2) {
            const bool last = (t == nt - 2);
            const char* a1 = cA + (size_t)(t + 1) * kstep;
            const char* a2 = last ? nA : cA + (size_t)(t + 2) * kstep; const char* b2 = last ? nB : cB + (size_t)(t + 2) * kstep;
            const char* a3 = a2 + kstep; const char* b3 = b2 + kstep;
            PG8_LDB(B0, 0, 0); PG8_LDB(B1, 0, 1); PG8_SCHED; PG8_LDA(At, 0, 0); PG8_STAGE(PG8_SA(1, 1), a1 + hstep, voffA);
            PG8_WAIT_V(8); PG8_WAIT_L(0); PG8_BAR; PG8_MMA(0, 0, At, B0); PG8_MMA(0, 1, At, B1); PG8_BAR; PG8_SCHED;
            PG8_LDA(At, 0, 1); PG8_STAGE(PG8_SB(0, 0), b2, voffB); PG8_STAGE(PG8_SB(0, 1), b2 + hstep, voffB); PG8_STAGE(PG8_SA(0, 0), a2, voffA);
            PG8_WAIT_V(8); PG8_WAIT_L(0); PG8_BAR; PG8_MMA(1, 0, At, B0); PG8_MMA(1, 1, At, B1); PG8_BAR; PG8_SCHED;
            PG8_LDB(B0, 1, 0); PG8_LDB(B1, 1, 1); PG8_SCHED; PG8_LDA(At, 1, 0); PG8_STAGE(PG8_SA(0, 1), a2 + hstep, voffA);
            PG8_WAIT_V(8); PG8_WAIT_L(0); PG8_BAR; PG8_MMA(0, 0, At, B0); PG8_MMA(0, 1, At, B1); PG8_BAR; PG8_SCHED;
            PG8_LDA(At, 1, 1); PG8_STAGE(PG8_SB(1, 0), b3, voffB); PG8_STAGE(PG8_SB(1, 1), b3 + hstep, voffB); PG8_STAGE(PG8_SA(1, 0), a3, voffA);
            PG8_WAIT_V(8); PG8_WAIT_L(0); PG8_BAR; PG8_MMA(1, 0, At, B0); PG8_MMA(1, 1, At, B1); PG8_BAR; PG8_SCHED;
        }
        if constexpr (ALIGN_EPI) { if (wr == 0) PG8_BAR; }
        E(acc, cur, wr, wc, fr, fq);
        if (!has_next) break;
#pragma unroll
        for (int a = 0; a < 2; ++a)
#pragma unroll
            for (int b = 0; b < 2; ++b)
#pragma unroll
                for (int m = 0; m < 4; ++m)
#pragma unroll
                    for (int n = 0; n < 2; ++n) acc[a][b][m][n] = (f32x4){0.f, 0.f, 0.f, 0.f};
        cur = nxt; cB = nB; cA = nA; ++ui;
        if constexpr (ALIGN_EPI) { if (wr == 1) PG8_BAR; }
    }
    PG8_WAIT_V(0);
    if constexpr (!ALIGN_EPI) { if (wr == 0) PG8_BAR; }
    PG8_BAR;
#undef PG8_SA
#undef PG8_SB
#undef PG8_STAGE
#undef PG8_LDA
#undef PG8_LDB
#undef PG8_MMA
#undef PG8_WAIT_V
#undef PG8_WAIT_L
#undef PG8_BAR
#undef PG8_SCHED
}
}

struct Args { const float* in[39]; float* out; unsigned char* ws; int ph_lo, ph_hi; };
typedef const __attribute__((address_space(4))) Args CArgs;
enum { I_X = 0, I_C, I_CTX, I_CCTX, I_WADA, I_BADA, I_WIN, I_HYCW, I_HYCB, I_HYW1, I_HYB1, I_HYW2, I_HYB2, I_HYW3, I_HYB3, I_HYW4, I_HYFREQ, I_HYD, I_SCCW,
       I_GLAWA, I_GLABA, I_GLANW, I_GDNCW, I_GDNALOG, I_GDNDT, I_GDNNW, I_WOUT, I_LN1G, I_LN1B, I_WR, I_BR, I_WG, I_BG, I_WU, I_BU, I_WD, I_BD, I_LN2G, I_LN2B };

__device__ __forceinline__ int row_batch(int row) { return row < NTOK_C ? (row >> 8) : ((row - NTOK_C) >> 11); }
__device__ __forceinline__ int mod_vec(int row) { return row < NTOK_C ? 16 : ((row - NTOK_C) >> 11); }

__device__ __forceinline__ void ph_mod(CArgs& a, LAS unsigned char* lds, int bid, int nblk) {
    LAS float* sc = (LAS float*)lds; LAS float* red = (LAS float*)(lds + 17 * 1024 * 4);
    const int tid = tidx(), lane = tid & 63, w = tid >> 6;
    const float* c = a.in[I_C]; const float* cc = a.in[I_CCTX];
    for (int i = tid; i < 17 * 1024; i += 512) { const float v = i < 16 * 1024 ? c[i] : cc[i - 16 * 1024]; sc[i] = siluf_(v); }
    __syncthreads();
    float* MOD = (float*)(a.ws + WS_MOD);
    for (int it = bid; it < DEPTH * 96; it += nblk) {
        const int l = it / 96, j0 = (it % 96) * 64;
        const float* W = a.in[I_WADA] + (size_t)l * 1024 * 6144 + j0 + lane;
        float acc[17];
#pragma unroll
        for (int v = 0; v < 17; ++v) acc[v] = 0.f;
#pragma unroll 16
        for (int kk = 0; kk < 128; ++kk) { const int k = w * 128 + kk; const float wv = W[(size_t)k * 6144];
#pragma unroll
            for (int v = 0; v < 17; ++v) acc[v] += sc[v * 1024 + k] * wv; }
#pragma unroll
        for (int v = 0; v < 17; ++v) red[(w * 17 + v) * 64 + lane] = acc[v];
        __syncthreads();
        for (int o = tid; o < 17 * 64; o += 512) { const int v = o >> 6, jj = o & 63; float s = 0.f;
#pragma unroll
            for (int ww = 0; ww < 8; ++ww) s += red[(ww * 17 + v) * 64 + jj];
            MOD[(size_t)(l * 17 + v) * 6144 + j0 + jj] = s + a.in[I_BADA][l * 6144 + j0 + jj]; }
        __syncthreads();
    }
}

__device__ __forceinline__ void ph_filters(CArgs& a, int gw, int ngw) {
    const int lane = tidx() & 63;
    float* KUN = (float*)(a.ws + WS_KUN);
#pragma unroll 1
    for (int it = gw; it < DEPTH * (CTXL + SEQ) / 4; it += ngw) {
        const int l = it / ((CTXL + SEQ) / 4), r = (it % ((CTXL + SEQ) / 4)) * 4, Lt = r < CTXL ? 0 : 1, pos0 = Lt ? r - CTXL : r, L = Lt ? SEQ : CTXL;
        float z[4], tn[4];
#pragma unroll
        for (int p = 0; p < 4; ++p) { const int pos = pos0 + p; tn[p] = (float)pos / (float)(L - 1); z[p] = 0.f;
            if (lane == 0) z[p] = tn[p];
            else if (lane <= 32) { const int j = (lane - 1) & 15; const float fj = 1e-4f + (float)j * ((15.f - 1e-4f) / 15.f);
                double rev = (double)fj * (double)pos / (double)L; rev -= floor(rev); const float rf = (float)rev;
                z[p] = lane <= 16 ? sin_rev(rf + 0.25f) : -sin_rev(rf); } }
        const float* w1 = a.in[I_HYW1] + l * 33 * 64; const float* w2 = a.in[I_HYW2] + l * 64 * 64; const float* w3 = a.in[I_HYW3] + l * 64 * 64; const float* w4 = a.in[I_HYW4] + l * 64 * 512;
        const float* fq = a.in[I_HYFREQ] + l * 3 * 64;
        float s[4], h[4];
        { const float bb = a.in[I_HYB1][l * 64 + lane];
#pragma unroll
          for (int p = 0; p < 4; ++p) s[p] = bb; }
#pragma unroll
        for (int i = 0; i < 33; ++i) { const float ww = w1[i * 64 + lane];
#pragma unroll
            for (int p = 0; p < 4; ++p) s[p] += rdlane_f(z[p], i) * ww; }
#pragma unroll
        for (int p = 0; p < 4; ++p) h[p] = sin_rad(fq[lane] * s[p]);
        { const float bb = a.in[I_HYB2][l * 64 + lane];
#pragma unroll
          for (int p = 0; p < 4; ++p) s[p] = bb; }
#pragma unroll 16
        for (int i = 0; i < 64; ++i) { const float ww = w2[i * 64 + lane];
#pragma unroll
            for (int p = 0; p < 4; ++p) s[p] += rdlane_f(h[p], i) * ww; }
#pragma unroll
        for (int p = 0; p < 4; ++p) h[p] = sin_rad(fq[64 + lane] * s[p]);
        { const float bb = a.in[I_HYB3][l * 64 + lane];
#pragma unroll
          for (int p = 0; p < 4; ++p) s[p] = bb; }
#pragma unroll 16
        for (int i = 0; i < 64; ++i) { const float ww = w3[i * 64 + lane];
#pragma unroll
            for (int p = 0; p < 4; ++p) s[p] += rdlane_f(h[p], i) * ww; }
#pragma unroll
        for (int p = 0; p < 4; ++p) h[p] = sin_rad(fq[128 + lane] * s[p]);
        float k[8][4];
#pragma unroll
        for (int m = 0; m < 8; ++m)
#pragma unroll
            for (int p = 0; p < 4; ++p) k[m][p] = 0.f;
#pragma unroll 4
        for (int i = 0; i < 64; ++i) { float hi[4];
#pragma unroll
            for (int p = 0; p < 4; ++p) hi[p] = rdlane_f(h[p], i);
#pragma unroll
            for (int m = 0; m < 8; ++m) { const float ww = w4[i * 512 + m * 64 + lane];
#pragma unroll
                for (int p = 0; p < 4; ++p) k[m][p] += hi[p] * ww; } }
#pragma unroll
        for (int m = 0; m < 8; ++m) { const int o = m * 64 + lane, ch = o & 255;
            const float delta = 3.0701134573253944f + (float)ch * ((15.350567286626972f - 3.0701134573253944f) / 255.f);
            *(f32x4*)(KUN + ((size_t)((l * 2 + Lt) * 512 + o)) * 2048 + pos0) = (f32x4){k[m][0] * __expf(-tn[0] * delta), k[m][1] * __expf(-tn[1] * delta), k[m][2] * __expf(-tn[2] * delta), k[m][3] * __expf(-tn[3] * delta)}; }
    }
}

__device__ __forceinline__ void ph_router_w(CArgs& a, int gt, int ngt) {
    bf16* hi = (bf16*)(a.ws + WS_WRT); bf16* lo = hi + DEPTH * NEXP * D;
    for (int i = gt; i < DEPTH * NEXP * D; i += ngt) { const int l = i / (NEXP * D), r = i % (NEXP * D), e = r / D, k = r % D;
        const float w = a.in[I_WR][((size_t)l * D + k) * NEXP + e]; const unsigned h = f2bf(w); hi[i] = (bf16)h; lo[i] = (bf16)f2bf(w - bf2f(h)); }
}
__device__ __forceinline__ void tr_item(const float* W, int Nsrc, int K, bf16* WTrow0, int n0, int k0, LAS float* scr, int lane) {
    const int c4 = (lane & 7) * 4; const bool ok = n0 + c4 < Nsrc;
    f32x4 t[8];
#pragma unroll
    for (int j = 0; j < 8; ++j) { const int kk = 8 * j + (lane >> 3); t[j] = ok ? *(const f32x4*)(W + (size_t)(k0 + kk) * Nsrc + n0 + c4) : (f32x4){0.f, 0.f, 0.f, 0.f}; }
#pragma unroll
    for (int j = 0; j < 8; ++j) { const int kk = 8 * j + (lane >> 3); LAS float* d = scr + kk * 33 + c4; d[0] = t[j][0]; d[1] = t[j][1]; d[2] = t[j][2]; d[3] = t[j][3]; }
    asm volatile("s_waitcnt lgkmcnt(0)" ::: "memory");
    const int c = lane & 7;
#pragma unroll
    for (int j = 0; j < 4; ++j) { const int n = (lane >> 3) + 8 * j; const LAS float* s = scr + (8 * c) * 33 + n;
        u32x4 o; o.x = pk2(s[0 * 33], s[1 * 33]); o.y = pk2(s[2 * 33], s[3 * 33]); o.z = pk2(s[4 * 33], s[5 * 33]); o.w = pk2(s[6 * 33], s[7 * 33]);
        *(u32x4*)(WTrow0 + (size_t)n * K + k0 + 8 * c) = o; }
    asm volatile("s_waitcnt lgkmcnt(0)" ::: "memory");
}
__device__ __forceinline__ void tr_item_f8(const float* W, int Nsrc, int K, unsigned char* WTrow0, int n0, int k0, float scale, LAS float* scr, int lane) {
    const int c4 = (lane & 7) * 4;
    f32x4 t[8];
#pragma unroll
    for (int j = 0; j < 8; ++j) { const int kk = 8 * j + (lane >> 3); t[j] = *(const f32x4*)(W + (size_t)(k0 + kk) * Nsrc + n0 + c4); }
#pragma unroll
    for (int j = 0; j < 8; ++j) { const int kk = 8 * j + (lane >> 3); LAS float* d = scr + kk * 33 + c4; d[0] = t[j][0]; d[1] = t[j][1]; d[2] = t[j][2]; d[3] = t[j][3]; }
    asm volatile("s_waitcnt lgkmcnt(0)" ::: "memory");
    const int n = lane >> 1, half = lane & 1; const LAS float* s = scr + (32 * half) * 33 + n;
    unsigned o[8];
#pragma unroll
    for (int i = 0; i < 8; ++i) o[i] = pk4_fp8(s[(4 * i) * 33] * scale, s[(4 * i + 1) * 33] * scale, s[(4 * i + 2) * 33] * scale, s[(4 * i + 3) * 33] * scale);
    unsigned char* dst = WTrow0 + (size_t)n * K + k0 + 32 * half;
    *(u32x4*)dst = (u32x4){o[0], o[1], o[2], o[3]}; *(u32x4*)(dst + 16) = (u32x4){o[4], o[5], o[6], o[7]};
    asm volatile("s_waitcnt lgkmcnt(0)" ::: "memory");
}
__device__ __forceinline__ void ph_tr_small(CArgs& a, LAS unsigned char* lds, int gw, int ngw) {
    const int lane = tidx() & 63, w = tidx() >> 6;
    LAS float* scr = (LAS float*)(lds + w * 8448);
    constexpr int I_IN = 16 * (D_INP / 32), I_OUT = 16 * 32;
    for (int it = gw; it < DEPTH * (I_IN + I_OUT); it += ngw) {
        const int l = it / (I_IN + I_OUT); int r = it % (I_IN + I_OUT);
        if (r < I_IN) { const int kb = r / (D_INP / 32), nb = r % (D_INP / 32);
            tr_item(a.in[I_WIN] + (size_t)l * 1024 * D_IN, D_IN, 1024, (bf16*)(a.ws + WS_WIN) + ((size_t)l * D_INP + nb * 32) * 1024, nb * 32, kb * 64, scr, lane); }
        else { r -= I_IN; const int kb = r / 32, nb = r % 32;
            tr_item(a.in[I_WOUT] + (size_t)l * 1024 * 1024, 1024, 1024, (bf16*)(a.ws + WS_WOUT) + ((size_t)l * 1024 + nb * 32) * 1024, nb * 32, kb * 64, scr, lane); }
    }
}
__device__ __forceinline__ void tr_experts_waves(CArgs& a, int l, LAS unsigned char* scrb, int gw, int ngw, int lane) {
    LAS float* scr = (LAS float*)scrb;
#pragma unroll 1
    for (int it = gw; it < NEXP * 3 * 512; it += ngw) {
        const int e = it / 1536, r = it % 1536, which = r / 512, q = r % 512, kb = q / 32, nb = q % 32, n0 = nb * 32;
        const float* W = a.in[which == 0 ? I_WG : (which == 1 ? I_WU : I_WD)] + ((size_t)(l * NEXP + e)) * 1024 * 1024;
        if (which == 2) tr_item_f8(W, 1024, 1024, a.ws + WS_WD + ((size_t)e * 1024 + n0) * 1024, n0, kb * 64, 32.f, scr, lane);
        else tr_item_f8(W, 1024, 1024, a.ws + WS_WGU + ((size_t)e * 2048 + (n0 >> 7) * 256 + which * 128 + (n0 & 127)) * 1024, n0, kb * 64, 32.f, scr, lane);
    }
}
__device__ __forceinline__ void ph_mod_input(CArgs& a, int gw, int ngw) {
    const int lane = tidx() & 63;
    const float* MOD = (const float*)(a.ws + WS_MOD);
    bf16* HB = (bf16*)(a.ws + WS_HB);
    for (int row = gw; row < NTOK; row += ngw) {
        const float* src = row < NTOK_C ? a.in[I_CTX] + (size_t)row * D : a.in[I_X] + (size_t)(row - NTOK_C) * D;
        const float* mv = MOD + (size_t)mod_vec(row) * 6144;
#pragma unroll
        for (int j = 0; j < 4; ++j) { const int c0 = j * 256 + lane * 4; const f32x4 x = *(const f32x4*)(src + c0), sh = *(const f32x4*)(mv + c0), sc = *(const f32x4*)(mv + 1024 + c0);
            u32x2 o; o.x = pk2(x[0] * (1.f + sc[0]) + sh[0], x[1] * (1.f + sc[1]) + sh[1]); o.y = pk2(x[2] * (1.f + sc[2]) + sh[2], x[3] * (1.f + sc[3]) + sh[3]);
            *(u32x2*)(HB + (size_t)row * D + c0) = o; }
    }
}

struct Chunk { int b, t0, L, row0, lo, hi; };
__device__ __forceinline__ Chunk chunk_of(int it) {
    Chunk c;
    if (it < 64) { c.b = it >> 2; c.t0 = (it & 3) * 64; c.L = CTXL; c.row0 = c.b * CTXL + c.t0; c.lo = 0; c.hi = CTXL; }
    else { const int r = it - 64; c.b = r >> 5; c.t0 = (r & 31) * 64; c.L = SEQ; c.row0 = NTOK_C + c.b * SEQ + c.t0; c.lo = c.t0; c.hi = c.t0 + 64; }
    return c;
}
__device__ __forceinline__ f32x4 bf4(u32x2 v) { return (f32x4){lo_bf(v.x), hi_bf(v.x), lo_bf(v.y), hi_bf(v.y)}; }
__device__ __forceinline__ void ph_prep_conv(CArgs& a, int l, LAS unsigned char* lds, int bid, int nblk) {
    const bf16* P = (const bf16*)(a.ws + WS_P);
    bf16* ZT = (bf16*)(a.ws + WS_MIX + MX_ZT); bf16* YMIX = (bf16*)(a.ws + WS_YMIX);
    LAS bf16* zt = (LAS bf16*)lds;
    const int tid = tidx(), c4 = (tid & 63) * 4, tg = tid >> 6;
    const float* hw = a.in[I_HYCW] + l * 3 * 768; const float* hb = a.in[I_HYCB] + l * 768; const float* sw = a.in[I_SCCW] + l * 3 * 256;
    f32x4 wx[3], wv[3], ws3[3];
#pragma unroll
    for (int k = 0; k < 3; ++k) { wx[k] = *(const f32x4*)(hw + k * 768 + 256 + c4); wv[k] = *(const f32x4*)(hw + k * 768 + 512 + c4); ws3[k] = *(const f32x4*)(sw + k * 256 + c4); }
    const f32x4 bx = *(const f32x4*)(hb + 256 + c4), bv = *(const f32x4*)(hb + 512 + c4);
#pragma unroll 1
    for (int it = bid; it < 576; it += nblk) {
        const Chunk c = chunk_of(it);
        const int tb = c.t0 + tg * 8;
        const bf16* pb = P + (size_t)(c.row0 + tg * 8) * D_INP;
        f32x4 x1[10], vv[10], mm[10];
#pragma unroll
        for (int r = 0; r < 10; ++r) { const int t = tb + r - 1; const bool ok = t >= c.lo && t < c.hi; const bf16* p = pb + (ptrdiff_t)(r - 1) * D_INP;
            x1[r] = ok ? bf4(*(const u32x2*)(p + HY0 + 256 + c4)) : (f32x4){0.f, 0.f, 0.f, 0.f}; vv[r] = ok ? bf4(*(const u32x2*)(p + HY0 + 512 + c4)) : (f32x4){0.f, 0.f, 0.f, 0.f};
            mm[r] = ok ? bf4(*(const u32x2*)(p + SC0 + 256 + c4)) * bf4(*(const u32x2*)(p + SC0 + 512 + c4)) : (f32x4){0.f, 0.f, 0.f, 0.f}; }
#pragma unroll
        for (int tt = 0; tt < 8; ++tt) {
            const f32x4 xx = wx[0] * x1[tt] + wx[1] * x1[tt + 1] + wx[2] * x1[tt + 2] + bx, v2 = wv[0] * vv[tt] + wv[1] * vv[tt + 1] + wv[2] * vv[tt + 2] + bv, z = xx * v2;
            u32x2 zo; zo.x = pk2(z[0], z[1]); zo.y = pk2(z[2], z[3]); *(LAS u32x2*)(zt + (tg * 8 + tt) * 264 + c4) = zo;
            const f32x4 bg = bf4(*(const u32x2*)(pb + (size_t)tt * D_INP + SC0 + c4));
            const f32x4 y = bg * (ws3[0] * mm[tt] + ws3[1] * mm[tt + 1] + ws3[2] * mm[tt + 2]);
            u32x2 yo; yo.x = pk2(y[0], y[1]); yo.y = pk2(y[2], y[3]); *(u32x2*)(YMIX + (size_t)(c.row0 + tg * 8 + tt) * D + 256 + c4) = yo;
        }
        __syncthreads();
        { const int ch = tid & 255, g0 = (tid >> 8) * 4;
          const int soff = c.L == CTXL ? 0 : CTXL;
#pragma unroll
          for (int g = 0; g < 4; ++g) { const int t8 = (g0 + g) * 8; unsigned short e[8];
#pragma unroll
              for (int j = 0; j < 8; ++j) e[j] = zt[(t8 + j) * 264 + ch];
              u32x4 o; o.x = e[0] | ((unsigned)e[1] << 16); o.y = e[2] | ((unsigned)e[3] << 16); o.z = e[4] | ((unsigned)e[5] << 16); o.w = e[6] | ((unsigned)e[7] << 16);
              *(u32x4*)(ZT + ((size_t)(ch * 16 + c.b)) * 2304 + soff + c.t0 + t8) = o; } }
        __syncthreads();
    }
}
__device__ __forceinline__ void ph_prep_tok(CArgs& a, int l, int gw, int ngw) {
    const int lane = tidx() & 63;
    const bf16* P = (const bf16*)(a.ws + WS_P);
    float* GDF = (float*)(a.ws + WS_MIX + MX_GDF); float* GDB = (float*)(a.ws + WS_MIX + MX_GDB);
    float* DQ = (float*)(a.ws + WS_MIX + MX_DQ); float* DK = (float*)(a.ws + WS_MIX + MX_DK); float* DV = (float*)(a.ws + WS_MIX + MX_DV); float* DG = (float*)(a.ws + WS_MIX + MX_DG);
    const float* wa = a.in[I_GLAWA] + l * 2 * 16 * 128; const float* ba = a.in[I_GLABA] + l * 2 * 128;
    const float* cw = a.in[I_GDNCW] + l * 3 * 768;
#pragma unroll 1
    for (int row0 = gw * 4; row0 < NTOK; row0 += ngw * 4) {
        { int z = 0; asm volatile("" : "+v"(z)); wa += z; cw += z; }
        const bf16* pr0 = P + (size_t)row0 * D_INP;
        float av[4], s[4][4];
#pragma unroll
        for (int r = 0; r < 4; ++r) { av[r] = lane < 32 ? bf2f(pr0[(size_t)r * D_INP + GLA0 + 768 + lane]) : 0.f; s[r][0] = ba[lane]; s[r][1] = ba[64 + lane]; s[r][2] = ba[128 + lane]; s[r][3] = ba[192 + lane]; }
#pragma unroll
        for (int i = 0; i < 16; ++i) { const float w0 = wa[i * 128 + lane], w1 = wa[i * 128 + 64 + lane], w2 = wa[2048 + i * 128 + lane], w3 = wa[2048 + i * 128 + 64 + lane];
#pragma unroll
            for (int r = 0; r < 4; ++r) { const float af = rdlane_f(av[r], i), ab = rdlane_f(av[r], 16 + i); s[r][0] += af * w0; s[r][1] += af * w1; s[r][2] += ab * w2; s[r][3] += ab * w3; } }
#pragma unroll
        for (int r = 0; r < 4; ++r) { const size_t o = (size_t)(row0 + r) * 128;
            GDF[o + lane] = __expf(logsigmoidf_(s[r][0]) * 0.0625f); GDF[o + 64 + lane] = __expf(logsigmoidf_(s[r][1]) * 0.0625f);
            GDB[o + lane] = __expf(logsigmoidf_(s[r][2]) * 0.0625f); GDB[o + 64 + lane] = __expf(logsigmoidf_(s[r][3]) * 0.0625f); }
        int tpos, lo, hi;
        if (row0 < NTOK_C) { tpos = row0 & 255; lo = 0; hi = CTXL; } else { tpos = (row0 - NTOK_C) & 2047; lo = tpos & ~63; hi = lo + 64; }
        float sq[4] = {0.f, 0.f, 0.f, 0.f}, sk[4] = {0.f, 0.f, 0.f, 0.f}; f32x4 qv[4], kv[4];
#pragma unroll
        for (int g = 0; g < 3; ++g) { const int col = g * 256 + 4 * lane; const bf16* p = pr0 + GDN0 + col;
            f32x4 x[6];
#pragma unroll
            for (int r = 0; r < 6; ++r) { const int t = tpos + r - 1; x[r] = (t >= lo && t < hi) ? bf4(*(const u32x2*)(p + (ptrdiff_t)(r - 1) * D_INP)) : (f32x4){0.f, 0.f, 0.f, 0.f}; }
            const f32x4 w0 = *(const f32x4*)(cw + col), w1 = *(const f32x4*)(cw + 768 + col), w2 = *(const f32x4*)(cw + 1536 + col);
#pragma unroll
            for (int r = 0; r < 4; ++r) { f32x4 y = w0 * x[r] + w1 * x[r + 1] + w2 * x[r + 2];
                y[0] = siluf_(y[0]); y[1] = siluf_(y[1]); y[2] = siluf_(y[2]); y[3] = siluf_(y[3]);
                if (g == 0) { qv[r] = y; sq[r] = (y[0] * y[0] + y[1] * y[1]) + (y[2] * y[2] + y[3] * y[3]); }
                else if (g == 1) { kv[r] = y; sk[r] = (y[0] * y[0] + y[1] * y[1]) + (y[2] * y[2] + y[3] * y[3]); }
                else *(f32x4*)(DV + (size_t)(row0 + r) * 256 + 4 * lane) = y; } }
#pragma unroll
        for (int r = 0; r < 4; ++r) { const float rq = rsqrtf(row16_sum(sq[r]) + 1e-6f) * 0.125f, rk = rsqrtf(row16_sum(sk[r]) + 1e-6f);
            *(f32x4*)(DQ + (size_t)(row0 + r) * 256 + 4 * lane) = qv[r] * rq; *(f32x4*)(DK + (size_t)(row0 + r) * 256 + 4 * lane) = kv[r] * rk; }
        if (lane < 16) { const int h = lane & 3, r = lane >> 2; const bf16* pr = pr0 + (size_t)r * D_INP;
            const float af = bf2f(pr[GDN0 + 1024 + h]), ab = bf2f(pr[GDN0 + 1028 + h]), bfv = bf2f(pr[GDN0 + 1032 + h]), bbv = bf2f(pr[GDN0 + 1036 + h]);
            const float* al = a.in[I_GDNALOG] + l * 8; const float* dt = a.in[I_GDNDT] + l * 8;
            const float gf = -__expf(al[h]) * softplusf_(af + dt[h]), gb = -__expf(al[4 + h]) * softplusf_(ab + dt[4 + h]);
            *(f32x4*)(DG + (size_t)(row0 + r) * 16 + 4 * h) = (f32x4){sigmoidf_(bfv), __expf(gf), sigmoidf_(bbv), __expf(gb)}; }
    }
}

__device__ __forceinline__ int scan_row(int b, int dir, int n) {
    if (n < CTXL) return b * CTXL + (dir ? CTXL - 1 - n : n);
    const int m = n - CTXL; return NTOK_C + b * SEQ + (dir ? SEQ - 1 - m : m);
}
__device__ __forceinline__ void gla_chain(CArgs& a, int chain, LAS unsigned char* lds) {
    const int b = chain >> 3, h = (chain >> 1) & 3, dir = chain & 1;
    const int tid = tidx(), lane = tid & 63, w = tid >> 6, vv = lane & 7, kq = lane >> 3;
    const bf16* P = (const bf16*)(a.ws + WS_P);
    const float* GD = (const float*)(a.ws + WS_MIX + (dir ? MX_GDB : MX_GDF));
    float* GO = (float*)(a.ws + WS_MIX + (dir ? MX_GOB : MX_GOF));
    LAS float* sq = (LAS float*)lds;
    LAS float* sk = sq + 64 * 32;
    LAS float* sd = sk + 64 * 32;
    LAS float* sv = sd + 64 * 32;
    float S[4] = {0.f, 0.f, 0.f, 0.f};
    for (int ch = 0; ch < 36; ++ch) {
        { const int tt = tid >> 3, sub = tid & 7, row = scan_row(b, dir, ch * 64 + tt);
          const bf16* pr = P + (size_t)row * D_INP + GLA0;
          const u32x2 qv = *(const u32x2*)(pr + h * 32 + sub * 4), kv = *(const u32x2*)(pr + 128 + h * 32 + sub * 4);
          const f32x4 dv = *(const f32x4*)(GD + (size_t)row * 128 + h * 32 + sub * 4);
          const u32x4 vv8 = *(const u32x4*)(pr + 256 + h * 64 + sub * 8);
          const float qs = 0.17677669529663687f;
          *(LAS f32x4*)(sq + tt * 32 + sub * 4) = (f32x4){lo_bf(qv.x) * qs, hi_bf(qv.x) * qs, lo_bf(qv.y) * qs, hi_bf(qv.y) * qs};
          *(LAS f32x4*)(sk + tt * 32 + sub * 4) = (f32x4){lo_bf(kv.x), hi_bf(kv.x), lo_bf(kv.y), hi_bf(kv.y)};
          *(LAS f32x4*)(sd + tt * 32 + sub * 4) = dv;
          *(LAS f32x4*)(sv + tt * 64 + sub * 8) = (f32x4){lo_bf(vv8.x), hi_bf(vv8.x), lo_bf(vv8.y), hi_bf(vv8.y)};
          *(LAS f32x4*)(sv + tt * 64 + sub * 8 + 4) = (f32x4){lo_bf(vv8.z), hi_bf(vv8.z), lo_bf(vv8.w), hi_bf(vv8.w)}; }
        __syncthreads();
#pragma unroll 4
        for (int tt = 0; tt < 64; ++tt) {
            const f32x4 q4 = *(const LAS f32x4*)(sq + tt * 32 + kq * 4), k4 = *(const LAS f32x4*)(sk + tt * 32 + kq * 4), d4 = *(const LAS f32x4*)(sd + tt * 32 + kq * 4);
            const float v = sv[tt * 64 + w * 8 + vv];
            float o = 0.f;
#pragma unroll
            for (int j = 0; j < 4; ++j) { S[j] = d4[j] * S[j] + k4[j] * v; o += q4[j] * S[j]; }
            o += __shfl_xor(o, 8); o += __shfl_xor(o, 16); o += __shfl_xor(o, 32);
            if (kq == 0) GO[(size_t)scan_row(b, dir, ch * 64 + tt) * 256 + h * 64 + w * 8 + vv] = o;
        }
        __syncthreads();
    }
}
__device__ __forceinline__ void gdn_chain(CArgs& a, int chain, LAS unsigned char* lds) {
    const int b = chain >> 3, h = (chain >> 1) & 3, dir = chain & 1;
    const int tid = tidx(), lane = tid & 63, w = tid >> 6, vv = lane & 7, kq = lane >> 3;
    const float* DQ = (const float*)(a.ws + WS_MIX + MX_DQ); const float* DK = (const float*)(a.ws + WS_MIX + MX_DK); const float* DV = (const float*)(a.ws + WS_MIX + MX_DV);
    const float* DG = (const float*)(a.ws + WS_MIX + MX_DG);
    float* DO = (float*)(a.ws + WS_MIX + (dir ? MX_DOB : MX_DOF));
    LAS float* sq = (LAS float*)lds;
    LAS float* sk = sq + 64 * 64;
    LAS float* sv = sk + 64 * 64;
    LAS float* sg = sv + 64 * 64;
    float S[8];
#pragma unroll
    for (int j = 0; j < 8; ++j) S[j] = 0.f;
    for (int ch = 0; ch < 36; ++ch) {
        { const int tt = tid >> 3, sub = tid & 7, row = scan_row(b, dir, ch * 64 + tt);
          const size_t o = (size_t)row * 256 + h * 64 + sub * 8;
          *(LAS f32x4*)(sq + tt * 64 + sub * 8) = *(const f32x4*)(DQ + o); *(LAS f32x4*)(sq + tt * 64 + sub * 8 + 4) = *(const f32x4*)(DQ + o + 4);
          *(LAS f32x4*)(sk + tt * 64 + sub * 8) = *(const f32x4*)(DK + o); *(LAS f32x4*)(sk + tt * 64 + sub * 8 + 4) = *(const f32x4*)(DK + o + 4);
          *(LAS f32x4*)(sv + tt * 64 + sub * 8) = *(const f32x4*)(DV + o); *(LAS f32x4*)(sv + tt * 64 + sub * 8 + 4) = *(const f32x4*)(DV + o + 4);
          if (sub == 0) { const f32x4 g4 = *(const f32x4*)(DG + (size_t)row * 16 + h * 4); *(LAS f32x2*)(sg + tt * 2) = dir ? (f32x2){g4[2], g4[3]} : (f32x2){g4[0], g4[1]}; } }
        __syncthreads();
#pragma unroll 2
        for (int tt = 0; tt < 64; ++tt) {
            const f32x4 ka = *(const LAS f32x4*)(sk + tt * 64 + kq * 8), kb = *(const LAS f32x4*)(sk + tt * 64 + kq * 8 + 4);
            const f32x4 qa = *(const LAS f32x4*)(sq + tt * 64 + kq * 8), qb = *(const LAS f32x4*)(sq + tt * 64 + kq * 8 + 4);
            const float v = sv[tt * 64 + w * 8 + vv]; const f32x2 g2 = *(const LAS f32x2*)(sg + tt * 2);
            const float beta = g2.x, eg = g2.y;
            float ks = (ka[0] * S[0] + ka[1] * S[1]) + (ka[2] * S[2] + ka[3] * S[3]) + ((kb[0] * S[4] + kb[1] * S[5]) + (kb[2] * S[6] + kb[3] * S[7]));
            ks += __shfl_xor(ks, 8); ks += __shfl_xor(ks, 16); ks += __shfl_xor(ks, 32);
            const float wv = beta * (v - eg * ks);
            float o = 0.f;
#pragma unroll
            for (int j = 0; j < 4; ++j) { S[j] = eg * S[j] + ka[j] * wv; o += qa[j] * S[j]; }
#pragma unroll
            for (int j = 0; j < 4; ++j) { S[4 + j] = eg * S[4 + j] + kb[j] * wv; o += qb[j] * S[4 + j]; }
            o += __shfl_xor(o, 8); o += __shfl_xor(o, 16); o += __shfl_xor(o, 32);
            if (kq == 0) DO[(size_t)scan_row(b, dir, ch * 64 + tt) * 256 + h * 64 + w * 8 + vv] = o;
        }
        __syncthreads();
    }
}
__device__ __forceinline__ float gdn_cprod(float eg, int lane) {
    float c = fmaxf(eg, 2.0611536e-9f);
    float t = dpp_f<0x90>(c); c *= (lane & 3) >= 1 ? t : 1.f;
    t = dpp_f<0x44>(c); c *= (lane & 3) >= 2 ? t : 1.f;
    return c;
}
__device__ __forceinline__ float oct_sum(float v) { v += dpp_f<0xB1>(v); v += dpp_f<0x4E>(v); v += dpp_f<0x141>(v); return v; }
__device__ __forceinline__ void gdn_wave(CArgs& a, int chain, int vbase, LAS unsigned char* wl, int lane) {
    const int b = chain >> 3, h = (chain >> 1) & 3, dir = chain & 1, vl = lane >> 3, kq = lane & 7;
    const float* DQ = (const float*)(a.ws + WS_MIX + MX_DQ); const float* DK = (const float*)(a.ws + WS_MIX + MX_DK); const float* DV = (const float*)(a.ws + WS_MIX + MX_DV);
    const float* DG = (const float*)(a.ws + WS_MIX + MX_DG);
    float* DO = (float*)(a.ws + WS_MIX + (dir ? MX_DOB : MX_DOF));
    f32x2 S2[4];
#pragma unroll
    for (int i = 0; i < 4; ++i) S2[i] = (f32x2){0.f, 0.f};
    f32x4 pk[4], pq[4], pv; f32x2 pg;
    const int step = dir ? -1 : 1;
#define GDN_FETCH(ci) do { const int r0_ = scan_row(b, dir, (ci) * 16); \
        _Pragma("unroll") for (int j = 0; j < 4; ++j) { const size_t o_ = (size_t)(r0_ + step * (4 * j + (lane >> 4))) * 256 + h * 64 + (lane & 15) * 4; pk[j] = *(const f32x4*)(DK + o_); pq[j] = *(const f32x4*)(DQ + o_); } \
        pv = *(const f32x4*)(DV + (size_t)(r0_ + step * ((lane & 31) >> 1)) * 256 + h * 64 + vbase + (lane & 1) * 4); \
        pg = *(const f32x2*)(DG + (size_t)(r0_ + step * (lane & 15)) * 16 + h * 4 + dir * 2); } while (0)
#define GDN_PUT(bufp) do { _Pragma("unroll") for (int j = 0; j < 4; ++j) { *(LAS f32x4*)((bufp) + j * 1024 + lane * 16) = pk[j]; *(LAS f32x4*)((bufp) + 4096 + j * 1024 + lane * 16) = pq[j]; } \
        if (lane < 32) *(LAS f32x4*)((bufp) + 8192 + lane * 16) = pv; } while (0)
    GDN_FETCH(0);
    float gA, gB, gC;
    { const float c = gdn_cprod(pg.y, lane); gA = pg.x / c; gB = pg.x; gC = c; }
    GDN_PUT(wl);
#pragma unroll 1
    for (int ci = 0; ci < 144; ++ci) {
        const LAS unsigned char* buf = wl + (ci & 1) * 8704;
        const float cA = gA, cB = gB, cC = gC;
        if (ci + 1 < 144) GDN_FETCH(ci + 1);
        const int r0 = scan_row(b, dir, ci * 16);
        float okeep = 0.f;
#pragma unroll 1
        for (int tg = 0; tg < 4; ++tg) {
#pragma unroll
            for (int tu = 0; tu < 4; ++tu) {
                const int tt = tg * 4 + tu;
                const f32x4 k0 = *(const LAS f32x4*)(buf + (tt * 64 + kq * 8) * 4), k1 = *(const LAS f32x4*)(buf + (tt * 64 + kq * 8 + 4) * 4);
                const f32x4 q0 = *(const LAS f32x4*)(buf + 4096 + (tt * 64 + kq * 8) * 4), q1 = *(const LAS f32x4*)(buf + 4096 + (tt * 64 + kq * 8 + 4) * 4);
                const float vv = *(const LAS float*)(buf + 8192 + (tt * 8 + vl) * 4);
                const float tA = rdlane_f(cA, tt), tB = rdlane_f(cB, tt), tC = rdlane_f(cC, tt);
                f32x2 ka = (f32x2){k0[0], k0[1]} * S2[0], kb = (f32x2){k0[2], k0[3]} * S2[1];
                ka = __builtin_elementwise_fma((f32x2){k1[0], k1[1]}, S2[2], ka); kb = __builtin_elementwise_fma((f32x2){k1[2], k1[3]}, S2[3], kb);
                ka = ka + kb;
                const float ks = oct_sum(ka.x + ka.y);
                const float wh = tA * vv - tB * ks; const f32x2 wh2 = (f32x2){wh, wh};
                S2[0] = __builtin_elementwise_fma((f32x2){k0[0], k0[1]}, wh2, S2[0]); S2[1] = __builtin_elementwise_fma((f32x2){k0[2], k0[3]}, wh2, S2[1]);
                S2[2] = __builtin_elementwise_fma((f32x2){k1[0], k1[1]}, wh2, S2[2]); S2[3] = __builtin_elementwise_fma((f32x2){k1[2], k1[3]}, wh2, S2[3]);
                f32x2 oa = (f32x2){q0[0], q0[1]} * S2[0], ob = (f32x2){q0[2], q0[3]} * S2[1];
                oa = __builtin_elementwise_fma((f32x2){q1[0], q1[1]}, S2[2], oa); ob = __builtin_elementwise_fma((f32x2){q1[2], q1[3]}, S2[3], ob);
                oa = oa + ob;
                const float o = tC * oct_sum(oa.x + oa.y);
                okeep = ((tt & 7) == kq) ? o : okeep;
            }
            { const float cl = rdlane_f(cC, tg * 4 + 3);
#pragma unroll
              for (int i = 0; i < 4; ++i) S2[i] = S2[i] * cl; }
            if (tg & 1) DO[(size_t)(r0 + step * ((tg >> 1) * 8 + kq)) * 256 + h * 64 + vbase + vl] = okeep;
        }
        if (ci + 1 < 144) {
            const float c = gdn_cprod(pg.y, lane); gA = pg.x / c; gB = pg.x; gC = c;
            GDN_PUT(wl + ((ci + 1) & 1) * 8704);
        }
    }
#undef GDN_FETCH
#undef GDN_PUT
}
__device__ __forceinline__ void gla_wave(CArgs& a, int chain, int vbase, LAS unsigned char* wl, int lane) {
    const int b = chain >> 3, h = (chain >> 1) & 3, dir = chain & 1, vl = lane >> 2, kq = lane & 3;
    const bf16* P = (const bf16*)(a.ws + WS_P);
    const float* GD = (const float*)(a.ws + WS_MIX + (dir ? MX_GDB : MX_GDF));
    float* GO = (float*)(a.ws + WS_MIX + (dir ? MX_GOB : MX_GOF));
    f32x2 S2[4];
#pragma unroll
    for (int i = 0; i < 4; ++i) S2[i] = (f32x2){0.f, 0.f};
    u32x4 pq, pk; f32x4 pd[2]; u32x2 pv;
    const int step = dir ? -1 : 1;
#define GLA_FETCH(ci) do { const int r0_ = scan_row(b, dir, (ci) * 16); \
        const bf16* pr_ = P + (size_t)(r0_ + step * (lane >> 2)) * D_INP + GLA0; \
        pq = *(const u32x4*)(pr_ + h * 32 + (lane & 3) * 8); pk = *(const u32x4*)(pr_ + 128 + h * 32 + (lane & 3) * 8); pv = *(const u32x2*)(pr_ + 256 + h * 64 + vbase + (lane & 3) * 4); \
        _Pragma("unroll") for (int j = 0; j < 2; ++j) pd[j] = *(const f32x4*)(GD + (size_t)(r0_ + step * (8 * j + (lane >> 3))) * 128 + h * 32 + (lane & 7) * 4); } while (0)
#define GLA_PUT(bufp) do { const float qs_ = 0.17677669529663687f; \
        *(LAS f32x4*)((bufp) + lane * 32) = (f32x4){lo_bf(pq.x) * qs_, hi_bf(pq.x) * qs_, lo_bf(pq.y) * qs_, hi_bf(pq.y) * qs_}; *(LAS f32x4*)((bufp) + lane * 32 + 16) = (f32x4){lo_bf(pq.z) * qs_, hi_bf(pq.z) * qs_, lo_bf(pq.w) * qs_, hi_bf(pq.w) * qs_}; \
        *(LAS f32x4*)((bufp) + 2048 + lane * 32) = (f32x4){lo_bf(pk.x), hi_bf(pk.x), lo_bf(pk.y), hi_bf(pk.y)}; *(LAS f32x4*)((bufp) + 2048 + lane * 32 + 16) = (f32x4){lo_bf(pk.z), hi_bf(pk.z), lo_bf(pk.w), hi_bf(pk.w)}; \
        *(LAS f32x4*)((bufp) + 4096 + lane * 16) = pd[0]; *(LAS f32x4*)((bufp) + 4096 + 1024 + lane * 16) = pd[1]; \
        *(LAS f32x4*)((bufp) + 6144 + lane * 16) = (f32x4){lo_bf(pv.x), hi_bf(pv.x), lo_bf(pv.y), hi_bf(pv.y)}; } while (0)
#define GLA_LD(Q, K, Dd, V, p, pvv) do { _Pragma("unroll") for (int m = 0; m < 2; ++m) { Q[m] = *(const LAS f32x4*)((p) + 16 * m); K[m] = *(const LAS f32x4*)((p) + 2048 + 16 * m); Dd[m] = *(const LAS f32x4*)((p) + 4096 + 16 * m); } V = *(const LAS float*)(pvv); } while (0)
#define GLA_TOK(Q, K, Dd, V, tu) do { const f32x2 vv2 = (f32x2){V, V}; \
        S2[0] = __builtin_elementwise_fma((f32x2){K[0][0], K[0][1]}, vv2, (f32x2){Dd[0][0], Dd[0][1]} * S2[0]); S2[1] = __builtin_elementwise_fma((f32x2){K[0][2], K[0][3]}, vv2, (f32x2){Dd[0][2], Dd[0][3]} * S2[1]); \
        S2[2] = __builtin_elementwise_fma((f32x2){K[1][0], K[1][1]}, vv2, (f32x2){Dd[1][0], Dd[1][1]} * S2[2]); S2[3] = __builtin_elementwise_fma((f32x2){K[1][2], K[1][3]}, vv2, (f32x2){Dd[1][2], Dd[1][3]} * S2[3]); \
        f32x2 oa = (f32x2){Q[0][0], Q[0][1]} * S2[0], ob = (f32x2){Q[0][2], Q[0][3]} * S2[1]; \
        oa = __builtin_elementwise_fma((f32x2){Q[1][0], Q[1][1]}, S2[2], oa); ob = __builtin_elementwise_fma((f32x2){Q[1][2], Q[1][3]}, S2[3], ob); oa = oa + ob; \
        const float o = quad_sum(oa.x + oa.y); okeep = ((tu) == kq) ? o : okeep; } while (0)
    GLA_FETCH(0);
    GLA_PUT(wl);
    f32x4 QA[2], KA[2], DA[2], QB[2], KB[2], DB[2]; float VA, VB;
    GLA_LD(QA, KA, DA, VA, wl + kq * 32, wl + 6144 + vl * 4);
#pragma unroll 1
    for (int ci = 0; ci < 144; ++ci) {
        LAS unsigned char* buf = wl + (ci & 1) * 7168; LAS unsigned char* obuf = wl + ((ci + 1) & 1) * 7168;
        if (ci + 1 < 144) GLA_FETCH(ci + 1);
        const int r0 = scan_row(b, dir, ci * 16);
        float okeep = 0.f;
#pragma unroll 1
        for (int tg = 0; tg < 4; ++tg) {
            if (tg == 3 && ci + 1 < 144) GLA_PUT(obuf);
            LAS unsigned char* pt = buf + tg * 512 + kq * 32; LAS unsigned char* pvt = buf + 6144 + tg * 256 + vl * 4;
            LAS unsigned char* pn = (tg == 3) ? obuf + kq * 32 : pt + 512; LAS unsigned char* pvn = (tg == 3) ? obuf + 6144 + vl * 4 : pvt + 256;
            GLA_LD(QB, KB, DB, VB, pt + 128, pvt + 64);  __builtin_amdgcn_sched_barrier(0); GLA_TOK(QA, KA, DA, VA, 0); __builtin_amdgcn_sched_barrier(0);
            GLA_LD(QA, KA, DA, VA, pt + 256, pvt + 128); __builtin_amdgcn_sched_barrier(0); GLA_TOK(QB, KB, DB, VB, 1); __builtin_amdgcn_sched_barrier(0);
            GLA_LD(QB, KB, DB, VB, pt + 384, pvt + 192); __builtin_amdgcn_sched_barrier(0); GLA_TOK(QA, KA, DA, VA, 2); __builtin_amdgcn_sched_barrier(0);
            GLA_LD(QA, KA, DA, VA, pn, pvn);             __builtin_amdgcn_sched_barrier(0); GLA_TOK(QB, KB, DB, VB, 3); __builtin_amdgcn_sched_barrier(0);
            GO[(size_t)(r0 + step * (tg * 4 + kq)) * 256 + h * 64 + vbase + vl] = okeep;
        }
    }
#undef GLA_FETCH
#undef GLA_PUT
#undef GLA_LD
#undef GLA_TOK
}
template <int L>
__device__ __forceinline__ void hyena_unit(CArgs& a, int l, int c, LAS unsigned char* lds) {
    constexpr int Lt = L == SEQ ? 1 : 0, SOFF = L == SEQ ? CTXL : 0, CST = (2 * L + 16) * 2 + 32;
    constexpr int NTW = L / 16 / 8;
    const int tid = tidx(), lane = tid & 63, w = tid >> 6, fr = lane & 15, kg = lane >> 4;
    const float* kf = (const float*)(a.ws + WS_KUN) + ((size_t)((l * 2 + Lt) * 512 + c)) * 2048;
    const float* kb = kf + (size_t)256 * 2048;
    LAS float* red = (LAS float*)(lds + 8 * CST);
    float s = 0.f;
    for (int t = tid; t < L; t += 512) s += fabsf(kf[t]) + (t >= 1 ? fabsf(kb[t]) : 0.f);
    s = wave_sum(s);
    if (lane == 0) red[w] = s;
    __syncthreads();
    float l1 = 0.f;
#pragma unroll
    for (int i = 0; i < 8; ++i) l1 += red[i];
    const float inv = 1.f / l1;
    for (int idx = tid; idx < 2 * L + 16; idx += 512) {
        float gv = 0.f;
        if (idx >= 1 && idx <= L) gv = kf[L - idx] * inv; else if (idx > L && idx < 2 * L) gv = kb[idx - L] * inv;
        const bf16 gb = (bf16)f2bf(gv);
#pragma unroll
        for (int r = 0; r < 8; ++r) if (idx - r >= 0) *(LAS bf16*)(lds + r * CST + (idx - r) * 2) = gb;
    }
    __syncthreads();
    const bf16* Z = (const bf16*)(a.ws + WS_MIX + MX_ZT) + ((size_t)(c * 16 + fr)) * 2304 + SOFF;
    float* YT = (float*)(a.ws + WS_MIX + MX_YT) + ((size_t)(c * 16 + fr)) * 2304 + SOFF;
    f32x4 acc[NTW];
#pragma unroll
    for (int j = 0; j < NTW; ++j) acc[j] = (f32x4){0.f, 0.f, 0.f, 0.f};
    const int rr = (8 - (fr & 7)) & 7;
    for (int i = 0; i < L / 32; ++i) {
        const bf16x8 Bf = *(const bf16x8*)(Z + 32 * i + 8 * kg);
#pragma unroll
        for (int j = 0; j < NTW; ++j) {
            const int t0 = 16 * (w * NTW + j);
            const int o = 32 * i + 8 * kg - t0 - fr + L;
            const bf16x8 Af = *(const LAS bf16x8*)(lds + rr * CST + (o >> 3) * 16);
            acc[j] = __builtin_amdgcn_mfma_f32_16x16x32_bf16(Af, Bf, acc[j], 0, 0, 0);
        }
    }
#pragma unroll
    for (int j = 0; j < NTW; ++j) *(f32x4*)(YT + 16 * (w * NTW + j) + 4 * kg) = acc[j];
    __syncthreads();
}
__device__ __forceinline__ void ph_scan(CArgs& a, int l, LAS unsigned char* lds, int bid, int nblk, unsigned long long& tacc) {
    const int tid = tidx(), lane = tid & 63, w = __builtin_amdgcn_readfirstlane(tid >> 6);
    unsigned long long t0 = 0ull;
    if (PROBE_PH >= 20) t0 = __builtin_amdgcn_s_memrealtime();
    if (w < 6) {
        for (int it = bid; it < 256; it += nblk) {
            const int p = it >> 1, half = it & 1;
            if (w < 4) gdn_wave(a, p, 32 * half + 8 * w, lds + w * 17408, lane);
            else gla_wave(a, p, 32 * half + 16 * (w & 1), lds + 69632 + (w - 4) * 14336, lane);
        }
        if (PROBE_PH == 20 && w < 4) tacc += __builtin_amdgcn_s_memrealtime() - t0;
        if (PROBE_PH == 21 && w >= 4) tacc += __builtin_amdgcn_s_memrealtime() - t0;
    } else {
        tr_experts_waves(a, l, lds + 98304 + (w - 6) * 8448, bid * 2 + (w - 6), nblk * 2, lane);
        if (PROBE_PH == 22) tacc += __builtin_amdgcn_s_memrealtime() - t0;
    }
    __syncthreads();
    if (PROBE_PH == 23) t0 = __builtin_amdgcn_s_memrealtime();
    for (int it = bid; it < 512; it += nblk) {
        if (it < 256) hyena_unit<SEQ>(a, l, it, lds);
        else hyena_unit<CTXL>(a, l, it - 256, lds);
    }
    if (PROBE_PH == 23) tacc += __builtin_amdgcn_s_memrealtime() - t0;
}

__device__ __forceinline__ void ph_post_hyena(CArgs& a, int l, LAS unsigned char* lds, int bid, int nblk) {
    const bf16* P = (const bf16*)(a.ws + WS_P);
    const float* YT = (const float*)(a.ws + WS_MIX + MX_YT); bf16* YMIX = (bf16*)(a.ws + WS_YMIX);
    LAS float* yt = (LAS float*)lds;
    const int tid = tidx(), c4 = (tid & 63) * 4, tg = tid >> 6;
    const float* hw = a.in[I_HYCW] + l * 3 * 768; const float* hb = a.in[I_HYCB] + l * 768;
    f32x4 w0[3], wx[3], wv[3];
#pragma unroll
    for (int k = 0; k < 3; ++k) { w0[k] = *(const f32x4*)(hw + k * 768 + c4); wx[k] = *(const f32x4*)(hw + k * 768 + 256 + c4); wv[k] = *(const f32x4*)(hw + k * 768 + 512 + c4); }
    const f32x4 b0 = *(const f32x4*)(hb + c4), bx = *(const f32x4*)(hb + 256 + c4), bv = *(const f32x4*)(hb + 512 + c4), hd = *(const f32x4*)(a.in[I_HYD] + l * 256 + c4);
#pragma unroll 1
    for (int it = bid; it < 576; it += nblk) {
        const Chunk c = chunk_of(it);
        const int soff = c.L == CTXL ? 0 : CTXL;
        { const int ch = tid & 255, half = tid >> 8;
          const float* srcp = YT + ((size_t)(ch * 16 + c.b)) * 2304 + soff + c.t0 + half * 32;
#pragma unroll
          for (int j = 0; j < 8; ++j) { const f32x4 v = *(const f32x4*)(srcp + 4 * j);
              yt[(half * 32 + 4 * j) * 260 + ch] = v[0]; yt[(half * 32 + 4 * j + 1) * 260 + ch] = v[1]; yt[(half * 32 + 4 * j + 2) * 260 + ch] = v[2]; yt[(half * 32 + 4 * j + 3) * 260 + ch] = v[3]; } }
        __syncthreads();
        const int tb = c.t0 + tg * 8;
        const bf16* pb = P + (size_t)(c.row0 + tg * 8) * D_INP;
        f32x4 x0[10], x1[10], vv[10];
#pragma unroll
        for (int r = 0; r < 10; ++r) { const int t = tb + r - 1; const bool ok = t >= c.lo && t < c.hi; const bf16* p = pb + (ptrdiff_t)(r - 1) * D_INP;
            x0[r] = ok ? bf4(*(const u32x2*)(p + HY0 + c4)) : (f32x4){0.f, 0.f, 0.f, 0.f};
            x1[r] = ok ? bf4(*(const u32x2*)(p + HY0 + 256 + c4)) : (f32x4){0.f, 0.f, 0.f, 0.f}; vv[r] = ok ? bf4(*(const u32x2*)(p + HY0 + 512 + c4)) : (f32x4){0.f, 0.f, 0.f, 0.f}; }
#pragma unroll
        for (int tt = 0; tt < 8; ++tt) {
            const f32x4 u0 = w0[0] * x0[tt] + w0[1] * x0[tt + 1] + w0[2] * x0[tt + 2] + b0;
            const f32x4 xx = wx[0] * x1[tt] + wx[1] * x1[tt + 1] + wx[2] * x1[tt + 2] + bx, v2 = wv[0] * vv[tt] + wv[1] * vv[tt + 1] + wv[2] * vv[tt + 2] + bv, z = xx * v2;
            const f32x4 y = *(const LAS f32x4*)(yt + (tg * 8 + tt) * 260 + c4);
            const f32x4 o = (y + z * hd) * u0;
            u32x2 oo; oo.x = pk2(o[0], o[1]); oo.y = pk2(o[2], o[3]); *(u32x2*)(YMIX + (size_t)(c.row0 + tg * 8 + tt) * D + c4) = oo;
        }
        __syncthreads();
    }
}
__device__ __forceinline__ void ph_post_tok(CArgs& a, int l, int gw, int ngw) {
    const int lane = tidx() & 63;
    const bf16* P = (const bf16*)(a.ws + WS_P); bf16* YMIX = (bf16*)(a.ws + WS_YMIX);
    const float* GOF = (const float*)(a.ws + WS_MIX + MX_GOF); const float* GOB = (const float*)(a.ws + WS_MIX + MX_GOB);
    const float* DOF = (const float*)(a.ws + WS_MIX + MX_DOF); const float* DOB = (const float*)(a.ws + WS_MIX + MX_DOB);
    const f32x4 nwa = *(const f32x4*)(a.in[I_GLANW] + l * 64 + (4 * lane & 63)), nwd = *(const f32x4*)(a.in[I_GDNNW] + l * 64 + (4 * lane & 63));
    for (int row = gw; row < NTOK; row += ngw) {
        const size_t o4 = (size_t)row * 256 + 4 * lane;
        f32x4 og = *(const f32x4*)(GOF + o4) + *(const f32x4*)(GOB + o4), od = *(const f32x4*)(DOF + o4) + *(const f32x4*)(DOB + o4);
        float sg = og[0] * og[0] + og[1] * og[1] + og[2] * og[2] + og[3] * og[3], sd = od[0] * od[0] + od[1] * od[1] + od[2] * od[2] + od[3] * od[3];
        sg = row16_sum(sg); sd = row16_sum(sd);
        const float rg = rsqrtf(sg * (1.f / 64.f) + 1e-6f), rd = rsqrtf(sd * (1.f / 64.f) + 1e-6f);
        const u32x2 r2 = *(const u32x2*)(P + (size_t)row * D_INP + GLA0 + 512 + 4 * lane), z2 = *(const u32x2*)(P + (size_t)row * D_INP + GDN0 + 768 + 4 * lane);
        u32x2 w;
        w.x = pk2(og[0] * rg * nwa[0] * siluf_(lo_bf(r2.x)), og[1] * rg * nwa[1] * siluf_(hi_bf(r2.x))); w.y = pk2(og[2] * rg * nwa[2] * siluf_(lo_bf(r2.y)), og[3] * rg * nwa[3] * siluf_(hi_bf(r2.y)));
        *(u32x2*)(YMIX + (size_t)row * D + 512 + 4 * lane) = w;
        w.x = pk2(od[0] * rd * nwd[0] * siluf_(lo_bf(z2.x)), od[1] * rd * nwd[1] * siluf_(hi_bf(z2.x))); w.y = pk2(od[2] * rd * nwd[2] * siluf_(lo_bf(z2.y)), od[3] * rd * nwd[3] * siluf_(hi_bf(z2.y)));
        *(u32x2*)(YMIX + (size_t)row * D + 768 + 4 * lane) = w;
    }
}

__device__ __forceinline__ void ph_ln1_route(CArgs& a, int l, LAS unsigned char* lds, int bid, int nblk) {
    const int tid = tidx(), lane = tid & 63, w = __builtin_amdgcn_readfirstlane(tid >> 6);
    const float* MOD = (const float*)(a.ws + WS_MOD) + (size_t)l * 17 * 6144;
    float* X = (float*)(a.ws + WS_X); const float* TMP = (const float*)(a.ws + WS_TMP); bf16* HB = (bf16*)(a.ws + WS_HB);
    const float* lg = a.in[I_LN1G] + l * D; const float* lb = a.in[I_LN1B] + l * D;
    const float* br = a.in[I_BR] + l * NEXP;
    const bf16* wh = (const bf16*)(a.ws + WS_WRT) + (size_t)l * NEXP * D; const bf16* wl = wh + DEPTH * NEXP * D;
    unsigned* cnt = (unsigned*)(a.ws + WS_CTL) + CW_CNT + l * NEXP * 64;
    int* LIST = (int*)(a.ws + WS_LIST); int* TOPE = (int*)(a.ws + WS_TOPE); float* TOPW = (float*)(a.ws + WS_TOPW);
    LAS float* hrow = (LAS float*)lds;
    LAS float* part = (LAS float*)(lds + 65792);
    const int row_lo = (l == DEPTH - 1) ? NTOK_C : 0;
    const int e = lane & 31, par = lane >> 5, fr = lane & 15, kg = lane >> 4;
    f32x4 xv[2][4], tv[2][4];
#define LN1_FETCH(base_) do { _Pragma("unroll") for (int t = 0; t < 2; ++t) { const int row_ = (base_) + 2 * w + t; \
        const float* xs_ = (l == 0) ? (row_ < NTOK_C ? a.in[I_CTX] + (size_t)row_ * D : a.in[I_X] + (size_t)(row_ - NTOK_C) * D) : X + (size_t)row_ * D; \
        _Pragma("unroll") for (int j = 0; j < 4; ++j) { xv[t][j] = *(const f32x4*)(xs_ + j * 256 + 4 * lane); tv[t][j] = *(const f32x4*)(TMP + (size_t)row_ * D + j * 256 + 4 * lane); } } } while (0)
    int base = row_lo + bid * 16;
    if (base < NTOK) LN1_FETCH(base);
    int p_row = -1, p_ee = 0; unsigned p_pos = 0u; float p_ww = 0.f;
#pragma unroll 1
    for (; base < NTOK; base += nblk * 16) {
#pragma unroll
        for (int t = 0; t < 2; ++t) {
            const int row = base + 2 * w + t;
            const float* mv = MOD + (size_t)mod_vec(row) * 6144;
            f32x4 v[4]; float s = 0.f;
#pragma unroll
            for (int j = 0; j < 4; ++j) { const int c0 = j * 256 + 4 * lane; const f32x4 g1 = *(const f32x4*)(mv + 2048 + c0);
                v[j] = DN_ALPHA * xv[t][j] + g1 * tv[t][j]; s += (v[j][0] + v[j][1]) + (v[j][2] + v[j][3]); }
            const float mean = wave_sum(s) * (1.f / D); float s2 = 0.f;
#pragma unroll
            for (int j = 0; j < 4; ++j) { v[j] = v[j] - mean; s2 += (v[j][0] * v[j][0] + v[j][1] * v[j][1]) + (v[j][2] * v[j][2] + v[j][3] * v[j][3]); }
            const float rstd = rsqrtf(wave_sum(s2) * (1.f / D) + LN_EPS);
#pragma unroll
            for (int j = 0; j < 4; ++j) { const int c0 = j * 256 + 4 * lane; const f32x4 g = *(const f32x4*)(lg + c0), bb = *(const f32x4*)(lb + c0), sh = *(const f32x4*)(mv + 3072 + c0), sc = *(const f32x4*)(mv + 4096 + c0);
                const f32x4 xn = v[j] * rstd * g + bb; *(f32x4*)(X + (size_t)row * D + c0) = xn;
                const f32x4 hh = xn * (1.f + sc) + sh;
                *(unsigned*)(a.ws + WS_HB8 + (size_t)row * D + c0) = pk4_fp8(hh[0], hh[1], hh[2], hh[3]);
                *(LAS f32x4*)(hrow + (2 * w + t) * 1028 + c0) = hh; }
        }
        __syncthreads();
        if (base + nblk * 16 < NTOK) LN1_FETCH(base + nblk * 16);
        {
            f32x4 acc[2] = {(f32x4){0.f, 0.f, 0.f, 0.f}, (f32x4){0.f, 0.f, 0.f, 0.f}};
#pragma unroll
            for (int ss = 0; ss < 4; ++ss) { const int k0 = 128 * w + 32 * ss + 8 * kg;
                const f32x4 h0 = *(const LAS f32x4*)(hrow + fr * 1028 + k0), h1 = *(const LAS f32x4*)(hrow + fr * 1028 + k0 + 4);
                u32x4 ah, al;
                ah.x = pk2(h0[0], h0[1]); ah.y = pk2(h0[2], h0[3]); ah.z = pk2(h1[0], h1[1]); ah.w = pk2(h1[2], h1[3]);
                al.x = pk2(h0[0] - lo_bf(ah.x), h0[1] - hi_bf(ah.x)); al.y = pk2(h0[2] - lo_bf(ah.y), h0[3] - hi_bf(ah.y)); al.z = pk2(h1[0] - lo_bf(ah.z), h1[1] - hi_bf(ah.z)); al.w = pk2(h1[2] - lo_bf(ah.w), h1[3] - hi_bf(ah.w));
                const bf16x8 Ah = __builtin_bit_cast(bf16x8, ah), Al = __builtin_bit_cast(bf16x8, al);
#pragma unroll
                for (int t = 0; t < 2; ++t) { const size_t wo = (size_t)(16 * t + fr) * D + k0;
                    const bf16x8 Bh = *(const bf16x8*)(wh + wo), Bl = *(const bf16x8*)(wl + wo);
                    acc[t] = __builtin_amdgcn_mfma_f32_16x16x32_bf16(Ah, Bh, acc[t], 0, 0, 0);
                    acc[t] = __builtin_amdgcn_mfma_f32_16x16x32_bf16(Ah, Bl, acc[t], 0, 0, 0);
                    acc[t] = __builtin_amdgcn_mfma_f32_16x16x32_bf16(Al, Bh, acc[t], 0, 0, 0); } }
#pragma unroll
            for (int t = 0; t < 2; ++t)
#pragma unroll
                for (int j = 0; j < 4; ++j) part[((w * 2 + t) * 16 + 4 * kg + j) * 16 + fr] = acc[t][j];
        }
        __syncthreads();
        {
            const int row = base + 2 * w + par;
            float cur = br[e];
#pragma unroll
            for (int ww = 0; ww < 8; ++ww) cur += part[((ww * 2 + (e >> 4)) * 16 + 2 * w + par) * 16 + (e & 15)];
            float tvv[4]; int ti[4];
#pragma unroll
            for (int k = 0; k < 4; ++k) { float bv = cur; int bi = e;
#define TOPSTEP(OV, OI) do { const float ov = (OV); const int oi = (OI); if (ov > bv || (ov == bv && oi < bi)) { bv = ov; bi = oi; } } while (0)
                TOPSTEP(dpp_f<0xB1>(bv), dpp_i<0xB1>(bi)); TOPSTEP(dpp_f<0x4E>(bv), dpp_i<0x4E>(bi)); TOPSTEP(dpp_f<0x141>(bv), dpp_i<0x141>(bi)); TOPSTEP(dpp_f<0x140>(bv), dpp_i<0x140>(bi));
                TOPSTEP(__shfl_xor(bv, 16), __shfl_xor(bi, 16));
#undef TOPSTEP
                tvv[k] = bv; ti[k] = bi; if (e == bi) cur = -3.0e38f; }
            const float e1 = __expf(tvv[1] - tvv[0]), e2 = __expf(tvv[2] - tvv[0]), e3 = __expf(tvv[3] - tvv[0]); const float inv = 1.f / (1.f + e1 + e2 + e3);
            if (e < 4) {
                if (p_row >= 0) { LIST[(size_t)p_ee * NTOK + p_pos] = p_row; TOPE[(size_t)p_row * 4 + e] = (p_ee << 20) | (int)p_pos; TOPW[(size_t)p_row * 4 + e] = p_ww; }
                p_ee = e == 0 ? ti[0] : e == 1 ? ti[1] : e == 2 ? ti[2] : ti[3]; p_ww = (e == 0 ? 1.f : e == 1 ? e1 : e == 2 ? e2 : e3) * inv; p_row = row;
                p_pos = atomicAdd(cnt + p_ee * 64, 1u); }
        }
    }
    if (e < 4 && p_row >= 0) { LIST[(size_t)p_ee * NTOK + p_pos] = p_row; TOPE[(size_t)p_row * 4 + e] = (p_ee << 20) | (int)p_pos; TOPW[(size_t)p_row * 4 + e] = p_ww; }
#undef LN1_FETCH
}
__device__ __forceinline__ void moe_tables(CArgs& a, int l, LAS unsigned char* lds, int NT) {
    LAS int* pre = (LAS int*)(lds + TAB_OFF); LAS int* mtl = pre + 40; LAS int* rowoff = pre + 80; LAS int* cn = pre + 120;
    if (tidx() == 0) { const unsigned* cnt = (const unsigned*)(a.ws + WS_CTL) + CW_CNT + l * NEXP * 64; int p = 0, r = 0;
        for (int e = 0; e < NEXP; ++e) { const int n = (int)__hip_atomic_load(cnt + e * 64, __ATOMIC_RELAXED, __HIP_MEMORY_SCOPE_AGENT), m = (n + 255) >> 8; pre[e] = p; mtl[e] = m > 0 ? m : 1; rowoff[e] = r; cn[e] = n; p += m * NT; r += m * 256; }
        pre[32] = p; }
    __syncthreads();
}
__device__ __forceinline__ void ph_ln2(CArgs& a, int l, LAS unsigned char* lds, int gw, int ngw) {
    const int lane = tidx() & 63;
    const float* MOD = (const float*)(a.ws + WS_MOD) + (size_t)l * 17 * 6144;
    float* X = (float*)(a.ws + WS_X); const bf16* YD = (const bf16*)(a.ws + WS_YD); bf16* HB = (bf16*)(a.ws + WS_HB);
    const float* lg = a.in[I_LN2G] + l * D; const float* lb = a.in[I_LN2B] + l * D;
    const int* TOPE = (const int*)(a.ws + WS_TOPE); const float* TOPW = (const float*)(a.ws + WS_TOPW);
    const LAS int* rowoff = (const LAS int*)(lds + TAB_OFF) + 80;
    const bool lastl = (l == DEPTH - 1);
    const int row_lo = lastl ? NTOK_C : 0;
#pragma unroll 1
    for (int row0 = row_lo + gw * 2; row0 < NTOK; row0 += ngw * 2) {
        u32x2 y2[2][4][4]; float tw[2][4]; f32x4 xv[2][4], g2v[2][4];
#pragma unroll
        for (int r = 0; r < 2; ++r) {
            const int row = row0 + r;
#pragma unroll
            for (int k = 0; k < 4; ++k) { const int te = TOPE[(size_t)row * 4 + k]; tw[r][k] = TOPW[(size_t)row * 4 + k];
                const bf16* yr = YD + ((size_t)(rowoff[te >> 20] + (te & 0xfffff))) * D;
#pragma unroll
                for (int j = 0; j < 4; ++j) y2[r][k][j] = *(const u32x2*)(yr + j * 256 + 4 * lane); }
            const float* mv = MOD + (size_t)mod_vec(row) * 6144;
#pragma unroll
            for (int j = 0; j < 4; ++j) { const int c0 = j * 256 + 4 * lane; xv[r][j] = *(const f32x4*)(X + (size_t)row * D + c0); g2v[r][j] = *(const f32x4*)(mv + 5120 + c0); }
        }
#pragma unroll
        for (int r = 0; r < 2; ++r) {
            const int row = row0 + r;
            const float* mv = MOD + (size_t)mod_vec(row) * 6144;
            f32x4 v[4]; float s = 0.f;
#pragma unroll
            for (int j = 0; j < 4; ++j) { f32x4 f = (f32x4){0.f, 0.f, 0.f, 0.f};
#pragma unroll
                for (int k = 0; k < 4; ++k) { const u32x2 yy = y2[r][k][j]; f += tw[r][k] * (f32x4){lo_bf(yy.x), hi_bf(yy.x), lo_bf(yy.y), hi_bf(yy.y)}; }
                v[j] = DN_ALPHA * xv[r][j] + g2v[r][j] * f; s += (v[j][0] + v[j][1]) + (v[j][2] + v[j][3]); }
            const float mean = wave_sum(s) * (1.f / D); float s2 = 0.f;
#pragma unroll
            for (int j = 0; j < 4; ++j) { v[j] = v[j] - mean; s2 += (v[j][0] * v[j][0] + v[j][1] * v[j][1]) + (v[j][2] * v[j][2] + v[j][3] * v[j][3]); }
            const float rstd = rsqrtf(wave_sum(s2) * (1.f / D) + LN_EPS);
            const float* mvn = mv + 17 * 6144;
#pragma unroll
            for (int j = 0; j < 4; ++j) { const int c0 = j * 256 + 4 * lane; const f32x4 g = *(const f32x4*)(lg + c0), bb = *(const f32x4*)(lb + c0);
                const f32x4 xn = v[j] * rstd * g + bb;
                if (lastl) *(f32x4*)(a.out + (size_t)(row - NTOK_C) * D + c0) = xn;
                else { *(f32x4*)(X + (size_t)row * D + c0) = xn; const f32x4 sh = *(const f32x4*)(mvn + c0), sc = *(const f32x4*)(mvn + 1024 + c0); const f32x4 hh = xn * (1.f + sc) + sh;
                    u32x2 o; o.x = pk2(hh[0], hh[1]); o.y = pk2(hh[2], hh[3]); *(u32x2*)(HB + (size_t)row * D + c0) = o; } }
        }
    }
}

constexpr int NPH = 2 + DEPTH * 9;
__device__ __forceinline__ CArgs* kargs() { CArgs* p = (CArgs*)__builtin_amdgcn_kernarg_segment_ptr(); asm volatile("" : "+s"(p)); return p; }
__global__ void __launch_bounds__(512, 2) trunk_fwd(Args a_unused) {
    extern __shared__ __attribute__((aligned(16))) unsigned char lds_raw[];
    LAS unsigned char* lds = (LAS unsigned char*)lds_raw;
    const int tid = threadIdx.x, wave = __builtin_amdgcn_readfirstlane(tid >> 6);
    const int bid = blockIdx.x, nblk = gridDim.x, gw = bid * 8 + wave, ngw = nblk * 8;
    volatile LAS unsigned* MISC = (volatile LAS unsigned*)(lds + MISC_OFF);
    if (tid < 64) MISC[tid] = 0u;
    __syncthreads();
    XcdBarrier bar; bar.x = 0; bar.st = nullptr;
    int lo, hi;
    { CArgs& a = *kargs(); lo = a.ph_lo; hi = a.ph_hi; bar.bar = (unsigned*)(a.ws + WS_CTL) + CW_BAR;
      if (hi - lo > 1) bar = xcd_barrier_post((unsigned*)(a.ws + WS_CTL) + CW_BAR, MISC); }
#define IN(k) (lo <= (k) && (k) < hi)
    unsigned long long tacc = 0ull, tbeg = 0ull;
#define PB_BEG(ty) do { if (PROBE_PH == (ty)) tbeg = __builtin_amdgcn_s_memrealtime(); } while (0)
#define PB_END(ty) do { if (PROBE_PH == (ty)) tacc += __builtin_amdgcn_s_memrealtime() - tbeg; } while (0)
#define SEAM(k) do { if (IN(k) && IN((k) + 1)) xcd_barrier(bar); } while (0)
    PB_BEG(0);
    if (IN(0)) { CArgs& a = *kargs(); unsigned long long t0 = 0ull;
#define PB_SUB(ty, stmt) do { if (PROBE_PH == (ty)) t0 = __builtin_amdgcn_s_memrealtime(); stmt; if (PROBE_PH == (ty)) tacc += __builtin_amdgcn_s_memrealtime() - t0; } while (0)
        PB_SUB(30, ph_mod(a, lds, bid, nblk)); __syncthreads(); PB_SUB(31, ph_filters(a, gw, ngw)); PB_SUB(32, ph_tr_small(a, lds, gw, ngw)); PB_SUB(33, ph_router_w(a, bid * 512 + tid, nblk * 512));
#undef PB_SUB
    }
    SEAM(0); PB_END(0); PB_BEG(1);
    if (IN(1)) { CArgs& a = *kargs(); ph_mod_input(a, gw, ngw); }
    SEAM(1); PB_END(1);
#pragma unroll 1
    for (int l = 0; l < DEPTH; ++l) {
        const int p0 = 2 + 9 * l;
        const bool lastl = (l == DEPTH - 1);
        PB_BEG(2);
        if (IN(p0 + 0)) {
            CArgs& a = *kargs();
            pg8::DenseSched S; S.init((const bf16*)(a.ws + WS_WIN) + (size_t)l * D_INP * 1024, 1024, NTOK, D_INP, nblk, bid, 0);
            pg8::EpiBf16 E{(bf16*)(a.ws + WS_P), D_INP, 0};
            pg8::gemm_phase<pg8::EpiBf16, pg8::DenseSched, true>(lds, (const char*)(a.ws + WS_HB), 1024, S, E);
        }
        SEAM(p0 + 0); PB_END(2); PB_BEG(3);
        if (IN(p0 + 1)) { CArgs& a = *kargs(); ph_prep_conv(a, l, lds, bid, nblk); ph_prep_tok(a, l, gw, ngw); }
        SEAM(p0 + 1); PB_END(3); PB_BEG(4);
        if (IN(p0 + 2)) { CArgs& a = *kargs(); ph_scan(a, l, lds, bid, nblk, tacc); }
        SEAM(p0 + 2); PB_END(4); PB_BEG(5);
        if (IN(p0 + 3)) { CArgs& a = *kargs(); ph_post_hyena(a, l, lds, bid, nblk); ph_post_tok(a, l, gw, ngw); }
        SEAM(p0 + 3); PB_END(5); PB_BEG(6);
        if (IN(p0 + 4)) {
            CArgs& a = *kargs();
            const int r0 = lastl ? NTOK_C : 0;
            pg8::DenseSched S; S.init((const bf16*)(a.ws + WS_WOUT) + (size_t)l * 1024 * 1024, 1024, NTOK - r0, 1024, nblk, bid, r0);
            pg8::EpiF32 E{(float*)(a.ws + WS_TMP), 1024, r0};
            pg8::gemm_phase<pg8::EpiF32, pg8::DenseSched, true>(lds, (const char*)(a.ws + WS_YMIX), 1024, S, E);
        }
        SEAM(p0 + 4); PB_END(6); PB_BEG(7);
        if (IN(p0 + 5)) { CArgs& a = *kargs(); ph_ln1_route(a, l, lds, bid, nblk); }
        SEAM(p0 + 5); PB_END(7); PB_BEG(8);
        if (IN(p0 + 6)) {
            CArgs& a = *kargs();
            moe_tables(a, l, lds, 8);
            const LAS int* tb = (const LAS int*)(lds + TAB_OFF);
            pg8::MoeSched<true, 8> S; S.Bt = (const char*)(a.ws + WS_WGU); S.bstride = (size_t)2048 * 1024; S.rb = 1024; S.list = (const int*)(a.ws + WS_LIST);
            S.pre = tb; S.mtl = tb + 40; S.rowoff = tb + 80; S.cnt = tb + 120; S.K = 1024; S.G = nblk; S.c = (nblk % 8 == 0) ? (bid % 8) * (nblk / 8) + bid / 8 : bid; S.total = tb[32];
            pg8::EpiSwiglu E{(bf16*)(a.ws + WS_H), a.in[I_BG] + (size_t)l * NEXP * 1024, a.in[I_BU] + (size_t)l * NEXP * 1024, tb + 80, 1.f / 32.f};
            pg8::gemm_phase_f8g<pg8::EpiSwiglu, pg8::MoeSched<true, 8>, true>(lds, (const char*)(a.ws + WS_HB8), 1024, S, E);
        }
        SEAM(p0 + 6); PB_END(8); PB_BEG(9);
        if (IN(p0 + 7)) {
            CArgs& a = *kargs();
            moe_tables(a, l, lds, 4);
            const LAS int* tb = (const LAS int*)(lds + TAB_OFF);
            pg8::MoeSched<false, 4> S; S.Bt = (const char*)(a.ws + WS_WD); S.bstride = (size_t)1024 * 1024; S.rb = 1024; S.list = nullptr;
            S.pre = tb; S.mtl = tb + 40; S.rowoff = tb + 80; S.cnt = tb + 120; S.K = 1024; S.G = nblk; S.c = (nblk % 8 == 0) ? (bid % 8) * (nblk / 8) + bid / 8 : bid; S.total = tb[32];
            pg8::EpiDown E{(bf16*)(a.ws + WS_YD), a.in[I_BD] + (size_t)l * NEXP * 1024, tb + 80, 1.f / 32.f};
            pg8::gemm_phase_f8<pg8::EpiDown, pg8::MoeSched<false, 4>, true>(lds, (const char*)(a.ws + WS_H), 1024, S, E);
        }
        SEAM(p0 + 7); PB_END(9); PB_BEG(10);
        if (IN(p0 + 8)) { CArgs& a = *kargs(); moe_tables(a, l, lds, 4); ph_ln2(a, l, lds, gw, ngw); }
        if (!lastl) SEAM(p0 + 8);
        PB_END(10);
    }
    if (PROBE_PH >= 0) { const unsigned long long t0 = __builtin_amdgcn_s_memrealtime(); while (__builtin_amdgcn_s_memrealtime() - t0 < tacc) __builtin_amdgcn_s_sleep(8); }
#undef IN
#undef SEAM
}

extern "C" void kernel_launch(void* const* d_in, const int* in_sizes, int n_in, void* d_out, int out_size, void* d_ws, size_t ws_size, hipStream_t stream) {
    static int grid = 0;
    if (grid == 0) {
        if (n_in != 39 || out_size != NTOK_L * D || ws_size < WS_END) { fprintf(stderr, "kernel_launch: unexpected problem (n_in %d, out %d, ws %zu < %zu)\n", n_in, out_size, ws_size, (size_t)WS_END); grid = -1; return; }
        int dev = 0, cus = 0, per_cu = 0;
        if (hipGetDevice(&dev) != hipSuccess || hipDeviceGetAttribute(&cus, hipDeviceAttributeMultiprocessorCount, dev) != hipSuccess) { grid = -1; return; }
        if (hipFuncSetAttribute((const void*)trunk_fwd, hipFuncAttributeMaxDynamicSharedMemorySize, LDS_BYTES) != hipSuccess) { fprintf(stderr, "kernel_launch: hipFuncSetAttribute failed\n"); grid = -1; return; }
        if (hipOccupancyMaxActiveBlocksPerMultiprocessor(&per_cu, (const void*)trunk_fwd, 512, LDS_BYTES) != hipSuccess || per_cu < 1) fprintf(stderr, "kernel_launch: occupancy query says %d\n", per_cu);
        (void)hipGetLastError();
        grid = cus;
    }
    if (grid < 0) return;
    (void)hipMemsetAsync((char*)d_ws + WS_CTL, 0, CTL_ZERO_BYTES, stream);
    Args a{};
    for (int i = 0; i < 39; ++i) a.in[i] = (const float*)d_in[i];
    a.out = (float*)d_out; a.ws = (unsigned char*)d_ws;
#if MK_FUSED
    a.ph_lo = 0; a.ph_hi = NPH;
    hipLaunchKernelGGL(trunk_fwd, dim3(grid), dim3(512), LDS_BYTES, stream, a);
#else
    for (int p = 0; p < NPH; ++p) { a.ph_lo = p; a.ph_hi = p + 1; hipLaunchKernelGGL(trunk_fwd, dim3(grid), dim3(512), LDS_BYTES, stream, a); }
#endif
}
```

```cpp
#include <hip/hip_runtime.h>
#include <cstdio>
#include <cstdint>

#ifndef MK_FUSED
#define MK_FUSED 1
#endif

#ifndef USE_NEW_GDN
#define USE_NEW_GDN 1
#endif
#ifndef USE_NEW_GLA
#define USE_NEW_GLA 1
#endif
#ifndef PROBE_PH
#define PROBE_PH -1
#endif

#define LAS __attribute__((address_space(3)))
#define GAS __attribute__((address_space(1)))
typedef unsigned short bf16;
typedef short bf16x8 __attribute__((ext_vector_type(8)));
typedef float f32x4 __attribute__((ext_vector_type(4)));
typedef float f32x2 __attribute__((ext_vector_type(2)));
typedef unsigned u32x4 __attribute__((ext_vector_type(4)));
typedef unsigned u32x2 __attribute__((ext_vector_type(2)));

constexpr int D = 1024, NB = 16, SEQ = 2048, CTXL = 256, DEPTH = 4;
constexpr int NTOK_C = NB * CTXL, NTOK_L = NB * SEQ, NTOK = NTOK_C + NTOK_L;
constexpr int D_IN = 3376, D_INP = 3584;
constexpr int HY0 = 0, SC0 = 768, GLA0 = 1536, GDN0 = 2336;
constexpr int NEXP = 32, TOPK = 4;
constexpr int MAXROWS = NTOK * TOPK + NEXP * 256;
constexpr float DN_ALPHA = 1.681792830507429f;
constexpr float LN_EPS = 1e-5f;

constexpr size_t MiB = 1u << 20;
constexpr size_t WS_CTL = 0, CTL_ZERO_BYTES = 1 * MiB;
constexpr size_t WS_MOD = 1 * MiB;
constexpr size_t WS_WRT = 3 * MiB;
constexpr size_t WS_KUN = 4 * MiB;
constexpr size_t WS_WIN = 36 * MiB;
constexpr size_t WS_WOUT = 64 * MiB;
constexpr size_t WS_WGU = 72 * MiB;
constexpr size_t WS_WD = 200 * MiB;
constexpr size_t WS_X = 264 * MiB;
constexpr size_t WS_HB = 408 * MiB;
constexpr size_t WS_P = 480 * MiB;
constexpr size_t WS_YMIX = 732 * MiB;
constexpr size_t WS_YD = WS_P;
constexpr size_t WS_TMP = 804 * MiB;
constexpr size_t WS_LIST = 948 * MiB;
constexpr size_t WS_TOPE = 953 * MiB;
constexpr size_t WS_TOPW = 954 * MiB;
constexpr size_t WS_H = 956 * MiB;
constexpr size_t WS_MIX = 1264 * MiB;
constexpr size_t MX_ZT = 0;
constexpr size_t MX_YT = 20 * MiB;
constexpr size_t MX_GDF = 56 * MiB, MX_GDB = 76 * MiB;
constexpr size_t MX_GOF = 96 * MiB, MX_GOB = 132 * MiB;
constexpr size_t MX_DQ = 168 * MiB, MX_DK = 204 * MiB, MX_DV = 240 * MiB;
constexpr size_t MX_DG = 276 * MiB;
constexpr size_t MX_DOF = 280 * MiB, MX_DOB = 316 * MiB;
constexpr size_t WS_HB8 = 1616 * MiB;
constexpr size_t WS_END = 1656 * MiB;
static_assert((size_t)MAXROWS * 1024 * 2 <= 324 * MiB, "YD overlay");
static_assert(WS_H + (size_t)MAXROWS * 1024 * 2 <= WS_MIX, "H");
constexpr int CW_BAR = 4096;
constexpr int CW_CNT = 16384;

constexpr int LDS_BYTES = 147456;
constexpr int MISC_OFF = 131072;
constexpr int TAB_OFF = 131072 + 256;

__device__ __forceinline__ float bf2f(unsigned v) { return __uint_as_float(v << 16); }
__device__ __forceinline__ unsigned f2bf(float f) { unsigned u = __float_as_uint(f); return (u + 0x7fffu + ((u >> 16) & 1u)) >> 16; }
__device__ __forceinline__ unsigned pk2(float lo, float hi) { return f2bf(lo) | (f2bf(hi) << 16); }
__device__ __forceinline__ unsigned pk4_fp8(float a, float b, float c, float d) { int r = __builtin_amdgcn_cvt_pk_fp8_f32(a, b, 0, false); return (unsigned)__builtin_amdgcn_cvt_pk_fp8_f32(c, d, r, true); }
__device__ __forceinline__ float lo_bf(unsigned w) { return __uint_as_float(w << 16); }
__device__ __forceinline__ float hi_bf(unsigned w) { return __uint_as_float(w & 0xffff0000u); }
__device__ __forceinline__ float sigmoidf_(float x) { return 1.f / (1.f + __expf(-x)); }
__device__ __forceinline__ float siluf_(float x) { return x / (1.f + __expf(-x)); }
__device__ __forceinline__ float softplusf_(float x) { return x > 20.f ? x : log1pf(__expf(x)); }
__device__ __forceinline__ float logsigmoidf_(float x) { return x >= 0.f ? -log1pf(__expf(-x)) : x - log1pf(__expf(x)); }
__device__ __forceinline__ float sin_rev(float r) { return __builtin_amdgcn_sinf(__builtin_amdgcn_fractf(r)); }
__device__ __forceinline__ float sin_rad(float x) { return sin_rev(x * 0.15915494309189535f); }
template <int CTRL> __device__ __forceinline__ float dpp_f(float v) { return __builtin_bit_cast(float, __builtin_amdgcn_update_dpp(0, __builtin_bit_cast(int, v), CTRL, 0xf, 0xf, true)); }
template <int CTRL> __device__ __forceinline__ int dpp_i(int v) { return __builtin_amdgcn_update_dpp(0, v, CTRL, 0xf, 0xf, true); }
__device__ __forceinline__ float quad_sum(float v) { v += dpp_f<0xB1>(v); v += dpp_f<0x4E>(v); return v; }
__device__ __forceinline__ float row16_sum(float v) { v += dpp_f<0xB1>(v); v += dpp_f<0x4E>(v); v += dpp_f<0x141>(v); v += dpp_f<0x140>(v); return v; }
__device__ __forceinline__ float rdlane_f(float v, int l) { return __builtin_bit_cast(float, __builtin_amdgcn_readlane(__builtin_bit_cast(int, v), l)); }
__device__ __forceinline__ float wave_sum(float v) {
    v = row16_sum(v);
    return (rdlane_f(v, 0) + rdlane_f(v, 16)) + (rdlane_f(v, 32) + rdlane_f(v, 48));
}
__device__ __forceinline__ int tidx() { int t = threadIdx.x; asm volatile("" : "+v"(t)); return t; }

#define XB_TMO      128
#define XB_XCNT(j)  (256  + 64 * (j))
#define XB_XSUB(j)  (1280 + 64 * (j))
#define XB_XGEN(j)  (2304 + 64 * (j))
#define XB_TOP      3328
#define XB_TOPGEN   3392
#define XCD_BAR_WORDS 3456
#define XB_SPIN_CAP (1u << 25)
__device__ __forceinline__ unsigned xb_ld(unsigned* p)              { return __hip_atomic_load(p, __ATOMIC_RELAXED, __HIP_MEMORY_SCOPE_AGENT); }
__device__ __forceinline__ unsigned xb_add(unsigned* p, unsigned v) { return __hip_atomic_fetch_add(p, v, __ATOMIC_RELAXED, __HIP_MEMORY_SCOPE_AGENT); }
__device__ __forceinline__ unsigned xb_xcc_id() { return (unsigned)__builtin_amdgcn_s_getreg((3 << 11) | 20) & 0xFu; }
#define XB_SPIN(cond, bar) do { unsigned _sp = 0; while (cond) { __builtin_amdgcn_s_sleep(1); \
    if ((++_sp & 255u) == 0u) { if (xb_ld(&(bar)[XB_TMO])) break; if (_sp > XB_SPIN_CAP) { atomicAdd(&(bar)[XB_TMO], 1u); break; } } } } while (0)
struct XcdBarrier { unsigned* bar; unsigned x; volatile LAS unsigned* st; };
__device__ __forceinline__ XcdBarrier xcd_barrier_post(unsigned* bar, volatile LAS unsigned* st) {
    XcdBarrier b; b.bar = bar; b.x = xb_xcc_id(); b.st = st;
    if (threadIdx.x == 0) (void)xb_add(&bar[XB_XCNT(b.x)], 1u);
    return b;
}
__device__ __forceinline__ void xcd_barrier_complete(unsigned* bar, unsigned x, unsigned& nloc, unsigned& nx) {
    const unsigned G = gridDim.x * gridDim.y * gridDim.z;
    unsigned sum, cnt, mine, sp = 0u;
    for (;;) {
        sum = 0u; cnt = 0u; mine = 0u;
#pragma unroll
        for (unsigned j = 0; j < 16; ++j) { const unsigned c = xb_ld(&bar[XB_XCNT(j)]); sum += c; cnt += (c > 0u) ? 1u : 0u; mine = (j == x) ? c : mine; }
        if (sum == G) break;
        __builtin_amdgcn_s_sleep(1);
        if ((++sp & 255u) == 0u) { if (xb_ld(&bar[XB_TMO])) break; if (sp > XB_SPIN_CAP) { atomicAdd(&bar[XB_TMO], 1u); break; } }
    }
    nloc = mine > 0u ? mine : 1u; nx = cnt > 0u ? cnt : 1u;
}
__device__ __forceinline__ void xcd_barrier(const XcdBarrier& b) {
    asm volatile("s_waitcnt vmcnt(0)" ::: "memory");
    __syncthreads();
    if (threadIdx.x == 0) {
        unsigned* bar = b.bar;
        __builtin_amdgcn_s_waitcnt(0);
        unsigned nloc = b.st[0], nx = b.st[1];
        if (nloc == 0u) { xcd_barrier_complete(bar, b.x, nloc, nx); b.st[0] = nloc; b.st[1] = nx; }
        const unsigned old = xb_add(&bar[XB_XSUB(b.x)], 1u);
        const unsigned gen = old / nloc;
        if (old + 1u == (gen + 1u) * nloc) {
            __builtin_amdgcn_fence(__ATOMIC_RELEASE, "agent");
            asm volatile("s_waitcnt vmcnt(0)" ::: "memory");
            const unsigned og = xb_add(&bar[XB_TOP], 1u);
            const unsigned tg = og / nx;
            if (og + 1u == (tg + 1u) * nx) xb_add(&bar[XB_TOPGEN], 1u);
            else XB_SPIN(xb_ld(&bar[XB_TOPGEN]) == tg, bar);
            __builtin_amdgcn_fence(__ATOMIC_ACQUIRE, "agent");
            xb_add(&bar[XB_XGEN(b.x)], 1u);
            asm volatile("s_waitcnt vmcnt(0)" ::: "memory");
        } else {
            XB_SPIN(xb_ld(&bar[XB_XGEN(b.x)]) == gen, bar);
            __builtin_amdgcn_fence(__ATOMIC_ACQUIRE, "agent");
            asm volatile("s_waitcnt vmcnt(0)" ::: "memory");
        }
    }
    __syncthreads();
}

namespace pg8 {
constexpr int BM = 256, BK = 64, HALF = 128, HTB = HALF * BK * 2, STAGE_BYTES = 8 * HTB, NXCD = 8, WGM = 8;
__host__ __device__ __forceinline__ int lds_byte(int r, int c) { const int st = (r >> 4) * 2 + (c >> 5), rr = r & 15, cc = c & 31, ob = rr * 64 + cc * 2; return st * 1024 + (ob ^ (((ob >> 9) & 1) << 5)); }
__host__ __device__ __forceinline__ void stage_rc(int b, int& R, int& C) { const int st = b / 1024, sb = b % 1024, swz = sb ^ (((sb >> 9) & 1) << 5); R = (st >> 1) * 16 + swz / 64; C = (st & 1) * 32 + (swz % 64) / 2; }
__host__ __device__ __forceinline__ int perm32(int rho) { const int n = rho >> 4, i = rho & 15; return 8 * (i >> 2) + 4 * n + (i & 3); }
__device__ __forceinline__ unsigned cvt_pk_bf16(float lo, float hi) { unsigned r; asm volatile("v_cvt_pk_bf16_f32 %0, %1, %2" : "=v"(r) : "v"(lo), "v"(hi)); return r; }

struct Unit { int pm, pn, e, mt; };

struct DenseSched {
    const char* Bt; int K, nM, nN, nwg, G, c, row0;
    __device__ __forceinline__ void init(const bf16* Bt_, int K_, int M, int N, int G_, int c_, int row0_) { Bt = (const char*)Bt_; K = K_; nM = M / BM; nN = N / BM; nwg = nM * nN; G = G_; c = c_; row0 = row0_; }
    __device__ __forceinline__ bool next(int i, Unit& u) const {
        const long L = (long)i * G + c; if (L >= nwg) return false;
        int wgid = (int)L; { const int q = nwg / NXCD, r = nwg % NXCD, xcd = wgid % NXCD, off = wgid / NXCD; wgid = (xcd < r ? xcd * (q + 1) : r * (q + 1) + (xcd - r) * q) + off; }
        const int nig = WGM * nN, gid = wgid / nig, fm = gid * WGM, gsz = (nM - fm) < WGM ? (nM - fm) : WGM;
        u.pm = fm + ((wgid % nig) % gsz); u.pn = (wgid % nig) / gsz; u.e = 0; u.mt = 0; return true;
    }
    __device__ __forceinline__ const char* b_ptr(const Unit& u) const { return Bt + (size_t)u.pn * (size_t)(BM * 2) * K; }
    __device__ __forceinline__ void a_offsets(const Unit& u, const int (&R)[2], const int (&C)[2], unsigned (&v)[2][2]) const {
#pragma unroll
        for (int h = 0; h < 2; ++h)
#pragma unroll
            for (int i = 0; i < 2; ++i) v[h][i] = (unsigned)((row0 + u.pm * BM + h * HALF + R[i]) * K + C[i]) * 2u;
    }
};
template <bool GATHER, int NT>
struct MoeSched {
    const char* Bt; size_t bstride;
    int rb;
    const int* list;
    const LAS int* pre; const LAS int* mtl; const LAS int* rowoff; const LAS int* cnt;
    int K, G, c, total;
    __device__ __forceinline__ bool next(int i, Unit& u) const {
        const int L = i * G + c; if (L >= total) return false;
        int e = 0;
#pragma unroll 1
        for (int j = 1; j < NEXP; ++j) e = (L >= pre[j]) ? j : e;
        const int rem = L - pre[e];
        u.e = e; u.pn = rem % NT; u.mt = rem / NT; u.pm = 0; return true;
    }
    __device__ __forceinline__ const char* b_ptr(const Unit& u) const { return Bt + (size_t)u.e * bstride + (size_t)u.pn * (size_t)BM * rb; }
    __device__ __forceinline__ const char* a_ptr(const Unit& u, const char* Abase) const { return Abase + (size_t)(rowoff[u.e] + u.mt * BM) * rb; }
    __device__ __forceinline__ void a_offsets(const Unit& u, const int (&R)[2], const int (&C)[2], unsigned (&v)[2][2]) const {
        if (GATHER) {
            const int n = cnt[u.e]; const int* lp = list + (size_t)u.e * NTOK;
#pragma unroll
            for (int h = 0; h < 2; ++h)
#pragma unroll
                for (int i = 0; i < 2; ++i) { const int idx = u.mt * BM + h * HALF + R[i]; const int tok = idx < n ? lp[idx] : 0; v[h][i] = (unsigned)(tok * rb + 2 * C[i]); }
        } else {
            const int r0 = rowoff[u.e] + u.mt * BM;
#pragma unroll
            for (int h = 0; h < 2; ++h)
#pragma unroll
                for (int i = 0; i < 2; ++i) v[h][i] = (unsigned)((r0 + h * HALF + R[i]) * K + C[i]) * 2u;
        }
    }
};

struct EpiBf16 {
    static constexpr bool PERM = true;
    bf16* O; int ldc; int row0;
    __device__ __forceinline__ void operator()(const f32x4 (&acc)[2][2][4][2], const Unit& u, int wr, int wc, int fr, int fq) const {
        const int r0 = row0 + u.pm * BM + wr * 64 + fr, col0 = u.pn * BM + wc * 32 + 8 * fq;
#pragma unroll
        for (int ai = 0; ai < 2; ++ai)
#pragma unroll
            for (int m = 0; m < 4; ++m) { bf16* rowp = O + (size_t)(r0 + ai * HALF + m * 16) * ldc + col0;
#pragma unroll
                for (int bj = 0; bj < 2; ++bj) { const f32x4 v0 = acc[ai][bj][m][0], v1 = acc[ai][bj][m][1];
                    u32x4 w; w.x = cvt_pk_bf16(v0[0], v0[1]); w.y = cvt_pk_bf16(v0[2], v0[3]); w.z = cvt_pk_bf16(v1[0], v1[1]); w.w = cvt_pk_bf16(v1[2], v1[3]);
                    *(u32x4*)(rowp + bj * HALF) = w; } }
    }
};
struct EpiF32 {
    static constexpr bool PERM = false;
    float* Cc; int ldc; int row0;
    __device__ __forceinline__ void operator()(const f32x4 (&acc)[2][2][4][2], const Unit& u, int wr, int wc, int fr, int fq) const {
        const int r0 = row0 + u.pm * BM + wr * 64 + fr, col0 = u.pn * BM + wc * 32 + 4 * fq;
#pragma unroll
        for (int ai = 0; ai < 2; ++ai)
#pragma unroll
            for (int m = 0; m < 4; ++m) { float* rowp = Cc + (size_t)(r0 + ai * HALF + m * 16) * ldc + col0;
#pragma unroll
                for (int bj = 0; bj < 2; ++bj)
#pragma unroll
                    for (int n = 0; n < 2; ++n) *(f32x4*)(rowp + bj * HALF + n * 16) = acc[ai][bj][m][n]; }
    }
};
struct EpiSwiglu {
    static constexpr bool PERM = true;
    bf16* H; const float* bg; const float* bu; const LAS int* rowoff; float ws;
    __device__ __forceinline__ void operator()(const f32x4 (&acc)[2][2][4][2], const Unit& u, int wr, int wc, int fr, int fq) const {
        const int r0 = rowoff[u.e] + u.mt * BM + wr * 64 + fr, j0 = u.pn * HALF + wc * 32 + 8 * fq;
        f32x4 gb[2], ub[2];
#pragma unroll
        for (int n = 0; n < 2; ++n) { gb[n] = *(const f32x4*)(bg + u.e * 1024 + j0 + 4 * n); ub[n] = *(const f32x4*)(bu + u.e * 1024 + j0 + 4 * n); }
#pragma unroll
        for (int ai = 0; ai < 2; ++ai)
#pragma unroll
            for (int m = 0; m < 4; ++m) { unsigned char* rowp = (unsigned char*)H + (size_t)(r0 + ai * HALF + m * 16) * 1024 + j0; float hv[8];
#pragma unroll
                for (int n = 0; n < 2; ++n)
#pragma unroll
                    for (int j = 0; j < 4; ++j) { float g = acc[ai][0][m][n][j] * ws + gb[n][j], up = acc[ai][1][m][n][j] * ws + ub[n][j];
                        g = fminf(g, 7.f); up = fminf(fmaxf(up, -7.f), 7.f);
                        hv[n * 4 + j] = (up + 1.f) * g * __builtin_amdgcn_rcpf(1.f + __expf(-1.702f * g)); }
                *(u32x2*)rowp = (u32x2){pk4_fp8(4.f * hv[0], 4.f * hv[1], 4.f * hv[2], 4.f * hv[3]), pk4_fp8(4.f * hv[4], 4.f * hv[5], 4.f * hv[6], 4.f * hv[7])}; }
    }
};
struct EpiDown {
    static constexpr bool PERM = true;
    bf16* Y; const float* bd; const LAS int* rowoff; float ws;
    __device__ __forceinline__ void operator()(const f32x4 (&acc)[2][2][4][2], const Unit& u, int wr, int wc, int fr, int fq) const {
        const int r0 = rowoff[u.e] + u.mt * BM + wr * 64 + fr, col0 = u.pn * BM + wc * 32 + 8 * fq;
        f32x4 bv[2][2];
#pragma unroll
        for (int bj = 0; bj < 2; ++bj)
#pragma unroll
            for (int n = 0; n < 2; ++n) bv[bj][n] = *(const f32x4*)(bd + u.e * 1024 + col0 + bj * HALF + 4 * n);
#pragma unroll
        for (int ai = 0; ai < 2; ++ai)
#pragma unroll
            for (int m = 0; m < 4; ++m) { bf16* rowp = Y + (size_t)(r0 + ai * HALF + m * 16) * 1024 + col0;
#pragma unroll
                for (int bj = 0; bj < 2; ++bj) { const f32x4 v0 = acc[ai][bj][m][0] * ws + bv[bj][0], v1 = acc[ai][bj][m][1] * ws + bv[bj][1];
                    u32x4 w; w.x = cvt_pk_bf16(v0[0], v0[1]); w.y = cvt_pk_bf16(v0[2], v0[3]); w.z = cvt_pk_bf16(v1[0], v1[1]); w.w = cvt_pk_bf16(v1[2], v1[3]);
                    *(u32x4*)(rowp + bj * HALF) = w; } }
    }
};

template <class Epi, class Sched, bool ALIGN_EPI>
__device__ __forceinline__ void gemm_phase(LAS unsigned char* lds, const char* Abase, const int K, const Sched& S, const Epi& E) {
    const int tid = tidx(), wid = __builtin_amdgcn_readfirstlane(tid >> 6), lane = tid & 63, wr = wid >> 2, wc = wid & 3, fr = lane & 15, fq = lane >> 4;
    const int nt = K / BK;
    int Rp[2], Cp[2]; unsigned voffB0;
#pragma unroll
    for (int i = 0; i < 2; ++i) stage_rc(tid * 16 + i * 8192, Rp[i], Cp[i]);
    { const int Rb = Epi::PERM ? ((Rp[0] & ~31) + perm32(Rp[0] & 31)) : Rp[0]; voffB0 = (unsigned)(Rb * K + Cp[0]) * 2u; }
    const size_t kstep = (size_t)(BK * 2);
    const size_t hstep = (size_t)HALF * K * 2;
    const unsigned ldsw = (unsigned)wid * 1024u;
    const int aoff = lds_byte(wr * 64 + fr, fq * 8), boff = lds_byte(wc * 32 + fr, fq * 8);
#define PG8_SA(b, h) (((b) * 2 + (h)) * HTB)
#define PG8_SB(b, h) ((4 + (b) * 2 + (h)) * HTB)
#define PG8_STAGE(bufoff, gbase, voff) do { _Pragma("unroll") for (int _i = 0; _i < 2; ++_i) \
        __builtin_amdgcn_global_load_lds((const unsigned*)((const char*)(gbase) + (voff)[_i]), (LAS unsigned*)(lds + (bufoff) + ldsw + _i * 8192), 16, 0, 0); } while (0)
#define PG8_STAGEB(bufoff, gbase) do { _Pragma("unroll") for (int _i = 0; _i < 2; ++_i) \
        __builtin_amdgcn_global_load_lds((const unsigned*)((const char*)(gbase) + (size_t)_i * 128 * K + voffB0), (LAS unsigned*)(lds + (bufoff) + ldsw + _i * 8192), 16, 0, 0); } while (0)
#define PG8_LDA(dst, b, h) do { _Pragma("unroll") for (int m = 0; m < 4; ++m) _Pragma("unroll") for (int k = 0; k < 2; ++k) dst[m][k] = *(const LAS bf16x8*)(lds + PG8_SA(b, h) + aoff + m * 2048 + k * 1024); } while (0)
#define PG8_LDB(dst, b, h) do { _Pragma("unroll") for (int n = 0; n < 2; ++n) _Pragma("unroll") for (int k = 0; k < 2; ++k) dst[n][k] = *(const LAS bf16x8*)(lds + PG8_SB(b, h) + boff + n * 2048 + k * 1024); } while (0)
#define PG8_MMA(ai, bj, At, Bt) do { __builtin_amdgcn_s_setprio(1); _Pragma("unroll") for (int m = 0; m < 4; ++m) _Pragma("unroll") for (int n = 0; n < 2; ++n) _Pragma("unroll") for (int k = 0; k < 2; ++k) \
        acc[ai][bj][m][n] = __builtin_amdgcn_mfma_f32_16x16x32_bf16(Bt[n][k], At[m][k], acc[ai][bj][m][n], 0, 0, 0); __builtin_amdgcn_s_setprio(0); } while (0)
#define PG8_WAIT_V(n) asm volatile("s_waitcnt vmcnt(" #n ")" ::: "memory")
#define PG8_WAIT_L(n) asm volatile("s_waitcnt lgkmcnt(" #n ")" ::: "memory")
#define PG8_BAR __builtin_amdgcn_s_barrier()
#define PG8_SCHED __builtin_amdgcn_sched_barrier(0)
    Unit cur, nxt; int ui = 0;
    if (!S.next(0, cur)) return;
    f32x4 acc[2][2][4][2];
#pragma unroll
    for (int a = 0; a < 2; ++a)
#pragma unroll
        for (int b = 0; b < 2; ++b)
#pragma unroll
            for (int m = 0; m < 4; ++m)
#pragma unroll
                for (int n = 0; n < 2; ++n) acc[a][b][m][n] = (f32x4){0.f, 0.f, 0.f, 0.f};
    bf16x8 At[4][2], B0[2][2], B1[2][2];
    unsigned vAc[2][2], vAn[2][2];
    S.a_offsets(cur, Rp, Cp, vAc);
    const char* cB = S.b_ptr(cur);
    PG8_STAGEB(PG8_SB(0, 0), cB); PG8_STAGEB(PG8_SB(0, 1), cB + hstep); PG8_STAGE(PG8_SA(0, 0), Abase, vAc[0]); PG8_STAGE(PG8_SA(0, 1), Abase, vAc[1]);
    if (wr == 1) PG8_BAR;
    PG8_WAIT_V(2); PG8_BAR;
    PG8_STAGEB(PG8_SB(1, 0), cB + kstep); PG8_STAGE(PG8_SA(1, 0), Abase + kstep, vAc[0]); PG8_STAGEB(PG8_SB(1, 1), cB + hstep + kstep);
    PG8_WAIT_V(6); PG8_BAR;
    for (;;) {
        const bool has_next = S.next(ui + 1, nxt);
        const char* nB = has_next ? S.b_ptr(nxt) : cB;
        if (has_next) S.a_offsets(nxt, Rp, Cp, vAn);
        else {
#pragma unroll
            for (int h = 0; h < 2; ++h)
#pragma unroll
                for (int i = 0; i < 2; ++i) vAn[h][i] = vAc[h][i]; }
        for (int t = 0; t < nt; t += 2) {
            const bool last = (t == nt - 2);
            const char* a1 = Abase + (size_t)(t + 1) * kstep;
            const char* a2 = last ? Abase : Abase + (size_t)(t + 2) * kstep; const char* b2 = last ? nB : cB + (size_t)(t + 2) * kstep;
            const char* a3 = a2 + kstep; const char* b3 = b2 + kstep;
            unsigned v2[2][2];
#pragma unroll
            for (int h = 0; h < 2; ++h)
#pragma unroll
                for (int i = 0; i < 2; ++i) v2[h][i] = last ? vAn[h][i] : vAc[h][i];
            PG8_LDB(B0, 0, 0); PG8_LDB(B1, 0, 1); PG8_SCHED; PG8_LDA(At, 0, 0); PG8_STAGE(PG8_SA(1, 1), a1, vAc[1]);
            PG8_WAIT_V(8); PG8_WAIT_L(0); PG8_BAR; PG8_MMA(0, 0, At, B0); PG8_MMA(0, 1, At, B1); PG8_BAR; PG8_SCHED;
            PG8_LDA(At, 0, 1); PG8_STAGEB(PG8_SB(0, 0), b2); PG8_STAGEB(PG8_SB(0, 1), b2 + hstep); PG8_STAGE(PG8_SA(0, 0), a2, v2[0]);
            PG8_WAIT_V(8); PG8_WAIT_L(0); PG8_BAR; PG8_MMA(1, 0, At, B0); PG8_MMA(1, 1, At, B1); PG8_BAR; PG8_SCHED;
            PG8_LDB(B0, 1, 0); PG8_LDB(B1, 1, 1); PG8_SCHED; PG8_LDA(At, 1, 0); PG8_STAGE(PG8_SA(0, 1), a2, v2[1]);
            PG8_WAIT_V(8); PG8_WAIT_L(0); PG8_BAR; PG8_MMA(0, 0, At, B0); PG8_MMA(0, 1, At, B1); PG8_BAR; PG8_SCHED;
            PG8_LDA(At, 1, 1); PG8_STAGEB(PG8_SB(1, 0), b3); PG8_STAGEB(PG8_SB(1, 1), b3 + hstep); PG8_STAGE(PG8_SA(1, 0), a3, v2[0]);
            PG8_WAIT_V(8); PG8_WAIT_L(0); PG8_BAR; PG8_MMA(1, 0, At, B0); PG8_MMA(1, 1, At, B1); PG8_BAR; PG8_SCHED;
        }
        if constexpr (ALIGN_EPI) { if (wr == 0) PG8_BAR; }
        E(acc, cur, wr, wc, fr, fq);
        if (!has_next) break;
#pragma unroll
        for (int a = 0; a < 2; ++a)
#pragma unroll
            for (int b = 0; b < 2; ++b)
#pragma unroll
                for (int m = 0; m < 4; ++m)
#pragma unroll
                    for (int n = 0; n < 2; ++n) acc[a][b][m][n] = (f32x4){0.f, 0.f, 0.f, 0.f};
        cur = nxt; cB = nB; ++ui;
#pragma unroll
        for (int h = 0; h < 2; ++h)
#pragma unroll
            for (int i = 0; i < 2; ++i) vAc[h][i] = vAn[h][i];
        if constexpr (ALIGN_EPI) { if (wr == 1) PG8_BAR; }
    }
    PG8_WAIT_V(0);
    if constexpr (!ALIGN_EPI) { if (wr == 0) PG8_BAR; }
    PG8_BAR;
#undef PG8_SA
#undef PG8_SB
#undef PG8_STAGE
#undef PG8_STAGEB
#undef PG8_LDA
#undef PG8_LDB
#undef PG8_MMA
#undef PG8_WAIT_V
#undef PG8_WAIT_L
#undef PG8_BAR
#undef PG8_SCHED
}
template <class Epi, class Sched, bool ALIGN_EPI>
__device__ __forceinline__ void gemm_phase_f8g(LAS unsigned char* lds, const char* Abase, const int K, const Sched& S, const Epi& E) {
    const int tid = tidx(), wid = __builtin_amdgcn_readfirstlane(tid >> 6), lane = tid & 63, wr = wid >> 2, wc = wid & 3, fr = lane & 15, fq = lane >> 4;
    const int nt = K / 128;
    int Rp[2], Cp[2]; unsigned voffB0;
#pragma unroll
    for (int i = 0; i < 2; ++i) stage_rc(tid * 16 + i * 8192, Rp[i], Cp[i]);
    { const int Rb = Epi::PERM ? ((Rp[0] & ~31) + perm32(Rp[0] & 31)) : Rp[0]; voffB0 = (unsigned)(Rb * K + 2 * Cp[0]); }
    const size_t kstep = (size_t)(BK * 2);
    const size_t hstep = (size_t)HALF * K;
    const unsigned ldsw = (unsigned)wid * 1024u;
    const int aoff0 = lds_byte(wr * 64 + fr, 16 * (fq & 1)) + (fq >> 1) * 1024, boff0 = lds_byte(wc * 32 + fr, 16 * (fq & 1)) + (fq >> 1) * 1024;
#define PG8_SA(b, h) (((b) * 2 + (h)) * HTB)
#define PG8_SB(b, h) ((4 + (b) * 2 + (h)) * HTB)
#define PG8_STAGE(bufoff, gbase, voff) do { _Pragma("unroll") for (int _i = 0; _i < 2; ++_i) \
        __builtin_amdgcn_global_load_lds((const unsigned*)((const char*)(gbase) + (voff)[_i]), (LAS unsigned*)(lds + (bufoff) + ldsw + _i * 8192), 16, 0, 0); } while (0)
#define PG8_STAGEB(bufoff, gbase) do { _Pragma("unroll") for (int _i = 0; _i < 2; ++_i) \
        __builtin_amdgcn_global_load_lds((const unsigned*)((const char*)(gbase) + (size_t)_i * 64 * K + voffB0), (LAS unsigned*)(lds + (bufoff) + ldsw + _i * 8192), 16, 0, 0); } while (0)
#define PG8_LDA(dst, b, h) do { _Pragma("unroll") for (int m = 0; m < 4; ++m) { const u32x4 lo_ = *(const LAS u32x4*)(lds + PG8_SA(b, h) + aoff0 + m * 2048), hi_ = *(const LAS u32x4*)(lds + PG8_SA(b, h) + aoff0 + 16 + m * 2048); \
        dst[m] = (v8i){(int)lo_.x, (int)lo_.y, (int)lo_.z, (int)lo_.w, (int)hi_.x, (int)hi_.y, (int)hi_.z, (int)hi_.w}; } } while (0)
#define PG8_LDB(dst, b, h) do { _Pragma("unroll") for (int n = 0; n < 2; ++n) { const u32x4 lo_ = *(const LAS u32x4*)(lds + PG8_SB(b, h) + boff0 + n * 2048), hi_ = *(const LAS u32x4*)(lds + PG8_SB(b, h) + boff0 + 16 + n * 2048); \
        dst[n] = (v8i){(int)lo_.x, (int)lo_.y, (int)lo_.z, (int)lo_.w, (int)hi_.x, (int)hi_.y, (int)hi_.z, (int)hi_.w}; } } while (0)
#define PG8_MMA(ai, bj, At, Bt) do { __builtin_amdgcn_s_setprio(1); _Pragma("unroll") for (int m = 0; m < 4; ++m) _Pragma("unroll") for (int n = 0; n < 2; ++n) \
        asm volatile("v_mfma_scale_f32_16x16x128_f8f6f4 %0, %1, %2, %0, %3, %3 op_sel_hi:[0,0,0]" : "+v"(acc[ai][bj][m][n]) : "v"(Bt[n]), "v"(At[m]), "v"(f8scale)); __builtin_amdgcn_s_setprio(0); } while (0)
#define PG8_WAIT_V(n) asm volatile("s_waitcnt vmcnt(" #n ")" ::: "memory")
#define PG8_WAIT_L(n) asm volatile("s_waitcnt lgkmcnt(" #n ")" ::: "memory")
#define PG8_BAR __builtin_amdgcn_s_barrier()
#define PG8_SCHED __builtin_amdgcn_sched_barrier(0)
    Unit cur, nxt; int ui = 0;
    if (!S.next(0, cur)) return;
    f32x4 acc[2][2][4][2];
#pragma unroll
    for (int a = 0; a < 2; ++a)
#pragma unroll
        for (int b = 0; b < 2; ++b)
#pragma unroll
            for (int m = 0; m < 4; ++m)
#pragma unroll
                for (int n = 0; n < 2; ++n) acc[a][b][m][n] = (f32x4){0.f, 0.f, 0.f, 0.f};
    typedef int v8i __attribute__((ext_vector_type(8)));
    v8i At[4], B0[2], B1[2];
    const int f8scale = 0x7f7f7f7f;
    unsigned vAc[2][2], vAn[2][2];
    S.a_offsets(cur, Rp, Cp, vAc);
    const char* cB = S.b_ptr(cur);
    PG8_STAGEB(PG8_SB(0, 0), cB); PG8_STAGEB(PG8_SB(0, 1), cB + hstep); PG8_STAGE(PG8_SA(0, 0), Abase, vAc[0]); PG8_STAGE(PG8_SA(0, 1), Abase, vAc[1]);
    if (wr == 1) PG8_BAR;
    PG8_WAIT_V(2); PG8_BAR;
    PG8_STAGEB(PG8_SB(1, 0), cB + kstep); PG8_STAGE(PG8_SA(1, 0), Abase + kstep, vAc[0]); PG8_STAGEB(PG8_SB(1, 1), cB + hstep + kstep);
    PG8_WAIT_V(6); PG8_BAR;
    for (;;) {
        const bool has_next = S.next(ui + 1, nxt);
        const char* nB = has_next ? S.b_ptr(nxt) : cB;
        if (has_next) S.a_offsets(nxt, Rp, Cp, vAn);
        else {
#pragma unroll
            for (int h = 0; h < 2; ++h)
#pragma unroll
                for (int i = 0; i < 2; ++i) vAn[h][i] = vAc[h][i]; }
#pragma unroll 1
        for (int t = 0; t < nt; t += 2) {
            const bool last = (t == nt - 2);
            const char* a1 = Abase + (size_t)(t + 1) * kstep;
            const char* a2 = last ? Abase : Abase + (size_t)(t + 2) * kstep; const char* b2 = last ? nB : cB + (size_t)(t + 2) * kstep;
            const char* a3 = a2 + kstep; const char* b3 = b2 + kstep;
            unsigned v2[2][2];
#pragma unroll
            for (int h = 0; h < 2; ++h)
#pragma unroll
                for (int i = 0; i < 2; ++i) v2[h][i] = last ? vAn[h][i] : vAc[h][i];
            PG8_LDB(B0, 0, 0); PG8_LDB(B1, 0, 1); PG8_SCHED; PG8_LDA(At, 0, 0); PG8_STAGE(PG8_SA(1, 1), a1, vAc[1]);
            PG8_WAIT_V(8); PG8_WAIT_L(0); PG8_BAR; PG8_MMA(0, 0, At, B0); PG8_MMA(0, 1, At, B1); PG8_BAR; PG8_SCHED;
            PG8_LDA(At, 0, 1); PG8_STAGEB(PG8_SB(0, 0), b2); PG8_STAGEB(PG8_SB(0, 1), b2 + hstep); PG8_STAGE(PG8_SA(0, 0), a2, v2[0]);
            PG8_WAIT_V(8); PG8_WAIT_L(0); PG8_BAR; PG8_MMA(1, 0, At, B0); PG8_MMA(1, 1, At, B1); PG8_BAR; PG8_SCHED;
            PG8_LDB(B0, 1, 0); PG8_LDB(B1, 1, 1); PG8_SCHED; PG8_LDA(At, 1, 0); PG8_STAGE(PG8_SA(0, 1), a2, v2[1]);
            PG8_WAIT_V(8); PG8_WAIT_L(0); PG8_BAR; PG8_MMA(0, 0, At, B0); PG8_MMA(0, 1, At, B1); PG8_BAR; PG8_SCHED;
            PG8_LDA(At, 1, 1); PG8_STAGEB(PG8_SB(1, 0), b3); PG8_STAGEB(PG8_SB(1, 1), b3 + hstep); PG8_STAGE(PG8_SA(1, 0), a3, v2[0]);
            PG8_WAIT_V(8); PG8_WAIT_L(0); PG8_BAR; PG8_MMA(1, 0, At, B0); PG8_MMA(1, 1, At, B1); PG8_BAR; PG8_SCHED;
        }
        if constexpr (ALIGN_EPI) { if (wr == 0) PG8_BAR; }
        E(acc, cur, wr, wc, fr, fq);
        if (!has_next) break;
#pragma unroll
        for (int a = 0; a < 2; ++a)
#pragma unroll
            for (int b = 0; b < 2; ++b)
#pragma unroll
                for (int m = 0; m < 4; ++m)
#pragma unroll
                    for (int n = 0; n < 2; ++n) acc[a][b][m][n] = (f32x4){0.f, 0.f, 0.f, 0.f};
        cur = nxt; cB = nB; ++ui;
#pragma unroll
        for (int h = 0; h < 2; ++h)
#pragma unroll
            for (int i = 0; i < 2; ++i) vAc[h][i] = vAn[h][i];
        if constexpr (ALIGN_EPI) { if (wr == 1) PG8_BAR; }
    }
    PG8_WAIT_V(0);
    if constexpr (!ALIGN_EPI) { if (wr == 0) PG8_BAR; }
    PG8_BAR;
#undef PG8_SA
#undef PG8_SB
#undef PG8_STAGE
#undef PG8_STAGEB
#undef PG8_LDA
#undef PG8_LDB
#undef PG8_MMA
#undef PG8_WAIT_V
#undef PG8_WAIT_L
#undef PG8_BAR
#undef PG8_SCHED
}
template <class Epi, class Sched, bool ALIGN_EPI>
__device__ __forceinline__ void gemm_phase_f8(LAS unsigned char* lds, const char* Abase, const int K, const Sched& S, const Epi& E) {
    const int tid = tidx(), wid = __builtin_amdgcn_readfirstlane(tid >> 6), lane = tid & 63, wr = wid >> 2, wc = wid & 3, fr = lane & 15, fq = lane >> 4;
    const int nt = K / 128;
    int Rp[1], Cp[1]; unsigned voffB[1], voffA[1];
#pragma unroll
    for (int i = 0; i < 1; ++i) { stage_rc(tid * 16 + i * 8192, Rp[i], Cp[i]); const int Rb = Epi::PERM ? ((Rp[i] & ~31) + perm32(Rp[i] & 31)) : Rp[i]; voffB[i] = (unsigned)(Rb * K + 2 * Cp[i]); voffA[i] = (unsigned)(Rp[i] * K + 2 * Cp[i]); }
    const size_t kstep = (size_t)(BK * 2);
    const size_t hstep = (size_t)HALF * K;
    const unsigned ldsw = (unsigned)wid * 1024u;
    const int aoff0 = lds_byte(wr * 64 + fr, 16 * (fq & 1)) + (fq >> 1) * 1024, boff0 = lds_byte(wc * 32 + fr, 16 * (fq & 1)) + (fq >> 1) * 1024;
#define PG8_SA(b, h) (((b) * 2 + (h)) * HTB)
#define PG8_SB(b, h) ((4 + (b) * 2 + (h)) * HTB)
#define PG8_STAGE(bufoff, gbase, voff) do { _Pragma("unroll") for (int _i = 0; _i < 2; ++_i) \
        __builtin_amdgcn_global_load_lds((const unsigned*)((const char*)(gbase) + (size_t)_i * 64 * K + (voff)[0]), (LAS unsigned*)(lds + (bufoff) + ldsw + _i * 8192), 16, 0, 0); } while (0)
#define PG8_LDA(dst, b, h) do { _Pragma("unroll") for (int m = 0; m < 4; ++m) { const u32x4 lo_ = *(const LAS u32x4*)(lds + PG8_SA(b, h) + aoff0 + m * 2048), hi_ = *(const LAS u32x4*)(lds + PG8_SA(b, h) + aoff0 + 16 + m * 2048); \
        dst[m] = (v8i){(int)lo_.x, (int)lo_.y, (int)lo_.z, (int)lo_.w, (int)hi_.x, (int)hi_.y, (int)hi_.z, (int)hi_.w}; } } while (0)
#define PG8_LDB(dst, b, h) do { _Pragma("unroll") for (int n = 0; n < 2; ++n) { const u32x4 lo_ = *(const LAS u32x4*)(lds + PG8_SB(b, h) + boff0 + n * 2048), hi_ = *(const LAS u32x4*)(lds + PG8_SB(b, h) + boff0 + 16 + n * 2048); \
        dst[n] = (v8i){(int)lo_.x, (int)lo_.y, (int)lo_.z, (int)lo_.w, (int)hi_.x, (int)hi_.y, (int)hi_.z, (int)hi_.w}; } } while (0)
#define PG8_MMA(ai, bj, At, Bt) do { __builtin_amdgcn_s_setprio(1); _Pragma("unroll") for (int m = 0; m < 4; ++m) _Pragma("unroll") for (int n = 0; n < 2; ++n) \
        asm volatile("v_mfma_scale_f32_16x16x128_f8f6f4 %0, %1, %2, %0, %3, %3 op_sel_hi:[0,0,0]" : "+v"(acc[ai][bj][m][n]) : "v"(Bt[n]), "v"(At[m]), "v"(f8scale)); __builtin_amdgcn_s_setprio(0); } while (0)
#define PG8_WAIT_V(n) asm volatile("s_waitcnt vmcnt(" #n ")" ::: "memory")
#define PG8_WAIT_L(n) asm volatile("s_waitcnt lgkmcnt(" #n ")" ::: "memory")
#define PG8_BAR __builtin_amdgcn_s_barrier()
#define PG8_SCHED __builtin_amdgcn_sched_barrier(0)
    Unit cur, nxt; int ui = 0;
    if (!S.next(0, cur)) return;
    f32x4 acc[2][2][4][2];
#pragma unroll
    for (int a = 0; a < 2; ++a)
#pragma unroll
        for (int b = 0; b < 2; ++b)
#pragma unroll
            for (int m = 0; m < 4; ++m)
#pragma unroll
                for (int n = 0; n < 2; ++n) acc[a][b][m][n] = (f32x4){0.f, 0.f, 0.f, 0.f};
    typedef int v8i __attribute__((ext_vector_type(8)));
    v8i At[4], B0[2], B1[2];
    const int f8scale = 0x7f7f7f7f;
    const char* cA = S.a_ptr(cur, Abase);
    const char* cB = S.b_ptr(cur);
    PG8_STAGE(PG8_SB(0, 0), cB, voffB); PG8_STAGE(PG8_SB(0, 1), cB + hstep, voffB); PG8_STAGE(PG8_SA(0, 0), cA, voffA); PG8_STAGE(PG8_SA(0, 1), cA + hstep, voffA);
    if (wr == 1) PG8_BAR;
    PG8_WAIT_V(2); PG8_BAR;
    PG8_STAGE(PG8_SB(1, 0), cB + kstep, voffB); PG8_STAGE(PG8_SA(1, 0), cA + kstep, voffA); PG8_STAGE(PG8_SB(1, 1), cB + hstep + kstep, voffB);
    PG8_WAIT_V(6); PG8_BAR;
    for (;;) {
        const bool has_next = S.next(ui + 1, nxt);
        const char* nB = has_next ? S.b_ptr(nxt) : cB; const char* nA = has_next ? S.a_ptr(nxt, Abase) : cA;
#pragma unroll 1
        for (int t = 0; t < nt; t += 2) {
            const bool last = (t == nt - 2);
            const char* a1 = cA + (size_t)(t + 1) * kstep;
            const char* a2 = last ? nA : cA + (size_t)(t + 2) * kstep; const char* b2 = last ? nB : cB + (size_t)(t + 2) * kstep;
            const char* a3 = a2 + kstep; const char* b3 = b2 + kstep;
            PG8_LDB(B0, 0, 0); PG8_LDB(B1, 0, 1); PG8_SCHED; PG8_LDA(At, 0, 0); PG8_STAGE(PG8_SA(1, 1), a1 + hstep, voffA);
            PG8_WAIT_V(8); PG8_WAIT_L(0); PG8_BAR; PG8_MMA(0, 0, At, B0); PG8_MMA(0, 1, At, B1); PG8_BAR; PG8_SCHED;
            PG8_LDA(At, 0, 1); PG8_STAGE(PG8_SB(0, 0), b2, voffB); PG8_STAGE(PG8_SB(0, 1), b2 + hstep, voffB); PG8_STAGE(PG8_SA(0, 0), a2, voffA);
            PG8_WAIT_V(8); PG8_WAIT_L(0); PG8_BAR; PG8_MMA(1, 0, At, B0); PG8_MMA(1, 1, At, B1); PG8_BAR; PG8_SCHED;
            PG8_LDB(B0, 1, 0); PG8_LDB(B1, 1, 1); PG8_SCHED; PG8_LDA(At, 1, 0); PG8_STAGE(PG8_SA(0, 1), a2 + hstep, voffA);
            PG8_WAIT_V(8); PG8_WAIT_L(0); PG8_BAR; PG8_MMA(0, 0, At, B0); PG8_MMA(0, 1, At, B1); PG8_BAR; PG8_SCHED;
            PG8_LDA(At, 1, 1); PG8_STAGE(PG8_SB(1, 0), b3, voffB); PG8_STAGE(PG8_SB(1, 1), b3 + hstep, voffB); PG8_STAGE(PG8_SA(1, 0), a3, voffA);
            PG8_WAIT_V(8); PG8_WAIT_L(0); PG8_BAR; PG8_MMA(1, 0, At, B0); PG8_MMA(1, 1, At, B1); PG8_BAR; PG8_SCHED;
        }
        if constexpr (ALIGN_EPI) { if (wr == 0) PG8_BAR; }
        E(acc, cur, wr, wc, fr, fq);
        if (!has_next) break;
#pragma unroll
        for (int a = 0; a < 2; ++a)
#pragma unroll
            for (int b = 0; b < 2; ++b)
#pragma unroll
                for (int m = 0; m < 4; ++m)
#pragma unroll
                    for (int n = 0; n < 2; ++n) acc[a][b][m][n] = (f32x4){0.f, 0.f, 0.f, 0.f};
        cur = nxt; cB = nB; cA = nA; ++ui;
        if constexpr (ALIGN_EPI) { if (wr == 1) PG8_BAR; }
    }
    PG8_WAIT_V(0);
    if constexpr (!ALIGN_EPI) { if (wr == 0) PG8_BAR; }
    PG8_BAR;
#undef PG8_SA
#undef PG8_SB
#undef PG8_STAGE
#undef PG8_LDA
#undef PG8_LDB
#undef PG8_MMA
#undef PG8_WAIT_V
#undef PG8_WAIT_L
#undef PG8_BAR
#undef PG8_SCHED
}
}

struct Args { const float* in[39]; float* out; unsigned char* ws; int ph_lo, ph_hi; };
typedef const __attribute__((address_space(4))) Args CArgs;
enum { I_X = 0, I_C, I_CTX, I_CCTX, I_WADA, I_BADA, I_WIN, I_HYCW, I_HYCB, I_HYW1, I_HYB1, I_HYW2, I_HYB2, I_HYW3, I_HYB3, I_HYW4, I_HYFREQ, I_HYD, I_SCCW,
       I_GLAWA, I_GLABA, I_GLANW, I_GDNCW, I_GDNALOG, I_GDNDT, I_GDNNW, I_WOUT, I_LN1G, I_LN1B, I_WR, I_BR, I_WG, I_BG, I_WU, I_BU, I_WD, I_BD, I_LN2G, I_LN2B };

__device__ __forceinline__ int row_batch(int row) { return row < NTOK_C ? (row >> 8) : ((row - NTOK_C) >> 11); }
__device__ __forceinline__ int mod_vec(int row) { return row < NTOK_C ? 16 : ((row - NTOK_C) >> 11); }

__device__ __forceinline__ void ph_mod(CArgs& a, LAS unsigned char* lds, int bid, int nblk) {
    LAS float* sc = (LAS float*)lds; LAS float* red = (LAS float*)(lds + 17 * 1024 * 4);
    const int tid = tidx(), lane = tid & 63, w = tid >> 6;
    const float* c = a.in[I_C]; const float* cc = a.in[I_CCTX];
    for (int i = tid; i < 17 * 1024; i += 512) { const float v = i < 16 * 1024 ? c[i] : cc[i - 16 * 1024]; sc[i] = siluf_(v); }
    __syncthreads();
    float* MOD = (float*)(a.ws + WS_MOD);
    for (int it = bid; it < DEPTH * 96; it += nblk) {
        const int l = it / 96, j0 = (it % 96) * 64;
        const float* W = a.in[I_WADA] + (size_t)l * 1024 * 6144 + j0 + lane;
        float acc[17];
#pragma unroll
        for (int v = 0; v < 17; ++v) acc[v] = 0.f;
#pragma unroll 16
        for (int kk = 0; kk < 128; ++kk) { const int k = w * 128 + kk; const float wv = W[(size_t)k * 6144];
#pragma unroll
            for (int v = 0; v < 17; ++v) acc[v] += sc[v * 1024 + k] * wv; }
#pragma unroll
        for (int v = 0; v < 17; ++v) red[(w * 17 + v) * 64 + lane] = acc[v];
        __syncthreads();
        for (int o = tid; o < 17 * 64; o += 512) { const int v = o >> 6, jj = o & 63; float s = 0.f;
#pragma unroll
            for (int ww = 0; ww < 8; ++ww) s += red[(ww * 17 + v) * 64 + jj];
            MOD[(size_t)(l * 17 + v) * 6144 + j0 + jj] = s + a.in[I_BADA][l * 6144 + j0 + jj]; }
        __syncthreads();
    }
}

__device__ __forceinline__ void ph_filters(CArgs& a, int gw, int ngw) {
    const int lane = tidx() & 63;
    float* KUN = (float*)(a.ws + WS_KUN);
#pragma unroll 1
    for (int it = gw; it < DEPTH * (CTXL + SEQ) / 4; it += ngw) {
        const int l = it / ((CTXL + SEQ) / 4), r = (it % ((CTXL + SEQ) / 4)) * 4, Lt = r < CTXL ? 0 : 1, pos0 = Lt ? r - CTXL : r, L = Lt ? SEQ : CTXL;
        float z[4], tn[4];
#pragma unroll
        for (int p = 0; p < 4; ++p) { const int pos = pos0 + p; tn[p] = (float)pos / (float)(L - 1); z[p] = 0.f;
            if (lane == 0) z[p] = tn[p];
            else if (lane <= 32) { const int j = (lane - 1) & 15; const float fj = 1e-4f + (float)j * ((15.f - 1e-4f) / 15.f);
                double rev = (double)fj * (double)pos / (double)L; rev -= floor(rev); const float rf = (float)rev;
                z[p] = lane <= 16 ? sin_rev(rf + 0.25f) : -sin_rev(rf); } }
        const float* w1 = a.in[I_HYW1] + l * 33 * 64; const float* w2 = a.in[I_HYW2] + l * 64 * 64; const float* w3 = a.in[I_HYW3] + l * 64 * 64; const float* w4 = a.in[I_HYW4] + l * 64 * 512;
        const float* fq = a.in[I_HYFREQ] + l * 3 * 64;
        float s[4], h[4];
        { const float bb = a.in[I_HYB1][l * 64 + lane];
#pragma unroll
          for (int p = 0; p < 4; ++p) s[p] = bb; }
#pragma unroll
        for (int i = 0; i < 33; ++i) { const float ww = w1[i * 64 + lane];
#pragma unroll
            for (int p = 0; p < 4; ++p) s[p] += rdlane_f(z[p], i) * ww; }
#pragma unroll
        for (int p = 0; p < 4; ++p) h[p] = sin_rad(fq[lane] * s[p]);
        { const float bb = a.in[I_HYB2][l * 64 + lane];
#pragma unroll
          for (int p = 0; p < 4; ++p) s[p] = bb; }
#pragma unroll 16
        for (int i = 0; i < 64; ++i) { const float ww = w2[i * 64 + lane];
#pragma unroll
            for (int p = 0; p < 4; ++p) s[p] += rdlane_f(h[p], i) * ww; }
#pragma unroll
        for (int p = 0; p < 4; ++p) h[p] = sin_rad(fq[64 + lane] * s[p]);
        { const float bb = a.in[I_HYB3][l * 64 + lane];
#pragma unroll
          for (int p = 0; p < 4; ++p) s[p] = bb; }
#pragma unroll 16
        for (int i = 0; i < 64; ++i) { const float ww = w3[i * 64 + lane];
#pragma unroll
            for (int p = 0; p < 4; ++p) s[p] += rdlane_f(h[p], i) * ww; }
#pragma unroll
        for (int p = 0; p < 4; ++p) h[p] = sin_rad(fq[128 + lane] * s[p]);
        float k[8][4];
#pragma unroll
        for (int m = 0; m < 8; ++m)
#pragma unroll
            for (int p = 0; p < 4; ++p) k[m][p] = 0.f;
#pragma unroll 4
        for (int i = 0; i < 64; ++i) { float hi[4];
#pragma unroll
            for (int p = 0; p < 4; ++p) hi[p] = rdlane_f(h[p], i);
#pragma unroll
            for (int m = 0; m < 8; ++m) { const float ww = w4[i * 512 + m * 64 + lane];
#pragma unroll
                for (int p = 0; p < 4; ++p) k[m][p] += hi[p] * ww; } }
#pragma unroll
        for (int m = 0; m < 8; ++m) { const int o = m * 64 + lane, ch = o & 255;
            const float delta = 3.0701134573253944f + (float)ch * ((15.350567286626972f - 3.0701134573253944f) / 255.f);
            *(f32x4*)(KUN + ((size_t)((l * 2 + Lt) * 512 + o)) * 2048 + pos0) = (f32x4){k[m][0] * __expf(-tn[0] * delta), k[m][1] * __expf(-tn[1] * delta), k[m][2] * __expf(-tn[2] * delta), k[m][3] * __expf(-tn[3] * delta)}; }
    }
}

__device__ __forceinline__ void ph_router_w(CArgs& a, int gt, int ngt) {
    bf16* hi = (bf16*)(a.ws + WS_WRT); bf16* lo = hi + DEPTH * NEXP * D;
    for (int i = gt; i < DEPTH * NEXP * D; i += ngt) { const int l = i / (NEXP * D), r = i % (NEXP * D), e = r / D, k = r % D;
        const float w = a.in[I_WR][((size_t)l * D + k) * NEXP + e]; const unsigned h = f2bf(w); hi[i] = (bf16)h; lo[i] = (bf16)f2bf(w - bf2f(h)); }
}
__device__ __forceinline__ void tr_item(const float* W, int Nsrc, int K, bf16* WTrow0, int n0, int k0, LAS float* scr, int lane) {
    const int c4 = (lane & 7) * 4; const bool ok = n0 + c4 < Nsrc;
    f32x4 t[8];
#pragma unroll
    for (int j = 0; j < 8; ++j) { const int kk = 8 * j + (lane >> 3); t[j] = ok ? *(const f32x4*)(W + (size_t)(k0 + kk) * Nsrc + n0 + c4) : (f32x4){0.f, 0.f, 0.f, 0.f}; }
#pragma unroll
    for (int j = 0; j < 8; ++j) { const int kk = 8 * j + (lane >> 3); LAS float* d = scr + kk * 33 + c4; d[0] = t[j][0]; d[1] = t[j][1]; d[2] = t[j][2]; d[3] = t[j][3]; }
    asm volatile("s_waitcnt lgkmcnt(0)" ::: "memory");
    const int c = lane & 7;
#pragma unroll
    for (int j = 0; j < 4; ++j) { const int n = (lane >> 3) + 8 * j; const LAS float* s = scr + (8 * c) * 33 + n;
        u32x4 o; o.x = pk2(s[0 * 33], s[1 * 33]); o.y = pk2(s[2 * 33], s[3 * 33]); o.z = pk2(s[4 * 33], s[5 * 33]); o.w = pk2(s[6 * 33], s[7 * 33]);
        *(u32x4*)(WTrow0 + (size_t)n * K + k0 + 8 * c) = o; }
    asm volatile("s_waitcnt lgkmcnt(0)" ::: "memory");
}
__device__ __forceinline__ void tr_item_f8(const float* W, int Nsrc, int K, unsigned char* WTrow0, int n0, int k0, float scale, LAS float* scr, int lane) {
    const int c4 = (lane & 7) * 4;
    f32x4 t[8];
#pragma unroll
    for (int j = 0; j < 8; ++j) { const int kk = 8 * j + (lane >> 3); t[j] = *(const f32x4*)(W + (size_t)(k0 + kk) * Nsrc + n0 + c4); }
#pragma unroll
    for (int j = 0; j < 8; ++j) { const int kk = 8 * j + (lane >> 3); LAS float* d = scr + kk * 33 + c4; d[0] = t[j][0]; d[1] = t[j][1]; d[2] = t[j][2]; d[3] = t[j][3]; }
    asm volatile("s_waitcnt lgkmcnt(0)" ::: "memory");
    const int n = lane >> 1, half = lane & 1; const LAS float* s = scr + (32 * half) * 33 + n;
    unsigned o[8];
#pragma unroll
    for (int i = 0; i < 8; ++i) o[i] = pk4_fp8(s[(4 * i) * 33] * scale, s[(4 * i + 1) * 33] * scale, s[(4 * i + 2) * 33] * scale, s[(4 * i + 3) * 33] * scale);
    unsigned char* dst = WTrow0 + (size_t)n * K + k0 + 32 * half;
    *(u32x4*)dst = (u32x4){o[0], o[1], o[2], o[3]}; *(u32x4*)(dst + 16) = (u32x4){o[4], o[5], o[6], o[7]};
    asm volatile("s_waitcnt lgkmcnt(0)" ::: "memory");
}
__device__ __forceinline__ void ph_tr_small(CArgs& a, LAS unsigned char* lds, int gw, int ngw) {
    const int lane = tidx() & 63, w = tidx() >> 6;
    LAS float* scr = (LAS float*)(lds + w * 8448);
    constexpr int I_IN = 16 * (D_INP / 32), I_OUT = 16 * 32;
    for (int it = gw; it < DEPTH * (I_IN + I_OUT); it += ngw) {
        const int l = it / (I_IN + I_OUT); int r = it % (I_IN + I_OUT);
        if (r < I_IN) { const int kb = r / (D_INP / 32), nb = r % (D_INP / 32);
            tr_item(a.in[I_WIN] + (size_t)l * 1024 * D_IN, D_IN, 1024, (bf16*)(a.ws + WS_WIN) + ((size_t)l * D_INP + nb * 32) * 1024, nb * 32, kb * 64, scr, lane); }
        else { r -= I_IN; const int kb = r / 32, nb = r % 32;
            tr_item(a.in[I_WOUT] + (size_t)l * 1024 * 1024, 1024, 1024, (bf16*)(a.ws + WS_WOUT) + ((size_t)l * 1024 + nb * 32) * 1024, nb * 32, kb * 64, scr, lane); }
    }
}
__device__ __forceinline__ void tr_experts_waves(CArgs& a, int l, LAS unsigned char* scrb, int gw, int ngw, int lane) {
    LAS float* scr = (LAS float*)scrb;
#pragma unroll 1
    for (int it = gw; it < NEXP * 3 * 512; it += ngw) {
        const int e = it / 1536, r = it % 1536, which = r / 512, q = r % 512, kb = q / 32, nb = q % 32, n0 = nb * 32;
        const float* W = a.in[which == 0 ? I_WG : (which == 1 ? I_WU : I_WD)] + ((size_t)(l * NEXP + e)) * 1024 * 1024;
        if (which == 2) tr_item_f8(W, 1024, 1024, a.ws + WS_WD + ((size_t)e * 1024 + n0) * 1024, n0, kb * 64, 32.f, scr, lane);
        else tr_item_f8(W, 1024, 1024, a.ws + WS_WGU + ((size_t)e * 2048 + (n0 >> 7) * 256 + which * 128 + (n0 & 127)) * 1024, n0, kb * 64, 32.f, scr, lane);
    }
}
__device__ __forceinline__ void ph_mod_input(CArgs& a, int gw, int ngw) {
    const int lane = tidx() & 63;
    const float* MOD = (const float*)(a.ws + WS_MOD);
    bf16* HB = (bf16*)(a.ws + WS_HB);
    for (int row = gw; row < NTOK; row += ngw) {
        const float* src = row < NTOK_C ? a.in[I_CTX] + (size_t)row * D : a.in[I_X] + (size_t)(row - NTOK_C) * D;
        const float* mv = MOD + (size_t)mod_vec(row) * 6144;
#pragma unroll
        for (int j = 0; j < 4; ++j) { const int c0 = j * 256 + lane * 4; const f32x4 x = *(const f32x4*)(src + c0), sh = *(const f32x4*)(mv + c0), sc = *(const f32x4*)(mv + 1024 + c0);
            u32x2 o; o.x = pk2(x[0] * (1.f + sc[0]) + sh[0], x[1] * (1.f + sc[1]) + sh[1]); o.y = pk2(x[2] * (1.f + sc[2]) + sh[2], x[3] * (1.f + sc[3]) + sh[3]);
            *(u32x2*)(HB + (size_t)row * D + c0) = o; }
    }
}

struct Chunk { int b, t0, L, row0, lo, hi; };
__device__ __forceinline__ Chunk chunk_of(int it) {
    Chunk c;
    if (it < 64) { c.b = it >> 2; c.t0 = (it & 3) * 64; c.L = CTXL; c.row0 = c.b * CTXL + c.t0; c.lo = 0; c.hi = CTXL; }
    else { const int r = it - 64; c.b = r >> 5; c.t0 = (r & 31) * 64; c.L = SEQ; c.row0 = NTOK_C + c.b * SEQ + c.t0; c.lo = c.t0; c.hi = c.t0 + 64; }
    return c;
}
__device__ __forceinline__ f32x4 bf4(u32x2 v) { return (f32x4){lo_bf(v.x), hi_bf(v.x), lo_bf(v.y), hi_bf(v.y)}; }
__device__ __forceinline__ void ph_prep_conv(CArgs& a, int l, LAS unsigned char* lds, int bid, int nblk) {
    const bf16* P = (const bf16*)(a.ws + WS_P);
    bf16* ZT = (bf16*)(a.ws + WS_MIX + MX_ZT); bf16* YMIX = (bf16*)(a.ws + WS_YMIX);
    LAS bf16* zt = (LAS bf16*)lds;
    const int tid = tidx(), c4 = (tid & 63) * 4, tg = tid >> 6;
    const float* hw = a.in[I_HYCW] + l * 3 * 768; const float* hb = a.in[I_HYCB] + l * 768; const float* sw = a.in[I_SCCW] + l * 3 * 256;
    f32x4 wx[3], wv[3], ws3[3];
#pragma unroll
    for (int k = 0; k < 3; ++k) { wx[k] = *(const f32x4*)(hw + k * 768 + 256 + c4); wv[k] = *(const f32x4*)(hw + k * 768 + 512 + c4); ws3[k] = *(const f32x4*)(sw + k * 256 + c4); }
    const f32x4 bx = *(const f32x4*)(hb + 256 + c4), bv = *(const f32x4*)(hb + 512 + c4);
#pragma unroll 1
    for (int it = bid; it < 576; it += nblk) {
        const Chunk c = chunk_of(it);
        const int tb = c.t0 + tg * 8;
        const bf16* pb = P + (size_t)(c.row0 + tg * 8) * D_INP;
        f32x4 x1[10], vv[10], mm[10];
#pragma unroll
        for (int r = 0; r < 10; ++r) { const int t = tb + r - 1; const bool ok = t >= c.lo && t < c.hi; const bf16* p = pb + (ptrdiff_t)(r - 1) * D_INP;
            x1[r] = ok ? bf4(*(const u32x2*)(p + HY0 + 256 + c4)) : (f32x4){0.f, 0.f, 0.f, 0.f}; vv[r] = ok ? bf4(*(const u32x2*)(p + HY0 + 512 + c4)) : (f32x4){0.f, 0.f, 0.f, 0.f};
            mm[r] = ok ? bf4(*(const u32x2*)(p + SC0 + 256 + c4)) * bf4(*(const u32x2*)(p + SC0 + 512 + c4)) : (f32x4){0.f, 0.f, 0.f, 0.f}; }
#pragma unroll
        for (int tt = 0; tt < 8; ++tt) {
            const f32x4 xx = wx[0] * x1[tt] + wx[1] * x1[tt + 1] + wx[2] * x1[tt + 2] + bx, v2 = wv[0] * vv[tt] + wv[1] * vv[tt + 1] + wv[2] * vv[tt + 2] + bv, z = xx * v2;
            u32x2 zo; zo.x = pk2(z[0], z[1]); zo.y = pk2(z[2], z[3]); *(LAS u32x2*)(zt + (tg * 8 + tt) * 264 + c4) = zo;
            const f32x4 bg = bf4(*(const u32x2*)(pb + (size_t)tt * D_INP + SC0 + c4));
            const f32x4 y = bg * (ws3[0] * mm[tt] + ws3[1] * mm[tt + 1] + ws3[2] * mm[tt + 2]);
            u32x2 yo; yo.x = pk2(y[0], y[1]); yo.y = pk2(y[2], y[3]); *(u32x2*)(YMIX + (size_t)(c.row0 + tg * 8 + tt) * D + 256 + c4) = yo;
        }
        __syncthreads();
        { const int ch = tid & 255, g0 = (tid >> 8) * 4;
          const int soff = c.L == CTXL ? 0 : CTXL;
#pragma unroll
          for (int g = 0; g < 4; ++g) { const int t8 = (g0 + g) * 8; unsigned short e[8];
#pragma unroll
              for (int j = 0; j < 8; ++j) e[j] = zt[(t8 + j) * 264 + ch];
              u32x4 o; o.x = e[0] | ((unsigned)e[1] << 16); o.y = e[2] | ((unsigned)e[3] << 16); o.z = e[4] | ((unsigned)e[5] << 16); o.w = e[6] | ((unsigned)e[7] << 16);
              *(u32x4*)(ZT + ((size_t)(ch * 16 + c.b)) * 2304 + soff + c.t0 + t8) = o; } }
        __syncthreads();
    }
}
__device__ __forceinline__ void ph_prep_tok(CArgs& a, int l, int gw, int ngw) {
    const int lane = tidx() & 63;
    const bf16* P = (const bf16*)(a.ws + WS_P);
    float* GDF = (float*)(a.ws + WS_MIX + MX_GDF); float* GDB = (float*)(a.ws + WS_MIX + MX_GDB);
    float* DQ = (float*)(a.ws + WS_MIX + MX_DQ); float* DK = (float*)(a.ws + WS_MIX + MX_DK); float* DV = (float*)(a.ws + WS_MIX + MX_DV); float* DG = (float*)(a.ws + WS_MIX + MX_DG);
    const float* wa = a.in[I_GLAWA] + l * 2 * 16 * 128; const float* ba = a.in[I_GLABA] + l * 2 * 128;
    const float* cw = a.in[I_GDNCW] + l * 3 * 768;
#pragma unroll 1
    for (int row0 = gw * 4; row0 < NTOK; row0 += ngw * 4) {
        { int z = 0; asm volatile("" : "+v"(z)); wa += z; cw += z; }
        const bf16* pr0 = P + (size_t)row0 * D_INP;
        float av[4], s[4][4];
#pragma unroll
        for (int r = 0; r < 4; ++r) { av[r] = lane < 32 ? bf2f(pr0[(size_t)r * D_INP + GLA0 + 768 + lane]) : 0.f; s[r][0] = ba[lane]; s[r][1] = ba[64 + lane]; s[r][2] = ba[128 + lane]; s[r][3] = ba[192 + lane]; }
#pragma unroll
        for (int i = 0; i < 16; ++i) { const float w0 = wa[i * 128 + lane], w1 = wa[i * 128 + 64 + lane], w2 = wa[2048 + i * 128 + lane], w3 = wa[2048 + i * 128 + 64 + lane];
#pragma unroll
            for (int r = 0; r < 4; ++r) { const float af = rdlane_f(av[r], i), ab = rdlane_f(av[r], 16 + i); s[r][0] += af * w0; s[r][1] += af * w1; s[r][2] += ab * w2; s[r][3] += ab * w3; } }
#pragma unroll
        for (int r = 0; r < 4; ++r) { const size_t o = (size_t)(row0 + r) * 128;
            GDF[o + lane] = __expf(logsigmoidf_(s[r][0]) * 0.0625f); GDF[o + 64 + lane] = __expf(logsigmoidf_(s[r][1]) * 0.0625f);
            GDB[o + lane] = __expf(logsigmoidf_(s[r][2]) * 0.0625f); GDB[o + 64 + lane] = __expf(logsigmoidf_(s[r][3]) * 0.0625f); }
        int tpos, lo, hi;
        if (row0 < NTOK_C) { tpos = row0 & 255; lo = 0; hi = CTXL; } else { tpos = (row0 - NTOK_C) & 2047; lo = tpos & ~63; hi = lo + 64; }
        float sq[4] = {0.f, 0.f, 0.f, 0.f}, sk[4] = {0.f, 0.f, 0.f, 0.f}; f32x4 qv[4], kv[4];
#pragma unroll
        for (int g = 0; g < 3; ++g) { const int col = g * 256 + 4 * lane; const bf16* p = pr0 + GDN0 + col;
            f32x4 x[6];
#pragma unroll
            for (int r = 0; r < 6; ++r) { const int t = tpos + r - 1; x[r] = (t >= lo && t < hi) ? bf4(*(const u32x2*)(p + (ptrdiff_t)(r - 1) * D_INP)) : (f32x4){0.f, 0.f, 0.f, 0.f}; }
            const f32x4 w0 = *(const f32x4*)(cw + col), w1 = *(const f32x4*)(cw + 768 + col), w2 = *(const f32x4*)(cw + 1536 + col);
#pragma unroll
            for (int r = 0; r < 4; ++r) { f32x4 y = w0 * x[r] + w1 * x[r + 1] + w2 * x[r + 2];
                y[0] = siluf_(y[0]); y[1] = siluf_(y[1]); y[2] = siluf_(y[2]); y[3] = siluf_(y[3]);
                if (g == 0) { qv[r] = y; sq[r] = (y[0] * y[0] + y[1] * y[1]) + (y[2] * y[2] + y[3] * y[3]); }
                else if (g == 1) { kv[r] = y; sk[r] = (y[0] * y[0] + y[1] * y[1]) + (y[2] * y[2] + y[3] * y[3]); }
                else *(f32x4*)(DV + (size_t)(row0 + r) * 256 + 4 * lane) = y; } }
#pragma unroll
        for (int r = 0; r < 4; ++r) { const float rq = rsqrtf(row16_sum(sq[r]) + 1e-6f) * 0.125f, rk = rsqrtf(row16_sum(sk[r]) + 1e-6f);
            *(f32x4*)(DQ + (size_t)(row0 + r) * 256 + 4 * lane) = qv[r] * rq; *(f32x4*)(DK + (size_t)(row0 + r) * 256 + 4 * lane) = kv[r] * rk; }
        if (lane < 16) { const int h = lane & 3, r = lane >> 2; const bf16* pr = pr0 + (size_t)r * D_INP;
            const float af = bf2f(pr[GDN0 + 1024 + h]), ab = bf2f(pr[GDN0 + 1028 + h]), bfv = bf2f(pr[GDN0 + 1032 + h]), bbv = bf2f(pr[GDN0 + 1036 + h]);
            const float* al = a.in[I_GDNALOG] + l * 8; const float* dt = a.in[I_GDNDT] + l * 8;
            const float gf = -__expf(al[h]) * softplusf_(af + dt[h]), gb = -__expf(al[4 + h]) * softplusf_(ab + dt[4 + h]);
            *(f32x4*)(DG + (size_t)(row0 + r) * 16 + 4 * h) = (f32x4){sigmoidf_(bfv), __expf(gf), sigmoidf_(bbv), __expf(gb)}; }
    }
}

__device__ __forceinline__ int scan_row(int b, int dir, int n) {
    if (n < CTXL) return b * CTXL + (dir ? CTXL - 1 - n : n);
    const int m = n - CTXL; return NTOK_C + b * SEQ + (dir ? SEQ - 1 - m : m);
}
__device__ __forceinline__ void gla_chain(CArgs& a, int chain, LAS unsigned char* lds) {
    const int b = chain >> 3, h = (chain >> 1) & 3, dir = chain & 1;
    const int tid = tidx(), lane = tid & 63, w = tid >> 6, vv = lane & 7, kq = lane >> 3;
    const bf16* P = (const bf16*)(a.ws + WS_P);
    const float* GD = (const float*)(a.ws + WS_MIX + (dir ? MX_GDB : MX_GDF));
    float* GO = (float*)(a.ws + WS_MIX + (dir ? MX_GOB : MX_GOF));
    LAS float* sq = (LAS float*)lds;
    LAS float* sk = sq + 64 * 32;
    LAS float* sd = sk + 64 * 32;
    LAS float* sv = sd + 64 * 32;
    float S[4] = {0.f, 0.f, 0.f, 0.f};
    for (int ch = 0; ch < 36; ++ch) {
        { const int tt = tid >> 3, sub = tid & 7, row = scan_row(b, dir, ch * 64 + tt);
          const bf16* pr = P + (size_t)row * D_INP + GLA0;
          const u32x2 qv = *(const u32x2*)(pr + h * 32 + sub * 4), kv = *(const u32x2*)(pr + 128 + h * 32 + sub * 4);
          const f32x4 dv = *(const f32x4*)(GD + (size_t)row * 128 + h * 32 + sub * 4);
          const u32x4 vv8 = *(const u32x4*)(pr + 256 + h * 64 + sub * 8);
          const float qs = 0.17677669529663687f;
          *(LAS f32x4*)(sq + tt * 32 + sub * 4) = (f32x4){lo_bf(qv.x) * qs, hi_bf(qv.x) * qs, lo_bf(qv.y) * qs, hi_bf(qv.y) * qs};
          *(LAS f32x4*)(sk + tt * 32 + sub * 4) = (f32x4){lo_bf(kv.x), hi_bf(kv.x), lo_bf(kv.y), hi_bf(kv.y)};
          *(LAS f32x4*)(sd + tt * 32 + sub * 4) = dv;
          *(LAS f32x4*)(sv + tt * 64 + sub * 8) = (f32x4){lo_bf(vv8.x), hi_bf(vv8.x), lo_bf(vv8.y), hi_bf(vv8.y)};
          *(LAS f32x4*)(sv + tt * 64 + sub * 8 + 4) = (f32x4){lo_bf(vv8.z), hi_bf(vv8.z), lo_bf(vv8.w), hi_bf(vv8.w)}; }
        __syncthreads();
#pragma unroll 4
        for (int tt = 0; tt < 64; ++tt) {
            const f32x4 q4 = *(const LAS f32x4*)(sq + tt * 32 + kq * 4), k4 = *(const LAS f32x4*)(sk + tt * 32 + kq * 4), d4 = *(const LAS f32x4*)(sd + tt * 32 + kq * 4);
            const float v = sv[tt * 64 + w * 8 + vv];
            float o = 0.f;
#pragma unroll
            for (int j = 0; j < 4; ++j) { S[j] = d4[j] * S[j] + k4[j] * v; o += q4[j] * S[j]; }
            o += __shfl_xor(o, 8); o += __shfl_xor(o, 16); o += __shfl_xor(o, 32);
            if (kq == 0) GO[(size_t)scan_row(b, dir, ch * 64 + tt) * 256 + h * 64 + w * 8 + vv] = o;
        }
        __syncthreads();
    }
}
__device__ __forceinline__ void gdn_chain(CArgs& a, int chain, LAS unsigned char* lds) {
    const int b = chain >> 3, h = (chain >> 1) & 3, dir = chain & 1;
    const int tid = tidx(), lane = tid & 63, w = tid >> 6, vv = lane & 7, kq = lane >> 3;
    const float* DQ = (const float*)(a.ws + WS_MIX + MX_DQ); const float* DK = (const float*)(a.ws + WS_MIX + MX_DK); const float* DV = (const float*)(a.ws + WS_MIX + MX_DV);
    const float* DG = (const float*)(a.ws + WS_MIX + MX_DG);
    float* DO = (float*)(a.ws + WS_MIX + (dir ? MX_DOB : MX_DOF));
    LAS float* sq = (LAS float*)lds;
    LAS float* sk = sq + 64 * 64;
    LAS float* sv = sk + 64 * 64;
    LAS float* sg = sv + 64 * 64;
    float S[8];
#pragma unroll
    for (int j = 0; j < 8; ++j) S[j] = 0.f;
    for (int ch = 0; ch < 36; ++ch) {
        { const int tt = tid >> 3, sub = tid & 7, row = scan_row(b, dir, ch * 64 + tt);
          const size_t o = (size_t)row * 256 + h * 64 + sub * 8;
          *(LAS f32x4*)(sq + tt * 64 + sub * 8) = *(const f32x4*)(DQ + o); *(LAS f32x4*)(sq + tt * 64 + sub * 8 + 4) = *(const f32x4*)(DQ + o + 4);
          *(LAS f32x4*)(sk + tt * 64 + sub * 8) = *(const f32x4*)(DK + o); *(LAS f32x4*)(sk + tt * 64 + sub * 8 + 4) = *(const f32x4*)(DK + o + 4);
          *(LAS f32x4*)(sv + tt * 64 + sub * 8) = *(const f32x4*)(DV + o); *(LAS f32x4*)(sv + tt * 64 + sub * 8 + 4) = *(const f32x4*)(DV + o + 4);
          if (sub == 0) { const f32x4 g4 = *(const f32x4*)(DG + (size_t)row * 16 + h * 4); *(LAS f32x2*)(sg + tt * 2) = dir ? (f32x2){g4[2], g4[3]} : (f32x2){g4[0], g4[1]}; } }
        __syncthreads();
#pragma unroll 2
        for (int tt = 0; tt < 64; ++tt) {
            const f32x4 ka = *(const LAS f32x4*)(sk + tt * 64 + kq * 8), kb = *(const LAS f32x4*)(sk + tt * 64 + kq * 8 + 4);
            const f32x4 qa = *(const LAS f32x4*)(sq + tt * 64 + kq * 8), qb = *(const LAS f32x4*)(sq + tt * 64 + kq * 8 + 4);
            const float v = sv[tt * 64 + w * 8 + vv]; const f32x2 g2 = *(const LAS f32x2*)(sg + tt * 2);
            const float beta = g2.x, eg = g2.y;
            float ks = (ka[0] * S[0] + ka[1] * S[1]) + (ka[2] * S[2] + ka[3] * S[3]) + ((kb[0] * S[4] + kb[1] * S[5]) + (kb[2] * S[6] + kb[3] * S[7]));
            ks += __shfl_xor(ks, 8); ks += __shfl_xor(ks, 16); ks += __shfl_xor(ks, 32);
            const float wv = beta * (v - eg * ks);
            float o = 0.f;
#pragma unroll
            for (int j = 0; j < 4; ++j) { S[j] = eg * S[j] + ka[j] * wv; o += qa[j] * S[j]; }
#pragma unroll
            for (int j = 0; j < 4; ++j) { S[4 + j] = eg * S[4 + j] + kb[j] * wv; o += qb[j] * S[4 + j]; }
            o += __shfl_xor(o, 8); o += __shfl_xor(o, 16); o += __shfl_xor(o, 32);
            if (kq == 0) DO[(size_t)scan_row(b, dir, ch * 64 + tt) * 256 + h * 64 + w * 8 + vv] = o;
        }
        __syncthreads();
    }
}
__device__ __forceinline__ float gdn_cprod(float eg, int lane) {
    float c = fmaxf(eg, 2.0611536e-9f);
    float t = dpp_f<0x90>(c); c *= (lane & 3) >= 1 ? t : 1.f;
    t = dpp_f<0x44>(c); c *= (lane & 3) >= 2 ? t : 1.f;
    return c;
}
__device__ __forceinline__ float oct_sum(float v) { v += dpp_f<0xB1>(v); v += dpp_f<0x4E>(v); v += dpp_f<0x141>(v); return v; }
__device__ __forceinline__ void gdn_wave(CArgs& a, int chain, int vbase, LAS unsigned char* wl, int lane) {
    const int b = chain >> 3, h = (chain >> 1) & 3, dir = chain & 1, vl = lane >> 3, kq = lane & 7;
    const float* DQ = (const float*)(a.ws + WS_MIX + MX_DQ); const float* DK = (const float*)(a.ws + WS_MIX + MX_DK); const float* DV = (const float*)(a.ws + WS_MIX + MX_DV);
    const float* DG = (const float*)(a.ws + WS_MIX + MX_DG);
    float* DO = (float*)(a.ws + WS_MIX + (dir ? MX_DOB : MX_DOF));
    f32x2 S2[4];
#pragma unroll
    for (int i = 0; i < 4; ++i) S2[i] = (f32x2){0.f, 0.f};
    f32x4 pk[4], pq[4], pv; f32x2 pg;
    const int step = dir ? -1 : 1;
#define GDN_FETCH(ci) do { const int r0_ = scan_row(b, dir, (ci) * 16); \
        _Pragma("unroll") for (int j = 0; j < 4; ++j) { const size_t o_ = (size_t)(r0_ + step * (4 * j + (lane >> 4))) * 256 + h * 64 + (lane & 15) * 4; pk[j] = *(const f32x4*)(DK + o_); pq[j] = *(const f32x4*)(DQ + o_); } \
        pv = *(const f32x4*)(DV + (size_t)(r0_ + step * ((lane & 31) >> 1)) * 256 + h * 64 + vbase + (lane & 1) * 4); \
        pg = *(const f32x2*)(DG + (size_t)(r0_ + step * (lane & 15)) * 16 + h * 4 + dir * 2); } while (0)
#define GDN_PUT(bufp) do { _Pragma("unroll") for (int j = 0; j < 4; ++j) { *(LAS f32x4*)((bufp) + j * 1024 + lane * 16) = pk[j]; *(LAS f32x4*)((bufp) + 4096 + j * 1024 + lane * 16) = pq[j]; } \
        if (lane < 32) *(LAS f32x4*)((bufp) + 8192 + lane * 16) = pv; } while (0)
    GDN_FETCH(0);
    float gA, gB, gC;
    { const float c = gdn_cprod(pg.y, lane); gA = pg.x / c; gB = pg.x; gC = c; }
    GDN_PUT(wl);
#pragma unroll 1
    for (int ci = 0; ci < 144; ++ci) {
        const LAS unsigned char* buf = wl + (ci & 1) * 8704;
        const float cA = gA, cB = gB, cC = gC;
        if (ci + 1 < 144) GDN_FETCH(ci + 1);
        const int r0 = scan_row(b, dir, ci * 16);
        float okeep = 0.f;
#pragma unroll 1
        for (int tg = 0; tg < 4; ++tg) {
#pragma unroll
            for (int tu = 0; tu < 4; ++tu) {
                const int tt = tg * 4 + tu;
                const f32x4 k0 = *(const LAS f32x4*)(buf + (tt * 64 + kq * 8) * 4), k1 = *(const LAS f32x4*)(buf + (tt * 64 + kq * 8 + 4) * 4);
                const f32x4 q0 = *(const LAS f32x4*)(buf + 4096 + (tt * 64 + kq * 8) * 4), q1 = *(const LAS f32x4*)(buf + 4096 + (tt * 64 + kq * 8 + 4) * 4);
                const float vv = *(const LAS float*)(buf + 8192 + (tt * 8 + vl) * 4);
                const float tA = rdlane_f(cA, tt), tB = rdlane_f(cB, tt), tC = rdlane_f(cC, tt);
                f32x2 ka = (f32x2){k0[0], k0[1]} * S2[0], kb = (f32x2){k0[2], k0[3]} * S2[1];
                ka = __builtin_elementwise_fma((f32x2){k1[0], k1[1]}, S2[2], ka); kb = __builtin_elementwise_fma((f32x2){k1[2], k1[3]}, S2[3], kb);
                ka = ka + kb;
                const float ks = oct_sum(ka.x + ka.y);
                const float wh = tA * vv - tB * ks; const f32x2 wh2 = (f32x2){wh, wh};
                S2[0] = __builtin_elementwise_fma((f32x2){k0[0], k0[1]}, wh2, S2[0]); S2[1] = __builtin_elementwise_fma((f32x2){k0[2], k0[3]}, wh2, S2[1]);
                S2[2] = __builtin_elementwise_fma((f32x2){k1[0], k1[1]}, wh2, S2[2]); S2[3] = __builtin_elementwise_fma((f32x2){k1[2], k1[3]}, wh2, S2[3]);
                f32x2 oa = (f32x2){q0[0], q0[1]} * S2[0], ob = (f32x2){q0[2], q0[3]} * S2[1];
                oa = __builtin_elementwise_fma((f32x2){q1[0], q1[1]}, S2[2], oa); ob = __builtin_elementwise_fma((f32x2){q1[2], q1[3]}, S2[3], ob);
                oa = oa + ob;
                const float o = tC * oct_sum(oa.x + oa.y);
                okeep = ((tt & 7) == kq) ? o : okeep;
            }
            { const float cl = rdlane_f(cC, tg * 4 + 3);
#pragma unroll
              for (int i = 0; i < 4; ++i) S2[i] = S2[i] * cl; }
            if (tg & 1) DO[(size_t)(r0 + step * ((tg >> 1) * 8 + kq)) * 256 + h * 64 + vbase + vl] = okeep;
        }
        if (ci + 1 < 144) {
            const float c = gdn_cprod(pg.y, lane); gA = pg.x / c; gB = pg.x; gC = c;
            GDN_PUT(wl + ((ci + 1) & 1) * 8704);
        }
    }
#undef GDN_FETCH
#undef GDN_PUT
}
__device__ __forceinline__ void gla_wave(CArgs& a, int chain, int vbase, LAS unsigned char* wl, int lane) {
    const int b = chain >> 3, h = (chain >> 1) & 3, dir = chain & 1, vl = lane >> 2, kq = lane & 3;
    const bf16* P = (const bf16*)(a.ws + WS_P);
    const float* GD = (const float*)(a.ws + WS_MIX + (dir ? MX_GDB : MX_GDF));
    float* GO = (float*)(a.ws + WS_MIX + (dir ? MX_GOB : MX_GOF));
    f32x2 S2[4];
#pragma unroll
    for (int i = 0; i < 4; ++i) S2[i] = (f32x2){0.f, 0.f};
    u32x4 pq, pk; f32x4 pd[2]; u32x2 pv;
    const int step = dir ? -1 : 1;
#define GLA_FETCH(ci) do { const int r0_ = scan_row(b, dir, (ci) * 16); \
        const bf16* pr_ = P + (size_t)(r0_ + step * (lane >> 2)) * D_INP + GLA0; \
        pq = *(const u32x4*)(pr_ + h * 32 + (lane & 3) * 8); pk = *(const u32x4*)(pr_ + 128 + h * 32 + (lane & 3) * 8); pv = *(const u32x2*)(pr_ + 256 + h * 64 + vbase + (lane & 3) * 4); \
        _Pragma("unroll") for (int j = 0; j < 2; ++j) pd[j] = *(const f32x4*)(GD + (size_t)(r0_ + step * (8 * j + (lane >> 3))) * 128 + h * 32 + (lane & 7) * 4); } while (0)
#define GLA_PUT(bufp) do { const float qs_ = 0.17677669529663687f; \
        *(LAS f32x4*)((bufp) + lane * 32) = (f32x4){lo_bf(pq.x) * qs_, hi_bf(pq.x) * qs_, lo_bf(pq.y) * qs_, hi_bf(pq.y) * qs_}; *(LAS f32x4*)((bufp) + lane * 32 + 16) = (f32x4){lo_bf(pq.z) * qs_, hi_bf(pq.z) * qs_, lo_bf(pq.w) * qs_, hi_bf(pq.w) * qs_}; \
        *(LAS f32x4*)((bufp) + 2048 + lane * 32) = (f32x4){lo_bf(pk.x), hi_bf(pk.x), lo_bf(pk.y), hi_bf(pk.y)}; *(LAS f32x4*)((bufp) + 2048 + lane * 32 + 16) = (f32x4){lo_bf(pk.z), hi_bf(pk.z), lo_bf(pk.w), hi_bf(pk.w)}; \
        *(LAS f32x4*)((bufp) + 4096 + lane * 16) = pd[0]; *(LAS f32x4*)((bufp) + 4096 + 1024 + lane * 16) = pd[1]; \
        *(LAS f32x4*)((bufp) + 6144 + lane * 16) = (f32x4){lo_bf(pv.x), hi_bf(pv.x), lo_bf(pv.y), hi_bf(pv.y)}; } while (0)
#define GLA_LD(Q, K, Dd, V, p, pvv) do { _Pragma("unroll") for (int m = 0; m < 2; ++m) { Q[m] = *(const LAS f32x4*)((p) + 16 * m); K[m] = *(const LAS f32x4*)((p) + 2048 + 16 * m); Dd[m] = *(const LAS f32x4*)((p) + 4096 + 16 * m); } V = *(const LAS float*)(pvv); } while (0)
#define GLA_TOK(Q, K, Dd, V, tu) do { const f32x2 vv2 = (f32x2){V, V}; \
        S2[0] = __builtin_elementwise_fma((f32x2){K[0][0], K[0][1]}, vv2, (f32x2){Dd[0][0], Dd[0][1]} * S2[0]); S2[1] = __builtin_elementwise_fma((f32x2){K[0][2], K[0][3]}, vv2, (f32x2){Dd[0][2], Dd[0][3]} * S2[1]); \
        S2[2] = __builtin_elementwise_fma((f32x2){K[1][0], K[1][1]}, vv2, (f32x2){Dd[1][0], Dd[1][1]} * S2[2]); S2[3] = __builtin_elementwise_fma((f32x2){K[1][2], K[1][3]}, vv2, (f32x2){Dd[1][2], Dd[1][3]} * S2[3]); \
        f32x2 oa = (f32x2){Q[0][0], Q[0][1]} * S2[0], ob = (f32x2){Q[0][2], Q[0][3]} * S2[1]; \
        oa = __builtin_elementwise_fma((f32x2){Q[1][0], Q[1][1]}, S2[2], oa); ob = __builtin_elementwise_fma((f32x2){Q[1][2], Q[1][3]}, S2[3], ob); oa = oa + ob; \
        const float o = quad_sum(oa.x + oa.y); okeep = ((tu) == kq) ? o : okeep; } while (0)
    GLA_FETCH(0);
    GLA_PUT(wl);
    f32x4 QA[2], KA[2], DA[2], QB[2], KB[2], DB[2]; float VA, VB;
    GLA_LD(QA, KA, DA, VA, wl + kq * 32, wl + 6144 + vl * 4);
#pragma unroll 1
    for (int ci = 0; ci < 144; ++ci) {
        LAS unsigned char* buf = wl + (ci & 1) * 7168; LAS unsigned char* obuf = wl + ((ci + 1) & 1) * 7168;
        if (ci + 1 < 144) GLA_FETCH(ci + 1);
        const int r0 = scan_row(b, dir, ci * 16);
        float okeep = 0.f;
#pragma unroll 1
        for (int tg = 0; tg < 4; ++tg) {
            if (tg == 3 && ci + 1 < 144) GLA_PUT(obuf);
            LAS unsigned char* pt = buf + tg * 512 + kq * 32; LAS unsigned char* pvt = buf + 6144 + tg * 256 + vl * 4;
            LAS unsigned char* pn = (tg == 3) ? obuf + kq * 32 : pt + 512; LAS unsigned char* pvn = (tg == 3) ? obuf + 6144 + vl * 4 : pvt + 256;
            GLA_LD(QB, KB, DB, VB, pt + 128, pvt + 64);  __builtin_amdgcn_sched_barrier(0); GLA_TOK(QA, KA, DA, VA, 0); __builtin_amdgcn_sched_barrier(0);
            GLA_LD(QA, KA, DA, VA, pt + 256, pvt + 128); __builtin_amdgcn_sched_barrier(0); GLA_TOK(QB, KB, DB, VB, 1); __builtin_amdgcn_sched_barrier(0);
            GLA_LD(QB, KB, DB, VB, pt + 384, pvt + 192); __builtin_amdgcn_sched_barrier(0); GLA_TOK(QA, KA, DA, VA, 2); __builtin_amdgcn_sched_barrier(0);
            GLA_LD(QA, KA, DA, VA, pn, pvn);             __builtin_amdgcn_sched_barrier(0); GLA_TOK(QB, KB, DB, VB, 3); __builtin_amdgcn_sched_barrier(0);
            GO[(size_t)(r0 + step * (tg * 4 + kq)) * 256 + h * 64 + vbase + vl] = okeep;
        }
    }
#undef GLA_FETCH
#undef GLA_PUT
#undef GLA_LD
#undef GLA_TOK
}
template <int L>
__device__ __forceinline__ void hyena_unit(CArgs& a, int l, int c, LAS unsigned char* lds) {
    constexpr int Lt = L == SEQ ? 1 : 0, SOFF = L == SEQ ? CTXL : 0, CST = (2 * L + 16) * 2 + 32;
    constexpr int NTW = L / 16 / 8;
    const int tid = tidx(), lane = tid & 63, w = tid >> 6, fr = lane & 15, kg = lane >> 4;
    const float* kf = (const float*)(a.ws + WS_KUN) + ((size_t)((l * 2 + Lt) * 512 + c)) * 2048;
    const float* kb = kf + (size_t)256 * 2048;
    LAS float* red = (LAS float*)(lds + 8 * CST);
    float s = 0.f;
    for (int t = tid; t < L; t += 512) s += fabsf(kf[t]) + (t >= 1 ? fabsf(kb[t]) : 0.f);
    s = wave_sum(s);
    if (lane == 0) red[w] = s;
    __syncthreads();
    float l1 = 0.f;
#pragma unroll
    for (int i = 0; i < 8; ++i) l1 += red[i];
    const float inv = 1.f / l1;
    for (int idx = tid; idx < 2 * L + 16; idx += 512) {
        float gv = 0.f;
        if (idx >= 1 && idx <= L) gv = kf[L - idx] * inv; else if (idx > L && idx < 2 * L) gv = kb[idx - L] * inv;
        const bf16 gb = (bf16)f2bf(gv);
#pragma unroll
        for (int r = 0; r < 8; ++r) if (idx - r >= 0) *(LAS bf16*)(lds + r * CST + (idx - r) * 2) = gb;
    }
    __syncthreads();
    const bf16* Z = (const bf16*)(a.ws + WS_MIX + MX_ZT) + ((size_t)(c * 16 + fr)) * 2304 + SOFF;
    float* YT = (float*)(a.ws + WS_MIX + MX_YT) + ((size_t)(c * 16 + fr)) * 2304 + SOFF;
    f32x4 acc[NTW];
#pragma unroll
    for (int j = 0; j < NTW; ++j) acc[j] = (f32x4){0.f, 0.f, 0.f, 0.f};
    const int rr = (8 - (fr & 7)) & 7;
    for (int i = 0; i < L / 32; ++i) {
        const bf16x8 Bf = *(const bf16x8*)(Z + 32 * i + 8 * kg);
#pragma unroll
        for (int j = 0; j < NTW; ++j) {
            const int t0 = 16 * (w * NTW + j);
            const int o = 32 * i + 8 * kg - t0 - fr + L;
            const bf16x8 Af = *(const LAS bf16x8*)(lds + rr * CST + (o >> 3) * 16);
            acc[j] = __builtin_amdgcn_mfma_f32_16x16x32_bf16(Af, Bf, acc[j], 0, 0, 0);
        }
    }
#pragma unroll
    for (int j = 0; j < NTW; ++j) *(f32x4*)(YT + 16 * (w * NTW + j) + 4 * kg) = acc[j];
    __syncthreads();
}
__device__ __forceinline__ void ph_scan(CArgs& a, int l, LAS unsigned char* lds, int bid, int nblk, unsigned long long& tacc) {
    const int tid = tidx(), lane = tid & 63, w = __builtin_amdgcn_readfirstlane(tid >> 6);
    unsigned long long t0 = 0ull;
    if (PROBE_PH >= 20) t0 = __builtin_amdgcn_s_memrealtime();
    if (w < 6) {
        for (int it = bid; it < 256; it += nblk) {
            const int p = it >> 1, half = it & 1;
            if (w < 4) gdn_wave(a, p, 32 * half + 8 * w, lds + w * 17408, lane);
            else gla_wave(a, p, 32 * half + 16 * (w & 1), lds + 69632 + (w - 4) * 14336, lane);
        }
        if (PROBE_PH == 20 && w < 4) tacc += __builtin_amdgcn_s_memrealtime() - t0;
        if (PROBE_PH == 21 && w >= 4) tacc += __builtin_amdgcn_s_memrealtime() - t0;
    } else {
        tr_experts_waves(a, l, lds + 98304 + (w - 6) * 8448, bid * 2 + (w - 6), nblk * 2, lane);
        if (PROBE_PH == 22) tacc += __builtin_amdgcn_s_memrealtime() - t0;
    }
    __syncthreads();
    if (PROBE_PH == 23) t0 = __builtin_amdgcn_s_memrealtime();
    for (int it = bid; it < 512; it += nblk) {
        if (it < 256) hyena_unit<SEQ>(a, l, it, lds);
        else hyena_unit<CTXL>(a, l, it - 256, lds);
    }
    if (PROBE_PH == 23) tacc += __builtin_amdgcn_s_memrealtime() - t0;
}

__device__ __forceinline__ void ph_post_hyena(CArgs& a, int l, LAS unsigned char* lds, int bid, int nblk) {
    const bf16* P = (const bf16*)(a.ws + WS_P);
    const float* YT = (const float*)(a.ws + WS_MIX + MX_YT); bf16* YMIX = (bf16*)(a.ws + WS_YMIX);
    LAS float* yt = (LAS float*)lds;
    const int tid = tidx(), c4 = (tid & 63) * 4, tg = tid >> 6;
    const float* hw = a.in[I_HYCW] + l * 3 * 768; const float* hb = a.in[I_HYCB] + l * 768;
    f32x4 w0[3], wx[3], wv[3];
#pragma unroll
    for (int k = 0; k < 3; ++k) { w0[k] = *(const f32x4*)(hw + k * 768 + c4); wx[k] = *(const f32x4*)(hw + k * 768 + 256 + c4); wv[k] = *(const f32x4*)(hw + k * 768 + 512 + c4); }
    const f32x4 b0 = *(const f32x4*)(hb + c4), bx = *(const f32x4*)(hb + 256 + c4), bv = *(const f32x4*)(hb + 512 + c4), hd = *(const f32x4*)(a.in[I_HYD] + l * 256 + c4);
#pragma unroll 1
    for (int it = bid; it < 576; it += nblk) {
        const Chunk c = chunk_of(it);
        const int soff = c.L == CTXL ? 0 : CTXL;
        { const int ch = tid & 255, half = tid >> 8;
          const float* srcp = YT + ((size_t)(ch * 16 + c.b)) * 2304 + soff + c.t0 + half * 32;
#pragma unroll
          for (int j = 0; j < 8; ++j) { const f32x4 v = *(const f32x4*)(srcp + 4 * j);
              yt[(half * 32 + 4 * j) * 260 + ch] = v[0]; yt[(half * 32 + 4 * j + 1) * 260 + ch] = v[1]; yt[(half * 32 + 4 * j + 2) * 260 + ch] = v[2]; yt[(half * 32 + 4 * j + 3) * 260 + ch] = v[3]; } }
        __syncthreads();
        const int tb = c.t0 + tg * 8;
        const bf16* pb = P + (size_t)(c.row0 + tg * 8) * D_INP;
        f32x4 x0[10], x1[10], vv[10];
#pragma unroll
        for (int r = 0; r < 10; ++r) { const int t = tb + r - 1; const bool ok = t >= c.lo && t < c.hi; const bf16* p = pb + (ptrdiff_t)(r - 1) * D_INP;
            x0[r] = ok ? bf4(*(const u32x2*)(p + HY0 + c4)) : (f32x4){0.f, 0.f, 0.f, 0.f};
            x1[r] = ok ? bf4(*(const u32x2*)(p + HY0 + 256 + c4)) : (f32x4){0.f, 0.f, 0.f, 0.f}; vv[r] = ok ? bf4(*(const u32x2*)(p + HY0 + 512 + c4)) : (f32x4){0.f, 0.f, 0.f, 0.f}; }
#pragma unroll
        for (int tt = 0; tt < 8; ++tt) {
            const f32x4 u0 = w0[0] * x0[tt] + w0[1] * x0[tt + 1] + w0[2] * x0[tt + 2] + b0;
            const f32x4 xx = wx[0] * x1[tt] + wx[1] * x1[tt + 1] + wx[2] * x1[tt + 2] + bx, v2 = wv[0] * vv[tt] + wv[1] * vv[tt + 1] + wv[2] * vv[tt + 2] + bv, z = xx * v2;
            const f32x4 y = *(const LAS f32x4*)(yt + (tg * 8 + tt) * 260 + c4);
            const f32x4 o = (y + z * hd) * u0;
            u32x2 oo; oo.x = pk2(o[0], o[1]); oo.y = pk2(o[2], o[3]); *(u32x2*)(YMIX + (size_t)(c.row0 + tg * 8 + tt) * D + c4) = oo;
        }
        __syncthreads();
    }
}
__device__ __forceinline__ void ph_post_tok(CArgs& a, int l, int gw, int ngw) {
    const int lane = tidx() & 63;
    const bf16* P = (const bf16*)(a.ws + WS_P); bf16* YMIX = (bf16*)(a.ws + WS_YMIX);
    const float* GOF = (const float*)(a.ws + WS_MIX + MX_GOF); const float* GOB = (const float*)(a.ws + WS_MIX + MX_GOB);
    const float* DOF = (const float*)(a.ws + WS_MIX + MX_DOF); const float* DOB = (const float*)(a.ws + WS_MIX + MX_DOB);
    const f32x4 nwa = *(const f32x4*)(a.in[I_GLANW] + l * 64 + (4 * lane & 63)), nwd = *(const f32x4*)(a.in[I_GDNNW] + l * 64 + (4 * lane & 63));
    for (int row = gw; row < NTOK; row += ngw) {
        const size_t o4 = (size_t)row * 256 + 4 * lane;
        f32x4 og = *(const f32x4*)(GOF + o4) + *(const f32x4*)(GOB + o4), od = *(const f32x4*)(DOF + o4) + *(const f32x4*)(DOB + o4);
        float sg = og[0] * og[0] + og[1] * og[1] + og[2] * og[2] + og[3] * og[3], sd = od[0] * od[0] + od[1] * od[1] + od[2] * od[2] + od[3] * od[3];
        sg = row16_sum(sg); sd = row16_sum(sd);
        const float rg = rsqrtf(sg * (1.f / 64.f) + 1e-6f), rd = rsqrtf(sd * (1.f / 64.f) + 1e-6f);
        const u32x2 r2 = *(const u32x2*)(P + (size_t)row * D_INP + GLA0 + 512 + 4 * lane), z2 = *(const u32x2*)(P + (size_t)row * D_INP + GDN0 + 768 + 4 * lane);
        u32x2 w;
        w.x = pk2(og[0] * rg * nwa[0] * siluf_(lo_bf(r2.x)), og[1] * rg * nwa[1] * siluf_(hi_bf(r2.x))); w.y = pk2(og[2] * rg * nwa[2] * siluf_(lo_bf(r2.y)), og[3] * rg * nwa[3] * siluf_(hi_bf(r2.y)));
        *(u32x2*)(YMIX + (size_t)row * D + 512 + 4 * lane) = w;
        w.x = pk2(od[0] * rd * nwd[0] * siluf_(lo_bf(z2.x)), od[1] * rd * nwd[1] * siluf_(hi_bf(z2.x))); w.y = pk2(od[2] * rd * nwd[2] * siluf_(lo_bf(z2.y)), od[3] * rd * nwd[3] * siluf_(hi_bf(z2.y)));
        *(u32x2*)(YMIX + (size_t)row * D + 768 + 4 * lane) = w;
    }
}

__device__ __forceinline__ void ph_ln1_route(CArgs& a, int l, LAS unsigned char* lds, int bid, int nblk) {
    const int tid = tidx(), lane = tid & 63, w = __builtin_amdgcn_readfirstlane(tid >> 6);
    const float* MOD = (const float*)(a.ws + WS_MOD) + (size_t)l * 17 * 6144;
    float* X = (float*)(a.ws + WS_X); const float* TMP = (const float*)(a.ws + WS_TMP); bf16* HB = (bf16*)(a.ws + WS_HB);
    const float* lg = a.in[I_LN1G] + l * D; const float* lb = a.in[I_LN1B] + l * D;
    const float* br = a.in[I_BR] + l * NEXP;
    const bf16* wh = (const bf16*)(a.ws + WS_WRT) + (size_t)l * NEXP * D; const bf16* wl = wh + DEPTH * NEXP * D;
    unsigned* cnt = (unsigned*)(a.ws + WS_CTL) + CW_CNT + l * NEXP * 64;
    int* LIST = (int*)(a.ws + WS_LIST); int* TOPE = (int*)(a.ws + WS_TOPE); float* TOPW = (float*)(a.ws + WS_TOPW);
    LAS float* hrow = (LAS float*)lds;
    LAS float* part = (LAS float*)(lds + 65792);
    const int row_lo = (l == DEPTH - 1) ? NTOK_C : 0;
    const int e = lane & 31, par = lane >> 5, fr = lane & 15, kg = lane >> 4;
    f32x4 xv[2][4], tv[2][4];
#define LN1_FETCH(base_) do { _Pragma("unroll") for (int t = 0; t < 2; ++t) { const int row_ = (base_) + 2 * w + t; \
        const float* xs_ = (l == 0) ? (row_ < NTOK_C ? a.in[I_CTX] + (size_t)row_ * D : a.in[I_X] + (size_t)(row_ - NTOK_C) * D) : X + (size_t)row_ * D; \
        _Pragma("unroll") for (int j = 0; j < 4; ++j) { xv[t][j] = *(const f32x4*)(xs_ + j * 256 + 4 * lane); tv[t][j] = *(const f32x4*)(TMP + (size_t)row_ * D + j * 256 + 4 * lane); } } } while (0)
    int base = row_lo + bid * 16;
    if (base < NTOK) LN1_FETCH(base);
    int p_row = -1, p_ee = 0; unsigned p_pos = 0u; float p_ww = 0.f;
#pragma unroll 1
    for (; base < NTOK; base += nblk * 16) {
#pragma unroll
        for (int t = 0; t < 2; ++t) {
            const int row = base + 2 * w + t;
            const float* mv = MOD + (size_t)mod_vec(row) * 6144;
            f32x4 v[4]; float s = 0.f;
#pragma unroll
            for (int j = 0; j < 4; ++j) { const int c0 = j * 256 + 4 * lane; const f32x4 g1 = *(const f32x4*)(mv + 2048 + c0);
                v[j] = DN_ALPHA * xv[t][j] + g1 * tv[t][j]; s += (v[j][0] + v[j][1]) + (v[j][2] + v[j][3]); }
            const float mean = wave_sum(s) * (1.f / D); float s2 = 0.f;
#pragma unroll
            for (int j = 0; j < 4; ++j) { v[j] = v[j] - mean; s2 += (v[j][0] * v[j][0] + v[j][1] * v[j][1]) + (v[j][2] * v[j][2] + v[j][3] * v[j][3]); }
            const float rstd = rsqrtf(wave_sum(s2) * (1.f / D) + LN_EPS);
#pragma unroll
            for (int j = 0; j < 4; ++j) { const int c0 = j * 256 + 4 * lane; const f32x4 g = *(const f32x4*)(lg + c0), bb = *(const f32x4*)(lb + c0), sh = *(const f32x4*)(mv + 3072 + c0), sc = *(const f32x4*)(mv + 4096 + c0);
                const f32x4 xn = v[j] * rstd * g + bb; *(f32x4*)(X + (size_t)row * D + c0) = xn;
                const f32x4 hh = xn * (1.f + sc) + sh;
                *(unsigned*)(a.ws + WS_HB8 + (size_t)row * D + c0) = pk4_fp8(4.f * hh[0], 4.f * hh[1], 4.f * hh[2], 4.f * hh[3]);
                *(LAS f32x4*)(hrow + (2 * w + t) * 1028 + c0) = hh; }
        }
        __syncthreads();
        if (base + nblk * 16 < NTOK) LN1_FETCH(base + nblk * 16);
        {
            f32x4 acc[2] = {(f32x4){0.f, 0.f, 0.f, 0.f}, (f32x4){0.f, 0.f, 0.f, 0.f}};
#pragma unroll
            for (int ss = 0; ss < 4; ++ss) { const int k0 = 128 * w + 32 * ss + 8 * kg;
                const f32x4 h0 = *(const LAS f32x4*)(hrow + fr * 1028 + k0), h1 = *(const LAS f32x4*)(hrow + fr * 1028 + k0 + 4);
                u32x4 ah, al;
                ah.x = pk2(h0[0], h0[1]); ah.y = pk2(h0[2], h0[3]); ah.z = pk2(h1[0], h1[1]); ah.w = pk2(h1[2], h1[3]);
                al.x = pk2(h0[0] - lo_bf(ah.x), h0[1] - hi_bf(ah.x)); al.y = pk2(h0[2] - lo_bf(ah.y), h0[3] - hi_bf(ah.y)); al.z = pk2(h1[0] - lo_bf(ah.z), h1[1] - hi_bf(ah.z)); al.w = pk2(h1[2] - lo_bf(ah.w), h1[3] - hi_bf(ah.w));
                const bf16x8 Ah = __builtin_bit_cast(bf16x8, ah), Al = __builtin_bit_cast(bf16x8, al);
#pragma unroll
                for (int t = 0; t < 2; ++t) { const size_t wo = (size_t)(16 * t + fr) * D + k0;
                    const bf16x8 Bh = *(const bf16x8*)(wh + wo), Bl = *(const bf16x8*)(wl + wo);
                    acc[t] = __builtin_amdgcn_mfma_f32_16x16x32_bf16(Ah, Bh, acc[t], 0, 0, 0);
                    acc[t] = __builtin_amdgcn_mfma_f32_16x16x32_bf16(Ah, Bl, acc[t], 0, 0, 0);
                    acc[t] = __builtin_amdgcn_mfma_f32_16x16x32_bf16(Al, Bh, acc[t], 0, 0, 0); } }
#pragma unroll
            for (int t = 0; t < 2; ++t)
#pragma unroll
                for (int j = 0; j < 4; ++j) part[((w * 2 + t) * 16 + 4 * kg + j) * 16 + fr] = acc[t][j];
        }
        __syncthreads();
        {
            const int row = base + 2 * w + par;
            float cur = br[e];
#pragma unroll
            for (int ww = 0; ww < 8; ++ww) cur += part[((ww * 2 + (e >> 4)) * 16 + 2 * w + par) * 16 + (e & 15)];
            float tvv[4]; int ti[4];
#pragma unroll
            for (int k = 0; k < 4; ++k) { float bv = cur; int bi = e;
#define TOPSTEP(OV, OI) do { const float ov = (OV); const int oi = (OI); if (ov > bv || (ov == bv && oi < bi)) { bv = ov; bi = oi; } } while (0)
                TOPSTEP(dpp_f<0xB1>(bv), dpp_i<0xB1>(bi)); TOPSTEP(dpp_f<0x4E>(bv), dpp_i<0x4E>(bi)); TOPSTEP(dpp_f<0x141>(bv), dpp_i<0x141>(bi)); TOPSTEP(dpp_f<0x140>(bv), dpp_i<0x140>(bi));
                TOPSTEP(__shfl_xor(bv, 16), __shfl_xor(bi, 16));
#undef TOPSTEP
                tvv[k] = bv; ti[k] = bi; if (e == bi) cur = -3.0e38f; }
            const float e1 = __expf(tvv[1] - tvv[0]), e2 = __expf(tvv[2] - tvv[0]), e3 = __expf(tvv[3] - tvv[0]); const float inv = 1.f / (1.f + e1 + e2 + e3);
            if (e < 4) {
                if (p_row >= 0) { LIST[(size_t)p_ee * NTOK + p_pos] = p_row; TOPE[(size_t)p_row * 4 + e] = (p_ee << 20) | (int)p_pos; TOPW[(size_t)p_row * 4 + e] = p_ww; }
                p_ee = e == 0 ? ti[0] : e == 1 ? ti[1] : e == 2 ? ti[2] : ti[3]; p_ww = (e == 0 ? 1.f : e == 1 ? e1 : e == 2 ? e2 : e3) * inv; p_row = row;
                p_pos = atomicAdd(cnt + p_ee * 64, 1u); }
        }
    }
    if (e < 4 && p_row >= 0) { LIST[(size_t)p_ee * NTOK + p_pos] = p_row; TOPE[(size_t)p_row * 4 + e] = (p_ee << 20) | (int)p_pos; TOPW[(size_t)p_row * 4 + e] = p_ww; }
#undef LN1_FETCH
}
__device__ __forceinline__ void moe_tables(CArgs& a, int l, LAS unsigned char* lds, int NT) {
    LAS int* pre = (LAS int*)(lds + TAB_OFF); LAS int* mtl = pre + 40; LAS int* rowoff = pre + 80; LAS int* cn = pre + 120;
    if (tidx() == 0) { const unsigned* cnt = (const unsigned*)(a.ws + WS_CTL) + CW_CNT + l * NEXP * 64; int p = 0, r = 0;
        for (int e = 0; e < NEXP; ++e) { const int n = (int)__hip_atomic_load(cnt + e * 64, __ATOMIC_RELAXED, __HIP_MEMORY_SCOPE_AGENT), m = (n + 255) >> 8; pre[e] = p; mtl[e] = m > 0 ? m : 1; rowoff[e] = r; cn[e] = n; p += m * NT; r += m * 256; }
        pre[32] = p; }
    __syncthreads();
}
__device__ __forceinline__ void ph_ln2(CArgs& a, int l, LAS unsigned char* lds, int gw, int ngw) {
    const int lane = tidx() & 63;
    const float* MOD = (const float*)(a.ws + WS_MOD) + (size_t)l * 17 * 6144;
    float* X = (float*)(a.ws + WS_X); const bf16* YD = (const bf16*)(a.ws + WS_YD); bf16* HB = (bf16*)(a.ws + WS_HB);
    const float* lg = a.in[I_LN2G] + l * D; const float* lb = a.in[I_LN2B] + l * D;
    const int* TOPE = (const int*)(a.ws + WS_TOPE); const float* TOPW = (const float*)(a.ws + WS_TOPW);
    const LAS int* rowoff = (const LAS int*)(lds + TAB_OFF) + 80;
    const bool lastl = (l == DEPTH - 1);
    const int row_lo = lastl ? NTOK_C : 0;
#pragma unroll 1
    for (int row0 = row_lo + gw * 2; row0 < NTOK; row0 += ngw * 2) {
        u32x2 y2[2][4][4]; float tw[2][4]; f32x4 xv[2][4], g2v[2][4];
#pragma unroll
        for (int r = 0; r < 2; ++r) {
            const int row = row0 + r;
#pragma unroll
            for (int k = 0; k < 4; ++k) { const int te = TOPE[(size_t)row * 4 + k]; tw[r][k] = TOPW[(size_t)row * 4 + k];
                const bf16* yr = YD + ((size_t)(rowoff[te >> 20] + (te & 0xfffff))) * D;
#pragma unroll
                for (int j = 0; j < 4; ++j) y2[r][k][j] = *(const u32x2*)(yr + j * 256 + 4 * lane); }
            const float* mv = MOD + (size_t)mod_vec(row) * 6144;
#pragma unroll
            for (int j = 0; j < 4; ++j) { const int c0 = j * 256 + 4 * lane; xv[r][j] = *(const f32x4*)(X + (size_t)row * D + c0); g2v[r][j] = *(const f32x4*)(mv + 5120 + c0); }
        }
#pragma unroll
        for (int r = 0; r < 2; ++r) {
            const int row = row0 + r;
            const float* mv = MOD + (size_t)mod_vec(row) * 6144;
            f32x4 v[4]; float s = 0.f;
#pragma unroll
            for (int j = 0; j < 4; ++j) { f32x4 f = (f32x4){0.f, 0.f, 0.f, 0.f};
#pragma unroll
                for (int k = 0; k < 4; ++k) { const u32x2 yy = y2[r][k][j]; f += tw[r][k] * (f32x4){lo_bf(yy.x), hi_bf(yy.x), lo_bf(yy.y), hi_bf(yy.y)}; }
                v[j] = DN_ALPHA * xv[r][j] + g2v[r][j] * f; s += (v[j][0] + v[j][1]) + (v[j][2] + v[j][3]); }
            const float mean = wave_sum(s) * (1.f / D); float s2 = 0.f;
#pragma unroll
            for (int j = 0; j < 4; ++j) { v[j] = v[j] - mean; s2 += (v[j][0] * v[j][0] + v[j][1] * v[j][1]) + (v[j][2] * v[j][2] + v[j][3] * v[j][3]); }
            const float rstd = rsqrtf(wave_sum(s2) * (1.f / D) + LN_EPS);
            const float* mvn = mv + 17 * 6144;
#pragma unroll
            for (int j = 0; j < 4; ++j) { const int c0 = j * 256 + 4 * lane; const f32x4 g = *(const f32x4*)(lg + c0), bb = *(const f32x4*)(lb + c0);
                const f32x4 xn = v[j] * rstd * g + bb;
                if (lastl) *(f32x4*)(a.out + (size_t)(row - NTOK_C) * D + c0) = xn;
                else { *(f32x4*)(X + (size_t)row * D + c0) = xn; const f32x4 sh = *(const f32x4*)(mvn + c0), sc = *(const f32x4*)(mvn + 1024 + c0); const f32x4 hh = xn * (1.f + sc) + sh;
                    u32x2 o; o.x = pk2(hh[0], hh[1]); o.y = pk2(hh[2], hh[3]); *(u32x2*)(HB + (size_t)row * D + c0) = o; } }
        }
    }
}

constexpr int NPH = 2 + DEPTH * 9;
__device__ __forceinline__ CArgs* kargs() { CArgs* p = (CArgs*)__builtin_amdgcn_kernarg_segment_ptr(); asm volatile("" : "+s"(p)); return p; }
__global__ void __launch_bounds__(512, 2) trunk_fwd(Args a_unused) {
    extern __shared__ __attribute__((aligned(16))) unsigned char lds_raw[];
    LAS unsigned char* lds = (LAS unsigned char*)lds_raw;
    const int tid = threadIdx.x, wave = __builtin_amdgcn_readfirstlane(tid >> 6);
    const int bid = blockIdx.x, nblk = gridDim.x, gw = bid * 8 + wave, ngw = nblk * 8;
    volatile LAS unsigned* MISC = (volatile LAS unsigned*)(lds + MISC_OFF);
    if (tid < 64) MISC[tid] = 0u;
    __syncthreads();
    XcdBarrier bar; bar.x = 0; bar.st = nullptr;
    int lo, hi;
    { CArgs& a = *kargs(); lo = a.ph_lo; hi = a.ph_hi; bar.bar = (unsigned*)(a.ws + WS_CTL) + CW_BAR;
      if (hi - lo > 1) bar = xcd_barrier_post((unsigned*)(a.ws + WS_CTL) + CW_BAR, MISC); }
#define IN(k) (lo <= (k) && (k) < hi)
    unsigned long long tacc = 0ull, tbeg = 0ull;
#define PB_BEG(ty) do { if (PROBE_PH == (ty)) tbeg = __builtin_amdgcn_s_memrealtime(); } while (0)
#define PB_END(ty) do { if (PROBE_PH == (ty)) tacc += __builtin_amdgcn_s_memrealtime() - tbeg; } while (0)
#define SEAM(k) do { if (IN(k) && IN((k) + 1)) xcd_barrier(bar); } while (0)
    PB_BEG(0);
    if (IN(0)) { CArgs& a = *kargs(); unsigned long long t0 = 0ull;
#define PB_SUB(ty, stmt) do { if (PROBE_PH == (ty)) t0 = __builtin_amdgcn_s_memrealtime(); stmt; if (PROBE_PH == (ty)) tacc += __builtin_amdgcn_s_memrealtime() - t0; } while (0)
        PB_SUB(30, ph_mod(a, lds, bid, nblk)); __syncthreads(); PB_SUB(31, ph_filters(a, gw, ngw)); PB_SUB(32, ph_tr_small(a, lds, gw, ngw)); PB_SUB(33, ph_router_w(a, bid * 512 + tid, nblk * 512));
#undef PB_SUB
    }
    SEAM(0); PB_END(0); PB_BEG(1);
    if (IN(1)) { CArgs& a = *kargs(); ph_mod_input(a, gw, ngw); }
    SEAM(1); PB_END(1);
#pragma unroll 1
    for (int l = 0; l < DEPTH; ++l) {
        const int p0 = 2 + 9 * l;
        const bool lastl = (l == DEPTH - 1);
        PB_BEG(2);
        if (IN(p0 + 0)) {
            CArgs& a = *kargs();
            pg8::DenseSched S; S.init((const bf16*)(a.ws + WS_WIN) + (size_t)l * D_INP * 1024, 1024, NTOK, D_INP, nblk, bid, 0);
            pg8::EpiBf16 E{(bf16*)(a.ws + WS_P), D_INP, 0};
            pg8::gemm_phase<pg8::EpiBf16, pg8::DenseSched, true>(lds, (const char*)(a.ws + WS_HB), 1024, S, E);
        }
        SEAM(p0 + 0); PB_END(2); PB_BEG(3);
        if (IN(p0 + 1)) { CArgs& a = *kargs(); ph_prep_conv(a, l, lds, bid, nblk); ph_prep_tok(a, l, gw, ngw); }
        SEAM(p0 + 1); PB_END(3); PB_BEG(4);
        if (IN(p0 + 2)) { CArgs& a = *kargs(); ph_scan(a, l, lds, bid, nblk, tacc); }
        SEAM(p0 + 2); PB_END(4); PB_BEG(5);
        if (IN(p0 + 3)) { CArgs& a = *kargs(); ph_post_hyena(a, l, lds, bid, nblk); ph_post_tok(a, l, gw, ngw); }
        SEAM(p0 + 3); PB_END(5); PB_BEG(6);
        if (IN(p0 + 4)) {
            CArgs& a = *kargs();
            const int r0 = lastl ? NTOK_C : 0;
            pg8::DenseSched S; S.init((const bf16*)(a.ws + WS_WOUT) + (size_t)l * 1024 * 1024, 1024, NTOK - r0, 1024, nblk, bid, r0);
            pg8::EpiF32 E{(float*)(a.ws + WS_TMP), 1024, r0};
            pg8::gemm_phase<pg8::EpiF32, pg8::DenseSched, true>(lds, (const char*)(a.ws + WS_YMIX), 1024, S, E);
        }
        SEAM(p0 + 4); PB_END(6); PB_BEG(7);
        if (IN(p0 + 5)) { CArgs& a = *kargs(); ph_ln1_route(a, l, lds, bid, nblk); }
        SEAM(p0 + 5); PB_END(7); PB_BEG(8);
        if (IN(p0 + 6)) {
            CArgs& a = *kargs();
            moe_tables(a, l, lds, 8);
            const LAS int* tb = (const LAS int*)(lds + TAB_OFF);
            pg8::MoeSched<true, 8> S; S.Bt = (const char*)(a.ws + WS_WGU); S.bstride = (size_t)2048 * 1024; S.rb = 1024; S.list = (const int*)(a.ws + WS_LIST);
            S.pre = tb; S.mtl = tb + 40; S.rowoff = tb + 80; S.cnt = tb + 120; S.K = 1024; S.G = nblk; S.c = (nblk % 8 == 0) ? (bid % 8) * (nblk / 8) + bid / 8 : bid; S.total = tb[32];
            pg8::EpiSwiglu E{(bf16*)(a.ws + WS_H), a.in[I_BG] + (size_t)l * NEXP * 1024, a.in[I_BU] + (size_t)l * NEXP * 1024, tb + 80, 1.f / 128.f};
            pg8::gemm_phase_f8g<pg8::EpiSwiglu, pg8::MoeSched<true, 8>, true>(lds, (const char*)(a.ws + WS_HB8), 1024, S, E);
        }
        SEAM(p0 + 6); PB_END(8); PB_BEG(9);
        if (IN(p0 + 7)) {
            CArgs& a = *kargs();
            moe_tables(a, l, lds, 4);
            const LAS int* tb = (const LAS int*)(lds + TAB_OFF);
            pg8::MoeSched<false, 4> S; S.Bt = (const char*)(a.ws + WS_WD); S.bstride = (size_t)1024 * 1024; S.rb = 1024; S.list = nullptr;
            S.pre = tb; S.mtl = tb + 40; S.rowoff = tb + 80; S.cnt = tb + 120; S.K = 1024; S.G = nblk; S.c = (nblk % 8 == 0) ? (bid % 8) * (nblk / 8) + bid / 8 : bid; S.total = tb[32];
            pg8::EpiDown E{(bf16*)(a.ws + WS_YD), a.in[I_BD] + (size_t)l * NEXP * 1024, tb + 80, 1.f / 128.f};
            pg8::gemm_phase_f8<pg8::EpiDown, pg8::MoeSched<false, 4>, true>(lds, (const char*)(a.ws + WS_H), 1024, S, E);
        }
        SEAM(p0 + 7); PB_END(9); PB_BEG(10);
        if (IN(p0 + 8)) { CArgs& a = *kargs(); moe_tables(a, l, lds, 4); ph_ln2(a, l, lds, gw, ngw); }
        if (!lastl) SEAM(p0 + 8);
        PB_END(10);
    }
    if (PROBE_PH >= 0) { const unsigned long long t0 = __builtin_amdgcn_s_memrealtime(); while (__builtin_amdgcn_s_memrealtime() - t0 < tacc) __builtin_amdgcn_s_sleep(8); }
#undef IN
#undef SEAM
}

extern "C" void kernel_launch(void* const* d_in, const int* in_sizes, int n_in, void* d_out, int out_size, void* d_ws, size_t ws_size, hipStream_t stream) {
    static int grid = 0;
    if (grid == 0) {
        if (n_in != 39 || out_size != NTOK_L * D || ws_size < WS_END) { fprintf(stderr, "kernel_launch: unexpected problem (n_in %d, out %d, ws %zu < %zu)\n", n_in, out_size, ws_size, (size_t)WS_END); grid = -1; return; }
        int dev = 0, cus = 0, per_cu = 0;
        if (hipGetDevice(&dev) != hipSuccess || hipDeviceGetAttribute(&cus, hipDeviceAttributeMultiprocessorCount, dev) != hipSuccess) { grid = -1; return; }
        if (hipFuncSetAttribute((const void*)trunk_fwd, hipFuncAttributeMaxDynamicSharedMemorySize, LDS_BYTES) != hipSuccess) { fprintf(stderr, "kernel_launch: hipFuncSetAttribute failed\n"); grid = -1; return; }
        if (hipOccupancyMaxActiveBlocksPerMultiprocessor(&per_cu, (const void*)trunk_fwd, 512, LDS_BYTES) != hipSuccess || per_cu < 1) fprintf(stderr, "kernel_launch: occupancy query says %d\n", per_cu);
        (void)hipGetLastError();
        grid = cus;
    }
    if (grid < 0) return;
    (void)hipMemsetAsync((char*)d_ws + WS_CTL, 0, CTL_ZERO_BYTES, stream);
    Args a{};
    for (int i = 0; i < 39; ++i) a.in[i] = (const float*)d_in[i];
    a.out = (float*)d_out; a.ws = (unsigned char*)d_ws;
#if MK_FUSED
    a.ph_lo = 0; a.ph_hi = NPH;
    hipLaunchKernelGGL(trunk_fwd, dim3(grid), dim3(512), LDS_BYTES, stream, a);
#else
    for (int p = 0; p < NPH; ++p) { a.ph_lo = p; a.ph_hi = p + 1; hipLaunchKernelGGL(trunk_fwd, dim3(grid), dim3(512), LDS_BYTES, stream, a); }
#endif
}
```

```cpp
#include <hip/hip_runtime.h>
#include <cstdio>
#include <cstdint>

#ifndef MK_FUSED
#define MK_FUSED 1
#endif

#ifndef USE_NEW_GDN
#define USE_NEW_GDN 1
#endif
#ifndef USE_NEW_GLA
#define USE_NEW_GLA 1
#endif
#ifndef PROBE_PH
#define PROBE_PH -1
#endif

#define LAS __attribute__((address_space(3)))
#define GAS __attribute__((address_space(1)))
typedef unsigned short bf16;
typedef short bf16x8 __attribute__((ext_vector_type(8)));
typedef float f32x4 __attribute__((ext_vector_type(4)));
typedef float f32x2 __attribute__((ext_vector_type(2)));
typedef unsigned u32x4 __attribute__((ext_vector_type(4)));
typedef unsigned u32x2 __attribute__((ext_vector_type(2)));

constexpr int D = 1024, NB = 16, SEQ = 2048, CTXL = 256, DEPTH = 4;
constexpr int NTOK_C = NB * CTXL, NTOK_L = NB * SEQ, NTOK = NTOK_C + NTOK_L;
constexpr int D_IN = 3376, D_INP = 3584;
constexpr int HY0 = 0, SC0 = 768, GLA0 = 1536, GDN0 = 2336;
constexpr int NEXP = 32, TOPK = 4;
constexpr int MAXROWS = NTOK * TOPK + NEXP * 256;
constexpr float DN_ALPHA = 1.681792830507429f;
constexpr float LN_EPS = 1e-5f;

constexpr size_t MiB = 1u << 20;
constexpr size_t WS_CTL = 0, CTL_ZERO_BYTES = 1 * MiB;
constexpr size_t WS_MOD = 1 * MiB;
constexpr size_t WS_WRT = 3 * MiB;
constexpr size_t WS_KUN = 4 * MiB;
constexpr size_t WS_WIN = 36 * MiB;
constexpr size_t WS_WOUT = 64 * MiB;
constexpr size_t WS_WGU = 72 * MiB;
constexpr size_t WS_WD = 200 * MiB;
constexpr size_t WS_X = 264 * MiB;
constexpr size_t WS_HB = 408 * MiB;
constexpr size_t WS_P = 480 * MiB;
constexpr size_t WS_YMIX = 732 * MiB;
constexpr size_t WS_YD = WS_P;
constexpr size_t WS_TMP = 804 * MiB;
constexpr size_t WS_LIST = 948 * MiB;
constexpr size_t WS_TOPE = 953 * MiB;
constexpr size_t WS_TOPW = 954 * MiB;
constexpr size_t WS_H = 956 * MiB;
constexpr size_t WS_MIX = 1264 * MiB;
constexpr size_t MX_ZT = 0;
constexpr size_t MX_YT = 20 * MiB;
constexpr size_t MX_GDF = 56 * MiB, MX_GDB = 76 * MiB;
constexpr size_t MX_GOF = 96 * MiB, MX_GOB = 132 * MiB;
constexpr size_t MX_DQ = 168 * MiB, MX_DK = 204 * MiB, MX_DV = 240 * MiB;
constexpr size_t MX_DG = 276 * MiB;
constexpr size_t MX_DOF = 280 * MiB, MX_DOB = 316 * MiB;
constexpr size_t WS_HB8 = 1616 * MiB;
constexpr size_t WS_END = 1980 * MiB;
constexpr int NUNIT = 128 * 36;
constexpr size_t WS_CKD = 1656 * MiB;
constexpr size_t CD_M = 0;
constexpr size_t CD_E = 36 * MiB;
constexpr size_t CD_BT = 72 * MiB;
constexpr size_t CD_FT = 144 * MiB;
constexpr size_t CD_KB = 180 * MiB, CD_QB = 198 * MiB;
constexpr size_t WS_CKA = WS_CKD + 216 * MiB;
constexpr size_t CA_QC = 0;
constexpr size_t CA_FT = 20 * MiB;
constexpr size_t CA_UT = 60 * MiB;
constexpr size_t CA_DL = 100 * MiB;
static_assert(WS_CKA + CA_DL + (size_t)NUNIT * 32 * 4 <= WS_END, "chunk data");
static_assert((size_t)MAXROWS * 1024 * 2 <= 324 * MiB, "YD overlay");
static_assert(WS_H + (size_t)MAXROWS * 1024 * 2 <= WS_MIX, "H");
constexpr int CW_BAR = 4096;
constexpr int CW_CNT = 16384;

constexpr int LDS_BYTES = 147456;
constexpr int MISC_OFF = 143360;
constexpr int TAB_OFF = 143360 + 256;

__device__ __forceinline__ float bf2f(unsigned v) { return __uint_as_float(v << 16); }
__device__ __forceinline__ unsigned f2bf(float f) { unsigned u = __float_as_uint(f); return (u + 0x7fffu + ((u >> 16) & 1u)) >> 16; }
__device__ __forceinline__ unsigned pk2(float lo, float hi) { return f2bf(lo) | (f2bf(hi) << 16); }
__device__ __forceinline__ unsigned pk4_fp8(float a, float b, float c, float d) { int r = __builtin_amdgcn_cvt_pk_fp8_f32(a, b, 0, false); return (unsigned)__builtin_amdgcn_cvt_pk_fp8_f32(c, d, r, true); }
__device__ __forceinline__ float lo_bf(unsigned w) { return __uint_as_float(w << 16); }
__device__ __forceinline__ float hi_bf(unsigned w) { return __uint_as_float(w & 0xffff0000u); }
__device__ __forceinline__ float sigmoidf_(float x) { return 1.f / (1.f + __expf(-x)); }
__device__ __forceinline__ float siluf_(float x) { return x / (1.f + __expf(-x)); }
__device__ __forceinline__ float softplusf_(float x) { return x > 20.f ? x : log1pf(__expf(x)); }
__device__ __forceinline__ float logsigmoidf_(float x) { return x >= 0.f ? -log1pf(__expf(-x)) : x - log1pf(__expf(x)); }
__device__ __forceinline__ float sin_rev(float r) { return __builtin_amdgcn_sinf(__builtin_amdgcn_fractf(r)); }
__device__ __forceinline__ float sin_rad(float x) { return sin_rev(x * 0.15915494309189535f); }
template <int CTRL> __device__ __forceinline__ float dpp_f(float v) { return __builtin_bit_cast(float, __builtin_amdgcn_update_dpp(0, __builtin_bit_cast(int, v), CTRL, 0xf, 0xf, true)); }
template <int CTRL> __device__ __forceinline__ int dpp_i(int v) { return __builtin_amdgcn_update_dpp(0, v, CTRL, 0xf, 0xf, true); }
__device__ __forceinline__ float quad_sum(float v) { v += dpp_f<0xB1>(v); v += dpp_f<0x4E>(v); return v; }
__device__ __forceinline__ float row16_sum(float v) { v += dpp_f<0xB1>(v); v += dpp_f<0x4E>(v); v += dpp_f<0x141>(v); v += dpp_f<0x140>(v); return v; }
__device__ __forceinline__ float rdlane_f(float v, int l) { return __builtin_bit_cast(float, __builtin_amdgcn_readlane(__builtin_bit_cast(int, v), l)); }
__device__ __forceinline__ float wave_sum(float v) {
    v = row16_sum(v);
    return (rdlane_f(v, 0) + rdlane_f(v, 16)) + (rdlane_f(v, 32) + rdlane_f(v, 48));
}
__device__ __forceinline__ int tidx() { int t = threadIdx.x; asm volatile("" : "+v"(t)); return t; }

#define XB_TMO      128
#define XB_XCNT(j)  (256  + 64 * (j))
#define XB_XSUB(j)  (1280 + 64 * (j))
#define XB_XGEN(j)  (2304 + 64 * (j))
#define XB_TOP      3328
#define XB_TOPGEN   3392
#define XCD_BAR_WORDS 3456
#define XB_SPIN_CAP (1u << 25)
__device__ __forceinline__ unsigned xb_ld(unsigned* p)              { return __hip_atomic_load(p, __ATOMIC_RELAXED, __HIP_MEMORY_SCOPE_AGENT); }
__device__ __forceinline__ unsigned xb_add(unsigned* p, unsigned v) { return __hip_atomic_fetch_add(p, v, __ATOMIC_RELAXED, __HIP_MEMORY_SCOPE_AGENT); }
__device__ __forceinline__ unsigned xb_xcc_id() { return (unsigned)__builtin_amdgcn_s_getreg((3 << 11) | 20) & 0xFu; }
#define XB_SPIN(cond, bar) do { unsigned _sp = 0; while (cond) { __builtin_amdgcn_s_sleep(1); \
    if ((++_sp & 255u) == 0u) { if (xb_ld(&(bar)[XB_TMO])) break; if (_sp > XB_SPIN_CAP) { atomicAdd(&(bar)[XB_TMO], 1u); break; } } } } while (0)
struct XcdBarrier { unsigned* bar; unsigned x; volatile LAS unsigned* st; };
__device__ __forceinline__ XcdBarrier xcd_barrier_post(unsigned* bar, volatile LAS unsigned* st) {
    XcdBarrier b; b.bar = bar; b.x = xb_xcc_id(); b.st = st;
    if (threadIdx.x == 0) (void)xb_add(&bar[XB_XCNT(b.x)], 1u);
    return b;
}
__device__ __forceinline__ void xcd_barrier_complete(unsigned* bar, unsigned x, unsigned& nloc, unsigned& nx) {
    const unsigned G = gridDim.x * gridDim.y * gridDim.z;
    unsigned sum, cnt, mine, sp = 0u;
    for (;;) {
        sum = 0u; cnt = 0u; mine = 0u;
#pragma unroll
        for (unsigned j = 0; j < 16; ++j) { const unsigned c = xb_ld(&bar[XB_XCNT(j)]); sum += c; cnt += (c > 0u) ? 1u : 0u; mine = (j == x) ? c : mine; }
        if (sum == G) break;
        __builtin_amdgcn_s_sleep(1);
        if ((++sp & 255u) == 0u) { if (xb_ld(&bar[XB_TMO])) break; if (sp > XB_SPIN_CAP) { atomicAdd(&bar[XB_TMO], 1u); break; } }
    }
    nloc = mine > 0u ? mine : 1u; nx = cnt > 0u ? cnt : 1u;
}
__device__ __forceinline__ void xcd_barrier(const XcdBarrier& b) {
    asm volatile("s_waitcnt vmcnt(0)" ::: "memory");
    __syncthreads();
    if (threadIdx.x == 0) {
        unsigned* bar = b.bar;
        __builtin_amdgcn_s_waitcnt(0);
        unsigned nloc = b.st[0], nx = b.st[1];
        if (nloc == 0u) { xcd_barrier_complete(bar, b.x, nloc, nx); b.st[0] = nloc; b.st[1] = nx; }
        const unsigned old = xb_add(&bar[XB_XSUB(b.x)], 1u);
        const unsigned gen = old / nloc;
        if (old + 1u == (gen + 1u) * nloc) {
            __builtin_amdgcn_fence(__ATOMIC_RELEASE, "agent");
            asm volatile("s_waitcnt vmcnt(0)" ::: "memory");
            const unsigned og = xb_add(&bar[XB_TOP], 1u);
            const unsigned tg = og / nx;
            if (og + 1u == (tg + 1u) * nx) xb_add(&bar[XB_TOPGEN], 1u);
            else XB_SPIN(xb_ld(&bar[XB_TOPGEN]) == tg, bar);
            __builtin_amdgcn_fence(__ATOMIC_ACQUIRE, "agent");
            xb_add(&bar[XB_XGEN(b.x)], 1u);
            asm volatile("s_waitcnt vmcnt(0)" ::: "memory");
        } else {
            XB_SPIN(xb_ld(&bar[XB_XGEN(b.x)]) == gen, bar);
            __builtin_amdgcn_fence(__ATOMIC_ACQUIRE, "agent");
            asm volatile("s_waitcnt vmcnt(0)" ::: "memory");
        }
    }
    __syncthreads();
}

namespace pg8 {
constexpr int BM = 256, BK = 64, HALF = 128, HTB = HALF * BK * 2, STAGE_BYTES = 8 * HTB, NXCD = 8, WGM = 8;
__host__ __device__ __forceinline__ int lds_byte(int r, int c) { const int st = (r >> 4) * 2 + (c >> 5), rr = r & 15, cc = c & 31, ob = rr * 64 + cc * 2; return st * 1024 + (ob ^ (((ob >> 9) & 1) << 5)); }
__host__ __device__ __forceinline__ void stage_rc(int b, int& R, int& C) { const int st = b / 1024, sb = b % 1024, swz = sb ^ (((sb >> 9) & 1) << 5); R = (st >> 1) * 16 + swz / 64; C = (st & 1) * 32 + (swz % 64) / 2; }
__host__ __device__ __forceinline__ int perm32(int rho) { const int n = rho >> 4, i = rho & 15; return 8 * (i >> 2) + 4 * n + (i & 3); }
__device__ __forceinline__ unsigned cvt_pk_bf16(float lo, float hi) { unsigned r; asm volatile("v_cvt_pk_bf16_f32 %0, %1, %2" : "=v"(r) : "v"(lo), "v"(hi)); return r; }

struct Unit { int pm, pn, e, mt; };

struct DenseSched {
    const char* Bt; int K, nM, nN, nwg, G, c, row0;
    __device__ __forceinline__ void init(const bf16* Bt_, int K_, int M, int N, int G_, int c_, int row0_) { Bt = (const char*)Bt_; K = K_; nM = M / BM; nN = N / BM; nwg = nM * nN; G = G_; c = c_; row0 = row0_; }
    __device__ __forceinline__ bool next(int i, Unit& u) const {
        const long L = (long)i * G + c; if (L >= nwg) return false;
        int wgid = (int)L; { const int q = nwg / NXCD, r = nwg % NXCD, xcd = wgid % NXCD, off = wgid / NXCD; wgid = (xcd < r ? xcd * (q + 1) : r * (q + 1) + (xcd - r) * q) + off; }
        const int nig = WGM * nN, gid = wgid / nig, fm = gid * WGM, gsz = (nM - fm) < WGM ? (nM - fm) : WGM;
        u.pm = fm + ((wgid % nig) % gsz); u.pn = (wgid % nig) / gsz; u.e = 0; u.mt = 0; return true;
    }
    __device__ __forceinline__ const char* b_ptr(const Unit& u) const { return Bt + (size_t)u.pn * (size_t)(BM * 2) * K; }
    __device__ __forceinline__ void a_offsets(const Unit& u, const int (&R)[2], const int (&C)[2], unsigned (&v)[2][2]) const {
#pragma unroll
        for (int h = 0; h < 2; ++h)
#pragma unroll
            for (int i = 0; i < 2; ++i) v[h][i] = (unsigned)((row0 + u.pm * BM + h * HALF + R[i]) * K + C[i]) * 2u;
    }
};
template <bool GATHER, int NT>
struct MoeSched {
    const char* Bt; size_t bstride;
    int rb;
    const int* list;
    const LAS int* pre; const LAS int* mtl; const LAS int* rowoff; const LAS int* cnt;
    int K, G, c, total;
    __device__ __forceinline__ bool next(int i, Unit& u) const {
        const int L = i * G + c; if (L >= total) return false;
        int e = 0;
#pragma unroll 1
        for (int j = 1; j < NEXP; ++j) e = (L >= pre[j]) ? j : e;
        const int rem = L - pre[e];
        u.e = e; u.pn = rem % NT; u.mt = rem / NT; u.pm = 0; return true;
    }
    __device__ __forceinline__ const char* b_ptr(const Unit& u) const { return Bt + (size_t)u.e * bstride + (size_t)u.pn * (size_t)BM * rb; }
    __device__ __forceinline__ const char* a_ptr(const Unit& u, const char* Abase) const { return Abase + (size_t)(rowoff[u.e] + u.mt * BM) * rb; }
    __device__ __forceinline__ void a_offsets(const Unit& u, const int (&R)[2], const int (&C)[2], unsigned (&v)[2][2]) const {
        if (GATHER) {
            const int n = cnt[u.e]; const int* lp = list + (size_t)u.e * NTOK;
#pragma unroll
            for (int h = 0; h < 2; ++h)
#pragma unroll
                for (int i = 0; i < 2; ++i) { const int idx = u.mt * BM + h * HALF + R[i]; const int tok = idx < n ? lp[idx] : 0; v[h][i] = (unsigned)(tok * rb + 2 * C[i]); }
        } else {
            const int r0 = rowoff[u.e] + u.mt * BM;
#pragma unroll
            for (int h = 0; h < 2; ++h)
#pragma unroll
                for (int i = 0; i < 2; ++i) v[h][i] = (unsigned)((r0 + h * HALF + R[i]) * K + C[i]) * 2u;
        }
    }
};

struct EpiBf16 {
    static constexpr bool PERM = true;
    bf16* O; int ldc; int row0;
    __device__ __forceinline__ void operator()(const f32x4 (&acc)[2][2][4][2], const Unit& u, int wr, int wc, int fr, int fq) const {
        const int r0 = row0 + u.pm * BM + wr * 64 + fr, col0 = u.pn * BM + wc * 32 + 8 * fq;
#pragma unroll
        for (int ai = 0; ai < 2; ++ai)
#pragma unroll
            for (int m = 0; m < 4; ++m) { bf16* rowp = O + (size_t)(r0 + ai * HALF + m * 16) * ldc + col0;
#pragma unroll
                for (int bj = 0; bj < 2; ++bj) { const f32x4 v0 = acc[ai][bj][m][0], v1 = acc[ai][bj][m][1];
                    u32x4 w; w.x = cvt_pk_bf16(v0[0], v0[1]); w.y = cvt_pk_bf16(v0[2], v0[3]); w.z = cvt_pk_bf16(v1[0], v1[1]); w.w = cvt_pk_bf16(v1[2], v1[3]);
                    *(u32x4*)(rowp + bj * HALF) = w; } }
    }
};
struct EpiF32 {
    static constexpr bool PERM = false;
    float* Cc; int ldc; int row0;
    __device__ __forceinline__ void operator()(const f32x4 (&acc)[2][2][4][2], const Unit& u, int wr, int wc, int fr, int fq) const {
        const int r0 = row0 + u.pm * BM + wr * 64 + fr, col0 = u.pn * BM + wc * 32 + 4 * fq;
#pragma unroll
        for (int ai = 0; ai < 2; ++ai)
#pragma unroll
            for (int m = 0; m < 4; ++m) { float* rowp = Cc + (size_t)(r0 + ai * HALF + m * 16) * ldc + col0;
#pragma unroll
                for (int bj = 0; bj < 2; ++bj)
#pragma unroll
                    for (int n = 0; n < 2; ++n) *(f32x4*)(rowp + bj * HALF + n * 16) = acc[ai][bj][m][n]; }
    }
};
struct EpiSwiglu {
    static constexpr bool PERM = true;
    bf16* H; const float* bg; const float* bu; const LAS int* rowoff; float ws;
    __device__ __forceinline__ void operator()(const f32x4 (&acc)[2][2][4][2], const Unit& u, int wr, int wc, int fr, int fq) const {
        const int r0 = rowoff[u.e] + u.mt * BM + wr * 64 + fr, j0 = u.pn * HALF + wc * 32 + 8 * fq;
        f32x4 gb[2], ub[2];
#pragma unroll
        for (int n = 0; n < 2; ++n) { gb[n] = *(const f32x4*)(bg + u.e * 1024 + j0 + 4 * n); ub[n] = *(const f32x4*)(bu + u.e * 1024 + j0 + 4 * n); }
#pragma unroll
        for (int ai = 0; ai < 2; ++ai)
#pragma unroll
            for (int m = 0; m < 4; ++m) { unsigned char* rowp = (unsigned char*)H + (size_t)(r0 + ai * HALF + m * 16) * 1024 + j0; float hv[8];
#pragma unroll
                for (int n = 0; n < 2; ++n)
#pragma unroll
                    for (int j = 0; j < 4; ++j) { float g = acc[ai][0][m][n][j] * ws + gb[n][j], up = acc[ai][1][m][n][j] * ws + ub[n][j];
                        g = fminf(g, 7.f); up = fminf(fmaxf(up, -7.f), 7.f);
                        hv[n * 4 + j] = (up + 1.f) * g * __builtin_amdgcn_rcpf(1.f + __expf(-1.702f * g)); }
                *(u32x2*)rowp = (u32x2){pk4_fp8(4.f * hv[0], 4.f * hv[1], 4.f * hv[2], 4.f * hv[3]), pk4_fp8(4.f * hv[4], 4.f * hv[5], 4.f * hv[6], 4.f * hv[7])}; }
    }
};
struct EpiDown {
    static constexpr bool PERM = true;
    bf16* Y; const float* bd; const LAS int* rowoff; float ws;
    __device__ __forceinline__ void operator()(const f32x4 (&acc)[2][2][4][2], const Unit& u, int wr, int wc, int fr, int fq) const {
        const int r0 = rowoff[u.e] + u.mt * BM + wr * 64 + fr, col0 = u.pn * BM + wc * 32 + 8 * fq;
        f32x4 bv[2][2];
#pragma unroll
        for (int bj = 0; bj < 2; ++bj)
#pragma unroll
            for (int n = 0; n < 2; ++n) bv[bj][n] = *(const f32x4*)(bd + u.e * 1024 + col0 + bj * HALF + 4 * n);
#pragma unroll
        for (int ai = 0; ai < 2; ++ai)
#pragma unroll
            for (int m = 0; m < 4; ++m) { bf16* rowp = Y + (size_t)(r0 + ai * HALF + m * 16) * 1024 + col0;
#pragma unroll
                for (int bj = 0; bj < 2; ++bj) { const f32x4 v0 = acc[ai][bj][m][0] * ws + bv[bj][0], v1 = acc[ai][bj][m][1] * ws + bv[bj][1];
                    u32x4 w; w.x = cvt_pk_bf16(v0[0], v0[1]); w.y = cvt_pk_bf16(v0[2], v0[3]); w.z = cvt_pk_bf16(v1[0], v1[1]); w.w = cvt_pk_bf16(v1[2], v1[3]);
                    *(u32x4*)(rowp + bj * HALF) = w; } }
    }
};

template <class Epi, class Sched, bool ALIGN_EPI>
__device__ __forceinline__ void gemm_phase(LAS unsigned char* lds, const char* Abase, const int K, const Sched& S, const Epi& E) {
    const int tid = tidx(), wid = __builtin_amdgcn_readfirstlane(tid >> 6), lane = tid & 63, wr = wid >> 2, wc = wid & 3, fr = lane & 15, fq = lane >> 4;
    const int nt = K / BK;
    int Rp[2], Cp[2]; unsigned voffB0;
#pragma unroll
    for (int i = 0; i < 2; ++i) stage_rc(tid * 16 + i * 8192, Rp[i], Cp[i]);
    { const int Rb = Epi::PERM ? ((Rp[0] & ~31) + perm32(Rp[0] & 31)) : Rp[0]; voffB0 = (unsigned)(Rb * K + Cp[0]) * 2u; }
    const size_t kstep = (size_t)(BK * 2);
    const size_t hstep = (size_t)HALF * K * 2;
    const unsigned ldsw = (unsigned)wid * 1024u;
    const int aoff = lds_byte(wr * 64 + fr, fq * 8), boff = lds_byte(wc * 32 + fr, fq * 8);
#define PG8_SA(b, h) (((b) * 2 + (h)) * HTB)
#define PG8_SB(b, h) ((4 + (b) * 2 + (h)) * HTB)
#define PG8_STAGE(bufoff, gbase, voff) do { _Pragma("unroll") for (int _i = 0; _i < 2; ++_i) \
        __builtin_amdgcn_global_load_lds((const unsigned*)((const char*)(gbase) + (voff)[_i]), (LAS unsigned*)(lds + (bufoff) + ldsw + _i * 8192), 16, 0, 0); } while (0)
#define PG8_STAGEB(bufoff, gbase) do { _Pragma("unroll") for (int _i = 0; _i < 2; ++_i) \
        __builtin_amdgcn_global_load_lds((const unsigned*)((const char*)(gbase) + (size_t)_i * 128 * K + voffB0), (LAS unsigned*)(lds + (bufoff) + ldsw + _i * 8192), 16, 0, 0); } while (0)
#define PG8_LDA(dst, b, h) do { _Pragma("unroll") for (int m = 0; m < 4; ++m) _Pragma("unroll") for (int k = 0; k < 2; ++k) dst[m][k] = *(const LAS bf16x8*)(lds + PG8_SA(b, h) + aoff + m * 2048 + k * 1024); } while (0)
#define PG8_LDB(dst, b, h) do { _Pragma("unroll") for (int n = 0; n < 2; ++n) _Pragma("unroll") for (int k = 0; k < 2; ++k) dst[n][k] = *(const LAS bf16x8*)(lds + PG8_SB(b, h) + boff + n * 2048 + k * 1024); } while (0)
#define PG8_MMA(ai, bj, At, Bt) do { __builtin_amdgcn_s_setprio(1); _Pragma("unroll") for (int m = 0; m < 4; ++m) _Pragma("unroll") for (int n = 0; n < 2; ++n) _Pragma("unroll") for (int k = 0; k < 2; ++k) \
        acc[ai][bj][m][n] = __builtin_amdgcn_mfma_f32_16x16x32_bf16(Bt[n][k], At[m][k], acc[ai][bj][m][n], 0, 0, 0); __builtin_amdgcn_s_setprio(0); } while (0)
#define PG8_WAIT_V(n) asm volatile("s_waitcnt vmcnt(" #n ")" ::: "memory")
#define PG8_WAIT_L(n) asm volatile("s_waitcnt lgkmcnt(" #n ")" ::: "memory")
#define PG8_BAR __builtin_amdgcn_s_barrier()
#define PG8_SCHED __builtin_amdgcn_sched_barrier(0)
    Unit cur, nxt; int ui = 0;
    if (!S.next(0, cur)) return;
    f32x4 acc[2][2][4][2];
#pragma unroll
    for (int a = 0; a < 2; ++a)
#pragma unroll
        for (int b = 0; b < 2; ++b)
#pragma unroll
            for (int m = 0; m < 4; ++m)
#pragma unroll
                for (int n = 0; n < 2; ++n) acc[a][b][m][n] = (f32x4){0.f, 0.f, 0.f, 0.f};
    bf16x8 At[4][2], B0[2][2], B1[2][2];
    unsigned vAc[2][2], vAn[2][2];
    S.a_offsets(cur, Rp, Cp, vAc);
    const char* cB = S.b_ptr(cur);
    PG8_STAGEB(PG8_SB(0, 0), cB); PG8_STAGEB(PG8_SB(0, 1), cB + hstep); PG8_STAGE(PG8_SA(0, 0), Abase, vAc[0]); PG8_STAGE(PG8_SA(0, 1), Abase, vAc[1]);
    if (wr == 1) PG8_BAR;
    PG8_WAIT_V(2); PG8_BAR;
    PG8_STAGEB(PG8_SB(1, 0), cB + kstep); PG8_STAGE(PG8_SA(1, 0), Abase + kstep, vAc[0]); PG8_STAGEB(PG8_SB(1, 1), cB + hstep + kstep);
    PG8_WAIT_V(6); PG8_BAR;
    for (;;) {
        const bool has_next = S.next(ui + 1, nxt);
        const char* nB = has_next ? S.b_ptr(nxt) : cB;
        if (has_next) S.a_offsets(nxt, Rp, Cp, vAn);
        else {
#pragma unroll
            for (int h = 0; h < 2; ++h)
#pragma unroll
                for (int i = 0; i < 2; ++i) vAn[h][i] = vAc[h][i]; }
        for (int t = 0; t < nt; t += 2) {
            const bool last = (t == nt - 2);
            const char* a1 = Abase + (size_t)(t + 1) * kstep;
            const char* a2 = last ? Abase : Abase + (size_t)(t + 2) * kstep; const char* b2 = last ? nB : cB + (size_t)(t + 2) * kstep;
            const char* a3 = a2 + kstep; const char* b3 = b2 + kstep;
            unsigned v2[2][2];
#pragma unroll
            for (int h = 0; h < 2; ++h)
#pragma unroll
                for (int i = 0; i < 2; ++i) v2[h][i] = last ? vAn[h][i] : vAc[h][i];
            PG8_LDB(B0, 0, 0); PG8_LDB(B1, 0, 1); PG8_SCHED; PG8_LDA(At, 0, 0); PG8_STAGE(PG8_SA(1, 1), a1, vAc[1]);
            PG8_WAIT_V(8); PG8_WAIT_L(0); PG8_BAR; PG8_MMA(0, 0, At, B0); PG8_MMA(0, 1, At, B1); PG8_BAR; PG8_SCHED;
            PG8_LDA(At, 0, 1); PG8_STAGEB(PG8_SB(0, 0), b2); PG8_STAGEB(PG8_SB(0, 1), b2 + hstep); PG8_STAGE(PG8_SA(0, 0), a2, v2[0]);
            PG8_WAIT_V(8); PG8_WAIT_L(0); PG8_BAR; PG8_MMA(1, 0, At, B0); PG8_MMA(1, 1, At, B1); PG8_BAR; PG8_SCHED;
            PG8_LDB(B0, 1, 0); PG8_LDB(B1, 1, 1); PG8_SCHED; PG8_LDA(At, 1, 0); PG8_STAGE(PG8_SA(0, 1), a2, v2[1]);
            PG8_WAIT_V(8); PG8_WAIT_L(0); PG8_BAR; PG8_MMA(0, 0, At, B0); PG8_MMA(0, 1, At, B1); PG8_BAR; PG8_SCHED;
            PG8_LDA(At, 1, 1); PG8_STAGEB(PG8_SB(1, 0), b3); PG8_STAGEB(PG8_SB(1, 1), b3 + hstep); PG8_STAGE(PG8_SA(1, 0), a3, v2[0]);
            PG8_WAIT_V(8); PG8_WAIT_L(0); PG8_BAR; PG8_MMA(1, 0, At, B0); PG8_MMA(1, 1, At, B1); PG8_BAR; PG8_SCHED;
        }
        if constexpr (ALIGN_EPI) { if (wr == 0) PG8_BAR; }
        E(acc, cur, wr, wc, fr, fq);
        if (!has_next) break;
#pragma unroll
        for (int a = 0; a < 2; ++a)
#pragma unroll
            for (int b = 0; b < 2; ++b)
#pragma unroll
                for (int m = 0; m < 4; ++m)
#pragma unroll
                    for (int n = 0; n < 2; ++n) acc[a][b][m][n] = (f32x4){0.f, 0.f, 0.f, 0.f};
        cur = nxt; cB = nB; ++ui;
#pragma unroll
        for (int h = 0; h < 2; ++h)
#pragma unroll
            for (int i = 0; i < 2; ++i) vAc[h][i] = vAn[h][i];
        if constexpr (ALIGN_EPI) { if (wr == 1) PG8_BAR; }
    }
    PG8_WAIT_V(0);
    if constexpr (!ALIGN_EPI) { if (wr == 0) PG8_BAR; }
    PG8_BAR;
#undef PG8_SA
#undef PG8_SB
#undef PG8_STAGE
#undef PG8_STAGEB
#undef PG8_LDA
#undef PG8_LDB
#undef PG8_MMA
#undef PG8_WAIT_V
#undef PG8_WAIT_L
#undef PG8_BAR
#undef PG8_SCHED
}
template <class Epi, class Sched, bool ALIGN_EPI>
__device__ __forceinline__ void gemm_phase_f8g(LAS unsigned char* lds, const char* Abase, const int K, const Sched& S, const Epi& E) {
    const int tid = tidx(), wid = __builtin_amdgcn_readfirstlane(tid >> 6), lane = tid & 63, wr = wid >> 2, wc = wid & 3, fr = lane & 15, fq = lane >> 4;
    const int nt = K / 128;
    int Rp[2], Cp[2]; unsigned voffB0;
#pragma unroll
    for (int i = 0; i < 2; ++i) stage_rc(tid * 16 + i * 8192, Rp[i], Cp[i]);
    { const int Rb = Epi::PERM ? ((Rp[0] & ~31) + perm32(Rp[0] & 31)) : Rp[0]; voffB0 = (unsigned)(Rb * K + 2 * Cp[0]); }
    const size_t kstep = (size_t)(BK * 2);
    const size_t hstep = (size_t)HALF * K;
    const unsigned ldsw = (unsigned)wid * 1024u;
    const int aoff0 = lds_byte(wr * 64 + fr, 16 * (fq & 1)) + (fq >> 1) * 1024, boff0 = lds_byte(wc * 32 + fr, 16 * (fq & 1)) + (fq >> 1) * 1024;
#define PG8_SA(b, h) (((b) * 2 + (h)) * HTB)
#define PG8_SB(b, h) ((4 + (b) * 2 + (h)) * HTB)
#define PG8_STAGE(bufoff, gbase, voff) do { _Pragma("unroll") for (int _i = 0; _i < 2; ++_i) \
        __builtin_amdgcn_global_load_lds((const unsigned*)((const char*)(gbase) + (voff)[_i]), (LAS unsigned*)(lds + (bufoff) + ldsw + _i * 8192), 16, 0, 0); } while (0)
#define PG8_STAGEB(bufoff, gbase) do { _Pragma("unroll") for (int _i = 0; _i < 2; ++_i) \
        __builtin_amdgcn_global_load_lds((const unsigned*)((const char*)(gbase) + (size_t)_i * 64 * K + voffB0), (LAS unsigned*)(lds + (bufoff) + ldsw + _i * 8192), 16, 0, 0); } while (0)
#define PG8_LDA(dst, b, h) do { _Pragma("unroll") for (int m = 0; m < 4; ++m) { const u32x4 lo_ = *(const LAS u32x4*)(lds + PG8_SA(b, h) + aoff0 + m * 2048), hi_ = *(const LAS u32x4*)(lds + PG8_SA(b, h) + aoff0 + 16 + m * 2048); \
        dst[m] = (v8i){(int)lo_.x, (int)lo_.y, (int)lo_.z, (int)lo_.w, (int)hi_.x, (int)hi_.y, (int)hi_.z, (int)hi_.w}; } } while (0)
#define PG8_LDB(dst, b, h) do { _Pragma("unroll") for (int n = 0; n < 2; ++n) { const u32x4 lo_ = *(const LAS u32x4*)(lds + PG8_SB(b, h) + boff0 + n * 2048), hi_ = *(const LAS u32x4*)(lds + PG8_SB(b, h) + boff0 + 16 + n * 2048); \
        dst[n] = (v8i){(int)lo_.x, (int)lo_.y, (int)lo_.z, (int)lo_.w, (int)hi_.x, (int)hi_.y, (int)hi_.z, (int)hi_.w}; } } while (0)
#define PG8_MMA(ai, bj, At, Bt) do { __builtin_amdgcn_s_setprio(1); _Pragma("unroll") for (int m = 0; m < 4; ++m) _Pragma("unroll") for (int n = 0; n < 2; ++n) \
        asm volatile("v_mfma_scale_f32_16x16x128_f8f6f4 %0, %1, %2, %0, %3, %3 op_sel_hi:[0,0,0]" : "+v"(acc[ai][bj][m][n]) : "v"(Bt[n]), "v"(At[m]), "v"(f8scale)); __builtin_amdgcn_s_setprio(0); } while (0)
#define PG8_WAIT_V(n) asm volatile("s_waitcnt vmcnt(" #n ")" ::: "memory")
#define PG8_WAIT_L(n) asm volatile("s_waitcnt lgkmcnt(" #n ")" ::: "memory")
#define PG8_BAR __builtin_amdgcn_s_barrier()
#define PG8_SCHED __builtin_amdgcn_sched_barrier(0)
    Unit cur, nxt; int ui = 0;
    if (!S.next(0, cur)) return;
    f32x4 acc[2][2][4][2];
#pragma unroll
    for (int a = 0; a < 2; ++a)
#pragma unroll
        for (int b = 0; b < 2; ++b)
#pragma unroll
            for (int m = 0; m < 4; ++m)
#pragma unroll
                for (int n = 0; n < 2; ++n) acc[a][b][m][n] = (f32x4){0.f, 0.f, 0.f, 0.f};
    typedef int v8i __attribute__((ext_vector_type(8)));
    v8i At[4], B0[2], B1[2];
    const int f8scale = 0x7f7f7f7f;
    unsigned vAc[2][2], vAn[2][2];
    S.a_offsets(cur, Rp, Cp, vAc);
    const char* cB = S.b_ptr(cur);
    PG8_STAGEB(PG8_SB(0, 0), cB); PG8_STAGEB(PG8_SB(0, 1), cB + hstep); PG8_STAGE(PG8_SA(0, 0), Abase, vAc[0]); PG8_STAGE(PG8_SA(0, 1), Abase, vAc[1]);
    if (wr == 1) PG8_BAR;
    PG8_WAIT_V(2); PG8_BAR;
    PG8_STAGEB(PG8_SB(1, 0), cB + kstep); PG8_STAGE(PG8_SA(1, 0), Abase + kstep, vAc[0]); PG8_STAGEB(PG8_SB(1, 1), cB + hstep + kstep);
    PG8_WAIT_V(6); PG8_BAR;
    for (;;) {
        const bool has_next = S.next(ui + 1, nxt);
        const char* nB = has_next ? S.b_ptr(nxt) : cB;
        if (has_next) S.a_offsets(nxt, Rp, Cp, vAn);
        else {
#pragma unroll
            for (int h = 0; h < 2; ++h)
#pragma unroll
                for (int i = 0; i < 2; ++i) vAn[h][i] = vAc[h][i]; }
#pragma unroll 1
        for (int t = 0; t < nt; t += 2) {
            const bool last = (t == nt - 2);
            const char* a1 = Abase + (size_t)(t + 1) * kstep;
            const char* a2 = last ? Abase : Abase + (size_t)(t + 2) * kstep; const char* b2 = last ? nB : cB + (size_t)(t + 2) * kstep;
            const char* a3 = a2 + kstep; const char* b3 = b2 + kstep;
            unsigned v2[2][2];
#pragma unroll
            for (int h = 0; h < 2; ++h)
#pragma unroll
                for (int i = 0; i < 2; ++i) v2[h][i] = last ? vAn[h][i] : vAc[h][i];
            PG8_LDB(B0, 0, 0); PG8_LDB(B1, 0, 1); PG8_SCHED; PG8_LDA(At, 0, 0); PG8_STAGE(PG8_SA(1, 1), a1, vAc[1]);
            PG8_WAIT_V(8); PG8_WAIT_L(0); PG8_BAR; PG8_MMA(0, 0, At, B0); PG8_MMA(0, 1, At, B1); PG8_BAR; PG8_SCHED;
            PG8_LDA(At, 0, 1); PG8_STAGEB(PG8_SB(0, 0), b2); PG8_STAGEB(PG8_SB(0, 1), b2 + hstep); PG8_STAGE(PG8_SA(0, 0), a2, v2[0]);
            PG8_WAIT_V(8); PG8_WAIT_L(0); PG8_BAR; PG8_MMA(1, 0, At, B0); PG8_MMA(1, 1, At, B1); PG8_BAR; PG8_SCHED;
            PG8_LDB(B0, 1, 0); PG8_LDB(B1, 1, 1); PG8_SCHED; PG8_LDA(At, 1, 0); PG8_STAGE(PG8_SA(0, 1), a2, v2[1]);
            PG8_WAIT_V(8); PG8_WAIT_L(0); PG8_BAR; PG8_MMA(0, 0, At, B0); PG8_MMA(0, 1, At, B1); PG8_BAR; PG8_SCHED;
            PG8_LDA(At, 1, 1); PG8_STAGEB(PG8_SB(1, 0), b3); PG8_STAGEB(PG8_SB(1, 1), b3 + hstep); PG8_STAGE(PG8_SA(1, 0), a3, v2[0]);
            PG8_WAIT_V(8); PG8_WAIT_L(0); PG8_BAR; PG8_MMA(1, 0, At, B0); PG8_MMA(1, 1, At, B1); PG8_BAR; PG8_SCHED;
        }
        if constexpr (ALIGN_EPI) { if (wr == 0) PG8_BAR; }
        E(acc, cur, wr, wc, fr, fq);
        if (!has_next) break;
#pragma unroll
        for (int a = 0; a < 2; ++a)
#pragma unroll
            for (int b = 0; b < 2; ++b)
#pragma unroll
                for (int m = 0; m < 4; ++m)
#pragma unroll
                    for (int n = 0; n < 2; ++n) acc[a][b][m][n] = (f32x4){0.f, 0.f, 0.f, 0.f};
        cur = nxt; cB = nB; ++ui;
#pragma unroll
        for (int h = 0; h < 2; ++h)
#pragma unroll
            for (int i = 0; i < 2; ++i) vAc[h][i] = vAn[h][i];
        if constexpr (ALIGN_EPI) { if (wr == 1) PG8_BAR; }
    }
    PG8_WAIT_V(0);
    if constexpr (!ALIGN_EPI) { if (wr == 0) PG8_BAR; }
    PG8_BAR;
#undef PG8_SA
#undef PG8_SB
#undef PG8_STAGE
#undef PG8_STAGEB
#undef PG8_LDA
#undef PG8_LDB
#undef PG8_MMA
#undef PG8_WAIT_V
#undef PG8_WAIT_L
#undef PG8_BAR
#undef PG8_SCHED
}
template <class Epi, class Sched, bool ALIGN_EPI>
__device__ __forceinline__ void gemm_phase_f8(LAS unsigned char* lds, const char* Abase, const int K, const Sched& S, const Epi& E) {
    const int tid = tidx(), wid = __builtin_amdgcn_readfirstlane(tid >> 6), lane = tid & 63, wr = wid >> 2, wc = wid & 3, fr = lane & 15, fq = lane >> 4;
    const int nt = K / 128;
    int Rp[1], Cp[1]; unsigned voffB[1], voffA[1];
#pragma unroll
    for (int i = 0; i < 1; ++i) { stage_rc(tid * 16 + i * 8192, Rp[i], Cp[i]); const int Rb = Epi::PERM ? ((Rp[i] & ~31) + perm32(Rp[i] & 31)) : Rp[i]; voffB[i] = (unsigned)(Rb * K + 2 * Cp[i]); voffA[i] = (unsigned)(Rp[i] * K + 2 * Cp[i]); }
    const size_t kstep = (size_t)(BK * 2);
    const size_t hstep = (size_t)HALF * K;
    const unsigned ldsw = (unsigned)wid * 1024u;
    const int aoff0 = lds_byte(wr * 64 + fr, 16 * (fq & 1)) + (fq >> 1) * 1024, boff0 = lds_byte(wc * 32 + fr, 16 * (fq & 1)) + (fq >> 1) * 1024;
#define PG8_SA(b, h) (((b) * 2 + (h)) * HTB)
#define PG8_SB(b, h) ((4 + (b) * 2 + (h)) * HTB)
#define PG8_STAGE(bufoff, gbase, voff) do { _Pragma("unroll") for (int _i = 0; _i < 2; ++_i) \
        __builtin_amdgcn_global_load_lds((const unsigned*)((const char*)(gbase) + (size_t)_i * 64 * K + (voff)[0]), (LAS unsigned*)(lds + (bufoff) + ldsw + _i * 8192), 16, 0, 0); } while (0)
#define PG8_LDA(dst, b, h) do { _Pragma("unroll") for (int m = 0; m < 4; ++m) { const u32x4 lo_ = *(const LAS u32x4*)(lds + PG8_SA(b, h) + aoff0 + m * 2048), hi_ = *(const LAS u32x4*)(lds + PG8_SA(b, h) + aoff0 + 16 + m * 2048); \
        dst[m] = (v8i){(int)lo_.x, (int)lo_.y, (int)lo_.z, (int)lo_.w, (int)hi_.x, (int)hi_.y, (int)hi_.z, (int)hi_.w}; } } while (0)
#define PG8_LDB(dst, b, h) do { _Pragma("unroll") for (int n = 0; n < 2; ++n) { const u32x4 lo_ = *(const LAS u32x4*)(lds + PG8_SB(b, h) + boff0 + n * 2048), hi_ = *(const LAS u32x4*)(lds + PG8_SB(b, h) + boff0 + 16 + n * 2048); \
        dst[n] = (v8i){(int)lo_.x, (int)lo_.y, (int)lo_.z, (int)lo_.w, (int)hi_.x, (int)hi_.y, (int)hi_.z, (int)hi_.w}; } } while (0)
#define PG8_MMA(ai, bj, At, Bt) do { __builtin_amdgcn_s_setprio(1); _Pragma("unroll") for (int m = 0; m < 4; ++m) _Pragma("unroll") for (int n = 0; n < 2; ++n) \
        asm volatile("v_mfma_scale_f32_16x16x128_f8f6f4 %0, %1, %2, %0, %3, %3 op_sel_hi:[0,0,0]" : "+v"(acc[ai][bj][m][n]) : "v"(Bt[n]), "v"(At[m]), "v"(f8scale)); __builtin_amdgcn_s_setprio(0); } while (0)
#define PG8_WAIT_V(n) asm volatile("s_waitcnt vmcnt(" #n ")" ::: "memory")
#define PG8_WAIT_L(n) asm volatile("s_waitcnt lgkmcnt(" #n ")" ::: "memory")
#define PG8_BAR __builtin_amdgcn_s_barrier()
#define PG8_SCHED __builtin_amdgcn_sched_barrier(0)
    Unit cur, nxt; int ui = 0;
    if (!S.next(0, cur)) return;
    f32x4 acc[2][2][4][2];
#pragma unroll
    for (int a = 0; a < 2; ++a)
#pragma unroll
        for (int b = 0; b < 2; ++b)
#pragma unroll
            for (int m = 0; m < 4; ++m)
#pragma unroll
                for (int n = 0; n < 2; ++n) acc[a][b][m][n] = (f32x4){0.f, 0.f, 0.f, 0.f};
    typedef int v8i __attribute__((ext_vector_type(8)));
    v8i At[4], B0[2], B1[2];
    const int f8scale = 0x7f7f7f7f;
    const char* cA = S.a_ptr(cur, Abase);
    const char* cB = S.b_ptr(cur);
    PG8_STAGE(PG8_SB(0, 0), cB, voffB); PG8_STAGE(PG8_SB(0, 1), cB + hstep, voffB); PG8_STAGE(PG8_SA(0, 0), cA, voffA); PG8_STAGE(PG8_SA(0, 1), cA + hstep, voffA);
    if (wr == 1) PG8_BAR;
    PG8_WAIT_V(2); PG8_BAR;
    PG8_STAGE(PG8_SB(1, 0), cB + kstep, voffB); PG8_STAGE(PG8_SA(1, 0), cA + kstep, voffA); PG8_STAGE(PG8_SB(1, 1), cB + hstep + kstep, voffB);
    PG8_WAIT_V(6); PG8_BAR;
    for (;;) {
        const bool has_next = S.next(ui + 1, nxt);
        const char* nB = has_next ? S.b_ptr(nxt) : cB; const char* nA = has_next ? S.a_ptr(nxt, Abase) : cA;
#pragma unroll 1
        for (int t = 0; t < nt; t += 2) {
            const bool last = (t == nt - 2);
            const char* a1 = cA + (size_t)(t + 1) * kstep;
            const char* a2 = last ? nA : cA + (size_t)(t + 2) * kstep; const char* b2 = last ? nB : cB + (size_t)(t + 2) * kstep;
            const char* a3 = a2 + kstep; const char* b3 = b2 + kstep;
            PG8_LDB(B0, 0, 0); PG8_LDB(B1, 0, 1); PG8_SCHED; PG8_LDA(At, 0, 0); PG8_STAGE(PG8_SA(1, 1), a1 + hstep, voffA);
            PG8_WAIT_V(8); PG8_WAIT_L(0); PG8_BAR; PG8_MMA(0, 0, At, B0); PG8_MMA(0, 1, At, B1); PG8_BAR; PG8_SCHED;
            PG8_LDA(At, 0, 1); PG8_STAGE(PG8_SB(0, 0), b2, voffB); PG8_STAGE(PG8_SB(0, 1), b2 + hstep, voffB); PG8_STAGE(PG8_SA(0, 0), a2, voffA);
            PG8_WAIT_V(8); PG8_WAIT_L(0); PG8_BAR; PG8_MMA(1, 0, At, B0); PG8_MMA(1, 1, At, B1); PG8_BAR; PG8_SCHED;
            PG8_LDB(B0, 1, 0); PG8_LDB(B1, 1, 1); PG8_SCHED; PG8_LDA(At, 1, 0); PG8_STAGE(PG8_SA(0, 1), a2 + hstep, voffA);
            PG8_WAIT_V(8); PG8_WAIT_L(0); PG8_BAR; PG8_MMA(0, 0, At, B0); PG8_MMA(0, 1, At, B1); PG8_BAR; PG8_SCHED;
            PG8_LDA(At, 1, 1); PG8_STAGE(PG8_SB(1, 0), b3, voffB); PG8_STAGE(PG8_SB(1, 1), b3 + hstep, voffB); PG8_STAGE(PG8_SA(1, 0), a3, voffA);
            PG8_WAIT_V(8); PG8_WAIT_L(0); PG8_BAR; PG8_MMA(1, 0, At, B0); PG8_MMA(1, 1, At, B1); PG8_BAR; PG8_SCHED;
        }
        if constexpr (ALIGN_EPI) { if (wr == 0) PG8_BAR; }
        E(acc, cur, wr, wc, fr, fq);
        if (!has_next) break;
#pragma unroll
        for (int a = 0; a < 2; ++a)
#pragma unroll
            for (int b = 0; b < 2; ++b)
#pragma unroll
                for (int m = 0; m < 4; ++m)
#pragma unroll
                    for (int n = 0; n < 2; ++n) acc[a][b][m][n] = (f32x4){0.f, 0.f, 0.f, 0.f};
        cur = nxt; cB = nB; cA = nA; ++ui;
        if constexpr (ALIGN_EPI) { if (wr == 1) PG8_BAR; }
    }
    PG8_WAIT_V(0);
    if constexpr (!ALIGN_EPI) { if (wr == 0) PG8_BAR; }
    PG8_BAR;
#undef PG8_SA
#undef PG8_SB
#undef PG8_STAGE
#undef PG8_LDA
#undef PG8_LDB
#undef PG8_MMA
#undef PG8_WAIT_V
#undef PG8_WAIT_L
#undef PG8_BAR
#undef PG8_SCHED
}
}

struct Args { const float* in[39]; float* out; unsigned char* ws; int ph_lo, ph_hi; };
typedef const __attribute__((address_space(4))) Args CArgs;
enum { I_X = 0, I_C, I_CTX, I_CCTX, I_WADA, I_BADA, I_WIN, I_HYCW, I_HYCB, I_HYW1, I_HYB1, I_HYW2, I_HYB2, I_HYW3, I_HYB3, I_HYW4, I_HYFREQ, I_HYD, I_SCCW,
       I_GLAWA, I_GLABA, I_GLANW, I_GDNCW, I_GDNALOG, I_GDNDT, I_GDNNW, I_WOUT, I_LN1G, I_LN1B, I_WR, I_BR, I_WG, I_BG, I_WU, I_BU, I_WD, I_BD, I_LN2G, I_LN2B };

__device__ __forceinline__ int row_batch(int row) { return row < NTOK_C ? (row >> 8) : ((row - NTOK_C) >> 11); }
__device__ __forceinline__ int mod_vec(int row) { return row < NTOK_C ? 16 : ((row - NTOK_C) >> 11); }

__device__ __forceinline__ void ph_mod(CArgs& a, LAS unsigned char* lds, int bid, int nblk) {
    LAS float* sc = (LAS float*)lds; LAS float* red = (LAS float*)(lds + 17 * 1024 * 4);
    const int tid = tidx(), lane = tid & 63, w = tid >> 6;
    const float* c = a.in[I_C]; const float* cc = a.in[I_CCTX];
    for (int i = tid; i < 17 * 1024; i += 512) { const float v = i < 16 * 1024 ? c[i] : cc[i - 16 * 1024]; sc[i] = siluf_(v); }
    __syncthreads();
    float* MOD = (float*)(a.ws + WS_MOD);
    for (int it = bid; it < DEPTH * 96; it += nblk) {
        const int l = it / 96, j0 = (it % 96) * 64;
        const float* W = a.in[I_WADA] + (size_t)l * 1024 * 6144 + j0 + lane;
        float acc[17];
#pragma unroll
        for (int v = 0; v < 17; ++v) acc[v] = 0.f;
#pragma unroll 16
        for (int kk = 0; kk < 128; ++kk) { const int k = w * 128 + kk; const float wv = W[(size_t)k * 6144];
#pragma unroll
            for (int v = 0; v < 17; ++v) acc[v] += sc[v * 1024 + k] * wv; }
#pragma unroll
        for (int v = 0; v < 17; ++v) red[(w * 17 + v) * 64 + lane] = acc[v];
        __syncthreads();
        for (int o = tid; o < 17 * 64; o += 512) { const int v = o >> 6, jj = o & 63; float s = 0.f;
#pragma unroll
            for (int ww = 0; ww < 8; ++ww) s += red[(ww * 17 + v) * 64 + jj];
            MOD[(size_t)(l * 17 + v) * 6144 + j0 + jj] = s + a.in[I_BADA][l * 6144 + j0 + jj]; }
        __syncthreads();
    }
}

__device__ __forceinline__ void ph_filters(CArgs& a, int gw, int ngw) {
    const int lane = tidx() & 63;
    float* KUN = (float*)(a.ws + WS_KUN);
#pragma unroll 1
    for (int it = gw; it < DEPTH * (CTXL + SEQ) / 4; it += ngw) {
        const int l = it / ((CTXL + SEQ) / 4), r = (it % ((CTXL + SEQ) / 4)) * 4, Lt = r < CTXL ? 0 : 1, pos0 = Lt ? r - CTXL : r, L = Lt ? SEQ : CTXL;
        float z[4], tn[4];
#pragma unroll
        for (int p = 0; p < 4; ++p) { const int pos = pos0 + p; tn[p] = (float)pos / (float)(L - 1); z[p] = 0.f;
            if (lane == 0) z[p] = tn[p];
            else if (lane <= 32) { const int j = (lane - 1) & 15; const float fj = 1e-4f + (float)j * ((15.f - 1e-4f) / 15.f);
                double rev = (double)fj * (double)pos / (double)L; rev -= floor(rev); const float rf = (float)rev;
                z[p] = lane <= 16 ? sin_rev(rf + 0.25f) : -sin_rev(rf); } }
        const float* w1 = a.in[I_HYW1] + l * 33 * 64; const float* w2 = a.in[I_HYW2] + l * 64 * 64; const float* w3 = a.in[I_HYW3] + l * 64 * 64; const float* w4 = a.in[I_HYW4] + l * 64 * 512;
        const float* fq = a.in[I_HYFREQ] + l * 3 * 64;
        float s[4], h[4];
        { const float bb = a.in[I_HYB1][l * 64 + lane];
#pragma unroll
          for (int p = 0; p < 4; ++p) s[p] = bb; }
#pragma unroll
        for (int i = 0; i < 33; ++i) { const float ww = w1[i * 64 + lane];
#pragma unroll
            for (int p = 0; p < 4; ++p) s[p] += rdlane_f(z[p], i) * ww; }
#pragma unroll
        for (int p = 0; p < 4; ++p) h[p] = sin_rad(fq[lane] * s[p]);
        { const float bb = a.in[I_HYB2][l * 64 + lane];
#pragma unroll
          for (int p = 0; p < 4; ++p) s[p] = bb; }
#pragma unroll 16
        for (int i = 0; i < 64; ++i) { const float ww = w2[i * 64 + lane];
#pragma unroll
            for (int p = 0; p < 4; ++p) s[p] += rdlane_f(h[p], i) * ww; }
#pragma unroll
        for (int p = 0; p < 4; ++p) h[p] = sin_rad(fq[64 + lane] * s[p]);
        { const float bb = a.in[I_HYB3][l * 64 + lane];
#pragma unroll
          for (int p = 0; p < 4; ++p) s[p] = bb; }
#pragma unroll 16
        for (int i = 0; i < 64; ++i) { const float ww = w3[i * 64 + lane];
#pragma unroll
            for (int p = 0; p < 4; ++p) s[p] += rdlane_f(h[p], i) * ww; }
#pragma unroll
        for (int p = 0; p < 4; ++p) h[p] = sin_rad(fq[128 + lane] * s[p]);
        float k[8][4];
#pragma unroll
        for (int m = 0; m < 8; ++m)
#pragma unroll
            for (int p = 0; p < 4; ++p) k[m][p] = 0.f;
#pragma unroll 4
        for (int i = 0; i < 64; ++i) { float hi[4];
#pragma unroll
            for (int p = 0; p < 4; ++p) hi[p] = rdlane_f(h[p], i);
#pragma unroll
            for (int m = 0; m < 8; ++m) { const float ww = w4[i * 512 + m * 64 + lane];
#pragma unroll
                for (int p = 0; p < 4; ++p) k[m][p] += hi[p] * ww; } }
#pragma unroll
        for (int m = 0; m < 8; ++m) { const int o = m * 64 + lane, ch = o & 255;
            const float delta = 3.0701134573253944f + (float)ch * ((15.350567286626972f - 3.0701134573253944f) / 255.f);
            *(f32x4*)(KUN + ((size_t)((l * 2 + Lt) * 512 + o)) * 2048 + pos0) = (f32x4){k[m][0] * __expf(-tn[0] * delta), k[m][1] * __expf(-tn[1] * delta), k[m][2] * __expf(-tn[2] * delta), k[m][3] * __expf(-tn[3] * delta)}; }
    }
}

__device__ __forceinline__ void ph_router_w(CArgs& a, int gt, int ngt) {
    bf16* hi = (bf16*)(a.ws + WS_WRT); bf16* lo = hi + DEPTH * NEXP * D;
    for (int i = gt; i < DEPTH * NEXP * D; i += ngt) { const int l = i / (NEXP * D), r = i % (NEXP * D), e = r / D, k = r % D;
        const float w = a.in[I_WR][((size_t)l * D + k) * NEXP + e]; const unsigned h = f2bf(w); hi[i] = (bf16)h; lo[i] = (bf16)f2bf(w - bf2f(h)); }
}
__device__ __forceinline__ void tr_item(const float* W, int Nsrc, int K, bf16* WTrow0, int n0, int k0, LAS float* scr, int lane) {
    const int c4 = (lane & 7) * 4; const bool ok = n0 + c4 < Nsrc;
    f32x4 t[8];
#pragma unroll
    for (int j = 0; j < 8; ++j) { const int kk = 8 * j + (lane >> 3); t[j] = ok ? *(const f32x4*)(W + (size_t)(k0 + kk) * Nsrc + n0 + c4) : (f32x4){0.f, 0.f, 0.f, 0.f}; }
#pragma unroll
    for (int j = 0; j < 8; ++j) { const int kk = 8 * j + (lane >> 3); LAS float* d = scr + kk * 33 + c4; d[0] = t[j][0]; d[1] = t[j][1]; d[2] = t[j][2]; d[3] = t[j][3]; }
    asm volatile("s_waitcnt lgkmcnt(0)" ::: "memory");
    const int c = lane & 7;
#pragma unroll
    for (int j = 0; j < 4; ++j) { const int n = (lane >> 3) + 8 * j; const LAS float* s = scr + (8 * c) * 33 + n;
        u32x4 o; o.x = pk2(s[0 * 33], s[1 * 33]); o.y = pk2(s[2 * 33], s[3 * 33]); o.z = pk2(s[4 * 33], s[5 * 33]); o.w = pk2(s[6 * 33], s[7 * 33]);
        *(u32x4*)(WTrow0 + (size_t)n * K + k0 + 8 * c) = o; }
    asm volatile("s_waitcnt lgkmcnt(0)" ::: "memory");
}
__device__ __forceinline__ void tr_item_f8(const float* W, int Nsrc, int K, unsigned char* WTrow0, int n0, int k0, float scale, LAS float* scr, int lane) {
    const int c4 = (lane & 7) * 4;
    f32x4 t[8];
#pragma unroll
    for (int j = 0; j < 8; ++j) { const int kk = 8 * j + (lane >> 3); t[j] = *(const f32x4*)(W + (size_t)(k0 + kk) * Nsrc + n0 + c4); }
#pragma unroll
    for (int j = 0; j < 8; ++j) { const int kk = 8 * j + (lane >> 3); LAS float* d = scr + kk * 33 + c4; d[0] = t[j][0]; d[1] = t[j][1]; d[2] = t[j][2]; d[3] = t[j][3]; }
    asm volatile("s_waitcnt lgkmcnt(0)" ::: "memory");
    const int n = lane >> 1, half = lane & 1; const LAS float* s = scr + (32 * half) * 33 + n;
    unsigned o[8];
#pragma unroll
    for (int i = 0; i < 8; ++i) o[i] = pk4_fp8(s[(4 * i) * 33] * scale, s[(4 * i + 1) * 33] * scale, s[(4 * i + 2) * 33] * scale, s[(4 * i + 3) * 33] * scale);
    unsigned char* dst = WTrow0 + (size_t)n * K + k0 + 32 * half;
    *(u32x4*)dst = (u32x4){o[0], o[1], o[2], o[3]}; *(u32x4*)(dst + 16) = (u32x4){o[4], o[5], o[6], o[7]};
    asm volatile("s_waitcnt lgkmcnt(0)" ::: "memory");
}
__device__ __forceinline__ void ph_tr_small(CArgs& a, LAS unsigned char* lds, int gw, int ngw) {
    const int lane = tidx() & 63, w = tidx() >> 6;
    LAS float* scr = (LAS float*)(lds + w * 8448);
    constexpr int I_IN = 16 * (D_INP / 32), I_OUT = 16 * 32;
    for (int it = gw; it < DEPTH * (I_IN + I_OUT); it += ngw) {
        const int l = it / (I_IN + I_OUT); int r = it % (I_IN + I_OUT);
        if (r < I_IN) { const int kb = r / (D_INP / 32), nb = r % (D_INP / 32);
            tr_item(a.in[I_WIN] + (size_t)l * 1024 * D_IN, D_IN, 1024, (bf16*)(a.ws + WS_WIN) + ((size_t)l * D_INP + nb * 32) * 1024, nb * 32, kb * 64, scr, lane); }
        else { r -= I_IN; const int kb = r / 32, nb = r % 32;
            tr_item(a.in[I_WOUT] + (size_t)l * 1024 * 1024, 1024, 1024, (bf16*)(a.ws + WS_WOUT) + ((size_t)l * 1024 + nb * 32) * 1024, nb * 32, kb * 64, scr, lane); }
    }
}
__device__ __forceinline__ void tr_experts_range(CArgs& a, int l, LAS unsigned char* scrb, int first, int last, int stride, int lane) {
    LAS float* scr = (LAS float*)scrb;
#pragma unroll 1
    for (int it = first; it < last; it += stride) {
        const int e = it / 1536, r = it % 1536, which = r / 512, q = r % 512, kb = q / 32, nb = q % 32, n0 = nb * 32;
        const float* W = a.in[which == 0 ? I_WG : (which == 1 ? I_WU : I_WD)] + ((size_t)(l * NEXP + e)) * 1024 * 1024;
        if (which == 2) tr_item_f8(W, 1024, 1024, a.ws + WS_WD + ((size_t)e * 1024 + n0) * 1024, n0, kb * 64, 32.f, scr, lane);
        else tr_item_f8(W, 1024, 1024, a.ws + WS_WGU + ((size_t)e * 2048 + (n0 >> 7) * 256 + which * 128 + (n0 & 127)) * 1024, n0, kb * 64, 32.f, scr, lane);
    }
}
__device__ __forceinline__ void ph_mod_input(CArgs& a, int gw, int ngw) {
    const int lane = tidx() & 63;
    const float* MOD = (const float*)(a.ws + WS_MOD);
    bf16* HB = (bf16*)(a.ws + WS_HB);
    for (int row = gw; row < NTOK; row += ngw) {
        const float* src = row < NTOK_C ? a.in[I_CTX] + (size_t)row * D : a.in[I_X] + (size_t)(row - NTOK_C) * D;
        const float* mv = MOD + (size_t)mod_vec(row) * 6144;
#pragma unroll
        for (int j = 0; j < 4; ++j) { const int c0 = j * 256 + lane * 4; const f32x4 x = *(const f32x4*)(src + c0), sh = *(const f32x4*)(mv + c0), sc = *(const f32x4*)(mv + 1024 + c0);
            u32x2 o; o.x = pk2(x[0] * (1.f + sc[0]) + sh[0], x[1] * (1.f + sc[1]) + sh[1]); o.y = pk2(x[2] * (1.f + sc[2]) + sh[2], x[3] * (1.f + sc[3]) + sh[3]);
            *(u32x2*)(HB + (size_t)row * D + c0) = o; }
    }
}

struct Chunk { int b, t0, L, row0, lo, hi; };
__device__ __forceinline__ Chunk chunk_of(int it) {
    Chunk c;
    if (it < 64) { c.b = it >> 2; c.t0 = (it & 3) * 64; c.L = CTXL; c.row0 = c.b * CTXL + c.t0; c.lo = 0; c.hi = CTXL; }
    else { const int r = it - 64; c.b = r >> 5; c.t0 = (r & 31) * 64; c.L = SEQ; c.row0 = NTOK_C + c.b * SEQ + c.t0; c.lo = c.t0; c.hi = c.t0 + 64; }
    return c;
}
__device__ __forceinline__ f32x4 bf4(u32x2 v) { return (f32x4){lo_bf(v.x), hi_bf(v.x), lo_bf(v.y), hi_bf(v.y)}; }
__device__ __forceinline__ void ph_prep_conv(CArgs& a, int l, LAS unsigned char* lds, int bid, int nblk) {
    const bf16* P = (const bf16*)(a.ws + WS_P);
    bf16* ZT = (bf16*)(a.ws + WS_MIX + MX_ZT); bf16* YMIX = (bf16*)(a.ws + WS_YMIX);
    LAS bf16* zt = (LAS bf16*)lds;
    const int tid = tidx(), c4 = (tid & 63) * 4, tg = tid >> 6;
    const float* hw = a.in[I_HYCW] + l * 3 * 768; const float* hb = a.in[I_HYCB] + l * 768; const float* sw = a.in[I_SCCW] + l * 3 * 256;
    f32x4 wx[3], wv[3], ws3[3];
#pragma unroll
    for (int k = 0; k < 3; ++k) { wx[k] = *(const f32x4*)(hw + k * 768 + 256 + c4); wv[k] = *(const f32x4*)(hw + k * 768 + 512 + c4); ws3[k] = *(const f32x4*)(sw + k * 256 + c4); }
    const f32x4 bx = *(const f32x4*)(hb + 256 + c4), bv = *(const f32x4*)(hb + 512 + c4);
#pragma unroll 1
    for (int it = bid; it < 576; it += nblk) {
        const Chunk c = chunk_of(it);
        const int tb = c.t0 + tg * 8;
        const bf16* pb = P + (size_t)(c.row0 + tg * 8) * D_INP;
        f32x4 x1[10], vv[10], mm[10];
#pragma unroll
        for (int r = 0; r < 10; ++r) { const int t = tb + r - 1; const bool ok = t >= c.lo && t < c.hi; const bf16* p = pb + (ptrdiff_t)(r - 1) * D_INP;
            x1[r] = ok ? bf4(*(const u32x2*)(p + HY0 + 256 + c4)) : (f32x4){0.f, 0.f, 0.f, 0.f}; vv[r] = ok ? bf4(*(const u32x2*)(p + HY0 + 512 + c4)) : (f32x4){0.f, 0.f, 0.f, 0.f};
            mm[r] = ok ? bf4(*(const u32x2*)(p + SC0 + 256 + c4)) * bf4(*(const u32x2*)(p + SC0 + 512 + c4)) : (f32x4){0.f, 0.f, 0.f, 0.f}; }
#pragma unroll
        for (int tt = 0; tt < 8; ++tt) {
            const f32x4 xx = wx[0] * x1[tt] + wx[1] * x1[tt + 1] + wx[2] * x1[tt + 2] + bx, v2 = wv[0] * vv[tt] + wv[1] * vv[tt + 1] + wv[2] * vv[tt + 2] + bv, z = xx * v2;
            u32x2 zo; zo.x = pk2(z[0], z[1]); zo.y = pk2(z[2], z[3]); *(LAS u32x2*)(zt + (tg * 8 + tt) * 264 + c4) = zo;
            const f32x4 bg = bf4(*(const u32x2*)(pb + (size_t)tt * D_INP + SC0 + c4));
            const f32x4 y = bg * (ws3[0] * mm[tt] + ws3[1] * mm[tt + 1] + ws3[2] * mm[tt + 2]);
            u32x2 yo; yo.x = pk2(y[0], y[1]); yo.y = pk2(y[2], y[3]); *(u32x2*)(YMIX + (size_t)(c.row0 + tg * 8 + tt) * D + 256 + c4) = yo;
        }
        __syncthreads();
        { const int ch = tid & 255, g0 = (tid >> 8) * 4;
          const int soff = c.L == CTXL ? 0 : CTXL;
#pragma unroll
          for (int g = 0; g < 4; ++g) { const int t8 = (g0 + g) * 8; unsigned short e[8];
#pragma unroll
              for (int j = 0; j < 8; ++j) e[j] = zt[(t8 + j) * 264 + ch];
              u32x4 o; o.x = e[0] | ((unsigned)e[1] << 16); o.y = e[2] | ((unsigned)e[3] << 16); o.z = e[4] | ((unsigned)e[5] << 16); o.w = e[6] | ((unsigned)e[7] << 16);
              *(u32x4*)(ZT + ((size_t)(ch * 16 + c.b)) * 2304 + soff + c.t0 + t8) = o; } }
        __syncthreads();
    }
}
__device__ __forceinline__ void ph_prep_tok(CArgs& a, int l, int gw, int ngw) {
    const int lane = tidx() & 63;
    const bf16* P = (const bf16*)(a.ws + WS_P);
    float* GDF = (float*)(a.ws + WS_MIX + MX_GDF); float* GDB = (float*)(a.ws + WS_MIX + MX_GDB);
    float* DQ = (float*)(a.ws + WS_MIX + MX_DQ); float* DK = (float*)(a.ws + WS_MIX + MX_DK); float* DV = (float*)(a.ws + WS_MIX + MX_DV); float* DG = (float*)(a.ws + WS_MIX + MX_DG);
    const float* wa = a.in[I_GLAWA] + l * 2 * 16 * 128; const float* ba = a.in[I_GLABA] + l * 2 * 128;
    const float* cw = a.in[I_GDNCW] + l * 3 * 768;
#pragma unroll 1
    for (int row0 = gw * 4; row0 < NTOK; row0 += ngw * 4) {
        { int z = 0; asm volatile("" : "+v"(z)); wa += z; cw += z; }
        const bf16* pr0 = P + (size_t)row0 * D_INP;
        float av[4], s[4][4];
#pragma unroll
        for (int r = 0; r < 4; ++r) { av[r] = lane < 32 ? bf2f(pr0[(size_t)r * D_INP + GLA0 + 768 + lane]) : 0.f; s[r][0] = ba[lane]; s[r][1] = ba[64 + lane]; s[r][2] = ba[128 + lane]; s[r][3] = ba[192 + lane]; }
#pragma unroll
        for (int i = 0; i < 16; ++i) { const float w0 = wa[i * 128 + lane], w1 = wa[i * 128 + 64 + lane], w2 = wa[2048 + i * 128 + lane], w3 = wa[2048 + i * 128 + 64 + lane];
#pragma unroll
            for (int r = 0; r < 4; ++r) { const float af = rdlane_f(av[r], i), ab = rdlane_f(av[r], 16 + i); s[r][0] += af * w0; s[r][1] += af * w1; s[r][2] += ab * w2; s[r][3] += ab * w3; } }
#pragma unroll
        for (int r = 0; r < 4; ++r) { const size_t o = (size_t)(row0 + r) * 128;
            GDF[o + lane] = logsigmoidf_(s[r][0]) * 0.0625f; GDF[o + 64 + lane] = logsigmoidf_(s[r][1]) * 0.0625f;
            GDB[o + lane] = logsigmoidf_(s[r][2]) * 0.0625f; GDB[o + 64 + lane] = logsigmoidf_(s[r][3]) * 0.0625f; }
        int tpos, lo, hi;
        if (row0 < NTOK_C) { tpos = row0 & 255; lo = 0; hi = CTXL; } else { tpos = (row0 - NTOK_C) & 2047; lo = tpos & ~63; hi = lo + 64; }
        float sq[4] = {0.f, 0.f, 0.f, 0.f}, sk[4] = {0.f, 0.f, 0.f, 0.f}; f32x4 qv[4], kv[4];
#pragma unroll
        for (int g = 0; g < 3; ++g) { const int col = g * 256 + 4 * lane; const bf16* p = pr0 + GDN0 + col;
            f32x4 x[6];
#pragma unroll
            for (int r = 0; r < 6; ++r) { const int t = tpos + r - 1; x[r] = (t >= lo && t < hi) ? bf4(*(const u32x2*)(p + (ptrdiff_t)(r - 1) * D_INP)) : (f32x4){0.f, 0.f, 0.f, 0.f}; }
            const f32x4 w0 = *(const f32x4*)(cw + col), w1 = *(const f32x4*)(cw + 768 + col), w2 = *(const f32x4*)(cw + 1536 + col);
#pragma unroll
            for (int r = 0; r < 4; ++r) { f32x4 y = w0 * x[r] + w1 * x[r + 1] + w2 * x[r + 2];
                y[0] = siluf_(y[0]); y[1] = siluf_(y[1]); y[2] = siluf_(y[2]); y[3] = siluf_(y[3]);
                if (g == 0) { qv[r] = y; sq[r] = (y[0] * y[0] + y[1] * y[1]) + (y[2] * y[2] + y[3] * y[3]); }
                else if (g == 1) { kv[r] = y; sk[r] = (y[0] * y[0] + y[1] * y[1]) + (y[2] * y[2] + y[3] * y[3]); }
                else *(f32x4*)(DV + (size_t)(row0 + r) * 256 + 4 * lane) = y; } }
#pragma unroll
        for (int r = 0; r < 4; ++r) { const float rq = rsqrtf(row16_sum(sq[r]) + 1e-6f) * 0.125f, rk = rsqrtf(row16_sum(sk[r]) + 1e-6f);
            const f32x4 qn = qv[r] * rq, kn = kv[r] * rk;
            *(f32x4*)(DQ + (size_t)(row0 + r) * 256 + 4 * lane) = qn; *(f32x4*)(DK + (size_t)(row0 + r) * 256 + 4 * lane) = kn;
            *(u32x2*)((bf16*)(a.ws + WS_CKD + CD_QB) + (size_t)(row0 + r) * 256 + 4 * lane) = (u32x2){pk2(qn[0], qn[1]), pk2(qn[2], qn[3])};
            *(u32x2*)((bf16*)(a.ws + WS_CKD + CD_KB) + (size_t)(row0 + r) * 256 + 4 * lane) = (u32x2){pk2(kn[0], kn[1]), pk2(kn[2], kn[3])}; }
        if (lane < 16) { const int h = lane & 3, r = lane >> 2; const bf16* pr = pr0 + (size_t)r * D_INP;
            const float af = bf2f(pr[GDN0 + 1024 + h]), ab = bf2f(pr[GDN0 + 1028 + h]), bfv = bf2f(pr[GDN0 + 1032 + h]), bbv = bf2f(pr[GDN0 + 1036 + h]);
            const float* al = a.in[I_GDNALOG] + l * 8; const float* dt = a.in[I_GDNDT] + l * 8;
            const float gf = -__expf(al[h]) * softplusf_(af + dt[h]), gb = -__expf(al[4 + h]) * softplusf_(ab + dt[4 + h]);
            *(f32x4*)(DG + (size_t)(row0 + r) * 16 + 4 * h) = (f32x4){sigmoidf_(bfv), gf, sigmoidf_(bbv), gb}; }
    }
}

__device__ __forceinline__ int scan_row(int b, int dir, int n) {
    if (n < CTXL) return b * CTXL + (dir ? CTXL - 1 - n : n);
    const int m = n - CTXL; return NTOK_C + b * SEQ + (dir ? SEQ - 1 - m : m);
}
__device__ __forceinline__ void gla_chain(CArgs& a, int chain, LAS unsigned char* lds) {
    const int b = chain >> 3, h = (chain >> 1) & 3, dir = chain & 1;
    const int tid = tidx(), lane = tid & 63, w = tid >> 6, vv = lane & 7, kq = lane >> 3;
    const bf16* P = (const bf16*)(a.ws + WS_P);
    const float* GD = (const float*)(a.ws + WS_MIX + (dir ? MX_GDB : MX_GDF));
    float* GO = (float*)(a.ws + WS_MIX + (dir ? MX_GOB : MX_GOF));
    LAS float* sq = (LAS float*)lds;
    LAS float* sk = sq + 64 * 32;
    LAS float* sd = sk + 64 * 32;
    LAS float* sv = sd + 64 * 32;
    float S[4] = {0.f, 0.f, 0.f, 0.f};
    for (int ch = 0; ch < 36; ++ch) {
        { const int tt = tid >> 3, sub = tid & 7, row = scan_row(b, dir, ch * 64 + tt);
          const bf16* pr = P + (size_t)row * D_INP + GLA0;
          const u32x2 qv = *(const u32x2*)(pr + h * 32 + sub * 4), kv = *(const u32x2*)(pr + 128 + h * 32 + sub * 4);
          const f32x4 dv = *(const f32x4*)(GD + (size_t)row * 128 + h * 32 + sub * 4);
          const u32x4 vv8 = *(const u32x4*)(pr + 256 + h * 64 + sub * 8);
          const float qs = 0.17677669529663687f;
          *(LAS f32x4*)(sq + tt * 32 + sub * 4) = (f32x4){lo_bf(qv.x) * qs, hi_bf(qv.x) * qs, lo_bf(qv.y) * qs, hi_bf(qv.y) * qs};
          *(LAS f32x4*)(sk + tt * 32 + sub * 4) = (f32x4){lo_bf(kv.x), hi_bf(kv.x), lo_bf(kv.y), hi_bf(kv.y)};
          *(LAS f32x4*)(sd + tt * 32 + sub * 4) = dv;
          *(LAS f32x4*)(sv + tt * 64 + sub * 8) = (f32x4){lo_bf(vv8.x), hi_bf(vv8.x), lo_bf(vv8.y), hi_bf(vv8.y)};
          *(LAS f32x4*)(sv + tt * 64 + sub * 8 + 4) = (f32x4){lo_bf(vv8.z), hi_bf(vv8.z), lo_bf(vv8.w), hi_bf(vv8.w)}; }
        __syncthreads();
#pragma unroll 4
        for (int tt = 0; tt < 64; ++tt) {
            const f32x4 q4 = *(const LAS f32x4*)(sq + tt * 32 + kq * 4), k4 = *(const LAS f32x4*)(sk + tt * 32 + kq * 4), d4 = *(const LAS f32x4*)(sd + tt * 32 + kq * 4);
            const float v = sv[tt * 64 + w * 8 + vv];
            float o = 0.f;
#pragma unroll
            for (int j = 0; j < 4; ++j) { S[j] = d4[j] * S[j] + k4[j] * v; o += q4[j] * S[j]; }
            o += __shfl_xor(o, 8); o += __shfl_xor(o, 16); o += __shfl_xor(o, 32);
            if (kq == 0) GO[(size_t)scan_row(b, dir, ch * 64 + tt) * 256 + h * 64 + w * 8 + vv] = o;
        }
        __syncthreads();
    }
}
__device__ __forceinline__ void gdn_chain(CArgs& a, int chain, LAS unsigned char* lds) {
    const int b = chain >> 3, h = (chain >> 1) & 3, dir = chain & 1;
    const int tid = tidx(), lane = tid & 63, w = tid >> 6, vv = lane & 7, kq = lane >> 3;
    const float* DQ = (const float*)(a.ws + WS_MIX + MX_DQ); const float* DK = (const float*)(a.ws + WS_MIX + MX_DK); const float* DV = (const float*)(a.ws + WS_MIX + MX_DV);
    const float* DG = (const float*)(a.ws + WS_MIX + MX_DG);
    float* DO = (float*)(a.ws + WS_MIX + (dir ? MX_DOB : MX_DOF));
    LAS float* sq = (LAS float*)lds;
    LAS float* sk = sq + 64 * 64;
    LAS float* sv = sk + 64 * 64;
    LAS float* sg = sv + 64 * 64;
    float S[8];
#pragma unroll
    for (int j = 0; j < 8; ++j) S[j] = 0.f;
    for (int ch = 0; ch < 36; ++ch) {
        { const int tt = tid >> 3, sub = tid & 7, row = scan_row(b, dir, ch * 64 + tt);
          const size_t o = (size_t)row * 256 + h * 64 + sub * 8;
          *(LAS f32x4*)(sq + tt * 64 + sub * 8) = *(const f32x4*)(DQ + o); *(LAS f32x4*)(sq + tt * 64 + sub * 8 + 4) = *(const f32x4*)(DQ + o + 4);
          *(LAS f32x4*)(sk + tt * 64 + sub * 8) = *(const f32x4*)(DK + o); *(LAS f32x4*)(sk + tt * 64 + sub * 8 + 4) = *(const f32x4*)(DK + o + 4);
          *(LAS f32x4*)(sv + tt * 64 + sub * 8) = *(const f32x4*)(DV + o); *(LAS f32x4*)(sv + tt * 64 + sub * 8 + 4) = *(const f32x4*)(DV + o + 4);
          if (sub == 0) { const f32x4 g4 = *(const f32x4*)(DG + (size_t)row * 16 + h * 4); *(LAS f32x2*)(sg + tt * 2) = dir ? (f32x2){g4[2], g4[3]} : (f32x2){g4[0], g4[1]}; } }
        __syncthreads();
#pragma unroll 2
        for (int tt = 0; tt < 64; ++tt) {
            const f32x4 ka = *(const LAS f32x4*)(sk + tt * 64 + kq * 8), kb = *(const LAS f32x4*)(sk + tt * 64 + kq * 8 + 4);
            const f32x4 qa = *(const LAS f32x4*)(sq + tt * 64 + kq * 8), qb = *(const LAS f32x4*)(sq + tt * 64 + kq * 8 + 4);
            const float v = sv[tt * 64 + w * 8 + vv]; const f32x2 g2 = *(const LAS f32x2*)(sg + tt * 2);
            const float beta = g2.x, eg = g2.y;
            float ks = (ka[0] * S[0] + ka[1] * S[1]) + (ka[2] * S[2] + ka[3] * S[3]) + ((kb[0] * S[4] + kb[1] * S[5]) + (kb[2] * S[6] + kb[3] * S[7]));
            ks += __shfl_xor(ks, 8); ks += __shfl_xor(ks, 16); ks += __shfl_xor(ks, 32);
            const float wv = beta * (v - eg * ks);
            float o = 0.f;
#pragma unroll
            for (int j = 0; j < 4; ++j) { S[j] = eg * S[j] + ka[j] * wv; o += qa[j] * S[j]; }
#pragma unroll
            for (int j = 0; j < 4; ++j) { S[4 + j] = eg * S[4 + j] + kb[j] * wv; o += qb[j] * S[4 + j]; }
            o += __shfl_xor(o, 8); o += __shfl_xor(o, 16); o += __shfl_xor(o, 32);
            if (kq == 0) DO[(size_t)scan_row(b, dir, ch * 64 + tt) * 256 + h * 64 + w * 8 + vv] = o;
        }
        __syncthreads();
    }
}
typedef unsigned u32x4a __attribute__((ext_vector_type(4)));
__device__ __forceinline__ bf16x8 frag2(u32x2 lo, u32x2 hi) { return __builtin_bit_cast(bf16x8, (u32x4){lo.x, lo.y, hi.x, hi.y}); }
__device__ __forceinline__ u32x2 cvt4(f32x4 v) { return (u32x2){pk2(v[0], v[1]), pk2(v[2], v[3])}; }

struct GdnIn { f32x2 g2; bf16x8 ak[2], aq[2], bk[2][2]; float kt8[8]; };
struct GdnIn2 { f32x4 R[4], Qv[4]; };
__device__ __forceinline__ void gdn_fetch(CArgs& a, int u, int w, int lane, GdnIn& in) {
    const int chain = u / 36, n = u % 36, b = chain >> 3, h = (chain >> 1) & 3, dir = chain & 1;
    const int r0 = scan_row(b, dir, n * 64), step = dir ? -1 : 1, fr = lane & 15, kg = lane >> 4;
    const float* DQ = (const float*)(a.ws + WS_MIX + MX_DQ) + h * 64; const float* DK = (const float*)(a.ws + WS_MIX + MX_DK) + h * 64; const float* DV = (const float*)(a.ws + WS_MIX + MX_DV) + h * 64;
    const float* DG = (const float*)(a.ws + WS_MIX + MX_DG);
    const bf16* KB = (const bf16*)(a.ws + WS_CKD + CD_KB) + (ptrdiff_t)r0 * 256 + h * 64; const bf16* QB = (const bf16*)(a.ws + WS_CKD + CD_QB) + (ptrdiff_t)r0 * 256 + h * 64;
    const ptrdiff_t ldt = (ptrdiff_t)step * 256;
    const bool isW = w >= 4; const int c0 = 16 * (w & 3), I1 = w >> 1;
    in.g2 = *(const f32x2*)(DG + (size_t)(r0 + step * lane) * 16 + h * 4 + dir * 2);
#pragma unroll
    for (int s = 0; s < 2; ++s) { in.ak[s] = *(const bf16x8*)(KB + (ptrdiff_t)(16 * I1 + fr) * ldt + 32 * s + 8 * kg); in.aq[s] = *(const bf16x8*)(QB + (ptrdiff_t)(16 * I1 + fr) * ldt + 32 * s + 8 * kg);
#pragma unroll
        for (int jj = 0; jj < 2; ++jj) in.bk[jj][s] = *(const bf16x8*)(KB + (ptrdiff_t)(16 * (2 * (w & 1) + jj) + fr) * ldt + 32 * s + 8 * kg); }
#pragma unroll
    for (int tt = 0; tt < 8; ++tt) in.kt8[tt] = DK[(size_t)(r0 + step * (8 * w + tt)) * 256 + lane];
}
__device__ __forceinline__ void gdn_fetch2(CArgs& a, int u, int w, int lane, GdnIn2& in) {
    const int chain = u / 36, n = u % 36, b = chain >> 3, h = (chain >> 1) & 3, dir = chain & 1;
    const int r0 = scan_row(b, dir, n * 64), step = dir ? -1 : 1, fr = lane & 15, kg = lane >> 4;
    const float* DQ = (const float*)(a.ws + WS_MIX + MX_DQ) + h * 64; const float* DK = (const float*)(a.ws + WS_MIX + MX_DK) + h * 64; const float* DV = (const float*)(a.ws + WS_MIX + MX_DV) + h * 64;
    const bool isW = w >= 4; const int c0 = 16 * (w & 3);
#pragma unroll
    for (int I = 0; I < 4; ++I)
#pragma unroll
        for (int e = 0; e < 4; ++e) { const size_t ro = (size_t)(r0 + step * (16 * I + 4 * kg + e)) * 256 + c0 + fr; in.R[I][e] = isW ? DK[ro] : DV[ro]; in.Qv[I][e] = isW ? DQ[ro] : 0.f; }
}
__device__ __forceinline__ float gdn_s1(const GdnIn& in, LAS unsigned char* ub, LAS unsigned char* dwb, int w, int lane) {
    const int fr = lane & 15, kg = lane >> 4, I1 = w >> 1;
    LAS bf16* AB = (LAS bf16*)ub; LAS bf16* ATT = AB + 4608; LAS bf16* KTT = ATT + 4608; LAS float* GT = (LAS float*)(dwb + 2048);
    float beta = in.g2.x, cum = in.g2.y;
#pragma unroll
    for (int o = 1; o < 64; o <<= 1) { const float t = __shfl_up(cum, o); if (lane >= o) cum += t; }
    const float cl = rdlane_f(cum, 63);
    GT[lane] = beta; GT[64 + lane] = cum; GT[128 + lane] = __expf(cum);
    asm volatile("s_waitcnt lgkmcnt(0)" ::: "memory");
    { const f32x4 ci = *(const LAS f32x4*)(GT + 64 + 16 * I1 + 4 * kg), bi = *(const LAS f32x4*)(GT + 16 * I1 + 4 * kg);
#pragma unroll
      for (int jj = 0; jj < 2; ++jj) { const int J = 2 * (w & 1) + jj;
          f32x4 ck = (f32x4){0.f, 0.f, 0.f, 0.f}, cq = (f32x4){0.f, 0.f, 0.f, 0.f};
#pragma unroll
          for (int s = 0; s < 2; ++s) { ck = __builtin_amdgcn_mfma_f32_16x16x32_bf16(in.ak[s], in.bk[jj][s], ck, 0, 0, 0); cq = __builtin_amdgcn_mfma_f32_16x16x32_bf16(in.aq[s], in.bk[jj][s], cq, 0, 0, 0); }
          const int j = 16 * J + fr; const float cj = GT[64 + j];
#pragma unroll
          for (int e = 0; e < 4; ++e) { const int i = 16 * I1 + 4 * kg + e; const float gm = __expf(fminf(ci[e] - cj, 0.f));
              AB[i * 72 + j] = (bf16)f2bf(j < i ? bi[e] * ck[e] * gm : 0.f); ATT[i * 72 + j] = (bf16)f2bf(j <= i ? cq[e] * gm : 0.f); } } }
    { const f32x4 c8a = *(const LAS f32x4*)(GT + 64 + 8 * w), c8b = *(const LAS f32x4*)(GT + 64 + 8 * w + 4);
#pragma unroll
      for (int tt = 0; tt < 8; ++tt) KTT[lane * 72 + 8 * w + tt] = (bf16)f2bf(in.kt8[tt] * __expf(cl - (tt < 4 ? c8a[tt & 3] : c8b[tt & 3]))); }
    asm volatile("s_waitcnt lgkmcnt(0)" ::: "memory");
    return cl;
}
__device__ __forceinline__ void gdn_s23(CArgs& a, int u, const GdnIn2& in, LAS unsigned char* ub, LAS unsigned char* dwb, int w, int lane, float cl) {
    const int fr = lane & 15, kg = lane >> 4;
    bf16* Mo = (bf16*)(a.ws + WS_CKD + CD_M) + (size_t)u * 4096; bf16* Eo = (bf16*)(a.ws + WS_CKD + CD_E) + (size_t)u * 4096;
    float* BTo = (float*)(a.ws + WS_CKD + CD_BT) + (size_t)u * 4096; bf16* FTo = (bf16*)(a.ws + WS_CKD + CD_FT) + (size_t)u * 4096;
    LAS bf16* AB = (LAS bf16*)ub; LAS bf16* ATT = AB + 4608; LAS bf16* KTT = ATT + 4608; LAS bf16* DW = (LAS bf16*)dwb; LAS float* GT = (LAS float*)(dwb + 2048);
    const bool isW = w >= 4; const int c0 = 16 * (w & 3);
    { const int blk = lane >> 4, c = lane & 15; float T[16];
#pragma unroll
      for (int hb = 0; hb < 4; ++hb) {
          u32x4 arow[4][2];
#pragma unroll
          for (int rr = 0; rr < 4; ++rr) { const int r = 4 * hb + rr; arow[rr][0] = *(const LAS u32x4*)(AB + (16 * blk + r) * 72 + 16 * blk); if (hb >= 2) arow[rr][1] = *(const LAS u32x4*)(AB + (16 * blk + r) * 72 + 16 * blk + 8); }
          asm volatile("s_waitcnt lgkmcnt(0)" ::: "memory");
#pragma unroll
          for (int rr = 0; rr < 4; ++rr) { const int r = 4 * hb + rr; float t = (r == c) ? 1.f : 0.f;
#pragma unroll
              for (int j = 0; j < r; ++j) { const unsigned wv = arow[rr][j >> 3][(j >> 1) & 3]; t -= ((j & 1) ? hi_bf(wv) : lo_bf(wv)) * T[j]; }
              T[r] = t; DW[(blk * 16 + r) * 16 + c] = (bf16)f2bf(t); } } }
    asm volatile("s_waitcnt lgkmcnt(0)" ::: "memory");
    f32x4 X[4];
#pragma unroll
    for (int I = 0; I < 4; ++I) {
        const f32x4 br = *(const LAS f32x4*)(GT + 16 * I + 4 * kg), er = *(const LAS f32x4*)(GT + 128 + 16 * I + 4 * kg);
        f32x4 acc = isW ? br * er * in.R[I] : br * in.R[I];
#pragma unroll
        for (int P = 0; 2 * P < I; ++P) {
            const u32x2 alo = *(const LAS u32x2*)(AB + (16 * I + fr) * 72 + 32 * P + 4 * kg);
            const u32x2 ahi = (2 * P + 1 < I) ? *(const LAS u32x2*)(AB + (16 * I + fr) * 72 + 32 * P + 16 + 4 * kg) : (u32x2){0u, 0u};
            const u32x2 xlo = cvt4(-X[2 * P]); const u32x2 xhi = (2 * P + 1 < I) ? cvt4(-X[2 * P + 1]) : (u32x2){0u, 0u};
            acc = __builtin_amdgcn_mfma_f32_16x16x32_bf16(frag2(alo, ahi), frag2(xlo, xhi), acc, 0, 0, 0); }
        const u32x2 dlo = *(const LAS u32x2*)(DW + (I * 16 + fr) * 16 + 4 * kg);
        X[I] = __builtin_amdgcn_mfma_f32_16x16x32_bf16(frag2(dlo, (u32x2){0u, 0u}), frag2(cvt4(acc), (u32x2){0u, 0u}), (f32x4){0.f, 0.f, 0.f, 0.f}, 0, 0, 0);
    }
    const bf16x8 Xb01 = frag2(cvt4(X[0]), cvt4(X[1])), Xb23 = frag2(cvt4(X[2]), cvt4(X[3]));
    const float ecl = __expf(cl);
#pragma unroll
    for (int t4 = 0; t4 < 4; ++t4) {
        const LAS bf16* ar = ATT + (16 * t4 + fr) * 72 + 4 * kg; const LAS bf16* kr = KTT + (16 * t4 + fr) * 72 + 4 * kg;
        f32x4 pa = (f32x4){0.f, 0.f, 0.f, 0.f}, pk = (f32x4){0.f, 0.f, 0.f, 0.f};
        pa = __builtin_amdgcn_mfma_f32_16x16x32_bf16(frag2(*(const LAS u32x2*)ar, *(const LAS u32x2*)(ar + 16)), Xb01, pa, 0, 0, 0);
        pa = __builtin_amdgcn_mfma_f32_16x16x32_bf16(frag2(*(const LAS u32x2*)(ar + 32), *(const LAS u32x2*)(ar + 48)), Xb23, pa, 0, 0, 0);
        pk = __builtin_amdgcn_mfma_f32_16x16x32_bf16(frag2(*(const LAS u32x2*)kr, *(const LAS u32x2*)(kr + 16)), Xb01, pk, 0, 0, 0);
        pk = __builtin_amdgcn_mfma_f32_16x16x32_bf16(frag2(*(const LAS u32x2*)(kr + 32), *(const LAS u32x2*)(kr + 48)), Xb23, pk, 0, 0, 0);
        if (!isW) {
            *(u32x2*)(FTo + (c0 + fr) * 64 + 16 * t4 + 4 * kg) = cvt4(pa);
            *(f32x4*)(BTo + (c0 + fr) * 64 + 16 * t4 + 4 * kg) = pk;
        } else {
            const f32x4 ec = *(const LAS f32x4*)(GT + 128 + 16 * t4 + 4 * kg);
#pragma unroll
            for (int e = 0; e < 4; ++e) { const int row = 16 * t4 + 4 * kg + e, col = c0 + fr;
                Eo[row * 64 + col] = (bf16)f2bf(ec[e] * in.Qv[t4][e] - pa[e]);
                Mo[row * 64 + col] = (bf16)f2bf((row == col ? ecl : 0.f) - pk[e]); }
        }
    }
}
__device__ __forceinline__ void gdn_chain_units(CArgs& a, int chain, LAS unsigned char* lds, int w, int lane) {
    asm volatile("" : "+v"(lane));
    LAS unsigned char* dwb = lds + 55296 + w * 3072;
    GdnIn A, B; GdnIn2 C;
    gdn_fetch(a, chain * 36, w, lane, A);
#pragma unroll 1
    for (int n = 0; n < 36; n += 2) {
        asm volatile("" : "+v"(lane));
        { gdn_fetch2(a, chain * 36 + n, w, lane, C); const float cl = gdn_s1(A, lds, dwb, w, lane); __syncthreads(); gdn_fetch(a, chain * 36 + n + 1, w, lane, B); gdn_s23(a, chain * 36 + n, C, lds, dwb, w, lane, cl); }
        asm volatile("" : "+v"(lane));
        { gdn_fetch2(a, chain * 36 + n + 1, w, lane, C); const float cl = gdn_s1(B, lds + 27648, dwb, w, lane); __syncthreads(); if (n + 2 < 36) gdn_fetch(a, chain * 36 + n + 2, w, lane, A); gdn_s23(a, chain * 36 + n + 1, C, lds + 27648, dwb, w, lane, cl); }
    }
}
__device__ __forceinline__ void gdn_seq_wave(CArgs& a, int chain, int vs, int lane) {
    asm volatile("" : "+v"(lane));
    const int b = chain >> 3, h = (chain >> 1) & 3, dir = chain & 1, fr = lane & 15, kg = lane >> 4, v = 16 * vs + fr, step = dir ? -1 : 1;
    float* DO = (float*)(a.ws + WS_MIX + (dir ? MX_DOB : MX_DOF));
    f32x4 S[4];
#pragma unroll
    for (int i = 0; i < 4; ++i) S[i] = (f32x4){0.f, 0.f, 0.f, 0.f};
#pragma unroll 1
    for (int n = 0; n < 36; ++n) {
        const int u = chain * 36 + n, r0 = scan_row(b, dir, n * 64);
        const bf16* Mo = (const bf16*)(a.ws + WS_CKD + CD_M) + (size_t)u * 4096; const bf16* Eo = (const bf16*)(a.ws + WS_CKD + CD_E) + (size_t)u * 4096;
        const float* BTo = (const float*)(a.ws + WS_CKD + CD_BT) + (size_t)u * 4096; const bf16* FTo = (const bf16*)(a.ws + WS_CKD + CD_FT) + (size_t)u * 4096;
        u32x2 ef[4][2][2], mf[4][2][2], ff[4]; f32x4 bi[4];
#pragma unroll
        for (int t = 0; t < 4; ++t) { ff[t] = *(const u32x2*)(FTo + v * 64 + 16 * t + 4 * kg); bi[t] = *(const f32x4*)(BTo + v * 64 + 16 * t + 4 * kg);
#pragma unroll
            for (int s = 0; s < 2; ++s) { const bf16* er = Eo + (16 * t + fr) * 64 + 32 * s + 4 * kg; ef[t][s][0] = *(const u32x2*)er; ef[t][s][1] = *(const u32x2*)(er + 16);
                const bf16* mr = Mo + (16 * t + fr) * 64 + 32 * s + 4 * kg; mf[t][s][0] = *(const u32x2*)mr; mf[t][s][1] = *(const u32x2*)(mr + 16); } }
        bf16x8 Sb[2];
#pragma unroll
        for (int s = 0; s < 2; ++s) Sb[s] = frag2(cvt4(S[2 * s]), cvt4(S[2 * s + 1]));
        f32x4 o[4];
#pragma unroll
        for (int t = 0; t < 4; ++t) { o[t] = (f32x4){lo_bf(ff[t].x), hi_bf(ff[t].x), lo_bf(ff[t].y), hi_bf(ff[t].y)};
#pragma unroll
            for (int s = 0; s < 2; ++s) o[t] = __builtin_amdgcn_mfma_f32_16x16x32_bf16(frag2(ef[t][s][0], ef[t][s][1]), Sb[s], o[t], 0, 0, 0);
            f32x4 sn = bi[t];
#pragma unroll
            for (int s = 0; s < 2; ++s) sn = __builtin_amdgcn_mfma_f32_16x16x32_bf16(frag2(mf[t][s][0], mf[t][s][1]), Sb[s], sn, 0, 0, 0);
            S[t] = sn; }
#pragma unroll
        for (int t = 0; t < 4; ++t)
#pragma unroll
            for (int e = 0; e < 4; ++e) DO[(size_t)(r0 + step * (16 * t + 4 * kg + e)) * 256 + h * 64 + v] = o[t][e];
    }
}

__device__ __forceinline__ void gdn_seq_block(CArgs& a, int chain, LAS unsigned char* lds, int w, int lane) {
    asm volatile("" : "+v"(lane));
    const int b = chain >> 3, h = (chain >> 1) & 3, dir = chain & 1, fr = lane & 15, kg = lane >> 4, step = dir ? -1 : 1;
    constexpr int SLOT = 45056;
    if (w >= 4) {
        const int q = w - 4;
        u32x4 rg[10];
#define SEQ_LD(n_) do { const int u_ = chain * 36 + (n_); \
        _Pragma("unroll") for (int j = 0; j < 10; ++j) { const int c_ = q + 4 * j; \
            const unsigned char* g_ = c_ < 8 ? a.ws + WS_CKD + CD_M + (size_t)u_ * 8192 + c_ * 1024 : (c_ < 16 ? a.ws + WS_CKD + CD_E + (size_t)u_ * 8192 + (c_ - 8) * 1024 : \
                (c_ < 32 ? a.ws + WS_CKD + CD_BT + (size_t)u_ * 16384 + (c_ - 16) * 1024 : a.ws + WS_CKD + CD_FT + (size_t)u_ * 8192 + (c_ - 32) * 1024)); \
            rg[j] = *(const u32x4*)(g_ + lane * 16); } } while (0)
#define SEQ_ST(n_) do { LAS unsigned char* s_ = lds + ((n_) % 3) * SLOT; \
        _Pragma("unroll") for (int j = 0; j < 10; ++j) { const int c_ = q + 4 * j; \
            const int off_ = c_ < 8 ? (c_ * 8 + (lane >> 3)) * 144 + (lane & 7) * 16 : (c_ < 16 ? 9216 + ((c_ - 8) * 8 + (lane >> 3)) * 144 + (lane & 7) * 16 : \
                (c_ < 32 ? 18432 + ((c_ - 16) * 4 + (lane >> 4)) * 272 + (lane & 15) * 16 : 35840 + ((c_ - 32) * 8 + (lane >> 3)) * 144 + (lane & 7) * 16)); \
            *(LAS u32x4*)(s_ + off_) = rg[j]; } } while (0)
        SEQ_LD(0); SEQ_ST(0); SEQ_LD(1); SEQ_ST(1); SEQ_LD(2);
        asm volatile("s_waitcnt lgkmcnt(0)" ::: "memory");
        __syncthreads();
#pragma unroll 1
        for (int n = 0; n < 36; ++n) {
            if (n + 2 < 36) { SEQ_ST(n + 2); }
            if (n + 3 < 36) { SEQ_LD(n + 3); }
            asm volatile("s_waitcnt lgkmcnt(0)" ::: "memory");
            __syncthreads();
        }
#undef SEQ_LD
#undef SEQ_ST
    } else {
        const int v = 16 * w + fr;
        float* DO = (float*)(a.ws + WS_MIX + (dir ? MX_DOB : MX_DOF));
        f32x4 S[4];
#pragma unroll
        for (int i = 0; i < 4; ++i) S[i] = (f32x4){0.f, 0.f, 0.f, 0.f};
        __syncthreads();
#pragma unroll 1
        for (int n = 0; n < 36; ++n) {
            const LAS unsigned char* sl = lds + (n % 3) * SLOT; const int r0 = scan_row(b, dir, n * 64);
            bf16x8 Sb[2];
#pragma unroll
            for (int s = 0; s < 2; ++s) Sb[s] = frag2(cvt4(S[2 * s]), cvt4(S[2 * s + 1]));
            f32x4 o[4];
#pragma unroll
            for (int t = 0; t < 4; ++t) {
                const u32x2 ff = *(const LAS u32x2*)(sl + 35840 + v * 144 + (16 * t + 4 * kg) * 2);
                o[t] = (f32x4){lo_bf(ff.x), hi_bf(ff.x), lo_bf(ff.y), hi_bf(ff.y)};
                f32x4 sn = *(const LAS f32x4*)(sl + 18432 + v * 272 + (16 * t + 4 * kg) * 4);
#pragma unroll
                for (int s = 0; s < 2; ++s) { const LAS unsigned char* er = sl + 9216 + (16 * t + fr) * 144 + (32 * s + 4 * kg) * 2; const LAS unsigned char* mr = sl + (16 * t + fr) * 144 + (32 * s + 4 * kg) * 2;
                    o[t] = __builtin_amdgcn_mfma_f32_16x16x32_bf16(frag2(*(const LAS u32x2*)er, *(const LAS u32x2*)(er + 32)), Sb[s], o[t], 0, 0, 0);
                    sn = __builtin_amdgcn_mfma_f32_16x16x32_bf16(frag2(*(const LAS u32x2*)mr, *(const LAS u32x2*)(mr + 32)), Sb[s], sn, 0, 0, 0); }
                S[t] = sn; }
#pragma unroll
            for (int t = 0; t < 4; ++t)
#pragma unroll
                for (int e = 0; e < 4; ++e) DO[(size_t)(r0 + step * (16 * t + 4 * kg + e)) * 256 + h * 64 + v] = o[t][e];
            __syncthreads();
        }
    }
}
__device__ __forceinline__ void gla_seq_block(CArgs& a, int chain, LAS unsigned char* lds, int w, int lane) {
    asm volatile("" : "+v"(lane));
    const int b = chain >> 3, h = (chain >> 1) & 3, dir = chain & 1, fr = lane & 15, kg = lane >> 4, step = dir ? -1 : 1;
    constexpr int SLOT = 23680;
    if (w >= 4) {
        const int q = w - 4;
        u32x4 rg[5]; float dl = 0.f;
#define SEQ_LD(n_) do { const int u_ = chain * 36 + (n_); \
        _Pragma("unroll") for (int j = 0; j < 5; ++j) { const int c_ = q + 4 * j; \
            const unsigned char* g_ = c_ < 4 ? a.ws + WS_CKA + CA_QC + (size_t)u_ * 4096 + c_ * 1024 : (c_ < 12 ? a.ws + WS_CKA + CA_FT + (size_t)u_ * 8192 + (c_ - 4) * 1024 : a.ws + WS_CKA + CA_UT + (size_t)u_ * 8192 + (c_ - 12) * 1024); \
            rg[j] = *(const u32x4*)(g_ + lane * 16); } \
        if (q == 0) dl = ((const float*)(a.ws + WS_CKA + CA_DL))[(size_t)u_ * 32 + (lane & 31)]; } while (0)
#define SEQ_ST(n_) do { LAS unsigned char* s_ = lds + ((n_) % 3) * SLOT; \
        _Pragma("unroll") for (int j = 0; j < 5; ++j) { const int c_ = q + 4 * j; \
            const int off_ = c_ < 4 ? (c_ * 16 + (lane >> 2)) * 80 + (lane & 3) * 16 : (c_ < 12 ? 5120 + ((c_ - 4) * 8 + (lane >> 3)) * 144 + (lane & 7) * 16 : 14336 + ((c_ - 12) * 8 + (lane >> 3)) * 144 + (lane & 7) * 16); \
            *(LAS u32x4*)(s_ + off_) = rg[j]; } \
        if (q == 0 && lane < 32) *(LAS float*)(s_ + 23552 + lane * 4) = dl; } while (0)
        SEQ_LD(0); SEQ_ST(0); SEQ_LD(1); SEQ_ST(1); SEQ_LD(2);
        asm volatile("s_waitcnt lgkmcnt(0)" ::: "memory");
        __syncthreads();
#pragma unroll 1
        for (int n = 0; n < 36; ++n) {
            if (n + 2 < 36) { SEQ_ST(n + 2); }
            if (n + 3 < 36) { SEQ_LD(n + 3); }
            asm volatile("s_waitcnt lgkmcnt(0)" ::: "memory");
            __syncthreads();
        }
#undef SEQ_LD
#undef SEQ_ST
    } else {
        const int v = 16 * w + fr;
        float* GO = (float*)(a.ws + WS_MIX + (dir ? MX_GOB : MX_GOF));
        f32x4 S[2] = {(f32x4){0.f, 0.f, 0.f, 0.f}, (f32x4){0.f, 0.f, 0.f, 0.f}};
        __syncthreads();
#pragma unroll 1
        for (int n = 0; n < 36; ++n) {
            const LAS unsigned char* sl = lds + (n % 3) * SLOT; const int r0 = scan_row(b, dir, n * 64);
            const bf16x8 Sb = frag2(cvt4(S[0]), cvt4(S[1]));
            f32x4 o[4];
#pragma unroll
            for (int t = 0; t < 4; ++t) { const u32x2 ff = *(const LAS u32x2*)(sl + 5120 + v * 144 + (16 * t + 4 * kg) * 2);
                o[t] = (f32x4){lo_bf(ff.x), hi_bf(ff.x), lo_bf(ff.y), hi_bf(ff.y)};
                const LAS unsigned char* qr = sl + (16 * t + fr) * 80 + 4 * kg * 2;
                o[t] = __builtin_amdgcn_mfma_f32_16x16x32_bf16(frag2(*(const LAS u32x2*)qr, *(const LAS u32x2*)(qr + 32)), Sb, o[t], 0, 0, 0); }
#pragma unroll
            for (int kt = 0; kt < 2; ++kt) { const f32x4 d4 = *(const LAS f32x4*)(sl + 23552 + (16 * kt + 4 * kg) * 4), u4 = *(const LAS f32x4*)(sl + 14336 + v * 144 + (16 * kt + 4 * kg) * 4); S[kt] = d4 * S[kt] + u4; }
#pragma unroll
            for (int t = 0; t < 4; ++t)
#pragma unroll
                for (int e = 0; e < 4; ++e) GO[(size_t)(r0 + step * (16 * t + 4 * kg + e)) * 256 + h * 64 + v] = o[t][e];
            __syncthreads();
        }
    }
}

struct GlaIn { float bc[32]; unsigned px[32]; };
__device__ __forceinline__ void gla_fetch(CArgs& a, int u, int w, int lane, GlaIn& in) {
    const int chain = u / 36, n = u % 36, b = chain >> 3, h = (chain >> 1) & 3, dir = chain & 1;
    const int r0 = scan_row(b, dir, n * 64), step = dir ? -1 : 1;
    const bf16* P = (const bf16*)(a.ws + WS_P);
    const float* GD = (const float*)(a.ws + WS_MIX + (dir ? MX_GDB : MX_GDF));
    if (w < 4) { const int k = lane & 31, half = lane >> 5; const int src_off = (w == 0 || w == 2) ? 0 : 128;
#pragma unroll
        for (int i = 0; i < 32; ++i) { in.bc[i] = GD[(size_t)(r0 + step * (32 * half + i)) * 128 + h * 32 + k]; in.px[i] = P[(size_t)(r0 + step * (32 * half + i)) * D_INP + GLA0 + src_off + h * 32 + k]; }
    } else { const int vv = 16 * (w - 4) + (lane & 15), tq = lane >> 4;
#pragma unroll
        for (int i = 0; i < 16; ++i) in.px[i] = P[(size_t)(r0 + step * (16 * tq + i)) * D_INP + GLA0 + 256 + h * 64 + vv];
#pragma unroll
        for (int i = 16; i < 32; ++i) in.px[i] = 0u;
#pragma unroll
        for (int i = 0; i < 32; ++i) in.bc[i] = 0.f;
    }
}
__device__ __forceinline__ void gla_s1(CArgs& a, int u, GlaIn& in, LAS unsigned char* ub, int w, int lane) {
    bf16* QC = (bf16*)(a.ws + WS_CKA + CA_QC) + (size_t)u * 2048; float* DL = (float*)(a.ws + WS_CKA + CA_DL) + (size_t)u * 32;
    LAS bf16* QE = (LAS bf16*)ub; LAS bf16* KE = QE + 2560; LAS bf16* KTT = KE + 2560; LAS bf16* VT = KTT + 2304;
    if (w < 4) {
        const int k = lane & 31, half = lane >> 5;
        float run = 0.f;
#pragma unroll
        for (int i = 0; i < 32; ++i) { run += in.bc[i]; in.bc[i] = run; }
        const float tot0 = __shfl(run, k), tot1 = __shfl(run, 32 + k);
        const float bref = tot0, blast = tot0 + tot1, off = half ? tot0 : 0.f;
        const float sc = (w == 0 || w == 2) ? 0.17677669529663687f : 1.f;
#pragma unroll
        for (int i = 0; i < 32; ++i) { const int t = 32 * half + i; const float bi = in.bc[i] + off;
            const float x = bf2f(in.px[i]) * sc;
            const float ex = w == 0 ? bi - bref : (w == 1 ? bref - bi : (w == 2 ? bi : blast - bi));
            const bf16 y = (bf16)f2bf(x * __expf(ex));
            if (w == 0) QE[t * 40 + k] = y; else if (w == 1) KE[t * 40 + k] = y; else if (w == 2) QC[t * 32 + k] = y; else KTT[k * 72 + t] = y; }
        if (w == 2 && half == 0) DL[k] = __expf(blast);
    } else {
        const int vv = 16 * (w - 4) + (lane & 15), tq = lane >> 4;
#pragma unroll
        for (int i = 0; i < 16; ++i) VT[vv * 72 + 16 * tq + i] = in.px[i];
    }
    asm volatile("s_waitcnt lgkmcnt(0)" ::: "memory");
}
__device__ __forceinline__ void gla_s2(CArgs& a, int u, LAS unsigned char* ub, int w, int lane) {
    const int fr = lane & 15, kg = lane >> 4;
    bf16* FT = (bf16*)(a.ws + WS_CKA + CA_FT) + (size_t)u * 4096; float* UT = (float*)(a.ws + WS_CKA + CA_UT) + (size_t)u * 2048;
    LAS bf16* QE = (LAS bf16*)ub; LAS bf16* KE = QE + 2560; LAS bf16* KTT = KE + 2560; LAS bf16* VT = KTT + 2304;
    const int It = w & 3, vh = w >> 2;
    const bf16x8 qf = *(const LAS bf16x8*)(QE + (16 * It + fr) * 40 + 8 * kg);
    f32x4 st[4];
#pragma unroll
    for (int Jt = 0; Jt < 4; ++Jt) { const bf16x8 kf = *(const LAS bf16x8*)(KE + (16 * Jt + fr) * 40 + 8 * kg);
        st[Jt] = __builtin_amdgcn_mfma_f32_16x16x32_bf16(kf, qf, (f32x4){0.f, 0.f, 0.f, 0.f}, 0, 0, 0);
#pragma unroll
        for (int e = 0; e < 4; ++e) st[Jt][e] = (16 * Jt + 4 * kg + e <= 16 * It + fr) ? st[Jt][e] : 0.f; }
    const bf16x8 Sb01 = frag2(cvt4(st[0]), cvt4(st[1])), Sb23 = frag2(cvt4(st[2]), cvt4(st[3]));
#pragma unroll
    for (int vv = 0; vv < 2; ++vv) { const int Vt = 2 * vh + vv; const LAS bf16* vr = VT + (16 * Vt + fr) * 72 + 4 * kg;
        f32x4 f = (f32x4){0.f, 0.f, 0.f, 0.f};
        f = __builtin_amdgcn_mfma_f32_16x16x32_bf16(frag2(*(const LAS u32x2*)vr, *(const LAS u32x2*)(vr + 16)), Sb01, f, 0, 0, 0);
        f = __builtin_amdgcn_mfma_f32_16x16x32_bf16(frag2(*(const LAS u32x2*)(vr + 32), *(const LAS u32x2*)(vr + 48)), Sb23, f, 0, 0, 0);
#pragma unroll
        for (int e = 0; e < 4; ++e) FT[(16 * Vt + 4 * kg + e) * 64 + 16 * It + fr] = (bf16)f2bf(f[e]); }
    const int kt = w & 1, Vu = w >> 1;
    f32x4 uu = (f32x4){0.f, 0.f, 0.f, 0.f};
#pragma unroll
    for (int s = 0; s < 2; ++s) uu = __builtin_amdgcn_mfma_f32_16x16x32_bf16(*(const LAS bf16x8*)(KTT + (16 * kt + fr) * 72 + 32 * s + 8 * kg), *(const LAS bf16x8*)(VT + (16 * Vu + fr) * 72 + 32 * s + 8 * kg), uu, 0, 0, 0);
    *(f32x4*)(UT + (16 * Vu + fr) * 32 + 16 * kt + 4 * kg) = uu;
}
__device__ __forceinline__ void gla_chain_units(CArgs& a, int chain, LAS unsigned char* lds, int w, int lane) {
    GlaIn A, B;
    asm volatile("" : "+v"(lane));
    gla_fetch(a, chain * 36, w, lane, A);
#pragma unroll 1
    for (int n = 0; n < 36; n += 2) {
        asm volatile("" : "+v"(lane));
        { gla_s1(a, chain * 36 + n, A, lds, w, lane); __syncthreads(); gla_fetch(a, chain * 36 + n + 1, w, lane, B); gla_s2(a, chain * 36 + n, lds, w, lane); }
        asm volatile("" : "+v"(lane));
        { gla_s1(a, chain * 36 + n + 1, B, lds + 24064, w, lane); __syncthreads(); if (n + 2 < 36) gla_fetch(a, chain * 36 + n + 2, w, lane, A); gla_s2(a, chain * 36 + n + 1, lds + 24064, w, lane); }
    }
}
__device__ __forceinline__ void gla_seq_wave(CArgs& a, int chain, int vs, int lane) {
    asm volatile("" : "+v"(lane));
    const int b = chain >> 3, h = (chain >> 1) & 3, dir = chain & 1, fr = lane & 15, kg = lane >> 4, v = 16 * vs + fr, step = dir ? -1 : 1;
    float* GO = (float*)(a.ws + WS_MIX + (dir ? MX_GOB : MX_GOF));
    f32x4 S[2] = {(f32x4){0.f, 0.f, 0.f, 0.f}, (f32x4){0.f, 0.f, 0.f, 0.f}};
#pragma unroll 1
    for (int n = 0; n < 36; ++n) {
        const int u = chain * 36 + n, r0 = scan_row(b, dir, n * 64);
        const bf16* QC = (const bf16*)(a.ws + WS_CKA + CA_QC) + (size_t)u * 2048; const bf16* FT = (const bf16*)(a.ws + WS_CKA + CA_FT) + (size_t)u * 4096;
        const float* UT = (const float*)(a.ws + WS_CKA + CA_UT) + (size_t)u * 2048; const float* DL = (const float*)(a.ws + WS_CKA + CA_DL) + (size_t)u * 32;
        u32x2 qf[4][2], ff[4]; f32x4 d4[2], u4[2];
#pragma unroll
        for (int t = 0; t < 4; ++t) { const bf16* qr = QC + (16 * t + fr) * 32; qf[t][0] = *(const u32x2*)(qr + 4 * kg); qf[t][1] = *(const u32x2*)(qr + 16 + 4 * kg); ff[t] = *(const u32x2*)(FT + v * 64 + 16 * t + 4 * kg); }
#pragma unroll
        for (int kt = 0; kt < 2; ++kt) { d4[kt] = *(const f32x4*)(DL + 16 * kt + 4 * kg); u4[kt] = *(const f32x4*)(UT + v * 32 + 16 * kt + 4 * kg); }
        const bf16x8 Sb = frag2(cvt4(S[0]), cvt4(S[1]));
        f32x4 o[4];
#pragma unroll
        for (int t = 0; t < 4; ++t) { o[t] = (f32x4){lo_bf(ff[t].x), hi_bf(ff[t].x), lo_bf(ff[t].y), hi_bf(ff[t].y)};
            o[t] = __builtin_amdgcn_mfma_f32_16x16x32_bf16(frag2(qf[t][0], qf[t][1]), Sb, o[t], 0, 0, 0); }
#pragma unroll
        for (int kt = 0; kt < 2; ++kt) S[kt] = d4[kt] * S[kt] + u4[kt];
#pragma unroll
        for (int t = 0; t < 4; ++t)
#pragma unroll
            for (int e = 0; e < 4; ++e) GO[(size_t)(r0 + step * (16 * t + 4 * kg + e)) * 256 + h * 64 + v] = o[t][e];
    }
}

template <int L>
__device__ __forceinline__ void hyena_unit(CArgs& a, int l, int c, LAS unsigned char* lds) {
    constexpr int Lt = L == SEQ ? 1 : 0, SOFF = L == SEQ ? CTXL : 0, CST = (2 * L + 16) * 2 + 32;
    constexpr int NTW = L / 16 / 8;
    const int tid = tidx(), lane = tid & 63, w = tid >> 6, fr = lane & 15, kg = lane >> 4;
    const float* kf = (const float*)(a.ws + WS_KUN) + ((size_t)((l * 2 + Lt) * 512 + c)) * 2048;
    const float* kb = kf + (size_t)256 * 2048;
    LAS float* red = (LAS float*)(lds + 8 * CST);
    float s = 0.f;
    for (int t = tid; t < L; t += 512) s += fabsf(kf[t]) + (t >= 1 ? fabsf(kb[t]) : 0.f);
    s = wave_sum(s);
    if (lane == 0) red[w] = s;
    __syncthreads();
    float l1 = 0.f;
#pragma unroll
    for (int i = 0; i < 8; ++i) l1 += red[i];
    const float inv = 1.f / l1;
    for (int idx = tid; idx < 2 * L + 16; idx += 512) {
        float gv = 0.f;
        if (idx >= 1 && idx <= L) gv = kf[L - idx] * inv; else if (idx > L && idx < 2 * L) gv = kb[idx - L] * inv;
        const bf16 gb = (bf16)f2bf(gv);
#pragma unroll
        for (int r = 0; r < 8; ++r) if (idx - r >= 0) *(LAS bf16*)(lds + r * CST + (idx - r) * 2) = gb;
    }
    __syncthreads();
    const bf16* Z = (const bf16*)(a.ws + WS_MIX + MX_ZT) + ((size_t)(c * 16 + fr)) * 2304 + SOFF;
    float* YT = (float*)(a.ws + WS_MIX + MX_YT) + ((size_t)(c * 16 + fr)) * 2304 + SOFF;
    f32x4 acc[NTW];
#pragma unroll
    for (int j = 0; j < NTW; ++j) acc[j] = (f32x4){0.f, 0.f, 0.f, 0.f};
    const int rr = (8 - (fr & 7)) & 7;
    for (int i = 0; i < L / 32; ++i) {
        const bf16x8 Bf = *(const bf16x8*)(Z + 32 * i + 8 * kg);
#pragma unroll
        for (int j = 0; j < NTW; ++j) {
            const int t0 = 16 * (w * NTW + j);
            const int o = 32 * i + 8 * kg - t0 - fr + L;
            const bf16x8 Af = *(const LAS bf16x8*)(lds + rr * CST + (o >> 3) * 16);
            acc[j] = __builtin_amdgcn_mfma_f32_16x16x32_bf16(Af, Bf, acc[j], 0, 0, 0);
        }
    }
#pragma unroll
    for (int j = 0; j < NTW; ++j) *(f32x4*)(YT + 16 * (w * NTW + j) + 4 * kg) = acc[j];
    __syncthreads();
}
__device__ __forceinline__ void ph_scan(CArgs& a, int l, LAS unsigned char* lds, int bid, int nblk, unsigned long long& tacc) {
    const int tid = tidx(), lane = tid & 63, w = __builtin_amdgcn_readfirstlane(tid >> 6);
    unsigned long long t0 = 0ull;
    if (PROBE_PH >= 20 && PROBE_PH < 50) t0 = __builtin_amdgcn_s_memrealtime();
#pragma unroll 1
    for (int c = bid; c < 256; c += nblk) {
        if (c < 128) {
            gdn_chain_units(a, c, lds, w, lane);
        } else {
            gla_chain_units(a, c - 128, lds, w, lane);
        }
        asm volatile("s_waitcnt vmcnt(0)" ::: "memory");
        __syncthreads();
        if (PROBE_PH == 20 && c < 128) tacc += __builtin_amdgcn_s_memrealtime() - t0;
        if (PROBE_PH == 24 && c >= 128) tacc += __builtin_amdgcn_s_memrealtime() - t0;
        if (PROBE_PH == 21) t0 = __builtin_amdgcn_s_memrealtime();
        if (c < 128) gdn_seq_block(a, c, lds, w, lane); else gla_seq_block(a, c - 128, lds, w, lane);
        __syncthreads();
        if (PROBE_PH == 21) tacc += __builtin_amdgcn_s_memrealtime() - t0;
    }
    if (PROBE_PH == 22) t0 = __builtin_amdgcn_s_memrealtime();
    {
        LAS unsigned char* scr = lds + w * 8448;
        if (nblk == 256) { const int per = bid < 128 ? 16 : 32, first = bid < 128 ? (bid * 8 + w) * 16 : 16384 + ((bid - 128) * 8 + w) * 32;
            tr_experts_range(a, l, scr, first, first + per, 1, lane); }
        else tr_experts_range(a, l, scr, bid * 8 + w, NEXP * 3 * 512, nblk * 8, lane);
    }
    if (PROBE_PH == 22) tacc += __builtin_amdgcn_s_memrealtime() - t0;
    __syncthreads();
    if (PROBE_PH == 23) t0 = __builtin_amdgcn_s_memrealtime();
    if (nblk == 256) {
        if (bid < 128) hyena_unit<SEQ>(a, l, bid, lds);
        else { const int g = bid - 128; hyena_unit<SEQ>(a, l, 128 + g, lds); hyena_unit<CTXL>(a, l, 2 * g, lds); hyena_unit<CTXL>(a, l, 2 * g + 1, lds); }
    } else {
        for (int it = bid; it < 512; it += nblk) { if (it < 256) hyena_unit<SEQ>(a, l, it, lds); else hyena_unit<CTXL>(a, l, it - 256, lds); }
    }
    if (PROBE_PH == 23) tacc += __builtin_amdgcn_s_memrealtime() - t0;
}

__device__ __forceinline__ void ph_post_hyena(CArgs& a, int l, LAS unsigned char* lds, int bid, int nblk) {
    const bf16* P = (const bf16*)(a.ws + WS_P);
    const float* YT = (const float*)(a.ws + WS_MIX + MX_YT); bf16* YMIX = (bf16*)(a.ws + WS_YMIX);
    LAS float* yt = (LAS float*)lds;
    const int tid = tidx(), c4 = (tid & 63) * 4, tg = tid >> 6;
    const float* hw = a.in[I_HYCW] + l * 3 * 768; const float* hb = a.in[I_HYCB] + l * 768;
    f32x4 w0[3], wx[3], wv[3];
#pragma unroll
    for (int k = 0; k < 3; ++k) { w0[k] = *(const f32x4*)(hw + k * 768 + c4); wx[k] = *(const f32x4*)(hw + k * 768 + 256 + c4); wv[k] = *(const f32x4*)(hw + k * 768 + 512 + c4); }
    const f32x4 b0 = *(const f32x4*)(hb + c4), bx = *(const f32x4*)(hb + 256 + c4), bv = *(const f32x4*)(hb + 512 + c4), hd = *(const f32x4*)(a.in[I_HYD] + l * 256 + c4);
#pragma unroll 1
    for (int it = bid; it < 576; it += nblk) {
        const Chunk c = chunk_of(it);
        const int soff = c.L == CTXL ? 0 : CTXL;
        { const int ch = tid & 255, half = tid >> 8;
          const float* srcp = YT + ((size_t)(ch * 16 + c.b)) * 2304 + soff + c.t0 + half * 32;
#pragma unroll
          for (int j = 0; j < 8; ++j) { const f32x4 v = *(const f32x4*)(srcp + 4 * j);
              yt[(half * 32 + 4 * j) * 260 + ch] = v[0]; yt[(half * 32 + 4 * j + 1) * 260 + ch] = v[1]; yt[(half * 32 + 4 * j + 2) * 260 + ch] = v[2]; yt[(half * 32 + 4 * j + 3) * 260 + ch] = v[3]; } }
        __syncthreads();
        const int tb = c.t0 + tg * 8;
        const bf16* pb = P + (size_t)(c.row0 + tg * 8) * D_INP;
        f32x4 x0[10], x1[10], vv[10];
#pragma unroll
        for (int r = 0; r < 10; ++r) { const int t = tb + r - 1; const bool ok = t >= c.lo && t < c.hi; const bf16* p = pb + (ptrdiff_t)(r - 1) * D_INP;
            x0[r] = ok ? bf4(*(const u32x2*)(p + HY0 + c4)) : (f32x4){0.f, 0.f, 0.f, 0.f};
            x1[r] = ok ? bf4(*(const u32x2*)(p + HY0 + 256 + c4)) : (f32x4){0.f, 0.f, 0.f, 0.f}; vv[r] = ok ? bf4(*(const u32x2*)(p + HY0 + 512 + c4)) : (f32x4){0.f, 0.f, 0.f, 0.f}; }
#pragma unroll
        for (int tt = 0; tt < 8; ++tt) {
            const f32x4 u0 = w0[0] * x0[tt] + w0[1] * x0[tt + 1] + w0[2] * x0[tt + 2] + b0;
            const f32x4 xx = wx[0] * x1[tt] + wx[1] * x1[tt + 1] + wx[2] * x1[tt + 2] + bx, v2 = wv[0] * vv[tt] + wv[1] * vv[tt + 1] + wv[2] * vv[tt + 2] + bv, z = xx * v2;
            const f32x4 y = *(const LAS f32x4*)(yt + (tg * 8 + tt) * 260 + c4);
            const f32x4 o = (y + z * hd) * u0;
            u32x2 oo; oo.x = pk2(o[0], o[1]); oo.y = pk2(o[2], o[3]); *(u32x2*)(YMIX + (size_t)(c.row0 + tg * 8 + tt) * D + c4) = oo;
        }
        __syncthreads();
    }
}
__device__ __forceinline__ void ph_post_tok(CArgs& a, int l, int gw, int ngw) {
    const int lane = tidx() & 63;
    const bf16* P = (const bf16*)(a.ws + WS_P); bf16* YMIX = (bf16*)(a.ws + WS_YMIX);
    const float* GOF = (const float*)(a.ws + WS_MIX + MX_GOF); const float* GOB = (const float*)(a.ws + WS_MIX + MX_GOB);
    const float* DOF = (const float*)(a.ws + WS_MIX + MX_DOF); const float* DOB = (const float*)(a.ws + WS_MIX + MX_DOB);
    const f32x4 nwa = *(const f32x4*)(a.in[I_GLANW] + l * 64 + (4 * lane & 63)), nwd = *(const f32x4*)(a.in[I_GDNNW] + l * 64 + (4 * lane & 63));
    for (int row = gw; row < NTOK; row += ngw) {
        const size_t o4 = (size_t)row * 256 + 4 * lane;
        f32x4 og = *(const f32x4*)(GOF + o4) + *(const f32x4*)(GOB + o4), od = *(const f32x4*)(DOF + o4) + *(const f32x4*)(DOB + o4);
        float sg = og[0] * og[0] + og[1] * og[1] + og[2] * og[2] + og[3] * og[3], sd = od[0] * od[0] + od[1] * od[1] + od[2] * od[2] + od[3] * od[3];
        sg = row16_sum(sg); sd = row16_sum(sd);
        const float rg = rsqrtf(sg * (1.f / 64.f) + 1e-6f), rd = rsqrtf(sd * (1.f / 64.f) + 1e-6f);
        const u32x2 r2 = *(const u32x2*)(P + (size_t)row * D_INP + GLA0 + 512 + 4 * lane), z2 = *(const u32x2*)(P + (size_t)row * D_INP + GDN0 + 768 + 4 * lane);
        u32x2 w;
        w.x = pk2(og[0] * rg * nwa[0] * siluf_(lo_bf(r2.x)), og[1] * rg * nwa[1] * siluf_(hi_bf(r2.x))); w.y = pk2(og[2] * rg * nwa[2] * siluf_(lo_bf(r2.y)), og[3] * rg * nwa[3] * siluf_(hi_bf(r2.y)));
        *(u32x2*)(YMIX + (size_t)row * D + 512 + 4 * lane) = w;
        w.x = pk2(od[0] * rd * nwd[0] * siluf_(lo_bf(z2.x)), od[1] * rd * nwd[1] * siluf_(hi_bf(z2.x))); w.y = pk2(od[2] * rd * nwd[2] * siluf_(lo_bf(z2.y)), od[3] * rd * nwd[3] * siluf_(hi_bf(z2.y)));
        *(u32x2*)(YMIX + (size_t)row * D + 768 + 4 * lane) = w;
    }
}

__device__ __forceinline__ void ph_ln1_route(CArgs& a, int l, LAS unsigned char* lds, int bid, int nblk) {
    const int tid = tidx(), lane = tid & 63, w = __builtin_amdgcn_readfirstlane(tid >> 6);
    const float* MOD = (const float*)(a.ws + WS_MOD) + (size_t)l * 17 * 6144;
    float* X = (float*)(a.ws + WS_X); const float* TMP = (const float*)(a.ws + WS_TMP); bf16* HB = (bf16*)(a.ws + WS_HB);
    const float* lg = a.in[I_LN1G] + l * D; const float* lb = a.in[I_LN1B] + l * D;
    const float* br = a.in[I_BR] + l * NEXP;
    const bf16* wh = (const bf16*)(a.ws + WS_WRT) + (size_t)l * NEXP * D; const bf16* wl = wh + DEPTH * NEXP * D;
    unsigned* cnt = (unsigned*)(a.ws + WS_CTL) + CW_CNT + l * NEXP * 64;
    int* LIST = (int*)(a.ws + WS_LIST); int* TOPE = (int*)(a.ws + WS_TOPE); float* TOPW = (float*)(a.ws + WS_TOPW);
    LAS float* hrow = (LAS float*)lds;
    LAS float* part = (LAS float*)(lds + 65792);
    const int row_lo = (l == DEPTH - 1) ? NTOK_C : 0;
    const int e = lane & 31, par = lane >> 5, fr = lane & 15, kg = lane >> 4;
    f32x4 xv[2][4], tv[2][4];
#define LN1_FETCH(base_) do { _Pragma("unroll") for (int t = 0; t < 2; ++t) { const int row_ = (base_) + 2 * w + t; \
        const float* xs_ = (l == 0) ? (row_ < NTOK_C ? a.in[I_CTX] + (size_t)row_ * D : a.in[I_X] + (size_t)(row_ - NTOK_C) * D) : X + (size_t)row_ * D; \
        _Pragma("unroll") for (int j = 0; j < 4; ++j) { xv[t][j] = *(const f32x4*)(xs_ + j * 256 + 4 * lane); tv[t][j] = *(const f32x4*)(TMP + (size_t)row_ * D + j * 256 + 4 * lane); } } } while (0)
    int base = row_lo + bid * 16;
    if (base < NTOK) LN1_FETCH(base);
    int p_row = -1, p_ee = 0; unsigned p_pos = 0u; float p_ww = 0.f;
#pragma unroll 1
    for (; base < NTOK; base += nblk * 16) {
#pragma unroll
        for (int t = 0; t < 2; ++t) {
            const int row = base + 2 * w + t;
            const float* mv = MOD + (size_t)mod_vec(row) * 6144;
            f32x4 v[4]; float s = 0.f;
#pragma unroll
            for (int j = 0; j < 4; ++j) { const int c0 = j * 256 + 4 * lane; const f32x4 g1 = *(const f32x4*)(mv + 2048 + c0);
                v[j] = DN_ALPHA * xv[t][j] + g1 * tv[t][j]; s += (v[j][0] + v[j][1]) + (v[j][2] + v[j][3]); }
            const float mean = wave_sum(s) * (1.f / D); float s2 = 0.f;
#pragma unroll
            for (int j = 0; j < 4; ++j) { v[j] = v[j] - mean; s2 += (v[j][0] * v[j][0] + v[j][1] * v[j][1]) + (v[j][2] * v[j][2] + v[j][3] * v[j][3]); }
            const float rstd = rsqrtf(wave_sum(s2) * (1.f / D) + LN_EPS);
#pragma unroll
            for (int j = 0; j < 4; ++j) { const int c0 = j * 256 + 4 * lane; const f32x4 g = *(const f32x4*)(lg + c0), bb = *(const f32x4*)(lb + c0), sh = *(const f32x4*)(mv + 3072 + c0), sc = *(const f32x4*)(mv + 4096 + c0);
                const f32x4 xn = v[j] * rstd * g + bb; *(f32x4*)(X + (size_t)row * D + c0) = xn;
                const f32x4 hh = xn * (1.f + sc) + sh;
                *(unsigned*)(a.ws + WS_HB8 + (size_t)row * D + c0) = pk4_fp8(4.f * hh[0], 4.f * hh[1], 4.f * hh[2], 4.f * hh[3]);
                *(LAS f32x4*)(hrow + (2 * w + t) * 1028 + c0) = hh; }
        }
        __syncthreads();
        if (base + nblk * 16 < NTOK) LN1_FETCH(base + nblk * 16);
        {
            f32x4 acc[2] = {(f32x4){0.f, 0.f, 0.f, 0.f}, (f32x4){0.f, 0.f, 0.f, 0.f}};
#pragma unroll
            for (int ss = 0; ss < 4; ++ss) { const int k0 = 128 * w + 32 * ss + 8 * kg;
                const f32x4 h0 = *(const LAS f32x4*)(hrow + fr * 1028 + k0), h1 = *(const LAS f32x4*)(hrow + fr * 1028 + k0 + 4);
                u32x4 ah, al;
                ah.x = pk2(h0[0], h0[1]); ah.y = pk2(h0[2], h0[3]); ah.z = pk2(h1[0], h1[1]); ah.w = pk2(h1[2], h1[3]);
                al.x = pk2(h0[0] - lo_bf(ah.x), h0[1] - hi_bf(ah.x)); al.y = pk2(h0[2] - lo_bf(ah.y), h0[3] - hi_bf(ah.y)); al.z = pk2(h1[0] - lo_bf(ah.z), h1[1] - hi_bf(ah.z)); al.w = pk2(h1[2] - lo_bf(ah.w), h1[3] - hi_bf(ah.w));
                const bf16x8 Ah = __builtin_bit_cast(bf16x8, ah), Al = __builtin_bit_cast(bf16x8, al);
#pragma unroll
                for (int t = 0; t < 2; ++t) { const size_t wo = (size_t)(16 * t + fr) * D + k0;
                    const bf16x8 Bh = *(const bf16x8*)(wh + wo), Bl = *(const bf16x8*)(wl + wo);
                    acc[t] = __builtin_amdgcn_mfma_f32_16x16x32_bf16(Ah, Bh, acc[t], 0, 0, 0);
                    acc[t] = __builtin_amdgcn_mfma_f32_16x16x32_bf16(Ah, Bl, acc[t], 0, 0, 0);
                    acc[t] = __builtin_amdgcn_mfma_f32_16x16x32_bf16(Al, Bh, acc[t], 0, 0, 0); } }
#pragma unroll
            for (int t = 0; t < 2; ++t)
#pragma unroll
                for (int j = 0; j < 4; ++j) part[((w * 2 + t) * 16 + 4 * kg + j) * 16 + fr] = acc[t][j];
        }
        __syncthreads();
        {
            const int row = base + 2 * w + par;
            float cur = br[e];
#pragma unroll
            for (int ww = 0; ww < 8; ++ww) cur += part[((ww * 2 + (e >> 4)) * 16 + 2 * w + par) * 16 + (e & 15)];
            float tvv[4]; int ti[4];
#pragma unroll
            for (int k = 0; k < 4; ++k) { float bv = cur; int bi = e;
#define TOPSTEP(OV, OI) do { const float ov = (OV); const int oi = (OI); if (ov > bv || (ov == bv && oi < bi)) { bv = ov; bi = oi; } } while (0)
                TOPSTEP(dpp_f<0xB1>(bv), dpp_i<0xB1>(bi)); TOPSTEP(dpp_f<0x4E>(bv), dpp_i<0x4E>(bi)); TOPSTEP(dpp_f<0x141>(bv), dpp_i<0x141>(bi)); TOPSTEP(dpp_f<0x140>(bv), dpp_i<0x140>(bi));
                TOPSTEP(__shfl_xor(bv, 16), __shfl_xor(bi, 16));
#undef TOPSTEP
                tvv[k] = bv; ti[k] = bi; if (e == bi) cur = -3.0e38f; }
            const float e1 = __expf(tvv[1] - tvv[0]), e2 = __expf(tvv[2] - tvv[0]), e3 = __expf(tvv[3] - tvv[0]); const float inv = 1.f / (1.f + e1 + e2 + e3);
            if (e < 4) {
                if (p_row >= 0) { LIST[(size_t)p_ee * NTOK + p_pos] = p_row; TOPE[(size_t)p_row * 4 + e] = (p_ee << 20) | (int)p_pos; TOPW[(size_t)p_row * 4 + e] = p_ww; }
                p_ee = e == 0 ? ti[0] : e == 1 ? ti[1] : e == 2 ? ti[2] : ti[3]; p_ww = (e == 0 ? 1.f : e == 1 ? e1 : e == 2 ? e2 : e3) * inv; p_row = row;
                p_pos = atomicAdd(cnt + p_ee * 64, 1u); }
        }
    }
    if (e < 4 && p_row >= 0) { LIST[(size_t)p_ee * NTOK + p_pos] = p_row; TOPE[(size_t)p_row * 4 + e] = (p_ee << 20) | (int)p_pos; TOPW[(size_t)p_row * 4 + e] = p_ww; }
#undef LN1_FETCH
}
__device__ __forceinline__ void moe_tables(CArgs& a, int l, LAS unsigned char* lds, int NT) {
    LAS int* pre = (LAS int*)(lds + TAB_OFF); LAS int* mtl = pre + 40; LAS int* rowoff = pre + 80; LAS int* cn = pre + 120;
    if (tidx() == 0) { const unsigned* cnt = (const unsigned*)(a.ws + WS_CTL) + CW_CNT + l * NEXP * 64; int p = 0, r = 0;
        for (int e = 0; e < NEXP; ++e) { const int n = (int)__hip_atomic_load(cnt + e * 64, __ATOMIC_RELAXED, __HIP_MEMORY_SCOPE_AGENT), m = (n + 255) >> 8; pre[e] = p; mtl[e] = m > 0 ? m : 1; rowoff[e] = r; cn[e] = n; p += m * NT; r += m * 256; }
        pre[32] = p; }
    __syncthreads();
}
__device__ __forceinline__ void ph_ln2(CArgs& a, int l, LAS unsigned char* lds, int gw, int ngw) {
    const int lane = tidx() & 63;
    const float* MOD = (const float*)(a.ws + WS_MOD) + (size_t)l * 17 * 6144;
    float* X = (float*)(a.ws + WS_X); const bf16* YD = (const bf16*)(a.ws + WS_YD); bf16* HB = (bf16*)(a.ws + WS_HB);
    const float* lg = a.in[I_LN2G] + l * D; const float* lb = a.in[I_LN2B] + l * D;
    const int* TOPE = (const int*)(a.ws + WS_TOPE); const float* TOPW = (const float*)(a.ws + WS_TOPW);
    const LAS int* rowoff = (const LAS int*)(lds + TAB_OFF) + 80;
    const bool lastl = (l == DEPTH - 1);
    const int row_lo = lastl ? NTOK_C : 0;
#pragma unroll 1
    for (int row0 = row_lo + gw * 2; row0 < NTOK; row0 += ngw * 2) {
        u32x2 y2[2][4][4]; float tw[2][4]; f32x4 xv[2][4], g2v[2][4];
#pragma unroll
        for (int r = 0; r < 2; ++r) {
            const int row = row0 + r;
#pragma unroll
            for (int k = 0; k < 4; ++k) { const int te = TOPE[(size_t)row * 4 + k]; tw[r][k] = TOPW[(size_t)row * 4 + k];
                const bf16* yr = YD + ((size_t)(rowoff[te >> 20] + (te & 0xfffff))) * D;
#pragma unroll
                for (int j = 0; j < 4; ++j) y2[r][k][j] = *(const u32x2*)(yr + j * 256 + 4 * lane); }
            const float* mv = MOD + (size_t)mod_vec(row) * 6144;
#pragma unroll
            for (int j = 0; j < 4; ++j) { const int c0 = j * 256 + 4 * lane; xv[r][j] = *(const f32x4*)(X + (size_t)row * D + c0); g2v[r][j] = *(const f32x4*)(mv + 5120 + c0); }
        }
#pragma unroll
        for (int r = 0; r < 2; ++r) {
            const int row = row0 + r;
            const float* mv = MOD + (size_t)mod_vec(row) * 6144;
            f32x4 v[4]; float s = 0.f;
#pragma unroll
            for (int j = 0; j < 4; ++j) { f32x4 f = (f32x4){0.f, 0.f, 0.f, 0.f};
#pragma unroll
                for (int k = 0; k < 4; ++k) { const u32x2 yy = y2[r][k][j]; f += tw[r][k] * (f32x4){lo_bf(yy.x), hi_bf(yy.x), lo_bf(yy.y), hi_bf(yy.y)}; }
                v[j] = DN_ALPHA * xv[r][j] + g2v[r][j] * f; s += (v[j][0] + v[j][1]) + (v[j][2] + v[j][3]); }
            const float mean = wave_sum(s) * (1.f / D); float s2 = 0.f;
#pragma unroll
            for (int j = 0; j < 4; ++j) { v[j] = v[j] - mean; s2 += (v[j][0] * v[j][0] + v[j][1] * v[j][1]) + (v[j][2] * v[j][2] + v[j][3] * v[j][3]); }
            const float rstd = rsqrtf(wave_sum(s2) * (1.f / D) + LN_EPS);
            const float* mvn = mv + 17 * 6144;
#pragma unroll
            for (int j = 0; j < 4; ++j) { const int c0 = j * 256 + 4 * lane; const f32x4 g = *(const f32x4*)(lg + c0), bb = *(const f32x4*)(lb + c0);
                const f32x4 xn = v[j] * rstd * g + bb;
                if (lastl) *(f32x4*)(a.out + (size_t)(row - NTOK_C) * D + c0) = xn;
                else { *(f32x4*)(X + (size_t)row * D + c0) = xn; const f32x4 sh = *(const f32x4*)(mvn + c0), sc = *(const f32x4*)(mvn + 1024 + c0); const f32x4 hh = xn * (1.f + sc) + sh;
                    u32x2 o; o.x = pk2(hh[0], hh[1]); o.y = pk2(hh[2], hh[3]); *(u32x2*)(HB + (size_t)row * D + c0) = o; } }
        }
    }
}

constexpr int NPH = 2 + DEPTH * 9;
__device__ __forceinline__ CArgs* kargs() { CArgs* p = (CArgs*)__builtin_amdgcn_kernarg_segment_ptr(); asm volatile("" : "+s"(p)); return p; }
__global__ void __launch_bounds__(512, 2) trunk_fwd(Args a_unused) {
    extern __shared__ __attribute__((aligned(16))) unsigned char lds_raw[];
    LAS unsigned char* lds = (LAS unsigned char*)lds_raw;
    const int tid = threadIdx.x, wave = __builtin_amdgcn_readfirstlane(tid >> 6);
    const int bid = blockIdx.x, nblk = gridDim.x, gw = bid * 8 + wave, ngw = nblk * 8;
    volatile LAS unsigned* MISC = (volatile LAS unsigned*)(lds + MISC_OFF);
    if (tid < 64) MISC[tid] = 0u;
    __syncthreads();
    XcdBarrier bar; bar.x = 0; bar.st = nullptr;
    int lo, hi;
    { CArgs& a = *kargs(); lo = a.ph_lo; hi = a.ph_hi; bar.bar = (unsigned*)(a.ws + WS_CTL) + CW_BAR;
      if (hi - lo > 1) bar = xcd_barrier_post((unsigned*)(a.ws + WS_CTL) + CW_BAR, MISC); }
#define IN(k) (lo <= (k) && (k) < hi)
    unsigned long long tacc = 0ull, tbeg = 0ull;
#define PB_BEG(ty) do { if (PROBE_PH == (ty)) tbeg = __builtin_amdgcn_s_memrealtime(); } while (0)
#define PB_END(ty) do { if (PROBE_PH == (ty)) tacc += __builtin_amdgcn_s_memrealtime() - tbeg; } while (0)
#define SEAM(k) do { if (IN(k) && IN((k) + 1)) xcd_barrier(bar); } while (0)
    PB_BEG(0);
    if (IN(0)) { CArgs& a = *kargs(); unsigned long long t0 = 0ull;
#define PB_SUB(ty, stmt) do { if (PROBE_PH == (ty)) t0 = __builtin_amdgcn_s_memrealtime(); stmt; if (PROBE_PH == (ty)) tacc += __builtin_amdgcn_s_memrealtime() - t0; } while (0)
        PB_SUB(30, ph_mod(a, lds, bid, nblk)); __syncthreads(); PB_SUB(31, ph_filters(a, gw, ngw)); PB_SUB(32, ph_tr_small(a, lds, gw, ngw)); PB_SUB(33, ph_router_w(a, bid * 512 + tid, nblk * 512));
#undef PB_SUB
    }
    SEAM(0); PB_END(0); PB_BEG(1);
    if (IN(1)) { CArgs& a = *kargs(); ph_mod_input(a, gw, ngw); }
    SEAM(1); PB_END(1);
#pragma unroll 1
    for (int l = 0; l < DEPTH; ++l) {
        const int p0 = 2 + 9 * l;
        const bool lastl = (l == DEPTH - 1);
        PB_BEG(2);
        if (IN(p0 + 0)) {
            CArgs& a = *kargs();
            pg8::DenseSched S; S.init((const bf16*)(a.ws + WS_WIN) + (size_t)l * D_INP * 1024, 1024, NTOK, D_INP, nblk, bid, 0);
            pg8::EpiBf16 E{(bf16*)(a.ws + WS_P), D_INP, 0};
            pg8::gemm_phase<pg8::EpiBf16, pg8::DenseSched, true>(lds, (const char*)(a.ws + WS_HB), 1024, S, E);
        }
        SEAM(p0 + 0); PB_END(2); PB_BEG(3);
        if (IN(p0 + 1)) { CArgs& a = *kargs(); ph_prep_conv(a, l, lds, bid, nblk); ph_prep_tok(a, l, gw, ngw); }
        SEAM(p0 + 1); PB_END(3); PB_BEG(4);
        if (IN(p0 + 2)) { CArgs& a = *kargs(); ph_scan(a, l, lds, bid, nblk, tacc); }
        SEAM(p0 + 2); PB_END(4); PB_BEG(5);
        if (IN(p0 + 3)) { CArgs& a = *kargs(); ph_post_hyena(a, l, lds, bid, nblk); ph_post_tok(a, l, gw, ngw); }
        SEAM(p0 + 3); PB_END(5); PB_BEG(6);
        if (IN(p0 + 4)) {
            CArgs& a = *kargs();
            const int r0 = lastl ? NTOK_C : 0;
            pg8::DenseSched S; S.init((const bf16*)(a.ws + WS_WOUT) + (size_t)l * 1024 * 1024, 1024, NTOK - r0, 1024, nblk, bid, r0);
            pg8::EpiF32 E{(float*)(a.ws + WS_TMP), 1024, r0};
            pg8::gemm_phase<pg8::EpiF32, pg8::DenseSched, true>(lds, (const char*)(a.ws + WS_YMIX), 1024, S, E);
        }
        SEAM(p0 + 4); PB_END(6); PB_BEG(7);
        if (IN(p0 + 5)) { CArgs& a = *kargs(); ph_ln1_route(a, l, lds, bid, nblk); }
        SEAM(p0 + 5); PB_END(7); PB_BEG(8);
        if (IN(p0 + 6)) {
            CArgs& a = *kargs();
            moe_tables(a, l, lds, 8);
            const LAS int* tb = (const LAS int*)(lds + TAB_OFF);
            pg8::MoeSched<true, 8> S; S.Bt = (const char*)(a.ws + WS_WGU); S.bstride = (size_t)2048 * 1024; S.rb = 1024; S.list = (const int*)(a.ws + WS_LIST);
            S.pre = tb; S.mtl = tb + 40; S.rowoff = tb + 80; S.cnt = tb + 120; S.K = 1024; S.G = nblk; S.c = (nblk % 8 == 0) ? (bid % 8) * (nblk / 8) + bid / 8 : bid; S.total = tb[32];
            pg8::EpiSwiglu E{(bf16*)(a.ws + WS_H), a.in[I_BG] + (size_t)l * NEXP * 1024, a.in[I_BU] + (size_t)l * NEXP * 1024, tb + 80, 1.f / 128.f};
            pg8::gemm_phase_f8g<pg8::EpiSwiglu, pg8::MoeSched<true, 8>, true>(lds, (const char*)(a.ws + WS_HB8), 1024, S, E);
        }
        SEAM(p0 + 6); PB_END(8); PB_BEG(9);
        if (IN(p0 + 7)) {
            CArgs& a = *kargs();
            moe_tables(a, l, lds, 4);
            const LAS int* tb = (const LAS int*)(lds + TAB_OFF);
            pg8::MoeSched<false, 4> S; S.Bt = (const char*)(a.ws + WS_WD); S.bstride = (size_t)1024 * 1024; S.rb = 1024; S.list = nullptr;
            S.pre = tb; S.mtl = tb + 40; S.rowoff = tb + 80; S.cnt = tb + 120; S.K = 1024; S.G = nblk; S.c = (nblk % 8 == 0) ? (bid % 8) * (nblk / 8) + bid / 8 : bid; S.total = tb[32];
            pg8::EpiDown E{(bf16*)(a.ws + WS_YD), a.in[I_BD] + (size_t)l * NEXP * 1024, tb + 80, 1.f / 128.f};
            pg8::gemm_phase_f8<pg8::EpiDown, pg8::MoeSched<false, 4>, true>(lds, (const char*)(a.ws + WS_H), 1024, S, E);
        }
        SEAM(p0 + 7); PB_END(9); PB_BEG(10);
        if (IN(p0 + 8)) { CArgs& a = *kargs(); moe_tables(a, l, lds, 4); ph_ln2(a, l, lds, gw, ngw); }
        if (!lastl) SEAM(p0 + 8);
        PB_END(10);
    }
    if (PROBE_PH >= 0) { const unsigned long long t0 = __builtin_amdgcn_s_memrealtime(); while (__builtin_amdgcn_s_memrealtime() - t0 < tacc) __builtin_amdgcn_s_sleep(8); }
#undef IN
#undef SEAM
}

extern "C" void kernel_launch(void* const* d_in, const int* in_sizes, int n_in, void* d_out, int out_size, void* d_ws, size_t ws_size, hipStream_t stream) {
    static int grid = 0;
    if (grid == 0) {
        if (n_in != 39 || out_size != NTOK_L * D || ws_size < WS_END) { fprintf(stderr, "kernel_launch: unexpected problem (n_in %d, out %d, ws %zu < %zu)\n", n_in, out_size, ws_size, (size_t)WS_END); grid = -1; return; }
        int dev = 0, cus = 0, per_cu = 0;
        if (hipGetDevice(&dev) != hipSuccess || hipDeviceGetAttribute(&cus, hipDeviceAttributeMultiprocessorCount, dev) != hipSuccess) { grid = -1; return; }
        if (hipFuncSetAttribute((const void*)trunk_fwd, hipFuncAttributeMaxDynamicSharedMemorySize, LDS_BYTES) != hipSuccess) { fprintf(stderr, "kernel_launch: hipFuncSetAttribute failed\n"); grid = -1; return; }
        if (hipOccupancyMaxActiveBlocksPerMultiprocessor(&per_cu, (const void*)trunk_fwd, 512, LDS_BYTES) != hipSuccess || per_cu < 1) fprintf(stderr, "kernel_launch: occupancy query says %d\n", per_cu);
        (void)hipGetLastError();
        grid = cus;
    }
    if (grid < 0) return;
    (void)hipMemsetAsync((char*)d_ws + WS_CTL, 0, CTL_ZERO_BYTES, stream);
    Args a{};
    for (int i = 0; i < 39; ++i) a.in[i] = (const float*)d_in[i];
    a.out = (float*)d_out; a.ws = (unsigned char*)d_ws;
#if MK_FUSED
    a.ph_lo = 0; a.ph_hi = NPH;
    hipLaunchKernelGGL(trunk_fwd, dim3(grid), dim3(512), LDS_BYTES, stream, a);
#else
    for (int p = 0; p < NPH; ++p) { a.ph_lo = p; a.ph_hi = p + 1; hipLaunchKernelGGL(trunk_fwd, dim3(grid), dim3(512), LDS_BYTES, stream, a); }
#endif
}
```

```cpp
#include <hip/hip_runtime.h>
#include <cstdio>
#include <cstdint>

#ifndef MK_FUSED
#define MK_FUSED 1
#endif

#ifndef USE_NEW_GDN
#define USE_NEW_GDN 1
#endif
#ifndef USE_NEW_GLA
#define USE_NEW_GLA 1
#endif
#ifndef PROBE_PH
#define PROBE_PH -1
#endif

#define LAS __attribute__((address_space(3)))
#define GAS __attribute__((address_space(1)))
typedef unsigned short bf16;
typedef short bf16x8 __attribute__((ext_vector_type(8)));
typedef float f32x4 __attribute__((ext_vector_type(4)));
typedef float f32x2 __attribute__((ext_vector_type(2)));
typedef unsigned u32x4 __attribute__((ext_vector_type(4)));
typedef unsigned u32x2 __attribute__((ext_vector_type(2)));

constexpr int D = 1024, NB = 16, SEQ = 2048, CTXL = 256, DEPTH = 4;
constexpr int NTOK_C = NB * CTXL, NTOK_L = NB * SEQ, NTOK = NTOK_C + NTOK_L;
constexpr int D_IN = 3376, D_INP = 3584;
constexpr int HY0 = 0, SC0 = 768, GLA0 = 1536, GDN0 = 2336;
constexpr int NEXP = 32, TOPK = 4;
constexpr int MAXROWS = NTOK * TOPK + NEXP * 256;
constexpr float DN_ALPHA = 1.681792830507429f;
constexpr float LN_EPS = 1e-5f;

constexpr size_t MiB = 1u << 20;
constexpr size_t WS_CTL = 0, CTL_ZERO_BYTES = 1 * MiB;
constexpr size_t WS_MOD = 1 * MiB;
constexpr size_t WS_WRT = 3 * MiB;
constexpr size_t WS_KUN = 4 * MiB;
constexpr size_t WS_WIN = 36 * MiB;
constexpr size_t WS_WOUT = 64 * MiB;
constexpr size_t WS_WGU = 72 * MiB;
constexpr size_t WS_WD = 200 * MiB;
constexpr size_t WS_X = 264 * MiB;
constexpr size_t WS_HB = 408 * MiB;
constexpr size_t WS_P = 480 * MiB;
constexpr size_t WS_YMIX = 732 * MiB;
constexpr size_t WS_YD = WS_P;
constexpr size_t WS_TMP = 804 * MiB;
constexpr size_t WS_LIST = 948 * MiB;
constexpr size_t WS_TOPE = 953 * MiB;
constexpr size_t WS_TOPW = 954 * MiB;
constexpr size_t WS_H = 956 * MiB;
constexpr size_t WS_MIX = 1264 * MiB;
constexpr size_t MX_ZT = 0;
constexpr size_t MX_YT = 20 * MiB;
constexpr size_t MX_GDF = 56 * MiB, MX_GDB = 76 * MiB;
constexpr size_t MX_GOF = 96 * MiB, MX_GOB = 132 * MiB;
constexpr size_t MX_DQ = 168 * MiB, MX_DK = 204 * MiB, MX_DV = 240 * MiB;
constexpr size_t MX_DG = 276 * MiB;
constexpr size_t MX_DOF = 280 * MiB, MX_DOB = 316 * MiB;
constexpr size_t WS_HB8 = 1616 * MiB;
constexpr size_t WS_END = 1980 * MiB;
constexpr int NUNIT = 128 * 36;
constexpr size_t WS_CKD = 1656 * MiB;
constexpr size_t CD_M = 0;
constexpr size_t CD_E = 36 * MiB;
constexpr size_t CD_BT = 72 * MiB;
constexpr size_t CD_FT = 144 * MiB;
constexpr size_t CD_KB = 180 * MiB, CD_QB = 198 * MiB;
constexpr size_t WS_CKA = WS_CKD + 216 * MiB;
constexpr size_t CA_QC = 0;
constexpr size_t CA_FT = 20 * MiB;
constexpr size_t CA_UT = 60 * MiB;
constexpr size_t CA_DL = 100 * MiB;
static_assert(WS_CKA + CA_DL + (size_t)NUNIT * 32 * 4 <= WS_END, "chunk data");
static_assert((size_t)MAXROWS * 1024 * 2 <= 324 * MiB, "YD overlay");
static_assert(WS_H + (size_t)MAXROWS * 1024 * 2 <= WS_MIX, "H");
constexpr int CW_BAR = 4096;
constexpr int CW_CNT = 16384;

constexpr int LDS_BYTES = 147456;
constexpr int MISC_OFF = 143360;
constexpr int TAB_OFF = 143360 + 256;

__device__ __forceinline__ float bf2f(unsigned v) { return __uint_as_float(v << 16); }
__device__ __forceinline__ unsigned f2bf(float f) { unsigned u = __float_as_uint(f); return (u + 0x7fffu + ((u >> 16) & 1u)) >> 16; }
__device__ __forceinline__ unsigned pk2(float lo, float hi) { return f2bf(lo) | (f2bf(hi) << 16); }
__device__ __forceinline__ unsigned pk4_fp8(float a, float b, float c, float d) { int r = __builtin_amdgcn_cvt_pk_fp8_f32(a, b, 0, false); return (unsigned)__builtin_amdgcn_cvt_pk_fp8_f32(c, d, r, true); }
__device__ __forceinline__ float lo_bf(unsigned w) { return __uint_as_float(w << 16); }
__device__ __forceinline__ float hi_bf(unsigned w) { return __uint_as_float(w & 0xffff0000u); }
__device__ __forceinline__ float sigmoidf_(float x) { return 1.f / (1.f + __expf(-x)); }
__device__ __forceinline__ float siluf_(float x) { return x / (1.f + __expf(-x)); }
__device__ __forceinline__ float softplusf_(float x) { return x > 20.f ? x : log1pf(__expf(x)); }
__device__ __forceinline__ float logsigmoidf_(float x) { return x >= 0.f ? -log1pf(__expf(-x)) : x - log1pf(__expf(x)); }
__device__ __forceinline__ float sin_rev(float r) { return __builtin_amdgcn_sinf(__builtin_amdgcn_fractf(r)); }
__device__ __forceinline__ float sin_rad(float x) { return sin_rev(x * 0.15915494309189535f); }
template <int CTRL> __device__ __forceinline__ float dpp_f(float v) { return __builtin_bit_cast(float, __builtin_amdgcn_update_dpp(0, __builtin_bit_cast(int, v), CTRL, 0xf, 0xf, true)); }
template <int CTRL> __device__ __forceinline__ int dpp_i(int v) { return __builtin_amdgcn_update_dpp(0, v, CTRL, 0xf, 0xf, true); }
__device__ __forceinline__ float quad_sum(float v) { v += dpp_f<0xB1>(v); v += dpp_f<0x4E>(v); return v; }
__device__ __forceinline__ float row16_sum(float v) { v += dpp_f<0xB1>(v); v += dpp_f<0x4E>(v); v += dpp_f<0x141>(v); v += dpp_f<0x140>(v); return v; }
__device__ __forceinline__ float rdlane_f(float v, int l) { return __builtin_bit_cast(float, __builtin_amdgcn_readlane(__builtin_bit_cast(int, v), l)); }
__device__ __forceinline__ float wave_sum(float v) {
    v = row16_sum(v);
    return (rdlane_f(v, 0) + rdlane_f(v, 16)) + (rdlane_f(v, 32) + rdlane_f(v, 48));
}
__device__ __forceinline__ int tidx() { int t = threadIdx.x; asm volatile("" : "+v"(t)); return t; }

#define XB_TMO      128
#define XB_XCNT(j)  (256  + 64 * (j))
#define XB_XSUB(j)  (1280 + 64 * (j))
#define XB_XGEN(j)  (2304 + 64 * (j))
#define XB_TOP      3328
#define XB_TOPGEN   3392
#define XCD_BAR_WORDS 3456
#define XB_SPIN_CAP (1u << 25)
__device__ __forceinline__ unsigned xb_ld(unsigned* p)              { return __hip_atomic_load(p, __ATOMIC_RELAXED, __HIP_MEMORY_SCOPE_AGENT); }
__device__ __forceinline__ unsigned xb_add(unsigned* p, unsigned v) { return __hip_atomic_fetch_add(p, v, __ATOMIC_RELAXED, __HIP_MEMORY_SCOPE_AGENT); }
__device__ __forceinline__ unsigned xb_xcc_id() { return (unsigned)__builtin_amdgcn_s_getreg((3 << 11) | 20) & 0xFu; }
#define XB_SPIN(cond, bar) do { unsigned _sp = 0; while (cond) { __builtin_amdgcn_s_sleep(1); \
    if ((++_sp & 255u) == 0u) { if (xb_ld(&(bar)[XB_TMO])) break; if (_sp > XB_SPIN_CAP) { atomicAdd(&(bar)[XB_TMO], 1u); break; } } } } while (0)
struct XcdBarrier { unsigned* bar; unsigned x; volatile LAS unsigned* st; };
__device__ __forceinline__ XcdBarrier xcd_barrier_post(unsigned* bar, volatile LAS unsigned* st) {
    XcdBarrier b; b.bar = bar; b.x = xb_xcc_id(); b.st = st;
    if (threadIdx.x == 0) (void)xb_add(&bar[XB_XCNT(b.x)], 1u);
    return b;
}
__device__ __forceinline__ void xcd_barrier_complete(unsigned* bar, unsigned x, unsigned& nloc, unsigned& nx) {
    const unsigned G = gridDim.x * gridDim.y * gridDim.z;
    unsigned sum, cnt, mine, sp = 0u;
    for (;;) {
        sum = 0u; cnt = 0u; mine = 0u;
#pragma unroll
        for (unsigned j = 0; j < 16; ++j) { const unsigned c = xb_ld(&bar[XB_XCNT(j)]); sum += c; cnt += (c > 0u) ? 1u : 0u; mine = (j == x) ? c : mine; }
        if (sum == G) break;
        __builtin_amdgcn_s_sleep(1);
        if ((++sp & 255u) == 0u) { if (xb_ld(&bar[XB_TMO])) break; if (sp > XB_SPIN_CAP) { atomicAdd(&bar[XB_TMO], 1u); break; } }
    }
    nloc = mine > 0u ? mine : 1u; nx = cnt > 0u ? cnt : 1u;
}
__device__ __forceinline__ void xcd_barrier(const XcdBarrier& b) {
    asm volatile("s_waitcnt vmcnt(0)" ::: "memory");
    __syncthreads();
    if (threadIdx.x == 0) {
        unsigned* bar = b.bar;
        __builtin_amdgcn_s_waitcnt(0);
        unsigned nloc = b.st[0], nx = b.st[1];
        if (nloc == 0u) { xcd_barrier_complete(bar, b.x, nloc, nx); b.st[0] = nloc; b.st[1] = nx; }
        const unsigned old = xb_add(&bar[XB_XSUB(b.x)], 1u);
        const unsigned gen = old / nloc;
        if (old + 1u == (gen + 1u) * nloc) {
            __builtin_amdgcn_fence(__ATOMIC_RELEASE, "agent");
            asm volatile("s_waitcnt vmcnt(0)" ::: "memory");
            const unsigned og = xb_add(&bar[XB_TOP], 1u);
            const unsigned tg = og / nx;
            if (og + 1u == (tg + 1u) * nx) xb_add(&bar[XB_TOPGEN], 1u);
            else XB_SPIN(xb_ld(&bar[XB_TOPGEN]) == tg, bar);
            __builtin_amdgcn_fence(__ATOMIC_ACQUIRE, "agent");
            xb_add(&bar[XB_XGEN(b.x)], 1u);
            asm volatile("s_waitcnt vmcnt(0)" ::: "memory");
        } else {
            XB_SPIN(xb_ld(&bar[XB_XGEN(b.x)]) == gen, bar);
            __builtin_amdgcn_fence(__ATOMIC_ACQUIRE, "agent");
            asm volatile("s_waitcnt vmcnt(0)" ::: "memory");
        }
    }
    __syncthreads();
}

namespace pg8 {
constexpr int BM = 256, BK = 64, HALF = 128, HTB = HALF * BK * 2, STAGE_BYTES = 8 * HTB, NXCD = 8, WGM = 8;
__host__ __device__ __forceinline__ int lds_byte(int r, int c) { const int st = (r >> 4) * 2 + (c >> 5), rr = r & 15, cc = c & 31, ob = rr * 64 + cc * 2; return st * 1024 + (ob ^ (((ob >> 9) & 1) << 5)); }
__host__ __device__ __forceinline__ void stage_rc(int b, int& R, int& C) { const int st = b / 1024, sb = b % 1024, swz = sb ^ (((sb >> 9) & 1) << 5); R = (st >> 1) * 16 + swz / 64; C = (st & 1) * 32 + (swz % 64) / 2; }
__host__ __device__ __forceinline__ int perm32(int rho) { const int n = rho >> 4, i = rho & 15; return 8 * (i >> 2) + 4 * n + (i & 3); }
__device__ __forceinline__ unsigned cvt_pk_bf16(float lo, float hi) { unsigned r; asm volatile("v_cvt_pk_bf16_f32 %0, %1, %2" : "=v"(r) : "v"(lo), "v"(hi)); return r; }

struct Unit { int pm, pn, e, mt; };

struct DenseSched {
    const char* Bt; int K, nM, nN, nwg, G, c, row0;
    __device__ __forceinline__ void init(const bf16* Bt_, int K_, int M, int N, int G_, int c_, int row0_) { Bt = (const char*)Bt_; K = K_; nM = M / BM; nN = N / BM; nwg = nM * nN; G = G_; c = c_; row0 = row0_; }
    __device__ __forceinline__ bool next(int i, Unit& u) const {
        const long L = (long)i * G + c; if (L >= nwg) return false;
        int wgid = (int)L; { const int q = nwg / NXCD, r = nwg % NXCD, xcd = wgid % NXCD, off = wgid / NXCD; wgid = (xcd < r ? xcd * (q + 1) : r * (q + 1) + (xcd - r) * q) + off; }
        const int nig = WGM * nN, gid = wgid / nig, fm = gid * WGM, gsz = (nM - fm) < WGM ? (nM - fm) : WGM;
        u.pm = fm + ((wgid % nig) % gsz); u.pn = (wgid % nig) / gsz; u.e = 0; u.mt = 0; return true;
    }
    __device__ __forceinline__ const char* b_ptr(const Unit& u) const { return Bt + (size_t)u.pn * (size_t)(BM * 2) * K; }
    __device__ __forceinline__ void a_offsets(const Unit& u, const int (&R)[2], const int (&C)[2], unsigned (&v)[2][2]) const {
#pragma unroll
        for (int h = 0; h < 2; ++h)
#pragma unroll
            for (int i = 0; i < 2; ++i) v[h][i] = (unsigned)((row0 + u.pm * BM + h * HALF + R[i]) * K + C[i]) * 2u;
    }
};
template <bool GATHER, int NT>
struct MoeSched {
    const char* Bt; size_t bstride;
    int rb;
    const int* list;
    const LAS int* pre; const LAS int* mtl; const LAS int* rowoff; const LAS int* cnt;
    int K, G, c, total;
    __device__ __forceinline__ bool next(int i, Unit& u) const {
        const int L = i * G + c; if (L >= total) return false;
        int e = 0;
#pragma unroll 1
        for (int j = 1; j < NEXP; ++j) e = (L >= pre[j]) ? j : e;
        const int rem = L - pre[e];
        u.e = e; u.pn = rem % NT; u.mt = rem / NT; u.pm = 0; return true;
    }
    __device__ __forceinline__ const char* b_ptr(const Unit& u) const { return Bt + (size_t)u.e * bstride + (size_t)u.pn * (size_t)BM * rb; }
    __device__ __forceinline__ const char* a_ptr(const Unit& u, const char* Abase) const { return Abase + (size_t)(rowoff[u.e] + u.mt * BM) * rb; }
    __device__ __forceinline__ void a_offsets(const Unit& u, const int (&R)[2], const int (&C)[2], unsigned (&v)[2][2]) const {
        if (GATHER) {
            const int n = cnt[u.e]; const int* lp = list + (size_t)u.e * NTOK;
#pragma unroll
            for (int h = 0; h < 2; ++h)
#pragma unroll
                for (int i = 0; i < 2; ++i) { const int idx = u.mt * BM + h * HALF + R[i]; const int tok = idx < n ? lp[idx] : 0; v[h][i] = (unsigned)(tok * rb + 2 * C[i]); }
        } else {
            const int r0 = rowoff[u.e] + u.mt * BM;
#pragma unroll
            for (int h = 0; h < 2; ++h)
#pragma unroll
                for (int i = 0; i < 2; ++i) v[h][i] = (unsigned)((r0 + h * HALF + R[i]) * K + C[i]) * 2u;
        }
    }
};

struct EpiBf16 {
    static constexpr bool PERM = true;
    bf16* O; int ldc; int row0;
    __device__ __forceinline__ void operator()(const f32x4 (&acc)[2][2][4][2], const Unit& u, int wr, int wc, int fr, int fq) const {
        const int r0 = row0 + u.pm * BM + wr * 64 + fr, col0 = u.pn * BM + wc * 32 + 8 * fq;
#pragma unroll
        for (int ai = 0; ai < 2; ++ai)
#pragma unroll
            for (int m = 0; m < 4; ++m) { bf16* rowp = O + (size_t)(r0 + ai * HALF + m * 16) * ldc + col0;
#pragma unroll
                for (int bj = 0; bj < 2; ++bj) { const f32x4 v0 = acc[ai][bj][m][0], v1 = acc[ai][bj][m][1];
                    u32x4 w; w.x = cvt_pk_bf16(v0[0], v0[1]); w.y = cvt_pk_bf16(v0[2], v0[3]); w.z = cvt_pk_bf16(v1[0], v1[1]); w.w = cvt_pk_bf16(v1[2], v1[3]);
                    *(u32x4*)(rowp + bj * HALF) = w; } }
    }
};
struct EpiF32 {
    static constexpr bool PERM = false;
    float* Cc; int ldc; int row0;
    __device__ __forceinline__ void operator()(const f32x4 (&acc)[2][2][4][2], const Unit& u, int wr, int wc, int fr, int fq) const {
        const int r0 = row0 + u.pm * BM + wr * 64 + fr, col0 = u.pn * BM + wc * 32 + 4 * fq;
#pragma unroll
        for (int ai = 0; ai < 2; ++ai)
#pragma unroll
            for (int m = 0; m < 4; ++m) { float* rowp = Cc + (size_t)(r0 + ai * HALF + m * 16) * ldc + col0;
#pragma unroll
                for (int bj = 0; bj < 2; ++bj)
#pragma unroll
                    for (int n = 0; n < 2; ++n) *(f32x4*)(rowp + bj * HALF + n * 16) = acc[ai][bj][m][n]; }
    }
};
struct EpiSwiglu {
    static constexpr bool PERM = true;
    bf16* H; const float* bg; const float* bu; const LAS int* rowoff; float ws;
    __device__ __forceinline__ void operator()(const f32x4 (&acc)[2][2][4][2], const Unit& u, int wr, int wc, int fr, int fq) const {
        const int r0 = rowoff[u.e] + u.mt * BM + wr * 64 + fr, j0 = u.pn * HALF + wc * 32 + 8 * fq;
        f32x4 gb[2], ub[2];
#pragma unroll
        for (int n = 0; n < 2; ++n) { gb[n] = *(const f32x4*)(bg + u.e * 1024 + j0 + 4 * n); ub[n] = *(const f32x4*)(bu + u.e * 1024 + j0 + 4 * n); }
#pragma unroll
        for (int ai = 0; ai < 2; ++ai)
#pragma unroll
            for (int m = 0; m < 4; ++m) { unsigned char* rowp = (unsigned char*)H + (size_t)(r0 + ai * HALF + m * 16) * 1024 + j0; float hv[8];
#pragma unroll
                for (int n = 0; n < 2; ++n)
#pragma unroll
                    for (int j = 0; j < 4; ++j) { float g = acc[ai][0][m][n][j] * ws + gb[n][j], up = acc[ai][1][m][n][j] * ws + ub[n][j];
                        g = fminf(g, 7.f); up = fminf(fmaxf(up, -7.f), 7.f);
                        hv[n * 4 + j] = (up + 1.f) * g * __builtin_amdgcn_rcpf(1.f + __expf(-1.702f * g)); }
                *(u32x2*)rowp = (u32x2){pk4_fp8(4.f * hv[0], 4.f * hv[1], 4.f * hv[2], 4.f * hv[3]), pk4_fp8(4.f * hv[4], 4.f * hv[5], 4.f * hv[6], 4.f * hv[7])}; }
    }
};
struct EpiDown {
    static constexpr bool PERM = true;
    bf16* Y; const float* bd; const LAS int* rowoff; float ws;
    __device__ __forceinline__ void operator()(const f32x4 (&acc)[2][2][4][2], const Unit& u, int wr, int wc, int fr, int fq) const {
        const int r0 = rowoff[u.e] + u.mt * BM + wr * 64 + fr, col0 = u.pn * BM + wc * 32 + 8 * fq;
        f32x4 bv[2][2];
#pragma unroll
        for (int bj = 0; bj < 2; ++bj)
#pragma unroll
            for (int n = 0; n < 2; ++n) bv[bj][n] = *(const f32x4*)(bd + u.e * 1024 + col0 + bj * HALF + 4 * n);
#pragma unroll
        for (int ai = 0; ai < 2; ++ai)
#pragma unroll
            for (int m = 0; m < 4; ++m) { bf16* rowp = Y + (size_t)(r0 + ai * HALF + m * 16) * 1024 + col0;
#pragma unroll
                for (int bj = 0; bj < 2; ++bj) { const f32x4 v0 = acc[ai][bj][m][0] * ws + bv[bj][0], v1 = acc[ai][bj][m][1] * ws + bv[bj][1];
                    u32x4 w; w.x = cvt_pk_bf16(v0[0], v0[1]); w.y = cvt_pk_bf16(v0[2], v0[3]); w.z = cvt_pk_bf16(v1[0], v1[1]); w.w = cvt_pk_bf16(v1[2], v1[3]);
                    *(u32x4*)(rowp + bj * HALF) = w; } }
    }
};

template <class Epi, class Sched, bool ALIGN_EPI>
__device__ __forceinline__ void gemm_phase(LAS unsigned char* lds, const char* Abase, const int K, const Sched& S, const Epi& E) {
    const int tid = tidx(), wid = __builtin_amdgcn_readfirstlane(tid >> 6), lane = tid & 63, wr = wid >> 2, wc = wid & 3, fr = lane & 15, fq = lane >> 4;
    const int nt = K / BK;
    int Rp[2], Cp[2]; unsigned voffB0;
#pragma unroll
    for (int i = 0; i < 2; ++i) stage_rc(tid * 16 + i * 8192, Rp[i], Cp[i]);
    { const int Rb = Epi::PERM ? ((Rp[0] & ~31) + perm32(Rp[0] & 31)) : Rp[0]; voffB0 = (unsigned)(Rb * K + Cp[0]) * 2u; }
    const size_t kstep = (size_t)(BK * 2);
    const size_t hstep = (size_t)HALF * K * 2;
    const unsigned ldsw = (unsigned)wid * 1024u;
    const int aoff = lds_byte(wr * 64 + fr, fq * 8), boff = lds_byte(wc * 32 + fr, fq * 8);
#define PG8_SA(b, h) (((b) * 2 + (h)) * HTB)
#define PG8_SB(b, h) ((4 + (b) * 2 + (h)) * HTB)
#define PG8_STAGE(bufoff, gbase, voff) do { _Pragma("unroll") for (int _i = 0; _i < 2; ++_i) \
        __builtin_amdgcn_global_load_lds((const unsigned*)((const char*)(gbase) + (voff)[_i]), (LAS unsigned*)(lds + (bufoff) + ldsw + _i * 8192), 16, 0, 0); } while (0)
#define PG8_STAGEB(bufoff, gbase) do { _Pragma("unroll") for (int _i = 0; _i < 2; ++_i) \
        __builtin_amdgcn_global_load_lds((const unsigned*)((const char*)(gbase) + (size_t)_i * 128 * K + voffB0), (LAS unsigned*)(lds + (bufoff) + ldsw + _i * 8192), 16, 0, 0); } while (0)
#define PG8_LDA(dst, b, h) do { _Pragma("unroll") for (int m = 0; m < 4; ++m) _Pragma("unroll") for (int k = 0; k < 2; ++k) dst[m][k] = *(const LAS bf16x8*)(lds + PG8_SA(b, h) + aoff + m * 2048 + k * 1024); } while (0)
#define PG8_LDB(dst, b, h) do { _Pragma("unroll") for (int n = 0; n < 2; ++n) _Pragma("unroll") for (int k = 0; k < 2; ++k) dst[n][k] = *(const LAS bf16x8*)(lds + PG8_SB(b, h) + boff + n * 2048 + k * 1024); } while (0)
#define PG8_MMA(ai, bj, At, Bt) do { __builtin_amdgcn_s_setprio(1); _Pragma("unroll") for (int m = 0; m < 4; ++m) _Pragma("unroll") for (int n = 0; n < 2; ++n) _Pragma("unroll") for (int k = 0; k < 2; ++k) \
        acc[ai][bj][m][n] = __builtin_amdgcn_mfma_f32_16x16x32_bf16(Bt[n][k], At[m][k], acc[ai][bj][m][n], 0, 0, 0); __builtin_amdgcn_s_setprio(0); } while (0)
#define PG8_WAIT_V(n) asm volatile("s_waitcnt vmcnt(" #n ")" ::: "memory")
#define PG8_WAIT_L(n) asm volatile("s_waitcnt lgkmcnt(" #n ")" ::: "memory")
#define PG8_BAR __builtin_amdgcn_s_barrier()
#define PG8_SCHED __builtin_amdgcn_sched_barrier(0)
    Unit cur, nxt; int ui = 0;
    if (!S.next(0, cur)) return;
    f32x4 acc[2][2][4][2];
#pragma unroll
    for (int a = 0; a < 2; ++a)
#pragma unroll
        for (int b = 0; b < 2; ++b)
#pragma unroll
            for (int m = 0; m < 4; ++m)
#pragma unroll
                for (int n = 0; n < 2; ++n) acc[a][b][m][n] = (f32x4){0.f, 0.f, 0.f, 0.f};
    bf16x8 At[4][2], B0[2][2], B1[2][2];
    unsigned vAc[2][2], vAn[2][2];
    S.a_offsets(cur, Rp, Cp, vAc);
    const char* cB = S.b_ptr(cur);
    PG8_STAGEB(PG8_SB(0, 0), cB); PG8_STAGEB(PG8_SB(0, 1), cB + hstep); PG8_STAGE(PG8_SA(0, 0), Abase, vAc[0]); PG8_STAGE(PG8_SA(0, 1), Abase, vAc[1]);
    if (wr == 1) PG8_BAR;
    PG8_WAIT_V(2); PG8_BAR;
    PG8_STAGEB(PG8_SB(1, 0), cB + kstep); PG8_STAGE(PG8_SA(1, 0), Abase + kstep, vAc[0]); PG8_STAGEB(PG8_SB(1, 1), cB + hstep + kstep);
    PG8_WAIT_V(6); PG8_BAR;
    for (;;) {
        const bool has_next = S.next(ui + 1, nxt);
        const char* nB = has_next ? S.b_ptr(nxt) : cB;
        if (has_next) S.a_offsets(nxt, Rp, Cp, vAn);
        else {
#pragma unroll
            for (int h = 0; h < 2; ++h)
#pragma unroll
                for (int i = 0; i < 2; ++i) vAn[h][i] = vAc[h][i]; }
        for (int t = 0; t < nt; t += 2) {
            const bool last = (t == nt - 2);
            const char* a1 = Abase + (size_t)(t + 1) * kstep;
            const char* a2 = last ? Abase : Abase + (size_t)(t + 2) * kstep; const char* b2 = last ? nB : cB + (size_t)(t + 2) * kstep;
            const char* a3 = a2 + kstep; const char* b3 = b2 + kstep;
            unsigned v2[2][2];
#pragma unroll
            for (int h = 0; h < 2; ++h)
#pragma unroll
                for (int i = 0; i < 2; ++i) v2[h][i] = last ? vAn[h][i] : vAc[h][i];
            PG8_LDB(B0, 0, 0); PG8_LDB(B1, 0, 1); PG8_SCHED; PG8_LDA(At, 0, 0); PG8_STAGE(PG8_SA(1, 1), a1, vAc[1]);
            PG8_WAIT_V(8); PG8_WAIT_L(0); PG8_BAR; PG8_MMA(0, 0, At, B0); PG8_MMA(0, 1, At, B1); PG8_BAR; PG8_SCHED;
            PG8_LDA(At, 0, 1); PG8_STAGEB(PG8_SB(0, 0), b2); PG8_STAGEB(PG8_SB(0, 1), b2 + hstep); PG8_STAGE(PG8_SA(0, 0), a2, v2[0]);
            PG8_WAIT_V(8); PG8_WAIT_L(0); PG8_BAR; PG8_MMA(1, 0, At, B0); PG8_MMA(1, 1, At, B1); PG8_BAR; PG8_SCHED;
            PG8_LDB(B0, 1, 0); PG8_LDB(B1, 1, 1); PG8_SCHED; PG8_LDA(At, 1, 0); PG8_STAGE(PG8_SA(0, 1), a2, v2[1]);
            PG8_WAIT_V(8); PG8_WAIT_L(0); PG8_BAR; PG8_MMA(0, 0, At, B0); PG8_MMA(0, 1, At, B1); PG8_BAR; PG8_SCHED;
            PG8_LDA(At, 1, 1); PG8_STAGEB(PG8_SB(1, 0), b3); PG8_STAGEB(PG8_SB(1, 1), b3 + hstep); PG8_STAGE(PG8_SA(1, 0), a3, v2[0]);
            PG8_WAIT_V(8); PG8_WAIT_L(0); PG8_BAR; PG8_MMA(1, 0, At, B0); PG8_MMA(1, 1, At, B1); PG8_BAR; PG8_SCHED;
        }
        if constexpr (ALIGN_EPI) { if (wr == 0) PG8_BAR; }
        E(acc, cur, wr, wc, fr, fq);
        if (!has_next) break;
#pragma unroll
        for (int a = 0; a < 2; ++a)
#pragma unroll
            for (int b = 0; b < 2; ++b)
#pragma unroll
                for (int m = 0; m < 4; ++m)
#pragma unroll
                    for (int n = 0; n < 2; ++n) acc[a][b][m][n] = (f32x4){0.f, 0.f, 0.f, 0.f};
        cur = nxt; cB = nB; ++ui;
#pragma unroll
        for (int h = 0; h < 2; ++h)
#pragma unroll
            for (int i = 0; i < 2; ++i) vAc[h][i] = vAn[h][i];
        if constexpr (ALIGN_EPI) { if (wr == 1) PG8_BAR; }
    }
    PG8_WAIT_V(0);
    if constexpr (!ALIGN_EPI) { if (wr == 0) PG8_BAR; }
    PG8_BAR;
#undef PG8_SA
#undef PG8_SB
#undef PG8_STAGE
#undef PG8_STAGEB
#undef PG8_LDA
#undef PG8_LDB
#undef PG8_MMA
#undef PG8_WAIT_V
#undef PG8_WAIT_L
#undef PG8_BAR
#undef PG8_SCHED
}
template <class Epi, class Sched, bool ALIGN_EPI>
__device__ __forceinline__ void gemm_phase_f8g(LAS unsigned char* lds, const char* Abase, const int K, const Sched& S, const Epi& E) {
    const int tid = tidx(), wid = __builtin_amdgcn_readfirstlane(tid >> 6), lane = tid & 63, wr = wid >> 2, wc = wid & 3, fr = lane & 15, fq = lane >> 4;
    const int nt = K / 128;
    int Rp[2], Cp[2]; unsigned voffB0;
#pragma unroll
    for (int i = 0; i < 2; ++i) stage_rc(tid * 16 + i * 8192, Rp[i], Cp[i]);
    { const int Rb = Epi::PERM ? ((Rp[0] & ~31) + perm32(Rp[0] & 31)) : Rp[0]; voffB0 = (unsigned)(Rb * K + 2 * Cp[0]); }
    const size_t kstep = (size_t)(BK * 2);
    const size_t hstep = (size_t)HALF * K;
    const unsigned ldsw = (unsigned)wid * 1024u;
    const int aoff0 = lds_byte(wr * 64 + fr, 16 * (fq & 1)) + (fq >> 1) * 1024, boff0 = lds_byte(wc * 32 + fr, 16 * (fq & 1)) + (fq >> 1) * 1024;
#define PG8_SA(b, h) (((b) * 2 + (h)) * HTB)
#define PG8_SB(b, h) ((4 + (b) * 2 + (h)) * HTB)
#define PG8_STAGE(bufoff, gbase, voff) do { _Pragma("unroll") for (int _i = 0; _i < 2; ++_i) \
        __builtin_amdgcn_global_load_lds((const unsigned*)((const char*)(gbase) + (voff)[_i]), (LAS unsigned*)(lds + (bufoff) + ldsw + _i * 8192), 16, 0, 0); } while (0)
#define PG8_STAGEB(bufoff, gbase) do { _Pragma("unroll") for (int _i = 0; _i < 2; ++_i) \
        __builtin_amdgcn_global_load_lds((const unsigned*)((const char*)(gbase) + (size_t)_i * 64 * K + voffB0), (LAS unsigned*)(lds + (bufoff) + ldsw + _i * 8192), 16, 0, 0); } while (0)
#define PG8_LDA(dst, b, h) do { _Pragma("unroll") for (int m = 0; m < 4; ++m) { const u32x4 lo_ = *(const LAS u32x4*)(lds + PG8_SA(b, h) + aoff0 + m * 2048), hi_ = *(const LAS u32x4*)(lds + PG8_SA(b, h) + aoff0 + 16 + m * 2048); \
        dst[m] = (v8i){(int)lo_.x, (int)lo_.y, (int)lo_.z, (int)lo_.w, (int)hi_.x, (int)hi_.y, (int)hi_.z, (int)hi_.w}; } } while (0)
#define PG8_LDB(dst, b, h) do { _Pragma("unroll") for (int n = 0; n < 2; ++n) { const u32x4 lo_ = *(const LAS u32x4*)(lds + PG8_SB(b, h) + boff0 + n * 2048), hi_ = *(const LAS u32x4*)(lds + PG8_SB(b, h) + boff0 + 16 + n * 2048); \
        dst[n] = (v8i){(int)lo_.x, (int)lo_.y, (int)lo_.z, (int)lo_.w, (int)hi_.x, (int)hi_.y, (int)hi_.z, (int)hi_.w}; } } while (0)
#define PG8_MMA(ai, bj, At, Bt) do { __builtin_amdgcn_s_setprio(1); _Pragma("unroll") for (int m = 0; m < 4; ++m) _Pragma("unroll") for (int n = 0; n < 2; ++n) \
        asm volatile("v_mfma_scale_f32_16x16x128_f8f6f4 %0, %1, %2, %0, %3, %3 op_sel_hi:[0,0,0]" : "+v"(acc[ai][bj][m][n]) : "v"(Bt[n]), "v"(At[m]), "v"(f8scale)); __builtin_amdgcn_s_setprio(0); } while (0)
#define PG8_WAIT_V(n) asm volatile("s_waitcnt vmcnt(" #n ")" ::: "memory")
#define PG8_WAIT_L(n) asm volatile("s_waitcnt lgkmcnt(" #n ")" ::: "memory")
#define PG8_BAR __builtin_amdgcn_s_barrier()
#define PG8_SCHED __builtin_amdgcn_sched_barrier(0)
    Unit cur, nxt; int ui = 0;
    if (!S.next(0, cur)) return;
    f32x4 acc[2][2][4][2];
#pragma unroll
    for (int a = 0; a < 2; ++a)
#pragma unroll
        for (int b = 0; b < 2; ++b)
#pragma unroll
            for (int m = 0; m < 4; ++m)
#pragma unroll
                for (int n = 0; n < 2; ++n) acc[a][b][m][n] = (f32x4){0.f, 0.f, 0.f, 0.f};
    typedef int v8i __attribute__((ext_vector_type(8)));
    v8i At[4], B0[2], B1[2];
    const int f8scale = 0x7f7f7f7f;
    unsigned vAc[2][2], vAn[2][2];
    S.a_offsets(cur, Rp, Cp, vAc);
    const char* cB = S.b_ptr(cur);
    PG8_STAGEB(PG8_SB(0, 0), cB); PG8_STAGEB(PG8_SB(0, 1), cB + hstep); PG8_STAGE(PG8_SA(0, 0), Abase, vAc[0]); PG8_STAGE(PG8_SA(0, 1), Abase, vAc[1]);
    if (wr == 1) PG8_BAR;
    PG8_WAIT_V(2); PG8_BAR;
    PG8_STAGEB(PG8_SB(1, 0), cB + kstep); PG8_STAGE(PG8_SA(1, 0), Abase + kstep, vAc[0]); PG8_STAGEB(PG8_SB(1, 1), cB + hstep + kstep);
    PG8_WAIT_V(6); PG8_BAR;
    for (;;) {
        const bool has_next = S.next(ui + 1, nxt);
        const char* nB = has_next ? S.b_ptr(nxt) : cB;
        if (has_next) S.a_offsets(nxt, Rp, Cp, vAn);
        else {
#pragma unroll
            for (int h = 0; h < 2; ++h)
#pragma unroll
                for (int i = 0; i < 2; ++i) vAn[h][i] = vAc[h][i]; }
#pragma unroll 1
        for (int t = 0; t < nt; t += 2) {
            const bool last = (t == nt - 2);
            const char* a1 = Abase + (size_t)(t + 1) * kstep;
            const char* a2 = last ? Abase : Abase + (size_t)(t + 2) * kstep; const char* b2 = last ? nB : cB + (size_t)(t + 2) * kstep;
            const char* a3 = a2 + kstep; const char* b3 = b2 + kstep;
            unsigned v2[2][2];
#pragma unroll
            for (int h = 0; h < 2; ++h)
#pragma unroll
                for (int i = 0; i < 2; ++i) v2[h][i] = last ? vAn[h][i] : vAc[h][i];
            PG8_LDB(B0, 0, 0); PG8_LDB(B1, 0, 1); PG8_SCHED; PG8_LDA(At, 0, 0); PG8_STAGE(PG8_SA(1, 1), a1, vAc[1]);
            PG8_WAIT_V(8); PG8_WAIT_L(0); PG8_BAR; PG8_MMA(0, 0, At, B0); PG8_MMA(0, 1, At, B1); PG8_BAR; PG8_SCHED;
            PG8_LDA(At, 0, 1); PG8_STAGEB(PG8_SB(0, 0), b2); PG8_STAGEB(PG8_SB(0, 1), b2 + hstep); PG8_STAGE(PG8_SA(0, 0), a2, v2[0]);
            PG8_WAIT_V(8); PG8_WAIT_L(0); PG8_BAR; PG8_MMA(1, 0, At, B0); PG8_MMA(1, 1, At, B1); PG8_BAR; PG8_SCHED;
            PG8_LDB(B0, 1, 0); PG8_LDB(B1, 1, 1); PG8_SCHED; PG8_LDA(At, 1, 0); PG8_STAGE(PG8_SA(0, 1), a2, v2[1]);
            PG8_WAIT_V(8); PG8_WAIT_L(0); PG8_BAR; PG8_MMA(0, 0, At, B0); PG8_MMA(0, 1, At, B1); PG8_BAR; PG8_SCHED;
            PG8_LDA(At, 1, 1); PG8_STAGEB(PG8_SB(1, 0), b3); PG8_STAGEB(PG8_SB(1, 1), b3 + hstep); PG8_STAGE(PG8_SA(1, 0), a3, v2[0]);
            PG8_WAIT_V(8); PG8_WAIT_L(0); PG8_BAR; PG8_MMA(1, 0, At, B0); PG8_MMA(1, 1, At, B1); PG8_BAR; PG8_SCHED;
        }
        if constexpr (ALIGN_EPI) { if (wr == 0) PG8_BAR; }
        E(acc, cur, wr, wc, fr, fq);
        if (!has_next) break;
#pragma unroll
        for (int a = 0; a < 2; ++a)
#pragma unroll
            for (int b = 0; b < 2; ++b)
#pragma unroll
                for (int m = 0; m < 4; ++m)
#pragma unroll
                    for (int n = 0; n < 2; ++n) acc[a][b][m][n] = (f32x4){0.f, 0.f, 0.f, 0.f};
        cur = nxt; cB = nB; ++ui;
#pragma unroll
        for (int h = 0; h < 2; ++h)
#pragma unroll
            for (int i = 0; i < 2; ++i) vAc[h][i] = vAn[h][i];
        if constexpr (ALIGN_EPI) { if (wr == 1) PG8_BAR; }
    }
    PG8_WAIT_V(0);
    if constexpr (!ALIGN_EPI) { if (wr == 0) PG8_BAR; }
    PG8_BAR;
#undef PG8_SA
#undef PG8_SB
#undef PG8_STAGE
#undef PG8_STAGEB
#undef PG8_LDA
#undef PG8_LDB
#undef PG8_MMA
#undef PG8_WAIT_V
#undef PG8_WAIT_L
#undef PG8_BAR
#undef PG8_SCHED
}
template <class Epi, class Sched, bool ALIGN_EPI>
__device__ __forceinline__ void gemm_phase_f8(LAS unsigned char* lds, const char* Abase, const int K, const Sched& S, const Epi& E) {
    const int tid = tidx(), wid = __builtin_amdgcn_readfirstlane(tid >> 6), lane = tid & 63, wr = wid >> 2, wc = wid & 3, fr = lane & 15, fq = lane >> 4;
    const int nt = K / 128;
    int Rp[1], Cp[1]; unsigned voffB[1], voffA[1];
#pragma unroll
    for (int i = 0; i < 1; ++i) { stage_rc(tid * 16 + i * 8192, Rp[i], Cp[i]); const int Rb = Epi::PERM ? ((Rp[i] & ~31) + perm32(Rp[i] & 31)) : Rp[i]; voffB[i] = (unsigned)(Rb * K + 2 * Cp[i]); voffA[i] = (unsigned)(Rp[i] * K + 2 * Cp[i]); }
    const size_t kstep = (size_t)(BK * 2);
    const size_t hstep = (size_t)HALF * K;
    const unsigned ldsw = (unsigned)wid * 1024u;
    const int aoff0 = lds_byte(wr * 64 + fr, 16 * (fq & 1)) + (fq >> 1) * 1024, boff0 = lds_byte(wc * 32 + fr, 16 * (fq & 1)) + (fq >> 1) * 1024;
#define PG8_SA(b, h) (((b) * 2 + (h)) * HTB)
#define PG8_SB(b, h) ((4 + (b) * 2 + (h)) * HTB)
#define PG8_STAGE(bufoff, gbase, voff) do { _Pragma("unroll") for (int _i = 0; _i < 2; ++_i) \
        __builtin_amdgcn_global_load_lds((const unsigned*)((const char*)(gbase) + (size_t)_i * 64 * K + (voff)[0]), (LAS unsigned*)(lds + (bufoff) + ldsw + _i * 8192), 16, 0, 0); } while (0)
#define PG8_LDA(dst, b, h) do { _Pragma("unroll") for (int m = 0; m < 4; ++m) { const u32x4 lo_ = *(const LAS u32x4*)(lds + PG8_SA(b, h) + aoff0 + m * 2048), hi_ = *(const LAS u32x4*)(lds + PG8_SA(b, h) + aoff0 + 16 + m * 2048); \
        dst[m] = (v8i){(int)lo_.x, (int)lo_.y, (int)lo_.z, (int)lo_.w, (int)hi_.x, (int)hi_.y, (int)hi_.z, (int)hi_.w}; } } while (0)
#define PG8_LDB(dst, b, h) do { _Pragma("unroll") for (int n = 0; n < 2; ++n) { const u32x4 lo_ = *(const LAS u32x4*)(lds + PG8_SB(b, h) + boff0 + n * 2048), hi_ = *(const LAS u32x4*)(lds + PG8_SB(b, h) + boff0 + 16 + n * 2048); \
        dst[n] = (v8i){(int)lo_.x, (int)lo_.y, (int)lo_.z, (int)lo_.w, (int)hi_.x, (int)hi_.y, (int)hi_.z, (int)hi_.w}; } } while (0)
#define PG8_MMA(ai, bj, At, Bt) do { __builtin_amdgcn_s_setprio(1); _Pragma("unroll") for (int m = 0; m < 4; ++m) _Pragma("unroll") for (int n = 0; n < 2; ++n) \
        asm volatile("v_mfma_scale_f32_16x16x128_f8f6f4 %0, %1, %2, %0, %3, %3 op_sel_hi:[0,0,0]" : "+v"(acc[ai][bj][m][n]) : "v"(Bt[n]), "v"(At[m]), "v"(f8scale)); __builtin_amdgcn_s_setprio(0); } while (0)
#define PG8_WAIT_V(n) asm volatile("s_waitcnt vmcnt(" #n ")" ::: "memory")
#define PG8_WAIT_L(n) asm volatile("s_waitcnt lgkmcnt(" #n ")" ::: "memory")
#define PG8_BAR __builtin_amdgcn_s_barrier()
#define PG8_SCHED __builtin_amdgcn_sched_barrier(0)
    Unit cur, nxt; int ui = 0;
    if (!S.next(0, cur)) return;
    f32x4 acc[2][2][4][2];
#pragma unroll
    for (int a = 0; a < 2; ++a)
#pragma unroll
        for (int b = 0; b < 2; ++b)
#pragma unroll
            for (int m = 0; m < 4; ++m)
#pragma unroll
                for (int n = 0; n < 2; ++n) acc[a][b][m][n] = (f32x4){0.f, 0.f, 0.f, 0.f};
    typedef int v8i __attribute__((ext_vector_type(8)));
    v8i At[4], B0[2], B1[2];
    const int f8scale = 0x7f7f7f7f;
    const char* cA = S.a_ptr(cur, Abase);
    const char* cB = S.b_ptr(cur);
    PG8_STAGE(PG8_SB(0, 0), cB, voffB); PG8_STAGE(PG8_SB(0, 1), cB + hstep, voffB); PG8_STAGE(PG8_SA(0, 0), cA, voffA); PG8_STAGE(PG8_SA(0, 1), cA + hstep, voffA);
    if (wr == 1) PG8_BAR;
    PG8_WAIT_V(2); PG8_BAR;
    PG8_STAGE(PG8_SB(1, 0), cB + kstep, voffB); PG8_STAGE(PG8_SA(1, 0), cA + kstep, voffA); PG8_STAGE(PG8_SB(1, 1), cB + hstep + kstep, voffB);
    PG8_WAIT_V(6); PG8_BAR;
    for (;;) {
        const bool has_next = S.next(ui + 1, nxt);
        const char* nB = has_next ? S.b_ptr(nxt) : cB; const char* nA = has_next ? S.a_ptr(nxt, Abase) : cA;
#pragma unroll 1
        for (int t = 0; t < nt; t += 2) {
            const bool last = (t == nt - 2);
            const char* a1 = cA + (size_t)(t + 1) * kstep;
            const char* a2 = last ? nA : cA + (size_t)(t + 2) * kstep; const char* b2 = last ? nB : cB + (size_t)(t + 2) * kstep;
            const char* a3 = a2 + kstep; const char* b3 = b2 + kstep;
            PG8_LDB(B0, 0, 0); PG8_LDB(B1, 0, 1); PG8_SCHED; PG8_LDA(At, 0, 0); PG8_STAGE(PG8_SA(1, 1), a1 + hstep, voffA);
            PG8_WAIT_V(8); PG8_WAIT_L(0); PG8_BAR; PG8_MMA(0, 0, At, B0); PG8_MMA(0, 1, At, B1); PG8_BAR; PG8_SCHED;
            PG8_LDA(At, 0, 1); PG8_STAGE(PG8_SB(0, 0), b2, voffB); PG8_STAGE(PG8_SB(0, 1), b2 + hstep, voffB); PG8_STAGE(PG8_SA(0, 0), a2, voffA);
            PG8_WAIT_V(8); PG8_WAIT_L(0); PG8_BAR; PG8_MMA(1, 0, At, B0); PG8_MMA(1, 1, At, B1); PG8_BAR; PG8_SCHED;
            PG8_LDB(B0, 1, 0); PG8_LDB(B1, 1, 1); PG8_SCHED; PG8_LDA(At, 1, 0); PG8_STAGE(PG8_SA(0, 1), a2 + hstep, voffA);
            PG8_WAIT_V(8); PG8_WAIT_L(0); PG8_BAR; PG8_MMA(0, 0, At, B0); PG8_MMA(0, 1, At, B1); PG8_BAR; PG8_SCHED;
            PG8_LDA(At, 1, 1); PG8_STAGE(PG8_SB(1, 0), b3, voffB); PG8_STAGE(PG8_SB(1, 1), b3 + hstep, voffB); PG8_STAGE(PG8_SA(1, 0), a3, voffA);
            PG8_WAIT_V(8); PG8_WAIT_L(0); PG8_BAR; PG8_MMA(1, 0, At, B0); PG8_MMA(1, 1, At, B1); PG8_BAR; PG8_SCHED;
        }
        if constexpr (ALIGN_EPI) { if (wr == 0) PG8_BAR; }
        E(acc, cur, wr, wc, fr, fq);
        if (!has_next) break;
#pragma unroll
        for (int a = 0; a < 2; ++a)
#pragma unroll
            for (int b = 0; b < 2; ++b)
#pragma unroll
                for (int m = 0; m < 4; ++m)
#pragma unroll
                    for (int n = 0; n < 2; ++n) acc[a][b][m][n] = (f32x4){0.f, 0.f, 0.f, 0.f};
        cur = nxt; cB = nB; cA = nA; ++ui;
        if constexpr (ALIGN_EPI) { if (wr == 1) PG8_BAR; }
    }
    PG8_WAIT_V(0);
    if constexpr (!ALIGN_EPI) { if (wr == 0) PG8_BAR; }
    PG8_BAR;
#undef PG8_SA
#undef PG8_SB
#undef PG8_STAGE
#undef PG8_LDA
#undef PG8_LDB
#undef PG8_MMA
#undef PG8_WAIT_V
#undef PG8_WAIT_L
#undef PG8_BAR
#undef PG8_SCHED
}
}

struct Args { const float* in[39]; float* out; unsigned char* ws; int ph_lo, ph_hi; };
typedef const __attribute__((address_space(4))) Args CArgs;
enum { I_X = 0, I_C, I_CTX, I_CCTX, I_WADA, I_BADA, I_WIN, I_HYCW, I_HYCB, I_HYW1, I_HYB1, I_HYW2, I_HYB2, I_HYW3, I_HYB3, I_HYW4, I_HYFREQ, I_HYD, I_SCCW,
       I_GLAWA, I_GLABA, I_GLANW, I_GDNCW, I_GDNALOG, I_GDNDT, I_GDNNW, I_WOUT, I_LN1G, I_LN1B, I_WR, I_BR, I_WG, I_BG, I_WU, I_BU, I_WD, I_BD, I_LN2G, I_LN2B };

__device__ __forceinline__ int row_batch(int row) { return row < NTOK_C ? (row >> 8) : ((row - NTOK_C) >> 11); }
__device__ __forceinline__ int mod_vec(int row) { return row < NTOK_C ? 16 : ((row - NTOK_C) >> 11); }

__device__ __forceinline__ void ph_mod(CArgs& a, LAS unsigned char* lds, int bid, int nblk) {
    LAS float* sc = (LAS float*)lds; LAS float* red = (LAS float*)(lds + 17 * 1024 * 4);
    const int tid = tidx(), lane = tid & 63, w = tid >> 6;
    const float* c = a.in[I_C]; const float* cc = a.in[I_CCTX];
    for (int i = tid; i < 17 * 1024; i += 512) { const float v = i < 16 * 1024 ? c[i] : cc[i - 16 * 1024]; sc[i] = siluf_(v); }
    __syncthreads();
    float* MOD = (float*)(a.ws + WS_MOD);
    for (int it = bid; it < DEPTH * 96; it += nblk) {
        const int l = it / 96, j0 = (it % 96) * 64;
        const float* W = a.in[I_WADA] + (size_t)l * 1024 * 6144 + j0 + lane;
        float acc[17];
#pragma unroll
        for (int v = 0; v < 17; ++v) acc[v] = 0.f;
#pragma unroll 16
        for (int kk = 0; kk < 128; ++kk) { const int k = w * 128 + kk; const float wv = W[(size_t)k * 6144];
#pragma unroll
            for (int v = 0; v < 17; ++v) acc[v] += sc[v * 1024 + k] * wv; }
#pragma unroll
        for (int v = 0; v < 17; ++v) red[(w * 17 + v) * 64 + lane] = acc[v];
        __syncthreads();
        for (int o = tid; o < 17 * 64; o += 512) { const int v = o >> 6, jj = o & 63; float s = 0.f;
#pragma unroll
            for (int ww = 0; ww < 8; ++ww) s += red[(ww * 17 + v) * 64 + jj];
            MOD[(size_t)(l * 17 + v) * 6144 + j0 + jj] = s + a.in[I_BADA][l * 6144 + j0 + jj]; }
        __syncthreads();
    }
}

__device__ __forceinline__ void ph_filters(CArgs& a, int gw, int ngw) {
    const int lane = tidx() & 63;
    float* KUN = (float*)(a.ws + WS_KUN);
#pragma unroll 1
    for (int it = gw; it < DEPTH * (CTXL + SEQ) / 4; it += ngw) {
        const int l = it / ((CTXL + SEQ) / 4), r = (it % ((CTXL + SEQ) / 4)) * 4, Lt = r < CTXL ? 0 : 1, pos0 = Lt ? r - CTXL : r, L = Lt ? SEQ : CTXL;
        float z[4], tn[4];
#pragma unroll
        for (int p = 0; p < 4; ++p) { const int pos = pos0 + p; tn[p] = (float)pos / (float)(L - 1); z[p] = 0.f;
            if (lane == 0) z[p] = tn[p];
            else if (lane <= 32) { const int j = (lane - 1) & 15; const float fj = 1e-4f + (float)j * ((15.f - 1e-4f) / 15.f);
                double rev = (double)fj * (double)pos / (double)L; rev -= floor(rev); const float rf = (float)rev;
                z[p] = lane <= 16 ? sin_rev(rf + 0.25f) : -sin_rev(rf); } }
        const float* w1 = a.in[I_HYW1] + l * 33 * 64; const float* w2 = a.in[I_HYW2] + l * 64 * 64; const float* w3 = a.in[I_HYW3] + l * 64 * 64; const float* w4 = a.in[I_HYW4] + l * 64 * 512;
        const float* fq = a.in[I_HYFREQ] + l * 3 * 64;
        float s[4], h[4];
        { const float bb = a.in[I_HYB1][l * 64 + lane];
#pragma unroll
          for (int p = 0; p < 4; ++p) s[p] = bb; }
#pragma unroll
        for (int i = 0; i < 33; ++i) { const float ww = w1[i * 64 + lane];
#pragma unroll
            for (int p = 0; p < 4; ++p) s[p] += rdlane_f(z[p], i) * ww; }
#pragma unroll
        for (int p = 0; p < 4; ++p) h[p] = sin_rad(fq[lane] * s[p]);
        { const float bb = a.in[I_HYB2][l * 64 + lane];
#pragma unroll
          for (int p = 0; p < 4; ++p) s[p] = bb; }
#pragma unroll 16
        for (int i = 0; i < 64; ++i) { const float ww = w2[i * 64 + lane];
#pragma unroll
            for (int p = 0; p < 4; ++p) s[p] += rdlane_f(h[p], i) * ww; }
#pragma unroll
        for (int p = 0; p < 4; ++p) h[p] = sin_rad(fq[64 + lane] * s[p]);
        { const float bb = a.in[I_HYB3][l * 64 + lane];
#pragma unroll
          for (int p = 0; p < 4; ++p) s[p] = bb; }
#pragma unroll 16
        for (int i = 0; i < 64; ++i) { const float ww = w3[i * 64 + lane];
#pragma unroll
            for (int p = 0; p < 4; ++p) s[p] += rdlane_f(h[p], i) * ww; }
#pragma unroll
        for (int p = 0; p < 4; ++p) h[p] = sin_rad(fq[128 + lane] * s[p]);
        float k[8][4];
#pragma unroll
        for (int m = 0; m < 8; ++m)
#pragma unroll
            for (int p = 0; p < 4; ++p) k[m][p] = 0.f;
#pragma unroll 4
        for (int i = 0; i < 64; ++i) { float hi[4];
#pragma unroll
            for (int p = 0; p < 4; ++p) hi[p] = rdlane_f(h[p], i);
#pragma unroll
            for (int m = 0; m < 8; ++m) { const float ww = w4[i * 512 + m * 64 + lane];
#pragma unroll
                for (int p = 0; p < 4; ++p) k[m][p] += hi[p] * ww; } }
#pragma unroll
        for (int m = 0; m < 8; ++m) { const int o = m * 64 + lane, ch = o & 255;
            const float delta = 3.0701134573253944f + (float)ch * ((15.350567286626972f - 3.0701134573253944f) / 255.f);
            *(f32x4*)(KUN + ((size_t)((l * 2 + Lt) * 512 + o)) * 2048 + pos0) = (f32x4){k[m][0] * __expf(-tn[0] * delta), k[m][1] * __expf(-tn[1] * delta), k[m][2] * __expf(-tn[2] * delta), k[m][3] * __expf(-tn[3] * delta)}; }
    }
}

__device__ __forceinline__ void ph_router_w(CArgs& a, int gt, int ngt) {
    bf16* hi = (bf16*)(a.ws + WS_WRT); bf16* lo = hi + DEPTH * NEXP * D;
    for (int i = gt; i < DEPTH * NEXP * D; i += ngt) { const int l = i / (NEXP * D), r = i % (NEXP * D), e = r / D, k = r % D;
        const float w = a.in[I_WR][((size_t)l * D + k) * NEXP + e]; const unsigned h = f2bf(w); hi[i] = (bf16)h; lo[i] = (bf16)f2bf(w - bf2f(h)); }
}
__device__ __forceinline__ void tr_item(const float* W, int Nsrc, int K, bf16* WTrow0, int n0, int k0, LAS float* scr, int lane) {
    const int c4 = (lane & 7) * 4; const bool ok = n0 + c4 < Nsrc;
    f32x4 t[8];
#pragma unroll
    for (int j = 0; j < 8; ++j) { const int kk = 8 * j + (lane >> 3); t[j] = ok ? *(const f32x4*)(W + (size_t)(k0 + kk) * Nsrc + n0 + c4) : (f32x4){0.f, 0.f, 0.f, 0.f}; }
#pragma unroll
    for (int j = 0; j < 8; ++j) { const int kk = 8 * j + (lane >> 3); LAS float* d = scr + kk * 33 + c4; d[0] = t[j][0]; d[1] = t[j][1]; d[2] = t[j][2]; d[3] = t[j][3]; }
    asm volatile("s_waitcnt lgkmcnt(0)" ::: "memory");
    const int c = lane & 7;
#pragma unroll
    for (int j = 0; j < 4; ++j) { const int n = (lane >> 3) + 8 * j; const LAS float* s = scr + (8 * c) * 33 + n;
        u32x4 o; o.x = pk2(s[0 * 33], s[1 * 33]); o.y = pk2(s[2 * 33], s[3 * 33]); o.z = pk2(s[4 * 33], s[5 * 33]); o.w = pk2(s[6 * 33], s[7 * 33]);
        *(u32x4*)(WTrow0 + (size_t)n * K + k0 + 8 * c) = o; }
    asm volatile("s_waitcnt lgkmcnt(0)" ::: "memory");
}
__device__ __forceinline__ void tr_item_f8(const float* W, int Nsrc, int K, unsigned char* WTrow0, int n0, int k0, float scale, LAS float* scr, int lane) {
    const int c4 = (lane & 7) * 4;
    f32x4 t[8];
#pragma unroll
    for (int j = 0; j < 8; ++j) { const int kk = 8 * j + (lane >> 3); t[j] = *(const f32x4*)(W + (size_t)(k0 + kk) * Nsrc + n0 + c4); }
#pragma unroll
    for (int j = 0; j < 8; ++j) { const int kk = 8 * j + (lane >> 3); LAS float* d = scr + kk * 33 + c4; d[0] = t[j][0]; d[1] = t[j][1]; d[2] = t[j][2]; d[3] = t[j][3]; }
    asm volatile("s_waitcnt lgkmcnt(0)" ::: "memory");
    const int n = lane >> 1, half = lane & 1; const LAS float* s = scr + (32 * half) * 33 + n;
    unsigned o[8];
#pragma unroll
    for (int i = 0; i < 8; ++i) o[i] = pk4_fp8(s[(4 * i) * 33] * scale, s[(4 * i + 1) * 33] * scale, s[(4 * i + 2) * 33] * scale, s[(4 * i + 3) * 33] * scale);
    unsigned char* dst = WTrow0 + (size_t)n * K + k0 + 32 * half;
    *(u32x4*)dst = (u32x4){o[0], o[1], o[2], o[3]}; *(u32x4*)(dst + 16) = (u32x4){o[4], o[5], o[6], o[7]};
    asm volatile("s_waitcnt lgkmcnt(0)" ::: "memory");
}
__device__ __forceinline__ void ph_tr_small(CArgs& a, LAS unsigned char* lds, int gw, int ngw) {
    const int lane = tidx() & 63, w = tidx() >> 6;
    LAS float* scr = (LAS float*)(lds + w * 8448);
    constexpr int I_IN = 16 * (D_INP / 32), I_OUT = 16 * 32;
    for (int it = gw; it < DEPTH * (I_IN + I_OUT); it += ngw) {
        const int l = it / (I_IN + I_OUT); int r = it % (I_IN + I_OUT);
        if (r < I_IN) { const int kb = r / (D_INP / 32), nb = r % (D_INP / 32);
            tr_item(a.in[I_WIN] + (size_t)l * 1024 * D_IN, D_IN, 1024, (bf16*)(a.ws + WS_WIN) + ((size_t)l * D_INP + nb * 32) * 1024, nb * 32, kb * 64, scr, lane); }
        else { r -= I_IN; const int kb = r / 32, nb = r % 32;
            tr_item(a.in[I_WOUT] + (size_t)l * 1024 * 1024, 1024, 1024, (bf16*)(a.ws + WS_WOUT) + ((size_t)l * 1024 + nb * 32) * 1024, nb * 32, kb * 64, scr, lane); }
    }
}
__device__ __forceinline__ void tr_experts_range(CArgs& a, int l, LAS unsigned char* scrb, int first, int last, int stride, int lane) {
    LAS float* scr = (LAS float*)scrb;
#pragma unroll 1
    for (int it = first; it < last; it += stride) {
        const int e = it / 1536, r = it % 1536, which = r / 512, q = r % 512, kb = q / 32, nb = q % 32, n0 = nb * 32;
        const float* W = a.in[which == 0 ? I_WG : (which == 1 ? I_WU : I_WD)] + ((size_t)(l * NEXP + e)) * 1024 * 1024;
        if (which == 2) tr_item_f8(W, 1024, 1024, a.ws + WS_WD + ((size_t)e * 1024 + n0) * 1024, n0, kb * 64, 32.f, scr, lane);
        else tr_item_f8(W, 1024, 1024, a.ws + WS_WGU + ((size_t)e * 2048 + (n0 >> 7) * 256 + which * 128 + (n0 & 127)) * 1024, n0, kb * 64, 32.f, scr, lane);
    }
}
__device__ __forceinline__ void ph_mod_input(CArgs& a, int gw, int ngw) {
    const int lane = tidx() & 63;
    const float* MOD = (const float*)(a.ws + WS_MOD);
    bf16* HB = (bf16*)(a.ws + WS_HB);
    for (int row = gw; row < NTOK; row += ngw) {
        const float* src = row < NTOK_C ? a.in[I_CTX] + (size_t)row * D : a.in[I_X] + (size_t)(row - NTOK_C) * D;
        const float* mv = MOD + (size_t)mod_vec(row) * 6144;
#pragma unroll
        for (int j = 0; j < 4; ++j) { const int c0 = j * 256 + lane * 4; const f32x4 x = *(const f32x4*)(src + c0), sh = *(const f32x4*)(mv + c0), sc = *(const f32x4*)(mv + 1024 + c0);
            u32x2 o; o.x = pk2(x[0] * (1.f + sc[0]) + sh[0], x[1] * (1.f + sc[1]) + sh[1]); o.y = pk2(x[2] * (1.f + sc[2]) + sh[2], x[3] * (1.f + sc[3]) + sh[3]);
            *(u32x2*)(HB + (size_t)row * D + c0) = o; }
    }
}

struct Chunk { int b, t0, L, row0, lo, hi; };
__device__ __forceinline__ Chunk chunk_of(int it) {
    Chunk c;
    if (it < 64) { c.b = it >> 2; c.t0 = (it & 3) * 64; c.L = CTXL; c.row0 = c.b * CTXL + c.t0; c.lo = 0; c.hi = CTXL; }
    else { const int r = it - 64; c.b = r >> 5; c.t0 = (r & 31) * 64; c.L = SEQ; c.row0 = NTOK_C + c.b * SEQ + c.t0; c.lo = c.t0; c.hi = c.t0 + 64; }
    return c;
}
__device__ __forceinline__ f32x4 bf4(u32x2 v) { return (f32x4){lo_bf(v.x), hi_bf(v.x), lo_bf(v.y), hi_bf(v.y)}; }
__device__ __forceinline__ void ph_prep_conv(CArgs& a, int l, LAS unsigned char* lds, int bid, int nblk) {
    const bf16* P = (const bf16*)(a.ws + WS_P);
    bf16* ZT = (bf16*)(a.ws + WS_MIX + MX_ZT); bf16* YMIX = (bf16*)(a.ws + WS_YMIX);
    LAS bf16* zt = (LAS bf16*)lds;
    const int tid = tidx(), c4 = (tid & 63) * 4, tg = tid >> 6;
    const float* hw = a.in[I_HYCW] + l * 3 * 768; const float* hb = a.in[I_HYCB] + l * 768; const float* sw = a.in[I_SCCW] + l * 3 * 256;
    f32x4 wx[3], wv[3], ws3[3];
#pragma unroll
    for (int k = 0; k < 3; ++k) { wx[k] = *(const f32x4*)(hw + k * 768 + 256 + c4); wv[k] = *(const f32x4*)(hw + k * 768 + 512 + c4); ws3[k] = *(const f32x4*)(sw + k * 256 + c4); }
    const f32x4 bx = *(const f32x4*)(hb + 256 + c4), bv = *(const f32x4*)(hb + 512 + c4);
#pragma unroll 1
    for (int it = bid; it < 576; it += nblk) {
        const Chunk c = chunk_of(it);
        const int tb = c.t0 + tg * 8;
        const bf16* pb = P + (size_t)(c.row0 + tg * 8) * D_INP;
        f32x4 x1[10], vv[10], mm[10];
#pragma unroll
        for (int r = 0; r < 10; ++r) { const int t = tb + r - 1; const bool ok = t >= c.lo && t < c.hi; const bf16* p = pb + (ptrdiff_t)(r - 1) * D_INP;
            x1[r] = ok ? bf4(*(const u32x2*)(p + HY0 + 256 + c4)) : (f32x4){0.f, 0.f, 0.f, 0.f}; vv[r] = ok ? bf4(*(const u32x2*)(p + HY0 + 512 + c4)) : (f32x4){0.f, 0.f, 0.f, 0.f};
            mm[r] = ok ? bf4(*(const u32x2*)(p + SC0 + 256 + c4)) * bf4(*(const u32x2*)(p + SC0 + 512 + c4)) : (f32x4){0.f, 0.f, 0.f, 0.f}; }
#pragma unroll
        for (int tt = 0; tt < 8; ++tt) {
            const f32x4 xx = wx[0] * x1[tt] + wx[1] * x1[tt + 1] + wx[2] * x1[tt + 2] + bx, v2 = wv[0] * vv[tt] + wv[1] * vv[tt + 1] + wv[2] * vv[tt + 2] + bv, z = xx * v2;
            u32x2 zo; zo.x = pk2(z[0], z[1]); zo.y = pk2(z[2], z[3]); *(LAS u32x2*)(zt + (tg * 8 + tt) * 264 + c4) = zo;
            const f32x4 bg = bf4(*(const u32x2*)(pb + (size_t)tt * D_INP + SC0 + c4));
            const f32x4 y = bg * (ws3[0] * mm[tt] + ws3[1] * mm[tt + 1] + ws3[2] * mm[tt + 2]);
            u32x2 yo; yo.x = pk2(y[0], y[1]); yo.y = pk2(y[2], y[3]); *(u32x2*)(YMIX + (size_t)(c.row0 + tg * 8 + tt) * D + 256 + c4) = yo;
        }
        __syncthreads();
        { const int ch = tid & 255, g0 = (tid >> 8) * 4;
          const int soff = c.L == CTXL ? 0 : CTXL;
#pragma unroll
          for (int g = 0; g < 4; ++g) { const int t8 = (g0 + g) * 8; unsigned short e[8];
#pragma unroll
              for (int j = 0; j < 8; ++j) e[j] = zt[(t8 + j) * 264 + ch];
              u32x4 o; o.x = e[0] | ((unsigned)e[1] << 16); o.y = e[2] | ((unsigned)e[3] << 16); o.z = e[4] | ((unsigned)e[5] << 16); o.w = e[6] | ((unsigned)e[7] << 16);
              *(u32x4*)(ZT + ((size_t)(ch * 16 + c.b)) * 2304 + soff + c.t0 + t8) = o; } }
        __syncthreads();
    }
}
__device__ __forceinline__ void ph_prep_tok(CArgs& a, int l, int gw, int ngw) {
    const int lane = tidx() & 63;
    const bf16* P = (const bf16*)(a.ws + WS_P);
    float* GDF = (float*)(a.ws + WS_MIX + MX_GDF); float* GDB = (float*)(a.ws + WS_MIX + MX_GDB);
    float* DQ = (float*)(a.ws + WS_MIX + MX_DQ); float* DK = (float*)(a.ws + WS_MIX + MX_DK); float* DV = (float*)(a.ws + WS_MIX + MX_DV); float* DG = (float*)(a.ws + WS_MIX + MX_DG);
    const float* wa = a.in[I_GLAWA] + l * 2 * 16 * 128; const float* ba = a.in[I_GLABA] + l * 2 * 128;
    const float* cw = a.in[I_GDNCW] + l * 3 * 768;
#pragma unroll 1
    for (int row0 = gw * 4; row0 < NTOK; row0 += ngw * 4) {
        { int z = 0; asm volatile("" : "+v"(z)); wa += z; cw += z; }
        const bf16* pr0 = P + (size_t)row0 * D_INP;
        float av[4], s[4][4];
#pragma unroll
        for (int r = 0; r < 4; ++r) { av[r] = lane < 32 ? bf2f(pr0[(size_t)r * D_INP + GLA0 + 768 + lane]) : 0.f; s[r][0] = ba[lane]; s[r][1] = ba[64 + lane]; s[r][2] = ba[128 + lane]; s[r][3] = ba[192 + lane]; }
#pragma unroll
        for (int i = 0; i < 16; ++i) { const float w0 = wa[i * 128 + lane], w1 = wa[i * 128 + 64 + lane], w2 = wa[2048 + i * 128 + lane], w3 = wa[2048 + i * 128 + 64 + lane];
#pragma unroll
            for (int r = 0; r < 4; ++r) { const float af = rdlane_f(av[r], i), ab = rdlane_f(av[r], 16 + i); s[r][0] += af * w0; s[r][1] += af * w1; s[r][2] += ab * w2; s[r][3] += ab * w3; } }
#pragma unroll
        for (int r = 0; r < 4; ++r) { const size_t o = (size_t)(row0 + r) * 128;
            GDF[o + lane] = logsigmoidf_(s[r][0]) * 0.0625f; GDF[o + 64 + lane] = logsigmoidf_(s[r][1]) * 0.0625f;
            GDB[o + lane] = logsigmoidf_(s[r][2]) * 0.0625f; GDB[o + 64 + lane] = logsigmoidf_(s[r][3]) * 0.0625f; }
        int tpos, lo, hi;
        if (row0 < NTOK_C) { tpos = row0 & 255; lo = 0; hi = CTXL; } else { tpos = (row0 - NTOK_C) & 2047; lo = tpos & ~63; hi = lo + 64; }
        float sq[4] = {0.f, 0.f, 0.f, 0.f}, sk[4] = {0.f, 0.f, 0.f, 0.f}; f32x4 qv[4], kv[4];
#pragma unroll
        for (int g = 0; g < 3; ++g) { const int col = g * 256 + 4 * lane; const bf16* p = pr0 + GDN0 + col;
            f32x4 x[6];
#pragma unroll
            for (int r = 0; r < 6; ++r) { const int t = tpos + r - 1; x[r] = (t >= lo && t < hi) ? bf4(*(const u32x2*)(p + (ptrdiff_t)(r - 1) * D_INP)) : (f32x4){0.f, 0.f, 0.f, 0.f}; }
            const f32x4 w0 = *(const f32x4*)(cw + col), w1 = *(const f32x4*)(cw + 768 + col), w2 = *(const f32x4*)(cw + 1536 + col);
#pragma unroll
            for (int r = 0; r < 4; ++r) { f32x4 y = w0 * x[r] + w1 * x[r + 1] + w2 * x[r + 2];
                y[0] = siluf_(y[0]); y[1] = siluf_(y[1]); y[2] = siluf_(y[2]); y[3] = siluf_(y[3]);
                if (g == 0) { qv[r] = y; sq[r] = (y[0] * y[0] + y[1] * y[1]) + (y[2] * y[2] + y[3] * y[3]); }
                else if (g == 1) { kv[r] = y; sk[r] = (y[0] * y[0] + y[1] * y[1]) + (y[2] * y[2] + y[3] * y[3]); }
                else *(f32x4*)(DV + (size_t)(row0 + r) * 256 + 4 * lane) = y; } }
#pragma unroll
        for (int r = 0; r < 4; ++r) { const float rq = rsqrtf(row16_sum(sq[r]) + 1e-6f) * 0.125f, rk = rsqrtf(row16_sum(sk[r]) + 1e-6f);
            const f32x4 qn = qv[r] * rq, kn = kv[r] * rk;
            *(f32x4*)(DQ + (size_t)(row0 + r) * 256 + 4 * lane) = qn; *(f32x4*)(DK + (size_t)(row0 + r) * 256 + 4 * lane) = kn;
            *(u32x2*)((bf16*)(a.ws + WS_CKD + CD_QB) + (size_t)(row0 + r) * 256 + 4 * lane) = (u32x2){pk2(qn[0], qn[1]), pk2(qn[2], qn[3])};
            *(u32x2*)((bf16*)(a.ws + WS_CKD + CD_KB) + (size_t)(row0 + r) * 256 + 4 * lane) = (u32x2){pk2(kn[0], kn[1]), pk2(kn[2], kn[3])}; }
        if (lane < 16) { const int h = lane & 3, r = lane >> 2; const bf16* pr = pr0 + (size_t)r * D_INP;
            const float af = bf2f(pr[GDN0 + 1024 + h]), ab = bf2f(pr[GDN0 + 1028 + h]), bfv = bf2f(pr[GDN0 + 1032 + h]), bbv = bf2f(pr[GDN0 + 1036 + h]);
            const float* al = a.in[I_GDNALOG] + l * 8; const float* dt = a.in[I_GDNDT] + l * 8;
            const float gf = -__expf(al[h]) * softplusf_(af + dt[h]), gb = -__expf(al[4 + h]) * softplusf_(ab + dt[4 + h]);
            *(f32x4*)(DG + (size_t)(row0 + r) * 16 + 4 * h) = (f32x4){sigmoidf_(bfv), gf, sigmoidf_(bbv), gb}; }
    }
}

__device__ __forceinline__ int scan_row(int b, int dir, int n) {
    if (n < CTXL) return b * CTXL + (dir ? CTXL - 1 - n : n);
    const int m = n - CTXL; return NTOK_C + b * SEQ + (dir ? SEQ - 1 - m : m);
}
__device__ __forceinline__ void gla_chain(CArgs& a, int chain, LAS unsigned char* lds) {
    const int b = chain >> 3, h = (chain >> 1) & 3, dir = chain & 1;
    const int tid = tidx(), lane = tid & 63, w = tid >> 6, vv = lane & 7, kq = lane >> 3;
    const bf16* P = (const bf16*)(a.ws + WS_P);
    const float* GD = (const float*)(a.ws + WS_MIX + (dir ? MX_GDB : MX_GDF));
    float* GO = (float*)(a.ws + WS_MIX + (dir ? MX_GOB : MX_GOF));
    LAS float* sq = (LAS float*)lds;
    LAS float* sk = sq + 64 * 32;
    LAS float* sd = sk + 64 * 32;
    LAS float* sv = sd + 64 * 32;
    float S[4] = {0.f, 0.f, 0.f, 0.f};
    for (int ch = 0; ch < 36; ++ch) {
        { const int tt = tid >> 3, sub = tid & 7, row = scan_row(b, dir, ch * 64 + tt);
          const bf16* pr = P + (size_t)row * D_INP + GLA0;
          const u32x2 qv = *(const u32x2*)(pr + h * 32 + sub * 4), kv = *(const u32x2*)(pr + 128 + h * 32 + sub * 4);
          const f32x4 dv = *(const f32x4*)(GD + (size_t)row * 128 + h * 32 + sub * 4);
          const u32x4 vv8 = *(const u32x4*)(pr + 256 + h * 64 + sub * 8);
          const float qs = 0.17677669529663687f;
          *(LAS f32x4*)(sq + tt * 32 + sub * 4) = (f32x4){lo_bf(qv.x) * qs, hi_bf(qv.x) * qs, lo_bf(qv.y) * qs, hi_bf(qv.y) * qs};
          *(LAS f32x4*)(sk + tt * 32 + sub * 4) = (f32x4){lo_bf(kv.x), hi_bf(kv.x), lo_bf(kv.y), hi_bf(kv.y)};
          *(LAS f32x4*)(sd + tt * 32 + sub * 4) = dv;
          *(LAS f32x4*)(sv + tt * 64 + sub * 8) = (f32x4){lo_bf(vv8.x), hi_bf(vv8.x), lo_bf(vv8.y), hi_bf(vv8.y)};
          *(LAS f32x4*)(sv + tt * 64 + sub * 8 + 4) = (f32x4){lo_bf(vv8.z), hi_bf(vv8.z), lo_bf(vv8.w), hi_bf(vv8.w)}; }
        __syncthreads();
#pragma unroll 4
        for (int tt = 0; tt < 64; ++tt) {
            const f32x4 q4 = *(const LAS f32x4*)(sq + tt * 32 + kq * 4), k4 = *(const LAS f32x4*)(sk + tt * 32 + kq * 4), d4 = *(const LAS f32x4*)(sd + tt * 32 + kq * 4);
            const float v = sv[tt * 64 + w * 8 + vv];
            float o = 0.f;
#pragma unroll
            for (int j = 0; j < 4; ++j) { S[j] = d4[j] * S[j] + k4[j] * v; o += q4[j] * S[j]; }
            o += __shfl_xor(o, 8); o += __shfl_xor(o, 16); o += __shfl_xor(o, 32);
            if (kq == 0) GO[(size_t)scan_row(b, dir, ch * 64 + tt) * 256 + h * 64 + w * 8 + vv] = o;
        }
        __syncthreads();
    }
}
__device__ __forceinline__ void gdn_chain(CArgs& a, int chain, LAS unsigned char* lds) {
    const int b = chain >> 3, h = (chain >> 1) & 3, dir = chain & 1;
    const int tid = tidx(), lane = tid & 63, w = tid >> 6, vv = lane & 7, kq = lane >> 3;
    const float* DQ = (const float*)(a.ws + WS_MIX + MX_DQ); const float* DK = (const float*)(a.ws + WS_MIX + MX_DK); const float* DV = (const float*)(a.ws + WS_MIX + MX_DV);
    const float* DG = (const float*)(a.ws + WS_MIX + MX_DG);
    float* DO = (float*)(a.ws + WS_MIX + (dir ? MX_DOB : MX_DOF));
    LAS float* sq = (LAS float*)lds;
    LAS float* sk = sq + 64 * 64;
    LAS float* sv = sk + 64 * 64;
    LAS float* sg = sv + 64 * 64;
    float S[8];
#pragma unroll
    for (int j = 0; j < 8; ++j) S[j] = 0.f;
    for (int ch = 0; ch < 36; ++ch) {
        { const int tt = tid >> 3, sub = tid & 7, row = scan_row(b, dir, ch * 64 + tt);
          const size_t o = (size_t)row * 256 + h * 64 + sub * 8;
          *(LAS f32x4*)(sq + tt * 64 + sub * 8) = *(const f32x4*)(DQ + o); *(LAS f32x4*)(sq + tt * 64 + sub * 8 + 4) = *(const f32x4*)(DQ + o + 4);
          *(LAS f32x4*)(sk + tt * 64 + sub * 8) = *(const f32x4*)(DK + o); *(LAS f32x4*)(sk + tt * 64 + sub * 8 + 4) = *(const f32x4*)(DK + o + 4);
          *(LAS f32x4*)(sv + tt * 64 + sub * 8) = *(const f32x4*)(DV + o); *(LAS f32x4*)(sv + tt * 64 + sub * 8 + 4) = *(const f32x4*)(DV + o + 4);
          if (sub == 0) { const f32x4 g4 = *(const f32x4*)(DG + (size_t)row * 16 + h * 4); *(LAS f32x2*)(sg + tt * 2) = dir ? (f32x2){g4[2], g4[3]} : (f32x2){g4[0], g4[1]}; } }
        __syncthreads();
#pragma unroll 2
        for (int tt = 0; tt < 64; ++tt) {
            const f32x4 ka = *(const LAS f32x4*)(sk + tt * 64 + kq * 8), kb = *(const LAS f32x4*)(sk + tt * 64 + kq * 8 + 4);
            const f32x4 qa = *(const LAS f32x4*)(sq + tt * 64 + kq * 8), qb = *(const LAS f32x4*)(sq + tt * 64 + kq * 8 + 4);
            const float v = sv[tt * 64 + w * 8 + vv]; const f32x2 g2 = *(const LAS f32x2*)(sg + tt * 2);
            const float beta = g2.x, eg = g2.y;
            float ks = (ka[0] * S[0] + ka[1] * S[1]) + (ka[2] * S[2] + ka[3] * S[3]) + ((kb[0] * S[4] + kb[1] * S[5]) + (kb[2] * S[6] + kb[3] * S[7]));
            ks += __shfl_xor(ks, 8); ks += __shfl_xor(ks, 16); ks += __shfl_xor(ks, 32);
            const float wv = beta * (v - eg * ks);
            float o = 0.f;
#pragma unroll
            for (int j = 0; j < 4; ++j) { S[j] = eg * S[j] + ka[j] * wv; o += qa[j] * S[j]; }
#pragma unroll
            for (int j = 0; j < 4; ++j) { S[4 + j] = eg * S[4 + j] + kb[j] * wv; o += qb[j] * S[4 + j]; }
            o += __shfl_xor(o, 8); o += __shfl_xor(o, 16); o += __shfl_xor(o, 32);
            if (kq == 0) DO[(size_t)scan_row(b, dir, ch * 64 + tt) * 256 + h * 64 + w * 8 + vv] = o;
        }
        __syncthreads();
    }
}
typedef unsigned u32x4a __attribute__((ext_vector_type(4)));
__device__ __forceinline__ bf16x8 frag2(u32x2 lo, u32x2 hi) { return __builtin_bit_cast(bf16x8, (u32x4){lo.x, lo.y, hi.x, hi.y}); }
__device__ __forceinline__ u32x2 cvt4(f32x4 v) { return (u32x2){pk2(v[0], v[1]), pk2(v[2], v[3])}; }

struct GdnIn { f32x2 g2; bf16x8 ak[2], aq[2], bk[2][2]; float kt8[8]; };
struct GdnIn2 { f32x4 R[4], Qv[4]; };
__device__ __forceinline__ void gdn_fetch(CArgs& a, int u, int w, int lane, GdnIn& in) {
    const int chain = u / 36, n = u % 36, b = chain >> 3, h = (chain >> 1) & 3, dir = chain & 1;
    const int r0 = scan_row(b, dir, n * 64), step = dir ? -1 : 1, fr = lane & 15, kg = lane >> 4;
    const float* DQ = (const float*)(a.ws + WS_MIX + MX_DQ) + h * 64; const float* DK = (const float*)(a.ws + WS_MIX + MX_DK) + h * 64; const float* DV = (const float*)(a.ws + WS_MIX + MX_DV) + h * 64;
    const float* DG = (const float*)(a.ws + WS_MIX + MX_DG);
    const bf16* KB = (const bf16*)(a.ws + WS_CKD + CD_KB) + (ptrdiff_t)r0 * 256 + h * 64; const bf16* QB = (const bf16*)(a.ws + WS_CKD + CD_QB) + (ptrdiff_t)r0 * 256 + h * 64;
    const ptrdiff_t ldt = (ptrdiff_t)step * 256;
    const bool isW = w >= 4; const int c0 = 16 * (w & 3), I1 = w >> 1;
    in.g2 = *(const f32x2*)(DG + (size_t)(r0 + step * lane) * 16 + h * 4 + dir * 2);
#pragma unroll
    for (int s = 0; s < 2; ++s) { in.ak[s] = *(const bf16x8*)(KB + (ptrdiff_t)(16 * I1 + fr) * ldt + 32 * s + 8 * kg); in.aq[s] = *(const bf16x8*)(QB + (ptrdiff_t)(16 * I1 + fr) * ldt + 32 * s + 8 * kg);
#pragma unroll
        for (int jj = 0; jj < 2; ++jj) in.bk[jj][s] = *(const bf16x8*)(KB + (ptrdiff_t)(16 * (2 * (w & 1) + jj) + fr) * ldt + 32 * s + 8 * kg); }
#pragma unroll
    for (int tt = 0; tt < 8; ++tt) in.kt8[tt] = DK[(size_t)(r0 + step * (8 * w + tt)) * 256 + lane];
}
__device__ __forceinline__ void gdn_fetch2(CArgs& a, int u, int w, int lane, GdnIn2& in) {
    const int chain = u / 36, n = u % 36, b = chain >> 3, h = (chain >> 1) & 3, dir = chain & 1;
    const int r0 = scan_row(b, dir, n * 64), step = dir ? -1 : 1, fr = lane & 15, kg = lane >> 4;
    const float* DQ = (const float*)(a.ws + WS_MIX + MX_DQ) + h * 64; const float* DK = (const float*)(a.ws + WS_MIX + MX_DK) + h * 64; const float* DV = (const float*)(a.ws + WS_MIX + MX_DV) + h * 64;
    const bool isW = w >= 4; const int c0 = 16 * (w & 3);
#pragma unroll
    for (int I = 0; I < 4; ++I)
#pragma unroll
        for (int e = 0; e < 4; ++e) { const size_t ro = (size_t)(r0 + step * (16 * I + 4 * kg + e)) * 256 + c0 + fr; in.R[I][e] = isW ? DK[ro] : DV[ro]; in.Qv[I][e] = isW ? DQ[ro] : 0.f; }
}
__device__ __forceinline__ float gdn_s1(const GdnIn& in, LAS unsigned char* ub, LAS unsigned char* dwb, int w, int lane) {
    const int fr = lane & 15, kg = lane >> 4, I1 = w >> 1;
    LAS bf16* AB = (LAS bf16*)ub; LAS bf16* ATT = AB + 4608; LAS bf16* KTT = ATT + 4608; LAS float* GT = (LAS float*)(dwb + 2048);
    float beta = in.g2.x, cum = in.g2.y;
#pragma unroll
    for (int o = 1; o < 64; o <<= 1) { const float t = __shfl_up(cum, o); if (lane >= o) cum += t; }
    const float cl = rdlane_f(cum, 63);
    GT[lane] = beta; GT[64 + lane] = cum; GT[128 + lane] = __expf(cum);
    asm volatile("s_waitcnt lgkmcnt(0)" ::: "memory");
    { const f32x4 ci = *(const LAS f32x4*)(GT + 64 + 16 * I1 + 4 * kg), bi = *(const LAS f32x4*)(GT + 16 * I1 + 4 * kg);
#pragma unroll
      for (int jj = 0; jj < 2; ++jj) { const int J = 2 * (w & 1) + jj;
          f32x4 ck = (f32x4){0.f, 0.f, 0.f, 0.f}, cq = (f32x4){0.f, 0.f, 0.f, 0.f};
#pragma unroll
          for (int s = 0; s < 2; ++s) { ck = __builtin_amdgcn_mfma_f32_16x16x32_bf16(in.ak[s], in.bk[jj][s], ck, 0, 0, 0); cq = __builtin_amdgcn_mfma_f32_16x16x32_bf16(in.aq[s], in.bk[jj][s], cq, 0, 0, 0); }
          const int j = 16 * J + fr; const float cj = GT[64 + j];
#pragma unroll
          for (int e = 0; e < 4; ++e) { const int i = 16 * I1 + 4 * kg + e; const float gm = __expf(fminf(ci[e] - cj, 0.f));
              AB[i * 72 + j] = (bf16)f2bf(j < i ? bi[e] * ck[e] * gm : 0.f); ATT[i * 72 + j] = (bf16)f2bf(j <= i ? cq[e] * gm : 0.f); } } }
    { const f32x4 c8a = *(const LAS f32x4*)(GT + 64 + 8 * w), c8b = *(const LAS f32x4*)(GT + 64 + 8 * w + 4);
#pragma unroll
      for (int tt = 0; tt < 8; ++tt) KTT[lane * 72 + 8 * w + tt] = (bf16)f2bf(in.kt8[tt] * __expf(cl - (tt < 4 ? c8a[tt & 3] : c8b[tt & 3]))); }
    asm volatile("s_waitcnt lgkmcnt(0)" ::: "memory");
    return cl;
}
__device__ __forceinline__ void gdn_s23(CArgs& a, int u, const GdnIn2& in, LAS unsigned char* ub, LAS unsigned char* dwb, int w, int lane, float cl) {
    const int fr = lane & 15, kg = lane >> 4;
    bf16* Mo = (bf16*)(a.ws + WS_CKD + CD_M) + (size_t)u * 4096; bf16* Eo = (bf16*)(a.ws + WS_CKD + CD_E) + (size_t)u * 4096;
    float* BTo = (float*)(a.ws + WS_CKD + CD_BT) + (size_t)u * 4096; bf16* FTo = (bf16*)(a.ws + WS_CKD + CD_FT) + (size_t)u * 4096;
    LAS bf16* AB = (LAS bf16*)ub; LAS bf16* ATT = AB + 4608; LAS bf16* KTT = ATT + 4608; LAS bf16* DW = (LAS bf16*)dwb; LAS float* GT = (LAS float*)(dwb + 2048);
    const bool isW = w >= 4; const int c0 = 16 * (w & 3);
    { const int blk = lane >> 4, c = lane & 15; float T[16];
#pragma unroll
      for (int hb = 0; hb < 4; ++hb) {
          u32x4 arow[4][2];
#pragma unroll
          for (int rr = 0; rr < 4; ++rr) { const int r = 4 * hb + rr; arow[rr][0] = *(const LAS u32x4*)(AB + (16 * blk + r) * 72 + 16 * blk); if (hb >= 2) arow[rr][1] = *(const LAS u32x4*)(AB + (16 * blk + r) * 72 + 16 * blk + 8); }
          asm volatile("s_waitcnt lgkmcnt(0)" ::: "memory");
#pragma unroll
          for (int rr = 0; rr < 4; ++rr) { const int r = 4 * hb + rr; float t = (r == c) ? 1.f : 0.f;
              float t2 = 0.f;
#pragma unroll
              for (int j = 0; j < r; ++j) { const unsigned wv = arow[rr][j >> 3][(j >> 1) & 3]; const float av = (j & 1) ? hi_bf(wv) : lo_bf(wv); if (j & 1) t2 -= av * T[j]; else t -= av * T[j]; }
              t += t2;
              T[r] = t; DW[(blk * 16 + r) * 16 + c] = (bf16)f2bf(t); } } }
    asm volatile("s_waitcnt lgkmcnt(0)" ::: "memory");
    f32x4 X[4];
#pragma unroll
    for (int I = 0; I < 4; ++I) {
        const f32x4 br = *(const LAS f32x4*)(GT + 16 * I + 4 * kg), er = *(const LAS f32x4*)(GT + 128 + 16 * I + 4 * kg);
        f32x4 acc = isW ? br * er * in.R[I] : br * in.R[I];
#pragma unroll
        for (int P = 0; 2 * P < I; ++P) {
            const u32x2 alo = *(const LAS u32x2*)(AB + (16 * I + fr) * 72 + 32 * P + 4 * kg);
            const u32x2 ahi = (2 * P + 1 < I) ? *(const LAS u32x2*)(AB + (16 * I + fr) * 72 + 32 * P + 16 + 4 * kg) : (u32x2){0u, 0u};
            const u32x2 xlo = cvt4(-X[2 * P]); const u32x2 xhi = (2 * P + 1 < I) ? cvt4(-X[2 * P + 1]) : (u32x2){0u, 0u};
            acc = __builtin_amdgcn_mfma_f32_16x16x32_bf16(frag2(alo, ahi), frag2(xlo, xhi), acc, 0, 0, 0); }
        const u32x2 dlo = *(const LAS u32x2*)(DW + (I * 16 + fr) * 16 + 4 * kg);
        X[I] = __builtin_amdgcn_mfma_f32_16x16x32_bf16(frag2(dlo, (u32x2){0u, 0u}), frag2(cvt4(acc), (u32x2){0u, 0u}), (f32x4){0.f, 0.f, 0.f, 0.f}, 0, 0, 0);
    }
    const bf16x8 Xb01 = frag2(cvt4(X[0]), cvt4(X[1])), Xb23 = frag2(cvt4(X[2]), cvt4(X[3]));
    const float ecl = __expf(cl);
    bf16* ftp = FTo + (c0 + fr) * 64 + 4 * kg; float* btp = BTo + (c0 + fr) * 64 + 4 * kg; bf16* ep = Eo + (4 * kg) * 64 + c0 + fr; bf16* mp = Mo + (4 * kg) * 64 + c0 + fr;
#pragma unroll
    for (int t4 = 0; t4 < 4; ++t4) {
        const LAS bf16* ar = ATT + (16 * t4 + fr) * 72 + 4 * kg; const LAS bf16* kr = KTT + (16 * t4 + fr) * 72 + 4 * kg;
        f32x4 pa = (f32x4){0.f, 0.f, 0.f, 0.f}, pk = (f32x4){0.f, 0.f, 0.f, 0.f};
        pa = __builtin_amdgcn_mfma_f32_16x16x32_bf16(frag2(*(const LAS u32x2*)ar, *(const LAS u32x2*)(ar + 16)), Xb01, pa, 0, 0, 0);
        pa = __builtin_amdgcn_mfma_f32_16x16x32_bf16(frag2(*(const LAS u32x2*)(ar + 32), *(const LAS u32x2*)(ar + 48)), Xb23, pa, 0, 0, 0);
        pk = __builtin_amdgcn_mfma_f32_16x16x32_bf16(frag2(*(const LAS u32x2*)kr, *(const LAS u32x2*)(kr + 16)), Xb01, pk, 0, 0, 0);
        pk = __builtin_amdgcn_mfma_f32_16x16x32_bf16(frag2(*(const LAS u32x2*)(kr + 32), *(const LAS u32x2*)(kr + 48)), Xb23, pk, 0, 0, 0);
        if (!isW) {
            *(u32x2*)(ftp + 16 * t4) = cvt4(pa);
            *(f32x4*)(btp + 16 * t4) = pk;
        } else {
            const f32x4 ec = *(const LAS f32x4*)(GT + 128 + 16 * t4 + 4 * kg);
#pragma unroll
            for (int e = 0; e < 4; ++e) { const int row = 16 * t4 + 4 * kg + e, col = c0 + fr;
                ep[(16 * t4 + e) * 64] = (bf16)f2bf(ec[e] * in.Qv[t4][e] - pa[e]);
                mp[(16 * t4 + e) * 64] = (bf16)f2bf((row == col ? ecl : 0.f) - pk[e]); }
        }
    }
}
__device__ __forceinline__ void gdn_chain_units(CArgs& a, int chain, LAS unsigned char* lds, int w, int lane, unsigned long long& tacc) {
    asm volatile("" : "+v"(lane));
    LAS unsigned char* dwb = lds + 55296 + w * 3072;
    GdnIn A, B; GdnIn2 C;
    gdn_fetch(a, chain * 36, w, lane, A);
#pragma unroll 1
    for (int n = 0; n < 36; n += 2) {
        asm volatile("" : "+v"(lane));
        { unsigned long long tq = 0ull; if (PROBE_PH >= 60 && PROBE_PH <= 62) tq = __builtin_amdgcn_s_memrealtime();
          gdn_fetch2(a, chain * 36 + n, w, lane, C); const float cl = gdn_s1(A, lds, dwb, w, lane);
          if (PROBE_PH == 60) tacc += __builtin_amdgcn_s_memrealtime() - tq; if (PROBE_PH == 61) tq = __builtin_amdgcn_s_memrealtime();
          __syncthreads();
          if (PROBE_PH == 61) tacc += __builtin_amdgcn_s_memrealtime() - tq; if (PROBE_PH >= 62 && PROBE_PH <= 64) tq = __builtin_amdgcn_s_memrealtime();
          gdn_fetch(a, chain * 36 + n + 1, w, lane, B); gdn_s23(a, chain * 36 + n, C, lds, dwb, w, lane, cl);
          if (PROBE_PH == 62 || (PROBE_PH == 63 && w < 4) || (PROBE_PH == 64 && w >= 4)) tacc += __builtin_amdgcn_s_memrealtime() - tq; }
        asm volatile("" : "+v"(lane));
        { gdn_fetch2(a, chain * 36 + n + 1, w, lane, C); const float cl = gdn_s1(B, lds + 27648, dwb, w, lane); __syncthreads(); if (n + 2 < 36) gdn_fetch(a, chain * 36 + n + 2, w, lane, A); gdn_s23(a, chain * 36 + n + 1, C, lds + 27648, dwb, w, lane, cl); }
    }
}
__device__ __forceinline__ void gdn_seq_wave(CArgs& a, int chain, int vs, int lane) {
    asm volatile("" : "+v"(lane));
    const int b = chain >> 3, h = (chain >> 1) & 3, dir = chain & 1, fr = lane & 15, kg = lane >> 4, v = 16 * vs + fr, step = dir ? -1 : 1;
    float* DO = (float*)(a.ws + WS_MIX + (dir ? MX_DOB : MX_DOF));
    f32x4 S[4];
#pragma unroll
    for (int i = 0; i < 4; ++i) S[i] = (f32x4){0.f, 0.f, 0.f, 0.f};
#pragma unroll 1
    for (int n = 0; n < 36; ++n) {
        const int u = chain * 36 + n, r0 = scan_row(b, dir, n * 64);
        const bf16* Mo = (const bf16*)(a.ws + WS_CKD + CD_M) + (size_t)u * 4096; const bf16* Eo = (const bf16*)(a.ws + WS_CKD + CD_E) + (size_t)u * 4096;
        const float* BTo = (const float*)(a.ws + WS_CKD + CD_BT) + (size_t)u * 4096; const bf16* FTo = (const bf16*)(a.ws + WS_CKD + CD_FT) + (size_t)u * 4096;
        u32x2 ef[4][2][2], mf[4][2][2], ff[4]; f32x4 bi[4];
#pragma unroll
        for (int t = 0; t < 4; ++t) { ff[t] = *(const u32x2*)(FTo + v * 64 + 16 * t + 4 * kg); bi[t] = *(const f32x4*)(BTo + v * 64 + 16 * t + 4 * kg);
#pragma unroll
            for (int s = 0; s < 2; ++s) { const bf16* er = Eo + (16 * t + fr) * 64 + 32 * s + 4 * kg; ef[t][s][0] = *(const u32x2*)er; ef[t][s][1] = *(const u32x2*)(er + 16);
                const bf16* mr = Mo + (16 * t + fr) * 64 + 32 * s + 4 * kg; mf[t][s][0] = *(const u32x2*)mr; mf[t][s][1] = *(const u32x2*)(mr + 16); } }
        bf16x8 Sb[2];
#pragma unroll
        for (int s = 0; s < 2; ++s) Sb[s] = frag2(cvt4(S[2 * s]), cvt4(S[2 * s + 1]));
        f32x4 o[4];
#pragma unroll
        for (int t = 0; t < 4; ++t) { o[t] = (f32x4){lo_bf(ff[t].x), hi_bf(ff[t].x), lo_bf(ff[t].y), hi_bf(ff[t].y)};
#pragma unroll
            for (int s = 0; s < 2; ++s) o[t] = __builtin_amdgcn_mfma_f32_16x16x32_bf16(frag2(ef[t][s][0], ef[t][s][1]), Sb[s], o[t], 0, 0, 0);
            f32x4 sn = bi[t];
#pragma unroll
            for (int s = 0; s < 2; ++s) sn = __builtin_amdgcn_mfma_f32_16x16x32_bf16(frag2(mf[t][s][0], mf[t][s][1]), Sb[s], sn, 0, 0, 0);
            S[t] = sn; }
#pragma unroll
        for (int t = 0; t < 4; ++t)
#pragma unroll
            for (int e = 0; e < 4; ++e) DO[(size_t)(r0 + step * (16 * t + 4 * kg + e)) * 256 + h * 64 + v] = o[t][e];
    }
}

__device__ __forceinline__ void gdn_seq_block(CArgs& a, int chain, LAS unsigned char* lds, int w, int lane) {
    asm volatile("" : "+v"(lane));
    const int b = chain >> 3, h = (chain >> 1) & 3, dir = chain & 1, fr = lane & 15, kg = lane >> 4, step = dir ? -1 : 1;
    constexpr int SLOT = 45056;
    if (w >= 4) {
        const int q = w - 4;
        u32x4 rg[10];
#define SEQ_LD(n_) do { const int u_ = chain * 36 + (n_); \
        _Pragma("unroll") for (int j = 0; j < 10; ++j) { const int c_ = q + 4 * j; \
            const unsigned char* g_ = c_ < 8 ? a.ws + WS_CKD + CD_M + (size_t)u_ * 8192 + c_ * 1024 : (c_ < 16 ? a.ws + WS_CKD + CD_E + (size_t)u_ * 8192 + (c_ - 8) * 1024 : \
                (c_ < 32 ? a.ws + WS_CKD + CD_BT + (size_t)u_ * 16384 + (c_ - 16) * 1024 : a.ws + WS_CKD + CD_FT + (size_t)u_ * 8192 + (c_ - 32) * 1024)); \
            rg[j] = *(const u32x4*)(g_ + lane * 16); } } while (0)
#define SEQ_ST(n_) do { LAS unsigned char* s_ = lds + ((n_) % 3) * SLOT; \
        _Pragma("unroll") for (int j = 0; j < 10; ++j) { const int c_ = q + 4 * j; \
            const int off_ = c_ < 8 ? (c_ * 8 + (lane >> 3)) * 144 + (lane & 7) * 16 : (c_ < 16 ? 9216 + ((c_ - 8) * 8 + (lane >> 3)) * 144 + (lane & 7) * 16 : \
                (c_ < 32 ? 18432 + ((c_ - 16) * 4 + (lane >> 4)) * 272 + (lane & 15) * 16 : 35840 + ((c_ - 32) * 8 + (lane >> 3)) * 144 + (lane & 7) * 16)); \
            *(LAS u32x4*)(s_ + off_) = rg[j]; } } while (0)
        SEQ_LD(0); SEQ_ST(0); SEQ_LD(1); SEQ_ST(1); SEQ_LD(2);
        asm volatile("s_waitcnt lgkmcnt(0)" ::: "memory");
        __syncthreads();
#pragma unroll 1
        for (int n = 0; n < 36; ++n) {
            if (n + 2 < 36) { SEQ_ST(n + 2); }
            if (n + 3 < 36) { SEQ_LD(n + 3); }
            asm volatile("s_waitcnt lgkmcnt(0)" ::: "memory");
            __syncthreads();
        }
#undef SEQ_LD
#undef SEQ_ST
    } else {
        const int v = 16 * w + fr;
        float* DO = (float*)(a.ws + WS_MIX + (dir ? MX_DOB : MX_DOF));
        f32x4 S[4];
#pragma unroll
        for (int i = 0; i < 4; ++i) S[i] = (f32x4){0.f, 0.f, 0.f, 0.f};
        __syncthreads();
#pragma unroll 1
        for (int n = 0; n < 36; ++n) {
            const LAS unsigned char* sl = lds + (n % 3) * SLOT; const int r0 = scan_row(b, dir, n * 64);
            bf16x8 Sb[2];
#pragma unroll
            for (int s = 0; s < 2; ++s) Sb[s] = frag2(cvt4(S[2 * s]), cvt4(S[2 * s + 1]));
            f32x4 o[4];
#pragma unroll
            for (int t = 0; t < 4; ++t) {
                const u32x2 ff = *(const LAS u32x2*)(sl + 35840 + v * 144 + (16 * t + 4 * kg) * 2);
                o[t] = (f32x4){lo_bf(ff.x), hi_bf(ff.x), lo_bf(ff.y), hi_bf(ff.y)};
                f32x4 sn = *(const LAS f32x4*)(sl + 18432 + v * 272 + (16 * t + 4 * kg) * 4);
#pragma unroll
                for (int s = 0; s < 2; ++s) { const LAS unsigned char* er = sl + 9216 + (16 * t + fr) * 144 + (32 * s + 4 * kg) * 2; const LAS unsigned char* mr = sl + (16 * t + fr) * 144 + (32 * s + 4 * kg) * 2;
                    o[t] = __builtin_amdgcn_mfma_f32_16x16x32_bf16(frag2(*(const LAS u32x2*)er, *(const LAS u32x2*)(er + 32)), Sb[s], o[t], 0, 0, 0);
                    sn = __builtin_amdgcn_mfma_f32_16x16x32_bf16(frag2(*(const LAS u32x2*)mr, *(const LAS u32x2*)(mr + 32)), Sb[s], sn, 0, 0, 0); }
                S[t] = sn; }
            { float* dp = DO + (ptrdiff_t)(r0 + step * 4 * kg) * 256 + h * 64 + v; const ptrdiff_t sd = (ptrdiff_t)step * 256;
#pragma unroll
              for (int t = 0; t < 4; ++t)
#pragma unroll
                  for (int e = 0; e < 4; ++e) dp[(16 * t + e) * sd] = o[t][e]; }
            __syncthreads();
        }
    }
}
__device__ __forceinline__ void gla_seq_block(CArgs& a, int chain, LAS unsigned char* lds, int w, int lane) {
    asm volatile("" : "+v"(lane));
    const int b = chain >> 3, h = (chain >> 1) & 3, dir = chain & 1, fr = lane & 15, kg = lane >> 4, step = dir ? -1 : 1;
    constexpr int SLOT = 23680;
    if (w >= 4) {
        const int q = w - 4;
        u32x4 rg[5]; float dl = 0.f;
#define SEQ_LD(n_) do { const int u_ = chain * 36 + (n_); \
        _Pragma("unroll") for (int j = 0; j < 5; ++j) { const int c_ = q + 4 * j; \
            const unsigned char* g_ = c_ < 4 ? a.ws + WS_CKA + CA_QC + (size_t)u_ * 4096 + c_ * 1024 : (c_ < 12 ? a.ws + WS_CKA + CA_FT + (size_t)u_ * 8192 + (c_ - 4) * 1024 : a.ws + WS_CKA + CA_UT + (size_t)u_ * 8192 + (c_ - 12) * 1024); \
            rg[j] = *(const u32x4*)(g_ + lane * 16); } \
        if (q == 0) dl = ((const float*)(a.ws + WS_CKA + CA_DL))[(size_t)u_ * 32 + (lane & 31)]; } while (0)
#define SEQ_ST(n_) do { LAS unsigned char* s_ = lds + ((n_) % 3) * SLOT; \
        _Pragma("unroll") for (int j = 0; j < 5; ++j) { const int c_ = q + 4 * j; \
            const int off_ = c_ < 4 ? (c_ * 16 + (lane >> 2)) * 80 + (lane & 3) * 16 : (c_ < 12 ? 5120 + ((c_ - 4) * 8 + (lane >> 3)) * 144 + (lane & 7) * 16 : 14336 + ((c_ - 12) * 8 + (lane >> 3)) * 144 + (lane & 7) * 16); \
            *(LAS u32x4*)(s_ + off_) = rg[j]; } \
        if (q == 0 && lane < 32) *(LAS float*)(s_ + 23552 + lane * 4) = dl; } while (0)
        SEQ_LD(0); SEQ_ST(0); SEQ_LD(1); SEQ_ST(1); SEQ_LD(2);
        asm volatile("s_waitcnt lgkmcnt(0)" ::: "memory");
        __syncthreads();
#pragma unroll 1
        for (int n = 0; n < 36; ++n) {
            if (n + 2 < 36) { SEQ_ST(n + 2); }
            if (n + 3 < 36) { SEQ_LD(n + 3); }
            asm volatile("s_waitcnt lgkmcnt(0)" ::: "memory");
            __syncthreads();
        }
#undef SEQ_LD
#undef SEQ_ST
    } else {
        const int v = 16 * w + fr;
        float* GO = (float*)(a.ws + WS_MIX + (dir ? MX_GOB : MX_GOF));
        f32x4 S[2] = {(f32x4){0.f, 0.f, 0.f, 0.f}, (f32x4){0.f, 0.f, 0.f, 0.f}};
        __syncthreads();
#pragma unroll 1
        for (int n = 0; n < 36; ++n) {
            const LAS unsigned char* sl = lds + (n % 3) * SLOT; const int r0 = scan_row(b, dir, n * 64);
            const bf16x8 Sb = frag2(cvt4(S[0]), cvt4(S[1]));
            f32x4 o[4];
#pragma unroll
            for (int t = 0; t < 4; ++t) { const u32x2 ff = *(const LAS u32x2*)(sl + 5120 + v * 144 + (16 * t + 4 * kg) * 2);
                o[t] = (f32x4){lo_bf(ff.x), hi_bf(ff.x), lo_bf(ff.y), hi_bf(ff.y)};
                const LAS unsigned char* qr = sl + (16 * t + fr) * 80 + 4 * kg * 2;
                o[t] = __builtin_amdgcn_mfma_f32_16x16x32_bf16(frag2(*(const LAS u32x2*)qr, *(const LAS u32x2*)(qr + 32)), Sb, o[t], 0, 0, 0); }
#pragma unroll
            for (int kt = 0; kt < 2; ++kt) { const f32x4 d4 = *(const LAS f32x4*)(sl + 23552 + (16 * kt + 4 * kg) * 4), u4 = *(const LAS f32x4*)(sl + 14336 + v * 144 + (16 * kt + 4 * kg) * 4); S[kt] = d4 * S[kt] + u4; }
            { float* gp = GO + (ptrdiff_t)(r0 + step * 4 * kg) * 256 + h * 64 + v; const ptrdiff_t sd = (ptrdiff_t)step * 256;
#pragma unroll
              for (int t = 0; t < 4; ++t)
#pragma unroll
                  for (int e = 0; e < 4; ++e) gp[(16 * t + e) * sd] = o[t][e]; }
            __syncthreads();
        }
    }
}

struct GlaIn { float bc[32]; unsigned px[32]; };
__device__ __forceinline__ void gla_fetch(CArgs& a, int u, int w, int lane, GlaIn& in) {
    const int chain = u / 36, n = u % 36, b = chain >> 3, h = (chain >> 1) & 3, dir = chain & 1;
    const int r0 = scan_row(b, dir, n * 64), step = dir ? -1 : 1;
    const bf16* P = (const bf16*)(a.ws + WS_P);
    const float* GD = (const float*)(a.ws + WS_MIX + (dir ? MX_GDB : MX_GDF));
    if (w < 4) { const int k = lane & 31, half = lane >> 5; const int src_off = (w == 0 || w == 2) ? 0 : 128;
#pragma unroll
        for (int i = 0; i < 32; ++i) { in.bc[i] = GD[(size_t)(r0 + step * (32 * half + i)) * 128 + h * 32 + k]; in.px[i] = P[(size_t)(r0 + step * (32 * half + i)) * D_INP + GLA0 + src_off + h * 32 + k]; }
    } else { const int vv = 16 * (w - 4) + (lane & 15), tq = lane >> 4;
#pragma unroll
        for (int i = 0; i < 16; ++i) in.px[i] = P[(size_t)(r0 + step * (16 * tq + i)) * D_INP + GLA0 + 256 + h * 64 + vv];
#pragma unroll
        for (int i = 16; i < 32; ++i) in.px[i] = 0u;
#pragma unroll
        for (int i = 0; i < 32; ++i) in.bc[i] = 0.f;
    }
}
__device__ __forceinline__ void gla_s1(CArgs& a, int u, GlaIn& in, LAS unsigned char* ub, int w, int lane) {
    bf16* QC = (bf16*)(a.ws + WS_CKA + CA_QC) + (size_t)u * 2048; float* DL = (float*)(a.ws + WS_CKA + CA_DL) + (size_t)u * 32;
    LAS bf16* QE = (LAS bf16*)ub; LAS bf16* KE = QE + 2560; LAS bf16* KTT = KE + 2560; LAS bf16* VT = KTT + 2304;
    if (w < 4) {
        const int k = lane & 31, half = lane >> 5;
        float run = 0.f;
#pragma unroll
        for (int i = 0; i < 32; ++i) { run += in.bc[i]; in.bc[i] = run; }
        const float tot0 = __shfl(run, k), tot1 = __shfl(run, 32 + k);
        const float bref = tot0, blast = tot0 + tot1, off = half ? tot0 : 0.f;
        const float sc = (w == 0 || w == 2) ? 0.17677669529663687f : 1.f;
#pragma unroll
        for (int i = 0; i < 32; ++i) { const int t = 32 * half + i; const float bi = in.bc[i] + off;
            const float x = bf2f(in.px[i]) * sc;
            const float ex = w == 0 ? bi - bref : (w == 1 ? bref - bi : (w == 2 ? bi : blast - bi));
            const bf16 y = (bf16)f2bf(x * __expf(ex));
            if (w == 0) QE[t * 40 + k] = y; else if (w == 1) KE[t * 40 + k] = y; else if (w == 2) QC[t * 32 + k] = y; else KTT[k * 72 + t] = y; }
        if (w == 2 && half == 0) DL[k] = __expf(blast);
    } else {
        const int vv = 16 * (w - 4) + (lane & 15), tq = lane >> 4;
#pragma unroll
        for (int i = 0; i < 16; ++i) VT[vv * 72 + 16 * tq + i] = in.px[i];
    }
    asm volatile("s_waitcnt lgkmcnt(0)" ::: "memory");
}
__device__ __forceinline__ void gla_s2(CArgs& a, int u, LAS unsigned char* ub, int w, int lane) {
    const int fr = lane & 15, kg = lane >> 4;
    bf16* FT = (bf16*)(a.ws + WS_CKA + CA_FT) + (size_t)u * 4096; float* UT = (float*)(a.ws + WS_CKA + CA_UT) + (size_t)u * 2048;
    LAS bf16* QE = (LAS bf16*)ub; LAS bf16* KE = QE + 2560; LAS bf16* KTT = KE + 2560; LAS bf16* VT = KTT + 2304;
    const int It = w & 3, vh = w >> 2;
    const bf16x8 qf = *(const LAS bf16x8*)(QE + (16 * It + fr) * 40 + 8 * kg);
    f32x4 st[4];
#pragma unroll
    for (int Jt = 0; Jt < 4; ++Jt) { const bf16x8 kf = *(const LAS bf16x8*)(KE + (16 * Jt + fr) * 40 + 8 * kg);
        st[Jt] = __builtin_amdgcn_mfma_f32_16x16x32_bf16(kf, qf, (f32x4){0.f, 0.f, 0.f, 0.f}, 0, 0, 0);
#pragma unroll
        for (int e = 0; e < 4; ++e) st[Jt][e] = (16 * Jt + 4 * kg + e <= 16 * It + fr) ? st[Jt][e] : 0.f; }
    const bf16x8 Sb01 = frag2(cvt4(st[0]), cvt4(st[1])), Sb23 = frag2(cvt4(st[2]), cvt4(st[3]));
    bf16* ftp = FT + (4 * kg) * 64 + 16 * It + fr;
#pragma unroll
    for (int vv = 0; vv < 2; ++vv) { const int Vt = 2 * vh + vv; const LAS bf16* vr = VT + (16 * Vt + fr) * 72 + 4 * kg;
        f32x4 f = (f32x4){0.f, 0.f, 0.f, 0.f};
        f = __builtin_amdgcn_mfma_f32_16x16x32_bf16(frag2(*(const LAS u32x2*)vr, *(const LAS u32x2*)(vr + 16)), Sb01, f, 0, 0, 0);
        f = __builtin_amdgcn_mfma_f32_16x16x32_bf16(frag2(*(const LAS u32x2*)(vr + 32), *(const LAS u32x2*)(vr + 48)), Sb23, f, 0, 0, 0);
#pragma unroll
        for (int e = 0; e < 4; ++e) ftp[(16 * Vt + e) * 64] = (bf16)f2bf(f[e]); }
    const int kt = w & 1, Vu = w >> 1;
    f32x4 uu = (f32x4){0.f, 0.f, 0.f, 0.f};
#pragma unroll
    for (int s = 0; s < 2; ++s) uu = __builtin_amdgcn_mfma_f32_16x16x32_bf16(*(const LAS bf16x8*)(KTT + (16 * kt + fr) * 72 + 32 * s + 8 * kg), *(const LAS bf16x8*)(VT + (16 * Vu + fr) * 72 + 32 * s + 8 * kg), uu, 0, 0, 0);
    *(f32x4*)(UT + (16 * Vu + fr) * 32 + 16 * kt + 4 * kg) = uu;
}
__device__ __forceinline__ void gla_chain_units(CArgs& a, int chain, LAS unsigned char* lds, int w, int lane) {
    GlaIn A, B;
    asm volatile("" : "+v"(lane));
    gla_fetch(a, chain * 36, w, lane, A);
#pragma unroll 1
    for (int n = 0; n < 36; n += 2) {
        asm volatile("" : "+v"(lane));
        { gla_s1(a, chain * 36 + n, A, lds, w, lane); __syncthreads(); gla_fetch(a, chain * 36 + n + 1, w, lane, B); gla_s2(a, chain * 36 + n, lds, w, lane); }
        asm volatile("" : "+v"(lane));
        { gla_s1(a, chain * 36 + n + 1, B, lds + 24064, w, lane); __syncthreads(); if (n + 2 < 36) gla_fetch(a, chain * 36 + n + 2, w, lane, A); gla_s2(a, chain * 36 + n + 1, lds + 24064, w, lane); }
    }
}
__device__ __forceinline__ void gla_seq_wave(CArgs& a, int chain, int vs, int lane) {
    asm volatile("" : "+v"(lane));
    const int b = chain >> 3, h = (chain >> 1) & 3, dir = chain & 1, fr = lane & 15, kg = lane >> 4, v = 16 * vs + fr, step = dir ? -1 : 1;
    float* GO = (float*)(a.ws + WS_MIX + (dir ? MX_GOB : MX_GOF));
    f32x4 S[2] = {(f32x4){0.f, 0.f, 0.f, 0.f}, (f32x4){0.f, 0.f, 0.f, 0.f}};
#pragma unroll 1
    for (int n = 0; n < 36; ++n) {
        const int u = chain * 36 + n, r0 = scan_row(b, dir, n * 64);
        const bf16* QC = (const bf16*)(a.ws + WS_CKA + CA_QC) + (size_t)u * 2048; const bf16* FT = (const bf16*)(a.ws + WS_CKA + CA_FT) + (size_t)u * 4096;
        const float* UT = (const float*)(a.ws + WS_CKA + CA_UT) + (size_t)u * 2048; const float* DL = (const float*)(a.ws + WS_CKA + CA_DL) + (size_t)u * 32;
        u32x2 qf[4][2], ff[4]; f32x4 d4[2], u4[2];
#pragma unroll
        for (int t = 0; t < 4; ++t) { const bf16* qr = QC + (16 * t + fr) * 32; qf[t][0] = *(const u32x2*)(qr + 4 * kg); qf[t][1] = *(const u32x2*)(qr + 16 + 4 * kg); ff[t] = *(const u32x2*)(FT + v * 64 + 16 * t + 4 * kg); }
#pragma unroll
        for (int kt = 0; kt < 2; ++kt) { d4[kt] = *(const f32x4*)(DL + 16 * kt + 4 * kg); u4[kt] = *(const f32x4*)(UT + v * 32 + 16 * kt + 4 * kg); }
        const bf16x8 Sb = frag2(cvt4(S[0]), cvt4(S[1]));
        f32x4 o[4];
#pragma unroll
        for (int t = 0; t < 4; ++t) { o[t] = (f32x4){lo_bf(ff[t].x), hi_bf(ff[t].x), lo_bf(ff[t].y), hi_bf(ff[t].y)};
            o[t] = __builtin_amdgcn_mfma_f32_16x16x32_bf16(frag2(qf[t][0], qf[t][1]), Sb, o[t], 0, 0, 0); }
#pragma unroll
        for (int kt = 0; kt < 2; ++kt) S[kt] = d4[kt] * S[kt] + u4[kt];
#pragma unroll
        for (int t = 0; t < 4; ++t)
#pragma unroll
            for (int e = 0; e < 4; ++e) GO[(size_t)(r0 + step * (16 * t + 4 * kg + e)) * 256 + h * 64 + v] = o[t][e];
    }
}

template <int L>
__device__ __forceinline__ void hyena_unit(CArgs& a, int l, int c, LAS unsigned char* lds) {
    constexpr int Lt = L == SEQ ? 1 : 0, SOFF = L == SEQ ? CTXL : 0, CST = (2 * L + 16) * 2 + 32;
    constexpr int NTW = L / 16 / 8;
    const int tid = tidx(), lane = tid & 63, w = tid >> 6, fr = lane & 15, kg = lane >> 4;
    const float* kf = (const float*)(a.ws + WS_KUN) + ((size_t)((l * 2 + Lt) * 512 + c)) * 2048;
    const float* kb = kf + (size_t)256 * 2048;
    LAS float* red = (LAS float*)(lds + 8 * CST);
    float s = 0.f;
    for (int t = tid; t < L; t += 512) s += fabsf(kf[t]) + (t >= 1 ? fabsf(kb[t]) : 0.f);
    s = wave_sum(s);
    if (lane == 0) red[w] = s;
    __syncthreads();
    float l1 = 0.f;
#pragma unroll
    for (int i = 0; i < 8; ++i) l1 += red[i];
    const float inv = 1.f / l1;
    for (int idx = tid; idx < 2 * L + 16; idx += 512) {
        float gv = 0.f;
        if (idx >= 1 && idx <= L) gv = kf[L - idx] * inv; else if (idx > L && idx < 2 * L) gv = kb[idx - L] * inv;
        const bf16 gb = (bf16)f2bf(gv);
#pragma unroll
        for (int r = 0; r < 8; ++r) if (idx - r >= 0) *(LAS bf16*)(lds + r * CST + (idx - r) * 2) = gb;
    }
    __syncthreads();
    const bf16* Z = (const bf16*)(a.ws + WS_MIX + MX_ZT) + ((size_t)(c * 16 + fr)) * 2304 + SOFF;
    float* YT = (float*)(a.ws + WS_MIX + MX_YT) + ((size_t)(c * 16 + fr)) * 2304 + SOFF;
    f32x4 acc[NTW];
#pragma unroll
    for (int j = 0; j < NTW; ++j) acc[j] = (f32x4){0.f, 0.f, 0.f, 0.f};
    const int rr = (8 - (fr & 7)) & 7;
    const LAS unsigned char* ap = lds + rr * CST + (((8 * kg - fr + L) >> 3) - 2 * w * NTW) * 16;
    const bf16* zp = Z + 8 * kg;
    if constexpr (L == SEQ) {
        static_assert(NTW == 16, "hyena_unit");
        bf16x8 zc[8], zn[8], A[16];
#pragma unroll
        for (int ii = 0; ii < 8; ++ii) zc[ii] = *(const bf16x8*)(zp + 32 * ii);
#pragma unroll
        for (int j = 2; j < 16; ++j) A[j] = *(const LAS bf16x8*)(ap - 32 * j);
#pragma unroll 1
        for (int ib = 0; ib < 8; ++ib) {
            const bf16* zq = zp + 256 * (ib < 7 ? ib + 1 : 7);
#pragma unroll
            for (int ii = 0; ii < 8; ++ii) zn[ii] = *(const bf16x8*)(zq + 32 * ii);
#pragma unroll
            for (int ii = 0; ii < 8; ++ii) {
                A[(16 - 2 * ii) & 15] = *(const LAS bf16x8*)(ap + 64 * ii);
                A[(17 - 2 * ii) & 15] = *(const LAS bf16x8*)(ap + 64 * ii - 32);
#pragma unroll
                for (int jj = 0; jj < 16; ++jj) { const int j = (jj + 2) & 15; acc[j] = __builtin_amdgcn_mfma_f32_16x16x32_bf16(A[(j + 16 - 2 * ii) & 15], zc[ii], acc[j], 0, 0, 0); }
            }
            ap += 512;
#pragma unroll
            for (int ii = 0; ii < 8; ++ii) zc[ii] = zn[ii];
        }
    } else {
        static_assert(L == 256, "hyena_unit");
        bf16x8 zc[8];
#pragma unroll
        for (int ii = 0; ii < 8; ++ii) zc[ii] = *(const bf16x8*)(zp + 32 * ii);
#pragma unroll
        for (int i = 0; i < 8; ++i)
#pragma unroll
            for (int j = 0; j < NTW; ++j) acc[j] = __builtin_amdgcn_mfma_f32_16x16x32_bf16(*(const LAS bf16x8*)(ap + (4 * i - 2 * j) * 16), zc[i], acc[j], 0, 0, 0);
    }
#pragma unroll
    for (int j = 0; j < NTW; ++j) *(f32x4*)(YT + 16 * (w * NTW + j) + 4 * kg) = acc[j];
    __syncthreads();
}
__device__ __forceinline__ void ph_scan(CArgs& a, int l, LAS unsigned char* lds, int bid, int nblk, unsigned long long& tacc) {
    const int tid = tidx(), lane = tid & 63, w = __builtin_amdgcn_readfirstlane(tid >> 6);
    unsigned long long t0 = 0ull;
    if (PROBE_PH >= 20 && PROBE_PH < 50) t0 = __builtin_amdgcn_s_memrealtime();
#pragma unroll 1
    for (int c = bid; c < 256; c += nblk) {
        if (c < 128) {
            gdn_chain_units(a, c, lds, w, lane, tacc);
        } else {
            gla_chain_units(a, c - 128, lds, w, lane);
        }
        asm volatile("s_waitcnt vmcnt(0)" ::: "memory");
        __syncthreads();
        if (PROBE_PH == 20 && c < 128) tacc += __builtin_amdgcn_s_memrealtime() - t0;
        if (PROBE_PH == 24 && c >= 128) tacc += __builtin_amdgcn_s_memrealtime() - t0;
        if (PROBE_PH == 21) t0 = __builtin_amdgcn_s_memrealtime();
        if (c < 128) gdn_seq_block(a, c, lds, w, lane); else gla_seq_block(a, c - 128, lds, w, lane);
        __syncthreads();
        if (PROBE_PH == 21) tacc += __builtin_amdgcn_s_memrealtime() - t0;
    }
    if (PROBE_PH == 22) t0 = __builtin_amdgcn_s_memrealtime();
    {
        LAS unsigned char* scr = lds + w * 8448;
        if (nblk == 256) { const int per = bid < 128 ? 16 : 32, first = bid < 128 ? (bid * 8 + w) * 16 : 16384 + ((bid - 128) * 8 + w) * 32;
            tr_experts_range(a, l, scr, first, first + per, 1, lane); }
        else tr_experts_range(a, l, scr, bid * 8 + w, NEXP * 3 * 512, nblk * 8, lane);
    }
    if (PROBE_PH == 22) tacc += __builtin_amdgcn_s_memrealtime() - t0;
    __syncthreads();
    if (PROBE_PH == 23) t0 = __builtin_amdgcn_s_memrealtime();
    if (nblk == 256) {
        if (bid < 128) hyena_unit<SEQ>(a, l, bid, lds);
        else { const int g = bid - 128; hyena_unit<SEQ>(a, l, 128 + g, lds); hyena_unit<CTXL>(a, l, 2 * g, lds); hyena_unit<CTXL>(a, l, 2 * g + 1, lds); }
    } else {
        for (int it = bid; it < 512; it += nblk) { if (it < 256) hyena_unit<SEQ>(a, l, it, lds); else hyena_unit<CTXL>(a, l, it - 256, lds); }
    }
    if (PROBE_PH == 23) tacc += __builtin_amdgcn_s_memrealtime() - t0;
}

__device__ __forceinline__ void ph_post_hyena(CArgs& a, int l, LAS unsigned char* lds, int bid, int nblk) {
    const bf16* P = (const bf16*)(a.ws + WS_P);
    const float* YT = (const float*)(a.ws + WS_MIX + MX_YT); bf16* YMIX = (bf16*)(a.ws + WS_YMIX);
    LAS float* yt = (LAS float*)lds;
    const int tid = tidx(), c4 = (tid & 63) * 4, tg = tid >> 6;
    const float* hw = a.in[I_HYCW] + l * 3 * 768; const float* hb = a.in[I_HYCB] + l * 768;
    f32x4 w0[3], wx[3], wv[3];
#pragma unroll
    for (int k = 0; k < 3; ++k) { w0[k] = *(const f32x4*)(hw + k * 768 + c4); wx[k] = *(const f32x4*)(hw + k * 768 + 256 + c4); wv[k] = *(const f32x4*)(hw + k * 768 + 512 + c4); }
    const f32x4 b0 = *(const f32x4*)(hb + c4), bx = *(const f32x4*)(hb + 256 + c4), bv = *(const f32x4*)(hb + 512 + c4), hd = *(const f32x4*)(a.in[I_HYD] + l * 256 + c4);
#pragma unroll 1
    for (int it = bid; it < 576; it += nblk) {
        const Chunk c = chunk_of(it);
        const int soff = c.L == CTXL ? 0 : CTXL;
        { const int ch = tid & 255, half = tid >> 8;
          const float* srcp = YT + ((size_t)(ch * 16 + c.b)) * 2304 + soff + c.t0 + half * 32;
#pragma unroll
          for (int j = 0; j < 8; ++j) { const f32x4 v = *(const f32x4*)(srcp + 4 * j);
              yt[(half * 32 + 4 * j) * 260 + ch] = v[0]; yt[(half * 32 + 4 * j + 1) * 260 + ch] = v[1]; yt[(half * 32 + 4 * j + 2) * 260 + ch] = v[2]; yt[(half * 32 + 4 * j + 3) * 260 + ch] = v[3]; } }
        __syncthreads();
        const int tb = c.t0 + tg * 8;
        const bf16* pb = P + (size_t)(c.row0 + tg * 8) * D_INP;
        f32x4 x0[10], x1[10], vv[10];
#pragma unroll
        for (int r = 0; r < 10; ++r) { const int t = tb + r - 1; const bool ok = t >= c.lo && t < c.hi; const bf16* p = pb + (ptrdiff_t)(r - 1) * D_INP;
            x0[r] = ok ? bf4(*(const u32x2*)(p + HY0 + c4)) : (f32x4){0.f, 0.f, 0.f, 0.f};
            x1[r] = ok ? bf4(*(const u32x2*)(p + HY0 + 256 + c4)) : (f32x4){0.f, 0.f, 0.f, 0.f}; vv[r] = ok ? bf4(*(const u32x2*)(p + HY0 + 512 + c4)) : (f32x4){0.f, 0.f, 0.f, 0.f}; }
#pragma unroll
        for (int tt = 0; tt < 8; ++tt) {
            const f32x4 u0 = w0[0] * x0[tt] + w0[1] * x0[tt + 1] + w0[2] * x0[tt + 2] + b0;
            const f32x4 xx = wx[0] * x1[tt] + wx[1] * x1[tt + 1] + wx[2] * x1[tt + 2] + bx, v2 = wv[0] * vv[tt] + wv[1] * vv[tt + 1] + wv[2] * vv[tt + 2] + bv, z = xx * v2;
            const f32x4 y = *(const LAS f32x4*)(yt + (tg * 8 + tt) * 260 + c4);
            const f32x4 o = (y + z * hd) * u0;
            u32x2 oo; oo.x = pk2(o[0], o[1]); oo.y = pk2(o[2], o[3]); *(u32x2*)(YMIX + (size_t)(c.row0 + tg * 8 + tt) * D + c4) = oo;
        }
        __syncthreads();
    }
}
__device__ __forceinline__ void ph_post_tok(CArgs& a, int l, int gw, int ngw) {
    const int lane = tidx() & 63;
    const bf16* P = (const bf16*)(a.ws + WS_P); bf16* YMIX = (bf16*)(a.ws + WS_YMIX);
    const float* GOF = (const float*)(a.ws + WS_MIX + MX_GOF); const float* GOB = (const float*)(a.ws + WS_MIX + MX_GOB);
    const float* DOF = (const float*)(a.ws + WS_MIX + MX_DOF); const float* DOB = (const float*)(a.ws + WS_MIX + MX_DOB);
    const f32x4 nwa = *(const f32x4*)(a.in[I_GLANW] + l * 64 + (4 * lane & 63)), nwd = *(const f32x4*)(a.in[I_GDNNW] + l * 64 + (4 * lane & 63));
    for (int row = gw; row < NTOK; row += ngw) {
        const size_t o4 = (size_t)row * 256 + 4 * lane;
        f32x4 og = *(const f32x4*)(GOF + o4) + *(const f32x4*)(GOB + o4), od = *(const f32x4*)(DOF + o4) + *(const f32x4*)(DOB + o4);
        float sg = og[0] * og[0] + og[1] * og[1] + og[2] * og[2] + og[3] * og[3], sd = od[0] * od[0] + od[1] * od[1] + od[2] * od[2] + od[3] * od[3];
        sg = row16_sum(sg); sd = row16_sum(sd);
        const float rg = rsqrtf(sg * (1.f / 64.f) + 1e-6f), rd = rsqrtf(sd * (1.f / 64.f) + 1e-6f);
        const u32x2 r2 = *(const u32x2*)(P + (size_t)row * D_INP + GLA0 + 512 + 4 * lane), z2 = *(const u32x2*)(P + (size_t)row * D_INP + GDN0 + 768 + 4 * lane);
        u32x2 w;
        w.x = pk2(og[0] * rg * nwa[0] * siluf_(lo_bf(r2.x)), og[1] * rg * nwa[1] * siluf_(hi_bf(r2.x))); w.y = pk2(og[2] * rg * nwa[2] * siluf_(lo_bf(r2.y)), og[3] * rg * nwa[3] * siluf_(hi_bf(r2.y)));
        *(u32x2*)(YMIX + (size_t)row * D + 512 + 4 * lane) = w;
        w.x = pk2(od[0] * rd * nwd[0] * siluf_(lo_bf(z2.x)), od[1] * rd * nwd[1] * siluf_(hi_bf(z2.x))); w.y = pk2(od[2] * rd * nwd[2] * siluf_(lo_bf(z2.y)), od[3] * rd * nwd[3] * siluf_(hi_bf(z2.y)));
        *(u32x2*)(YMIX + (size_t)row * D + 768 + 4 * lane) = w;
    }
}

__device__ __forceinline__ void ph_ln1_route(CArgs& a, int l, LAS unsigned char* lds, int bid, int nblk) {
    const int tid = tidx(), lane = tid & 63, w = __builtin_amdgcn_readfirstlane(tid >> 6);
    const float* MOD = (const float*)(a.ws + WS_MOD) + (size_t)l * 17 * 6144;
    float* X = (float*)(a.ws + WS_X); const float* TMP = (const float*)(a.ws + WS_TMP); bf16* HB = (bf16*)(a.ws + WS_HB);
    const float* lg = a.in[I_LN1G] + l * D; const float* lb = a.in[I_LN1B] + l * D;
    const float* br = a.in[I_BR] + l * NEXP;
    const bf16* wh = (const bf16*)(a.ws + WS_WRT) + (size_t)l * NEXP * D; const bf16* wl = wh + DEPTH * NEXP * D;
    unsigned* cnt = (unsigned*)(a.ws + WS_CTL) + CW_CNT + l * NEXP * 64;
    int* LIST = (int*)(a.ws + WS_LIST); int* TOPE = (int*)(a.ws + WS_TOPE); float* TOPW = (float*)(a.ws + WS_TOPW);
    LAS float* hrow = (LAS float*)lds;
    LAS float* part = (LAS float*)(lds + 65792);
    const int row_lo = (l == DEPTH - 1) ? NTOK_C : 0;
    const int e = lane & 31, par = lane >> 5, fr = lane & 15, kg = lane >> 4;
    f32x4 xv[2][4], tv[2][4];
#define LN1_FETCH(base_) do { _Pragma("unroll") for (int t = 0; t < 2; ++t) { const int row_ = (base_) + 2 * w + t; \
        const float* xs_ = (l == 0) ? (row_ < NTOK_C ? a.in[I_CTX] + (size_t)row_ * D : a.in[I_X] + (size_t)(row_ - NTOK_C) * D) : X + (size_t)row_ * D; \
        _Pragma("unroll") for (int j = 0; j < 4; ++j) { xv[t][j] = *(const f32x4*)(xs_ + j * 256 + 4 * lane); tv[t][j] = *(const f32x4*)(TMP + (size_t)row_ * D + j * 256 + 4 * lane); } } } while (0)
    int base = row_lo + bid * 16;
    if (base < NTOK) LN1_FETCH(base);
    int p_row = -1, p_ee = 0; unsigned p_pos = 0u; float p_ww = 0.f;
#pragma unroll 1
    for (; base < NTOK; base += nblk * 16) {
#pragma unroll
        for (int t = 0; t < 2; ++t) {
            const int row = base + 2 * w + t;
            const float* mv = MOD + (size_t)mod_vec(row) * 6144;
            f32x4 v[4]; float s = 0.f;
#pragma unroll
            for (int j = 0; j < 4; ++j) { const int c0 = j * 256 + 4 * lane; const f32x4 g1 = *(const f32x4*)(mv + 2048 + c0);
                v[j] = DN_ALPHA * xv[t][j] + g1 * tv[t][j]; s += (v[j][0] + v[j][1]) + (v[j][2] + v[j][3]); }
            const float mean = wave_sum(s) * (1.f / D); float s2 = 0.f;
#pragma unroll
            for (int j = 0; j < 4; ++j) { v[j] = v[j] - mean; s2 += (v[j][0] * v[j][0] + v[j][1] * v[j][1]) + (v[j][2] * v[j][2] + v[j][3] * v[j][3]); }
            const float rstd = rsqrtf(wave_sum(s2) * (1.f / D) + LN_EPS);
#pragma unroll
            for (int j = 0; j < 4; ++j) { const int c0 = j * 256 + 4 * lane; const f32x4 g = *(const f32x4*)(lg + c0), bb = *(const f32x4*)(lb + c0), sh = *(const f32x4*)(mv + 3072 + c0), sc = *(const f32x4*)(mv + 4096 + c0);
                const f32x4 xn = v[j] * rstd * g + bb; *(f32x4*)(X + (size_t)row * D + c0) = xn;
                const f32x4 hh = xn * (1.f + sc) + sh;
                *(unsigned*)(a.ws + WS_HB8 + (size_t)row * D + c0) = pk4_fp8(4.f * hh[0], 4.f * hh[1], 4.f * hh[2], 4.f * hh[3]);
                *(LAS f32x4*)(hrow + (2 * w + t) * 1028 + c0) = hh; }
        }
        __syncthreads();
        if (base + nblk * 16 < NTOK) LN1_FETCH(base + nblk * 16);
        {
            f32x4 acc[2] = {(f32x4){0.f, 0.f, 0.f, 0.f}, (f32x4){0.f, 0.f, 0.f, 0.f}};
#pragma unroll
            for (int ss = 0; ss < 4; ++ss) { const int k0 = 128 * w + 32 * ss + 8 * kg;
                const f32x4 h0 = *(const LAS f32x4*)(hrow + fr * 1028 + k0), h1 = *(const LAS f32x4*)(hrow + fr * 1028 + k0 + 4);
                u32x4 ah, al;
                ah.x = pk2(h0[0], h0[1]); ah.y = pk2(h0[2], h0[3]); ah.z = pk2(h1[0], h1[1]); ah.w = pk2(h1[2], h1[3]);
                al.x = pk2(h0[0] - lo_bf(ah.x), h0[1] - hi_bf(ah.x)); al.y = pk2(h0[2] - lo_bf(ah.y), h0[3] - hi_bf(ah.y)); al.z = pk2(h1[0] - lo_bf(ah.z), h1[1] - hi_bf(ah.z)); al.w = pk2(h1[2] - lo_bf(ah.w), h1[3] - hi_bf(ah.w));
                const bf16x8 Ah = __builtin_bit_cast(bf16x8, ah), Al = __builtin_bit_cast(bf16x8, al);
#pragma unroll
                for (int t = 0; t < 2; ++t) { const size_t wo = (size_t)(16 * t + fr) * D + k0;
                    const bf16x8 Bh = *(const bf16x8*)(wh + wo), Bl = *(const bf16x8*)(wl + wo);
                    acc[t] = __builtin_amdgcn_mfma_f32_16x16x32_bf16(Ah, Bh, acc[t], 0, 0, 0);
                    acc[t] = __builtin_amdgcn_mfma_f32_16x16x32_bf16(Ah, Bl, acc[t], 0, 0, 0);
                    acc[t] = __builtin_amdgcn_mfma_f32_16x16x32_bf16(Al, Bh, acc[t], 0, 0, 0); } }
#pragma unroll
            for (int t = 0; t < 2; ++t)
#pragma unroll
                for (int j = 0; j < 4; ++j) part[((w * 2 + t) * 16 + 4 * kg + j) * 16 + fr] = acc[t][j];
        }
        __syncthreads();
        {
            const int row = base + 2 * w + par;
            float cur = br[e];
#pragma unroll
            for (int ww = 0; ww < 8; ++ww) cur += part[((ww * 2 + (e >> 4)) * 16 + 2 * w + par) * 16 + (e & 15)];
            float tvv[4]; int ti[4];
#pragma unroll
            for (int k = 0; k < 4; ++k) { float bv = cur; int bi = e;
#define TOPSTEP(OV, OI) do { const float ov = (OV); const int oi = (OI); if (ov > bv || (ov == bv && oi < bi)) { bv = ov; bi = oi; } } while (0)
                TOPSTEP(dpp_f<0xB1>(bv), dpp_i<0xB1>(bi)); TOPSTEP(dpp_f<0x4E>(bv), dpp_i<0x4E>(bi)); TOPSTEP(dpp_f<0x141>(bv), dpp_i<0x141>(bi)); TOPSTEP(dpp_f<0x140>(bv), dpp_i<0x140>(bi));
                TOPSTEP(__shfl_xor(bv, 16), __shfl_xor(bi, 16));
#undef TOPSTEP
                tvv[k] = bv; ti[k] = bi; if (e == bi) cur = -3.0e38f; }
            const float e1 = __expf(tvv[1] - tvv[0]), e2 = __expf(tvv[2] - tvv[0]), e3 = __expf(tvv[3] - tvv[0]); const float inv = 1.f / (1.f + e1 + e2 + e3);
            if (e < 4) {
                if (p_row >= 0) { LIST[(size_t)p_ee * NTOK + p_pos] = p_row; TOPE[(size_t)p_row * 4 + e] = (p_ee << 20) | (int)p_pos; TOPW[(size_t)p_row * 4 + e] = p_ww; }
                p_ee = e == 0 ? ti[0] : e == 1 ? ti[1] : e == 2 ? ti[2] : ti[3]; p_ww = (e == 0 ? 1.f : e == 1 ? e1 : e == 2 ? e2 : e3) * inv; p_row = row;
                p_pos = atomicAdd(cnt + p_ee * 64, 1u); }
        }
    }
    if (e < 4 && p_row >= 0) { LIST[(size_t)p_ee * NTOK + p_pos] = p_row; TOPE[(size_t)p_row * 4 + e] = (p_ee << 20) | (int)p_pos; TOPW[(size_t)p_row * 4 + e] = p_ww; }
#undef LN1_FETCH
}
__device__ __forceinline__ void moe_tables(CArgs& a, int l, LAS unsigned char* lds, int NT) {
    LAS int* pre = (LAS int*)(lds + TAB_OFF); LAS int* mtl = pre + 40; LAS int* rowoff = pre + 80; LAS int* cn = pre + 120;
    if (tidx() == 0) { const unsigned* cnt = (const unsigned*)(a.ws + WS_CTL) + CW_CNT + l * NEXP * 64; int p = 0, r = 0;
        for (int e = 0; e < NEXP; ++e) { const int n = (int)__hip_atomic_load(cnt + e * 64, __ATOMIC_RELAXED, __HIP_MEMORY_SCOPE_AGENT), m = (n + 255) >> 8; pre[e] = p; mtl[e] = m > 0 ? m : 1; rowoff[e] = r; cn[e] = n; p += m * NT; r += m * 256; }
        pre[32] = p; }
    __syncthreads();
}
__device__ __forceinline__ void ph_ln2(CArgs& a, int l, LAS unsigned char* lds, int gw, int ngw) {
    const int lane = tidx() & 63;
    const float* MOD = (const float*)(a.ws + WS_MOD) + (size_t)l * 17 * 6144;
    float* X = (float*)(a.ws + WS_X); const bf16* YD = (const bf16*)(a.ws + WS_YD); bf16* HB = (bf16*)(a.ws + WS_HB);
    const float* lg = a.in[I_LN2G] + l * D; const float* lb = a.in[I_LN2B] + l * D;
    const int* TOPE = (const int*)(a.ws + WS_TOPE); const float* TOPW = (const float*)(a.ws + WS_TOPW);
    const LAS int* rowoff = (const LAS int*)(lds + TAB_OFF) + 80;
    const bool lastl = (l == DEPTH - 1);
    const int row_lo = lastl ? NTOK_C : 0;
#pragma unroll 1
    for (int row0 = row_lo + gw * 2; row0 < NTOK; row0 += ngw * 2) {
        u32x2 y2[2][4][4]; float tw[2][4]; f32x4 xv[2][4], g2v[2][4];
#pragma unroll
        for (int r = 0; r < 2; ++r) {
            const int row = row0 + r;
#pragma unroll
            for (int k = 0; k < 4; ++k) { const int te = TOPE[(size_t)row * 4 + k]; tw[r][k] = TOPW[(size_t)row * 4 + k];
                const bf16* yr = YD + ((size_t)(rowoff[te >> 20] + (te & 0xfffff))) * D;
#pragma unroll
                for (int j = 0; j < 4; ++j) y2[r][k][j] = *(const u32x2*)(yr + j * 256 + 4 * lane); }
            const float* mv = MOD + (size_t)mod_vec(row) * 6144;
#pragma unroll
            for (int j = 0; j < 4; ++j) { const int c0 = j * 256 + 4 * lane; xv[r][j] = *(const f32x4*)(X + (size_t)row * D + c0); g2v[r][j] = *(const f32x4*)(mv + 5120 + c0); }
        }
#pragma unroll
        for (int r = 0; r < 2; ++r) {
            const int row = row0 + r;
            const float* mv = MOD + (size_t)mod_vec(row) * 6144;
            f32x4 v[4]; float s = 0.f;
#pragma unroll
            for (int j = 0; j < 4; ++j) { f32x4 f = (f32x4){0.f, 0.f, 0.f, 0.f};
#pragma unroll
                for (int k = 0; k < 4; ++k) { const u32x2 yy = y2[r][k][j]; f += tw[r][k] * (f32x4){lo_bf(yy.x), hi_bf(yy.x), lo_bf(yy.y), hi_bf(yy.y)}; }
                v[j] = DN_ALPHA * xv[r][j] + g2v[r][j] * f; s += (v[j][0] + v[j][1]) + (v[j][2] + v[j][3]); }
            const float mean = wave_sum(s) * (1.f / D); float s2 = 0.f;
#pragma unroll
            for (int j = 0; j < 4; ++j) { v[j] = v[j] - mean; s2 += (v[j][0] * v[j][0] + v[j][1] * v[j][1]) + (v[j][2] * v[j][2] + v[j][3] * v[j][3]); }
            const float rstd = rsqrtf(wave_sum(s2) * (1.f / D) + LN_EPS);
            const float* mvn = mv + 17 * 6144;
#pragma unroll
            for (int j = 0; j < 4; ++j) { const int c0 = j * 256 + 4 * lane; const f32x4 g = *(const f32x4*)(lg + c0), bb = *(const f32x4*)(lb + c0);
                const f32x4 xn = v[j] * rstd * g + bb;
                if (lastl) *(f32x4*)(a.out + (size_t)(row - NTOK_C) * D + c0) = xn;
                else { *(f32x4*)(X + (size_t)row * D + c0) = xn; const f32x4 sh = *(const f32x4*)(mvn + c0), sc = *(const f32x4*)(mvn + 1024 + c0); const f32x4 hh = xn * (1.f + sc) + sh;
                    u32x2 o; o.x = pk2(hh[0], hh[1]); o.y = pk2(hh[2], hh[3]); *(u32x2*)(HB + (size_t)row * D + c0) = o; } }
        }
    }
}

constexpr int NPH = 2 + DEPTH * 9;
__device__ __forceinline__ CArgs* kargs() { CArgs* p = (CArgs*)__builtin_amdgcn_kernarg_segment_ptr(); asm volatile("" : "+s"(p)); return p; }
__global__ void __launch_bounds__(512, 2) trunk_fwd(Args a_unused) {
    extern __shared__ __attribute__((aligned(16))) unsigned char lds_raw[];
    LAS unsigned char* lds = (LAS unsigned char*)lds_raw;
    const int tid = threadIdx.x, wave = __builtin_amdgcn_readfirstlane(tid >> 6);
    const int bid = blockIdx.x, nblk = gridDim.x, gw = bid * 8 + wave, ngw = nblk * 8;
    volatile LAS unsigned* MISC = (volatile LAS unsigned*)(lds + MISC_OFF);
    if (tid < 64) MISC[tid] = 0u;
    __syncthreads();
    XcdBarrier bar; bar.x = 0; bar.st = nullptr;
    int lo, hi;
    { CArgs& a = *kargs(); lo = a.ph_lo; hi = a.ph_hi; bar.bar = (unsigned*)(a.ws + WS_CTL) + CW_BAR;
      if (hi - lo > 1) bar = xcd_barrier_post((unsigned*)(a.ws + WS_CTL) + CW_BAR, MISC); }
#define IN(k) (lo <= (k) && (k) < hi)
    unsigned long long tacc = 0ull, tbeg = 0ull;
#define PB_BEG(ty) do { if (PROBE_PH == (ty)) tbeg = __builtin_amdgcn_s_memrealtime(); } while (0)
#define PB_END(ty) do { if (PROBE_PH == (ty)) tacc += __builtin_amdgcn_s_memrealtime() - tbeg; } while (0)
#define SEAM(k) do { if (IN(k) && IN((k) + 1)) xcd_barrier(bar); } while (0)
    PB_BEG(0);
    if (IN(0)) { CArgs& a = *kargs(); unsigned long long t0 = 0ull;
#define PB_SUB(ty, stmt) do { if (PROBE_PH == (ty)) t0 = __builtin_amdgcn_s_memrealtime(); stmt; if (PROBE_PH == (ty)) tacc += __builtin_amdgcn_s_memrealtime() - t0; } while (0)
        PB_SUB(30, ph_mod(a, lds, bid, nblk)); __syncthreads(); PB_SUB(31, ph_filters(a, gw, ngw)); PB_SUB(32, ph_tr_small(a, lds, gw, ngw)); PB_SUB(33, ph_router_w(a, bid * 512 + tid, nblk * 512));
#undef PB_SUB
    }
    SEAM(0); PB_END(0); PB_BEG(1);
    if (IN(1)) { CArgs& a = *kargs(); ph_mod_input(a, gw, ngw); }
    SEAM(1); PB_END(1);
#pragma unroll 1
    for (int l = 0; l < DEPTH; ++l) {
        const int p0 = 2 + 9 * l;
        const bool lastl = (l == DEPTH - 1);
        PB_BEG(2);
        if (IN(p0 + 0)) {
            CArgs& a = *kargs();
            pg8::DenseSched S; S.init((const bf16*)(a.ws + WS_WIN) + (size_t)l * D_INP * 1024, 1024, NTOK, D_INP, nblk, bid, 0);
            pg8::EpiBf16 E{(bf16*)(a.ws + WS_P), D_INP, 0};
            pg8::gemm_phase<pg8::EpiBf16, pg8::DenseSched, true>(lds, (const char*)(a.ws + WS_HB), 1024, S, E);
        }
        SEAM(p0 + 0); PB_END(2); PB_BEG(3);
        if (IN(p0 + 1)) { CArgs& a = *kargs(); ph_prep_conv(a, l, lds, bid, nblk); ph_prep_tok(a, l, gw, ngw); }
        SEAM(p0 + 1); PB_END(3); PB_BEG(4);
        if (IN(p0 + 2)) { CArgs& a = *kargs(); ph_scan(a, l, lds, bid, nblk, tacc); }
        SEAM(p0 + 2); PB_END(4); PB_BEG(5);
        if (IN(p0 + 3)) { CArgs& a = *kargs(); ph_post_hyena(a, l, lds, bid, nblk); ph_post_tok(a, l, gw, ngw); }
        SEAM(p0 + 3); PB_END(5); PB_BEG(6);
        if (IN(p0 + 4)) {
            CArgs& a = *kargs();
            const int r0 = lastl ? NTOK_C : 0;
            pg8::DenseSched S; S.init((const bf16*)(a.ws + WS_WOUT) + (size_t)l * 1024 * 1024, 1024, NTOK - r0, 1024, nblk, bid, r0);
            pg8::EpiF32 E{(float*)(a.ws + WS_TMP), 1024, r0};
            pg8::gemm_phase<pg8::EpiF32, pg8::DenseSched, true>(lds, (const char*)(a.ws + WS_YMIX), 1024, S, E);
        }
        SEAM(p0 + 4); PB_END(6); PB_BEG(7);
        if (IN(p0 + 5)) { CArgs& a = *kargs(); ph_ln1_route(a, l, lds, bid, nblk); }
        SEAM(p0 + 5); PB_END(7); PB_BEG(8);
        if (IN(p0 + 6)) {
            CArgs& a = *kargs();
            moe_tables(a, l, lds, 8);
            const LAS int* tb = (const LAS int*)(lds + TAB_OFF);
            pg8::MoeSched<true, 8> S; S.Bt = (const char*)(a.ws + WS_WGU); S.bstride = (size_t)2048 * 1024; S.rb = 1024; S.list = (const int*)(a.ws + WS_LIST);
            S.pre = tb; S.mtl = tb + 40; S.rowoff = tb + 80; S.cnt = tb + 120; S.K = 1024; S.G = nblk; S.c = (nblk % 8 == 0) ? (bid % 8) * (nblk / 8) + bid / 8 : bid; S.total = tb[32];
            pg8::EpiSwiglu E{(bf16*)(a.ws + WS_H), a.in[I_BG] + (size_t)l * NEXP * 1024, a.in[I_BU] + (size_t)l * NEXP * 1024, tb + 80, 1.f / 128.f};
            pg8::gemm_phase_f8g<pg8::EpiSwiglu, pg8::MoeSched<true, 8>, true>(lds, (const char*)(a.ws + WS_HB8), 1024, S, E);
        }
        SEAM(p0 + 6); PB_END(8); PB_BEG(9);
        if (IN(p0 + 7)) {
            CArgs& a = *kargs();
            moe_tables(a, l, lds, 4);
            const LAS int* tb = (const LAS int*)(lds + TAB_OFF);
            pg8::MoeSched<false, 4> S; S.Bt = (const char*)(a.ws + WS_WD); S.bstride = (size_t)1024 * 1024; S.rb = 1024; S.list = nullptr;
            S.pre = tb; S.mtl = tb + 40; S.rowoff = tb + 80; S.cnt = tb + 120; S.K = 1024; S.G = nblk; S.c = (nblk % 8 == 0) ? (bid % 8) * (nblk / 8) + bid / 8 : bid; S.total = tb[32];
            pg8::EpiDown E{(bf16*)(a.ws + WS_YD), a.in[I_BD] + (size_t)l * NEXP * 1024, tb + 80, 1.f / 128.f};
            pg8::gemm_phase_f8<pg8::EpiDown, pg8::MoeSched<false, 4>, true>(lds, (const char*)(a.ws + WS_H), 1024, S, E);
        }
        SEAM(p0 + 7); PB_END(9); PB_BEG(10);
        if (IN(p0 + 8)) { CArgs& a = *kargs(); moe_tables(a, l, lds, 4); ph_ln2(a, l, lds, gw, ngw); }
        if (!lastl) SEAM(p0 + 8);
        PB_END(10);
    }
    if (PROBE_PH >= 0) { const unsigned long long t0 = __builtin_amdgcn_s_memrealtime(); while (__builtin_amdgcn_s_memrealtime() - t0 < tacc) __builtin_amdgcn_s_sleep(8); }
#undef IN
#undef SEAM
}

extern "C" void kernel_launch(void* const* d_in, const int* in_sizes, int n_in, void* d_out, int out_size, void* d_ws, size_t ws_size, hipStream_t stream) {
    static int grid = 0;
    if (grid == 0) {
        if (n_in != 39 || out_size != NTOK_L * D || ws_size < WS_END) { fprintf(stderr, "kernel_launch: unexpected problem (n_in %d, out %d, ws %zu < %zu)\n", n_in, out_size, ws_size, (size_t)WS_END); grid = -1; return; }
        int dev = 0, cus = 0, per_cu = 0;
        if (hipGetDevice(&dev) != hipSuccess || hipDeviceGetAttribute(&cus, hipDeviceAttributeMultiprocessorCount, dev) != hipSuccess) { grid = -1; return; }
        if (hipFuncSetAttribute((const void*)trunk_fwd, hipFuncAttributeMaxDynamicSharedMemorySize, LDS_BYTES) != hipSuccess) { fprintf(stderr, "kernel_launch: hipFuncSetAttribute failed\n"); grid = -1; return; }
        if (hipOccupancyMaxActiveBlocksPerMultiprocessor(&per_cu, (const void*)trunk_fwd, 512, LDS_BYTES) != hipSuccess || per_cu < 1) fprintf(stderr, "kernel_launch: occupancy query says %d\n", per_cu);
        (void)hipGetLastError();
        grid = cus;
    }
    if (grid < 0) return;
    (void)hipMemsetAsync((char*)d_ws + WS_CTL, 0, CTL_ZERO_BYTES, stream);
    Args a{};
    for (int i = 0; i < 39; ++i) a.in[i] = (const float*)d_in[i];
    a.out = (float*)d_out; a.ws = (unsigned char*)d_ws;
#if MK_FUSED
    a.ph_lo = 0; a.ph_hi = NPH;
    hipLaunchKernelGGL(trunk_fwd, dim3(grid), dim3(512), LDS_BYTES, stream, a);
#else
    for (int p = 0; p < NPH; ++p) { a.ph_lo = p; a.ph_hi = p + 1; hipLaunchKernelGGL(trunk_fwd, dim3(grid), dim3(512), LDS_BYTES, stream, a); }
#endif
}
```

```cpp
#include <hip/hip_runtime.h>
#include <cstdio>
#include <cstdint>

#ifndef MK_FUSED
#define MK_FUSED 1
#endif

#ifndef USE_NEW_GDN
#define USE_NEW_GDN 1
#endif
#ifndef USE_NEW_GLA
#define USE_NEW_GLA 1
#endif
#ifndef PROBE_PH
#define PROBE_PH -1
#endif

#define LAS __attribute__((address_space(3)))
#define GAS __attribute__((address_space(1)))
typedef unsigned short bf16;
typedef short bf16x8 __attribute__((ext_vector_type(8)));
typedef float f32x4 __attribute__((ext_vector_type(4)));
typedef float f32x2 __attribute__((ext_vector_type(2)));
typedef unsigned u32x4 __attribute__((ext_vector_type(4)));
typedef unsigned u32x2 __attribute__((ext_vector_type(2)));

constexpr int D = 1024, NB = 16, SEQ = 2048, CTXL = 256, DEPTH = 4;
constexpr int NTOK_C = NB * CTXL, NTOK_L = NB * SEQ, NTOK = NTOK_C + NTOK_L;
constexpr int D_IN = 3376, D_INP = 3584;
constexpr int HY0 = 0, SC0 = 768, GLA0 = 1536, GDN0 = 2336;
constexpr int NEXP = 32, TOPK = 4;
constexpr int MAXROWS = NTOK * TOPK + NEXP * 256;
constexpr float DN_ALPHA = 1.681792830507429f;
constexpr float LN_EPS = 1e-5f;

constexpr size_t MiB = 1u << 20;
constexpr size_t WS_CTL = 0, CTL_ZERO_BYTES = 1 * MiB;
constexpr size_t WS_MOD = 1 * MiB;
constexpr size_t WS_WRT = 3 * MiB;
constexpr size_t WS_KUN = 4 * MiB;
constexpr size_t WS_WIN = 36 * MiB;
constexpr size_t WS_WOUT = 64 * MiB;
constexpr size_t WS_WGU = 72 * MiB;
constexpr size_t WS_WD = 200 * MiB;
constexpr size_t WS_X = 264 * MiB;
constexpr size_t WS_HB = 408 * MiB;
constexpr size_t WS_P = 480 * MiB;
constexpr size_t WS_YMIX = 732 * MiB;
constexpr size_t WS_YD = WS_P;
constexpr size_t WS_TMP = 804 * MiB;
constexpr size_t WS_LIST = 948 * MiB;
constexpr size_t WS_TOPE = 953 * MiB;
constexpr size_t WS_TOPW = 954 * MiB;
constexpr size_t WS_H = 956 * MiB;
constexpr size_t WS_MIX = 1264 * MiB;
constexpr size_t MX_ZT = 0;
constexpr size_t MX_YT = 20 * MiB;
constexpr size_t MX_GDF = 56 * MiB, MX_GDB = 76 * MiB;
constexpr size_t MX_GOF = 96 * MiB, MX_GOB = 132 * MiB;
constexpr size_t MX_DQ = 168 * MiB, MX_DK = 204 * MiB, MX_DV = 240 * MiB;
constexpr size_t MX_DG = 276 * MiB;
constexpr size_t MX_DOF = 280 * MiB, MX_DOB = 316 * MiB;
constexpr size_t WS_HB8 = 1616 * MiB;
constexpr size_t WS_END = 1980 * MiB;
constexpr int NUNIT = 128 * 36;
constexpr size_t WS_CKD = 1656 * MiB;
constexpr size_t CD_M = 0;
constexpr size_t CD_E = 36 * MiB;
constexpr size_t CD_BT = 72 * MiB;
constexpr size_t CD_FT = 144 * MiB;
constexpr size_t CD_KB = 180 * MiB, CD_QB = 198 * MiB;
constexpr size_t WS_CKA = WS_CKD + 216 * MiB;
constexpr size_t CA_QC = 0;
constexpr size_t CA_FT = 20 * MiB;
constexpr size_t CA_UT = 60 * MiB;
constexpr size_t CA_DL = 100 * MiB;
static_assert(WS_CKA + CA_DL + (size_t)NUNIT * 32 * 4 <= WS_END, "chunk data");
static_assert((size_t)MAXROWS * 1024 * 2 <= 324 * MiB, "YD overlay");
static_assert(WS_H + (size_t)MAXROWS * 1024 * 2 <= WS_MIX, "H");
constexpr int CW_BAR = 4096;
constexpr int CW_CNT = 16384;

constexpr int LDS_BYTES = 147456;
constexpr int MISC_OFF = 143360;
constexpr int TAB_OFF = 143360 + 256;

__device__ __forceinline__ float bf2f(unsigned v) { return __uint_as_float(v << 16); }
__device__ __forceinline__ unsigned f2bf(float f) { unsigned u = __float_as_uint(f); return (u + 0x7fffu + ((u >> 16) & 1u)) >> 16; }
__device__ __forceinline__ unsigned pk2(float lo, float hi) { return f2bf(lo) | (f2bf(hi) << 16); }
__device__ __forceinline__ unsigned pk4_fp8(float a, float b, float c, float d) { int r = __builtin_amdgcn_cvt_pk_fp8_f32(a, b, 0, false); return (unsigned)__builtin_amdgcn_cvt_pk_fp8_f32(c, d, r, true); }
__device__ __forceinline__ float lo_bf(unsigned w) { return __uint_as_float(w << 16); }
__device__ __forceinline__ float hi_bf(unsigned w) { return __uint_as_float(w & 0xffff0000u); }
__device__ __forceinline__ float sigmoidf_(float x) { return 1.f / (1.f + __expf(-x)); }
__device__ __forceinline__ float siluf_(float x) { return x / (1.f + __expf(-x)); }
__device__ __forceinline__ float softplusf_(float x) { return x > 20.f ? x : log1pf(__expf(x)); }
__device__ __forceinline__ float logsigmoidf_(float x) { return x >= 0.f ? -log1pf(__expf(-x)) : x - log1pf(__expf(x)); }
__device__ __forceinline__ float sin_rev(float r) { return __builtin_amdgcn_sinf(__builtin_amdgcn_fractf(r)); }
__device__ __forceinline__ float sin_rad(float x) { return sin_rev(x * 0.15915494309189535f); }
template <int CTRL> __device__ __forceinline__ float dpp_f(float v) { return __builtin_bit_cast(float, __builtin_amdgcn_update_dpp(0, __builtin_bit_cast(int, v), CTRL, 0xf, 0xf, true)); }
template <int CTRL> __device__ __forceinline__ int dpp_i(int v) { return __builtin_amdgcn_update_dpp(0, v, CTRL, 0xf, 0xf, true); }
__device__ __forceinline__ float quad_sum(float v) { v += dpp_f<0xB1>(v); v += dpp_f<0x4E>(v); return v; }
__device__ __forceinline__ float row16_sum(float v) { v += dpp_f<0xB1>(v); v += dpp_f<0x4E>(v); v += dpp_f<0x141>(v); v += dpp_f<0x140>(v); return v; }
__device__ __forceinline__ float rdlane_f(float v, int l) { return __builtin_bit_cast(float, __builtin_amdgcn_readlane(__builtin_bit_cast(int, v), l)); }
__device__ __forceinline__ float wave_sum(float v) {
    v = row16_sum(v);
    return (rdlane_f(v, 0) + rdlane_f(v, 16)) + (rdlane_f(v, 32) + rdlane_f(v, 48));
}
__device__ __forceinline__ int tidx() { int t = threadIdx.x; asm volatile("" : "+v"(t)); return t; }

#define XB_TMO      128
#define XB_XCNT(j)  (256  + 64 * (j))
#define XB_XSUB(j)  (1280 + 64 * (j))
#define XB_XGEN(j)  (2304 + 64 * (j))
#define XB_TOP      3328
#define XB_TOPGEN   3392
#define XCD_BAR_WORDS 3456
#define XB_SPIN_CAP (1u << 25)
__device__ __forceinline__ unsigned xb_ld(unsigned* p)              { return __hip_atomic_load(p, __ATOMIC_RELAXED, __HIP_MEMORY_SCOPE_AGENT); }
__device__ __forceinline__ unsigned xb_add(unsigned* p, unsigned v) { return __hip_atomic_fetch_add(p, v, __ATOMIC_RELAXED, __HIP_MEMORY_SCOPE_AGENT); }
__device__ __forceinline__ unsigned xb_xcc_id() { return (unsigned)__builtin_amdgcn_s_getreg((3 << 11) | 20) & 0xFu; }
#define XB_SPIN(cond, bar) do { unsigned _sp = 0; while (cond) { __builtin_amdgcn_s_sleep(1); \
    if ((++_sp & 255u) == 0u) { if (xb_ld(&(bar)[XB_TMO])) break; if (_sp > XB_SPIN_CAP) { atomicAdd(&(bar)[XB_TMO], 1u); break; } } } } while (0)
struct XcdBarrier { unsigned* bar; unsigned x; volatile LAS unsigned* st; };
__device__ __forceinline__ XcdBarrier xcd_barrier_post(unsigned* bar, volatile LAS unsigned* st) {
    XcdBarrier b; b.bar = bar; b.x = xb_xcc_id(); b.st = st;
    if (threadIdx.x == 0) (void)xb_add(&bar[XB_XCNT(b.x)], 1u);
    return b;
}
__device__ __forceinline__ void xcd_barrier_complete(unsigned* bar, unsigned x, unsigned& nloc, unsigned& nx) {
    const unsigned G = gridDim.x * gridDim.y * gridDim.z;
    unsigned sum, cnt, mine, sp = 0u;
    for (;;) {
        sum = 0u; cnt = 0u; mine = 0u;
#pragma unroll
        for (unsigned j = 0; j < 16; ++j) { const unsigned c = xb_ld(&bar[XB_XCNT(j)]); sum += c; cnt += (c > 0u) ? 1u : 0u; mine = (j == x) ? c : mine; }
        if (sum == G) break;
        __builtin_amdgcn_s_sleep(1);
        if ((++sp & 255u) == 0u) { if (xb_ld(&bar[XB_TMO])) break; if (sp > XB_SPIN_CAP) { atomicAdd(&bar[XB_TMO], 1u); break; } }
    }
    nloc = mine > 0u ? mine : 1u; nx = cnt > 0u ? cnt : 1u;
}
__device__ __forceinline__ void xcd_barrier(const XcdBarrier& b) {
    asm volatile("s_waitcnt vmcnt(0)" ::: "memory");
    __syncthreads();
    if (threadIdx.x == 0) {
        unsigned* bar = b.bar;
        __builtin_amdgcn_s_waitcnt(0);
        unsigned nloc = b.st[0], nx = b.st[1];
        if (nloc == 0u) { xcd_barrier_complete(bar, b.x, nloc, nx); b.st[0] = nloc; b.st[1] = nx; }
        const unsigned old = xb_add(&bar[XB_XSUB(b.x)], 1u);
        const unsigned gen = old / nloc;
        if (old + 1u == (gen + 1u) * nloc) {
            __builtin_amdgcn_fence(__ATOMIC_RELEASE, "agent");
            asm volatile("s_waitcnt vmcnt(0)" ::: "memory");
            const unsigned og = xb_add(&bar[XB_TOP], 1u);
            const unsigned tg = og / nx;
            if (og + 1u == (tg + 1u) * nx) xb_add(&bar[XB_TOPGEN], 1u);
            else XB_SPIN(xb_ld(&bar[XB_TOPGEN]) == tg, bar);
            __builtin_amdgcn_fence(__ATOMIC_ACQUIRE, "agent");
            xb_add(&bar[XB_XGEN(b.x)], 1u);
            asm volatile("s_waitcnt vmcnt(0)" ::: "memory");
        } else {
            XB_SPIN(xb_ld(&bar[XB_XGEN(b.x)]) == gen, bar);
            __builtin_amdgcn_fence(__ATOMIC_ACQUIRE, "agent");
            asm volatile("s_waitcnt vmcnt(0)" ::: "memory");
        }
    }
    __syncthreads();
}

namespace pg8 {
constexpr int BM = 256, BK = 64, HALF = 128, HTB = HALF * BK * 2, STAGE_BYTES = 8 * HTB, NXCD = 8, WGM = 8;
__host__ __device__ __forceinline__ int lds_byte(int r, int c) { const int st = (r >> 4) * 2 + (c >> 5), rr = r & 15, cc = c & 31, ob = rr * 64 + cc * 2; return st * 1024 + (ob ^ (((ob >> 9) & 1) << 5)); }
__host__ __device__ __forceinline__ void stage_rc(int b, int& R, int& C) { const int st = b / 1024, sb = b % 1024, swz = sb ^ (((sb >> 9) & 1) << 5); R = (st >> 1) * 16 + swz / 64; C = (st & 1) * 32 + (swz % 64) / 2; }
__host__ __device__ __forceinline__ int perm32(int rho) { const int n = rho >> 4, i = rho & 15; return 8 * (i >> 2) + 4 * n + (i & 3); }
__device__ __forceinline__ unsigned cvt_pk_bf16(float lo, float hi) { unsigned r; asm volatile("v_cvt_pk_bf16_f32 %0, %1, %2" : "=v"(r) : "v"(lo), "v"(hi)); return r; }

struct Unit { int pm, pn, e, mt; };

struct DenseSched {
    const char* Bt; int K, nM, nN, nwg, G, c, row0;
    __device__ __forceinline__ void init(const bf16* Bt_, int K_, int M, int N, int G_, int c_, int row0_) { Bt = (const char*)Bt_; K = K_; nM = M / BM; nN = N / BM; nwg = nM * nN; G = G_; c = c_; row0 = row0_; }
    __device__ __forceinline__ bool next(int i, Unit& u) const {
        const long L = (long)i * G + c; if (L >= nwg) return false;
        int wgid = (int)L; { const int q = nwg / NXCD, r = nwg % NXCD, xcd = wgid % NXCD, off = wgid / NXCD; wgid = (xcd < r ? xcd * (q + 1) : r * (q + 1) + (xcd - r) * q) + off; }
        const int nig = WGM * nN, gid = wgid / nig, fm = gid * WGM, gsz = (nM - fm) < WGM ? (nM - fm) : WGM;
        u.pm = fm + ((wgid % nig) % gsz); u.pn = (wgid % nig) / gsz; u.e = 0; u.mt = 0; return true;
    }
    __device__ __forceinline__ const char* b_ptr(const Unit& u) const { return Bt + (size_t)u.pn * (size_t)(BM * 2) * K; }
    __device__ __forceinline__ void a_offsets(const Unit& u, const int (&R)[2], const int (&C)[2], unsigned (&v)[2][2]) const {
#pragma unroll
        for (int h = 0; h < 2; ++h)
#pragma unroll
            for (int i = 0; i < 2; ++i) v[h][i] = (unsigned)((row0 + u.pm * BM + h * HALF + R[i]) * K + C[i]) * 2u;
    }
};
template <bool GATHER, int NT>
struct MoeSched {
    const char* Bt; size_t bstride;
    int rb;
    const int* list;
    const LAS int* pre; const LAS int* mtl; const LAS int* rowoff; const LAS int* cnt;
    int K, G, c, total;
    __device__ __forceinline__ bool next(int i, Unit& u) const {
        const int L = i * G + c; if (L >= total) return false;
        int e = 0;
#pragma unroll 1
        for (int j = 1; j < NEXP; ++j) e = (L >= pre[j]) ? j : e;
        const int rem = L - pre[e];
        u.e = e; u.pn = rem % NT; u.mt = rem / NT; u.pm = 0; return true;
    }
    __device__ __forceinline__ const char* b_ptr(const Unit& u) const { return Bt + (size_t)u.e * bstride + (size_t)u.pn * (size_t)BM * rb; }
    __device__ __forceinline__ const char* a_ptr(const Unit& u, const char* Abase) const { return Abase + (size_t)(rowoff[u.e] + u.mt * BM) * rb; }
    __device__ __forceinline__ void a_offsets(const Unit& u, const int (&R)[2], const int (&C)[2], unsigned (&v)[2][2]) const {
        if (GATHER) {
            const int n = cnt[u.e]; const int* lp = list + (size_t)u.e * NTOK;
#pragma unroll
            for (int h = 0; h < 2; ++h)
#pragma unroll
                for (int i = 0; i < 2; ++i) { const int idx = u.mt * BM + h * HALF + R[i]; const int tok = idx < n ? lp[idx] : 0; v[h][i] = (unsigned)(tok * rb + 2 * C[i]); }
        } else {
            const int r0 = rowoff[u.e] + u.mt * BM;
#pragma unroll
            for (int h = 0; h < 2; ++h)
#pragma unroll
                for (int i = 0; i < 2; ++i) v[h][i] = (unsigned)((r0 + h * HALF + R[i]) * K + C[i]) * 2u;
        }
    }
};

struct EpiBf16 {
    static constexpr bool PERM = true;
    bf16* O; int ldc; int row0;
    __device__ __forceinline__ void operator()(const f32x4 (&acc)[2][2][4][2], const Unit& u, int wr, int wc, int fr, int fq) const {
        const int r0 = row0 + u.pm * BM + wr * 64 + fr, col0 = u.pn * BM + wc * 32 + 8 * fq;
#pragma unroll
        for (int ai = 0; ai < 2; ++ai)
#pragma unroll
            for (int m = 0; m < 4; ++m) { bf16* rowp = O + (size_t)(r0 + ai * HALF + m * 16) * ldc + col0;
#pragma unroll
                for (int bj = 0; bj < 2; ++bj) { const f32x4 v0 = acc[ai][bj][m][0], v1 = acc[ai][bj][m][1];
                    u32x4 w; w.x = cvt_pk_bf16(v0[0], v0[1]); w.y = cvt_pk_bf16(v0[2], v0[3]); w.z = cvt_pk_bf16(v1[0], v1[1]); w.w = cvt_pk_bf16(v1[2], v1[3]);
                    *(u32x4*)(rowp + bj * HALF) = w; } }
    }
};
struct EpiF32 {
    static constexpr bool PERM = false;
    float* Cc; int ldc; int row0;
    __device__ __forceinline__ void operator()(const f32x4 (&acc)[2][2][4][2], const Unit& u, int wr, int wc, int fr, int fq) const {
        const int r0 = row0 + u.pm * BM + wr * 64 + fr, col0 = u.pn * BM + wc * 32 + 4 * fq;
#pragma unroll
        for (int ai = 0; ai < 2; ++ai)
#pragma unroll
            for (int m = 0; m < 4; ++m) { float* rowp = Cc + (size_t)(r0 + ai * HALF + m * 16) * ldc + col0;
#pragma unroll
                for (int bj = 0; bj < 2; ++bj)
#pragma unroll
                    for (int n = 0; n < 2; ++n) *(f32x4*)(rowp + bj * HALF + n * 16) = acc[ai][bj][m][n]; }
    }
};
struct EpiSwiglu {
    static constexpr bool PERM = true;
    bf16* H; const float* bg; const float* bu; const LAS int* rowoff; float ws;
    __device__ __forceinline__ void operator()(const f32x4 (&acc)[2][2][4][2], const Unit& u, int wr, int wc, int fr, int fq) const {
        const int r0 = rowoff[u.e] + u.mt * BM + wr * 64 + fr, j0 = u.pn * HALF + wc * 32 + 8 * fq;
        f32x4 gb[2], ub[2];
#pragma unroll
        for (int n = 0; n < 2; ++n) { gb[n] = *(const f32x4*)(bg + u.e * 1024 + j0 + 4 * n); ub[n] = *(const f32x4*)(bu + u.e * 1024 + j0 + 4 * n); }
#pragma unroll
        for (int ai = 0; ai < 2; ++ai)
#pragma unroll
            for (int m = 0; m < 4; ++m) { unsigned char* rowp = (unsigned char*)H + (size_t)(r0 + ai * HALF + m * 16) * 1024 + j0; float hv[8];
#pragma unroll
                for (int n = 0; n < 2; ++n)
#pragma unroll
                    for (int j = 0; j < 4; ++j) { float g = acc[ai][0][m][n][j] * ws + gb[n][j], up = acc[ai][1][m][n][j] * ws + ub[n][j];
                        g = fminf(g, 7.f); up = fminf(fmaxf(up, -7.f), 7.f);
                        hv[n * 4 + j] = (up + 1.f) * g * __builtin_amdgcn_rcpf(1.f + __expf(-1.702f * g)); }
                *(u32x2*)rowp = (u32x2){pk4_fp8(4.f * hv[0], 4.f * hv[1], 4.f * hv[2], 4.f * hv[3]), pk4_fp8(4.f * hv[4], 4.f * hv[5], 4.f * hv[6], 4.f * hv[7])}; }
    }
};
struct EpiDown {
    static constexpr bool PERM = true;
    bf16* Y; const float* bd; const LAS int* rowoff; float ws;
    __device__ __forceinline__ void operator()(const f32x4 (&acc)[2][2][4][2], const Unit& u, int wr, int wc, int fr, int fq) const {
        const int r0 = rowoff[u.e] + u.mt * BM + wr * 64 + fr, col0 = u.pn * BM + wc * 32 + 8 * fq;
        f32x4 bv[2][2];
#pragma unroll
        for (int bj = 0; bj < 2; ++bj)
#pragma unroll
            for (int n = 0; n < 2; ++n) bv[bj][n] = *(const f32x4*)(bd + u.e * 1024 + col0 + bj * HALF + 4 * n);
#pragma unroll
        for (int ai = 0; ai < 2; ++ai)
#pragma unroll
            for (int m = 0; m < 4; ++m) { bf16* rowp = Y + (size_t)(r0 + ai * HALF + m * 16) * 1024 + col0;
#pragma unroll
                for (int bj = 0; bj < 2; ++bj) { const f32x4 v0 = acc[ai][bj][m][0] * ws + bv[bj][0], v1 = acc[ai][bj][m][1] * ws + bv[bj][1];
                    u32x4 w; w.x = cvt_pk_bf16(v0[0], v0[1]); w.y = cvt_pk_bf16(v0[2], v0[3]); w.z = cvt_pk_bf16(v1[0], v1[1]); w.w = cvt_pk_bf16(v1[2], v1[3]);
                    *(u32x4*)(rowp + bj * HALF) = w; } }
    }
};

template <class Epi, class Sched, bool ALIGN_EPI>
__device__ __forceinline__ void gemm_phase(LAS unsigned char* lds, const char* Abase, const int K, const Sched& S, const Epi& E) {
    const int tid = tidx(), wid = __builtin_amdgcn_readfirstlane(tid >> 6), lane = tid & 63, wr = wid >> 2, wc = wid & 3, fr = lane & 15, fq = lane >> 4;
    const int nt = K / BK;
    int Rp[2], Cp[2]; unsigned voffB0;
#pragma unroll
    for (int i = 0; i < 2; ++i) stage_rc(tid * 16 + i * 8192, Rp[i], Cp[i]);
    { const int Rb = Epi::PERM ? ((Rp[0] & ~31) + perm32(Rp[0] & 31)) : Rp[0]; voffB0 = (unsigned)(Rb * K + Cp[0]) * 2u; }
    const size_t kstep = (size_t)(BK * 2);
    const size_t hstep = (size_t)HALF * K * 2;
    const unsigned ldsw = (unsigned)wid * 1024u;
    const int aoff = lds_byte(wr * 64 + fr, fq * 8), boff = lds_byte(wc * 32 + fr, fq * 8);
#define PG8_SA(b, h) (((b) * 2 + (h)) * HTB)
#define PG8_SB(b, h) ((4 + (b) * 2 + (h)) * HTB)
#define PG8_STAGE(bufoff, gbase, voff) do { _Pragma("unroll") for (int _i = 0; _i < 2; ++_i) \
        __builtin_amdgcn_global_load_lds((const unsigned*)((const char*)(gbase) + (voff)[_i]), (LAS unsigned*)(lds + (bufoff) + ldsw + _i * 8192), 16, 0, 0); } while (0)
#define PG8_STAGEB(bufoff, gbase) do { _Pragma("unroll") for (int _i = 0; _i < 2; ++_i) \
        __builtin_amdgcn_global_load_lds((const unsigned*)((const char*)(gbase) + (size_t)_i * 128 * K + voffB0), (LAS unsigned*)(lds + (bufoff) + ldsw + _i * 8192), 16, 0, 0); } while (0)
#define PG8_LDA(dst, b, h) do { _Pragma("unroll") for (int m = 0; m < 4; ++m) _Pragma("unroll") for (int k = 0; k < 2; ++k) dst[m][k] = *(const LAS bf16x8*)(lds + PG8_SA(b, h) + aoff + m * 2048 + k * 1024); } while (0)
#define PG8_LDB(dst, b, h) do { _Pragma("unroll") for (int n = 0; n < 2; ++n) _Pragma("unroll") for (int k = 0; k < 2; ++k) dst[n][k] = *(const LAS bf16x8*)(lds + PG8_SB(b, h) + boff + n * 2048 + k * 1024); } while (0)
#define PG8_MMA(ai, bj, At, Bt) do { __builtin_amdgcn_s_setprio(1); _Pragma("unroll") for (int m = 0; m < 4; ++m) _Pragma("unroll") for (int n = 0; n < 2; ++n) _Pragma("unroll") for (int k = 0; k < 2; ++k) \
        acc[ai][bj][m][n] = __builtin_amdgcn_mfma_f32_16x16x32_bf16(Bt[n][k], At[m][k], acc[ai][bj][m][n], 0, 0, 0); __builtin_amdgcn_s_setprio(0); } while (0)
#define PG8_WAIT_V(n) asm volatile("s_waitcnt vmcnt(" #n ")" ::: "memory")
#define PG8_WAIT_L(n) asm volatile("s_waitcnt lgkmcnt(" #n ")" ::: "memory")
#define PG8_BAR __builtin_amdgcn_s_barrier()
#define PG8_SCHED __builtin_amdgcn_sched_barrier(0)
    Unit cur, nxt; int ui = 0;
    if (!S.next(0, cur)) return;
    f32x4 acc[2][2][4][2];
#pragma unroll
    for (int a = 0; a < 2; ++a)
#pragma unroll
        for (int b = 0; b < 2; ++b)
#pragma unroll
            for (int m = 0; m < 4; ++m)
#pragma unroll
                for (int n = 0; n < 2; ++n) acc[a][b][m][n] = (f32x4){0.f, 0.f, 0.f, 0.f};
    bf16x8 At[4][2], B0[2][2], B1[2][2];
    unsigned vAc[2][2], vAn[2][2];
    S.a_offsets(cur, Rp, Cp, vAc);
    const char* cB = S.b_ptr(cur);
    PG8_STAGEB(PG8_SB(0, 0), cB); PG8_STAGEB(PG8_SB(0, 1), cB + hstep); PG8_STAGE(PG8_SA(0, 0), Abase, vAc[0]); PG8_STAGE(PG8_SA(0, 1), Abase, vAc[1]);
    if (wr == 1) PG8_BAR;
    PG8_WAIT_V(2); PG8_BAR;
    PG8_STAGEB(PG8_SB(1, 0), cB + kstep); PG8_STAGE(PG8_SA(1, 0), Abase + kstep, vAc[0]); PG8_STAGEB(PG8_SB(1, 1), cB + hstep + kstep);
    PG8_WAIT_V(6); PG8_BAR;
    for (;;) {
        const bool has_next = S.next(ui + 1, nxt);
        const char* nB = has_next ? S.b_ptr(nxt) : cB;
        if (has_next) S.a_offsets(nxt, Rp, Cp, vAn);
        else {
#pragma unroll
            for (int h = 0; h < 2; ++h)
#pragma unroll
                for (int i = 0; i < 2; ++i) vAn[h][i] = vAc[h][i]; }
        for (int t = 0; t < nt; t += 2) {
            const bool last = (t == nt - 2);
            const char* a1 = Abase + (size_t)(t + 1) * kstep;
            const char* a2 = last ? Abase : Abase + (size_t)(t + 2) * kstep; const char* b2 = last ? nB : cB + (size_t)(t + 2) * kstep;
            const char* a3 = a2 + kstep; const char* b3 = b2 + kstep;
            unsigned v2[2][2];
#pragma unroll
            for (int h = 0; h < 2; ++h)
#pragma unroll
                for (int i = 0; i < 2; ++i) v2[h][i] = last ? vAn[h][i] : vAc[h][i];
            PG8_LDB(B0, 0, 0); PG8_LDB(B1, 0, 1); PG8_SCHED; PG8_LDA(At, 0, 0); PG8_STAGE(PG8_SA(1, 1), a1, vAc[1]);
            PG8_WAIT_V(8); PG8_WAIT_L(0); PG8_BAR; PG8_MMA(0, 0, At, B0); PG8_MMA(0, 1, At, B1); PG8_BAR; PG8_SCHED;
            PG8_LDA(At, 0, 1); PG8_STAGEB(PG8_SB(0, 0), b2); PG8_STAGEB(PG8_SB(0, 1), b2 + hstep); PG8_STAGE(PG8_SA(0, 0), a2, v2[0]);
            PG8_WAIT_V(8); PG8_WAIT_L(0); PG8_BAR; PG8_MMA(1, 0, At, B0); PG8_MMA(1, 1, At, B1); PG8_BAR; PG8_SCHED;
            PG8_LDB(B0, 1, 0); PG8_LDB(B1, 1, 1); PG8_SCHED; PG8_LDA(At, 1, 0); PG8_STAGE(PG8_SA(0, 1), a2, v2[1]);
            PG8_WAIT_V(8); PG8_WAIT_L(0); PG8_BAR; PG8_MMA(0, 0, At, B0); PG8_MMA(0, 1, At, B1); PG8_BAR; PG8_SCHED;
            PG8_LDA(At, 1, 1); PG8_STAGEB(PG8_SB(1, 0), b3); PG8_STAGEB(PG8_SB(1, 1), b3 + hstep); PG8_STAGE(PG8_SA(1, 0), a3, v2[0]);
            PG8_WAIT_V(8); PG8_WAIT_L(0); PG8_BAR; PG8_MMA(1, 0, At, B0); PG8_MMA(1, 1, At, B1); PG8_BAR; PG8_SCHED;
        }
        if constexpr (ALIGN_EPI) { if (wr == 0) PG8_BAR; }
        E(acc, cur, wr, wc, fr, fq);
        if (!has_next) break;
#pragma unroll
        for (int a = 0; a < 2; ++a)
#pragma unroll
            for (int b = 0; b < 2; ++b)
#pragma unroll
                for (int m = 0; m < 4; ++m)
#pragma unroll
                    for (int n = 0; n < 2; ++n) acc[a][b][m][n] = (f32x4){0.f, 0.f, 0.f, 0.f};
        cur = nxt; cB = nB; ++ui;
#pragma unroll
        for (int h = 0; h < 2; ++h)
#pragma unroll
            for (int i = 0; i < 2; ++i) vAc[h][i] = vAn[h][i];
        if constexpr (ALIGN_EPI) { if (wr == 1) PG8_BAR; }
    }
    PG8_WAIT_V(0);
    if constexpr (!ALIGN_EPI) { if (wr == 0) PG8_BAR; }
    PG8_BAR;
#undef PG8_SA
#undef PG8_SB
#undef PG8_STAGE
#undef PG8_STAGEB
#undef PG8_LDA
#undef PG8_LDB
#undef PG8_MMA
#undef PG8_WAIT_V
#undef PG8_WAIT_L
#undef PG8_BAR
#undef PG8_SCHED
}
template <class Epi, class Sched, bool ALIGN_EPI>
__device__ __forceinline__ void gemm_phase_f8g(LAS unsigned char* lds, const char* Abase, const int K, const Sched& S, const Epi& E) {
    const int tid = tidx(), wid = __builtin_amdgcn_readfirstlane(tid >> 6), lane = tid & 63, wr = wid >> 2, wc = wid & 3, fr = lane & 15, fq = lane >> 4;
    const int nt = K / 128;
    int Rp[2], Cp[2]; unsigned voffB0;
#pragma unroll
    for (int i = 0; i < 2; ++i) stage_rc(tid * 16 + i * 8192, Rp[i], Cp[i]);
    { const int Rb = Epi::PERM ? ((Rp[0] & ~31) + perm32(Rp[0] & 31)) : Rp[0]; voffB0 = (unsigned)(Rb * K + 2 * Cp[0]); }
    const size_t kstep = (size_t)(BK * 2);
    const size_t hstep = (size_t)HALF * K;
    const unsigned ldsw = (unsigned)wid * 1024u;
    const int aoff0 = lds_byte(wr * 64 + fr, 16 * (fq & 1)) + (fq >> 1) * 1024, boff0 = lds_byte(wc * 32 + fr, 16 * (fq & 1)) + (fq >> 1) * 1024;
#define PG8_SA(b, h) (((b) * 2 + (h)) * HTB)
#define PG8_SB(b, h) ((4 + (b) * 2 + (h)) * HTB)
#define PG8_STAGE(bufoff, gbase, voff) do { _Pragma("unroll") for (int _i = 0; _i < 2; ++_i) \
        __builtin_amdgcn_global_load_lds((const unsigned*)((const char*)(gbase) + (voff)[_i]), (LAS unsigned*)(lds + (bufoff) + ldsw + _i * 8192), 16, 0, 0); } while (0)
#define PG8_STAGEB(bufoff, gbase) do { _Pragma("unroll") for (int _i = 0; _i < 2; ++_i) \
        __builtin_amdgcn_global_load_lds((const unsigned*)((const char*)(gbase) + (size_t)_i * 64 * K + voffB0), (LAS unsigned*)(lds + (bufoff) + ldsw + _i * 8192), 16, 0, 0); } while (0)
#define PG8_LDA(dst, b, h) do { _Pragma("unroll") for (int m = 0; m < 4; ++m) { const u32x4 lo_ = *(const LAS u32x4*)(lds + PG8_SA(b, h) + aoff0 + m * 2048), hi_ = *(const LAS u32x4*)(lds + PG8_SA(b, h) + aoff0 + 16 + m * 2048); \
        dst[m] = (v8i){(int)lo_.x, (int)lo_.y, (int)lo_.z, (int)lo_.w, (int)hi_.x, (int)hi_.y, (int)hi_.z, (int)hi_.w}; } } while (0)
#define PG8_LDB(dst, b, h) do { _Pragma("unroll") for (int n = 0; n < 2; ++n) { const u32x4 lo_ = *(const LAS u32x4*)(lds + PG8_SB(b, h) + boff0 + n * 2048), hi_ = *(const LAS u32x4*)(lds + PG8_SB(b, h) + boff0 + 16 + n * 2048); \
        dst[n] = (v8i){(int)lo_.x, (int)lo_.y, (int)lo_.z, (int)lo_.w, (int)hi_.x, (int)hi_.y, (int)hi_.z, (int)hi_.w}; } } while (0)
#define PG8_MMA(ai, bj, At, Bt) do { __builtin_amdgcn_s_setprio(1); _Pragma("unroll") for (int m = 0; m < 4; ++m) _Pragma("unroll") for (int n = 0; n < 2; ++n) \
        asm volatile("v_mfma_scale_f32_16x16x128_f8f6f4 %0, %1, %2, %0, %3, %3 op_sel_hi:[0,0,0]" : "+v"(acc[ai][bj][m][n]) : "v"(Bt[n]), "v"(At[m]), "v"(f8scale)); __builtin_amdgcn_s_setprio(0); } while (0)
#define PG8_WAIT_V(n) asm volatile("s_waitcnt vmcnt(" #n ")" ::: "memory")
#define PG8_WAIT_L(n) asm volatile("s_waitcnt lgkmcnt(" #n ")" ::: "memory")
#define PG8_BAR __builtin_amdgcn_s_barrier()
#define PG8_SCHED __builtin_amdgcn_sched_barrier(0)
    Unit cur, nxt; int ui = 0;
    if (!S.next(0, cur)) return;
    f32x4 acc[2][2][4][2];
#pragma unroll
    for (int a = 0; a < 2; ++a)
#pragma unroll
        for (int b = 0; b < 2; ++b)
#pragma unroll
            for (int m = 0; m < 4; ++m)
#pragma unroll
                for (int n = 0; n < 2; ++n) acc[a][b][m][n] = (f32x4){0.f, 0.f, 0.f, 0.f};
    typedef int v8i __attribute__((ext_vector_type(8)));
    v8i At[4], B0[2], B1[2];
    const int f8scale = 0x7f7f7f7f;
    unsigned vAc[2][2], vAn[2][2];
    S.a_offsets(cur, Rp, Cp, vAc);
    const char* cB = S.b_ptr(cur);
    PG8_STAGEB(PG8_SB(0, 0), cB); PG8_STAGEB(PG8_SB(0, 1), cB + hstep); PG8_STAGE(PG8_SA(0, 0), Abase, vAc[0]); PG8_STAGE(PG8_SA(0, 1), Abase, vAc[1]);
    if (wr == 1) PG8_BAR;
    PG8_WAIT_V(2); PG8_BAR;
    PG8_STAGEB(PG8_SB(1, 0), cB + kstep); PG8_STAGE(PG8_SA(1, 0), Abase + kstep, vAc[0]); PG8_STAGEB(PG8_SB(1, 1), cB + hstep + kstep);
    PG8_WAIT_V(6); PG8_BAR;
    for (;;) {
        const bool has_next = S.next(ui + 1, nxt);
        const char* nB = has_next ? S.b_ptr(nxt) : cB;
        if (has_next) S.a_offsets(nxt, Rp, Cp, vAn);
        else {
#pragma unroll
            for (int h = 0; h < 2; ++h)
#pragma unroll
                for (int i = 0; i < 2; ++i) vAn[h][i] = vAc[h][i]; }
#pragma unroll 1
        for (int t = 0; t < nt; t += 2) {
            const bool last = (t == nt - 2);
            const char* a1 = Abase + (size_t)(t + 1) * kstep;
            const char* a2 = last ? Abase : Abase + (size_t)(t + 2) * kstep; const char* b2 = last ? nB : cB + (size_t)(t + 2) * kstep;
            const char* a3 = a2 + kstep; const char* b3 = b2 + kstep;
            unsigned v2[2][2];
#pragma unroll
            for (int h = 0; h < 2; ++h)
#pragma unroll
                for (int i = 0; i < 2; ++i) v2[h][i] = last ? vAn[h][i] : vAc[h][i];
            PG8_LDB(B0, 0, 0); PG8_LDB(B1, 0, 1); PG8_SCHED; PG8_LDA(At, 0, 0); PG8_STAGE(PG8_SA(1, 1), a1, vAc[1]);
            PG8_WAIT_V(8); PG8_WAIT_L(0); PG8_BAR; PG8_MMA(0, 0, At, B0); PG8_MMA(0, 1, At, B1); PG8_BAR; PG8_SCHED;
            PG8_LDA(At, 0, 1); PG8_STAGEB(PG8_SB(0, 0), b2); PG8_STAGEB(PG8_SB(0, 1), b2 + hstep); PG8_STAGE(PG8_SA(0, 0), a2, v2[0]);
            PG8_WAIT_V(8); PG8_WAIT_L(0); PG8_BAR; PG8_MMA(1, 0, At, B0); PG8_MMA(1, 1, At, B1); PG8_BAR; PG8_SCHED;
            PG8_LDB(B0, 1, 0); PG8_LDB(B1, 1, 1); PG8_SCHED; PG8_LDA(At, 1, 0); PG8_STAGE(PG8_SA(0, 1), a2, v2[1]);
            PG8_WAIT_V(8); PG8_WAIT_L(0); PG8_BAR; PG8_MMA(0, 0, At, B0); PG8_MMA(0, 1, At, B1); PG8_BAR; PG8_SCHED;
            PG8_LDA(At, 1, 1); PG8_STAGEB(PG8_SB(1, 0), b3); PG8_STAGEB(PG8_SB(1, 1), b3 + hstep); PG8_STAGE(PG8_SA(1, 0), a3, v2[0]);
            PG8_WAIT_V(8); PG8_WAIT_L(0); PG8_BAR; PG8_MMA(1, 0, At, B0); PG8_MMA(1, 1, At, B1); PG8_BAR; PG8_SCHED;
        }
        if constexpr (ALIGN_EPI) { if (wr == 0) PG8_BAR; }
        E(acc, cur, wr, wc, fr, fq);
        if (!has_next) break;
#pragma unroll
        for (int a = 0; a < 2; ++a)
#pragma unroll
            for (int b = 0; b < 2; ++b)
#pragma unroll
                for (int m = 0; m < 4; ++m)
#pragma unroll
                    for (int n = 0; n < 2; ++n) acc[a][b][m][n] = (f32x4){0.f, 0.f, 0.f, 0.f};
        cur = nxt; cB = nB; ++ui;
#pragma unroll
        for (int h = 0; h < 2; ++h)
#pragma unroll
            for (int i = 0; i < 2; ++i) vAc[h][i] = vAn[h][i];
        if constexpr (ALIGN_EPI) { if (wr == 1) PG8_BAR; }
    }
    PG8_WAIT_V(0);
    if constexpr (!ALIGN_EPI) { if (wr == 0) PG8_BAR; }
    PG8_BAR;
#undef PG8_SA
#undef PG8_SB
#undef PG8_STAGE
#undef PG8_STAGEB
#undef PG8_LDA
#undef PG8_LDB
#undef PG8_MMA
#undef PG8_WAIT_V
#undef PG8_WAIT_L
#undef PG8_BAR
#undef PG8_SCHED
}
template <class Epi, class Sched, bool ALIGN_EPI>
__device__ __forceinline__ void gemm_phase_f8(LAS unsigned char* lds, const char* Abase, const int K, const Sched& S, const Epi& E) {
    const int tid = tidx(), wid = __builtin_amdgcn_readfirstlane(tid >> 6), lane = tid & 63, wr = wid >> 2, wc = wid & 3, fr = lane & 15, fq = lane >> 4;
    const int nt = K / 128;
    int Rp[1], Cp[1]; unsigned voffB[1], voffA[1];
#pragma unroll
    for (int i = 0; i < 1; ++i) { stage_rc(tid * 16 + i * 8192, Rp[i], Cp[i]); const int Rb = Epi::PERM ? ((Rp[i] & ~31) + perm32(Rp[i] & 31)) : Rp[i]; voffB[i] = (unsigned)(Rb * K + 2 * Cp[i]); voffA[i] = (unsigned)(Rp[i] * K + 2 * Cp[i]); }
    const size_t kstep = (size_t)(BK * 2);
    const size_t hstep = (size_t)HALF * K;
    const unsigned ldsw = (unsigned)wid * 1024u;
    const int aoff0 = lds_byte(wr * 64 + fr, 16 * (fq & 1)) + (fq >> 1) * 1024, boff0 = lds_byte(wc * 32 + fr, 16 * (fq & 1)) + (fq >> 1) * 1024;
#define PG8_SA(b, h) (((b) * 2 + (h)) * HTB)
#define PG8_SB(b, h) ((4 + (b) * 2 + (h)) * HTB)
#define PG8_STAGE(bufoff, gbase, voff) do { _Pragma("unroll") for (int _i = 0; _i < 2; ++_i) \
        __builtin_amdgcn_global_load_lds((const unsigned*)((const char*)(gbase) + (size_t)_i * 64 * K + (voff)[0]), (LAS unsigned*)(lds + (bufoff) + ldsw + _i * 8192), 16, 0, 0); } while (0)
#define PG8_LDA(dst, b, h) do { _Pragma("unroll") for (int m = 0; m < 4; ++m) { const u32x4 lo_ = *(const LAS u32x4*)(lds + PG8_SA(b, h) + aoff0 + m * 2048), hi_ = *(const LAS u32x4*)(lds + PG8_SA(b, h) + aoff0 + 16 + m * 2048); \
        dst[m] = (v8i){(int)lo_.x, (int)lo_.y, (int)lo_.z, (int)lo_.w, (int)hi_.x, (int)hi_.y, (int)hi_.z, (int)hi_.w}; } } while (0)
#define PG8_LDB(dst, b, h) do { _Pragma("unroll") for (int n = 0; n < 2; ++n) { const u32x4 lo_ = *(const LAS u32x4*)(lds + PG8_SB(b, h) + boff0 + n * 2048), hi_ = *(const LAS u32x4*)(lds + PG8_SB(b, h) + boff0 + 16 + n * 2048); \
        dst[n] = (v8i){(int)lo_.x, (int)lo_.y, (int)lo_.z, (int)lo_.w, (int)hi_.x, (int)hi_.y, (int)hi_.z, (int)hi_.w}; } } while (0)
#define PG8_MMA(ai, bj, At, Bt) do { __builtin_amdgcn_s_setprio(1); _Pragma("unroll") for (int m = 0; m < 4; ++m) _Pragma("unroll") for (int n = 0; n < 2; ++n) \
        asm volatile("v_mfma_scale_f32_16x16x128_f8f6f4 %0, %1, %2, %0, %3, %3 op_sel_hi:[0,0,0]" : "+v"(acc[ai][bj][m][n]) : "v"(Bt[n]), "v"(At[m]), "v"(f8scale)); __builtin_amdgcn_s_setprio(0); } while (0)
#define PG8_WAIT_V(n) asm volatile("s_waitcnt vmcnt(" #n ")" ::: "memory")
#define PG8_WAIT_L(n) asm volatile("s_waitcnt lgkmcnt(" #n ")" ::: "memory")
#define PG8_BAR __builtin_amdgcn_s_barrier()
#define PG8_SCHED __builtin_amdgcn_sched_barrier(0)
    Unit cur, nxt; int ui = 0;
    if (!S.next(0, cur)) return;
    f32x4 acc[2][2][4][2];
#pragma unroll
    for (int a = 0; a < 2; ++a)
#pragma unroll
        for (int b = 0; b < 2; ++b)
#pragma unroll
            for (int m = 0; m < 4; ++m)
#pragma unroll
                for (int n = 0; n < 2; ++n) acc[a][b][m][n] = (f32x4){0.f, 0.f, 0.f, 0.f};
    typedef int v8i __attribute__((ext_vector_type(8)));
    v8i At[4], B0[2], B1[2];
    const int f8scale = 0x7f7f7f7f;
    const char* cA = S.a_ptr(cur, Abase);
    const char* cB = S.b_ptr(cur);
    PG8_STAGE(PG8_SB(0, 0), cB, voffB); PG8_STAGE(PG8_SB(0, 1), cB + hstep, voffB); PG8_STAGE(PG8_SA(0, 0), cA, voffA); PG8_STAGE(PG8_SA(0, 1), cA + hstep, voffA);
    if (wr == 1) PG8_BAR;
    PG8_WAIT_V(2); PG8_BAR;
    PG8_STAGE(PG8_SB(1, 0), cB + kstep, voffB); PG8_STAGE(PG8_SA(1, 0), cA + kstep, voffA); PG8_STAGE(PG8_SB(1, 1), cB + hstep + kstep, voffB);
    PG8_WAIT_V(6); PG8_BAR;
    for (;;) {
        const bool has_next = S.next(ui + 1, nxt);
        const char* nB = has_next ? S.b_ptr(nxt) : cB; const char* nA = has_next ? S.a_ptr(nxt, Abase) : cA;
#pragma unroll 1
        for (int t = 0; t < nt; t += 2) {
            const bool last = (t == nt - 2);
            const char* a1 = cA + (size_t)(t + 1) * kstep;
            const char* a2 = last ? nA : cA + (size_t)(t + 2) * kstep; const char* b2 = last ? nB : cB + (size_t)(t + 2) * kstep;
            const char* a3 = a2 + kstep; const char* b3 = b2 + kstep;
            PG8_LDB(B0, 0, 0); PG8_LDB(B1, 0, 1); PG8_SCHED; PG8_LDA(At, 0, 0); PG8_STAGE(PG8_SA(1, 1), a1 + hstep, voffA);
            PG8_WAIT_V(8); PG8_WAIT_L(0); PG8_BAR; PG8_MMA(0, 0, At, B0); PG8_MMA(0, 1, At, B1); PG8_BAR; PG8_SCHED;
            PG8_LDA(At, 0, 1); PG8_STAGE(PG8_SB(0, 0), b2, voffB); PG8_STAGE(PG8_SB(0, 1), b2 + hstep, voffB); PG8_STAGE(PG8_SA(0, 0), a2, voffA);
            PG8_WAIT_V(8); PG8_WAIT_L(0); PG8_BAR; PG8_MMA(1, 0, At, B0); PG8_MMA(1, 1, At, B1); PG8_BAR; PG8_SCHED;
            PG8_LDB(B0, 1, 0); PG8_LDB(B1, 1, 1); PG8_SCHED; PG8_LDA(At, 1, 0); PG8_STAGE(PG8_SA(0, 1), a2 + hstep, voffA);
            PG8_WAIT_V(8); PG8_WAIT_L(0); PG8_BAR; PG8_MMA(0, 0, At, B0); PG8_MMA(0, 1, At, B1); PG8_BAR; PG8_SCHED;
            PG8_LDA(At, 1, 1); PG8_STAGE(PG8_SB(1, 0), b3, voffB); PG8_STAGE(PG8_SB(1, 1), b3 + hstep, voffB); PG8_STAGE(PG8_SA(1, 0), a3, voffA);
            PG8_WAIT_V(8); PG8_WAIT_L(0); PG8_BAR; PG8_MMA(1, 0, At, B0); PG8_MMA(1, 1, At, B1); PG8_BAR; PG8_SCHED;
        }
        if constexpr (ALIGN_EPI) { if (wr == 0) PG8_BAR; }
        E(acc, cur, wr, wc, fr, fq);
        if (!has_next) break;
#pragma unroll
        for (int a = 0; a < 2; ++a)
#pragma unroll
            for (int b = 0; b < 2; ++b)
#pragma unroll
                for (int m = 0; m < 4; ++m)
#pragma unroll
                    for (int n = 0; n < 2; ++n) acc[a][b][m][n] = (f32x4){0.f, 0.f, 0.f, 0.f};
        cur = nxt; cB = nB; cA = nA; ++ui;
        if constexpr (ALIGN_EPI) { if (wr == 1) PG8_BAR; }
    }
    PG8_WAIT_V(0);
    if constexpr (!ALIGN_EPI) { if (wr == 0) PG8_BAR; }
    PG8_BAR;
#undef PG8_SA
#undef PG8_SB
#undef PG8_STAGE
#undef PG8_LDA
#undef PG8_LDB
#undef PG8_MMA
#undef PG8_WAIT_V
#undef PG8_WAIT_L
#undef PG8_BAR
#undef PG8_SCHED
}
}

struct Args { const float* in[39]; float* out; unsigned char* ws; int ph_lo, ph_hi; };
typedef const __attribute__((address_space(4))) Args CArgs;
enum { I_X = 0, I_C, I_CTX, I_CCTX, I_WADA, I_BADA, I_WIN, I_HYCW, I_HYCB, I_HYW1, I_HYB1, I_HYW2, I_HYB2, I_HYW3, I_HYB3, I_HYW4, I_HYFREQ, I_HYD, I_SCCW,
       I_GLAWA, I_GLABA, I_GLANW, I_GDNCW, I_GDNALOG, I_GDNDT, I_GDNNW, I_WOUT, I_LN1G, I_LN1B, I_WR, I_BR, I_WG, I_BG, I_WU, I_BU, I_WD, I_BD, I_LN2G, I_LN2B };

__device__ __forceinline__ int row_batch(int row) { return row < NTOK_C ? (row >> 8) : ((row - NTOK_C) >> 11); }
__device__ __forceinline__ int mod_vec(int row) { return row < NTOK_C ? 16 : ((row - NTOK_C) >> 11); }

__device__ __forceinline__ void ph_mod(CArgs& a, LAS unsigned char* lds, int bid, int nblk) {
    LAS float* sc = (LAS float*)lds; LAS float* red = (LAS float*)(lds + 17 * 1024 * 4);
    const int tid = tidx(), lane = tid & 63, w = tid >> 6;
    const float* c = a.in[I_C]; const float* cc = a.in[I_CCTX];
    for (int i = tid; i < 17 * 1024; i += 512) { const float v = i < 16 * 1024 ? c[i] : cc[i - 16 * 1024]; sc[i] = siluf_(v); }
    __syncthreads();
    float* MOD = (float*)(a.ws + WS_MOD);
    for (int it = bid; it < DEPTH * 96; it += nblk) {
        const int l = it / 96, j0 = (it % 96) * 64;
        const float* W = a.in[I_WADA] + (size_t)l * 1024 * 6144 + j0 + lane;
        float acc[17];
#pragma unroll
        for (int v = 0; v < 17; ++v) acc[v] = 0.f;
#pragma unroll 16
        for (int kk = 0; kk < 128; ++kk) { const int k = w * 128 + kk; const float wv = W[(size_t)k * 6144];
#pragma unroll
            for (int v = 0; v < 17; ++v) acc[v] += sc[v * 1024 + k] * wv; }
#pragma unroll
        for (int v = 0; v < 17; ++v) red[(w * 17 + v) * 64 + lane] = acc[v];
        __syncthreads();
        for (int o = tid; o < 17 * 64; o += 512) { const int v = o >> 6, jj = o & 63; float s = 0.f;
#pragma unroll
            for (int ww = 0; ww < 8; ++ww) s += red[(ww * 17 + v) * 64 + jj];
            MOD[(size_t)(l * 17 + v) * 6144 + j0 + jj] = s + a.in[I_BADA][l * 6144 + j0 + jj]; }
        __syncthreads();
    }
}

__device__ __forceinline__ void ph_filters(CArgs& a, int gw, int ngw) {
    const int lane = tidx() & 63;
    float* KUN = (float*)(a.ws + WS_KUN);
#pragma unroll 1
    for (int it = gw; it < DEPTH * (CTXL + SEQ) / 4; it += ngw) {
        const int l = it / ((CTXL + SEQ) / 4), r = (it % ((CTXL + SEQ) / 4)) * 4, Lt = r < CTXL ? 0 : 1, pos0 = Lt ? r - CTXL : r, L = Lt ? SEQ : CTXL;
        float z[4], tn[4];
#pragma unroll
        for (int p = 0; p < 4; ++p) { const int pos = pos0 + p; tn[p] = (float)pos / (float)(L - 1); z[p] = 0.f;
            if (lane == 0) z[p] = tn[p];
            else if (lane <= 32) { const int j = (lane - 1) & 15; const float fj = 1e-4f + (float)j * ((15.f - 1e-4f) / 15.f);
                double rev = (double)fj * (double)pos / (double)L; rev -= floor(rev); const float rf = (float)rev;
                z[p] = lane <= 16 ? sin_rev(rf + 0.25f) : -sin_rev(rf); } }
        const float* w1 = a.in[I_HYW1] + l * 33 * 64; const float* w2 = a.in[I_HYW2] + l * 64 * 64; const float* w3 = a.in[I_HYW3] + l * 64 * 64; const float* w4 = a.in[I_HYW4] + l * 64 * 512;
        const float* fq = a.in[I_HYFREQ] + l * 3 * 64;
        float s[4], h[4];
        { const float bb = a.in[I_HYB1][l * 64 + lane];
#pragma unroll
          for (int p = 0; p < 4; ++p) s[p] = bb; }
#pragma unroll
        for (int i = 0; i < 33; ++i) { const float ww = w1[i * 64 + lane];
#pragma unroll
            for (int p = 0; p < 4; ++p) s[p] += rdlane_f(z[p], i) * ww; }
#pragma unroll
        for (int p = 0; p < 4; ++p) h[p] = sin_rad(fq[lane] * s[p]);
        { const float bb = a.in[I_HYB2][l * 64 + lane];
#pragma unroll
          for (int p = 0; p < 4; ++p) s[p] = bb; }
#pragma unroll 16
        for (int i = 0; i < 64; ++i) { const float ww = w2[i * 64 + lane];
#pragma unroll
            for (int p = 0; p < 4; ++p) s[p] += rdlane_f(h[p], i) * ww; }
#pragma unroll
        for (int p = 0; p < 4; ++p) h[p] = sin_rad(fq[64 + lane] * s[p]);
        { const float bb = a.in[I_HYB3][l * 64 + lane];
#pragma unroll
          for (int p = 0; p < 4; ++p) s[p] = bb; }
#pragma unroll 16
        for (int i = 0; i < 64; ++i) { const float ww = w3[i * 64 + lane];
#pragma unroll
            for (int p = 0; p < 4; ++p) s[p] += rdlane_f(h[p], i) * ww; }
#pragma unroll
        for (int p = 0; p < 4; ++p) h[p] = sin_rad(fq[128 + lane] * s[p]);
        float k[8][4];
#pragma unroll
        for (int m = 0; m < 8; ++m)
#pragma unroll
            for (int p = 0; p < 4; ++p) k[m][p] = 0.f;
#pragma unroll 4
        for (int i = 0; i < 64; ++i) { float hi[4];
#pragma unroll
            for (int p = 0; p < 4; ++p) hi[p] = rdlane_f(h[p], i);
#pragma unroll
            for (int m = 0; m < 8; ++m) { const float ww = w4[i * 512 + m * 64 + lane];
#pragma unroll
                for (int p = 0; p < 4; ++p) k[m][p] += hi[p] * ww; } }
#pragma unroll
        for (int m = 0; m < 8; ++m) { const int o = m * 64 + lane, ch = o & 255;
            const float delta = 3.0701134573253944f + (float)ch * ((15.350567286626972f - 3.0701134573253944f) / 255.f);
            *(f32x4*)(KUN + ((size_t)((l * 2 + Lt) * 512 + o)) * 2048 + pos0) = (f32x4){k[m][0] * __expf(-tn[0] * delta), k[m][1] * __expf(-tn[1] * delta), k[m][2] * __expf(-tn[2] * delta), k[m][3] * __expf(-tn[3] * delta)}; }
    }
}

__device__ __forceinline__ void ph_router_w(CArgs& a, int gt, int ngt) {
    bf16* hi = (bf16*)(a.ws + WS_WRT); bf16* lo = hi + DEPTH * NEXP * D;
    for (int i = gt; i < DEPTH * NEXP * D; i += ngt) { const int l = i / (NEXP * D), r = i % (NEXP * D), e = r / D, k = r % D;
        const float w = a.in[I_WR][((size_t)l * D + k) * NEXP + e]; const unsigned h = f2bf(w); hi[i] = (bf16)h; lo[i] = (bf16)f2bf(w - bf2f(h)); }
}
__device__ __forceinline__ void tr_item(const float* W, int Nsrc, int K, bf16* WTrow0, int n0, int k0, LAS float* scr, int lane) {
    const int c4 = (lane & 7) * 4; const bool ok = n0 + c4 < Nsrc;
    f32x4 t[8];
#pragma unroll
    for (int j = 0; j < 8; ++j) { const int kk = 8 * j + (lane >> 3); t[j] = ok ? *(const f32x4*)(W + (size_t)(k0 + kk) * Nsrc + n0 + c4) : (f32x4){0.f, 0.f, 0.f, 0.f}; }
#pragma unroll
    for (int j = 0; j < 8; ++j) { const int kk = 8 * j + (lane >> 3); LAS float* d = scr + kk * 33 + c4; d[0] = t[j][0]; d[1] = t[j][1]; d[2] = t[j][2]; d[3] = t[j][3]; }
    asm volatile("s_waitcnt lgkmcnt(0)" ::: "memory");
    const int c = lane & 7;
#pragma unroll
    for (int j = 0; j < 4; ++j) { const int n = (lane >> 3) + 8 * j; const LAS float* s = scr + (8 * c) * 33 + n;
        u32x4 o; o.x = pk2(s[0 * 33], s[1 * 33]); o.y = pk2(s[2 * 33], s[3 * 33]); o.z = pk2(s[4 * 33], s[5 * 33]); o.w = pk2(s[6 * 33], s[7 * 33]);
        *(u32x4*)(WTrow0 + (size_t)n * K + k0 + 8 * c) = o; }
    asm volatile("s_waitcnt lgkmcnt(0)" ::: "memory");
}
__device__ __forceinline__ void tr_item_f8(const float* W, int Nsrc, int K, unsigned char* WTrow0, int n0, int k0, float scale, LAS float* scr, int lane) {
    const int c4 = (lane & 7) * 4;
    f32x4 t[8];
#pragma unroll
    for (int j = 0; j < 8; ++j) { const int kk = 8 * j + (lane >> 3); t[j] = *(const f32x4*)(W + (size_t)(k0 + kk) * Nsrc + n0 + c4); }
#pragma unroll
    for (int j = 0; j < 8; ++j) { const int kk = 8 * j + (lane >> 3); LAS float* d = scr + kk * 33 + c4; d[0] = t[j][0]; d[1] = t[j][1]; d[2] = t[j][2]; d[3] = t[j][3]; }
    asm volatile("s_waitcnt lgkmcnt(0)" ::: "memory");
    const int n = lane >> 1, half = lane & 1; const LAS float* s = scr + (32 * half) * 33 + n;
    unsigned o[8];
#pragma unroll
    for (int i = 0; i < 8; ++i) o[i] = pk4_fp8(s[(4 * i) * 33] * scale, s[(4 * i + 1) * 33] * scale, s[(4 * i + 2) * 33] * scale, s[(4 * i + 3) * 33] * scale);
    unsigned char* dst = WTrow0 + (size_t)n * K + k0 + 32 * half;
    *(u32x4*)dst = (u32x4){o[0], o[1], o[2], o[3]}; *(u32x4*)(dst + 16) = (u32x4){o[4], o[5], o[6], o[7]};
    asm volatile("s_waitcnt lgkmcnt(0)" ::: "memory");
}
__device__ __forceinline__ void ph_tr_small(CArgs& a, LAS unsigned char* lds, int gw, int ngw) {
    const int lane = tidx() & 63, w = tidx() >> 6;
    LAS float* scr = (LAS float*)(lds + w * 8448);
    constexpr int I_IN = 16 * (D_INP / 32), I_OUT = 16 * 32;
    for (int it = gw; it < DEPTH * (I_IN + I_OUT); it += ngw) {
        const int l = it / (I_IN + I_OUT); int r = it % (I_IN + I_OUT);
        if (r < I_IN) { const int kb = r / (D_INP / 32), nb = r % (D_INP / 32);
            tr_item(a.in[I_WIN] + (size_t)l * 1024 * D_IN, D_IN, 1024, (bf16*)(a.ws + WS_WIN) + ((size_t)l * D_INP + nb * 32) * 1024, nb * 32, kb * 64, scr, lane); }
        else { r -= I_IN; const int kb = r / 32, nb = r % 32;
            tr_item(a.in[I_WOUT] + (size_t)l * 1024 * 1024, 1024, 1024, (bf16*)(a.ws + WS_WOUT) + ((size_t)l * 1024 + nb * 32) * 1024, nb * 32, kb * 64, scr, lane); }
    }
}
__device__ __forceinline__ void tr_experts_range(CArgs& a, int l, LAS unsigned char* scrb, int first, int last, int stride, int lane) {
    LAS float* scr = (LAS float*)scrb;
#pragma unroll 1
    for (int it = first; it < last; it += stride) {
        const int e = it / 1536, r = it % 1536, which = r / 512, q = r % 512, kb = q / 32, nb = q % 32, n0 = nb * 32;
        const float* W = a.in[which == 0 ? I_WG : (which == 1 ? I_WU : I_WD)] + ((size_t)(l * NEXP + e)) * 1024 * 1024;
        if (which == 2) tr_item_f8(W, 1024, 1024, a.ws + WS_WD + ((size_t)e * 1024 + n0) * 1024, n0, kb * 64, 32.f, scr, lane);
        else tr_item_f8(W, 1024, 1024, a.ws + WS_WGU + ((size_t)e * 2048 + (n0 >> 7) * 256 + which * 128 + (n0 & 127)) * 1024, n0, kb * 64, 32.f, scr, lane);
    }
}
__device__ __forceinline__ void ph_mod_input(CArgs& a, int gw, int ngw) {
    const int lane = tidx() & 63;
    const float* MOD = (const float*)(a.ws + WS_MOD);
    bf16* HB = (bf16*)(a.ws + WS_HB);
    for (int row = gw; row < NTOK; row += ngw) {
        const float* src = row < NTOK_C ? a.in[I_CTX] + (size_t)row * D : a.in[I_X] + (size_t)(row - NTOK_C) * D;
        const float* mv = MOD + (size_t)mod_vec(row) * 6144;
#pragma unroll
        for (int j = 0; j < 4; ++j) { const int c0 = j * 256 + lane * 4; const f32x4 x = *(const f32x4*)(src + c0), sh = *(const f32x4*)(mv + c0), sc = *(const f32x4*)(mv + 1024 + c0);
            u32x2 o; o.x = pk2(x[0] * (1.f + sc[0]) + sh[0], x[1] * (1.f + sc[1]) + sh[1]); o.y = pk2(x[2] * (1.f + sc[2]) + sh[2], x[3] * (1.f + sc[3]) + sh[3]);
            *(u32x2*)(HB + (size_t)row * D + c0) = o; }
    }
}

struct Chunk { int b, t0, L, row0, lo, hi; };
__device__ __forceinline__ Chunk chunk_of(int it) {
    Chunk c;
    if (it < 64) { c.b = it >> 2; c.t0 = (it & 3) * 64; c.L = CTXL; c.row0 = c.b * CTXL + c.t0; c.lo = 0; c.hi = CTXL; }
    else { const int r = it - 64; c.b = r >> 5; c.t0 = (r & 31) * 64; c.L = SEQ; c.row0 = NTOK_C + c.b * SEQ + c.t0; c.lo = c.t0; c.hi = c.t0 + 64; }
    return c;
}
__device__ __forceinline__ f32x4 bf4(u32x2 v) { return (f32x4){lo_bf(v.x), hi_bf(v.x), lo_bf(v.y), hi_bf(v.y)}; }
__device__ __forceinline__ void ph_prep_conv(CArgs& a, int l, LAS unsigned char* lds, int bid, int nblk) {
    const bf16* P = (const bf16*)(a.ws + WS_P);
    bf16* ZT = (bf16*)(a.ws + WS_MIX + MX_ZT); bf16* YMIX = (bf16*)(a.ws + WS_YMIX);
    LAS bf16* zt = (LAS bf16*)lds;
    const int tid = tidx(), c4 = (tid & 63) * 4, tg = tid >> 6;
    const float* hw = a.in[I_HYCW] + l * 3 * 768; const float* hb = a.in[I_HYCB] + l * 768; const float* sw = a.in[I_SCCW] + l * 3 * 256;
    f32x4 wx[3], wv[3], ws3[3];
#pragma unroll
    for (int k = 0; k < 3; ++k) { wx[k] = *(const f32x4*)(hw + k * 768 + 256 + c4); wv[k] = *(const f32x4*)(hw + k * 768 + 512 + c4); ws3[k] = *(const f32x4*)(sw + k * 256 + c4); }
    const f32x4 bx = *(const f32x4*)(hb + 256 + c4), bv = *(const f32x4*)(hb + 512 + c4);
#pragma unroll 1
    for (int it = bid; it < 576; it += nblk) {
        const Chunk c = chunk_of(it);
        const int tb = c.t0 + tg * 8;
        const bf16* pb = P + (size_t)(c.row0 + tg * 8) * D_INP;
        f32x4 x1[10], vv[10], mm[10];
#pragma unroll
        for (int r = 0; r < 10; ++r) { const int t = tb + r - 1; const bool ok = t >= c.lo && t < c.hi; const bf16* p = pb + (ptrdiff_t)(r - 1) * D_INP;
            x1[r] = ok ? bf4(*(const u32x2*)(p + HY0 + 256 + c4)) : (f32x4){0.f, 0.f, 0.f, 0.f}; vv[r] = ok ? bf4(*(const u32x2*)(p + HY0 + 512 + c4)) : (f32x4){0.f, 0.f, 0.f, 0.f};
            mm[r] = ok ? bf4(*(const u32x2*)(p + SC0 + 256 + c4)) * bf4(*(const u32x2*)(p + SC0 + 512 + c4)) : (f32x4){0.f, 0.f, 0.f, 0.f}; }
#pragma unroll
        for (int tt = 0; tt < 8; ++tt) {
            const f32x4 xx = wx[0] * x1[tt] + wx[1] * x1[tt + 1] + wx[2] * x1[tt + 2] + bx, v2 = wv[0] * vv[tt] + wv[1] * vv[tt + 1] + wv[2] * vv[tt + 2] + bv, z = xx * v2;
            u32x2 zo; zo.x = pk2(z[0], z[1]); zo.y = pk2(z[2], z[3]); *(LAS u32x2*)(zt + (tg * 8 + tt) * 264 + c4) = zo;
            const f32x4 bg = bf4(*(const u32x2*)(pb + (size_t)tt * D_INP + SC0 + c4));
            const f32x4 y = bg * (ws3[0] * mm[tt] + ws3[1] * mm[tt + 1] + ws3[2] * mm[tt + 2]);
            u32x2 yo; yo.x = pk2(y[0], y[1]); yo.y = pk2(y[2], y[3]); *(u32x2*)(YMIX + (size_t)(c.row0 + tg * 8 + tt) * D + 256 + c4) = yo;
        }
        __syncthreads();
        { const int ch = tid & 255, g0 = (tid >> 8) * 4;
          const int soff = c.L == CTXL ? 0 : CTXL;
#pragma unroll
          for (int g = 0; g < 4; ++g) { const int t8 = (g0 + g) * 8; unsigned short e[8];
#pragma unroll
              for (int j = 0; j < 8; ++j) e[j] = zt[(t8 + j) * 264 + ch];
              u32x4 o; o.x = e[0] | ((unsigned)e[1] << 16); o.y = e[2] | ((unsigned)e[3] << 16); o.z = e[4] | ((unsigned)e[5] << 16); o.w = e[6] | ((unsigned)e[7] << 16);
              *(u32x4*)(ZT + ((size_t)(ch * 16 + c.b)) * 2304 + soff + c.t0 + t8) = o; } }
        __syncthreads();
    }
}
__device__ __forceinline__ void ph_prep_tok(CArgs& a, int l, int gw, int ngw) {
    const int lane = tidx() & 63;
    const bf16* P = (const bf16*)(a.ws + WS_P);
    float* GDF = (float*)(a.ws + WS_MIX + MX_GDF); float* GDB = (float*)(a.ws + WS_MIX + MX_GDB);
    float* DQ = (float*)(a.ws + WS_MIX + MX_DQ); float* DK = (float*)(a.ws + WS_MIX + MX_DK); float* DV = (float*)(a.ws + WS_MIX + MX_DV); float* DG = (float*)(a.ws + WS_MIX + MX_DG);
    const float* wa = a.in[I_GLAWA] + l * 2 * 16 * 128; const float* ba = a.in[I_GLABA] + l * 2 * 128;
    const float* cw = a.in[I_GDNCW] + l * 3 * 768;
#pragma unroll 1
    for (int row0 = gw * 4; row0 < NTOK; row0 += ngw * 4) {
        { int z = 0; asm volatile("" : "+v"(z)); wa += z; cw += z; }
        const bf16* pr0 = P + (size_t)row0 * D_INP;
        float av[4], s[4][4];
#pragma unroll
        for (int r = 0; r < 4; ++r) { av[r] = lane < 32 ? bf2f(pr0[(size_t)r * D_INP + GLA0 + 768 + lane]) : 0.f; s[r][0] = ba[lane]; s[r][1] = ba[64 + lane]; s[r][2] = ba[128 + lane]; s[r][3] = ba[192 + lane]; }
#pragma unroll
        for (int i = 0; i < 16; ++i) { const float w0 = wa[i * 128 + lane], w1 = wa[i * 128 + 64 + lane], w2 = wa[2048 + i * 128 + lane], w3 = wa[2048 + i * 128 + 64 + lane];
#pragma unroll
            for (int r = 0; r < 4; ++r) { const float af = rdlane_f(av[r], i), ab = rdlane_f(av[r], 16 + i); s[r][0] += af * w0; s[r][1] += af * w1; s[r][2] += ab * w2; s[r][3] += ab * w3; } }
#pragma unroll
        for (int r = 0; r < 4; ++r) { const size_t o = (size_t)(row0 + r) * 128;
            GDF[o + lane] = logsigmoidf_(s[r][0]) * 0.0625f; GDF[o + 64 + lane] = logsigmoidf_(s[r][1]) * 0.0625f;
            GDB[o + lane] = logsigmoidf_(s[r][2]) * 0.0625f; GDB[o + 64 + lane] = logsigmoidf_(s[r][3]) * 0.0625f; }
        int tpos, lo, hi;
        if (row0 < NTOK_C) { tpos = row0 & 255; lo = 0; hi = CTXL; } else { tpos = (row0 - NTOK_C) & 2047; lo = tpos & ~63; hi = lo + 64; }
        float sq[4] = {0.f, 0.f, 0.f, 0.f}, sk[4] = {0.f, 0.f, 0.f, 0.f}; f32x4 qv[4], kv[4];
#pragma unroll
        for (int g = 0; g < 3; ++g) { const int col = g * 256 + 4 * lane; const bf16* p = pr0 + GDN0 + col;
            f32x4 x[6];
#pragma unroll
            for (int r = 0; r < 6; ++r) { const int t = tpos + r - 1; x[r] = (t >= lo && t < hi) ? bf4(*(const u32x2*)(p + (ptrdiff_t)(r - 1) * D_INP)) : (f32x4){0.f, 0.f, 0.f, 0.f}; }
            const f32x4 w0 = *(const f32x4*)(cw + col), w1 = *(const f32x4*)(cw + 768 + col), w2 = *(const f32x4*)(cw + 1536 + col);
#pragma unroll
            for (int r = 0; r < 4; ++r) { f32x4 y = w0 * x[r] + w1 * x[r + 1] + w2 * x[r + 2];
                y[0] = siluf_(y[0]); y[1] = siluf_(y[1]); y[2] = siluf_(y[2]); y[3] = siluf_(y[3]);
                if (g == 0) { qv[r] = y; sq[r] = (y[0] * y[0] + y[1] * y[1]) + (y[2] * y[2] + y[3] * y[3]); }
                else if (g == 1) { kv[r] = y; sk[r] = (y[0] * y[0] + y[1] * y[1]) + (y[2] * y[2] + y[3] * y[3]); }
                else *(f32x4*)(DV + (size_t)(row0 + r) * 256 + 4 * lane) = y; } }
#pragma unroll
        for (int r = 0; r < 4; ++r) { const float rq = rsqrtf(row16_sum(sq[r]) + 1e-6f) * 0.125f, rk = rsqrtf(row16_sum(sk[r]) + 1e-6f);
            const f32x4 qn = qv[r] * rq, kn = kv[r] * rk;
            *(f32x4*)(DQ + (size_t)(row0 + r) * 256 + 4 * lane) = qn; *(f32x4*)(DK + (size_t)(row0 + r) * 256 + 4 * lane) = kn;
            *(u32x2*)((bf16*)(a.ws + WS_CKD + CD_QB) + (size_t)(row0 + r) * 256 + 4 * lane) = (u32x2){pk2(qn[0], qn[1]), pk2(qn[2], qn[3])};
            *(u32x2*)((bf16*)(a.ws + WS_CKD + CD_KB) + (size_t)(row0 + r) * 256 + 4 * lane) = (u32x2){pk2(kn[0], kn[1]), pk2(kn[2], kn[3])}; }
        if (lane < 16) { const int h = lane & 3, r = lane >> 2; const bf16* pr = pr0 + (size_t)r * D_INP;
            const float af = bf2f(pr[GDN0 + 1024 + h]), ab = bf2f(pr[GDN0 + 1028 + h]), bfv = bf2f(pr[GDN0 + 1032 + h]), bbv = bf2f(pr[GDN0 + 1036 + h]);
            const float* al = a.in[I_GDNALOG] + l * 8; const float* dt = a.in[I_GDNDT] + l * 8;
            const float gf = -__expf(al[h]) * softplusf_(af + dt[h]), gb = -__expf(al[4 + h]) * softplusf_(ab + dt[4 + h]);
            *(f32x4*)(DG + (size_t)(row0 + r) * 16 + 4 * h) = (f32x4){sigmoidf_(bfv), gf, sigmoidf_(bbv), gb}; }
    }
}

__device__ __forceinline__ int scan_row(int b, int dir, int n) {
    if (n < CTXL) return b * CTXL + (dir ? CTXL - 1 - n : n);
    const int m = n - CTXL; return NTOK_C + b * SEQ + (dir ? SEQ - 1 - m : m);
}
__device__ __forceinline__ void gla_chain(CArgs& a, int chain, LAS unsigned char* lds) {
    const int b = chain >> 3, h = (chain >> 1) & 3, dir = chain & 1;
    const int tid = tidx(), lane = tid & 63, w = tid >> 6, vv = lane & 7, kq = lane >> 3;
    const bf16* P = (const bf16*)(a.ws + WS_P);
    const float* GD = (const float*)(a.ws + WS_MIX + (dir ? MX_GDB : MX_GDF));
    float* GO = (float*)(a.ws + WS_MIX + (dir ? MX_GOB : MX_GOF));
    LAS float* sq = (LAS float*)lds;
    LAS float* sk = sq + 64 * 32;
    LAS float* sd = sk + 64 * 32;
    LAS float* sv = sd + 64 * 32;
    float S[4] = {0.f, 0.f, 0.f, 0.f};
    for (int ch = 0; ch < 36; ++ch) {
        { const int tt = tid >> 3, sub = tid & 7, row = scan_row(b, dir, ch * 64 + tt);
          const bf16* pr = P + (size_t)row * D_INP + GLA0;
          const u32x2 qv = *(const u32x2*)(pr + h * 32 + sub * 4), kv = *(const u32x2*)(pr + 128 + h * 32 + sub * 4);
          const f32x4 dv = *(const f32x4*)(GD + (size_t)row * 128 + h * 32 + sub * 4);
          const u32x4 vv8 = *(const u32x4*)(pr + 256 + h * 64 + sub * 8);
          const float qs = 0.17677669529663687f;
          *(LAS f32x4*)(sq + tt * 32 + sub * 4) = (f32x4){lo_bf(qv.x) * qs, hi_bf(qv.x) * qs, lo_bf(qv.y) * qs, hi_bf(qv.y) * qs};
          *(LAS f32x4*)(sk + tt * 32 + sub * 4) = (f32x4){lo_bf(kv.x), hi_bf(kv.x), lo_bf(kv.y), hi_bf(kv.y)};
          *(LAS f32x4*)(sd + tt * 32 + sub * 4) = dv;
          *(LAS f32x4*)(sv + tt * 64 + sub * 8) = (f32x4){lo_bf(vv8.x), hi_bf(vv8.x), lo_bf(vv8.y), hi_bf(vv8.y)};
          *(LAS f32x4*)(sv + tt * 64 + sub * 8 + 4) = (f32x4){lo_bf(vv8.z), hi_bf(vv8.z), lo_bf(vv8.w), hi_bf(vv8.w)}; }
        __syncthreads();
#pragma unroll 4
        for (int tt = 0; tt < 64; ++tt) {
            const f32x4 q4 = *(const LAS f32x4*)(sq + tt * 32 + kq * 4), k4 = *(const LAS f32x4*)(sk + tt * 32 + kq * 4), d4 = *(const LAS f32x4*)(sd + tt * 32 + kq * 4);
            const float v = sv[tt * 64 + w * 8 + vv];
            float o = 0.f;
#pragma unroll
            for (int j = 0; j < 4; ++j) { S[j] = d4[j] * S[j] + k4[j] * v; o += q4[j] * S[j]; }
            o += __shfl_xor(o, 8); o += __shfl_xor(o, 16); o += __shfl_xor(o, 32);
            if (kq == 0) GO[(size_t)scan_row(b, dir, ch * 64 + tt) * 256 + h * 64 + w * 8 + vv] = o;
        }
        __syncthreads();
    }
}
__device__ __forceinline__ void gdn_chain(CArgs& a, int chain, LAS unsigned char* lds) {
    const int b = chain >> 3, h = (chain >> 1) & 3, dir = chain & 1;
    const int tid = tidx(), lane = tid & 63, w = tid >> 6, vv = lane & 7, kq = lane >> 3;
    const float* DQ = (const float*)(a.ws + WS_MIX + MX_DQ); const float* DK = (const float*)(a.ws + WS_MIX + MX_DK); const float* DV = (const float*)(a.ws + WS_MIX + MX_DV);
    const float* DG = (const float*)(a.ws + WS_MIX + MX_DG);
    float* DO = (float*)(a.ws + WS_MIX + (dir ? MX_DOB : MX_DOF));
    LAS float* sq = (LAS float*)lds;
    LAS float* sk = sq + 64 * 64;
    LAS float* sv = sk + 64 * 64;
    LAS float* sg = sv + 64 * 64;
    float S[8];
#pragma unroll
    for (int j = 0; j < 8; ++j) S[j] = 0.f;
    for (int ch = 0; ch < 36; ++ch) {
        { const int tt = tid >> 3, sub = tid & 7, row = scan_row(b, dir, ch * 64 + tt);
          const size_t o = (size_t)row * 256 + h * 64 + sub * 8;
          *(LAS f32x4*)(sq + tt * 64 + sub * 8) = *(const f32x4*)(DQ + o); *(LAS f32x4*)(sq + tt * 64 + sub * 8 + 4) = *(const f32x4*)(DQ + o + 4);
          *(LAS f32x4*)(sk + tt * 64 + sub * 8) = *(const f32x4*)(DK + o); *(LAS f32x4*)(sk + tt * 64 + sub * 8 + 4) = *(const f32x4*)(DK + o + 4);
          *(LAS f32x4*)(sv + tt * 64 + sub * 8) = *(const f32x4*)(DV + o); *(LAS f32x4*)(sv + tt * 64 + sub * 8 + 4) = *(const f32x4*)(DV + o + 4);
          if (sub == 0) { const f32x4 g4 = *(const f32x4*)(DG + (size_t)row * 16 + h * 4); *(LAS f32x2*)(sg + tt * 2) = dir ? (f32x2){g4[2], g4[3]} : (f32x2){g4[0], g4[1]}; } }
        __syncthreads();
#pragma unroll 2
        for (int tt = 0; tt < 64; ++tt) {
            const f32x4 ka = *(const LAS f32x4*)(sk + tt * 64 + kq * 8), kb = *(const LAS f32x4*)(sk + tt * 64 + kq * 8 + 4);
            const f32x4 qa = *(const LAS f32x4*)(sq + tt * 64 + kq * 8), qb = *(const LAS f32x4*)(sq + tt * 64 + kq * 8 + 4);
            const float v = sv[tt * 64 + w * 8 + vv]; const f32x2 g2 = *(const LAS f32x2*)(sg + tt * 2);
            const float beta = g2.x, eg = g2.y;
            float ks = (ka[0] * S[0] + ka[1] * S[1]) + (ka[2] * S[2] + ka[3] * S[3]) + ((kb[0] * S[4] + kb[1] * S[5]) + (kb[2] * S[6] + kb[3] * S[7]));
            ks += __shfl_xor(ks, 8); ks += __shfl_xor(ks, 16); ks += __shfl_xor(ks, 32);
            const float wv = beta * (v - eg * ks);
            float o = 0.f;
#pragma unroll
            for (int j = 0; j < 4; ++j) { S[j] = eg * S[j] + ka[j] * wv; o += qa[j] * S[j]; }
#pragma unroll
            for (int j = 0; j < 4; ++j) { S[4 + j] = eg * S[4 + j] + kb[j] * wv; o += qb[j] * S[4 + j]; }
            o += __shfl_xor(o, 8); o += __shfl_xor(o, 16); o += __shfl_xor(o, 32);
            if (kq == 0) DO[(size_t)scan_row(b, dir, ch * 64 + tt) * 256 + h * 64 + w * 8 + vv] = o;
        }
        __syncthreads();
    }
}
typedef unsigned u32x4a __attribute__((ext_vector_type(4)));
__device__ __forceinline__ bf16x8 frag2(u32x2 lo, u32x2 hi) { return __builtin_bit_cast(bf16x8, (u32x4){lo.x, lo.y, hi.x, hi.y}); }
__device__ __forceinline__ u32x2 cvt4(f32x4 v) { return (u32x2){pk2(v[0], v[1]), pk2(v[2], v[3])}; }

struct GdnIn { f32x2 g2; bf16x8 ak[2], aq[2], bk[2][2]; float kt8[8]; };
struct GdnIn2 { f32x4 R[4], Qv[4]; };
__device__ __forceinline__ void gdn_fetch(CArgs& a, int u, int w, int lane, GdnIn& in) {
    const int chain = u / 36, n = u % 36, b = chain >> 3, h = (chain >> 1) & 3, dir = chain & 1;
    const int r0 = scan_row(b, dir, n * 64), step = dir ? -1 : 1, fr = lane & 15, kg = lane >> 4;
    const float* DQ = (const float*)(a.ws + WS_MIX + MX_DQ) + h * 64; const float* DK = (const float*)(a.ws + WS_MIX + MX_DK) + h * 64; const float* DV = (const float*)(a.ws + WS_MIX + MX_DV) + h * 64;
    const float* DG = (const float*)(a.ws + WS_MIX + MX_DG);
    const bf16* KB = (const bf16*)(a.ws + WS_CKD + CD_KB) + (ptrdiff_t)r0 * 256 + h * 64; const bf16* QB = (const bf16*)(a.ws + WS_CKD + CD_QB) + (ptrdiff_t)r0 * 256 + h * 64;
    const ptrdiff_t ldt = (ptrdiff_t)step * 256;
    const bool isW = w >= 4; const int c0 = 16 * (w & 3), I1 = w >> 1;
    in.g2 = *(const f32x2*)(DG + (size_t)(r0 + step * lane) * 16 + h * 4 + dir * 2);
#pragma unroll
    for (int s = 0; s < 2; ++s) { in.ak[s] = *(const bf16x8*)(KB + (ptrdiff_t)(16 * I1 + fr) * ldt + 32 * s + 8 * kg); in.aq[s] = *(const bf16x8*)(QB + (ptrdiff_t)(16 * I1 + fr) * ldt + 32 * s + 8 * kg);
#pragma unroll
        for (int jj = 0; jj < 2; ++jj) in.bk[jj][s] = *(const bf16x8*)(KB + (ptrdiff_t)(16 * (2 * (w & 1) + jj) + fr) * ldt + 32 * s + 8 * kg); }
#pragma unroll
    for (int tt = 0; tt < 8; ++tt) in.kt8[tt] = DK[(size_t)(r0 + step * (8 * w + tt)) * 256 + lane];
}
__device__ __forceinline__ void gdn_fetch2(CArgs& a, int u, int w, int lane, GdnIn2& in) {
    const int chain = u / 36, n = u % 36, b = chain >> 3, h = (chain >> 1) & 3, dir = chain & 1;
    const int r0 = scan_row(b, dir, n * 64), step = dir ? -1 : 1, fr = lane & 15, kg = lane >> 4;
    const float* DQ = (const float*)(a.ws + WS_MIX + MX_DQ) + h * 64; const float* DK = (const float*)(a.ws + WS_MIX + MX_DK) + h * 64; const float* DV = (const float*)(a.ws + WS_MIX + MX_DV) + h * 64;
    const bool isW = w >= 4; const int c0 = 16 * (w & 3);
#pragma unroll
    for (int I = 0; I < 4; ++I)
#pragma unroll
        for (int e = 0; e < 4; ++e) { const size_t ro = (size_t)(r0 + step * (16 * I + 4 * kg + e)) * 256 + c0 + fr; in.R[I][e] = isW ? DK[ro] : DV[ro]; in.Qv[I][e] = isW ? DQ[ro] : 0.f; }
}
__device__ __forceinline__ float gdn_s1(const GdnIn& in, LAS unsigned char* ub, LAS unsigned char* dwb, int w, int lane) {
    const int fr = lane & 15, kg = lane >> 4, I1 = w >> 1;
    LAS bf16* AB = (LAS bf16*)ub; LAS bf16* ATT = AB + 4608; LAS bf16* KTT = ATT + 4608; LAS float* GT = (LAS float*)(dwb + 2048);
    float beta = in.g2.x, cum = in.g2.y;
#pragma unroll
    for (int o = 1; o < 64; o <<= 1) { const float t = __shfl_up(cum, o); if (lane >= o) cum += t; }
    const float cl = rdlane_f(cum, 63);
    GT[lane] = beta; GT[64 + lane] = cum; GT[128 + lane] = __expf(cum);
    asm volatile("s_waitcnt lgkmcnt(0)" ::: "memory");
    { const f32x4 ci = *(const LAS f32x4*)(GT + 64 + 16 * I1 + 4 * kg), bi = *(const LAS f32x4*)(GT + 16 * I1 + 4 * kg);
#pragma unroll
      for (int jj = 0; jj < 2; ++jj) { const int J = 2 * (w & 1) + jj;
          f32x4 ck = (f32x4){0.f, 0.f, 0.f, 0.f}, cq = (f32x4){0.f, 0.f, 0.f, 0.f};
#pragma unroll
          for (int s = 0; s < 2; ++s) { ck = __builtin_amdgcn_mfma_f32_16x16x32_bf16(in.ak[s], in.bk[jj][s], ck, 0, 0, 0); cq = __builtin_amdgcn_mfma_f32_16x16x32_bf16(in.aq[s], in.bk[jj][s], cq, 0, 0, 0); }
          const int j = 16 * J + fr; const float cj = GT[64 + j];
#pragma unroll
          for (int e = 0; e < 4; ++e) { const int i = 16 * I1 + 4 * kg + e; const float gm = __expf(fminf(ci[e] - cj, 0.f));
              AB[i * 72 + j] = (bf16)f2bf(j < i ? bi[e] * ck[e] * gm : 0.f); ATT[i * 72 + j] = (bf16)f2bf(j <= i ? cq[e] * gm : 0.f); } } }
    { const f32x4 c8a = *(const LAS f32x4*)(GT + 64 + 8 * w), c8b = *(const LAS f32x4*)(GT + 64 + 8 * w + 4);
#pragma unroll
      for (int tt = 0; tt < 8; ++tt) KTT[lane * 72 + 8 * w + tt] = (bf16)f2bf(in.kt8[tt] * __expf(cl - (tt < 4 ? c8a[tt & 3] : c8b[tt & 3]))); }
    asm volatile("s_waitcnt lgkmcnt(0)" ::: "memory");
    return cl;
}
__device__ __forceinline__ void gdn_s23(CArgs& a, int u, const GdnIn2& in, LAS unsigned char* ub, LAS unsigned char* dwb, int w, int lane, float cl) {
    const int fr = lane & 15, kg = lane >> 4;
    bf16* Mo = (bf16*)(a.ws + WS_CKD + CD_M) + (size_t)u * 4096; bf16* Eo = (bf16*)(a.ws + WS_CKD + CD_E) + (size_t)u * 4096;
    float* BTo = (float*)(a.ws + WS_CKD + CD_BT) + (size_t)u * 4096; bf16* FTo = (bf16*)(a.ws + WS_CKD + CD_FT) + (size_t)u * 4096;
    LAS bf16* AB = (LAS bf16*)ub; LAS bf16* ATT = AB + 4608; LAS bf16* KTT = ATT + 4608; LAS bf16* DW = (LAS bf16*)dwb; LAS float* GT = (LAS float*)(dwb + 2048);
    const bool isW = w >= 4; const int c0 = 16 * (w & 3);
    { const int blk = lane >> 4, c = lane & 15; float T[16];
#pragma unroll
      for (int hb = 0; hb < 4; ++hb) {
          u32x4 arow[4][2];
#pragma unroll
          for (int rr = 0; rr < 4; ++rr) { const int r = 4 * hb + rr; arow[rr][0] = *(const LAS u32x4*)(AB + (16 * blk + r) * 72 + 16 * blk); if (hb >= 2) arow[rr][1] = *(const LAS u32x4*)(AB + (16 * blk + r) * 72 + 16 * blk + 8); }
          asm volatile("s_waitcnt lgkmcnt(0)" ::: "memory");
#pragma unroll
          for (int rr = 0; rr < 4; ++rr) { const int r = 4 * hb + rr; float t = (r == c) ? 1.f : 0.f;
              float t2 = 0.f;
#pragma unroll
              for (int j = 0; j < r; ++j) { const unsigned wv = arow[rr][j >> 3][(j >> 1) & 3]; const float av = (j & 1) ? hi_bf(wv) : lo_bf(wv); if (j & 1) t2 -= av * T[j]; else t -= av * T[j]; }
              t += t2;
              T[r] = t; DW[(blk * 16 + r) * 16 + c] = (bf16)f2bf(t); } } }
    asm volatile("s_waitcnt lgkmcnt(0)" ::: "memory");
    f32x4 X[4];
#pragma unroll
    for (int I = 0; I < 4; ++I) {
        const f32x4 br = *(const LAS f32x4*)(GT + 16 * I + 4 * kg), er = *(const LAS f32x4*)(GT + 128 + 16 * I + 4 * kg);
        f32x4 acc = isW ? br * er * in.R[I] : br * in.R[I];
#pragma unroll
        for (int P = 0; 2 * P < I; ++P) {
            const u32x2 alo = *(const LAS u32x2*)(AB + (16 * I + fr) * 72 + 32 * P + 4 * kg);
            const u32x2 ahi = (2 * P + 1 < I) ? *(const LAS u32x2*)(AB + (16 * I + fr) * 72 + 32 * P + 16 + 4 * kg) : (u32x2){0u, 0u};
            const u32x2 xlo = cvt4(-X[2 * P]); const u32x2 xhi = (2 * P + 1 < I) ? cvt4(-X[2 * P + 1]) : (u32x2){0u, 0u};
            acc = __builtin_amdgcn_mfma_f32_16x16x32_bf16(frag2(alo, ahi), frag2(xlo, xhi), acc, 0, 0, 0); }
        const u32x2 dlo = *(const LAS u32x2*)(DW + (I * 16 + fr) * 16 + 4 * kg);
        X[I] = __builtin_amdgcn_mfma_f32_16x16x32_bf16(frag2(dlo, (u32x2){0u, 0u}), frag2(cvt4(acc), (u32x2){0u, 0u}), (f32x4){0.f, 0.f, 0.f, 0.f}, 0, 0, 0);
    }
    const bf16x8 Xb01 = frag2(cvt4(X[0]), cvt4(X[1])), Xb23 = frag2(cvt4(X[2]), cvt4(X[3]));
    const float ecl = __expf(cl);
    bf16* ftp = FTo + (c0 + fr) * 64 + 4 * kg; float* btp = BTo + (c0 + fr) * 64 + 4 * kg; bf16* ep = Eo + (4 * kg) * 64 + c0 + fr; bf16* mp = Mo + (4 * kg) * 64 + c0 + fr;
#pragma unroll
    for (int t4 = 0; t4 < 4; ++t4) {
        const LAS bf16* ar = ATT + (16 * t4 + fr) * 72 + 4 * kg; const LAS bf16* kr = KTT + (16 * t4 + fr) * 72 + 4 * kg;
        f32x4 pa = (f32x4){0.f, 0.f, 0.f, 0.f}, pk = (f32x4){0.f, 0.f, 0.f, 0.f};
        pa = __builtin_amdgcn_mfma_f32_16x16x32_bf16(frag2(*(const LAS u32x2*)ar, *(const LAS u32x2*)(ar + 16)), Xb01, pa, 0, 0, 0);
        pa = __builtin_amdgcn_mfma_f32_16x16x32_bf16(frag2(*(const LAS u32x2*)(ar + 32), *(const LAS u32x2*)(ar + 48)), Xb23, pa, 0, 0, 0);
        pk = __builtin_amdgcn_mfma_f32_16x16x32_bf16(frag2(*(const LAS u32x2*)kr, *(const LAS u32x2*)(kr + 16)), Xb01, pk, 0, 0, 0);
        pk = __builtin_amdgcn_mfma_f32_16x16x32_bf16(frag2(*(const LAS u32x2*)(kr + 32), *(const LAS u32x2*)(kr + 48)), Xb23, pk, 0, 0, 0);
        if (!isW) {
            *(u32x2*)(ftp + 16 * t4) = cvt4(pa);
            *(f32x4*)(btp + 16 * t4) = pk;
        } else {
            const f32x4 ec = *(const LAS f32x4*)(GT + 128 + 16 * t4 + 4 * kg);
#pragma unroll
            for (int e = 0; e < 4; ++e) { const int row = 16 * t4 + 4 * kg + e, col = c0 + fr;
                ep[(16 * t4 + e) * 64] = (bf16)f2bf(ec[e] * in.Qv[t4][e] - pa[e]);
                mp[(16 * t4 + e) * 64] = (bf16)f2bf((row == col ? ecl : 0.f) - pk[e]); }
        }
    }
}
__device__ __forceinline__ void gdn_chain_units(CArgs& a, int chain, LAS unsigned char* lds, int w, int lane, unsigned long long& tacc) {
    asm volatile("" : "+v"(lane));
    LAS unsigned char* dwb = lds + 55296 + w * 3072;
    GdnIn A, B; GdnIn2 C;
    gdn_fetch(a, chain * 36, w, lane, A);
#pragma unroll 1
    for (int n = 0; n < 36; n += 2) {
        asm volatile("" : "+v"(lane));
        { unsigned long long tq = 0ull; if (PROBE_PH >= 60 && PROBE_PH <= 62) tq = __builtin_amdgcn_s_memrealtime();
          gdn_fetch2(a, chain * 36 + n, w, lane, C); const float cl = gdn_s1(A, lds, dwb, w, lane);
          if (PROBE_PH == 60) tacc += __builtin_amdgcn_s_memrealtime() - tq; if (PROBE_PH == 61) tq = __builtin_amdgcn_s_memrealtime();
          __syncthreads();
          if (PROBE_PH == 61) tacc += __builtin_amdgcn_s_memrealtime() - tq; if (PROBE_PH >= 62 && PROBE_PH <= 64) tq = __builtin_amdgcn_s_memrealtime();
          gdn_fetch(a, chain * 36 + n + 1, w, lane, B); gdn_s23(a, chain * 36 + n, C, lds, dwb, w, lane, cl);
          if (PROBE_PH == 62 || (PROBE_PH == 63 && w < 4) || (PROBE_PH == 64 && w >= 4)) tacc += __builtin_amdgcn_s_memrealtime() - tq; }
        asm volatile("" : "+v"(lane));
        { gdn_fetch2(a, chain * 36 + n + 1, w, lane, C); const float cl = gdn_s1(B, lds + 27648, dwb, w, lane); __syncthreads(); if (n + 2 < 36) gdn_fetch(a, chain * 36 + n + 2, w, lane, A); gdn_s23(a, chain * 36 + n + 1, C, lds + 27648, dwb, w, lane, cl); }
    }
}
__device__ __forceinline__ void gdn_seq_wave(CArgs& a, int chain, int vs, int lane) {
    asm volatile("" : "+v"(lane));
    const int b = chain >> 3, h = (chain >> 1) & 3, dir = chain & 1, fr = lane & 15, kg = lane >> 4, v = 16 * vs + fr, step = dir ? -1 : 1;
    float* DO = (float*)(a.ws + WS_MIX + (dir ? MX_DOB : MX_DOF));
    f32x4 S[4];
#pragma unroll
    for (int i = 0; i < 4; ++i) S[i] = (f32x4){0.f, 0.f, 0.f, 0.f};
#pragma unroll 1
    for (int n = 0; n < 36; ++n) {
        const int u = chain * 36 + n, r0 = scan_row(b, dir, n * 64);
        const bf16* Mo = (const bf16*)(a.ws + WS_CKD + CD_M) + (size_t)u * 4096; const bf16* Eo = (const bf16*)(a.ws + WS_CKD + CD_E) + (size_t)u * 4096;
        const float* BTo = (const float*)(a.ws + WS_CKD + CD_BT) + (size_t)u * 4096; const bf16* FTo = (const bf16*)(a.ws + WS_CKD + CD_FT) + (size_t)u * 4096;
        u32x2 ef[4][2][2], mf[4][2][2], ff[4]; f32x4 bi[4];
#pragma unroll
        for (int t = 0; t < 4; ++t) { ff[t] = *(const u32x2*)(FTo + v * 64 + 16 * t + 4 * kg); bi[t] = *(const f32x4*)(BTo + v * 64 + 16 * t + 4 * kg);
#pragma unroll
            for (int s = 0; s < 2; ++s) { const bf16* er = Eo + (16 * t + fr) * 64 + 32 * s + 4 * kg; ef[t][s][0] = *(const u32x2*)er; ef[t][s][1] = *(const u32x2*)(er + 16);
                const bf16* mr = Mo + (16 * t + fr) * 64 + 32 * s + 4 * kg; mf[t][s][0] = *(const u32x2*)mr; mf[t][s][1] = *(const u32x2*)(mr + 16); } }
        bf16x8 Sb[2];
#pragma unroll
        for (int s = 0; s < 2; ++s) Sb[s] = frag2(cvt4(S[2 * s]), cvt4(S[2 * s + 1]));
        f32x4 o[4];
#pragma unroll
        for (int t = 0; t < 4; ++t) { o[t] = (f32x4){lo_bf(ff[t].x), hi_bf(ff[t].x), lo_bf(ff[t].y), hi_bf(ff[t].y)};
#pragma unroll
            for (int s = 0; s < 2; ++s) o[t] = __builtin_amdgcn_mfma_f32_16x16x32_bf16(frag2(ef[t][s][0], ef[t][s][1]), Sb[s], o[t], 0, 0, 0);
            f32x4 sn = bi[t];
#pragma unroll
            for (int s = 0; s < 2; ++s) sn = __builtin_amdgcn_mfma_f32_16x16x32_bf16(frag2(mf[t][s][0], mf[t][s][1]), Sb[s], sn, 0, 0, 0);
            S[t] = sn; }
#pragma unroll
        for (int t = 0; t < 4; ++t)
#pragma unroll
            for (int e = 0; e < 4; ++e) DO[(size_t)(r0 + step * (16 * t + 4 * kg + e)) * 256 + h * 64 + v] = o[t][e];
    }
}

__device__ __forceinline__ void gdn_seq_block(CArgs& a, int chain, LAS unsigned char* lds, int w, int lane) {
    asm volatile("" : "+v"(lane));
    const int b = chain >> 3, h = (chain >> 1) & 3, dir = chain & 1, fr = lane & 15, kg = lane >> 4, step = dir ? -1 : 1;
    constexpr int SLOT = 45056;
    if (w >= 4) {
        const int q = w - 4;
        u32x4 rg[10];
#define SEQ_LD(n_) do { const int u_ = chain * 36 + (n_); \
        _Pragma("unroll") for (int j = 0; j < 10; ++j) { const int c_ = q + 4 * j; \
            const unsigned char* g_ = c_ < 8 ? a.ws + WS_CKD + CD_M + (size_t)u_ * 8192 + c_ * 1024 : (c_ < 16 ? a.ws + WS_CKD + CD_E + (size_t)u_ * 8192 + (c_ - 8) * 1024 : \
                (c_ < 32 ? a.ws + WS_CKD + CD_BT + (size_t)u_ * 16384 + (c_ - 16) * 1024 : a.ws + WS_CKD + CD_FT + (size_t)u_ * 8192 + (c_ - 32) * 1024)); \
            rg[j] = *(const u32x4*)(g_ + lane * 16); } } while (0)
#define SEQ_ST(n_) do { LAS unsigned char* s_ = lds + ((n_) % 3) * SLOT; \
        _Pragma("unroll") for (int j = 0; j < 10; ++j) { const int c_ = q + 4 * j; \
            const int off_ = c_ < 8 ? (c_ * 8 + (lane >> 3)) * 144 + (lane & 7) * 16 : (c_ < 16 ? 9216 + ((c_ - 8) * 8 + (lane >> 3)) * 144 + (lane & 7) * 16 : \
                (c_ < 32 ? 18432 + ((c_ - 16) * 4 + (lane >> 4)) * 272 + (lane & 15) * 16 : 35840 + ((c_ - 32) * 8 + (lane >> 3)) * 144 + (lane & 7) * 16)); \
            *(LAS u32x4*)(s_ + off_) = rg[j]; } } while (0)
        SEQ_LD(0); SEQ_ST(0); SEQ_LD(1); SEQ_ST(1); SEQ_LD(2);
        asm volatile("s_waitcnt lgkmcnt(0)" ::: "memory");
        __syncthreads();
#pragma unroll 1
        for (int n = 0; n < 36; ++n) {
            if (n + 2 < 36) { SEQ_ST(n + 2); }
            if (n + 3 < 36) { SEQ_LD(n + 3); }
            asm volatile("s_waitcnt lgkmcnt(0)" ::: "memory");
            __syncthreads();
        }
#undef SEQ_LD
#undef SEQ_ST
    } else {
        const int v = 16 * w + fr;
        float* DO = (float*)(a.ws + WS_MIX + (dir ? MX_DOB : MX_DOF));
        f32x4 S[4];
#pragma unroll
        for (int i = 0; i < 4; ++i) S[i] = (f32x4){0.f, 0.f, 0.f, 0.f};
        __syncthreads();
#pragma unroll 1
        for (int n = 0; n < 36; ++n) {
            const LAS unsigned char* sl = lds + (n % 3) * SLOT; const int r0 = scan_row(b, dir, n * 64);
            bf16x8 Sb[2];
#pragma unroll
            for (int s = 0; s < 2; ++s) Sb[s] = frag2(cvt4(S[2 * s]), cvt4(S[2 * s + 1]));
            f32x4 o[4];
#pragma unroll
            for (int t = 0; t < 4; ++t) {
                const u32x2 ff = *(const LAS u32x2*)(sl + 35840 + v * 144 + (16 * t + 4 * kg) * 2);
                o[t] = (f32x4){lo_bf(ff.x), hi_bf(ff.x), lo_bf(ff.y), hi_bf(ff.y)};
                f32x4 sn = *(const LAS f32x4*)(sl + 18432 + v * 272 + (16 * t + 4 * kg) * 4);
#pragma unroll
                for (int s = 0; s < 2; ++s) { const LAS unsigned char* er = sl + 9216 + (16 * t + fr) * 144 + (32 * s + 4 * kg) * 2; const LAS unsigned char* mr = sl + (16 * t + fr) * 144 + (32 * s + 4 * kg) * 2;
                    o[t] = __builtin_amdgcn_mfma_f32_16x16x32_bf16(frag2(*(const LAS u32x2*)er, *(const LAS u32x2*)(er + 32)), Sb[s], o[t], 0, 0, 0);
                    sn = __builtin_amdgcn_mfma_f32_16x16x32_bf16(frag2(*(const LAS u32x2*)mr, *(const LAS u32x2*)(mr + 32)), Sb[s], sn, 0, 0, 0); }
                S[t] = sn; }
            { float* dp = DO + (ptrdiff_t)(r0 + step * 4 * kg) * 256 + h * 64 + v; const ptrdiff_t sd = (ptrdiff_t)step * 256;
#pragma unroll
              for (int t = 0; t < 4; ++t)
#pragma unroll
                  for (int e = 0; e < 4; ++e) dp[(16 * t + e) * sd] = o[t][e]; }
            __syncthreads();
        }
    }
}
__device__ __forceinline__ void gla_seq_block(CArgs& a, int chain, LAS unsigned char* lds, int w, int lane) {
    asm volatile("" : "+v"(lane));
    const int b = chain >> 3, h = (chain >> 1) & 3, dir = chain & 1, fr = lane & 15, kg = lane >> 4, step = dir ? -1 : 1;
    constexpr int SLOT = 23680;
    if (w >= 4) {
        const int q = w - 4;
        u32x4 rg[5]; float dl = 0.f;
#define SEQ_LD(n_) do { const int u_ = chain * 36 + (n_); \
        _Pragma("unroll") for (int j = 0; j < 5; ++j) { const int c_ = q + 4 * j; \
            const unsigned char* g_ = c_ < 4 ? a.ws + WS_CKA + CA_QC + (size_t)u_ * 4096 + c_ * 1024 : (c_ < 12 ? a.ws + WS_CKA + CA_FT + (size_t)u_ * 8192 + (c_ - 4) * 1024 : a.ws + WS_CKA + CA_UT + (size_t)u_ * 8192 + (c_ - 12) * 1024); \
            rg[j] = *(const u32x4*)(g_ + lane * 16); } \
        if (q == 0) dl = ((const float*)(a.ws + WS_CKA + CA_DL))[(size_t)u_ * 32 + (lane & 31)]; } while (0)
#define SEQ_ST(n_) do { LAS unsigned char* s_ = lds + ((n_) % 3) * SLOT; \
        _Pragma("unroll") for (int j = 0; j < 5; ++j) { const int c_ = q + 4 * j; \
            const int off_ = c_ < 4 ? (c_ * 16 + (lane >> 2)) * 80 + (lane & 3) * 16 : (c_ < 12 ? 5120 + ((c_ - 4) * 8 + (lane >> 3)) * 144 + (lane & 7) * 16 : 14336 + ((c_ - 12) * 8 + (lane >> 3)) * 144 + (lane & 7) * 16); \
            *(LAS u32x4*)(s_ + off_) = rg[j]; } \
        if (q == 0 && lane < 32) *(LAS float*)(s_ + 23552 + lane * 4) = dl; } while (0)
        SEQ_LD(0); SEQ_ST(0); SEQ_LD(1); SEQ_ST(1); SEQ_LD(2);
        asm volatile("s_waitcnt lgkmcnt(0)" ::: "memory");
        __syncthreads();
#pragma unroll 1
        for (int n = 0; n < 36; ++n) {
            if (n + 2 < 36) { SEQ_ST(n + 2); }
            if (n + 3 < 36) { SEQ_LD(n + 3); }
            asm volatile("s_waitcnt lgkmcnt(0)" ::: "memory");
            __syncthreads();
        }
#undef SEQ_LD
#undef SEQ_ST
    } else {
        const int v = 16 * w + fr;
        float* GO = (float*)(a.ws + WS_MIX + (dir ? MX_GOB : MX_GOF));
        f32x4 S[2] = {(f32x4){0.f, 0.f, 0.f, 0.f}, (f32x4){0.f, 0.f, 0.f, 0.f}};
        __syncthreads();
#pragma unroll 1
        for (int n = 0; n < 36; ++n) {
            const LAS unsigned char* sl = lds + (n % 3) * SLOT; const int r0 = scan_row(b, dir, n * 64);
            const bf16x8 Sb = frag2(cvt4(S[0]), cvt4(S[1]));
            f32x4 o[4];
#pragma unroll
            for (int t = 0; t < 4; ++t) { const u32x2 ff = *(const LAS u32x2*)(sl + 5120 + v * 144 + (16 * t + 4 * kg) * 2);
                o[t] = (f32x4){lo_bf(ff.x), hi_bf(ff.x), lo_bf(ff.y), hi_bf(ff.y)};
                const LAS unsigned char* qr = sl + (16 * t + fr) * 80 + 4 * kg * 2;
                o[t] = __builtin_amdgcn_mfma_f32_16x16x32_bf16(frag2(*(const LAS u32x2*)qr, *(const LAS u32x2*)(qr + 32)), Sb, o[t], 0, 0, 0); }
#pragma unroll
            for (int kt = 0; kt < 2; ++kt) { const f32x4 d4 = *(const LAS f32x4*)(sl + 23552 + (16 * kt + 4 * kg) * 4), u4 = *(const LAS f32x4*)(sl + 14336 + v * 144 + (16 * kt + 4 * kg) * 4); S[kt] = d4 * S[kt] + u4; }
            { float* gp = GO + (ptrdiff_t)(r0 + step * 4 * kg) * 256 + h * 64 + v; const ptrdiff_t sd = (ptrdiff_t)step * 256;
#pragma unroll
              for (int t = 0; t < 4; ++t)
#pragma unroll
                  for (int e = 0; e < 4; ++e) gp[(16 * t + e) * sd] = o[t][e]; }
            __syncthreads();
        }
    }
}

struct GlaIn { float bc[32]; unsigned px[32]; };
__device__ __forceinline__ void gla_fetch(CArgs& a, int u, int w, int lane, GlaIn& in) {
    const int chain = u / 36, n = u % 36, b = chain >> 3, h = (chain >> 1) & 3, dir = chain & 1;
    const int r0 = scan_row(b, dir, n * 64), step = dir ? -1 : 1;
    const bf16* P = (const bf16*)(a.ws + WS_P);
    const float* GD = (const float*)(a.ws + WS_MIX + (dir ? MX_GDB : MX_GDF));
    if (w < 4) { const int k = lane & 31, half = lane >> 5; const int src_off = (w == 0 || w == 2) ? 0 : 128;
#pragma unroll
        for (int i = 0; i < 32; ++i) { in.bc[i] = GD[(size_t)(r0 + step * (32 * half + i)) * 128 + h * 32 + k]; in.px[i] = P[(size_t)(r0 + step * (32 * half + i)) * D_INP + GLA0 + src_off + h * 32 + k]; }
    } else { const int vv = 16 * (w - 4) + (lane & 15), tq = lane >> 4;
#pragma unroll
        for (int i = 0; i < 16; ++i) in.px[i] = P[(size_t)(r0 + step * (16 * tq + i)) * D_INP + GLA0 + 256 + h * 64 + vv];
#pragma unroll
        for (int i = 16; i < 32; ++i) in.px[i] = 0u;
#pragma unroll
        for (int i = 0; i < 32; ++i) in.bc[i] = 0.f;
    }
}
__device__ __forceinline__ void gla_s1(CArgs& a, int u, GlaIn& in, LAS unsigned char* ub, int w, int lane) {
    bf16* QC = (bf16*)(a.ws + WS_CKA + CA_QC) + (size_t)u * 2048; float* DL = (float*)(a.ws + WS_CKA + CA_DL) + (size_t)u * 32;
    LAS bf16* QE = (LAS bf16*)ub; LAS bf16* KE = QE + 2560; LAS bf16* KTT = KE + 2560; LAS bf16* VT = KTT + 2304;
    if (w < 4) {
        const int k = lane & 31, half = lane >> 5;
        float run = 0.f;
#pragma unroll
        for (int i = 0; i < 32; ++i) { run += in.bc[i]; in.bc[i] = run; }
        const float tot0 = __shfl(run, k), tot1 = __shfl(run, 32 + k);
        const float bref = tot0, blast = tot0 + tot1, off = half ? tot0 : 0.f;
        const float sc = (w == 0 || w == 2) ? 0.17677669529663687f : 1.f;
#pragma unroll
        for (int i = 0; i < 32; ++i) { const int t = 32 * half + i; const float bi = in.bc[i] + off;
            const float x = bf2f(in.px[i]) * sc;
            const float ex = w == 0 ? bi - bref : (w == 1 ? bref - bi : (w == 2 ? bi : blast - bi));
            const bf16 y = (bf16)f2bf(x * __expf(ex));
            if (w == 0) QE[t * 40 + k] = y; else if (w == 1) KE[t * 40 + k] = y; else if (w == 2) QC[t * 32 + k] = y; else KTT[k * 72 + t] = y; }
        if (w == 2 && half == 0) DL[k] = __expf(blast);
    } else {
        const int vv = 16 * (w - 4) + (lane & 15), tq = lane >> 4;
#pragma unroll
        for (int i = 0; i < 16; ++i) VT[vv * 72 + 16 * tq + i] = in.px[i];
    }
    asm volatile("s_waitcnt lgkmcnt(0)" ::: "memory");
}
__device__ __forceinline__ void gla_s2(CArgs& a, int u, LAS unsigned char* ub, int w, int lane) {
    const int fr = lane & 15, kg = lane >> 4;
    bf16* FT = (bf16*)(a.ws + WS_CKA + CA_FT) + (size_t)u * 4096; float* UT = (float*)(a.ws + WS_CKA + CA_UT) + (size_t)u * 2048;
    LAS bf16* QE = (LAS bf16*)ub; LAS bf16* KE = QE + 2560; LAS bf16* KTT = KE + 2560; LAS bf16* VT = KTT + 2304;
    const int It = w & 3, vh = w >> 2;
    const bf16x8 qf = *(const LAS bf16x8*)(QE + (16 * It + fr) * 40 + 8 * kg);
    f32x4 st[4];
#pragma unroll
    for (int Jt = 0; Jt < 4; ++Jt) { const bf16x8 kf = *(const LAS bf16x8*)(KE + (16 * Jt + fr) * 40 + 8 * kg);
        st[Jt] = __builtin_amdgcn_mfma_f32_16x16x32_bf16(kf, qf, (f32x4){0.f, 0.f, 0.f, 0.f}, 0, 0, 0);
#pragma unroll
        for (int e = 0; e < 4; ++e) st[Jt][e] = (16 * Jt + 4 * kg + e <= 16 * It + fr) ? st[Jt][e] : 0.f; }
    const bf16x8 Sb01 = frag2(cvt4(st[0]), cvt4(st[1])), Sb23 = frag2(cvt4(st[2]), cvt4(st[3]));
    bf16* ftp = FT + (4 * kg) * 64 + 16 * It + fr;
#pragma unroll
    for (int vv = 0; vv < 2; ++vv) { const int Vt = 2 * vh + vv; const LAS bf16* vr = VT + (16 * Vt + fr) * 72 + 4 * kg;
        f32x4 f = (f32x4){0.f, 0.f, 0.f, 0.f};
        f = __builtin_amdgcn_mfma_f32_16x16x32_bf16(frag2(*(const LAS u32x2*)vr, *(const LAS u32x2*)(vr + 16)), Sb01, f, 0, 0, 0);
        f = __builtin_amdgcn_mfma_f32_16x16x32_bf16(frag2(*(const LAS u32x2*)(vr + 32), *(const LAS u32x2*)(vr + 48)), Sb23, f, 0, 0, 0);
#pragma unroll
        for (int e = 0; e < 4; ++e) ftp[(16 * Vt + e) * 64] = (bf16)f2bf(f[e]); }
    const int kt = w & 1, Vu = w >> 1;
    f32x4 uu = (f32x4){0.f, 0.f, 0.f, 0.f};
#pragma unroll
    for (int s = 0; s < 2; ++s) uu = __builtin_amdgcn_mfma_f32_16x16x32_bf16(*(const LAS bf16x8*)(KTT + (16 * kt + fr) * 72 + 32 * s + 8 * kg), *(const LAS bf16x8*)(VT + (16 * Vu + fr) * 72 + 32 * s + 8 * kg), uu, 0, 0, 0);
    *(f32x4*)(UT + (16 * Vu + fr) * 32 + 16 * kt + 4 * kg) = uu;
}
__device__ __forceinline__ void gla_chain_units(CArgs& a, int chain, LAS unsigned char* lds, int w, int lane) {
    GlaIn A, B;
    asm volatile("" : "+v"(lane));
    gla_fetch(a, chain * 36, w, lane, A);
#pragma unroll 1
    for (int n = 0; n < 36; n += 2) {
        asm volatile("" : "+v"(lane));
        { gla_s1(a, chain * 36 + n, A, lds, w, lane); __syncthreads(); gla_fetch(a, chain * 36 + n + 1, w, lane, B); gla_s2(a, chain * 36 + n, lds, w, lane); }
        asm volatile("" : "+v"(lane));
        { gla_s1(a, chain * 36 + n + 1, B, lds + 24064, w, lane); __syncthreads(); if (n + 2 < 36) gla_fetch(a, chain * 36 + n + 2, w, lane, A); gla_s2(a, chain * 36 + n + 1, lds + 24064, w, lane); }
    }
}
__device__ __forceinline__ void gla_seq_wave(CArgs& a, int chain, int vs, int lane) {
    asm volatile("" : "+v"(lane));
    const int b = chain >> 3, h = (chain >> 1) & 3, dir = chain & 1, fr = lane & 15, kg = lane >> 4, v = 16 * vs + fr, step = dir ? -1 : 1;
    float* GO = (float*)(a.ws + WS_MIX + (dir ? MX_GOB : MX_GOF));
    f32x4 S[2] = {(f32x4){0.f, 0.f, 0.f, 0.f}, (f32x4){0.f, 0.f, 0.f, 0.f}};
#pragma unroll 1
    for (int n = 0; n < 36; ++n) {
        const int u = chain * 36 + n, r0 = scan_row(b, dir, n * 64);
        const bf16* QC = (const bf16*)(a.ws + WS_CKA + CA_QC) + (size_t)u * 2048; const bf16* FT = (const bf16*)(a.ws + WS_CKA + CA_FT) + (size_t)u * 4096;
        const float* UT = (const float*)(a.ws + WS_CKA + CA_UT) + (size_t)u * 2048; const float* DL = (const float*)(a.ws + WS_CKA + CA_DL) + (size_t)u * 32;
        u32x2 qf[4][2], ff[4]; f32x4 d4[2], u4[2];
#pragma unroll
        for (int t = 0; t < 4; ++t) { const bf16* qr = QC + (16 * t + fr) * 32; qf[t][0] = *(const u32x2*)(qr + 4 * kg); qf[t][1] = *(const u32x2*)(qr + 16 + 4 * kg); ff[t] = *(const u32x2*)(FT + v * 64 + 16 * t + 4 * kg); }
#pragma unroll
        for (int kt = 0; kt < 2; ++kt) { d4[kt] = *(const f32x4*)(DL + 16 * kt + 4 * kg); u4[kt] = *(const f32x4*)(UT + v * 32 + 16 * kt + 4 * kg); }
        const bf16x8 Sb = frag2(cvt4(S[0]), cvt4(S[1]));
        f32x4 o[4];
#pragma unroll
        for (int t = 0; t < 4; ++t) { o[t] = (f32x4){lo_bf(ff[t].x), hi_bf(ff[t].x), lo_bf(ff[t].y), hi_bf(ff[t].y)};
            o[t] = __builtin_amdgcn_mfma_f32_16x16x32_bf16(frag2(qf[t][0], qf[t][1]), Sb, o[t], 0, 0, 0); }
#pragma unroll
        for (int kt = 0; kt < 2; ++kt) S[kt] = d4[kt] * S[kt] + u4[kt];
#pragma unroll
        for (int t = 0; t < 4; ++t)
#pragma unroll
            for (int e = 0; e < 4; ++e) GO[(size_t)(r0 + step * (16 * t + 4 * kg + e)) * 256 + h * 64 + v] = o[t][e];
    }
}

template <int L>
__device__ __forceinline__ void hyena_unit(CArgs& a, int l, int c, LAS unsigned char* lds) {
    constexpr int Lt = L == SEQ ? 1 : 0, SOFF = L == SEQ ? CTXL : 0, CST = (2 * L + 16) * 2 + 32;
    constexpr int NTW = L / 16 / 8;
    const int tid = tidx(), lane = tid & 63, w = tid >> 6, fr = lane & 15, kg = lane >> 4;
    const float* kf = (const float*)(a.ws + WS_KUN) + ((size_t)((l * 2 + Lt) * 512 + c)) * 2048;
    const float* kb = kf + (size_t)256 * 2048;
    LAS float* red = (LAS float*)(lds + 8 * CST);
    const bf16* Z = (const bf16*)(a.ws + WS_MIX + MX_ZT) + ((size_t)(c * 16 + fr)) * 2304 + SOFF;
    const bf16* zp = Z + 8 * kg;
    bf16x8 zc[8];
#pragma unroll
    for (int ii = 0; ii < 8; ++ii) zc[ii] = *(const bf16x8*)(zp + 32 * ii);
    constexpr int NI = (2 * L + 16 + 511) / 512;
    float gv[NI];
    float s = 0.f;
#pragma unroll
    for (int q = 0; q < NI; ++q) {
        const int idx = tid + 512 * q, ic = min(max(idx, 1), 2 * L - 1);
        const float v = *(ic <= L ? kf + (L - ic) : kb + (ic - L));
        gv[q] = (idx >= 1 && idx < 2 * L) ? v : 0.f;
        s += fabsf(gv[q]);
    }
    s = wave_sum(s);
    if (lane == 0) red[w] = s;
    __syncthreads();
    float l1 = 0.f;
#pragma unroll
    for (int i = 0; i < 8; ++i) l1 += red[i];
    const float inv = 1.f / l1;
#pragma unroll
    for (int q = 0; q < NI; ++q) {
        const int idx = tid + 512 * q;
        const bf16 gb = (bf16)f2bf(gv[q] * inv);
        if (idx < 2 * L + 16) {
#pragma unroll
            for (int r = 0; r < 8; ++r) if (idx - r >= 0) *(LAS bf16*)(lds + r * CST + (idx - r) * 2) = gb;
        }
    }
    __syncthreads();
    float* YT = (float*)(a.ws + WS_MIX + MX_YT) + ((size_t)(c * 16 + fr)) * 2304 + SOFF;
    f32x4 acc[NTW];
#pragma unroll
    for (int j = 0; j < NTW; ++j) acc[j] = (f32x4){0.f, 0.f, 0.f, 0.f};
    const int rr = (8 - (fr & 7)) & 7;
    const LAS unsigned char* ap = lds + rr * CST + (((8 * kg - fr + L) >> 3) - 2 * w * NTW) * 16;
    if constexpr (L == SEQ) {
        static_assert(NTW == 16, "hyena_unit");
        bf16x8 zn[8], A[16];
#pragma unroll
        for (int j = 2; j < 16; ++j) A[j] = *(const LAS bf16x8*)(ap - 32 * j);
#pragma unroll 1
        for (int ib = 0; ib < 8; ++ib) {
            const bf16* zq = zp + 256 * (ib < 7 ? ib + 1 : 7);
#pragma unroll
            for (int ii = 0; ii < 8; ++ii) zn[ii] = *(const bf16x8*)(zq + 32 * ii);
#pragma unroll
            for (int ii = 0; ii < 8; ++ii) {
                A[(16 - 2 * ii) & 15] = *(const LAS bf16x8*)(ap + 64 * ii);
                A[(17 - 2 * ii) & 15] = *(const LAS bf16x8*)(ap + 64 * ii - 32);
#pragma unroll
                for (int jj = 0; jj < 16; ++jj) { const int j = (jj + 2) & 15; acc[j] = __builtin_amdgcn_mfma_f32_16x16x32_bf16(A[(j + 16 - 2 * ii) & 15], zc[ii], acc[j], 0, 0, 0); }
            }
            ap += 512;
#pragma unroll
            for (int ii = 0; ii < 8; ++ii) zc[ii] = zn[ii];
        }
    } else {
        static_assert(L == 256, "hyena_unit");
#pragma unroll
        for (int i = 0; i < 8; ++i)
#pragma unroll
            for (int j = 0; j < NTW; ++j) acc[j] = __builtin_amdgcn_mfma_f32_16x16x32_bf16(*(const LAS bf16x8*)(ap + (4 * i - 2 * j) * 16), zc[i], acc[j], 0, 0, 0);
    }
#pragma unroll
    for (int j = 0; j < NTW; ++j) *(f32x4*)(YT + 16 * (w * NTW + j) + 4 * kg) = acc[j];
    __syncthreads();
}
__device__ __forceinline__ void ph_scan(CArgs& a, int l, LAS unsigned char* lds, int bid, int nblk, unsigned long long& tacc) {
    const int tid = tidx(), lane = tid & 63, w = __builtin_amdgcn_readfirstlane(tid >> 6);
    unsigned long long t0 = 0ull;
    if (PROBE_PH >= 20 && PROBE_PH < 50) t0 = __builtin_amdgcn_s_memrealtime();
#pragma unroll 1
    for (int c = bid; c < 256; c += nblk) {
        if (c < 128) {
            gdn_chain_units(a, c, lds, w, lane, tacc);
        } else {
            gla_chain_units(a, c - 128, lds, w, lane);
        }
        asm volatile("s_waitcnt vmcnt(0)" ::: "memory");
        __syncthreads();
        if (PROBE_PH == 20 && c < 128) tacc += __builtin_amdgcn_s_memrealtime() - t0;
        if (PROBE_PH == 24 && c >= 128) tacc += __builtin_amdgcn_s_memrealtime() - t0;
        if (PROBE_PH == 21) t0 = __builtin_amdgcn_s_memrealtime();
        if (c < 128) gdn_seq_block(a, c, lds, w, lane); else gla_seq_block(a, c - 128, lds, w, lane);
        __syncthreads();
        if (PROBE_PH == 21) tacc += __builtin_amdgcn_s_memrealtime() - t0;
    }
    if (PROBE_PH == 22) t0 = __builtin_amdgcn_s_memrealtime();
    {
        LAS unsigned char* scr = lds + w * 8448;
        if (nblk == 256) { const int per = bid < 128 ? 16 : 32, first = bid < 128 ? (bid * 8 + w) * 16 : 16384 + ((bid - 128) * 8 + w) * 32;
            tr_experts_range(a, l, scr, first, first + per, 1, lane); }
        else tr_experts_range(a, l, scr, bid * 8 + w, NEXP * 3 * 512, nblk * 8, lane);
    }
    if (PROBE_PH == 22) tacc += __builtin_amdgcn_s_memrealtime() - t0;
    __syncthreads();
    if (PROBE_PH == 23) t0 = __builtin_amdgcn_s_memrealtime();
    if (nblk == 256) {
        if (bid < 128) hyena_unit<SEQ>(a, l, bid, lds);
        else { const int g = bid - 128; hyena_unit<SEQ>(a, l, 128 + g, lds); hyena_unit<CTXL>(a, l, 2 * g, lds); hyena_unit<CTXL>(a, l, 2 * g + 1, lds); }
    } else {
        for (int it = bid; it < 512; it += nblk) { if (it < 256) hyena_unit<SEQ>(a, l, it, lds); else hyena_unit<CTXL>(a, l, it - 256, lds); }
    }
    if (PROBE_PH == 23) tacc += __builtin_amdgcn_s_memrealtime() - t0;
}

__device__ __forceinline__ void ph_post_hyena(CArgs& a, int l, LAS unsigned char* lds, int bid, int nblk) {
    const bf16* P = (const bf16*)(a.ws + WS_P);
    const float* YT = (const float*)(a.ws + WS_MIX + MX_YT); bf16* YMIX = (bf16*)(a.ws + WS_YMIX);
    LAS float* yt = (LAS float*)lds;
    const int tid = tidx(), c4 = (tid & 63) * 4, tg = tid >> 6;
    const float* hw = a.in[I_HYCW] + l * 3 * 768; const float* hb = a.in[I_HYCB] + l * 768;
    f32x4 w0[3], wx[3], wv[3];
#pragma unroll
    for (int k = 0; k < 3; ++k) { w0[k] = *(const f32x4*)(hw + k * 768 + c4); wx[k] = *(const f32x4*)(hw + k * 768 + 256 + c4); wv[k] = *(const f32x4*)(hw + k * 768 + 512 + c4); }
    const f32x4 b0 = *(const f32x4*)(hb + c4), bx = *(const f32x4*)(hb + 256 + c4), bv = *(const f32x4*)(hb + 512 + c4), hd = *(const f32x4*)(a.in[I_HYD] + l * 256 + c4);
#pragma unroll 1
    for (int it = bid; it < 576; it += nblk) {
        const Chunk c = chunk_of(it);
        const int soff = c.L == CTXL ? 0 : CTXL;
        { const int ch = tid & 255, half = tid >> 8;
          const float* srcp = YT + ((size_t)(ch * 16 + c.b)) * 2304 + soff + c.t0 + half * 32;
#pragma unroll
          for (int j = 0; j < 8; ++j) { const f32x4 v = *(const f32x4*)(srcp + 4 * j);
              yt[(half * 32 + 4 * j) * 260 + ch] = v[0]; yt[(half * 32 + 4 * j + 1) * 260 + ch] = v[1]; yt[(half * 32 + 4 * j + 2) * 260 + ch] = v[2]; yt[(half * 32 + 4 * j + 3) * 260 + ch] = v[3]; } }
        __syncthreads();
        const int tb = c.t0 + tg * 8;
        const bf16* pb = P + (size_t)(c.row0 + tg * 8) * D_INP;
        f32x4 x0[10], x1[10], vv[10];
#pragma unroll
        for (int r = 0; r < 10; ++r) { const int t = tb + r - 1; const bool ok = t >= c.lo && t < c.hi; const bf16* p = pb + (ptrdiff_t)(r - 1) * D_INP;
            x0[r] = ok ? bf4(*(const u32x2*)(p + HY0 + c4)) : (f32x4){0.f, 0.f, 0.f, 0.f};
            x1[r] = ok ? bf4(*(const u32x2*)(p + HY0 + 256 + c4)) : (f32x4){0.f, 0.f, 0.f, 0.f}; vv[r] = ok ? bf4(*(const u32x2*)(p + HY0 + 512 + c4)) : (f32x4){0.f, 0.f, 0.f, 0.f}; }
#pragma unroll
        for (int tt = 0; tt < 8; ++tt) {
            const f32x4 u0 = w0[0] * x0[tt] + w0[1] * x0[tt + 1] + w0[2] * x0[tt + 2] + b0;
            const f32x4 xx = wx[0] * x1[tt] + wx[1] * x1[tt + 1] + wx[2] * x1[tt + 2] + bx, v2 = wv[0] * vv[tt] + wv[1] * vv[tt + 1] + wv[2] * vv[tt + 2] + bv, z = xx * v2;
            const f32x4 y = *(const LAS f32x4*)(yt + (tg * 8 + tt) * 260 + c4);
            const f32x4 o = (y + z * hd) * u0;
            u32x2 oo; oo.x = pk2(o[0], o[1]); oo.y = pk2(o[2], o[3]); *(u32x2*)(YMIX + (size_t)(c.row0 + tg * 8 + tt) * D + c4) = oo;
        }
        __syncthreads();
    }
}
__device__ __forceinline__ void ph_post_tok(CArgs& a, int l, int gw, int ngw) {
    const int lane = tidx() & 63;
    const bf16* P = (const bf16*)(a.ws + WS_P); bf16* YMIX = (bf16*)(a.ws + WS_YMIX);
    const float* GOF = (const float*)(a.ws + WS_MIX + MX_GOF); const float* GOB = (const float*)(a.ws + WS_MIX + MX_GOB);
    const float* DOF = (const float*)(a.ws + WS_MIX + MX_DOF); const float* DOB = (const float*)(a.ws + WS_MIX + MX_DOB);
    const f32x4 nwa = *(const f32x4*)(a.in[I_GLANW] + l * 64 + (4 * lane & 63)), nwd = *(const f32x4*)(a.in[I_GDNNW] + l * 64 + (4 * lane & 63));
    for (int row = gw; row < NTOK; row += ngw) {
        const size_t o4 = (size_t)row * 256 + 4 * lane;
        f32x4 og = *(const f32x4*)(GOF + o4) + *(const f32x4*)(GOB + o4), od = *(const f32x4*)(DOF + o4) + *(const f32x4*)(DOB + o4);
        float sg = og[0] * og[0] + og[1] * og[1] + og[2] * og[2] + og[3] * og[3], sd = od[0] * od[0] + od[1] * od[1] + od[2] * od[2] + od[3] * od[3];
        sg = row16_sum(sg); sd = row16_sum(sd);
        const float rg = rsqrtf(sg * (1.f / 64.f) + 1e-6f), rd = rsqrtf(sd * (1.f / 64.f) + 1e-6f);
        const u32x2 r2 = *(const u32x2*)(P + (size_t)row * D_INP + GLA0 + 512 + 4 * lane), z2 = *(const u32x2*)(P + (size_t)row * D_INP + GDN0 + 768 + 4 * lane);
        u32x2 w;
        w.x = pk2(og[0] * rg * nwa[0] * siluf_(lo_bf(r2.x)), og[1] * rg * nwa[1] * siluf_(hi_bf(r2.x))); w.y = pk2(og[2] * rg * nwa[2] * siluf_(lo_bf(r2.y)), og[3] * rg * nwa[3] * siluf_(hi_bf(r2.y)));
        *(u32x2*)(YMIX + (size_t)row * D + 512 + 4 * lane) = w;
        w.x = pk2(od[0] * rd * nwd[0] * siluf_(lo_bf(z2.x)), od[1] * rd * nwd[1] * siluf_(hi_bf(z2.x))); w.y = pk2(od[2] * rd * nwd[2] * siluf_(lo_bf(z2.y)), od[3] * rd * nwd[3] * siluf_(hi_bf(z2.y)));
        *(u32x2*)(YMIX + (size_t)row * D + 768 + 4 * lane) = w;
    }
}

__device__ __forceinline__ void ph_ln1_route(CArgs& a, int l, LAS unsigned char* lds, int bid, int nblk) {
    const int tid = tidx(), lane = tid & 63, w = __builtin_amdgcn_readfirstlane(tid >> 6);
    const float* MOD = (const float*)(a.ws + WS_MOD) + (size_t)l * 17 * 6144;
    float* X = (float*)(a.ws + WS_X); const float* TMP = (const float*)(a.ws + WS_TMP); bf16* HB = (bf16*)(a.ws + WS_HB);
    const float* lg = a.in[I_LN1G] + l * D; const float* lb = a.in[I_LN1B] + l * D;
    const float* br = a.in[I_BR] + l * NEXP;
    const bf16* wh = (const bf16*)(a.ws + WS_WRT) + (size_t)l * NEXP * D; const bf16* wl = wh + DEPTH * NEXP * D;
    unsigned* cnt = (unsigned*)(a.ws + WS_CTL) + CW_CNT + l * NEXP * 64;
    int* LIST = (int*)(a.ws + WS_LIST); int* TOPE = (int*)(a.ws + WS_TOPE); float* TOPW = (float*)(a.ws + WS_TOPW);
    LAS float* hrow = (LAS float*)lds;
    LAS float* part = (LAS float*)(lds + 65792);
    const int row_lo = (l == DEPTH - 1) ? NTOK_C : 0;
    const int e = lane & 31, par = lane >> 5, fr = lane & 15, kg = lane >> 4;
    f32x4 xv[2][4], tv[2][4];
#define LN1_FETCH(base_) do { _Pragma("unroll") for (int t = 0; t < 2; ++t) { const int row_ = (base_) + 2 * w + t; \
        const float* xs_ = (l == 0) ? (row_ < NTOK_C ? a.in[I_CTX] + (size_t)row_ * D : a.in[I_X] + (size_t)(row_ - NTOK_C) * D) : X + (size_t)row_ * D; \
        _Pragma("unroll") for (int j = 0; j < 4; ++j) { xv[t][j] = *(const f32x4*)(xs_ + j * 256 + 4 * lane); tv[t][j] = *(const f32x4*)(TMP + (size_t)row_ * D + j * 256 + 4 * lane); } } } while (0)
    constexpr int CAP = 112;
    LAS unsigned* lcnt = (LAS unsigned*)(lds + 82176);
    LAS int* ent = (LAS int*)(lds + 82176 + 256);
    LAS float* entw = (LAS float*)(lds + 82176 + 256 + CAP * 256);
    if (tid < 32) lcnt[tid] = 0u;
    int base = row_lo + bid * 16, base0 = base, nb = 0;
#define LN1_FLUSH do { __syncthreads(); \
        if (tid < 32) { const unsigned n_ = lcnt[tid]; unsigned g_ = 0u; if (n_) g_ = atomicAdd(cnt + tid * 64, n_); lcnt[32 + tid] = g_; lcnt[tid] = 0u; } \
        __syncthreads(); \
        for (int idx = tid; idx < nb * 64; idx += 512) { const int pe_ = ent[idx], ee_ = pe_ >> 20; const unsigned pos_ = lcnt[32 + ee_] + (unsigned)(pe_ & 0xfffff); \
            const int row_ = base0 + (idx >> 6) * nblk * 16 + ((idx >> 2) & 15); \
            LIST[(size_t)ee_ * NTOK + pos_] = row_; TOPE[(size_t)row_ * 4 + (idx & 3)] = (ee_ << 20) | (int)pos_; TOPW[(size_t)row_ * 4 + (idx & 3)] = entw[idx]; } \
        __syncthreads(); nb = 0; } while (0)
    if (base < NTOK) LN1_FETCH(base);
    bf16x8 Bh[4][2], Bl[4][2];
#pragma unroll
    for (int ss = 0; ss < 4; ++ss)
#pragma unroll
        for (int t = 0; t < 2; ++t) { const size_t wo = (size_t)(16 * t + fr) * D + 128 * w + 32 * ss + 8 * kg; Bh[ss][t] = *(const bf16x8*)(wh + wo); Bl[ss][t] = *(const bf16x8*)(wl + wo); }
    const float bre = br[e];
#pragma unroll 1
    for (; base < NTOK; base += nblk * 16) {
#pragma unroll
        for (int t = 0; t < 2; ++t) {
            const int row = base + 2 * w + t;
            const float* mv = MOD + (size_t)mod_vec(row) * 6144;
            f32x4 v[4]; float s = 0.f;
#pragma unroll
            for (int j = 0; j < 4; ++j) { const int c0 = j * 256 + 4 * lane; const f32x4 g1 = *(const f32x4*)(mv + 2048 + c0);
                v[j] = DN_ALPHA * xv[t][j] + g1 * tv[t][j]; s += (v[j][0] + v[j][1]) + (v[j][2] + v[j][3]); }
            const float mean = wave_sum(s) * (1.f / D); float s2 = 0.f;
#pragma unroll
            for (int j = 0; j < 4; ++j) { v[j] = v[j] - mean; s2 += (v[j][0] * v[j][0] + v[j][1] * v[j][1]) + (v[j][2] * v[j][2] + v[j][3] * v[j][3]); }
            const float rstd = rsqrtf(wave_sum(s2) * (1.f / D) + LN_EPS);
#pragma unroll
            for (int j = 0; j < 4; ++j) { const int c0 = j * 256 + 4 * lane; const f32x4 g = *(const f32x4*)(lg + c0), bb = *(const f32x4*)(lb + c0), sh = *(const f32x4*)(mv + 3072 + c0), sc = *(const f32x4*)(mv + 4096 + c0);
                const f32x4 xn = v[j] * rstd * g + bb; *(f32x4*)(X + (size_t)row * D + c0) = xn;
                const f32x4 hh = xn * (1.f + sc) + sh;
                *(unsigned*)(a.ws + WS_HB8 + (size_t)row * D + c0) = pk4_fp8(4.f * hh[0], 4.f * hh[1], 4.f * hh[2], 4.f * hh[3]);
                *(LAS f32x4*)(hrow + (2 * w + t) * 1028 + c0) = hh; }
        }
        __syncthreads();
        if (base + nblk * 16 < NTOK) LN1_FETCH(base + nblk * 16);
        {
            f32x4 acc[2] = {(f32x4){0.f, 0.f, 0.f, 0.f}, (f32x4){0.f, 0.f, 0.f, 0.f}};
#pragma unroll
            for (int ss = 0; ss < 4; ++ss) { const int k0 = 128 * w + 32 * ss + 8 * kg;
                const f32x4 h0 = *(const LAS f32x4*)(hrow + fr * 1028 + k0), h1 = *(const LAS f32x4*)(hrow + fr * 1028 + k0 + 4);
                u32x4 ah, al;
                ah.x = pk2(h0[0], h0[1]); ah.y = pk2(h0[2], h0[3]); ah.z = pk2(h1[0], h1[1]); ah.w = pk2(h1[2], h1[3]);
                al.x = pk2(h0[0] - lo_bf(ah.x), h0[1] - hi_bf(ah.x)); al.y = pk2(h0[2] - lo_bf(ah.y), h0[3] - hi_bf(ah.y)); al.z = pk2(h1[0] - lo_bf(ah.z), h1[1] - hi_bf(ah.z)); al.w = pk2(h1[2] - lo_bf(ah.w), h1[3] - hi_bf(ah.w));
                const bf16x8 Ah = __builtin_bit_cast(bf16x8, ah), Al = __builtin_bit_cast(bf16x8, al);
#pragma unroll
                for (int t = 0; t < 2; ++t) {
                    acc[t] = __builtin_amdgcn_mfma_f32_16x16x32_bf16(Ah, Bh[ss][t], acc[t], 0, 0, 0);
                    acc[t] = __builtin_amdgcn_mfma_f32_16x16x32_bf16(Ah, Bl[ss][t], acc[t], 0, 0, 0);
                    acc[t] = __builtin_amdgcn_mfma_f32_16x16x32_bf16(Al, Bh[ss][t], acc[t], 0, 0, 0); } }
#pragma unroll
            for (int t = 0; t < 2; ++t)
#pragma unroll
                for (int j = 0; j < 4; ++j) part[((w * 2 + t) * 16 + 4 * kg + j) * 16 + fr] = acc[t][j];
        }
        __syncthreads();
        {
            float cur = bre;
#pragma unroll
            for (int ww = 0; ww < 8; ++ww) cur += part[((ww * 2 + (e >> 4)) * 16 + 2 * w + par) * 16 + (e & 15)];
            float tvv[4]; int ti[4];
#pragma unroll
            for (int k = 0; k < 4; ++k) { float bv = cur; int bi = e;
#define TOPSTEP(OV, OI) do { const float ov = (OV); const int oi = (OI); if (ov > bv || (ov == bv && oi < bi)) { bv = ov; bi = oi; } } while (0)
                TOPSTEP(dpp_f<0xB1>(bv), dpp_i<0xB1>(bi)); TOPSTEP(dpp_f<0x4E>(bv), dpp_i<0x4E>(bi)); TOPSTEP(dpp_f<0x141>(bv), dpp_i<0x141>(bi)); TOPSTEP(dpp_f<0x140>(bv), dpp_i<0x140>(bi));
                TOPSTEP(__shfl_xor(bv, 16), __shfl_xor(bi, 16));
#undef TOPSTEP
                tvv[k] = bv; ti[k] = bi; if (e == bi) cur = -3.0e38f; }
            const float e1 = __expf(tvv[1] - tvv[0]), e2 = __expf(tvv[2] - tvv[0]), e3 = __expf(tvv[3] - tvv[0]); const float inv = 1.f / (1.f + e1 + e2 + e3);
            if (e < 4) {
                const int ee = e == 0 ? ti[0] : e == 1 ? ti[1] : e == 2 ? ti[2] : ti[3]; const float ww = (e == 0 ? 1.f : e == 1 ? e1 : e == 2 ? e2 : e3) * inv;
                const unsigned lp = __hip_atomic_fetch_add(lcnt + ee, 1u, __ATOMIC_RELAXED, __HIP_MEMORY_SCOPE_WORKGROUP);
                const int idx = nb * 64 + w * 8 + par * 4 + e;
                ent[idx] = (ee << 20) | (int)lp; entw[idx] = ww; }
        }
        ++nb;
        if (nb == CAP) { LN1_FLUSH; base0 = base + nblk * 16; }
    }
    if (nb > 0) LN1_FLUSH;
#undef LN1_FLUSH
#undef LN1_FETCH
}
__device__ __forceinline__ void moe_tables(CArgs& a, int l, LAS unsigned char* lds, int NT) {
    LAS int* pre = (LAS int*)(lds + TAB_OFF); LAS int* mtl = pre + 40; LAS int* rowoff = pre + 80; LAS int* cn = pre + 120;
    if (tidx() == 0) { const unsigned* cnt = (const unsigned*)(a.ws + WS_CTL) + CW_CNT + l * NEXP * 64; int p = 0, r = 0;
        for (int e = 0; e < NEXP; ++e) { const int n = (int)__hip_atomic_load(cnt + e * 64, __ATOMIC_RELAXED, __HIP_MEMORY_SCOPE_AGENT), m = (n + 255) >> 8; pre[e] = p; mtl[e] = m > 0 ? m : 1; rowoff[e] = r; cn[e] = n; p += m * NT; r += m * 256; }
        pre[32] = p; }
    __syncthreads();
}
__device__ __forceinline__ void ph_ln2(CArgs& a, int l, LAS unsigned char* lds, int gw, int ngw) {
    const int lane = tidx() & 63;
    const float* MOD = (const float*)(a.ws + WS_MOD) + (size_t)l * 17 * 6144;
    float* X = (float*)(a.ws + WS_X); const bf16* YD = (const bf16*)(a.ws + WS_YD); bf16* HB = (bf16*)(a.ws + WS_HB);
    const float* lg = a.in[I_LN2G] + l * D; const float* lb = a.in[I_LN2B] + l * D;
    const int* TOPE = (const int*)(a.ws + WS_TOPE); const float* TOPW = (const float*)(a.ws + WS_TOPW);
    const LAS int* rowoff = (const LAS int*)(lds + TAB_OFF) + 80;
    const bool lastl = (l == DEPTH - 1);
    const int row_lo = lastl ? NTOK_C : 0;
#pragma unroll 1
    for (int row0 = row_lo + gw * 2; row0 < NTOK; row0 += ngw * 2) {
        u32x2 y2[2][4][4]; float tw[2][4]; f32x4 xv[2][4], g2v[2][4];
#pragma unroll
        for (int r = 0; r < 2; ++r) {
            const int row = row0 + r;
#pragma unroll
            for (int k = 0; k < 4; ++k) { const int te = TOPE[(size_t)row * 4 + k]; tw[r][k] = TOPW[(size_t)row * 4 + k];
                const bf16* yr = YD + ((size_t)(rowoff[te >> 20] + (te & 0xfffff))) * D;
#pragma unroll
                for (int j = 0; j < 4; ++j) y2[r][k][j] = *(const u32x2*)(yr + j * 256 + 4 * lane); }
            const float* mv = MOD + (size_t)mod_vec(row) * 6144;
#pragma unroll
            for (int j = 0; j < 4; ++j) { const int c0 = j * 256 + 4 * lane; xv[r][j] = *(const f32x4*)(X + (size_t)row * D + c0); g2v[r][j] = *(const f32x4*)(mv + 5120 + c0); }
        }
#pragma unroll
        for (int r = 0; r < 2; ++r) {
            const int row = row0 + r;
            const float* mv = MOD + (size_t)mod_vec(row) * 6144;
            f32x4 v[4]; float s = 0.f;
#pragma unroll
            for (int j = 0; j < 4; ++j) { f32x4 f = (f32x4){0.f, 0.f, 0.f, 0.f};
#pragma unroll
                for (int k = 0; k < 4; ++k) { const u32x2 yy = y2[r][k][j]; f += tw[r][k] * (f32x4){lo_bf(yy.x), hi_bf(yy.x), lo_bf(yy.y), hi_bf(yy.y)}; }
                v[j] = DN_ALPHA * xv[r][j] + g2v[r][j] * f; s += (v[j][0] + v[j][1]) + (v[j][2] + v[j][3]); }
            const float mean = wave_sum(s) * (1.f / D); float s2 = 0.f;
#pragma unroll
            for (int j = 0; j < 4; ++j) { v[j] = v[j] - mean; s2 += (v[j][0] * v[j][0] + v[j][1] * v[j][1]) + (v[j][2] * v[j][2] + v[j][3] * v[j][3]); }
            const float rstd = rsqrtf(wave_sum(s2) * (1.f / D) + LN_EPS);
            const float* mvn = mv + 17 * 6144;
#pragma unroll
            for (int j = 0; j < 4; ++j) { const int c0 = j * 256 + 4 * lane; const f32x4 g = *(const f32x4*)(lg + c0), bb = *(const f32x4*)(lb + c0);
                const f32x4 xn = v[j] * rstd * g + bb;
                if (lastl) *(f32x4*)(a.out + (size_t)(row - NTOK_C) * D + c0) = xn;
                else { *(f32x4*)(X + (size_t)row * D + c0) = xn; const f32x4 sh = *(const f32x4*)(mvn + c0), sc = *(const f32x4*)(mvn + 1024 + c0); const f32x4 hh = xn * (1.f + sc) + sh;
                    u32x2 o; o.x = pk2(hh[0], hh[1]); o.y = pk2(hh[2], hh[3]); *(u32x2*)(HB + (size_t)row * D + c0) = o; } }
        }
    }
}

constexpr int NPH = 2 + DEPTH * 9;
__device__ __forceinline__ CArgs* kargs() { CArgs* p = (CArgs*)__builtin_amdgcn_kernarg_segment_ptr(); asm volatile("" : "+s"(p)); return p; }
__global__ void __launch_bounds__(512, 2) trunk_fwd(Args a_unused) {
    extern __shared__ __attribute__((aligned(16))) unsigned char lds_raw[];
    LAS unsigned char* lds = (LAS unsigned char*)lds_raw;
    const int tid = threadIdx.x, wave = __builtin_amdgcn_readfirstlane(tid >> 6);
    const int bid = blockIdx.x, nblk = gridDim.x, gw = bid * 8 + wave, ngw = nblk * 8;
    volatile LAS unsigned* MISC = (volatile LAS unsigned*)(lds + MISC_OFF);
    if (tid < 64) MISC[tid] = 0u;
    __syncthreads();
    XcdBarrier bar; bar.x = 0; bar.st = nullptr;
    int lo, hi;
    { CArgs& a = *kargs(); lo = a.ph_lo; hi = a.ph_hi; bar.bar = (unsigned*)(a.ws + WS_CTL) + CW_BAR;
      if (hi - lo > 1) bar = xcd_barrier_post((unsigned*)(a.ws + WS_CTL) + CW_BAR, MISC); }
#define IN(k) (lo <= (k) && (k) < hi)
    unsigned long long tacc = 0ull, tbeg = 0ull;
#define PB_BEG(ty) do { if (PROBE_PH == (ty)) tbeg = __builtin_amdgcn_s_memrealtime(); } while (0)
#define PB_END(ty) do { if (PROBE_PH == (ty)) tacc += __builtin_amdgcn_s_memrealtime() - tbeg; } while (0)
#define SEAM(k) do { if (IN(k) && IN((k) + 1)) xcd_barrier(bar); } while (0)
    PB_BEG(0);
    if (IN(0)) { CArgs& a = *kargs(); unsigned long long t0 = 0ull;
#define PB_SUB(ty, stmt) do { if (PROBE_PH == (ty)) t0 = __builtin_amdgcn_s_memrealtime(); stmt; if (PROBE_PH == (ty)) tacc += __builtin_amdgcn_s_memrealtime() - t0; } while (0)
        PB_SUB(30, ph_mod(a, lds, bid, nblk)); __syncthreads(); PB_SUB(31, ph_filters(a, gw, ngw)); PB_SUB(32, ph_tr_small(a, lds, gw, ngw)); PB_SUB(33, ph_router_w(a, bid * 512 + tid, nblk * 512));
#undef PB_SUB
    }
    SEAM(0); PB_END(0); PB_BEG(1);
    if (IN(1)) { CArgs& a = *kargs(); ph_mod_input(a, gw, ngw); }
    SEAM(1); PB_END(1);
#pragma unroll 1
    for (int l = 0; l < DEPTH; ++l) {
        const int p0 = 2 + 9 * l;
        const bool lastl = (l == DEPTH - 1);
        PB_BEG(2);
        if (IN(p0 + 0)) {
            CArgs& a = *kargs();
            pg8::DenseSched S; S.init((const bf16*)(a.ws + WS_WIN) + (size_t)l * D_INP * 1024, 1024, NTOK, D_INP, nblk, bid, 0);
            pg8::EpiBf16 E{(bf16*)(a.ws + WS_P), D_INP, 0};
            pg8::gemm_phase<pg8::EpiBf16, pg8::DenseSched, true>(lds, (const char*)(a.ws + WS_HB), 1024, S, E);
        }
        SEAM(p0 + 0); PB_END(2); PB_BEG(3);
        if (IN(p0 + 1)) { CArgs& a = *kargs(); ph_prep_conv(a, l, lds, bid, nblk); ph_prep_tok(a, l, gw, ngw); }
        SEAM(p0 + 1); PB_END(3); PB_BEG(4);
        if (IN(p0 + 2)) { CArgs& a = *kargs(); ph_scan(a, l, lds, bid, nblk, tacc); }
        SEAM(p0 + 2); PB_END(4); PB_BEG(5);
        if (IN(p0 + 3)) { CArgs& a = *kargs(); ph_post_hyena(a, l, lds, bid, nblk); ph_post_tok(a, l, gw, ngw); }
        SEAM(p0 + 3); PB_END(5); PB_BEG(6);
        if (IN(p0 + 4)) {
            CArgs& a = *kargs();
            const int r0 = lastl ? NTOK_C : 0;
            pg8::DenseSched S; S.init((const bf16*)(a.ws + WS_WOUT) + (size_t)l * 1024 * 1024, 1024, NTOK - r0, 1024, nblk, bid, r0);
            pg8::EpiF32 E{(float*)(a.ws + WS_TMP), 1024, r0};
            pg8::gemm_phase<pg8::EpiF32, pg8::DenseSched, true>(lds, (const char*)(a.ws + WS_YMIX), 1024, S, E);
        }
        SEAM(p0 + 4); PB_END(6); PB_BEG(7);
        if (IN(p0 + 5)) { CArgs& a = *kargs(); ph_ln1_route(a, l, lds, bid, nblk); }
        SEAM(p0 + 5); PB_END(7); PB_BEG(8);
        if (IN(p0 + 6)) {
            CArgs& a = *kargs();
            moe_tables(a, l, lds, 8);
            const LAS int* tb = (const LAS int*)(lds + TAB_OFF);
            pg8::MoeSched<true, 8> S; S.Bt = (const char*)(a.ws + WS_WGU); S.bstride = (size_t)2048 * 1024; S.rb = 1024; S.list = (const int*)(a.ws + WS_LIST);
            S.pre = tb; S.mtl = tb + 40; S.rowoff = tb + 80; S.cnt = tb + 120; S.K = 1024; S.G = nblk; S.c = (nblk % 8 == 0) ? (bid % 8) * (nblk / 8) + bid / 8 : bid; S.total = tb[32];
            pg8::EpiSwiglu E{(bf16*)(a.ws + WS_H), a.in[I_BG] + (size_t)l * NEXP * 1024, a.in[I_BU] + (size_t)l * NEXP * 1024, tb + 80, 1.f / 128.f};
            pg8::gemm_phase_f8g<pg8::EpiSwiglu, pg8::MoeSched<true, 8>, true>(lds, (const char*)(a.ws + WS_HB8), 1024, S, E);
        }
        SEAM(p0 + 6); PB_END(8); PB_BEG(9);
        if (IN(p0 + 7)) {
            CArgs& a = *kargs();
            moe_tables(a, l, lds, 4);
            const LAS int* tb = (const LAS int*)(lds + TAB_OFF);
            pg8::MoeSched<false, 4> S; S.Bt = (const char*)(a.ws + WS_WD); S.bstride = (size_t)1024 * 1024; S.rb = 1024; S.list = nullptr;
            S.pre = tb; S.mtl = tb + 40; S.rowoff = tb + 80; S.cnt = tb + 120; S.K = 1024; S.G = nblk; S.c = (nblk % 8 == 0) ? (bid % 8) * (nblk / 8) + bid / 8 : bid; S.total = tb[32];
            pg8::EpiDown E{(bf16*)(a.ws + WS_YD), a.in[I_BD] + (size_t)l * NEXP * 1024, tb + 80, 1.f / 128.f};
            pg8::gemm_phase_f8<pg8::EpiDown, pg8::MoeSched<false, 4>, true>(lds, (const char*)(a.ws + WS_H), 1024, S, E);
        }
        SEAM(p0 + 7); PB_END(9); PB_BEG(10);
        if (IN(p0 + 8)) { CArgs& a = *kargs(); moe_tables(a, l, lds, 4); ph_ln2(a, l, lds, gw, ngw); }
        if (!lastl) SEAM(p0 + 8);
        PB_END(10);
    }
    if (PROBE_PH >= 0) { const unsigned long long t0 = __builtin_amdgcn_s_memrealtime(); while (__builtin_amdgcn_s_memrealtime() - t0 < tacc) __builtin_amdgcn_s_sleep(8); }
#undef IN
#undef SEAM
}

extern "C" void kernel_launch(void* const* d_in, const int* in_sizes, int n_in, void* d_out, int out_size, void* d_ws, size_t ws_size, hipStream_t stream) {
    static int grid = 0;
    if (grid == 0) {
        if (n_in != 39 || out_size != NTOK_L * D || ws_size < WS_END) { fprintf(stderr, "kernel_launch: unexpected problem (n_in %d, out %d, ws %zu < %zu)\n", n_in, out_size, ws_size, (size_t)WS_END); grid = -1; return; }
        int dev = 0, cus = 0, per_cu = 0;
        if (hipGetDevice(&dev) != hipSuccess || hipDeviceGetAttribute(&cus, hipDeviceAttributeMultiprocessorCount, dev) != hipSuccess) { grid = -1; return; }
        if (hipFuncSetAttribute((const void*)trunk_fwd, hipFuncAttributeMaxDynamicSharedMemorySize, LDS_BYTES) != hipSuccess) { fprintf(stderr, "kernel_launch: hipFuncSetAttribute failed\n"); grid = -1; return; }
        if (hipOccupancyMaxActiveBlocksPerMultiprocessor(&per_cu, (const void*)trunk_fwd, 512, LDS_BYTES) != hipSuccess || per_cu < 1) fprintf(stderr, "kernel_launch: occupancy query says %d\n", per_cu);
        (void)hipGetLastError();
        grid = cus;
    }
    if (grid < 0) return;
    (void)hipMemsetAsync((char*)d_ws + WS_CTL, 0, CTL_ZERO_BYTES, stream);
    Args a{};
    for (int i = 0; i < 39; ++i) a.in[i] = (const float*)d_in[i];
    a.out = (float*)d_out; a.ws = (unsigned char*)d_ws;
#if MK_FUSED
    a.ph_lo = 0; a.ph_hi = NPH;
    hipLaunchKernelGGL(trunk_fwd, dim3(grid), dim3(512), LDS_BYTES, stream, a);
#else
    for (int p = 0; p < NPH; ++p) { a.ph_lo = p; a.ph_hi = p + 1; hipLaunchKernelGGL(trunk_fwd, dim3(grid), dim3(512), LDS_BYTES, stream, a); }
#endif
}
```

```cpp
#include <hip/hip_runtime.h>
#include <cstdio>
#include <cstdint>

#ifndef MK_FUSED
#define MK_FUSED 1
#endif

#ifndef USE_NEW_GDN
#define USE_NEW_GDN 1
#endif
#ifndef USE_NEW_GLA
#define USE_NEW_GLA 1
#endif
#ifndef PROBE_PH
#define PROBE_PH -1
#endif

#define LAS __attribute__((address_space(3)))
#define GAS __attribute__((address_space(1)))
typedef unsigned short bf16;
typedef short bf16x8 __attribute__((ext_vector_type(8)));
typedef float f32x4 __attribute__((ext_vector_type(4)));
typedef float f32x2 __attribute__((ext_vector_type(2)));
typedef unsigned u32x4 __attribute__((ext_vector_type(4)));
typedef unsigned u32x2 __attribute__((ext_vector_type(2)));

constexpr int D = 1024, NB = 16, SEQ = 2048, CTXL = 256, DEPTH = 4;
constexpr int NTOK_C = NB * CTXL, NTOK_L = NB * SEQ, NTOK = NTOK_C + NTOK_L;
constexpr int D_IN = 3376, D_INP = 3584;
constexpr int HY0 = 0, SC0 = 768, GLA0 = 1536, GDN0 = 2336;
constexpr int NEXP = 32, TOPK = 4;
constexpr int MAXROWS = NTOK * TOPK + NEXP * 256;
constexpr float DN_ALPHA = 1.681792830507429f;
constexpr float LN_EPS = 1e-5f;

constexpr size_t MiB = 1u << 20;
constexpr size_t WS_CTL = 0, CTL_ZERO_BYTES = 1 * MiB;
constexpr size_t WS_MOD = 1 * MiB;
constexpr size_t WS_WRT = 3 * MiB;
constexpr size_t WS_KUN = 4 * MiB;
constexpr size_t WS_WIN = 36 * MiB;
constexpr size_t WS_WOUT = 64 * MiB;
constexpr size_t WS_WGU = 72 * MiB;
constexpr size_t WS_WD = 200 * MiB;
constexpr size_t WS_X = 264 * MiB;
constexpr size_t WS_HB = 408 * MiB;
constexpr size_t WS_P = 480 * MiB;
constexpr size_t WS_YMIX = 732 * MiB;
constexpr size_t WS_YD = WS_P;
constexpr size_t WS_TMP = 804 * MiB;
constexpr size_t WS_LIST = 948 * MiB;
constexpr size_t WS_TOPE = 953 * MiB;
constexpr size_t WS_TOPW = 954 * MiB;
constexpr size_t WS_H = 956 * MiB;
constexpr size_t WS_MIX = 1264 * MiB;
constexpr size_t MX_ZT = 0;
constexpr size_t MX_YT = 20 * MiB;
constexpr size_t MX_GDF = 56 * MiB, MX_GDB = 76 * MiB;
constexpr size_t MX_GOF = 96 * MiB, MX_GOB = 132 * MiB;
constexpr size_t MX_DQ = 168 * MiB, MX_DK = 204 * MiB, MX_DV = 240 * MiB;
constexpr size_t MX_DG = 276 * MiB;
constexpr size_t MX_DOF = 280 * MiB, MX_DOB = 316 * MiB;
constexpr size_t WS_HB8 = 1616 * MiB;
constexpr size_t WS_END = 1980 * MiB;
constexpr int NUNIT = 128 * 36;
constexpr size_t WS_CKD = 1656 * MiB;
constexpr size_t CD_M = 0;
constexpr size_t CD_E = 36 * MiB;
constexpr size_t CD_BT = 72 * MiB;
constexpr size_t CD_FT = 144 * MiB;
constexpr size_t CD_KB = 180 * MiB, CD_QB = 198 * MiB;
constexpr size_t WS_CKA = WS_CKD + 216 * MiB;
constexpr size_t CA_QC = 0;
constexpr size_t CA_FT = 20 * MiB;
constexpr size_t CA_UT = 60 * MiB;
constexpr size_t CA_DL = 100 * MiB;
static_assert(WS_CKA + CA_DL + (size_t)NUNIT * 32 * 4 <= WS_END, "chunk data");
static_assert((size_t)MAXROWS * 1024 * 2 <= 324 * MiB, "YD overlay");
static_assert(WS_H + (size_t)MAXROWS * 1024 * 2 <= WS_MIX, "H");
constexpr int CW_BAR = 4096;
constexpr int CW_CNT = 16384;

constexpr int LDS_BYTES = 147456;
constexpr int MISC_OFF = 143360;
constexpr int TAB_OFF = 143360 + 256;

__device__ __forceinline__ float bf2f(unsigned v) { return __uint_as_float(v << 16); }
__device__ __forceinline__ unsigned f2bf(float f) { unsigned u = __float_as_uint(f); return (u + 0x7fffu + ((u >> 16) & 1u)) >> 16; }
__device__ __forceinline__ unsigned pk2(float lo, float hi) { return f2bf(lo) | (f2bf(hi) << 16); }
__device__ __forceinline__ unsigned pk4_fp8(float a, float b, float c, float d) { int r = __builtin_amdgcn_cvt_pk_fp8_f32(a, b, 0, false); return (unsigned)__builtin_amdgcn_cvt_pk_fp8_f32(c, d, r, true); }
__device__ __forceinline__ float lo_bf(unsigned w) { return __uint_as_float(w << 16); }
__device__ __forceinline__ float hi_bf(unsigned w) { return __uint_as_float(w & 0xffff0000u); }
__device__ __forceinline__ float sigmoidf_(float x) { return 1.f / (1.f + __expf(-x)); }
__device__ __forceinline__ float siluf_(float x) { return x / (1.f + __expf(-x)); }
__device__ __forceinline__ float softplusf_(float x) { return x > 20.f ? x : log1pf(__expf(x)); }
__device__ __forceinline__ float logsigmoidf_(float x) { return x >= 0.f ? -log1pf(__expf(-x)) : x - log1pf(__expf(x)); }
__device__ __forceinline__ float sin_rev(float r) { return __builtin_amdgcn_sinf(__builtin_amdgcn_fractf(r)); }
__device__ __forceinline__ float sin_rad(float x) { return sin_rev(x * 0.15915494309189535f); }
template <int CTRL> __device__ __forceinline__ float dpp_f(float v) { return __builtin_bit_cast(float, __builtin_amdgcn_update_dpp(0, __builtin_bit_cast(int, v), CTRL, 0xf, 0xf, true)); }
template <int CTRL> __device__ __forceinline__ int dpp_i(int v) { return __builtin_amdgcn_update_dpp(0, v, CTRL, 0xf, 0xf, true); }
__device__ __forceinline__ float quad_sum(float v) { v += dpp_f<0xB1>(v); v += dpp_f<0x4E>(v); return v; }
__device__ __forceinline__ float row16_sum(float v) { v += dpp_f<0xB1>(v); v += dpp_f<0x4E>(v); v += dpp_f<0x141>(v); v += dpp_f<0x140>(v); return v; }
__device__ __forceinline__ float rdlane_f(float v, int l) { return __builtin_bit_cast(float, __builtin_amdgcn_readlane(__builtin_bit_cast(int, v), l)); }
__device__ __forceinline__ float wave_sum(float v) {
    v = row16_sum(v);
    return (rdlane_f(v, 0) + rdlane_f(v, 16)) + (rdlane_f(v, 32) + rdlane_f(v, 48));
}
__device__ __forceinline__ int tidx() { int t = threadIdx.x; asm volatile("" : "+v"(t)); return t; }

#define XB_TMO      128
#define XB_XCNT(j)  (256  + 64 * (j))
#define XB_XSUB(j)  (1280 + 64 * (j))
#define XB_XGEN(j)  (2304 + 64 * (j))
#define XB_TOP      3328
#define XB_TOPGEN   3392
#define XCD_BAR_WORDS 3456
#define XB_SPIN_CAP (1u << 25)
__device__ __forceinline__ unsigned xb_ld(unsigned* p)              { return __hip_atomic_load(p, __ATOMIC_RELAXED, __HIP_MEMORY_SCOPE_AGENT); }
__device__ __forceinline__ unsigned xb_add(unsigned* p, unsigned v) { return __hip_atomic_fetch_add(p, v, __ATOMIC_RELAXED, __HIP_MEMORY_SCOPE_AGENT); }
__device__ __forceinline__ unsigned xb_xcc_id() { return (unsigned)__builtin_amdgcn_s_getreg((3 << 11) | 20) & 0xFu; }
#define XB_SPIN(cond, bar) do { unsigned _sp = 0; while (cond) { __builtin_amdgcn_s_sleep(1); \
    if ((++_sp & 255u) == 0u) { if (xb_ld(&(bar)[XB_TMO])) break; if (_sp > XB_SPIN_CAP) { atomicAdd(&(bar)[XB_TMO], 1u); break; } } } } while (0)
struct XcdBarrier { unsigned* bar; unsigned x; volatile LAS unsigned* st; };
__device__ __forceinline__ XcdBarrier xcd_barrier_post(unsigned* bar, volatile LAS unsigned* st) {
    XcdBarrier b; b.bar = bar; b.x = xb_xcc_id(); b.st = st;
    if (threadIdx.x == 0) (void)xb_add(&bar[XB_XCNT(b.x)], 1u);
    return b;
}
__device__ __forceinline__ void xcd_barrier_complete(unsigned* bar, unsigned x, unsigned& nloc, unsigned& nx) {
    const unsigned G = gridDim.x * gridDim.y * gridDim.z;
    unsigned sum, cnt, mine, sp = 0u;
    for (;;) {
        sum = 0u; cnt = 0u; mine = 0u;
#pragma unroll
        for (unsigned j = 0; j < 16; ++j) { const unsigned c = xb_ld(&bar[XB_XCNT(j)]); sum += c; cnt += (c > 0u) ? 1u : 0u; mine = (j == x) ? c : mine; }
        if (sum == G) break;
        __builtin_amdgcn_s_sleep(1);
        if ((++sp & 255u) == 0u) { if (xb_ld(&bar[XB_TMO])) break; if (sp > XB_SPIN_CAP) { atomicAdd(&bar[XB_TMO], 1u); break; } }
    }
    nloc = mine > 0u ? mine : 1u; nx = cnt > 0u ? cnt : 1u;
}
__device__ __forceinline__ void xcd_barrier(const XcdBarrier& b) {
    asm volatile("s_waitcnt vmcnt(0)" ::: "memory");
    __syncthreads();
    if (threadIdx.x == 0) {
        unsigned* bar = b.bar;
        __builtin_amdgcn_s_waitcnt(0);
        unsigned nloc = b.st[0], nx = b.st[1];
        if (nloc == 0u) { xcd_barrier_complete(bar, b.x, nloc, nx); b.st[0] = nloc; b.st[1] = nx; }
        const unsigned old = xb_add(&bar[XB_XSUB(b.x)], 1u);
        const unsigned gen = old / nloc;
        if (old + 1u == (gen + 1u) * nloc) {
            __builtin_amdgcn_fence(__ATOMIC_RELEASE, "agent");
            asm volatile("s_waitcnt vmcnt(0)" ::: "memory");
            const unsigned og = xb_add(&bar[XB_TOP], 1u);
            const unsigned tg = og / nx;
            if (og + 1u == (tg + 1u) * nx) xb_add(&bar[XB_TOPGEN], 1u);
            else XB_SPIN(xb_ld(&bar[XB_TOPGEN]) == tg, bar);
            __builtin_amdgcn_fence(__ATOMIC_ACQUIRE, "agent");
            xb_add(&bar[XB_XGEN(b.x)], 1u);
            asm volatile("s_waitcnt vmcnt(0)" ::: "memory");
        } else {
            XB_SPIN(xb_ld(&bar[XB_XGEN(b.x)]) == gen, bar);
            __builtin_amdgcn_fence(__ATOMIC_ACQUIRE, "agent");
            asm volatile("s_waitcnt vmcnt(0)" ::: "memory");
        }
    }
    __syncthreads();
}

namespace pg8 {
constexpr int BM = 256, BK = 64, HALF = 128, HTB = HALF * BK * 2, STAGE_BYTES = 8 * HTB, NXCD = 8, WGM = 8;
__host__ __device__ __forceinline__ int lds_byte(int r, int c) { const int st = (r >> 4) * 2 + (c >> 5), rr = r & 15, cc = c & 31, ob = rr * 64 + cc * 2; return st * 1024 + (ob ^ (((ob >> 9) & 1) << 5)); }
__host__ __device__ __forceinline__ void stage_rc(int b, int& R, int& C) { const int st = b / 1024, sb = b % 1024, swz = sb ^ (((sb >> 9) & 1) << 5); R = (st >> 1) * 16 + swz / 64; C = (st & 1) * 32 + (swz % 64) / 2; }
__host__ __device__ __forceinline__ int perm32(int rho) { const int n = rho >> 4, i = rho & 15; return 8 * (i >> 2) + 4 * n + (i & 3); }
__device__ __forceinline__ unsigned cvt_pk_bf16(float lo, float hi) { unsigned r; asm volatile("v_cvt_pk_bf16_f32 %0, %1, %2" : "=v"(r) : "v"(lo), "v"(hi)); return r; }

struct Unit { int pm, pn, e, mt; };

struct DenseSched {
    const char* Bt; int K, nM, nN, nwg, G, c, row0;
    __device__ __forceinline__ void init(const bf16* Bt_, int K_, int M, int N, int G_, int c_, int row0_) { Bt = (const char*)Bt_; K = K_; nM = M / BM; nN = N / BM; nwg = nM * nN; G = G_; c = c_; row0 = row0_; }
    __device__ __forceinline__ bool next(int i, Unit& u) const {
        const long L = (long)i * G + c; if (L >= nwg) return false;
        int wgid = (int)L; { const int q = nwg / NXCD, r = nwg % NXCD, xcd = wgid % NXCD, off = wgid / NXCD; wgid = (xcd < r ? xcd * (q + 1) : r * (q + 1) + (xcd - r) * q) + off; }
        const int nig = WGM * nN, gid = wgid / nig, fm = gid * WGM, gsz = (nM - fm) < WGM ? (nM - fm) : WGM;
        u.pm = fm + ((wgid % nig) % gsz); u.pn = (wgid % nig) / gsz; u.e = 0; u.mt = 0; return true;
    }
    __device__ __forceinline__ const char* b_ptr(const Unit& u) const { return Bt + (size_t)u.pn * (size_t)(BM * 2) * K; }
    __device__ __forceinline__ void a_offsets(const Unit& u, const int (&R)[2], const int (&C)[2], unsigned (&v)[2][2]) const {
#pragma unroll
        for (int h = 0; h < 2; ++h)
#pragma unroll
            for (int i = 0; i < 2; ++i) v[h][i] = (unsigned)((row0 + u.pm * BM + h * HALF + R[i]) * K + C[i]) * 2u;
    }
};
template <bool GATHER, int NT>
struct MoeSched {
    const char* Bt; size_t bstride;
    int rb;
    const int* list;
    const LAS int* pre; const LAS int* mtl; const LAS int* rowoff; const LAS int* cnt;
    int K, G, c, total;
    __device__ __forceinline__ bool next(int i, Unit& u) const {
        const int L = i * G + c; if (L >= total) return false;
        int e = 0;
#pragma unroll 1
        for (int j = 1; j < NEXP; ++j) e = (L >= pre[j]) ? j : e;
        const int rem = L - pre[e];
        u.e = e; u.pn = rem % NT; u.mt = rem / NT; u.pm = 0; return true;
    }
    __device__ __forceinline__ const char* b_ptr(const Unit& u) const { return Bt + (size_t)u.e * bstride + (size_t)u.pn * (size_t)BM * rb; }
    __device__ __forceinline__ const char* a_ptr(const Unit& u, const char* Abase) const { return Abase + (size_t)(rowoff[u.e] + u.mt * BM) * rb; }
    __device__ __forceinline__ void a_offsets(const Unit& u, const int (&R)[2], const int (&C)[2], unsigned (&v)[2][2]) const {
        if (GATHER) {
            const int n = cnt[u.e]; const int* lp = list + (size_t)u.e * NTOK;
#pragma unroll
            for (int h = 0; h < 2; ++h)
#pragma unroll
                for (int i = 0; i < 2; ++i) { const int idx = u.mt * BM + h * HALF + R[i]; const int tok = idx < n ? lp[idx] : 0; v[h][i] = (unsigned)(tok * rb + 2 * C[i]); }
        } else {
            const int r0 = rowoff[u.e] + u.mt * BM;
#pragma unroll
            for (int h = 0; h < 2; ++h)
#pragma unroll
                for (int i = 0; i < 2; ++i) v[h][i] = (unsigned)((r0 + h * HALF + R[i]) * K + C[i]) * 2u;
        }
    }
};

struct EpiBf16 {
    static constexpr bool PERM = true;
    bf16* O; int ldc; int row0;
    __device__ __forceinline__ void operator()(const f32x4 (&acc)[2][2][4][2], const Unit& u, int wr, int wc, int fr, int fq) const {
        const int r0 = row0 + u.pm * BM + wr * 64 + fr, col0 = u.pn * BM + wc * 32 + 8 * fq;
#pragma unroll
        for (int ai = 0; ai < 2; ++ai)
#pragma unroll
            for (int m = 0; m < 4; ++m) { bf16* rowp = O + (size_t)(r0 + ai * HALF + m * 16) * ldc + col0;
#pragma unroll
                for (int bj = 0; bj < 2; ++bj) { const f32x4 v0 = acc[ai][bj][m][0], v1 = acc[ai][bj][m][1];
                    u32x4 w; w.x = cvt_pk_bf16(v0[0], v0[1]); w.y = cvt_pk_bf16(v0[2], v0[3]); w.z = cvt_pk_bf16(v1[0], v1[1]); w.w = cvt_pk_bf16(v1[2], v1[3]);
                    *(u32x4*)(rowp + bj * HALF) = w; } }
    }
};
struct EpiF32 {
    static constexpr bool PERM = false;
    float* Cc; int ldc; int row0;
    __device__ __forceinline__ void operator()(const f32x4 (&acc)[2][2][4][2], const Unit& u, int wr, int wc, int fr, int fq) const {
        const int r0 = row0 + u.pm * BM + wr * 64 + fr, col0 = u.pn * BM + wc * 32 + 4 * fq;
#pragma unroll
        for (int ai = 0; ai < 2; ++ai)
#pragma unroll
            for (int m = 0; m < 4; ++m) { float* rowp = Cc + (size_t)(r0 + ai * HALF + m * 16) * ldc + col0;
#pragma unroll
                for (int bj = 0; bj < 2; ++bj)
#pragma unroll
                    for (int n = 0; n < 2; ++n) *(f32x4*)(rowp + bj * HALF + n * 16) = acc[ai][bj][m][n]; }
    }
};
struct EpiSwiglu {
    static constexpr bool PERM = true;
    bf16* H; const float* bg; const float* bu; const LAS int* rowoff; float ws;
    __device__ __forceinline__ void operator()(const f32x4 (&acc)[2][2][4][2], const Unit& u, int wr, int wc, int fr, int fq) const {
        const int r0 = rowoff[u.e] + u.mt * BM + wr * 64 + fr, j0 = u.pn * HALF + wc * 32 + 8 * fq;
        f32x4 gb[2], ub[2];
#pragma unroll
        for (int n = 0; n < 2; ++n) { gb[n] = *(const f32x4*)(bg + u.e * 1024 + j0 + 4 * n); ub[n] = *(const f32x4*)(bu + u.e * 1024 + j0 + 4 * n); }
#pragma unroll
        for (int ai = 0; ai < 2; ++ai)
#pragma unroll
            for (int m = 0; m < 4; ++m) { unsigned char* rowp = (unsigned char*)H + (size_t)(r0 + ai * HALF + m * 16) * 1024 + j0; float hv[8];
#pragma unroll
                for (int n = 0; n < 2; ++n)
#pragma unroll
                    for (int j = 0; j < 4; ++j) { float g = acc[ai][0][m][n][j] * ws + gb[n][j], up = acc[ai][1][m][n][j] * ws + ub[n][j];
                        g = fminf(g, 7.f); up = fminf(fmaxf(up, -7.f), 7.f);
                        hv[n * 4 + j] = (up + 1.f) * g * __builtin_amdgcn_rcpf(1.f + __expf(-1.702f * g)); }
                *(u32x2*)rowp = (u32x2){pk4_fp8(4.f * hv[0], 4.f * hv[1], 4.f * hv[2], 4.f * hv[3]), pk4_fp8(4.f * hv[4], 4.f * hv[5], 4.f * hv[6], 4.f * hv[7])}; }
    }
};
struct EpiDown {
    static constexpr bool PERM = true;
    bf16* Y; const float* bd; const LAS int* rowoff; float ws;
    __device__ __forceinline__ void operator()(const f32x4 (&acc)[2][2][4][2], const Unit& u, int wr, int wc, int fr, int fq) const {
        const int r0 = rowoff[u.e] + u.mt * BM + wr * 64 + fr, col0 = u.pn * BM + wc * 32 + 8 * fq;
        f32x4 bv[2][2];
#pragma unroll
        for (int bj = 0; bj < 2; ++bj)
#pragma unroll
            for (int n = 0; n < 2; ++n) bv[bj][n] = *(const f32x4*)(bd + u.e * 1024 + col0 + bj * HALF + 4 * n);
#pragma unroll
        for (int ai = 0; ai < 2; ++ai)
#pragma unroll
            for (int m = 0; m < 4; ++m) { bf16* rowp = Y + (size_t)(r0 + ai * HALF + m * 16) * 1024 + col0;
#pragma unroll
                for (int bj = 0; bj < 2; ++bj) { const f32x4 v0 = acc[ai][bj][m][0] * ws + bv[bj][0], v1 = acc[ai][bj][m][1] * ws + bv[bj][1];
                    u32x4 w; w.x = cvt_pk_bf16(v0[0], v0[1]); w.y = cvt_pk_bf16(v0[2], v0[3]); w.z = cvt_pk_bf16(v1[0], v1[1]); w.w = cvt_pk_bf16(v1[2], v1[3]);
                    *(u32x4*)(rowp + bj * HALF) = w; } }
    }
};

template <class Epi, class Sched, bool ALIGN_EPI>
__device__ __forceinline__ void gemm_phase(LAS unsigned char* lds, const char* Abase, const int K, const Sched& S, const Epi& E) {
    const int tid = tidx(), wid = __builtin_amdgcn_readfirstlane(tid >> 6), lane = tid & 63, wr = wid >> 2, wc = wid & 3, fr = lane & 15, fq = lane >> 4;
    const int nt = K / BK;
    int Rp[2], Cp[2]; unsigned voffB0;
#pragma unroll
    for (int i = 0; i < 2; ++i) stage_rc(tid * 16 + i * 8192, Rp[i], Cp[i]);
    { const int Rb = Epi::PERM ? ((Rp[0] & ~31) + perm32(Rp[0] & 31)) : Rp[0]; voffB0 = (unsigned)(Rb * K + Cp[0]) * 2u; }
    const size_t kstep = (size_t)(BK * 2);
    const size_t hstep = (size_t)HALF * K * 2;
    const unsigned ldsw = (unsigned)wid * 1024u;
    const int aoff = lds_byte(wr * 64 + fr, fq * 8), boff = lds_byte(wc * 32 + fr, fq * 8);
#define PG8_SA(b, h) (((b) * 2 + (h)) * HTB)
#define PG8_SB(b, h) ((4 + (b) * 2 + (h)) * HTB)
#define PG8_STAGE(bufoff, gbase, voff) do { _Pragma("unroll") for (int _i = 0; _i < 2; ++_i) \
        __builtin_amdgcn_global_load_lds((const unsigned*)((const char*)(gbase) + (voff)[_i]), (LAS unsigned*)(lds + (bufoff) + ldsw + _i * 8192), 16, 0, 0); } while (0)
#define PG8_STAGEB(bufoff, gbase) do { _Pragma("unroll") for (int _i = 0; _i < 2; ++_i) \
        __builtin_amdgcn_global_load_lds((const unsigned*)((const char*)(gbase) + (size_t)_i * 128 * K + voffB0), (LAS unsigned*)(lds + (bufoff) + ldsw + _i * 8192), 16, 0, 0); } while (0)
#define PG8_LDA(dst, b, h) do { _Pragma("unroll") for (int m = 0; m < 4; ++m) _Pragma("unroll") for (int k = 0; k < 2; ++k) dst[m][k] = *(const LAS bf16x8*)(lds + PG8_SA(b, h) + aoff + m * 2048 + k * 1024); } while (0)
#define PG8_LDB(dst, b, h) do { _Pragma("unroll") for (int n = 0; n < 2; ++n) _Pragma("unroll") for (int k = 0; k < 2; ++k) dst[n][k] = *(const LAS bf16x8*)(lds + PG8_SB(b, h) + boff + n * 2048 + k * 1024); } while (0)
#define PG8_MMA(ai, bj, At, Bt) do { __builtin_amdgcn_s_setprio(1); _Pragma("unroll") for (int m = 0; m < 4; ++m) _Pragma("unroll") for (int n = 0; n < 2; ++n) _Pragma("unroll") for (int k = 0; k < 2; ++k) \
        acc[ai][bj][m][n] = __builtin_amdgcn_mfma_f32_16x16x32_bf16(Bt[n][k], At[m][k], acc[ai][bj][m][n], 0, 0, 0); __builtin_amdgcn_s_setprio(0); } while (0)
#define PG8_WAIT_V(n) asm volatile("s_waitcnt vmcnt(" #n ")" ::: "memory")
#define PG8_WAIT_L(n) asm volatile("s_waitcnt lgkmcnt(" #n ")" ::: "memory")
#define PG8_BAR __builtin_amdgcn_s_barrier()
#define PG8_SCHED __builtin_amdgcn_sched_barrier(0)
    Unit cur, nxt; int ui = 0;
    if (!S.next(0, cur)) return;
    f32x4 acc[2][2][4][2];
#pragma unroll
    for (int a = 0; a < 2; ++a)
#pragma unroll
        for (int b = 0; b < 2; ++b)
#pragma unroll
            for (int m = 0; m < 4; ++m)
#pragma unroll
                for (int n = 0; n < 2; ++n) acc[a][b][m][n] = (f32x4){0.f, 0.f, 0.f, 0.f};
    bf16x8 At[4][2], B0[2][2], B1[2][2];
    unsigned vAc[2][2], vAn[2][2];
    S.a_offsets(cur, Rp, Cp, vAc);
    const char* cB = S.b_ptr(cur);
    PG8_STAGEB(PG8_SB(0, 0), cB); PG8_STAGEB(PG8_SB(0, 1), cB + hstep); PG8_STAGE(PG8_SA(0, 0), Abase, vAc[0]); PG8_STAGE(PG8_SA(0, 1), Abase, vAc[1]);
    if (wr == 1) PG8_BAR;
    PG8_WAIT_V(2); PG8_BAR;
    PG8_STAGEB(PG8_SB(1, 0), cB + kstep); PG8_STAGE(PG8_SA(1, 0), Abase + kstep, vAc[0]); PG8_STAGEB(PG8_SB(1, 1), cB + hstep + kstep);
    PG8_WAIT_V(6); PG8_BAR;
    for (;;) {
        const bool has_next = S.next(ui + 1, nxt);
        const char* nB = has_next ? S.b_ptr(nxt) : cB;
        if (has_next) S.a_offsets(nxt, Rp, Cp, vAn);
        else {
#pragma unroll
            for (int h = 0; h < 2; ++h)
#pragma unroll
                for (int i = 0; i < 2; ++i) vAn[h][i] = vAc[h][i]; }
        for (int t = 0; t < nt; t += 2) {
            const bool last = (t == nt - 2);
            const char* a1 = Abase + (size_t)(t + 1) * kstep;
            const char* a2 = last ? Abase : Abase + (size_t)(t + 2) * kstep; const char* b2 = last ? nB : cB + (size_t)(t + 2) * kstep;
            const char* a3 = a2 + kstep; const char* b3 = b2 + kstep;
            unsigned v2[2][2];
#pragma unroll
            for (int h = 0; h < 2; ++h)
#pragma unroll
                for (int i = 0; i < 2; ++i) v2[h][i] = last ? vAn[h][i] : vAc[h][i];
            PG8_LDB(B0, 0, 0); PG8_LDB(B1, 0, 1); PG8_SCHED; PG8_LDA(At, 0, 0); PG8_STAGE(PG8_SA(1, 1), a1, vAc[1]);
            PG8_WAIT_V(8); PG8_WAIT_L(0); PG8_BAR; PG8_MMA(0, 0, At, B0); PG8_MMA(0, 1, At, B1); PG8_BAR; PG8_SCHED;
            PG8_LDA(At, 0, 1); PG8_STAGEB(PG8_SB(0, 0), b2); PG8_STAGEB(PG8_SB(0, 1), b2 + hstep); PG8_STAGE(PG8_SA(0, 0), a2, v2[0]);
            PG8_WAIT_V(8); PG8_WAIT_L(0); PG8_BAR; PG8_MMA(1, 0, At, B0); PG8_MMA(1, 1, At, B1); PG8_BAR; PG8_SCHED;
            PG8_LDB(B0, 1, 0); PG8_LDB(B1, 1, 1); PG8_SCHED; PG8_LDA(At, 1, 0); PG8_STAGE(PG8_SA(0, 1), a2, v2[1]);
            PG8_WAIT_V(8); PG8_WAIT_L(0); PG8_BAR; PG8_MMA(0, 0, At, B0); PG8_MMA(0, 1, At, B1); PG8_BAR; PG8_SCHED;
            PG8_LDA(At, 1, 1); PG8_STAGEB(PG8_SB(1, 0), b3); PG8_STAGEB(PG8_SB(1, 1), b3 + hstep); PG8_STAGE(PG8_SA(1, 0), a3, v2[0]);
            PG8_WAIT_V(8); PG8_WAIT_L(0); PG8_BAR; PG8_MMA(1, 0, At, B0); PG8_MMA(1, 1, At, B1); PG8_BAR; PG8_SCHED;
        }
        if constexpr (ALIGN_EPI) { if (wr == 0) PG8_BAR; }
        E(acc, cur, wr, wc, fr, fq);
        if (!has_next) break;
#pragma unroll
        for (int a = 0; a < 2; ++a)
#pragma unroll
            for (int b = 0; b < 2; ++b)
#pragma unroll
                for (int m = 0; m < 4; ++m)
#pragma unroll
                    for (int n = 0; n < 2; ++n) acc[a][b][m][n] = (f32x4){0.f, 0.f, 0.f, 0.f};
        cur = nxt; cB = nB; ++ui;
#pragma unroll
        for (int h = 0; h < 2; ++h)
#pragma unroll
            for (int i = 0; i < 2; ++i) vAc[h][i] = vAn[h][i];
        if constexpr (ALIGN_EPI) { if (wr == 1) PG8_BAR; }
    }
    PG8_WAIT_V(0);
    if constexpr (!ALIGN_EPI) { if (wr == 0) PG8_BAR; }
    PG8_BAR;
#undef PG8_SA
#undef PG8_SB
#undef PG8_STAGE
#undef PG8_STAGEB
#undef PG8_LDA
#undef PG8_LDB
#undef PG8_MMA
#undef PG8_WAIT_V
#undef PG8_WAIT_L
#undef PG8_BAR
#undef PG8_SCHED
}
template <class Epi, class Sched, bool ALIGN_EPI>
__device__ __forceinline__ void gemm_phase_f8g(LAS unsigned char* lds, const char* Abase, const int K, const Sched& S, const Epi& E) {
    const int tid = tidx(), wid = __builtin_amdgcn_readfirstlane(tid >> 6), lane = tid & 63, wr = wid >> 2, wc = wid & 3, fr = lane & 15, fq = lane >> 4;
    const int nt = K / 128;
    int Rp[2], Cp[2]; unsigned voffB0;
#pragma unroll
    for (int i = 0; i < 2; ++i) stage_rc(tid * 16 + i * 8192, Rp[i], Cp[i]);
    { const int Rb = Epi::PERM ? ((Rp[0] & ~31) + perm32(Rp[0] & 31)) : Rp[0]; voffB0 = (unsigned)(Rb * K + 2 * Cp[0]); }
    const size_t kstep = (size_t)(BK * 2);
    const size_t hstep = (size_t)HALF * K;
    const unsigned ldsw = (unsigned)wid * 1024u;
    const int aoff0 = lds_byte(wr * 64 + fr, 16 * (fq & 1)) + (fq >> 1) * 1024, boff0 = lds_byte(wc * 32 + fr, 16 * (fq & 1)) + (fq >> 1) * 1024;
#define PG8_SA(b, h) (((b) * 2 + (h)) * HTB)
#define PG8_SB(b, h) ((4 + (b) * 2 + (h)) * HTB)
#define PG8_STAGE(bufoff, gbase, voff) do { _Pragma("unroll") for (int _i = 0; _i < 2; ++_i) \
        __builtin_amdgcn_global_load_lds((const unsigned*)((const char*)(gbase) + (voff)[_i]), (LAS unsigned*)(lds + (bufoff) + ldsw + _i * 8192), 16, 0, 0); } while (0)
#define PG8_STAGEB(bufoff, gbase) do { _Pragma("unroll") for (int _i = 0; _i < 2; ++_i) \
        __builtin_amdgcn_global_load_lds((const unsigned*)((const char*)(gbase) + (size_t)_i * 64 * K + voffB0), (LAS unsigned*)(lds + (bufoff) + ldsw + _i * 8192), 16, 0, 0); } while (0)
#define PG8_LDA(dst, b, h) do { _Pragma("unroll") for (int m = 0; m < 4; ++m) { const u32x4 lo_ = *(const LAS u32x4*)(lds + PG8_SA(b, h) + aoff0 + m * 2048), hi_ = *(const LAS u32x4*)(lds + PG8_SA(b, h) + aoff0 + 16 + m * 2048); \
        dst[m] = (v8i){(int)lo_.x, (int)lo_.y, (int)lo_.z, (int)lo_.w, (int)hi_.x, (int)hi_.y, (int)hi_.z, (int)hi_.w}; } } while (0)
#define PG8_LDB(dst, b, h) do { _Pragma("unroll") for (int n = 0; n < 2; ++n) { const u32x4 lo_ = *(const LAS u32x4*)(lds + PG8_SB(b, h) + boff0 + n * 2048), hi_ = *(const LAS u32x4*)(lds + PG8_SB(b, h) + boff0 + 16 + n * 2048); \
        dst[n] = (v8i){(int)lo_.x, (int)lo_.y, (int)lo_.z, (int)lo_.w, (int)hi_.x, (int)hi_.y, (int)hi_.z, (int)hi_.w}; } } while (0)
#define PG8_MMA(ai, bj, At, Bt) do { __builtin_amdgcn_s_setprio(1); _Pragma("unroll") for (int m = 0; m < 4; ++m) _Pragma("unroll") for (int n = 0; n < 2; ++n) \
        asm volatile("v_mfma_scale_f32_16x16x128_f8f6f4 %0, %1, %2, %0, %3, %3 op_sel_hi:[0,0,0]" : "+v"(acc[ai][bj][m][n]) : "v"(Bt[n]), "v"(At[m]), "v"(f8scale)); __builtin_amdgcn_s_setprio(0); } while (0)
#define PG8_WAIT_V(n) asm volatile("s_waitcnt vmcnt(" #n ")" ::: "memory")
#define PG8_WAIT_L(n) asm volatile("s_waitcnt lgkmcnt(" #n ")" ::: "memory")
#define PG8_BAR __builtin_amdgcn_s_barrier()
#define PG8_SCHED __builtin_amdgcn_sched_barrier(0)
    Unit cur, nxt; int ui = 0;
    if (!S.next(0, cur)) return;
    f32x4 acc[2][2][4][2];
#pragma unroll
    for (int a = 0; a < 2; ++a)
#pragma unroll
        for (int b = 0; b < 2; ++b)
#pragma unroll
            for (int m = 0; m < 4; ++m)
#pragma unroll
                for (int n = 0; n < 2; ++n) acc[a][b][m][n] = (f32x4){0.f, 0.f, 0.f, 0.f};
    typedef int v8i __attribute__((ext_vector_type(8)));
    v8i At[4], B0[2], B1[2];
    const int f8scale = 0x7f7f7f7f;
    unsigned vAc[2][2], vAn[2][2];
    S.a_offsets(cur, Rp, Cp, vAc);
    const char* cB = S.b_ptr(cur);
    PG8_STAGEB(PG8_SB(0, 0), cB); PG8_STAGEB(PG8_SB(0, 1), cB + hstep); PG8_STAGE(PG8_SA(0, 0), Abase, vAc[0]); PG8_STAGE(PG8_SA(0, 1), Abase, vAc[1]);
    if (wr == 1) PG8_BAR;
    PG8_WAIT_V(2); PG8_BAR;
    PG8_STAGEB(PG8_SB(1, 0), cB + kstep); PG8_STAGE(PG8_SA(1, 0), Abase + kstep, vAc[0]); PG8_STAGEB(PG8_SB(1, 1), cB + hstep + kstep);
    PG8_WAIT_V(6); PG8_BAR;
    for (;;) {
        const bool has_next = S.next(ui + 1, nxt);
        const char* nB = has_next ? S.b_ptr(nxt) : cB;
        if (has_next) S.a_offsets(nxt, Rp, Cp, vAn);
        else {
#pragma unroll
            for (int h = 0; h < 2; ++h)
#pragma unroll
                for (int i = 0; i < 2; ++i) vAn[h][i] = vAc[h][i]; }
#pragma unroll 1
        for (int t = 0; t < nt; t += 2) {
            const bool last = (t == nt - 2);
            const char* a1 = Abase + (size_t)(t + 1) * kstep;
            const char* a2 = last ? Abase : Abase + (size_t)(t + 2) * kstep; const char* b2 = last ? nB : cB + (size_t)(t + 2) * kstep;
            const char* a3 = a2 + kstep; const char* b3 = b2 + kstep;
            unsigned v2[2][2];
#pragma unroll
            for (int h = 0; h < 2; ++h)
#pragma unroll
                for (int i = 0; i < 2; ++i) v2[h][i] = last ? vAn[h][i] : vAc[h][i];
            PG8_LDB(B0, 0, 0); PG8_LDB(B1, 0, 1); PG8_SCHED; PG8_LDA(At, 0, 0); PG8_STAGE(PG8_SA(1, 1), a1, vAc[1]);
            PG8_WAIT_V(8); PG8_WAIT_L(0); PG8_BAR; PG8_MMA(0, 0, At, B0); PG8_MMA(0, 1, At, B1); PG8_BAR; PG8_SCHED;
            PG8_LDA(At, 0, 1); PG8_STAGEB(PG8_SB(0, 0), b2); PG8_STAGEB(PG8_SB(0, 1), b2 + hstep); PG8_STAGE(PG8_SA(0, 0), a2, v2[0]);
            PG8_WAIT_V(8); PG8_WAIT_L(0); PG8_BAR; PG8_MMA(1, 0, At, B0); PG8_MMA(1, 1, At, B1); PG8_BAR; PG8_SCHED;
            PG8_LDB(B0, 1, 0); PG8_LDB(B1, 1, 1); PG8_SCHED; PG8_LDA(At, 1, 0); PG8_STAGE(PG8_SA(0, 1), a2, v2[1]);
            PG8_WAIT_V(8); PG8_WAIT_L(0); PG8_BAR; PG8_MMA(0, 0, At, B0); PG8_MMA(0, 1, At, B1); PG8_BAR; PG8_SCHED;
            PG8_LDA(At, 1, 1); PG8_STAGEB(PG8_SB(1, 0), b3); PG8_STAGEB(PG8_SB(1, 1), b3 + hstep); PG8_STAGE(PG8_SA(1, 0), a3, v2[0]);
            PG8_WAIT_V(8); PG8_WAIT_L(0); PG8_BAR; PG8_MMA(1, 0, At, B0); PG8_MMA(1, 1, At, B1); PG8_BAR; PG8_SCHED;
        }
        if constexpr (ALIGN_EPI) { if (wr == 0) PG8_BAR; }
        E(acc, cur, wr, wc, fr, fq);
        if (!has_next) break;
#pragma unroll
        for (int a = 0; a < 2; ++a)
#pragma unroll
            for (int b = 0; b < 2; ++b)
#pragma unroll
                for (int m = 0; m < 4; ++m)
#pragma unroll
                    for (int n = 0; n < 2; ++n) acc[a][b][m][n] = (f32x4){0.f, 0.f, 0.f, 0.f};
        cur = nxt; cB = nB; ++ui;
#pragma unroll
        for (int h = 0; h < 2; ++h)
#pragma unroll
            for (int i = 0; i < 2; ++i) vAc[h][i] = vAn[h][i];
        if constexpr (ALIGN_EPI) { if (wr == 1) PG8_BAR; }
    }
    PG8_WAIT_V(0);
    if constexpr (!ALIGN_EPI) { if (wr == 0) PG8_BAR; }
    PG8_BAR;
#undef PG8_SA
#undef PG8_SB
#undef PG8_STAGE
#undef PG8_STAGEB
#undef PG8_LDA
#undef PG8_LDB
#undef PG8_MMA
#undef PG8_WAIT_V
#undef PG8_WAIT_L
#undef PG8_BAR
#undef PG8_SCHED
}
template <class Epi, class Sched, bool ALIGN_EPI>
__device__ __forceinline__ void gemm_phase_f8(LAS unsigned char* lds, const char* Abase, const int K, const Sched& S, const Epi& E) {
    const int tid = tidx(), wid = __builtin_amdgcn_readfirstlane(tid >> 6), lane = tid & 63, wr = wid >> 2, wc = wid & 3, fr = lane & 15, fq = lane >> 4;
    const int nt = K / 128;
    int Rp[1], Cp[1]; unsigned voffB[1], voffA[1];
#pragma unroll
    for (int i = 0; i < 1; ++i) { stage_rc(tid * 16 + i * 8192, Rp[i], Cp[i]); const int Rb = Epi::PERM ? ((Rp[i] & ~31) + perm32(Rp[i] & 31)) : Rp[i]; voffB[i] = (unsigned)(Rb * K + 2 * Cp[i]); voffA[i] = (unsigned)(Rp[i] * K + 2 * Cp[i]); }
    const size_t kstep = (size_t)(BK * 2);
    const size_t hstep = (size_t)HALF * K;
    const unsigned ldsw = (unsigned)wid * 1024u;
    const int aoff0 = lds_byte(wr * 64 + fr, 16 * (fq & 1)) + (fq >> 1) * 1024, boff0 = lds_byte(wc * 32 + fr, 16 * (fq & 1)) + (fq >> 1) * 1024;
#define PG8_SA(b, h) (((b) * 2 + (h)) * HTB)
#define PG8_SB(b, h) ((4 + (b) * 2 + (h)) * HTB)
#define PG8_STAGE(bufoff, gbase, voff) do { _Pragma("unroll") for (int _i = 0; _i < 2; ++_i) \
        __builtin_amdgcn_global_load_lds((const unsigned*)((const char*)(gbase) + (size_t)_i * 64 * K + (voff)[0]), (LAS unsigned*)(lds + (bufoff) + ldsw + _i * 8192), 16, 0, 0); } while (0)
#define PG8_LDA(dst, b, h) do { _Pragma("unroll") for (int m = 0; m < 4; ++m) { const u32x4 lo_ = *(const LAS u32x4*)(lds + PG8_SA(b, h) + aoff0 + m * 2048), hi_ = *(const LAS u32x4*)(lds + PG8_SA(b, h) + aoff0 + 16 + m * 2048); \
        dst[m] = (v8i){(int)lo_.x, (int)lo_.y, (int)lo_.z, (int)lo_.w, (int)hi_.x, (int)hi_.y, (int)hi_.z, (int)hi_.w}; } } while (0)
#define PG8_LDB(dst, b, h) do { _Pragma("unroll") for (int n = 0; n < 2; ++n) { const u32x4 lo_ = *(const LAS u32x4*)(lds + PG8_SB(b, h) + boff0 + n * 2048), hi_ = *(const LAS u32x4*)(lds + PG8_SB(b, h) + boff0 + 16 + n * 2048); \
        dst[n] = (v8i){(int)lo_.x, (int)lo_.y, (int)lo_.z, (int)lo_.w, (int)hi_.x, (int)hi_.y, (int)hi_.z, (int)hi_.w}; } } while (0)
#define PG8_MMA(ai, bj, At, Bt) do { __builtin_amdgcn_s_setprio(1); _Pragma("unroll") for (int m = 0; m < 4; ++m) _Pragma("unroll") for (int n = 0; n < 2; ++n) \
        asm volatile("v_mfma_scale_f32_16x16x128_f8f6f4 %0, %1, %2, %0, %3, %3 op_sel_hi:[0,0,0]" : "+v"(acc[ai][bj][m][n]) : "v"(Bt[n]), "v"(At[m]), "v"(f8scale)); __builtin_amdgcn_s_setprio(0); } while (0)
#define PG8_WAIT_V(n) asm volatile("s_waitcnt vmcnt(" #n ")" ::: "memory")
#define PG8_WAIT_L(n) asm volatile("s_waitcnt lgkmcnt(" #n ")" ::: "memory")
#define PG8_BAR __builtin_amdgcn_s_barrier()
#define PG8_SCHED __builtin_amdgcn_sched_barrier(0)
    Unit cur, nxt; int ui = 0;
    if (!S.next(0, cur)) return;
    f32x4 acc[2][2][4][2];
#pragma unroll
    for (int a = 0; a < 2; ++a)
#pragma unroll
        for (int b = 0; b < 2; ++b)
#pragma unroll
            for (int m = 0; m < 4; ++m)
#pragma unroll
                for (int n = 0; n < 2; ++n) acc[a][b][m][n] = (f32x4){0.f, 0.f, 0.f, 0.f};
    typedef int v8i __attribute__((ext_vector_type(8)));
    v8i At[4], B0[2], B1[2];
    const int f8scale = 0x7f7f7f7f;
    const char* cA = S.a_ptr(cur, Abase);
    const char* cB = S.b_ptr(cur);
    PG8_STAGE(PG8_SB(0, 0), cB, voffB); PG8_STAGE(PG8_SB(0, 1), cB + hstep, voffB); PG8_STAGE(PG8_SA(0, 0), cA, voffA); PG8_STAGE(PG8_SA(0, 1), cA + hstep, voffA);
    if (wr == 1) PG8_BAR;
    PG8_WAIT_V(2); PG8_BAR;
    PG8_STAGE(PG8_SB(1, 0), cB + kstep, voffB); PG8_STAGE(PG8_SA(1, 0), cA + kstep, voffA); PG8_STAGE(PG8_SB(1, 1), cB + hstep + kstep, voffB);
    PG8_WAIT_V(6); PG8_BAR;
    for (;;) {
        const bool has_next = S.next(ui + 1, nxt);
        const char* nB = has_next ? S.b_ptr(nxt) : cB; const char* nA = has_next ? S.a_ptr(nxt, Abase) : cA;
#pragma unroll 1
        for (int t = 0; t < nt; t += 2) {
            const bool last = (t == nt - 2);
            const char* a1 = cA + (size_t)(t + 1) * kstep;
            const char* a2 = last ? nA : cA + (size_t)(t + 2) * kstep; const char* b2 = last ? nB : cB + (size_t)(t + 2) * kstep;
            const char* a3 = a2 + kstep; const char* b3 = b2 + kstep;
            PG8_LDB(B0, 0, 0); PG8_LDB(B1, 0, 1); PG8_SCHED; PG8_LDA(At, 0, 0); PG8_STAGE(PG8_SA(1, 1), a1 + hstep, voffA);
            PG8_WAIT_V(8); PG8_WAIT_L(0); PG8_BAR; PG8_MMA(0, 0, At, B0); PG8_MMA(0, 1, At, B1); PG8_BAR; PG8_SCHED;
            PG8_LDA(At, 0, 1); PG8_STAGE(PG8_SB(0, 0), b2, voffB); PG8_STAGE(PG8_SB(0, 1), b2 + hstep, voffB); PG8_STAGE(PG8_SA(0, 0), a2, voffA);
            PG8_WAIT_V(8); PG8_WAIT_L(0); PG8_BAR; PG8_MMA(1, 0, At, B0); PG8_MMA(1, 1, At, B1); PG8_BAR; PG8_SCHED;
            PG8_LDB(B0, 1, 0); PG8_LDB(B1, 1, 1); PG8_SCHED; PG8_LDA(At, 1, 0); PG8_STAGE(PG8_SA(0, 1), a2 + hstep, voffA);
            PG8_WAIT_V(8); PG8_WAIT_L(0); PG8_BAR; PG8_MMA(0, 0, At, B0); PG8_MMA(0, 1, At, B1); PG8_BAR; PG8_SCHED;
            PG8_LDA(At, 1, 1); PG8_STAGE(PG8_SB(1, 0), b3, voffB); PG8_STAGE(PG8_SB(1, 1), b3 + hstep, voffB); PG8_STAGE(PG8_SA(1, 0), a3, voffA);
            PG8_WAIT_V(8); PG8_WAIT_L(0); PG8_BAR; PG8_MMA(1, 0, At, B0); PG8_MMA(1, 1, At, B1); PG8_BAR; PG8_SCHED;
        }
        if constexpr (ALIGN_EPI) { if (wr == 0) PG8_BAR; }
        E(acc, cur, wr, wc, fr, fq);
        if (!has_next) break;
#pragma unroll
        for (int a = 0; a < 2; ++a)
#pragma unroll
            for (int b = 0; b < 2; ++b)
#pragma unroll
                for (int m = 0; m < 4; ++m)
#pragma unroll
                    for (int n = 0; n < 2; ++n) acc[a][b][m][n] = (f32x4){0.f, 0.f, 0.f, 0.f};
        cur = nxt; cB = nB; cA = nA; ++ui;
        if constexpr (ALIGN_EPI) { if (wr == 1) PG8_BAR; }
    }
    PG8_WAIT_V(0);
    if constexpr (!ALIGN_EPI) { if (wr == 0) PG8_BAR; }
    PG8_BAR;
#undef PG8_SA
#undef PG8_SB
#undef PG8_STAGE
#undef PG8_LDA
#undef PG8_LDB
#undef PG8_MMA
#undef PG8_WAIT_V
#undef PG8_WAIT_L
#undef PG8_BAR
#undef PG8_SCHED
}
}

struct Args { const float* in[39]; float* out; unsigned char* ws; int ph_lo, ph_hi; };
typedef const __attribute__((address_space(4))) Args CArgs;
enum { I_X = 0, I_C, I_CTX, I_CCTX, I_WADA, I_BADA, I_WIN, I_HYCW, I_HYCB, I_HYW1, I_HYB1, I_HYW2, I_HYB2, I_HYW3, I_HYB3, I_HYW4, I_HYFREQ, I_HYD, I_SCCW,
       I_GLAWA, I_GLABA, I_GLANW, I_GDNCW, I_GDNALOG, I_GDNDT, I_GDNNW, I_WOUT, I_LN1G, I_LN1B, I_WR, I_BR, I_WG, I_BG, I_WU, I_BU, I_WD, I_BD, I_LN2G, I_LN2B };

__device__ __forceinline__ int row_batch(int row) { return row < NTOK_C ? (row >> 8) : ((row - NTOK_C) >> 11); }
__device__ __forceinline__ int mod_vec(int row) { return row < NTOK_C ? 16 : ((row - NTOK_C) >> 11); }

__device__ __forceinline__ void ph_mod(CArgs& a, LAS unsigned char* lds, int bid, int nblk) {
    LAS float* sc = (LAS float*)lds; LAS float* red = (LAS float*)(lds + 17 * 1024 * 4);
    const int tid = tidx(), lane = tid & 63, w = tid >> 6;
    const float* c = a.in[I_C]; const float* cc = a.in[I_CCTX];
    for (int i = tid; i < 17 * 1024; i += 512) { const float v = i < 16 * 1024 ? c[i] : cc[i - 16 * 1024]; sc[i] = siluf_(v); }
    __syncthreads();
    float* MOD = (float*)(a.ws + WS_MOD);
    for (int it = bid; it < DEPTH * 96; it += nblk) {
        const int l = it / 96, j0 = (it % 96) * 64;
        const float* W = a.in[I_WADA] + (size_t)l * 1024 * 6144 + j0 + lane;
        float acc[17];
#pragma unroll
        for (int v = 0; v < 17; ++v) acc[v] = 0.f;
#pragma unroll 16
        for (int kk = 0; kk < 128; ++kk) { const int k = w * 128 + kk; const float wv = W[(size_t)k * 6144];
#pragma unroll
            for (int v = 0; v < 17; ++v) acc[v] += sc[v * 1024 + k] * wv; }
#pragma unroll
        for (int v = 0; v < 17; ++v) red[(w * 17 + v) * 64 + lane] = acc[v];
        __syncthreads();
        for (int o = tid; o < 17 * 64; o += 512) { const int v = o >> 6, jj = o & 63; float s = 0.f;
#pragma unroll
            for (int ww = 0; ww < 8; ++ww) s += red[(ww * 17 + v) * 64 + jj];
            MOD[(size_t)(l * 17 + v) * 6144 + j0 + jj] = s + a.in[I_BADA][l * 6144 + j0 + jj]; }
        __syncthreads();
    }
}

__device__ __forceinline__ void ph_filters(CArgs& a, int gw, int ngw) {
    const int lane = tidx() & 63;
    float* KUN = (float*)(a.ws + WS_KUN);
#pragma unroll 1
    for (int it = gw; it < DEPTH * (CTXL + SEQ) / 4; it += ngw) {
        const int l = it / ((CTXL + SEQ) / 4), r = (it % ((CTXL + SEQ) / 4)) * 4, Lt = r < CTXL ? 0 : 1, pos0 = Lt ? r - CTXL : r, L = Lt ? SEQ : CTXL;
        float z[4], tn[4];
#pragma unroll
        for (int p = 0; p < 4; ++p) { const int pos = pos0 + p; tn[p] = (float)pos / (float)(L - 1); z[p] = 0.f;
            if (lane == 0) z[p] = tn[p];
            else if (lane <= 32) { const int j = (lane - 1) & 15; const float fj = 1e-4f + (float)j * ((15.f - 1e-4f) / 15.f);
                double rev = (double)fj * (double)pos / (double)L; rev -= floor(rev); const float rf = (float)rev;
                z[p] = lane <= 16 ? sin_rev(rf + 0.25f) : -sin_rev(rf); } }
        const float* w1 = a.in[I_HYW1] + l * 33 * 64; const float* w2 = a.in[I_HYW2] + l * 64 * 64; const float* w3 = a.in[I_HYW3] + l * 64 * 64; const float* w4 = a.in[I_HYW4] + l * 64 * 512;
        const float* fq = a.in[I_HYFREQ] + l * 3 * 64;
        float s[4], h[4];
        { const float bb = a.in[I_HYB1][l * 64 + lane];
#pragma unroll
          for (int p = 0; p < 4; ++p) s[p] = bb; }
#pragma unroll
        for (int i = 0; i < 33; ++i) { const float ww = w1[i * 64 + lane];
#pragma unroll
            for (int p = 0; p < 4; ++p) s[p] += rdlane_f(z[p], i) * ww; }
#pragma unroll
        for (int p = 0; p < 4; ++p) h[p] = sin_rad(fq[lane] * s[p]);
        { const float bb = a.in[I_HYB2][l * 64 + lane];
#pragma unroll
          for (int p = 0; p < 4; ++p) s[p] = bb; }
#pragma unroll 16
        for (int i = 0; i < 64; ++i) { const float ww = w2[i * 64 + lane];
#pragma unroll
            for (int p = 0; p < 4; ++p) s[p] += rdlane_f(h[p], i) * ww; }
#pragma unroll
        for (int p = 0; p < 4; ++p) h[p] = sin_rad(fq[64 + lane] * s[p]);
        { const float bb = a.in[I_HYB3][l * 64 + lane];
#pragma unroll
          for (int p = 0; p < 4; ++p) s[p] = bb; }
#pragma unroll 16
        for (int i = 0; i < 64; ++i) { const float ww = w3[i * 64 + lane];
#pragma unroll
            for (int p = 0; p < 4; ++p) s[p] += rdlane_f(h[p], i) * ww; }
#pragma unroll
        for (int p = 0; p < 4; ++p) h[p] = sin_rad(fq[128 + lane] * s[p]);
        float k[8][4];
#pragma unroll
        for (int m = 0; m < 8; ++m)
#pragma unroll
            for (int p = 0; p < 4; ++p) k[m][p] = 0.f;
#pragma unroll 4
        for (int i = 0; i < 64; ++i) { float hi[4];
#pragma unroll
            for (int p = 0; p < 4; ++p) hi[p] = rdlane_f(h[p], i);
#pragma unroll
            for (int m = 0; m < 8; ++m) { const float ww = w4[i * 512 + m * 64 + lane];
#pragma unroll
                for (int p = 0; p < 4; ++p) k[m][p] += hi[p] * ww; } }
#pragma unroll
        for (int m = 0; m < 8; ++m) { const int o = m * 64 + lane, ch = o & 255;
            const float delta = 3.0701134573253944f + (float)ch * ((15.350567286626972f - 3.0701134573253944f) / 255.f);
            *(f32x4*)(KUN + ((size_t)((l * 2 + Lt) * 512 + o)) * 2048 + pos0) = (f32x4){k[m][0] * __expf(-tn[0] * delta), k[m][1] * __expf(-tn[1] * delta), k[m][2] * __expf(-tn[2] * delta), k[m][3] * __expf(-tn[3] * delta)}; }
    }
}

__device__ __forceinline__ void ph_router_w(CArgs& a, int gt, int ngt) {
    bf16* hi = (bf16*)(a.ws + WS_WRT); bf16* lo = hi + DEPTH * NEXP * D;
    for (int i = gt; i < DEPTH * NEXP * D; i += ngt) { const int l = i / (NEXP * D), r = i % (NEXP * D), e = r / D, k = r % D;
        const float w = a.in[I_WR][((size_t)l * D + k) * NEXP + e]; const unsigned h = f2bf(w); hi[i] = (bf16)h; lo[i] = (bf16)f2bf(w - bf2f(h)); }
}
__device__ __forceinline__ void tr_item(const float* W, int Nsrc, int K, bf16* WTrow0, int n0, int k0, LAS float* scr, int lane) {
    const int c4 = (lane & 7) * 4; const bool ok = n0 + c4 < Nsrc;
    f32x4 t[8];
#pragma unroll
    for (int j = 0; j < 8; ++j) { const int kk = 8 * j + (lane >> 3); t[j] = ok ? *(const f32x4*)(W + (size_t)(k0 + kk) * Nsrc + n0 + c4) : (f32x4){0.f, 0.f, 0.f, 0.f}; }
#pragma unroll
    for (int j = 0; j < 8; ++j) { const int kk = 8 * j + (lane >> 3); LAS float* d = scr + kk * 33 + c4; d[0] = t[j][0]; d[1] = t[j][1]; d[2] = t[j][2]; d[3] = t[j][3]; }
    asm volatile("s_waitcnt lgkmcnt(0)" ::: "memory");
    const int c = lane & 7;
#pragma unroll
    for (int j = 0; j < 4; ++j) { const int n = (lane >> 3) + 8 * j; const LAS float* s = scr + (8 * c) * 33 + n;
        u32x4 o; o.x = pk2(s[0 * 33], s[1 * 33]); o.y = pk2(s[2 * 33], s[3 * 33]); o.z = pk2(s[4 * 33], s[5 * 33]); o.w = pk2(s[6 * 33], s[7 * 33]);
        *(u32x4*)(WTrow0 + (size_t)n * K + k0 + 8 * c) = o; }
    asm volatile("s_waitcnt lgkmcnt(0)" ::: "memory");
}
__device__ __forceinline__ void tr_item_f8(const float* W, int Nsrc, int K, unsigned char* WTrow0, int n0, int k0, float scale, LAS float* scr, int lane) {
    const int c4 = (lane & 7) * 4;
    f32x4 t[8];
#pragma unroll
    for (int j = 0; j < 8; ++j) { const int kk = 8 * j + (lane >> 3); t[j] = *(const f32x4*)(W + (size_t)(k0 + kk) * Nsrc + n0 + c4); }
#pragma unroll
    for (int j = 0; j < 8; ++j) { const int kk = 8 * j + (lane >> 3); LAS float* d = scr + kk * 33 + c4; d[0] = t[j][0]; d[1] = t[j][1]; d[2] = t[j][2]; d[3] = t[j][3]; }
    asm volatile("s_waitcnt lgkmcnt(0)" ::: "memory");
    const int n = lane >> 1, half = lane & 1; const LAS float* s = scr + (32 * half) * 33 + n;
    unsigned o[8];
#pragma unroll
    for (int i = 0; i < 8; ++i) o[i] = pk4_fp8(s[(4 * i) * 33] * scale, s[(4 * i + 1) * 33] * scale, s[(4 * i + 2) * 33] * scale, s[(4 * i + 3) * 33] * scale);
    unsigned char* dst = WTrow0 + (size_t)n * K + k0 + 32 * half;
    *(u32x4*)dst = (u32x4){o[0], o[1], o[2], o[3]}; *(u32x4*)(dst + 16) = (u32x4){o[4], o[5], o[6], o[7]};
    asm volatile("s_waitcnt lgkmcnt(0)" ::: "memory");
}
__device__ __forceinline__ void ph_tr_small(CArgs& a, LAS unsigned char* lds, int gw, int ngw) {
    const int lane = tidx() & 63, w = tidx() >> 6;
    LAS float* scr = (LAS float*)(lds + w * 8448);
    constexpr int I_IN = 16 * (D_INP / 32), I_OUT = 16 * 32;
    for (int it = gw; it < DEPTH * (I_IN + I_OUT); it += ngw) {
        const int l = it / (I_IN + I_OUT); int r = it % (I_IN + I_OUT);
        if (r < I_IN) { const int kb = r / (D_INP / 32), nb = r % (D_INP / 32);
            tr_item(a.in[I_WIN] + (size_t)l * 1024 * D_IN, D_IN, 1024, (bf16*)(a.ws + WS_WIN) + ((size_t)l * D_INP + nb * 32) * 1024, nb * 32, kb * 64, scr, lane); }
        else { r -= I_IN; const int kb = r / 32, nb = r % 32;
            tr_item(a.in[I_WOUT] + (size_t)l * 1024 * 1024, 1024, 1024, (bf16*)(a.ws + WS_WOUT) + ((size_t)l * 1024 + nb * 32) * 1024, nb * 32, kb * 64, scr, lane); }
    }
}
__device__ __forceinline__ void tr_experts_range(CArgs& a, int l, LAS unsigned char* scrb, int first, int last, int stride, int lane) {
    LAS float* scr = (LAS float*)scrb;
#pragma unroll 1
    for (int it = first; it < last; it += stride) {
        const int e = it / 1536, r = it % 1536, which = r / 512, q = r % 512, kb = q / 32, nb = q % 32, n0 = nb * 32;
        const float* W = a.in[which == 0 ? I_WG : (which == 1 ? I_WU : I_WD)] + ((size_t)(l * NEXP + e)) * 1024 * 1024;
        if (which == 2) tr_item_f8(W, 1024, 1024, a.ws + WS_WD + ((size_t)e * 1024 + n0) * 1024, n0, kb * 64, 32.f, scr, lane);
        else tr_item_f8(W, 1024, 1024, a.ws + WS_WGU + ((size_t)e * 2048 + (n0 >> 7) * 256 + which * 128 + (n0 & 127)) * 1024, n0, kb * 64, 32.f, scr, lane);
    }
}
__device__ __forceinline__ void ph_mod_input(CArgs& a, int gw, int ngw) {
    const int lane = tidx() & 63;
    const float* MOD = (const float*)(a.ws + WS_MOD);
    bf16* HB = (bf16*)(a.ws + WS_HB);
    for (int row = gw; row < NTOK; row += ngw) {
        const float* src = row < NTOK_C ? a.in[I_CTX] + (size_t)row * D : a.in[I_X] + (size_t)(row - NTOK_C) * D;
        const float* mv = MOD + (size_t)mod_vec(row) * 6144;
#pragma unroll
        for (int j = 0; j < 4; ++j) { const int c0 = j * 256 + lane * 4; const f32x4 x = *(const f32x4*)(src + c0), sh = *(const f32x4*)(mv + c0), sc = *(const f32x4*)(mv + 1024 + c0);
            u32x2 o; o.x = pk2(x[0] * (1.f + sc[0]) + sh[0], x[1] * (1.f + sc[1]) + sh[1]); o.y = pk2(x[2] * (1.f + sc[2]) + sh[2], x[3] * (1.f + sc[3]) + sh[3]);
            *(u32x2*)(HB + (size_t)row * D + c0) = o; }
    }
}

struct Chunk { int b, t0, L, row0, lo, hi; };
__device__ __forceinline__ Chunk chunk_of(int it) {
    Chunk c;
    if (it < 64) { c.b = it >> 2; c.t0 = (it & 3) * 64; c.L = CTXL; c.row0 = c.b * CTXL + c.t0; c.lo = 0; c.hi = CTXL; }
    else { const int r = it - 64; c.b = r >> 5; c.t0 = (r & 31) * 64; c.L = SEQ; c.row0 = NTOK_C + c.b * SEQ + c.t0; c.lo = c.t0; c.hi = c.t0 + 64; }
    return c;
}
__device__ __forceinline__ f32x4 bf4(u32x2 v) { return (f32x4){lo_bf(v.x), hi_bf(v.x), lo_bf(v.y), hi_bf(v.y)}; }
__device__ __forceinline__ void ph_prep_conv(CArgs& a, int l, LAS unsigned char* lds, int bid, int nblk) {
    const bf16* P = (const bf16*)(a.ws + WS_P);
    bf16* ZT = (bf16*)(a.ws + WS_MIX + MX_ZT); bf16* YMIX = (bf16*)(a.ws + WS_YMIX);
    LAS bf16* zt = (LAS bf16*)lds;
    const int tid = tidx(), c4 = (tid & 63) * 4, tg = tid >> 6;
    const float* hw = a.in[I_HYCW] + l * 3 * 768; const float* hb = a.in[I_HYCB] + l * 768; const float* sw = a.in[I_SCCW] + l * 3 * 256;
    f32x4 wx[3], wv[3], ws3[3];
#pragma unroll
    for (int k = 0; k < 3; ++k) { wx[k] = *(const f32x4*)(hw + k * 768 + 256 + c4); wv[k] = *(const f32x4*)(hw + k * 768 + 512 + c4); ws3[k] = *(const f32x4*)(sw + k * 256 + c4); }
    const f32x4 bx = *(const f32x4*)(hb + 256 + c4), bv = *(const f32x4*)(hb + 512 + c4);
#pragma unroll 1
    for (int it = bid; it < 576; it += nblk) {
        const Chunk c = chunk_of(it);
        const int tb = c.t0 + tg * 8;
        const bf16* pb = P + (size_t)(c.row0 + tg * 8) * D_INP;
        f32x4 x1[10], vv[10], mm[10];
#pragma unroll
        for (int r = 0; r < 10; ++r) { const int t = tb + r - 1, tc = min(max(t, c.lo), c.hi - 1); const float ok = (t == tc) ? 1.f : 0.f; const bf16* p = pb + (ptrdiff_t)(tc - tb) * D_INP;
            x1[r] = ok * bf4(*(const u32x2*)(p + HY0 + 256 + c4)); vv[r] = ok * bf4(*(const u32x2*)(p + HY0 + 512 + c4));
            mm[r] = ok * bf4(*(const u32x2*)(p + SC0 + 256 + c4)) * bf4(*(const u32x2*)(p + SC0 + 512 + c4)); }
#pragma unroll
        for (int tt = 0; tt < 8; ++tt) {
            const f32x4 xx = wx[0] * x1[tt] + wx[1] * x1[tt + 1] + wx[2] * x1[tt + 2] + bx, v2 = wv[0] * vv[tt] + wv[1] * vv[tt + 1] + wv[2] * vv[tt + 2] + bv, z = xx * v2;
            u32x2 zo; zo.x = pk2(z[0], z[1]); zo.y = pk2(z[2], z[3]); *(LAS u32x2*)(zt + (tg * 8 + tt) * 264 + c4) = zo;
            const f32x4 bg = bf4(*(const u32x2*)(pb + (size_t)tt * D_INP + SC0 + c4));
            const f32x4 y = bg * (ws3[0] * mm[tt] + ws3[1] * mm[tt + 1] + ws3[2] * mm[tt + 2]);
            u32x2 yo; yo.x = pk2(y[0], y[1]); yo.y = pk2(y[2], y[3]); *(u32x2*)(YMIX + (size_t)(c.row0 + tg * 8 + tt) * D + 256 + c4) = yo;
        }
        __syncthreads();
        { const int ch = tid & 255, g0 = (tid >> 8) * 4;
          const int soff = c.L == CTXL ? 0 : CTXL;
#pragma unroll
          for (int g = 0; g < 4; ++g) { const int t8 = (g0 + g) * 8; unsigned short e[8];
#pragma unroll
              for (int j = 0; j < 8; ++j) e[j] = zt[(t8 + j) * 264 + ch];
              u32x4 o; o.x = e[0] | ((unsigned)e[1] << 16); o.y = e[2] | ((unsigned)e[3] << 16); o.z = e[4] | ((unsigned)e[5] << 16); o.w = e[6] | ((unsigned)e[7] << 16);
              *(u32x4*)(ZT + ((size_t)(ch * 16 + c.b)) * 2304 + soff + c.t0 + t8) = o; } }
        __syncthreads();
    }
}
__device__ __forceinline__ void ph_prep_tok(CArgs& a, int l, int gw, int ngw) {
    const int lane = tidx() & 63;
    const bf16* P = (const bf16*)(a.ws + WS_P);
    float* GDF = (float*)(a.ws + WS_MIX + MX_GDF); float* GDB = (float*)(a.ws + WS_MIX + MX_GDB);
    float* DQ = (float*)(a.ws + WS_MIX + MX_DQ); float* DK = (float*)(a.ws + WS_MIX + MX_DK); float* DV = (float*)(a.ws + WS_MIX + MX_DV); float* DG = (float*)(a.ws + WS_MIX + MX_DG);
    const float* wa = a.in[I_GLAWA] + l * 2 * 16 * 128; const float* ba = a.in[I_GLABA] + l * 2 * 128;
    const float* cw = a.in[I_GDNCW] + l * 3 * 768;
#pragma unroll 1
    for (int row0 = gw * 4; row0 < NTOK; row0 += ngw * 4) {
        { int z = 0; asm volatile("" : "+v"(z)); wa += z; cw += z; }
        const bf16* pr0 = P + (size_t)row0 * D_INP;
        float av[4], s[4][4];
#pragma unroll
        for (int r = 0; r < 4; ++r) { av[r] = bf2f(pr0[(size_t)r * D_INP + GLA0 + 768 + (lane & 31)]); s[r][0] = ba[lane]; s[r][1] = ba[64 + lane]; s[r][2] = ba[128 + lane]; s[r][3] = ba[192 + lane]; }
#pragma unroll
        for (int i = 0; i < 16; ++i) { const float w0 = wa[i * 128 + lane], w1 = wa[i * 128 + 64 + lane], w2 = wa[2048 + i * 128 + lane], w3 = wa[2048 + i * 128 + 64 + lane];
#pragma unroll
            for (int r = 0; r < 4; ++r) { const float af = rdlane_f(av[r], i), ab = rdlane_f(av[r], 16 + i); s[r][0] += af * w0; s[r][1] += af * w1; s[r][2] += ab * w2; s[r][3] += ab * w3; } }
#pragma unroll
        for (int r = 0; r < 4; ++r) { const size_t o = (size_t)(row0 + r) * 128;
            GDF[o + lane] = logsigmoidf_(s[r][0]) * 0.0625f; GDF[o + 64 + lane] = logsigmoidf_(s[r][1]) * 0.0625f;
            GDB[o + lane] = logsigmoidf_(s[r][2]) * 0.0625f; GDB[o + 64 + lane] = logsigmoidf_(s[r][3]) * 0.0625f; }
        int tpos, lo, hi;
        if (row0 < NTOK_C) { tpos = row0 & 255; lo = 0; hi = CTXL; } else { tpos = (row0 - NTOK_C) & 2047; lo = tpos & ~63; hi = lo + 64; }
        float sq[4] = {0.f, 0.f, 0.f, 0.f}, sk[4] = {0.f, 0.f, 0.f, 0.f}; f32x4 qv[4], kv[4];
#pragma unroll
        for (int g = 0; g < 3; ++g) { const int col = g * 256 + 4 * lane; const bf16* p = pr0 + GDN0 + col;
            f32x4 x[6];
#pragma unroll
            for (int r = 0; r < 6; ++r) { const int t = tpos + r - 1, tc = min(max(t, lo), hi - 1);
                const f32x4 xl = bf4(*(const u32x2*)(p + (ptrdiff_t)(tc - tpos) * D_INP)); x[r] = (t == tc) ? xl : (f32x4){0.f, 0.f, 0.f, 0.f}; }
            const f32x4 w0 = *(const f32x4*)(cw + col), w1 = *(const f32x4*)(cw + 768 + col), w2 = *(const f32x4*)(cw + 1536 + col);
#pragma unroll
            for (int r = 0; r < 4; ++r) { f32x4 y = w0 * x[r] + w1 * x[r + 1] + w2 * x[r + 2];
                y[0] = siluf_(y[0]); y[1] = siluf_(y[1]); y[2] = siluf_(y[2]); y[3] = siluf_(y[3]);
                if (g == 0) { qv[r] = y; sq[r] = (y[0] * y[0] + y[1] * y[1]) + (y[2] * y[2] + y[3] * y[3]); }
                else if (g == 1) { kv[r] = y; sk[r] = (y[0] * y[0] + y[1] * y[1]) + (y[2] * y[2] + y[3] * y[3]); }
                else *(f32x4*)(DV + (size_t)(row0 + r) * 256 + 4 * lane) = y; } }
#pragma unroll
        for (int r = 0; r < 4; ++r) { const float rq = rsqrtf(row16_sum(sq[r]) + 1e-6f) * 0.125f, rk = rsqrtf(row16_sum(sk[r]) + 1e-6f);
            const f32x4 qn = qv[r] * rq, kn = kv[r] * rk;
            *(f32x4*)(DQ + (size_t)(row0 + r) * 256 + 4 * lane) = qn; *(f32x4*)(DK + (size_t)(row0 + r) * 256 + 4 * lane) = kn;
            *(u32x2*)((bf16*)(a.ws + WS_CKD + CD_QB) + (size_t)(row0 + r) * 256 + 4 * lane) = (u32x2){pk2(qn[0], qn[1]), pk2(qn[2], qn[3])};
            *(u32x2*)((bf16*)(a.ws + WS_CKD + CD_KB) + (size_t)(row0 + r) * 256 + 4 * lane) = (u32x2){pk2(kn[0], kn[1]), pk2(kn[2], kn[3])}; }
        if (lane < 16) { const int h = lane & 3, r = lane >> 2; const bf16* pr = pr0 + (size_t)r * D_INP;
            const float af = bf2f(pr[GDN0 + 1024 + h]), ab = bf2f(pr[GDN0 + 1028 + h]), bfv = bf2f(pr[GDN0 + 1032 + h]), bbv = bf2f(pr[GDN0 + 1036 + h]);
            const float* al = a.in[I_GDNALOG] + l * 8; const float* dt = a.in[I_GDNDT] + l * 8;
            const float gf = -__expf(al[h]) * softplusf_(af + dt[h]), gb = -__expf(al[4 + h]) * softplusf_(ab + dt[4 + h]);
            *(f32x4*)(DG + (size_t)(row0 + r) * 16 + 4 * h) = (f32x4){sigmoidf_(bfv), gf, sigmoidf_(bbv), gb}; }
    }
}

__device__ __forceinline__ int scan_row(int b, int dir, int n) {
    if (n < CTXL) return b * CTXL + (dir ? CTXL - 1 - n : n);
    const int m = n - CTXL; return NTOK_C + b * SEQ + (dir ? SEQ - 1 - m : m);
}
__device__ __forceinline__ void gla_chain(CArgs& a, int chain, LAS unsigned char* lds) {
    const int b = chain >> 3, h = (chain >> 1) & 3, dir = chain & 1;
    const int tid = tidx(), lane = tid & 63, w = tid >> 6, vv = lane & 7, kq = lane >> 3;
    const bf16* P = (const bf16*)(a.ws + WS_P);
    const float* GD = (const float*)(a.ws + WS_MIX + (dir ? MX_GDB : MX_GDF));
    float* GO = (float*)(a.ws + WS_MIX + (dir ? MX_GOB : MX_GOF));
    LAS float* sq = (LAS float*)lds;
    LAS float* sk = sq + 64 * 32;
    LAS float* sd = sk + 64 * 32;
    LAS float* sv = sd + 64 * 32;
    float S[4] = {0.f, 0.f, 0.f, 0.f};
    for (int ch = 0; ch < 36; ++ch) {
        { const int tt = tid >> 3, sub = tid & 7, row = scan_row(b, dir, ch * 64 + tt);
          const bf16* pr = P + (size_t)row * D_INP + GLA0;
          const u32x2 qv = *(const u32x2*)(pr + h * 32 + sub * 4), kv = *(const u32x2*)(pr + 128 + h * 32 + sub * 4);
          const f32x4 dv = *(const f32x4*)(GD + (size_t)row * 128 + h * 32 + sub * 4);
          const u32x4 vv8 = *(const u32x4*)(pr + 256 + h * 64 + sub * 8);
          const float qs = 0.17677669529663687f;
          *(LAS f32x4*)(sq + tt * 32 + sub * 4) = (f32x4){lo_bf(qv.x) * qs, hi_bf(qv.x) * qs, lo_bf(qv.y) * qs, hi_bf(qv.y) * qs};
          *(LAS f32x4*)(sk + tt * 32 + sub * 4) = (f32x4){lo_bf(kv.x), hi_bf(kv.x), lo_bf(kv.y), hi_bf(kv.y)};
          *(LAS f32x4*)(sd + tt * 32 + sub * 4) = dv;
          *(LAS f32x4*)(sv + tt * 64 + sub * 8) = (f32x4){lo_bf(vv8.x), hi_bf(vv8.x), lo_bf(vv8.y), hi_bf(vv8.y)};
          *(LAS f32x4*)(sv + tt * 64 + sub * 8 + 4) = (f32x4){lo_bf(vv8.z), hi_bf(vv8.z), lo_bf(vv8.w), hi_bf(vv8.w)}; }
        __syncthreads();
#pragma unroll 4
        for (int tt = 0; tt < 64; ++tt) {
            const f32x4 q4 = *(const LAS f32x4*)(sq + tt * 32 + kq * 4), k4 = *(const LAS f32x4*)(sk + tt * 32 + kq * 4), d4 = *(const LAS f32x4*)(sd + tt * 32 + kq * 4);
            const float v = sv[tt * 64 + w * 8 + vv];
            float o = 0.f;
#pragma unroll
            for (int j = 0; j < 4; ++j) { S[j] = d4[j] * S[j] + k4[j] * v; o += q4[j] * S[j]; }
            o += __shfl_xor(o, 8); o += __shfl_xor(o, 16); o += __shfl_xor(o, 32);
            if (kq == 0) GO[(size_t)scan_row(b, dir, ch * 64 + tt) * 256 + h * 64 + w * 8 + vv] = o;
        }
        __syncthreads();
    }
}
__device__ __forceinline__ void gdn_chain(CArgs& a, int chain, LAS unsigned char* lds) {
    const int b = chain >> 3, h = (chain >> 1) & 3, dir = chain & 1;
    const int tid = tidx(), lane = tid & 63, w = tid >> 6, vv = lane & 7, kq = lane >> 3;
    const float* DQ = (const float*)(a.ws + WS_MIX + MX_DQ); const float* DK = (const float*)(a.ws + WS_MIX + MX_DK); const float* DV = (const float*)(a.ws + WS_MIX + MX_DV);
    const float* DG = (const float*)(a.ws + WS_MIX + MX_DG);
    float* DO = (float*)(a.ws + WS_MIX + (dir ? MX_DOB : MX_DOF));
    LAS float* sq = (LAS float*)lds;
    LAS float* sk = sq + 64 * 64;
    LAS float* sv = sk + 64 * 64;
    LAS float* sg = sv + 64 * 64;
    float S[8];
#pragma unroll
    for (int j = 0; j < 8; ++j) S[j] = 0.f;
    for (int ch = 0; ch < 36; ++ch) {
        { const int tt = tid >> 3, sub = tid & 7, row = scan_row(b, dir, ch * 64 + tt);
          const size_t o = (size_t)row * 256 + h * 64 + sub * 8;
          *(LAS f32x4*)(sq + tt * 64 + sub * 8) = *(const f32x4*)(DQ + o); *(LAS f32x4*)(sq + tt * 64 + sub * 8 + 4) = *(const f32x4*)(DQ + o + 4);
          *(LAS f32x4*)(sk + tt * 64 + sub * 8) = *(const f32x4*)(DK + o); *(LAS f32x4*)(sk + tt * 64 + sub * 8 + 4) = *(const f32x4*)(DK + o + 4);
          *(LAS f32x4*)(sv + tt * 64 + sub * 8) = *(const f32x4*)(DV + o); *(LAS f32x4*)(sv + tt * 64 + sub * 8 + 4) = *(const f32x4*)(DV + o + 4);
          if (sub == 0) { const f32x4 g4 = *(const f32x4*)(DG + (size_t)row * 16 + h * 4); *(LAS f32x2*)(sg + tt * 2) = dir ? (f32x2){g4[2], g4[3]} : (f32x2){g4[0], g4[1]}; } }
        __syncthreads();
#pragma unroll 2
        for (int tt = 0; tt < 64; ++tt) {
            const f32x4 ka = *(const LAS f32x4*)(sk + tt * 64 + kq * 8), kb = *(const LAS f32x4*)(sk + tt * 64 + kq * 8 + 4);
            const f32x4 qa = *(const LAS f32x4*)(sq + tt * 64 + kq * 8), qb = *(const LAS f32x4*)(sq + tt * 64 + kq * 8 + 4);
            const float v = sv[tt * 64 + w * 8 + vv]; const f32x2 g2 = *(const LAS f32x2*)(sg + tt * 2);
            const float beta = g2.x, eg = g2.y;
            float ks = (ka[0] * S[0] + ka[1] * S[1]) + (ka[2] * S[2] + ka[3] * S[3]) + ((kb[0] * S[4] + kb[1] * S[5]) + (kb[2] * S[6] + kb[3] * S[7]));
            ks += __shfl_xor(ks, 8); ks += __shfl_xor(ks, 16); ks += __shfl_xor(ks, 32);
            const float wv = beta * (v - eg * ks);
            float o = 0.f;
#pragma unroll
            for (int j = 0; j < 4; ++j) { S[j] = eg * S[j] + ka[j] * wv; o += qa[j] * S[j]; }
#pragma unroll
            for (int j = 0; j < 4; ++j) { S[4 + j] = eg * S[4 + j] + kb[j] * wv; o += qb[j] * S[4 + j]; }
            o += __shfl_xor(o, 8); o += __shfl_xor(o, 16); o += __shfl_xor(o, 32);
            if (kq == 0) DO[(size_t)scan_row(b, dir, ch * 64 + tt) * 256 + h * 64 + w * 8 + vv] = o;
        }
        __syncthreads();
    }
}
typedef unsigned u32x4a __attribute__((ext_vector_type(4)));
__device__ __forceinline__ bf16x8 frag2(u32x2 lo, u32x2 hi) { return __builtin_bit_cast(bf16x8, (u32x4){lo.x, lo.y, hi.x, hi.y}); }
__device__ __forceinline__ u32x2 cvt4(f32x4 v) { return (u32x2){pk2(v[0], v[1]), pk2(v[2], v[3])}; }

struct GdnIn { f32x2 g2; bf16x8 ak[2], aq[2], bk[2][2]; float kt8[8]; };
struct GdnIn2 { f32x4 R[4], Qv[4]; };
__device__ __forceinline__ void gdn_fetch(CArgs& a, int u, int w, int lane, GdnIn& in) {
    const int chain = u / 36, n = u % 36, b = chain >> 3, h = (chain >> 1) & 3, dir = chain & 1;
    const int r0 = scan_row(b, dir, n * 64), step = dir ? -1 : 1, fr = lane & 15, kg = lane >> 4;
    const float* DQ = (const float*)(a.ws + WS_MIX + MX_DQ) + h * 64; const float* DK = (const float*)(a.ws + WS_MIX + MX_DK) + h * 64; const float* DV = (const float*)(a.ws + WS_MIX + MX_DV) + h * 64;
    const float* DG = (const float*)(a.ws + WS_MIX + MX_DG);
    const bf16* KB = (const bf16*)(a.ws + WS_CKD + CD_KB) + (ptrdiff_t)r0 * 256 + h * 64; const bf16* QB = (const bf16*)(a.ws + WS_CKD + CD_QB) + (ptrdiff_t)r0 * 256 + h * 64;
    const ptrdiff_t ldt = (ptrdiff_t)step * 256;
    const bool isW = w >= 4; const int c0 = 16 * (w & 3), I1 = w >> 1;
    in.g2 = *(const f32x2*)(DG + (size_t)(r0 + step * lane) * 16 + h * 4 + dir * 2);
#pragma unroll
    for (int s = 0; s < 2; ++s) { in.ak[s] = *(const bf16x8*)(KB + (ptrdiff_t)(16 * I1 + fr) * ldt + 32 * s + 8 * kg); in.aq[s] = *(const bf16x8*)(QB + (ptrdiff_t)(16 * I1 + fr) * ldt + 32 * s + 8 * kg);
#pragma unroll
        for (int jj = 0; jj < 2; ++jj) in.bk[jj][s] = *(const bf16x8*)(KB + (ptrdiff_t)(16 * (2 * (w & 1) + jj) + fr) * ldt + 32 * s + 8 * kg); }
#pragma unroll
    for (int tt = 0; tt < 8; ++tt) in.kt8[tt] = DK[(size_t)(r0 + step * (8 * w + tt)) * 256 + lane];
}
__device__ __forceinline__ void gdn_fetch2(CArgs& a, int u, int w, int lane, GdnIn2& in) {
    const int chain = u / 36, n = u % 36, b = chain >> 3, h = (chain >> 1) & 3, dir = chain & 1;
    const int r0 = scan_row(b, dir, n * 64), step = dir ? -1 : 1, fr = lane & 15, kg = lane >> 4;
    const float* DQ = (const float*)(a.ws + WS_MIX + MX_DQ) + h * 64; const float* DK = (const float*)(a.ws + WS_MIX + MX_DK) + h * 64; const float* DV = (const float*)(a.ws + WS_MIX + MX_DV) + h * 64;
    const bool isW = w >= 4; const int c0 = 16 * (w & 3);
#pragma unroll
    for (int I = 0; I < 4; ++I)
#pragma unroll
        for (int e = 0; e < 4; ++e) { const size_t ro = (size_t)(r0 + step * (16 * I + 4 * kg + e)) * 256 + c0 + fr; in.R[I][e] = isW ? DK[ro] : DV[ro]; in.Qv[I][e] = isW ? DQ[ro] : 0.f; }
}
__device__ __forceinline__ float gdn_s1(const GdnIn& in, LAS unsigned char* ub, LAS unsigned char* dwb, int w, int lane) {
    const int fr = lane & 15, kg = lane >> 4, I1 = w >> 1;
    LAS bf16* AB = (LAS bf16*)ub; LAS bf16* ATT = AB + 4608; LAS bf16* KTT = ATT + 4608; LAS float* GT = (LAS float*)(dwb + 2048);
    float beta = in.g2.x, cum = in.g2.y;
#pragma unroll
    for (int o = 1; o < 64; o <<= 1) { const float t = __shfl_up(cum, o); if (lane >= o) cum += t; }
    const float cl = rdlane_f(cum, 63);
    GT[lane] = beta; GT[64 + lane] = cum; GT[128 + lane] = __expf(cum);
    asm volatile("s_waitcnt lgkmcnt(0)" ::: "memory");
    { const f32x4 ci = *(const LAS f32x4*)(GT + 64 + 16 * I1 + 4 * kg), bi = *(const LAS f32x4*)(GT + 16 * I1 + 4 * kg);
#pragma unroll
      for (int jj = 0; jj < 2; ++jj) { const int J = 2 * (w & 1) + jj;
          f32x4 ck = (f32x4){0.f, 0.f, 0.f, 0.f}, cq = (f32x4){0.f, 0.f, 0.f, 0.f};
#pragma unroll
          for (int s = 0; s < 2; ++s) { ck = __builtin_amdgcn_mfma_f32_16x16x32_bf16(in.ak[s], in.bk[jj][s], ck, 0, 0, 0); cq = __builtin_amdgcn_mfma_f32_16x16x32_bf16(in.aq[s], in.bk[jj][s], cq, 0, 0, 0); }
          const int j = 16 * J + fr; const float cj = GT[64 + j];
#pragma unroll
          for (int e = 0; e < 4; ++e) { const int i = 16 * I1 + 4 * kg + e; const float gm = __expf(fminf(ci[e] - cj, 0.f));
              AB[i * 72 + j] = (bf16)f2bf(j < i ? bi[e] * ck[e] * gm : 0.f); ATT[i * 72 + j] = (bf16)f2bf(j <= i ? cq[e] * gm : 0.f); } } }
    { const f32x4 c8a = *(const LAS f32x4*)(GT + 64 + 8 * w), c8b = *(const LAS f32x4*)(GT + 64 + 8 * w + 4);
#pragma unroll
      for (int tt = 0; tt < 8; ++tt) KTT[lane * 72 + 8 * w + tt] = (bf16)f2bf(in.kt8[tt] * __expf(cl - (tt < 4 ? c8a[tt & 3] : c8b[tt & 3]))); }
    asm volatile("s_waitcnt lgkmcnt(0)" ::: "memory");
    return cl;
}
__device__ __forceinline__ void gdn_s23(CArgs& a, int u, const GdnIn2& in, LAS unsigned char* ub, LAS unsigned char* dwb, int w, int lane, float cl) {
    const int fr = lane & 15, kg = lane >> 4;
    bf16* Mo = (bf16*)(a.ws + WS_CKD + CD_M) + (size_t)u * 4096; bf16* Eo = (bf16*)(a.ws + WS_CKD + CD_E) + (size_t)u * 4096;
    float* BTo = (float*)(a.ws + WS_CKD + CD_BT) + (size_t)u * 4096; bf16* FTo = (bf16*)(a.ws + WS_CKD + CD_FT) + (size_t)u * 4096;
    LAS bf16* AB = (LAS bf16*)ub; LAS bf16* ATT = AB + 4608; LAS bf16* KTT = ATT + 4608; LAS bf16* DW = (LAS bf16*)dwb; LAS float* GT = (LAS float*)(dwb + 2048);
    const bool isW = w >= 4; const int c0 = 16 * (w & 3);
    { const int blk = lane >> 4, c = lane & 15; float T[16];
#pragma unroll
      for (int hb = 0; hb < 4; ++hb) {
          u32x4 arow[4][2];
#pragma unroll
          for (int rr = 0; rr < 4; ++rr) { const int r = 4 * hb + rr; arow[rr][0] = *(const LAS u32x4*)(AB + (16 * blk + r) * 72 + 16 * blk); if (hb >= 2) arow[rr][1] = *(const LAS u32x4*)(AB + (16 * blk + r) * 72 + 16 * blk + 8); }
          asm volatile("s_waitcnt lgkmcnt(0)" ::: "memory");
#pragma unroll
          for (int rr = 0; rr < 4; ++rr) { const int r = 4 * hb + rr; float t = (r == c) ? 1.f : 0.f;
              float t2 = 0.f;
#pragma unroll
              for (int j = 0; j < r; ++j) { const unsigned wv = arow[rr][j >> 3][(j >> 1) & 3]; const float av = (j & 1) ? hi_bf(wv) : lo_bf(wv); if (j & 1) t2 -= av * T[j]; else t -= av * T[j]; }
              t += t2;
              T[r] = t; DW[(blk * 16 + r) * 16 + c] = (bf16)f2bf(t); } } }
    asm volatile("s_waitcnt lgkmcnt(0)" ::: "memory");
    f32x4 X[4];
#pragma unroll
    for (int I = 0; I < 4; ++I) {
        const f32x4 br = *(const LAS f32x4*)(GT + 16 * I + 4 * kg), er = *(const LAS f32x4*)(GT + 128 + 16 * I + 4 * kg);
        f32x4 acc = isW ? br * er * in.R[I] : br * in.R[I];
#pragma unroll
        for (int P = 0; 2 * P < I; ++P) {
            const u32x2 alo = *(const LAS u32x2*)(AB + (16 * I + fr) * 72 + 32 * P + 4 * kg);
            const u32x2 ahi = (2 * P + 1 < I) ? *(const LAS u32x2*)(AB + (16 * I + fr) * 72 + 32 * P + 16 + 4 * kg) : (u32x2){0u, 0u};
            const u32x2 xlo = cvt4(-X[2 * P]); const u32x2 xhi = (2 * P + 1 < I) ? cvt4(-X[2 * P + 1]) : (u32x2){0u, 0u};
            acc = __builtin_amdgcn_mfma_f32_16x16x32_bf16(frag2(alo, ahi), frag2(xlo, xhi), acc, 0, 0, 0); }
        const u32x2 dlo = *(const LAS u32x2*)(DW + (I * 16 + fr) * 16 + 4 * kg);
        X[I] = __builtin_amdgcn_mfma_f32_16x16x32_bf16(frag2(dlo, (u32x2){0u, 0u}), frag2(cvt4(acc), (u32x2){0u, 0u}), (f32x4){0.f, 0.f, 0.f, 0.f}, 0, 0, 0);
    }
    const bf16x8 Xb01 = frag2(cvt4(X[0]), cvt4(X[1])), Xb23 = frag2(cvt4(X[2]), cvt4(X[3]));
    const float ecl = __expf(cl);
    bf16* ftp = FTo + (c0 + fr) * 64 + 4 * kg; float* btp = BTo + (c0 + fr) * 64 + 4 * kg; bf16* ep = Eo + (4 * kg) * 64 + c0 + fr; bf16* mp = Mo + (4 * kg) * 64 + c0 + fr;
#pragma unroll
    for (int t4 = 0; t4 < 4; ++t4) {
        const LAS bf16* ar = ATT + (16 * t4 + fr) * 72 + 4 * kg; const LAS bf16* kr = KTT + (16 * t4 + fr) * 72 + 4 * kg;
        f32x4 pa = (f32x4){0.f, 0.f, 0.f, 0.f}, pk = (f32x4){0.f, 0.f, 0.f, 0.f};
        pa = __builtin_amdgcn_mfma_f32_16x16x32_bf16(frag2(*(const LAS u32x2*)ar, *(const LAS u32x2*)(ar + 16)), Xb01, pa, 0, 0, 0);
        pa = __builtin_amdgcn_mfma_f32_16x16x32_bf16(frag2(*(const LAS u32x2*)(ar + 32), *(const LAS u32x2*)(ar + 48)), Xb23, pa, 0, 0, 0);
        pk = __builtin_amdgcn_mfma_f32_16x16x32_bf16(frag2(*(const LAS u32x2*)kr, *(const LAS u32x2*)(kr + 16)), Xb01, pk, 0, 0, 0);
        pk = __builtin_amdgcn_mfma_f32_16x16x32_bf16(frag2(*(const LAS u32x2*)(kr + 32), *(const LAS u32x2*)(kr + 48)), Xb23, pk, 0, 0, 0);
        if (!isW) {
            *(u32x2*)(ftp + 16 * t4) = cvt4(pa);
            *(f32x4*)(btp + 16 * t4) = pk;
        } else {
            const f32x4 ec = *(const LAS f32x4*)(GT + 128 + 16 * t4 + 4 * kg);
#pragma unroll
            for (int e = 0; e < 4; ++e) { const int row = 16 * t4 + 4 * kg + e, col = c0 + fr;
                ep[(16 * t4 + e) * 64] = (bf16)f2bf(ec[e] * in.Qv[t4][e] - pa[e]);
                mp[(16 * t4 + e) * 64] = (bf16)f2bf((row == col ? ecl : 0.f) - pk[e]); }
        }
    }
}
__device__ __forceinline__ void gdn_chain_units(CArgs& a, int chain, LAS unsigned char* lds, int w, int lane, unsigned long long& tacc) {
    asm volatile("" : "+v"(lane));
    LAS unsigned char* dwb = lds + 55296 + w * 3072;
    GdnIn A, B; GdnIn2 C;
    gdn_fetch(a, chain * 36, w, lane, A);
#pragma unroll 1
    for (int n = 0; n < 36; n += 2) {
        asm volatile("" : "+v"(lane));
        { unsigned long long tq = 0ull; if (PROBE_PH >= 60 && PROBE_PH <= 62) tq = __builtin_amdgcn_s_memrealtime();
          gdn_fetch2(a, chain * 36 + n, w, lane, C); const float cl = gdn_s1(A, lds, dwb, w, lane);
          if (PROBE_PH == 60) tacc += __builtin_amdgcn_s_memrealtime() - tq; if (PROBE_PH == 61) tq = __builtin_amdgcn_s_memrealtime();
          __syncthreads();
          if (PROBE_PH == 61) tacc += __builtin_amdgcn_s_memrealtime() - tq; if (PROBE_PH >= 62 && PROBE_PH <= 64) tq = __builtin_amdgcn_s_memrealtime();
          gdn_fetch(a, chain * 36 + n + 1, w, lane, B); gdn_s23(a, chain * 36 + n, C, lds, dwb, w, lane, cl);
          if (PROBE_PH == 62 || (PROBE_PH == 63 && w < 4) || (PROBE_PH == 64 && w >= 4)) tacc += __builtin_amdgcn_s_memrealtime() - tq; }
        asm volatile("" : "+v"(lane));
        { gdn_fetch2(a, chain * 36 + n + 1, w, lane, C); const float cl = gdn_s1(B, lds + 27648, dwb, w, lane); __syncthreads(); if (n + 2 < 36) gdn_fetch(a, chain * 36 + n + 2, w, lane, A); gdn_s23(a, chain * 36 + n + 1, C, lds + 27648, dwb, w, lane, cl); }
    }
}
__device__ __forceinline__ void gdn_seq_wave(CArgs& a, int chain, int vs, int lane) {
    asm volatile("" : "+v"(lane));
    const int b = chain >> 3, h = (chain >> 1) & 3, dir = chain & 1, fr = lane & 15, kg = lane >> 4, v = 16 * vs + fr, step = dir ? -1 : 1;
    float* DO = (float*)(a.ws + WS_MIX + (dir ? MX_DOB : MX_DOF));
    f32x4 S[4];
#pragma unroll
    for (int i = 0; i < 4; ++i) S[i] = (f32x4){0.f, 0.f, 0.f, 0.f};
#pragma unroll 1
    for (int n = 0; n < 36; ++n) {
        const int u = chain * 36 + n, r0 = scan_row(b, dir, n * 64);
        const bf16* Mo = (const bf16*)(a.ws + WS_CKD + CD_M) + (size_t)u * 4096; const bf16* Eo = (const bf16*)(a.ws + WS_CKD + CD_E) + (size_t)u * 4096;
        const float* BTo = (const float*)(a.ws + WS_CKD + CD_BT) + (size_t)u * 4096; const bf16* FTo = (const bf16*)(a.ws + WS_CKD + CD_FT) + (size_t)u * 4096;
        u32x2 ef[4][2][2], mf[4][2][2], ff[4]; f32x4 bi[4];
#pragma unroll
        for (int t = 0; t < 4; ++t) { ff[t] = *(const u32x2*)(FTo + v * 64 + 16 * t + 4 * kg); bi[t] = *(const f32x4*)(BTo + v * 64 + 16 * t + 4 * kg);
#pragma unroll
            for (int s = 0; s < 2; ++s) { const bf16* er = Eo + (16 * t + fr) * 64 + 32 * s + 4 * kg; ef[t][s][0] = *(const u32x2*)er; ef[t][s][1] = *(const u32x2*)(er + 16);
                const bf16* mr = Mo + (16 * t + fr) * 64 + 32 * s + 4 * kg; mf[t][s][0] = *(const u32x2*)mr; mf[t][s][1] = *(const u32x2*)(mr + 16); } }
        bf16x8 Sb[2];
#pragma unroll
        for (int s = 0; s < 2; ++s) Sb[s] = frag2(cvt4(S[2 * s]), cvt4(S[2 * s + 1]));
        f32x4 o[4];
#pragma unroll
        for (int t = 0; t < 4; ++t) { o[t] = (f32x4){lo_bf(ff[t].x), hi_bf(ff[t].x), lo_bf(ff[t].y), hi_bf(ff[t].y)};
#pragma unroll
            for (int s = 0; s < 2; ++s) o[t] = __builtin_amdgcn_mfma_f32_16x16x32_bf16(frag2(ef[t][s][0], ef[t][s][1]), Sb[s], o[t], 0, 0, 0);
            f32x4 sn = bi[t];
#pragma unroll
            for (int s = 0; s < 2; ++s) sn = __builtin_amdgcn_mfma_f32_16x16x32_bf16(frag2(mf[t][s][0], mf[t][s][1]), Sb[s], sn, 0, 0, 0);
            S[t] = sn; }
#pragma unroll
        for (int t = 0; t < 4; ++t)
#pragma unroll
            for (int e = 0; e < 4; ++e) DO[(size_t)(r0 + step * (16 * t + 4 * kg + e)) * 256 + h * 64 + v] = o[t][e];
    }
}

__device__ __forceinline__ void gdn_seq_block(CArgs& a, int chain, LAS unsigned char* lds, int w, int lane) {
    asm volatile("" : "+v"(lane));
    const int b = chain >> 3, h = (chain >> 1) & 3, dir = chain & 1, fr = lane & 15, kg = lane >> 4, step = dir ? -1 : 1;
    constexpr int SLOT = 45056;
    if (w >= 4) {
        const int q = w - 4;
        u32x4 rg[10];
#define SEQ_LD(n_) do { const int u_ = chain * 36 + (n_); \
        _Pragma("unroll") for (int j = 0; j < 10; ++j) { const int c_ = q + 4 * j; \
            const unsigned char* g_ = c_ < 8 ? a.ws + WS_CKD + CD_M + (size_t)u_ * 8192 + c_ * 1024 : (c_ < 16 ? a.ws + WS_CKD + CD_E + (size_t)u_ * 8192 + (c_ - 8) * 1024 : \
                (c_ < 32 ? a.ws + WS_CKD + CD_BT + (size_t)u_ * 16384 + (c_ - 16) * 1024 : a.ws + WS_CKD + CD_FT + (size_t)u_ * 8192 + (c_ - 32) * 1024)); \
            rg[j] = *(const u32x4*)(g_ + lane * 16); } } while (0)
#define SEQ_ST(n_) do { LAS unsigned char* s_ = lds + ((n_) % 3) * SLOT; \
        _Pragma("unroll") for (int j = 0; j < 10; ++j) { const int c_ = q + 4 * j; \
            const int off_ = c_ < 8 ? (c_ * 8 + (lane >> 3)) * 144 + (lane & 7) * 16 : (c_ < 16 ? 9216 + ((c_ - 8) * 8 + (lane >> 3)) * 144 + (lane & 7) * 16 : \
                (c_ < 32 ? 18432 + ((c_ - 16) * 4 + (lane >> 4)) * 272 + (lane & 15) * 16 : 35840 + ((c_ - 32) * 8 + (lane >> 3)) * 144 + (lane & 7) * 16)); \
            *(LAS u32x4*)(s_ + off_) = rg[j]; } } while (0)
        SEQ_LD(0); SEQ_ST(0); SEQ_LD(1); SEQ_ST(1); SEQ_LD(2);
        asm volatile("s_waitcnt lgkmcnt(0)" ::: "memory");
        __syncthreads();
#pragma unroll 1
        for (int n = 0; n < 36; ++n) {
            if (n + 2 < 36) { SEQ_ST(n + 2); }
            if (n + 3 < 36) { SEQ_LD(n + 3); }
            asm volatile("s_waitcnt lgkmcnt(0)" ::: "memory");
            __syncthreads();
        }
#undef SEQ_LD
#undef SEQ_ST
    } else {
        const int v = 16 * w + fr;
        float* DO = (float*)(a.ws + WS_MIX + (dir ? MX_DOB : MX_DOF));
        f32x4 S[4];
#pragma unroll
        for (int i = 0; i < 4; ++i) S[i] = (f32x4){0.f, 0.f, 0.f, 0.f};
        __syncthreads();
#pragma unroll 1
        for (int n = 0; n < 36; ++n) {
            const LAS unsigned char* sl = lds + (n % 3) * SLOT; const int r0 = scan_row(b, dir, n * 64);
            bf16x8 Sb[2];
#pragma unroll
            for (int s = 0; s < 2; ++s) Sb[s] = frag2(cvt4(S[2 * s]), cvt4(S[2 * s + 1]));
            f32x4 o[4];
#pragma unroll
            for (int t = 0; t < 4; ++t) {
                const u32x2 ff = *(const LAS u32x2*)(sl + 35840 + v * 144 + (16 * t + 4 * kg) * 2);
                o[t] = (f32x4){lo_bf(ff.x), hi_bf(ff.x), lo_bf(ff.y), hi_bf(ff.y)};
                f32x4 sn = *(const LAS f32x4*)(sl + 18432 + v * 272 + (16 * t + 4 * kg) * 4);
#pragma unroll
                for (int s = 0; s < 2; ++s) { const LAS unsigned char* er = sl + 9216 + (16 * t + fr) * 144 + (32 * s + 4 * kg) * 2; const LAS unsigned char* mr = sl + (16 * t + fr) * 144 + (32 * s + 4 * kg) * 2;
                    o[t] = __builtin_amdgcn_mfma_f32_16x16x32_bf16(frag2(*(const LAS u32x2*)er, *(const LAS u32x2*)(er + 32)), Sb[s], o[t], 0, 0, 0);
                    sn = __builtin_amdgcn_mfma_f32_16x16x32_bf16(frag2(*(const LAS u32x2*)mr, *(const LAS u32x2*)(mr + 32)), Sb[s], sn, 0, 0, 0); }
                S[t] = sn; }
            { float* dp = DO + (ptrdiff_t)(r0 + step * 4 * kg) * 256 + h * 64 + v; const ptrdiff_t sd = (ptrdiff_t)step * 256;
#pragma unroll
              for (int t = 0; t < 4; ++t)
#pragma unroll
                  for (int e = 0; e < 4; ++e) dp[(16 * t + e) * sd] = o[t][e]; }
            __syncthreads();
        }
    }
}
__device__ __forceinline__ void gla_seq_block(CArgs& a, int chain, LAS unsigned char* lds, int w, int lane) {
    asm volatile("" : "+v"(lane));
    const int b = chain >> 3, h = (chain >> 1) & 3, dir = chain & 1, fr = lane & 15, kg = lane >> 4, step = dir ? -1 : 1;
    constexpr int SLOT = 23680;
    if (w >= 4) {
        const int q = w - 4;
        u32x4 rg[5]; float dl = 0.f;
#define SEQ_LD(n_) do { const int u_ = chain * 36 + (n_); \
        _Pragma("unroll") for (int j = 0; j < 5; ++j) { const int c_ = q + 4 * j; \
            const unsigned char* g_ = c_ < 4 ? a.ws + WS_CKA + CA_QC + (size_t)u_ * 4096 + c_ * 1024 : (c_ < 12 ? a.ws + WS_CKA + CA_FT + (size_t)u_ * 8192 + (c_ - 4) * 1024 : a.ws + WS_CKA + CA_UT + (size_t)u_ * 8192 + (c_ - 12) * 1024); \
            rg[j] = *(const u32x4*)(g_ + lane * 16); } \
        if (q == 0) dl = ((const float*)(a.ws + WS_CKA + CA_DL))[(size_t)u_ * 32 + (lane & 31)]; } while (0)
#define SEQ_ST(n_) do { LAS unsigned char* s_ = lds + ((n_) % 3) * SLOT; \
        _Pragma("unroll") for (int j = 0; j < 5; ++j) { const int c_ = q + 4 * j; \
            const int off_ = c_ < 4 ? (c_ * 16 + (lane >> 2)) * 80 + (lane & 3) * 16 : (c_ < 12 ? 5120 + ((c_ - 4) * 8 + (lane >> 3)) * 144 + (lane & 7) * 16 : 14336 + ((c_ - 12) * 8 + (lane >> 3)) * 144 + (lane & 7) * 16); \
            *(LAS u32x4*)(s_ + off_) = rg[j]; } \
        if (q == 0 && lane < 32) *(LAS float*)(s_ + 23552 + lane * 4) = dl; } while (0)
        SEQ_LD(0); SEQ_ST(0); SEQ_LD(1); SEQ_ST(1); SEQ_LD(2);
        asm volatile("s_waitcnt lgkmcnt(0)" ::: "memory");
        __syncthreads();
#pragma unroll 1
        for (int n = 0; n < 36; ++n) {
            if (n + 2 < 36) { SEQ_ST(n + 2); }
            if (n + 3 < 36) { SEQ_LD(n + 3); }
            asm volatile("s_waitcnt lgkmcnt(0)" ::: "memory");
            __syncthreads();
        }
#undef SEQ_LD
#undef SEQ_ST
    } else {
        const int v = 16 * w + fr;
        float* GO = (float*)(a.ws + WS_MIX + (dir ? MX_GOB : MX_GOF));
        f32x4 S[2] = {(f32x4){0.f, 0.f, 0.f, 0.f}, (f32x4){0.f, 0.f, 0.f, 0.f}};
        __syncthreads();
#pragma unroll 1
        for (int n = 0; n < 36; ++n) {
            const LAS unsigned char* sl = lds + (n % 3) * SLOT; const int r0 = scan_row(b, dir, n * 64);
            const bf16x8 Sb = frag2(cvt4(S[0]), cvt4(S[1]));
            f32x4 o[4];
#pragma unroll
            for (int t = 0; t < 4; ++t) { const u32x2 ff = *(const LAS u32x2*)(sl + 5120 + v * 144 + (16 * t + 4 * kg) * 2);
                o[t] = (f32x4){lo_bf(ff.x), hi_bf(ff.x), lo_bf(ff.y), hi_bf(ff.y)};
                const LAS unsigned char* qr = sl + (16 * t + fr) * 80 + 4 * kg * 2;
                o[t] = __builtin_amdgcn_mfma_f32_16x16x32_bf16(frag2(*(const LAS u32x2*)qr, *(const LAS u32x2*)(qr + 32)), Sb, o[t], 0, 0, 0); }
#pragma unroll
            for (int kt = 0; kt < 2; ++kt) { const f32x4 d4 = *(const LAS f32x4*)(sl + 23552 + (16 * kt + 4 * kg) * 4), u4 = *(const LAS f32x4*)(sl + 14336 + v * 144 + (16 * kt + 4 * kg) * 4); S[kt] = d4 * S[kt] + u4; }
            { float* gp = GO + (ptrdiff_t)(r0 + step * 4 * kg) * 256 + h * 64 + v; const ptrdiff_t sd = (ptrdiff_t)step * 256;
#pragma unroll
              for (int t = 0; t < 4; ++t)
#pragma unroll
                  for (int e = 0; e < 4; ++e) gp[(16 * t + e) * sd] = o[t][e]; }
            __syncthreads();
        }
    }
}

struct GlaIn { float bc[32]; unsigned px[32]; };
__device__ __forceinline__ void gla_fetch(CArgs& a, int u, int w, int lane, GlaIn& in) {
    const int chain = u / 36, n = u % 36, b = chain >> 3, h = (chain >> 1) & 3, dir = chain & 1;
    const int r0 = scan_row(b, dir, n * 64), step = dir ? -1 : 1;
    const bf16* P = (const bf16*)(a.ws + WS_P);
    const float* GD = (const float*)(a.ws + WS_MIX + (dir ? MX_GDB : MX_GDF));
    if (w < 4) { const int k = lane & 31, half = lane >> 5; const int src_off = (w == 0 || w == 2) ? 0 : 128;
#pragma unroll
        for (int i = 0; i < 32; ++i) { in.bc[i] = GD[(size_t)(r0 + step * (32 * half + i)) * 128 + h * 32 + k]; in.px[i] = P[(size_t)(r0 + step * (32 * half + i)) * D_INP + GLA0 + src_off + h * 32 + k]; }
    } else { const int vv = 16 * (w - 4) + (lane & 15), tq = lane >> 4;
#pragma unroll
        for (int i = 0; i < 16; ++i) in.px[i] = P[(size_t)(r0 + step * (16 * tq + i)) * D_INP + GLA0 + 256 + h * 64 + vv];
#pragma unroll
        for (int i = 16; i < 32; ++i) in.px[i] = 0u;
#pragma unroll
        for (int i = 0; i < 32; ++i) in.bc[i] = 0.f;
    }
}
__device__ __forceinline__ void gla_s1(CArgs& a, int u, GlaIn& in, LAS unsigned char* ub, int w, int lane) {
    bf16* QC = (bf16*)(a.ws + WS_CKA + CA_QC) + (size_t)u * 2048; float* DL = (float*)(a.ws + WS_CKA + CA_DL) + (size_t)u * 32;
    LAS bf16* QE = (LAS bf16*)ub; LAS bf16* KE = QE + 2560; LAS bf16* KTT = KE + 2560; LAS bf16* VT = KTT + 2304;
    if (w < 4) {
        const int k = lane & 31, half = lane >> 5;
        float run = 0.f;
#pragma unroll
        for (int i = 0; i < 32; ++i) { run += in.bc[i]; in.bc[i] = run; }
        const float tot0 = __shfl(run, k), tot1 = __shfl(run, 32 + k);
        const float bref = tot0, blast = tot0 + tot1, off = half ? tot0 : 0.f;
        const float sc = (w == 0 || w == 2) ? 0.17677669529663687f : 1.f;
#pragma unroll
        for (int i = 0; i < 32; ++i) { const int t = 32 * half + i; const float bi = in.bc[i] + off;
            const float x = bf2f(in.px[i]) * sc;
            const float ex = w == 0 ? bi - bref : (w == 1 ? bref - bi : (w == 2 ? bi : blast - bi));
            const bf16 y = (bf16)f2bf(x * __expf(ex));
            if (w == 0) QE[t * 40 + k] = y; else if (w == 1) KE[t * 40 + k] = y; else if (w == 2) QC[t * 32 + k] = y; else KTT[k * 72 + t] = y; }
        if (w == 2 && half == 0) DL[k] = __expf(blast);
    } else {
        const int vv = 16 * (w - 4) + (lane & 15), tq = lane >> 4;
#pragma unroll
        for (int i = 0; i < 16; ++i) VT[vv * 72 + 16 * tq + i] = in.px[i];
    }
    asm volatile("s_waitcnt lgkmcnt(0)" ::: "memory");
}
__device__ __forceinline__ void gla_s2(CArgs& a, int u, LAS unsigned char* ub, int w, int lane) {
    const int fr = lane & 15, kg = lane >> 4;
    bf16* FT = (bf16*)(a.ws + WS_CKA + CA_FT) + (size_t)u * 4096; float* UT = (float*)(a.ws + WS_CKA + CA_UT) + (size_t)u * 2048;
    LAS bf16* QE = (LAS bf16*)ub; LAS bf16* KE = QE + 2560; LAS bf16* KTT = KE + 2560; LAS bf16* VT = KTT + 2304;
    const int It = w & 3, vh = w >> 2;
    const bf16x8 qf = *(const LAS bf16x8*)(QE + (16 * It + fr) * 40 + 8 * kg);
    f32x4 st[4];
#pragma unroll
    for (int Jt = 0; Jt < 4; ++Jt) { const bf16x8 kf = *(const LAS bf16x8*)(KE + (16 * Jt + fr) * 40 + 8 * kg);
        st[Jt] = __builtin_amdgcn_mfma_f32_16x16x32_bf16(kf, qf, (f32x4){0.f, 0.f, 0.f, 0.f}, 0, 0, 0);
#pragma unroll
        for (int e = 0; e < 4; ++e) st[Jt][e] = (16 * Jt + 4 * kg + e <= 16 * It + fr) ? st[Jt][e] : 0.f; }
    const bf16x8 Sb01 = frag2(cvt4(st[0]), cvt4(st[1])), Sb23 = frag2(cvt4(st[2]), cvt4(st[3]));
    bf16* ftp = FT + (4 * kg) * 64 + 16 * It + fr;
#pragma unroll
    for (int vv = 0; vv < 2; ++vv) { const int Vt = 2 * vh + vv; const LAS bf16* vr = VT + (16 * Vt + fr) * 72 + 4 * kg;
        f32x4 f = (f32x4){0.f, 0.f, 0.f, 0.f};
        f = __builtin_amdgcn_mfma_f32_16x16x32_bf16(frag2(*(const LAS u32x2*)vr, *(const LAS u32x2*)(vr + 16)), Sb01, f, 0, 0, 0);
        f = __builtin_amdgcn_mfma_f32_16x16x32_bf16(frag2(*(const LAS u32x2*)(vr + 32), *(const LAS u32x2*)(vr + 48)), Sb23, f, 0, 0, 0);
#pragma unroll
        for (int e = 0; e < 4; ++e) ftp[(16 * Vt + e) * 64] = (bf16)f2bf(f[e]); }
    const int kt = w & 1, Vu = w >> 1;
    f32x4 uu = (f32x4){0.f, 0.f, 0.f, 0.f};
#pragma unroll
    for (int s = 0; s < 2; ++s) uu = __builtin_amdgcn_mfma_f32_16x16x32_bf16(*(const LAS bf16x8*)(KTT + (16 * kt + fr) * 72 + 32 * s + 8 * kg), *(const LAS bf16x8*)(VT + (16 * Vu + fr) * 72 + 32 * s + 8 * kg), uu, 0, 0, 0);
    *(f32x4*)(UT + (16 * Vu + fr) * 32 + 16 * kt + 4 * kg) = uu;
}
__device__ __forceinline__ void gla_chain_units(CArgs& a, int chain, LAS unsigned char* lds, int w, int lane) {
    GlaIn A, B;
    asm volatile("" : "+v"(lane));
    gla_fetch(a, chain * 36, w, lane, A);
#pragma unroll 1
    for (int n = 0; n < 36; n += 2) {
        asm volatile("" : "+v"(lane));
        { gla_s1(a, chain * 36 + n, A, lds, w, lane); __syncthreads(); gla_fetch(a, chain * 36 + n + 1, w, lane, B); gla_s2(a, chain * 36 + n, lds, w, lane); }
        asm volatile("" : "+v"(lane));
        { gla_s1(a, chain * 36 + n + 1, B, lds + 24064, w, lane); __syncthreads(); if (n + 2 < 36) gla_fetch(a, chain * 36 + n + 2, w, lane, A); gla_s2(a, chain * 36 + n + 1, lds + 24064, w, lane); }
    }
}
__device__ __forceinline__ void gla_seq_wave(CArgs& a, int chain, int vs, int lane) {
    asm volatile("" : "+v"(lane));
    const int b = chain >> 3, h = (chain >> 1) & 3, dir = chain & 1, fr = lane & 15, kg = lane >> 4, v = 16 * vs + fr, step = dir ? -1 : 1;
    float* GO = (float*)(a.ws + WS_MIX + (dir ? MX_GOB : MX_GOF));
    f32x4 S[2] = {(f32x4){0.f, 0.f, 0.f, 0.f}, (f32x4){0.f, 0.f, 0.f, 0.f}};
#pragma unroll 1
    for (int n = 0; n < 36; ++n) {
        const int u = chain * 36 + n, r0 = scan_row(b, dir, n * 64);
        const bf16* QC = (const bf16*)(a.ws + WS_CKA + CA_QC) + (size_t)u * 2048; const bf16* FT = (const bf16*)(a.ws + WS_CKA + CA_FT) + (size_t)u * 4096;
        const float* UT = (const float*)(a.ws + WS_CKA + CA_UT) + (size_t)u * 2048; const float* DL = (const float*)(a.ws + WS_CKA + CA_DL) + (size_t)u * 32;
        u32x2 qf[4][2], ff[4]; f32x4 d4[2], u4[2];
#pragma unroll
        for (int t = 0; t < 4; ++t) { const bf16* qr = QC + (16 * t + fr) * 32; qf[t][0] = *(const u32x2*)(qr + 4 * kg); qf[t][1] = *(const u32x2*)(qr + 16 + 4 * kg); ff[t] = *(const u32x2*)(FT + v * 64 + 16 * t + 4 * kg); }
#pragma unroll
        for (int kt = 0; kt < 2; ++kt) { d4[kt] = *(const f32x4*)(DL + 16 * kt + 4 * kg); u4[kt] = *(const f32x4*)(UT + v * 32 + 16 * kt + 4 * kg); }
        const bf16x8 Sb = frag2(cvt4(S[0]), cvt4(S[1]));
        f32x4 o[4];
#pragma unroll
        for (int t = 0; t < 4; ++t) { o[t] = (f32x4){lo_bf(ff[t].x), hi_bf(ff[t].x), lo_bf(ff[t].y), hi_bf(ff[t].y)};
            o[t] = __builtin_amdgcn_mfma_f32_16x16x32_bf16(frag2(qf[t][0], qf[t][1]), Sb, o[t], 0, 0, 0); }
#pragma unroll
        for (int kt = 0; kt < 2; ++kt) S[kt] = d4[kt] * S[kt] + u4[kt];
#pragma unroll
        for (int t = 0; t < 4; ++t)
#pragma unroll
            for (int e = 0; e < 4; ++e) GO[(size_t)(r0 + step * (16 * t + 4 * kg + e)) * 256 + h * 64 + v] = o[t][e];
    }
}

template <int L>
__device__ __forceinline__ void hyena_unit(CArgs& a, int l, int c, LAS unsigned char* lds) {
    constexpr int Lt = L == SEQ ? 1 : 0, SOFF = L == SEQ ? CTXL : 0, CST = (2 * L + 16) * 2 + 32;
    constexpr int NTW = L / 16 / 8;
    const int tid = tidx(), lane = tid & 63, w = tid >> 6, fr = lane & 15, kg = lane >> 4;
    const float* kf = (const float*)(a.ws + WS_KUN) + ((size_t)((l * 2 + Lt) * 512 + c)) * 2048;
    const float* kb = kf + (size_t)256 * 2048;
    LAS float* red = (LAS float*)(lds + 8 * CST);
    const bf16* Z = (const bf16*)(a.ws + WS_MIX + MX_ZT) + ((size_t)(c * 16 + fr)) * 2304 + SOFF;
    const bf16* zp = Z + 8 * kg;
    bf16x8 zc[8];
#pragma unroll
    for (int ii = 0; ii < 8; ++ii) zc[ii] = *(const bf16x8*)(zp + 32 * ii);
    constexpr int NI = (2 * L + 16 + 511) / 512;
    float gv[NI];
    float s = 0.f;
#pragma unroll
    for (int q = 0; q < NI; ++q) {
        const int idx = tid + 512 * q, ic = min(max(idx, 1), 2 * L - 1);
        const float v = *(ic <= L ? kf + (L - ic) : kb + (ic - L));
        gv[q] = (idx >= 1 && idx < 2 * L) ? v : 0.f;
        s += fabsf(gv[q]);
    }
    s = wave_sum(s);
    if (lane == 0) red[w] = s;
    __syncthreads();
    float l1 = 0.f;
#pragma unroll
    for (int i = 0; i < 8; ++i) l1 += red[i];
    const float inv = 1.f / l1;
#pragma unroll
    for (int q = 0; q < NI; ++q) {
        const int idx = tid + 512 * q;
        const bf16 gb = (bf16)f2bf(gv[q] * inv);
        if (idx < 2 * L + 16) {
#pragma unroll
            for (int r = 0; r < 8; ++r) if (idx - r >= 0) *(LAS bf16*)(lds + r * CST + (idx - r) * 2) = gb;
        }
    }
    __syncthreads();
    float* YT = (float*)(a.ws + WS_MIX + MX_YT) + ((size_t)(c * 16 + fr)) * 2304 + SOFF;
    f32x4 acc[NTW];
#pragma unroll
    for (int j = 0; j < NTW; ++j) acc[j] = (f32x4){0.f, 0.f, 0.f, 0.f};
    const int rr = (8 - (fr & 7)) & 7;
    const LAS unsigned char* ap = lds + rr * CST + (((8 * kg - fr + L) >> 3) - 2 * w * NTW) * 16;
    if constexpr (L == SEQ) {
        static_assert(NTW == 16, "hyena_unit");
        bf16x8 zn[8], A[16];
#pragma unroll
        for (int j = 2; j < 16; ++j) A[j] = *(const LAS bf16x8*)(ap - 32 * j);
#pragma unroll 1
        for (int ib = 0; ib < 8; ++ib) {
            const bf16* zq = zp + 256 * (ib < 7 ? ib + 1 : 7);
#pragma unroll
            for (int ii = 0; ii < 8; ++ii) zn[ii] = *(const bf16x8*)(zq + 32 * ii);
#pragma unroll
            for (int ii = 0; ii < 8; ++ii) {
                A[(16 - 2 * ii) & 15] = *(const LAS bf16x8*)(ap + 64 * ii);
                A[(17 - 2 * ii) & 15] = *(const LAS bf16x8*)(ap + 64 * ii - 32);
#pragma unroll
                for (int jj = 0; jj < 16; ++jj) { const int j = (jj + 2) & 15; acc[j] = __builtin_amdgcn_mfma_f32_16x16x32_bf16(A[(j + 16 - 2 * ii) & 15], zc[ii], acc[j], 0, 0, 0); }
            }
            ap += 512;
#pragma unroll
            for (int ii = 0; ii < 8; ++ii) zc[ii] = zn[ii];
        }
    } else {
        static_assert(L == 256, "hyena_unit");
#pragma unroll
        for (int i = 0; i < 8; ++i)
#pragma unroll
            for (int j = 0; j < NTW; ++j) acc[j] = __builtin_amdgcn_mfma_f32_16x16x32_bf16(*(const LAS bf16x8*)(ap + (4 * i - 2 * j) * 16), zc[i], acc[j], 0, 0, 0);
    }
#pragma unroll
    for (int j = 0; j < NTW; ++j) *(f32x4*)(YT + 16 * (w * NTW + j) + 4 * kg) = acc[j];
    __syncthreads();
}
__device__ __forceinline__ void ph_scan(CArgs& a, int l, LAS unsigned char* lds, int bid, int nblk, unsigned long long& tacc) {
    const int tid = tidx(), lane = tid & 63, w = __builtin_amdgcn_readfirstlane(tid >> 6);
    unsigned long long t0 = 0ull;
    if (PROBE_PH >= 20 && PROBE_PH < 50) t0 = __builtin_amdgcn_s_memrealtime();
#pragma unroll 1
    for (int c = bid; c < 256; c += nblk) {
        if (c < 128) {
            gdn_chain_units(a, c, lds, w, lane, tacc);
        } else {
            gla_chain_units(a, c - 128, lds, w, lane);
        }
        asm volatile("s_waitcnt vmcnt(0)" ::: "memory");
        __syncthreads();
        if (PROBE_PH == 20 && c < 128) tacc += __builtin_amdgcn_s_memrealtime() - t0;
        if (PROBE_PH == 24 && c >= 128) tacc += __builtin_amdgcn_s_memrealtime() - t0;
        if (PROBE_PH == 21) t0 = __builtin_amdgcn_s_memrealtime();
        if (c < 128) gdn_seq_block(a, c, lds, w, lane); else gla_seq_block(a, c - 128, lds, w, lane);
        __syncthreads();
        if (PROBE_PH == 21) tacc += __builtin_amdgcn_s_memrealtime() - t0;
    }
    if (PROBE_PH == 22) t0 = __builtin_amdgcn_s_memrealtime();
    {
        LAS unsigned char* scr = lds + w * 8448;
        if (nblk == 256) { const int per = bid < 128 ? 16 : 32, first = bid < 128 ? (bid * 8 + w) * 16 : 16384 + ((bid - 128) * 8 + w) * 32;
            tr_experts_range(a, l, scr, first, first + per, 1, lane); }
        else tr_experts_range(a, l, scr, bid * 8 + w, NEXP * 3 * 512, nblk * 8, lane);
    }
    if (PROBE_PH == 22) tacc += __builtin_amdgcn_s_memrealtime() - t0;
    __syncthreads();
    if (PROBE_PH == 23) t0 = __builtin_amdgcn_s_memrealtime();
    if (nblk == 256) {
        if (bid < 128) hyena_unit<SEQ>(a, l, bid, lds);
        else { const int g = bid - 128; hyena_unit<SEQ>(a, l, 128 + g, lds); hyena_unit<CTXL>(a, l, 2 * g, lds); hyena_unit<CTXL>(a, l, 2 * g + 1, lds); }
    } else {
        for (int it = bid; it < 512; it += nblk) { if (it < 256) hyena_unit<SEQ>(a, l, it, lds); else hyena_unit<CTXL>(a, l, it - 256, lds); }
    }
    if (PROBE_PH == 23) tacc += __builtin_amdgcn_s_memrealtime() - t0;
}

__device__ __forceinline__ void ph_post_hyena(CArgs& a, int l, LAS unsigned char* lds, int bid, int nblk) {
    const bf16* P = (const bf16*)(a.ws + WS_P);
    const float* YT = (const float*)(a.ws + WS_MIX + MX_YT); bf16* YMIX = (bf16*)(a.ws + WS_YMIX);
    LAS float* yt = (LAS float*)lds;
    const int tid = tidx(), c4 = (tid & 63) * 4, tg = tid >> 6;
    const float* hw = a.in[I_HYCW] + l * 3 * 768; const float* hb = a.in[I_HYCB] + l * 768;
    f32x4 w0[3], wx[3], wv[3];
#pragma unroll
    for (int k = 0; k < 3; ++k) { w0[k] = *(const f32x4*)(hw + k * 768 + c4); wx[k] = *(const f32x4*)(hw + k * 768 + 256 + c4); wv[k] = *(const f32x4*)(hw + k * 768 + 512 + c4); }
    const f32x4 b0 = *(const f32x4*)(hb + c4), bx = *(const f32x4*)(hb + 256 + c4), bv = *(const f32x4*)(hb + 512 + c4), hd = *(const f32x4*)(a.in[I_HYD] + l * 256 + c4);
#pragma unroll 1
    for (int it = bid; it < 576; it += nblk) {
        const Chunk c = chunk_of(it);
        const int soff = c.L == CTXL ? 0 : CTXL;
        { const int ch = tid & 255, half = tid >> 8;
          const float* srcp = YT + ((size_t)(ch * 16 + c.b)) * 2304 + soff + c.t0 + half * 32;
#pragma unroll
          for (int j = 0; j < 8; ++j) { const f32x4 v = *(const f32x4*)(srcp + 4 * j);
              yt[(half * 32 + 4 * j) * 260 + ch] = v[0]; yt[(half * 32 + 4 * j + 1) * 260 + ch] = v[1]; yt[(half * 32 + 4 * j + 2) * 260 + ch] = v[2]; yt[(half * 32 + 4 * j + 3) * 260 + ch] = v[3]; } }
        __syncthreads();
        const int tb = c.t0 + tg * 8;
        const bf16* pb = P + (size_t)(c.row0 + tg * 8) * D_INP;
        f32x4 x0[10], x1[10], vv[10];
#pragma unroll
        for (int r = 0; r < 10; ++r) { const int t = tb + r - 1, tc = min(max(t, c.lo), c.hi - 1); const float ok = (t == tc) ? 1.f : 0.f; const bf16* p = pb + (ptrdiff_t)(tc - tb) * D_INP;
            x0[r] = ok * bf4(*(const u32x2*)(p + HY0 + c4));
            x1[r] = ok * bf4(*(const u32x2*)(p + HY0 + 256 + c4)); vv[r] = ok * bf4(*(const u32x2*)(p + HY0 + 512 + c4)); }
#pragma unroll
        for (int tt = 0; tt < 8; ++tt) {
            const f32x4 u0 = w0[0] * x0[tt] + w0[1] * x0[tt + 1] + w0[2] * x0[tt + 2] + b0;
            const f32x4 xx = wx[0] * x1[tt] + wx[1] * x1[tt + 1] + wx[2] * x1[tt + 2] + bx, v2 = wv[0] * vv[tt] + wv[1] * vv[tt + 1] + wv[2] * vv[tt + 2] + bv, z = xx * v2;
            const f32x4 y = *(const LAS f32x4*)(yt + (tg * 8 + tt) * 260 + c4);
            const f32x4 o = (y + z * hd) * u0;
            u32x2 oo; oo.x = pk2(o[0], o[1]); oo.y = pk2(o[2], o[3]); *(u32x2*)(YMIX + (size_t)(c.row0 + tg * 8 + tt) * D + c4) = oo;
        }
        __syncthreads();
    }
}
__device__ __forceinline__ void ph_post_tok(CArgs& a, int l, int gw, int ngw) {
    const int lane = tidx() & 63;
    const bf16* P = (const bf16*)(a.ws + WS_P); bf16* YMIX = (bf16*)(a.ws + WS_YMIX);
    const float* GOF = (const float*)(a.ws + WS_MIX + MX_GOF); const float* GOB = (const float*)(a.ws + WS_MIX + MX_GOB);
    const float* DOF = (const float*)(a.ws + WS_MIX + MX_DOF); const float* DOB = (const float*)(a.ws + WS_MIX + MX_DOB);
    const f32x4 nwa = *(const f32x4*)(a.in[I_GLANW] + l * 64 + (4 * lane & 63)), nwd = *(const f32x4*)(a.in[I_GDNNW] + l * 64 + (4 * lane & 63));
#pragma unroll 1
    for (int row0 = gw; row0 < NTOK; row0 += 4 * ngw) {
        f32x4 og[4], od[4]; u32x2 r2[4], z2[4];
#pragma unroll
        for (int r = 0; r < 4; ++r) { const int row = min(row0 + r * ngw, NTOK - 1); const size_t o4 = (size_t)row * 256 + 4 * lane;
            og[r] = *(const f32x4*)(GOF + o4) + *(const f32x4*)(GOB + o4); od[r] = *(const f32x4*)(DOF + o4) + *(const f32x4*)(DOB + o4);
            r2[r] = *(const u32x2*)(P + (size_t)row * D_INP + GLA0 + 512 + 4 * lane); z2[r] = *(const u32x2*)(P + (size_t)row * D_INP + GDN0 + 768 + 4 * lane); }
#pragma unroll
        for (int r = 0; r < 4; ++r) { const int row = row0 + r * ngw;
            if (row < NTOK) {
                float sg = og[r][0] * og[r][0] + og[r][1] * og[r][1] + og[r][2] * og[r][2] + og[r][3] * og[r][3], sd = od[r][0] * od[r][0] + od[r][1] * od[r][1] + od[r][2] * od[r][2] + od[r][3] * od[r][3];
                sg = row16_sum(sg); sd = row16_sum(sd);
                const float rg = rsqrtf(sg * (1.f / 64.f) + 1e-6f), rd = rsqrtf(sd * (1.f / 64.f) + 1e-6f);
                u32x2 w;
                w.x = pk2(og[r][0] * rg * nwa[0] * siluf_(lo_bf(r2[r].x)), og[r][1] * rg * nwa[1] * siluf_(hi_bf(r2[r].x))); w.y = pk2(og[r][2] * rg * nwa[2] * siluf_(lo_bf(r2[r].y)), og[r][3] * rg * nwa[3] * siluf_(hi_bf(r2[r].y)));
                *(u32x2*)(YMIX + (size_t)row * D + 512 + 4 * lane) = w;
                w.x = pk2(od[r][0] * rd * nwd[0] * siluf_(lo_bf(z2[r].x)), od[r][1] * rd * nwd[1] * siluf_(hi_bf(z2[r].x))); w.y = pk2(od[r][2] * rd * nwd[2] * siluf_(lo_bf(z2[r].y)), od[r][3] * rd * nwd[3] * siluf_(hi_bf(z2[r].y)));
                *(u32x2*)(YMIX + (size_t)row * D + 768 + 4 * lane) = w; } }
    }
}

__device__ __forceinline__ void ph_ln1_route(CArgs& a, int l, LAS unsigned char* lds, int bid, int nblk) {
    const int tid = tidx(), lane = tid & 63, w = __builtin_amdgcn_readfirstlane(tid >> 6);
    const float* MOD = (const float*)(a.ws + WS_MOD) + (size_t)l * 17 * 6144;
    float* X = (float*)(a.ws + WS_X); const float* TMP = (const float*)(a.ws + WS_TMP); bf16* HB = (bf16*)(a.ws + WS_HB);
    const float* lg = a.in[I_LN1G] + l * D; const float* lb = a.in[I_LN1B] + l * D;
    const float* br = a.in[I_BR] + l * NEXP;
    const bf16* wh = (const bf16*)(a.ws + WS_WRT) + (size_t)l * NEXP * D; const bf16* wl = wh + DEPTH * NEXP * D;
    unsigned* cnt = (unsigned*)(a.ws + WS_CTL) + CW_CNT + l * NEXP * 64;
    int* LIST = (int*)(a.ws + WS_LIST); int* TOPE = (int*)(a.ws + WS_TOPE); float* TOPW = (float*)(a.ws + WS_TOPW);
    LAS float* hrow = (LAS float*)lds;
    LAS float* part = (LAS float*)(lds + 65792);
    const int row_lo = (l == DEPTH - 1) ? NTOK_C : 0;
    const int e = lane & 31, par = lane >> 5, fr = lane & 15, kg = lane >> 4;
    f32x4 xv[2][4], tv[2][4];
#define LN1_FETCH(base_) do { _Pragma("unroll") for (int t = 0; t < 2; ++t) { const int row_ = (base_) + 2 * w + t; \
        const float* xs_ = (l == 0) ? (row_ < NTOK_C ? a.in[I_CTX] + (size_t)row_ * D : a.in[I_X] + (size_t)(row_ - NTOK_C) * D) : X + (size_t)row_ * D; \
        _Pragma("unroll") for (int j = 0; j < 4; ++j) { xv[t][j] = *(const f32x4*)(xs_ + j * 256 + 4 * lane); tv[t][j] = *(const f32x4*)(TMP + (size_t)row_ * D + j * 256 + 4 * lane); } } } while (0)
    constexpr int CAP = 112;
    LAS unsigned* lcnt = (LAS unsigned*)(lds + 82176);
    LAS int* ent = (LAS int*)(lds + 82176 + 256);
    LAS float* entw = (LAS float*)(lds + 82176 + 256 + CAP * 256);
    if (tid < 32) lcnt[tid] = 0u;
    int base = row_lo + bid * 16, base0 = base, nb = 0;
#define LN1_FLUSH do { __syncthreads(); \
        if (tid < 32) { const unsigned n_ = lcnt[tid]; unsigned g_ = 0u; if (n_) g_ = atomicAdd(cnt + tid * 64, n_); lcnt[32 + tid] = g_; lcnt[tid] = 0u; } \
        __syncthreads(); \
        for (int idx = tid; idx < nb * 64; idx += 512) { const int pe_ = ent[idx], ee_ = pe_ >> 20; const unsigned pos_ = lcnt[32 + ee_] + (unsigned)(pe_ & 0xfffff); \
            const int row_ = base0 + (idx >> 6) * nblk * 16 + ((idx >> 2) & 15); \
            LIST[(size_t)ee_ * NTOK + pos_] = row_; TOPE[(size_t)row_ * 4 + (idx & 3)] = (ee_ << 20) | (int)pos_; TOPW[(size_t)row_ * 4 + (idx & 3)] = entw[idx]; } \
        __syncthreads(); nb = 0; } while (0)
    if (base < NTOK) LN1_FETCH(base);
    bf16x8 Bh[4][2], Bl[4][2];
#pragma unroll
    for (int ss = 0; ss < 4; ++ss)
#pragma unroll
        for (int t = 0; t < 2; ++t) { const size_t wo = (size_t)(16 * t + fr) * D + 128 * w + 32 * ss + 8 * kg; Bh[ss][t] = *(const bf16x8*)(wh + wo); Bl[ss][t] = *(const bf16x8*)(wl + wo); }
    const float bre = br[e];
#pragma unroll 1
    for (; base < NTOK; base += nblk * 16) {
#pragma unroll
        for (int t = 0; t < 2; ++t) {
            const int row = base + 2 * w + t;
            const float* mv = MOD + (size_t)mod_vec(row) * 6144;
            f32x4 v[4]; float s = 0.f;
#pragma unroll
            for (int j = 0; j < 4; ++j) { const int c0 = j * 256 + 4 * lane; const f32x4 g1 = *(const f32x4*)(mv + 2048 + c0);
                v[j] = DN_ALPHA * xv[t][j] + g1 * tv[t][j]; s += (v[j][0] + v[j][1]) + (v[j][2] + v[j][3]); }
            const float mean = wave_sum(s) * (1.f / D); float s2 = 0.f;
#pragma unroll
            for (int j = 0; j < 4; ++j) { v[j] = v[j] - mean; s2 += (v[j][0] * v[j][0] + v[j][1] * v[j][1]) + (v[j][2] * v[j][2] + v[j][3] * v[j][3]); }
            const float rstd = rsqrtf(wave_sum(s2) * (1.f / D) + LN_EPS);
#pragma unroll
            for (int j = 0; j < 4; ++j) { const int c0 = j * 256 + 4 * lane; const f32x4 g = *(const f32x4*)(lg + c0), bb = *(const f32x4*)(lb + c0), sh = *(const f32x4*)(mv + 3072 + c0), sc = *(const f32x4*)(mv + 4096 + c0);
                const f32x4 xn = v[j] * rstd * g + bb; *(f32x4*)(X + (size_t)row * D + c0) = xn;
                const f32x4 hh = xn * (1.f + sc) + sh;
                *(unsigned*)(a.ws + WS_HB8 + (size_t)row * D + c0) = pk4_fp8(4.f * hh[0], 4.f * hh[1], 4.f * hh[2], 4.f * hh[3]);
                *(LAS f32x4*)(hrow + (2 * w + t) * 1028 + c0) = hh; }
        }
        __syncthreads();
        if (base + nblk * 16 < NTOK) LN1_FETCH(base + nblk * 16);
        {
            f32x4 acc[2] = {(f32x4){0.f, 0.f, 0.f, 0.f}, (f32x4){0.f, 0.f, 0.f, 0.f}};
#pragma unroll
            for (int ss = 0; ss < 4; ++ss) { const int k0 = 128 * w + 32 * ss + 8 * kg;
                const f32x4 h0 = *(const LAS f32x4*)(hrow + fr * 1028 + k0), h1 = *(const LAS f32x4*)(hrow + fr * 1028 + k0 + 4);
                u32x4 ah, al;
                ah.x = pk2(h0[0], h0[1]); ah.y = pk2(h0[2], h0[3]); ah.z = pk2(h1[0], h1[1]); ah.w = pk2(h1[2], h1[3]);
                al.x = pk2(h0[0] - lo_bf(ah.x), h0[1] - hi_bf(ah.x)); al.y = pk2(h0[2] - lo_bf(ah.y), h0[3] - hi_bf(ah.y)); al.z = pk2(h1[0] - lo_bf(ah.z), h1[1] - hi_bf(ah.z)); al.w = pk2(h1[2] - lo_bf(ah.w), h1[3] - hi_bf(ah.w));
                const bf16x8 Ah = __builtin_bit_cast(bf16x8, ah), Al = __builtin_bit_cast(bf16x8, al);
#pragma unroll
                for (int t = 0; t < 2; ++t) {
                    acc[t] = __builtin_amdgcn_mfma_f32_16x16x32_bf16(Ah, Bh[ss][t], acc[t], 0, 0, 0);
                    acc[t] = __builtin_amdgcn_mfma_f32_16x16x32_bf16(Ah, Bl[ss][t], acc[t], 0, 0, 0);
                    acc[t] = __builtin_amdgcn_mfma_f32_16x16x32_bf16(Al, Bh[ss][t], acc[t], 0, 0, 0); } }
#pragma unroll
            for (int t = 0; t < 2; ++t)
#pragma unroll
                for (int j = 0; j < 4; ++j) part[((w * 2 + t) * 16 + 4 * kg + j) * 16 + fr] = acc[t][j];
        }
        __syncthreads();
        {
            float cur = bre;
#pragma unroll
            for (int ww = 0; ww < 8; ++ww) cur += part[((ww * 2 + (e >> 4)) * 16 + 2 * w + par) * 16 + (e & 15)];
            float tvv[4]; int ti[4];
#pragma unroll
            for (int k = 0; k < 4; ++k) { float bv = cur; int bi = e;
#define TOPSTEP(OV, OI) do { const float ov = (OV); const int oi = (OI); if (ov > bv || (ov == bv && oi < bi)) { bv = ov; bi = oi; } } while (0)
                TOPSTEP(dpp_f<0xB1>(bv), dpp_i<0xB1>(bi)); TOPSTEP(dpp_f<0x4E>(bv), dpp_i<0x4E>(bi)); TOPSTEP(dpp_f<0x141>(bv), dpp_i<0x141>(bi)); TOPSTEP(dpp_f<0x140>(bv), dpp_i<0x140>(bi));
                TOPSTEP(__shfl_xor(bv, 16), __shfl_xor(bi, 16));
#undef TOPSTEP
                tvv[k] = bv; ti[k] = bi; if (e == bi) cur = -3.0e38f; }
            const float e1 = __expf(tvv[1] - tvv[0]), e2 = __expf(tvv[2] - tvv[0]), e3 = __expf(tvv[3] - tvv[0]); const float inv = 1.f / (1.f + e1 + e2 + e3);
            if (e < 4) {
                const int ee = e == 0 ? ti[0] : e == 1 ? ti[1] : e == 2 ? ti[2] : ti[3]; const float ww = (e == 0 ? 1.f : e == 1 ? e1 : e == 2 ? e2 : e3) * inv;
                const unsigned lp = __hip_atomic_fetch_add(lcnt + ee, 1u, __ATOMIC_RELAXED, __HIP_MEMORY_SCOPE_WORKGROUP);
                const int idx = nb * 64 + w * 8 + par * 4 + e;
                ent[idx] = (ee << 20) | (int)lp; entw[idx] = ww; }
        }
        ++nb;
        if (nb == CAP) { LN1_FLUSH; base0 = base + nblk * 16; }
    }
    if (nb > 0) LN1_FLUSH;
#undef LN1_FLUSH
#undef LN1_FETCH
}
__device__ __forceinline__ void moe_tables(CArgs& a, int l, LAS unsigned char* lds, int NT) {
    LAS int* pre = (LAS int*)(lds + TAB_OFF); LAS int* mtl = pre + 40; LAS int* rowoff = pre + 80; LAS int* cn = pre + 120;
    if (tidx() == 0) { const unsigned* cnt = (const unsigned*)(a.ws + WS_CTL) + CW_CNT + l * NEXP * 64; int p = 0, r = 0;
        for (int e = 0; e < NEXP; ++e) { const int n = (int)__hip_atomic_load(cnt + e * 64, __ATOMIC_RELAXED, __HIP_MEMORY_SCOPE_AGENT), m = (n + 255) >> 8; pre[e] = p; mtl[e] = m > 0 ? m : 1; rowoff[e] = r; cn[e] = n; p += m * NT; r += m * 256; }
        pre[32] = p; }
    __syncthreads();
}
__device__ __forceinline__ void ph_ln2(CArgs& a, int l, LAS unsigned char* lds, int gw, int ngw) {
    const int lane = tidx() & 63;
    const float* MOD = (const float*)(a.ws + WS_MOD) + (size_t)l * 17 * 6144;
    float* X = (float*)(a.ws + WS_X); const bf16* YD = (const bf16*)(a.ws + WS_YD); bf16* HB = (bf16*)(a.ws + WS_HB);
    const float* lg = a.in[I_LN2G] + l * D; const float* lb = a.in[I_LN2B] + l * D;
    const int* TOPE = (const int*)(a.ws + WS_TOPE); const float* TOPW = (const float*)(a.ws + WS_TOPW);
    const LAS int* rowoff = (const LAS int*)(lds + TAB_OFF) + 80;
    const bool lastl = (l == DEPTH - 1);
    const int row_lo = lastl ? NTOK_C : 0;
#pragma unroll 1
    for (int row0 = row_lo + gw * 2; row0 < NTOK; row0 += ngw * 2) {
        u32x2 y2[2][4][4]; float tw[2][4]; f32x4 xv[2][4], g2v[2][4];
#pragma unroll
        for (int r = 0; r < 2; ++r) {
            const int row = row0 + r;
#pragma unroll
            for (int k = 0; k < 4; ++k) { const int te = TOPE[(size_t)row * 4 + k]; tw[r][k] = TOPW[(size_t)row * 4 + k];
                const bf16* yr = YD + ((size_t)(rowoff[te >> 20] + (te & 0xfffff))) * D;
#pragma unroll
                for (int j = 0; j < 4; ++j) y2[r][k][j] = *(const u32x2*)(yr + j * 256 + 4 * lane); }
            const float* mv = MOD + (size_t)mod_vec(row) * 6144;
#pragma unroll
            for (int j = 0; j < 4; ++j) { const int c0 = j * 256 + 4 * lane; xv[r][j] = *(const f32x4*)(X + (size_t)row * D + c0); g2v[r][j] = *(const f32x4*)(mv + 5120 + c0); }
        }
#pragma unroll
        for (int r = 0; r < 2; ++r) {
            const int row = row0 + r;
            const float* mv = MOD + (size_t)mod_vec(row) * 6144;
            f32x4 v[4]; float s = 0.f;
#pragma unroll
            for (int j = 0; j < 4; ++j) { f32x4 f = (f32x4){0.f, 0.f, 0.f, 0.f};
#pragma unroll
                for (int k = 0; k < 4; ++k) { const u32x2 yy = y2[r][k][j]; f += tw[r][k] * (f32x4){lo_bf(yy.x), hi_bf(yy.x), lo_bf(yy.y), hi_bf(yy.y)}; }
                v[j] = DN_ALPHA * xv[r][j] + g2v[r][j] * f; s += (v[j][0] + v[j][1]) + (v[j][2] + v[j][3]); }
            const float mean = wave_sum(s) * (1.f / D); float s2 = 0.f;
#pragma unroll
            for (int j = 0; j < 4; ++j) { v[j] = v[j] - mean; s2 += (v[j][0] * v[j][0] + v[j][1] * v[j][1]) + (v[j][2] * v[j][2] + v[j][3] * v[j][3]); }
            const float rstd = rsqrtf(wave_sum(s2) * (1.f / D) + LN_EPS);
            const float* mvn = mv + 17 * 6144;
#pragma unroll
            for (int j = 0; j < 4; ++j) { const int c0 = j * 256 + 4 * lane; const f32x4 g = *(const f32x4*)(lg + c0), bb = *(const f32x4*)(lb + c0);
                const f32x4 xn = v[j] * rstd * g + bb;
                if (lastl) *(f32x4*)(a.out + (size_t)(row - NTOK_C) * D + c0) = xn;
                else { *(f32x4*)(X + (size_t)row * D + c0) = xn; const f32x4 sh = *(const f32x4*)(mvn + c0), sc = *(const f32x4*)(mvn + 1024 + c0); const f32x4 hh = xn * (1.f + sc) + sh;
                    u32x2 o; o.x = pk2(hh[0], hh[1]); o.y = pk2(hh[2], hh[3]); *(u32x2*)(HB + (size_t)row * D + c0) = o; } }
        }
    }
}

constexpr int NPH = 2 + DEPTH * 9;
__device__ __forceinline__ CArgs* kargs() { CArgs* p = (CArgs*)__builtin_amdgcn_kernarg_segment_ptr(); asm volatile("" : "+s"(p)); return p; }
__global__ void __launch_bounds__(512, 2) trunk_fwd(Args a_unused) {
    extern __shared__ __attribute__((aligned(16))) unsigned char lds_raw[];
    LAS unsigned char* lds = (LAS unsigned char*)lds_raw;
    const int tid = threadIdx.x, wave = __builtin_amdgcn_readfirstlane(tid >> 6);
    const int bid = blockIdx.x, nblk = gridDim.x, gw = bid * 8 + wave, ngw = nblk * 8;
    volatile LAS unsigned* MISC = (volatile LAS unsigned*)(lds + MISC_OFF);
    if (tid < 64) MISC[tid] = 0u;
    __syncthreads();
    XcdBarrier bar; bar.x = 0; bar.st = nullptr;
    int lo, hi;
    { CArgs& a = *kargs(); lo = a.ph_lo; hi = a.ph_hi; bar.bar = (unsigned*)(a.ws + WS_CTL) + CW_BAR;
      if (hi - lo > 1) bar = xcd_barrier_post((unsigned*)(a.ws + WS_CTL) + CW_BAR, MISC); }
#define IN(k) (lo <= (k) && (k) < hi)
    unsigned long long tacc = 0ull, tbeg = 0ull;
#define PB_BEG(ty) do { if (PROBE_PH == (ty)) tbeg = __builtin_amdgcn_s_memrealtime(); } while (0)
#define PB_END(ty) do { if (PROBE_PH == (ty)) tacc += __builtin_amdgcn_s_memrealtime() - tbeg; } while (0)
#define SEAM(k) do { if (IN(k) && IN((k) + 1)) xcd_barrier(bar); } while (0)
    PB_BEG(0);
    if (IN(0)) { CArgs& a = *kargs(); unsigned long long t0 = 0ull;
#define PB_SUB(ty, stmt) do { if (PROBE_PH == (ty)) t0 = __builtin_amdgcn_s_memrealtime(); stmt; if (PROBE_PH == (ty)) tacc += __builtin_amdgcn_s_memrealtime() - t0; } while (0)
        PB_SUB(30, ph_mod(a, lds, bid, nblk)); __syncthreads(); PB_SUB(31, ph_filters(a, gw, ngw)); PB_SUB(32, ph_tr_small(a, lds, gw, ngw)); PB_SUB(33, ph_router_w(a, bid * 512 + tid, nblk * 512));
#undef PB_SUB
    }
    SEAM(0); PB_END(0); PB_BEG(1);
    if (IN(1)) { CArgs& a = *kargs(); ph_mod_input(a, gw, ngw); }
    SEAM(1); PB_END(1);
#pragma unroll 1
    for (int l = 0; l < DEPTH; ++l) {
        const int p0 = 2 + 9 * l;
        const bool lastl = (l == DEPTH - 1);
        PB_BEG(2);
        if (IN(p0 + 0)) {
            CArgs& a = *kargs();
            pg8::DenseSched S; S.init((const bf16*)(a.ws + WS_WIN) + (size_t)l * D_INP * 1024, 1024, NTOK, D_INP, nblk, bid, 0);
            pg8::EpiBf16 E{(bf16*)(a.ws + WS_P), D_INP, 0};
            pg8::gemm_phase<pg8::EpiBf16, pg8::DenseSched, true>(lds, (const char*)(a.ws + WS_HB), 1024, S, E);
        }
        SEAM(p0 + 0); PB_END(2); PB_BEG(3);
        if (IN(p0 + 1)) { CArgs& a = *kargs(); PB_BEG(50); ph_prep_conv(a, l, lds, bid, nblk); PB_END(50); PB_BEG(51); ph_prep_tok(a, l, gw, ngw); PB_END(51); }
        SEAM(p0 + 1); PB_END(3); PB_BEG(4);
        if (IN(p0 + 2)) { CArgs& a = *kargs(); ph_scan(a, l, lds, bid, nblk, tacc); }
        SEAM(p0 + 2); PB_END(4); PB_BEG(5);
        if (IN(p0 + 3)) { CArgs& a = *kargs(); PB_BEG(52); ph_post_hyena(a, l, lds, bid, nblk); PB_END(52); PB_BEG(53); ph_post_tok(a, l, gw, ngw); PB_END(53); }
        SEAM(p0 + 3); PB_END(5); PB_BEG(6);
        if (IN(p0 + 4)) {
            CArgs& a = *kargs();
            const int r0 = lastl ? NTOK_C : 0;
            pg8::DenseSched S; S.init((const bf16*)(a.ws + WS_WOUT) + (size_t)l * 1024 * 1024, 1024, NTOK - r0, 1024, nblk, bid, r0);
            pg8::EpiF32 E{(float*)(a.ws + WS_TMP), 1024, r0};
            pg8::gemm_phase<pg8::EpiF32, pg8::DenseSched, true>(lds, (const char*)(a.ws + WS_YMIX), 1024, S, E);
        }
        SEAM(p0 + 4); PB_END(6); PB_BEG(7);
        if (IN(p0 + 5)) { CArgs& a = *kargs(); ph_ln1_route(a, l, lds, bid, nblk); }
        SEAM(p0 + 5); PB_END(7); PB_BEG(8);
        if (IN(p0 + 6)) {
            CArgs& a = *kargs();
            moe_tables(a, l, lds, 8);
            const LAS int* tb = (const LAS int*)(lds + TAB_OFF);
            pg8::MoeSched<true, 8> S; S.Bt = (const char*)(a.ws + WS_WGU); S.bstride = (size_t)2048 * 1024; S.rb = 1024; S.list = (const int*)(a.ws + WS_LIST);
            S.pre = tb; S.mtl = tb + 40; S.rowoff = tb + 80; S.cnt = tb + 120; S.K = 1024; S.G = nblk; S.c = (nblk % 8 == 0) ? (bid % 8) * (nblk / 8) + bid / 8 : bid; S.total = tb[32];
            pg8::EpiSwiglu E{(bf16*)(a.ws + WS_H), a.in[I_BG] + (size_t)l * NEXP * 1024, a.in[I_BU] + (size_t)l * NEXP * 1024, tb + 80, 1.f / 128.f};
            pg8::gemm_phase_f8g<pg8::EpiSwiglu, pg8::MoeSched<true, 8>, true>(lds, (const char*)(a.ws + WS_HB8), 1024, S, E);
        }
        SEAM(p0 + 6); PB_END(8); PB_BEG(9);
        if (IN(p0 + 7)) {
            CArgs& a = *kargs();
            moe_tables(a, l, lds, 4);
            const LAS int* tb = (const LAS int*)(lds + TAB_OFF);
            pg8::MoeSched<false, 4> S; S.Bt = (const char*)(a.ws + WS_WD); S.bstride = (size_t)1024 * 1024; S.rb = 1024; S.list = nullptr;
            S.pre = tb; S.mtl = tb + 40; S.rowoff = tb + 80; S.cnt = tb + 120; S.K = 1024; S.G = nblk; S.c = (nblk % 8 == 0) ? (bid % 8) * (nblk / 8) + bid / 8 : bid; S.total = tb[32];
            pg8::EpiDown E{(bf16*)(a.ws + WS_YD), a.in[I_BD] + (size_t)l * NEXP * 1024, tb + 80, 1.f / 128.f};
            pg8::gemm_phase_f8<pg8::EpiDown, pg8::MoeSched<false, 4>, true>(lds, (const char*)(a.ws + WS_H), 1024, S, E);
        }
        SEAM(p0 + 7); PB_END(9); PB_BEG(10);
        if (IN(p0 + 8)) { CArgs& a = *kargs(); moe_tables(a, l, lds, 4); ph_ln2(a, l, lds, gw, ngw); }
        if (!lastl) SEAM(p0 + 8);
        PB_END(10);
    }
    if (PROBE_PH >= 0) { const unsigned long long t0 = __builtin_amdgcn_s_memrealtime(); while (__builtin_amdgcn_s_memrealtime() - t0 < tacc) __builtin_amdgcn_s_sleep(8); }
#undef IN
#undef SEAM
}

extern "C" void kernel_launch(void* const* d_in, const int* in_sizes, int n_in, void* d_out, int out_size, void* d_ws, size_t ws_size, hipStream_t stream) {
    static int grid = 0;
    if (grid == 0) {
        if (n_in != 39 || out_size != NTOK_L * D || ws_size < WS_END) { fprintf(stderr, "kernel_launch: unexpected problem (n_in %d, out %d, ws %zu < %zu)\n", n_in, out_size, ws_size, (size_t)WS_END); grid = -1; return; }
        int dev = 0, cus = 0, per_cu = 0;
        if (hipGetDevice(&dev) != hipSuccess || hipDeviceGetAttribute(&cus, hipDeviceAttributeMultiprocessorCount, dev) != hipSuccess) { grid = -1; return; }
        if (hipFuncSetAttribute((const void*)trunk_fwd, hipFuncAttributeMaxDynamicSharedMemorySize, LDS_BYTES) != hipSuccess) { fprintf(stderr, "kernel_launch: hipFuncSetAttribute failed\n"); grid = -1; return; }
        if (hipOccupancyMaxActiveBlocksPerMultiprocessor(&per_cu, (const void*)trunk_fwd, 512, LDS_BYTES) != hipSuccess || per_cu < 1) fprintf(stderr, "kernel_launch: occupancy query says %d\n", per_cu);
        (void)hipGetLastError();
        grid = cus;
    }
    if (grid < 0) return;
    (void)hipMemsetAsync((char*)d_ws + WS_CTL, 0, CTL_ZERO_BYTES, stream);
    Args a{};
    for (int i = 0; i < 39; ++i) a.in[i] = (const float*)d_in[i];
    a.out = (float*)d_out; a.ws = (unsigned char*)d_ws;
#if MK_FUSED
    a.ph_lo = 0; a.ph_hi = NPH;
    hipLaunchKernelGGL(trunk_fwd, dim3(grid), dim3(512), LDS_BYTES, stream, a);
#else
    for (int p = 0; p < NPH; ++p) { a.ph_lo = p; a.ph_hi = p + 1; hipLaunchKernelGGL(trunk_fwd, dim3(grid), dim3(512), LDS_BYTES, stream, a); }
#endif
}
```

```cpp
#include <hip/hip_runtime.h>
#include <cstdio>
#include <cstdint>

#ifndef MK_FUSED
#define MK_FUSED 1
#endif

#ifndef USE_NEW_GDN
#define USE_NEW_GDN 1
#endif
#ifndef USE_NEW_GLA
#define USE_NEW_GLA 1
#endif
#ifndef PROBE_PH
#define PROBE_PH -1
#endif

#define LAS __attribute__((address_space(3)))
#define GAS __attribute__((address_space(1)))
typedef unsigned short bf16;
typedef short bf16x8 __attribute__((ext_vector_type(8)));
typedef float f32x4 __attribute__((ext_vector_type(4)));
typedef float f32x2 __attribute__((ext_vector_type(2)));
typedef unsigned u32x4 __attribute__((ext_vector_type(4)));
typedef unsigned u32x2 __attribute__((ext_vector_type(2)));

constexpr int D = 1024, NB = 16, SEQ = 2048, CTXL = 256, DEPTH = 4;
constexpr int NTOK_C = NB * CTXL, NTOK_L = NB * SEQ, NTOK = NTOK_C + NTOK_L;
constexpr int D_IN = 3376, D_INP = 3584;
constexpr int HY0 = 0, SC0 = 768, GLA0 = 1536, GDN0 = 2336;
constexpr int NEXP = 32, TOPK = 4;
constexpr int MAXROWS = NTOK * TOPK + NEXP * 256;
constexpr float DN_ALPHA = 1.681792830507429f;
constexpr float LN_EPS = 1e-5f;

constexpr size_t MiB = 1u << 20;
constexpr size_t WS_CTL = 0, CTL_ZERO_BYTES = 1 * MiB;
constexpr size_t WS_MOD = 1 * MiB;
constexpr size_t WS_WRT = 3 * MiB;
constexpr size_t WS_KUN = 4 * MiB;
constexpr size_t WS_WIN = 36 * MiB;
constexpr size_t WS_WOUT = 64 * MiB;
constexpr size_t WS_WGU = 72 * MiB;
constexpr size_t WS_WD = 200 * MiB;
constexpr size_t WS_X = 264 * MiB;
constexpr size_t WS_HB = 408 * MiB;
constexpr size_t WS_P = 480 * MiB;
constexpr size_t WS_YMIX = 732 * MiB;
constexpr size_t WS_YD = WS_P;
constexpr size_t WS_TMP = 804 * MiB;
constexpr size_t WS_LIST = 948 * MiB;
constexpr size_t WS_TOPE = 953 * MiB;
constexpr size_t WS_TOPW = 954 * MiB;
constexpr size_t WS_H = 956 * MiB;
constexpr size_t WS_MIX = 1264 * MiB;
constexpr size_t MX_ZT = 0;
constexpr size_t MX_YT = 20 * MiB;
constexpr size_t MX_GDF = 56 * MiB, MX_GDB = 76 * MiB;
constexpr size_t MX_GOF = 96 * MiB, MX_GOB = 132 * MiB;
constexpr size_t MX_DQ = 168 * MiB, MX_DK = 204 * MiB, MX_DV = 240 * MiB;
constexpr size_t MX_DG = 276 * MiB;
constexpr size_t MX_DOF = 280 * MiB, MX_DOB = 316 * MiB;
constexpr size_t WS_HB8 = 1616 * MiB;
constexpr size_t WS_END = 1980 * MiB;
constexpr int NUNIT = 128 * 36;
constexpr size_t WS_CKD = 1656 * MiB;
constexpr size_t CD_M = 0;
constexpr size_t CD_E = 36 * MiB;
constexpr size_t CD_BT = 72 * MiB;
constexpr size_t CD_FT = 144 * MiB;
constexpr size_t CD_KB = 180 * MiB, CD_QB = 198 * MiB;
constexpr size_t WS_CKA = WS_CKD + 216 * MiB;
constexpr size_t CA_QC = 0;
constexpr size_t CA_FT = 20 * MiB;
constexpr size_t CA_UT = 60 * MiB;
constexpr size_t CA_DL = 100 * MiB;
static_assert(WS_CKA + CA_DL + (size_t)NUNIT * 32 * 4 <= WS_END, "chunk data");
static_assert((size_t)MAXROWS * 1024 * 2 <= 324 * MiB, "YD overlay");
static_assert(WS_H + (size_t)MAXROWS * 1024 * 2 <= WS_MIX, "H");
constexpr int CW_BAR = 4096;
constexpr int CW_CNT = 16384;

constexpr int LDS_BYTES = 147456;
constexpr int MISC_OFF = 143360;
constexpr int TAB_OFF = 143360 + 256;

__device__ __forceinline__ float bf2f(unsigned v) { return __uint_as_float(v << 16); }
__device__ __forceinline__ unsigned f2bf(float f) { unsigned u = __float_as_uint(f); return (u + 0x7fffu + ((u >> 16) & 1u)) >> 16; }
__device__ __forceinline__ unsigned pk2(float lo, float hi) { return f2bf(lo) | (f2bf(hi) << 16); }
__device__ __forceinline__ unsigned pk4_fp8(float a, float b, float c, float d) { int r = __builtin_amdgcn_cvt_pk_fp8_f32(a, b, 0, false); return (unsigned)__builtin_amdgcn_cvt_pk_fp8_f32(c, d, r, true); }
__device__ __forceinline__ float lo_bf(unsigned w) { return __uint_as_float(w << 16); }
__device__ __forceinline__ float hi_bf(unsigned w) { return __uint_as_float(w & 0xffff0000u); }
__device__ __forceinline__ float sigmoidf_(float x) { return 1.f / (1.f + __expf(-x)); }
__device__ __forceinline__ float siluf_(float x) { return x / (1.f + __expf(-x)); }
__device__ __forceinline__ float softplusf_(float x) { return fmaxf(x, 0.f) + __logf(1.f + __expf(-fabsf(x))); }
__device__ __forceinline__ float logsigmoidf_(float x) { return fminf(x, 0.f) - __logf(1.f + __expf(-fabsf(x))); }
__device__ __forceinline__ float sin_rev(float r) { return __builtin_amdgcn_sinf(__builtin_amdgcn_fractf(r)); }
__device__ __forceinline__ float sin_rad(float x) { return sin_rev(x * 0.15915494309189535f); }
template <int CTRL> __device__ __forceinline__ float dpp_f(float v) { return __builtin_bit_cast(float, __builtin_amdgcn_update_dpp(0, __builtin_bit_cast(int, v), CTRL, 0xf, 0xf, true)); }
template <int CTRL> __device__ __forceinline__ int dpp_i(int v) { return __builtin_amdgcn_update_dpp(0, v, CTRL, 0xf, 0xf, true); }
__device__ __forceinline__ float quad_sum(float v) { v += dpp_f<0xB1>(v); v += dpp_f<0x4E>(v); return v; }
__device__ __forceinline__ float row16_sum(float v) { v += dpp_f<0xB1>(v); v += dpp_f<0x4E>(v); v += dpp_f<0x141>(v); v += dpp_f<0x140>(v); return v; }
__device__ __forceinline__ float rdlane_f(float v, int l) { return __builtin_bit_cast(float, __builtin_amdgcn_readlane(__builtin_bit_cast(int, v), l)); }
__device__ __forceinline__ float wave_sum(float v) {
    v = row16_sum(v);
    return (rdlane_f(v, 0) + rdlane_f(v, 16)) + (rdlane_f(v, 32) + rdlane_f(v, 48));
}
__device__ __forceinline__ int tidx() { int t = threadIdx.x; asm volatile("" : "+v"(t)); return t; }

#define XB_TMO      128
#define XB_XCNT(j)  (256  + 64 * (j))
#define XB_XSUB(j)  (1280 + 64 * (j))
#define XB_XGEN(j)  (2304 + 64 * (j))
#define XB_TOP      3328
#define XB_TOPGEN   3392
#define XCD_BAR_WORDS 3456
#define XB_SPIN_CAP (1u << 25)
__device__ __forceinline__ unsigned xb_ld(unsigned* p)              { return __hip_atomic_load(p, __ATOMIC_RELAXED, __HIP_MEMORY_SCOPE_AGENT); }
__device__ __forceinline__ unsigned xb_add(unsigned* p, unsigned v) { return __hip_atomic_fetch_add(p, v, __ATOMIC_RELAXED, __HIP_MEMORY_SCOPE_AGENT); }
__device__ __forceinline__ unsigned xb_xcc_id() { return (unsigned)__builtin_amdgcn_s_getreg((3 << 11) | 20) & 0xFu; }
#define XB_SPIN(cond, bar) do { unsigned _sp = 0; while (cond) { __builtin_amdgcn_s_sleep(1); \
    if ((++_sp & 255u) == 0u) { if (xb_ld(&(bar)[XB_TMO])) break; if (_sp > XB_SPIN_CAP) { atomicAdd(&(bar)[XB_TMO], 1u); break; } } } } while (0)
struct XcdBarrier { unsigned* bar; unsigned x; volatile LAS unsigned* st; };
__device__ __forceinline__ XcdBarrier xcd_barrier_post(unsigned* bar, volatile LAS unsigned* st) {
    XcdBarrier b; b.bar = bar; b.x = xb_xcc_id(); b.st = st;
    if (threadIdx.x == 0) (void)xb_add(&bar[XB_XCNT(b.x)], 1u);
    return b;
}
__device__ __forceinline__ void xcd_barrier_complete(unsigned* bar, unsigned x, unsigned& nloc, unsigned& nx) {
    const unsigned G = gridDim.x * gridDim.y * gridDim.z;
    unsigned sum, cnt, mine, sp = 0u;
    for (;;) {
        sum = 0u; cnt = 0u; mine = 0u;
#pragma unroll
        for (unsigned j = 0; j < 16; ++j) { const unsigned c = xb_ld(&bar[XB_XCNT(j)]); sum += c; cnt += (c > 0u) ? 1u : 0u; mine = (j == x) ? c : mine; }
        if (sum == G) break;
        __builtin_amdgcn_s_sleep(1);
        if ((++sp & 255u) == 0u) { if (xb_ld(&bar[XB_TMO])) break; if (sp > XB_SPIN_CAP) { atomicAdd(&bar[XB_TMO], 1u); break; } }
    }
    nloc = mine > 0u ? mine : 1u; nx = cnt > 0u ? cnt : 1u;
}
__device__ __forceinline__ void xcd_barrier(const XcdBarrier& b) {
    asm volatile("s_waitcnt vmcnt(0)" ::: "memory");
    __syncthreads();
    if (threadIdx.x == 0) {
        unsigned* bar = b.bar;
        __builtin_amdgcn_s_waitcnt(0);
        unsigned nloc = b.st[0], nx = b.st[1];
        if (nloc == 0u) { xcd_barrier_complete(bar, b.x, nloc, nx); b.st[0] = nloc; b.st[1] = nx; }
        const unsigned old = xb_add(&bar[XB_XSUB(b.x)], 1u);
        const unsigned gen = old / nloc;
        if (old + 1u == (gen + 1u) * nloc) {
            __builtin_amdgcn_fence(__ATOMIC_RELEASE, "agent");
            asm volatile("s_waitcnt vmcnt(0)" ::: "memory");
            const unsigned og = xb_add(&bar[XB_TOP], 1u);
            const unsigned tg = og / nx;
            if (og + 1u == (tg + 1u) * nx) xb_add(&bar[XB_TOPGEN], 1u);
            else XB_SPIN(xb_ld(&bar[XB_TOPGEN]) == tg, bar);
            __builtin_amdgcn_fence(__ATOMIC_ACQUIRE, "agent");
            xb_add(&bar[XB_XGEN(b.x)], 1u);
            asm volatile("s_waitcnt vmcnt(0)" ::: "memory");
        } else {
            XB_SPIN(xb_ld(&bar[XB_XGEN(b.x)]) == gen, bar);
            __builtin_amdgcn_fence(__ATOMIC_ACQUIRE, "agent");
            asm volatile("s_waitcnt vmcnt(0)" ::: "memory");
        }
    }
    __syncthreads();
}

namespace pg8 {
constexpr int BM = 256, BK = 64, HALF = 128, HTB = HALF * BK * 2, STAGE_BYTES = 8 * HTB, NXCD = 8, WGM = 8;
__host__ __device__ __forceinline__ int lds_byte(int r, int c) { const int st = (r >> 4) * 2 + (c >> 5), rr = r & 15, cc = c & 31, ob = rr * 64 + cc * 2; return st * 1024 + (ob ^ (((ob >> 9) & 1) << 5)); }
__host__ __device__ __forceinline__ void stage_rc(int b, int& R, int& C) { const int st = b / 1024, sb = b % 1024, swz = sb ^ (((sb >> 9) & 1) << 5); R = (st >> 1) * 16 + swz / 64; C = (st & 1) * 32 + (swz % 64) / 2; }
__host__ __device__ __forceinline__ int perm32(int rho) { const int n = rho >> 4, i = rho & 15; return 8 * (i >> 2) + 4 * n + (i & 3); }
__device__ __forceinline__ unsigned cvt_pk_bf16(float lo, float hi) { unsigned r; asm volatile("v_cvt_pk_bf16_f32 %0, %1, %2" : "=v"(r) : "v"(lo), "v"(hi)); return r; }

struct Unit { int pm, pn, e, mt; };

struct DenseSched {
    const char* Bt; int K, nM, nN, nwg, G, c, row0;
    __device__ __forceinline__ void init(const bf16* Bt_, int K_, int M, int N, int G_, int c_, int row0_) { Bt = (const char*)Bt_; K = K_; nM = M / BM; nN = N / BM; nwg = nM * nN; G = G_; c = c_; row0 = row0_; }
    __device__ __forceinline__ bool next(int i, Unit& u) const {
        const long L = (long)i * G + c; if (L >= nwg) return false;
        int wgid = (int)L; { const int q = nwg / NXCD, r = nwg % NXCD, xcd = wgid % NXCD, off = wgid / NXCD; wgid = (xcd < r ? xcd * (q + 1) : r * (q + 1) + (xcd - r) * q) + off; }
        const int nig = WGM * nN, gid = wgid / nig, fm = gid * WGM, gsz = (nM - fm) < WGM ? (nM - fm) : WGM;
        u.pm = fm + ((wgid % nig) % gsz); u.pn = (wgid % nig) / gsz; u.e = 0; u.mt = 0; return true;
    }
    __device__ __forceinline__ const char* b_ptr(const Unit& u) const { return Bt + (size_t)u.pn * (size_t)(BM * 2) * K; }
    __device__ __forceinline__ void a_offsets(const Unit& u, const int (&R)[2], const int (&C)[2], unsigned (&v)[2][2]) const {
#pragma unroll
        for (int h = 0; h < 2; ++h)
#pragma unroll
            for (int i = 0; i < 2; ++i) v[h][i] = (unsigned)((row0 + u.pm * BM + h * HALF + R[i]) * K + C[i]) * 2u;
    }
};
template <bool GATHER, int NT>
struct MoeSched {
    const char* Bt; size_t bstride;
    int rb;
    const int* list;
    const LAS int* pre; const LAS int* mtl; const LAS int* rowoff; const LAS int* cnt;
    int K, G, c, total;
    __device__ __forceinline__ bool next(int i, Unit& u) const {
        const int L = i * G + c; if (L >= total) return false;
        int e = 0;
#pragma unroll 1
        for (int j = 1; j < NEXP; ++j) e = (L >= pre[j]) ? j : e;
        const int rem = L - pre[e];
        u.e = e; u.pn = rem % NT; u.mt = rem / NT; u.pm = 0; return true;
    }
    __device__ __forceinline__ const char* b_ptr(const Unit& u) const { return Bt + (size_t)u.e * bstride + (size_t)u.pn * (size_t)BM * rb; }
    __device__ __forceinline__ const char* a_ptr(const Unit& u, const char* Abase) const { return Abase + (size_t)(rowoff[u.e] + u.mt * BM) * rb; }
    __device__ __forceinline__ void a_offsets(const Unit& u, const int (&R)[2], const int (&C)[2], unsigned (&v)[2][2]) const {
        if (GATHER) {
            const int n = cnt[u.e]; const int* lp = list + (size_t)u.e * NTOK;
#pragma unroll
            for (int h = 0; h < 2; ++h)
#pragma unroll
                for (int i = 0; i < 2; ++i) { const int idx = u.mt * BM + h * HALF + R[i]; const int tok = idx < n ? lp[idx] : 0; v[h][i] = (unsigned)(tok * rb + 2 * C[i]); }
        } else {
            const int r0 = rowoff[u.e] + u.mt * BM;
#pragma unroll
            for (int h = 0; h < 2; ++h)
#pragma unroll
                for (int i = 0; i < 2; ++i) v[h][i] = (unsigned)((r0 + h * HALF + R[i]) * K + C[i]) * 2u;
        }
    }
};

struct EpiBf16 {
    static constexpr bool PERM = true;
    bf16* O; int ldc; int row0;
    __device__ __forceinline__ void operator()(const f32x4 (&acc)[2][2][4][2], const Unit& u, int wr, int wc, int fr, int fq) const {
        const int r0 = row0 + u.pm * BM + wr * 64 + fr, col0 = u.pn * BM + wc * 32 + 8 * fq;
#pragma unroll
        for (int ai = 0; ai < 2; ++ai)
#pragma unroll
            for (int m = 0; m < 4; ++m) { bf16* rowp = O + (size_t)(r0 + ai * HALF + m * 16) * ldc + col0;
#pragma unroll
                for (int bj = 0; bj < 2; ++bj) { const f32x4 v0 = acc[ai][bj][m][0], v1 = acc[ai][bj][m][1];
                    u32x4 w; w.x = cvt_pk_bf16(v0[0], v0[1]); w.y = cvt_pk_bf16(v0[2], v0[3]); w.z = cvt_pk_bf16(v1[0], v1[1]); w.w = cvt_pk_bf16(v1[2], v1[3]);
                    *(u32x4*)(rowp + bj * HALF) = w; } }
    }
};
struct EpiF32 {
    static constexpr bool PERM = false;
    float* Cc; int ldc; int row0;
    __device__ __forceinline__ void operator()(const f32x4 (&acc)[2][2][4][2], const Unit& u, int wr, int wc, int fr, int fq) const {
        const int r0 = row0 + u.pm * BM + wr * 64 + fr, col0 = u.pn * BM + wc * 32 + 4 * fq;
#pragma unroll
        for (int ai = 0; ai < 2; ++ai)
#pragma unroll
            for (int m = 0; m < 4; ++m) { float* rowp = Cc + (size_t)(r0 + ai * HALF + m * 16) * ldc + col0;
#pragma unroll
                for (int bj = 0; bj < 2; ++bj)
#pragma unroll
                    for (int n = 0; n < 2; ++n) *(f32x4*)(rowp + bj * HALF + n * 16) = acc[ai][bj][m][n]; }
    }
};
struct EpiSwiglu {
    static constexpr bool PERM = true;
    bf16* H; const float* bg; const float* bu; const LAS int* rowoff; float ws;
    __device__ __forceinline__ void operator()(const f32x4 (&acc)[2][2][4][2], const Unit& u, int wr, int wc, int fr, int fq) const {
        const int r0 = rowoff[u.e] + u.mt * BM + wr * 64 + fr, j0 = u.pn * HALF + wc * 32 + 8 * fq;
        f32x4 gb[2], ub[2];
#pragma unroll
        for (int n = 0; n < 2; ++n) { gb[n] = *(const f32x4*)(bg + u.e * 1024 + j0 + 4 * n); ub[n] = *(const f32x4*)(bu + u.e * 1024 + j0 + 4 * n); }
#pragma unroll
        for (int ai = 0; ai < 2; ++ai)
#pragma unroll
            for (int m = 0; m < 4; ++m) { unsigned char* rowp = (unsigned char*)H + (size_t)(r0 + ai * HALF + m * 16) * 1024 + j0; float hv[8];
#pragma unroll
                for (int n = 0; n < 2; ++n)
#pragma unroll
                    for (int j = 0; j < 4; ++j) { float g = acc[ai][0][m][n][j] * ws + gb[n][j], up = acc[ai][1][m][n][j] * ws + ub[n][j];
                        g = fminf(g, 7.f); up = fminf(fmaxf(up, -7.f), 7.f);
                        hv[n * 4 + j] = (up + 1.f) * g * __builtin_amdgcn_rcpf(1.f + __expf(-1.702f * g)); }
                *(u32x2*)rowp = (u32x2){pk4_fp8(4.f * hv[0], 4.f * hv[1], 4.f * hv[2], 4.f * hv[3]), pk4_fp8(4.f * hv[4], 4.f * hv[5], 4.f * hv[6], 4.f * hv[7])}; }
    }
};
struct EpiDown {
    static constexpr bool PERM = true;
    bf16* Y; const float* bd; const LAS int* rowoff; float ws;
    __device__ __forceinline__ void operator()(const f32x4 (&acc)[2][2][4][2], const Unit& u, int wr, int wc, int fr, int fq) const {
        const int r0 = rowoff[u.e] + u.mt * BM + wr * 64 + fr, col0 = u.pn * BM + wc * 32 + 8 * fq;
        f32x4 bv[2][2];
#pragma unroll
        for (int bj = 0; bj < 2; ++bj)
#pragma unroll
            for (int n = 0; n < 2; ++n) bv[bj][n] = *(const f32x4*)(bd + u.e * 1024 + col0 + bj * HALF + 4 * n);
#pragma unroll
        for (int ai = 0; ai < 2; ++ai)
#pragma unroll
            for (int m = 0; m < 4; ++m) { bf16* rowp = Y + (size_t)(r0 + ai * HALF + m * 16) * 1024 + col0;
#pragma unroll
                for (int bj = 0; bj < 2; ++bj) { const f32x4 v0 = acc[ai][bj][m][0] * ws + bv[bj][0], v1 = acc[ai][bj][m][1] * ws + bv[bj][1];
                    u32x4 w; w.x = cvt_pk_bf16(v0[0], v0[1]); w.y = cvt_pk_bf16(v0[2], v0[3]); w.z = cvt_pk_bf16(v1[0], v1[1]); w.w = cvt_pk_bf16(v1[2], v1[3]);
                    *(u32x4*)(rowp + bj * HALF) = w; } }
    }
};

template <class Epi, class Sched, bool ALIGN_EPI>
__device__ __forceinline__ void gemm_phase(LAS unsigned char* lds, const char* Abase, const int K, const Sched& S, const Epi& E) {
    const int tid = tidx(), wid = __builtin_amdgcn_readfirstlane(tid >> 6), lane = tid & 63, wr = wid >> 2, wc = wid & 3, fr = lane & 15, fq = lane >> 4;
    const int nt = K / BK;
    int Rp[2], Cp[2]; unsigned voffB0;
#pragma unroll
    for (int i = 0; i < 2; ++i) stage_rc(tid * 16 + i * 8192, Rp[i], Cp[i]);
    { const int Rb = Epi::PERM ? ((Rp[0] & ~31) + perm32(Rp[0] & 31)) : Rp[0]; voffB0 = (unsigned)(Rb * K + Cp[0]) * 2u; }
    const size_t kstep = (size_t)(BK * 2);
    const size_t hstep = (size_t)HALF * K * 2;
    const unsigned ldsw = (unsigned)wid * 1024u;
    const int aoff = lds_byte(wr * 64 + fr, fq * 8), boff = lds_byte(wc * 32 + fr, fq * 8);
#define PG8_SA(b, h) (((b) * 2 + (h)) * HTB)
#define PG8_SB(b, h) ((4 + (b) * 2 + (h)) * HTB)
#define PG8_STAGE(bufoff, gbase, voff) do { _Pragma("unroll") for (int _i = 0; _i < 2; ++_i) \
        __builtin_amdgcn_global_load_lds((const unsigned*)((const char*)(gbase) + (voff)[_i]), (LAS unsigned*)(lds + (bufoff) + ldsw + _i * 8192), 16, 0, 0); } while (0)
#define PG8_STAGEB(bufoff, gbase) do { _Pragma("unroll") for (int _i = 0; _i < 2; ++_i) \
        __builtin_amdgcn_global_load_lds((const unsigned*)((const char*)(gbase) + (size_t)_i * 128 * K + voffB0), (LAS unsigned*)(lds + (bufoff) + ldsw + _i * 8192), 16, 0, 0); } while (0)
#define PG8_LDA(dst, b, h) do { _Pragma("unroll") for (int m = 0; m < 4; ++m) _Pragma("unroll") for (int k = 0; k < 2; ++k) dst[m][k] = *(const LAS bf16x8*)(lds + PG8_SA(b, h) + aoff + m * 2048 + k * 1024); } while (0)
#define PG8_LDB(dst, b, h) do { _Pragma("unroll") for (int n = 0; n < 2; ++n) _Pragma("unroll") for (int k = 0; k < 2; ++k) dst[n][k] = *(const LAS bf16x8*)(lds + PG8_SB(b, h) + boff + n * 2048 + k * 1024); } while (0)
#define PG8_MMA(ai, bj, At, Bt) do { __builtin_amdgcn_s_setprio(1); _Pragma("unroll") for (int m = 0; m < 4; ++m) _Pragma("unroll") for (int n = 0; n < 2; ++n) _Pragma("unroll") for (int k = 0; k < 2; ++k) \
        acc[ai][bj][m][n] = __builtin_amdgcn_mfma_f32_16x16x32_bf16(Bt[n][k], At[m][k], acc[ai][bj][m][n], 0, 0, 0); __builtin_amdgcn_s_setprio(0); } while (0)
#define PG8_WAIT_V(n) asm volatile("s_waitcnt vmcnt(" #n ")" ::: "memory")
#define PG8_WAIT_L(n) asm volatile("s_waitcnt lgkmcnt(" #n ")" ::: "memory")
#define PG8_BAR __builtin_amdgcn_s_barrier()
#define PG8_SCHED __builtin_amdgcn_sched_barrier(0)
    Unit cur, nxt; int ui = 0;
    if (!S.next(0, cur)) return;
    f32x4 acc[2][2][4][2];
#pragma unroll
    for (int a = 0; a < 2; ++a)
#pragma unroll
        for (int b = 0; b < 2; ++b)
#pragma unroll
            for (int m = 0; m < 4; ++m)
#pragma unroll
                for (int n = 0; n < 2; ++n) acc[a][b][m][n] = (f32x4){0.f, 0.f, 0.f, 0.f};
    bf16x8 At[4][2], B0[2][2], B1[2][2];
    unsigned vAc[2][2], vAn[2][2];
    S.a_offsets(cur, Rp, Cp, vAc);
    const char* cB = S.b_ptr(cur);
    PG8_STAGEB(PG8_SB(0, 0), cB); PG8_STAGEB(PG8_SB(0, 1), cB + hstep); PG8_STAGE(PG8_SA(0, 0), Abase, vAc[0]); PG8_STAGE(PG8_SA(0, 1), Abase, vAc[1]);
    if (wr == 1) PG8_BAR;
    PG8_WAIT_V(2); PG8_BAR;
    PG8_STAGEB(PG8_SB(1, 0), cB + kstep); PG8_STAGE(PG8_SA(1, 0), Abase + kstep, vAc[0]); PG8_STAGEB(PG8_SB(1, 1), cB + hstep + kstep);
    PG8_WAIT_V(6); PG8_BAR;
    for (;;) {
        const bool has_next = S.next(ui + 1, nxt);
        const char* nB = has_next ? S.b_ptr(nxt) : cB;
        if (has_next) S.a_offsets(nxt, Rp, Cp, vAn);
        else {
#pragma unroll
            for (int h = 0; h < 2; ++h)
#pragma unroll
                for (int i = 0; i < 2; ++i) vAn[h][i] = vAc[h][i]; }
        for (int t = 0; t < nt; t += 2) {
            const bool last = (t == nt - 2);
            const char* a1 = Abase + (size_t)(t + 1) * kstep;
            const char* a2 = last ? Abase : Abase + (size_t)(t + 2) * kstep; const char* b2 = last ? nB : cB + (size_t)(t + 2) * kstep;
            const char* a3 = a2 + kstep; const char* b3 = b2 + kstep;
            unsigned v2[2][2];
#pragma unroll
            for (int h = 0; h < 2; ++h)
#pragma unroll
                for (int i = 0; i < 2; ++i) v2[h][i] = last ? vAn[h][i] : vAc[h][i];
            PG8_LDB(B0, 0, 0); PG8_LDB(B1, 0, 1); PG8_SCHED; PG8_LDA(At, 0, 0); PG8_STAGE(PG8_SA(1, 1), a1, vAc[1]);
            PG8_WAIT_V(8); PG8_WAIT_L(0); PG8_BAR; PG8_MMA(0, 0, At, B0); PG8_MMA(0, 1, At, B1); PG8_BAR; PG8_SCHED;
            PG8_LDA(At, 0, 1); PG8_STAGEB(PG8_SB(0, 0), b2); PG8_STAGEB(PG8_SB(0, 1), b2 + hstep); PG8_STAGE(PG8_SA(0, 0), a2, v2[0]);
            PG8_WAIT_V(8); PG8_WAIT_L(0); PG8_BAR; PG8_MMA(1, 0, At, B0); PG8_MMA(1, 1, At, B1); PG8_BAR; PG8_SCHED;
            PG8_LDB(B0, 1, 0); PG8_LDB(B1, 1, 1); PG8_SCHED; PG8_LDA(At, 1, 0); PG8_STAGE(PG8_SA(0, 1), a2, v2[1]);
            PG8_WAIT_V(8); PG8_WAIT_L(0); PG8_BAR; PG8_MMA(0, 0, At, B0); PG8_MMA(0, 1, At, B1); PG8_BAR; PG8_SCHED;
            PG8_LDA(At, 1, 1); PG8_STAGEB(PG8_SB(1, 0), b3); PG8_STAGEB(PG8_SB(1, 1), b3 + hstep); PG8_STAGE(PG8_SA(1, 0), a3, v2[0]);
            PG8_WAIT_V(8); PG8_WAIT_L(0); PG8_BAR; PG8_MMA(1, 0, At, B0); PG8_MMA(1, 1, At, B1); PG8_BAR; PG8_SCHED;
        }
        if constexpr (ALIGN_EPI) { if (wr == 0) PG8_BAR; }
        E(acc, cur, wr, wc, fr, fq);
        if (!has_next) break;
#pragma unroll
        for (int a = 0; a < 2; ++a)
#pragma unroll
            for (int b = 0; b < 2; ++b)
#pragma unroll
                for (int m = 0; m < 4; ++m)
#pragma unroll
                    for (int n = 0; n < 2; ++n) acc[a][b][m][n] = (f32x4){0.f, 0.f, 0.f, 0.f};
        cur = nxt; cB = nB; ++ui;
#pragma unroll
        for (int h = 0; h < 2; ++h)
#pragma unroll
            for (int i = 0; i < 2; ++i) vAc[h][i] = vAn[h][i];
        if constexpr (ALIGN_EPI) { if (wr == 1) PG8_BAR; }
    }
    PG8_WAIT_V(0);
    if constexpr (!ALIGN_EPI) { if (wr == 0) PG8_BAR; }
    PG8_BAR;
#undef PG8_SA
#undef PG8_SB
#undef PG8_STAGE
#undef PG8_STAGEB
#undef PG8_LDA
#undef PG8_LDB
#undef PG8_MMA
#undef PG8_WAIT_V
#undef PG8_WAIT_L
#undef PG8_BAR
#undef PG8_SCHED
}
template <class Epi, class Sched, bool ALIGN_EPI>
__device__ __forceinline__ void gemm_phase_f8g(LAS unsigned char* lds, const char* Abase, const int K, const Sched& S, const Epi& E) {
    const int tid = tidx(), wid = __builtin_amdgcn_readfirstlane(tid >> 6), lane = tid & 63, wr = wid >> 2, wc = wid & 3, fr = lane & 15, fq = lane >> 4;
    const int nt = K / 128;
    int Rp[2], Cp[2]; unsigned voffB0;
#pragma unroll
    for (int i = 0; i < 2; ++i) stage_rc(tid * 16 + i * 8192, Rp[i], Cp[i]);
    { const int Rb = Epi::PERM ? ((Rp[0] & ~31) + perm32(Rp[0] & 31)) : Rp[0]; voffB0 = (unsigned)(Rb * K + 2 * Cp[0]); }
    const size_t kstep = (size_t)(BK * 2);
    const size_t hstep = (size_t)HALF * K;
    const unsigned ldsw = (unsigned)wid * 1024u;
    const int aoff0 = lds_byte(wr * 64 + fr, 16 * (fq & 1)) + (fq >> 1) * 1024, boff0 = lds_byte(wc * 32 + fr, 16 * (fq & 1)) + (fq >> 1) * 1024;
#define PG8_SA(b, h) (((b) * 2 + (h)) * HTB)
#define PG8_SB(b, h) ((4 + (b) * 2 + (h)) * HTB)
#define PG8_STAGE(bufoff, gbase, voff) do { _Pragma("unroll") for (int _i = 0; _i < 2; ++_i) \
        __builtin_amdgcn_global_load_lds((const unsigned*)((const char*)(gbase) + (voff)[_i]), (LAS unsigned*)(lds + (bufoff) + ldsw + _i * 8192), 16, 0, 0); } while (0)
#define PG8_STAGEB(bufoff, gbase) do { _Pragma("unroll") for (int _i = 0; _i < 2; ++_i) \
        __builtin_amdgcn_global_load_lds((const unsigned*)((const char*)(gbase) + (size_t)_i * 64 * K + voffB0), (LAS unsigned*)(lds + (bufoff) + ldsw + _i * 8192), 16, 0, 0); } while (0)
#define PG8_LDA(dst, b, h) do { _Pragma("unroll") for (int m = 0; m < 4; ++m) { const u32x4 lo_ = *(const LAS u32x4*)(lds + PG8_SA(b, h) + aoff0 + m * 2048), hi_ = *(const LAS u32x4*)(lds + PG8_SA(b, h) + aoff0 + 16 + m * 2048); \
        dst[m] = (v8i){(int)lo_.x, (int)lo_.y, (int)lo_.z, (int)lo_.w, (int)hi_.x, (int)hi_.y, (int)hi_.z, (int)hi_.w}; } } while (0)
#define PG8_LDB(dst, b, h) do { _Pragma("unroll") for (int n = 0; n < 2; ++n) { const u32x4 lo_ = *(const LAS u32x4*)(lds + PG8_SB(b, h) + boff0 + n * 2048), hi_ = *(const LAS u32x4*)(lds + PG8_SB(b, h) + boff0 + 16 + n * 2048); \
        dst[n] = (v8i){(int)lo_.x, (int)lo_.y, (int)lo_.z, (int)lo_.w, (int)hi_.x, (int)hi_.y, (int)hi_.z, (int)hi_.w}; } } while (0)
#define PG8_MMA(ai, bj, At, Bt) do { __builtin_amdgcn_s_setprio(1); _Pragma("unroll") for (int m = 0; m < 4; ++m) _Pragma("unroll") for (int n = 0; n < 2; ++n) \
        asm volatile("v_mfma_scale_f32_16x16x128_f8f6f4 %0, %1, %2, %0, %3, %3 op_sel_hi:[0,0,0]" : "+v"(acc[ai][bj][m][n]) : "v"(Bt[n]), "v"(At[m]), "v"(f8scale)); __builtin_amdgcn_s_setprio(0); } while (0)
#define PG8_WAIT_V(n) asm volatile("s_waitcnt vmcnt(" #n ")" ::: "memory")
#define PG8_WAIT_L(n) asm volatile("s_waitcnt lgkmcnt(" #n ")" ::: "memory")
#define PG8_BAR __builtin_amdgcn_s_barrier()
#define PG8_SCHED __builtin_amdgcn_sched_barrier(0)
    Unit cur, nxt; int ui = 0;
    if (!S.next(0, cur)) return;
    f32x4 acc[2][2][4][2];
#pragma unroll
    for (int a = 0; a < 2; ++a)
#pragma unroll
        for (int b = 0; b < 2; ++b)
#pragma unroll
            for (int m = 0; m < 4; ++m)
#pragma unroll
                for (int n = 0; n < 2; ++n) acc[a][b][m][n] = (f32x4){0.f, 0.f, 0.f, 0.f};
    typedef int v8i __attribute__((ext_vector_type(8)));
    v8i At[4], B0[2], B1[2];
    const int f8scale = 0x7f7f7f7f;
    unsigned vAc[2][2], vAn[2][2];
    S.a_offsets(cur, Rp, Cp, vAc);
    const char* cB = S.b_ptr(cur);
    PG8_STAGEB(PG8_SB(0, 0), cB); PG8_STAGEB(PG8_SB(0, 1), cB + hstep); PG8_STAGE(PG8_SA(0, 0), Abase, vAc[0]); PG8_STAGE(PG8_SA(0, 1), Abase, vAc[1]);
    if (wr == 1) PG8_BAR;
    PG8_WAIT_V(2); PG8_BAR;
    PG8_STAGEB(PG8_SB(1, 0), cB + kstep); PG8_STAGE(PG8_SA(1, 0), Abase + kstep, vAc[0]); PG8_STAGEB(PG8_SB(1, 1), cB + hstep + kstep);
    PG8_WAIT_V(6); PG8_BAR;
    for (;;) {
        const bool has_next = S.next(ui + 1, nxt);
        const char* nB = has_next ? S.b_ptr(nxt) : cB;
        if (has_next) S.a_offsets(nxt, Rp, Cp, vAn);
        else {
#pragma unroll
            for (int h = 0; h < 2; ++h)
#pragma unroll
                for (int i = 0; i < 2; ++i) vAn[h][i] = vAc[h][i]; }
#pragma unroll 1
        for (int t = 0; t < nt; t += 2) {
            const bool last = (t == nt - 2);
            const char* a1 = Abase + (size_t)(t + 1) * kstep;
            const char* a2 = last ? Abase : Abase + (size_t)(t + 2) * kstep; const char* b2 = last ? nB : cB + (size_t)(t + 2) * kstep;
            const char* a3 = a2 + kstep; const char* b3 = b2 + kstep;
            unsigned v2[2][2];
#pragma unroll
            for (int h = 0; h < 2; ++h)
#pragma unroll
                for (int i = 0; i < 2; ++i) v2[h][i] = last ? vAn[h][i] : vAc[h][i];
            PG8_LDB(B0, 0, 0); PG8_LDB(B1, 0, 1); PG8_SCHED; PG8_LDA(At, 0, 0); PG8_STAGE(PG8_SA(1, 1), a1, vAc[1]);
            PG8_WAIT_V(8); PG8_WAIT_L(0); PG8_BAR; PG8_MMA(0, 0, At, B0); PG8_MMA(0, 1, At, B1); PG8_BAR; PG8_SCHED;
            PG8_LDA(At, 0, 1); PG8_STAGEB(PG8_SB(0, 0), b2); PG8_STAGEB(PG8_SB(0, 1), b2 + hstep); PG8_STAGE(PG8_SA(0, 0), a2, v2[0]);
            PG8_WAIT_V(8); PG8_WAIT_L(0); PG8_BAR; PG8_MMA(1, 0, At, B0); PG8_MMA(1, 1, At, B1); PG8_BAR; PG8_SCHED;
            PG8_LDB(B0, 1, 0); PG8_LDB(B1, 1, 1); PG8_SCHED; PG8_LDA(At, 1, 0); PG8_STAGE(PG8_SA(0, 1), a2, v2[1]);
            PG8_WAIT_V(8); PG8_WAIT_L(0); PG8_BAR; PG8_MMA(0, 0, At, B0); PG8_MMA(0, 1, At, B1); PG8_BAR; PG8_SCHED;
            PG8_LDA(At, 1, 1); PG8_STAGEB(PG8_SB(1, 0), b3); PG8_STAGEB(PG8_SB(1, 1), b3 + hstep); PG8_STAGE(PG8_SA(1, 0), a3, v2[0]);
            PG8_WAIT_V(8); PG8_WAIT_L(0); PG8_BAR; PG8_MMA(1, 0, At, B0); PG8_MMA(1, 1, At, B1); PG8_BAR; PG8_SCHED;
        }
        if constexpr (ALIGN_EPI) { if (wr == 0) PG8_BAR; }
        E(acc, cur, wr, wc, fr, fq);
        if (!has_next) break;
#pragma unroll
        for (int a = 0; a < 2; ++a)
#pragma unroll
            for (int b = 0; b < 2; ++b)
#pragma unroll
                for (int m = 0; m < 4; ++m)
#pragma unroll
                    for (int n = 0; n < 2; ++n) acc[a][b][m][n] = (f32x4){0.f, 0.f, 0.f, 0.f};
        cur = nxt; cB = nB; ++ui;
#pragma unroll
        for (int h = 0; h < 2; ++h)
#pragma unroll
            for (int i = 0; i < 2; ++i) vAc[h][i] = vAn[h][i];
        if constexpr (ALIGN_EPI) { if (wr == 1) PG8_BAR; }
    }
    PG8_WAIT_V(0);
    if constexpr (!ALIGN_EPI) { if (wr == 0) PG8_BAR; }
    PG8_BAR;
#undef PG8_SA
#undef PG8_SB
#undef PG8_STAGE
#undef PG8_STAGEB
#undef PG8_LDA
#undef PG8_LDB
#undef PG8_MMA
#undef PG8_WAIT_V
#undef PG8_WAIT_L
#undef PG8_BAR
#undef PG8_SCHED
}
template <class Epi, class Sched, bool ALIGN_EPI>
__device__ __forceinline__ void gemm_phase_f8(LAS unsigned char* lds, const char* Abase, const int K, const Sched& S, const Epi& E) {
    const int tid = tidx(), wid = __builtin_amdgcn_readfirstlane(tid >> 6), lane = tid & 63, wr = wid >> 2, wc = wid & 3, fr = lane & 15, fq = lane >> 4;
    const int nt = K / 128;
    int Rp[1], Cp[1]; unsigned voffB[1], voffA[1];
#pragma unroll
    for (int i = 0; i < 1; ++i) { stage_rc(tid * 16 + i * 8192, Rp[i], Cp[i]); const int Rb = Epi::PERM ? ((Rp[i] & ~31) + perm32(Rp[i] & 31)) : Rp[i]; voffB[i] = (unsigned)(Rb * K + 2 * Cp[i]); voffA[i] = (unsigned)(Rp[i] * K + 2 * Cp[i]); }
    const size_t kstep = (size_t)(BK * 2);
    const size_t hstep = (size_t)HALF * K;
    const unsigned ldsw = (unsigned)wid * 1024u;
    const int aoff0 = lds_byte(wr * 64 + fr, 16 * (fq & 1)) + (fq >> 1) * 1024, boff0 = lds_byte(wc * 32 + fr, 16 * (fq & 1)) + (fq >> 1) * 1024;
#define PG8_SA(b, h) (((b) * 2 + (h)) * HTB)
#define PG8_SB(b, h) ((4 + (b) * 2 + (h)) * HTB)
#define PG8_STAGE(bufoff, gbase, voff) do { _Pragma("unroll") for (int _i = 0; _i < 2; ++_i) \
        __builtin_amdgcn_global_load_lds((const unsigned*)((const char*)(gbase) + (size_t)_i * 64 * K + (voff)[0]), (LAS unsigned*)(lds + (bufoff) + ldsw + _i * 8192), 16, 0, 0); } while (0)
#define PG8_LDA(dst, b, h) do { _Pragma("unroll") for (int m = 0; m < 4; ++m) { const u32x4 lo_ = *(const LAS u32x4*)(lds + PG8_SA(b, h) + aoff0 + m * 2048), hi_ = *(const LAS u32x4*)(lds + PG8_SA(b, h) + aoff0 + 16 + m * 2048); \
        dst[m] = (v8i){(int)lo_.x, (int)lo_.y, (int)lo_.z, (int)lo_.w, (int)hi_.x, (int)hi_.y, (int)hi_.z, (int)hi_.w}; } } while (0)
#define PG8_LDB(dst, b, h) do { _Pragma("unroll") for (int n = 0; n < 2; ++n) { const u32x4 lo_ = *(const LAS u32x4*)(lds + PG8_SB(b, h) + boff0 + n * 2048), hi_ = *(const LAS u32x4*)(lds + PG8_SB(b, h) + boff0 + 16 + n * 2048); \
        dst[n] = (v8i){(int)lo_.x, (int)lo_.y, (int)lo_.z, (int)lo_.w, (int)hi_.x, (int)hi_.y, (int)hi_.z, (int)hi_.w}; } } while (0)
#define PG8_MMA(ai, bj, At, Bt) do { __builtin_amdgcn_s_setprio(1); _Pragma("unroll") for (int m = 0; m < 4; ++m) _Pragma("unroll") for (int n = 0; n < 2; ++n) \
        asm volatile("v_mfma_scale_f32_16x16x128_f8f6f4 %0, %1, %2, %0, %3, %3 op_sel_hi:[0,0,0]" : "+v"(acc[ai][bj][m][n]) : "v"(Bt[n]), "v"(At[m]), "v"(f8scale)); __builtin_amdgcn_s_setprio(0); } while (0)
#define PG8_WAIT_V(n) asm volatile("s_waitcnt vmcnt(" #n ")" ::: "memory")
#define PG8_WAIT_L(n) asm volatile("s_waitcnt lgkmcnt(" #n ")" ::: "memory")
#define PG8_BAR __builtin_amdgcn_s_barrier()
#define PG8_SCHED __builtin_amdgcn_sched_barrier(0)
    Unit cur, nxt; int ui = 0;
    if (!S.next(0, cur)) return;
    f32x4 acc[2][2][4][2];
#pragma unroll
    for (int a = 0; a < 2; ++a)
#pragma unroll
        for (int b = 0; b < 2; ++b)
#pragma unroll
            for (int m = 0; m < 4; ++m)
#pragma unroll
                for (int n = 0; n < 2; ++n) acc[a][b][m][n] = (f32x4){0.f, 0.f, 0.f, 0.f};
    typedef int v8i __attribute__((ext_vector_type(8)));
    v8i At[4], B0[2], B1[2];
    const int f8scale = 0x7f7f7f7f;
    const char* cA = S.a_ptr(cur, Abase);
    const char* cB = S.b_ptr(cur);
    PG8_STAGE(PG8_SB(0, 0), cB, voffB); PG8_STAGE(PG8_SB(0, 1), cB + hstep, voffB); PG8_STAGE(PG8_SA(0, 0), cA, voffA); PG8_STAGE(PG8_SA(0, 1), cA + hstep, voffA);
    if (wr == 1) PG8_BAR;
    PG8_WAIT_V(2); PG8_BAR;
    PG8_STAGE(PG8_SB(1, 0), cB + kstep, voffB); PG8_STAGE(PG8_SA(1, 0), cA + kstep, voffA); PG8_STAGE(PG8_SB(1, 1), cB + hstep + kstep, voffB);
    PG8_WAIT_V(6); PG8_BAR;
    for (;;) {
        const bool has_next = S.next(ui + 1, nxt);
        const char* nB = has_next ? S.b_ptr(nxt) : cB; const char* nA = has_next ? S.a_ptr(nxt, Abase) : cA;
#pragma unroll 1
        for (int t = 0; t < nt; t += 2) {
            const bool last = (t == nt - 2);
            const char* a1 = cA + (size_t)(t + 1) * kstep;
            const char* a2 = last ? nA : cA + (size_t)(t + 2) * kstep; const char* b2 = last ? nB : cB + (size_t)(t + 2) * kstep;
            const char* a3 = a2 + kstep; const char* b3 = b2 + kstep;
            PG8_LDB(B0, 0, 0); PG8_LDB(B1, 0, 1); PG8_SCHED; PG8_LDA(At, 0, 0); PG8_STAGE(PG8_SA(1, 1), a1 + hstep, voffA);
            PG8_WAIT_V(8); PG8_WAIT_L(0); PG8_BAR; PG8_MMA(0, 0, At, B0); PG8_MMA(0, 1, At, B1); PG8_BAR; PG8_SCHED;
            PG8_LDA(At, 0, 1); PG8_STAGE(PG8_SB(0, 0), b2, voffB); PG8_STAGE(PG8_SB(0, 1), b2 + hstep, voffB); PG8_STAGE(PG8_SA(0, 0), a2, voffA);
            PG8_WAIT_V(8); PG8_WAIT_L(0); PG8_BAR; PG8_MMA(1, 0, At, B0); PG8_MMA(1, 1, At, B1); PG8_BAR; PG8_SCHED;
            PG8_LDB(B0, 1, 0); PG8_LDB(B1, 1, 1); PG8_SCHED; PG8_LDA(At, 1, 0); PG8_STAGE(PG8_SA(0, 1), a2 + hstep, voffA);
            PG8_WAIT_V(8); PG8_WAIT_L(0); PG8_BAR; PG8_MMA(0, 0, At, B0); PG8_MMA(0, 1, At, B1); PG8_BAR; PG8_SCHED;
            PG8_LDA(At, 1, 1); PG8_STAGE(PG8_SB(1, 0), b3, voffB); PG8_STAGE(PG8_SB(1, 1), b3 + hstep, voffB); PG8_STAGE(PG8_SA(1, 0), a3, voffA);
            PG8_WAIT_V(8); PG8_WAIT_L(0); PG8_BAR; PG8_MMA(1, 0, At, B0); PG8_MMA(1, 1, At, B1); PG8_BAR; PG8_SCHED;
        }
        if constexpr (ALIGN_EPI) { if (wr == 0) PG8_BAR; }
        E(acc, cur, wr, wc, fr, fq);
        if (!has_next) break;
#pragma unroll
        for (int a = 0; a < 2; ++a)
#pragma unroll
            for (int b = 0; b < 2; ++b)
#pragma unroll
                for (int m = 0; m < 4; ++m)
#pragma unroll
                    for (int n = 0; n < 2; ++n) acc[a][b][m][n] = (f32x4){0.f, 0.f, 0.f, 0.f};
        cur = nxt; cB = nB; cA = nA; ++ui;
        if constexpr (ALIGN_EPI) { if (wr == 1) PG8_BAR; }
    }
    PG8_WAIT_V(0);
    if constexpr (!ALIGN_EPI) { if (wr == 0) PG8_BAR; }
    PG8_BAR;
#undef PG8_SA
#undef PG8_SB
#undef PG8_STAGE
#undef PG8_LDA
#undef PG8_LDB
#undef PG8_MMA
#undef PG8_WAIT_V
#undef PG8_WAIT_L
#undef PG8_BAR
#undef PG8_SCHED
}
}

struct Args { const float* in[39]; float* out; unsigned char* ws; int ph_lo, ph_hi; };
typedef const __attribute__((address_space(4))) Args CArgs;
enum { I_X = 0, I_C, I_CTX, I_CCTX, I_WADA, I_BADA, I_WIN, I_HYCW, I_HYCB, I_HYW1, I_HYB1, I_HYW2, I_HYB2, I_HYW3, I_HYB3, I_HYW4, I_HYFREQ, I_HYD, I_SCCW,
       I_GLAWA, I_GLABA, I_GLANW, I_GDNCW, I_GDNALOG, I_GDNDT, I_GDNNW, I_WOUT, I_LN1G, I_LN1B, I_WR, I_BR, I_WG, I_BG, I_WU, I_BU, I_WD, I_BD, I_LN2G, I_LN2B };

__device__ __forceinline__ int row_batch(int row) { return row < NTOK_C ? (row >> 8) : ((row - NTOK_C) >> 11); }
__device__ __forceinline__ int mod_vec(int row) { return row < NTOK_C ? 16 : ((row - NTOK_C) >> 11); }

__device__ __forceinline__ void ph_mod(CArgs& a, LAS unsigned char* lds, int bid, int nblk) {
    LAS float* sc = (LAS float*)lds; LAS float* red = (LAS float*)(lds + 17 * 1024 * 4);
    const int tid = tidx(), lane = tid & 63, w = tid >> 6;
    const float* c = a.in[I_C]; const float* cc = a.in[I_CCTX];
    for (int i = tid; i < 17 * 1024; i += 512) { const float v = i < 16 * 1024 ? c[i] : cc[i - 16 * 1024]; sc[i] = siluf_(v); }
    __syncthreads();
    float* MOD = (float*)(a.ws + WS_MOD);
    for (int it = bid; it < DEPTH * 96; it += nblk) {
        const int l = it / 96, j0 = (it % 96) * 64;
        const float* W = a.in[I_WADA] + (size_t)l * 1024 * 6144 + j0 + lane;
        float acc[17];
#pragma unroll
        for (int v = 0; v < 17; ++v) acc[v] = 0.f;
#pragma unroll 16
        for (int kk = 0; kk < 128; ++kk) { const int k = w * 128 + kk; const float wv = W[(size_t)k * 6144];
#pragma unroll
            for (int v = 0; v < 17; ++v) acc[v] += sc[v * 1024 + k] * wv; }
#pragma unroll
        for (int v = 0; v < 17; ++v) red[(w * 17 + v) * 64 + lane] = acc[v];
        __syncthreads();
        for (int o = tid; o < 17 * 64; o += 512) { const int v = o >> 6, jj = o & 63; float s = 0.f;
#pragma unroll
            for (int ww = 0; ww < 8; ++ww) s += red[(ww * 17 + v) * 64 + jj];
            MOD[(size_t)(l * 17 + v) * 6144 + j0 + jj] = s + a.in[I_BADA][l * 6144 + j0 + jj]; }
        __syncthreads();
    }
}

__device__ __forceinline__ void ph_filters(CArgs& a, int gw, int ngw) {
    const int lane = tidx() & 63;
    float* KUN = (float*)(a.ws + WS_KUN);
#pragma unroll 1
    for (int it = gw; it < DEPTH * (CTXL + SEQ) / 4; it += ngw) {
        const int l = it / ((CTXL + SEQ) / 4), r = (it % ((CTXL + SEQ) / 4)) * 4, Lt = r < CTXL ? 0 : 1, pos0 = Lt ? r - CTXL : r, L = Lt ? SEQ : CTXL;
        float z[4], tn[4];
#pragma unroll
        for (int p = 0; p < 4; ++p) { const int pos = pos0 + p; tn[p] = (float)pos / (float)(L - 1); z[p] = 0.f;
            if (lane == 0) z[p] = tn[p];
            else if (lane <= 32) { const int j = (lane - 1) & 15; const float fj = 1e-4f + (float)j * ((15.f - 1e-4f) / 15.f);
                double rev = (double)fj * (double)pos / (double)L; rev -= floor(rev); const float rf = (float)rev;
                z[p] = lane <= 16 ? sin_rev(rf + 0.25f) : -sin_rev(rf); } }
        const float* w1 = a.in[I_HYW1] + l * 33 * 64; const float* w2 = a.in[I_HYW2] + l * 64 * 64; const float* w3 = a.in[I_HYW3] + l * 64 * 64; const float* w4 = a.in[I_HYW4] + l * 64 * 512;
        const float* fq = a.in[I_HYFREQ] + l * 3 * 64;
        float s[4], h[4];
        { const float bb = a.in[I_HYB1][l * 64 + lane];
#pragma unroll
          for (int p = 0; p < 4; ++p) s[p] = bb; }
#pragma unroll
        for (int i = 0; i < 33; ++i) { const float ww = w1[i * 64 + lane];
#pragma unroll
            for (int p = 0; p < 4; ++p) s[p] += rdlane_f(z[p], i) * ww; }
#pragma unroll
        for (int p = 0; p < 4; ++p) h[p] = sin_rad(fq[lane] * s[p]);
        { const float bb = a.in[I_HYB2][l * 64 + lane];
#pragma unroll
          for (int p = 0; p < 4; ++p) s[p] = bb; }
#pragma unroll 16
        for (int i = 0; i < 64; ++i) { const float ww = w2[i * 64 + lane];
#pragma unroll
            for (int p = 0; p < 4; ++p) s[p] += rdlane_f(h[p], i) * ww; }
#pragma unroll
        for (int p = 0; p < 4; ++p) h[p] = sin_rad(fq[64 + lane] * s[p]);
        { const float bb = a.in[I_HYB3][l * 64 + lane];
#pragma unroll
          for (int p = 0; p < 4; ++p) s[p] = bb; }
#pragma unroll 16
        for (int i = 0; i < 64; ++i) { const float ww = w3[i * 64 + lane];
#pragma unroll
            for (int p = 0; p < 4; ++p) s[p] += rdlane_f(h[p], i) * ww; }
#pragma unroll
        for (int p = 0; p < 4; ++p) h[p] = sin_rad(fq[128 + lane] * s[p]);
        float k[8][4];
#pragma unroll
        for (int m = 0; m < 8; ++m)
#pragma unroll
            for (int p = 0; p < 4; ++p) k[m][p] = 0.f;
#pragma unroll 4
        for (int i = 0; i < 64; ++i) { float hi[4];
#pragma unroll
            for (int p = 0; p < 4; ++p) hi[p] = rdlane_f(h[p], i);
#pragma unroll
            for (int m = 0; m < 8; ++m) { const float ww = w4[i * 512 + m * 64 + lane];
#pragma unroll
                for (int p = 0; p < 4; ++p) k[m][p] += hi[p] * ww; } }
#pragma unroll
        for (int m = 0; m < 8; ++m) { const int o = m * 64 + lane, ch = o & 255;
            const float delta = 3.0701134573253944f + (float)ch * ((15.350567286626972f - 3.0701134573253944f) / 255.f);
            *(f32x4*)(KUN + ((size_t)((l * 2 + Lt) * 512 + o)) * 2048 + pos0) = (f32x4){k[m][0] * __expf(-tn[0] * delta), k[m][1] * __expf(-tn[1] * delta), k[m][2] * __expf(-tn[2] * delta), k[m][3] * __expf(-tn[3] * delta)}; }
    }
}

__device__ __forceinline__ void ph_router_w(CArgs& a, int gt, int ngt) {
    bf16* hi = (bf16*)(a.ws + WS_WRT); bf16* lo = hi + DEPTH * NEXP * D;
    for (int i = gt; i < DEPTH * NEXP * D; i += ngt) { const int l = i / (NEXP * D), r = i % (NEXP * D), e = r / D, k = r % D;
        const float w = a.in[I_WR][((size_t)l * D + k) * NEXP + e]; const unsigned h = f2bf(w); hi[i] = (bf16)h; lo[i] = (bf16)f2bf(w - bf2f(h)); }
}
__device__ __forceinline__ void tr_item(const float* W, int Nsrc, int K, bf16* WTrow0, int n0, int k0, LAS float* scr, int lane) {
    const int c4 = (lane & 7) * 4; const bool ok = n0 + c4 < Nsrc;
    f32x4 t[8];
#pragma unroll
    for (int j = 0; j < 8; ++j) { const int kk = 8 * j + (lane >> 3); t[j] = ok ? *(const f32x4*)(W + (size_t)(k0 + kk) * Nsrc + n0 + c4) : (f32x4){0.f, 0.f, 0.f, 0.f}; }
#pragma unroll
    for (int j = 0; j < 8; ++j) { const int kk = 8 * j + (lane >> 3); LAS float* d = scr + kk * 33 + c4; d[0] = t[j][0]; d[1] = t[j][1]; d[2] = t[j][2]; d[3] = t[j][3]; }
    asm volatile("s_waitcnt lgkmcnt(0)" ::: "memory");
    const int c = lane & 7;
#pragma unroll
    for (int j = 0; j < 4; ++j) { const int n = (lane >> 3) + 8 * j; const LAS float* s = scr + (8 * c) * 33 + n;
        u32x4 o; o.x = pk2(s[0 * 33], s[1 * 33]); o.y = pk2(s[2 * 33], s[3 * 33]); o.z = pk2(s[4 * 33], s[5 * 33]); o.w = pk2(s[6 * 33], s[7 * 33]);
        *(u32x4*)(WTrow0 + (size_t)n * K + k0 + 8 * c) = o; }
    asm volatile("s_waitcnt lgkmcnt(0)" ::: "memory");
}
__device__ __forceinline__ void tr_item_f8(const float* W, int Nsrc, int K, unsigned char* WTrow0, int n0, int k0, float scale, LAS float* scr, int lane) {
    const int c4 = (lane & 7) * 4;
    f32x4 t[8];
#pragma unroll
    for (int j = 0; j < 8; ++j) { const int kk = 8 * j + (lane >> 3); t[j] = *(const f32x4*)(W + (size_t)(k0 + kk) * Nsrc + n0 + c4); }
#pragma unroll
    for (int j = 0; j < 8; ++j) { const int kk = 8 * j + (lane >> 3); LAS float* d = scr + kk * 33 + c4; d[0] = t[j][0]; d[1] = t[j][1]; d[2] = t[j][2]; d[3] = t[j][3]; }
    asm volatile("s_waitcnt lgkmcnt(0)" ::: "memory");
    const int n = lane >> 1, half = lane & 1; const LAS float* s = scr + (32 * half) * 33 + n;
    unsigned o[8];
#pragma unroll
    for (int i = 0; i < 8; ++i) o[i] = pk4_fp8(s[(4 * i) * 33] * scale, s[(4 * i + 1) * 33] * scale, s[(4 * i + 2) * 33] * scale, s[(4 * i + 3) * 33] * scale);
    unsigned char* dst = WTrow0 + (size_t)n * K + k0 + 32 * half;
    *(u32x4*)dst = (u32x4){o[0], o[1], o[2], o[3]}; *(u32x4*)(dst + 16) = (u32x4){o[4], o[5], o[6], o[7]};
    asm volatile("s_waitcnt lgkmcnt(0)" ::: "memory");
}
__device__ __forceinline__ void ph_tr_small(CArgs& a, LAS unsigned char* lds, int gw, int ngw) {
    const int lane = tidx() & 63, w = tidx() >> 6;
    LAS float* scr = (LAS float*)(lds + w * 8448);
    constexpr int I_IN = 16 * (D_INP / 32), I_OUT = 16 * 32;
    for (int it = gw; it < DEPTH * (I_IN + I_OUT); it += ngw) {
        const int l = it / (I_IN + I_OUT); int r = it % (I_IN + I_OUT);
        if (r < I_IN) { const int kb = r / (D_INP / 32), nb = r % (D_INP / 32);
            tr_item(a.in[I_WIN] + (size_t)l * 1024 * D_IN, D_IN, 1024, (bf16*)(a.ws + WS_WIN) + ((size_t)l * D_INP + nb * 32) * 1024, nb * 32, kb * 64, scr, lane); }
        else { r -= I_IN; const int kb = r / 32, nb = r % 32;
            tr_item(a.in[I_WOUT] + (size_t)l * 1024 * 1024, 1024, 1024, (bf16*)(a.ws + WS_WOUT) + ((size_t)l * 1024 + nb * 32) * 1024, nb * 32, kb * 64, scr, lane); }
    }
}
__device__ __forceinline__ void tr_experts_range(CArgs& a, int l, LAS unsigned char* scrb, int first, int last, int stride, int lane) {
    LAS float* scr = (LAS float*)scrb;
#pragma unroll 1
    for (int it = first; it < last; it += stride) {
        const int e = it / 1536, r = it % 1536, which = r / 512, q = r % 512, kb = q / 32, nb = q % 32, n0 = nb * 32;
        const float* W = a.in[which == 0 ? I_WG : (which == 1 ? I_WU : I_WD)] + ((size_t)(l * NEXP + e)) * 1024 * 1024;
        if (which == 2) tr_item_f8(W, 1024, 1024, a.ws + WS_WD + ((size_t)e * 1024 + n0) * 1024, n0, kb * 64, 32.f, scr, lane);
        else tr_item_f8(W, 1024, 1024, a.ws + WS_WGU + ((size_t)e * 2048 + (n0 >> 7) * 256 + which * 128 + (n0 & 127)) * 1024, n0, kb * 64, 32.f, scr, lane);
    }
}
__device__ __forceinline__ void ph_mod_input(CArgs& a, int gw, int ngw) {
    const int lane = tidx() & 63;
    const float* MOD = (const float*)(a.ws + WS_MOD);
    bf16* HB = (bf16*)(a.ws + WS_HB);
    for (int row = gw; row < NTOK; row += ngw) {
        const float* src = row < NTOK_C ? a.in[I_CTX] + (size_t)row * D : a.in[I_X] + (size_t)(row - NTOK_C) * D;
        const float* mv = MOD + (size_t)mod_vec(row) * 6144;
#pragma unroll
        for (int j = 0; j < 4; ++j) { const int c0 = j * 256 + lane * 4; const f32x4 x = *(const f32x4*)(src + c0), sh = *(const f32x4*)(mv + c0), sc = *(const f32x4*)(mv + 1024 + c0);
            u32x2 o; o.x = pk2(x[0] * (1.f + sc[0]) + sh[0], x[1] * (1.f + sc[1]) + sh[1]); o.y = pk2(x[2] * (1.f + sc[2]) + sh[2], x[3] * (1.f + sc[3]) + sh[3]);
            *(u32x2*)(HB + (size_t)row * D + c0) = o; }
    }
}

struct Chunk { int b, t0, L, row0, lo, hi; };
__device__ __forceinline__ Chunk chunk_of(int it) {
    Chunk c;
    if (it < 64) { c.b = it >> 2; c.t0 = (it & 3) * 64; c.L = CTXL; c.row0 = c.b * CTXL + c.t0; c.lo = 0; c.hi = CTXL; }
    else { const int r = it - 64; c.b = r >> 5; c.t0 = (r & 31) * 64; c.L = SEQ; c.row0 = NTOK_C + c.b * SEQ + c.t0; c.lo = c.t0; c.hi = c.t0 + 64; }
    return c;
}
__device__ __forceinline__ f32x4 bf4(u32x2 v) { return (f32x4){lo_bf(v.x), hi_bf(v.x), lo_bf(v.y), hi_bf(v.y)}; }
__device__ __forceinline__ void ph_prep_conv(CArgs& a, int l, LAS unsigned char* lds, int bid, int nblk) {
    const bf16* P = (const bf16*)(a.ws + WS_P);
    bf16* ZT = (bf16*)(a.ws + WS_MIX + MX_ZT); bf16* YMIX = (bf16*)(a.ws + WS_YMIX);
    LAS bf16* zt = (LAS bf16*)lds;
    const int tid = tidx(), c4 = (tid & 63) * 4, tg = tid >> 6;
    const float* hw = a.in[I_HYCW] + l * 3 * 768; const float* hb = a.in[I_HYCB] + l * 768; const float* sw = a.in[I_SCCW] + l * 3 * 256;
    f32x4 wx[3], wv[3], ws3[3];
#pragma unroll
    for (int k = 0; k < 3; ++k) { wx[k] = *(const f32x4*)(hw + k * 768 + 256 + c4); wv[k] = *(const f32x4*)(hw + k * 768 + 512 + c4); ws3[k] = *(const f32x4*)(sw + k * 256 + c4); }
    const f32x4 bx = *(const f32x4*)(hb + 256 + c4), bv = *(const f32x4*)(hb + 512 + c4);
#pragma unroll 1
    for (int it = bid; it < 576; it += nblk) {
        const Chunk c = chunk_of(it);
        const int tb = c.t0 + tg * 8;
        const bf16* pb = P + (size_t)(c.row0 + tg * 8) * D_INP;
        f32x4 x1[10], vv[10], mm[10];
#pragma unroll
        for (int r = 0; r < 10; ++r) { const int t = tb + r - 1, tc = min(max(t, c.lo), c.hi - 1); const float ok = (t == tc) ? 1.f : 0.f; const bf16* p = pb + (ptrdiff_t)(tc - tb) * D_INP;
            x1[r] = ok * bf4(*(const u32x2*)(p + HY0 + 256 + c4)); vv[r] = ok * bf4(*(const u32x2*)(p + HY0 + 512 + c4));
            mm[r] = ok * bf4(*(const u32x2*)(p + SC0 + 256 + c4)) * bf4(*(const u32x2*)(p + SC0 + 512 + c4)); }
#pragma unroll
        for (int tt = 0; tt < 8; ++tt) {
            const f32x4 xx = wx[0] * x1[tt] + wx[1] * x1[tt + 1] + wx[2] * x1[tt + 2] + bx, v2 = wv[0] * vv[tt] + wv[1] * vv[tt + 1] + wv[2] * vv[tt + 2] + bv, z = xx * v2;
            u32x2 zo; zo.x = pk2(z[0], z[1]); zo.y = pk2(z[2], z[3]); *(LAS u32x2*)(zt + (tg * 8 + tt) * 264 + c4) = zo;
            const f32x4 bg = bf4(*(const u32x2*)(pb + (size_t)tt * D_INP + SC0 + c4));
            const f32x4 y = bg * (ws3[0] * mm[tt] + ws3[1] * mm[tt + 1] + ws3[2] * mm[tt + 2]);
            u32x2 yo; yo.x = pk2(y[0], y[1]); yo.y = pk2(y[2], y[3]); *(u32x2*)(YMIX + (size_t)(c.row0 + tg * 8 + tt) * D + 256 + c4) = yo;
        }
        __syncthreads();
        { const int ch = tid & 255, g0 = (tid >> 8) * 4;
          const int soff = c.L == CTXL ? 0 : CTXL;
#pragma unroll
          for (int g = 0; g < 4; ++g) { const int t8 = (g0 + g) * 8; unsigned short e[8];
#pragma unroll
              for (int j = 0; j < 8; ++j) e[j] = zt[(t8 + j) * 264 + ch];
              u32x4 o; o.x = e[0] | ((unsigned)e[1] << 16); o.y = e[2] | ((unsigned)e[3] << 16); o.z = e[4] | ((unsigned)e[5] << 16); o.w = e[6] | ((unsigned)e[7] << 16);
              *(u32x4*)(ZT + ((size_t)(ch * 16 + c.b)) * 2304 + soff + c.t0 + t8) = o; } }
        __syncthreads();
    }
}
__device__ __forceinline__ void ph_prep_tok(CArgs& a, int l, LAS unsigned char* lds, int gw, int ngw) {
    const int tid = tidx(), lane = tid & 63;
    const bf16* P = (const bf16*)(a.ws + WS_P);
    float* GDF = (float*)(a.ws + WS_MIX + MX_GDF); float* GDB = (float*)(a.ws + WS_MIX + MX_GDB);
    float* DQ = (float*)(a.ws + WS_MIX + MX_DQ); float* DK = (float*)(a.ws + WS_MIX + MX_DK); float* DV = (float*)(a.ws + WS_MIX + MX_DV); float* DG = (float*)(a.ws + WS_MIX + MX_DG);
    LAS float* swa = (LAS float*)(lds + 40960);
    LAS float* sba = swa + 4096;
    LAS float* scw = sba + 256;
    { const float* wa = a.in[I_GLAWA] + l * 2 * 16 * 128; const float* ba = a.in[I_GLABA] + l * 2 * 128; const float* cw = a.in[I_GDNCW] + l * 3 * 768;
      for (int i = tid; i < 4096; i += 512) swa[i] = wa[i];
      if (tid < 256) sba[tid] = ba[tid];
      for (int i = tid; i < 2304; i += 512) scw[i] = cw[i]; }
    const int gh = lane & 3, gr = (lane >> 2) & 3;
    const float eaf = -__expf(a.in[I_GDNALOG][l * 8 + gh]), eab = -__expf(a.in[I_GDNALOG][l * 8 + 4 + gh]), dtf = a.in[I_GDNDT][l * 8 + gh], dtb = a.in[I_GDNDT][l * 8 + 4 + gh];
    __syncthreads();
#pragma unroll 1
    for (int row0 = gw * 4; row0 < NTOK; row0 += ngw * 4) {
        int z = 0; asm volatile("" : "+v"(z));
        const LAS float* wa = swa + z; const LAS float* cw = scw + z;
        const bf16* pr0 = P + (size_t)row0 * D_INP;
        int tpos, lo, hi;
        if (row0 < NTOK_C) { tpos = row0 & 255; lo = 0; hi = CTXL; } else { tpos = (row0 - NTOK_C) & 2047; lo = tpos & ~63; hi = lo + 64; }
        bf16 avb[4]; u32x2 xr[3][6]; bf16 gb4[4];
#pragma unroll
        for (int r = 0; r < 4; ++r) avb[r] = pr0[(size_t)r * D_INP + GLA0 + 768 + (lane & 31)];
#pragma unroll
        for (int g = 0; g < 3; ++g)
#pragma unroll
            for (int r = 0; r < 6; ++r) { const int tc = min(max(tpos + r - 1, lo), hi - 1); xr[g][r] = *(const u32x2*)(pr0 + (ptrdiff_t)(tc - tpos) * D_INP + GDN0 + g * 256 + 4 * lane); }
#pragma unroll
        for (int i = 0; i < 4; ++i) gb4[i] = pr0[(size_t)gr * D_INP + GDN0 + 1024 + 4 * i + gh];
        float av[4], s[4][4];
#pragma unroll
        for (int r = 0; r < 4; ++r) { av[r] = bf2f(avb[r]); s[r][0] = sba[lane]; s[r][1] = sba[64 + lane]; s[r][2] = sba[128 + lane]; s[r][3] = sba[192 + lane]; }
#pragma unroll
        for (int i = 0; i < 16; ++i) { const float w0 = wa[i * 128 + lane], w1 = wa[i * 128 + 64 + lane], w2 = wa[2048 + i * 128 + lane], w3 = wa[2048 + i * 128 + 64 + lane];
#pragma unroll
            for (int r = 0; r < 4; ++r) { const float af = rdlane_f(av[r], i), ab = rdlane_f(av[r], 16 + i); s[r][0] += af * w0; s[r][1] += af * w1; s[r][2] += ab * w2; s[r][3] += ab * w3; } }
#pragma unroll
        for (int r = 0; r < 4; ++r) { const size_t o = (size_t)(row0 + r) * 128;
            GDF[o + lane] = logsigmoidf_(s[r][0]) * 0.0625f; GDF[o + 64 + lane] = logsigmoidf_(s[r][1]) * 0.0625f;
            GDB[o + lane] = logsigmoidf_(s[r][2]) * 0.0625f; GDB[o + 64 + lane] = logsigmoidf_(s[r][3]) * 0.0625f; }
        float sq[4] = {0.f, 0.f, 0.f, 0.f}, sk[4] = {0.f, 0.f, 0.f, 0.f}; f32x4 qv[4], kv[4];
#pragma unroll
        for (int g = 0; g < 3; ++g) { const int col = g * 256 + 4 * lane;
            f32x4 x[6];
#pragma unroll
            for (int r = 0; r < 6; ++r) { const int t = tpos + r - 1; x[r] = (t >= lo && t < hi) ? bf4(xr[g][r]) : (f32x4){0.f, 0.f, 0.f, 0.f}; }
            const f32x4 w0 = *(const LAS f32x4*)(cw + col), w1 = *(const LAS f32x4*)(cw + 768 + col), w2 = *(const LAS f32x4*)(cw + 1536 + col);
#pragma unroll
            for (int r = 0; r < 4; ++r) { f32x4 y = w0 * x[r] + w1 * x[r + 1] + w2 * x[r + 2];
                y[0] = siluf_(y[0]); y[1] = siluf_(y[1]); y[2] = siluf_(y[2]); y[3] = siluf_(y[3]);
                if (g == 0) { qv[r] = y; sq[r] = (y[0] * y[0] + y[1] * y[1]) + (y[2] * y[2] + y[3] * y[3]); }
                else if (g == 1) { kv[r] = y; sk[r] = (y[0] * y[0] + y[1] * y[1]) + (y[2] * y[2] + y[3] * y[3]); }
                else *(f32x4*)(DV + (size_t)(row0 + r) * 256 + 4 * lane) = y; } }
#pragma unroll
        for (int r = 0; r < 4; ++r) { const float rq = rsqrtf(row16_sum(sq[r]) + 1e-6f) * 0.125f, rk = rsqrtf(row16_sum(sk[r]) + 1e-6f);
            const f32x4 qn = qv[r] * rq, kn = kv[r] * rk;
            *(f32x4*)(DQ + (size_t)(row0 + r) * 256 + 4 * lane) = qn; *(f32x4*)(DK + (size_t)(row0 + r) * 256 + 4 * lane) = kn;
            *(u32x2*)((bf16*)(a.ws + WS_CKD + CD_QB) + (size_t)(row0 + r) * 256 + 4 * lane) = (u32x2){pk2(qn[0], qn[1]), pk2(qn[2], qn[3])};
            *(u32x2*)((bf16*)(a.ws + WS_CKD + CD_KB) + (size_t)(row0 + r) * 256 + 4 * lane) = (u32x2){pk2(kn[0], kn[1]), pk2(kn[2], kn[3])}; }
        if (lane < 16) { const float af = bf2f(gb4[0]), ab = bf2f(gb4[1]), bfv = bf2f(gb4[2]), bbv = bf2f(gb4[3]);
            const float gf = eaf * softplusf_(af + dtf), gb = eab * softplusf_(ab + dtb);
            *(f32x4*)(DG + (size_t)(row0 + gr) * 16 + 4 * gh) = (f32x4){sigmoidf_(bfv), gf, sigmoidf_(bbv), gb}; }
    }
}

__device__ __forceinline__ int scan_row(int b, int dir, int n) {
    if (n < CTXL) return b * CTXL + (dir ? CTXL - 1 - n : n);
    const int m = n - CTXL; return NTOK_C + b * SEQ + (dir ? SEQ - 1 - m : m);
}
__device__ __forceinline__ void gla_chain(CArgs& a, int chain, LAS unsigned char* lds) {
    const int b = chain >> 3, h = (chain >> 1) & 3, dir = chain & 1;
    const int tid = tidx(), lane = tid & 63, w = tid >> 6, vv = lane & 7, kq = lane >> 3;
    const bf16* P = (const bf16*)(a.ws + WS_P);
    const float* GD = (const float*)(a.ws + WS_MIX + (dir ? MX_GDB : MX_GDF));
    float* GO = (float*)(a.ws + WS_MIX + (dir ? MX_GOB : MX_GOF));
    LAS float* sq = (LAS float*)lds;
    LAS float* sk = sq + 64 * 32;
    LAS float* sd = sk + 64 * 32;
    LAS float* sv = sd + 64 * 32;
    float S[4] = {0.f, 0.f, 0.f, 0.f};
    for (int ch = 0; ch < 36; ++ch) {
        { const int tt = tid >> 3, sub = tid & 7, row = scan_row(b, dir, ch * 64 + tt);
          const bf16* pr = P + (size_t)row * D_INP + GLA0;
          const u32x2 qv = *(const u32x2*)(pr + h * 32 + sub * 4), kv = *(const u32x2*)(pr + 128 + h * 32 + sub * 4);
          const f32x4 dv = *(const f32x4*)(GD + (size_t)row * 128 + h * 32 + sub * 4);
          const u32x4 vv8 = *(const u32x4*)(pr + 256 + h * 64 + sub * 8);
          const float qs = 0.17677669529663687f;
          *(LAS f32x4*)(sq + tt * 32 + sub * 4) = (f32x4){lo_bf(qv.x) * qs, hi_bf(qv.x) * qs, lo_bf(qv.y) * qs, hi_bf(qv.y) * qs};
          *(LAS f32x4*)(sk + tt * 32 + sub * 4) = (f32x4){lo_bf(kv.x), hi_bf(kv.x), lo_bf(kv.y), hi_bf(kv.y)};
          *(LAS f32x4*)(sd + tt * 32 + sub * 4) = dv;
          *(LAS f32x4*)(sv + tt * 64 + sub * 8) = (f32x4){lo_bf(vv8.x), hi_bf(vv8.x), lo_bf(vv8.y), hi_bf(vv8.y)};
          *(LAS f32x4*)(sv + tt * 64 + sub * 8 + 4) = (f32x4){lo_bf(vv8.z), hi_bf(vv8.z), lo_bf(vv8.w), hi_bf(vv8.w)}; }
        __syncthreads();
#pragma unroll 4
        for (int tt = 0; tt < 64; ++tt) {
            const f32x4 q4 = *(const LAS f32x4*)(sq + tt * 32 + kq * 4), k4 = *(const LAS f32x4*)(sk + tt * 32 + kq * 4), d4 = *(const LAS f32x4*)(sd + tt * 32 + kq * 4);
            const float v = sv[tt * 64 + w * 8 + vv];
            float o = 0.f;
#pragma unroll
            for (int j = 0; j < 4; ++j) { S[j] = d4[j] * S[j] + k4[j] * v; o += q4[j] * S[j]; }
            o += __shfl_xor(o, 8); o += __shfl_xor(o, 16); o += __shfl_xor(o, 32);
            if (kq == 0) GO[(size_t)scan_row(b, dir, ch * 64 + tt) * 256 + h * 64 + w * 8 + vv] = o;
        }
        __syncthreads();
    }
}
__device__ __forceinline__ void gdn_chain(CArgs& a, int chain, LAS unsigned char* lds) {
    const int b = chain >> 3, h = (chain >> 1) & 3, dir = chain & 1;
    const int tid = tidx(), lane = tid & 63, w = tid >> 6, vv = lane & 7, kq = lane >> 3;
    const float* DQ = (const float*)(a.ws + WS_MIX + MX_DQ); const float* DK = (const float*)(a.ws + WS_MIX + MX_DK); const float* DV = (const float*)(a.ws + WS_MIX + MX_DV);
    const float* DG = (const float*)(a.ws + WS_MIX + MX_DG);
    float* DO = (float*)(a.ws + WS_MIX + (dir ? MX_DOB : MX_DOF));
    LAS float* sq = (LAS float*)lds;
    LAS float* sk = sq + 64 * 64;
    LAS float* sv = sk + 64 * 64;
    LAS float* sg = sv + 64 * 64;
    float S[8];
#pragma unroll
    for (int j = 0; j < 8; ++j) S[j] = 0.f;
    for (int ch = 0; ch < 36; ++ch) {
        { const int tt = tid >> 3, sub = tid & 7, row = scan_row(b, dir, ch * 64 + tt);
          const size_t o = (size_t)row * 256 + h * 64 + sub * 8;
          *(LAS f32x4*)(sq + tt * 64 + sub * 8) = *(const f32x4*)(DQ + o); *(LAS f32x4*)(sq + tt * 64 + sub * 8 + 4) = *(const f32x4*)(DQ + o + 4);
          *(LAS f32x4*)(sk + tt * 64 + sub * 8) = *(const f32x4*)(DK + o); *(LAS f32x4*)(sk + tt * 64 + sub * 8 + 4) = *(const f32x4*)(DK + o + 4);
          *(LAS f32x4*)(sv + tt * 64 + sub * 8) = *(const f32x4*)(DV + o); *(LAS f32x4*)(sv + tt * 64 + sub * 8 + 4) = *(const f32x4*)(DV + o + 4);
          if (sub == 0) { const f32x4 g4 = *(const f32x4*)(DG + (size_t)row * 16 + h * 4); *(LAS f32x2*)(sg + tt * 2) = dir ? (f32x2){g4[2], g4[3]} : (f32x2){g4[0], g4[1]}; } }
        __syncthreads();
#pragma unroll 2
        for (int tt = 0; tt < 64; ++tt) {
            const f32x4 ka = *(const LAS f32x4*)(sk + tt * 64 + kq * 8), kb = *(const LAS f32x4*)(sk + tt * 64 + kq * 8 + 4);
            const f32x4 qa = *(const LAS f32x4*)(sq + tt * 64 + kq * 8), qb = *(const LAS f32x4*)(sq + tt * 64 + kq * 8 + 4);
            const float v = sv[tt * 64 + w * 8 + vv]; const f32x2 g2 = *(const LAS f32x2*)(sg + tt * 2);
            const float beta = g2.x, eg = g2.y;
            float ks = (ka[0] * S[0] + ka[1] * S[1]) + (ka[2] * S[2] + ka[3] * S[3]) + ((kb[0] * S[4] + kb[1] * S[5]) + (kb[2] * S[6] + kb[3] * S[7]));
            ks += __shfl_xor(ks, 8); ks += __shfl_xor(ks, 16); ks += __shfl_xor(ks, 32);
            const float wv = beta * (v - eg * ks);
            float o = 0.f;
#pragma unroll
            for (int j = 0; j < 4; ++j) { S[j] = eg * S[j] + ka[j] * wv; o += qa[j] * S[j]; }
#pragma unroll
            for (int j = 0; j < 4; ++j) { S[4 + j] = eg * S[4 + j] + kb[j] * wv; o += qb[j] * S[4 + j]; }
            o += __shfl_xor(o, 8); o += __shfl_xor(o, 16); o += __shfl_xor(o, 32);
            if (kq == 0) DO[(size_t)scan_row(b, dir, ch * 64 + tt) * 256 + h * 64 + w * 8 + vv] = o;
        }
        __syncthreads();
    }
}
typedef unsigned u32x4a __attribute__((ext_vector_type(4)));
__device__ __forceinline__ bf16x8 frag2(u32x2 lo, u32x2 hi) { return __builtin_bit_cast(bf16x8, (u32x4){lo.x, lo.y, hi.x, hi.y}); }
__device__ __forceinline__ u32x2 cvt4(f32x4 v) { return (u32x2){pk2(v[0], v[1]), pk2(v[2], v[3])}; }

struct GdnIn { f32x2 g2; bf16x8 ak[2], aq[2], bk[2][2]; float kt8[8]; };
struct GdnIn2 { f32x4 R[4], Qv[4]; };
__device__ __forceinline__ void gdn_fetch(CArgs& a, int u, int w, int lane, GdnIn& in) {
    const int chain = u / 36, n = u % 36, b = chain >> 3, h = (chain >> 1) & 3, dir = chain & 1;
    const int r0 = scan_row(b, dir, n * 64), step = dir ? -1 : 1, fr = lane & 15, kg = lane >> 4;
    const float* DQ = (const float*)(a.ws + WS_MIX + MX_DQ) + h * 64; const float* DK = (const float*)(a.ws + WS_MIX + MX_DK) + h * 64; const float* DV = (const float*)(a.ws + WS_MIX + MX_DV) + h * 64;
    const float* DG = (const float*)(a.ws + WS_MIX + MX_DG);
    const bf16* KB = (const bf16*)(a.ws + WS_CKD + CD_KB) + (ptrdiff_t)r0 * 256 + h * 64; const bf16* QB = (const bf16*)(a.ws + WS_CKD + CD_QB) + (ptrdiff_t)r0 * 256 + h * 64;
    const ptrdiff_t ldt = (ptrdiff_t)step * 256;
    const bool isW = w >= 4; const int c0 = 16 * (w & 3), I1 = w >> 1;
    in.g2 = *(const f32x2*)(DG + (size_t)(r0 + step * lane) * 16 + h * 4 + dir * 2);
#pragma unroll
    for (int s = 0; s < 2; ++s) { in.ak[s] = *(const bf16x8*)(KB + (ptrdiff_t)(16 * I1 + fr) * ldt + 32 * s + 8 * kg); in.aq[s] = *(const bf16x8*)(QB + (ptrdiff_t)(16 * I1 + fr) * ldt + 32 * s + 8 * kg);
#pragma unroll
        for (int jj = 0; jj < 2; ++jj) in.bk[jj][s] = *(const bf16x8*)(KB + (ptrdiff_t)(16 * (2 * (w & 1) + jj) + fr) * ldt + 32 * s + 8 * kg); }
#pragma unroll
    for (int tt = 0; tt < 8; ++tt) in.kt8[tt] = DK[(size_t)(r0 + step * (8 * w + tt)) * 256 + lane];
}
__device__ __forceinline__ void gdn_fetch2(CArgs& a, int u, int w, int lane, GdnIn2& in) {
    const int chain = u / 36, n = u % 36, b = chain >> 3, h = (chain >> 1) & 3, dir = chain & 1;
    const int r0 = scan_row(b, dir, n * 64), step = dir ? -1 : 1, fr = lane & 15, kg = lane >> 4;
    const float* DQ = (const float*)(a.ws + WS_MIX + MX_DQ) + h * 64; const float* DK = (const float*)(a.ws + WS_MIX + MX_DK) + h * 64; const float* DV = (const float*)(a.ws + WS_MIX + MX_DV) + h * 64;
    const bool isW = w >= 4; const int c0 = 16 * (w & 3);
#pragma unroll
    for (int I = 0; I < 4; ++I)
#pragma unroll
        for (int e = 0; e < 4; ++e) { const size_t ro = (size_t)(r0 + step * (16 * I + 4 * kg + e)) * 256 + c0 + fr; in.R[I][e] = isW ? DK[ro] : DV[ro]; in.Qv[I][e] = isW ? DQ[ro] : 0.f; }
}
__device__ __forceinline__ float gdn_s1(const GdnIn& in, LAS unsigned char* ub, LAS unsigned char* dwb, int w, int lane) {
    const int fr = lane & 15, kg = lane >> 4, I1 = w >> 1;
    LAS bf16* AB = (LAS bf16*)ub; LAS bf16* ATT = AB + 4608; LAS bf16* KTT = ATT + 4608; LAS float* GT = (LAS float*)(dwb + 2048);
    float beta = in.g2.x, cum = in.g2.y;
#pragma unroll
    for (int o = 1; o < 64; o <<= 1) { const float t = __shfl_up(cum, o); if (lane >= o) cum += t; }
    const float cl = rdlane_f(cum, 63);
    GT[lane] = beta; GT[64 + lane] = cum; GT[128 + lane] = __expf(cum);
    asm volatile("s_waitcnt lgkmcnt(0)" ::: "memory");
    { const f32x4 ci = *(const LAS f32x4*)(GT + 64 + 16 * I1 + 4 * kg), bi = *(const LAS f32x4*)(GT + 16 * I1 + 4 * kg);
#pragma unroll
      for (int jj = 0; jj < 2; ++jj) { const int J = 2 * (w & 1) + jj;
          f32x4 ck = (f32x4){0.f, 0.f, 0.f, 0.f}, cq = (f32x4){0.f, 0.f, 0.f, 0.f};
#pragma unroll
          for (int s = 0; s < 2; ++s) { ck = __builtin_amdgcn_mfma_f32_16x16x32_bf16(in.ak[s], in.bk[jj][s], ck, 0, 0, 0); cq = __builtin_amdgcn_mfma_f32_16x16x32_bf16(in.aq[s], in.bk[jj][s], cq, 0, 0, 0); }
          const int j = 16 * J + fr; const float cj = GT[64 + j];
#pragma unroll
          for (int e = 0; e < 4; ++e) { const int i = 16 * I1 + 4 * kg + e; const float gm = __expf(fminf(ci[e] - cj, 0.f));
              AB[i * 72 + j] = (bf16)f2bf(j < i ? bi[e] * ck[e] * gm : 0.f); ATT[i * 72 + j] = (bf16)f2bf(j <= i ? cq[e] * gm : 0.f); } } }
    { const f32x4 c8a = *(const LAS f32x4*)(GT + 64 + 8 * w), c8b = *(const LAS f32x4*)(GT + 64 + 8 * w + 4);
#pragma unroll
      for (int tt = 0; tt < 8; ++tt) KTT[lane * 72 + 8 * w + tt] = (bf16)f2bf(in.kt8[tt] * __expf(cl - (tt < 4 ? c8a[tt & 3] : c8b[tt & 3]))); }
    asm volatile("s_waitcnt lgkmcnt(0)" ::: "memory");
    return cl;
}
__device__ __forceinline__ void gdn_s23(CArgs& a, int u, const GdnIn2& in, LAS unsigned char* ub, LAS unsigned char* dwb, int w, int lane, float cl) {
    const int fr = lane & 15, kg = lane >> 4;
    bf16* Mo = (bf16*)(a.ws + WS_CKD + CD_M) + (size_t)u * 4096; bf16* Eo = (bf16*)(a.ws + WS_CKD + CD_E) + (size_t)u * 4096;
    float* BTo = (float*)(a.ws + WS_CKD + CD_BT) + (size_t)u * 4096; bf16* FTo = (bf16*)(a.ws + WS_CKD + CD_FT) + (size_t)u * 4096;
    LAS bf16* AB = (LAS bf16*)ub; LAS bf16* ATT = AB + 4608; LAS bf16* KTT = ATT + 4608; LAS bf16* DW = (LAS bf16*)dwb; LAS float* GT = (LAS float*)(dwb + 2048);
    const bool isW = w >= 4; const int c0 = 16 * (w & 3);
    { const int blk = lane >> 4, c = lane & 15; float T[16];
#pragma unroll
      for (int hb = 0; hb < 4; ++hb) {
          u32x4 arow[4][2];
#pragma unroll
          for (int rr = 0; rr < 4; ++rr) { const int r = 4 * hb + rr; arow[rr][0] = *(const LAS u32x4*)(AB + (16 * blk + r) * 72 + 16 * blk); if (hb >= 2) arow[rr][1] = *(const LAS u32x4*)(AB + (16 * blk + r) * 72 + 16 * blk + 8); }
          asm volatile("s_waitcnt lgkmcnt(0)" ::: "memory");
#pragma unroll
          for (int rr = 0; rr < 4; ++rr) { const int r = 4 * hb + rr; float t = (r == c) ? 1.f : 0.f;
              float t2 = 0.f;
#pragma unroll
              for (int j = 0; j < r; ++j) { const unsigned wv = arow[rr][j >> 3][(j >> 1) & 3]; const float av = (j & 1) ? hi_bf(wv) : lo_bf(wv); if (j & 1) t2 -= av * T[j]; else t -= av * T[j]; }
              t += t2;
              T[r] = t; DW[(blk * 16 + r) * 16 + c] = (bf16)f2bf(t); } } }
    asm volatile("s_waitcnt lgkmcnt(0)" ::: "memory");
    f32x4 X[4];
#pragma unroll
    for (int I = 0; I < 4; ++I) {
        const f32x4 br = *(const LAS f32x4*)(GT + 16 * I + 4 * kg), er = *(const LAS f32x4*)(GT + 128 + 16 * I + 4 * kg);
        f32x4 acc = isW ? br * er * in.R[I] : br * in.R[I];
#pragma unroll
        for (int P = 0; 2 * P < I; ++P) {
            const u32x2 alo = *(const LAS u32x2*)(AB + (16 * I + fr) * 72 + 32 * P + 4 * kg);
            const u32x2 ahi = (2 * P + 1 < I) ? *(const LAS u32x2*)(AB + (16 * I + fr) * 72 + 32 * P + 16 + 4 * kg) : (u32x2){0u, 0u};
            const u32x2 xlo = cvt4(-X[2 * P]); const u32x2 xhi = (2 * P + 1 < I) ? cvt4(-X[2 * P + 1]) : (u32x2){0u, 0u};
            acc = __builtin_amdgcn_mfma_f32_16x16x32_bf16(frag2(alo, ahi), frag2(xlo, xhi), acc, 0, 0, 0); }
        const u32x2 dlo = *(const LAS u32x2*)(DW + (I * 16 + fr) * 16 + 4 * kg);
        X[I] = __builtin_amdgcn_mfma_f32_16x16x32_bf16(frag2(dlo, (u32x2){0u, 0u}), frag2(cvt4(acc), (u32x2){0u, 0u}), (f32x4){0.f, 0.f, 0.f, 0.f}, 0, 0, 0);
    }
    const bf16x8 Xb01 = frag2(cvt4(X[0]), cvt4(X[1])), Xb23 = frag2(cvt4(X[2]), cvt4(X[3]));
    const float ecl = __expf(cl);
    bf16* ftp = FTo + (c0 + fr) * 64 + 4 * kg; float* btp = BTo + (c0 + fr) * 64 + 4 * kg; bf16* ep = Eo + (4 * kg) * 64 + c0 + fr; bf16* mp = Mo + (4 * kg) * 64 + c0 + fr;
#pragma unroll
    for (int t4 = 0; t4 < 4; ++t4) {
        const LAS bf16* ar = ATT + (16 * t4 + fr) * 72 + 4 * kg; const LAS bf16* kr = KTT + (16 * t4 + fr) * 72 + 4 * kg;
        f32x4 pa = (f32x4){0.f, 0.f, 0.f, 0.f}, pk = (f32x4){0.f, 0.f, 0.f, 0.f};
        pa = __builtin_amdgcn_mfma_f32_16x16x32_bf16(frag2(*(const LAS u32x2*)ar, *(const LAS u32x2*)(ar + 16)), Xb01, pa, 0, 0, 0);
        pa = __builtin_amdgcn_mfma_f32_16x16x32_bf16(frag2(*(const LAS u32x2*)(ar + 32), *(const LAS u32x2*)(ar + 48)), Xb23, pa, 0, 0, 0);
        pk = __builtin_amdgcn_mfma_f32_16x16x32_bf16(frag2(*(const LAS u32x2*)kr, *(const LAS u32x2*)(kr + 16)), Xb01, pk, 0, 0, 0);
        pk = __builtin_amdgcn_mfma_f32_16x16x32_bf16(frag2(*(const LAS u32x2*)(kr + 32), *(const LAS u32x2*)(kr + 48)), Xb23, pk, 0, 0, 0);
        if (!isW) {
            *(u32x2*)(ftp + 16 * t4) = cvt4(pa);
            *(f32x4*)(btp + 16 * t4) = pk;
        } else {
            const f32x4 ec = *(const LAS f32x4*)(GT + 128 + 16 * t4 + 4 * kg);
#pragma unroll
            for (int e = 0; e < 4; ++e) { const int row = 16 * t4 + 4 * kg + e, col = c0 + fr;
                ep[(16 * t4 + e) * 64] = (bf16)f2bf(ec[e] * in.Qv[t4][e] - pa[e]);
                mp[(16 * t4 + e) * 64] = (bf16)f2bf((row == col ? ecl : 0.f) - pk[e]); }
        }
    }
}
__device__ __forceinline__ void gdn_chain_units(CArgs& a, int chain, LAS unsigned char* lds, int w, int lane, unsigned long long& tacc) {
    asm volatile("" : "+v"(lane));
    LAS unsigned char* dwb = lds + 55296 + w * 3072;
    GdnIn A, B; GdnIn2 C;
    gdn_fetch(a, chain * 36, w, lane, A);
#pragma unroll 1
    for (int n = 0; n < 36; n += 2) {
        asm volatile("" : "+v"(lane));
        { unsigned long long tq = 0ull; if (PROBE_PH >= 60 && PROBE_PH <= 62) tq = __builtin_amdgcn_s_memrealtime();
          gdn_fetch2(a, chain * 36 + n, w, lane, C); const float cl = gdn_s1(A, lds, dwb, w, lane);
          if (PROBE_PH == 60) tacc += __builtin_amdgcn_s_memrealtime() - tq; if (PROBE_PH == 61) tq = __builtin_amdgcn_s_memrealtime();
          __syncthreads();
          if (PROBE_PH == 61) tacc += __builtin_amdgcn_s_memrealtime() - tq; if (PROBE_PH >= 62 && PROBE_PH <= 64) tq = __builtin_amdgcn_s_memrealtime();
          gdn_fetch(a, chain * 36 + n + 1, w, lane, B); gdn_s23(a, chain * 36 + n, C, lds, dwb, w, lane, cl);
          if (PROBE_PH == 62 || (PROBE_PH == 63 && w < 4) || (PROBE_PH == 64 && w >= 4)) tacc += __builtin_amdgcn_s_memrealtime() - tq; }
        asm volatile("" : "+v"(lane));
        { gdn_fetch2(a, chain * 36 + n + 1, w, lane, C); const float cl = gdn_s1(B, lds + 27648, dwb, w, lane); __syncthreads(); if (n + 2 < 36) gdn_fetch(a, chain * 36 + n + 2, w, lane, A); gdn_s23(a, chain * 36 + n + 1, C, lds + 27648, dwb, w, lane, cl); }
    }
}
__device__ __forceinline__ void gdn_seq_wave(CArgs& a, int chain, int vs, int lane) {
    asm volatile("" : "+v"(lane));
    const int b = chain >> 3, h = (chain >> 1) & 3, dir = chain & 1, fr = lane & 15, kg = lane >> 4, v = 16 * vs + fr, step = dir ? -1 : 1;
    float* DO = (float*)(a.ws + WS_MIX + (dir ? MX_DOB : MX_DOF));
    f32x4 S[4];
#pragma unroll
    for (int i = 0; i < 4; ++i) S[i] = (f32x4){0.f, 0.f, 0.f, 0.f};
#pragma unroll 1
    for (int n = 0; n < 36; ++n) {
        const int u = chain * 36 + n, r0 = scan_row(b, dir, n * 64);
        const bf16* Mo = (const bf16*)(a.ws + WS_CKD + CD_M) + (size_t)u * 4096; const bf16* Eo = (const bf16*)(a.ws + WS_CKD + CD_E) + (size_t)u * 4096;
        const float* BTo = (const float*)(a.ws + WS_CKD + CD_BT) + (size_t)u * 4096; const bf16* FTo = (const bf16*)(a.ws + WS_CKD + CD_FT) + (size_t)u * 4096;
        u32x2 ef[4][2][2], mf[4][2][2], ff[4]; f32x4 bi[4];
#pragma unroll
        for (int t = 0; t < 4; ++t) { ff[t] = *(const u32x2*)(FTo + v * 64 + 16 * t + 4 * kg); bi[t] = *(const f32x4*)(BTo + v * 64 + 16 * t + 4 * kg);
#pragma unroll
            for (int s = 0; s < 2; ++s) { const bf16* er = Eo + (16 * t + fr) * 64 + 32 * s + 4 * kg; ef[t][s][0] = *(const u32x2*)er; ef[t][s][1] = *(const u32x2*)(er + 16);
                const bf16* mr = Mo + (16 * t + fr) * 64 + 32 * s + 4 * kg; mf[t][s][0] = *(const u32x2*)mr; mf[t][s][1] = *(const u32x2*)(mr + 16); } }
        bf16x8 Sb[2];
#pragma unroll
        for (int s = 0; s < 2; ++s) Sb[s] = frag2(cvt4(S[2 * s]), cvt4(S[2 * s + 1]));
        f32x4 o[4];
#pragma unroll
        for (int t = 0; t < 4; ++t) { o[t] = (f32x4){lo_bf(ff[t].x), hi_bf(ff[t].x), lo_bf(ff[t].y), hi_bf(ff[t].y)};
#pragma unroll
            for (int s = 0; s < 2; ++s) o[t] = __builtin_amdgcn_mfma_f32_16x16x32_bf16(frag2(ef[t][s][0], ef[t][s][1]), Sb[s], o[t], 0, 0, 0);
            f32x4 sn = bi[t];
#pragma unroll
            for (int s = 0; s < 2; ++s) sn = __builtin_amdgcn_mfma_f32_16x16x32_bf16(frag2(mf[t][s][0], mf[t][s][1]), Sb[s], sn, 0, 0, 0);
            S[t] = sn; }
#pragma unroll
        for (int t = 0; t < 4; ++t)
#pragma unroll
            for (int e = 0; e < 4; ++e) DO[(size_t)(r0 + step * (16 * t + 4 * kg + e)) * 256 + h * 64 + v] = o[t][e];
    }
}

__device__ __forceinline__ void gdn_seq_block(CArgs& a, int chain, LAS unsigned char* lds, int w, int lane) {
    asm volatile("" : "+v"(lane));
    const int b = chain >> 3, h = (chain >> 1) & 3, dir = chain & 1, fr = lane & 15, kg = lane >> 4, step = dir ? -1 : 1;
    constexpr int SLOT = 45056;
    if (w >= 4) {
        const int q = w - 4;
        u32x4 rg[10];
#define SEQ_LD(n_) do { const int u_ = chain * 36 + (n_); \
        _Pragma("unroll") for (int j = 0; j < 10; ++j) { const int c_ = q + 4 * j; \
            const unsigned char* g_ = c_ < 8 ? a.ws + WS_CKD + CD_M + (size_t)u_ * 8192 + c_ * 1024 : (c_ < 16 ? a.ws + WS_CKD + CD_E + (size_t)u_ * 8192 + (c_ - 8) * 1024 : \
                (c_ < 32 ? a.ws + WS_CKD + CD_BT + (size_t)u_ * 16384 + (c_ - 16) * 1024 : a.ws + WS_CKD + CD_FT + (size_t)u_ * 8192 + (c_ - 32) * 1024)); \
            rg[j] = *(const u32x4*)(g_ + lane * 16); } } while (0)
#define SEQ_ST(n_) do { LAS unsigned char* s_ = lds + ((n_) % 3) * SLOT; \
        _Pragma("unroll") for (int j = 0; j < 10; ++j) { const int c_ = q + 4 * j; \
            const int off_ = c_ < 8 ? (c_ * 8 + (lane >> 3)) * 144 + (lane & 7) * 16 : (c_ < 16 ? 9216 + ((c_ - 8) * 8 + (lane >> 3)) * 144 + (lane & 7) * 16 : \
                (c_ < 32 ? 18432 + ((c_ - 16) * 4 + (lane >> 4)) * 272 + (lane & 15) * 16 : 35840 + ((c_ - 32) * 8 + (lane >> 3)) * 144 + (lane & 7) * 16)); \
            *(LAS u32x4*)(s_ + off_) = rg[j]; } } while (0)
        SEQ_LD(0); SEQ_ST(0); SEQ_LD(1); SEQ_ST(1); SEQ_LD(2);
        asm volatile("s_waitcnt lgkmcnt(0)" ::: "memory");
        __syncthreads();
#pragma unroll 1
        for (int n = 0; n < 36; ++n) {
            if (n + 2 < 36) { SEQ_ST(n + 2); }
            if (n + 3 < 36) { SEQ_LD(n + 3); }
            asm volatile("s_waitcnt lgkmcnt(0)" ::: "memory");
            __syncthreads();
        }
#undef SEQ_LD
#undef SEQ_ST
    } else {
        const int v = 16 * w + fr;
        float* DO = (float*)(a.ws + WS_MIX + (dir ? MX_DOB : MX_DOF));
        f32x4 S[4];
#pragma unroll
        for (int i = 0; i < 4; ++i) S[i] = (f32x4){0.f, 0.f, 0.f, 0.f};
        __syncthreads();
#pragma unroll 1
        for (int n = 0; n < 36; ++n) {
            const LAS unsigned char* sl = lds + (n % 3) * SLOT; const int r0 = scan_row(b, dir, n * 64);
            bf16x8 Sb[2];
#pragma unroll
            for (int s = 0; s < 2; ++s) Sb[s] = frag2(cvt4(S[2 * s]), cvt4(S[2 * s + 1]));
            f32x4 o[4];
#pragma unroll
            for (int t = 0; t < 4; ++t) {
                const u32x2 ff = *(const LAS u32x2*)(sl + 35840 + v * 144 + (16 * t + 4 * kg) * 2);
                o[t] = (f32x4){lo_bf(ff.x), hi_bf(ff.x), lo_bf(ff.y), hi_bf(ff.y)};
                f32x4 sn = *(const LAS f32x4*)(sl + 18432 + v * 272 + (16 * t + 4 * kg) * 4);
#pragma unroll
                for (int s = 0; s < 2; ++s) { const LAS unsigned char* er = sl + 9216 + (16 * t + fr) * 144 + (32 * s + 4 * kg) * 2; const LAS unsigned char* mr = sl + (16 * t + fr) * 144 + (32 * s + 4 * kg) * 2;
                    o[t] = __builtin_amdgcn_mfma_f32_16x16x32_bf16(frag2(*(const LAS u32x2*)er, *(const LAS u32x2*)(er + 32)), Sb[s], o[t], 0, 0, 0);
                    sn = __builtin_amdgcn_mfma_f32_16x16x32_bf16(frag2(*(const LAS u32x2*)mr, *(const LAS u32x2*)(mr + 32)), Sb[s], sn, 0, 0, 0); }
                S[t] = sn; }
            { float* dp = DO + (ptrdiff_t)(r0 + step * 4 * kg) * 256 + h * 64 + v; const ptrdiff_t sd = (ptrdiff_t)step * 256;
#pragma unroll
              for (int t = 0; t < 4; ++t)
#pragma unroll
                  for (int e = 0; e < 4; ++e) dp[(16 * t + e) * sd] = o[t][e]; }
            __syncthreads();
        }
    }
}
__device__ __forceinline__ void gla_seq_block(CArgs& a, int chain, LAS unsigned char* lds, int w, int lane) {
    asm volatile("" : "+v"(lane));
    const int b = chain >> 3, h = (chain >> 1) & 3, dir = chain & 1, fr = lane & 15, kg = lane >> 4, step = dir ? -1 : 1;
    constexpr int SLOT = 23680;
    if (w >= 4) {
        const int q = w - 4;
        u32x4 rg[5]; float dl = 0.f;
#define SEQ_LD(n_) do { const int u_ = chain * 36 + (n_); \
        _Pragma("unroll") for (int j = 0; j < 5; ++j) { const int c_ = q + 4 * j; \
            const unsigned char* g_ = c_ < 4 ? a.ws + WS_CKA + CA_QC + (size_t)u_ * 4096 + c_ * 1024 : (c_ < 12 ? a.ws + WS_CKA + CA_FT + (size_t)u_ * 8192 + (c_ - 4) * 1024 : a.ws + WS_CKA + CA_UT + (size_t)u_ * 8192 + (c_ - 12) * 1024); \
            rg[j] = *(const u32x4*)(g_ + lane * 16); } \
        if (q == 0) dl = ((const float*)(a.ws + WS_CKA + CA_DL))[(size_t)u_ * 32 + (lane & 31)]; } while (0)
#define SEQ_ST(n_) do { LAS unsigned char* s_ = lds + ((n_) % 3) * SLOT; \
        _Pragma("unroll") for (int j = 0; j < 5; ++j) { const int c_ = q + 4 * j; \
            const int off_ = c_ < 4 ? (c_ * 16 + (lane >> 2)) * 80 + (lane & 3) * 16 : (c_ < 12 ? 5120 + ((c_ - 4) * 8 + (lane >> 3)) * 144 + (lane & 7) * 16 : 14336 + ((c_ - 12) * 8 + (lane >> 3)) * 144 + (lane & 7) * 16); \
            *(LAS u32x4*)(s_ + off_) = rg[j]; } \
        if (q == 0 && lane < 32) *(LAS float*)(s_ + 23552 + lane * 4) = dl; } while (0)
        SEQ_LD(0); SEQ_ST(0); SEQ_LD(1); SEQ_ST(1); SEQ_LD(2);
        asm volatile("s_waitcnt lgkmcnt(0)" ::: "memory");
        __syncthreads();
#pragma unroll 1
        for (int n = 0; n < 36; ++n) {
            if (n + 2 < 36) { SEQ_ST(n + 2); }
            if (n + 3 < 36) { SEQ_LD(n + 3); }
            asm volatile("s_waitcnt lgkmcnt(0)" ::: "memory");
            __syncthreads();
        }
#undef SEQ_LD
#undef SEQ_ST
    } else {
        const int v = 16 * w + fr;
        float* GO = (float*)(a.ws + WS_MIX + (dir ? MX_GOB : MX_GOF));
        f32x4 S[2] = {(f32x4){0.f, 0.f, 0.f, 0.f}, (f32x4){0.f, 0.f, 0.f, 0.f}};
        __syncthreads();
#pragma unroll 1
        for (int n = 0; n < 36; ++n) {
            const LAS unsigned char* sl = lds + (n % 3) * SLOT; const int r0 = scan_row(b, dir, n * 64);
            const bf16x8 Sb = frag2(cvt4(S[0]), cvt4(S[1]));
            f32x4 o[4];
#pragma unroll
            for (int t = 0; t < 4; ++t) { const u32x2 ff = *(const LAS u32x2*)(sl + 5120 + v * 144 + (16 * t + 4 * kg) * 2);
                o[t] = (f32x4){lo_bf(ff.x), hi_bf(ff.x), lo_bf(ff.y), hi_bf(ff.y)};
                const LAS unsigned char* qr = sl + (16 * t + fr) * 80 + 4 * kg * 2;
                o[t] = __builtin_amdgcn_mfma_f32_16x16x32_bf16(frag2(*(const LAS u32x2*)qr, *(const LAS u32x2*)(qr + 32)), Sb, o[t], 0, 0, 0); }
#pragma unroll
            for (int kt = 0; kt < 2; ++kt) { const f32x4 d4 = *(const LAS f32x4*)(sl + 23552 + (16 * kt + 4 * kg) * 4), u4 = *(const LAS f32x4*)(sl + 14336 + v * 144 + (16 * kt + 4 * kg) * 4); S[kt] = d4 * S[kt] + u4; }
            { float* gp = GO + (ptrdiff_t)(r0 + step * 4 * kg) * 256 + h * 64 + v; const ptrdiff_t sd = (ptrdiff_t)step * 256;
#pragma unroll
              for (int t = 0; t < 4; ++t)
#pragma unroll
                  for (int e = 0; e < 4; ++e) gp[(16 * t + e) * sd] = o[t][e]; }
            __syncthreads();
        }
    }
}

struct GlaIn { float bc[32]; unsigned px[32]; };
__device__ __forceinline__ void gla_fetch(CArgs& a, int u, int w, int lane, GlaIn& in) {
    const int chain = u / 36, n = u % 36, b = chain >> 3, h = (chain >> 1) & 3, dir = chain & 1;
    const int r0 = scan_row(b, dir, n * 64), step = dir ? -1 : 1;
    const bf16* P = (const bf16*)(a.ws + WS_P);
    const float* GD = (const float*)(a.ws + WS_MIX + (dir ? MX_GDB : MX_GDF));
    if (w < 4) { const int k = lane & 31, half = lane >> 5; const int src_off = (w == 0 || w == 2) ? 0 : 128;
#pragma unroll
        for (int i = 0; i < 32; ++i) { in.bc[i] = GD[(size_t)(r0 + step * (32 * half + i)) * 128 + h * 32 + k]; in.px[i] = P[(size_t)(r0 + step * (32 * half + i)) * D_INP + GLA0 + src_off + h * 32 + k]; }
    } else { const int vv = 16 * (w - 4) + (lane & 15), tq = lane >> 4;
#pragma unroll
        for (int i = 0; i < 16; ++i) in.px[i] = P[(size_t)(r0 + step * (16 * tq + i)) * D_INP + GLA0 + 256 + h * 64 + vv];
#pragma unroll
        for (int i = 16; i < 32; ++i) in.px[i] = 0u;
#pragma unroll
        for (int i = 0; i < 32; ++i) in.bc[i] = 0.f;
    }
}
__device__ __forceinline__ void gla_s1(CArgs& a, int u, GlaIn& in, LAS unsigned char* ub, int w, int lane) {
    bf16* QC = (bf16*)(a.ws + WS_CKA + CA_QC) + (size_t)u * 2048; float* DL = (float*)(a.ws + WS_CKA + CA_DL) + (size_t)u * 32;
    LAS bf16* QE = (LAS bf16*)ub; LAS bf16* KE = QE + 2560; LAS bf16* KTT = KE + 2560; LAS bf16* VT = KTT + 2304;
    if (w < 4) {
        const int k = lane & 31, half = lane >> 5;
        float run = 0.f;
#pragma unroll
        for (int i = 0; i < 32; ++i) { run += in.bc[i]; in.bc[i] = run; }
        const float tot0 = __shfl(run, k), tot1 = __shfl(run, 32 + k);
        const float bref = tot0, blast = tot0 + tot1, off = half ? tot0 : 0.f;
        const float sc = (w == 0 || w == 2) ? 0.17677669529663687f : 1.f;
#pragma unroll
        for (int i = 0; i < 32; ++i) { const int t = 32 * half + i; const float bi = in.bc[i] + off;
            const float x = bf2f(in.px[i]) * sc;
            const float ex = w == 0 ? bi - bref : (w == 1 ? bref - bi : (w == 2 ? bi : blast - bi));
            const bf16 y = (bf16)f2bf(x * __expf(ex));
            if (w == 0) QE[t * 40 + k] = y; else if (w == 1) KE[t * 40 + k] = y; else if (w == 2) QC[t * 32 + k] = y; else KTT[k * 72 + t] = y; }
        if (w == 2 && half == 0) DL[k] = __expf(blast);
    } else {
        const int vv = 16 * (w - 4) + (lane & 15), tq = lane >> 4;
#pragma unroll
        for (int i = 0; i < 16; ++i) VT[vv * 72 + 16 * tq + i] = in.px[i];
    }
    asm volatile("s_waitcnt lgkmcnt(0)" ::: "memory");
}
__device__ __forceinline__ void gla_s2(CArgs& a, int u, LAS unsigned char* ub, int w, int lane) {
    const int fr = lane & 15, kg = lane >> 4;
    bf16* FT = (bf16*)(a.ws + WS_CKA + CA_FT) + (size_t)u * 4096; float* UT = (float*)(a.ws + WS_CKA + CA_UT) + (size_t)u * 2048;
    LAS bf16* QE = (LAS bf16*)ub; LAS bf16* KE = QE + 2560; LAS bf16* KTT = KE + 2560; LAS bf16* VT = KTT + 2304;
    const int It = w & 3, vh = w >> 2;
    const bf16x8 qf = *(const LAS bf16x8*)(QE + (16 * It + fr) * 40 + 8 * kg);
    f32x4 st[4];
#pragma unroll
    for (int Jt = 0; Jt < 4; ++Jt) { const bf16x8 kf = *(const LAS bf16x8*)(KE + (16 * Jt + fr) * 40 + 8 * kg);
        st[Jt] = __builtin_amdgcn_mfma_f32_16x16x32_bf16(kf, qf, (f32x4){0.f, 0.f, 0.f, 0.f}, 0, 0, 0);
#pragma unroll
        for (int e = 0; e < 4; ++e) st[Jt][e] = (16 * Jt + 4 * kg + e <= 16 * It + fr) ? st[Jt][e] : 0.f; }
    const bf16x8 Sb01 = frag2(cvt4(st[0]), cvt4(st[1])), Sb23 = frag2(cvt4(st[2]), cvt4(st[3]));
    bf16* ftp = FT + (4 * kg) * 64 + 16 * It + fr;
#pragma unroll
    for (int vv = 0; vv < 2; ++vv) { const int Vt = 2 * vh + vv; const LAS bf16* vr = VT + (16 * Vt + fr) * 72 + 4 * kg;
        f32x4 f = (f32x4){0.f, 0.f, 0.f, 0.f};
        f = __builtin_amdgcn_mfma_f32_16x16x32_bf16(frag2(*(const LAS u32x2*)vr, *(const LAS u32x2*)(vr + 16)), Sb01, f, 0, 0, 0);
        f = __builtin_amdgcn_mfma_f32_16x16x32_bf16(frag2(*(const LAS u32x2*)(vr + 32), *(const LAS u32x2*)(vr + 48)), Sb23, f, 0, 0, 0);
#pragma unroll
        for (int e = 0; e < 4; ++e) ftp[(16 * Vt + e) * 64] = (bf16)f2bf(f[e]); }
    const int kt = w & 1, Vu = w >> 1;
    f32x4 uu = (f32x4){0.f, 0.f, 0.f, 0.f};
#pragma unroll
    for (int s = 0; s < 2; ++s) uu = __builtin_amdgcn_mfma_f32_16x16x32_bf16(*(const LAS bf16x8*)(KTT + (16 * kt + fr) * 72 + 32 * s + 8 * kg), *(const LAS bf16x8*)(VT + (16 * Vu + fr) * 72 + 32 * s + 8 * kg), uu, 0, 0, 0);
    *(f32x4*)(UT + (16 * Vu + fr) * 32 + 16 * kt + 4 * kg) = uu;
}
__device__ __forceinline__ void gla_chain_units(CArgs& a, int chain, LAS unsigned char* lds, int w, int lane) {
    GlaIn A, B;
    asm volatile("" : "+v"(lane));
    gla_fetch(a, chain * 36, w, lane, A);
#pragma unroll 1
    for (int n = 0; n < 36; n += 2) {
        asm volatile("" : "+v"(lane));
        { gla_s1(a, chain * 36 + n, A, lds, w, lane); __syncthreads(); gla_fetch(a, chain * 36 + n + 1, w, lane, B); gla_s2(a, chain * 36 + n, lds, w, lane); }
        asm volatile("" : "+v"(lane));
        { gla_s1(a, chain * 36 + n + 1, B, lds + 24064, w, lane); __syncthreads(); if (n + 2 < 36) gla_fetch(a, chain * 36 + n + 2, w, lane, A); gla_s2(a, chain * 36 + n + 1, lds + 24064, w, lane); }
    }
}
__device__ __forceinline__ void gla_seq_wave(CArgs& a, int chain, int vs, int lane) {
    asm volatile("" : "+v"(lane));
    const int b = chain >> 3, h = (chain >> 1) & 3, dir = chain & 1, fr = lane & 15, kg = lane >> 4, v = 16 * vs + fr, step = dir ? -1 : 1;
    float* GO = (float*)(a.ws + WS_MIX + (dir ? MX_GOB : MX_GOF));
    f32x4 S[2] = {(f32x4){0.f, 0.f, 0.f, 0.f}, (f32x4){0.f, 0.f, 0.f, 0.f}};
#pragma unroll 1
    for (int n = 0; n < 36; ++n) {
        const int u = chain * 36 + n, r0 = scan_row(b, dir, n * 64);
        const bf16* QC = (const bf16*)(a.ws + WS_CKA + CA_QC) + (size_t)u * 2048; const bf16* FT = (const bf16*)(a.ws + WS_CKA + CA_FT) + (size_t)u * 4096;
        const float* UT = (const float*)(a.ws + WS_CKA + CA_UT) + (size_t)u * 2048; const float* DL = (const float*)(a.ws + WS_CKA + CA_DL) + (size_t)u * 32;
        u32x2 qf[4][2], ff[4]; f32x4 d4[2], u4[2];
#pragma unroll
        for (int t = 0; t < 4; ++t) { const bf16* qr = QC + (16 * t + fr) * 32; qf[t][0] = *(const u32x2*)(qr + 4 * kg); qf[t][1] = *(const u32x2*)(qr + 16 + 4 * kg); ff[t] = *(const u32x2*)(FT + v * 64 + 16 * t + 4 * kg); }
#pragma unroll
        for (int kt = 0; kt < 2; ++kt) { d4[kt] = *(const f32x4*)(DL + 16 * kt + 4 * kg); u4[kt] = *(const f32x4*)(UT + v * 32 + 16 * kt + 4 * kg); }
        const bf16x8 Sb = frag2(cvt4(S[0]), cvt4(S[1]));
        f32x4 o[4];
#pragma unroll
        for (int t = 0; t < 4; ++t) { o[t] = (f32x4){lo_bf(ff[t].x), hi_bf(ff[t].x), lo_bf(ff[t].y), hi_bf(ff[t].y)};
            o[t] = __builtin_amdgcn_mfma_f32_16x16x32_bf16(frag2(qf[t][0], qf[t][1]), Sb, o[t], 0, 0, 0); }
#pragma unroll
        for (int kt = 0; kt < 2; ++kt) S[kt] = d4[kt] * S[kt] + u4[kt];
#pragma unroll
        for (int t = 0; t < 4; ++t)
#pragma unroll
            for (int e = 0; e < 4; ++e) GO[(size_t)(r0 + step * (16 * t + 4 * kg + e)) * 256 + h * 64 + v] = o[t][e];
    }
}

template <int L>
__device__ __forceinline__ void hyena_unit(CArgs& a, int l, int c, LAS unsigned char* lds) {
    constexpr int Lt = L == SEQ ? 1 : 0, SOFF = L == SEQ ? CTXL : 0, CST = (2 * L + 16) * 2 + 32;
    constexpr int NTW = L / 16 / 8;
    const int tid = tidx(), lane = tid & 63, w = tid >> 6, fr = lane & 15, kg = lane >> 4;
    const float* kf = (const float*)(a.ws + WS_KUN) + ((size_t)((l * 2 + Lt) * 512 + c)) * 2048;
    const float* kb = kf + (size_t)256 * 2048;
    LAS float* red = (LAS float*)(lds + 8 * CST);
    const bf16* Z = (const bf16*)(a.ws + WS_MIX + MX_ZT) + ((size_t)(c * 16 + fr)) * 2304 + SOFF;
    const bf16* zp = Z + 8 * kg;
    bf16x8 zc[8];
#pragma unroll
    for (int ii = 0; ii < 8; ++ii) zc[ii] = *(const bf16x8*)(zp + 32 * ii);
    constexpr int NI = (2 * L + 16 + 511) / 512;
    float gv[NI];
    float s = 0.f;
#pragma unroll
    for (int q = 0; q < NI; ++q) {
        const int idx = tid + 512 * q, ic = min(max(idx, 1), 2 * L - 1);
        const float v = *(ic <= L ? kf + (L - ic) : kb + (ic - L));
        gv[q] = (idx >= 1 && idx < 2 * L) ? v : 0.f;
        s += fabsf(gv[q]);
    }
    s = wave_sum(s);
    if (lane == 0) red[w] = s;
    __syncthreads();
    float l1 = 0.f;
#pragma unroll
    for (int i = 0; i < 8; ++i) l1 += red[i];
    const float inv = 1.f / l1;
#pragma unroll
    for (int q = 0; q < NI; ++q) {
        const int idx = tid + 512 * q;
        const bf16 gb = (bf16)f2bf(gv[q] * inv);
        if (idx < 2 * L + 16) {
#pragma unroll
            for (int r = 0; r < 8; ++r) if (idx - r >= 0) *(LAS bf16*)(lds + r * CST + (idx - r) * 2) = gb;
        }
    }
    __syncthreads();
    float* YT = (float*)(a.ws + WS_MIX + MX_YT) + ((size_t)(c * 16 + fr)) * 2304 + SOFF;
    f32x4 acc[NTW];
#pragma unroll
    for (int j = 0; j < NTW; ++j) acc[j] = (f32x4){0.f, 0.f, 0.f, 0.f};
    const int rr = (8 - (fr & 7)) & 7;
    const LAS unsigned char* ap = lds + rr * CST + (((8 * kg - fr + L) >> 3) - 2 * w * NTW) * 16;
    if constexpr (L == SEQ) {
        static_assert(NTW == 16, "hyena_unit");
        bf16x8 zn[8], A[16];
#pragma unroll
        for (int j = 2; j < 16; ++j) A[j] = *(const LAS bf16x8*)(ap - 32 * j);
#pragma unroll 1
        for (int ib = 0; ib < 8; ++ib) {
            const bf16* zq = zp + 256 * (ib < 7 ? ib + 1 : 7);
#pragma unroll
            for (int ii = 0; ii < 8; ++ii) zn[ii] = *(const bf16x8*)(zq + 32 * ii);
#pragma unroll
            for (int ii = 0; ii < 8; ++ii) {
                A[(16 - 2 * ii) & 15] = *(const LAS bf16x8*)(ap + 64 * ii);
                A[(17 - 2 * ii) & 15] = *(const LAS bf16x8*)(ap + 64 * ii - 32);
#pragma unroll
                for (int jj = 0; jj < 16; ++jj) { const int j = (jj + 2) & 15; acc[j] = __builtin_amdgcn_mfma_f32_16x16x32_bf16(A[(j + 16 - 2 * ii) & 15], zc[ii], acc[j], 0, 0, 0); }
            }
            ap += 512;
#pragma unroll
            for (int ii = 0; ii < 8; ++ii) zc[ii] = zn[ii];
        }
    } else {
        static_assert(L == 256, "hyena_unit");
#pragma unroll
        for (int i = 0; i < 8; ++i)
#pragma unroll
            for (int j = 0; j < NTW; ++j) acc[j] = __builtin_amdgcn_mfma_f32_16x16x32_bf16(*(const LAS bf16x8*)(ap + (4 * i - 2 * j) * 16), zc[i], acc[j], 0, 0, 0);
    }
#pragma unroll
    for (int j = 0; j < NTW; ++j) *(f32x4*)(YT + 16 * (w * NTW + j) + 4 * kg) = acc[j];
    __syncthreads();
}
__device__ __forceinline__ void ph_scan(CArgs& a, int l, LAS unsigned char* lds, int bid, int nblk, unsigned long long& tacc) {
    const int tid = tidx(), lane = tid & 63, w = __builtin_amdgcn_readfirstlane(tid >> 6);
    unsigned long long t0 = 0ull;
    if (PROBE_PH >= 20 && PROBE_PH < 50) t0 = __builtin_amdgcn_s_memrealtime();
#pragma unroll 1
    for (int c = bid; c < 256; c += nblk) {
        if (c < 128) {
            gdn_chain_units(a, c, lds, w, lane, tacc);
        } else {
            gla_chain_units(a, c - 128, lds, w, lane);
        }
        asm volatile("s_waitcnt vmcnt(0)" ::: "memory");
        __syncthreads();
        if (PROBE_PH == 20 && c < 128) tacc += __builtin_amdgcn_s_memrealtime() - t0;
        if (PROBE_PH == 24 && c >= 128) tacc += __builtin_amdgcn_s_memrealtime() - t0;
        if (PROBE_PH == 21) t0 = __builtin_amdgcn_s_memrealtime();
        if (c < 128) gdn_seq_block(a, c, lds, w, lane); else gla_seq_block(a, c - 128, lds, w, lane);
        __syncthreads();
        if (PROBE_PH == 21) tacc += __builtin_amdgcn_s_memrealtime() - t0;
    }
    if (PROBE_PH == 22) t0 = __builtin_amdgcn_s_memrealtime();
    {
        LAS unsigned char* scr = lds + w * 8448;
        if (nblk == 256) { const int per = bid < 128 ? 16 : 32, first = bid < 128 ? (bid * 8 + w) * 16 : 16384 + ((bid - 128) * 8 + w) * 32;
            tr_experts_range(a, l, scr, first, first + per, 1, lane); }
        else tr_experts_range(a, l, scr, bid * 8 + w, NEXP * 3 * 512, nblk * 8, lane);
    }
    if (PROBE_PH == 22) tacc += __builtin_amdgcn_s_memrealtime() - t0;
    __syncthreads();
    if (PROBE_PH == 23) t0 = __builtin_amdgcn_s_memrealtime();
    if (nblk == 256) {
        if (bid < 128) hyena_unit<SEQ>(a, l, bid, lds);
        else { const int g = bid - 128; hyena_unit<SEQ>(a, l, 128 + g, lds); hyena_unit<CTXL>(a, l, 2 * g, lds); hyena_unit<CTXL>(a, l, 2 * g + 1, lds); }
    } else {
        for (int it = bid; it < 512; it += nblk) { if (it < 256) hyena_unit<SEQ>(a, l, it, lds); else hyena_unit<CTXL>(a, l, it - 256, lds); }
    }
    if (PROBE_PH == 23) tacc += __builtin_amdgcn_s_memrealtime() - t0;
}

__device__ __forceinline__ void ph_post_hyena(CArgs& a, int l, LAS unsigned char* lds, int bid, int nblk) {
    const bf16* P = (const bf16*)(a.ws + WS_P);
    const float* YT = (const float*)(a.ws + WS_MIX + MX_YT); bf16* YMIX = (bf16*)(a.ws + WS_YMIX);
    LAS float* yt = (LAS float*)lds;
    const int tid = tidx(), c4 = (tid & 63) * 4, tg = tid >> 6;
    const float* hw = a.in[I_HYCW] + l * 3 * 768; const float* hb = a.in[I_HYCB] + l * 768;
    f32x4 w0[3], wx[3], wv[3];
#pragma unroll
    for (int k = 0; k < 3; ++k) { w0[k] = *(const f32x4*)(hw + k * 768 + c4); wx[k] = *(const f32x4*)(hw + k * 768 + 256 + c4); wv[k] = *(const f32x4*)(hw + k * 768 + 512 + c4); }
    const f32x4 b0 = *(const f32x4*)(hb + c4), bx = *(const f32x4*)(hb + 256 + c4), bv = *(const f32x4*)(hb + 512 + c4), hd = *(const f32x4*)(a.in[I_HYD] + l * 256 + c4);
#pragma unroll 1
    for (int it = bid; it < 576; it += nblk) {
        const Chunk c = chunk_of(it);
        const int soff = c.L == CTXL ? 0 : CTXL;
        { const int ch = tid & 255, half = tid >> 8;
          const float* srcp = YT + ((size_t)(ch * 16 + c.b)) * 2304 + soff + c.t0 + half * 32;
#pragma unroll
          for (int j = 0; j < 8; ++j) { const f32x4 v = *(const f32x4*)(srcp + 4 * j);
              yt[(half * 32 + 4 * j) * 260 + ch] = v[0]; yt[(half * 32 + 4 * j + 1) * 260 + ch] = v[1]; yt[(half * 32 + 4 * j + 2) * 260 + ch] = v[2]; yt[(half * 32 + 4 * j + 3) * 260 + ch] = v[3]; } }
        __syncthreads();
        const int tb = c.t0 + tg * 8;
        const bf16* pb = P + (size_t)(c.row0 + tg * 8) * D_INP;
        f32x4 x0[10], x1[10], vv[10];
#pragma unroll
        for (int r = 0; r < 10; ++r) { const int t = tb + r - 1, tc = min(max(t, c.lo), c.hi - 1); const float ok = (t == tc) ? 1.f : 0.f; const bf16* p = pb + (ptrdiff_t)(tc - tb) * D_INP;
            x0[r] = ok * bf4(*(const u32x2*)(p + HY0 + c4));
            x1[r] = ok * bf4(*(const u32x2*)(p + HY0 + 256 + c4)); vv[r] = ok * bf4(*(const u32x2*)(p + HY0 + 512 + c4)); }
#pragma unroll
        for (int tt = 0; tt < 8; ++tt) {
            const f32x4 u0 = w0[0] * x0[tt] + w0[1] * x0[tt + 1] + w0[2] * x0[tt + 2] + b0;
            const f32x4 xx = wx[0] * x1[tt] + wx[1] * x1[tt + 1] + wx[2] * x1[tt + 2] + bx, v2 = wv[0] * vv[tt] + wv[1] * vv[tt + 1] + wv[2] * vv[tt + 2] + bv, z = xx * v2;
            const f32x4 y = *(const LAS f32x4*)(yt + (tg * 8 + tt) * 260 + c4);
            const f32x4 o = (y + z * hd) * u0;
            u32x2 oo; oo.x = pk2(o[0], o[1]); oo.y = pk2(o[2], o[3]); *(u32x2*)(YMIX + (size_t)(c.row0 + tg * 8 + tt) * D + c4) = oo;
        }
        __syncthreads();
    }
}
__device__ __forceinline__ void ph_post_tok(CArgs& a, int l, int gw, int ngw) {
    const int lane = tidx() & 63;
    const bf16* P = (const bf16*)(a.ws + WS_P); bf16* YMIX = (bf16*)(a.ws + WS_YMIX);
    const float* GOF = (const float*)(a.ws + WS_MIX + MX_GOF); const float* GOB = (const float*)(a.ws + WS_MIX + MX_GOB);
    const float* DOF = (const float*)(a.ws + WS_MIX + MX_DOF); const float* DOB = (const float*)(a.ws + WS_MIX + MX_DOB);
    const f32x4 nwa = *(const f32x4*)(a.in[I_GLANW] + l * 64 + (4 * lane & 63)), nwd = *(const f32x4*)(a.in[I_GDNNW] + l * 64 + (4 * lane & 63));
#pragma unroll 1
    for (int row0 = gw; row0 < NTOK; row0 += 4 * ngw) {
        f32x4 og[4], od[4]; u32x2 r2[4], z2[4];
#pragma unroll
        for (int r = 0; r < 4; ++r) { const int row = min(row0 + r * ngw, NTOK - 1); const size_t o4 = (size_t)row * 256 + 4 * lane;
            og[r] = *(const f32x4*)(GOF + o4) + *(const f32x4*)(GOB + o4); od[r] = *(const f32x4*)(DOF + o4) + *(const f32x4*)(DOB + o4);
            r2[r] = *(const u32x2*)(P + (size_t)row * D_INP + GLA0 + 512 + 4 * lane); z2[r] = *(const u32x2*)(P + (size_t)row * D_INP + GDN0 + 768 + 4 * lane); }
#pragma unroll
        for (int r = 0; r < 4; ++r) { const int row = row0 + r * ngw;
            if (row < NTOK) {
                float sg = og[r][0] * og[r][0] + og[r][1] * og[r][1] + og[r][2] * og[r][2] + og[r][3] * og[r][3], sd = od[r][0] * od[r][0] + od[r][1] * od[r][1] + od[r][2] * od[r][2] + od[r][3] * od[r][3];
                sg = row16_sum(sg); sd = row16_sum(sd);
                const float rg = rsqrtf(sg * (1.f / 64.f) + 1e-6f), rd = rsqrtf(sd * (1.f / 64.f) + 1e-6f);
                u32x2 w;
                w.x = pk2(og[r][0] * rg * nwa[0] * siluf_(lo_bf(r2[r].x)), og[r][1] * rg * nwa[1] * siluf_(hi_bf(r2[r].x))); w.y = pk2(og[r][2] * rg * nwa[2] * siluf_(lo_bf(r2[r].y)), og[r][3] * rg * nwa[3] * siluf_(hi_bf(r2[r].y)));
                *(u32x2*)(YMIX + (size_t)row * D + 512 + 4 * lane) = w;
                w.x = pk2(od[r][0] * rd * nwd[0] * siluf_(lo_bf(z2[r].x)), od[r][1] * rd * nwd[1] * siluf_(hi_bf(z2[r].x))); w.y = pk2(od[r][2] * rd * nwd[2] * siluf_(lo_bf(z2[r].y)), od[r][3] * rd * nwd[3] * siluf_(hi_bf(z2[r].y)));
                *(u32x2*)(YMIX + (size_t)row * D + 768 + 4 * lane) = w; } }
    }
}

__device__ __forceinline__ void ph_ln1_route(CArgs& a, int l, LAS unsigned char* lds, int bid, int nblk) {
    const int tid = tidx(), lane = tid & 63, w = __builtin_amdgcn_readfirstlane(tid >> 6);
    const float* MOD = (const float*)(a.ws + WS_MOD) + (size_t)l * 17 * 6144;
    float* X = (float*)(a.ws + WS_X); const float* TMP = (const float*)(a.ws + WS_TMP); bf16* HB = (bf16*)(a.ws + WS_HB);
    const float* lg = a.in[I_LN1G] + l * D; const float* lb = a.in[I_LN1B] + l * D;
    const float* br = a.in[I_BR] + l * NEXP;
    const bf16* wh = (const bf16*)(a.ws + WS_WRT) + (size_t)l * NEXP * D; const bf16* wl = wh + DEPTH * NEXP * D;
    unsigned* cnt = (unsigned*)(a.ws + WS_CTL) + CW_CNT + l * NEXP * 64;
    int* LIST = (int*)(a.ws + WS_LIST); int* TOPE = (int*)(a.ws + WS_TOPE); float* TOPW = (float*)(a.ws + WS_TOPW);
    LAS float* hrow = (LAS float*)lds;
    LAS float* part = (LAS float*)(lds + 65792);
    const int row_lo = (l == DEPTH - 1) ? NTOK_C : 0;
    const int e = lane & 31, par = lane >> 5, fr = lane & 15, kg = lane >> 4;
    f32x4 xv[2][4], tv[2][4];
#define LN1_FETCH(base_) do { _Pragma("unroll") for (int t = 0; t < 2; ++t) { const int row_ = (base_) + 2 * w + t; \
        const float* xs_ = (l == 0) ? (row_ < NTOK_C ? a.in[I_CTX] + (size_t)row_ * D : a.in[I_X] + (size_t)(row_ - NTOK_C) * D) : X + (size_t)row_ * D; \
        _Pragma("unroll") for (int j = 0; j < 4; ++j) { xv[t][j] = *(const f32x4*)(xs_ + j * 256 + 4 * lane); tv[t][j] = *(const f32x4*)(TMP + (size_t)row_ * D + j * 256 + 4 * lane); } } } while (0)
    constexpr int CAP = 112;
    LAS unsigned* lcnt = (LAS unsigned*)(lds + 82176);
    LAS int* ent = (LAS int*)(lds + 82176 + 256);
    LAS float* entw = (LAS float*)(lds + 82176 + 256 + CAP * 256);
    if (tid < 32) lcnt[tid] = 0u;
    int base = row_lo + bid * 16, base0 = base, nb = 0;
#define LN1_FLUSH do { __syncthreads(); \
        if (tid < 32) { const unsigned n_ = lcnt[tid]; unsigned g_ = 0u; if (n_) g_ = atomicAdd(cnt + tid * 64, n_); lcnt[32 + tid] = g_; lcnt[tid] = 0u; } \
        __syncthreads(); \
        for (int idx = tid; idx < nb * 64; idx += 512) { const int pe_ = ent[idx], ee_ = pe_ >> 20; const unsigned pos_ = lcnt[32 + ee_] + (unsigned)(pe_ & 0xfffff); \
            const int row_ = base0 + (idx >> 6) * nblk * 16 + ((idx >> 2) & 15); \
            LIST[(size_t)ee_ * NTOK + pos_] = row_; TOPE[(size_t)row_ * 4 + (idx & 3)] = (ee_ << 20) | (int)pos_; TOPW[(size_t)row_ * 4 + (idx & 3)] = entw[idx]; } \
        __syncthreads(); nb = 0; } while (0)
    if (base < NTOK) LN1_FETCH(base);
    bf16x8 Bh[4][2], Bl[4][2];
#pragma unroll
    for (int ss = 0; ss < 4; ++ss)
#pragma unroll
        for (int t = 0; t < 2; ++t) { const size_t wo = (size_t)(16 * t + fr) * D + 128 * w + 32 * ss + 8 * kg; Bh[ss][t] = *(const bf16x8*)(wh + wo); Bl[ss][t] = *(const bf16x8*)(wl + wo); }
    const float bre = br[e];
#pragma unroll 1
    for (; base < NTOK; base += nblk * 16) {
#pragma unroll
        for (int t = 0; t < 2; ++t) {
            const int row = base + 2 * w + t;
            const float* mv = MOD + (size_t)mod_vec(row) * 6144;
            f32x4 v[4]; float s = 0.f;
#pragma unroll
            for (int j = 0; j < 4; ++j) { const int c0 = j * 256 + 4 * lane; const f32x4 g1 = *(const f32x4*)(mv + 2048 + c0);
                v[j] = DN_ALPHA * xv[t][j] + g1 * tv[t][j]; s += (v[j][0] + v[j][1]) + (v[j][2] + v[j][3]); }
            const float mean = wave_sum(s) * (1.f / D); float s2 = 0.f;
#pragma unroll
            for (int j = 0; j < 4; ++j) { v[j] = v[j] - mean; s2 += (v[j][0] * v[j][0] + v[j][1] * v[j][1]) + (v[j][2] * v[j][2] + v[j][3] * v[j][3]); }
            const float rstd = rsqrtf(wave_sum(s2) * (1.f / D) + LN_EPS);
#pragma unroll
            for (int j = 0; j < 4; ++j) { const int c0 = j * 256 + 4 * lane; const f32x4 g = *(const f32x4*)(lg + c0), bb = *(const f32x4*)(lb + c0), sh = *(const f32x4*)(mv + 3072 + c0), sc = *(const f32x4*)(mv + 4096 + c0);
                const f32x4 xn = v[j] * rstd * g + bb; *(f32x4*)(X + (size_t)row * D + c0) = xn;
                const f32x4 hh = xn * (1.f + sc) + sh;
                *(unsigned*)(a.ws + WS_HB8 + (size_t)row * D + c0) = pk4_fp8(4.f * hh[0], 4.f * hh[1], 4.f * hh[2], 4.f * hh[3]);
                *(LAS f32x4*)(hrow + (2 * w + t) * 1028 + c0) = hh; }
        }
        __syncthreads();
        if (base + nblk * 16 < NTOK) LN1_FETCH(base + nblk * 16);
        {
            f32x4 acc[2] = {(f32x4){0.f, 0.f, 0.f, 0.f}, (f32x4){0.f, 0.f, 0.f, 0.f}};
#pragma unroll
            for (int ss = 0; ss < 4; ++ss) { const int k0 = 128 * w + 32 * ss + 8 * kg;
                const f32x4 h0 = *(const LAS f32x4*)(hrow + fr * 1028 + k0), h1 = *(const LAS f32x4*)(hrow + fr * 1028 + k0 + 4);
                u32x4 ah, al;
                ah.x = pk2(h0[0], h0[1]); ah.y = pk2(h0[2], h0[3]); ah.z = pk2(h1[0], h1[1]); ah.w = pk2(h1[2], h1[3]);
                al.x = pk2(h0[0] - lo_bf(ah.x), h0[1] - hi_bf(ah.x)); al.y = pk2(h0[2] - lo_bf(ah.y), h0[3] - hi_bf(ah.y)); al.z = pk2(h1[0] - lo_bf(ah.z), h1[1] - hi_bf(ah.z)); al.w = pk2(h1[2] - lo_bf(ah.w), h1[3] - hi_bf(ah.w));
                const bf16x8 Ah = __builtin_bit_cast(bf16x8, ah), Al = __builtin_bit_cast(bf16x8, al);
#pragma unroll
                for (int t = 0; t < 2; ++t) {
                    acc[t] = __builtin_amdgcn_mfma_f32_16x16x32_bf16(Ah, Bh[ss][t], acc[t], 0, 0, 0);
                    acc[t] = __builtin_amdgcn_mfma_f32_16x16x32_bf16(Ah, Bl[ss][t], acc[t], 0, 0, 0);
                    acc[t] = __builtin_amdgcn_mfma_f32_16x16x32_bf16(Al, Bh[ss][t], acc[t], 0, 0, 0); } }
#pragma unroll
            for (int t = 0; t < 2; ++t)
#pragma unroll
                for (int j = 0; j < 4; ++j) part[((w * 2 + t) * 16 + 4 * kg + j) * 16 + fr] = acc[t][j];
        }
        __syncthreads();
        {
            float cur = bre;
#pragma unroll
            for (int ww = 0; ww < 8; ++ww) cur += part[((ww * 2 + (e >> 4)) * 16 + 2 * w + par) * 16 + (e & 15)];
            float tvv[4]; int ti[4];
#pragma unroll
            for (int k = 0; k < 4; ++k) { float bv = cur; int bi = e;
#define TOPSTEP(OV, OI) do { const float ov = (OV); const int oi = (OI); if (ov > bv || (ov == bv && oi < bi)) { bv = ov; bi = oi; } } while (0)
                TOPSTEP(dpp_f<0xB1>(bv), dpp_i<0xB1>(bi)); TOPSTEP(dpp_f<0x4E>(bv), dpp_i<0x4E>(bi)); TOPSTEP(dpp_f<0x141>(bv), dpp_i<0x141>(bi)); TOPSTEP(dpp_f<0x140>(bv), dpp_i<0x140>(bi));
                TOPSTEP(__shfl_xor(bv, 16), __shfl_xor(bi, 16));
#undef TOPSTEP
                tvv[k] = bv; ti[k] = bi; if (e == bi) cur = -3.0e38f; }
            const float e1 = __expf(tvv[1] - tvv[0]), e2 = __expf(tvv[2] - tvv[0]), e3 = __expf(tvv[3] - tvv[0]); const float inv = 1.f / (1.f + e1 + e2 + e3);
            if (e < 4) {
                const int ee = e == 0 ? ti[0] : e == 1 ? ti[1] : e == 2 ? ti[2] : ti[3]; const float ww = (e == 0 ? 1.f : e == 1 ? e1 : e == 2 ? e2 : e3) * inv;
                const unsigned lp = __hip_atomic_fetch_add(lcnt + ee, 1u, __ATOMIC_RELAXED, __HIP_MEMORY_SCOPE_WORKGROUP);
                const int idx = nb * 64 + w * 8 + par * 4 + e;
                ent[idx] = (ee << 20) | (int)lp; entw[idx] = ww; }
        }
        ++nb;
        if (nb == CAP) { LN1_FLUSH; base0 = base + nblk * 16; }
    }
    if (nb > 0) LN1_FLUSH;
#undef LN1_FLUSH
#undef LN1_FETCH
}
__device__ __forceinline__ void moe_tables(CArgs& a, int l, LAS unsigned char* lds, int NT) {
    LAS int* pre = (LAS int*)(lds + TAB_OFF); LAS int* mtl = pre + 40; LAS int* rowoff = pre + 80; LAS int* cn = pre + 120;
    if (tidx() == 0) { const unsigned* cnt = (const unsigned*)(a.ws + WS_CTL) + CW_CNT + l * NEXP * 64; int p = 0, r = 0;
        for (int e = 0; e < NEXP; ++e) { const int n = (int)__hip_atomic_load(cnt + e * 64, __ATOMIC_RELAXED, __HIP_MEMORY_SCOPE_AGENT), m = (n + 255) >> 8; pre[e] = p; mtl[e] = m > 0 ? m : 1; rowoff[e] = r; cn[e] = n; p += m * NT; r += m * 256; }
        pre[32] = p; }
    __syncthreads();
}
__device__ __forceinline__ void ph_ln2(CArgs& a, int l, LAS unsigned char* lds, int gw, int ngw) {
    const int lane = tidx() & 63;
    const float* MOD = (const float*)(a.ws + WS_MOD) + (size_t)l * 17 * 6144;
    float* X = (float*)(a.ws + WS_X); const bf16* YD = (const bf16*)(a.ws + WS_YD); bf16* HB = (bf16*)(a.ws + WS_HB);
    const float* lg = a.in[I_LN2G] + l * D; const float* lb = a.in[I_LN2B] + l * D;
    const int* TOPE = (const int*)(a.ws + WS_TOPE); const float* TOPW = (const float*)(a.ws + WS_TOPW);
    const LAS int* rowoff = (const LAS int*)(lds + TAB_OFF) + 80;
    const bool lastl = (l == DEPTH - 1);
    const int row_lo = lastl ? NTOK_C : 0;
#pragma unroll 1
    for (int row0 = row_lo + gw * 2; row0 < NTOK; row0 += ngw * 2) {
        u32x2 y2[2][4][4]; float tw[2][4]; f32x4 xv[2][4], g2v[2][4];
#pragma unroll
        for (int r = 0; r < 2; ++r) {
            const int row = row0 + r;
#pragma unroll
            for (int k = 0; k < 4; ++k) { const int te = TOPE[(size_t)row * 4 + k]; tw[r][k] = TOPW[(size_t)row * 4 + k];
                const bf16* yr = YD + ((size_t)(rowoff[te >> 20] + (te & 0xfffff))) * D;
#pragma unroll
                for (int j = 0; j < 4; ++j) y2[r][k][j] = *(const u32x2*)(yr + j * 256 + 4 * lane); }
            const float* mv = MOD + (size_t)mod_vec(row) * 6144;
#pragma unroll
            for (int j = 0; j < 4; ++j) { const int c0 = j * 256 + 4 * lane; xv[r][j] = *(const f32x4*)(X + (size_t)row * D + c0); g2v[r][j] = *(const f32x4*)(mv + 5120 + c0); }
        }
#pragma unroll
        for (int r = 0; r < 2; ++r) {
            const int row = row0 + r;
            const float* mv = MOD + (size_t)mod_vec(row) * 6144;
            f32x4 v[4]; float s = 0.f;
#pragma unroll
            for (int j = 0; j < 4; ++j) { f32x4 f = (f32x4){0.f, 0.f, 0.f, 0.f};
#pragma unroll
                for (int k = 0; k < 4; ++k) { const u32x2 yy = y2[r][k][j]; f += tw[r][k] * (f32x4){lo_bf(yy.x), hi_bf(yy.x), lo_bf(yy.y), hi_bf(yy.y)}; }
                v[j] = DN_ALPHA * xv[r][j] + g2v[r][j] * f; s += (v[j][0] + v[j][1]) + (v[j][2] + v[j][3]); }
            const float mean = wave_sum(s) * (1.f / D); float s2 = 0.f;
#pragma unroll
            for (int j = 0; j < 4; ++j) { v[j] = v[j] - mean; s2 += (v[j][0] * v[j][0] + v[j][1] * v[j][1]) + (v[j][2] * v[j][2] + v[j][3] * v[j][3]); }
            const float rstd = rsqrtf(wave_sum(s2) * (1.f / D) + LN_EPS);
            const float* mvn = mv + 17 * 6144;
#pragma unroll
            for (int j = 0; j < 4; ++j) { const int c0 = j * 256 + 4 * lane; const f32x4 g = *(const f32x4*)(lg + c0), bb = *(const f32x4*)(lb + c0);
                const f32x4 xn = v[j] * rstd * g + bb;
                if (lastl) *(f32x4*)(a.out + (size_t)(row - NTOK_C) * D + c0) = xn;
                else { *(f32x4*)(X + (size_t)row * D + c0) = xn; const f32x4 sh = *(const f32x4*)(mvn + c0), sc = *(const f32x4*)(mvn + 1024 + c0); const f32x4 hh = xn * (1.f + sc) + sh;
                    u32x2 o; o.x = pk2(hh[0], hh[1]); o.y = pk2(hh[2], hh[3]); *(u32x2*)(HB + (size_t)row * D + c0) = o; } }
        }
    }
}

constexpr int NPH = 2 + DEPTH * 9;
__device__ __forceinline__ CArgs* kargs() { CArgs* p = (CArgs*)__builtin_amdgcn_kernarg_segment_ptr(); asm volatile("" : "+s"(p)); return p; }
__global__ void __launch_bounds__(512, 2) trunk_fwd(Args a_unused) {
    extern __shared__ __attribute__((aligned(16))) unsigned char lds_raw[];
    LAS unsigned char* lds = (LAS unsigned char*)lds_raw;
    const int tid = threadIdx.x, wave = __builtin_amdgcn_readfirstlane(tid >> 6);
    const int bid = blockIdx.x, nblk = gridDim.x, gw = bid * 8 + wave, ngw = nblk * 8;
    volatile LAS unsigned* MISC = (volatile LAS unsigned*)(lds + MISC_OFF);
    if (tid < 64) MISC[tid] = 0u;
    __syncthreads();
    XcdBarrier bar; bar.x = 0; bar.st = nullptr;
    int lo, hi;
    { CArgs& a = *kargs(); lo = a.ph_lo; hi = a.ph_hi; bar.bar = (unsigned*)(a.ws + WS_CTL) + CW_BAR;
      if (hi - lo > 1) bar = xcd_barrier_post((unsigned*)(a.ws + WS_CTL) + CW_BAR, MISC); }
#define IN(k) (lo <= (k) && (k) < hi)
    unsigned long long tacc = 0ull, tbeg = 0ull;
#define PB_BEG(ty) do { if (PROBE_PH == (ty)) tbeg = __builtin_amdgcn_s_memrealtime(); } while (0)
#define PB_END(ty) do { if (PROBE_PH == (ty)) tacc += __builtin_amdgcn_s_memrealtime() - tbeg; } while (0)
#define SEAM(k) do { if (IN(k) && IN((k) + 1)) xcd_barrier(bar); } while (0)
    PB_BEG(0);
    if (IN(0)) { CArgs& a = *kargs(); unsigned long long t0 = 0ull;
#define PB_SUB(ty, stmt) do { if (PROBE_PH == (ty)) t0 = __builtin_amdgcn_s_memrealtime(); stmt; if (PROBE_PH == (ty)) tacc += __builtin_amdgcn_s_memrealtime() - t0; } while (0)
        PB_SUB(30, ph_mod(a, lds, bid, nblk)); __syncthreads(); PB_SUB(31, ph_filters(a, gw, ngw)); PB_SUB(32, ph_tr_small(a, lds, gw, ngw)); PB_SUB(33, ph_router_w(a, bid * 512 + tid, nblk * 512));
#undef PB_SUB
    }
    SEAM(0); PB_END(0); PB_BEG(1);
    if (IN(1)) { CArgs& a = *kargs(); ph_mod_input(a, gw, ngw); }
    SEAM(1); PB_END(1);
#pragma unroll 1
    for (int l = 0; l < DEPTH; ++l) {
        const int p0 = 2 + 9 * l;
        const bool lastl = (l == DEPTH - 1);
        PB_BEG(2);
        if (IN(p0 + 0)) {
            CArgs& a = *kargs();
            pg8::DenseSched S; S.init((const bf16*)(a.ws + WS_WIN) + (size_t)l * D_INP * 1024, 1024, NTOK, D_INP, nblk, bid, 0);
            pg8::EpiBf16 E{(bf16*)(a.ws + WS_P), D_INP, 0};
            pg8::gemm_phase<pg8::EpiBf16, pg8::DenseSched, true>(lds, (const char*)(a.ws + WS_HB), 1024, S, E);
        }
        SEAM(p0 + 0); PB_END(2); PB_BEG(3);
        if (IN(p0 + 1)) { CArgs& a = *kargs(); PB_BEG(50); ph_prep_conv(a, l, lds, bid, nblk); PB_END(50); PB_BEG(51); ph_prep_tok(a, l, lds, gw, ngw); PB_END(51); }
        SEAM(p0 + 1); PB_END(3); PB_BEG(4);
        if (IN(p0 + 2)) { CArgs& a = *kargs(); ph_scan(a, l, lds, bid, nblk, tacc); }
        SEAM(p0 + 2); PB_END(4); PB_BEG(5);
        if (IN(p0 + 3)) { CArgs& a = *kargs(); PB_BEG(52); ph_post_hyena(a, l, lds, bid, nblk); PB_END(52); PB_BEG(53); ph_post_tok(a, l, gw, ngw); PB_END(53); }
        SEAM(p0 + 3); PB_END(5); PB_BEG(6);
        if (IN(p0 + 4)) {
            CArgs& a = *kargs();
            const int r0 = lastl ? NTOK_C : 0;
            pg8::DenseSched S; S.init((const bf16*)(a.ws + WS_WOUT) + (size_t)l * 1024 * 1024, 1024, NTOK - r0, 1024, nblk, bid, r0);
            pg8::EpiF32 E{(float*)(a.ws + WS_TMP), 1024, r0};
            pg8::gemm_phase<pg8::EpiF32, pg8::DenseSched, true>(lds, (const char*)(a.ws + WS_YMIX), 1024, S, E);
        }
        SEAM(p0 + 4); PB_END(6); PB_BEG(7);
        if (IN(p0 + 5)) { CArgs& a = *kargs(); ph_ln1_route(a, l, lds, bid, nblk); }
        SEAM(p0 + 5); PB_END(7); PB_BEG(8);
        if (IN(p0 + 6)) {
            CArgs& a = *kargs();
            moe_tables(a, l, lds, 8);
            const LAS int* tb = (const LAS int*)(lds + TAB_OFF);
            pg8::MoeSched<true, 8> S; S.Bt = (const char*)(a.ws + WS_WGU); S.bstride = (size_t)2048 * 1024; S.rb = 1024; S.list = (const int*)(a.ws + WS_LIST);
            S.pre = tb; S.mtl = tb + 40; S.rowoff = tb + 80; S.cnt = tb + 120; S.K = 1024; S.G = nblk; S.c = (nblk % 8 == 0) ? (bid % 8) * (nblk / 8) + bid / 8 : bid; S.total = tb[32];
            pg8::EpiSwiglu E{(bf16*)(a.ws + WS_H), a.in[I_BG] + (size_t)l * NEXP * 1024, a.in[I_BU] + (size_t)l * NEXP * 1024, tb + 80, 1.f / 128.f};
            pg8::gemm_phase_f8g<pg8::EpiSwiglu, pg8::MoeSched<true, 8>, true>(lds, (const char*)(a.ws + WS_HB8), 1024, S, E);
        }
        SEAM(p0 + 6); PB_END(8); PB_BEG(9);
        if (IN(p0 + 7)) {
            CArgs& a = *kargs();
            moe_tables(a, l, lds, 4);
            const LAS int* tb = (const LAS int*)(lds + TAB_OFF);
            pg8::MoeSched<false, 4> S; S.Bt = (const char*)(a.ws + WS_WD); S.bstride = (size_t)1024 * 1024; S.rb = 1024; S.list = nullptr;
            S.pre = tb; S.mtl = tb + 40; S.rowoff = tb + 80; S.cnt = tb + 120; S.K = 1024; S.G = nblk; S.c = (nblk % 8 == 0) ? (bid % 8) * (nblk / 8) + bid / 8 : bid; S.total = tb[32];
            pg8::EpiDown E{(bf16*)(a.ws + WS_YD), a.in[I_BD] + (size_t)l * NEXP * 1024, tb + 80, 1.f / 128.f};
            pg8::gemm_phase_f8<pg8::EpiDown, pg8::MoeSched<false, 4>, true>(lds, (const char*)(a.ws + WS_H), 1024, S, E);
        }
        SEAM(p0 + 7); PB_END(9); PB_BEG(10);
        if (IN(p0 + 8)) { CArgs& a = *kargs(); moe_tables(a, l, lds, 4); ph_ln2(a, l, lds, gw, ngw); }
        if (!lastl) SEAM(p0 + 8);
        PB_END(10);
    }
    if (PROBE_PH >= 0) { const unsigned long long t0 = __builtin_amdgcn_s_memrealtime(); while (__builtin_amdgcn_s_memrealtime() - t0 < tacc) __builtin_amdgcn_s_sleep(8); }
#undef IN
#undef SEAM
}

extern "C" void kernel_launch(void* const* d_in, const int* in_sizes, int n_in, void* d_out, int out_size, void* d_ws, size_t ws_size, hipStream_t stream) {
    static int grid = 0;
    if (grid == 0) {
        if (n_in != 39 || out_size != NTOK_L * D || ws_size < WS_END) { fprintf(stderr, "kernel_launch: unexpected problem (n_in %d, out %d, ws %zu < %zu)\n", n_in, out_size, ws_size, (size_t)WS_END); grid = -1; return; }
        int dev = 0, cus = 0, per_cu = 0;
        if (hipGetDevice(&dev) != hipSuccess || hipDeviceGetAttribute(&cus, hipDeviceAttributeMultiprocessorCount, dev) != hipSuccess) { grid = -1; return; }
        if (hipFuncSetAttribute((const void*)trunk_fwd, hipFuncAttributeMaxDynamicSharedMemorySize, LDS_BYTES) != hipSuccess) { fprintf(stderr, "kernel_launch: hipFuncSetAttribute failed\n"); grid = -1; return; }
        if (hipOccupancyMaxActiveBlocksPerMultiprocessor(&per_cu, (const void*)trunk_fwd, 512, LDS_BYTES) != hipSuccess || per_cu < 1) fprintf(stderr, "kernel_launch: occupancy query says %d\n", per_cu);
        (void)hipGetLastError();
        grid = cus;
    }
    if (grid < 0) return;
    (void)hipMemsetAsync((char*)d_ws + WS_CTL, 0, CTL_ZERO_BYTES, stream);
    Args a{};
    for (int i = 0; i < 39; ++i) a.in[i] = (const float*)d_in[i];
    a.out = (float*)d_out; a.ws = (unsigned char*)d_ws;
#if MK_FUSED
    a.ph_lo = 0; a.ph_hi = NPH;
    hipLaunchKernelGGL(trunk_fwd, dim3(grid), dim3(512), LDS_BYTES, stream, a);
#else
    for (int p = 0; p < NPH; ++p) { a.ph_lo = p; a.ph_hi = p + 1; hipLaunchKernelGGL(trunk_fwd, dim3(grid), dim3(512), LDS_BYTES, stream, a); }
#endif
}
```

```cpp
#include <hip/hip_runtime.h>
#include <cstdio>
#include <cstdint>

#ifndef MK_FUSED
#define MK_FUSED 1
#endif

#ifndef USE_NEW_GDN
#define USE_NEW_GDN 1
#endif
#ifndef USE_NEW_GLA
#define USE_NEW_GLA 1
#endif
#ifndef PROBE_PH
#define PROBE_PH -1
#endif

#define LAS __attribute__((address_space(3)))
#define GAS __attribute__((address_space(1)))
typedef unsigned short bf16;
typedef short bf16x8 __attribute__((ext_vector_type(8)));
typedef float f32x4 __attribute__((ext_vector_type(4)));
typedef float f32x2 __attribute__((ext_vector_type(2)));
typedef unsigned u32x4 __attribute__((ext_vector_type(4)));
typedef unsigned u32x2 __attribute__((ext_vector_type(2)));

constexpr int D = 1024, NB = 16, SEQ = 2048, CTXL = 256, DEPTH = 4;
constexpr int NTOK_C = NB * CTXL, NTOK_L = NB * SEQ, NTOK = NTOK_C + NTOK_L;
constexpr int D_IN = 3376, D_INP = 3584;
constexpr int HY0 = 0, SC0 = 768, GLA0 = 1536, GDN0 = 2336;
constexpr int NEXP = 32, TOPK = 4;
constexpr int MAXROWS = NTOK * TOPK + NEXP * 256;
constexpr float DN_ALPHA = 1.681792830507429f;
constexpr float LN_EPS = 1e-5f;

constexpr size_t MiB = 1u << 20;
constexpr size_t WS_CTL = 0, CTL_ZERO_BYTES = 1 * MiB;
constexpr size_t WS_MOD = 1 * MiB;
constexpr size_t WS_WRT = 3 * MiB;
constexpr size_t WS_KUN = 4 * MiB;
constexpr size_t WS_WIN = 36 * MiB;
constexpr size_t WS_WOUT = 64 * MiB;
constexpr size_t WS_WGU = 72 * MiB;
constexpr size_t WS_WD = 200 * MiB;
constexpr size_t WS_X = 264 * MiB;
constexpr size_t WS_HB = 408 * MiB;
constexpr size_t WS_P = 480 * MiB;
constexpr size_t WS_YMIX = 732 * MiB;
constexpr size_t WS_YD = WS_P;
constexpr size_t WS_TMP = 804 * MiB;
constexpr size_t WS_LIST = 948 * MiB;
constexpr size_t WS_TOPE = 953 * MiB;
constexpr size_t WS_TOPW = 954 * MiB;
constexpr size_t WS_H = 956 * MiB;
constexpr size_t WS_MIX = 1264 * MiB;
constexpr size_t MX_ZT = 0;
constexpr size_t MX_YT = 20 * MiB;
constexpr size_t MX_GDF = 56 * MiB, MX_GDB = 76 * MiB;
constexpr size_t MX_GOF = 96 * MiB, MX_GOB = 132 * MiB;
constexpr size_t MX_DQ = 168 * MiB, MX_DK = 204 * MiB, MX_DV = 240 * MiB;
constexpr size_t MX_DG = 276 * MiB;
constexpr size_t MX_DOF = 280 * MiB, MX_DOB = 316 * MiB;
constexpr size_t WS_HB8 = 1616 * MiB;
constexpr size_t WS_END = 1980 * MiB;
constexpr int NUNIT = 128 * 36;
constexpr size_t WS_CKD = 1656 * MiB;
constexpr size_t CD_M = 0;
constexpr size_t CD_E = 36 * MiB;
constexpr size_t CD_BT = 72 * MiB;
constexpr size_t CD_FT = 144 * MiB;
constexpr size_t CD_KB = 180 * MiB, CD_QB = 198 * MiB;
constexpr size_t WS_CKA = WS_CKD + 216 * MiB;
constexpr size_t CA_QC = 0;
constexpr size_t CA_FT = 20 * MiB;
constexpr size_t CA_UT = 60 * MiB;
constexpr size_t CA_DL = 100 * MiB;
static_assert(WS_CKA + CA_DL + (size_t)NUNIT * 32 * 4 <= WS_END, "chunk data");
static_assert((size_t)MAXROWS * 1024 * 2 <= 324 * MiB, "YD overlay");
static_assert(WS_H + (size_t)MAXROWS * 1024 * 2 <= WS_MIX, "H");
constexpr int CW_BAR = 4096;
constexpr int CW_CNT = 16384;

constexpr int LDS_BYTES = 147456;
constexpr int MISC_OFF = 143360;
constexpr int TAB_OFF = 143360 + 256;

__device__ __forceinline__ float bf2f(unsigned v) { return __uint_as_float(v << 16); }
__device__ __forceinline__ unsigned f2bf(float f) { unsigned u = __float_as_uint(f); return (u + 0x7fffu + ((u >> 16) & 1u)) >> 16; }
__device__ __forceinline__ unsigned pk2(float lo, float hi) { return f2bf(lo) | (f2bf(hi) << 16); }
__device__ __forceinline__ unsigned pk4_fp8(float a, float b, float c, float d) { int r = __builtin_amdgcn_cvt_pk_fp8_f32(a, b, 0, false); return (unsigned)__builtin_amdgcn_cvt_pk_fp8_f32(c, d, r, true); }
__device__ __forceinline__ float lo_bf(unsigned w) { return __uint_as_float(w << 16); }
__device__ __forceinline__ float hi_bf(unsigned w) { return __uint_as_float(w & 0xffff0000u); }
__device__ __forceinline__ float sigmoidf_(float x) { return 1.f / (1.f + __expf(-x)); }
__device__ __forceinline__ float siluf_(float x) { return x / (1.f + __expf(-x)); }
__device__ __forceinline__ float softplusf_(float x) { return fmaxf(x, 0.f) + __logf(1.f + __expf(-fabsf(x))); }
__device__ __forceinline__ float logsigmoidf_(float x) { return fminf(x, 0.f) - __logf(1.f + __expf(-fabsf(x))); }
__device__ __forceinline__ float sin_rev(float r) { return __builtin_amdgcn_sinf(__builtin_amdgcn_fractf(r)); }
__device__ __forceinline__ float sin_rad(float x) { return sin_rev(x * 0.15915494309189535f); }
template <int CTRL> __device__ __forceinline__ float dpp_f(float v) { return __builtin_bit_cast(float, __builtin_amdgcn_update_dpp(0, __builtin_bit_cast(int, v), CTRL, 0xf, 0xf, true)); }
template <int CTRL> __device__ __forceinline__ int dpp_i(int v) { return __builtin_amdgcn_update_dpp(0, v, CTRL, 0xf, 0xf, true); }
__device__ __forceinline__ float quad_sum(float v) { v += dpp_f<0xB1>(v); v += dpp_f<0x4E>(v); return v; }
__device__ __forceinline__ float row16_sum(float v) { v += dpp_f<0xB1>(v); v += dpp_f<0x4E>(v); v += dpp_f<0x141>(v); v += dpp_f<0x140>(v); return v; }
__device__ __forceinline__ float rdlane_f(float v, int l) { return __builtin_bit_cast(float, __builtin_amdgcn_readlane(__builtin_bit_cast(int, v), l)); }
__device__ __forceinline__ float wave_sum(float v) {
    v = row16_sum(v);
    return (rdlane_f(v, 0) + rdlane_f(v, 16)) + (rdlane_f(v, 32) + rdlane_f(v, 48));
}
__device__ __forceinline__ int tidx() { int t = threadIdx.x; asm volatile("" : "+v"(t)); return t; }

#define XB_TMO      128
#define XB_XCNT(j)  (256  + 64 * (j))
#define XB_XSUB(j)  (1280 + 64 * (j))
#define XB_XGEN(j)  (2304 + 64 * (j))
#define XB_TOP      3328
#define XB_TOPGEN   3392
#define XCD_BAR_WORDS 3456
#define XB_SPIN_CAP (1u << 25)
__device__ __forceinline__ unsigned xb_ld(unsigned* p)              { return __hip_atomic_load(p, __ATOMIC_RELAXED, __HIP_MEMORY_SCOPE_AGENT); }
__device__ __forceinline__ unsigned xb_add(unsigned* p, unsigned v) { return __hip_atomic_fetch_add(p, v, __ATOMIC_RELAXED, __HIP_MEMORY_SCOPE_AGENT); }
__device__ __forceinline__ unsigned xb_xcc_id() { return (unsigned)__builtin_amdgcn_s_getreg((3 << 11) | 20) & 0xFu; }
#define XB_SPIN(cond, bar) do { unsigned _sp = 0; while (cond) { __builtin_amdgcn_s_sleep(1); \
    if ((++_sp & 255u) == 0u) { if (xb_ld(&(bar)[XB_TMO])) break; if (_sp > XB_SPIN_CAP) { atomicAdd(&(bar)[XB_TMO], 1u); break; } } } } while (0)
struct XcdBarrier { unsigned* bar; unsigned x; volatile LAS unsigned* st; };
__device__ __forceinline__ XcdBarrier xcd_barrier_post(unsigned* bar, volatile LAS unsigned* st) {
    XcdBarrier b; b.bar = bar; b.x = xb_xcc_id(); b.st = st;
    if (threadIdx.x == 0) (void)xb_add(&bar[XB_XCNT(b.x)], 1u);
    return b;
}
__device__ __forceinline__ void xcd_barrier_complete(unsigned* bar, unsigned x, unsigned& nloc, unsigned& nx) {
    const unsigned G = gridDim.x * gridDim.y * gridDim.z;
    unsigned sum, cnt, mine, sp = 0u;
    for (;;) {
        sum = 0u; cnt = 0u; mine = 0u;
#pragma unroll
        for (unsigned j = 0; j < 16; ++j) { const unsigned c = xb_ld(&bar[XB_XCNT(j)]); sum += c; cnt += (c > 0u) ? 1u : 0u; mine = (j == x) ? c : mine; }
        if (sum == G) break;
        __builtin_amdgcn_s_sleep(1);
        if ((++sp & 255u) == 0u) { if (xb_ld(&bar[XB_TMO])) break; if (sp > XB_SPIN_CAP) { atomicAdd(&bar[XB_TMO], 1u); break; } }
    }
    nloc = mine > 0u ? mine : 1u; nx = cnt > 0u ? cnt : 1u;
}
__device__ __forceinline__ void xcd_barrier(const XcdBarrier& b) {
    asm volatile("s_waitcnt vmcnt(0)" ::: "memory");
    __syncthreads();
    if (threadIdx.x == 0) {
        unsigned* bar = b.bar;
        __builtin_amdgcn_s_waitcnt(0);
        unsigned nloc = b.st[0], nx = b.st[1];
        if (nloc == 0u) { xcd_barrier_complete(bar, b.x, nloc, nx); b.st[0] = nloc; b.st[1] = nx; }
        const unsigned old = xb_add(&bar[XB_XSUB(b.x)], 1u);
        const unsigned gen = old / nloc;
        if (old + 1u == (gen + 1u) * nloc) {
            __builtin_amdgcn_fence(__ATOMIC_RELEASE, "agent");
            asm volatile("s_waitcnt vmcnt(0)" ::: "memory");
            const unsigned og = xb_add(&bar[XB_TOP], 1u);
            const unsigned tg = og / nx;
            if (og + 1u == (tg + 1u) * nx) xb_add(&bar[XB_TOPGEN], 1u);
            else XB_SPIN(xb_ld(&bar[XB_TOPGEN]) == tg, bar);
            __builtin_amdgcn_fence(__ATOMIC_ACQUIRE, "agent");
            xb_add(&bar[XB_XGEN(b.x)], 1u);
            asm volatile("s_waitcnt vmcnt(0)" ::: "memory");
        } else {
            XB_SPIN(xb_ld(&bar[XB_XGEN(b.x)]) == gen, bar);
            __builtin_amdgcn_fence(__ATOMIC_ACQUIRE, "agent");
            asm volatile("s_waitcnt vmcnt(0)" ::: "memory");
        }
    }
    __syncthreads();
}

namespace pg8 {
constexpr int BM = 256, BK = 64, HALF = 128, HTB = HALF * BK * 2, STAGE_BYTES = 8 * HTB, NXCD = 8, WGM = 8;
__host__ __device__ __forceinline__ int lds_byte(int r, int c) { const int st = (r >> 4) * 2 + (c >> 5), rr = r & 15, cc = c & 31, ob = rr * 64 + cc * 2; return st * 1024 + (ob ^ (((ob >> 9) & 1) << 5)); }
__host__ __device__ __forceinline__ void stage_rc(int b, int& R, int& C) { const int st = b / 1024, sb = b % 1024, swz = sb ^ (((sb >> 9) & 1) << 5); R = (st >> 1) * 16 + swz / 64; C = (st & 1) * 32 + (swz % 64) / 2; }
__host__ __device__ __forceinline__ int perm32(int rho) { const int n = rho >> 4, i = rho & 15; return 8 * (i >> 2) + 4 * n + (i & 3); }
__device__ __forceinline__ unsigned cvt_pk_bf16(float lo, float hi) { unsigned r; asm volatile("v_cvt_pk_bf16_f32 %0, %1, %2" : "=v"(r) : "v"(lo), "v"(hi)); return r; }

struct Unit { int pm, pn, e, mt; };

struct DenseSched {
    const char* Bt; int K, nM, nN, nwg, G, c, row0;
    __device__ __forceinline__ void init(const bf16* Bt_, int K_, int M, int N, int G_, int c_, int row0_) { Bt = (const char*)Bt_; K = K_; nM = M / BM; nN = N / BM; nwg = nM * nN; G = G_; c = c_; row0 = row0_; }
    __device__ __forceinline__ bool next(int i, Unit& u) const {
        const long L = (long)i * G + c; if (L >= nwg) return false;
        int wgid = (int)L; { const int q = nwg / NXCD, r = nwg % NXCD, xcd = wgid % NXCD, off = wgid / NXCD; wgid = (xcd < r ? xcd * (q + 1) : r * (q + 1) + (xcd - r) * q) + off; }
        const int nig = WGM * nN, gid = wgid / nig, fm = gid * WGM, gsz = (nM - fm) < WGM ? (nM - fm) : WGM;
        u.pm = fm + ((wgid % nig) % gsz); u.pn = (wgid % nig) / gsz; u.e = 0; u.mt = 0; return true;
    }
    __device__ __forceinline__ const char* b_ptr(const Unit& u) const { return Bt + (size_t)u.pn * (size_t)(BM * 2) * K; }
    __device__ __forceinline__ void a_offsets(const Unit& u, const int (&R)[2], const int (&C)[2], unsigned (&v)[2][2]) const {
#pragma unroll
        for (int h = 0; h < 2; ++h)
#pragma unroll
            for (int i = 0; i < 2; ++i) v[h][i] = (unsigned)((row0 + u.pm * BM + h * HALF + R[i]) * K + C[i]) * 2u;
    }
};
template <bool GATHER, int NT>
struct MoeSched {
    const char* Bt; size_t bstride;
    int rb;
    const int* list;
    const LAS int* pre; const LAS int* mtl; const LAS int* rowoff; const LAS int* cnt;
    int K, G, c, total;
    __device__ __forceinline__ bool next(int i, Unit& u) const {
        const int L = i * G + c; if (L >= total) return false;
        int e = 0;
#pragma unroll 1
        for (int j = 1; j < NEXP; ++j) e = (L >= pre[j]) ? j : e;
        const int rem = L - pre[e];
        u.e = e; u.pn = rem % NT; u.mt = rem / NT; u.pm = 0; return true;
    }
    __device__ __forceinline__ const char* b_ptr(const Unit& u) const { return Bt + (size_t)u.e * bstride + (size_t)u.pn * (size_t)BM * rb; }
    __device__ __forceinline__ const char* a_ptr(const Unit& u, const char* Abase) const { return Abase + (size_t)(rowoff[u.e] + u.mt * BM) * rb; }
    __device__ __forceinline__ void a_offsets(const Unit& u, const int (&R)[2], const int (&C)[2], unsigned (&v)[2][2]) const {
        if (GATHER) {
            const int n = cnt[u.e]; const int* lp = list + (size_t)u.e * NTOK;
#pragma unroll
            for (int h = 0; h < 2; ++h)
#pragma unroll
                for (int i = 0; i < 2; ++i) { const int idx = u.mt * BM + h * HALF + R[i]; const int tok = idx < n ? lp[idx] : 0; v[h][i] = (unsigned)(tok * rb + 2 * C[i]); }
        } else {
            const int r0 = rowoff[u.e] + u.mt * BM;
#pragma unroll
            for (int h = 0; h < 2; ++h)
#pragma unroll
                for (int i = 0; i < 2; ++i) v[h][i] = (unsigned)((r0 + h * HALF + R[i]) * K + C[i]) * 2u;
        }
    }
};

struct EpiBf16 {
    static constexpr bool PERM = true;
    bf16* O; int ldc; int row0;
    __device__ __forceinline__ void operator()(const f32x4 (&acc)[2][2][4][2], const Unit& u, int wr, int wc, int fr, int fq) const {
        const int r0 = row0 + u.pm * BM + wr * 64 + fr, col0 = u.pn * BM + wc * 32 + 8 * fq;
#pragma unroll
        for (int ai = 0; ai < 2; ++ai)
#pragma unroll
            for (int m = 0; m < 4; ++m) { bf16* rowp = O + (size_t)(r0 + ai * HALF + m * 16) * ldc + col0;
#pragma unroll
                for (int bj = 0; bj < 2; ++bj) { const f32x4 v0 = acc[ai][bj][m][0], v1 = acc[ai][bj][m][1];
                    u32x4 w; w.x = cvt_pk_bf16(v0[0], v0[1]); w.y = cvt_pk_bf16(v0[2], v0[3]); w.z = cvt_pk_bf16(v1[0], v1[1]); w.w = cvt_pk_bf16(v1[2], v1[3]);
                    *(u32x4*)(rowp + bj * HALF) = w; } }
    }
};
struct EpiF32 {
    static constexpr bool PERM = false;
    float* Cc; int ldc; int row0;
    __device__ __forceinline__ void operator()(const f32x4 (&acc)[2][2][4][2], const Unit& u, int wr, int wc, int fr, int fq) const {
        const int r0 = row0 + u.pm * BM + wr * 64 + fr, col0 = u.pn * BM + wc * 32 + 4 * fq;
#pragma unroll
        for (int ai = 0; ai < 2; ++ai)
#pragma unroll
            for (int m = 0; m < 4; ++m) { float* rowp = Cc + (size_t)(r0 + ai * HALF + m * 16) * ldc + col0;
#pragma unroll
                for (int bj = 0; bj < 2; ++bj)
#pragma unroll
                    for (int n = 0; n < 2; ++n) *(f32x4*)(rowp + bj * HALF + n * 16) = acc[ai][bj][m][n]; }
    }
};
struct EpiSwiglu {
    static constexpr bool PERM = true;
    bf16* H; const float* bg; const float* bu; const LAS int* rowoff; float ws;
    __device__ __forceinline__ void operator()(const f32x4 (&acc)[2][2][4][2], const Unit& u, int wr, int wc, int fr, int fq) const {
        const int r0 = rowoff[u.e] + u.mt * BM + wr * 64 + fr, j0 = u.pn * HALF + wc * 32 + 8 * fq;
        f32x4 gb[2], ub[2];
#pragma unroll
        for (int n = 0; n < 2; ++n) { gb[n] = *(const f32x4*)(bg + u.e * 1024 + j0 + 4 * n); ub[n] = *(const f32x4*)(bu + u.e * 1024 + j0 + 4 * n); }
#pragma unroll
        for (int ai = 0; ai < 2; ++ai)
#pragma unroll
            for (int m = 0; m < 4; ++m) { unsigned char* rowp = (unsigned char*)H + (size_t)(r0 + ai * HALF + m * 16) * 1024 + j0; float hv[8];
#pragma unroll
                for (int n = 0; n < 2; ++n)
#pragma unroll
                    for (int j = 0; j < 4; ++j) { float g = acc[ai][0][m][n][j] * ws + gb[n][j], up = acc[ai][1][m][n][j] * ws + ub[n][j];
                        g = fminf(g, 7.f); up = fminf(fmaxf(up, -7.f), 7.f);
                        hv[n * 4 + j] = (up + 1.f) * g * __builtin_amdgcn_rcpf(1.f + __expf(-1.702f * g)); }
                *(u32x2*)rowp = (u32x2){pk4_fp8(4.f * hv[0], 4.f * hv[1], 4.f * hv[2], 4.f * hv[3]), pk4_fp8(4.f * hv[4], 4.f * hv[5], 4.f * hv[6], 4.f * hv[7])}; }
    }
};
struct EpiDown {
    static constexpr bool PERM = true;
    bf16* Y; const float* bd; const LAS int* rowoff; float ws;
    __device__ __forceinline__ void operator()(const f32x4 (&acc)[2][2][4][2], const Unit& u, int wr, int wc, int fr, int fq) const {
        const int r0 = rowoff[u.e] + u.mt * BM + wr * 64 + fr, col0 = u.pn * BM + wc * 32 + 8 * fq;
        f32x4 bv[2][2];
#pragma unroll
        for (int bj = 0; bj < 2; ++bj)
#pragma unroll
            for (int n = 0; n < 2; ++n) bv[bj][n] = *(const f32x4*)(bd + u.e * 1024 + col0 + bj * HALF + 4 * n);
#pragma unroll
        for (int ai = 0; ai < 2; ++ai)
#pragma unroll
            for (int m = 0; m < 4; ++m) { bf16* rowp = Y + (size_t)(r0 + ai * HALF + m * 16) * 1024 + col0;
#pragma unroll
                for (int bj = 0; bj < 2; ++bj) { const f32x4 v0 = acc[ai][bj][m][0] * ws + bv[bj][0], v1 = acc[ai][bj][m][1] * ws + bv[bj][1];
                    u32x4 w; w.x = cvt_pk_bf16(v0[0], v0[1]); w.y = cvt_pk_bf16(v0[2], v0[3]); w.z = cvt_pk_bf16(v1[0], v1[1]); w.w = cvt_pk_bf16(v1[2], v1[3]);
                    *(u32x4*)(rowp + bj * HALF) = w; } }
    }
};

template <class Epi, class Sched, bool ALIGN_EPI>
__device__ __forceinline__ void gemm_phase(LAS unsigned char* lds, const char* Abase, const int K, const Sched& S, const Epi& E) {
    const int tid = tidx(), wid = __builtin_amdgcn_readfirstlane(tid >> 6), lane = tid & 63, wr = wid >> 2, wc = wid & 3, fr = lane & 15, fq = lane >> 4;
    const int nt = K / BK;
    int Rp[2], Cp[2]; unsigned voffB0;
#pragma unroll
    for (int i = 0; i < 2; ++i) stage_rc(tid * 16 + i * 8192, Rp[i], Cp[i]);
    { const int Rb = Epi::PERM ? ((Rp[0] & ~31) + perm32(Rp[0] & 31)) : Rp[0]; voffB0 = (unsigned)(Rb * K + Cp[0]) * 2u; }
    const size_t kstep = (size_t)(BK * 2);
    const size_t hstep = (size_t)HALF * K * 2;
    const unsigned ldsw = (unsigned)wid * 1024u;
    const int aoff = lds_byte(wr * 64 + fr, fq * 8), boff = lds_byte(wc * 32 + fr, fq * 8);
#define PG8_SA(b, h) (((b) * 2 + (h)) * HTB)
#define PG8_SB(b, h) ((4 + (b) * 2 + (h)) * HTB)
#define PG8_STAGE(bufoff, gbase, voff) do { _Pragma("unroll") for (int _i = 0; _i < 2; ++_i) \
        __builtin_amdgcn_global_load_lds((const unsigned*)((const char*)(gbase) + (voff)[_i]), (LAS unsigned*)(lds + (bufoff) + ldsw + _i * 8192), 16, 0, 0); } while (0)
#define PG8_STAGEB(bufoff, gbase) do { _Pragma("unroll") for (int _i = 0; _i < 2; ++_i) \
        __builtin_amdgcn_global_load_lds((const unsigned*)((const char*)(gbase) + (size_t)_i * 128 * K + voffB0), (LAS unsigned*)(lds + (bufoff) + ldsw + _i * 8192), 16, 0, 0); } while (0)
#define PG8_LDA(dst, b, h) do { _Pragma("unroll") for (int m = 0; m < 4; ++m) _Pragma("unroll") for (int k = 0; k < 2; ++k) dst[m][k] = *(const LAS bf16x8*)(lds + PG8_SA(b, h) + aoff + m * 2048 + k * 1024); } while (0)
#define PG8_LDB(dst, b, h) do { _Pragma("unroll") for (int n = 0; n < 2; ++n) _Pragma("unroll") for (int k = 0; k < 2; ++k) dst[n][k] = *(const LAS bf16x8*)(lds + PG8_SB(b, h) + boff + n * 2048 + k * 1024); } while (0)
#define PG8_MMA(ai, bj, At, Bt) do { __builtin_amdgcn_s_setprio(1); _Pragma("unroll") for (int m = 0; m < 4; ++m) _Pragma("unroll") for (int n = 0; n < 2; ++n) _Pragma("unroll") for (int k = 0; k < 2; ++k) \
        acc[ai][bj][m][n] = __builtin_amdgcn_mfma_f32_16x16x32_bf16(Bt[n][k], At[m][k], acc[ai][bj][m][n], 0, 0, 0); __builtin_amdgcn_s_setprio(0); } while (0)
#define PG8_WAIT_V(n) asm volatile("s_waitcnt vmcnt(" #n ")" ::: "memory")
#define PG8_WAIT_L(n) asm volatile("s_waitcnt lgkmcnt(" #n ")" ::: "memory")
#define PG8_BAR __builtin_amdgcn_s_barrier()
#define PG8_SCHED __builtin_amdgcn_sched_barrier(0)
    Unit cur, nxt; int ui = 0;
    if (!S.next(0, cur)) return;
    f32x4 acc[2][2][4][2];
#pragma unroll
    for (int a = 0; a < 2; ++a)
#pragma unroll
        for (int b = 0; b < 2; ++b)
#pragma unroll
            for (int m = 0; m < 4; ++m)
#pragma unroll
                for (int n = 0; n < 2; ++n) acc[a][b][m][n] = (f32x4){0.f, 0.f, 0.f, 0.f};
    bf16x8 At[4][2], B0[2][2], B1[2][2];
    unsigned vAc[2][2], vAn[2][2];
    S.a_offsets(cur, Rp, Cp, vAc);
    const char* cB = S.b_ptr(cur);
    PG8_STAGEB(PG8_SB(0, 0), cB); PG8_STAGEB(PG8_SB(0, 1), cB + hstep); PG8_STAGE(PG8_SA(0, 0), Abase, vAc[0]); PG8_STAGE(PG8_SA(0, 1), Abase, vAc[1]);
    if (wr == 1) PG8_BAR;
    PG8_WAIT_V(2); PG8_BAR;
    PG8_STAGEB(PG8_SB(1, 0), cB + kstep); PG8_STAGE(PG8_SA(1, 0), Abase + kstep, vAc[0]); PG8_STAGEB(PG8_SB(1, 1), cB + hstep + kstep);
    PG8_WAIT_V(6); PG8_BAR;
    for (;;) {
        const bool has_next = S.next(ui + 1, nxt);
        const char* nB = has_next ? S.b_ptr(nxt) : cB;
        if (has_next) S.a_offsets(nxt, Rp, Cp, vAn);
        else {
#pragma unroll
            for (int h = 0; h < 2; ++h)
#pragma unroll
                for (int i = 0; i < 2; ++i) vAn[h][i] = vAc[h][i]; }
        for (int t = 0; t < nt; t += 2) {
            const bool last = (t == nt - 2);
            const char* a1 = Abase + (size_t)(t + 1) * kstep;
            const char* a2 = last ? Abase : Abase + (size_t)(t + 2) * kstep; const char* b2 = last ? nB : cB + (size_t)(t + 2) * kstep;
            const char* a3 = a2 + kstep; const char* b3 = b2 + kstep;
            unsigned v2[2][2];
#pragma unroll
            for (int h = 0; h < 2; ++h)
#pragma unroll
                for (int i = 0; i < 2; ++i) v2[h][i] = last ? vAn[h][i] : vAc[h][i];
            PG8_LDB(B0, 0, 0); PG8_LDB(B1, 0, 1); PG8_SCHED; PG8_LDA(At, 0, 0); PG8_STAGE(PG8_SA(1, 1), a1, vAc[1]);
            PG8_WAIT_V(8); PG8_WAIT_L(0); PG8_BAR; PG8_MMA(0, 0, At, B0); PG8_MMA(0, 1, At, B1); PG8_BAR; PG8_SCHED;
            PG8_LDA(At, 0, 1); PG8_STAGEB(PG8_SB(0, 0), b2); PG8_STAGEB(PG8_SB(0, 1), b2 + hstep); PG8_STAGE(PG8_SA(0, 0), a2, v2[0]);
            PG8_WAIT_V(8); PG8_WAIT_L(0); PG8_BAR; PG8_MMA(1, 0, At, B0); PG8_MMA(1, 1, At, B1); PG8_BAR; PG8_SCHED;
            PG8_LDB(B0, 1, 0); PG8_LDB(B1, 1, 1); PG8_SCHED; PG8_LDA(At, 1, 0); PG8_STAGE(PG8_SA(0, 1), a2, v2[1]);
            PG8_WAIT_V(8); PG8_WAIT_L(0); PG8_BAR; PG8_MMA(0, 0, At, B0); PG8_MMA(0, 1, At, B1); PG8_BAR; PG8_SCHED;
            PG8_LDA(At, 1, 1); PG8_STAGEB(PG8_SB(1, 0), b3); PG8_STAGEB(PG8_SB(1, 1), b3 + hstep); PG8_STAGE(PG8_SA(1, 0), a3, v2[0]);
            PG8_WAIT_V(8); PG8_WAIT_L(0); PG8_BAR; PG8_MMA(1, 0, At, B0); PG8_MMA(1, 1, At, B1); PG8_BAR; PG8_SCHED;
        }
        if constexpr (ALIGN_EPI) { if (wr == 0) PG8_BAR; }
        E(acc, cur, wr, wc, fr, fq);
        if (!has_next) break;
#pragma unroll
        for (int a = 0; a < 2; ++a)
#pragma unroll
            for (int b = 0; b < 2; ++b)
#pragma unroll
                for (int m = 0; m < 4; ++m)
#pragma unroll
                    for (int n = 0; n < 2; ++n) acc[a][b][m][n] = (f32x4){0.f, 0.f, 0.f, 0.f};
        cur = nxt; cB = nB; ++ui;
#pragma unroll
        for (int h = 0; h < 2; ++h)
#pragma unroll
            for (int i = 0; i < 2; ++i) vAc[h][i] = vAn[h][i];
        if constexpr (ALIGN_EPI) { if (wr == 1) PG8_BAR; }
    }
    PG8_WAIT_V(0);
    if constexpr (!ALIGN_EPI) { if (wr == 0) PG8_BAR; }
    PG8_BAR;
#undef PG8_SA
#undef PG8_SB
#undef PG8_STAGE
#undef PG8_STAGEB
#undef PG8_LDA
#undef PG8_LDB
#undef PG8_MMA
#undef PG8_WAIT_V
#undef PG8_WAIT_L
#undef PG8_BAR
#undef PG8_SCHED
}
template <class Epi, class Sched, bool ALIGN_EPI>
__device__ __forceinline__ void gemm_phase_f8g(LAS unsigned char* lds, const char* Abase, const int K, const Sched& S, const Epi& E) {
    const int tid = tidx(), wid = __builtin_amdgcn_readfirstlane(tid >> 6), lane = tid & 63, wr = wid >> 2, wc = wid & 3, fr = lane & 15, fq = lane >> 4;
    const int nt = K / 128;
    int Rp[2], Cp[2]; unsigned voffB0;
#pragma unroll
    for (int i = 0; i < 2; ++i) stage_rc(tid * 16 + i * 8192, Rp[i], Cp[i]);
    { const int Rb = Epi::PERM ? ((Rp[0] & ~31) + perm32(Rp[0] & 31)) : Rp[0]; voffB0 = (unsigned)(Rb * K + 2 * Cp[0]); }
    const size_t kstep = (size_t)(BK * 2);
    const size_t hstep = (size_t)HALF * K;
    const unsigned ldsw = (unsigned)wid * 1024u;
    const int aoff0 = lds_byte(wr * 64 + fr, 16 * (fq & 1)) + (fq >> 1) * 1024, boff0 = lds_byte(wc * 32 + fr, 16 * (fq & 1)) + (fq >> 1) * 1024;
#define PG8_SA(b, h) (((b) * 2 + (h)) * HTB)
#define PG8_SB(b, h) ((4 + (b) * 2 + (h)) * HTB)
#define PG8_STAGE(bufoff, gbase, voff) do { _Pragma("unroll") for (int _i = 0; _i < 2; ++_i) \
        __builtin_amdgcn_global_load_lds((const unsigned*)((const char*)(gbase) + (voff)[_i]), (LAS unsigned*)(lds + (bufoff) + ldsw + _i * 8192), 16, 0, 0); } while (0)
#define PG8_STAGEB(bufoff, gbase) do { _Pragma("unroll") for (int _i = 0; _i < 2; ++_i) \
        __builtin_amdgcn_global_load_lds((const unsigned*)((const char*)(gbase) + (size_t)_i * 64 * K + voffB0), (LAS unsigned*)(lds + (bufoff) + ldsw + _i * 8192), 16, 0, 0); } while (0)
#define PG8_LDA(dst, b, h) do { _Pragma("unroll") for (int m = 0; m < 4; ++m) { const u32x4 lo_ = *(const LAS u32x4*)(lds + PG8_SA(b, h) + aoff0 + m * 2048), hi_ = *(const LAS u32x4*)(lds + PG8_SA(b, h) + aoff0 + 16 + m * 2048); \
        dst[m] = (v8i){(int)lo_.x, (int)lo_.y, (int)lo_.z, (int)lo_.w, (int)hi_.x, (int)hi_.y, (int)hi_.z, (int)hi_.w}; } } while (0)
#define PG8_LDB(dst, b, h) do { _Pragma("unroll") for (int n = 0; n < 2; ++n) { const u32x4 lo_ = *(const LAS u32x4*)(lds + PG8_SB(b, h) + boff0 + n * 2048), hi_ = *(const LAS u32x4*)(lds + PG8_SB(b, h) + boff0 + 16 + n * 2048); \
        dst[n] = (v8i){(int)lo_.x, (int)lo_.y, (int)lo_.z, (int)lo_.w, (int)hi_.x, (int)hi_.y, (int)hi_.z, (int)hi_.w}; } } while (0)
#define PG8_MMA(ai, bj, At, Bt) do { __builtin_amdgcn_s_setprio(1); _Pragma("unroll") for (int m = 0; m < 4; ++m) _Pragma("unroll") for (int n = 0; n < 2; ++n) \
        asm volatile("v_mfma_scale_f32_16x16x128_f8f6f4 %0, %1, %2, %0, %3, %3 op_sel_hi:[0,0,0]" : "+v"(acc[ai][bj][m][n]) : "v"(Bt[n]), "v"(At[m]), "v"(f8scale)); __builtin_amdgcn_s_setprio(0); } while (0)
#define PG8_WAIT_V(n) asm volatile("s_waitcnt vmcnt(" #n ")" ::: "memory")
#define PG8_WAIT_L(n) asm volatile("s_waitcnt lgkmcnt(" #n ")" ::: "memory")
#define PG8_BAR __builtin_amdgcn_s_barrier()
#define PG8_SCHED __builtin_amdgcn_sched_barrier(0)
    Unit cur, nxt; int ui = 0;
    if (!S.next(0, cur)) return;
    f32x4 acc[2][2][4][2];
#pragma unroll
    for (int a = 0; a < 2; ++a)
#pragma unroll
        for (int b = 0; b < 2; ++b)
#pragma unroll
            for (int m = 0; m < 4; ++m)
#pragma unroll
                for (int n = 0; n < 2; ++n) acc[a][b][m][n] = (f32x4){0.f, 0.f, 0.f, 0.f};
    typedef int v8i __attribute__((ext_vector_type(8)));
    v8i At[4], B0[2], B1[2];
    const int f8scale = 0x7f7f7f7f;
    unsigned vAc[2][2], vAn[2][2];
    S.a_offsets(cur, Rp, Cp, vAc);
    const char* cB = S.b_ptr(cur);
    PG8_STAGEB(PG8_SB(0, 0), cB); PG8_STAGEB(PG8_SB(0, 1), cB + hstep); PG8_STAGE(PG8_SA(0, 0), Abase, vAc[0]); PG8_STAGE(PG8_SA(0, 1), Abase, vAc[1]);
    if (wr == 1) PG8_BAR;
    PG8_WAIT_V(2); PG8_BAR;
    PG8_STAGEB(PG8_SB(1, 0), cB + kstep); PG8_STAGE(PG8_SA(1, 0), Abase + kstep, vAc[0]); PG8_STAGEB(PG8_SB(1, 1), cB + hstep + kstep);
    PG8_WAIT_V(6); PG8_BAR;
    for (;;) {
        const bool has_next = S.next(ui + 1, nxt);
        const char* nB = has_next ? S.b_ptr(nxt) : cB;
        if (has_next) S.a_offsets(nxt, Rp, Cp, vAn);
        else {
#pragma unroll
            for (int h = 0; h < 2; ++h)
#pragma unroll
                for (int i = 0; i < 2; ++i) vAn[h][i] = vAc[h][i]; }
#pragma unroll 1
        for (int t = 0; t < nt; t += 2) {
            const bool last = (t == nt - 2);
            const char* a1 = Abase + (size_t)(t + 1) * kstep;
            const char* a2 = last ? Abase : Abase + (size_t)(t + 2) * kstep; const char* b2 = last ? nB : cB + (size_t)(t + 2) * kstep;
            const char* a3 = a2 + kstep; const char* b3 = b2 + kstep;
            unsigned v2[2][2];
#pragma unroll
            for (int h = 0; h < 2; ++h)
#pragma unroll
                for (int i = 0; i < 2; ++i) v2[h][i] = last ? vAn[h][i] : vAc[h][i];
            PG8_LDB(B0, 0, 0); PG8_LDB(B1, 0, 1); PG8_SCHED; PG8_LDA(At, 0, 0); PG8_STAGE(PG8_SA(1, 1), a1, vAc[1]);
            PG8_WAIT_V(8); PG8_WAIT_L(0); PG8_BAR; PG8_MMA(0, 0, At, B0); PG8_MMA(0, 1, At, B1); PG8_BAR; PG8_SCHED;
            PG8_LDA(At, 0, 1); PG8_STAGEB(PG8_SB(0, 0), b2); PG8_STAGEB(PG8_SB(0, 1), b2 + hstep); PG8_STAGE(PG8_SA(0, 0), a2, v2[0]);
            PG8_WAIT_V(8); PG8_WAIT_L(0); PG8_BAR; PG8_MMA(1, 0, At, B0); PG8_MMA(1, 1, At, B1); PG8_BAR; PG8_SCHED;
            PG8_LDB(B0, 1, 0); PG8_LDB(B1, 1, 1); PG8_SCHED; PG8_LDA(At, 1, 0); PG8_STAGE(PG8_SA(0, 1), a2, v2[1]);
            PG8_WAIT_V(8); PG8_WAIT_L(0); PG8_BAR; PG8_MMA(0, 0, At, B0); PG8_MMA(0, 1, At, B1); PG8_BAR; PG8_SCHED;
            PG8_LDA(At, 1, 1); PG8_STAGEB(PG8_SB(1, 0), b3); PG8_STAGEB(PG8_SB(1, 1), b3 + hstep); PG8_STAGE(PG8_SA(1, 0), a3, v2[0]);
            PG8_WAIT_V(8); PG8_WAIT_L(0); PG8_BAR; PG8_MMA(1, 0, At, B0); PG8_MMA(1, 1, At, B1); PG8_BAR; PG8_SCHED;
        }
        if constexpr (ALIGN_EPI) { if (wr == 0) PG8_BAR; }
        E(acc, cur, wr, wc, fr, fq);
        if (!has_next) break;
#pragma unroll
        for (int a = 0; a < 2; ++a)
#pragma unroll
            for (int b = 0; b < 2; ++b)
#pragma unroll
                for (int m = 0; m < 4; ++m)
#pragma unroll
                    for (int n = 0; n < 2; ++n) acc[a][b][m][n] = (f32x4){0.f, 0.f, 0.f, 0.f};
        cur = nxt; cB = nB; ++ui;
#pragma unroll
        for (int h = 0; h < 2; ++h)
#pragma unroll
            for (int i = 0; i < 2; ++i) vAc[h][i] = vAn[h][i];
        if constexpr (ALIGN_EPI) { if (wr == 1) PG8_BAR; }
    }
    PG8_WAIT_V(0);
    if constexpr (!ALIGN_EPI) { if (wr == 0) PG8_BAR; }
    PG8_BAR;
#undef PG8_SA
#undef PG8_SB
#undef PG8_STAGE
#undef PG8_STAGEB
#undef PG8_LDA
#undef PG8_LDB
#undef PG8_MMA
#undef PG8_WAIT_V
#undef PG8_WAIT_L
#undef PG8_BAR
#undef PG8_SCHED
}
template <class Epi, class Sched, bool ALIGN_EPI>
__device__ __forceinline__ void gemm_phase_f8(LAS unsigned char* lds, const char* Abase, const int K, const Sched& S, const Epi& E) {
    const int tid = tidx(), wid = __builtin_amdgcn_readfirstlane(tid >> 6), lane = tid & 63, wr = wid >> 2, wc = wid & 3, fr = lane & 15, fq = lane >> 4;
    const int nt = K / 128;
    int Rp[1], Cp[1]; unsigned voffB[1], voffA[1];
#pragma unroll
    for (int i = 0; i < 1; ++i) { stage_rc(tid * 16 + i * 8192, Rp[i], Cp[i]); const int Rb = Epi::PERM ? ((Rp[i] & ~31) + perm32(Rp[i] & 31)) : Rp[i]; voffB[i] = (unsigned)(Rb * K + 2 * Cp[i]); voffA[i] = (unsigned)(Rp[i] * K + 2 * Cp[i]); }
    const size_t kstep = (size_t)(BK * 2);
    const size_t hstep = (size_t)HALF * K;
    const unsigned ldsw = (unsigned)wid * 1024u;
    const int aoff0 = lds_byte(wr * 64 + fr, 16 * (fq & 1)) + (fq >> 1) * 1024, boff0 = lds_byte(wc * 32 + fr, 16 * (fq & 1)) + (fq >> 1) * 1024;
#define PG8_SA(b, h) (((b) * 2 + (h)) * HTB)
#define PG8_SB(b, h) ((4 + (b) * 2 + (h)) * HTB)
#define PG8_STAGE(bufoff, gbase, voff) do { _Pragma("unroll") for (int _i = 0; _i < 2; ++_i) \
        __builtin_amdgcn_global_load_lds((const unsigned*)((const char*)(gbase) + (size_t)_i * 64 * K + (voff)[0]), (LAS unsigned*)(lds + (bufoff) + ldsw + _i * 8192), 16, 0, 0); } while (0)
#define PG8_LDA(dst, b, h) do { _Pragma("unroll") for (int m = 0; m < 4; ++m) { const u32x4 lo_ = *(const LAS u32x4*)(lds + PG8_SA(b, h) + aoff0 + m * 2048), hi_ = *(const LAS u32x4*)(lds + PG8_SA(b, h) + aoff0 + 16 + m * 2048); \
        dst[m] = (v8i){(int)lo_.x, (int)lo_.y, (int)lo_.z, (int)lo_.w, (int)hi_.x, (int)hi_.y, (int)hi_.z, (int)hi_.w}; } } while (0)
#define PG8_LDB(dst, b, h) do { _Pragma("unroll") for (int n = 0; n < 2; ++n) { const u32x4 lo_ = *(const LAS u32x4*)(lds + PG8_SB(b, h) + boff0 + n * 2048), hi_ = *(const LAS u32x4*)(lds + PG8_SB(b, h) + boff0 + 16 + n * 2048); \
        dst[n] = (v8i){(int)lo_.x, (int)lo_.y, (int)lo_.z, (int)lo_.w, (int)hi_.x, (int)hi_.y, (int)hi_.z, (int)hi_.w}; } } while (0)
#define PG8_MMA(ai, bj, At, Bt) do { __builtin_amdgcn_s_setprio(1); _Pragma("unroll") for (int m = 0; m < 4; ++m) _Pragma("unroll") for (int n = 0; n < 2; ++n) \
        asm volatile("v_mfma_scale_f32_16x16x128_f8f6f4 %0, %1, %2, %0, %3, %3 op_sel_hi:[0,0,0]" : "+v"(acc[ai][bj][m][n]) : "v"(Bt[n]), "v"(At[m]), "v"(f8scale)); __builtin_amdgcn_s_setprio(0); } while (0)
#define PG8_WAIT_V(n) asm volatile("s_waitcnt vmcnt(" #n ")" ::: "memory")
#define PG8_WAIT_L(n) asm volatile("s_waitcnt lgkmcnt(" #n ")" ::: "memory")
#define PG8_BAR __builtin_amdgcn_s_barrier()
#define PG8_SCHED __builtin_amdgcn_sched_barrier(0)
    Unit cur, nxt; int ui = 0;
    if (!S.next(0, cur)) return;
    f32x4 acc[2][2][4][2];
#pragma unroll
    for (int a = 0; a < 2; ++a)
#pragma unroll
        for (int b = 0; b < 2; ++b)
#pragma unroll
            for (int m = 0; m < 4; ++m)
#pragma unroll
                for (int n = 0; n < 2; ++n) acc[a][b][m][n] = (f32x4){0.f, 0.f, 0.f, 0.f};
    typedef int v8i __attribute__((ext_vector_type(8)));
    v8i At[4], B0[2], B1[2];
    const int f8scale = 0x7f7f7f7f;
    const char* cA = S.a_ptr(cur, Abase);
    const char* cB = S.b_ptr(cur);
    PG8_STAGE(PG8_SB(0, 0), cB, voffB); PG8_STAGE(PG8_SB(0, 1), cB + hstep, voffB); PG8_STAGE(PG8_SA(0, 0), cA, voffA); PG8_STAGE(PG8_SA(0, 1), cA + hstep, voffA);
    if (wr == 1) PG8_BAR;
    PG8_WAIT_V(2); PG8_BAR;
    PG8_STAGE(PG8_SB(1, 0), cB + kstep, voffB); PG8_STAGE(PG8_SA(1, 0), cA + kstep, voffA); PG8_STAGE(PG8_SB(1, 1), cB + hstep + kstep, voffB);
    PG8_WAIT_V(6); PG8_BAR;
    for (;;) {
        const bool has_next = S.next(ui + 1, nxt);
        const char* nB = has_next ? S.b_ptr(nxt) : cB; const char* nA = has_next ? S.a_ptr(nxt, Abase) : cA;
#pragma unroll 1
        for (int t = 0; t < nt; t += 2) {
            const bool last = (t == nt - 2);
            const char* a1 = cA + (size_t)(t + 1) * kstep;
            const char* a2 = last ? nA : cA + (size_t)(t + 2) * kstep; const char* b2 = last ? nB : cB + (size_t)(t + 2) * kstep;
            const char* a3 = a2 + kstep; const char* b3 = b2 + kstep;
            PG8_LDB(B0, 0, 0); PG8_LDB(B1, 0, 1); PG8_SCHED; PG8_LDA(At, 0, 0); PG8_STAGE(PG8_SA(1, 1), a1 + hstep, voffA);
            PG8_WAIT_V(8); PG8_WAIT_L(0); PG8_BAR; PG8_MMA(0, 0, At, B0); PG8_MMA(0, 1, At, B1); PG8_BAR; PG8_SCHED;
            PG8_LDA(At, 0, 1); PG8_STAGE(PG8_SB(0, 0), b2, voffB); PG8_STAGE(PG8_SB(0, 1), b2 + hstep, voffB); PG8_STAGE(PG8_SA(0, 0), a2, voffA);
            PG8_WAIT_V(8); PG8_WAIT_L(0); PG8_BAR; PG8_MMA(1, 0, At, B0); PG8_MMA(1, 1, At, B1); PG8_BAR; PG8_SCHED;
            PG8_LDB(B0, 1, 0); PG8_LDB(B1, 1, 1); PG8_SCHED; PG8_LDA(At, 1, 0); PG8_STAGE(PG8_SA(0, 1), a2 + hstep, voffA);
            PG8_WAIT_V(8); PG8_WAIT_L(0); PG8_BAR; PG8_MMA(0, 0, At, B0); PG8_MMA(0, 1, At, B1); PG8_BAR; PG8_SCHED;
            PG8_LDA(At, 1, 1); PG8_STAGE(PG8_SB(1, 0), b3, voffB); PG8_STAGE(PG8_SB(1, 1), b3 + hstep, voffB); PG8_STAGE(PG8_SA(1, 0), a3, voffA);
            PG8_WAIT_V(8); PG8_WAIT_L(0); PG8_BAR; PG8_MMA(1, 0, At, B0); PG8_MMA(1, 1, At, B1); PG8_BAR; PG8_SCHED;
        }
        if constexpr (ALIGN_EPI) { if (wr == 0) PG8_BAR; }
        E(acc, cur, wr, wc, fr, fq);
        if (!has_next) break;
#pragma unroll
        for (int a = 0; a < 2; ++a)
#pragma unroll
            for (int b = 0; b < 2; ++b)
#pragma unroll
                for (int m = 0; m < 4; ++m)
#pragma unroll
                    for (int n = 0; n < 2; ++n) acc[a][b][m][n] = (f32x4){0.f, 0.f, 0.f, 0.f};
        cur = nxt; cB = nB; cA = nA; ++ui;
        if constexpr (ALIGN_EPI) { if (wr == 1) PG8_BAR; }
    }
    PG8_WAIT_V(0);
    if constexpr (!ALIGN_EPI) { if (wr == 0) PG8_BAR; }
    PG8_BAR;
#undef PG8_SA
#undef PG8_SB
#undef PG8_STAGE
#undef PG8_LDA
#undef PG8_LDB
#undef PG8_MMA
#undef PG8_WAIT_V
#undef PG8_WAIT_L
#undef PG8_BAR
#undef PG8_SCHED
}
}

struct Args { const float* in[39]; float* out; unsigned char* ws; int ph_lo, ph_hi; };
typedef const __attribute__((address_space(4))) Args CArgs;
enum { I_X = 0, I_C, I_CTX, I_CCTX, I_WADA, I_BADA, I_WIN, I_HYCW, I_HYCB, I_HYW1, I_HYB1, I_HYW2, I_HYB2, I_HYW3, I_HYB3, I_HYW4, I_HYFREQ, I_HYD, I_SCCW,
       I_GLAWA, I_GLABA, I_GLANW, I_GDNCW, I_GDNALOG, I_GDNDT, I_GDNNW, I_WOUT, I_LN1G, I_LN1B, I_WR, I_BR, I_WG, I_BG, I_WU, I_BU, I_WD, I_BD, I_LN2G, I_LN2B };

__device__ __forceinline__ int row_batch(int row) { return row < NTOK_C ? (row >> 8) : ((row - NTOK_C) >> 11); }
__device__ __forceinline__ int mod_vec(int row) { return row < NTOK_C ? 16 : ((row - NTOK_C) >> 11); }

__device__ __forceinline__ void ph_mod(CArgs& a, LAS unsigned char* lds, int bid, int nblk) {
    LAS float* sc = (LAS float*)lds; LAS float* red = (LAS float*)(lds + 17 * 1024 * 4);
    const int tid = tidx(), lane = tid & 63, w = tid >> 6;
    const float* c = a.in[I_C]; const float* cc = a.in[I_CCTX];
    for (int i = tid; i < 17 * 1024; i += 512) { const float v = i < 16 * 1024 ? c[i] : cc[i - 16 * 1024]; sc[i] = siluf_(v); }
    __syncthreads();
    float* MOD = (float*)(a.ws + WS_MOD);
    for (int it = bid; it < DEPTH * 96; it += nblk) {
        const int l = it / 96, j0 = (it % 96) * 64;
        const float* W = a.in[I_WADA] + (size_t)l * 1024 * 6144 + j0 + lane;
        float acc[17];
#pragma unroll
        for (int v = 0; v < 17; ++v) acc[v] = 0.f;
#pragma unroll 16
        for (int kk = 0; kk < 128; ++kk) { const int k = w * 128 + kk; const float wv = W[(size_t)k * 6144];
#pragma unroll
            for (int v = 0; v < 17; ++v) acc[v] += sc[v * 1024 + k] * wv; }
#pragma unroll
        for (int v = 0; v < 17; ++v) red[(w * 17 + v) * 64 + lane] = acc[v];
        __syncthreads();
        for (int o = tid; o < 17 * 64; o += 512) { const int v = o >> 6, jj = o & 63; float s = 0.f;
#pragma unroll
            for (int ww = 0; ww < 8; ++ww) s += red[(ww * 17 + v) * 64 + jj];
            MOD[(size_t)(l * 17 + v) * 6144 + j0 + jj] = s + a.in[I_BADA][l * 6144 + j0 + jj]; }
        __syncthreads();
    }
}

__device__ __forceinline__ void ph_filters(CArgs& a, int gw, int ngw) {
    const int lane = tidx() & 63;
    float* KUN = (float*)(a.ws + WS_KUN);
#pragma unroll 1
    for (int it = gw; it < DEPTH * (CTXL + SEQ) / 4; it += ngw) {
        const int l = it / ((CTXL + SEQ) / 4), r = (it % ((CTXL + SEQ) / 4)) * 4, Lt = r < CTXL ? 0 : 1, pos0 = Lt ? r - CTXL : r, L = Lt ? SEQ : CTXL;
        float z[4], tn[4];
#pragma unroll
        for (int p = 0; p < 4; ++p) { const int pos = pos0 + p; tn[p] = (float)pos / (float)(L - 1); z[p] = 0.f;
            if (lane == 0) z[p] = tn[p];
            else if (lane <= 32) { const int j = (lane - 1) & 15; const float fj = 1e-4f + (float)j * ((15.f - 1e-4f) / 15.f);
                double rev = (double)fj * (double)pos / (double)L; rev -= floor(rev); const float rf = (float)rev;
                z[p] = lane <= 16 ? sin_rev(rf + 0.25f) : -sin_rev(rf); } }
        const float* w1 = a.in[I_HYW1] + l * 33 * 64; const float* w2 = a.in[I_HYW2] + l * 64 * 64; const float* w3 = a.in[I_HYW3] + l * 64 * 64; const float* w4 = a.in[I_HYW4] + l * 64 * 512;
        const float* fq = a.in[I_HYFREQ] + l * 3 * 64;
        float s[4], h[4];
        { const float bb = a.in[I_HYB1][l * 64 + lane];
#pragma unroll
          for (int p = 0; p < 4; ++p) s[p] = bb; }
#pragma unroll
        for (int i = 0; i < 33; ++i) { const float ww = w1[i * 64 + lane];
#pragma unroll
            for (int p = 0; p < 4; ++p) s[p] += rdlane_f(z[p], i) * ww; }
#pragma unroll
        for (int p = 0; p < 4; ++p) h[p] = sin_rad(fq[lane] * s[p]);
        { const float bb = a.in[I_HYB2][l * 64 + lane];
#pragma unroll
          for (int p = 0; p < 4; ++p) s[p] = bb; }
#pragma unroll 16
        for (int i = 0; i < 64; ++i) { const float ww = w2[i * 64 + lane];
#pragma unroll
            for (int p = 0; p < 4; ++p) s[p] += rdlane_f(h[p], i) * ww; }
#pragma unroll
        for (int p = 0; p < 4; ++p) h[p] = sin_rad(fq[64 + lane] * s[p]);
        { const float bb = a.in[I_HYB3][l * 64 + lane];
#pragma unroll
          for (int p = 0; p < 4; ++p) s[p] = bb; }
#pragma unroll 16
        for (int i = 0; i < 64; ++i) { const float ww = w3[i * 64 + lane];
#pragma unroll
            for (int p = 0; p < 4; ++p) s[p] += rdlane_f(h[p], i) * ww; }
#pragma unroll
        for (int p = 0; p < 4; ++p) h[p] = sin_rad(fq[128 + lane] * s[p]);
        float k[8][4];
#pragma unroll
        for (int m = 0; m < 8; ++m)
#pragma unroll
            for (int p = 0; p < 4; ++p) k[m][p] = 0.f;
#pragma unroll 4
        for (int i = 0; i < 64; ++i) { float hi[4];
#pragma unroll
            for (int p = 0; p < 4; ++p) hi[p] = rdlane_f(h[p], i);
#pragma unroll
            for (int m = 0; m < 8; ++m) { const float ww = w4[i * 512 + m * 64 + lane];
#pragma unroll
                for (int p = 0; p < 4; ++p) k[m][p] += hi[p] * ww; } }
#pragma unroll
        for (int m = 0; m < 8; ++m) { const int o = m * 64 + lane, ch = o & 255;
            const float delta = 3.0701134573253944f + (float)ch * ((15.350567286626972f - 3.0701134573253944f) / 255.f);
            *(f32x4*)(KUN + ((size_t)((l * 2 + Lt) * 512 + o)) * 2048 + pos0) = (f32x4){k[m][0] * __expf(-tn[0] * delta), k[m][1] * __expf(-tn[1] * delta), k[m][2] * __expf(-tn[2] * delta), k[m][3] * __expf(-tn[3] * delta)}; }
    }
}

__device__ __forceinline__ void ph_router_w(CArgs& a, int gt, int ngt) {
    bf16* hi = (bf16*)(a.ws + WS_WRT); bf16* lo = hi + DEPTH * NEXP * D;
    for (int i = gt; i < DEPTH * NEXP * D; i += ngt) { const int l = i / (NEXP * D), r = i % (NEXP * D), e = r / D, k = r % D;
        const float w = a.in[I_WR][((size_t)l * D + k) * NEXP + e]; const unsigned h = f2bf(w); hi[i] = (bf16)h; lo[i] = (bf16)f2bf(w - bf2f(h)); }
}
__device__ __forceinline__ void tr_item(const float* W, int Nsrc, int K, bf16* WTrow0, int n0, int k0, LAS float* scr, int lane) {
    const int c4 = (lane & 7) * 4; const bool ok = n0 + c4 < Nsrc;
    f32x4 t[8];
#pragma unroll
    for (int j = 0; j < 8; ++j) { const int kk = 8 * j + (lane >> 3); t[j] = ok ? *(const f32x4*)(W + (size_t)(k0 + kk) * Nsrc + n0 + c4) : (f32x4){0.f, 0.f, 0.f, 0.f}; }
#pragma unroll
    for (int j = 0; j < 8; ++j) { const int kk = 8 * j + (lane >> 3); LAS float* d = scr + kk * 33 + c4; d[0] = t[j][0]; d[1] = t[j][1]; d[2] = t[j][2]; d[3] = t[j][3]; }
    asm volatile("s_waitcnt lgkmcnt(0)" ::: "memory");
    const int c = lane & 7;
#pragma unroll
    for (int j = 0; j < 4; ++j) { const int n = (lane >> 3) + 8 * j; const LAS float* s = scr + (8 * c) * 33 + n;
        u32x4 o; o.x = pk2(s[0 * 33], s[1 * 33]); o.y = pk2(s[2 * 33], s[3 * 33]); o.z = pk2(s[4 * 33], s[5 * 33]); o.w = pk2(s[6 * 33], s[7 * 33]);
        *(u32x4*)(WTrow0 + (size_t)n * K + k0 + 8 * c) = o; }
    asm volatile("s_waitcnt lgkmcnt(0)" ::: "memory");
}
__device__ __forceinline__ void tr_item_f8(const float* W, int Nsrc, int K, unsigned char* WTrow0, int n0, int k0, float scale, LAS float* scr, int lane) {
    const int c4 = (lane & 7) * 4;
    f32x4 t[8];
#pragma unroll
    for (int j = 0; j < 8; ++j) { const int kk = 8 * j + (lane >> 3); t[j] = *(const f32x4*)(W + (size_t)(k0 + kk) * Nsrc + n0 + c4); }
#pragma unroll
    for (int j = 0; j < 8; ++j) { const int kk = 8 * j + (lane >> 3); LAS float* d = scr + kk * 33 + c4; d[0] = t[j][0]; d[1] = t[j][1]; d[2] = t[j][2]; d[3] = t[j][3]; }
    asm volatile("s_waitcnt lgkmcnt(0)" ::: "memory");
    const int n = lane >> 1, half = lane & 1; const LAS float* s = scr + (32 * half) * 33 + n;
    unsigned o[8];
#pragma unroll
    for (int i = 0; i < 8; ++i) o[i] = pk4_fp8(s[(4 * i) * 33] * scale, s[(4 * i + 1) * 33] * scale, s[(4 * i + 2) * 33] * scale, s[(4 * i + 3) * 33] * scale);
    unsigned char* dst = WTrow0 + (size_t)n * K + k0 + 32 * half;
    *(u32x4*)dst = (u32x4){o[0], o[1], o[2], o[3]}; *(u32x4*)(dst + 16) = (u32x4){o[4], o[5], o[6], o[7]};
    asm volatile("s_waitcnt lgkmcnt(0)" ::: "memory");
}
__device__ __forceinline__ void ph_tr_small(CArgs& a, LAS unsigned char* lds, int gw, int ngw) {
    const int lane = tidx() & 63, w = tidx() >> 6;
    LAS float* scr = (LAS float*)(lds + w * 8448);
    constexpr int I_IN = 16 * (D_INP / 32), I_OUT = 16 * 32;
    for (int it = gw; it < DEPTH * (I_IN + I_OUT); it += ngw) {
        const int l = it / (I_IN + I_OUT); int r = it % (I_IN + I_OUT);
        if (r < I_IN) { const int kb = r / (D_INP / 32), nb = r % (D_INP / 32);
            tr_item(a.in[I_WIN] + (size_t)l * 1024 * D_IN, D_IN, 1024, (bf16*)(a.ws + WS_WIN) + ((size_t)l * D_INP + nb * 32) * 1024, nb * 32, kb * 64, scr, lane); }
        else { r -= I_IN; const int kb = r / 32, nb = r % 32;
            tr_item(a.in[I_WOUT] + (size_t)l * 1024 * 1024, 1024, 1024, (bf16*)(a.ws + WS_WOUT) + ((size_t)l * 1024 + nb * 32) * 1024, nb * 32, kb * 64, scr, lane); }
    }
}
__device__ __forceinline__ void tr_experts_range(CArgs& a, int l, LAS unsigned char* scrb, int first, int last, int stride, int lane) {
    LAS float* scr = (LAS float*)scrb;
#pragma unroll 1
    for (int it = first; it < last; it += stride) {
        const int e = it / 1536, r = it % 1536, which = r / 512, q = r % 512, kb = q / 32, nb = q % 32, n0 = nb * 32;
        const float* W = a.in[which == 0 ? I_WG : (which == 1 ? I_WU : I_WD)] + ((size_t)(l * NEXP + e)) * 1024 * 1024;
        if (which == 2) tr_item_f8(W, 1024, 1024, a.ws + WS_WD + ((size_t)e * 1024 + n0) * 1024, n0, kb * 64, 32.f, scr, lane);
        else tr_item_f8(W, 1024, 1024, a.ws + WS_WGU + ((size_t)e * 2048 + (n0 >> 7) * 256 + which * 128 + (n0 & 127)) * 1024, n0, kb * 64, 32.f, scr, lane);
    }
}
__device__ __forceinline__ void ph_mod_input(CArgs& a, int gw, int ngw) {
    const int lane = tidx() & 63;
    const float* MOD = (const float*)(a.ws + WS_MOD);
    bf16* HB = (bf16*)(a.ws + WS_HB);
    for (int row = gw; row < NTOK; row += ngw) {
        const float* src = row < NTOK_C ? a.in[I_CTX] + (size_t)row * D : a.in[I_X] + (size_t)(row - NTOK_C) * D;
        const float* mv = MOD + (size_t)mod_vec(row) * 6144;
#pragma unroll
        for (int j = 0; j < 4; ++j) { const int c0 = j * 256 + lane * 4; const f32x4 x = *(const f32x4*)(src + c0), sh = *(const f32x4*)(mv + c0), sc = *(const f32x4*)(mv + 1024 + c0);
            u32x2 o; o.x = pk2(x[0] * (1.f + sc[0]) + sh[0], x[1] * (1.f + sc[1]) + sh[1]); o.y = pk2(x[2] * (1.f + sc[2]) + sh[2], x[3] * (1.f + sc[3]) + sh[3]);
            *(u32x2*)(HB + (size_t)row * D + c0) = o; }
    }
}

struct Chunk { int b, t0, L, row0, lo, hi; };
__device__ __forceinline__ Chunk chunk_of(int it) {
    Chunk c;
    if (it < 64) { c.b = it >> 2; c.t0 = (it & 3) * 64; c.L = CTXL; c.row0 = c.b * CTXL + c.t0; c.lo = 0; c.hi = CTXL; }
    else { const int r = it - 64; c.b = r >> 5; c.t0 = (r & 31) * 64; c.L = SEQ; c.row0 = NTOK_C + c.b * SEQ + c.t0; c.lo = c.t0; c.hi = c.t0 + 64; }
    return c;
}
__device__ __forceinline__ f32x4 bf4(u32x2 v) { return (f32x4){lo_bf(v.x), hi_bf(v.x), lo_bf(v.y), hi_bf(v.y)}; }
__device__ __forceinline__ void ph_prep_conv(CArgs& a, int l, LAS unsigned char* lds, int bid, int nblk) {
    const bf16* P = (const bf16*)(a.ws + WS_P);
    bf16* ZT = (bf16*)(a.ws + WS_MIX + MX_ZT); bf16* YMIX = (bf16*)(a.ws + WS_YMIX);
    LAS bf16* zt = (LAS bf16*)lds;
    const int tid = tidx(), c4 = (tid & 63) * 4, tg = tid >> 6;
    const float* hw = a.in[I_HYCW] + l * 3 * 768; const float* hb = a.in[I_HYCB] + l * 768; const float* sw = a.in[I_SCCW] + l * 3 * 256;
    f32x4 wx[3], wv[3], ws3[3];
#pragma unroll
    for (int k = 0; k < 3; ++k) { wx[k] = *(const f32x4*)(hw + k * 768 + 256 + c4); wv[k] = *(const f32x4*)(hw + k * 768 + 512 + c4); ws3[k] = *(const f32x4*)(sw + k * 256 + c4); }
    const f32x4 bx = *(const f32x4*)(hb + 256 + c4), bv = *(const f32x4*)(hb + 512 + c4);
#pragma unroll 1
    for (int it = bid; it < 576; it += nblk) {
        const Chunk c = chunk_of(it);
        const int tb = c.t0 + tg * 8;
        const bf16* pb = P + (size_t)(c.row0 + tg * 8) * D_INP;
        f32x4 x1[10], vv[10], mm[10];
#pragma unroll
        for (int r = 0; r < 10; ++r) { const int t = tb + r - 1, tc = min(max(t, c.lo), c.hi - 1); const float ok = (t == tc) ? 1.f : 0.f; const bf16* p = pb + (ptrdiff_t)(tc - tb) * D_INP;
            x1[r] = ok * bf4(*(const u32x2*)(p + HY0 + 256 + c4)); vv[r] = ok * bf4(*(const u32x2*)(p + HY0 + 512 + c4));
            mm[r] = ok * bf4(*(const u32x2*)(p + SC0 + 256 + c4)) * bf4(*(const u32x2*)(p + SC0 + 512 + c4)); }
#pragma unroll
        for (int tt = 0; tt < 8; ++tt) {
            const f32x4 xx = wx[0] * x1[tt] + wx[1] * x1[tt + 1] + wx[2] * x1[tt + 2] + bx, v2 = wv[0] * vv[tt] + wv[1] * vv[tt + 1] + wv[2] * vv[tt + 2] + bv, z = xx * v2;
            u32x2 zo; zo.x = pk2(z[0], z[1]); zo.y = pk2(z[2], z[3]); *(LAS u32x2*)(zt + (tg * 8 + tt) * 264 + c4) = zo;
            const f32x4 bg = bf4(*(const u32x2*)(pb + (size_t)tt * D_INP + SC0 + c4));
            const f32x4 y = bg * (ws3[0] * mm[tt] + ws3[1] * mm[tt + 1] + ws3[2] * mm[tt + 2]);
            u32x2 yo; yo.x = pk2(y[0], y[1]); yo.y = pk2(y[2], y[3]); *(u32x2*)(YMIX + (size_t)(c.row0 + tg * 8 + tt) * D + 256 + c4) = yo;
        }
        __syncthreads();
        { const int ch = tid & 255, g0 = (tid >> 8) * 4;
          const int soff = c.L == CTXL ? 0 : CTXL;
#pragma unroll
          for (int g = 0; g < 4; ++g) { const int t8 = (g0 + g) * 8; unsigned short e[8];
#pragma unroll
              for (int j = 0; j < 8; ++j) e[j] = zt[(t8 + j) * 264 + ch];
              u32x4 o; o.x = e[0] | ((unsigned)e[1] << 16); o.y = e[2] | ((unsigned)e[3] << 16); o.z = e[4] | ((unsigned)e[5] << 16); o.w = e[6] | ((unsigned)e[7] << 16);
              *(u32x4*)(ZT + ((size_t)(ch * 16 + c.b)) * 2304 + soff + c.t0 + t8) = o; } }
        __syncthreads();
    }
}
__device__ __forceinline__ void ph_prep_tok(CArgs& a, int l, LAS unsigned char* lds, int gw, int ngw) {
    const int tid = tidx(), lane = tid & 63;
    const bf16* P = (const bf16*)(a.ws + WS_P);
    float* GDF = (float*)(a.ws + WS_MIX + MX_GDF); float* GDB = (float*)(a.ws + WS_MIX + MX_GDB);
    float* DQ = (float*)(a.ws + WS_MIX + MX_DQ); float* DK = (float*)(a.ws + WS_MIX + MX_DK); float* DV = (float*)(a.ws + WS_MIX + MX_DV); float* DG = (float*)(a.ws + WS_MIX + MX_DG);
    LAS float* swa = (LAS float*)(lds + 40960);
    LAS float* sba = swa + 4096;
    LAS float* scw = sba + 256;
    { const float* wa = a.in[I_GLAWA] + l * 2 * 16 * 128; const float* ba = a.in[I_GLABA] + l * 2 * 128; const float* cw = a.in[I_GDNCW] + l * 3 * 768;
      for (int i = tid; i < 4096; i += 512) swa[i] = wa[i];
      if (tid < 256) sba[tid] = ba[tid];
      for (int i = tid; i < 2304; i += 512) scw[i] = cw[i]; }
    const int gh = lane & 3, gr = (lane >> 2) & 3;
    const float eaf = -__expf(a.in[I_GDNALOG][l * 8 + gh]), eab = -__expf(a.in[I_GDNALOG][l * 8 + 4 + gh]), dtf = a.in[I_GDNDT][l * 8 + gh], dtb = a.in[I_GDNDT][l * 8 + 4 + gh];
    __syncthreads();
#pragma unroll 1
    for (int row0 = gw * 4; row0 < NTOK; row0 += ngw * 4) {
        int z = 0; asm volatile("" : "+v"(z));
        const LAS float* wa = swa + z; const LAS float* cw = scw + z;
        const bf16* pr0 = P + (size_t)row0 * D_INP;
        int tpos, lo, hi;
        if (row0 < NTOK_C) { tpos = row0 & 255; lo = 0; hi = CTXL; } else { tpos = (row0 - NTOK_C) & 2047; lo = tpos & ~63; hi = lo + 64; }
        bf16 avb[4]; u32x2 xr[3][6]; bf16 gb4[4];
#pragma unroll
        for (int r = 0; r < 4; ++r) avb[r] = pr0[(size_t)r * D_INP + GLA0 + 768 + (lane & 31)];
#pragma unroll
        for (int g = 0; g < 3; ++g)
#pragma unroll
            for (int r = 0; r < 6; ++r) { const int tc = min(max(tpos + r - 1, lo), hi - 1); xr[g][r] = *(const u32x2*)(pr0 + (ptrdiff_t)(tc - tpos) * D_INP + GDN0 + g * 256 + 4 * lane); }
#pragma unroll
        for (int i = 0; i < 4; ++i) gb4[i] = pr0[(size_t)gr * D_INP + GDN0 + 1024 + 4 * i + gh];
        float av[4], s[4][4];
#pragma unroll
        for (int r = 0; r < 4; ++r) { av[r] = bf2f(avb[r]); s[r][0] = sba[lane]; s[r][1] = sba[64 + lane]; s[r][2] = sba[128 + lane]; s[r][3] = sba[192 + lane]; }
#pragma unroll
        for (int i = 0; i < 16; ++i) { const float w0 = wa[i * 128 + lane], w1 = wa[i * 128 + 64 + lane], w2 = wa[2048 + i * 128 + lane], w3 = wa[2048 + i * 128 + 64 + lane];
#pragma unroll
            for (int r = 0; r < 4; ++r) { const float af = rdlane_f(av[r], i), ab = rdlane_f(av[r], 16 + i); s[r][0] += af * w0; s[r][1] += af * w1; s[r][2] += ab * w2; s[r][3] += ab * w3; } }
#pragma unroll
        for (int r = 0; r < 4; ++r) { const size_t o = (size_t)(row0 + r) * 128;
            GDF[o + lane] = logsigmoidf_(s[r][0]) * 0.0625f; GDF[o + 64 + lane] = logsigmoidf_(s[r][1]) * 0.0625f;
            GDB[o + lane] = logsigmoidf_(s[r][2]) * 0.0625f; GDB[o + 64 + lane] = logsigmoidf_(s[r][3]) * 0.0625f; }
        float sq[4] = {0.f, 0.f, 0.f, 0.f}, sk[4] = {0.f, 0.f, 0.f, 0.f}; f32x4 qv[4], kv[4];
#pragma unroll
        for (int g = 0; g < 3; ++g) { const int col = g * 256 + 4 * lane;
            f32x4 x[6];
#pragma unroll
            for (int r = 0; r < 6; ++r) { const int t = tpos + r - 1; x[r] = (t >= lo && t < hi) ? bf4(xr[g][r]) : (f32x4){0.f, 0.f, 0.f, 0.f}; }
            const f32x4 w0 = *(const LAS f32x4*)(cw + col), w1 = *(const LAS f32x4*)(cw + 768 + col), w2 = *(const LAS f32x4*)(cw + 1536 + col);
#pragma unroll
            for (int r = 0; r < 4; ++r) { f32x4 y = w0 * x[r] + w1 * x[r + 1] + w2 * x[r + 2];
                y[0] = siluf_(y[0]); y[1] = siluf_(y[1]); y[2] = siluf_(y[2]); y[3] = siluf_(y[3]);
                if (g == 0) { qv[r] = y; sq[r] = (y[0] * y[0] + y[1] * y[1]) + (y[2] * y[2] + y[3] * y[3]); }
                else if (g == 1) { kv[r] = y; sk[r] = (y[0] * y[0] + y[1] * y[1]) + (y[2] * y[2] + y[3] * y[3]); }
                else *(f32x4*)(DV + (size_t)(row0 + r) * 256 + 4 * lane) = y; } }
#pragma unroll
        for (int r = 0; r < 4; ++r) { const float rq = rsqrtf(row16_sum(sq[r]) + 1e-6f) * 0.125f, rk = rsqrtf(row16_sum(sk[r]) + 1e-6f);
            const f32x4 qn = qv[r] * rq, kn = kv[r] * rk;
            *(f32x4*)(DQ + (size_t)(row0 + r) * 256 + 4 * lane) = qn; *(f32x4*)(DK + (size_t)(row0 + r) * 256 + 4 * lane) = kn;
            *(u32x2*)((bf16*)(a.ws + WS_CKD + CD_QB) + (size_t)(row0 + r) * 256 + 4 * lane) = (u32x2){pk2(qn[0], qn[1]), pk2(qn[2], qn[3])};
            *(u32x2*)((bf16*)(a.ws + WS_CKD + CD_KB) + (size_t)(row0 + r) * 256 + 4 * lane) = (u32x2){pk2(kn[0], kn[1]), pk2(kn[2], kn[3])}; }
        if (lane < 16) { const float af = bf2f(gb4[0]), ab = bf2f(gb4[1]), bfv = bf2f(gb4[2]), bbv = bf2f(gb4[3]);
            const float gf = eaf * softplusf_(af + dtf), gb = eab * softplusf_(ab + dtb);
            *(f32x4*)(DG + (size_t)(row0 + gr) * 16 + 4 * gh) = (f32x4){sigmoidf_(bfv), gf, sigmoidf_(bbv), gb}; }
    }
}

__device__ __forceinline__ int scan_row(int b, int dir, int n) {
    if (n < CTXL) return b * CTXL + (dir ? CTXL - 1 - n : n);
    const int m = n - CTXL; return NTOK_C + b * SEQ + (dir ? SEQ - 1 - m : m);
}
__device__ __forceinline__ void gla_chain(CArgs& a, int chain, LAS unsigned char* lds) {
    const int b = chain >> 3, h = (chain >> 1) & 3, dir = chain & 1;
    const int tid = tidx(), lane = tid & 63, w = tid >> 6, vv = lane & 7, kq = lane >> 3;
    const bf16* P = (const bf16*)(a.ws + WS_P);
    const float* GD = (const float*)(a.ws + WS_MIX + (dir ? MX_GDB : MX_GDF));
    float* GO = (float*)(a.ws + WS_MIX + (dir ? MX_GOB : MX_GOF));
    LAS float* sq = (LAS float*)lds;
    LAS float* sk = sq + 64 * 32;
    LAS float* sd = sk + 64 * 32;
    LAS float* sv = sd + 64 * 32;
    float S[4] = {0.f, 0.f, 0.f, 0.f};
    for (int ch = 0; ch < 36; ++ch) {
        { const int tt = tid >> 3, sub = tid & 7, row = scan_row(b, dir, ch * 64 + tt);
          const bf16* pr = P + (size_t)row * D_INP + GLA0;
          const u32x2 qv = *(const u32x2*)(pr + h * 32 + sub * 4), kv = *(const u32x2*)(pr + 128 + h * 32 + sub * 4);
          const f32x4 dv = *(const f32x4*)(GD + (size_t)row * 128 + h * 32 + sub * 4);
          const u32x4 vv8 = *(const u32x4*)(pr + 256 + h * 64 + sub * 8);
          const float qs = 0.17677669529663687f;
          *(LAS f32x4*)(sq + tt * 32 + sub * 4) = (f32x4){lo_bf(qv.x) * qs, hi_bf(qv.x) * qs, lo_bf(qv.y) * qs, hi_bf(qv.y) * qs};
          *(LAS f32x4*)(sk + tt * 32 + sub * 4) = (f32x4){lo_bf(kv.x), hi_bf(kv.x), lo_bf(kv.y), hi_bf(kv.y)};
          *(LAS f32x4*)(sd + tt * 32 + sub * 4) = dv;
          *(LAS f32x4*)(sv + tt * 64 + sub * 8) = (f32x4){lo_bf(vv8.x), hi_bf(vv8.x), lo_bf(vv8.y), hi_bf(vv8.y)};
          *(LAS f32x4*)(sv + tt * 64 + sub * 8 + 4) = (f32x4){lo_bf(vv8.z), hi_bf(vv8.z), lo_bf(vv8.w), hi_bf(vv8.w)}; }
        __syncthreads();
#pragma unroll 4
        for (int tt = 0; tt < 64; ++tt) {
            const f32x4 q4 = *(const LAS f32x4*)(sq + tt * 32 + kq * 4), k4 = *(const LAS f32x4*)(sk + tt * 32 + kq * 4), d4 = *(const LAS f32x4*)(sd + tt * 32 + kq * 4);
            const float v = sv[tt * 64 + w * 8 + vv];
            float o = 0.f;
#pragma unroll
            for (int j = 0; j < 4; ++j) { S[j] = d4[j] * S[j] + k4[j] * v; o += q4[j] * S[j]; }
            o += __shfl_xor(o, 8); o += __shfl_xor(o, 16); o += __shfl_xor(o, 32);
            if (kq == 0) GO[(size_t)scan_row(b, dir, ch * 64 + tt) * 256 + h * 64 + w * 8 + vv] = o;
        }
        __syncthreads();
    }
}
__device__ __forceinline__ void gdn_chain(CArgs& a, int chain, LAS unsigned char* lds) {
    const int b = chain >> 3, h = (chain >> 1) & 3, dir = chain & 1;
    const int tid = tidx(), lane = tid & 63, w = tid >> 6, vv = lane & 7, kq = lane >> 3;
    const float* DQ = (const float*)(a.ws + WS_MIX + MX_DQ); const float* DK = (const float*)(a.ws + WS_MIX + MX_DK); const float* DV = (const float*)(a.ws + WS_MIX + MX_DV);
    const float* DG = (const float*)(a.ws + WS_MIX + MX_DG);
    float* DO = (float*)(a.ws + WS_MIX + (dir ? MX_DOB : MX_DOF));
    LAS float* sq = (LAS float*)lds;
    LAS float* sk = sq + 64 * 64;
    LAS float* sv = sk + 64 * 64;
    LAS float* sg = sv + 64 * 64;
    float S[8];
#pragma unroll
    for (int j = 0; j < 8; ++j) S[j] = 0.f;
    for (int ch = 0; ch < 36; ++ch) {
        { const int tt = tid >> 3, sub = tid & 7, row = scan_row(b, dir, ch * 64 + tt);
          const size_t o = (size_t)row * 256 + h * 64 + sub * 8;
          *(LAS f32x4*)(sq + tt * 64 + sub * 8) = *(const f32x4*)(DQ + o); *(LAS f32x4*)(sq + tt * 64 + sub * 8 + 4) = *(const f32x4*)(DQ + o + 4);
          *(LAS f32x4*)(sk + tt * 64 + sub * 8) = *(const f32x4*)(DK + o); *(LAS f32x4*)(sk + tt * 64 + sub * 8 + 4) = *(const f32x4*)(DK + o + 4);
          *(LAS f32x4*)(sv + tt * 64 + sub * 8) = *(const f32x4*)(DV + o); *(LAS f32x4*)(sv + tt * 64 + sub * 8 + 4) = *(const f32x4*)(DV + o + 4);
          if (sub == 0) { const f32x4 g4 = *(const f32x4*)(DG + (size_t)row * 16 + h * 4); *(LAS f32x2*)(sg + tt * 2) = dir ? (f32x2){g4[2], g4[3]} : (f32x2){g4[0], g4[1]}; } }
        __syncthreads();
#pragma unroll 2
        for (int tt = 0; tt < 64; ++tt) {
            const f32x4 ka = *(const LAS f32x4*)(sk + tt * 64 + kq * 8), kb = *(const LAS f32x4*)(sk + tt * 64 + kq * 8 + 4);
            const f32x4 qa = *(const LAS f32x4*)(sq + tt * 64 + kq * 8), qb = *(const LAS f32x4*)(sq + tt * 64 + kq * 8 + 4);
            const float v = sv[tt * 64 + w * 8 + vv]; const f32x2 g2 = *(const LAS f32x2*)(sg + tt * 2);
            const float beta = g2.x, eg = g2.y;
            float ks = (ka[0] * S[0] + ka[1] * S[1]) + (ka[2] * S[2] + ka[3] * S[3]) + ((kb[0] * S[4] + kb[1] * S[5]) + (kb[2] * S[6] + kb[3] * S[7]));
            ks += __shfl_xor(ks, 8); ks += __shfl_xor(ks, 16); ks += __shfl_xor(ks, 32);
            const float wv = beta * (v - eg * ks);
            float o = 0.f;
#pragma unroll
            for (int j = 0; j < 4; ++j) { S[j] = eg * S[j] + ka[j] * wv; o += qa[j] * S[j]; }
#pragma unroll
            for (int j = 0; j < 4; ++j) { S[4 + j] = eg * S[4 + j] + kb[j] * wv; o += qb[j] * S[4 + j]; }
            o += __shfl_xor(o, 8); o += __shfl_xor(o, 16); o += __shfl_xor(o, 32);
            if (kq == 0) DO[(size_t)scan_row(b, dir, ch * 64 + tt) * 256 + h * 64 + w * 8 + vv] = o;
        }
        __syncthreads();
    }
}
typedef unsigned u32x4a __attribute__((ext_vector_type(4)));
__device__ __forceinline__ bf16x8 frag2(u32x2 lo, u32x2 hi) { return __builtin_bit_cast(bf16x8, (u32x4){lo.x, lo.y, hi.x, hi.y}); }
__device__ __forceinline__ u32x2 cvt4(f32x4 v) { return (u32x2){pk2(v[0], v[1]), pk2(v[2], v[3])}; }

struct GdnIn { f32x2 g2; bf16x8 ak[2], aq[2], bk[2][2]; float kt8[8]; };
struct GdnIn2 { f32x4 R[4], Qv[4]; };
__device__ __forceinline__ void gdn_fetch(CArgs& a, int u, int w, int lane, GdnIn& in) {
    const int chain = u / 36, n = u % 36, b = chain >> 3, h = (chain >> 1) & 3, dir = chain & 1;
    const int r0 = scan_row(b, dir, n * 64), step = dir ? -1 : 1, fr = lane & 15, kg = lane >> 4;
    const float* DQ = (const float*)(a.ws + WS_MIX + MX_DQ) + h * 64; const float* DK = (const float*)(a.ws + WS_MIX + MX_DK) + h * 64; const float* DV = (const float*)(a.ws + WS_MIX + MX_DV) + h * 64;
    const float* DG = (const float*)(a.ws + WS_MIX + MX_DG);
    const bf16* KB = (const bf16*)(a.ws + WS_CKD + CD_KB) + (ptrdiff_t)r0 * 256 + h * 64; const bf16* QB = (const bf16*)(a.ws + WS_CKD + CD_QB) + (ptrdiff_t)r0 * 256 + h * 64;
    const ptrdiff_t ldt = (ptrdiff_t)step * 256;
    const bool isW = w >= 4; const int c0 = 16 * (w & 3), I1 = w >> 1;
    in.g2 = *(const f32x2*)(DG + (size_t)(r0 + step * lane) * 16 + h * 4 + dir * 2);
#pragma unroll
    for (int s = 0; s < 2; ++s) { in.ak[s] = *(const bf16x8*)(KB + (ptrdiff_t)(16 * I1 + fr) * ldt + 32 * s + 8 * kg); in.aq[s] = *(const bf16x8*)(QB + (ptrdiff_t)(16 * I1 + fr) * ldt + 32 * s + 8 * kg);
#pragma unroll
        for (int jj = 0; jj < 2; ++jj) in.bk[jj][s] = *(const bf16x8*)(KB + (ptrdiff_t)(16 * (2 * (w & 1) + jj) + fr) * ldt + 32 * s + 8 * kg); }
#pragma unroll
    for (int tt = 0; tt < 8; ++tt) in.kt8[tt] = DK[(size_t)(r0 + step * (8 * w + tt)) * 256 + lane];
}
__device__ __forceinline__ void gdn_fetch2(CArgs& a, int u, int w, int lane, GdnIn2& in) {
    const int chain = u / 36, n = u % 36, b = chain >> 3, h = (chain >> 1) & 3, dir = chain & 1;
    const int r0 = scan_row(b, dir, n * 64), step = dir ? -1 : 1, fr = lane & 15, kg = lane >> 4;
    const float* DQ = (const float*)(a.ws + WS_MIX + MX_DQ) + h * 64; const float* DK = (const float*)(a.ws + WS_MIX + MX_DK) + h * 64; const float* DV = (const float*)(a.ws + WS_MIX + MX_DV) + h * 64;
    const bool isW = w >= 4; const int c0 = 16 * (w & 3);
#pragma unroll
    for (int I = 0; I < 4; ++I)
#pragma unroll
        for (int e = 0; e < 4; ++e) { const size_t ro = (size_t)(r0 + step * (16 * I + 4 * kg + e)) * 256 + c0 + fr; in.R[I][e] = isW ? DK[ro] : DV[ro]; in.Qv[I][e] = isW ? DQ[ro] : 0.f; }
}
__device__ __forceinline__ float gdn_s1(const GdnIn& in, LAS unsigned char* ub, LAS unsigned char* dwb, int w, int lane) {
    const int fr = lane & 15, kg = lane >> 4, I1 = w >> 1;
    LAS bf16* AB = (LAS bf16*)ub; LAS bf16* ATT = AB + 4608; LAS bf16* KTT = ATT + 4608; LAS float* GT = (LAS float*)(dwb + 2048);
    float beta = in.g2.x, cum = in.g2.y;
#pragma unroll
    for (int o = 1; o < 64; o <<= 1) { const float t = __shfl_up(cum, o); if (lane >= o) cum += t; }
    const float cl = rdlane_f(cum, 63);
    GT[lane] = beta; GT[64 + lane] = cum; GT[128 + lane] = __expf(cum);
    asm volatile("s_waitcnt lgkmcnt(0)" ::: "memory");
    { const f32x4 ci = *(const LAS f32x4*)(GT + 64 + 16 * I1 + 4 * kg), bi = *(const LAS f32x4*)(GT + 16 * I1 + 4 * kg);
#pragma unroll
      for (int jj = 0; jj < 2; ++jj) { const int J = 2 * (w & 1) + jj;
          f32x4 ck = (f32x4){0.f, 0.f, 0.f, 0.f}, cq = (f32x4){0.f, 0.f, 0.f, 0.f};
#pragma unroll
          for (int s = 0; s < 2; ++s) { ck = __builtin_amdgcn_mfma_f32_16x16x32_bf16(in.ak[s], in.bk[jj][s], ck, 0, 0, 0); cq = __builtin_amdgcn_mfma_f32_16x16x32_bf16(in.aq[s], in.bk[jj][s], cq, 0, 0, 0); }
          const int j = 16 * J + fr; const float cj = GT[64 + j];
#pragma unroll
          for (int e = 0; e < 4; ++e) { const int i = 16 * I1 + 4 * kg + e; const float gm = __expf(fminf(ci[e] - cj, 0.f));
              AB[i * 72 + j] = (bf16)f2bf(j < i ? bi[e] * ck[e] * gm : 0.f); ATT[i * 72 + j] = (bf16)f2bf(j <= i ? cq[e] * gm : 0.f); } } }
    { const f32x4 c8a = *(const LAS f32x4*)(GT + 64 + 8 * w), c8b = *(const LAS f32x4*)(GT + 64 + 8 * w + 4);
#pragma unroll
      for (int tt = 0; tt < 8; ++tt) KTT[lane * 72 + 8 * w + tt] = (bf16)f2bf(in.kt8[tt] * __expf(cl - (tt < 4 ? c8a[tt & 3] : c8b[tt & 3]))); }
    asm volatile("s_waitcnt lgkmcnt(0)" ::: "memory");
    return cl;
}
__device__ __forceinline__ void gdn_s23(CArgs& a, int u, const GdnIn2& in, LAS unsigned char* ub, LAS unsigned char* dwb, int w, int lane, float cl) {
    const int fr = lane & 15, kg = lane >> 4;
    bf16* Mo = (bf16*)(a.ws + WS_CKD + CD_M) + (size_t)u * 4096; bf16* Eo = (bf16*)(a.ws + WS_CKD + CD_E) + (size_t)u * 4096;
    float* BTo = (float*)(a.ws + WS_CKD + CD_BT) + (size_t)u * 4096; bf16* FTo = (bf16*)(a.ws + WS_CKD + CD_FT) + (size_t)u * 4096;
    LAS bf16* AB = (LAS bf16*)ub; LAS bf16* ATT = AB + 4608; LAS bf16* KTT = ATT + 4608; LAS bf16* DW = (LAS bf16*)dwb; LAS float* GT = (LAS float*)(dwb + 2048);
    const bool isW = w >= 4; const int c0 = 16 * (w & 3);
    { const int blk = lane >> 4, c = lane & 15; float T[16];
#pragma unroll
      for (int hb = 0; hb < 4; ++hb) {
          u32x4 arow[4][2];
#pragma unroll
          for (int rr = 0; rr < 4; ++rr) { const int r = 4 * hb + rr; arow[rr][0] = *(const LAS u32x4*)(AB + (16 * blk + r) * 72 + 16 * blk); if (hb >= 2) arow[rr][1] = *(const LAS u32x4*)(AB + (16 * blk + r) * 72 + 16 * blk + 8); }
          asm volatile("s_waitcnt lgkmcnt(0)" ::: "memory");
#pragma unroll
          for (int rr = 0; rr < 4; ++rr) { const int r = 4 * hb + rr; float t = (r == c) ? 1.f : 0.f;
              float t2 = 0.f;
#pragma unroll
              for (int j = 0; j < r; ++j) { const unsigned wv = arow[rr][j >> 3][(j >> 1) & 3]; const float av = (j & 1) ? hi_bf(wv) : lo_bf(wv); if (j & 1) t2 -= av * T[j]; else t -= av * T[j]; }
              t += t2;
              T[r] = t; DW[(blk * 16 + r) * 16 + c] = (bf16)f2bf(t); } } }
    asm volatile("s_waitcnt lgkmcnt(0)" ::: "memory");
    f32x4 X[4];
#pragma unroll
    for (int I = 0; I < 4; ++I) {
        const f32x4 br = *(const LAS f32x4*)(GT + 16 * I + 4 * kg), er = *(const LAS f32x4*)(GT + 128 + 16 * I + 4 * kg);
        f32x4 acc = isW ? br * er * in.R[I] : br * in.R[I];
#pragma unroll
        for (int P = 0; 2 * P < I; ++P) {
            const u32x2 alo = *(const LAS u32x2*)(AB + (16 * I + fr) * 72 + 32 * P + 4 * kg);
            const u32x2 ahi = (2 * P + 1 < I) ? *(const LAS u32x2*)(AB + (16 * I + fr) * 72 + 32 * P + 16 + 4 * kg) : (u32x2){0u, 0u};
            const u32x2 xlo = cvt4(-X[2 * P]); const u32x2 xhi = (2 * P + 1 < I) ? cvt4(-X[2 * P + 1]) : (u32x2){0u, 0u};
            acc = __builtin_amdgcn_mfma_f32_16x16x32_bf16(frag2(alo, ahi), frag2(xlo, xhi), acc, 0, 0, 0); }
        const u32x2 dlo = *(const LAS u32x2*)(DW + (I * 16 + fr) * 16 + 4 * kg);
        X[I] = __builtin_amdgcn_mfma_f32_16x16x32_bf16(frag2(dlo, (u32x2){0u, 0u}), frag2(cvt4(acc), (u32x2){0u, 0u}), (f32x4){0.f, 0.f, 0.f, 0.f}, 0, 0, 0);
    }
    const bf16x8 Xb01 = frag2(cvt4(X[0]), cvt4(X[1])), Xb23 = frag2(cvt4(X[2]), cvt4(X[3]));
    const float ecl = __expf(cl);
    bf16* ftp = FTo + (c0 + fr) * 64 + 4 * kg; float* btp = BTo + (c0 + fr) * 64 + 4 * kg; bf16* ep = Eo + (4 * kg) * 64 + c0 + fr; bf16* mp = Mo + (4 * kg) * 64 + c0 + fr;
#pragma unroll
    for (int t4 = 0; t4 < 4; ++t4) {
        const LAS bf16* ar = ATT + (16 * t4 + fr) * 72 + 4 * kg; const LAS bf16* kr = KTT + (16 * t4 + fr) * 72 + 4 * kg;
        f32x4 pa = (f32x4){0.f, 0.f, 0.f, 0.f}, pk = (f32x4){0.f, 0.f, 0.f, 0.f};
        pa = __builtin_amdgcn_mfma_f32_16x16x32_bf16(frag2(*(const LAS u32x2*)ar, *(const LAS u32x2*)(ar + 16)), Xb01, pa, 0, 0, 0);
        pa = __builtin_amdgcn_mfma_f32_16x16x32_bf16(frag2(*(const LAS u32x2*)(ar + 32), *(const LAS u32x2*)(ar + 48)), Xb23, pa, 0, 0, 0);
        pk = __builtin_amdgcn_mfma_f32_16x16x32_bf16(frag2(*(const LAS u32x2*)kr, *(const LAS u32x2*)(kr + 16)), Xb01, pk, 0, 0, 0);
        pk = __builtin_amdgcn_mfma_f32_16x16x32_bf16(frag2(*(const LAS u32x2*)(kr + 32), *(const LAS u32x2*)(kr + 48)), Xb23, pk, 0, 0, 0);
        if (!isW) {
            *(u32x2*)(ftp + 16 * t4) = cvt4(pa);
            *(f32x4*)(btp + 16 * t4) = pk;
        } else {
            const f32x4 ec = *(const LAS f32x4*)(GT + 128 + 16 * t4 + 4 * kg);
#pragma unroll
            for (int e = 0; e < 4; ++e) { const int row = 16 * t4 + 4 * kg + e, col = c0 + fr;
                ep[(16 * t4 + e) * 64] = (bf16)f2bf(ec[e] * in.Qv[t4][e] - pa[e]);
                mp[(16 * t4 + e) * 64] = (bf16)f2bf((row == col ? ecl : 0.f) - pk[e]); }
        }
    }
}
__device__ __forceinline__ void gdn_chain_units(CArgs& a, int chain, LAS unsigned char* lds, int w, int lane, unsigned long long& tacc) {
    asm volatile("" : "+v"(lane));
    LAS unsigned char* dwb = lds + 55296 + w * 3072;
    GdnIn A, B; GdnIn2 C;
    gdn_fetch(a, chain * 36, w, lane, A);
#pragma unroll 1
    for (int n = 0; n < 36; n += 2) {
        asm volatile("" : "+v"(lane));
        { unsigned long long tq = 0ull; if (PROBE_PH >= 60 && PROBE_PH <= 62) tq = __builtin_amdgcn_s_memrealtime();
          gdn_fetch2(a, chain * 36 + n, w, lane, C); const float cl = gdn_s1(A, lds, dwb, w, lane);
          if (PROBE_PH == 60) tacc += __builtin_amdgcn_s_memrealtime() - tq; if (PROBE_PH == 61) tq = __builtin_amdgcn_s_memrealtime();
          __syncthreads();
          if (PROBE_PH == 61) tacc += __builtin_amdgcn_s_memrealtime() - tq; if (PROBE_PH >= 62 && PROBE_PH <= 64) tq = __builtin_amdgcn_s_memrealtime();
          gdn_fetch(a, chain * 36 + n + 1, w, lane, B); gdn_s23(a, chain * 36 + n, C, lds, dwb, w, lane, cl);
          if (PROBE_PH == 62 || (PROBE_PH == 63 && w < 4) || (PROBE_PH == 64 && w >= 4)) tacc += __builtin_amdgcn_s_memrealtime() - tq; }
        asm volatile("" : "+v"(lane));
        { gdn_fetch2(a, chain * 36 + n + 1, w, lane, C); const float cl = gdn_s1(B, lds + 27648, dwb, w, lane); __syncthreads(); if (n + 2 < 36) gdn_fetch(a, chain * 36 + n + 2, w, lane, A); gdn_s23(a, chain * 36 + n + 1, C, lds + 27648, dwb, w, lane, cl); }
    }
}
__device__ __forceinline__ void gdn_seq_wave(CArgs& a, int chain, int vs, int lane) {
    asm volatile("" : "+v"(lane));
    const int b = chain >> 3, h = (chain >> 1) & 3, dir = chain & 1, fr = lane & 15, kg = lane >> 4, v = 16 * vs + fr, step = dir ? -1 : 1;
    float* DO = (float*)(a.ws + WS_MIX + (dir ? MX_DOB : MX_DOF));
    f32x4 S[4];
#pragma unroll
    for (int i = 0; i < 4; ++i) S[i] = (f32x4){0.f, 0.f, 0.f, 0.f};
#pragma unroll 1
    for (int n = 0; n < 36; ++n) {
        const int u = chain * 36 + n, r0 = scan_row(b, dir, n * 64);
        const bf16* Mo = (const bf16*)(a.ws + WS_CKD + CD_M) + (size_t)u * 4096; const bf16* Eo = (const bf16*)(a.ws + WS_CKD + CD_E) + (size_t)u * 4096;
        const float* BTo = (const float*)(a.ws + WS_CKD + CD_BT) + (size_t)u * 4096; const bf16* FTo = (const bf16*)(a.ws + WS_CKD + CD_FT) + (size_t)u * 4096;
        u32x2 ef[4][2][2], mf[4][2][2], ff[4]; f32x4 bi[4];
#pragma unroll
        for (int t = 0; t < 4; ++t) { ff[t] = *(const u32x2*)(FTo + v * 64 + 16 * t + 4 * kg); bi[t] = *(const f32x4*)(BTo + v * 64 + 16 * t + 4 * kg);
#pragma unroll
            for (int s = 0; s < 2; ++s) { const bf16* er = Eo + (16 * t + fr) * 64 + 32 * s + 4 * kg; ef[t][s][0] = *(const u32x2*)er; ef[t][s][1] = *(const u32x2*)(er + 16);
                const bf16* mr = Mo + (16 * t + fr) * 64 + 32 * s + 4 * kg; mf[t][s][0] = *(const u32x2*)mr; mf[t][s][1] = *(const u32x2*)(mr + 16); } }
        bf16x8 Sb[2];
#pragma unroll
        for (int s = 0; s < 2; ++s) Sb[s] = frag2(cvt4(S[2 * s]), cvt4(S[2 * s + 1]));
        f32x4 o[4];
#pragma unroll
        for (int t = 0; t < 4; ++t) { o[t] = (f32x4){lo_bf(ff[t].x), hi_bf(ff[t].x), lo_bf(ff[t].y), hi_bf(ff[t].y)};
#pragma unroll
            for (int s = 0; s < 2; ++s) o[t] = __builtin_amdgcn_mfma_f32_16x16x32_bf16(frag2(ef[t][s][0], ef[t][s][1]), Sb[s], o[t], 0, 0, 0);
            f32x4 sn = bi[t];
#pragma unroll
            for (int s = 0; s < 2; ++s) sn = __builtin_amdgcn_mfma_f32_16x16x32_bf16(frag2(mf[t][s][0], mf[t][s][1]), Sb[s], sn, 0, 0, 0);
            S[t] = sn; }
#pragma unroll
        for (int t = 0; t < 4; ++t)
#pragma unroll
            for (int e = 0; e < 4; ++e) DO[(size_t)(r0 + step * (16 * t + 4 * kg + e)) * 256 + h * 64 + v] = o[t][e];
    }
}

__device__ __forceinline__ void gdn_seq_block(CArgs& a, int chain, LAS unsigned char* lds, int w, int lane) {
    asm volatile("" : "+v"(lane));
    const int b = chain >> 3, h = (chain >> 1) & 3, dir = chain & 1, fr = lane & 15, kg = lane >> 4, step = dir ? -1 : 1;
    constexpr int SLOT = 45056;
    if (w >= 4) {
        const int q = w - 4;
        u32x4 rg[10];
#define SEQ_LD(n_) do { const int u_ = chain * 36 + (n_); \
        _Pragma("unroll") for (int j = 0; j < 10; ++j) { const int c_ = q + 4 * j; \
            const unsigned char* g_ = c_ < 8 ? a.ws + WS_CKD + CD_M + (size_t)u_ * 8192 + c_ * 1024 : (c_ < 16 ? a.ws + WS_CKD + CD_E + (size_t)u_ * 8192 + (c_ - 8) * 1024 : \
                (c_ < 32 ? a.ws + WS_CKD + CD_BT + (size_t)u_ * 16384 + (c_ - 16) * 1024 : a.ws + WS_CKD + CD_FT + (size_t)u_ * 8192 + (c_ - 32) * 1024)); \
            rg[j] = *(const u32x4*)(g_ + lane * 16); } } while (0)
#define SEQ_ST(n_) do { LAS unsigned char* s_ = lds + ((n_) % 3) * SLOT; \
        _Pragma("unroll") for (int j = 0; j < 10; ++j) { const int c_ = q + 4 * j; \
            const int off_ = c_ < 8 ? (c_ * 8 + (lane >> 3)) * 144 + (lane & 7) * 16 : (c_ < 16 ? 9216 + ((c_ - 8) * 8 + (lane >> 3)) * 144 + (lane & 7) * 16 : \
                (c_ < 32 ? 18432 + ((c_ - 16) * 4 + (lane >> 4)) * 272 + (lane & 15) * 16 : 35840 + ((c_ - 32) * 8 + (lane >> 3)) * 144 + (lane & 7) * 16)); \
            *(LAS u32x4*)(s_ + off_) = rg[j]; } } while (0)
        SEQ_LD(0); SEQ_ST(0); SEQ_LD(1); SEQ_ST(1); SEQ_LD(2);
        asm volatile("s_waitcnt lgkmcnt(0)" ::: "memory");
        __syncthreads();
#pragma unroll 1
        for (int n = 0; n < 36; ++n) {
            if (n + 2 < 36) { SEQ_ST(n + 2); }
            if (n + 3 < 36) { SEQ_LD(n + 3); }
            asm volatile("s_waitcnt lgkmcnt(0)" ::: "memory");
            __syncthreads();
        }
#undef SEQ_LD
#undef SEQ_ST
    } else {
        const int v = 16 * w + fr;
        float* DO = (float*)(a.ws + WS_MIX + (dir ? MX_DOB : MX_DOF));
        f32x4 S[4];
#pragma unroll
        for (int i = 0; i < 4; ++i) S[i] = (f32x4){0.f, 0.f, 0.f, 0.f};
        __syncthreads();
#pragma unroll 1
        for (int n = 0; n < 36; ++n) {
            const LAS unsigned char* sl = lds + (n % 3) * SLOT; const int r0 = scan_row(b, dir, n * 64);
            bf16x8 Sb[2];
#pragma unroll
            for (int s = 0; s < 2; ++s) Sb[s] = frag2(cvt4(S[2 * s]), cvt4(S[2 * s + 1]));
            f32x4 o[4];
#pragma unroll
            for (int t = 0; t < 4; ++t) {
                const u32x2 ff = *(const LAS u32x2*)(sl + 35840 + v * 144 + (16 * t + 4 * kg) * 2);
                o[t] = (f32x4){lo_bf(ff.x), hi_bf(ff.x), lo_bf(ff.y), hi_bf(ff.y)};
                f32x4 sn = *(const LAS f32x4*)(sl + 18432 + v * 272 + (16 * t + 4 * kg) * 4);
#pragma unroll
                for (int s = 0; s < 2; ++s) { const LAS unsigned char* er = sl + 9216 + (16 * t + fr) * 144 + (32 * s + 4 * kg) * 2; const LAS unsigned char* mr = sl + (16 * t + fr) * 144 + (32 * s + 4 * kg) * 2;
                    o[t] = __builtin_amdgcn_mfma_f32_16x16x32_bf16(frag2(*(const LAS u32x2*)er, *(const LAS u32x2*)(er + 32)), Sb[s], o[t], 0, 0, 0);
                    sn = __builtin_amdgcn_mfma_f32_16x16x32_bf16(frag2(*(const LAS u32x2*)mr, *(const LAS u32x2*)(mr + 32)), Sb[s], sn, 0, 0, 0); }
                S[t] = sn; }
            { float* dp = DO + (ptrdiff_t)(r0 + step * 4 * kg) * 256 + h * 64 + v; const ptrdiff_t sd = (ptrdiff_t)step * 256;
#pragma unroll
              for (int t = 0; t < 4; ++t)
#pragma unroll
                  for (int e = 0; e < 4; ++e) dp[(16 * t + e) * sd] = o[t][e]; }
            __syncthreads();
        }
    }
}
__device__ __forceinline__ void gla_seq_block(CArgs& a, int chain, LAS unsigned char* lds, int w, int lane) {
    asm volatile("" : "+v"(lane));
    const int b = chain >> 3, h = (chain >> 1) & 3, dir = chain & 1, fr = lane & 15, kg = lane >> 4, step = dir ? -1 : 1;
    constexpr int SLOT = 23680;
    if (w >= 4) {
        const int q = w - 4;
        u32x4 rg[5]; float dl = 0.f;
#define SEQ_LD(n_) do { const int u_ = chain * 36 + (n_); \
        _Pragma("unroll") for (int j = 0; j < 5; ++j) { const int c_ = q + 4 * j; \
            const unsigned char* g_ = c_ < 4 ? a.ws + WS_CKA + CA_QC + (size_t)u_ * 4096 + c_ * 1024 : (c_ < 12 ? a.ws + WS_CKA + CA_FT + (size_t)u_ * 8192 + (c_ - 4) * 1024 : a.ws + WS_CKA + CA_UT + (size_t)u_ * 8192 + (c_ - 12) * 1024); \
            rg[j] = *(const u32x4*)(g_ + lane * 16); } \
        if (q == 0) dl = ((const float*)(a.ws + WS_CKA + CA_DL))[(size_t)u_ * 32 + (lane & 31)]; } while (0)
#define SEQ_ST(n_) do { LAS unsigned char* s_ = lds + ((n_) % 3) * SLOT; \
        _Pragma("unroll") for (int j = 0; j < 5; ++j) { const int c_ = q + 4 * j; \
            const int off_ = c_ < 4 ? (c_ * 16 + (lane >> 2)) * 80 + (lane & 3) * 16 : (c_ < 12 ? 5120 + ((c_ - 4) * 8 + (lane >> 3)) * 144 + (lane & 7) * 16 : 14336 + ((c_ - 12) * 8 + (lane >> 3)) * 144 + (lane & 7) * 16); \
            *(LAS u32x4*)(s_ + off_) = rg[j]; } \
        if (q == 0 && lane < 32) *(LAS float*)(s_ + 23552 + lane * 4) = dl; } while (0)
        SEQ_LD(0); SEQ_ST(0); SEQ_LD(1); SEQ_ST(1); SEQ_LD(2);
        asm volatile("s_waitcnt lgkmcnt(0)" ::: "memory");
        __syncthreads();
#pragma unroll 1
        for (int n = 0; n < 36; ++n) {
            if (n + 2 < 36) { SEQ_ST(n + 2); }
            if (n + 3 < 36) { SEQ_LD(n + 3); }
            asm volatile("s_waitcnt lgkmcnt(0)" ::: "memory");
            __syncthreads();
        }
#undef SEQ_LD
#undef SEQ_ST
    } else {
        const int v = 16 * w + fr;
        float* GO = (float*)(a.ws + WS_MIX + (dir ? MX_GOB : MX_GOF));
        f32x4 S[2] = {(f32x4){0.f, 0.f, 0.f, 0.f}, (f32x4){0.f, 0.f, 0.f, 0.f}};
        __syncthreads();
#pragma unroll 1
        for (int n = 0; n < 36; ++n) {
            const LAS unsigned char* sl = lds + (n % 3) * SLOT; const int r0 = scan_row(b, dir, n * 64);
            const bf16x8 Sb = frag2(cvt4(S[0]), cvt4(S[1]));
            f32x4 o[4];
#pragma unroll
            for (int t = 0; t < 4; ++t) { const u32x2 ff = *(const LAS u32x2*)(sl + 5120 + v * 144 + (16 * t + 4 * kg) * 2);
                o[t] = (f32x4){lo_bf(ff.x), hi_bf(ff.x), lo_bf(ff.y), hi_bf(ff.y)};
                const LAS unsigned char* qr = sl + (16 * t + fr) * 80 + 4 * kg * 2;
                o[t] = __builtin_amdgcn_mfma_f32_16x16x32_bf16(frag2(*(const LAS u32x2*)qr, *(const LAS u32x2*)(qr + 32)), Sb, o[t], 0, 0, 0); }
#pragma unroll
            for (int kt = 0; kt < 2; ++kt) { const f32x4 d4 = *(const LAS f32x4*)(sl + 23552 + (16 * kt + 4 * kg) * 4), u4 = *(const LAS f32x4*)(sl + 14336 + v * 144 + (16 * kt + 4 * kg) * 4); S[kt] = d4 * S[kt] + u4; }
            { float* gp = GO + (ptrdiff_t)(r0 + step * 4 * kg) * 256 + h * 64 + v; const ptrdiff_t sd = (ptrdiff_t)step * 256;
#pragma unroll
              for (int t = 0; t < 4; ++t)
#pragma unroll
                  for (int e = 0; e < 4; ++e) gp[(16 * t + e) * sd] = o[t][e]; }
            __syncthreads();
        }
    }
}

struct GlaIn { float bc[32]; unsigned px[32]; };
__device__ __forceinline__ void gla_fetch(CArgs& a, int u, int w, int lane, GlaIn& in) {
    const int chain = u / 36, n = u % 36, b = chain >> 3, h = (chain >> 1) & 3, dir = chain & 1;
    const int r0 = scan_row(b, dir, n * 64), step = dir ? -1 : 1;
    const bf16* P = (const bf16*)(a.ws + WS_P);
    const float* GD = (const float*)(a.ws + WS_MIX + (dir ? MX_GDB : MX_GDF));
    if (w < 4) { const int k = lane & 31, half = lane >> 5; const int src_off = (w == 0 || w == 2) ? 0 : 128;
#pragma unroll
        for (int i = 0; i < 32; ++i) { in.bc[i] = GD[(size_t)(r0 + step * (32 * half + i)) * 128 + h * 32 + k]; in.px[i] = P[(size_t)(r0 + step * (32 * half + i)) * D_INP + GLA0 + src_off + h * 32 + k]; }
    } else { const int vv = 16 * (w - 4) + (lane & 15), tq = lane >> 4;
#pragma unroll
        for (int i = 0; i < 16; ++i) in.px[i] = P[(size_t)(r0 + step * (16 * tq + i)) * D_INP + GLA0 + 256 + h * 64 + vv];
#pragma unroll
        for (int i = 16; i < 32; ++i) in.px[i] = 0u;
#pragma unroll
        for (int i = 0; i < 32; ++i) in.bc[i] = 0.f;
    }
}
__device__ __forceinline__ void gla_s1(CArgs& a, int u, GlaIn& in, LAS unsigned char* ub, int w, int lane) {
    bf16* QC = (bf16*)(a.ws + WS_CKA + CA_QC) + (size_t)u * 2048; float* DL = (float*)(a.ws + WS_CKA + CA_DL) + (size_t)u * 32;
    LAS bf16* QE = (LAS bf16*)ub; LAS bf16* KE = QE + 2560; LAS bf16* KTT = KE + 2560; LAS bf16* VT = KTT + 2304;
    if (w < 4) {
        const int k = lane & 31, half = lane >> 5;
        float run = 0.f;
#pragma unroll
        for (int i = 0; i < 32; ++i) { run += in.bc[i]; in.bc[i] = run; }
        const float tot0 = __shfl(run, k), tot1 = __shfl(run, 32 + k);
        const float bref = tot0, blast = tot0 + tot1, off = half ? tot0 : 0.f;
        const float sc = (w == 0 || w == 2) ? 0.17677669529663687f : 1.f;
#pragma unroll
        for (int i = 0; i < 32; ++i) { const int t = 32 * half + i; const float bi = in.bc[i] + off;
            const float x = bf2f(in.px[i]) * sc;
            const float ex = w == 0 ? bi - bref : (w == 1 ? bref - bi : (w == 2 ? bi : blast - bi));
            const bf16 y = (bf16)f2bf(x * __expf(ex));
            if (w == 0) QE[t * 40 + k] = y; else if (w == 1) KE[t * 40 + k] = y; else if (w == 2) QC[t * 32 + k] = y; else KTT[k * 72 + t] = y; }
        if (w == 2 && half == 0) DL[k] = __expf(blast);
    } else {
        const int vv = 16 * (w - 4) + (lane & 15), tq = lane >> 4;
#pragma unroll
        for (int i = 0; i < 16; ++i) VT[vv * 72 + 16 * tq + i] = in.px[i];
    }
    asm volatile("s_waitcnt lgkmcnt(0)" ::: "memory");
}
__device__ __forceinline__ void gla_s2(CArgs& a, int u, LAS unsigned char* ub, int w, int lane) {
    const int fr = lane & 15, kg = lane >> 4;
    bf16* FT = (bf16*)(a.ws + WS_CKA + CA_FT) + (size_t)u * 4096; float* UT = (float*)(a.ws + WS_CKA + CA_UT) + (size_t)u * 2048;
    LAS bf16* QE = (LAS bf16*)ub; LAS bf16* KE = QE + 2560; LAS bf16* KTT = KE + 2560; LAS bf16* VT = KTT + 2304;
    const int It = w & 3, vh = w >> 2;
    const bf16x8 qf = *(const LAS bf16x8*)(QE + (16 * It + fr) * 40 + 8 * kg);
    f32x4 st[4];
#pragma unroll
    for (int Jt = 0; Jt < 4; ++Jt) { const bf16x8 kf = *(const LAS bf16x8*)(KE + (16 * Jt + fr) * 40 + 8 * kg);
        st[Jt] = __builtin_amdgcn_mfma_f32_16x16x32_bf16(kf, qf, (f32x4){0.f, 0.f, 0.f, 0.f}, 0, 0, 0);
#pragma unroll
        for (int e = 0; e < 4; ++e) st[Jt][e] = (16 * Jt + 4 * kg + e <= 16 * It + fr) ? st[Jt][e] : 0.f; }
    const bf16x8 Sb01 = frag2(cvt4(st[0]), cvt4(st[1])), Sb23 = frag2(cvt4(st[2]), cvt4(st[3]));
    bf16* ftp = FT + (4 * kg) * 64 + 16 * It + fr;
#pragma unroll
    for (int vv = 0; vv < 2; ++vv) { const int Vt = 2 * vh + vv; const LAS bf16* vr = VT + (16 * Vt + fr) * 72 + 4 * kg;
        f32x4 f = (f32x4){0.f, 0.f, 0.f, 0.f};
        f = __builtin_amdgcn_mfma_f32_16x16x32_bf16(frag2(*(const LAS u32x2*)vr, *(const LAS u32x2*)(vr + 16)), Sb01, f, 0, 0, 0);
        f = __builtin_amdgcn_mfma_f32_16x16x32_bf16(frag2(*(const LAS u32x2*)(vr + 32), *(const LAS u32x2*)(vr + 48)), Sb23, f, 0, 0, 0);
#pragma unroll
        for (int e = 0; e < 4; ++e) ftp[(16 * Vt + e) * 64] = (bf16)f2bf(f[e]); }
    const int kt = w & 1, Vu = w >> 1;
    f32x4 uu = (f32x4){0.f, 0.f, 0.f, 0.f};
#pragma unroll
    for (int s = 0; s < 2; ++s) uu = __builtin_amdgcn_mfma_f32_16x16x32_bf16(*(const LAS bf16x8*)(KTT + (16 * kt + fr) * 72 + 32 * s + 8 * kg), *(const LAS bf16x8*)(VT + (16 * Vu + fr) * 72 + 32 * s + 8 * kg), uu, 0, 0, 0);
    *(f32x4*)(UT + (16 * Vu + fr) * 32 + 16 * kt + 4 * kg) = uu;
}
__device__ __forceinline__ void gla_chain_units(CArgs& a, int chain, LAS unsigned char* lds, int w, int lane) {
    GlaIn A, B;
    asm volatile("" : "+v"(lane));
    gla_fetch(a, chain * 36, w, lane, A);
#pragma unroll 1
    for (int n = 0; n < 36; n += 2) {
        asm volatile("" : "+v"(lane));
        { gla_s1(a, chain * 36 + n, A, lds, w, lane); __syncthreads(); gla_fetch(a, chain * 36 + n + 1, w, lane, B); gla_s2(a, chain * 36 + n, lds, w, lane); }
        asm volatile("" : "+v"(lane));
        { gla_s1(a, chain * 36 + n + 1, B, lds + 24064, w, lane); __syncthreads(); if (n + 2 < 36) gla_fetch(a, chain * 36 + n + 2, w, lane, A); gla_s2(a, chain * 36 + n + 1, lds + 24064, w, lane); }
    }
}
__device__ __forceinline__ void gla_seq_wave(CArgs& a, int chain, int vs, int lane) {
    asm volatile("" : "+v"(lane));
    const int b = chain >> 3, h = (chain >> 1) & 3, dir = chain & 1, fr = lane & 15, kg = lane >> 4, v = 16 * vs + fr, step = dir ? -1 : 1;
    float* GO = (float*)(a.ws + WS_MIX + (dir ? MX_GOB : MX_GOF));
    f32x4 S[2] = {(f32x4){0.f, 0.f, 0.f, 0.f}, (f32x4){0.f, 0.f, 0.f, 0.f}};
#pragma unroll 1
    for (int n = 0; n < 36; ++n) {
        const int u = chain * 36 + n, r0 = scan_row(b, dir, n * 64);
        const bf16* QC = (const bf16*)(a.ws + WS_CKA + CA_QC) + (size_t)u * 2048; const bf16* FT = (const bf16*)(a.ws + WS_CKA + CA_FT) + (size_t)u * 4096;
        const float* UT = (const float*)(a.ws + WS_CKA + CA_UT) + (size_t)u * 2048; const float* DL = (const float*)(a.ws + WS_CKA + CA_DL) + (size_t)u * 32;
        u32x2 qf[4][2], ff[4]; f32x4 d4[2], u4[2];
#pragma unroll
        for (int t = 0; t < 4; ++t) { const bf16* qr = QC + (16 * t + fr) * 32; qf[t][0] = *(const u32x2*)(qr + 4 * kg); qf[t][1] = *(const u32x2*)(qr + 16 + 4 * kg); ff[t] = *(const u32x2*)(FT + v * 64 + 16 * t + 4 * kg); }
#pragma unroll
        for (int kt = 0; kt < 2; ++kt) { d4[kt] = *(const f32x4*)(DL + 16 * kt + 4 * kg); u4[kt] = *(const f32x4*)(UT + v * 32 + 16 * kt + 4 * kg); }
        const bf16x8 Sb = frag2(cvt4(S[0]), cvt4(S[1]));
        f32x4 o[4];
#pragma unroll
        for (int t = 0; t < 4; ++t) { o[t] = (f32x4){lo_bf(ff[t].x), hi_bf(ff[t].x), lo_bf(ff[t].y), hi_bf(ff[t].y)};
            o[t] = __builtin_amdgcn_mfma_f32_16x16x32_bf16(frag2(qf[t][0], qf[t][1]), Sb, o[t], 0, 0, 0); }
#pragma unroll
        for (int kt = 0; kt < 2; ++kt) S[kt] = d4[kt] * S[kt] + u4[kt];
#pragma unroll
        for (int t = 0; t < 4; ++t)
#pragma unroll
            for (int e = 0; e < 4; ++e) GO[(size_t)(r0 + step * (16 * t + 4 * kg + e)) * 256 + h * 64 + v] = o[t][e];
    }
}

template <int L>
__device__ __forceinline__ void hyena_unit(CArgs& a, int l, int c, LAS unsigned char* lds) {
    constexpr int Lt = L == SEQ ? 1 : 0, SOFF = L == SEQ ? CTXL : 0, CST = (2 * L + 16) * 2 + 32;
    constexpr int NTW = L / 16 / 8;
    const int tid = tidx(), lane = tid & 63, w = tid >> 6, fr = lane & 15, kg = lane >> 4;
    const float* kf = (const float*)(a.ws + WS_KUN) + ((size_t)((l * 2 + Lt) * 512 + c)) * 2048;
    const float* kb = kf + (size_t)256 * 2048;
    LAS float* red = (LAS float*)(lds + 8 * CST);
    const bf16* Z = (const bf16*)(a.ws + WS_MIX + MX_ZT) + ((size_t)(c * 16 + fr)) * 2304 + SOFF;
    const bf16* zp = Z + 8 * kg;
    bf16x8 zc[8];
#pragma unroll
    for (int ii = 0; ii < 8; ++ii) zc[ii] = *(const bf16x8*)(zp + 32 * ii);
    constexpr int NI = (2 * L + 16 + 511) / 512;
    float gv[NI];
    float s = 0.f;
#pragma unroll
    for (int q = 0; q < NI; ++q) {
        const int idx = tid + 512 * q, ic = min(max(idx, 1), 2 * L - 1);
        const float v = *(ic <= L ? kf + (L - ic) : kb + (ic - L));
        gv[q] = (idx >= 1 && idx < 2 * L) ? v : 0.f;
        s += fabsf(gv[q]);
    }
    s = wave_sum(s);
    if (lane == 0) red[w] = s;
    __syncthreads();
    float l1 = 0.f;
#pragma unroll
    for (int i = 0; i < 8; ++i) l1 += red[i];
    const float inv = 1.f / l1;
#pragma unroll
    for (int q = 0; q < NI; ++q) {
        const int idx = tid + 512 * q;
        const bf16 gb = (bf16)f2bf(gv[q] * inv);
        if (idx < 2 * L + 16) {
#pragma unroll
            for (int r = 0; r < 8; ++r) if (idx - r >= 0) *(LAS bf16*)(lds + r * CST + (idx - r) * 2) = gb;
        }
    }
    __syncthreads();
    float* YT = (float*)(a.ws + WS_MIX + MX_YT) + ((size_t)(c * 16 + fr)) * 2304 + SOFF;
    f32x4 acc[NTW];
#pragma unroll
    for (int j = 0; j < NTW; ++j) acc[j] = (f32x4){0.f, 0.f, 0.f, 0.f};
    const int rr = (8 - (fr & 7)) & 7;
    const LAS unsigned char* ap = lds + rr * CST + (((8 * kg - fr + L) >> 3) - 2 * w * NTW) * 16;
    if constexpr (L == SEQ) {
        static_assert(NTW == 16, "hyena_unit");
        bf16x8 zn[8], A[16];
#pragma unroll
        for (int j = 2; j < 16; ++j) A[j] = *(const LAS bf16x8*)(ap - 32 * j);
#pragma unroll 1
        for (int ib = 0; ib < 8; ++ib) {
            const bf16* zq = zp + 256 * (ib < 7 ? ib + 1 : 7);
#pragma unroll
            for (int ii = 0; ii < 8; ++ii) zn[ii] = *(const bf16x8*)(zq + 32 * ii);
#pragma unroll
            for (int ii = 0; ii < 8; ++ii) {
                A[(16 - 2 * ii) & 15] = *(const LAS bf16x8*)(ap + 64 * ii);
                A[(17 - 2 * ii) & 15] = *(const LAS bf16x8*)(ap + 64 * ii - 32);
#pragma unroll
                for (int jj = 0; jj < 16; ++jj) { const int j = (jj + 2) & 15; acc[j] = __builtin_amdgcn_mfma_f32_16x16x32_bf16(A[(j + 16 - 2 * ii) & 15], zc[ii], acc[j], 0, 0, 0); }
            }
            ap += 512;
#pragma unroll
            for (int ii = 0; ii < 8; ++ii) zc[ii] = zn[ii];
        }
    } else {
        static_assert(L == 256, "hyena_unit");
#pragma unroll
        for (int i = 0; i < 8; ++i)
#pragma unroll
            for (int j = 0; j < NTW; ++j) acc[j] = __builtin_amdgcn_mfma_f32_16x16x32_bf16(*(const LAS bf16x8*)(ap + (4 * i - 2 * j) * 16), zc[i], acc[j], 0, 0, 0);
    }
#pragma unroll
    for (int j = 0; j < NTW; ++j) *(f32x4*)(YT + 16 * (w * NTW + j) + 4 * kg) = acc[j];
    __syncthreads();
}
__device__ __forceinline__ void ph_scan(CArgs& a, int l, LAS unsigned char* lds, int bid, int nblk, unsigned long long& tacc) {
    const int tid = tidx(), lane = tid & 63, w = __builtin_amdgcn_readfirstlane(tid >> 6);
    unsigned long long t0 = 0ull;
    if (PROBE_PH >= 20 && PROBE_PH < 50) t0 = __builtin_amdgcn_s_memrealtime();
#pragma unroll 1
    for (int c = bid; c < 256; c += nblk) {
        if (c < 128) {
            gdn_chain_units(a, c, lds, w, lane, tacc);
        } else {
            gla_chain_units(a, c - 128, lds, w, lane);
        }
        asm volatile("s_waitcnt vmcnt(0)" ::: "memory");
        __syncthreads();
        if (PROBE_PH == 20 && c < 128) tacc += __builtin_amdgcn_s_memrealtime() - t0;
        if (PROBE_PH == 24 && c >= 128) tacc += __builtin_amdgcn_s_memrealtime() - t0;
        if (PROBE_PH == 21) t0 = __builtin_amdgcn_s_memrealtime();
        if (c < 128) gdn_seq_block(a, c, lds, w, lane); else gla_seq_block(a, c - 128, lds, w, lane);
        __syncthreads();
        if (PROBE_PH == 21) tacc += __builtin_amdgcn_s_memrealtime() - t0;
    }
    if (PROBE_PH == 22) t0 = __builtin_amdgcn_s_memrealtime();
    {
        LAS unsigned char* scr = lds + w * 8448;
        if (nblk == 256) { const int per = bid < 128 ? 16 : 32, first = bid < 128 ? (bid * 8 + w) * 16 : 16384 + ((bid - 128) * 8 + w) * 32;
            tr_experts_range(a, l, scr, first, first + per, 1, lane); }
        else tr_experts_range(a, l, scr, bid * 8 + w, NEXP * 3 * 512, nblk * 8, lane);
    }
    if (PROBE_PH == 22) tacc += __builtin_amdgcn_s_memrealtime() - t0;
    __syncthreads();
    if (PROBE_PH == 23) t0 = __builtin_amdgcn_s_memrealtime();
    if (nblk == 256) {
        if (bid < 128) hyena_unit<SEQ>(a, l, bid, lds);
        else { const int g = bid - 128; hyena_unit<SEQ>(a, l, 128 + g, lds); hyena_unit<CTXL>(a, l, 2 * g, lds); hyena_unit<CTXL>(a, l, 2 * g + 1, lds); }
    } else {
        for (int it = bid; it < 512; it += nblk) { if (it < 256) hyena_unit<SEQ>(a, l, it, lds); else hyena_unit<CTXL>(a, l, it - 256, lds); }
    }
    if (PROBE_PH == 23) tacc += __builtin_amdgcn_s_memrealtime() - t0;
}

__device__ __forceinline__ void ph_post_hyena(CArgs& a, int l, LAS unsigned char* lds, int bid, int nblk) {
    const bf16* P = (const bf16*)(a.ws + WS_P);
    const float* YT = (const float*)(a.ws + WS_MIX + MX_YT); bf16* YMIX = (bf16*)(a.ws + WS_YMIX);
    LAS float* yt = (LAS float*)lds;
    const int tid = tidx(), c4 = (tid & 63) * 4, tg = tid >> 6;
    const float* hw = a.in[I_HYCW] + l * 3 * 768; const float* hb = a.in[I_HYCB] + l * 768;
    f32x4 w0[3], wx[3], wv[3];
#pragma unroll
    for (int k = 0; k < 3; ++k) { w0[k] = *(const f32x4*)(hw + k * 768 + c4); wx[k] = *(const f32x4*)(hw + k * 768 + 256 + c4); wv[k] = *(const f32x4*)(hw + k * 768 + 512 + c4); }
    const f32x4 b0 = *(const f32x4*)(hb + c4), bx = *(const f32x4*)(hb + 256 + c4), bv = *(const f32x4*)(hb + 512 + c4), hd = *(const f32x4*)(a.in[I_HYD] + l * 256 + c4);
#pragma unroll 1
    for (int it = bid; it < 576; it += nblk) {
        const Chunk c = chunk_of(it);
        const int soff = c.L == CTXL ? 0 : CTXL;
        { const int ch = tid & 255, half = tid >> 8;
          const float* srcp = YT + ((size_t)(ch * 16 + c.b)) * 2304 + soff + c.t0 + half * 32;
#pragma unroll
          for (int j = 0; j < 8; ++j) { const f32x4 v = *(const f32x4*)(srcp + 4 * j);
              yt[(half * 32 + 4 * j) * 260 + ch] = v[0]; yt[(half * 32 + 4 * j + 1) * 260 + ch] = v[1]; yt[(half * 32 + 4 * j + 2) * 260 + ch] = v[2]; yt[(half * 32 + 4 * j + 3) * 260 + ch] = v[3]; } }
        __syncthreads();
        const int tb = c.t0 + tg * 8;
        const bf16* pb = P + (size_t)(c.row0 + tg * 8) * D_INP;
        f32x4 x0[10], x1[10], vv[10];
#pragma unroll
        for (int r = 0; r < 10; ++r) { const int t = tb + r - 1, tc = min(max(t, c.lo), c.hi - 1); const float ok = (t == tc) ? 1.f : 0.f; const bf16* p = pb + (ptrdiff_t)(tc - tb) * D_INP;
            x0[r] = ok * bf4(*(const u32x2*)(p + HY0 + c4));
            x1[r] = ok * bf4(*(const u32x2*)(p + HY0 + 256 + c4)); vv[r] = ok * bf4(*(const u32x2*)(p + HY0 + 512 + c4)); }
#pragma unroll
        for (int tt = 0; tt < 8; ++tt) {
            const f32x4 u0 = w0[0] * x0[tt] + w0[1] * x0[tt + 1] + w0[2] * x0[tt + 2] + b0;
            const f32x4 xx = wx[0] * x1[tt] + wx[1] * x1[tt + 1] + wx[2] * x1[tt + 2] + bx, v2 = wv[0] * vv[tt] + wv[1] * vv[tt + 1] + wv[2] * vv[tt + 2] + bv, z = xx * v2;
            const f32x4 y = *(const LAS f32x4*)(yt + (tg * 8 + tt) * 260 + c4);
            const f32x4 o = (y + z * hd) * u0;
            u32x2 oo; oo.x = pk2(o[0], o[1]); oo.y = pk2(o[2], o[3]); *(u32x2*)(YMIX + (size_t)(c.row0 + tg * 8 + tt) * D + c4) = oo;
        }
        __syncthreads();
    }
}
__device__ __forceinline__ void ph_post_tok(CArgs& a, int l, int gw, int ngw) {
    const int lane = tidx() & 63;
    const bf16* P = (const bf16*)(a.ws + WS_P); bf16* YMIX = (bf16*)(a.ws + WS_YMIX);
    const float* GOF = (const float*)(a.ws + WS_MIX + MX_GOF); const float* GOB = (const float*)(a.ws + WS_MIX + MX_GOB);
    const float* DOF = (const float*)(a.ws + WS_MIX + MX_DOF); const float* DOB = (const float*)(a.ws + WS_MIX + MX_DOB);
    const f32x4 nwa = *(const f32x4*)(a.in[I_GLANW] + l * 64 + (4 * lane & 63)), nwd = *(const f32x4*)(a.in[I_GDNNW] + l * 64 + (4 * lane & 63));
#pragma unroll 1
    for (int row0 = gw; row0 < NTOK; row0 += 4 * ngw) {
        f32x4 og[4], od[4]; u32x2 r2[4], z2[4];
#pragma unroll
        for (int r = 0; r < 4; ++r) { const int row = min(row0 + r * ngw, NTOK - 1); const size_t o4 = (size_t)row * 256 + 4 * lane;
            og[r] = *(const f32x4*)(GOF + o4) + *(const f32x4*)(GOB + o4); od[r] = *(const f32x4*)(DOF + o4) + *(const f32x4*)(DOB + o4);
            r2[r] = *(const u32x2*)(P + (size_t)row * D_INP + GLA0 + 512 + 4 * lane); z2[r] = *(const u32x2*)(P + (size_t)row * D_INP + GDN0 + 768 + 4 * lane); }
#pragma unroll
        for (int r = 0; r < 4; ++r) { const int row = row0 + r * ngw;
            if (row < NTOK) {
                float sg = og[r][0] * og[r][0] + og[r][1] * og[r][1] + og[r][2] * og[r][2] + og[r][3] * og[r][3], sd = od[r][0] * od[r][0] + od[r][1] * od[r][1] + od[r][2] * od[r][2] + od[r][3] * od[r][3];
                sg = row16_sum(sg); sd = row16_sum(sd);
                const float rg = rsqrtf(sg * (1.f / 64.f) + 1e-6f), rd = rsqrtf(sd * (1.f / 64.f) + 1e-6f);
                u32x2 w;
                w.x = pk2(og[r][0] * rg * nwa[0] * siluf_(lo_bf(r2[r].x)), og[r][1] * rg * nwa[1] * siluf_(hi_bf(r2[r].x))); w.y = pk2(og[r][2] * rg * nwa[2] * siluf_(lo_bf(r2[r].y)), og[r][3] * rg * nwa[3] * siluf_(hi_bf(r2[r].y)));
                *(u32x2*)(YMIX + (size_t)row * D + 512 + 4 * lane) = w;
                w.x = pk2(od[r][0] * rd * nwd[0] * siluf_(lo_bf(z2[r].x)), od[r][1] * rd * nwd[1] * siluf_(hi_bf(z2[r].x))); w.y = pk2(od[r][2] * rd * nwd[2] * siluf_(lo_bf(z2[r].y)), od[r][3] * rd * nwd[3] * siluf_(hi_bf(z2[r].y)));
                *(u32x2*)(YMIX + (size_t)row * D + 768 + 4 * lane) = w; } }
    }
}

__device__ __forceinline__ void ph_ln1_route(CArgs& a, int l, LAS unsigned char* lds, int bid, int nblk) {
    const int tid = tidx(), lane = tid & 63, w = __builtin_amdgcn_readfirstlane(tid >> 6);
    const float* MOD = (const float*)(a.ws + WS_MOD) + (size_t)l * 17 * 6144;
    float* X = (float*)(a.ws + WS_X); const float* TMP = (const float*)(a.ws + WS_TMP); bf16* HB = (bf16*)(a.ws + WS_HB);
    const float* lg = a.in[I_LN1G] + l * D; const float* lb = a.in[I_LN1B] + l * D;
    const float* br = a.in[I_BR] + l * NEXP;
    const bf16* wh = (const bf16*)(a.ws + WS_WRT) + (size_t)l * NEXP * D; const bf16* wl = wh + DEPTH * NEXP * D;
    unsigned* cnt = (unsigned*)(a.ws + WS_CTL) + CW_CNT + l * NEXP * 64;
    int* LIST = (int*)(a.ws + WS_LIST); int* TOPE = (int*)(a.ws + WS_TOPE); float* TOPW = (float*)(a.ws + WS_TOPW);
    LAS float* hrow = (LAS float*)lds;
    LAS float* part = (LAS float*)(lds + 65792);
    const int row_lo = (l == DEPTH - 1) ? NTOK_C : 0;
    const int e = lane & 31, par = lane >> 5, fr = lane & 15, kg = lane >> 4;
    f32x4 xv[2][4], tv[2][4];
#define LN1_FETCH(base_) do { _Pragma("unroll") for (int t = 0; t < 2; ++t) { const int row_ = (base_) + 2 * w + t; \
        const float* xs_ = (l == 0) ? (row_ < NTOK_C ? a.in[I_CTX] + (size_t)row_ * D : a.in[I_X] + (size_t)(row_ - NTOK_C) * D) : X + (size_t)row_ * D; \
        _Pragma("unroll") for (int j = 0; j < 4; ++j) { xv[t][j] = *(const f32x4*)(xs_ + j * 256 + 4 * lane); tv[t][j] = *(const f32x4*)(TMP + (size_t)row_ * D + j * 256 + 4 * lane); } } } while (0)
    constexpr int CAP = 112;
    LAS unsigned* lcnt = (LAS unsigned*)(lds + 82176);
    LAS int* ent = (LAS int*)(lds + 82176 + 256);
    LAS float* entw = (LAS float*)(lds + 82176 + 256 + CAP * 256);
    if (tid < 32) lcnt[tid] = 0u;
    int base = row_lo + bid * 16, base0 = base, nb = 0;
#define LN1_FLUSH do { __syncthreads(); \
        if (tid < 32) { const unsigned n_ = lcnt[tid]; unsigned g_ = 0u; if (n_) g_ = atomicAdd(cnt + tid * 64, n_); lcnt[32 + tid] = g_; lcnt[tid] = 0u; } \
        __syncthreads(); \
        for (int idx = tid; idx < nb * 64; idx += 512) { const int pe_ = ent[idx], ee_ = pe_ >> 20; const unsigned pos_ = lcnt[32 + ee_] + (unsigned)(pe_ & 0xfffff); \
            const int row_ = base0 + (idx >> 6) * nblk * 16 + ((idx >> 2) & 15); \
            LIST[(size_t)ee_ * NTOK + pos_] = row_; TOPE[(size_t)row_ * 4 + (idx & 3)] = (ee_ << 20) | (int)pos_; TOPW[(size_t)row_ * 4 + (idx & 3)] = entw[idx]; } \
        __syncthreads(); nb = 0; } while (0)
    if (base < NTOK) LN1_FETCH(base);
    bf16x8 Bh[4][2], Bl[4][2];
#pragma unroll
    for (int ss = 0; ss < 4; ++ss)
#pragma unroll
        for (int t = 0; t < 2; ++t) { const size_t wo = (size_t)(16 * t + fr) * D + 128 * w + 32 * ss + 8 * kg; Bh[ss][t] = *(const bf16x8*)(wh + wo); Bl[ss][t] = *(const bf16x8*)(wl + wo); }
    const float bre = br[e];
#pragma unroll 1
    for (; base < NTOK; base += nblk * 16) {
#pragma unroll
        for (int t = 0; t < 2; ++t) {
            const int row = base + 2 * w + t;
            const float* mv = MOD + (size_t)mod_vec(row) * 6144;
            f32x4 v[4]; float s = 0.f;
#pragma unroll
            for (int j = 0; j < 4; ++j) { const int c0 = j * 256 + 4 * lane; const f32x4 g1 = *(const f32x4*)(mv + 2048 + c0);
                v[j] = DN_ALPHA * xv[t][j] + g1 * tv[t][j]; s += (v[j][0] + v[j][1]) + (v[j][2] + v[j][3]); }
            const float mean = wave_sum(s) * (1.f / D); float s2 = 0.f;
#pragma unroll
            for (int j = 0; j < 4; ++j) { v[j] = v[j] - mean; s2 += (v[j][0] * v[j][0] + v[j][1] * v[j][1]) + (v[j][2] * v[j][2] + v[j][3] * v[j][3]); }
            const float rstd = rsqrtf(wave_sum(s2) * (1.f / D) + LN_EPS);
#pragma unroll
            for (int j = 0; j < 4; ++j) { const int c0 = j * 256 + 4 * lane; const f32x4 g = *(const f32x4*)(lg + c0), bb = *(const f32x4*)(lb + c0), sh = *(const f32x4*)(mv + 3072 + c0), sc = *(const f32x4*)(mv + 4096 + c0);
                const f32x4 xn = v[j] * rstd * g + bb; *(f32x4*)(X + (size_t)row * D + c0) = xn;
                const f32x4 hh = xn * (1.f + sc) + sh;
                *(unsigned*)(a.ws + WS_HB8 + (size_t)row * D + c0) = pk4_fp8(4.f * hh[0], 4.f * hh[1], 4.f * hh[2], 4.f * hh[3]);
                *(LAS f32x4*)(hrow + (2 * w + t) * 1028 + c0) = hh; }
        }
        __syncthreads();
        if (base + nblk * 16 < NTOK) LN1_FETCH(base + nblk * 16);
        {
            f32x4 acc[2] = {(f32x4){0.f, 0.f, 0.f, 0.f}, (f32x4){0.f, 0.f, 0.f, 0.f}};
#pragma unroll
            for (int ss = 0; ss < 4; ++ss) { const int k0 = 128 * w + 32 * ss + 8 * kg;
                const f32x4 h0 = *(const LAS f32x4*)(hrow + fr * 1028 + k0), h1 = *(const LAS f32x4*)(hrow + fr * 1028 + k0 + 4);
                u32x4 ah, al;
                ah.x = pk2(h0[0], h0[1]); ah.y = pk2(h0[2], h0[3]); ah.z = pk2(h1[0], h1[1]); ah.w = pk2(h1[2], h1[3]);
                al.x = pk2(h0[0] - lo_bf(ah.x), h0[1] - hi_bf(ah.x)); al.y = pk2(h0[2] - lo_bf(ah.y), h0[3] - hi_bf(ah.y)); al.z = pk2(h1[0] - lo_bf(ah.z), h1[1] - hi_bf(ah.z)); al.w = pk2(h1[2] - lo_bf(ah.w), h1[3] - hi_bf(ah.w));
                const bf16x8 Ah = __builtin_bit_cast(bf16x8, ah), Al = __builtin_bit_cast(bf16x8, al);
#pragma unroll
                for (int t = 0; t < 2; ++t) {
                    acc[t] = __builtin_amdgcn_mfma_f32_16x16x32_bf16(Ah, Bh[ss][t], acc[t], 0, 0, 0);
                    acc[t] = __builtin_amdgcn_mfma_f32_16x16x32_bf16(Ah, Bl[ss][t], acc[t], 0, 0, 0);
                    acc[t] = __builtin_amdgcn_mfma_f32_16x16x32_bf16(Al, Bh[ss][t], acc[t], 0, 0, 0); } }
#pragma unroll
            for (int t = 0; t < 2; ++t)
#pragma unroll
                for (int j = 0; j < 4; ++j) part[((w * 2 + t) * 16 + 4 * kg + j) * 16 + fr] = acc[t][j];
        }
        __syncthreads();
        {
            float cur = bre;
#pragma unroll
            for (int ww = 0; ww < 8; ++ww) cur += part[((ww * 2 + (e >> 4)) * 16 + 2 * w + par) * 16 + (e & 15)];
            float tvv[4]; int ti[4];
#pragma unroll
            for (int k = 0; k < 4; ++k) { float bv = cur; int bi = e;
#define TOPSTEP(OV, OI) do { const float ov = (OV); const int oi = (OI); if (ov > bv || (ov == bv && oi < bi)) { bv = ov; bi = oi; } } while (0)
                TOPSTEP(dpp_f<0xB1>(bv), dpp_i<0xB1>(bi)); TOPSTEP(dpp_f<0x4E>(bv), dpp_i<0x4E>(bi)); TOPSTEP(dpp_f<0x141>(bv), dpp_i<0x141>(bi)); TOPSTEP(dpp_f<0x140>(bv), dpp_i<0x140>(bi));
                TOPSTEP(__shfl_xor(bv, 16), __shfl_xor(bi, 16));
#undef TOPSTEP
                tvv[k] = bv; ti[k] = bi; if (e == bi) cur = -3.0e38f; }
            const float e1 = __expf(tvv[1] - tvv[0]), e2 = __expf(tvv[2] - tvv[0]), e3 = __expf(tvv[3] - tvv[0]); const float inv = 1.f / (1.f + e1 + e2 + e3);
            if (e < 4) {
                const int ee = e == 0 ? ti[0] : e == 1 ? ti[1] : e == 2 ? ti[2] : ti[3]; const float ww = (e == 0 ? 1.f : e == 1 ? e1 : e == 2 ? e2 : e3) * inv;
                const unsigned lp = __hip_atomic_fetch_add(lcnt + ee, 1u, __ATOMIC_RELAXED, __HIP_MEMORY_SCOPE_WORKGROUP);
                const int idx = nb * 64 + w * 8 + par * 4 + e;
                ent[idx] = (ee << 20) | (int)lp; entw[idx] = ww; }
        }
        ++nb;
        if (nb == CAP) { LN1_FLUSH; base0 = base + nblk * 16; }
    }
    if (nb > 0) LN1_FLUSH;
#undef LN1_FLUSH
#undef LN1_FETCH
}
__device__ __forceinline__ void moe_tables(CArgs& a, int l, LAS unsigned char* lds, int NT) {
    LAS int* pre = (LAS int*)(lds + TAB_OFF); LAS int* mtl = pre + 40; LAS int* rowoff = pre + 80; LAS int* cn = pre + 120;
    if (tidx() < 64) {
        const int lane = tidx(), e = lane & 31;
        const unsigned* cnt = (const unsigned*)(a.ws + WS_CTL) + CW_CNT + l * NEXP * 64;
        const int n = (int)__hip_atomic_load(cnt + e * 64, __ATOMIC_RELAXED, __HIP_MEMORY_SCOPE_AGENT), m = (n + 255) >> 8;
        int incl = m;
#pragma unroll
        for (int d = 1; d < 32; d <<= 1) { const int t = __shfl_up(incl, d, 32); if (e >= d) incl += t; }
        const int excl = incl - m;
        if (lane < 32) { pre[e] = excl * NT; mtl[e] = m > 0 ? m : 1; rowoff[e] = excl * 256; cn[e] = n; if (e == 31) pre[32] = incl * NT; }
    }
    __syncthreads();
}
__device__ __forceinline__ void ph_ln2(CArgs& a, int l, LAS unsigned char* lds, int gw, int ngw) {
    const int lane = tidx() & 63;
    const float* MOD = (const float*)(a.ws + WS_MOD) + (size_t)l * 17 * 6144;
    float* X = (float*)(a.ws + WS_X); const bf16* YD = (const bf16*)(a.ws + WS_YD); bf16* HB = (bf16*)(a.ws + WS_HB);
    const float* lg = a.in[I_LN2G] + l * D; const float* lb = a.in[I_LN2B] + l * D;
    const int* TOPE = (const int*)(a.ws + WS_TOPE); const float* TOPW = (const float*)(a.ws + WS_TOPW);
    const LAS int* rowoff = (const LAS int*)(lds + TAB_OFF) + 80;
    const bool lastl = (l == DEPTH - 1);
    const int row_lo = lastl ? NTOK_C : 0;
    f32x4 lgv[4], lbv[4];
#pragma unroll
    for (int j = 0; j < 4; ++j) { lgv[j] = *(const f32x4*)(lg + j * 256 + 4 * lane); lbv[j] = *(const f32x4*)(lb + j * 256 + 4 * lane); }
    int te[2][4]; float tw[2][4];
    { const int row0 = min(row_lo + gw * 2, NTOK - 2);
#pragma unroll
      for (int r = 0; r < 2; ++r)
#pragma unroll
          for (int k = 0; k < 4; ++k) { te[r][k] = TOPE[(size_t)(row0 + r) * 4 + k]; tw[r][k] = TOPW[(size_t)(row0 + r) * 4 + k]; } }
#pragma unroll 1
    for (int row0 = row_lo + gw * 2; row0 < NTOK; row0 += ngw * 2) {
        u32x2 y2[2][4][4]; f32x4 xv[2][4], g2v[4], shv[4], scv[4]; float cw[2][4];
        const float* mv = MOD + (size_t)mod_vec(row0) * 6144;
        const float* mvn = mv + 17 * 6144;
#pragma unroll
        for (int r = 0; r < 2; ++r) {
            const int row = row0 + r;
#pragma unroll
            for (int k = 0; k < 4; ++k) { cw[r][k] = tw[r][k];
                const bf16* yr = YD + ((size_t)(rowoff[te[r][k] >> 20] + (te[r][k] & 0xfffff))) * D;
#pragma unroll
                for (int j = 0; j < 4; ++j) y2[r][k][j] = *(const u32x2*)(yr + j * 256 + 4 * lane); }
#pragma unroll
            for (int j = 0; j < 4; ++j) xv[r][j] = *(const f32x4*)(X + (size_t)row * D + j * 256 + 4 * lane);
        }
#pragma unroll
        for (int j = 0; j < 4; ++j) { const int c0 = j * 256 + 4 * lane; g2v[j] = *(const f32x4*)(mv + 5120 + c0);
            if (!lastl) { shv[j] = *(const f32x4*)(mvn + c0); scv[j] = *(const f32x4*)(mvn + 1024 + c0); } else { shv[j] = (f32x4){0.f, 0.f, 0.f, 0.f}; scv[j] = shv[j]; } }
        { const int rown = min(row0 + ngw * 2, NTOK - 2);
#pragma unroll
          for (int r = 0; r < 2; ++r)
#pragma unroll
              for (int k = 0; k < 4; ++k) { te[r][k] = TOPE[(size_t)(rown + r) * 4 + k]; tw[r][k] = TOPW[(size_t)(rown + r) * 4 + k]; } }
#pragma unroll
        for (int r = 0; r < 2; ++r) {
            const int row = row0 + r;
            f32x4 v[4]; float s = 0.f;
#pragma unroll
            for (int j = 0; j < 4; ++j) { f32x4 f = (f32x4){0.f, 0.f, 0.f, 0.f};
#pragma unroll
                for (int k = 0; k < 4; ++k) { const u32x2 yy = y2[r][k][j]; f += cw[r][k] * (f32x4){lo_bf(yy.x), hi_bf(yy.x), lo_bf(yy.y), hi_bf(yy.y)}; }
                v[j] = DN_ALPHA * xv[r][j] + g2v[j] * f; s += (v[j][0] + v[j][1]) + (v[j][2] + v[j][3]); }
            const float mean = wave_sum(s) * (1.f / D); float s2 = 0.f;
#pragma unroll
            for (int j = 0; j < 4; ++j) { v[j] = v[j] - mean; s2 += (v[j][0] * v[j][0] + v[j][1] * v[j][1]) + (v[j][2] * v[j][2] + v[j][3] * v[j][3]); }
            const float rstd = rsqrtf(wave_sum(s2) * (1.f / D) + LN_EPS);
#pragma unroll
            for (int j = 0; j < 4; ++j) { const int c0 = j * 256 + 4 * lane;
                const f32x4 xn = v[j] * rstd * lgv[j] + lbv[j];
                if (lastl) *(f32x4*)(a.out + (size_t)(row - NTOK_C) * D + c0) = xn;
                else { *(f32x4*)(X + (size_t)row * D + c0) = xn; const f32x4 hh = xn * (1.f + scv[j]) + shv[j];
                    u32x2 o; o.x = pk2(hh[0], hh[1]); o.y = pk2(hh[2], hh[3]); *(u32x2*)(HB + (size_t)row * D + c0) = o; } }
        }
    }
}

constexpr int NPH = 2 + DEPTH * 9;
__device__ __forceinline__ CArgs* kargs() { CArgs* p = (CArgs*)__builtin_amdgcn_kernarg_segment_ptr(); asm volatile("" : "+s"(p)); return p; }
__global__ void __launch_bounds__(512, 2) trunk_fwd(Args a_unused) {
    extern __shared__ __attribute__((aligned(16))) unsigned char lds_raw[];
    LAS unsigned char* lds = (LAS unsigned char*)lds_raw;
    const int tid = threadIdx.x, wave = __builtin_amdgcn_readfirstlane(tid >> 6);
    const int bid = blockIdx.x, nblk = gridDim.x, gw = bid * 8 + wave, ngw = nblk * 8;
    volatile LAS unsigned* MISC = (volatile LAS unsigned*)(lds + MISC_OFF);
    if (tid < 64) MISC[tid] = 0u;
    __syncthreads();
    XcdBarrier bar; bar.x = 0; bar.st = nullptr;
    int lo, hi;
    { CArgs& a = *kargs(); lo = a.ph_lo; hi = a.ph_hi; bar.bar = (unsigned*)(a.ws + WS_CTL) + CW_BAR;
      if (hi - lo > 1) bar = xcd_barrier_post((unsigned*)(a.ws + WS_CTL) + CW_BAR, MISC); }
#define IN(k) (lo <= (k) && (k) < hi)
    unsigned long long tacc = 0ull, tbeg = 0ull;
#define PB_BEG(ty) do { if (PROBE_PH == (ty)) tbeg = __builtin_amdgcn_s_memrealtime(); } while (0)
#define PB_END(ty) do { if (PROBE_PH == (ty)) tacc += __builtin_amdgcn_s_memrealtime() - tbeg; } while (0)
#define SEAM(k) do { if (IN(k) && IN((k) + 1)) xcd_barrier(bar); } while (0)
    PB_BEG(0);
    if (IN(0)) { CArgs& a = *kargs(); unsigned long long t0 = 0ull;
#define PB_SUB(ty, stmt) do { if (PROBE_PH == (ty)) t0 = __builtin_amdgcn_s_memrealtime(); stmt; if (PROBE_PH == (ty)) tacc += __builtin_amdgcn_s_memrealtime() - t0; } while (0)
        PB_SUB(30, ph_mod(a, lds, bid, nblk)); __syncthreads(); PB_SUB(31, ph_filters(a, gw, ngw)); PB_SUB(32, ph_tr_small(a, lds, gw, ngw)); PB_SUB(33, ph_router_w(a, bid * 512 + tid, nblk * 512));
#undef PB_SUB
    }
    SEAM(0); PB_END(0); PB_BEG(1);
    if (IN(1)) { CArgs& a = *kargs(); ph_mod_input(a, gw, ngw); }
    SEAM(1); PB_END(1);
#pragma unroll 1
    for (int l = 0; l < DEPTH; ++l) {
        const int p0 = 2 + 9 * l;
        const bool lastl = (l == DEPTH - 1);
        PB_BEG(2);
        if (IN(p0 + 0)) {
            CArgs& a = *kargs();
            pg8::DenseSched S; S.init((const bf16*)(a.ws + WS_WIN) + (size_t)l * D_INP * 1024, 1024, NTOK, D_INP, nblk, bid, 0);
            pg8::EpiBf16 E{(bf16*)(a.ws + WS_P), D_INP, 0};
            pg8::gemm_phase<pg8::EpiBf16, pg8::DenseSched, true>(lds, (const char*)(a.ws + WS_HB), 1024, S, E);
        }
        SEAM(p0 + 0); PB_END(2); PB_BEG(3);
        if (IN(p0 + 1)) { CArgs& a = *kargs(); PB_BEG(50); ph_prep_conv(a, l, lds, bid, nblk); PB_END(50); PB_BEG(51); ph_prep_tok(a, l, lds, gw, ngw); PB_END(51); }
        SEAM(p0 + 1); PB_END(3); PB_BEG(4);
        if (IN(p0 + 2)) { CArgs& a = *kargs(); ph_scan(a, l, lds, bid, nblk, tacc); }
        SEAM(p0 + 2); PB_END(4); PB_BEG(5);
        if (IN(p0 + 3)) { CArgs& a = *kargs(); PB_BEG(52); ph_post_hyena(a, l, lds, bid, nblk); PB_END(52); PB_BEG(53); ph_post_tok(a, l, gw, ngw); PB_END(53); }
        SEAM(p0 + 3); PB_END(5); PB_BEG(6);
        if (IN(p0 + 4)) {
            CArgs& a = *kargs();
            const int r0 = lastl ? NTOK_C : 0;
            pg8::DenseSched S; S.init((const bf16*)(a.ws + WS_WOUT) + (size_t)l * 1024 * 1024, 1024, NTOK - r0, 1024, nblk, bid, r0);
            pg8::EpiF32 E{(float*)(a.ws + WS_TMP), 1024, r0};
            pg8::gemm_phase<pg8::EpiF32, pg8::DenseSched, true>(lds, (const char*)(a.ws + WS_YMIX), 1024, S, E);
        }
        SEAM(p0 + 4); PB_END(6); PB_BEG(7);
        if (IN(p0 + 5)) { CArgs& a = *kargs(); ph_ln1_route(a, l, lds, bid, nblk); }
        SEAM(p0 + 5); PB_END(7); PB_BEG(8);
        if (IN(p0 + 6)) {
            CArgs& a = *kargs();
            moe_tables(a, l, lds, 8);
            const LAS int* tb = (const LAS int*)(lds + TAB_OFF);
            pg8::MoeSched<true, 8> S; S.Bt = (const char*)(a.ws + WS_WGU); S.bstride = (size_t)2048 * 1024; S.rb = 1024; S.list = (const int*)(a.ws + WS_LIST);
            S.pre = tb; S.mtl = tb + 40; S.rowoff = tb + 80; S.cnt = tb + 120; S.K = 1024; S.G = nblk; S.c = (nblk % 8 == 0) ? (bid % 8) * (nblk / 8) + bid / 8 : bid; S.total = tb[32];
            pg8::EpiSwiglu E{(bf16*)(a.ws + WS_H), a.in[I_BG] + (size_t)l * NEXP * 1024, a.in[I_BU] + (size_t)l * NEXP * 1024, tb + 80, 1.f / 128.f};
            pg8::gemm_phase_f8g<pg8::EpiSwiglu, pg8::MoeSched<true, 8>, true>(lds, (const char*)(a.ws + WS_HB8), 1024, S, E);
        }
        SEAM(p0 + 6); PB_END(8); PB_BEG(9);
        if (IN(p0 + 7)) {
            CArgs& a = *kargs();
            moe_tables(a, l, lds, 4);
            const LAS int* tb = (const LAS int*)(lds + TAB_OFF);
            pg8::MoeSched<false, 4> S; S.Bt = (const char*)(a.ws + WS_WD); S.bstride = (size_t)1024 * 1024; S.rb = 1024; S.list = nullptr;
            S.pre = tb; S.mtl = tb + 40; S.rowoff = tb + 80; S.cnt = tb + 120; S.K = 1024; S.G = nblk; S.c = (nblk % 8 == 0) ? (bid % 8) * (nblk / 8) + bid / 8 : bid; S.total = tb[32];
            pg8::EpiDown E{(bf16*)(a.ws + WS_YD), a.in[I_BD] + (size_t)l * NEXP * 1024, tb + 80, 1.f / 128.f};
            pg8::gemm_phase_f8<pg8::EpiDown, pg8::MoeSched<false, 4>, true>(lds, (const char*)(a.ws + WS_H), 1024, S, E);
        }
        SEAM(p0 + 7); PB_END(9); PB_BEG(10);
        if (IN(p0 + 8)) { CArgs& a = *kargs(); moe_tables(a, l, lds, 4); ph_ln2(a, l, lds, gw, ngw); }
        if (!lastl) SEAM(p0 + 8);
        PB_END(10);
    }
    if (PROBE_PH >= 0) { const unsigned long long t0 = __builtin_amdgcn_s_memrealtime(); while (__builtin_amdgcn_s_memrealtime() - t0 < tacc) __builtin_amdgcn_s_sleep(8); }
#undef IN
#undef SEAM
}

extern "C" void kernel_launch(void* const* d_in, const int* in_sizes, int n_in, void* d_out, int out_size, void* d_ws, size_t ws_size, hipStream_t stream) {
    static int grid = 0;
    if (grid == 0) {
        if (n_in != 39 || out_size != NTOK_L * D || ws_size < WS_END) { fprintf(stderr, "kernel_launch: unexpected problem (n_in %d, out %d, ws %zu < %zu)\n", n_in, out_size, ws_size, (size_t)WS_END); grid = -1; return; }
        int dev = 0, cus = 0, per_cu = 0;
        if (hipGetDevice(&dev) != hipSuccess || hipDeviceGetAttribute(&cus, hipDeviceAttributeMultiprocessorCount, dev) != hipSuccess) { grid = -1; return; }
        if (hipFuncSetAttribute((const void*)trunk_fwd, hipFuncAttributeMaxDynamicSharedMemorySize, LDS_BYTES) != hipSuccess) { fprintf(stderr, "kernel_launch: hipFuncSetAttribute failed\n"); grid = -1; return; }
        if (hipOccupancyMaxActiveBlocksPerMultiprocessor(&per_cu, (const void*)trunk_fwd, 512, LDS_BYTES) != hipSuccess || per_cu < 1) fprintf(stderr, "kernel_launch: occupancy query says %d\n", per_cu);
        (void)hipGetLastError();
        grid = cus;
    }
    if (grid < 0) return;
    (void)hipMemsetAsync((char*)d_ws + WS_CTL, 0, CTL_ZERO_BYTES, stream);
    Args a{};
    for (int i = 0; i < 39; ++i) a.in[i] = (const float*)d_in[i];
    a.out = (float*)d_out; a.ws = (unsigned char*)d_ws;
#if MK_FUSED
    a.ph_lo = 0; a.ph_hi = NPH;
    hipLaunchKernelGGL(trunk_fwd, dim3(grid), dim3(512), LDS_BYTES, stream, a);
#else
    for (int p = 0; p < NPH; ++p) { a.ph_lo = p; a.ph_hi = p + 1; hipLaunchKernelGGL(trunk_fwd, dim3(grid), dim3(512), LDS_BYTES, stream, a); }
#endif
}
```

```cpp
#include <hip/hip_runtime.h>
#include <cstdio>
#include <cstdint>

#ifndef MK_FUSED
#define MK_FUSED 1
#endif

#ifndef USE_NEW_GDN
#define USE_NEW_GDN 1
#endif
#ifndef USE_NEW_GLA
#define USE_NEW_GLA 1
#endif
#ifndef PROBE_PH
#define PROBE_PH -1
#endif

#define LAS __attribute__((address_space(3)))
#define GAS __attribute__((address_space(1)))
typedef unsigned short bf16;
typedef short bf16x8 __attribute__((ext_vector_type(8)));
typedef float f32x4 __attribute__((ext_vector_type(4)));
typedef float f32x2 __attribute__((ext_vector_type(2)));
typedef unsigned u32x4 __attribute__((ext_vector_type(4)));
typedef unsigned u32x2 __attribute__((ext_vector_type(2)));

constexpr int D = 1024, NB = 16, SEQ = 2048, CTXL = 256, DEPTH = 4;
constexpr int NTOK_C = NB * CTXL, NTOK_L = NB * SEQ, NTOK = NTOK_C + NTOK_L;
constexpr int D_IN = 3376, D_INP = 3584;
constexpr int HY0 = 0, SC0 = 768, GLA0 = 1536, GDN0 = 2336;
constexpr int NEXP = 32, TOPK = 4;
constexpr int MAXROWS = NTOK * TOPK + NEXP * 256;
constexpr float DN_ALPHA = 1.681792830507429f;
constexpr float LN_EPS = 1e-5f;

constexpr size_t MiB = 1u << 20;
constexpr size_t WS_CTL = 0, CTL_ZERO_BYTES = 1 * MiB;
constexpr size_t WS_MOD = 1 * MiB;
constexpr size_t WS_WRT = 3 * MiB;
constexpr size_t WS_KUN = 4 * MiB;
constexpr size_t WS_WIN = 36 * MiB;
constexpr size_t WS_WOUT = 64 * MiB;
constexpr size_t WS_WGU = 72 * MiB;
constexpr size_t WS_WD = 200 * MiB;
constexpr size_t WS_X = 264 * MiB;
constexpr size_t WS_HB = 408 * MiB;
constexpr size_t WS_P = 480 * MiB;
constexpr size_t WS_YMIX = 732 * MiB;
constexpr size_t WS_YD = WS_P;
constexpr size_t WS_TMP = 804 * MiB;
constexpr size_t WS_LIST = 948 * MiB;
constexpr size_t WS_TOPE = 953 * MiB;
constexpr size_t WS_TOPW = 954 * MiB;
constexpr size_t WS_H = 956 * MiB;
constexpr size_t WS_MIX = 1264 * MiB;
constexpr size_t MX_ZT = 0;
constexpr size_t MX_YT = 20 * MiB;
constexpr size_t MX_GDF = 56 * MiB, MX_GDB = 76 * MiB;
constexpr size_t MX_GOF = 96 * MiB, MX_GOB = 132 * MiB;
constexpr size_t MX_DQ = 168 * MiB, MX_DK = 204 * MiB, MX_DV = 240 * MiB;
constexpr size_t MX_DG = 276 * MiB;
constexpr size_t MX_DOF = 280 * MiB, MX_DOB = 316 * MiB;
constexpr size_t WS_HB8 = 1616 * MiB;
constexpr size_t WS_END = 1980 * MiB;
constexpr int NUNIT = 128 * 36;
constexpr size_t WS_CKD = 1656 * MiB;
constexpr size_t CD_M = 0;
constexpr size_t CD_E = 36 * MiB;
constexpr size_t CD_BT = 72 * MiB;
constexpr size_t CD_FT = 144 * MiB;
constexpr size_t CD_KB = 180 * MiB, CD_QB = 198 * MiB;
constexpr size_t WS_CKA = WS_CKD + 216 * MiB;
constexpr size_t CA_QC = 0;
constexpr size_t CA_FT = 20 * MiB;
constexpr size_t CA_UT = 60 * MiB;
constexpr size_t CA_DL = 100 * MiB;
static_assert(WS_CKA + CA_DL + (size_t)NUNIT * 32 * 4 <= WS_END, "chunk data");
static_assert((size_t)MAXROWS * 1024 * 2 <= 324 * MiB, "YD overlay");
static_assert(WS_H + (size_t)MAXROWS * 1024 * 2 <= WS_MIX, "H");
constexpr int CW_BAR = 4096;
constexpr int CW_CNT = 16384;

constexpr int LDS_BYTES = 147456;
constexpr int MISC_OFF = 143360;
constexpr int TAB_OFF = 143360 + 256;

__device__ __forceinline__ float bf2f(unsigned v) { return __uint_as_float(v << 16); }
__device__ __forceinline__ unsigned f2bf(float f) { unsigned u = __float_as_uint(f); return (u + 0x7fffu + ((u >> 16) & 1u)) >> 16; }
__device__ __forceinline__ unsigned pk2(float lo, float hi) { return f2bf(lo) | (f2bf(hi) << 16); }
__device__ __forceinline__ unsigned pk4_fp8(float a, float b, float c, float d) { int r = __builtin_amdgcn_cvt_pk_fp8_f32(a, b, 0, false); return (unsigned)__builtin_amdgcn_cvt_pk_fp8_f32(c, d, r, true); }
__device__ __forceinline__ float clamp448(float v) { return fminf(fmaxf(v, -448.f), 448.f); }
__device__ __forceinline__ unsigned pk4_fp8s(float a, float b, float c, float d, float s) { return pk4_fp8(clamp448(a * s), clamp448(b * s), clamp448(c * s), clamp448(d * s)); }
constexpr float YD_SCALE = 4.f;
__device__ __forceinline__ float lo_bf(unsigned w) { return __uint_as_float(w << 16); }
__device__ __forceinline__ float hi_bf(unsigned w) { return __uint_as_float(w & 0xffff0000u); }
__device__ __forceinline__ float sigmoidf_(float x) { return 1.f / (1.f + __expf(-x)); }
__device__ __forceinline__ float siluf_(float x) { return x / (1.f + __expf(-x)); }
__device__ __forceinline__ float softplusf_(float x) { return fmaxf(x, 0.f) + __logf(1.f + __expf(-fabsf(x))); }
__device__ __forceinline__ float logsigmoidf_(float x) { return fminf(x, 0.f) - __logf(1.f + __expf(-fabsf(x))); }
__device__ __forceinline__ float sin_rev(float r) { return __builtin_amdgcn_sinf(__builtin_amdgcn_fractf(r)); }
__device__ __forceinline__ float sin_rad(float x) { return sin_rev(x * 0.15915494309189535f); }
template <int CTRL> __device__ __forceinline__ float dpp_f(float v) { return __builtin_bit_cast(float, __builtin_amdgcn_update_dpp(0, __builtin_bit_cast(int, v), CTRL, 0xf, 0xf, true)); }
template <int CTRL> __device__ __forceinline__ int dpp_i(int v) { return __builtin_amdgcn_update_dpp(0, v, CTRL, 0xf, 0xf, true); }
__device__ __forceinline__ float quad_sum(float v) { v += dpp_f<0xB1>(v); v += dpp_f<0x4E>(v); return v; }
__device__ __forceinline__ float row16_sum(float v) { v += dpp_f<0xB1>(v); v += dpp_f<0x4E>(v); v += dpp_f<0x141>(v); v += dpp_f<0x140>(v); return v; }
__device__ __forceinline__ float rdlane_f(float v, int l) { return __builtin_bit_cast(float, __builtin_amdgcn_readlane(__builtin_bit_cast(int, v), l)); }
__device__ __forceinline__ float wave_sum(float v) {
    v = row16_sum(v);
    return (rdlane_f(v, 0) + rdlane_f(v, 16)) + (rdlane_f(v, 32) + rdlane_f(v, 48));
}
__device__ __forceinline__ int tidx() { int t = threadIdx.x; asm volatile("" : "+v"(t)); return t; }

#define XB_TMO      128
#define XB_XCNT(j)  (256  + 64 * (j))
#define XB_XSUB(j)  (1280 + 64 * (j))
#define XB_XGEN(j)  (2304 + 64 * (j))
#define XB_TOP      3328
#define XB_TOPGEN   3392
#define XCD_BAR_WORDS 3456
#define XB_SPIN_CAP (1u << 25)
__device__ __forceinline__ unsigned xb_ld(unsigned* p)              { return __hip_atomic_load(p, __ATOMIC_RELAXED, __HIP_MEMORY_SCOPE_AGENT); }
__device__ __forceinline__ unsigned xb_add(unsigned* p, unsigned v) { return __hip_atomic_fetch_add(p, v, __ATOMIC_RELAXED, __HIP_MEMORY_SCOPE_AGENT); }
__device__ __forceinline__ unsigned xb_xcc_id() { return (unsigned)__builtin_amdgcn_s_getreg((3 << 11) | 20) & 0xFu; }
#define XB_SPIN(cond, bar) do { unsigned _sp = 0; while (cond) { __builtin_amdgcn_s_sleep(1); \
    if ((++_sp & 255u) == 0u) { if (xb_ld(&(bar)[XB_TMO])) break; if (_sp > XB_SPIN_CAP) { atomicAdd(&(bar)[XB_TMO], 1u); break; } } } } while (0)
struct XcdBarrier { unsigned* bar; unsigned x; volatile LAS unsigned* st; };
__device__ __forceinline__ XcdBarrier xcd_barrier_post(unsigned* bar, volatile LAS unsigned* st) {
    XcdBarrier b; b.bar = bar; b.x = xb_xcc_id(); b.st = st;
    if (threadIdx.x == 0) (void)xb_add(&bar[XB_XCNT(b.x)], 1u);
    return b;
}
__device__ __forceinline__ void xcd_barrier_complete(unsigned* bar, unsigned x, unsigned& nloc, unsigned& nx) {
    const unsigned G = gridDim.x * gridDim.y * gridDim.z;
    unsigned sum, cnt, mine, sp = 0u;
    for (;;) {
        sum = 0u; cnt = 0u; mine = 0u;
#pragma unroll
        for (unsigned j = 0; j < 16; ++j) { const unsigned c = xb_ld(&bar[XB_XCNT(j)]); sum += c; cnt += (c > 0u) ? 1u : 0u; mine = (j == x) ? c : mine; }
        if (sum == G) break;
        __builtin_amdgcn_s_sleep(1);
        if ((++sp & 255u) == 0u) { if (xb_ld(&bar[XB_TMO])) break; if (sp > XB_SPIN_CAP) { atomicAdd(&bar[XB_TMO], 1u); break; } }
    }
    nloc = mine > 0u ? mine : 1u; nx = cnt > 0u ? cnt : 1u;
}
__device__ __forceinline__ void xcd_barrier(const XcdBarrier& b) {
    asm volatile("s_waitcnt vmcnt(0)" ::: "memory");
    __syncthreads();
    if (threadIdx.x == 0) {
        unsigned* bar = b.bar;
        __builtin_amdgcn_s_waitcnt(0);
        unsigned nloc = b.st[0], nx = b.st[1];
        if (nloc == 0u) { xcd_barrier_complete(bar, b.x, nloc, nx); b.st[0] = nloc; b.st[1] = nx; }
        const unsigned old = xb_add(&bar[XB_XSUB(b.x)], 1u);
        const unsigned gen = old / nloc;
        if (old + 1u == (gen + 1u) * nloc) {
            __builtin_amdgcn_fence(__ATOMIC_RELEASE, "agent");
            asm volatile("s_waitcnt vmcnt(0)" ::: "memory");
            const unsigned og = xb_add(&bar[XB_TOP], 1u);
            const unsigned tg = og / nx;
            if (og + 1u == (tg + 1u) * nx) xb_add(&bar[XB_TOPGEN], 1u);
            else XB_SPIN(xb_ld(&bar[XB_TOPGEN]) == tg, bar);
            __builtin_amdgcn_fence(__ATOMIC_ACQUIRE, "agent");
            xb_add(&bar[XB_XGEN(b.x)], 1u);
            asm volatile("s_waitcnt vmcnt(0)" ::: "memory");
        } else {
            XB_SPIN(xb_ld(&bar[XB_XGEN(b.x)]) == gen, bar);
            __builtin_amdgcn_fence(__ATOMIC_ACQUIRE, "agent");
            asm volatile("s_waitcnt vmcnt(0)" ::: "memory");
        }
    }
    __syncthreads();
}

namespace pg8 {
constexpr int BM = 256, BK = 64, HALF = 128, HTB = HALF * BK * 2, STAGE_BYTES = 8 * HTB, NXCD = 8, WGM = 8;
__host__ __device__ __forceinline__ int lds_byte(int r, int c) { const int st = (r >> 4) * 2 + (c >> 5), rr = r & 15, cc = c & 31, ob = rr * 64 + cc * 2; return st * 1024 + (ob ^ (((ob >> 9) & 1) << 5)); }
__host__ __device__ __forceinline__ void stage_rc(int b, int& R, int& C) { const int st = b / 1024, sb = b % 1024, swz = sb ^ (((sb >> 9) & 1) << 5); R = (st >> 1) * 16 + swz / 64; C = (st & 1) * 32 + (swz % 64) / 2; }
__host__ __device__ __forceinline__ int perm32(int rho) { const int n = rho >> 4, i = rho & 15; return 8 * (i >> 2) + 4 * n + (i & 3); }
__device__ __forceinline__ unsigned cvt_pk_bf16(float lo, float hi) { unsigned r; asm volatile("v_cvt_pk_bf16_f32 %0, %1, %2" : "=v"(r) : "v"(lo), "v"(hi)); return r; }

struct Unit { int pm, pn, e, mt; };

struct DenseSched {
    const char* Bt; int K, nM, nN, nwg, G, c, row0;
    __device__ __forceinline__ void init(const bf16* Bt_, int K_, int M, int N, int G_, int c_, int row0_) { Bt = (const char*)Bt_; K = K_; nM = M / BM; nN = N / BM; nwg = nM * nN; G = G_; c = c_; row0 = row0_; }
    __device__ __forceinline__ bool next(int i, Unit& u) const {
        const long L = (long)i * G + c; if (L >= nwg) return false;
        int wgid = (int)L; { const int q = nwg / NXCD, r = nwg % NXCD, xcd = wgid % NXCD, off = wgid / NXCD; wgid = (xcd < r ? xcd * (q + 1) : r * (q + 1) + (xcd - r) * q) + off; }
        const int nig = WGM * nN, gid = wgid / nig, fm = gid * WGM, gsz = (nM - fm) < WGM ? (nM - fm) : WGM;
        u.pm = fm + ((wgid % nig) % gsz); u.pn = (wgid % nig) / gsz; u.e = 0; u.mt = 0; return true;
    }
    __device__ __forceinline__ const char* b_ptr(const Unit& u) const { return Bt + (size_t)u.pn * (size_t)(BM * 2) * K; }
    __device__ __forceinline__ void a_offsets(const Unit& u, const int (&R)[2], const int (&C)[2], unsigned (&v)[2][2]) const {
#pragma unroll
        for (int h = 0; h < 2; ++h)
#pragma unroll
            for (int i = 0; i < 2; ++i) v[h][i] = (unsigned)((row0 + u.pm * BM + h * HALF + R[i]) * K + C[i]) * 2u;
    }
};
template <bool GATHER, int NT>
struct MoeSched {
    const char* Bt; size_t bstride;
    int rb;
    const int* list;
    const LAS int* pre; const LAS int* mtl; const LAS int* rowoff; const LAS int* cnt;
    int K, G, c, total;
    __device__ __forceinline__ bool next(int i, Unit& u) const {
        const int L = i * G + c; if (L >= total) return false;
        int e = 0;
#pragma unroll 1
        for (int j = 1; j < NEXP; ++j) e = (L >= pre[j]) ? j : e;
        const int rem = L - pre[e];
        u.e = e; u.pn = rem % NT; u.mt = rem / NT; u.pm = 0; return true;
    }
    __device__ __forceinline__ const char* b_ptr(const Unit& u) const { return Bt + (size_t)u.e * bstride + (size_t)u.pn * (size_t)BM * rb; }
    __device__ __forceinline__ const char* a_ptr(const Unit& u, const char* Abase) const { return Abase + (size_t)(rowoff[u.e] + u.mt * BM) * rb; }
    __device__ __forceinline__ void a_offsets(const Unit& u, const int (&R)[2], const int (&C)[2], unsigned (&v)[2][2]) const {
        if (GATHER) {
            const int n = cnt[u.e]; const int* lp = list + (size_t)u.e * NTOK;
#pragma unroll
            for (int h = 0; h < 2; ++h)
#pragma unroll
                for (int i = 0; i < 2; ++i) { const int idx = u.mt * BM + h * HALF + R[i]; const int tok = idx < n ? lp[idx] : 0; v[h][i] = (unsigned)(tok * rb + 2 * C[i]); }
        } else {
            const int r0 = rowoff[u.e] + u.mt * BM;
#pragma unroll
            for (int h = 0; h < 2; ++h)
#pragma unroll
                for (int i = 0; i < 2; ++i) v[h][i] = (unsigned)((r0 + h * HALF + R[i]) * K + C[i]) * 2u;
        }
    }
};

struct EpiBf16 {
    static constexpr bool PERM = true;
    bf16* O; int ldc; int row0;
    __device__ __forceinline__ void operator()(const f32x4 (&acc)[2][2][4][2], const Unit& u, int wr, int wc, int fr, int fq) const {
        const int r0 = row0 + u.pm * BM + wr * 64 + fr, col0 = u.pn * BM + wc * 32 + 8 * fq;
#pragma unroll
        for (int ai = 0; ai < 2; ++ai)
#pragma unroll
            for (int m = 0; m < 4; ++m) { bf16* rowp = O + (size_t)(r0 + ai * HALF + m * 16) * ldc + col0;
#pragma unroll
                for (int bj = 0; bj < 2; ++bj) { const f32x4 v0 = acc[ai][bj][m][0], v1 = acc[ai][bj][m][1];
                    u32x4 w; w.x = cvt_pk_bf16(v0[0], v0[1]); w.y = cvt_pk_bf16(v0[2], v0[3]); w.z = cvt_pk_bf16(v1[0], v1[1]); w.w = cvt_pk_bf16(v1[2], v1[3]);
                    *(u32x4*)(rowp + bj * HALF) = w; } }
    }
};
struct EpiF32 {
    static constexpr bool PERM = false;
    float* Cc; int ldc; int row0;
    __device__ __forceinline__ void operator()(const f32x4 (&acc)[2][2][4][2], const Unit& u, int wr, int wc, int fr, int fq) const {
        const int r0 = row0 + u.pm * BM + wr * 64 + fr, col0 = u.pn * BM + wc * 32 + 4 * fq;
#pragma unroll
        for (int ai = 0; ai < 2; ++ai)
#pragma unroll
            for (int m = 0; m < 4; ++m) { float* rowp = Cc + (size_t)(r0 + ai * HALF + m * 16) * ldc + col0;
#pragma unroll
                for (int bj = 0; bj < 2; ++bj)
#pragma unroll
                    for (int n = 0; n < 2; ++n) *(f32x4*)(rowp + bj * HALF + n * 16) = acc[ai][bj][m][n]; }
    }
};
struct EpiSwiglu {
    static constexpr bool PERM = true;
    bf16* H; const float* bg; const float* bu; const LAS int* rowoff; float ws;
    __device__ __forceinline__ void operator()(const f32x4 (&acc)[2][2][4][2], const Unit& u, int wr, int wc, int fr, int fq) const {
        const int r0 = rowoff[u.e] + u.mt * BM + wr * 64 + fr, j0 = u.pn * HALF + wc * 32 + 8 * fq;
        f32x4 gb[2], ub[2];
#pragma unroll
        for (int n = 0; n < 2; ++n) { gb[n] = *(const f32x4*)(bg + u.e * 1024 + j0 + 4 * n); ub[n] = *(const f32x4*)(bu + u.e * 1024 + j0 + 4 * n); }
#pragma unroll
        for (int ai = 0; ai < 2; ++ai)
#pragma unroll
            for (int m = 0; m < 4; ++m) { unsigned char* rowp = (unsigned char*)H + (size_t)(r0 + ai * HALF + m * 16) * 1024 + j0; float hv[8];
#pragma unroll
                for (int n = 0; n < 2; ++n)
#pragma unroll
                    for (int j = 0; j < 4; ++j) { float g = acc[ai][0][m][n][j] * ws + gb[n][j], up = acc[ai][1][m][n][j] * ws + ub[n][j];
                        g = fminf(g, 7.f); up = fminf(fmaxf(up, -7.f), 7.f);
                        hv[n * 4 + j] = (up + 1.f) * g * __builtin_amdgcn_rcpf(1.f + __expf(-1.702f * g)); }
                *(u32x2*)rowp = (u32x2){pk4_fp8(4.f * hv[0], 4.f * hv[1], 4.f * hv[2], 4.f * hv[3]), pk4_fp8(4.f * hv[4], 4.f * hv[5], 4.f * hv[6], 4.f * hv[7])}; }
    }
};
struct EpiDown {
    static constexpr bool PERM = true;
    bf16* Y; const float* bd; const LAS int* rowoff; float ws;
    __device__ __forceinline__ void operator()(const f32x4 (&acc)[2][2][4][2], const Unit& u, int wr, int wc, int fr, int fq) const {
        const int r0 = rowoff[u.e] + u.mt * BM + wr * 64 + fr, col0 = u.pn * BM + wc * 32 + 8 * fq;
        f32x4 bv[2][2];
#pragma unroll
        for (int bj = 0; bj < 2; ++bj)
#pragma unroll
            for (int n = 0; n < 2; ++n) bv[bj][n] = *(const f32x4*)(bd + u.e * 1024 + col0 + bj * HALF + 4 * n);
#pragma unroll
        for (int ai = 0; ai < 2; ++ai)
#pragma unroll
            for (int m = 0; m < 4; ++m) { unsigned char* rowp = (unsigned char*)Y + (size_t)(r0 + ai * HALF + m * 16) * 1024 + col0;
#pragma unroll
                for (int bj = 0; bj < 2; ++bj) { const f32x4 v0 = acc[ai][bj][m][0] * ws + bv[bj][0], v1 = acc[ai][bj][m][1] * ws + bv[bj][1];
                    *(u32x2*)(rowp + bj * HALF) = (u32x2){pk4_fp8s(v0[0], v0[1], v0[2], v0[3], YD_SCALE), pk4_fp8s(v1[0], v1[1], v1[2], v1[3], YD_SCALE)}; } }
    }
};

template <class Epi, class Sched, bool ALIGN_EPI>
__device__ __forceinline__ void gemm_phase(LAS unsigned char* lds, const char* Abase, const int K, const Sched& S, const Epi& E) {
    const int tid = tidx(), wid = __builtin_amdgcn_readfirstlane(tid >> 6), lane = tid & 63, wr = wid >> 2, wc = wid & 3, fr = lane & 15, fq = lane >> 4;
    const int nt = K / BK;
    int Rp[2], Cp[2]; unsigned voffB0;
#pragma unroll
    for (int i = 0; i < 2; ++i) stage_rc(tid * 16 + i * 8192, Rp[i], Cp[i]);
    { const int Rb = Epi::PERM ? ((Rp[0] & ~31) + perm32(Rp[0] & 31)) : Rp[0]; voffB0 = (unsigned)(Rb * K + Cp[0]) * 2u; }
    const size_t kstep = (size_t)(BK * 2);
    const size_t hstep = (size_t)HALF * K * 2;
    const unsigned ldsw = (unsigned)wid * 1024u;
    const int aoff = lds_byte(wr * 64 + fr, fq * 8), boff = lds_byte(wc * 32 + fr, fq * 8);
#define PG8_SA(b, h) (((b) * 2 + (h)) * HTB)
#define PG8_SB(b, h) ((4 + (b) * 2 + (h)) * HTB)
#define PG8_STAGE(bufoff, gbase, voff) do { _Pragma("unroll") for (int _i = 0; _i < 2; ++_i) \
        __builtin_amdgcn_global_load_lds((const unsigned*)((const char*)(gbase) + (voff)[_i]), (LAS unsigned*)(lds + (bufoff) + ldsw + _i * 8192), 16, 0, 0); } while (0)
#define PG8_STAGEB(bufoff, gbase) do { _Pragma("unroll") for (int _i = 0; _i < 2; ++_i) \
        __builtin_amdgcn_global_load_lds((const unsigned*)((const char*)(gbase) + (size_t)_i * 128 * K + voffB0), (LAS unsigned*)(lds + (bufoff) + ldsw + _i * 8192), 16, 0, 0); } while (0)
#define PG8_LDA(dst, b, h) do { _Pragma("unroll") for (int m = 0; m < 4; ++m) _Pragma("unroll") for (int k = 0; k < 2; ++k) dst[m][k] = *(const LAS bf16x8*)(lds + PG8_SA(b, h) + aoff + m * 2048 + k * 1024); } while (0)
#define PG8_LDB(dst, b, h) do { _Pragma("unroll") for (int n = 0; n < 2; ++n) _Pragma("unroll") for (int k = 0; k < 2; ++k) dst[n][k] = *(const LAS bf16x8*)(lds + PG8_SB(b, h) + boff + n * 2048 + k * 1024); } while (0)
#define PG8_MMA(ai, bj, At, Bt) do { __builtin_amdgcn_s_setprio(1); _Pragma("unroll") for (int m = 0; m < 4; ++m) _Pragma("unroll") for (int n = 0; n < 2; ++n) _Pragma("unroll") for (int k = 0; k < 2; ++k) \
        acc[ai][bj][m][n] = __builtin_amdgcn_mfma_f32_16x16x32_bf16(Bt[n][k], At[m][k], acc[ai][bj][m][n], 0, 0, 0); __builtin_amdgcn_s_setprio(0); } while (0)
#define PG8_WAIT_V(n) asm volatile("s_waitcnt vmcnt(" #n ")" ::: "memory")
#define PG8_WAIT_L(n) asm volatile("s_waitcnt lgkmcnt(" #n ")" ::: "memory")
#define PG8_BAR __builtin_amdgcn_s_barrier()
#define PG8_SCHED __builtin_amdgcn_sched_barrier(0)
    Unit cur, nxt; int ui = 0;
    if (!S.next(0, cur)) return;
    f32x4 acc[2][2][4][2];
#pragma unroll
    for (int a = 0; a < 2; ++a)
#pragma unroll
        for (int b = 0; b < 2; ++b)
#pragma unroll
            for (int m = 0; m < 4; ++m)
#pragma unroll
                for (int n = 0; n < 2; ++n) acc[a][b][m][n] = (f32x4){0.f, 0.f, 0.f, 0.f};
    bf16x8 At[4][2], B0[2][2], B1[2][2];
    unsigned vAc[2][2], vAn[2][2];
    S.a_offsets(cur, Rp, Cp, vAc);
    const char* cB = S.b_ptr(cur);
    PG8_STAGEB(PG8_SB(0, 0), cB); PG8_STAGEB(PG8_SB(0, 1), cB + hstep); PG8_STAGE(PG8_SA(0, 0), Abase, vAc[0]); PG8_STAGE(PG8_SA(0, 1), Abase, vAc[1]);
    if (wr == 1) PG8_BAR;
    PG8_WAIT_V(2); PG8_BAR;
    PG8_STAGEB(PG8_SB(1, 0), cB + kstep); PG8_STAGE(PG8_SA(1, 0), Abase + kstep, vAc[0]); PG8_STAGEB(PG8_SB(1, 1), cB + hstep + kstep);
    PG8_WAIT_V(6); PG8_BAR;
    for (;;) {
        const bool has_next = S.next(ui + 1, nxt);
        const char* nB = has_next ? S.b_ptr(nxt) : cB;
        if (has_next) S.a_offsets(nxt, Rp, Cp, vAn);
        else {
#pragma unroll
            for (int h = 0; h < 2; ++h)
#pragma unroll
                for (int i = 0; i < 2; ++i) vAn[h][i] = vAc[h][i]; }
        for (int t = 0; t < nt; t += 2) {
            const bool last = (t == nt - 2);
            const char* a1 = Abase + (size_t)(t + 1) * kstep;
            const char* a2 = last ? Abase : Abase + (size_t)(t + 2) * kstep; const char* b2 = last ? nB : cB + (size_t)(t + 2) * kstep;
            const char* a3 = a2 + kstep; const char* b3 = b2 + kstep;
            unsigned v2[2][2];
#pragma unroll
            for (int h = 0; h < 2; ++h)
#pragma unroll
                for (int i = 0; i < 2; ++i) v2[h][i] = last ? vAn[h][i] : vAc[h][i];
            PG8_LDB(B0, 0, 0); PG8_LDB(B1, 0, 1); PG8_SCHED; PG8_LDA(At, 0, 0); PG8_STAGE(PG8_SA(1, 1), a1, vAc[1]);
            PG8_WAIT_V(8); PG8_WAIT_L(0); PG8_BAR; PG8_MMA(0, 0, At, B0); PG8_MMA(0, 1, At, B1); PG8_BAR; PG8_SCHED;
            PG8_LDA(At, 0, 1); PG8_STAGEB(PG8_SB(0, 0), b2); PG8_STAGEB(PG8_SB(0, 1), b2 + hstep); PG8_STAGE(PG8_SA(0, 0), a2, v2[0]);
            PG8_WAIT_V(8); PG8_WAIT_L(0); PG8_BAR; PG8_MMA(1, 0, At, B0); PG8_MMA(1, 1, At, B1); PG8_BAR; PG8_SCHED;
            PG8_LDB(B0, 1, 0); PG8_LDB(B1, 1, 1); PG8_SCHED; PG8_LDA(At, 1, 0); PG8_STAGE(PG8_SA(0, 1), a2, v2[1]);
            PG8_WAIT_V(8); PG8_WAIT_L(0); PG8_BAR; PG8_MMA(0, 0, At, B0); PG8_MMA(0, 1, At, B1); PG8_BAR; PG8_SCHED;
            PG8_LDA(At, 1, 1); PG8_STAGEB(PG8_SB(1, 0), b3); PG8_STAGEB(PG8_SB(1, 1), b3 + hstep); PG8_STAGE(PG8_SA(1, 0), a3, v2[0]);
            PG8_WAIT_V(8); PG8_WAIT_L(0); PG8_BAR; PG8_MMA(1, 0, At, B0); PG8_MMA(1, 1, At, B1); PG8_BAR; PG8_SCHED;
        }
        if constexpr (ALIGN_EPI) { if (wr == 0) PG8_BAR; }
        E(acc, cur, wr, wc, fr, fq);
        if (!has_next) break;
#pragma unroll
        for (int a = 0; a < 2; ++a)
#pragma unroll
            for (int b = 0; b < 2; ++b)
#pragma unroll
                for (int m = 0; m < 4; ++m)
#pragma unroll
                    for (int n = 0; n < 2; ++n) acc[a][b][m][n] = (f32x4){0.f, 0.f, 0.f, 0.f};
        cur = nxt; cB = nB; ++ui;
#pragma unroll
        for (int h = 0; h < 2; ++h)
#pragma unroll
            for (int i = 0; i < 2; ++i) vAc[h][i] = vAn[h][i];
        if constexpr (ALIGN_EPI) { if (wr == 1) PG8_BAR; }
    }
    PG8_WAIT_V(0);
    if constexpr (!ALIGN_EPI) { if (wr == 0) PG8_BAR; }
    PG8_BAR;
#undef PG8_SA
#undef PG8_SB
#undef PG8_STAGE
#undef PG8_STAGEB
#undef PG8_LDA
#undef PG8_LDB
#undef PG8_MMA
#undef PG8_WAIT_V
#undef PG8_WAIT_L
#undef PG8_BAR
#undef PG8_SCHED
}
template <class Epi, class Sched, bool ALIGN_EPI>
__device__ __forceinline__ void gemm_phase_f8g(LAS unsigned char* lds, const char* Abase, const int K, const Sched& S, const Epi& E) {
    const int tid = tidx(), wid = __builtin_amdgcn_readfirstlane(tid >> 6), lane = tid & 63, wr = wid >> 2, wc = wid & 3, fr = lane & 15, fq = lane >> 4;
    const int nt = K / 128;
    int Rp[2], Cp[2]; unsigned voffB0;
#pragma unroll
    for (int i = 0; i < 2; ++i) stage_rc(tid * 16 + i * 8192, Rp[i], Cp[i]);
    { const int Rb = Epi::PERM ? ((Rp[0] & ~31) + perm32(Rp[0] & 31)) : Rp[0]; voffB0 = (unsigned)(Rb * K + 2 * Cp[0]); }
    const size_t kstep = (size_t)(BK * 2);
    const size_t hstep = (size_t)HALF * K;
    const unsigned ldsw = (unsigned)wid * 1024u;
    const int aoff0 = lds_byte(wr * 64 + fr, 16 * (fq & 1)) + (fq >> 1) * 1024, boff0 = lds_byte(wc * 32 + fr, 16 * (fq & 1)) + (fq >> 1) * 1024;
#define PG8_SA(b, h) (((b) * 2 + (h)) * HTB)
#define PG8_SB(b, h) ((4 + (b) * 2 + (h)) * HTB)
#define PG8_STAGE(bufoff, gbase, voff) do { _Pragma("unroll") for (int _i = 0; _i < 2; ++_i) \
        __builtin_amdgcn_global_load_lds((const unsigned*)((const char*)(gbase) + (voff)[_i]), (LAS unsigned*)(lds + (bufoff) + ldsw + _i * 8192), 16, 0, 0); } while (0)
#define PG8_STAGEB(bufoff, gbase) do { _Pragma("unroll") for (int _i = 0; _i < 2; ++_i) \
        __builtin_amdgcn_global_load_lds((const unsigned*)((const char*)(gbase) + (size_t)_i * 64 * K + voffB0), (LAS unsigned*)(lds + (bufoff) + ldsw + _i * 8192), 16, 0, 0); } while (0)
#define PG8_LDA(dst, b, h) do { _Pragma("unroll") for (int m = 0; m < 4; ++m) { const u32x4 lo_ = *(const LAS u32x4*)(lds + PG8_SA(b, h) + aoff0 + m * 2048), hi_ = *(const LAS u32x4*)(lds + PG8_SA(b, h) + aoff0 + 16 + m * 2048); \
        dst[m] = (v8i){(int)lo_.x, (int)lo_.y, (int)lo_.z, (int)lo_.w, (int)hi_.x, (int)hi_.y, (int)hi_.z, (int)hi_.w}; } } while (0)
#define PG8_LDB(dst, b, h) do { _Pragma("unroll") for (int n = 0; n < 2; ++n) { const u32x4 lo_ = *(const LAS u32x4*)(lds + PG8_SB(b, h) + boff0 + n * 2048), hi_ = *(const LAS u32x4*)(lds + PG8_SB(b, h) + boff0 + 16 + n * 2048); \
        dst[n] = (v8i){(int)lo_.x, (int)lo_.y, (int)lo_.z, (int)lo_.w, (int)hi_.x, (int)hi_.y, (int)hi_.z, (int)hi_.w}; } } while (0)
#define PG8_MMA(ai, bj, At, Bt) do { __builtin_amdgcn_s_setprio(1); _Pragma("unroll") for (int m = 0; m < 4; ++m) _Pragma("unroll") for (int n = 0; n < 2; ++n) \
        asm volatile("v_mfma_scale_f32_16x16x128_f8f6f4 %0, %1, %2, %0, %3, %3 op_sel_hi:[0,0,0]" : "+v"(acc[ai][bj][m][n]) : "v"(Bt[n]), "v"(At[m]), "v"(f8scale)); __builtin_amdgcn_s_setprio(0); } while (0)
#define PG8_WAIT_V(n) asm volatile("s_waitcnt vmcnt(" #n ")" ::: "memory")
#define PG8_WAIT_L(n) asm volatile("s_waitcnt lgkmcnt(" #n ")" ::: "memory")
#define PG8_BAR __builtin_amdgcn_s_barrier()
#define PG8_SCHED __builtin_amdgcn_sched_barrier(0)
    Unit cur, nxt; int ui = 0;
    if (!S.next(0, cur)) return;
    f32x4 acc[2][2][4][2];
#pragma unroll
    for (int a = 0; a < 2; ++a)
#pragma unroll
        for (int b = 0; b < 2; ++b)
#pragma unroll
            for (int m = 0; m < 4; ++m)
#pragma unroll
                for (int n = 0; n < 2; ++n) acc[a][b][m][n] = (f32x4){0.f, 0.f, 0.f, 0.f};
    typedef int v8i __attribute__((ext_vector_type(8)));
    v8i At[4], B0[2], B1[2];
    const int f8scale = 0x7f7f7f7f;
    unsigned vAc[2][2], vAn[2][2];
    S.a_offsets(cur, Rp, Cp, vAc);
    const char* cB = S.b_ptr(cur);
    PG8_STAGEB(PG8_SB(0, 0), cB); PG8_STAGEB(PG8_SB(0, 1), cB + hstep); PG8_STAGE(PG8_SA(0, 0), Abase, vAc[0]); PG8_STAGE(PG8_SA(0, 1), Abase, vAc[1]);
    if (wr == 1) PG8_BAR;
    PG8_WAIT_V(2); PG8_BAR;
    PG8_STAGEB(PG8_SB(1, 0), cB + kstep); PG8_STAGE(PG8_SA(1, 0), Abase + kstep, vAc[0]); PG8_STAGEB(PG8_SB(1, 1), cB + hstep + kstep);
    PG8_WAIT_V(6); PG8_BAR;
    for (;;) {
        const bool has_next = S.next(ui + 1, nxt);
        const char* nB = has_next ? S.b_ptr(nxt) : cB;
        if (has_next) S.a_offsets(nxt, Rp, Cp, vAn);
        else {
#pragma unroll
            for (int h = 0; h < 2; ++h)
#pragma unroll
                for (int i = 0; i < 2; ++i) vAn[h][i] = vAc[h][i]; }
#pragma unroll 1
        for (int t = 0; t < nt; t += 2) {
            const bool last = (t == nt - 2);
            const char* a1 = Abase + (size_t)(t + 1) * kstep;
            const char* a2 = last ? Abase : Abase + (size_t)(t + 2) * kstep; const char* b2 = last ? nB : cB + (size_t)(t + 2) * kstep;
            const char* a3 = a2 + kstep; const char* b3 = b2 + kstep;
            unsigned v2[2][2];
#pragma unroll
            for (int h = 0; h < 2; ++h)
#pragma unroll
                for (int i = 0; i < 2; ++i) v2[h][i] = last ? vAn[h][i] : vAc[h][i];
            PG8_LDB(B0, 0, 0); PG8_LDB(B1, 0, 1); PG8_SCHED; PG8_LDA(At, 0, 0); PG8_STAGE(PG8_SA(1, 1), a1, vAc[1]);
            PG8_WAIT_V(8); PG8_WAIT_L(0); PG8_BAR; PG8_MMA(0, 0, At, B0); PG8_MMA(0, 1, At, B1); PG8_BAR; PG8_SCHED;
            PG8_LDA(At, 0, 1); PG8_STAGEB(PG8_SB(0, 0), b2); PG8_STAGEB(PG8_SB(0, 1), b2 + hstep); PG8_STAGE(PG8_SA(0, 0), a2, v2[0]);
            PG8_WAIT_V(8); PG8_WAIT_L(0); PG8_BAR; PG8_MMA(1, 0, At, B0); PG8_MMA(1, 1, At, B1); PG8_BAR; PG8_SCHED;
            PG8_LDB(B0, 1, 0); PG8_LDB(B1, 1, 1); PG8_SCHED; PG8_LDA(At, 1, 0); PG8_STAGE(PG8_SA(0, 1), a2, v2[1]);
            PG8_WAIT_V(8); PG8_WAIT_L(0); PG8_BAR; PG8_MMA(0, 0, At, B0); PG8_MMA(0, 1, At, B1); PG8_BAR; PG8_SCHED;
            PG8_LDA(At, 1, 1); PG8_STAGEB(PG8_SB(1, 0), b3); PG8_STAGEB(PG8_SB(1, 1), b3 + hstep); PG8_STAGE(PG8_SA(1, 0), a3, v2[0]);
            PG8_WAIT_V(8); PG8_WAIT_L(0); PG8_BAR; PG8_MMA(1, 0, At, B0); PG8_MMA(1, 1, At, B1); PG8_BAR; PG8_SCHED;
        }
        if constexpr (ALIGN_EPI) { if (wr == 0) PG8_BAR; }
        E(acc, cur, wr, wc, fr, fq);
        if (!has_next) break;
#pragma unroll
        for (int a = 0; a < 2; ++a)
#pragma unroll
            for (int b = 0; b < 2; ++b)
#pragma unroll
                for (int m = 0; m < 4; ++m)
#pragma unroll
                    for (int n = 0; n < 2; ++n) acc[a][b][m][n] = (f32x4){0.f, 0.f, 0.f, 0.f};
        cur = nxt; cB = nB; ++ui;
#pragma unroll
        for (int h = 0; h < 2; ++h)
#pragma unroll
            for (int i = 0; i < 2; ++i) vAc[h][i] = vAn[h][i];
        if constexpr (ALIGN_EPI) { if (wr == 1) PG8_BAR; }
    }
    PG8_WAIT_V(0);
    if constexpr (!ALIGN_EPI) { if (wr == 0) PG8_BAR; }
    PG8_BAR;
#undef PG8_SA
#undef PG8_SB
#undef PG8_STAGE
#undef PG8_STAGEB
#undef PG8_LDA
#undef PG8_LDB
#undef PG8_MMA
#undef PG8_WAIT_V
#undef PG8_WAIT_L
#undef PG8_BAR
#undef PG8_SCHED
}
template <class Epi, class Sched, bool ALIGN_EPI>
__device__ __forceinline__ void gemm_phase_f8(LAS unsigned char* lds, const char* Abase, const int K, const Sched& S, const Epi& E) {
    const int tid = tidx(), wid = __builtin_amdgcn_readfirstlane(tid >> 6), lane = tid & 63, wr = wid >> 2, wc = wid & 3, fr = lane & 15, fq = lane >> 4;
    const int nt = K / 128;
    int Rp[1], Cp[1]; unsigned voffB[1], voffA[1];
#pragma unroll
    for (int i = 0; i < 1; ++i) { stage_rc(tid * 16 + i * 8192, Rp[i], Cp[i]); const int Rb = Epi::PERM ? ((Rp[i] & ~31) + perm32(Rp[i] & 31)) : Rp[i]; voffB[i] = (unsigned)(Rb * K + 2 * Cp[i]); voffA[i] = (unsigned)(Rp[i] * K + 2 * Cp[i]); }
    const size_t kstep = (size_t)(BK * 2);
    const size_t hstep = (size_t)HALF * K;
    const unsigned ldsw = (unsigned)wid * 1024u;
    const int aoff0 = lds_byte(wr * 64 + fr, 16 * (fq & 1)) + (fq >> 1) * 1024, boff0 = lds_byte(wc * 32 + fr, 16 * (fq & 1)) + (fq >> 1) * 1024;
#define PG8_SA(b, h) (((b) * 2 + (h)) * HTB)
#define PG8_SB(b, h) ((4 + (b) * 2 + (h)) * HTB)
#define PG8_STAGE(bufoff, gbase, voff) do { _Pragma("unroll") for (int _i = 0; _i < 2; ++_i) \
        __builtin_amdgcn_global_load_lds((const unsigned*)((const char*)(gbase) + (size_t)_i * 64 * K + (voff)[0]), (LAS unsigned*)(lds + (bufoff) + ldsw + _i * 8192), 16, 0, 0); } while (0)
#define PG8_LDA(dst, b, h) do { _Pragma("unroll") for (int m = 0; m < 4; ++m) { const u32x4 lo_ = *(const LAS u32x4*)(lds + PG8_SA(b, h) + aoff0 + m * 2048), hi_ = *(const LAS u32x4*)(lds + PG8_SA(b, h) + aoff0 + 16 + m * 2048); \
        dst[m] = (v8i){(int)lo_.x, (int)lo_.y, (int)lo_.z, (int)lo_.w, (int)hi_.x, (int)hi_.y, (int)hi_.z, (int)hi_.w}; } } while (0)
#define PG8_LDB(dst, b, h) do { _Pragma("unroll") for (int n = 0; n < 2; ++n) { const u32x4 lo_ = *(const LAS u32x4*)(lds + PG8_SB(b, h) + boff0 + n * 2048), hi_ = *(const LAS u32x4*)(lds + PG8_SB(b, h) + boff0 + 16 + n * 2048); \
        dst[n] = (v8i){(int)lo_.x, (int)lo_.y, (int)lo_.z, (int)lo_.w, (int)hi_.x, (int)hi_.y, (int)hi_.z, (int)hi_.w}; } } while (0)
#define PG8_MMA(ai, bj, At, Bt) do { __builtin_amdgcn_s_setprio(1); _Pragma("unroll") for (int m = 0; m < 4; ++m) _Pragma("unroll") for (int n = 0; n < 2; ++n) \
        asm volatile("v_mfma_scale_f32_16x16x128_f8f6f4 %0, %1, %2, %0, %3, %3 op_sel_hi:[0,0,0]" : "+v"(acc[ai][bj][m][n]) : "v"(Bt[n]), "v"(At[m]), "v"(f8scale)); __builtin_amdgcn_s_setprio(0); } while (0)
#define PG8_WAIT_V(n) asm volatile("s_waitcnt vmcnt(" #n ")" ::: "memory")
#define PG8_WAIT_L(n) asm volatile("s_waitcnt lgkmcnt(" #n ")" ::: "memory")
#define PG8_BAR __builtin_amdgcn_s_barrier()
#define PG8_SCHED __builtin_amdgcn_sched_barrier(0)
    Unit cur, nxt; int ui = 0;
    if (!S.next(0, cur)) return;
    f32x4 acc[2][2][4][2];
#pragma unroll
    for (int a = 0; a < 2; ++a)
#pragma unroll
        for (int b = 0; b < 2; ++b)
#pragma unroll
            for (int m = 0; m < 4; ++m)
#pragma unroll
                for (int n = 0; n < 2; ++n) acc[a][b][m][n] = (f32x4){0.f, 0.f, 0.f, 0.f};
    typedef int v8i __attribute__((ext_vector_type(8)));
    v8i At[4], B0[2], B1[2];
    const int f8scale = 0x7f7f7f7f;
    const char* cA = S.a_ptr(cur, Abase);
    const char* cB = S.b_ptr(cur);
    PG8_STAGE(PG8_SB(0, 0), cB, voffB); PG8_STAGE(PG8_SB(0, 1), cB + hstep, voffB); PG8_STAGE(PG8_SA(0, 0), cA, voffA); PG8_STAGE(PG8_SA(0, 1), cA + hstep, voffA);
    if (wr == 1) PG8_BAR;
    PG8_WAIT_V(2); PG8_BAR;
    PG8_STAGE(PG8_SB(1, 0), cB + kstep, voffB); PG8_STAGE(PG8_SA(1, 0), cA + kstep, voffA); PG8_STAGE(PG8_SB(1, 1), cB + hstep + kstep, voffB);
    PG8_WAIT_V(6); PG8_BAR;
    for (;;) {
        const bool has_next = S.next(ui + 1, nxt);
        const char* nB = has_next ? S.b_ptr(nxt) : cB; const char* nA = has_next ? S.a_ptr(nxt, Abase) : cA;
#pragma unroll 1
        for (int t = 0; t < nt; t += 2) {
            const bool last = (t == nt - 2);
            const char* a1 = cA + (size_t)(t + 1) * kstep;
            const char* a2 = last ? nA : cA + (size_t)(t + 2) * kstep; const char* b2 = last ? nB : cB + (size_t)(t + 2) * kstep;
            const char* a3 = a2 + kstep; const char* b3 = b2 + kstep;
            PG8_LDB(B0, 0, 0); PG8_LDB(B1, 0, 1); PG8_SCHED; PG8_LDA(At, 0, 0); PG8_STAGE(PG8_SA(1, 1), a1 + hstep, voffA);
            PG8_WAIT_V(8); PG8_WAIT_L(0); PG8_BAR; PG8_MMA(0, 0, At, B0); PG8_MMA(0, 1, At, B1); PG8_BAR; PG8_SCHED;
            PG8_LDA(At, 0, 1); PG8_STAGE(PG8_SB(0, 0), b2, voffB); PG8_STAGE(PG8_SB(0, 1), b2 + hstep, voffB); PG8_STAGE(PG8_SA(0, 0), a2, voffA);
            PG8_WAIT_V(8); PG8_WAIT_L(0); PG8_BAR; PG8_MMA(1, 0, At, B0); PG8_MMA(1, 1, At, B1); PG8_BAR; PG8_SCHED;
            PG8_LDB(B0, 1, 0); PG8_LDB(B1, 1, 1); PG8_SCHED; PG8_LDA(At, 1, 0); PG8_STAGE(PG8_SA(0, 1), a2 + hstep, voffA);
            PG8_WAIT_V(8); PG8_WAIT_L(0); PG8_BAR; PG8_MMA(0, 0, At, B0); PG8_MMA(0, 1, At, B1); PG8_BAR; PG8_SCHED;
            PG8_LDA(At, 1, 1); PG8_STAGE(PG8_SB(1, 0), b3, voffB); PG8_STAGE(PG8_SB(1, 1), b3 + hstep, voffB); PG8_STAGE(PG8_SA(1, 0), a3, voffA);
            PG8_WAIT_V(8); PG8_WAIT_L(0); PG8_BAR; PG8_MMA(1, 0, At, B0); PG8_MMA(1, 1, At, B1); PG8_BAR; PG8_SCHED;
        }
        if constexpr (ALIGN_EPI) { if (wr == 0) PG8_BAR; }
        E(acc, cur, wr, wc, fr, fq);
        if (!has_next) break;
#pragma unroll
        for (int a = 0; a < 2; ++a)
#pragma unroll
            for (int b = 0; b < 2; ++b)
#pragma unroll
                for (int m = 0; m < 4; ++m)
#pragma unroll
                    for (int n = 0; n < 2; ++n) acc[a][b][m][n] = (f32x4){0.f, 0.f, 0.f, 0.f};
        cur = nxt; cB = nB; cA = nA; ++ui;
        if constexpr (ALIGN_EPI) { if (wr == 1) PG8_BAR; }
    }
    PG8_WAIT_V(0);
    if constexpr (!ALIGN_EPI) { if (wr == 0) PG8_BAR; }
    PG8_BAR;
#undef PG8_SA
#undef PG8_SB
#undef PG8_STAGE
#undef PG8_LDA
#undef PG8_LDB
#undef PG8_MMA
#undef PG8_WAIT_V
#undef PG8_WAIT_L
#undef PG8_BAR
#undef PG8_SCHED
}
}

struct Args { const float* in[39]; float* out; unsigned char* ws; int ph_lo, ph_hi; };
typedef const __attribute__((address_space(4))) Args CArgs;
enum { I_X = 0, I_C, I_CTX, I_CCTX, I_WADA, I_BADA, I_WIN, I_HYCW, I_HYCB, I_HYW1, I_HYB1, I_HYW2, I_HYB2, I_HYW3, I_HYB3, I_HYW4, I_HYFREQ, I_HYD, I_SCCW,
       I_GLAWA, I_GLABA, I_GLANW, I_GDNCW, I_GDNALOG, I_GDNDT, I_GDNNW, I_WOUT, I_LN1G, I_LN1B, I_WR, I_BR, I_WG, I_BG, I_WU, I_BU, I_WD, I_BD, I_LN2G, I_LN2B };

__device__ __forceinline__ int row_batch(int row) { return row < NTOK_C ? (row >> 8) : ((row - NTOK_C) >> 11); }
__device__ __forceinline__ int mod_vec(int row) { return row < NTOK_C ? 16 : ((row - NTOK_C) >> 11); }

__device__ __forceinline__ void ph_mod(CArgs& a, LAS unsigned char* lds, int bid, int nblk) {
    LAS float* sc = (LAS float*)lds; LAS float* red = (LAS float*)(lds + 1024 * 20 * 4);
    const int tid = tidx(), lane = tid & 63, w = tid >> 6;
    const float* c = a.in[I_C]; const float* cc = a.in[I_CCTX];
#pragma unroll 8
    for (int q = 0; q < 32; ++q) { const int i = tid + 512 * q; sc[(i & 1023) * 20 + (i >> 10)] = siluf_(c[i]); }
#pragma unroll
    for (int q = 0; q < 2; ++q) { const int i = tid + 512 * q; sc[i * 20 + 16] = siluf_(cc[i]); }
    __syncthreads();
    float* MOD = (float*)(a.ws + WS_MOD);
    for (int it = bid; it < DEPTH * 96; it += nblk) {
        const int l = it / 96, j0 = (it % 96) * 64;
        const float* W = a.in[I_WADA] + (size_t)l * 1024 * 6144 + j0 + lane;
        float acc[17];
#pragma unroll
        for (int v = 0; v < 17; ++v) acc[v] = 0.f;
#pragma unroll 16
        for (int kk = 0; kk < 128; ++kk) { const int k = w * 128 + kk; const float wv = W[(size_t)k * 6144];
            const LAS f32x4* s4 = (const LAS f32x4*)(sc + k * 20);
#pragma unroll
            for (int q = 0; q < 4; ++q) { const f32x4 sv = s4[q]; acc[4 * q] += sv[0] * wv; acc[4 * q + 1] += sv[1] * wv; acc[4 * q + 2] += sv[2] * wv; acc[4 * q + 3] += sv[3] * wv; }
            acc[16] += sc[k * 20 + 16] * wv; }
#pragma unroll
        for (int v = 0; v < 17; ++v) red[(w * 17 + v) * 64 + lane] = acc[v];
        __syncthreads();
        for (int o = tid; o < 17 * 64; o += 512) { const int v = o >> 6, jj = o & 63; float s = 0.f;
#pragma unroll
            for (int ww = 0; ww < 8; ++ww) s += red[(ww * 17 + v) * 64 + jj];
            MOD[(size_t)(l * 17 + v) * 6144 + j0 + jj] = s + a.in[I_BADA][l * 6144 + j0 + jj]; }
        __syncthreads();
    }
}

__device__ __forceinline__ void ph_filters(CArgs& a, int gw, int ngw) {
    const int lane = tidx() & 63;
    float* KUN = (float*)(a.ws + WS_KUN);
#pragma unroll 1
    for (int it = gw; it < DEPTH * (CTXL + SEQ) / 4; it += ngw) {
        const int l = it / ((CTXL + SEQ) / 4), r = (it % ((CTXL + SEQ) / 4)) * 4, Lt = r < CTXL ? 0 : 1, pos0 = Lt ? r - CTXL : r, L = Lt ? SEQ : CTXL;
        float z[4], tn[4];
#pragma unroll
        for (int p = 0; p < 4; ++p) { const int pos = pos0 + p; tn[p] = (float)pos / (float)(L - 1); z[p] = 0.f;
            if (lane == 0) z[p] = tn[p];
            else if (lane <= 32) { const int j = (lane - 1) & 15; const float fj = 1e-4f + (float)j * ((15.f - 1e-4f) / 15.f);
                double rev = (double)fj * (double)pos / (double)L; rev -= floor(rev); const float rf = (float)rev;
                z[p] = lane <= 16 ? sin_rev(rf + 0.25f) : -sin_rev(rf); } }
        const float* w1 = a.in[I_HYW1] + l * 33 * 64; const float* w2 = a.in[I_HYW2] + l * 64 * 64; const float* w3 = a.in[I_HYW3] + l * 64 * 64; const float* w4 = a.in[I_HYW4] + l * 64 * 512;
        const float* fq = a.in[I_HYFREQ] + l * 3 * 64;
        float s[4], h[4];
        { const float bb = a.in[I_HYB1][l * 64 + lane];
#pragma unroll
          for (int p = 0; p < 4; ++p) s[p] = bb; }
#pragma unroll
        for (int i = 0; i < 33; ++i) { const float ww = w1[i * 64 + lane];
#pragma unroll
            for (int p = 0; p < 4; ++p) s[p] += rdlane_f(z[p], i) * ww; }
#pragma unroll
        for (int p = 0; p < 4; ++p) h[p] = sin_rad(fq[lane] * s[p]);
        { const float bb = a.in[I_HYB2][l * 64 + lane];
#pragma unroll
          for (int p = 0; p < 4; ++p) s[p] = bb; }
#pragma unroll 16
        for (int i = 0; i < 64; ++i) { const float ww = w2[i * 64 + lane];
#pragma unroll
            for (int p = 0; p < 4; ++p) s[p] += rdlane_f(h[p], i) * ww; }
#pragma unroll
        for (int p = 0; p < 4; ++p) h[p] = sin_rad(fq[64 + lane] * s[p]);
        { const float bb = a.in[I_HYB3][l * 64 + lane];
#pragma unroll
          for (int p = 0; p < 4; ++p) s[p] = bb; }
#pragma unroll 16
        for (int i = 0; i < 64; ++i) { const float ww = w3[i * 64 + lane];
#pragma unroll
            for (int p = 0; p < 4; ++p) s[p] += rdlane_f(h[p], i) * ww; }
#pragma unroll
        for (int p = 0; p < 4; ++p) h[p] = sin_rad(fq[128 + lane] * s[p]);
        float k[8][4];
#pragma unroll
        for (int m = 0; m < 8; ++m)
#pragma unroll
            for (int p = 0; p < 4; ++p) k[m][p] = 0.f;
#pragma unroll 4
        for (int i = 0; i < 64; ++i) { float hi[4];
#pragma unroll
            for (int p = 0; p < 4; ++p) hi[p] = rdlane_f(h[p], i);
#pragma unroll
            for (int m = 0; m < 8; ++m) { const float ww = w4[i * 512 + m * 64 + lane];
#pragma unroll
                for (int p = 0; p < 4; ++p) k[m][p] += hi[p] * ww; } }
#pragma unroll
        for (int m = 0; m < 8; ++m) { const int o = m * 64 + lane, ch = o & 255;
            const float delta = 3.0701134573253944f + (float)ch * ((15.350567286626972f - 3.0701134573253944f) / 255.f);
            *(f32x4*)(KUN + ((size_t)((l * 2 + Lt) * 512 + o)) * 2048 + pos0) = (f32x4){k[m][0] * __expf(-tn[0] * delta), k[m][1] * __expf(-tn[1] * delta), k[m][2] * __expf(-tn[2] * delta), k[m][3] * __expf(-tn[3] * delta)}; }
    }
}

__device__ __forceinline__ void ph_router_w(CArgs& a, int gt, int ngt) {
    bf16* hi = (bf16*)(a.ws + WS_WRT); bf16* lo = hi + DEPTH * NEXP * D;
    for (int i = gt; i < DEPTH * NEXP * D; i += ngt) { const int l = i / (NEXP * D), r = i % (NEXP * D), e = r / D, k = r % D;
        const float w = a.in[I_WR][((size_t)l * D + k) * NEXP + e]; const unsigned h = f2bf(w); hi[i] = (bf16)h; lo[i] = (bf16)f2bf(w - bf2f(h)); }
}
__device__ __forceinline__ void tr_item(const float* W, int Nsrc, int K, bf16* WTrow0, int n0, int k0, LAS float* scr, int lane) {
    const int c4 = (lane & 7) * 4; const bool ok = n0 + c4 < Nsrc;
    f32x4 t[8];
#pragma unroll
    for (int j = 0; j < 8; ++j) { const int kk = 8 * j + (lane >> 3); t[j] = ok ? *(const f32x4*)(W + (size_t)(k0 + kk) * Nsrc + n0 + c4) : (f32x4){0.f, 0.f, 0.f, 0.f}; }
#pragma unroll
    for (int j = 0; j < 8; ++j) { const int kk = 8 * j + (lane >> 3); LAS float* d = scr + kk * 33 + c4; d[0] = t[j][0]; d[1] = t[j][1]; d[2] = t[j][2]; d[3] = t[j][3]; }
    asm volatile("s_waitcnt lgkmcnt(0)" ::: "memory");
    const int c = lane & 7;
#pragma unroll
    for (int j = 0; j < 4; ++j) { const int n = (lane >> 3) + 8 * j; const LAS float* s = scr + (8 * c) * 33 + n;
        u32x4 o; o.x = pk2(s[0 * 33], s[1 * 33]); o.y = pk2(s[2 * 33], s[3 * 33]); o.z = pk2(s[4 * 33], s[5 * 33]); o.w = pk2(s[6 * 33], s[7 * 33]);
        *(u32x4*)(WTrow0 + (size_t)n * K + k0 + 8 * c) = o; }
    asm volatile("s_waitcnt lgkmcnt(0)" ::: "memory");
}
__device__ __forceinline__ void tr_item_f8(const float* W, int Nsrc, int K, unsigned char* WTrow0, int n0, int k0, float scale, LAS float* scr, int lane) {
    const int c4 = (lane & 7) * 4;
    f32x4 t[8];
#pragma unroll
    for (int j = 0; j < 8; ++j) { const int kk = 8 * j + (lane >> 3); t[j] = *(const f32x4*)(W + (size_t)(k0 + kk) * Nsrc + n0 + c4); }
#pragma unroll
    for (int j = 0; j < 8; ++j) { const int kk = 8 * j + (lane >> 3); LAS float* d = scr + kk * 33 + c4; d[0] = t[j][0]; d[1] = t[j][1]; d[2] = t[j][2]; d[3] = t[j][3]; }
    asm volatile("s_waitcnt lgkmcnt(0)" ::: "memory");
    const int n = lane >> 1, half = lane & 1; const LAS float* s = scr + (32 * half) * 33 + n;
    unsigned o[8];
#pragma unroll
    for (int i = 0; i < 8; ++i) o[i] = pk4_fp8(s[(4 * i) * 33] * scale, s[(4 * i + 1) * 33] * scale, s[(4 * i + 2) * 33] * scale, s[(4 * i + 3) * 33] * scale);
    unsigned char* dst = WTrow0 + (size_t)n * K + k0 + 32 * half;
    *(u32x4*)dst = (u32x4){o[0], o[1], o[2], o[3]}; *(u32x4*)(dst + 16) = (u32x4){o[4], o[5], o[6], o[7]};
    asm volatile("s_waitcnt lgkmcnt(0)" ::: "memory");
}
__device__ __forceinline__ void ph_tr_small(CArgs& a, LAS unsigned char* lds, int gw, int ngw) {
    const int lane = tidx() & 63, w = tidx() >> 6;
    LAS float* scr = (LAS float*)(lds + w * 8448);
    constexpr int I_IN = 16 * (D_INP / 32), I_OUT = 16 * 32;
    for (int it = gw; it < DEPTH * (I_IN + I_OUT); it += ngw) {
        const int l = it / (I_IN + I_OUT); int r = it % (I_IN + I_OUT);
        if (r < I_IN) { const int kb = r / (D_INP / 32), nb = r % (D_INP / 32);
            tr_item(a.in[I_WIN] + (size_t)l * 1024 * D_IN, D_IN, 1024, (bf16*)(a.ws + WS_WIN) + ((size_t)l * D_INP + nb * 32) * 1024, nb * 32, kb * 64, scr, lane); }
        else { r -= I_IN; const int kb = r / 32, nb = r % 32;
            tr_item(a.in[I_WOUT] + (size_t)l * 1024 * 1024, 1024, 1024, (bf16*)(a.ws + WS_WOUT) + ((size_t)l * 1024 + nb * 32) * 1024, nb * 32, kb * 64, scr, lane); }
    }
}
__device__ __forceinline__ void tr_experts_range(CArgs& a, int l, LAS unsigned char* scrb, int first, int last, int stride, int lane) {
    LAS float* scr = (LAS float*)scrb;
#pragma unroll 1
    for (int it = first; it < last; it += stride) {
        const int e = it / 1536, r = it % 1536, which = r / 512, q = r % 512, kb = q / 32, nb = q % 32, n0 = nb * 32;
        const float* W = a.in[which == 0 ? I_WG : (which == 1 ? I_WU : I_WD)] + ((size_t)(l * NEXP + e)) * 1024 * 1024;
        if (which == 2) tr_item_f8(W, 1024, 1024, a.ws + WS_WD + ((size_t)e * 1024 + n0) * 1024, n0, kb * 64, 32.f, scr, lane);
        else tr_item_f8(W, 1024, 1024, a.ws + WS_WGU + ((size_t)e * 2048 + (n0 >> 7) * 256 + which * 128 + (n0 & 127)) * 1024, n0, kb * 64, 32.f, scr, lane);
    }
}
struct CvbRegs { f32x4 t[16]; };
__device__ __forceinline__ void cvb_load(CArgs& a, int l, int bit, int w, int lane, CvbRegs& r) {
    const int kbb = bit & 7, nb = (bit >> 3) & 3, m = bit >> 5, e = m / 3, which = m - 3 * e;
    const float* W = a.in[which == 0 ? I_WG : (which == 1 ? I_WU : I_WD)] + ((size_t)(l * NEXP + e)) * 1024 * 1024 + (size_t)(128 * kbb + 16 * w) * 1024 + 256 * nb + 4 * lane;
#pragma unroll
    for (int j = 0; j < 16; ++j) r.t[j] = *(const f32x4*)(W + (size_t)j * 1024);
}
__device__ __forceinline__ void cvb_store(CArgs& a, int bit, int w, int lane, const CvbRegs& r, LAS unsigned char* T) {
    const int tid = w * 64 + lane;
#pragma unroll
    for (int i = 0; i < 4; ++i) { u32x4 o;
        o.x = pk4_fp8(32.f * r.t[0][i], 32.f * r.t[1][i], 32.f * r.t[2][i], 32.f * r.t[3][i]); o.y = pk4_fp8(32.f * r.t[4][i], 32.f * r.t[5][i], 32.f * r.t[6][i], 32.f * r.t[7][i]);
        o.z = pk4_fp8(32.f * r.t[8][i], 32.f * r.t[9][i], 32.f * r.t[10][i], 32.f * r.t[11][i]); o.w = pk4_fp8(32.f * r.t[12][i], 32.f * r.t[13][i], 32.f * r.t[14][i], 32.f * r.t[15][i]);
        *(LAS u32x4*)(T + (4 * lane + i) * 144 + 16 * w) = o; }
    __syncthreads();
    const int kbb = bit & 7, nb = (bit >> 3) & 3, m = bit >> 5, e = m / 3, which = m - 3 * e;
#pragma unroll
    for (int q = 0; q < 4; ++q) { const int p = tid + 512 * q, row = p >> 3, c = p & 7, n = 256 * nb + row;
        const u32x4 v = *(const LAS u32x4*)(T + row * 144 + 16 * c);
        unsigned char* dst = (which == 2 ? a.ws + WS_WD + ((size_t)e * 1024 + n) * 1024 : a.ws + WS_WGU + ((size_t)e * 2048 + (n >> 7) * 256 + which * 128 + (n & 127)) * 1024) + 128 * kbb + 16 * c;
        *(u32x4*)dst = v; }
}
__device__ __forceinline__ void ph_mod_input(CArgs& a, int gw, int ngw) {
    const int lane = tidx() & 63;
    const float* MOD = (const float*)(a.ws + WS_MOD);
    bf16* HB = (bf16*)(a.ws + WS_HB);
    for (int row = gw; row < NTOK; row += ngw) {
        const float* src = row < NTOK_C ? a.in[I_CTX] + (size_t)row * D : a.in[I_X] + (size_t)(row - NTOK_C) * D;
        const float* mv = MOD + (size_t)mod_vec(row) * 6144;
#pragma unroll
        for (int j = 0; j < 4; ++j) { const int c0 = j * 256 + lane * 4; const f32x4 x = *(const f32x4*)(src + c0), sh = *(const f32x4*)(mv + c0), sc = *(const f32x4*)(mv + 1024 + c0);
            u32x2 o; o.x = pk2(x[0] * (1.f + sc[0]) + sh[0], x[1] * (1.f + sc[1]) + sh[1]); o.y = pk2(x[2] * (1.f + sc[2]) + sh[2], x[3] * (1.f + sc[3]) + sh[3]);
            *(u32x2*)(HB + (size_t)row * D + c0) = o; }
    }
}

struct Chunk { int b, t0, L, row0, lo, hi; };
__device__ __forceinline__ Chunk chunk_of(int it) {
    Chunk c;
    if (it < 64) { c.b = it >> 2; c.t0 = (it & 3) * 64; c.L = CTXL; c.row0 = c.b * CTXL + c.t0; c.lo = 0; c.hi = CTXL; }
    else { const int r = it - 64; c.b = r >> 5; c.t0 = (r & 31) * 64; c.L = SEQ; c.row0 = NTOK_C + c.b * SEQ + c.t0; c.lo = c.t0; c.hi = c.t0 + 64; }
    return c;
}
__device__ __forceinline__ f32x4 bf4(u32x2 v) { return (f32x4){lo_bf(v.x), hi_bf(v.x), lo_bf(v.y), hi_bf(v.y)}; }
__device__ __forceinline__ void ph_prep_conv(CArgs& a, int l, LAS unsigned char* lds, int bid, int nblk) {
    const bf16* P = (const bf16*)(a.ws + WS_P);
    bf16* ZT = (bf16*)(a.ws + WS_MIX + MX_ZT); bf16* YMIX = (bf16*)(a.ws + WS_YMIX);
    LAS bf16* zt = (LAS bf16*)lds;
    const int tid = tidx(), c4 = (tid & 63) * 4, tg = tid >> 6;
    const float* hw = a.in[I_HYCW] + l * 3 * 768; const float* hb = a.in[I_HYCB] + l * 768; const float* sw = a.in[I_SCCW] + l * 3 * 256;
    f32x4 wx[3], wv[3], ws3[3];
#pragma unroll
    for (int k = 0; k < 3; ++k) { wx[k] = *(const f32x4*)(hw + k * 768 + 256 + c4); wv[k] = *(const f32x4*)(hw + k * 768 + 512 + c4); ws3[k] = *(const f32x4*)(sw + k * 256 + c4); }
    const f32x4 bx = *(const f32x4*)(hb + 256 + c4), bv = *(const f32x4*)(hb + 512 + c4);
#pragma unroll 1
    for (int it = bid + (l == DEPTH - 1 ? 64 : 0); it < 576; it += nblk) {
        const Chunk c = chunk_of(it);
        const int tb = c.t0 + tg * 8;
        const bf16* pb = P + (size_t)(c.row0 + tg * 8) * D_INP;
        f32x4 x1[10], vv[10], mm[10];
#pragma unroll
        for (int r = 0; r < 10; ++r) { const int t = tb + r - 1, tc = min(max(t, c.lo), c.hi - 1); const float ok = (t == tc) ? 1.f : 0.f; const bf16* p = pb + (ptrdiff_t)(tc - tb) * D_INP;
            x1[r] = ok * bf4(*(const u32x2*)(p + HY0 + 256 + c4)); vv[r] = ok * bf4(*(const u32x2*)(p + HY0 + 512 + c4));
            mm[r] = ok * bf4(*(const u32x2*)(p + SC0 + 256 + c4)) * bf4(*(const u32x2*)(p + SC0 + 512 + c4)); }
#pragma unroll
        for (int tt = 0; tt < 8; ++tt) {
            const f32x4 xx = wx[0] * x1[tt] + wx[1] * x1[tt + 1] + wx[2] * x1[tt + 2] + bx, v2 = wv[0] * vv[tt] + wv[1] * vv[tt + 1] + wv[2] * vv[tt + 2] + bv, z = xx * v2;
            u32x2 zo; zo.x = pk2(z[0], z[1]); zo.y = pk2(z[2], z[3]); *(LAS u32x2*)(zt + (tg * 8 + tt) * 264 + c4) = zo;
            const f32x4 bg = bf4(*(const u32x2*)(pb + (size_t)tt * D_INP + SC0 + c4));
            const f32x4 y = bg * (ws3[0] * mm[tt] + ws3[1] * mm[tt + 1] + ws3[2] * mm[tt + 2]);
            u32x2 yo; yo.x = pk2(y[0], y[1]); yo.y = pk2(y[2], y[3]); *(u32x2*)(YMIX + (size_t)(c.row0 + tg * 8 + tt) * D + 256 + c4) = yo;
        }
        __syncthreads();
        { const int ch = tid & 255, g0 = (tid >> 8) * 4;
          const int soff = c.L == CTXL ? 0 : CTXL;
#pragma unroll
          for (int g = 0; g < 4; ++g) { const int t8 = (g0 + g) * 8; unsigned short e[8];
#pragma unroll
              for (int j = 0; j < 8; ++j) e[j] = zt[(t8 + j) * 264 + ch];
              u32x4 o; o.x = e[0] | ((unsigned)e[1] << 16); o.y = e[2] | ((unsigned)e[3] << 16); o.z = e[4] | ((unsigned)e[5] << 16); o.w = e[6] | ((unsigned)e[7] << 16);
              *(u32x4*)(ZT + ((size_t)(ch * 16 + c.b)) * 2304 + soff + c.t0 + t8) = o; } }
        __syncthreads();
    }
}
__device__ __forceinline__ void ph_prep_tok(CArgs& a, int l, LAS unsigned char* lds, int gw, int ngw) {
    const int tid = tidx(), lane = tid & 63;
    const bf16* P = (const bf16*)(a.ws + WS_P);
    float* GDF = (float*)(a.ws + WS_MIX + MX_GDF); float* GDB = (float*)(a.ws + WS_MIX + MX_GDB);
    float* DQ = (float*)(a.ws + WS_MIX + MX_DQ); float* DK = (float*)(a.ws + WS_MIX + MX_DK); float* DV = (float*)(a.ws + WS_MIX + MX_DV); float* DG = (float*)(a.ws + WS_MIX + MX_DG);
    LAS float* swa = (LAS float*)(lds + 40960);
    LAS float* sba = swa + 4096;
    LAS float* scw = sba + 256;
    { const float* wa = a.in[I_GLAWA] + l * 2 * 16 * 128; const float* ba = a.in[I_GLABA] + l * 2 * 128; const float* cw = a.in[I_GDNCW] + l * 3 * 768;
      for (int i = tid; i < 4096; i += 512) swa[i] = wa[i];
      if (tid < 256) sba[tid] = ba[tid];
      for (int i = tid; i < 2304; i += 512) scw[i] = cw[i]; }
    const int gh = lane & 3, gr = (lane >> 2) & 3;
    const float eaf = -__expf(a.in[I_GDNALOG][l * 8 + gh]), eab = -__expf(a.in[I_GDNALOG][l * 8 + 4 + gh]), dtf = a.in[I_GDNDT][l * 8 + gh], dtb = a.in[I_GDNDT][l * 8 + 4 + gh];
    __syncthreads();
#pragma unroll 1
    for (int row0 = gw * 4; row0 < NTOK; row0 += ngw * 4) {
        int z = 0; asm volatile("" : "+v"(z));
        const LAS float* wa = swa + z; const LAS float* cw = scw + z;
        const bf16* pr0 = P + (size_t)row0 * D_INP;
        int tpos, lo, hi;
        if (row0 < NTOK_C) { tpos = row0 & 255; lo = 0; hi = CTXL; } else { tpos = (row0 - NTOK_C) & 2047; lo = tpos & ~63; hi = lo + 64; }
        bf16 avb[4]; u32x2 xr[3][6]; bf16 gb4[4];
#pragma unroll
        for (int r = 0; r < 4; ++r) avb[r] = pr0[(size_t)r * D_INP + GLA0 + 768 + (lane & 31)];
#pragma unroll
        for (int g = 0; g < 3; ++g)
#pragma unroll
            for (int r = 0; r < 6; ++r) { const int tc = min(max(tpos + r - 1, lo), hi - 1); xr[g][r] = *(const u32x2*)(pr0 + (ptrdiff_t)(tc - tpos) * D_INP + GDN0 + g * 256 + 4 * lane); }
#pragma unroll
        for (int i = 0; i < 4; ++i) gb4[i] = pr0[(size_t)gr * D_INP + GDN0 + 1024 + 4 * i + gh];
        float av[4], s[4][4];
#pragma unroll
        for (int r = 0; r < 4; ++r) { av[r] = bf2f(avb[r]); s[r][0] = sba[lane]; s[r][1] = sba[64 + lane]; s[r][2] = sba[128 + lane]; s[r][3] = sba[192 + lane]; }
#pragma unroll
        for (int i = 0; i < 16; ++i) { const float w0 = wa[i * 128 + lane], w1 = wa[i * 128 + 64 + lane], w2 = wa[2048 + i * 128 + lane], w3 = wa[2048 + i * 128 + 64 + lane];
#pragma unroll
            for (int r = 0; r < 4; ++r) { const float af = rdlane_f(av[r], i), ab = rdlane_f(av[r], 16 + i); s[r][0] += af * w0; s[r][1] += af * w1; s[r][2] += ab * w2; s[r][3] += ab * w3; } }
#pragma unroll
        for (int r = 0; r < 4; ++r) { const size_t o = (size_t)(row0 + r) * 128;
            ((bf16*)GDF)[o + lane] = (bf16)f2bf(logsigmoidf_(s[r][0]) * 0.0625f); ((bf16*)GDF)[o + 64 + lane] = (bf16)f2bf(logsigmoidf_(s[r][1]) * 0.0625f);
            ((bf16*)GDB)[o + lane] = (bf16)f2bf(logsigmoidf_(s[r][2]) * 0.0625f); ((bf16*)GDB)[o + 64 + lane] = (bf16)f2bf(logsigmoidf_(s[r][3]) * 0.0625f); }
        float sq[4] = {0.f, 0.f, 0.f, 0.f}, sk[4] = {0.f, 0.f, 0.f, 0.f}; f32x4 qv[4], kv[4];
#pragma unroll
        for (int g = 0; g < 3; ++g) { const int col = g * 256 + 4 * lane;
            f32x4 x[6];
#pragma unroll
            for (int r = 0; r < 6; ++r) { const int t = tpos + r - 1; x[r] = (t >= lo && t < hi) ? bf4(xr[g][r]) : (f32x4){0.f, 0.f, 0.f, 0.f}; }
            const f32x4 w0 = *(const LAS f32x4*)(cw + col), w1 = *(const LAS f32x4*)(cw + 768 + col), w2 = *(const LAS f32x4*)(cw + 1536 + col);
#pragma unroll
            for (int r = 0; r < 4; ++r) { f32x4 y = w0 * x[r] + w1 * x[r + 1] + w2 * x[r + 2];
                y[0] = siluf_(y[0]); y[1] = siluf_(y[1]); y[2] = siluf_(y[2]); y[3] = siluf_(y[3]);
                if (g == 0) { qv[r] = y; sq[r] = (y[0] * y[0] + y[1] * y[1]) + (y[2] * y[2] + y[3] * y[3]); }
                else if (g == 1) { kv[r] = y; sk[r] = (y[0] * y[0] + y[1] * y[1]) + (y[2] * y[2] + y[3] * y[3]); }
                else *(u32x2*)((bf16*)DV + (size_t)(row0 + r) * 256 + 4 * lane) = (u32x2){pk2(y[0], y[1]), pk2(y[2], y[3])}; } }
#pragma unroll
        for (int r = 0; r < 4; ++r) { const float rq = rsqrtf(row16_sum(sq[r]) + 1e-6f) * 0.125f, rk = rsqrtf(row16_sum(sk[r]) + 1e-6f);
            const f32x4 qn = qv[r] * rq, kn = kv[r] * rk;
            *(u32x2*)((bf16*)(a.ws + WS_CKD + CD_QB) + (size_t)(row0 + r) * 256 + 4 * lane) = (u32x2){pk2(qn[0], qn[1]), pk2(qn[2], qn[3])};
            *(u32x2*)((bf16*)(a.ws + WS_CKD + CD_KB) + (size_t)(row0 + r) * 256 + 4 * lane) = (u32x2){pk2(kn[0], kn[1]), pk2(kn[2], kn[3])}; }
        if (lane < 16) { const float af = bf2f(gb4[0]), ab = bf2f(gb4[1]), bfv = bf2f(gb4[2]), bbv = bf2f(gb4[3]);
            const float gf = eaf * softplusf_(af + dtf), gb = eab * softplusf_(ab + dtb);
            *(f32x4*)(DG + (size_t)(row0 + gr) * 16 + 4 * gh) = (f32x4){sigmoidf_(bfv), gf, sigmoidf_(bbv), gb}; }
    }
}

__device__ __forceinline__ int scan_row(int b, int dir, int n) {
    if (n < CTXL) return b * CTXL + (dir ? CTXL - 1 - n : n);
    const int m = n - CTXL; return NTOK_C + b * SEQ + (dir ? SEQ - 1 - m : m);
}
__device__ __forceinline__ void gla_chain(CArgs& a, int chain, LAS unsigned char* lds) {
    const int b = chain >> 3, h = (chain >> 1) & 3, dir = chain & 1;
    const int tid = tidx(), lane = tid & 63, w = tid >> 6, vv = lane & 7, kq = lane >> 3;
    const bf16* P = (const bf16*)(a.ws + WS_P);
    const float* GD = (const float*)(a.ws + WS_MIX + (dir ? MX_GDB : MX_GDF));
    float* GO = (float*)(a.ws + WS_MIX + (dir ? MX_GOB : MX_GOF));
    LAS float* sq = (LAS float*)lds;
    LAS float* sk = sq + 64 * 32;
    LAS float* sd = sk + 64 * 32;
    LAS float* sv = sd + 64 * 32;
    float S[4] = {0.f, 0.f, 0.f, 0.f};
    for (int ch = 0; ch < 36; ++ch) {
        { const int tt = tid >> 3, sub = tid & 7, row = scan_row(b, dir, ch * 64 + tt);
          const bf16* pr = P + (size_t)row * D_INP + GLA0;
          const u32x2 qv = *(const u32x2*)(pr + h * 32 + sub * 4), kv = *(const u32x2*)(pr + 128 + h * 32 + sub * 4);
          const f32x4 dv = *(const f32x4*)(GD + (size_t)row * 128 + h * 32 + sub * 4);
          const u32x4 vv8 = *(const u32x4*)(pr + 256 + h * 64 + sub * 8);
          const float qs = 0.17677669529663687f;
          *(LAS f32x4*)(sq + tt * 32 + sub * 4) = (f32x4){lo_bf(qv.x) * qs, hi_bf(qv.x) * qs, lo_bf(qv.y) * qs, hi_bf(qv.y) * qs};
          *(LAS f32x4*)(sk + tt * 32 + sub * 4) = (f32x4){lo_bf(kv.x), hi_bf(kv.x), lo_bf(kv.y), hi_bf(kv.y)};
          *(LAS f32x4*)(sd + tt * 32 + sub * 4) = dv;
          *(LAS f32x4*)(sv + tt * 64 + sub * 8) = (f32x4){lo_bf(vv8.x), hi_bf(vv8.x), lo_bf(vv8.y), hi_bf(vv8.y)};
          *(LAS f32x4*)(sv + tt * 64 + sub * 8 + 4) = (f32x4){lo_bf(vv8.z), hi_bf(vv8.z), lo_bf(vv8.w), hi_bf(vv8.w)}; }
        __syncthreads();
#pragma unroll 4
        for (int tt = 0; tt < 64; ++tt) {
            const f32x4 q4 = *(const LAS f32x4*)(sq + tt * 32 + kq * 4), k4 = *(const LAS f32x4*)(sk + tt * 32 + kq * 4), d4 = *(const LAS f32x4*)(sd + tt * 32 + kq * 4);
            const float v = sv[tt * 64 + w * 8 + vv];
            float o = 0.f;
#pragma unroll
            for (int j = 0; j < 4; ++j) { S[j] = d4[j] * S[j] + k4[j] * v; o += q4[j] * S[j]; }
            o += __shfl_xor(o, 8); o += __shfl_xor(o, 16); o += __shfl_xor(o, 32);
            if (kq == 0) GO[(size_t)scan_row(b, dir, ch * 64 + tt) * 256 + h * 64 + w * 8 + vv] = o;
        }
        __syncthreads();
    }
}
__device__ __forceinline__ void gdn_chain(CArgs& a, int chain, LAS unsigned char* lds) {
    const int b = chain >> 3, h = (chain >> 1) & 3, dir = chain & 1;
    const int tid = tidx(), lane = tid & 63, w = tid >> 6, vv = lane & 7, kq = lane >> 3;
    const float* DQ = (const float*)(a.ws + WS_MIX + MX_DQ); const float* DK = (const float*)(a.ws + WS_MIX + MX_DK); const float* DV = (const float*)(a.ws + WS_MIX + MX_DV);
    const float* DG = (const float*)(a.ws + WS_MIX + MX_DG);
    float* DO = (float*)(a.ws + WS_MIX + (dir ? MX_DOB : MX_DOF));
    LAS float* sq = (LAS float*)lds;
    LAS float* sk = sq + 64 * 64;
    LAS float* sv = sk + 64 * 64;
    LAS float* sg = sv + 64 * 64;
    float S[8];
#pragma unroll
    for (int j = 0; j < 8; ++j) S[j] = 0.f;
    for (int ch = 0; ch < 36; ++ch) {
        { const int tt = tid >> 3, sub = tid & 7, row = scan_row(b, dir, ch * 64 + tt);
          const size_t o = (size_t)row * 256 + h * 64 + sub * 8;
          *(LAS f32x4*)(sq + tt * 64 + sub * 8) = *(const f32x4*)(DQ + o); *(LAS f32x4*)(sq + tt * 64 + sub * 8 + 4) = *(const f32x4*)(DQ + o + 4);
          *(LAS f32x4*)(sk + tt * 64 + sub * 8) = *(const f32x4*)(DK + o); *(LAS f32x4*)(sk + tt * 64 + sub * 8 + 4) = *(const f32x4*)(DK + o + 4);
          *(LAS f32x4*)(sv + tt * 64 + sub * 8) = *(const f32x4*)(DV + o); *(LAS f32x4*)(sv + tt * 64 + sub * 8 + 4) = *(const f32x4*)(DV + o + 4);
          if (sub == 0) { const f32x4 g4 = *(const f32x4*)(DG + (size_t)row * 16 + h * 4); *(LAS f32x2*)(sg + tt * 2) = dir ? (f32x2){g4[2], g4[3]} : (f32x2){g4[0], g4[1]}; } }
        __syncthreads();
#pragma unroll 2
        for (int tt = 0; tt < 64; ++tt) {
            const f32x4 ka = *(const LAS f32x4*)(sk + tt * 64 + kq * 8), kb = *(const LAS f32x4*)(sk + tt * 64 + kq * 8 + 4);
            const f32x4 qa = *(const LAS f32x4*)(sq + tt * 64 + kq * 8), qb = *(const LAS f32x4*)(sq + tt * 64 + kq * 8 + 4);
            const float v = sv[tt * 64 + w * 8 + vv]; const f32x2 g2 = *(const LAS f32x2*)(sg + tt * 2);
            const float beta = g2.x, eg = g2.y;
            float ks = (ka[0] * S[0] + ka[1] * S[1]) + (ka[2] * S[2] + ka[3] * S[3]) + ((kb[0] * S[4] + kb[1] * S[5]) + (kb[2] * S[6] + kb[3] * S[7]));
            ks += __shfl_xor(ks, 8); ks += __shfl_xor(ks, 16); ks += __shfl_xor(ks, 32);
            const float wv = beta * (v - eg * ks);
            float o = 0.f;
#pragma unroll
            for (int j = 0; j < 4; ++j) { S[j] = eg * S[j] + ka[j] * wv; o += qa[j] * S[j]; }
#pragma unroll
            for (int j = 0; j < 4; ++j) { S[4 + j] = eg * S[4 + j] + kb[j] * wv; o += qb[j] * S[4 + j]; }
            o += __shfl_xor(o, 8); o += __shfl_xor(o, 16); o += __shfl_xor(o, 32);
            if (kq == 0) DO[(size_t)scan_row(b, dir, ch * 64 + tt) * 256 + h * 64 + w * 8 + vv] = o;
        }
        __syncthreads();
    }
}
typedef unsigned u32x4a __attribute__((ext_vector_type(4)));
__device__ __forceinline__ bf16x8 frag2(u32x2 lo, u32x2 hi) { return __builtin_bit_cast(bf16x8, (u32x4){lo.x, lo.y, hi.x, hi.y}); }
__device__ __forceinline__ u32x2 cvt4(f32x4 v) { return (u32x2){pk2(v[0], v[1]), pk2(v[2], v[3])}; }

struct GdnIn { f32x2 g2; bf16x8 ak[2], aq[2], bk[2][2]; unsigned kt8[8]; };
struct GdnIn2 { u32x4 R[4], Qv[4]; };
__device__ __forceinline__ void gdn_fetch(CArgs& a, int u, int w, int lane, GdnIn& in) {
    const int chain = u / 36, n = u % 36, b = chain >> 3, h = (chain >> 1) & 3, dir = chain & 1;
    const int r0 = scan_row(b, dir, n * 64), step = dir ? -1 : 1, fr = lane & 15, kg = lane >> 4;
    const float* DQ = (const float*)(a.ws + WS_MIX + MX_DQ) + h * 64; const float* DK = (const float*)(a.ws + WS_MIX + MX_DK) + h * 64; const float* DV = (const float*)(a.ws + WS_MIX + MX_DV) + h * 64;
    const float* DG = (const float*)(a.ws + WS_MIX + MX_DG);
    const bf16* KB = (const bf16*)(a.ws + WS_CKD + CD_KB) + (ptrdiff_t)r0 * 256 + h * 64; const bf16* QB = (const bf16*)(a.ws + WS_CKD + CD_QB) + (ptrdiff_t)r0 * 256 + h * 64;
    const ptrdiff_t ldt = (ptrdiff_t)step * 256;
    const bool isW = w >= 4; const int c0 = 16 * (w & 3), I1 = w >> 1;
    in.g2 = *(const f32x2*)(DG + (size_t)(r0 + step * lane) * 16 + h * 4 + dir * 2);
#pragma unroll
    for (int s = 0; s < 2; ++s) { in.ak[s] = *(const bf16x8*)(KB + (ptrdiff_t)(16 * I1 + fr) * ldt + 32 * s + 8 * kg); in.aq[s] = *(const bf16x8*)(QB + (ptrdiff_t)(16 * I1 + fr) * ldt + 32 * s + 8 * kg);
#pragma unroll
        for (int jj = 0; jj < 2; ++jj) in.bk[jj][s] = *(const bf16x8*)(KB + (ptrdiff_t)(16 * (2 * (w & 1) + jj) + fr) * ldt + 32 * s + 8 * kg); }
#pragma unroll
    for (int tt = 0; tt < 8; ++tt) in.kt8[tt] = KB[(ptrdiff_t)(8 * w + tt) * ldt + lane];
}
__device__ __forceinline__ void gdn_fetch2(CArgs& a, int u, int w, int lane, GdnIn2& in) {
    const int chain = u / 36, n = u % 36, b = chain >> 3, h = (chain >> 1) & 3, dir = chain & 1;
    const int r0 = scan_row(b, dir, n * 64), step = dir ? -1 : 1, fr = lane & 15, kg = lane >> 4;
    const bf16* QBh = (const bf16*)(a.ws + WS_CKD + CD_QB) + h * 64; const bf16* KBh = (const bf16*)(a.ws + WS_CKD + CD_KB) + h * 64; const bf16* VBh = (const bf16*)(a.ws + WS_MIX + MX_DV) + h * 64;
    const bool isW = w >= 4; const int c0 = 16 * (w & 3);
#pragma unroll
    for (int I = 0; I < 4; ++I)
#pragma unroll
        for (int e = 0; e < 4; ++e) { const size_t ro = (size_t)(r0 + step * (16 * I + 4 * kg + e)) * 256 + c0 + fr; in.R[I][e] = isW ? (unsigned)KBh[ro] : (unsigned)VBh[ro]; in.Qv[I][e] = isW ? (unsigned)QBh[ro] : 0u; }
}
__device__ __forceinline__ float gdn_s1(const GdnIn& in, LAS unsigned char* ub, LAS unsigned char* dwb, int w, int lane) {
    const int fr = lane & 15, kg = lane >> 4, I1 = w >> 1;
    LAS bf16* AB = (LAS bf16*)ub; LAS bf16* ATT = AB + 4608; LAS bf16* KTT = ATT + 4608; LAS float* GT = (LAS float*)(dwb + 2048);
    float beta = in.g2.x, cum = in.g2.y;
#pragma unroll
    for (int o = 1; o < 64; o <<= 1) { const float t = __shfl_up(cum, o); if (lane >= o) cum += t; }
    const float cl = rdlane_f(cum, 63);
    GT[lane] = beta; GT[64 + lane] = cum; GT[128 + lane] = __expf(cum);
    asm volatile("s_waitcnt lgkmcnt(0)" ::: "memory");
    { const f32x4 ci = *(const LAS f32x4*)(GT + 64 + 16 * I1 + 4 * kg), bi = *(const LAS f32x4*)(GT + 16 * I1 + 4 * kg);
#pragma unroll
      for (int jj = 0; jj < 2; ++jj) { const int J = 2 * (w & 1) + jj;
          f32x4 ck = (f32x4){0.f, 0.f, 0.f, 0.f}, cq = (f32x4){0.f, 0.f, 0.f, 0.f};
#pragma unroll
          for (int s = 0; s < 2; ++s) { ck = __builtin_amdgcn_mfma_f32_16x16x32_bf16(in.ak[s], in.bk[jj][s], ck, 0, 0, 0); cq = __builtin_amdgcn_mfma_f32_16x16x32_bf16(in.aq[s], in.bk[jj][s], cq, 0, 0, 0); }
          const int j = 16 * J + fr; const float cj = GT[64 + j];
#pragma unroll
          for (int e = 0; e < 4; ++e) { const int i = 16 * I1 + 4 * kg + e; const float gm = __expf(fminf(ci[e] - cj, 0.f));
              AB[i * 72 + j] = (bf16)f2bf(j < i ? bi[e] * ck[e] * gm : 0.f); ATT[i * 72 + j] = (bf16)f2bf(j <= i ? cq[e] * gm : 0.f); } } }
    { const f32x4 c8a = *(const LAS f32x4*)(GT + 64 + 8 * w), c8b = *(const LAS f32x4*)(GT + 64 + 8 * w + 4);
#pragma unroll
      for (int tt = 0; tt < 8; ++tt) KTT[lane * 72 + 8 * w + tt] = (bf16)f2bf(__uint_as_float(in.kt8[tt] << 16) * __expf(cl - (tt < 4 ? c8a[tt & 3] : c8b[tt & 3]))); }
    asm volatile("s_waitcnt lgkmcnt(0)" ::: "memory");
    return cl;
}
__device__ __forceinline__ void gdn_s23(CArgs& a, int u, const GdnIn2& in, LAS unsigned char* ub, LAS unsigned char* dwb, int w, int lane, float cl) {
    const int fr = lane & 15, kg = lane >> 4;
    bf16* Mo = (bf16*)(a.ws + WS_CKD + CD_M) + (size_t)u * 4096; bf16* Eo = (bf16*)(a.ws + WS_CKD + CD_E) + (size_t)u * 4096;
    bf16* BTo = (bf16*)(a.ws + WS_CKD + CD_BT) + (size_t)u * 4096; bf16* FTo = (bf16*)(a.ws + WS_CKD + CD_FT) + (size_t)u * 4096;
    LAS bf16* AB = (LAS bf16*)ub; LAS bf16* ATT = AB + 4608; LAS bf16* KTT = ATT + 4608; LAS bf16* DW = (LAS bf16*)dwb; LAS float* GT = (LAS float*)(dwb + 2048);
    const bool isW = w >= 4; const int c0 = 16 * (w & 3);
    { const int blk = lane >> 4, c = lane & 15; float T[16];
#pragma unroll
      for (int hb = 0; hb < 4; ++hb) {
          u32x4 arow[4][2];
#pragma unroll
          for (int rr = 0; rr < 4; ++rr) { const int r = 4 * hb + rr; arow[rr][0] = *(const LAS u32x4*)(AB + (16 * blk + r) * 72 + 16 * blk); if (hb >= 2) arow[rr][1] = *(const LAS u32x4*)(AB + (16 * blk + r) * 72 + 16 * blk + 8); }
          asm volatile("s_waitcnt lgkmcnt(0)" ::: "memory");
#pragma unroll
          for (int rr = 0; rr < 4; ++rr) { const int r = 4 * hb + rr; float t = (r == c) ? 1.f : 0.f;
              float t2 = 0.f;
#pragma unroll
              for (int j = 0; j < r; ++j) { const unsigned wv = arow[rr][j >> 3][(j >> 1) & 3]; const float av = (j & 1) ? hi_bf(wv) : lo_bf(wv); if (j & 1) t2 -= av * T[j]; else t -= av * T[j]; }
              t += t2;
              T[r] = t; DW[(blk * 16 + r) * 16 + c] = (bf16)f2bf(t); } } }
    asm volatile("s_waitcnt lgkmcnt(0)" ::: "memory");
    f32x4 X[4];
#pragma unroll
    for (int I = 0; I < 4; ++I) {
        const f32x4 br = *(const LAS f32x4*)(GT + 16 * I + 4 * kg), er = *(const LAS f32x4*)(GT + 128 + 16 * I + 4 * kg);
        const f32x4 Rf = (f32x4){__uint_as_float(in.R[I].x << 16), __uint_as_float(in.R[I].y << 16), __uint_as_float(in.R[I].z << 16), __uint_as_float(in.R[I].w << 16)};
        f32x4 acc = isW ? br * er * Rf : br * Rf;
#pragma unroll
        for (int P = 0; 2 * P < I; ++P) {
            const u32x2 alo = *(const LAS u32x2*)(AB + (16 * I + fr) * 72 + 32 * P + 4 * kg);
            const u32x2 ahi = (2 * P + 1 < I) ? *(const LAS u32x2*)(AB + (16 * I + fr) * 72 + 32 * P + 16 + 4 * kg) : (u32x2){0u, 0u};
            const u32x2 xlo = cvt4(-X[2 * P]); const u32x2 xhi = (2 * P + 1 < I) ? cvt4(-X[2 * P + 1]) : (u32x2){0u, 0u};
            acc = __builtin_amdgcn_mfma_f32_16x16x32_bf16(frag2(alo, ahi), frag2(xlo, xhi), acc, 0, 0, 0); }
        const u32x2 dlo = *(const LAS u32x2*)(DW + (I * 16 + fr) * 16 + 4 * kg);
        X[I] = __builtin_amdgcn_mfma_f32_16x16x32_bf16(frag2(dlo, (u32x2){0u, 0u}), frag2(cvt4(acc), (u32x2){0u, 0u}), (f32x4){0.f, 0.f, 0.f, 0.f}, 0, 0, 0);
    }
    const bf16x8 Xb01 = frag2(cvt4(X[0]), cvt4(X[1])), Xb23 = frag2(cvt4(X[2]), cvt4(X[3]));
    const float ecl = __expf(cl);
    bf16* ftp = FTo + (c0 + fr) * 64 + 4 * kg; bf16* btp = BTo + (c0 + fr) * 64 + 4 * kg; bf16* ep = Eo + (4 * kg) * 64 + c0 + fr; bf16* mp = Mo + (4 * kg) * 64 + c0 + fr;
#pragma unroll
    for (int t4 = 0; t4 < 4; ++t4) {
        const LAS bf16* ar = ATT + (16 * t4 + fr) * 72 + 4 * kg; const LAS bf16* kr = KTT + (16 * t4 + fr) * 72 + 4 * kg;
        f32x4 pa = (f32x4){0.f, 0.f, 0.f, 0.f}, pk = (f32x4){0.f, 0.f, 0.f, 0.f};
        pa = __builtin_amdgcn_mfma_f32_16x16x32_bf16(frag2(*(const LAS u32x2*)ar, *(const LAS u32x2*)(ar + 16)), Xb01, pa, 0, 0, 0);
        pa = __builtin_amdgcn_mfma_f32_16x16x32_bf16(frag2(*(const LAS u32x2*)(ar + 32), *(const LAS u32x2*)(ar + 48)), Xb23, pa, 0, 0, 0);
        pk = __builtin_amdgcn_mfma_f32_16x16x32_bf16(frag2(*(const LAS u32x2*)kr, *(const LAS u32x2*)(kr + 16)), Xb01, pk, 0, 0, 0);
        pk = __builtin_amdgcn_mfma_f32_16x16x32_bf16(frag2(*(const LAS u32x2*)(kr + 32), *(const LAS u32x2*)(kr + 48)), Xb23, pk, 0, 0, 0);
        if (!isW) {
            *(u32x2*)(ftp + 16 * t4) = cvt4(pa);
            *(u32x2*)(btp + 16 * t4) = cvt4(pk);
        } else {
            const f32x4 ec = *(const LAS f32x4*)(GT + 128 + 16 * t4 + 4 * kg);
#pragma unroll
            for (int e = 0; e < 4; ++e) { const int row = 16 * t4 + 4 * kg + e, col = c0 + fr;
                ep[(16 * t4 + e) * 64] = (bf16)f2bf(ec[e] * __uint_as_float(in.Qv[t4][e] << 16) - pa[e]);
                mp[(16 * t4 + e) * 64] = (bf16)f2bf((row == col ? ecl : 0.f) - pk[e]); }
        }
    }
}
__device__ __forceinline__ void gdn_chain_units(CArgs& a, int chain, LAS unsigned char* lds, int w, int lane, unsigned long long& tacc) {
    asm volatile("" : "+v"(lane));
    LAS unsigned char* dwb = lds + 55296 + w * 3072;
    GdnIn A, B; GdnIn2 C;
    gdn_fetch(a, chain * 36, w, lane, A);
#pragma unroll 1
    for (int n = 0; n < 36; n += 2) {
        asm volatile("" : "+v"(lane));
        { unsigned long long tq = 0ull; if (PROBE_PH >= 60 && PROBE_PH <= 62) tq = __builtin_amdgcn_s_memrealtime();
          gdn_fetch2(a, chain * 36 + n, w, lane, C); const float cl = gdn_s1(A, lds, dwb, w, lane);
          if (PROBE_PH == 60) tacc += __builtin_amdgcn_s_memrealtime() - tq; if (PROBE_PH == 61) tq = __builtin_amdgcn_s_memrealtime();
          __syncthreads();
          if (PROBE_PH == 61) tacc += __builtin_amdgcn_s_memrealtime() - tq; if (PROBE_PH >= 62 && PROBE_PH <= 64) tq = __builtin_amdgcn_s_memrealtime();
          gdn_fetch(a, chain * 36 + n + 1, w, lane, B); gdn_s23(a, chain * 36 + n, C, lds, dwb, w, lane, cl);
          if (PROBE_PH == 62 || (PROBE_PH == 63 && w < 4) || (PROBE_PH == 64 && w >= 4)) tacc += __builtin_amdgcn_s_memrealtime() - tq; }
        asm volatile("" : "+v"(lane));
        { gdn_fetch2(a, chain * 36 + n + 1, w, lane, C); const float cl = gdn_s1(B, lds + 27648, dwb, w, lane); __syncthreads(); if (n + 2 < 36) gdn_fetch(a, chain * 36 + n + 2, w, lane, A); gdn_s23(a, chain * 36 + n + 1, C, lds + 27648, dwb, w, lane, cl); }
    }
}
__device__ __forceinline__ void gdn_seq_wave(CArgs& a, int chain, int vs, int lane) {
    asm volatile("" : "+v"(lane));
    const int b = chain >> 3, h = (chain >> 1) & 3, dir = chain & 1, fr = lane & 15, kg = lane >> 4, v = 16 * vs + fr, step = dir ? -1 : 1;
    float* DO = (float*)(a.ws + WS_MIX + (dir ? MX_DOB : MX_DOF));
    f32x4 S[4];
#pragma unroll
    for (int i = 0; i < 4; ++i) S[i] = (f32x4){0.f, 0.f, 0.f, 0.f};
#pragma unroll 1
    for (int n = 0; n < 36; ++n) {
        const int u = chain * 36 + n, r0 = scan_row(b, dir, n * 64);
        const bf16* Mo = (const bf16*)(a.ws + WS_CKD + CD_M) + (size_t)u * 4096; const bf16* Eo = (const bf16*)(a.ws + WS_CKD + CD_E) + (size_t)u * 4096;
        const float* BTo = (const float*)(a.ws + WS_CKD + CD_BT) + (size_t)u * 4096; const bf16* FTo = (const bf16*)(a.ws + WS_CKD + CD_FT) + (size_t)u * 4096;
        u32x2 ef[4][2][2], mf[4][2][2], ff[4]; f32x4 bi[4];
#pragma unroll
        for (int t = 0; t < 4; ++t) { ff[t] = *(const u32x2*)(FTo + v * 64 + 16 * t + 4 * kg); bi[t] = *(const f32x4*)(BTo + v * 64 + 16 * t + 4 * kg);
#pragma unroll
            for (int s = 0; s < 2; ++s) { const bf16* er = Eo + (16 * t + fr) * 64 + 32 * s + 4 * kg; ef[t][s][0] = *(const u32x2*)er; ef[t][s][1] = *(const u32x2*)(er + 16);
                const bf16* mr = Mo + (16 * t + fr) * 64 + 32 * s + 4 * kg; mf[t][s][0] = *(const u32x2*)mr; mf[t][s][1] = *(const u32x2*)(mr + 16); } }
        bf16x8 Sb[2];
#pragma unroll
        for (int s = 0; s < 2; ++s) Sb[s] = frag2(cvt4(S[2 * s]), cvt4(S[2 * s + 1]));
        f32x4 o[4];
#pragma unroll
        for (int t = 0; t < 4; ++t) { o[t] = (f32x4){lo_bf(ff[t].x), hi_bf(ff[t].x), lo_bf(ff[t].y), hi_bf(ff[t].y)};
#pragma unroll
            for (int s = 0; s < 2; ++s) o[t] = __builtin_amdgcn_mfma_f32_16x16x32_bf16(frag2(ef[t][s][0], ef[t][s][1]), Sb[s], o[t], 0, 0, 0);
            f32x4 sn = bi[t];
#pragma unroll
            for (int s = 0; s < 2; ++s) sn = __builtin_amdgcn_mfma_f32_16x16x32_bf16(frag2(mf[t][s][0], mf[t][s][1]), Sb[s], sn, 0, 0, 0);
            S[t] = sn; }
#pragma unroll
        for (int t = 0; t < 4; ++t)
#pragma unroll
            for (int e = 0; e < 4; ++e) DO[(size_t)(r0 + step * (16 * t + 4 * kg + e)) * 256 + h * 64 + v] = o[t][e];
    }
}

__device__ __forceinline__ void gdn_seq_block(CArgs& a, int chain, LAS unsigned char* lds, int w, int lane) {
    asm volatile("" : "+v"(lane));
    const int b = chain >> 3, h = (chain >> 1) & 3, dir = chain & 1, fr = lane & 15, kg = lane >> 4, step = dir ? -1 : 1;
    constexpr int SLOT = 36864;
    if (w >= 4) {
        const int q = w - 4;
        u32x4 rg[8];
#define SEQ_LD(n_) do { const int u_ = chain * 36 + (n_); \
        _Pragma("unroll") for (int j = 0; j < 8; ++j) { const int c_ = q + 4 * j; \
            const unsigned char* g_ = c_ < 8 ? a.ws + WS_CKD + CD_M + (size_t)u_ * 8192 + c_ * 1024 : (c_ < 16 ? a.ws + WS_CKD + CD_E + (size_t)u_ * 8192 + (c_ - 8) * 1024 : \
                (c_ < 24 ? a.ws + WS_CKD + CD_BT + (size_t)u_ * 8192 + (c_ - 16) * 1024 : a.ws + WS_CKD + CD_FT + (size_t)u_ * 8192 + (c_ - 24) * 1024)); \
            rg[j] = *(const u32x4*)(g_ + lane * 16); } } while (0)
#define SEQ_ST(n_) do { LAS unsigned char* s_ = lds + ((n_) % 3) * SLOT; \
        _Pragma("unroll") for (int j = 0; j < 8; ++j) { const int c_ = q + 4 * j; \
            const int off_ = (c_ >> 3) * 9216 + ((c_ & 7) * 8 + (lane >> 3)) * 144 + (lane & 7) * 16; \
            *(LAS u32x4*)(s_ + off_) = rg[j]; } } while (0)
        SEQ_LD(0); SEQ_ST(0); SEQ_LD(1); SEQ_ST(1); SEQ_LD(2);
        asm volatile("s_waitcnt lgkmcnt(0)" ::: "memory");
        __syncthreads();
#pragma unroll 1
        for (int n = 0; n < 36; ++n) {
            if (n + 2 < 36) { SEQ_ST(n + 2); }
            if (n + 3 < 36) { SEQ_LD(n + 3); }
            asm volatile("s_waitcnt lgkmcnt(0)" ::: "memory");
            __syncthreads();
        }
#undef SEQ_LD
#undef SEQ_ST
    } else {
        const int v = 16 * w + fr;
        bf16* DO = (bf16*)(a.ws + WS_MIX + (dir ? MX_DOB : MX_DOF));
        f32x4 S[4];
#pragma unroll
        for (int i = 0; i < 4; ++i) S[i] = (f32x4){0.f, 0.f, 0.f, 0.f};
        __syncthreads();
#pragma unroll 1
        for (int n = 0; n < 36; ++n) {
            const LAS unsigned char* sl = lds + (n % 3) * SLOT; const int r0 = scan_row(b, dir, n * 64);
            bf16x8 Sb[2];
#pragma unroll
            for (int s = 0; s < 2; ++s) Sb[s] = frag2(cvt4(S[2 * s]), cvt4(S[2 * s + 1]));
            f32x4 o[4];
#pragma unroll
            for (int t = 0; t < 4; ++t) {
                const u32x2 ff = *(const LAS u32x2*)(sl + 27648 + v * 144 + (16 * t + 4 * kg) * 2);
                o[t] = (f32x4){lo_bf(ff.x), hi_bf(ff.x), lo_bf(ff.y), hi_bf(ff.y)};
                const u32x2 bb2 = *(const LAS u32x2*)(sl + 18432 + v * 144 + (16 * t + 4 * kg) * 2);
                f32x4 sn = (f32x4){lo_bf(bb2.x), hi_bf(bb2.x), lo_bf(bb2.y), hi_bf(bb2.y)};
#pragma unroll
                for (int s = 0; s < 2; ++s) { const LAS unsigned char* er = sl + 9216 + (16 * t + fr) * 144 + (32 * s + 4 * kg) * 2; const LAS unsigned char* mr = sl + (16 * t + fr) * 144 + (32 * s + 4 * kg) * 2;
                    o[t] = __builtin_amdgcn_mfma_f32_16x16x32_bf16(frag2(*(const LAS u32x2*)er, *(const LAS u32x2*)(er + 32)), Sb[s], o[t], 0, 0, 0);
                    sn = __builtin_amdgcn_mfma_f32_16x16x32_bf16(frag2(*(const LAS u32x2*)mr, *(const LAS u32x2*)(mr + 32)), Sb[s], sn, 0, 0, 0); }
                S[t] = sn; }
            { bf16* dp = DO + (ptrdiff_t)(r0 + step * 4 * kg) * 256 + h * 64 + v; const ptrdiff_t sd = (ptrdiff_t)step * 256;
#pragma unroll
              for (int t = 0; t < 4; ++t)
#pragma unroll
                  for (int e = 0; e < 4; ++e) dp[(16 * t + e) * sd] = (bf16)f2bf(o[t][e]); }
            __syncthreads();
        }
    }
}
__device__ __forceinline__ void gla_seq_block(CArgs& a, int chain, LAS unsigned char* lds, int w, int lane) {
    asm volatile("" : "+v"(lane));
    const int b = chain >> 3, h = (chain >> 1) & 3, dir = chain & 1, fr = lane & 15, kg = lane >> 4, step = dir ? -1 : 1;
    constexpr int SLOT = 19584;
    if (w >= 4) {
        const int q = w - 4;
        u32x4 rg[4]; float dl = 0.f;
#define SEQ_LD(n_) do { const int u_ = chain * 36 + (n_); \
        _Pragma("unroll") for (int j = 0; j < 4; ++j) { const int c_ = q + 4 * j; \
            const unsigned char* g_ = c_ < 4 ? a.ws + WS_CKA + CA_QC + (size_t)u_ * 4096 + c_ * 1024 : (c_ < 12 ? a.ws + WS_CKA + CA_FT + (size_t)u_ * 8192 + (c_ - 4) * 1024 : a.ws + WS_CKA + CA_UT + (size_t)u_ * 4096 + (c_ - 12) * 1024); \
            rg[j] = *(const u32x4*)(g_ + lane * 16); } \
        if (q == 0) dl = ((const float*)(a.ws + WS_CKA + CA_DL))[(size_t)u_ * 32 + (lane & 31)]; } while (0)
#define SEQ_ST(n_) do { LAS unsigned char* s_ = lds + ((n_) % 3) * SLOT; \
        _Pragma("unroll") for (int j = 0; j < 4; ++j) { const int c_ = q + 4 * j; \
            const int off_ = c_ < 4 ? (c_ * 16 + (lane >> 2)) * 80 + (lane & 3) * 16 : (c_ < 12 ? 5120 + ((c_ - 4) * 8 + (lane >> 3)) * 144 + (lane & 7) * 16 : 14336 + ((c_ - 12) * 16 + (lane >> 2)) * 80 + (lane & 3) * 16); \
            *(LAS u32x4*)(s_ + off_) = rg[j]; } \
        if (q == 0 && lane < 32) *(LAS float*)(s_ + 19456 + lane * 4) = dl; } while (0)
        SEQ_LD(0); SEQ_ST(0); SEQ_LD(1); SEQ_ST(1); SEQ_LD(2);
        asm volatile("s_waitcnt lgkmcnt(0)" ::: "memory");
        __syncthreads();
#pragma unroll 1
        for (int n = 0; n < 36; ++n) {
            if (n + 2 < 36) { SEQ_ST(n + 2); }
            if (n + 3 < 36) { SEQ_LD(n + 3); }
            asm volatile("s_waitcnt lgkmcnt(0)" ::: "memory");
            __syncthreads();
        }
#undef SEQ_LD
#undef SEQ_ST
    } else {
        const int v = 16 * w + fr;
        bf16* GO = (bf16*)(a.ws + WS_MIX + (dir ? MX_GOB : MX_GOF));
        f32x4 S[2] = {(f32x4){0.f, 0.f, 0.f, 0.f}, (f32x4){0.f, 0.f, 0.f, 0.f}};
        __syncthreads();
#pragma unroll 1
        for (int n = 0; n < 36; ++n) {
            const LAS unsigned char* sl = lds + (n % 3) * SLOT; const int r0 = scan_row(b, dir, n * 64);
            const bf16x8 Sb = frag2(cvt4(S[0]), cvt4(S[1]));
            f32x4 o[4];
#pragma unroll
            for (int t = 0; t < 4; ++t) { const u32x2 ff = *(const LAS u32x2*)(sl + 5120 + v * 144 + (16 * t + 4 * kg) * 2);
                o[t] = (f32x4){lo_bf(ff.x), hi_bf(ff.x), lo_bf(ff.y), hi_bf(ff.y)};
                const LAS unsigned char* qr = sl + (16 * t + fr) * 80 + 4 * kg * 2;
                o[t] = __builtin_amdgcn_mfma_f32_16x16x32_bf16(frag2(*(const LAS u32x2*)qr, *(const LAS u32x2*)(qr + 32)), Sb, o[t], 0, 0, 0); }
#pragma unroll
            for (int kt = 0; kt < 2; ++kt) { const f32x4 d4 = *(const LAS f32x4*)(sl + 19456 + (16 * kt + 4 * kg) * 4); const u32x2 u2 = *(const LAS u32x2*)(sl + 14336 + v * 80 + (16 * kt + 4 * kg) * 2);
                S[kt] = d4 * S[kt] + (f32x4){lo_bf(u2.x), hi_bf(u2.x), lo_bf(u2.y), hi_bf(u2.y)}; }
            { bf16* gp = GO + (ptrdiff_t)(r0 + step * 4 * kg) * 256 + h * 64 + v; const ptrdiff_t sd = (ptrdiff_t)step * 256;
#pragma unroll
              for (int t = 0; t < 4; ++t)
#pragma unroll
                  for (int e = 0; e < 4; ++e) gp[(16 * t + e) * sd] = (bf16)f2bf(o[t][e]); }
            __syncthreads();
        }
    }
}

struct GlaIn { float bc[32]; unsigned px[32]; };
__device__ __forceinline__ void gla_fetch(CArgs& a, int u, int w, int lane, GlaIn& in) {
    const int chain = u / 36, n = u % 36, b = chain >> 3, h = (chain >> 1) & 3, dir = chain & 1;
    const int r0 = scan_row(b, dir, n * 64), step = dir ? -1 : 1;
    const bf16* P = (const bf16*)(a.ws + WS_P);
    const bf16* GD = (const bf16*)(a.ws + WS_MIX + (dir ? MX_GDB : MX_GDF));
    if (w < 4) { const int k = lane & 31, half = lane >> 5; const int src_off = (w == 0 || w == 2) ? 0 : 128;
#pragma unroll
        for (int i = 0; i < 32; ++i) { in.bc[i] = __uint_as_float((unsigned)GD[(size_t)(r0 + step * (32 * half + i)) * 128 + h * 32 + k]); in.px[i] = P[(size_t)(r0 + step * (32 * half + i)) * D_INP + GLA0 + src_off + h * 32 + k]; }
    } else { const int vv = 16 * (w - 4) + (lane & 15), tq = lane >> 4;
#pragma unroll
        for (int i = 0; i < 16; ++i) in.px[i] = P[(size_t)(r0 + step * (16 * tq + i)) * D_INP + GLA0 + 256 + h * 64 + vv];
#pragma unroll
        for (int i = 16; i < 32; ++i) in.px[i] = 0u;
#pragma unroll
        for (int i = 0; i < 32; ++i) in.bc[i] = 0.f;
    }
}
__device__ __forceinline__ void gla_s1(CArgs& a, int u, GlaIn& in, LAS unsigned char* ub, int w, int lane) {
    bf16* QC = (bf16*)(a.ws + WS_CKA + CA_QC) + (size_t)u * 2048; float* DL = (float*)(a.ws + WS_CKA + CA_DL) + (size_t)u * 32;
    LAS bf16* QE = (LAS bf16*)ub; LAS bf16* KE = QE + 2560; LAS bf16* KTT = KE + 2560; LAS bf16* VT = KTT + 2304;
    if (w < 4) {
        const int k = lane & 31, half = lane >> 5;
        float run = 0.f;
#pragma unroll
        for (int i = 0; i < 32; ++i) { run += __uint_as_float(__float_as_uint(in.bc[i]) << 16); in.bc[i] = run; }
        const float tot0 = __shfl(run, k), tot1 = __shfl(run, 32 + k);
        const float bref = tot0, blast = tot0 + tot1, off = half ? tot0 : 0.f;
        const float sc = (w == 0 || w == 2) ? 0.17677669529663687f : 1.f;
#pragma unroll
        for (int i = 0; i < 32; ++i) { const int t = 32 * half + i; const float bi = in.bc[i] + off;
            const float x = bf2f(in.px[i]) * sc;
            const float ex = w == 0 ? bi - bref : (w == 1 ? bref - bi : (w == 2 ? bi : blast - bi));
            const bf16 y = (bf16)f2bf(x * __expf(ex));
            if (w == 0) QE[t * 40 + k] = y; else if (w == 1) KE[t * 40 + k] = y; else if (w == 2) QC[t * 32 + k] = y; else KTT[k * 72 + t] = y; }
        if (w == 2 && half == 0) DL[k] = __expf(blast);
    } else {
        const int vv = 16 * (w - 4) + (lane & 15), tq = lane >> 4;
#pragma unroll
        for (int i = 0; i < 16; ++i) VT[vv * 72 + 16 * tq + i] = in.px[i];
    }
    asm volatile("s_waitcnt lgkmcnt(0)" ::: "memory");
}
__device__ __forceinline__ void gla_s2(CArgs& a, int u, LAS unsigned char* ub, int w, int lane) {
    const int fr = lane & 15, kg = lane >> 4;
    bf16* FT = (bf16*)(a.ws + WS_CKA + CA_FT) + (size_t)u * 4096; bf16* UT = (bf16*)(a.ws + WS_CKA + CA_UT) + (size_t)u * 2048;
    LAS bf16* QE = (LAS bf16*)ub; LAS bf16* KE = QE + 2560; LAS bf16* KTT = KE + 2560; LAS bf16* VT = KTT + 2304;
    const int It = w & 3, vh = w >> 2;
    const bf16x8 qf = *(const LAS bf16x8*)(QE + (16 * It + fr) * 40 + 8 * kg);
    f32x4 st[4];
#pragma unroll
    for (int Jt = 0; Jt < 4; ++Jt) { const bf16x8 kf = *(const LAS bf16x8*)(KE + (16 * Jt + fr) * 40 + 8 * kg);
        st[Jt] = __builtin_amdgcn_mfma_f32_16x16x32_bf16(kf, qf, (f32x4){0.f, 0.f, 0.f, 0.f}, 0, 0, 0);
#pragma unroll
        for (int e = 0; e < 4; ++e) st[Jt][e] = (16 * Jt + 4 * kg + e <= 16 * It + fr) ? st[Jt][e] : 0.f; }
    const bf16x8 Sb01 = frag2(cvt4(st[0]), cvt4(st[1])), Sb23 = frag2(cvt4(st[2]), cvt4(st[3]));
    bf16* ftp = FT + (4 * kg) * 64 + 16 * It + fr;
#pragma unroll
    for (int vv = 0; vv < 2; ++vv) { const int Vt = 2 * vh + vv; const LAS bf16* vr = VT + (16 * Vt + fr) * 72 + 4 * kg;
        f32x4 f = (f32x4){0.f, 0.f, 0.f, 0.f};
        f = __builtin_amdgcn_mfma_f32_16x16x32_bf16(frag2(*(const LAS u32x2*)vr, *(const LAS u32x2*)(vr + 16)), Sb01, f, 0, 0, 0);
        f = __builtin_amdgcn_mfma_f32_16x16x32_bf16(frag2(*(const LAS u32x2*)(vr + 32), *(const LAS u32x2*)(vr + 48)), Sb23, f, 0, 0, 0);
#pragma unroll
        for (int e = 0; e < 4; ++e) ftp[(16 * Vt + e) * 64] = (bf16)f2bf(f[e]); }
    const int kt = w & 1, Vu = w >> 1;
    f32x4 uu = (f32x4){0.f, 0.f, 0.f, 0.f};
#pragma unroll
    for (int s = 0; s < 2; ++s) uu = __builtin_amdgcn_mfma_f32_16x16x32_bf16(*(const LAS bf16x8*)(KTT + (16 * kt + fr) * 72 + 32 * s + 8 * kg), *(const LAS bf16x8*)(VT + (16 * Vu + fr) * 72 + 32 * s + 8 * kg), uu, 0, 0, 0);
    *(u32x2*)(UT + (16 * Vu + fr) * 32 + 16 * kt + 4 * kg) = cvt4(uu);
}
__device__ __forceinline__ void gla_chain_units(CArgs& a, int chain, LAS unsigned char* lds, int w, int lane) {
    GlaIn A, B;
    asm volatile("" : "+v"(lane));
    gla_fetch(a, chain * 36, w, lane, A);
#pragma unroll 1
    for (int n = 0; n < 36; n += 2) {
        asm volatile("" : "+v"(lane));
        { gla_s1(a, chain * 36 + n, A, lds, w, lane); __syncthreads(); gla_fetch(a, chain * 36 + n + 1, w, lane, B); gla_s2(a, chain * 36 + n, lds, w, lane); }
        asm volatile("" : "+v"(lane));
        { gla_s1(a, chain * 36 + n + 1, B, lds + 24064, w, lane); __syncthreads(); if (n + 2 < 36) gla_fetch(a, chain * 36 + n + 2, w, lane, A); gla_s2(a, chain * 36 + n + 1, lds + 24064, w, lane); }
    }
}
__device__ __forceinline__ void gla_seq_wave(CArgs& a, int chain, int vs, int lane) {
    asm volatile("" : "+v"(lane));
    const int b = chain >> 3, h = (chain >> 1) & 3, dir = chain & 1, fr = lane & 15, kg = lane >> 4, v = 16 * vs + fr, step = dir ? -1 : 1;
    float* GO = (float*)(a.ws + WS_MIX + (dir ? MX_GOB : MX_GOF));
    f32x4 S[2] = {(f32x4){0.f, 0.f, 0.f, 0.f}, (f32x4){0.f, 0.f, 0.f, 0.f}};
#pragma unroll 1
    for (int n = 0; n < 36; ++n) {
        const int u = chain * 36 + n, r0 = scan_row(b, dir, n * 64);
        const bf16* QC = (const bf16*)(a.ws + WS_CKA + CA_QC) + (size_t)u * 2048; const bf16* FT = (const bf16*)(a.ws + WS_CKA + CA_FT) + (size_t)u * 4096;
        const float* UT = (const float*)(a.ws + WS_CKA + CA_UT) + (size_t)u * 2048; const float* DL = (const float*)(a.ws + WS_CKA + CA_DL) + (size_t)u * 32;
        u32x2 qf[4][2], ff[4]; f32x4 d4[2], u4[2];
#pragma unroll
        for (int t = 0; t < 4; ++t) { const bf16* qr = QC + (16 * t + fr) * 32; qf[t][0] = *(const u32x2*)(qr + 4 * kg); qf[t][1] = *(const u32x2*)(qr + 16 + 4 * kg); ff[t] = *(const u32x2*)(FT + v * 64 + 16 * t + 4 * kg); }
#pragma unroll
        for (int kt = 0; kt < 2; ++kt) { d4[kt] = *(const f32x4*)(DL + 16 * kt + 4 * kg); u4[kt] = *(const f32x4*)(UT + v * 32 + 16 * kt + 4 * kg); }
        const bf16x8 Sb = frag2(cvt4(S[0]), cvt4(S[1]));
        f32x4 o[4];
#pragma unroll
        for (int t = 0; t < 4; ++t) { o[t] = (f32x4){lo_bf(ff[t].x), hi_bf(ff[t].x), lo_bf(ff[t].y), hi_bf(ff[t].y)};
            o[t] = __builtin_amdgcn_mfma_f32_16x16x32_bf16(frag2(qf[t][0], qf[t][1]), Sb, o[t], 0, 0, 0); }
#pragma unroll
        for (int kt = 0; kt < 2; ++kt) S[kt] = d4[kt] * S[kt] + u4[kt];
#pragma unroll
        for (int t = 0; t < 4; ++t)
#pragma unroll
            for (int e = 0; e < 4; ++e) GO[(size_t)(r0 + step * (16 * t + 4 * kg + e)) * 256 + h * 64 + v] = o[t][e];
    }
}

template <int L>
__device__ __forceinline__ void hyena_unit(CArgs& a, int l, int c, LAS unsigned char* lds) {
    constexpr int Lt = L == SEQ ? 1 : 0, SOFF = L == SEQ ? CTXL : 0, CST = (2 * L + 16) * 2 + 32;
    constexpr int NTW = L / 16 / 8;
    const int tid = tidx(), lane = tid & 63, w = tid >> 6, fr = lane & 15, kg = lane >> 4;
    const float* kf = (const float*)(a.ws + WS_KUN) + ((size_t)((l * 2 + Lt) * 512 + c)) * 2048;
    const float* kb = kf + (size_t)256 * 2048;
    LAS float* red = (LAS float*)(lds + 8 * CST);
    const bf16* Z = (const bf16*)(a.ws + WS_MIX + MX_ZT) + ((size_t)(c * 16 + fr)) * 2304 + SOFF;
    const bf16* zp = Z + 8 * kg;
    bf16x8 zc[8];
#pragma unroll
    for (int ii = 0; ii < 8; ++ii) zc[ii] = *(const bf16x8*)(zp + 32 * ii);
    constexpr int NI = (2 * L + 16 + 511) / 512;
    float gv[NI];
    float s = 0.f;
#pragma unroll
    for (int q = 0; q < NI; ++q) {
        const int idx = tid + 512 * q, ic = min(max(idx, 1), 2 * L - 1);
        const float v = *(ic <= L ? kf + (L - ic) : kb + (ic - L));
        gv[q] = (idx >= 1 && idx < 2 * L) ? v : 0.f;
        s += fabsf(gv[q]);
    }
    s = wave_sum(s);
    if (lane == 0) red[w] = s;
    __syncthreads();
    float l1 = 0.f;
#pragma unroll
    for (int i = 0; i < 8; ++i) l1 += red[i];
    const float inv = 1.f / l1;
#pragma unroll
    for (int q = 0; q < NI; ++q) {
        const int idx = tid + 512 * q;
        const bf16 gb = (bf16)f2bf(gv[q] * inv);
        if (idx < 2 * L + 16) {
#pragma unroll
            for (int r = 0; r < 8; ++r) if (idx - r >= 0) *(LAS bf16*)(lds + r * CST + (idx - r) * 2) = gb;
        }
    }
    __syncthreads();
    bf16* YT = (bf16*)(a.ws + WS_MIX + MX_YT) + ((size_t)(c * 16 + fr)) * 2304 + SOFF;
    f32x4 acc[NTW];
#pragma unroll
    for (int j = 0; j < NTW; ++j) acc[j] = (f32x4){0.f, 0.f, 0.f, 0.f};
    const int rr = (8 - (fr & 7)) & 7;
    const LAS unsigned char* ap = lds + rr * CST + (((8 * kg - fr + L) >> 3) - 2 * w * NTW) * 16;
    if constexpr (L == SEQ) {
        static_assert(NTW == 16, "hyena_unit");
        bf16x8 zn[8], A[16];
#pragma unroll
        for (int j = 2; j < 16; ++j) A[j] = *(const LAS bf16x8*)(ap - 32 * j);
#pragma unroll 1
        for (int ib = 0; ib < 8; ++ib) {
            const bf16* zq = zp + 256 * (ib < 7 ? ib + 1 : 7);
#pragma unroll
            for (int ii = 0; ii < 8; ++ii) zn[ii] = *(const bf16x8*)(zq + 32 * ii);
#pragma unroll
            for (int ii = 0; ii < 8; ++ii) {
                A[(16 - 2 * ii) & 15] = *(const LAS bf16x8*)(ap + 64 * ii);
                A[(17 - 2 * ii) & 15] = *(const LAS bf16x8*)(ap + 64 * ii - 32);
#pragma unroll
                for (int jj = 0; jj < 16; ++jj) { const int j = (jj + 2) & 15; acc[j] = __builtin_amdgcn_mfma_f32_16x16x32_bf16(A[(j + 16 - 2 * ii) & 15], zc[ii], acc[j], 0, 0, 0); }
            }
            ap += 512;
#pragma unroll
            for (int ii = 0; ii < 8; ++ii) zc[ii] = zn[ii];
        }
    } else {
        static_assert(L == 256, "hyena_unit");
#pragma unroll
        for (int i = 0; i < 8; ++i)
#pragma unroll
            for (int j = 0; j < NTW; ++j) acc[j] = __builtin_amdgcn_mfma_f32_16x16x32_bf16(*(const LAS bf16x8*)(ap + (4 * i - 2 * j) * 16), zc[i], acc[j], 0, 0, 0);
    }
#pragma unroll
    for (int j = 0; j < NTW; ++j) *(u32x2*)(YT + 16 * (w * NTW + j) + 4 * kg) = (u32x2){pk2(acc[j][0], acc[j][1]), pk2(acc[j][2], acc[j][3])};
    __syncthreads();
}
__device__ __forceinline__ void ph_scan(CArgs& a, int l, LAS unsigned char* lds, int bid, int nblk, unsigned long long& tacc) {
    const int tid = tidx(), lane = tid & 63, w = __builtin_amdgcn_readfirstlane(tid >> 6);
    unsigned long long t0 = 0ull;
    if (PROBE_PH >= 20 && PROBE_PH < 50) t0 = __builtin_amdgcn_s_memrealtime();
#pragma unroll 1
    for (int c = bid; c < 256; c += nblk) {
        if (c < 128) {
            gdn_chain_units(a, c, lds, w, lane, tacc);
        } else {
            gla_chain_units(a, c - 128, lds, w, lane);
        }
        asm volatile("s_waitcnt vmcnt(0)" ::: "memory");
        __syncthreads();
        if (PROBE_PH == 20 && c < 128) tacc += __builtin_amdgcn_s_memrealtime() - t0;
        if (PROBE_PH == 24 && c >= 128) tacc += __builtin_amdgcn_s_memrealtime() - t0;
        if (PROBE_PH == 21) t0 = __builtin_amdgcn_s_memrealtime();
        if (c < 128) gdn_seq_block(a, c, lds, w, lane); else gla_seq_block(a, c - 128, lds, w, lane);
        __syncthreads();
        if (PROBE_PH == 21) tacc += __builtin_amdgcn_s_memrealtime() - t0;
    }
    if (PROBE_PH == 23) t0 = __builtin_amdgcn_s_memrealtime();
    if (nblk == 256) {
        if (bid < 128) hyena_unit<SEQ>(a, l, bid, lds);
        else { const int g = bid - 128; hyena_unit<SEQ>(a, l, 128 + g, lds); if (l != DEPTH - 1) { hyena_unit<CTXL>(a, l, 2 * g, lds); hyena_unit<CTXL>(a, l, 2 * g + 1, lds); } }
    } else {
        for (int it = bid; it < (l == DEPTH - 1 ? 256 : 512); it += nblk) { if (it < 256) hyena_unit<SEQ>(a, l, it, lds); else hyena_unit<CTXL>(a, l, it - 256, lds); }
    }
    if (PROBE_PH == 23) tacc += __builtin_amdgcn_s_memrealtime() - t0;
    if (PROBE_PH == 22) t0 = __builtin_amdgcn_s_memrealtime();
    {
        LAS unsigned char* scr = lds + w * 8448;
        if (nblk == 256) { const int per = bid < 128 ? 8 : 16, first = bid < 128 ? bid * 8 : 1024 + (bid - 128) * 16;
            CvbRegs r0, r1;
            cvb_load(a, l, first, w, lane, r0);
#pragma unroll 1
            for (int it = first; it < first + per; it += 2) {
                cvb_load(a, l, it + 1, w, lane, r1);
                cvb_store(a, it, w, lane, r0, lds);
                cvb_load(a, l, min(it + 2, first + per - 1), w, lane, r0);
                cvb_store(a, it + 1, w, lane, r1, lds + 36864); } }
        else tr_experts_range(a, l, scr, bid * 8 + w, NEXP * 3 * 512, nblk * 8, lane);
    }
    if (PROBE_PH == 22) tacc += __builtin_amdgcn_s_memrealtime() - t0;
}

__device__ __forceinline__ void ph_post_hyena(CArgs& a, int l, LAS unsigned char* lds, int bid, int nblk) {
    const bf16* P = (const bf16*)(a.ws + WS_P);
    const bf16* YT = (const bf16*)(a.ws + WS_MIX + MX_YT); bf16* YMIX = (bf16*)(a.ws + WS_YMIX);
    LAS float* yt = (LAS float*)lds;
    const int tid = tidx(), c4 = (tid & 63) * 4, tg = tid >> 6;
    const float* hw = a.in[I_HYCW] + l * 3 * 768; const float* hb = a.in[I_HYCB] + l * 768;
    f32x4 w0[3], wx[3], wv[3];
#pragma unroll
    for (int k = 0; k < 3; ++k) { w0[k] = *(const f32x4*)(hw + k * 768 + c4); wx[k] = *(const f32x4*)(hw + k * 768 + 256 + c4); wv[k] = *(const f32x4*)(hw + k * 768 + 512 + c4); }
    const f32x4 b0 = *(const f32x4*)(hb + c4), bx = *(const f32x4*)(hb + 256 + c4), bv = *(const f32x4*)(hb + 512 + c4), hd = *(const f32x4*)(a.in[I_HYD] + l * 256 + c4);
#pragma unroll 1
    for (int it = bid + (l == DEPTH - 1 ? 64 : 0); it < 576; it += nblk) {
        const Chunk c = chunk_of(it);
        const int soff = c.L == CTXL ? 0 : CTXL;
        { const int ch = tid & 255, half = tid >> 8;
          const bf16* srcp = YT + ((size_t)(ch * 16 + c.b)) * 2304 + soff + c.t0 + half * 32;
          u32x4 v8[4];
#pragma unroll
          for (int j = 0; j < 4; ++j) v8[j] = *(const u32x4*)(srcp + 8 * j);
#pragma unroll
          for (int j = 0; j < 4; ++j) { LAS float* d = yt + (half * 32 + 8 * j) * 260 + ch;
              d[0] = lo_bf(v8[j].x); d[260] = hi_bf(v8[j].x); d[2 * 260] = lo_bf(v8[j].y); d[3 * 260] = hi_bf(v8[j].y); d[4 * 260] = lo_bf(v8[j].z); d[5 * 260] = hi_bf(v8[j].z); d[6 * 260] = lo_bf(v8[j].w); d[7 * 260] = hi_bf(v8[j].w); } }
        __syncthreads();
        const int tb = c.t0 + tg * 8;
        const bf16* pb = P + (size_t)(c.row0 + tg * 8) * D_INP;
        f32x4 x0[10], x1[10], vv[10];
#pragma unroll
        for (int r = 0; r < 10; ++r) { const int t = tb + r - 1, tc = min(max(t, c.lo), c.hi - 1); const float ok = (t == tc) ? 1.f : 0.f; const bf16* p = pb + (ptrdiff_t)(tc - tb) * D_INP;
            x0[r] = ok * bf4(*(const u32x2*)(p + HY0 + c4));
            x1[r] = ok * bf4(*(const u32x2*)(p + HY0 + 256 + c4)); vv[r] = ok * bf4(*(const u32x2*)(p + HY0 + 512 + c4)); }
#pragma unroll
        for (int tt = 0; tt < 8; ++tt) {
            const f32x4 u0 = w0[0] * x0[tt] + w0[1] * x0[tt + 1] + w0[2] * x0[tt + 2] + b0;
            const f32x4 xx = wx[0] * x1[tt] + wx[1] * x1[tt + 1] + wx[2] * x1[tt + 2] + bx, v2 = wv[0] * vv[tt] + wv[1] * vv[tt + 1] + wv[2] * vv[tt + 2] + bv, z = xx * v2;
            const f32x4 y = *(const LAS f32x4*)(yt + (tg * 8 + tt) * 260 + c4);
            const f32x4 o = (y + z * hd) * u0;
            u32x2 oo; oo.x = pk2(o[0], o[1]); oo.y = pk2(o[2], o[3]); *(u32x2*)(YMIX + (size_t)(c.row0 + tg * 8 + tt) * D + c4) = oo;
        }
        __syncthreads();
    }
}
__device__ __forceinline__ void ph_post_tok(CArgs& a, int l, int gw, int ngw) {
    const int lane = tidx() & 63;
    const bf16* P = (const bf16*)(a.ws + WS_P); bf16* YMIX = (bf16*)(a.ws + WS_YMIX);
    const bf16* GOF = (const bf16*)(a.ws + WS_MIX + MX_GOF); const bf16* GOB = (const bf16*)(a.ws + WS_MIX + MX_GOB);
    const bf16* DOF = (const bf16*)(a.ws + WS_MIX + MX_DOF); const bf16* DOB = (const bf16*)(a.ws + WS_MIX + MX_DOB);
    const f32x4 nwa = *(const f32x4*)(a.in[I_GLANW] + l * 64 + (4 * lane & 63)), nwd = *(const f32x4*)(a.in[I_GDNNW] + l * 64 + (4 * lane & 63));
#pragma unroll 1
    for (int row0 = (l == DEPTH - 1 ? NTOK_C : 0) + gw; row0 < NTOK; row0 += 4 * ngw) {
        f32x4 og[4], od[4]; u32x2 r2[4], z2[4];
#pragma unroll
        for (int r = 0; r < 4; ++r) { const int row = min(row0 + r * ngw, NTOK - 1); const size_t o4 = (size_t)row * 256 + 4 * lane;
            og[r] = bf4(*(const u32x2*)(GOF + o4)) + bf4(*(const u32x2*)(GOB + o4)); od[r] = bf4(*(const u32x2*)(DOF + o4)) + bf4(*(const u32x2*)(DOB + o4));
            r2[r] = *(const u32x2*)(P + (size_t)row * D_INP + GLA0 + 512 + 4 * lane); z2[r] = *(const u32x2*)(P + (size_t)row * D_INP + GDN0 + 768 + 4 * lane); }
#pragma unroll
        for (int r = 0; r < 4; ++r) { const int row = row0 + r * ngw;
            if (row < NTOK) {
                float sg = og[r][0] * og[r][0] + og[r][1] * og[r][1] + og[r][2] * og[r][2] + og[r][3] * og[r][3], sd = od[r][0] * od[r][0] + od[r][1] * od[r][1] + od[r][2] * od[r][2] + od[r][3] * od[r][3];
                sg = row16_sum(sg); sd = row16_sum(sd);
                const float rg = rsqrtf(sg * (1.f / 64.f) + 1e-6f), rd = rsqrtf(sd * (1.f / 64.f) + 1e-6f);
                u32x2 w;
                w.x = pk2(og[r][0] * rg * nwa[0] * siluf_(lo_bf(r2[r].x)), og[r][1] * rg * nwa[1] * siluf_(hi_bf(r2[r].x))); w.y = pk2(og[r][2] * rg * nwa[2] * siluf_(lo_bf(r2[r].y)), og[r][3] * rg * nwa[3] * siluf_(hi_bf(r2[r].y)));
                *(u32x2*)(YMIX + (size_t)row * D + 512 + 4 * lane) = w;
                w.x = pk2(od[r][0] * rd * nwd[0] * siluf_(lo_bf(z2[r].x)), od[r][1] * rd * nwd[1] * siluf_(hi_bf(z2[r].x))); w.y = pk2(od[r][2] * rd * nwd[2] * siluf_(lo_bf(z2[r].y)), od[r][3] * rd * nwd[3] * siluf_(hi_bf(z2[r].y)));
                *(u32x2*)(YMIX + (size_t)row * D + 768 + 4 * lane) = w; } }
    }
}

__device__ __forceinline__ void ph_ln1_route(CArgs& a, int l, LAS unsigned char* lds, int bid, int nblk) {
    const int tid = tidx(), lane = tid & 63, w = __builtin_amdgcn_readfirstlane(tid >> 6);
    const float* MOD = (const float*)(a.ws + WS_MOD) + (size_t)l * 17 * 6144;
    bf16* X = (bf16*)(a.ws + WS_X); const bf16* TMP = (const bf16*)(a.ws + WS_TMP); bf16* HB = (bf16*)(a.ws + WS_HB);
    const float* lg = a.in[I_LN1G] + l * D; const float* lb = a.in[I_LN1B] + l * D;
    const float* br = a.in[I_BR] + l * NEXP;
    const bf16* wh = (const bf16*)(a.ws + WS_WRT) + (size_t)l * NEXP * D; const bf16* wl = wh + DEPTH * NEXP * D;
    unsigned* cnt = (unsigned*)(a.ws + WS_CTL) + CW_CNT + l * NEXP * 64;
    int* LIST = (int*)(a.ws + WS_LIST); int* TOPE = (int*)(a.ws + WS_TOPE); float* TOPW = (float*)(a.ws + WS_TOPW);
    LAS float* hrow = (LAS float*)lds;
    LAS float* part = (LAS float*)(lds + 65792);
    const int row_lo = (l == DEPTH - 1) ? NTOK_C : 0;
    const int e = lane & 31, par = lane >> 5, fr = lane & 15, kg = lane >> 4;
    u32x4 xw[2][4]; u32x2 tv[2][4];
#define LN1_FETCH(base_) do { _Pragma("unroll") for (int t = 0; t < 2; ++t) { const int row_ = (base_) + 2 * w + t; \
        if (l == 0) { const float* xs_ = row_ < NTOK_C ? a.in[I_CTX] + (size_t)row_ * D : a.in[I_X] + (size_t)(row_ - NTOK_C) * D; \
            _Pragma("unroll") for (int j = 0; j < 4; ++j) xw[t][j] = *(const u32x4*)(xs_ + j * 256 + 4 * lane); } \
        else { _Pragma("unroll") for (int j = 0; j < 4; ++j) { const u32x2 x2_ = *(const u32x2*)(X + (size_t)row_ * D + j * 256 + 4 * lane); xw[t][j] = (u32x4){x2_.x, x2_.y, 0u, 0u}; } } \
        _Pragma("unroll") for (int j = 0; j < 4; ++j) tv[t][j] = *(const u32x2*)(TMP + (size_t)row_ * D + j * 256 + 4 * lane); } } while (0)
    constexpr int CAP = 64;
    LAS unsigned* lcnt = (LAS unsigned*)(lds + 82176);
    LAS int* ent = (LAS int*)(lds + 82176 + 256);
    LAS float* entw = (LAS float*)(lds + 82176 + 256 + CAP * 256);
    if (tid < 32) lcnt[tid] = 0u;
    LAS float* mods = (LAS float*)(lds + 82176 + 256 + 2 * CAP * 256);
    LAS float* lgb = mods + 3072;
    { const int b0 = row_lo + bid * 16;
      if (b0 < NTOK) { const float* mv0 = MOD + (size_t)mod_vec(b0) * 6144 + 2048;
          for (int i = tid; i < 768; i += 512) *(LAS f32x4*)(mods + 4 * i) = *(const f32x4*)(mv0 + 4 * i); }
      if (tid < 256) *(LAS f32x4*)(lgb + 4 * tid) = *(const f32x4*)(lg + 4 * tid); else *(LAS f32x4*)(lgb + 1024 + 4 * (tid - 256)) = *(const f32x4*)(lb + 4 * (tid - 256)); }
    __syncthreads();
    int base = row_lo + bid * 16, base0 = base, nb = 0;
#define LN1_FLUSH do { __syncthreads(); \
        if (tid < 32) { const unsigned n_ = lcnt[tid]; unsigned g_ = 0u; if (n_) g_ = atomicAdd(cnt + tid * 64, n_); lcnt[32 + tid] = g_; lcnt[tid] = 0u; } \
        __syncthreads(); \
        for (int idx = tid; idx < nb * 64; idx += 512) { const int pe_ = ent[idx], ee_ = pe_ >> 20; const unsigned pos_ = lcnt[32 + ee_] + (unsigned)(pe_ & 0xfffff); \
            const int row_ = base0 + (idx >> 6) * nblk * 16 + ((idx >> 2) & 15); \
            LIST[(size_t)ee_ * NTOK + pos_] = row_; TOPE[(size_t)row_ * 4 + (idx & 3)] = (ee_ << 20) | (int)pos_; TOPW[(size_t)row_ * 4 + (idx & 3)] = entw[idx]; } \
        __syncthreads(); nb = 0; } while (0)
    if (base < NTOK) LN1_FETCH(base);
    bf16x8 Bh[4][2], Bl[4][2];
#pragma unroll
    for (int ss = 0; ss < 4; ++ss)
#pragma unroll
        for (int t = 0; t < 2; ++t) { const size_t wo = (size_t)(16 * t + fr) * D + 128 * w + 32 * ss + 8 * kg; Bh[ss][t] = *(const bf16x8*)(wh + wo); Bl[ss][t] = *(const bf16x8*)(wl + wo); }
    const float bre = br[e];
#pragma unroll 1
    for (; base < NTOK; base += nblk * 16) {
#pragma unroll
        for (int t = 0; t < 2; ++t) {
            const int row = base + 2 * w + t;
            f32x4 v[4]; float s = 0.f;
#pragma unroll
            for (int j = 0; j < 4; ++j) { const int c0 = j * 256 + 4 * lane; const f32x4 g1 = *(const LAS f32x4*)(mods + c0);
                const f32x4 xin = (l == 0) ? __builtin_bit_cast(f32x4, xw[t][j]) : (f32x4){lo_bf(xw[t][j].x), hi_bf(xw[t][j].x), lo_bf(xw[t][j].y), hi_bf(xw[t][j].y)};
                v[j] = DN_ALPHA * xin + g1 * (f32x4){lo_bf(tv[t][j].x), hi_bf(tv[t][j].x), lo_bf(tv[t][j].y), hi_bf(tv[t][j].y)}; s += (v[j][0] + v[j][1]) + (v[j][2] + v[j][3]); }
            const float mean = wave_sum(s) * (1.f / D); float s2 = 0.f;
#pragma unroll
            for (int j = 0; j < 4; ++j) { v[j] = v[j] - mean; s2 += (v[j][0] * v[j][0] + v[j][1] * v[j][1]) + (v[j][2] * v[j][2] + v[j][3] * v[j][3]); }
            const float rstd = rsqrtf(wave_sum(s2) * (1.f / D) + LN_EPS);
#pragma unroll
            for (int j = 0; j < 4; ++j) { const int c0 = j * 256 + 4 * lane; const f32x4 g = *(const LAS f32x4*)(lgb + c0), bb = *(const LAS f32x4*)(lgb + 1024 + c0), sh = *(const LAS f32x4*)(mods + 1024 + c0), sc = *(const LAS f32x4*)(mods + 2048 + c0);
                const f32x4 xn = v[j] * rstd * g + bb; *(u32x2*)(X + (size_t)row * D + c0) = (u32x2){pk2(xn[0], xn[1]), pk2(xn[2], xn[3])};
                const f32x4 hh = xn * (1.f + sc) + sh;
                *(unsigned*)(a.ws + WS_HB8 + (size_t)row * D + c0) = pk4_fp8(4.f * hh[0], 4.f * hh[1], 4.f * hh[2], 4.f * hh[3]);
                *(LAS f32x4*)(hrow + (2 * w + t) * 1028 + c0) = hh; }
        }
        __syncthreads();
        f32x4 mnext[2] = {(f32x4){0.f, 0.f, 0.f, 0.f}, (f32x4){0.f, 0.f, 0.f, 0.f}};
        const bool more = base + nblk * 16 < NTOK;
        if (more) { const float* mvn = MOD + (size_t)mod_vec(base + nblk * 16) * 6144 + 2048; mnext[0] = *(const f32x4*)(mvn + 4 * tid); if (tid < 256) mnext[1] = *(const f32x4*)(mvn + 2048 + 4 * tid); }
        if (more) LN1_FETCH(base + nblk * 16);
        {
            f32x4 acc[2] = {(f32x4){0.f, 0.f, 0.f, 0.f}, (f32x4){0.f, 0.f, 0.f, 0.f}};
#pragma unroll
            for (int ss = 0; ss < 4; ++ss) { const int k0 = 128 * w + 32 * ss + 8 * kg;
                const f32x4 h0 = *(const LAS f32x4*)(hrow + fr * 1028 + k0), h1 = *(const LAS f32x4*)(hrow + fr * 1028 + k0 + 4);
                u32x4 ah, al;
                ah.x = pk2(h0[0], h0[1]); ah.y = pk2(h0[2], h0[3]); ah.z = pk2(h1[0], h1[1]); ah.w = pk2(h1[2], h1[3]);
                al.x = pk2(h0[0] - lo_bf(ah.x), h0[1] - hi_bf(ah.x)); al.y = pk2(h0[2] - lo_bf(ah.y), h0[3] - hi_bf(ah.y)); al.z = pk2(h1[0] - lo_bf(ah.z), h1[1] - hi_bf(ah.z)); al.w = pk2(h1[2] - lo_bf(ah.w), h1[3] - hi_bf(ah.w));
                const bf16x8 Ah = __builtin_bit_cast(bf16x8, ah), Al = __builtin_bit_cast(bf16x8, al);
#pragma unroll
                for (int t = 0; t < 2; ++t) {
                    acc[t] = __builtin_amdgcn_mfma_f32_16x16x32_bf16(Ah, Bh[ss][t], acc[t], 0, 0, 0);
                    acc[t] = __builtin_amdgcn_mfma_f32_16x16x32_bf16(Ah, Bl[ss][t], acc[t], 0, 0, 0);
                    acc[t] = __builtin_amdgcn_mfma_f32_16x16x32_bf16(Al, Bh[ss][t], acc[t], 0, 0, 0); } }
#pragma unroll
            for (int t = 0; t < 2; ++t)
#pragma unroll
                for (int j = 0; j < 4; ++j) part[((w * 2 + t) * 16 + 4 * kg + j) * 16 + fr] = acc[t][j];
        }
        if (more) { *(LAS f32x4*)(mods + 4 * tid) = mnext[0]; if (tid < 256) *(LAS f32x4*)(mods + 2048 + 4 * tid) = mnext[1]; }
        __syncthreads();
        {
            float cur = bre;
#pragma unroll
            for (int ww = 0; ww < 8; ++ww) cur += part[((ww * 2 + (e >> 4)) * 16 + 2 * w + par) * 16 + (e & 15)];
            float tvv[4]; int ti[4];
#pragma unroll
            for (int k = 0; k < 4; ++k) { float bv = cur; int bi = e;
#define TOPSTEP(OV, OI) do { const float ov = (OV); const int oi = (OI); if (ov > bv || (ov == bv && oi < bi)) { bv = ov; bi = oi; } } while (0)
                TOPSTEP(dpp_f<0xB1>(bv), dpp_i<0xB1>(bi)); TOPSTEP(dpp_f<0x4E>(bv), dpp_i<0x4E>(bi)); TOPSTEP(dpp_f<0x141>(bv), dpp_i<0x141>(bi)); TOPSTEP(dpp_f<0x140>(bv), dpp_i<0x140>(bi));
                TOPSTEP(__shfl_xor(bv, 16), __shfl_xor(bi, 16));
#undef TOPSTEP
                tvv[k] = bv; ti[k] = bi; if (e == bi) cur = -3.0e38f; }
            const float e1 = __expf(tvv[1] - tvv[0]), e2 = __expf(tvv[2] - tvv[0]), e3 = __expf(tvv[3] - tvv[0]); const float inv = 1.f / (1.f + e1 + e2 + e3);
            if (e < 4) {
                const int ee = e == 0 ? ti[0] : e == 1 ? ti[1] : e == 2 ? ti[2] : ti[3]; const float ww = (e == 0 ? 1.f : e == 1 ? e1 : e == 2 ? e2 : e3) * inv;
                const unsigned lp = __hip_atomic_fetch_add(lcnt + ee, 1u, __ATOMIC_RELAXED, __HIP_MEMORY_SCOPE_WORKGROUP);
                const int idx = nb * 64 + w * 8 + par * 4 + e;
                ent[idx] = (ee << 20) | (int)lp; entw[idx] = ww; }
        }
        ++nb;
        if (nb == CAP) { LN1_FLUSH; base0 = base + nblk * 16; }
    }
    if (nb > 0) LN1_FLUSH;
#undef LN1_FLUSH
#undef LN1_FETCH
}
__device__ __forceinline__ void moe_tables(CArgs& a, int l, LAS unsigned char* lds, int NT) {
    LAS int* pre = (LAS int*)(lds + TAB_OFF); LAS int* mtl = pre + 40; LAS int* rowoff = pre + 80; LAS int* cn = pre + 120;
    if (tidx() < 64) {
        const int lane = tidx(), e = lane & 31;
        const unsigned* cnt = (const unsigned*)(a.ws + WS_CTL) + CW_CNT + l * NEXP * 64;
        const int n = (int)__hip_atomic_load(cnt + e * 64, __ATOMIC_RELAXED, __HIP_MEMORY_SCOPE_AGENT), m = (n + 255) >> 8;
        int incl = m;
#pragma unroll
        for (int d = 1; d < 32; d <<= 1) { const int t = __shfl_up(incl, d, 32); if (e >= d) incl += t; }
        const int excl = incl - m;
        if (lane < 32) { pre[e] = excl * NT; mtl[e] = m > 0 ? m : 1; rowoff[e] = excl * 256; cn[e] = n; if (e == 31) pre[32] = incl * NT; }
    }
    __syncthreads();
}
__device__ __forceinline__ void ph_ln2(CArgs& a, int l, LAS unsigned char* lds, int gw, int ngw) {
    const int lane = tidx() & 63;
    const float* MOD = (const float*)(a.ws + WS_MOD) + (size_t)l * 17 * 6144;
    bf16* X = (bf16*)(a.ws + WS_X); const unsigned char* YD = a.ws + WS_YD; bf16* HB = (bf16*)(a.ws + WS_HB);
    const float* lg = a.in[I_LN2G] + l * D; const float* lb = a.in[I_LN2B] + l * D;
    const int* TOPE = (const int*)(a.ws + WS_TOPE); const float* TOPW = (const float*)(a.ws + WS_TOPW);
    const LAS int* rowoff = (const LAS int*)(lds + TAB_OFF) + 80;
    const bool lastl = (l == DEPTH - 1);
    const int row_lo = lastl ? NTOK_C : 0;
    f32x4 lgv[4], lbv[4];
#pragma unroll
    for (int j = 0; j < 4; ++j) { lgv[j] = *(const f32x4*)(lg + j * 256 + 4 * lane); lbv[j] = *(const f32x4*)(lb + j * 256 + 4 * lane); }
    int te[2][4]; float tw[2][4];
    { const int row0 = min(row_lo + gw * 2, NTOK - 2);
#pragma unroll
      for (int r = 0; r < 2; ++r)
#pragma unroll
          for (int k = 0; k < 4; ++k) { te[r][k] = TOPE[(size_t)(row0 + r) * 4 + k]; tw[r][k] = TOPW[(size_t)(row0 + r) * 4 + k]; } }
#pragma unroll 1
    for (int row0 = row_lo + gw * 2; row0 < NTOK; row0 += ngw * 2) {
        unsigned y2[2][4][4]; u32x2 xv[2][4]; f32x4 g2v[4], shv[4], scv[4]; float cw[2][4];
        const float* mv = MOD + (size_t)mod_vec(row0) * 6144;
        const float* mvn = mv + 17 * 6144;
#pragma unroll
        for (int r = 0; r < 2; ++r) {
            const int row = row0 + r;
#pragma unroll
            for (int k = 0; k < 4; ++k) { cw[r][k] = tw[r][k] * (1.f / YD_SCALE);
                const unsigned char* yr = YD + ((size_t)(rowoff[te[r][k] >> 20] + (te[r][k] & 0xfffff))) * D;
#pragma unroll
                for (int j = 0; j < 4; ++j) y2[r][k][j] = *(const unsigned*)(yr + j * 256 + 4 * lane); }
#pragma unroll
            for (int j = 0; j < 4; ++j) xv[r][j] = *(const u32x2*)(X + (size_t)row * D + j * 256 + 4 * lane);
        }
#pragma unroll
        for (int j = 0; j < 4; ++j) { const int c0 = j * 256 + 4 * lane; g2v[j] = *(const f32x4*)(mv + 5120 + c0);
            if (!lastl) { shv[j] = *(const f32x4*)(mvn + c0); scv[j] = *(const f32x4*)(mvn + 1024 + c0); } else { shv[j] = (f32x4){0.f, 0.f, 0.f, 0.f}; scv[j] = shv[j]; } }
        { const int rown = min(row0 + ngw * 2, NTOK - 2);
#pragma unroll
          for (int r = 0; r < 2; ++r)
#pragma unroll
              for (int k = 0; k < 4; ++k) { te[r][k] = TOPE[(size_t)(rown + r) * 4 + k]; tw[r][k] = TOPW[(size_t)(rown + r) * 4 + k]; } }
#pragma unroll
        for (int r = 0; r < 2; ++r) {
            const int row = row0 + r;
            f32x4 v[4]; float s = 0.f;
#pragma unroll
            for (int j = 0; j < 4; ++j) { f32x4 f = (f32x4){0.f, 0.f, 0.f, 0.f};
#pragma unroll
                for (int k = 0; k < 4; ++k) { const int yy = (int)y2[r][k][j]; const f32x2 ya = __builtin_amdgcn_cvt_pk_f32_fp8(yy, false), yb = __builtin_amdgcn_cvt_pk_f32_fp8(yy, true); f += cw[r][k] * (f32x4){ya[0], ya[1], yb[0], yb[1]}; }
                v[j] = DN_ALPHA * (f32x4){lo_bf(xv[r][j].x), hi_bf(xv[r][j].x), lo_bf(xv[r][j].y), hi_bf(xv[r][j].y)} + g2v[j] * f; s += (v[j][0] + v[j][1]) + (v[j][2] + v[j][3]); }
            const float mean = wave_sum(s) * (1.f / D); float s2 = 0.f;
#pragma unroll
            for (int j = 0; j < 4; ++j) { v[j] = v[j] - mean; s2 += (v[j][0] * v[j][0] + v[j][1] * v[j][1]) + (v[j][2] * v[j][2] + v[j][3] * v[j][3]); }
            const float rstd = rsqrtf(wave_sum(s2) * (1.f / D) + LN_EPS);
#pragma unroll
            for (int j = 0; j < 4; ++j) { const int c0 = j * 256 + 4 * lane;
                const f32x4 xn = v[j] * rstd * lgv[j] + lbv[j];
                if (lastl) *(f32x4*)(a.out + (size_t)(row - NTOK_C) * D + c0) = xn;
                else { *(u32x2*)(X + (size_t)row * D + c0) = (u32x2){pk2(xn[0], xn[1]), pk2(xn[2], xn[3])}; const f32x4 hh = xn * (1.f + scv[j]) + shv[j];
                    u32x2 o; o.x = pk2(hh[0], hh[1]); o.y = pk2(hh[2], hh[3]); *(u32x2*)(HB + (size_t)row * D + c0) = o; } }
        }
    }
}

constexpr int NPH = 2 + DEPTH * 9;
__device__ __forceinline__ CArgs* kargs() { CArgs* p = (CArgs*)__builtin_amdgcn_kernarg_segment_ptr(); asm volatile("" : "+s"(p)); return p; }
__global__ void __launch_bounds__(512, 2) trunk_fwd(Args a_unused) {
    extern __shared__ __attribute__((aligned(16))) unsigned char lds_raw[];
    LAS unsigned char* lds = (LAS unsigned char*)lds_raw;
    const int tid = threadIdx.x, wave = __builtin_amdgcn_readfirstlane(tid >> 6);
    const int bid = blockIdx.x, nblk = gridDim.x, gw = bid * 8 + wave, ngw = nblk * 8;
    volatile LAS unsigned* MISC = (volatile LAS unsigned*)(lds + MISC_OFF);
    if (tid < 64) MISC[tid] = 0u;
    __syncthreads();
    XcdBarrier bar; bar.x = 0; bar.st = nullptr;
    int lo, hi;
    { CArgs& a = *kargs(); lo = a.ph_lo; hi = a.ph_hi; bar.bar = (unsigned*)(a.ws + WS_CTL) + CW_BAR;
      if (hi - lo > 1) bar = xcd_barrier_post((unsigned*)(a.ws + WS_CTL) + CW_BAR, MISC); }
#define IN(k) (lo <= (k) && (k) < hi)
    unsigned long long tacc = 0ull, tbeg = 0ull;
#define PB_BEG(ty) do { if (PROBE_PH == (ty)) tbeg = __builtin_amdgcn_s_memrealtime(); } while (0)
#define PB_END(ty) do { if (PROBE_PH == (ty)) tacc += __builtin_amdgcn_s_memrealtime() - tbeg; } while (0)
#define SEAM(k) do { if (IN(k) && IN((k) + 1)) xcd_barrier(bar); } while (0)
    PB_BEG(0);
    if (IN(0)) { CArgs& a = *kargs(); unsigned long long t0 = 0ull;
#define PB_SUB(ty, stmt) do { if (PROBE_PH == (ty)) t0 = __builtin_amdgcn_s_memrealtime(); stmt; if (PROBE_PH == (ty)) tacc += __builtin_amdgcn_s_memrealtime() - t0; } while (0)
        PB_SUB(30, ph_mod(a, lds, bid, nblk)); __syncthreads(); PB_SUB(31, ph_filters(a, ngw - 1 - gw, ngw)); PB_SUB(32, ph_tr_small(a, lds, ngw - 1 - gw, ngw));        PB_SUB(33, ph_router_w(a, bid * 512 + tid, nblk * 512));
#undef PB_SUB
    }
    SEAM(0); PB_END(0); PB_BEG(1);
    if (IN(1)) { CArgs& a = *kargs(); ph_mod_input(a, gw, ngw); }
    SEAM(1); PB_END(1);
#pragma unroll 1
    for (int l = 0; l < DEPTH; ++l) {
        const int p0 = 2 + 9 * l;
        const bool lastl = (l == DEPTH - 1);
        PB_BEG(2);
        if (IN(p0 + 0)) {
            CArgs& a = *kargs();
            pg8::DenseSched S; S.init((const bf16*)(a.ws + WS_WIN) + (size_t)l * D_INP * 1024, 1024, NTOK, D_INP, nblk, bid, 0);
            pg8::EpiBf16 E{(bf16*)(a.ws + WS_P), D_INP, 0};
            pg8::gemm_phase<pg8::EpiBf16, pg8::DenseSched, true>(lds, (const char*)(a.ws + WS_HB), 1024, S, E);
        }
        SEAM(p0 + 0); PB_END(2); PB_BEG(3);
        if (IN(p0 + 1)) { CArgs& a = *kargs(); PB_BEG(50); ph_prep_conv(a, l, lds, bid, nblk); PB_END(50); PB_BEG(51); ph_prep_tok(a, l, lds, ngw - 1 - gw, ngw);        PB_END(51); }
        SEAM(p0 + 1); PB_END(3); PB_BEG(4);
        if (IN(p0 + 2)) { CArgs& a = *kargs(); ph_scan(a, l, lds, bid, nblk, tacc); }
        SEAM(p0 + 2); PB_END(4); PB_BEG(5);
        if (IN(p0 + 3)) { CArgs& a = *kargs(); PB_BEG(52); ph_post_hyena(a, l, lds, bid, nblk); PB_END(52); PB_BEG(53); ph_post_tok(a, l, ngw - 1 - gw, ngw); PB_END(53); }
        SEAM(p0 + 3); PB_END(5); PB_BEG(6);
        if (IN(p0 + 4)) {
            CArgs& a = *kargs();
            const int r0 = lastl ? NTOK_C : 0;
            pg8::DenseSched S; S.init((const bf16*)(a.ws + WS_WOUT) + (size_t)l * 1024 * 1024, 1024, NTOK - r0, 1024, nblk, bid, r0);
            pg8::EpiBf16 E{(bf16*)(a.ws + WS_TMP), 1024, r0};
            pg8::gemm_phase<pg8::EpiBf16, pg8::DenseSched, true>(lds, (const char*)(a.ws + WS_YMIX), 1024, S, E);
        }
        SEAM(p0 + 4); PB_END(6); PB_BEG(7);
        if (IN(p0 + 5)) { CArgs& a = *kargs(); ph_ln1_route(a, l, lds, bid, nblk); }
        SEAM(p0 + 5); PB_END(7); PB_BEG(8);
        if (IN(p0 + 6)) {
            CArgs& a = *kargs();
            moe_tables(a, l, lds, 8);
            const LAS int* tb = (const LAS int*)(lds + TAB_OFF);
            pg8::MoeSched<true, 8> S; S.Bt = (const char*)(a.ws + WS_WGU); S.bstride = (size_t)2048 * 1024; S.rb = 1024; S.list = (const int*)(a.ws + WS_LIST);
            S.pre = tb; S.mtl = tb + 40; S.rowoff = tb + 80; S.cnt = tb + 120; S.K = 1024; S.G = nblk; S.c = (nblk % 8 == 0) ? (bid % 8) * (nblk / 8) + bid / 8 : bid; S.total = tb[32];
            pg8::EpiSwiglu E{(bf16*)(a.ws + WS_H), a.in[I_BG] + (size_t)l * NEXP * 1024, a.in[I_BU] + (size_t)l * NEXP * 1024, tb + 80, 1.f / 128.f};
            pg8::gemm_phase_f8g<pg8::EpiSwiglu, pg8::MoeSched<true, 8>, true>(lds, (const char*)(a.ws + WS_HB8), 1024, S, E);
        }
        SEAM(p0 + 6); PB_END(8); PB_BEG(9);
        if (IN(p0 + 7)) {
            CArgs& a = *kargs();
            moe_tables(a, l, lds, 4);
            const LAS int* tb = (const LAS int*)(lds + TAB_OFF);
            pg8::MoeSched<false, 4> S; S.Bt = (const char*)(a.ws + WS_WD); S.bstride = (size_t)1024 * 1024; S.rb = 1024; S.list = nullptr;
            S.pre = tb; S.mtl = tb + 40; S.rowoff = tb + 80; S.cnt = tb + 120; S.K = 1024; S.G = nblk; S.c = (nblk % 8 == 0) ? (bid % 8) * (nblk / 8) + bid / 8 : bid; S.total = tb[32];
            pg8::EpiDown E{(bf16*)(a.ws + WS_YD), a.in[I_BD] + (size_t)l * NEXP * 1024, tb + 80, 1.f / 128.f};
            pg8::gemm_phase_f8<pg8::EpiDown, pg8::MoeSched<false, 4>, true>(lds, (const char*)(a.ws + WS_H), 1024, S, E);
        }
        SEAM(p0 + 7); PB_END(9); PB_BEG(10);
        if (IN(p0 + 8)) { CArgs& a = *kargs(); moe_tables(a, l, lds, 4); ph_ln2(a, l, lds, gw, ngw); }
        if (!lastl) SEAM(p0 + 8);
        PB_END(10);
    }
    if (PROBE_PH >= 0) { const unsigned long long t0 = __builtin_amdgcn_s_memrealtime(); while (__builtin_amdgcn_s_memrealtime() - t0 < tacc) __builtin_amdgcn_s_sleep(8); }
#undef IN
#undef SEAM
}

extern "C" void kernel_launch(void* const* d_in, const int* in_sizes, int n_in, void* d_out, int out_size, void* d_ws, size_t ws_size, hipStream_t stream) {
    static int grid = 0;
    if (grid == 0) {
        if (n_in != 39 || out_size != NTOK_L * D || ws_size < WS_END) { fprintf(stderr, "kernel_launch: unexpected problem (n_in %d, out %d, ws %zu < %zu)\n", n_in, out_size, ws_size, (size_t)WS_END); grid = -1; return; }
        int dev = 0, cus = 0, per_cu = 0;
        if (hipGetDevice(&dev) != hipSuccess || hipDeviceGetAttribute(&cus, hipDeviceAttributeMultiprocessorCount, dev) != hipSuccess) { grid = -1; return; }
        if (hipFuncSetAttribute((const void*)trunk_fwd, hipFuncAttributeMaxDynamicSharedMemorySize, LDS_BYTES) != hipSuccess) { fprintf(stderr, "kernel_launch: hipFuncSetAttribute failed\n"); grid = -1; return; }
        if (hipOccupancyMaxActiveBlocksPerMultiprocessor(&per_cu, (const void*)trunk_fwd, 512, LDS_BYTES) != hipSuccess || per_cu < 1) fprintf(stderr, "kernel_launch: occupancy query says %d\n", per_cu);
        (void)hipGetLastError();
        grid = cus;
    }
    if (grid < 0) return;
    (void)hipMemsetAsync((char*)d_ws + WS_CTL, 0, CTL_ZERO_BYTES, stream);
    Args a{};
    for (int i = 0; i < 39; ++i) a.in[i] = (const float*)d_in[i];
    a.out = (float*)d_out; a.ws = (unsigned char*)d_ws;
#if MK_FUSED
    a.ph_lo = 0; a.ph_hi = NPH;
    hipLaunchKernelGGL(trunk_fwd, dim3(grid), dim3(512), LDS_BYTES, stream, a);
#else
    for (int p = 0; p < NPH; ++p) { a.ph_lo = p; a.ph_hi = p + 1; hipLaunchKernelGGL(trunk_fwd, dim3(grid), dim3(512), LDS_BYTES, stream, a); }
#endif
}
```
